# Optimizing an MI355X kernel written in HIP

```python
import jax, jax.numpy as jnp
from jax import lax
import numpy as np

D_MODEL = 1024
BATCH = 8
SEQ = 8192
DEPTH = 1

CONV_DIM = 512
CONV_GROUPS = 8
CONV_K = 3
RWKV_HEADS = 8
RWKV_HEAD_DIM = 64
RWKV_DIM = RWKV_HEADS * RWKV_HEAD_DIM
DECAY_RANK = 64
ICLR_RANK = 64
GATE_RANK = 128
DECAY_SCALE = 0.6065306597126334
GN_EPS = 64e-5
CONV_PROJ = 3 * CONV_DIM
RWKV_PROJ = 3 * RWKV_DIM + DECAY_RANK + ICLR_RANK + GATE_RANK
GATE_PROJ = 2 * D_MODEL
IN_PROJ = CONV_PROJ + RWKV_PROJ + GATE_PROJ
PEER_HEADS = 8
PEER_NKEYS = 128
PEER_EXPERTS = PEER_NKEYS * PEER_NKEYS
PEER_QDIM = 256
PEER_HALF = PEER_QDIM // 2
PEER_TOPK = 16
PEER_TOKEN_BLOCK = 128
PLE_DIM = 256
NORM_EPS = 1e-6

kernel_name = "hybrid_conv_rwkv7_peer_block"


def rmsnorm(x, g):
    xf = x.astype(jnp.float32)
    y = xf * lax.rsqrt(jnp.mean(xf * xf, axis=-1, keepdims=True) + NORM_EPS)
    return y.astype(x.dtype) * g


def short_conv_mixer(z, conv_w, conv_b):
    gate_b, gate_c, x_in = jnp.split(z, 3, axis=-1)
    u = gate_c * x_in
    y = lax.conv_general_dilated(u, conv_w[:, None, :], window_strides=(1,), padding=[(CONV_K - 1, 0)],
                                 dimension_numbers=('NWC', 'WIO', 'NWC'), feature_group_count=CONV_DIM)
    return gate_b * (y + conv_b)


def rwkv7_scan(r, w, k, v, kk, a):
    bsz, _, nh, nd = r.shape
    xs = tuple(jnp.moveaxis(t, 1, 0) for t in (r, w, k, v, kk, a))

    def step(S, inp):
        r_t, w_t, k_t, v_t, kk_t, a_t = inp
        s_kk = jnp.einsum('bhvk,bhk->bhv', S, kk_t)
        S = (S * w_t[:, :, None, :] - s_kk[..., None] * (kk_t * a_t)[:, :, None, :]
             + v_t[..., None] * k_t[:, :, None, :])
        return S, jnp.einsum('bhvk,bhk->bhv', S, r_t)

    s0 = jnp.zeros((bsz, nh, nd, nd), jnp.float32)
    _, ys = lax.scan(step, s0, xs)
    return jnp.moveaxis(ys, 0, 1)


def rwkv7_mixer(z, shift_mu, w0, w_up, a0, a_up, g_up, k_k, k_a, r_k, ln_g, ln_b):
    bsz, seq, _ = z.shape
    f32 = jnp.float32
    z_prev = jnp.pad(z, ((0, 0), (1, 0), (0, 0)))[:, :-1]
    z = z + shift_mu * (z_prev - z)
    r, k, v, wd, ad, gd = jnp.split(
        z, [RWKV_DIM, 2 * RWKV_DIM, 3 * RWKV_DIM, 3 * RWKV_DIM + DECAY_RANK,
            3 * RWKV_DIM + DECAY_RANK + ICLR_RANK], axis=-1)
    d = (w0 + jnp.tanh(wd) @ w_up).astype(f32)
    decay = jnp.exp(-DECAY_SCALE * jax.nn.sigmoid(d))
    a = jax.nn.sigmoid(a0 + ad @ a_up)
    g = jax.nn.sigmoid(gd) @ g_up
    heads = lambda t: t.reshape(bsz, seq, RWKV_HEADS, RWKV_HEAD_DIM).astype(f32)
    kk = heads(k * k_k)
    kk = kk * lax.rsqrt(jnp.sum(kk * kk, axis=-1, keepdims=True) + 1e-12)
    k = k * (1.0 + (a - 1.0) * k_a)
    rh, kh, vh, ah, wh = heads(r), heads(k), heads(v), heads(a), heads(decay)
    y = rwkv7_scan(rh, wh, kh, vh, kk, ah)
    mu = jnp.mean(y, axis=-1, keepdims=True)
    var = jnp.mean(jnp.square(y - mu), axis=-1, keepdims=True)
    y = ((y - mu) * lax.rsqrt(var + GN_EPS)).reshape(bsz, seq, RWKV_DIM) * ln_g + ln_b
    bonus = jnp.sum(rh * kh * r_k.astype(f32), axis=-1, keepdims=True) * vh
    y = (y + bonus.reshape(bsz, seq, RWKV_DIM)) * g
    return y.astype(z.dtype)


def peer_ffn(u, wq, subkeys, tab_u, tab_v):
    bsz, seq, dm = u.shape
    blocks = u.reshape(-1, PEER_TOKEN_BLOCK, dm)

    def one_block(xb):
        tb = xb.shape[0]
        q = (xb @ wq).reshape(tb, PEER_HEADS, 2, PEER_HALF)
        s = jnp.einsum('thcd,hcnd->thcn', q, subkeys)
        sv, si = lax.top_k(s, PEER_TOPK)
        cand_s = (sv[:, :, 0, :, None] + sv[:, :, 1, None, :]).reshape(tb, PEER_HEADS, PEER_TOPK * PEER_TOPK)
        cand_i = (si[:, :, 0, :, None] * PEER_NKEYS + si[:, :, 1, None, :]).reshape(tb, PEER_HEADS, PEER_TOPK * PEER_TOPK)
        top_s, pos = lax.top_k(cand_s, PEER_TOPK)
        idx = jnp.take_along_axis(cand_i, pos, axis=-1)
        gate = jax.nn.softmax(top_s.astype(jnp.float32), axis=-1).astype(xb.dtype)
        hid = jax.nn.gelu(jnp.einsum('td,thkd->thk', xb, tab_u[idx]))
        return jnp.einsum('thk,thkd->td', gate * hid, tab_v[idx])

    return lax.map(one_block, blocks).reshape(bsz, seq, dm)


def setup_inputs(seed: int = 0) -> dict:
    key = jax.random.key(seed)
    ks = iter(jax.random.split(key, 40))
    nrm = lambda shape, scale: jax.random.normal(next(ks), shape, jnp.float32) * scale
    L = DEPTH
    return {
        'x': nrm((BATCH, SEQ, D_MODEL), 1.0),
        'p': nrm((DEPTH, BATCH, SEQ, PLE_DIM), 1.0),
        'norm_mix_g': 1.0 + nrm((L, D_MODEL), 0.02),
        'w_in': nrm((L, D_MODEL, IN_PROJ), D_MODEL ** -0.5),
        'conv_w': nrm((L, CONV_K, CONV_DIM), CONV_K ** -0.5),
        'conv_b': nrm((L, CONV_DIM), 0.01),
        'shift_mu': jax.random.uniform(next(ks), (L, RWKV_PROJ), jnp.float32),
        'w0': nrm((L, RWKV_DIM), 0.5),
        'w_up': nrm((L, DECAY_RANK, RWKV_DIM), 0.5 * DECAY_RANK ** -0.5),
        'a0': nrm((L, RWKV_DIM), 0.5),
        'a_up': nrm((L, ICLR_RANK, RWKV_DIM), 0.5 * ICLR_RANK ** -0.5),
        'g_up': nrm((L, GATE_RANK, RWKV_DIM), GATE_RANK ** -0.5),
        'k_k': 0.85 + nrm((L, RWKV_DIM), 0.05),
        'k_a': 1.0 + nrm((L, RWKV_DIM), 0.05),
        'r_k': nrm((L, RWKV_HEADS, RWKV_HEAD_DIM), 0.1),
        'ln_x_g': 1.0 + nrm((L, RWKV_DIM), 0.02),
        'ln_x_b': nrm((L, RWKV_DIM), 0.01),
        'w_branch_a': nrm((L, CONV_DIM, D_MODEL), CONV_DIM ** -0.5),
        'w_branch_b': nrm((L, RWKV_DIM, D_MODEL), RWKV_DIM ** -0.5),
        'w_out': nrm((L, D_MODEL, D_MODEL), D_MODEL ** -0.5),
        'norm_ffn_g': 1.0 + nrm((L, D_MODEL), 0.02),
        'peer_wq': nrm((L, D_MODEL, PEER_HEADS * PEER_QDIM), D_MODEL ** -0.5),
        'peer_subkeys': nrm((L, PEER_HEADS, 2, PEER_NKEYS, PEER_HALF), PEER_HALF ** -0.5),
        'peer_u': nrm((L, PEER_EXPERTS, D_MODEL), D_MODEL ** -0.5),
        'peer_v': nrm((L, PEER_EXPERTS, D_MODEL), (PEER_HEADS * PEER_TOPK) ** -0.5),
        'norm_ple_g': 1.0 + nrm((L, D_MODEL), 0.02),
        'ple_gate_w': nrm((L, D_MODEL, D_MODEL), D_MODEL ** -0.5),
        'ple_proj_w': nrm((L, PLE_DIM, D_MODEL), PLE_DIM ** -0.5),
        'final_norm_g': 1.0 + nrm((D_MODEL,), 0.02),
    }


def reference(x, p, norm_mix_g, w_in, conv_w, conv_b, shift_mu, w0, w_up, a0, a_up, g_up,
              k_k, k_a, r_k, ln_x_g, ln_x_b, w_branch_a, w_branch_b, w_out, norm_ffn_g,
              peer_wq, peer_subkeys, peer_u, peer_v, norm_ple_g, ple_gate_w, ple_proj_w,
              final_norm_g):
    h = x
    for i in range(DEPTH):
        xn = rmsnorm(h, norm_mix_g[i])
        z = xn @ w_in[i]
        z_conv = z[..., :CONV_PROJ]
        z_rwkv = z[..., CONV_PROJ:CONV_PROJ + RWKV_PROJ]
        gate_a, gate_b = jnp.split(z[..., CONV_PROJ + RWKV_PROJ:], 2, axis=-1)
        y_a = short_conv_mixer(z_conv, conv_w[i], conv_b[i]) @ w_branch_a[i]
        y_b = rwkv7_mixer(z_rwkv, shift_mu[i], w0[i], w_up[i], a0[i], a_up[i], g_up[i],
                          k_k[i], k_a[i], r_k[i], ln_x_g[i], ln_x_b[i]) @ w_branch_b[i]
        merged = jax.nn.sigmoid(gate_a) * y_a + jax.nn.sigmoid(gate_b) * y_b
        h = h + merged @ w_out[i]
        h = h + peer_ffn(rmsnorm(h, norm_ffn_g[i]), peer_wq[i], peer_subkeys[i], peer_u[i], peer_v[i])
        ple_gate = jax.nn.sigmoid(rmsnorm(h, norm_ple_g[i]) @ ple_gate_w[i])
        h = h + ple_gate * (p[i] @ ple_proj_w[i])
    return rmsnorm(h, final_norm_g)
```

```cpp
#include <hip/hip_runtime.h>
#include <hip/hip_cooperative_groups.h>
#include <cstdio>
namespace cg = cooperative_groups;

#ifndef ONE_LAUNCH
#define ONE_LAUNCH 1
#endif

#define LAS __attribute__((address_space(3)))
typedef _Float16 h16;
typedef _Float16 h16x8 __attribute__((ext_vector_type(8)));
typedef _Float16 h16x4 __attribute__((ext_vector_type(4)));
typedef _Float16 h16x2 __attribute__((ext_vector_type(2)));
typedef float f32x4 __attribute__((ext_vector_type(4)));
typedef float f32x2 __attribute__((ext_vector_type(2)));
typedef unsigned u32x4 __attribute__((ext_vector_type(4)));
typedef unsigned u32x2 __attribute__((ext_vector_type(2)));

constexpr int MTOK = 65536, DM = 1024, SEQ = 8192, NB = 8;
constexpr int NIN = 5376;
constexpr int NTHREADS = 512, NWAVES = 8, NBLK = 256;
constexpr int LDS_BYTES = 131072;
constexpr float NORM_EPS = 1e-6f;

constexpr size_t MiB = 1u << 20;
constexpr size_t O_WIN = 0;
constexpr size_t O_WA = O_WIN + (size_t)5376 * 1024 * 2;
constexpr size_t O_WB = O_WA + 1 * MiB;
constexpr size_t O_WO = O_WB + 1 * MiB;
constexpr size_t O_WG = O_WO + 2 * MiB;
constexpr size_t O_WP = O_WG + 2 * MiB;
constexpr size_t O_WLR = O_WP + MiB / 2;
constexpr size_t O_WS = O_WLR + 3 * MiB / 4;
constexpr size_t O_U16 = O_WS + 4 * MiB;
constexpr size_t O_V16 = O_U16 + 32 * MiB;
constexpr size_t O_P16 = O_V16 + 32 * MiB;
constexpr size_t O_PART1 = O_P16 + 32 * MiB;
constexpr size_t O_PART3 = O_PART1 + 4 * MiB;
constexpr size_t O_RS1 = O_PART3 + 4 * MiB;
constexpr size_t O_RS2 = O_RS1 + MiB / 4;
constexpr size_t O_XN = O_RS2 + MiB / 4;
constexpr size_t O_ZC = O_XN + 128 * MiB;
constexpr size_t O_ZR = O_ZC + 192 * MiB;
constexpr size_t O_ZG = O_ZR + 224 * MiB;
constexpr size_t WS_END = O_ZG + 256 * MiB;
constexpr size_t O_CA = O_XN;
constexpr size_t O_APR = O_XN + 64 * MiB;
constexpr size_t O_H1B = O_XN;
constexpr size_t O_WD = O_ZC;
constexpr size_t O_BD = O_ZC + 64 * MiB;
constexpr size_t O_GG = O_ZC + 128 * MiB;
constexpr size_t O_MERGED = O_ZC;
constexpr size_t O_H2B = O_ZC;
constexpr size_t O_PQ = O_ZR;
constexpr size_t O_SST = O_ZR + 64 * MiB;
constexpr size_t O_Y = O_ZR + 96 * MiB;
constexpr size_t O_YB = O_ZR + 160 * MiB;
constexpr size_t O_IDX = O_ZR;
constexpr size_t O_GATE = O_ZR + 16 * MiB;
constexpr size_t O_PP = O_ZR + 64 * MiB;
constexpr size_t O_SCORES = O_ZG;

struct Args {
    const float* in[29];
    float* out;
    unsigned char* ws;
    int ph_lo, ph_hi;
};

__device__ __forceinline__ int tid_() { int t = threadIdx.x; asm volatile("" : "+v"(t)); return t; }
__device__ __forceinline__ float sigmoidf_(float x) { return __builtin_amdgcn_rcpf(1.0f + __expf(-x)); }
__device__ __forceinline__ float wave_sum(float v) {
#pragma unroll
    for (int o = 1; o < 64; o <<= 1) v += __shfl_xor(v, o);
    return v;
}
__device__ __forceinline__ h16x8 pack8(f32x4 a, f32x4 b) {
    h16x8 r;
    r[0] = (h16)a[0]; r[1] = (h16)a[1]; r[2] = (h16)a[2]; r[3] = (h16)a[3];
    r[4] = (h16)b[0]; r[5] = (h16)b[1]; r[6] = (h16)b[2]; r[7] = (h16)b[3];
    return r;
}
__device__ __forceinline__ h16x4 pack4(f32x4 a) {
    h16x4 r; r[0] = (h16)a[0]; r[1] = (h16)a[1]; r[2] = (h16)a[2]; r[3] = (h16)a[3]; return r;
}

namespace pg8 {
constexpr int BM = 256, BK = 64, HALF = 128, HTB = HALF * BK * 2, STAGE_BYTES = 8 * HTB, NXCD = 8, WGM = 8;
__device__ __forceinline__ int lds_byte(int r, int c) { const int st = (r >> 4) * 2 + (c >> 5), rr = r & 15, cc = c & 31, ob = rr * 64 + cc * 2; return st * 1024 + (ob ^ (((ob >> 9) & 1) << 5)); }
__device__ __forceinline__ void stage_rc(int b, int& R, int& C) { const int st = b / 1024, sb = b % 1024, swz = sb ^ (((sb >> 9) & 1) << 5); R = (st >> 1) * 16 + swz / 64; C = (st & 1) * 32 + (swz % 64) / 2; }
__device__ __forceinline__ int perm32(int rho) { const int n = rho >> 4, i = rho & 15; return 8 * (i >> 2) + 4 * n + (i & 3); }

struct Unit { int pm, pn; };
struct Gemm { const h16* A; const h16* Bt; int M, N, K; };

struct StaticOrder {
    int nM, nN, nwg, G, c;
    __device__ void init(int M, int N, int G_, int c_) { nM = M / BM; nN = N / BM; nwg = nM * nN; G = G_; c = c_; }
    __device__ bool next(int i, Unit& u) const {
        const long L = (long)i * G + c; if (L >= nwg) return false;
        int wgid = (int)L; { const int q = nwg / NXCD, r = nwg % NXCD, xcd = wgid % NXCD, off = wgid / NXCD; wgid = (xcd < r ? xcd * (q + 1) : r * (q + 1) + (xcd - r) * q) + off; }
        const int nig = WGM * nN, gid = wgid / nig, fm = gid * WGM, gsz = (nM - fm) < WGM ? (nM - fm) : WGM;
        u.pm = fm + ((wgid % nig) % gsz); u.pn = (wgid % nig) / gsz; return true;
    }
};

template <class Epi>
__device__ __forceinline__ void gemm_phase(LAS unsigned char* lds, const Gemm g, const StaticOrder& S, const Epi& E) {
    const int tid = tid_(), wid = __builtin_amdgcn_readfirstlane(tid >> 6), lane = tid & 63, wr = wid >> 2, wc = wid & 3, fr = lane & 15, fq = lane >> 4;
    const int K = g.K, nt = K / BK;
    unsigned voffA[2], voffB[2];
#pragma unroll
    for (int i = 0; i < 2; ++i) { int R, C; stage_rc(tid * 16 + i * 8192, R, C); const int Rb = (R & ~31) + perm32(R & 31);
        voffA[i] = (unsigned)(R * K + C) * 2u; voffB[i] = (unsigned)(Rb * K + C) * 2u; }
    const size_t kstep = (size_t)(BK * 2);
    const size_t hstep = (size_t)HALF * K * 2;
    const size_t tstep = 2 * hstep;
    const unsigned ldsw = (unsigned)wid * 1024u;
    const int aoff = lds_byte(wr * 64 + fr, fq * 8), boff = lds_byte(wc * 32 + fr, fq * 8);
#define PG8_SA(b, h) (((b) * 2 + (h)) * HTB)
#define PG8_SB(b, h) ((4 + (b) * 2 + (h)) * HTB)
#define PG8_STAGE(bufoff, gbase, voff) do { _Pragma("unroll") for (int _i = 0; _i < 2; ++_i) \
        __builtin_amdgcn_global_load_lds((const unsigned*)((const char*)(gbase) + (voff)[_i]), (LAS unsigned*)(lds + (bufoff) + ldsw + _i * 8192), 16, 0, 0); } while (0)
#define PG8_LDA(dst, b, h) do { _Pragma("unroll") for (int m = 0; m < 4; ++m) _Pragma("unroll") for (int k = 0; k < 2; ++k) dst[m][k] = *(const LAS h16x8*)(lds + PG8_SA(b, h) + aoff + m * 2048 + k * 1024); } while (0)
#define PG8_LDB(dst, b, h) do { _Pragma("unroll") for (int n = 0; n < 2; ++n) _Pragma("unroll") for (int k = 0; k < 2; ++k) dst[n][k] = *(const LAS h16x8*)(lds + PG8_SB(b, h) + boff + n * 2048 + k * 1024); } while (0)
#define PG8_MMA(ai, bj, At, Bt) do { __builtin_amdgcn_s_setprio(1); _Pragma("unroll") for (int m = 0; m < 4; ++m) _Pragma("unroll") for (int n = 0; n < 2; ++n) _Pragma("unroll") for (int k = 0; k < 2; ++k) \
        acc[ai][bj][m][n] = __builtin_amdgcn_mfma_f32_16x16x32_f16(Bt[n][k], At[m][k], acc[ai][bj][m][n], 0, 0, 0); __builtin_amdgcn_s_setprio(0); } while (0)
#define PG8_WAIT_V(n) asm volatile("s_waitcnt vmcnt(" #n ")" ::: "memory")
#define PG8_WAIT_L(n) asm volatile("s_waitcnt lgkmcnt(" #n ")" ::: "memory")
#define PG8_BAR __builtin_amdgcn_s_barrier()
#define PG8_SCHED __builtin_amdgcn_sched_barrier(0)
    Unit cur, nxt; int ui = 0;
    if (!S.next(0, cur)) return;
    f32x4 acc[2][2][4][2];
#pragma unroll
    for (int a = 0; a < 2; ++a)
#pragma unroll
        for (int b = 0; b < 2; ++b)
#pragma unroll
            for (int m = 0; m < 4; ++m)
#pragma unroll
                for (int n = 0; n < 2; ++n) acc[a][b][m][n] = (f32x4){0.f, 0.f, 0.f, 0.f};
    h16x8 At[4][2], B0[2][2], B1[2][2];
    const char* cA = (const char*)g.A + (size_t)cur.pm * tstep; const char* cB = (const char*)g.Bt + (size_t)cur.pn * tstep;
    PG8_STAGE(PG8_SB(0, 0), cB, voffB); PG8_STAGE(PG8_SA(0, 0), cA, voffA); PG8_STAGE(PG8_SB(0, 1), cB + hstep, voffB); PG8_STAGE(PG8_SA(0, 1), cA + hstep, voffA);
    if (wr == 1) PG8_BAR;
    PG8_WAIT_V(4); PG8_BAR;
    PG8_STAGE(PG8_SB(1, 0), cB + kstep, voffB); PG8_STAGE(PG8_SA(1, 0), cA + kstep, voffA); PG8_STAGE(PG8_SB(1, 1), cB + hstep + kstep, voffB);
    PG8_WAIT_V(6); PG8_BAR;
    for (;;) {
        const bool has_next = S.next(ui + 1, nxt);
        const char* nA = has_next ? (const char*)g.A + (size_t)nxt.pm * tstep : cA; const char* nB = has_next ? (const char*)g.Bt + (size_t)nxt.pn * tstep : cB;
        for (int t = 0; t < nt; t += 2) {
            const bool last = (t == nt - 2);
            const char* a1 = cA + (size_t)(t + 1) * kstep;
            const char* a2 = last ? nA : cA + (size_t)(t + 2) * kstep; const char* b2 = last ? nB : cB + (size_t)(t + 2) * kstep;
            const char* a3 = a2 + kstep; const char* b3 = b2 + kstep;
            PG8_LDB(B0, 0, 0); PG8_SCHED; PG8_LDA(At, 0, 0); PG8_STAGE(PG8_SA(1, 1), a1 + hstep, voffA);
            PG8_WAIT_L(8); PG8_BAR; PG8_WAIT_L(0); PG8_MMA(0, 0, At, B0); PG8_BAR; PG8_SCHED;
            PG8_LDB(B1, 0, 1); PG8_STAGE(PG8_SB(0, 0), b2, voffB);
            PG8_BAR; PG8_WAIT_L(0); PG8_MMA(0, 1, At, B1); PG8_BAR;
            PG8_LDA(At, 0, 1); PG8_STAGE(PG8_SA(0, 0), a2, voffA);
            PG8_BAR; PG8_WAIT_L(0); PG8_MMA(1, 0, At, B0); PG8_BAR; PG8_SCHED;
            PG8_STAGE(PG8_SB(0, 1), b2 + hstep, voffB);
            PG8_WAIT_V(6); PG8_BAR; PG8_MMA(1, 1, At, B1); PG8_BAR;
            PG8_LDB(B0, 1, 0); PG8_SCHED; PG8_LDA(At, 1, 0); PG8_STAGE(PG8_SA(0, 1), a2 + hstep, voffA);
            PG8_WAIT_L(8); PG8_BAR; PG8_WAIT_L(0); PG8_MMA(0, 0, At, B0); PG8_BAR; PG8_SCHED;
            PG8_LDB(B1, 1, 1); PG8_STAGE(PG8_SB(1, 0), b3, voffB);
            PG8_BAR; PG8_WAIT_L(0); PG8_MMA(0, 1, At, B1); PG8_BAR;
            PG8_LDA(At, 1, 1); PG8_STAGE(PG8_SA(1, 0), a3, voffA);
            PG8_BAR; PG8_WAIT_L(0); PG8_MMA(1, 0, At, B0); PG8_BAR; PG8_SCHED;
            PG8_STAGE(PG8_SB(1, 1), b3 + hstep, voffB);
            PG8_WAIT_V(6); PG8_BAR; PG8_MMA(1, 1, At, B1); PG8_BAR;
        }
        E(acc, cur, wr, wc, fr, fq);
        if (!has_next) break;
#pragma unroll
        for (int a = 0; a < 2; ++a)
#pragma unroll
            for (int b = 0; b < 2; ++b)
#pragma unroll
                for (int m = 0; m < 4; ++m)
#pragma unroll
                    for (int n = 0; n < 2; ++n) acc[a][b][m][n] = (f32x4){0.f, 0.f, 0.f, 0.f};
        cur = nxt; cA = nA; cB = nB; ++ui;
    }
    PG8_WAIT_V(0);
    if (wr == 0) PG8_BAR;
    PG8_BAR;
#undef PG8_SA
#undef PG8_SB
#undef PG8_STAGE
#undef PG8_LDA
#undef PG8_LDB
#undef PG8_MMA
#undef PG8_WAIT_V
#undef PG8_WAIT_L
#undef PG8_BAR
#undef PG8_SCHED
}
}
using pg8::Unit;
typedef const f32x4 (&AccRef)[2][2][4][2];

#define EPI_LOOP_BEGIN \
    _Pragma("unroll") for (int ai = 0; ai < 2; ++ai) _Pragma("unroll") for (int m = 0; m < 4; ++m) { \
        const int row = u.pm * 256 + ai * 128 + wr * 64 + m * 16 + fr; \
        _Pragma("unroll") for (int bj = 0; bj < 2; ++bj) { \
            const int col = u.pn * 256 + bj * 128 + wc * 32 + 8 * fq; \
            const f32x4 v0 = acc[ai][bj][m][0], v1 = acc[ai][bj][m][1];
#define EPI_LOOP_END } }

struct EpiZ {
    h16 *zc, *zr, *zg;
    __device__ __forceinline__ void operator()(AccRef acc, const Unit& u, int wr, int wc, int fr, int fq) const {
        const int colt = u.pn * 256; h16* base; int ld, c0;
        if (colt < 1536) { base = zc; ld = 1536; c0 = colt; } else if (colt < 3328) { base = zr; ld = 1792; c0 = colt - 1536; } else { base = zg; ld = 2048; c0 = colt - 3328; }
        EPI_LOOP_BEGIN
            *(h16x8*)(base + (size_t)row * ld + (col - colt + c0)) = pack8(v0, v1);
        EPI_LOOP_END
    }
};
struct EpiF16 {
    h16* O; int ld;
    __device__ __forceinline__ void operator()(AccRef acc, const Unit& u, int wr, int wc, int fr, int fq) const {
        EPI_LOOP_BEGIN
            *(h16x8*)(O + (size_t)row * ld + col) = pack8(v0, v1);
        EPI_LOOP_END
    }
};
struct EpiYA {
    const h16* zg; float* tmp;
    __device__ __forceinline__ void operator()(AccRef acc, const Unit& u, int wr, int wc, int fr, int fq) const {
        EPI_LOOP_BEGIN
            const h16x8 gv = *(const h16x8*)(zg + (size_t)row * 2048 + col);
            f32x4 o0, o1;
#pragma unroll
            for (int j = 0; j < 4; ++j) { o0[j] = sigmoidf_((float)gv[j]) * v0[j]; o1[j] = sigmoidf_((float)gv[4 + j]) * v1[j]; }
            float* p = tmp + (size_t)row * 1024 + col;
            *(f32x4*)p = o0; *(f32x4*)(p + 4) = o1;
        EPI_LOOP_END
    }
};
struct EpiYB {
    const h16* zg; const float* tmp; h16* merged;
    __device__ __forceinline__ void operator()(AccRef acc, const Unit& u, int wr, int wc, int fr, int fq) const {
        EPI_LOOP_BEGIN
            const h16x8 gv = *(const h16x8*)(zg + (size_t)row * 2048 + 1024 + col);
            const float* p = tmp + (size_t)row * 1024 + col;
            f32x4 o0 = *(const f32x4*)p, o1 = *(const f32x4*)(p + 4);
#pragma unroll
            for (int j = 0; j < 4; ++j) { o0[j] += sigmoidf_((float)gv[j]) * v0[j]; o1[j] += sigmoidf_((float)gv[4 + j]) * v1[j]; }
            *(h16x8*)(merged + (size_t)row * 1024 + col) = pack8(o0, o1);
        EPI_LOOP_END
    }
};
struct EpiH1 {
    const float* x; float* out; h16* hb; float* part;
    __device__ __forceinline__ void operator()(AccRef acc, const Unit& u, int wr, int wc, int fr, int fq) const {
#pragma unroll
        for (int ai = 0; ai < 2; ++ai)
#pragma unroll
            for (int m = 0; m < 4; ++m) {
                const int row = u.pm * 256 + ai * 128 + wr * 64 + m * 16 + fr; float ss = 0.f;
#pragma unroll
                for (int bj = 0; bj < 2; ++bj) {
                    const int col = u.pn * 256 + bj * 128 + wc * 32 + 8 * fq;
                    const float* xp = x + (size_t)row * 1024 + col;
                    f32x4 o0 = *(const f32x4*)xp + acc[ai][bj][m][0], o1 = *(const f32x4*)(xp + 4) + acc[ai][bj][m][1];
                    float* op = out + (size_t)row * 1024 + col;
                    *(f32x4*)op = o0; *(f32x4*)(op + 4) = o1;
                    *(h16x8*)(hb + (size_t)row * 1024 + col) = pack8(o0, o1);
                    ss += (o0[0] * o0[0] + o0[1] * o0[1]) + (o0[2] * o0[2] + o0[3] * o0[3]) + (o1[0] * o1[0] + o1[1] * o1[1]) + (o1[2] * o1[2] + o1[3] * o1[3]);
                }
                ss += __shfl_xor(ss, 16); ss += __shfl_xor(ss, 32);
                if (fq == 0) part[(size_t)row * 16 + u.pn * 4 + wc] = ss;
            }
    }
};
struct EpiGate {
    float* out; const h16* pp; const float* rs2; float* part;
    __device__ __forceinline__ void operator()(AccRef acc, const Unit& u, int wr, int wc, int fr, int fq) const {
#pragma unroll
        for (int ai = 0; ai < 2; ++ai)
#pragma unroll
            for (int m = 0; m < 4; ++m) {
                const int row = u.pm * 256 + ai * 128 + wr * 64 + m * 16 + fr; float ss = 0.f; const float rs = rs2[row];
#pragma unroll
                for (int bj = 0; bj < 2; ++bj) {
                    const int col = u.pn * 256 + bj * 128 + wc * 32 + 8 * fq;
                    float* op = out + (size_t)row * 1024 + col;
                    f32x4 o0 = *(const f32x4*)op, o1 = *(const f32x4*)(op + 4);
                    const h16x8 pv = *(const h16x8*)(pp + (size_t)row * 1024 + col);
                    const f32x4 v0 = acc[ai][bj][m][0], v1 = acc[ai][bj][m][1];
#pragma unroll
                    for (int j = 0; j < 4; ++j) { o0[j] += sigmoidf_(rs * v0[j]) * (float)pv[j]; o1[j] += sigmoidf_(rs * v1[j]) * (float)pv[4 + j]; }
                    *(f32x4*)op = o0; *(f32x4*)(op + 4) = o1;
                    ss += (o0[0] * o0[0] + o0[1] * o0[1]) + (o0[2] * o0[2] + o0[3] * o0[3]) + (o1[0] * o1[0] + o1[1] * o1[1]) + (o1[2] * o1[2] + o1[3] * o1[3]);
                }
                ss += __shfl_xor(ss, 16); ss += __shfl_xor(ss, 32);
                if (fq == 0) part[(size_t)row * 16 + u.pn * 4 + wc] = ss;
            }
    }
};

__device__ __forceinline__ void tr_item(const float* W, int N, const float* g, h16* WT, int ldk, int koff, int k0, int n0, LAS float* scr, int lane) {
#pragma unroll 8
    for (int i = 0; i < 32; ++i) { const int kk = 2 * i + (lane >> 5); float v = W[(size_t)(k0 + kk) * N + n0 + (lane & 31)]; if (g) v *= g[k0 + kk]; scr[kk * 33 + (lane & 31)] = v; }
    asm volatile("s_waitcnt lgkmcnt(0)" ::: "memory");
    const int c = lane & 7;
#pragma unroll
    for (int j = 0; j < 4; ++j) { const int n = (lane >> 3) + 8 * j; const LAS float* s = scr + (8 * c) * 33 + n;
        h16x8 o;
#pragma unroll
        for (int e = 0; e < 8; ++e) o[e] = (h16)s[e * 33];
        *(h16x8*)(WT + (size_t)(n0 + n) * ldk + koff + k0 + 8 * c) = o; }
    asm volatile("s_waitcnt lgkmcnt(0)" ::: "memory");
}
struct TrJob { const float* W; const float* g; h16* WT; int K, N, ldk, koff; };

__device__ __forceinline__ void phase_prep(const Args& a, LAS unsigned char* lds) {
    const int tid = tid_(), lane = tid & 63, wave = tid >> 6;
    const int gw = blockIdx.x * NWAVES + wave, NGW = gridDim.x * NWAVES;
    unsigned char* ws = a.ws;
    {
        LAS float* scr = (LAS float*)(lds + wave * 8704);
        TrJob jobs[9] = {
            {a.in[3], a.in[2], (h16*)(ws + O_WIN), 1024, NIN, 1024, 0},
            {a.in[17], nullptr, (h16*)(ws + O_WA), 512, 1024, 512, 0},
            {a.in[18], nullptr, (h16*)(ws + O_WB), 512, 1024, 512, 0},
            {a.in[19], nullptr, (h16*)(ws + O_WO), 1024, 1024, 1024, 0},
            {a.in[26], a.in[25], (h16*)(ws + O_WG), 1024, 1024, 1024, 0},
            {a.in[27], nullptr, (h16*)(ws + O_WP), 256, 1024, 256, 0},
            {a.in[8], nullptr, (h16*)(ws + O_WLR), 64, 512, 256, 0},
            {a.in[10], nullptr, (h16*)(ws + O_WLR) + (size_t)512 * 256, 64, 512, 256, 64},
            {a.in[11], nullptr, (h16*)(ws + O_WLR) + (size_t)1024 * 256, 128, 512, 256, 128},
        };
        int base = 0;
#pragma unroll
        for (int j = 0; j < 9; ++j) {
            const TrJob J = jobs[j]; const int nnb = J.N / 32, items = (J.K / 64) * nnb;
            int first = gw - (base % NGW); if (first < 0) first += NGW;
            for (int r = first; r < items; r += NGW) tr_item(J.W, J.N, J.g, J.WT, J.ldk, J.koff, (r / nnb) * 64, (r % nnb) * 32, scr, lane);
            base += items;
        }
        h16* wlr = (h16*)(ws + O_WLR);
        for (int i = blockIdx.x * NTHREADS + tid; i < 1536 * 256 / 8; i += gridDim.x * NTHREADS) {
            const int n = (i * 8) / 256, k = (i * 8) % 256; const int blk = n / 512;
            const bool inblk = (blk == 0) ? (k < 64) : (blk == 1) ? (k >= 64 && k < 128) : (k >= 128);
            if (!inblk) { h16x8 z; for (int e = 0; e < 8; ++e) z[e] = (h16)0.f; *(h16x8*)(wlr + (size_t)i * 8) = z; }
        }
    }
    __syncthreads();
    {
        LAS float* LA = (LAS float*)lds;
        LAS float* LB = (LAS float*)(lds + 64 * 129 * 4);
        const float* wq = a.in[21]; const float* sk = a.in[22]; const float* gf = a.in[20];
        h16* wst = (h16*)(ws + O_WS);
        for (int it = blockIdx.x; it < 256; it += gridDim.x) {
            const int g16 = it >> 4, k0 = (it & 15) * 64;
            for (int i = tid; i < 64 * 128; i += NTHREADS) { const int k = i >> 7, d = i & 127; LA[k * 129 + d] = wq[(size_t)(k0 + k) * 2048 + g16 * 128 + d] * gf[k0 + k]; }
            for (int i = tid; i < 128 * 128; i += NTHREADS) { const int n = i >> 7, d = i & 127; LB[n * 129 + d] = sk[((size_t)g16 * 128 + n) * 128 + d]; }
            __syncthreads();
            const int n = tid & 127, kg = tid >> 7;
            float o[16];
#pragma unroll
            for (int j = 0; j < 16; ++j) o[j] = 0.f;
            for (int d = 0; d < 128; ++d) { const float b = LB[n * 129 + d];
#pragma unroll
                for (int j = 0; j < 16; ++j) o[j] += LA[(kg * 16 + j) * 129 + d] * b; }
            h16x8 o0, o1;
#pragma unroll
            for (int j = 0; j < 8; ++j) { o0[j] = (h16)o[j]; o1[j] = (h16)o[8 + j]; }
            h16* dst = wst + (size_t)(g16 * 128 + n) * 1024 + k0 + kg * 16;
            *(h16x8*)dst = o0; *(h16x8*)(dst + 8) = o1;
            __syncthreads();
        }
    }
    {
        const float* gf = a.in[20];
        const f32x4* pu = (const f32x4*)a.in[23]; const f32x4* pv = (const f32x4*)a.in[24];
        h16x4* du = (h16x4*)(ws + O_U16); h16x4* dv = (h16x4*)(ws + O_V16);
        const int n4 = 16384 * 1024 / 4;
        for (int i = blockIdx.x * NTHREADS + tid; i < n4; i += gridDim.x * NTHREADS) {
            const f32x4 g4 = *(const f32x4*)(gf + (i & 255) * 4);
            du[i] = pack4(pu[i] * g4); dv[i] = pack4(pv[i]);
        }
        const f32x4* pp = (const f32x4*)a.in[1]; h16x4* dp = (h16x4*)(ws + O_P16);
        const int np4 = MTOK * 256 / 4;
        for (int i = blockIdx.x * NTHREADS + tid; i < np4; i += gridDim.x * NTHREADS) dp[i] = pack4(pp[i]);
    }
    {
        const float* x = a.in[0]; h16* xn = (h16*)(ws + O_XN);
        for (int r = gw; r < MTOK; r += NGW) {
            const f32x4* xr = (const f32x4*)(x + (size_t)r * 1024) + lane;
            f32x4 v[4]; float s = 0.f;
#pragma unroll
            for (int j = 0; j < 4; ++j) { v[j] = xr[64 * j]; s += (v[j][0] * v[j][0] + v[j][1] * v[j][1]) + (v[j][2] * v[j][2] + v[j][3] * v[j][3]); }
            const float rs = rsqrtf(wave_sum(s) * (1.f / 1024.f) + NORM_EPS);
            h16x4* o = (h16x4*)(xn + (size_t)r * 1024) + lane;
#pragma unroll
            for (int j = 0; j < 4; ++j) o[64 * j] = pack4(v[j] * rs);
        }
    }
}

__device__ __forceinline__ void phase_conv(const Args& a) {
    const int tid = tid_(), lane = tid & 63, wave = tid >> 6;
    const int gw = blockIdx.x * NWAVES + wave, NGW = gridDim.x * NWAVES;
    const h16* zc = (const h16*)(a.ws + O_ZC); h16* ca = (h16*)(a.ws + O_CA);
    const float* cw = a.in[4]; const float* cb = a.in[5];
    float w0[8], w1[8], w2[8], bb[8];
#pragma unroll
    for (int j = 0; j < 8; ++j) { const int c = lane * 8 + j; w0[j] = cw[c]; w1[j] = cw[512 + c]; w2[j] = cw[1024 + c]; bb[j] = cb[c]; }
    for (int run = gw; run < MTOK / 32; run += NGW) {
        const int t0 = run * 32;
        float u1[8], u2[8];
        if ((t0 % SEQ) == 0) {
#pragma unroll
            for (int j = 0; j < 8; ++j) { u1[j] = 0.f; u2[j] = 0.f; }
        } else {
            const h16x8 c1 = *(const h16x8*)(zc + (size_t)(t0 - 1) * 1536 + 512 + lane * 8), x1 = *(const h16x8*)(zc + (size_t)(t0 - 1) * 1536 + 1024 + lane * 8);
            const h16x8 c2 = *(const h16x8*)(zc + (size_t)(t0 - 2) * 1536 + 512 + lane * 8), x2 = *(const h16x8*)(zc + (size_t)(t0 - 2) * 1536 + 1024 + lane * 8);
#pragma unroll
            for (int j = 0; j < 8; ++j) { u1[j] = (float)c1[j] * (float)x1[j]; u2[j] = (float)c2[j] * (float)x2[j]; }
        }
        for (int t = t0; t < t0 + 32; ++t) {
            const h16* zrow = zc + (size_t)t * 1536 + lane * 8;
            const h16x8 gb = *(const h16x8*)zrow, gc = *(const h16x8*)(zrow + 512), xi = *(const h16x8*)(zrow + 1024);
            h16x8 o;
#pragma unroll
            for (int j = 0; j < 8; ++j) { const float u0 = (float)gc[j] * (float)xi[j];
                const float y = w0[j] * u2[j] + w1[j] * u1[j] + w2[j] * u0 + bb[j];
                o[j] = (h16)((float)gb[j] * y); u2[j] = u1[j]; u1[j] = u0; }
            *(h16x8*)(ca + (size_t)t * 512 + lane * 8) = o;
        }
    }
}


__device__ __forceinline__ float tanhf_(float x) { return 1.0f - 2.0f * __builtin_amdgcn_rcpf(1.0f + __expf(2.0f * x)); }
__device__ __forceinline__ void phase_rwkv_prep(const Args& a) {
    const int tid = tid_(), lane = tid & 63, wave = tid >> 6;
    const int gw = blockIdx.x * NWAVES + wave, NGW = gridDim.x * NWAVES;
    const h16* zr = (const h16*)(a.ws + O_ZR);
    h16* R = (h16*)a.out; h16* KS = R + (size_t)MTOK * 512; h16* V = KS + (size_t)MTOK * 512; h16* KK = V + (size_t)MTOK * 512;
    h16* APR = (h16*)(a.ws + O_APR);
    const float* mu = a.in[6]; const float* k_k = a.in[12];
    float mr[8], mk[8], mv[8], mt[8], kk8[8];
#pragma unroll
    for (int j = 0; j < 8; ++j) { const int c = lane * 8 + j; mr[j] = mu[c]; mk[j] = mu[512 + c]; mv[j] = mu[1024 + c]; mt[j] = mu[1536 + (c & 255)]; kk8[j] = k_k[c]; }
    for (int run = gw; run < MTOK / 32; run += NGW) {
        const int t0 = run * 32;
        float pr[8], pk[8], pv[8], pt[8];
        if ((t0 % SEQ) == 0) {
#pragma unroll
            for (int j = 0; j < 8; ++j) { pr[j] = 0.f; pk[j] = 0.f; pv[j] = 0.f; pt[j] = 0.f; }
        } else {
            const h16* zp = zr + (size_t)(t0 - 1) * 1792 + lane * 8;
            const h16x8 a0 = *(const h16x8*)zp, a1 = *(const h16x8*)(zp + 512), a2 = *(const h16x8*)(zp + 1024), a3 = *(const h16x8*)(zr + (size_t)(t0 - 1) * 1792 + 1536 + (lane & 31) * 8);
#pragma unroll
            for (int j = 0; j < 8; ++j) { pr[j] = (float)a0[j]; pk[j] = (float)a1[j]; pv[j] = (float)a2[j]; pt[j] = (float)a3[j]; }
        }
        for (int t = t0; t < t0 + 32; ++t) {
            const h16* zp = zr + (size_t)t * 1792 + lane * 8;
            const h16x8 a0 = *(const h16x8*)zp, a1 = *(const h16x8*)(zp + 512), a2 = *(const h16x8*)(zp + 1024), a3 = *(const h16x8*)(zr + (size_t)t * 1792 + 1536 + (lane & 31) * 8);
            h16x8 orr, ok, ov, okk, ot; float kr[8]; float ss = 0.f;
#pragma unroll
            for (int j = 0; j < 8; ++j) {
                const float zr_ = (float)a0[j], zk_ = (float)a1[j], zv_ = (float)a2[j], zt_ = (float)a3[j];
                const float r = zr_ + mr[j] * (pr[j] - zr_), k = zk_ + mk[j] * (pk[j] - zk_), v = zv_ + mv[j] * (pv[j] - zv_), tl = zt_ + mt[j] * (pt[j] - zt_);
                pr[j] = zr_; pk[j] = zk_; pv[j] = zv_; pt[j] = zt_;
                orr[j] = (h16)r; ok[j] = (h16)k; ov[j] = (h16)v;
                kr[j] = k * kk8[j]; ss += kr[j] * kr[j];
                const float tv = (lane < 8) ? tanhf_(tl) : (lane < 16) ? tl : sigmoidf_(tl);
                ot[j] = (h16)tv;
            }
            ss += __shfl_xor(ss, 1); ss += __shfl_xor(ss, 2); ss += __shfl_xor(ss, 4);
            const float rn = rsqrtf(ss + 1e-12f);
#pragma unroll
            for (int j = 0; j < 8; ++j) okk[j] = (h16)(kr[j] * rn);
            const size_t o = (size_t)t * 512 + lane * 8;
            *(h16x8*)(R + o) = orr; *(h16x8*)(KS + o) = ok; *(h16x8*)(V + o) = ov; *(h16x8*)(KK + o) = okk;
            if (lane < 32) *(h16x8*)(APR + (size_t)t * 256 + lane * 8) = ot;
        }
    }
}

struct EpiLR {
    const float *w0, *a0, *k_a; h16 *WD, *KS, *BD, *GG; const h16* KK;
    __device__ __forceinline__ void operator()(AccRef acc, const Unit& u, int wr, int wc, int fr, int fq) const {
        const int part = u.pn >> 1;
        EPI_LOOP_BEGIN
            const int c = col - part * 512; const size_t o = (size_t)row * 512 + c;
            if (part == 0) {
                const f32x4 b0 = *(const f32x4*)(w0 + c), b1 = *(const f32x4*)(w0 + c + 4); f32x4 o0, o1;
#pragma unroll
                for (int j = 0; j < 4; ++j) { o0[j] = __expf(-0.6065306597126334f * sigmoidf_(b0[j] + v0[j])); o1[j] = __expf(-0.6065306597126334f * sigmoidf_(b1[j] + v1[j])); }
                *(h16x8*)(WD + o) = pack8(o0, o1);
            } else if (part == 1) {
                const f32x4 b0 = *(const f32x4*)(a0 + c), b1 = *(const f32x4*)(a0 + c + 4), ka0 = *(const f32x4*)(k_a + c), ka1 = *(const f32x4*)(k_a + c + 4);
                const h16x8 ks = *(const h16x8*)(KS + o), kk = *(const h16x8*)(KK + o); f32x4 k0, k1, bb0, bb1;
#pragma unroll
                for (int j = 0; j < 4; ++j) { const float aa0 = sigmoidf_(b0[j] + v0[j]), aa1 = sigmoidf_(b1[j] + v1[j]);
                    k0[j] = (float)ks[j] * (1.0f + (aa0 - 1.0f) * ka0[j]); k1[j] = (float)ks[4 + j] * (1.0f + (aa1 - 1.0f) * ka1[j]);
                    bb0[j] = aa0 * (float)kk[j]; bb1[j] = aa1 * (float)kk[4 + j]; }
                *(h16x8*)(KS + o) = pack8(k0, k1); *(h16x8*)(BD + o) = pack8(bb0, bb1);
            } else {
                *(h16x8*)(GG + o) = pack8(v0, v1);
            }
        EPI_LOOP_END
    }
};

constexpr int SC_L = 256, SC_NCH = SEQ / SC_L, SC_NB = 4;
constexpr int SC_STEP_F = 6 * 64;
constexpr int SC_WAVE_BYTES = 2 * SC_NB * SC_STEP_F * 4 + 1024;
template <int MODE>
__device__ __forceinline__ void scan_wave(const Args& a, LAS unsigned char* lds, int task) {
    const int tid = tid_(), lane = tid & 63, wave = tid >> 6;
    const int q = lane & 3, rg = lane >> 2;
    const int chain = task / SC_NCH, chunk = task % SC_NCH, b = chain >> 3, h = chain & 7;
    const size_t row0 = (size_t)b * SEQ + (size_t)chunk * SC_L;
    const h16* R = (const h16*)a.out; const h16* KS = R + (size_t)MTOK * 512; const h16* V = KS + (size_t)MTOK * 512; const h16* KK = V + (size_t)MTOK * 512;
    const h16* WD = (const h16*)(a.ws + O_WD); const h16* BD = (const h16*)(a.ws + O_BD);
    LAS float* buf = (LAS float*)(lds + wave * SC_WAVE_BYTES);
    LAS float* ybuf = buf + 2 * SC_NB * SC_STEP_F;
    const h16* gp[3]; int lo[3];
#pragma unroll
    for (int j = 0; j < 3; ++j) { const int p = lane + 64 * j, seg = p >> 3, part = p & 7, st = seg / 6, ar = seg % 6;
        const h16* base = (ar == 0) ? KK : (ar == 1) ? WD : (ar == 2) ? BD : (ar == 3) ? KS : (ar == 4) ? R : V;
        gp[j] = base + (row0 + st) * 512 + h * 64 + part * 8; lo[j] = st * SC_STEP_F + ar * 64 + part * 8; }
    float s[4][16];
    if (MODE == 0) {
#pragma unroll
        for (int i = 0; i < 4; ++i)
#pragma unroll
            for (int j = 0; j < 16; ++j) s[i][j] = 0.f;
    } else if (MODE == 1) {
#pragma unroll
        for (int i = 0; i < 4; ++i)
#pragma unroll
            for (int j = 0; j < 16; ++j) s[i][j] = (i == q && j == rg) ? 1.f : 0.f;
    } else {
        const float* S0 = (const float*)(a.ws + O_SST) + (size_t)task * 4096;
#pragma unroll
        for (int i = 0; i < 4; ++i)
#pragma unroll
            for (int j4 = 0; j4 < 4; ++j4) { const f32x4 t = *(const f32x4*)(S0 + (rg + 16 * i) * 64 + 16 * q + 4 * j4);
                s[i][4 * j4] = t[0]; s[i][4 * j4 + 1] = t[1]; s[i][4 * j4 + 2] = t[2]; s[i][4 * j4 + 3] = t[3]; }
    }
    h16x8 pre[3];
#pragma unroll
    for (int j = 0; j < 3; ++j) pre[j] = *(const h16x8*)gp[j];
    for (int bt = 0; bt < SC_L / SC_NB; ++bt) {
        LAS float* cb = buf + (bt & 1) * SC_NB * SC_STEP_F;
#pragma unroll
        for (int j = 0; j < 3; ++j) { f32x4 x0, x1;
#pragma unroll
            for (int e = 0; e < 4; ++e) { x0[e] = (float)pre[j][e]; x1[e] = (float)pre[j][4 + e]; }
            *(LAS f32x4*)(cb + lo[j]) = x0; *(LAS f32x4*)(cb + lo[j] + 4) = x1; }
        if (bt + 1 < SC_L / SC_NB) {
#pragma unroll
            for (int j = 0; j < 3; ++j) pre[j] = *(const h16x8*)(gp[j] + (size_t)(bt + 1) * SC_NB * 512);
        }
#pragma unroll 1
        for (int st = 0; st < SC_NB; ++st) {
            const LAS float* sb = cb + st * SC_STEP_F;
            float kk[16], w[16], bb[16], kx[16], vv[4];
#pragma unroll
            for (int j4 = 0; j4 < 4; ++j4) {
                const f32x4 t0 = *(const LAS f32x4*)(sb + 16 * q + 4 * j4), t1 = *(const LAS f32x4*)(sb + 64 + 16 * q + 4 * j4), t2 = *(const LAS f32x4*)(sb + 128 + 16 * q + 4 * j4);
#pragma unroll
                for (int e = 0; e < 4; ++e) { kk[4 * j4 + e] = t0[e]; w[4 * j4 + e] = t1[e]; bb[4 * j4 + e] = t2[e]; }
                if (MODE != 1) { const f32x4 t3 = *(const LAS f32x4*)(sb + 192 + 16 * q + 4 * j4);
#pragma unroll
                    for (int e = 0; e < 4; ++e) kx[4 * j4 + e] = t3[e]; }
            }
            if (MODE != 1) {
#pragma unroll
                for (int i = 0; i < 4; ++i) vv[i] = sb[320 + rg + 16 * i];
            }
            float us[4];
#pragma unroll
            for (int i = 0; i < 4; ++i) { float t = 0.f;
#pragma unroll
                for (int j = 0; j < 16; ++j) t += s[i][j] * kk[j];
                t += __shfl_xor(t, 1); t += __shfl_xor(t, 2); us[i] = t; }
#pragma unroll
            for (int i = 0; i < 4; ++i)
#pragma unroll
                for (int j = 0; j < 16; ++j) { if (MODE != 1) s[i][j] = s[i][j] * w[j] - us[i] * bb[j] + vv[i] * kx[j]; else s[i][j] = s[i][j] * w[j] - us[i] * bb[j]; }
            if (MODE == 2) {
                float rr[16];
#pragma unroll
                for (int j4 = 0; j4 < 4; ++j4) { const f32x4 t4 = *(const LAS f32x4*)(sb + 256 + 16 * q + 4 * j4);
#pragma unroll
                    for (int e = 0; e < 4; ++e) rr[4 * j4 + e] = t4[e]; }
#pragma unroll
                for (int i = 0; i < 4; ++i) { float y = 0.f;
#pragma unroll
                    for (int j = 0; j < 16; ++j) y += s[i][j] * rr[j];
                    y += __shfl_xor(y, 1); y += __shfl_xor(y, 2);
                    if (q == 0) ybuf[st * 64 + rg + 16 * i] = y; }
            }
        }
        if (MODE == 2) {
            if (lane < 32) { const int st = lane >> 3, part = lane & 7; h16x8 o;
#pragma unroll
                for (int e = 0; e < 8; ++e) o[e] = (h16)ybuf[st * 64 + part * 8 + e];
                *(h16x8*)((h16*)(a.ws + O_Y) + (row0 + (size_t)bt * SC_NB + st) * 512 + h * 64 + part * 8) = o; }
        }
    }
    if (MODE != 2) {
        float* PQ = (float*)(a.ws + O_PQ) + (size_t)task * 8192 + (MODE == 0 ? 4096 : 0);
#pragma unroll
        for (int i = 0; i < 4; ++i)
#pragma unroll
            for (int j4 = 0; j4 < 4; ++j4) { const int o = (rg + 16 * i) * 64 + 16 * q + 4 * j4;
                *(f32x4*)(PQ + o) = (f32x4){s[i][4 * j4], s[i][4 * j4 + 1], s[i][4 * j4 + 2], s[i][4 * j4 + 3]}; }
    }
}
template <bool FIRST>
__device__ __forceinline__ void phase_scan(const Args& a, LAS unsigned char* lds) {
    const int wave = tid_() >> 6;
    if (FIRST) {
        for (int t2 = blockIdx.x * NWAVES + wave; t2 < 2 * 64 * SC_NCH; t2 += gridDim.x * NWAVES) {
            if (t2 & 1) scan_wave<1>(a, lds, t2 >> 1); else scan_wave<0>(a, lds, t2 >> 1); }
    } else {
        for (int task = blockIdx.x * NWAVES + wave; task < 64 * SC_NCH; task += gridDim.x * NWAVES) scan_wave<2>(a, lds, task);
    }
}
__device__ __forceinline__ void phase_scan_combine(const Args& a, LAS unsigned char* lds) {
    const int tid = tid_(), row = tid >> 3, cb = (tid & 7) * 8;
    LAS float* LS = (LAS float*)lds;
    for (int chain = blockIdx.x; chain < 64; chain += gridDim.x) {
        float sr[8];
#pragma unroll
        for (int j = 0; j < 8; ++j) sr[j] = 0.f;
        for (int c = 0; c < SC_NCH; ++c) {
            const int task = chain * SC_NCH + c;
            float* S0 = (float*)(a.ws + O_SST) + (size_t)task * 4096 + row * 64 + cb;
            *(f32x4*)S0 = (f32x4){sr[0], sr[1], sr[2], sr[3]}; *(f32x4*)(S0 + 4) = (f32x4){sr[4], sr[5], sr[6], sr[7]};
            if (c == SC_NCH - 1) break;
            __syncthreads();
#pragma unroll
            for (int j = 0; j < 8; ++j) LS[row * 65 + cb + j] = sr[j];
            __syncthreads();
            const float* P = (const float*)(a.ws + O_PQ) + (size_t)task * 8192; const float* Q = P + 4096;
            const f32x4 q0 = *(const f32x4*)(Q + row * 64 + cb), q1 = *(const f32x4*)(Q + row * 64 + cb + 4);
            float acc[8] = {q0[0], q0[1], q0[2], q0[3], q1[0], q1[1], q1[2], q1[3]};
#pragma unroll 8
            for (int k = 0; k < 64; ++k) { const float sk = LS[row * 65 + k]; const f32x4 p0 = *(const f32x4*)(P + k * 64 + cb), p1 = *(const f32x4*)(P + k * 64 + cb + 4);
#pragma unroll
                for (int j = 0; j < 4; ++j) { acc[j] += sk * p0[j]; acc[4 + j] += sk * p1[j]; } }
#pragma unroll
            for (int j = 0; j < 8; ++j) sr[j] = acc[j];
        }
        __syncthreads();
    }
}
__device__ __forceinline__ void phase_rwkv_post(const Args& a) {
    const int tid = tid_(), lane = tid & 63, wave = tid >> 6;
    const int gw = blockIdx.x * NWAVES + wave, NGW = gridDim.x * NWAVES;
    const h16* R = (const h16*)a.out; const h16* KS = R + (size_t)MTOK * 512; const h16* V = KS + (size_t)MTOK * 512;
    const h16* GG = (const h16*)(a.ws + O_GG); const h16* Y = (const h16*)(a.ws + O_Y); h16* YB = (h16*)(a.ws + O_YB);
    float rk[8], lg[8], lb[8];
#pragma unroll
    for (int j = 0; j < 8; ++j) { const int c = lane * 8 + j; rk[j] = a.in[14][c]; lg[j] = a.in[15][c]; lb[j] = a.in[16][c]; }
    for (int t = gw; t < MTOK; t += NGW) {
        const size_t o = (size_t)t * 512 + lane * 8;
        const h16x8 y8 = *(const h16x8*)(Y + o), r8 = *(const h16x8*)(R + o), k8 = *(const h16x8*)(KS + o), v8 = *(const h16x8*)(V + o), g8 = *(const h16x8*)(GG + o);
        float y[8]; float sm = 0.f, bs = 0.f;
#pragma unroll
        for (int j = 0; j < 8; ++j) { y[j] = (float)y8[j]; sm += y[j]; bs += (float)r8[j] * (float)k8[j] * rk[j]; }
        sm += __shfl_xor(sm, 1); sm += __shfl_xor(sm, 2); sm += __shfl_xor(sm, 4);
        bs += __shfl_xor(bs, 1); bs += __shfl_xor(bs, 2); bs += __shfl_xor(bs, 4);
        const float mean = sm * (1.f / 64.f); float vs = 0.f;
#pragma unroll
        for (int j = 0; j < 8; ++j) { y[j] -= mean; vs += y[j] * y[j]; }
        vs += __shfl_xor(vs, 1); vs += __shfl_xor(vs, 2); vs += __shfl_xor(vs, 4);
        const float rstd = rsqrtf(vs * (1.f / 64.f) + 64e-5f);
        h16x8 ov;
#pragma unroll
        for (int j = 0; j < 8; ++j) ov[j] = (h16)((y[j] * rstd * lg[j] + lb[j] + bs * (float)v8[j]) * (float)g8[j]);
        *(h16x8*)(YB + o) = ov;
    }
}


__device__ __forceinline__ void ins16(unsigned (&L)[16], unsigned x) {
#pragma unroll
    for (int j = 0; j < 16; ++j) { const unsigned hi = L[j] > x ? L[j] : x; x = L[j] > x ? x : L[j]; L[j] = hi; }
}
__device__ __forceinline__ unsigned ord32(float f) { const unsigned u = __float_as_uint(f); return (u & 0x80000000u) ? ~u : (u | 0x80000000u); }
__device__ __forceinline__ float unord32(unsigned k) { return __uint_as_float((k & 0x80000000u) ? (k & 0x7fffffffu) : ~k); }
__device__ __forceinline__ void phase_topk(const Args& a, LAS unsigned char* lds) {
    const int tid = tid_();
    const h16* SC = (const h16*)(a.ws + O_SCORES);
    const float* part = (const float*)(a.ws + O_PART1);
    unsigned short* IDX = (unsigned short*)(a.ws + O_IDX); float* GATE = (float*)(a.ws + O_GATE); float* RS1 = (float*)(a.ws + O_RS1);
    LAS unsigned char* LI = lds;
    for (int task = blockIdx.x * NTHREADS + tid; task < MTOK * 8; task += gridDim.x * NTHREADS) {
        const int t = task >> 3, h = task & 7;
        float ssq = 0.f;
#pragma unroll
        for (int j = 0; j < 4; ++j) { const f32x4 p4 = *(const f32x4*)(part + (size_t)t * 16 + 4 * j); ssq += (p4[0] + p4[1]) + (p4[2] + p4[3]); }
        const float rs = rsqrtf(ssq * (1.f / 1024.f) + NORM_EPS);
        if (h == 0) RS1[t] = rs;
        float sv[2][16];
#pragma unroll
        for (int c = 0; c < 2; ++c) {
            unsigned L[16];
#pragma unroll
            for (int j = 0; j < 16; ++j) L[j] = 0u;
            const h16* row = SC + (size_t)t * 2048 + h * 256 + c * 128;
#pragma unroll 2
            for (int n8 = 0; n8 < 16; ++n8) {
                const u32x4 w4 = *(const u32x4*)(row + n8 * 8);
#pragma unroll
                for (int e = 0; e < 8; ++e) {
                    const unsigned bits = (e & 1) ? (w4[e >> 1] >> 16) : (w4[e >> 1] & 0xffffu);
                    const unsigned o16 = (bits & 0x8000u) ? (~bits & 0xffffu) : (bits | 0x8000u);
                    ins16(L, (o16 << 16) | (unsigned)(127 - (n8 * 8 + e)));
                }
            }
#pragma unroll
            for (int j = 0; j < 16; ++j) {
                const unsigned o16 = L[j] >> 16; const unsigned bits = (o16 & 0x8000u) ? (o16 & 0x7fffu) : (~o16 & 0xffffu);
                union { unsigned short u; h16 f; } cv; cv.u = (unsigned short)bits; sv[c][j] = (float)cv.f;
                LI[(c * 16 + j) * 512 + tid] = (unsigned char)(127u - (L[j] & 127u));
            }
        }
        unsigned L[16];
#pragma unroll
        for (int j = 0; j < 16; ++j) L[j] = 0u;
#pragma unroll
        for (int i = 0; i < 16; ++i)
#pragma unroll
            for (int j = 0; j < 16; ++j) if ((i + 1) * (j + 1) <= 16) ins16(L, (ord32(sv[0][i] + sv[1][j]) & ~255u) | (unsigned)(255 - (i * 16 + j)));
        float e[16]; float den = 0.f; const float mx = unord32(L[0] & ~255u) * rs;
        unsigned short id[16];
#pragma unroll
        for (int k = 0; k < 16; ++k) {
            const float v = unord32(L[k] & ~255u) * rs; e[k] = __expf(v - mx); den += e[k];
            const unsigned pos = 255u - (L[k] & 255u); const unsigned i = pos >> 4, j = pos & 15u;
            id[k] = (unsigned short)((unsigned)LI[i * 512 + tid] * 128u + (unsigned)LI[(16 + j) * 512 + tid]);
        }
        const float inv = __builtin_amdgcn_rcpf(den);
        u32x4 i0, i1;
        i0[0] = id[0] | (id[1] << 16); i0[1] = id[2] | (id[3] << 16); i0[2] = id[4] | (id[5] << 16); i0[3] = id[6] | (id[7] << 16);
        i1[0] = id[8] | (id[9] << 16); i1[1] = id[10] | (id[11] << 16); i1[2] = id[12] | (id[13] << 16); i1[3] = id[14] | (id[15] << 16);
        u32x4* ip = (u32x4*)(IDX + (size_t)task * 16); ip[0] = i0; ip[1] = i1;
        f32x4* gp = (f32x4*)(GATE + (size_t)task * 16);
#pragma unroll
        for (int k4 = 0; k4 < 4; ++k4) gp[k4] = (f32x4){e[4 * k4] * inv, e[4 * k4 + 1] * inv, e[4 * k4 + 2] * inv, e[4 * k4 + 3] * inv};
    }
}

__device__ __forceinline__ float gelu_tanh(float x) { const float u = 0.7978845608028654f * (x + 0.044715f * x * x * x); return 0.5f * x * (1.0f + tanhf_(u)); }
__device__ __forceinline__ float dot16(const h16x8& a0, const h16x8& a1, const h16x8& b0, const h16x8& b1) {
    float s = 0.f;
#pragma unroll
    for (int j = 0; j < 4; ++j) {
        s = __builtin_amdgcn_fdot2((h16x2){a0[2 * j], a0[2 * j + 1]}, (h16x2){b0[2 * j], b0[2 * j + 1]}, s, false);
        s = __builtin_amdgcn_fdot2((h16x2){a1[2 * j], a1[2 * j + 1]}, (h16x2){b1[2 * j], b1[2 * j + 1]}, s, false);
    }
    return s;
}
__device__ __forceinline__ void phase_gather(const Args& a) {
    const int tid = tid_(), lane = tid & 63, wave = tid >> 6;
    const int gw = blockIdx.x * NWAVES + wave, NGW = gridDim.x * NWAVES;
    const h16* H1B = (const h16*)(a.ws + O_H1B); const h16* U = (const h16*)(a.ws + O_U16); const h16* Vt = (const h16*)(a.ws + O_V16);
    const unsigned short* IDX = (const unsigned short*)(a.ws + O_IDX); const float* GATE = (const float*)(a.ws + O_GATE); const float* RS1 = (const float*)(a.ws + O_RS1);
    h16* H2B = (h16*)(a.ws + O_H2B); float* RS2 = (float*)(a.ws + O_RS2);
    const int myk = ((lane >> 5) & 1) * 4 + ((lane >> 4) & 1) * 2 + ((lane >> 3) & 1);
    for (int t = gw; t < MTOK; t += NGW) {
        const h16x8 x0 = *(const h16x8*)(H1B + (size_t)t * 1024 + 8 * lane), x1 = *(const h16x8*)(H1B + (size_t)t * 1024 + 512 + 8 * lane);
        const float rs = RS1[t];
        const unsigned id_lo = IDX[(size_t)t * 128 + lane], id_hi = IDX[(size_t)t * 128 + 64 + lane];
        float acc[16];
#pragma unroll
        for (int j = 0; j < 16; ++j) acc[j] = 0.f;
#pragma unroll 1
        for (int g = 0; g < 16; ++g) {
            const unsigned idv = (g < 8) ? id_lo : id_hi;
            h16x8 u0[8], u1[8], v0[8], v1[8];
#pragma unroll
            for (int r = 0; r < 8; ++r) {
                const unsigned e = (unsigned)__shfl((int)idv, (g & 7) * 8 + r);
                const unsigned eu = (unsigned)__builtin_amdgcn_readfirstlane((int)e);
                const h16* ur = U + (size_t)eu * 1024; const h16* vr = Vt + (size_t)eu * 1024;
                u0[r] = *(const h16x8*)(ur + 8 * lane); u1[r] = *(const h16x8*)(ur + 512 + 8 * lane);
                v0[r] = *(const h16x8*)(vr + 8 * lane); v1[r] = *(const h16x8*)(vr + 512 + 8 * lane);
            }
            float p[8];
#pragma unroll
            for (int r = 0; r < 8; ++r) p[r] = dot16(x0, x1, u0[r], u1[r]);
            float q4[4], q2[2], q1;
#pragma unroll
            for (int i = 0; i < 4; ++i) { const float keep = (lane & 32) ? p[i + 4] : p[i], send = (lane & 32) ? p[i] : p[i + 4]; q4[i] = keep + __shfl_xor(send, 32); }
#pragma unroll
            for (int i = 0; i < 2; ++i) { const float keep = (lane & 16) ? q4[i + 2] : q4[i], send = (lane & 16) ? q4[i] : q4[i + 2]; q2[i] = keep + __shfl_xor(send, 16); }
            { const float keep = (lane & 8) ? q2[1] : q2[0], send = (lane & 8) ? q2[0] : q2[1]; q1 = keep + __shfl_xor(send, 8); }
            q1 += __shfl_xor(q1, 4); q1 += __shfl_xor(q1, 2); q1 += __shfl_xor(q1, 1);
            const float gt = GATE[(size_t)t * 128 + g * 8 + myk];
            const float coef = gt * gelu_tanh(rs * q1);
#pragma unroll
            for (int r = 0; r < 8; ++r) {
                const int src = ((r >> 2) & 1) * 32 + ((r >> 1) & 1) * 16 + (r & 1) * 8;
                const float c = __shfl(coef, src);
#pragma unroll
                for (int j = 0; j < 8; ++j) { acc[j] += c * (float)v0[r][j]; acc[8 + j] += c * (float)v1[r][j]; }
            }
        }
        float* orow = a.out + (size_t)t * 1024;
        f32x4 h0 = *(const f32x4*)(orow + 8 * lane), h1 = *(const f32x4*)(orow + 8 * lane + 4), h2 = *(const f32x4*)(orow + 512 + 8 * lane), h3 = *(const f32x4*)(orow + 512 + 8 * lane + 4);
#pragma unroll
        for (int j = 0; j < 4; ++j) { h0[j] += acc[j]; h1[j] += acc[4 + j]; h2[j] += acc[8 + j]; h3[j] += acc[12 + j]; }
        *(f32x4*)(orow + 8 * lane) = h0; *(f32x4*)(orow + 8 * lane + 4) = h1; *(f32x4*)(orow + 512 + 8 * lane) = h2; *(f32x4*)(orow + 512 + 8 * lane + 4) = h3;
        *(h16x8*)(H2B + (size_t)t * 1024 + 8 * lane) = pack8(h0, h1); *(h16x8*)(H2B + (size_t)t * 1024 + 512 + 8 * lane) = pack8(h2, h3);
        float ss = 0.f;
#pragma unroll
        for (int j = 0; j < 4; ++j) ss += h0[j] * h0[j] + h1[j] * h1[j] + h2[j] * h2[j] + h3[j] * h3[j];
        ss = wave_sum(ss);
        if (lane == 0) RS2[t] = rsqrtf(ss * (1.f / 1024.f) + NORM_EPS);
    }
}

__device__ __forceinline__ void phase_peer_tail(const Args& a) {
    const int tid = tid_(), lane = tid & 63, wave = tid >> 6;
    const int gw = blockIdx.x * NWAVES + wave, NGW = gridDim.x * NWAVES;
    h16* h2b = (h16*)(a.ws + O_H2B); float* rs2 = (float*)(a.ws + O_RS2);
    for (int r = gw; r < MTOK; r += NGW) {
        const f32x4* xr = (const f32x4*)(a.out + (size_t)r * 1024) + lane;
        f32x4 v[4]; float s = 0.f;
#pragma unroll
        for (int j = 0; j < 4; ++j) { v[j] = xr[64 * j]; s += (v[j][0] * v[j][0] + v[j][1] * v[j][1]) + (v[j][2] * v[j][2] + v[j][3] * v[j][3]); }
        const float rs = rsqrtf(wave_sum(s) * (1.f / 1024.f) + NORM_EPS);
        h16x4* o = (h16x4*)(h2b + (size_t)r * 1024) + lane;
#pragma unroll
        for (int j = 0; j < 4; ++j) o[64 * j] = pack4(v[j]);
        if (lane == 0) rs2[r] = rs;
    }
}

__device__ __forceinline__ void phase_final(const Args& a) {
    const int tid = tid_(), lane = tid & 63, wave = tid >> 6;
    const int gw = blockIdx.x * NWAVES + wave, NGW = gridDim.x * NWAVES;
    const float* part = (const float*)(a.ws + O_PART3); const float* fg = a.in[28];
    f32x4 g4[4];
#pragma unroll
    for (int j = 0; j < 4; ++j) g4[j] = *((const f32x4*)fg + lane + 64 * j);
    for (int r = gw; r < MTOK; r += NGW) {
        float s = (lane < 16) ? part[(size_t)r * 16 + lane] : 0.f;
        s = wave_sum(s);
        const float rs = rsqrtf(s * (1.f / 1024.f) + NORM_EPS);
        f32x4* xr = (f32x4*)(a.out + (size_t)r * 1024) + lane;
#pragma unroll
        for (int j = 0; j < 4; ++j) xr[64 * j] = xr[64 * j] * rs * g4[j];
    }
}

constexpr int NPHASE = 17;
__global__ void __launch_bounds__(NTHREADS, 2) mk(Args a) {
    extern __shared__ __attribute__((aligned(16))) unsigned char smem[];
    LAS unsigned char* lds = (LAS unsigned char*)smem;
    unsigned char* ws = a.ws;
#if ONE_LAUNCH
    cg::grid_group grid = cg::this_grid();
#define SYNC() grid.sync()
#else
#define SYNC() do {} while (0)
#endif
#define IN(k) (a.ph_lo <= (k) && (k) < a.ph_hi)
#define SEAM(k) do { if (IN(k) && IN((k) + 1)) SYNC(); } while (0)
    const int G = gridDim.x, bid = blockIdx.x;
    if (IN(0)) { phase_prep(a, lds); } SEAM(0);
    if (IN(1)) { pg8::Gemm g{(const h16*)(ws + O_XN), (const h16*)(ws + O_WIN), MTOK, NIN, 1024}; pg8::StaticOrder S; S.init(MTOK, NIN, G, bid);
        EpiZ E{(h16*)(ws + O_ZC), (h16*)(ws + O_ZR), (h16*)(ws + O_ZG)}; pg8::gemm_phase(lds, g, S, E); } SEAM(1);
    if (IN(2)) { phase_conv(a); phase_rwkv_prep(a); } SEAM(2);
    if (IN(3)) { pg8::Gemm g{(const h16*)(ws + O_APR), (const h16*)(ws + O_WLR), MTOK, 1536, 256}; pg8::StaticOrder S; S.init(MTOK, 1536, G, bid);
        h16* R = (h16*)a.out; h16* KS = R + (size_t)MTOK * 512; h16* KK = KS + (size_t)2 * MTOK * 512;
        EpiLR E{a.in[7], a.in[9], a.in[13], (h16*)(ws + O_WD), KS, (h16*)(ws + O_BD), (h16*)(ws + O_GG), KK}; pg8::gemm_phase(lds, g, S, E); } SEAM(3);
    if (IN(4)) { phase_scan<true>(a, lds); } SEAM(4);
    if (IN(5)) { phase_scan_combine(a, lds); } SEAM(5);
    if (IN(6)) { phase_scan<false>(a, lds); } SEAM(6);
    if (IN(7)) { phase_rwkv_post(a); } SEAM(7);
    if (IN(8)) { pg8::Gemm g{(const h16*)(ws + O_CA), (const h16*)(ws + O_WA), MTOK, 1024, 512}; pg8::StaticOrder S; S.init(MTOK, 1024, G, bid);
        EpiYA E{(const h16*)(ws + O_ZG), a.out}; pg8::gemm_phase(lds, g, S, E); } SEAM(8);
    if (IN(9)) { pg8::Gemm g{(const h16*)(ws + O_YB), (const h16*)(ws + O_WB), MTOK, 1024, 512}; pg8::StaticOrder S; S.init(MTOK, 1024, G, bid);
        EpiYB E{(const h16*)(ws + O_ZG), a.out, (h16*)(ws + O_MERGED)}; pg8::gemm_phase(lds, g, S, E); } SEAM(9);
    if (IN(10)) { pg8::Gemm g{(const h16*)(ws + O_MERGED), (const h16*)(ws + O_WO), MTOK, 1024, 1024}; pg8::StaticOrder S; S.init(MTOK, 1024, G, bid);
        EpiH1 E{a.in[0], a.out, (h16*)(ws + O_H1B), (float*)(ws + O_PART1)}; pg8::gemm_phase(lds, g, S, E); } SEAM(10);
    if (IN(11)) { pg8::Gemm g{(const h16*)(ws + O_H1B), (const h16*)(ws + O_WS), MTOK, 2048, 1024}; pg8::StaticOrder S; S.init(MTOK, 2048, G, bid);
        EpiF16 E{(h16*)(ws + O_SCORES), 2048}; pg8::gemm_phase(lds, g, S, E); } SEAM(11);
    if (IN(12)) { phase_topk(a, lds); } SEAM(12);
    if (IN(13)) { phase_gather(a); } SEAM(13);
    if (IN(14)) { pg8::Gemm g{(const h16*)(ws + O_P16), (const h16*)(ws + O_WP), MTOK, 1024, 256}; pg8::StaticOrder S; S.init(MTOK, 1024, G, bid);
        EpiF16 E{(h16*)(ws + O_PP), 1024}; pg8::gemm_phase(lds, g, S, E); } SEAM(14);
    if (IN(15)) { pg8::Gemm g{(const h16*)(ws + O_H2B), (const h16*)(ws + O_WG), MTOK, 1024, 1024}; pg8::StaticOrder S; S.init(MTOK, 1024, G, bid);
        EpiGate E{a.out, (const h16*)(ws + O_PP), (const float*)(ws + O_RS2), (float*)(ws + O_PART3)}; pg8::gemm_phase(lds, g, S, E); } SEAM(15);
    if (IN(16)) { phase_final(a); }
}

extern "C" void kernel_launch(void* const* d_in, const int* in_sizes, int n_in, void* d_out, int out_size, void* d_ws, size_t ws_size, hipStream_t stream) {
    static int ready = 0;
    if (!ready) {
        if (n_in != 29 || ws_size < WS_END) { fprintf(stderr, "kernel_launch: unexpected n_in %d / ws %zu (need %zu)\n", n_in, ws_size, (size_t)WS_END); ready = -1; return; }
        if (hipFuncSetAttribute((const void*)mk, hipFuncAttributeMaxDynamicSharedMemorySize, LDS_BYTES) != hipSuccess) { fprintf(stderr, "hipFuncSetAttribute failed\n"); ready = -1; return; }
        ready = 1;
    }
    if (ready < 0) return;
    Args a{};
    for (int i = 0; i < 29; ++i) a.in[i] = (const float*)d_in[i];
    a.out = (float*)d_out; a.ws = (unsigned char*)d_ws;
#if ONE_LAUNCH
    a.ph_lo = 0; a.ph_hi = NPHASE;
    void* args[] = {&a};
    hipLaunchCooperativeKernel((const void*)mk, dim3(NBLK), dim3(NTHREADS), args, LDS_BYTES, stream);
#else
    const int phases[] = {0, 1, 2, 3, 4, 5, 6, 7, 8, 9, 10, 11, 12, 13, 14, 15, 16};
    for (int ph : phases) { a.ph_lo = ph; a.ph_hi = ph + 1; hipLaunchKernelGGL(mk, dim3(NBLK), dim3(NTHREADS), LDS_BYTES, stream, a); }
#endif
}
```

```cpp
#include <hip/hip_runtime.h>
#include <hip/hip_cooperative_groups.h>
#include <cstdio>
namespace cg = cooperative_groups;

#ifndef ONE_LAUNCH
#define ONE_LAUNCH 1
#endif

#define LAS __attribute__((address_space(3)))
typedef _Float16 h16;
typedef _Float16 h16x8 __attribute__((ext_vector_type(8)));
typedef _Float16 h16x4 __attribute__((ext_vector_type(4)));
typedef _Float16 h16x2 __attribute__((ext_vector_type(2)));
typedef float f32x4 __attribute__((ext_vector_type(4)));
typedef float f32x2 __attribute__((ext_vector_type(2)));
typedef unsigned u32x4 __attribute__((ext_vector_type(4)));
typedef unsigned u32x2 __attribute__((ext_vector_type(2)));

constexpr int MTOK = 65536, DM = 1024, SEQ = 8192, NB = 8;
constexpr int NIN = 5376;
constexpr int NTHREADS = 512, NWAVES = 8, NBLK = 256;
constexpr int LDS_BYTES = 131072;
constexpr float NORM_EPS = 1e-6f;

constexpr size_t MiB = 1u << 20;
constexpr size_t O_WIN = 0;
constexpr size_t O_WA = O_WIN + (size_t)5376 * 1024 * 2;
constexpr size_t O_WB = O_WA + 1 * MiB;
constexpr size_t O_WO = O_WB + 1 * MiB;
constexpr size_t O_WG = O_WO + 2 * MiB;
constexpr size_t O_WP = O_WG + 2 * MiB;
constexpr size_t O_WLR = O_WP + MiB / 2;
constexpr size_t O_WS = O_WLR + 3 * MiB / 4;
constexpr size_t O_U16 = O_WS + 4 * MiB;
constexpr size_t O_V16 = O_U16 + 32 * MiB;
constexpr size_t O_P16 = O_V16 + 32 * MiB;
constexpr size_t O_PART1 = O_P16 + 32 * MiB;
constexpr size_t O_PART3 = O_PART1 + 4 * MiB;
constexpr size_t O_RS1 = O_PART3 + 4 * MiB;
constexpr size_t O_RS2 = O_RS1 + MiB / 4;
constexpr size_t O_XN = O_RS2 + MiB / 4;
constexpr size_t O_ZC = O_XN + 128 * MiB;
constexpr size_t O_ZR = O_ZC + 192 * MiB;
constexpr size_t O_ZG = O_ZR + 224 * MiB;
constexpr size_t O_SS2 = O_ZG + 256 * MiB;
constexpr size_t O_USC = O_SS2 + 2 * MiB;
constexpr size_t O_VSC = O_USC + 65536;
constexpr size_t O_CTR = O_VSC + 65536;
constexpr size_t WS_END = O_CTR + 4096;
constexpr size_t O_U8 = O_U16;
constexpr size_t O_V8 = O_U16 + 16 * MiB;
constexpr size_t O_PART = O_ZG;
constexpr size_t O_COEF = O_ZR + 48 * MiB;
constexpr size_t O_CA = O_XN;
constexpr size_t O_APR = O_XN + 64 * MiB;
constexpr size_t O_H1B = O_XN;
constexpr size_t O_WD = O_ZC;
constexpr size_t O_BD = O_ZC + 64 * MiB;
constexpr size_t O_GG = O_ZC + 128 * MiB;
constexpr size_t O_MERGED = O_ZC;
constexpr size_t O_H2B = O_ZC;
constexpr size_t O_PQ = O_ZR;
constexpr size_t O_SST = O_ZR + 64 * MiB;
constexpr size_t O_Y = O_ZR + 96 * MiB;
constexpr size_t O_YB = O_ZR + 160 * MiB;
constexpr size_t O_IDX = O_ZR;
constexpr size_t O_GATE = O_ZR + 16 * MiB;
constexpr size_t O_PP = O_ZR + 64 * MiB;
constexpr size_t O_SCORES = O_ZG;

struct Args {
    const float* in[29];
    float* out;
    unsigned char* ws;
    int ph_lo, ph_hi;
};

__device__ __forceinline__ int tid_() { int t = threadIdx.x; asm volatile("" : "+v"(t)); return t; }
__device__ __forceinline__ float sigmoidf_(float x) { return __builtin_amdgcn_rcpf(1.0f + __expf(-x)); }
__device__ __forceinline__ float wave_sum(float v) {
#pragma unroll
    for (int o = 1; o < 64; o <<= 1) v += __shfl_xor(v, o);
    return v;
}
__device__ __forceinline__ h16x8 pack8(f32x4 a, f32x4 b) {
    h16x8 r;
    r[0] = (h16)a[0]; r[1] = (h16)a[1]; r[2] = (h16)a[2]; r[3] = (h16)a[3];
    r[4] = (h16)b[0]; r[5] = (h16)b[1]; r[6] = (h16)b[2]; r[7] = (h16)b[3];
    return r;
}
__device__ __forceinline__ h16x4 pack4(f32x4 a) {
    h16x4 r; r[0] = (h16)a[0]; r[1] = (h16)a[1]; r[2] = (h16)a[2]; r[3] = (h16)a[3]; return r;
}

namespace pg8 {
constexpr int BM = 256, BK = 64, HALF = 128, HTB = HALF * BK * 2, STAGE_BYTES = 8 * HTB, NXCD = 8, WGM = 8;
__device__ __forceinline__ int lds_byte(int r, int c) { const int st = (r >> 4) * 2 + (c >> 5), rr = r & 15, cc = c & 31, ob = rr * 64 + cc * 2; return st * 1024 + (ob ^ (((ob >> 9) & 1) << 5)); }
__device__ __forceinline__ void stage_rc(int b, int& R, int& C) { const int st = b / 1024, sb = b % 1024, swz = sb ^ (((sb >> 9) & 1) << 5); R = (st >> 1) * 16 + swz / 64; C = (st & 1) * 32 + (swz % 64) / 2; }
__device__ __forceinline__ int perm32(int rho) { const int n = rho >> 4, i = rho & 15; return 8 * (i >> 2) + 4 * n + (i & 3); }

struct Unit { int pm, pn; };
struct Gemm { const h16* A; const h16* Bt; int M, N, K; };

struct StaticOrder {
    int nM, nN, nwg, G, c;
    __device__ void init(int M, int N, int G_, int c_) { nM = M / BM; nN = N / BM; nwg = nM * nN; G = G_; c = c_; }
    __device__ bool next(int i, Unit& u) const {
        const long L = (long)i * G + c; if (L >= nwg) return false;
        int wgid = (int)L; { const int q = nwg / NXCD, r = nwg % NXCD, xcd = wgid % NXCD, off = wgid / NXCD; wgid = (xcd < r ? xcd * (q + 1) : r * (q + 1) + (xcd - r) * q) + off; }
        const int nig = WGM * nN, gid = wgid / nig, fm = gid * WGM, gsz = (nM - fm) < WGM ? (nM - fm) : WGM;
        u.pm = fm + ((wgid % nig) % gsz); u.pn = (wgid % nig) / gsz; return true;
    }
};

template <class Epi>
__device__ __forceinline__ void gemm_phase(LAS unsigned char* lds, const Gemm g, const StaticOrder& S, const Epi& E) {
    const int tid = tid_(), wid = __builtin_amdgcn_readfirstlane(tid >> 6), lane = tid & 63, wr = wid >> 2, wc = wid & 3, fr = lane & 15, fq = lane >> 4;
    const int K = g.K, nt = K / BK;
    unsigned voffA[2], voffB[2];
#pragma unroll
    for (int i = 0; i < 2; ++i) { int R, C; stage_rc(tid * 16 + i * 8192, R, C); const int Rb = (R & ~31) + perm32(R & 31);
        voffA[i] = (unsigned)(R * K + C) * 2u; voffB[i] = (unsigned)(Rb * K + C) * 2u; }
    const size_t kstep = (size_t)(BK * 2);
    const size_t hstep = (size_t)HALF * K * 2;
    const size_t tstep = 2 * hstep;
    const unsigned ldsw = (unsigned)wid * 1024u;
    const int aoff = lds_byte(wr * 64 + fr, fq * 8), boff = lds_byte(wc * 32 + fr, fq * 8);
#define PG8_SA(b, h) (((b) * 2 + (h)) * HTB)
#define PG8_SB(b, h) ((4 + (b) * 2 + (h)) * HTB)
#define PG8_STAGE(bufoff, gbase, voff) do { _Pragma("unroll") for (int _i = 0; _i < 2; ++_i) \
        __builtin_amdgcn_global_load_lds((const unsigned*)((const char*)(gbase) + (voff)[_i]), (LAS unsigned*)(lds + (bufoff) + ldsw + _i * 8192), 16, 0, 0); } while (0)
#define PG8_LDA(dst, b, h) do { _Pragma("unroll") for (int m = 0; m < 4; ++m) _Pragma("unroll") for (int k = 0; k < 2; ++k) dst[m][k] = *(const LAS h16x8*)(lds + PG8_SA(b, h) + aoff + m * 2048 + k * 1024); } while (0)
#define PG8_LDB(dst, b, h) do { _Pragma("unroll") for (int n = 0; n < 2; ++n) _Pragma("unroll") for (int k = 0; k < 2; ++k) dst[n][k] = *(const LAS h16x8*)(lds + PG8_SB(b, h) + boff + n * 2048 + k * 1024); } while (0)
#define PG8_MMA(ai, bj, At, Bt) do { __builtin_amdgcn_s_setprio(1); _Pragma("unroll") for (int m = 0; m < 4; ++m) _Pragma("unroll") for (int n = 0; n < 2; ++n) _Pragma("unroll") for (int k = 0; k < 2; ++k) \
        acc[ai][bj][m][n] = __builtin_amdgcn_mfma_f32_16x16x32_f16(Bt[n][k], At[m][k], acc[ai][bj][m][n], 0, 0, 0); __builtin_amdgcn_s_setprio(0); } while (0)
#define PG8_WAIT_V(n) asm volatile("s_waitcnt vmcnt(" #n ")" ::: "memory")
#define PG8_WAIT_L(n) asm volatile("s_waitcnt lgkmcnt(" #n ")" ::: "memory")
#define PG8_BAR __builtin_amdgcn_s_barrier()
#define PG8_SCHED __builtin_amdgcn_sched_barrier(0)
    Unit cur, nxt; int ui = 0;
    if (!S.next(0, cur)) return;
    f32x4 acc[2][2][4][2];
#pragma unroll
    for (int a = 0; a < 2; ++a)
#pragma unroll
        for (int b = 0; b < 2; ++b)
#pragma unroll
            for (int m = 0; m < 4; ++m)
#pragma unroll
                for (int n = 0; n < 2; ++n) acc[a][b][m][n] = (f32x4){0.f, 0.f, 0.f, 0.f};
    h16x8 At[4][2], B0[2][2], B1[2][2];
    const char* cA = (const char*)g.A + (size_t)cur.pm * tstep; const char* cB = (const char*)g.Bt + (size_t)cur.pn * tstep;
    PG8_STAGE(PG8_SB(0, 0), cB, voffB); PG8_STAGE(PG8_SA(0, 0), cA, voffA); PG8_STAGE(PG8_SB(0, 1), cB + hstep, voffB); PG8_STAGE(PG8_SA(0, 1), cA + hstep, voffA);
    if (wr == 1) PG8_BAR;
    PG8_WAIT_V(4); PG8_BAR;
    PG8_STAGE(PG8_SB(1, 0), cB + kstep, voffB); PG8_STAGE(PG8_SA(1, 0), cA + kstep, voffA); PG8_STAGE(PG8_SB(1, 1), cB + hstep + kstep, voffB);
    PG8_WAIT_V(6); PG8_BAR;
    for (;;) {
        const bool has_next = S.next(ui + 1, nxt);
        const char* nA = has_next ? (const char*)g.A + (size_t)nxt.pm * tstep : cA; const char* nB = has_next ? (const char*)g.Bt + (size_t)nxt.pn * tstep : cB;
        for (int t = 0; t < nt; t += 2) {
            const bool last = (t == nt - 2);
            const char* a1 = cA + (size_t)(t + 1) * kstep;
            const char* a2 = last ? nA : cA + (size_t)(t + 2) * kstep; const char* b2 = last ? nB : cB + (size_t)(t + 2) * kstep;
            const char* a3 = a2 + kstep; const char* b3 = b2 + kstep;
            PG8_LDB(B0, 0, 0); PG8_SCHED; PG8_LDA(At, 0, 0); PG8_STAGE(PG8_SA(1, 1), a1 + hstep, voffA);
            PG8_WAIT_L(8); PG8_BAR; PG8_WAIT_L(0); PG8_MMA(0, 0, At, B0); PG8_BAR; PG8_SCHED;
            PG8_LDB(B1, 0, 1); PG8_STAGE(PG8_SB(0, 0), b2, voffB);
            PG8_BAR; PG8_WAIT_L(0); PG8_MMA(0, 1, At, B1); PG8_BAR;
            PG8_LDA(At, 0, 1); PG8_STAGE(PG8_SA(0, 0), a2, voffA);
            PG8_BAR; PG8_WAIT_L(0); PG8_MMA(1, 0, At, B0); PG8_BAR; PG8_SCHED;
            PG8_STAGE(PG8_SB(0, 1), b2 + hstep, voffB);
            PG8_WAIT_V(6); PG8_BAR; PG8_MMA(1, 1, At, B1); PG8_BAR;
            PG8_LDB(B0, 1, 0); PG8_SCHED; PG8_LDA(At, 1, 0); PG8_STAGE(PG8_SA(0, 1), a2 + hstep, voffA);
            PG8_WAIT_L(8); PG8_BAR; PG8_WAIT_L(0); PG8_MMA(0, 0, At, B0); PG8_BAR; PG8_SCHED;
            PG8_LDB(B1, 1, 1); PG8_STAGE(PG8_SB(1, 0), b3, voffB);
            PG8_BAR; PG8_WAIT_L(0); PG8_MMA(0, 1, At, B1); PG8_BAR;
            PG8_LDA(At, 1, 1); PG8_STAGE(PG8_SA(1, 0), a3, voffA);
            PG8_BAR; PG8_WAIT_L(0); PG8_MMA(1, 0, At, B0); PG8_BAR; PG8_SCHED;
            PG8_STAGE(PG8_SB(1, 1), b3 + hstep, voffB);
            PG8_WAIT_V(6); PG8_BAR; PG8_MMA(1, 1, At, B1); PG8_BAR;
        }
        E(acc, cur, wr, wc, fr, fq);
        if (!has_next) break;
#pragma unroll
        for (int a = 0; a < 2; ++a)
#pragma unroll
            for (int b = 0; b < 2; ++b)
#pragma unroll
                for (int m = 0; m < 4; ++m)
#pragma unroll
                    for (int n = 0; n < 2; ++n) acc[a][b][m][n] = (f32x4){0.f, 0.f, 0.f, 0.f};
        cur = nxt; cA = nA; cB = nB; ++ui;
    }
    PG8_WAIT_V(0);
    if (wr == 0) PG8_BAR;
    PG8_BAR;
#undef PG8_SA
#undef PG8_SB
#undef PG8_STAGE
#undef PG8_LDA
#undef PG8_LDB
#undef PG8_MMA
#undef PG8_WAIT_V
#undef PG8_WAIT_L
#undef PG8_BAR
#undef PG8_SCHED
}
}
using pg8::Unit;
typedef const f32x4 (&AccRef)[2][2][4][2];

#define EPI_LOOP_BEGIN \
    _Pragma("unroll") for (int ai = 0; ai < 2; ++ai) _Pragma("unroll") for (int m = 0; m < 4; ++m) { \
        const int row = u.pm * 256 + ai * 128 + wr * 64 + m * 16 + fr; \
        _Pragma("unroll") for (int bj = 0; bj < 2; ++bj) { \
            const int col = u.pn * 256 + bj * 128 + wc * 32 + 8 * fq; \
            const f32x4 v0 = acc[ai][bj][m][0], v1 = acc[ai][bj][m][1];
#define EPI_LOOP_END } }

struct EpiZ {
    h16 *zc, *zr, *zg;
    __device__ __forceinline__ void operator()(AccRef acc, const Unit& u, int wr, int wc, int fr, int fq) const {
        const int colt = u.pn * 256; h16* base; int ld, c0;
        if (colt < 1536) { base = zc; ld = 1536; c0 = colt; } else if (colt < 3328) { base = zr; ld = 1792; c0 = colt - 1536; } else { base = zg; ld = 2048; c0 = colt - 3328; }
        EPI_LOOP_BEGIN
            *(h16x8*)(base + (size_t)row * ld + (col - colt + c0)) = pack8(v0, v1);
        EPI_LOOP_END
    }
};
struct EpiF16 {
    h16* O; int ld;
    __device__ __forceinline__ void operator()(AccRef acc, const Unit& u, int wr, int wc, int fr, int fq) const {
        EPI_LOOP_BEGIN
            *(h16x8*)(O + (size_t)row * ld + col) = pack8(v0, v1);
        EPI_LOOP_END
    }
};
struct EpiYA {
    const h16* zg; float* tmp;
    __device__ __forceinline__ void operator()(AccRef acc, const Unit& u, int wr, int wc, int fr, int fq) const {
        EPI_LOOP_BEGIN
            const h16x8 gv = *(const h16x8*)(zg + (size_t)row * 2048 + col);
            f32x4 o0, o1;
#pragma unroll
            for (int j = 0; j < 4; ++j) { o0[j] = sigmoidf_((float)gv[j]) * v0[j]; o1[j] = sigmoidf_((float)gv[4 + j]) * v1[j]; }
            float* p = tmp + (size_t)row * 1024 + col;
            *(f32x4*)p = o0; *(f32x4*)(p + 4) = o1;
        EPI_LOOP_END
    }
};
struct EpiYB {
    const h16* zg; const float* tmp; h16* merged;
    __device__ __forceinline__ void operator()(AccRef acc, const Unit& u, int wr, int wc, int fr, int fq) const {
        EPI_LOOP_BEGIN
            const h16x8 gv = *(const h16x8*)(zg + (size_t)row * 2048 + 1024 + col);
            const float* p = tmp + (size_t)row * 1024 + col;
            f32x4 o0 = *(const f32x4*)p, o1 = *(const f32x4*)(p + 4);
#pragma unroll
            for (int j = 0; j < 4; ++j) { o0[j] += sigmoidf_((float)gv[j]) * v0[j]; o1[j] += sigmoidf_((float)gv[4 + j]) * v1[j]; }
            *(h16x8*)(merged + (size_t)row * 1024 + col) = pack8(o0, o1);
        EPI_LOOP_END
    }
};
struct EpiH1 {
    const float* x; float* out; h16* hb; float* part;
    __device__ __forceinline__ void operator()(AccRef acc, const Unit& u, int wr, int wc, int fr, int fq) const {
#pragma unroll
        for (int ai = 0; ai < 2; ++ai)
#pragma unroll
            for (int m = 0; m < 4; ++m) {
                const int row = u.pm * 256 + ai * 128 + wr * 64 + m * 16 + fr; float ss = 0.f;
#pragma unroll
                for (int bj = 0; bj < 2; ++bj) {
                    const int col = u.pn * 256 + bj * 128 + wc * 32 + 8 * fq;
                    const float* xp = x + (size_t)row * 1024 + col;
                    f32x4 o0 = *(const f32x4*)xp + acc[ai][bj][m][0], o1 = *(const f32x4*)(xp + 4) + acc[ai][bj][m][1];
                    float* op = out + (size_t)row * 1024 + col;
                    *(f32x4*)op = o0; *(f32x4*)(op + 4) = o1;
                    *(h16x8*)(hb + (size_t)row * 1024 + col) = pack8(o0, o1);
                    ss += (o0[0] * o0[0] + o0[1] * o0[1]) + (o0[2] * o0[2] + o0[3] * o0[3]) + (o1[0] * o1[0] + o1[1] * o1[1]) + (o1[2] * o1[2] + o1[3] * o1[3]);
                }
                ss += __shfl_xor(ss, 16); ss += __shfl_xor(ss, 32);
                if (fq == 0) part[(size_t)row * 16 + u.pn * 4 + wc] = ss;
            }
    }
};
struct EpiGate {
    float* out; const h16* pp; const float* rs2; float* part;
    __device__ __forceinline__ void operator()(AccRef acc, const Unit& u, int wr, int wc, int fr, int fq) const {
#pragma unroll
        for (int ai = 0; ai < 2; ++ai)
#pragma unroll
            for (int m = 0; m < 4; ++m) {
                const int row = u.pm * 256 + ai * 128 + wr * 64 + m * 16 + fr; float ss = 0.f;
                const f32x4 sa = *(const f32x4*)(rs2 + (size_t)row * 8), sb = *(const f32x4*)(rs2 + (size_t)row * 8 + 4);
                const float rs = rsqrtf(((sa[0] + sa[1]) + (sa[2] + sa[3]) + (sb[0] + sb[1]) + (sb[2] + sb[3])) * (1.f / 1024.f) + NORM_EPS);
#pragma unroll
                for (int bj = 0; bj < 2; ++bj) {
                    const int col = u.pn * 256 + bj * 128 + wc * 32 + 8 * fq;
                    float* op = out + (size_t)row * 1024 + col;
                    f32x4 o0 = *(const f32x4*)op, o1 = *(const f32x4*)(op + 4);
                    const h16x8 pv = *(const h16x8*)(pp + (size_t)row * 1024 + col);
                    const f32x4 v0 = acc[ai][bj][m][0], v1 = acc[ai][bj][m][1];
#pragma unroll
                    for (int j = 0; j < 4; ++j) { o0[j] += sigmoidf_(rs * v0[j]) * (float)pv[j]; o1[j] += sigmoidf_(rs * v1[j]) * (float)pv[4 + j]; }
                    *(f32x4*)op = o0; *(f32x4*)(op + 4) = o1;
                    ss += (o0[0] * o0[0] + o0[1] * o0[1]) + (o0[2] * o0[2] + o0[3] * o0[3]) + (o1[0] * o1[0] + o1[1] * o1[1]) + (o1[2] * o1[2] + o1[3] * o1[3]);
                }
                ss += __shfl_xor(ss, 16); ss += __shfl_xor(ss, 32);
                if (fq == 0) part[(size_t)row * 16 + u.pn * 4 + wc] = ss;
            }
    }
};

__device__ __forceinline__ void tr_item(const float* W, int N, const float* g, h16* WT, int ldk, int koff, int k0, int n0, LAS float* scr, int lane) {
#pragma unroll 8
    for (int i = 0; i < 32; ++i) { const int kk = 2 * i + (lane >> 5); float v = W[(size_t)(k0 + kk) * N + n0 + (lane & 31)]; if (g) v *= g[k0 + kk]; scr[kk * 33 + (lane & 31)] = v; }
    asm volatile("s_waitcnt lgkmcnt(0)" ::: "memory");
    const int c = lane & 7;
#pragma unroll
    for (int j = 0; j < 4; ++j) { const int n = (lane >> 3) + 8 * j; const LAS float* s = scr + (8 * c) * 33 + n;
        h16x8 o;
#pragma unroll
        for (int e = 0; e < 8; ++e) o[e] = (h16)s[e * 33];
        *(h16x8*)(WT + (size_t)(n0 + n) * ldk + koff + k0 + 8 * c) = o; }
    asm volatile("s_waitcnt lgkmcnt(0)" ::: "memory");
}
struct TrJob { const float* W; const float* g; h16* WT; int K, N, ldk, koff; };

__device__ __forceinline__ void phase_prep(const Args& a, LAS unsigned char* lds) {
    const int tid = tid_(), lane = tid & 63, wave = tid >> 6;
    const int gw = blockIdx.x * NWAVES + wave, NGW = gridDim.x * NWAVES;
    unsigned char* ws = a.ws;
    {
        LAS float* scr = (LAS float*)(lds + wave * 8704);
        TrJob jobs[9] = {
            {a.in[3], a.in[2], (h16*)(ws + O_WIN), 1024, NIN, 1024, 0},
            {a.in[17], nullptr, (h16*)(ws + O_WA), 512, 1024, 512, 0},
            {a.in[18], nullptr, (h16*)(ws + O_WB), 512, 1024, 512, 0},
            {a.in[19], nullptr, (h16*)(ws + O_WO), 1024, 1024, 1024, 0},
            {a.in[26], a.in[25], (h16*)(ws + O_WG), 1024, 1024, 1024, 0},
            {a.in[27], nullptr, (h16*)(ws + O_WP), 256, 1024, 256, 0},
            {a.in[8], nullptr, (h16*)(ws + O_WLR), 64, 512, 256, 0},
            {a.in[10], nullptr, (h16*)(ws + O_WLR) + (size_t)512 * 256, 64, 512, 256, 64},
            {a.in[11], nullptr, (h16*)(ws + O_WLR) + (size_t)1024 * 256, 128, 512, 256, 128},
        };
        int base = 0;
#pragma unroll
        for (int j = 0; j < 9; ++j) {
            const TrJob J = jobs[j]; const int nnb = J.N / 32, items = (J.K / 64) * nnb;
            int first = gw - (base % NGW); if (first < 0) first += NGW;
            for (int r = first; r < items; r += NGW) tr_item(J.W, J.N, J.g, J.WT, J.ldk, J.koff, (r / nnb) * 64, (r % nnb) * 32, scr, lane);
            base += items;
        }
        h16* wlr = (h16*)(ws + O_WLR);
        for (int i = blockIdx.x * NTHREADS + tid; i < 1536 * 256 / 8; i += gridDim.x * NTHREADS) {
            const int n = (i * 8) / 256, k = (i * 8) % 256; const int blk = n / 512;
            const bool inblk = (blk == 0) ? (k < 64) : (blk == 1) ? (k >= 64 && k < 128) : (k >= 128);
            if (!inblk) { h16x8 z; for (int e = 0; e < 8; ++e) z[e] = (h16)0.f; *(h16x8*)(wlr + (size_t)i * 8) = z; }
        }
    }
    __syncthreads();
    {
        LAS float* LA = (LAS float*)lds;
        LAS float* LB = (LAS float*)(lds + 64 * 129 * 4);
        const float* wq = a.in[21]; const float* sk = a.in[22]; const float* gf = a.in[20];
        h16* wst = (h16*)(ws + O_WS);
        for (int it = blockIdx.x; it < 256; it += gridDim.x) {
            const int g16 = it >> 4, k0 = (it & 15) * 64;
            for (int i = tid; i < 64 * 128; i += NTHREADS) { const int k = i >> 7, d = i & 127; LA[k * 129 + d] = wq[(size_t)(k0 + k) * 2048 + g16 * 128 + d] * gf[k0 + k]; }
            for (int i = tid; i < 128 * 128; i += NTHREADS) { const int n = i >> 7, d = i & 127; LB[n * 129 + d] = sk[((size_t)g16 * 128 + n) * 128 + d]; }
            __syncthreads();
            const int n = tid & 127, kg = tid >> 7;
            float o[16];
#pragma unroll
            for (int j = 0; j < 16; ++j) o[j] = 0.f;
            for (int d = 0; d < 128; ++d) { const float b = LB[n * 129 + d];
#pragma unroll
                for (int j = 0; j < 16; ++j) o[j] += LA[(kg * 16 + j) * 129 + d] * b; }
            h16x8 o0, o1;
#pragma unroll
            for (int j = 0; j < 8; ++j) { o0[j] = (h16)o[j]; o1[j] = (h16)o[8 + j]; }
            h16* dst = wst + (size_t)(g16 * 128 + n) * 1024 + k0 + kg * 16;
            *(h16x8*)dst = o0; *(h16x8*)(dst + 8) = o1;
            __syncthreads();
        }
    }
    {
        const float* gf = a.in[20];
        f32x4 g4[4];
#pragma unroll
        for (int j = 0; j < 4; ++j) g4[j] = *(const f32x4*)(gf + 16 * lane + 4 * j);
        for (int r = gw; r < 2 * 16384; r += NGW) {
            const int tb = r >> 14, e = r & 16383;
            const float* src = (tb ? a.in[24] : a.in[23]) + (size_t)e * 1024 + 16 * lane;
            f32x4 v[4]; float mx = 0.f;
#pragma unroll
            for (int j = 0; j < 4; ++j) { v[j] = *(const f32x4*)(src + 4 * j); if (!tb) v[j] = v[j] * g4[j];
#pragma unroll
                for (int c = 0; c < 4; ++c) mx = fmaxf(mx, fabsf(v[j][c])); }
#pragma unroll
            for (int o = 1; o < 64; o <<= 1) mx = fmaxf(mx, __shfl_xor(mx, o));
            mx = fmaxf(mx, 1e-30f);
            const float sc = 224.0f / mx;
            u32x4 q;
#pragma unroll
            for (int j = 0; j < 4; ++j) { int w = 0; w = __builtin_amdgcn_cvt_pk_fp8_f32(v[j][0] * sc, v[j][1] * sc, w, false); w = __builtin_amdgcn_cvt_pk_fp8_f32(v[j][2] * sc, v[j][3] * sc, w, true); q[j] = (unsigned)w; }
            unsigned char* dst = ws + (tb ? O_V8 : O_U8) + ((size_t)(lane >> 3) * 16384 + e) * 128 + 16 * (lane & 7);
            *(u32x4*)dst = q;
            if (lane == 0) ((float*)(ws + (tb ? O_VSC : O_USC)))[e] = mx * (1.0f / 224.0f);
        }
        if (blockIdx.x == 0 && tid < 16) ((unsigned*)(ws + O_CTR))[tid * 64] = 0u;
        const f32x4* pp = (const f32x4*)a.in[1]; h16x4* dp = (h16x4*)(ws + O_P16);
        const int np4 = MTOK * 256 / 4;
        for (int i = blockIdx.x * NTHREADS + tid; i < np4; i += gridDim.x * NTHREADS) dp[i] = pack4(pp[i]);
    }
    {
        const float* x = a.in[0]; h16* xn = (h16*)(ws + O_XN);
        for (int r = gw; r < MTOK; r += NGW) {
            const f32x4* xr = (const f32x4*)(x + (size_t)r * 1024) + lane;
            f32x4 v[4]; float s = 0.f;
#pragma unroll
            for (int j = 0; j < 4; ++j) { v[j] = xr[64 * j]; s += (v[j][0] * v[j][0] + v[j][1] * v[j][1]) + (v[j][2] * v[j][2] + v[j][3] * v[j][3]); }
            const float rs = rsqrtf(wave_sum(s) * (1.f / 1024.f) + NORM_EPS);
            h16x4* o = (h16x4*)(xn + (size_t)r * 1024) + lane;
#pragma unroll
            for (int j = 0; j < 4; ++j) o[64 * j] = pack4(v[j] * rs);
        }
    }
}

__device__ __forceinline__ void phase_conv(const Args& a) {
    const int tid = tid_(), lane = tid & 63, wave = tid >> 6;
    const int gw = blockIdx.x * NWAVES + wave, NGW = gridDim.x * NWAVES;
    const h16* zc = (const h16*)(a.ws + O_ZC); h16* ca = (h16*)(a.ws + O_CA);
    const float* cw = a.in[4]; const float* cb = a.in[5];
    float w0[8], w1[8], w2[8], bb[8];
#pragma unroll
    for (int j = 0; j < 8; ++j) { const int c = lane * 8 + j; w0[j] = cw[c]; w1[j] = cw[512 + c]; w2[j] = cw[1024 + c]; bb[j] = cb[c]; }
    for (int run = gw; run < MTOK / 32; run += NGW) {
        const int t0 = run * 32;
        float u1[8], u2[8];
        if ((t0 % SEQ) == 0) {
#pragma unroll
            for (int j = 0; j < 8; ++j) { u1[j] = 0.f; u2[j] = 0.f; }
        } else {
            const h16x8 c1 = *(const h16x8*)(zc + (size_t)(t0 - 1) * 1536 + 512 + lane * 8), x1 = *(const h16x8*)(zc + (size_t)(t0 - 1) * 1536 + 1024 + lane * 8);
            const h16x8 c2 = *(const h16x8*)(zc + (size_t)(t0 - 2) * 1536 + 512 + lane * 8), x2 = *(const h16x8*)(zc + (size_t)(t0 - 2) * 1536 + 1024 + lane * 8);
#pragma unroll
            for (int j = 0; j < 8; ++j) { u1[j] = (float)c1[j] * (float)x1[j]; u2[j] = (float)c2[j] * (float)x2[j]; }
        }
        for (int t = t0; t < t0 + 32; ++t) {
            const h16* zrow = zc + (size_t)t * 1536 + lane * 8;
            const h16x8 gb = *(const h16x8*)zrow, gc = *(const h16x8*)(zrow + 512), xi = *(const h16x8*)(zrow + 1024);
            h16x8 o;
#pragma unroll
            for (int j = 0; j < 8; ++j) { const float u0 = (float)gc[j] * (float)xi[j];
                const float y = w0[j] * u2[j] + w1[j] * u1[j] + w2[j] * u0 + bb[j];
                o[j] = (h16)((float)gb[j] * y); u2[j] = u1[j]; u1[j] = u0; }
            *(h16x8*)(ca + (size_t)t * 512 + lane * 8) = o;
        }
    }
}


__device__ __forceinline__ float tanhf_(float x) { return 1.0f - 2.0f * __builtin_amdgcn_rcpf(1.0f + __expf(2.0f * x)); }
__device__ __forceinline__ void phase_rwkv_prep(const Args& a) {
    const int tid = tid_(), lane = tid & 63, wave = tid >> 6;
    const int gw = blockIdx.x * NWAVES + wave, NGW = gridDim.x * NWAVES;
    const h16* zr = (const h16*)(a.ws + O_ZR);
    h16* R = (h16*)a.out; h16* KS = R + (size_t)MTOK * 512; h16* V = KS + (size_t)MTOK * 512; h16* KK = V + (size_t)MTOK * 512;
    h16* APR = (h16*)(a.ws + O_APR);
    const float* mu = a.in[6]; const float* k_k = a.in[12];
    float mr[8], mk[8], mv[8], mt[8], kk8[8];
#pragma unroll
    for (int j = 0; j < 8; ++j) { const int c = lane * 8 + j; mr[j] = mu[c]; mk[j] = mu[512 + c]; mv[j] = mu[1024 + c]; mt[j] = mu[1536 + (c & 255)]; kk8[j] = k_k[c]; }
    for (int run = gw; run < MTOK / 32; run += NGW) {
        const int t0 = run * 32;
        float pr[8], pk[8], pv[8], pt[8];
        if ((t0 % SEQ) == 0) {
#pragma unroll
            for (int j = 0; j < 8; ++j) { pr[j] = 0.f; pk[j] = 0.f; pv[j] = 0.f; pt[j] = 0.f; }
        } else {
            const h16* zp = zr + (size_t)(t0 - 1) * 1792 + lane * 8;
            const h16x8 a0 = *(const h16x8*)zp, a1 = *(const h16x8*)(zp + 512), a2 = *(const h16x8*)(zp + 1024), a3 = *(const h16x8*)(zr + (size_t)(t0 - 1) * 1792 + 1536 + (lane & 31) * 8);
#pragma unroll
            for (int j = 0; j < 8; ++j) { pr[j] = (float)a0[j]; pk[j] = (float)a1[j]; pv[j] = (float)a2[j]; pt[j] = (float)a3[j]; }
        }
        for (int t = t0; t < t0 + 32; ++t) {
            const h16* zp = zr + (size_t)t * 1792 + lane * 8;
            const h16x8 a0 = *(const h16x8*)zp, a1 = *(const h16x8*)(zp + 512), a2 = *(const h16x8*)(zp + 1024), a3 = *(const h16x8*)(zr + (size_t)t * 1792 + 1536 + (lane & 31) * 8);
            h16x8 orr, ok, ov, okk, ot; float kr[8]; float ss = 0.f;
#pragma unroll
            for (int j = 0; j < 8; ++j) {
                const float zr_ = (float)a0[j], zk_ = (float)a1[j], zv_ = (float)a2[j], zt_ = (float)a3[j];
                const float r = zr_ + mr[j] * (pr[j] - zr_), k = zk_ + mk[j] * (pk[j] - zk_), v = zv_ + mv[j] * (pv[j] - zv_), tl = zt_ + mt[j] * (pt[j] - zt_);
                pr[j] = zr_; pk[j] = zk_; pv[j] = zv_; pt[j] = zt_;
                orr[j] = (h16)r; ok[j] = (h16)k; ov[j] = (h16)v;
                kr[j] = k * kk8[j]; ss += kr[j] * kr[j];
                const float tv = (lane < 8) ? tanhf_(tl) : (lane < 16) ? tl : sigmoidf_(tl);
                ot[j] = (h16)tv;
            }
            ss += __shfl_xor(ss, 1); ss += __shfl_xor(ss, 2); ss += __shfl_xor(ss, 4);
            const float rn = rsqrtf(ss + 1e-12f);
#pragma unroll
            for (int j = 0; j < 8; ++j) okk[j] = (h16)(kr[j] * rn);
            const size_t o = (size_t)t * 512 + lane * 8;
            *(h16x8*)(R + o) = orr; *(h16x8*)(KS + o) = ok; *(h16x8*)(V + o) = ov; *(h16x8*)(KK + o) = okk;
            if (lane < 32) *(h16x8*)(APR + (size_t)t * 256 + lane * 8) = ot;
        }
    }
}

struct EpiLR {
    const float *w0, *a0, *k_a; h16 *WD, *KS, *BD, *GG; const h16* KK;
    __device__ __forceinline__ void operator()(AccRef acc, const Unit& u, int wr, int wc, int fr, int fq) const {
        const int part = u.pn >> 1;
        EPI_LOOP_BEGIN
            const int c = col - part * 512; const size_t o = (size_t)row * 512 + c;
            if (part == 0) {
                const f32x4 b0 = *(const f32x4*)(w0 + c), b1 = *(const f32x4*)(w0 + c + 4); f32x4 o0, o1;
#pragma unroll
                for (int j = 0; j < 4; ++j) { o0[j] = __expf(-0.6065306597126334f * sigmoidf_(b0[j] + v0[j])); o1[j] = __expf(-0.6065306597126334f * sigmoidf_(b1[j] + v1[j])); }
                *(h16x8*)(WD + o) = pack8(o0, o1);
            } else if (part == 1) {
                const f32x4 b0 = *(const f32x4*)(a0 + c), b1 = *(const f32x4*)(a0 + c + 4), ka0 = *(const f32x4*)(k_a + c), ka1 = *(const f32x4*)(k_a + c + 4);
                const h16x8 ks = *(const h16x8*)(KS + o), kk = *(const h16x8*)(KK + o); f32x4 k0, k1, bb0, bb1;
#pragma unroll
                for (int j = 0; j < 4; ++j) { const float aa0 = sigmoidf_(b0[j] + v0[j]), aa1 = sigmoidf_(b1[j] + v1[j]);
                    k0[j] = (float)ks[j] * (1.0f + (aa0 - 1.0f) * ka0[j]); k1[j] = (float)ks[4 + j] * (1.0f + (aa1 - 1.0f) * ka1[j]);
                    bb0[j] = aa0 * (float)kk[j]; bb1[j] = aa1 * (float)kk[4 + j]; }
                *(h16x8*)(KS + o) = pack8(k0, k1); *(h16x8*)(BD + o) = pack8(bb0, bb1);
            } else {
                *(h16x8*)(GG + o) = pack8(v0, v1);
            }
        EPI_LOOP_END
    }
};

constexpr int SC_L = 256, SC_NCH = SEQ / SC_L, SC_NB = 4;
constexpr int SC_STEP_F = 6 * 64;
constexpr int SC_WAVE_BYTES = 2 * SC_NB * SC_STEP_F * 4 + 1024;
template <int MODE>
__device__ __forceinline__ void scan_wave(const Args& a, LAS unsigned char* lds, int task) {
    const int tid = tid_(), lane = tid & 63, wave = tid >> 6;
    const int q = lane & 3, rg = lane >> 2;
    const int chain = task / SC_NCH, chunk = task % SC_NCH, b = chain >> 3, h = chain & 7;
    const size_t row0 = (size_t)b * SEQ + (size_t)chunk * SC_L;
    const h16* R = (const h16*)a.out; const h16* KS = R + (size_t)MTOK * 512; const h16* V = KS + (size_t)MTOK * 512; const h16* KK = V + (size_t)MTOK * 512;
    const h16* WD = (const h16*)(a.ws + O_WD); const h16* BD = (const h16*)(a.ws + O_BD);
    LAS float* buf = (LAS float*)(lds + wave * SC_WAVE_BYTES);
    LAS float* ybuf = buf + 2 * SC_NB * SC_STEP_F;
    const h16* gp[3]; int lo[3];
#pragma unroll
    for (int j = 0; j < 3; ++j) { const int p = lane + 64 * j, seg = p >> 3, part = p & 7, st = seg / 6, ar = seg % 6;
        const h16* base = (ar == 0) ? KK : (ar == 1) ? WD : (ar == 2) ? BD : (ar == 3) ? KS : (ar == 4) ? R : V;
        gp[j] = base + (row0 + st) * 512 + h * 64 + part * 8; lo[j] = st * SC_STEP_F + ar * 64 + part * 8; }
    float s[4][16];
    if (MODE == 0) {
#pragma unroll
        for (int i = 0; i < 4; ++i)
#pragma unroll
            for (int j = 0; j < 16; ++j) s[i][j] = 0.f;
    } else if (MODE == 1) {
#pragma unroll
        for (int i = 0; i < 4; ++i)
#pragma unroll
            for (int j = 0; j < 16; ++j) s[i][j] = (i == q && j == rg) ? 1.f : 0.f;
    } else {
        const float* S0 = (const float*)(a.ws + O_SST) + (size_t)task * 4096;
#pragma unroll
        for (int i = 0; i < 4; ++i)
#pragma unroll
            for (int j4 = 0; j4 < 4; ++j4) { const f32x4 t = *(const f32x4*)(S0 + (rg + 16 * i) * 64 + 16 * q + 4 * j4);
                s[i][4 * j4] = t[0]; s[i][4 * j4 + 1] = t[1]; s[i][4 * j4 + 2] = t[2]; s[i][4 * j4 + 3] = t[3]; }
    }
    h16x8 pre[3];
#pragma unroll
    for (int j = 0; j < 3; ++j) pre[j] = *(const h16x8*)gp[j];
    for (int bt = 0; bt < SC_L / SC_NB; ++bt) {
        LAS float* cb = buf + (bt & 1) * SC_NB * SC_STEP_F;
#pragma unroll
        for (int j = 0; j < 3; ++j) { f32x4 x0, x1;
#pragma unroll
            for (int e = 0; e < 4; ++e) { x0[e] = (float)pre[j][e]; x1[e] = (float)pre[j][4 + e]; }
            *(LAS f32x4*)(cb + lo[j]) = x0; *(LAS f32x4*)(cb + lo[j] + 4) = x1; }
        if (bt + 1 < SC_L / SC_NB) {
#pragma unroll
            for (int j = 0; j < 3; ++j) pre[j] = *(const h16x8*)(gp[j] + (size_t)(bt + 1) * SC_NB * 512);
        }
#pragma unroll 1
        for (int st = 0; st < SC_NB; ++st) {
            const LAS float* sb = cb + st * SC_STEP_F;
            float kk[16], w[16], bb[16], kx[16], vv[4];
#pragma unroll
            for (int j4 = 0; j4 < 4; ++j4) {
                const f32x4 t0 = *(const LAS f32x4*)(sb + 16 * q + 4 * j4), t1 = *(const LAS f32x4*)(sb + 64 + 16 * q + 4 * j4), t2 = *(const LAS f32x4*)(sb + 128 + 16 * q + 4 * j4);
#pragma unroll
                for (int e = 0; e < 4; ++e) { kk[4 * j4 + e] = t0[e]; w[4 * j4 + e] = t1[e]; bb[4 * j4 + e] = t2[e]; }
                if (MODE != 1) { const f32x4 t3 = *(const LAS f32x4*)(sb + 192 + 16 * q + 4 * j4);
#pragma unroll
                    for (int e = 0; e < 4; ++e) kx[4 * j4 + e] = t3[e]; }
            }
            if (MODE != 1) {
#pragma unroll
                for (int i = 0; i < 4; ++i) vv[i] = sb[320 + rg + 16 * i];
            }
            float us[4];
#pragma unroll
            for (int i = 0; i < 4; ++i) { float t = 0.f;
#pragma unroll
                for (int j = 0; j < 16; ++j) t += s[i][j] * kk[j];
                t += __shfl_xor(t, 1); t += __shfl_xor(t, 2); us[i] = t; }
#pragma unroll
            for (int i = 0; i < 4; ++i)
#pragma unroll
                for (int j = 0; j < 16; ++j) { if (MODE != 1) s[i][j] = s[i][j] * w[j] - us[i] * bb[j] + vv[i] * kx[j]; else s[i][j] = s[i][j] * w[j] - us[i] * bb[j]; }
            if (MODE == 2) {
                float rr[16];
#pragma unroll
                for (int j4 = 0; j4 < 4; ++j4) { const f32x4 t4 = *(const LAS f32x4*)(sb + 256 + 16 * q + 4 * j4);
#pragma unroll
                    for (int e = 0; e < 4; ++e) rr[4 * j4 + e] = t4[e]; }
#pragma unroll
                for (int i = 0; i < 4; ++i) { float y = 0.f;
#pragma unroll
                    for (int j = 0; j < 16; ++j) y += s[i][j] * rr[j];
                    y += __shfl_xor(y, 1); y += __shfl_xor(y, 2);
                    if (q == 0) ybuf[st * 64 + rg + 16 * i] = y; }
            }
        }
        if (MODE == 2) {
            if (lane < 32) { const int st = lane >> 3, part = lane & 7; h16x8 o;
#pragma unroll
                for (int e = 0; e < 8; ++e) o[e] = (h16)ybuf[st * 64 + part * 8 + e];
                *(h16x8*)((h16*)(a.ws + O_Y) + (row0 + (size_t)bt * SC_NB + st) * 512 + h * 64 + part * 8) = o; }
        }
    }
    if (MODE != 2) {
        float* PQ = (float*)(a.ws + O_PQ) + (size_t)task * 8192 + (MODE == 0 ? 4096 : 0);
#pragma unroll
        for (int i = 0; i < 4; ++i)
#pragma unroll
            for (int j4 = 0; j4 < 4; ++j4) { const int o = (rg + 16 * i) * 64 + 16 * q + 4 * j4;
                *(f32x4*)(PQ + o) = (f32x4){s[i][4 * j4], s[i][4 * j4 + 1], s[i][4 * j4 + 2], s[i][4 * j4 + 3]}; }
    }
}
template <bool FIRST>
__device__ __forceinline__ void phase_scan(const Args& a, LAS unsigned char* lds) {
    const int wave = tid_() >> 6;
    if (FIRST) {
        for (int t2 = blockIdx.x * NWAVES + wave; t2 < 2 * 64 * SC_NCH; t2 += gridDim.x * NWAVES) {
            if (t2 & 1) scan_wave<1>(a, lds, t2 >> 1); else scan_wave<0>(a, lds, t2 >> 1); }
    } else {
        for (int task = blockIdx.x * NWAVES + wave; task < 64 * SC_NCH; task += gridDim.x * NWAVES) scan_wave<2>(a, lds, task);
    }
}
__device__ __forceinline__ void phase_scan_combine(const Args& a, LAS unsigned char* lds) {
    const int tid = tid_(), row = tid >> 3, cb = (tid & 7) * 8;
    LAS float* LS = (LAS float*)lds;
    for (int chain = blockIdx.x; chain < 64; chain += gridDim.x) {
        float sr[8];
#pragma unroll
        for (int j = 0; j < 8; ++j) sr[j] = 0.f;
        for (int c = 0; c < SC_NCH; ++c) {
            const int task = chain * SC_NCH + c;
            float* S0 = (float*)(a.ws + O_SST) + (size_t)task * 4096 + row * 64 + cb;
            *(f32x4*)S0 = (f32x4){sr[0], sr[1], sr[2], sr[3]}; *(f32x4*)(S0 + 4) = (f32x4){sr[4], sr[5], sr[6], sr[7]};
            if (c == SC_NCH - 1) break;
            __syncthreads();
#pragma unroll
            for (int j = 0; j < 8; ++j) LS[row * 65 + cb + j] = sr[j];
            __syncthreads();
            const float* P = (const float*)(a.ws + O_PQ) + (size_t)task * 8192; const float* Q = P + 4096;
            const f32x4 q0 = *(const f32x4*)(Q + row * 64 + cb), q1 = *(const f32x4*)(Q + row * 64 + cb + 4);
            float acc[8] = {q0[0], q0[1], q0[2], q0[3], q1[0], q1[1], q1[2], q1[3]};
#pragma unroll 8
            for (int k = 0; k < 64; ++k) { const float sk = LS[row * 65 + k]; const f32x4 p0 = *(const f32x4*)(P + k * 64 + cb), p1 = *(const f32x4*)(P + k * 64 + cb + 4);
#pragma unroll
                for (int j = 0; j < 4; ++j) { acc[j] += sk * p0[j]; acc[4 + j] += sk * p1[j]; } }
#pragma unroll
            for (int j = 0; j < 8; ++j) sr[j] = acc[j];
        }
        __syncthreads();
    }
}
__device__ __forceinline__ void phase_rwkv_post(const Args& a) {
    const int tid = tid_(), lane = tid & 63, wave = tid >> 6;
    const int gw = blockIdx.x * NWAVES + wave, NGW = gridDim.x * NWAVES;
    const h16* R = (const h16*)a.out; const h16* KS = R + (size_t)MTOK * 512; const h16* V = KS + (size_t)MTOK * 512;
    const h16* GG = (const h16*)(a.ws + O_GG); const h16* Y = (const h16*)(a.ws + O_Y); h16* YB = (h16*)(a.ws + O_YB);
    float rk[8], lg[8], lb[8];
#pragma unroll
    for (int j = 0; j < 8; ++j) { const int c = lane * 8 + j; rk[j] = a.in[14][c]; lg[j] = a.in[15][c]; lb[j] = a.in[16][c]; }
    for (int t = gw; t < MTOK; t += NGW) {
        const size_t o = (size_t)t * 512 + lane * 8;
        const h16x8 y8 = *(const h16x8*)(Y + o), r8 = *(const h16x8*)(R + o), k8 = *(const h16x8*)(KS + o), v8 = *(const h16x8*)(V + o), g8 = *(const h16x8*)(GG + o);
        float y[8]; float sm = 0.f, bs = 0.f;
#pragma unroll
        for (int j = 0; j < 8; ++j) { y[j] = (float)y8[j]; sm += y[j]; bs += (float)r8[j] * (float)k8[j] * rk[j]; }
        sm += __shfl_xor(sm, 1); sm += __shfl_xor(sm, 2); sm += __shfl_xor(sm, 4);
        bs += __shfl_xor(bs, 1); bs += __shfl_xor(bs, 2); bs += __shfl_xor(bs, 4);
        const float mean = sm * (1.f / 64.f); float vs = 0.f;
#pragma unroll
        for (int j = 0; j < 8; ++j) { y[j] -= mean; vs += y[j] * y[j]; }
        vs += __shfl_xor(vs, 1); vs += __shfl_xor(vs, 2); vs += __shfl_xor(vs, 4);
        const float rstd = rsqrtf(vs * (1.f / 64.f) + 64e-5f);
        h16x8 ov;
#pragma unroll
        for (int j = 0; j < 8; ++j) ov[j] = (h16)((y[j] * rstd * lg[j] + lb[j] + bs * (float)v8[j]) * (float)g8[j]);
        *(h16x8*)(YB + o) = ov;
    }
}


__device__ __forceinline__ void ins16(unsigned (&L)[16], unsigned x) {
#pragma unroll
    for (int j = 0; j < 16; ++j) { const unsigned hi = L[j] > x ? L[j] : x; x = L[j] > x ? x : L[j]; L[j] = hi; }
}
__device__ __forceinline__ unsigned ord32(float f) { const unsigned u = __float_as_uint(f); return (u & 0x80000000u) ? ~u : (u | 0x80000000u); }
__device__ __forceinline__ float unord32(unsigned k) { return __uint_as_float((k & 0x80000000u) ? (k & 0x7fffffffu) : ~k); }
__device__ __forceinline__ void phase_topk(const Args& a, LAS unsigned char* lds) {
    const int tid = tid_();
    const h16* SC = (const h16*)(a.ws + O_SCORES);
    const float* part = (const float*)(a.ws + O_PART1);
    unsigned short* IDX = (unsigned short*)(a.ws + O_IDX); float* GATE = (float*)(a.ws + O_GATE); float* RS1 = (float*)(a.ws + O_RS1);
    LAS unsigned char* LI = lds;
    for (int task = blockIdx.x * NTHREADS + tid; task < MTOK * 8; task += gridDim.x * NTHREADS) {
        const int t = task >> 3, h = task & 7;
        float ssq = 0.f;
#pragma unroll
        for (int j = 0; j < 4; ++j) { const f32x4 p4 = *(const f32x4*)(part + (size_t)t * 16 + 4 * j); ssq += (p4[0] + p4[1]) + (p4[2] + p4[3]); }
        const float rs = rsqrtf(ssq * (1.f / 1024.f) + NORM_EPS);
        if (h == 0) RS1[t] = rs;
        float sv[2][16];
#pragma unroll
        for (int c = 0; c < 2; ++c) {
            unsigned L[16];
#pragma unroll
            for (int j = 0; j < 16; ++j) L[j] = 0u;
            const h16* row = SC + (size_t)t * 2048 + h * 256 + c * 128;
#pragma unroll 2
            for (int n8 = 0; n8 < 16; ++n8) {
                const u32x4 w4 = *(const u32x4*)(row + n8 * 8);
#pragma unroll
                for (int e = 0; e < 8; ++e) {
                    const unsigned bits = (e & 1) ? (w4[e >> 1] >> 16) : (w4[e >> 1] & 0xffffu);
                    const unsigned o16 = (bits & 0x8000u) ? (~bits & 0xffffu) : (bits | 0x8000u);
                    ins16(L, (o16 << 16) | (unsigned)(127 - (n8 * 8 + e)));
                }
            }
#pragma unroll
            for (int j = 0; j < 16; ++j) {
                const unsigned o16 = L[j] >> 16; const unsigned bits = (o16 & 0x8000u) ? (o16 & 0x7fffu) : (~o16 & 0xffffu);
                union { unsigned short u; h16 f; } cv; cv.u = (unsigned short)bits; sv[c][j] = (float)cv.f;
                LI[(c * 16 + j) * 512 + tid] = (unsigned char)(127u - (L[j] & 127u));
            }
        }
        unsigned L[16];
#pragma unroll
        for (int j = 0; j < 16; ++j) L[j] = 0u;
#pragma unroll
        for (int i = 0; i < 16; ++i)
#pragma unroll
            for (int j = 0; j < 16; ++j) if ((i + 1) * (j + 1) <= 16) ins16(L, (ord32(sv[0][i] + sv[1][j]) & ~255u) | (unsigned)(255 - (i * 16 + j)));
        float e[16]; float den = 0.f; const float mx = unord32(L[0] & ~255u) * rs;
        unsigned short id[16];
#pragma unroll
        for (int k = 0; k < 16; ++k) {
            const float v = unord32(L[k] & ~255u) * rs; e[k] = __expf(v - mx); den += e[k];
            const unsigned pos = 255u - (L[k] & 255u); const unsigned i = pos >> 4, j = pos & 15u;
            id[k] = (unsigned short)((unsigned)LI[i * 512 + tid] * 128u + (unsigned)LI[(16 + j) * 512 + tid]);
        }
        const float inv = __builtin_amdgcn_rcpf(den);
        u32x4 i0, i1;
        i0[0] = id[0] | (id[1] << 16); i0[1] = id[2] | (id[3] << 16); i0[2] = id[4] | (id[5] << 16); i0[3] = id[6] | (id[7] << 16);
        i1[0] = id[8] | (id[9] << 16); i1[1] = id[10] | (id[11] << 16); i1[2] = id[12] | (id[13] << 16); i1[3] = id[14] | (id[15] << 16);
        u32x4* ip = (u32x4*)(IDX + (size_t)task * 16); ip[0] = i0; ip[1] = i1;
        f32x4* gp = (f32x4*)(GATE + (size_t)task * 16);
#pragma unroll
        for (int k4 = 0; k4 < 4; ++k4) gp[k4] = (f32x4){e[4 * k4] * inv, e[4 * k4 + 1] * inv, e[4 * k4 + 2] * inv, e[4 * k4 + 3] * inv};
    }
}

__device__ __forceinline__ float gelu_tanh(float x) { const float u = 0.7978845608028654f * (x + 0.044715f * x * x * x); return 0.5f * x * (1.0f + tanhf_(u)); }
__device__ __forceinline__ unsigned xcc_id() { return (unsigned)__builtin_amdgcn_s_getreg((3 << 11) | 20) & 7u; }
constexpr int GA_TC = 32, GA_NCH = MTOK / GA_TC;
__device__ __forceinline__ void dec16(const u32x4 q, float (&o)[16]) {
#pragma unroll
    for (int w = 0; w < 4; ++w) { const f32x2 lo = __builtin_amdgcn_cvt_pk_f32_fp8((int)q[w], false), hi = __builtin_amdgcn_cvt_pk_f32_fp8((int)q[w], true);
        o[4 * w] = lo[0]; o[4 * w + 1] = lo[1]; o[4 * w + 2] = hi[0]; o[4 * w + 3] = hi[1]; }
}
template <int PH>
__device__ __forceinline__ void phase_gather(const Args& a) {
    const int tid = tid_(), lane = tid & 63, m = lane & 7, r8 = lane >> 3;
    unsigned* ctr = (unsigned*)(a.ws + O_CTR) + PH * 8 * 64;
    const unsigned short* IDX = (const unsigned short*)(a.ws + O_IDX);
    const unsigned j0 = xcc_id();
    for (unsigned dj = 0; dj < 8; ++dj) {
        const unsigned j = (j0 + dj) & 7u;
        const unsigned char* TB = a.ws + (PH ? O_V8 : O_U8) + (size_t)j * 16384 * 128 + 16 * m;
        for (;;) {
            unsigned c = 0; if (lane == 0) c = __hip_atomic_fetch_add(ctr + j * 64, 1u, __ATOMIC_RELAXED, __HIP_MEMORY_SCOPE_AGENT);
            c = (unsigned)__builtin_amdgcn_readfirstlane((int)c);
            if (c >= (unsigned)GA_NCH) break;
#pragma unroll 1
            for (int ti = 0; ti < GA_TC; ++ti) {
                const int t = c * GA_TC + ti;
                const u32x4* ip = (const u32x4*)(IDX + (size_t)t * 128 + 16 * r8); const u32x4 ia = ip[0], ib = ip[1];
                u32x4 q[16];
#pragma unroll
                for (int i = 0; i < 16; ++i) { const unsigned w = (i < 8) ? ia[(i & 7) >> 1] : ib[(i & 7) >> 1]; const unsigned e = (i & 1) ? (w >> 16) : (w & 0xffffu);
                    q[i] = *(const u32x4*)(TB + (size_t)e * 128); }
                if (PH == 0) {
                    const h16* xp = (const h16*)(a.ws + O_H1B) + (size_t)t * 1024 + 128 * j + 16 * m;
                    const h16x8 xa = *(const h16x8*)xp, xb = *(const h16x8*)(xp + 8);
                    float x[16];
#pragma unroll
                    for (int k = 0; k < 8; ++k) { x[k] = (float)xa[k]; x[8 + k] = (float)xb[k]; }
                    float p[16];
#pragma unroll
                    for (int i = 0; i < 16; ++i) { float d[16]; dec16(q[i], d); float s0 = 0.f, s1 = 0.f;
#pragma unroll
                        for (int k = 0; k < 8; ++k) { s0 += x[2 * k] * d[2 * k]; s1 += x[2 * k + 1] * d[2 * k + 1]; }
                        p[i] = s0 + s1; }
                    float q8[8], q4[4], q2[2];
#pragma unroll
                    for (int i = 0; i < 8; ++i) { const float keep = (lane & 4) ? p[i + 8] : p[i], send = (lane & 4) ? p[i] : p[i + 8]; q8[i] = keep + __shfl_xor(send, 4); }
#pragma unroll
                    for (int i = 0; i < 4; ++i) { const float keep = (lane & 2) ? q8[i + 4] : q8[i], send = (lane & 2) ? q8[i] : q8[i + 4]; q4[i] = keep + __shfl_xor(send, 2); }
#pragma unroll
                    for (int i = 0; i < 2; ++i) { const float keep = (lane & 1) ? q4[i + 2] : q4[i], send = (lane & 1) ? q4[i] : q4[i + 2]; q2[i] = keep + __shfl_xor(send, 1); }
                    *(f32x2*)((float*)(a.ws + O_PART) + ((size_t)j * MTOK + t) * 128 + 16 * r8 + 2 * m) = (f32x2){q2[0], q2[1]};
                } else {
                    const f32x4* cp = (const f32x4*)((const float*)(a.ws + O_COEF) + (size_t)t * 128 + 16 * r8);
                    float cf[16];
#pragma unroll
                    for (int k4 = 0; k4 < 4; ++k4) { const f32x4 c4 = cp[k4]; cf[4 * k4] = c4[0]; cf[4 * k4 + 1] = c4[1]; cf[4 * k4 + 2] = c4[2]; cf[4 * k4 + 3] = c4[3]; }
                    float acc[16];
#pragma unroll
                    for (int k = 0; k < 16; ++k) acc[k] = 0.f;
#pragma unroll
                    for (int i = 0; i < 16; ++i) { float d[16]; dec16(q[i], d);
#pragma unroll
                        for (int k = 0; k < 16; ++k) acc[k] += cf[i] * d[k]; }
                    float q8[8], q4[4], q2[2];
#pragma unroll
                    for (int i = 0; i < 8; ++i) { const float keep = (lane & 32) ? acc[i + 8] : acc[i], send = (lane & 32) ? acc[i] : acc[i + 8]; q8[i] = keep + __shfl_xor(send, 32); }
#pragma unroll
                    for (int i = 0; i < 4; ++i) { const float keep = (lane & 16) ? q8[i + 4] : q8[i], send = (lane & 16) ? q8[i] : q8[i + 4]; q4[i] = keep + __shfl_xor(send, 16); }
#pragma unroll
                    for (int i = 0; i < 2; ++i) { const float keep = (lane & 8) ? q4[i + 2] : q4[i], send = (lane & 8) ? q4[i] : q4[i + 2]; q2[i] = keep + __shfl_xor(send, 8); }
                    const int col = 128 * j + 16 * m + 2 * r8;
                    float* op = a.out + (size_t)t * 1024 + col;
                    f32x2 hv = *(const f32x2*)op; hv[0] += q2[0]; hv[1] += q2[1];
                    *(f32x2*)op = hv;
                    *(h16x2*)((h16*)(a.ws + O_H2B) + (size_t)t * 1024 + col) = (h16x2){(h16)hv[0], (h16)hv[1]};
                    const float ss = wave_sum(hv[0] * hv[0] + hv[1] * hv[1]);
                    if (lane == 0) ((float*)(a.ws + O_SS2))[(size_t)t * 8 + j] = ss;
                }
            }
        }
    }
}
__device__ __forceinline__ void phase_coef(const Args& a) {
    const int tid = tid_();
    const float* PART = (const float*)(a.ws + O_PART); const unsigned short* IDX = (const unsigned short*)(a.ws + O_IDX);
    const float* GATE = (const float*)(a.ws + O_GATE); const float* RS1 = (const float*)(a.ws + O_RS1);
    const float* USC = (const float*)(a.ws + O_USC); const float* VSC = (const float*)(a.ws + O_VSC); float* COEF = (float*)(a.ws + O_COEF);
    for (int i = blockIdx.x * NTHREADS + tid; i < MTOK * 128; i += gridDim.x * NTHREADS) {
        float s = 0.f;
#pragma unroll
        for (int j = 0; j < 8; ++j) s += PART[(size_t)j * MTOK * 128 + i];
        const unsigned e = IDX[i];
        COEF[i] = GATE[i] * gelu_tanh(RS1[i >> 7] * USC[e] * s) * VSC[e];
    }
}

__device__ __forceinline__ void phase_final(const Args& a) {
    const int tid = tid_(), lane = tid & 63, wave = tid >> 6;
    const int gw = blockIdx.x * NWAVES + wave, NGW = gridDim.x * NWAVES;
    const float* part = (const float*)(a.ws + O_PART3); const float* fg = a.in[28];
    f32x4 g4[4];
#pragma unroll
    for (int j = 0; j < 4; ++j) g4[j] = *((const f32x4*)fg + lane + 64 * j);
    for (int r = gw; r < MTOK; r += NGW) {
        float s = (lane < 16) ? part[(size_t)r * 16 + lane] : 0.f;
        s = wave_sum(s);
        const float rs = rsqrtf(s * (1.f / 1024.f) + NORM_EPS);
        f32x4* xr = (f32x4*)(a.out + (size_t)r * 1024) + lane;
#pragma unroll
        for (int j = 0; j < 4; ++j) xr[64 * j] = xr[64 * j] * rs * g4[j];
    }
}

constexpr int NPHASE = 19;
__global__ void __launch_bounds__(NTHREADS, 2) mk(Args a) {
    extern __shared__ __attribute__((aligned(16))) unsigned char smem[];
    LAS unsigned char* lds = (LAS unsigned char*)smem;
    unsigned char* ws = a.ws;
#if ONE_LAUNCH
    cg::grid_group grid = cg::this_grid();
#define SYNC() grid.sync()
#else
#define SYNC() do {} while (0)
#endif
#define IN(k) (a.ph_lo <= (k) && (k) < a.ph_hi)
#define SEAM(k) do { if (IN(k) && IN((k) + 1)) SYNC(); } while (0)
    const int G = gridDim.x, bid = blockIdx.x;
    if (IN(0)) { phase_prep(a, lds); } SEAM(0);
    if (IN(1)) { pg8::Gemm g{(const h16*)(ws + O_XN), (const h16*)(ws + O_WIN), MTOK, NIN, 1024}; pg8::StaticOrder S; S.init(MTOK, NIN, G, bid);
        EpiZ E{(h16*)(ws + O_ZC), (h16*)(ws + O_ZR), (h16*)(ws + O_ZG)}; pg8::gemm_phase(lds, g, S, E); } SEAM(1);
    if (IN(2)) { phase_conv(a); phase_rwkv_prep(a); } SEAM(2);
    if (IN(3)) { pg8::Gemm g{(const h16*)(ws + O_APR), (const h16*)(ws + O_WLR), MTOK, 1536, 256}; pg8::StaticOrder S; S.init(MTOK, 1536, G, bid);
        h16* R = (h16*)a.out; h16* KS = R + (size_t)MTOK * 512; h16* KK = KS + (size_t)2 * MTOK * 512;
        EpiLR E{a.in[7], a.in[9], a.in[13], (h16*)(ws + O_WD), KS, (h16*)(ws + O_BD), (h16*)(ws + O_GG), KK}; pg8::gemm_phase(lds, g, S, E); } SEAM(3);
    if (IN(4)) { phase_scan<true>(a, lds); } SEAM(4);
    if (IN(5)) { phase_scan_combine(a, lds); } SEAM(5);
    if (IN(6)) { phase_scan<false>(a, lds); } SEAM(6);
    if (IN(7)) { phase_rwkv_post(a); } SEAM(7);
    if (IN(8)) { pg8::Gemm g{(const h16*)(ws + O_CA), (const h16*)(ws + O_WA), MTOK, 1024, 512}; pg8::StaticOrder S; S.init(MTOK, 1024, G, bid);
        EpiYA E{(const h16*)(ws + O_ZG), a.out}; pg8::gemm_phase(lds, g, S, E); } SEAM(8);
    if (IN(9)) { pg8::Gemm g{(const h16*)(ws + O_YB), (const h16*)(ws + O_WB), MTOK, 1024, 512}; pg8::StaticOrder S; S.init(MTOK, 1024, G, bid);
        EpiYB E{(const h16*)(ws + O_ZG), a.out, (h16*)(ws + O_MERGED)}; pg8::gemm_phase(lds, g, S, E); } SEAM(9);
    if (IN(10)) { pg8::Gemm g{(const h16*)(ws + O_MERGED), (const h16*)(ws + O_WO), MTOK, 1024, 1024}; pg8::StaticOrder S; S.init(MTOK, 1024, G, bid);
        EpiH1 E{a.in[0], a.out, (h16*)(ws + O_H1B), (float*)(ws + O_PART1)}; pg8::gemm_phase(lds, g, S, E); } SEAM(10);
    if (IN(11)) { pg8::Gemm g{(const h16*)(ws + O_H1B), (const h16*)(ws + O_WS), MTOK, 2048, 1024}; pg8::StaticOrder S; S.init(MTOK, 2048, G, bid);
        EpiF16 E{(h16*)(ws + O_SCORES), 2048}; pg8::gemm_phase(lds, g, S, E); } SEAM(11);
    if (IN(12)) { phase_topk(a, lds); } SEAM(12);
    if (IN(13)) { phase_gather<0>(a); } SEAM(13);
    if (IN(14)) { phase_coef(a); } SEAM(14);
    if (IN(15)) { phase_gather<1>(a); } SEAM(15);
    if (IN(16)) { pg8::Gemm g{(const h16*)(ws + O_P16), (const h16*)(ws + O_WP), MTOK, 1024, 256}; pg8::StaticOrder S; S.init(MTOK, 1024, G, bid);
        EpiF16 E{(h16*)(ws + O_PP), 1024}; pg8::gemm_phase(lds, g, S, E); } SEAM(16);
    if (IN(17)) { pg8::Gemm g{(const h16*)(ws + O_H2B), (const h16*)(ws + O_WG), MTOK, 1024, 1024}; pg8::StaticOrder S; S.init(MTOK, 1024, G, bid);
        EpiGate E{a.out, (const h16*)(ws + O_PP), (const float*)(ws + O_SS2), (float*)(ws + O_PART3)}; pg8::gemm_phase(lds, g, S, E); } SEAM(17);
    if (IN(18)) { phase_final(a); }
}

extern "C" void kernel_launch(void* const* d_in, const int* in_sizes, int n_in, void* d_out, int out_size, void* d_ws, size_t ws_size, hipStream_t stream) {
    static int ready = 0;
    if (!ready) {
        if (n_in != 29 || ws_size < WS_END) { fprintf(stderr, "kernel_launch: unexpected n_in %d / ws %zu (need %zu)\n", n_in, ws_size, (size_t)WS_END); ready = -1; return; }
        if (hipFuncSetAttribute((const void*)mk, hipFuncAttributeMaxDynamicSharedMemorySize, LDS_BYTES) != hipSuccess) { fprintf(stderr, "hipFuncSetAttribute failed\n"); ready = -1; return; }
        ready = 1;
    }
    if (ready < 0) return;
    Args a{};
    for (int i = 0; i < 29; ++i) a.in[i] = (const float*)d_in[i];
    a.out = (float*)d_out; a.ws = (unsigned char*)d_ws;
#if ONE_LAUNCH
    a.ph_lo = 0; a.ph_hi = NPHASE;
    void* args[] = {&a};
    hipLaunchCooperativeKernel((const void*)mk, dim3(NBLK), dim3(NTHREADS), args, LDS_BYTES, stream);
#else
    const int phases[] = {0, 1, 2, 3, 4, 5, 6, 7, 8, 9, 10, 11, 12, 13, 14, 15, 16, 17, 18};
    for (int ph : phases) { a.ph_lo = ph; a.ph_hi = ph + 1; hipLaunchKernelGGL(mk, dim3(NBLK), dim3(NTHREADS), LDS_BYTES, stream, a); }
#endif
}
```

```cpp
#include <hip/hip_runtime.h>
#include <hip/hip_cooperative_groups.h>
#include <cstdio>
namespace cg = cooperative_groups;

#ifndef REP_MASK
#define REP_MASK 0u
#endif
#ifndef ONE_LAUNCH
#define ONE_LAUNCH 1
#endif

#define LAS __attribute__((address_space(3)))
typedef _Float16 h16;
typedef _Float16 h16x8 __attribute__((ext_vector_type(8)));
typedef _Float16 h16x4 __attribute__((ext_vector_type(4)));
typedef _Float16 h16x2 __attribute__((ext_vector_type(2)));
typedef float f32x4 __attribute__((ext_vector_type(4)));
typedef float f32x2 __attribute__((ext_vector_type(2)));
typedef unsigned u32x4 __attribute__((ext_vector_type(4)));
typedef unsigned u32x2 __attribute__((ext_vector_type(2)));

constexpr int MTOK = 65536, DM = 1024, SEQ = 8192, NB = 8;
constexpr int NIN = 5376;
constexpr int NTHREADS = 512, NWAVES = 8, NBLK = 256;
constexpr int LDS_BYTES = 131072;
constexpr float NORM_EPS = 1e-6f;

constexpr size_t MiB = 1u << 20;
constexpr size_t O_WIN = 0;
constexpr size_t O_WA = O_WIN + (size_t)5376 * 1024 * 2;
constexpr size_t O_WB = O_WA + 1 * MiB;
constexpr size_t O_WO = O_WB + 1 * MiB;
constexpr size_t O_WG = O_WO + 2 * MiB;
constexpr size_t O_WP = O_WG + 2 * MiB;
constexpr size_t O_WLR = O_WP + MiB / 2;
constexpr size_t O_WS = O_WLR + 3 * MiB / 4;
constexpr size_t O_U16 = O_WS + 4 * MiB;
constexpr size_t O_V16 = O_U16 + 32 * MiB;
constexpr size_t O_P16 = O_V16 + 32 * MiB;
constexpr size_t O_PART1 = O_P16 + 32 * MiB;
constexpr size_t O_PART3 = O_PART1 + 4 * MiB;
constexpr size_t O_RS1 = O_PART3 + 4 * MiB;
constexpr size_t O_RS2 = O_RS1 + MiB / 4;
constexpr size_t O_XN = O_RS2 + MiB / 4;
constexpr size_t O_ZC = O_XN + 128 * MiB;
constexpr size_t O_ZR = O_ZC + 192 * MiB;
constexpr size_t O_ZG = O_ZR + 224 * MiB;
constexpr size_t O_SS2 = O_ZG + 256 * MiB;
constexpr size_t O_USC = O_SS2 + 2 * MiB;
constexpr size_t O_VSC = O_USC + 65536;
constexpr size_t O_CTR = O_VSC + 65536;
constexpr size_t WS_END = O_CTR + 8192;
constexpr size_t O_U8 = O_U16;
constexpr size_t O_V8 = O_U16 + 16 * MiB;
constexpr size_t O_PART = O_ZG;
constexpr size_t O_COEF = O_ZR + 48 * MiB;
constexpr size_t O_CA = O_XN;
constexpr size_t O_APR = O_XN + 64 * MiB;
constexpr size_t O_H1B = O_XN;
constexpr size_t O_WD = O_ZC;
constexpr size_t O_BD = O_ZC + 64 * MiB;
constexpr size_t O_GG = O_ZC + 128 * MiB;
constexpr size_t O_MERGED = O_ZC;
constexpr size_t O_H2B = O_ZC;
constexpr size_t O_PQ = O_ZR;
constexpr size_t O_SST = O_ZR + 64 * MiB;
constexpr size_t O_Y = O_ZR + 96 * MiB;
constexpr size_t O_YB = O_ZR + 160 * MiB;
constexpr size_t O_IDX = O_ZR;
constexpr size_t O_GATE = O_ZR + 16 * MiB;
constexpr size_t O_PP = O_ZR + 64 * MiB;
constexpr size_t O_SCORES = O_ZG;

struct Args {
    const float* in[29];
    float* out;
    unsigned char* ws;
    int ph_lo, ph_hi;
};

__device__ __forceinline__ int tid_() { int t = threadIdx.x; asm volatile("" : "+v"(t)); return t; }
__device__ __forceinline__ float sigmoidf_(float x) { return __builtin_amdgcn_rcpf(1.0f + __expf(-x)); }
__device__ __forceinline__ float wave_sum(float v) {
#pragma unroll
    for (int o = 1; o < 64; o <<= 1) v += __shfl_xor(v, o);
    return v;
}
__device__ __forceinline__ h16x8 pack8(f32x4 a, f32x4 b) {
    h16x8 r;
    r[0] = (h16)a[0]; r[1] = (h16)a[1]; r[2] = (h16)a[2]; r[3] = (h16)a[3];
    r[4] = (h16)b[0]; r[5] = (h16)b[1]; r[6] = (h16)b[2]; r[7] = (h16)b[3];
    return r;
}
__device__ __forceinline__ h16x4 pack4(f32x4 a) {
    h16x4 r; r[0] = (h16)a[0]; r[1] = (h16)a[1]; r[2] = (h16)a[2]; r[3] = (h16)a[3]; return r;
}

namespace pg8 {
constexpr int BM = 256, BK = 64, HALF = 128, HTB = HALF * BK * 2, STAGE_BYTES = 8 * HTB, NXCD = 8, WGM = 8;
__device__ __forceinline__ int lds_byte(int r, int c) { const int st = (r >> 4) * 2 + (c >> 5), rr = r & 15, cc = c & 31, ob = rr * 64 + cc * 2; return st * 1024 + (ob ^ (((ob >> 9) & 1) << 5)); }
__device__ __forceinline__ void stage_rc(int b, int& R, int& C) { const int st = b / 1024, sb = b % 1024, swz = sb ^ (((sb >> 9) & 1) << 5); R = (st >> 1) * 16 + swz / 64; C = (st & 1) * 32 + (swz % 64) / 2; }
__device__ __forceinline__ int perm32(int rho) { const int n = rho >> 4, i = rho & 15; return 8 * (i >> 2) + 4 * n + (i & 3); }

struct Unit { int pm, pn; };
struct Gemm { const h16* A; const h16* Bt; int M, N, K; };

struct StaticOrder {
    int nM, nN, nwg, G, c;
    __device__ void init(int M, int N, int G_, int c_) { nM = M / BM; nN = N / BM; nwg = nM * nN; G = G_; c = c_; }
    __device__ bool next(int i, Unit& u) const {
        const long L = (long)i * G + c; if (L >= nwg) return false;
        int wgid = (int)L; { const int q = nwg / NXCD, r = nwg % NXCD, xcd = wgid % NXCD, off = wgid / NXCD; wgid = (xcd < r ? xcd * (q + 1) : r * (q + 1) + (xcd - r) * q) + off; }
        const int nig = WGM * nN, gid = wgid / nig, fm = gid * WGM, gsz = (nM - fm) < WGM ? (nM - fm) : WGM;
        u.pm = fm + ((wgid % nig) % gsz); u.pn = (wgid % nig) / gsz; return true;
    }
};

template <class Epi>
__device__ __forceinline__ void gemm_phase(LAS unsigned char* lds, const Gemm g, const StaticOrder& S, const Epi& E) {
    const int tid = tid_(), wid = __builtin_amdgcn_readfirstlane(tid >> 6), lane = tid & 63, wr = wid >> 2, wc = wid & 3, fr = lane & 15, fq = lane >> 4;
    const int K = g.K, nt = K / BK;
    unsigned voffA[2], voffB[2];
#pragma unroll
    for (int i = 0; i < 2; ++i) { int R, C; stage_rc(tid * 16 + i * 8192, R, C); const int Rb = (R & ~31) + perm32(R & 31);
        voffA[i] = (unsigned)(R * K + C) * 2u; voffB[i] = (unsigned)(Rb * K + C) * 2u; }
    const size_t kstep = (size_t)(BK * 2);
    const size_t hstep = (size_t)HALF * K * 2;
    const size_t tstep = 2 * hstep;
    const unsigned ldsw = (unsigned)wid * 1024u;
    const int aoff = lds_byte(wr * 64 + fr, fq * 8), boff = lds_byte(wc * 32 + fr, fq * 8);
#define PG8_SA(b, h) (((b) * 2 + (h)) * HTB)
#define PG8_SB(b, h) ((4 + (b) * 2 + (h)) * HTB)
#define PG8_STAGE(bufoff, gbase, voff) do { _Pragma("unroll") for (int _i = 0; _i < 2; ++_i) \
        __builtin_amdgcn_global_load_lds((const unsigned*)((const char*)(gbase) + (voff)[_i]), (LAS unsigned*)(lds + (bufoff) + ldsw + _i * 8192), 16, 0, 0); } while (0)
#define PG8_LDA(dst, b, h) do { _Pragma("unroll") for (int m = 0; m < 4; ++m) _Pragma("unroll") for (int k = 0; k < 2; ++k) dst[m][k] = *(const LAS h16x8*)(lds + PG8_SA(b, h) + aoff + m * 2048 + k * 1024); } while (0)
#define PG8_LDB(dst, b, h) do { _Pragma("unroll") for (int n = 0; n < 2; ++n) _Pragma("unroll") for (int k = 0; k < 2; ++k) dst[n][k] = *(const LAS h16x8*)(lds + PG8_SB(b, h) + boff + n * 2048 + k * 1024); } while (0)
#define PG8_MMA(ai, bj, At, Bt) do { __builtin_amdgcn_s_setprio(1); _Pragma("unroll") for (int m = 0; m < 4; ++m) _Pragma("unroll") for (int n = 0; n < 2; ++n) _Pragma("unroll") for (int k = 0; k < 2; ++k) \
        acc[ai][bj][m][n] = __builtin_amdgcn_mfma_f32_16x16x32_f16(Bt[n][k], At[m][k], acc[ai][bj][m][n], 0, 0, 0); __builtin_amdgcn_s_setprio(0); } while (0)
#define PG8_WAIT_V(n) asm volatile("s_waitcnt vmcnt(" #n ")" ::: "memory")
#define PG8_WAIT_L(n) asm volatile("s_waitcnt lgkmcnt(" #n ")" ::: "memory")
#define PG8_BAR __builtin_amdgcn_s_barrier()
#define PG8_SCHED __builtin_amdgcn_sched_barrier(0)
    Unit cur, nxt; int ui = 0;
    if (!S.next(0, cur)) return;
    f32x4 acc[2][2][4][2];
#pragma unroll
    for (int a = 0; a < 2; ++a)
#pragma unroll
        for (int b = 0; b < 2; ++b)
#pragma unroll
            for (int m = 0; m < 4; ++m)
#pragma unroll
                for (int n = 0; n < 2; ++n) acc[a][b][m][n] = (f32x4){0.f, 0.f, 0.f, 0.f};
    h16x8 At[4][2], B0[2][2], B1[2][2];
    const char* cA = (const char*)g.A + (size_t)cur.pm * tstep; const char* cB = (const char*)g.Bt + (size_t)cur.pn * tstep;
    PG8_STAGE(PG8_SB(0, 0), cB, voffB); PG8_STAGE(PG8_SA(0, 0), cA, voffA); PG8_STAGE(PG8_SB(0, 1), cB + hstep, voffB); PG8_STAGE(PG8_SA(0, 1), cA + hstep, voffA);
    if (wr == 1) PG8_BAR;
    PG8_WAIT_V(4); PG8_BAR;
    PG8_STAGE(PG8_SB(1, 0), cB + kstep, voffB); PG8_STAGE(PG8_SA(1, 0), cA + kstep, voffA); PG8_STAGE(PG8_SB(1, 1), cB + hstep + kstep, voffB);
    PG8_WAIT_V(6); PG8_BAR;
    for (;;) {
        const bool has_next = S.next(ui + 1, nxt);
        const char* nA = has_next ? (const char*)g.A + (size_t)nxt.pm * tstep : cA; const char* nB = has_next ? (const char*)g.Bt + (size_t)nxt.pn * tstep : cB;
        for (int t = 0; t < nt; t += 2) {
            const bool last = (t == nt - 2);
            const char* a1 = cA + (size_t)(t + 1) * kstep;
            const char* a2 = last ? nA : cA + (size_t)(t + 2) * kstep; const char* b2 = last ? nB : cB + (size_t)(t + 2) * kstep;
            const char* a3 = a2 + kstep; const char* b3 = b2 + kstep;
            PG8_LDB(B0, 0, 0); PG8_SCHED; PG8_LDA(At, 0, 0); PG8_STAGE(PG8_SA(1, 1), a1 + hstep, voffA);
            PG8_WAIT_L(8); PG8_BAR; PG8_WAIT_L(0); PG8_MMA(0, 0, At, B0); PG8_BAR; PG8_SCHED;
            PG8_LDB(B1, 0, 1); PG8_STAGE(PG8_SB(0, 0), b2, voffB);
            PG8_BAR; PG8_WAIT_L(0); PG8_MMA(0, 1, At, B1); PG8_BAR;
            PG8_LDA(At, 0, 1); PG8_STAGE(PG8_SA(0, 0), a2, voffA);
            PG8_BAR; PG8_WAIT_L(0); PG8_MMA(1, 0, At, B0); PG8_BAR; PG8_SCHED;
            PG8_STAGE(PG8_SB(0, 1), b2 + hstep, voffB);
            PG8_WAIT_V(6); PG8_BAR; PG8_MMA(1, 1, At, B1); PG8_BAR;
            PG8_LDB(B0, 1, 0); PG8_SCHED; PG8_LDA(At, 1, 0); PG8_STAGE(PG8_SA(0, 1), a2 + hstep, voffA);
            PG8_WAIT_L(8); PG8_BAR; PG8_WAIT_L(0); PG8_MMA(0, 0, At, B0); PG8_BAR; PG8_SCHED;
            PG8_LDB(B1, 1, 1); PG8_STAGE(PG8_SB(1, 0), b3, voffB);
            PG8_BAR; PG8_WAIT_L(0); PG8_MMA(0, 1, At, B1); PG8_BAR;
            PG8_LDA(At, 1, 1); PG8_STAGE(PG8_SA(1, 0), a3, voffA);
            PG8_BAR; PG8_WAIT_L(0); PG8_MMA(1, 0, At, B0); PG8_BAR; PG8_SCHED;
            PG8_STAGE(PG8_SB(1, 1), b3 + hstep, voffB);
            PG8_WAIT_V(6); PG8_BAR; PG8_MMA(1, 1, At, B1); PG8_BAR;
        }
        E(acc, cur, wr, wc, fr, fq);
        if (!has_next) break;
#pragma unroll
        for (int a = 0; a < 2; ++a)
#pragma unroll
            for (int b = 0; b < 2; ++b)
#pragma unroll
                for (int m = 0; m < 4; ++m)
#pragma unroll
                    for (int n = 0; n < 2; ++n) acc[a][b][m][n] = (f32x4){0.f, 0.f, 0.f, 0.f};
        cur = nxt; cA = nA; cB = nB; ++ui;
    }
    PG8_WAIT_V(0);
    if (wr == 0) PG8_BAR;
    PG8_BAR;
#undef PG8_SA
#undef PG8_SB
#undef PG8_STAGE
#undef PG8_LDA
#undef PG8_LDB
#undef PG8_MMA
#undef PG8_WAIT_V
#undef PG8_WAIT_L
#undef PG8_BAR
#undef PG8_SCHED
}
}
using pg8::Unit;
typedef const f32x4 (&AccRef)[2][2][4][2];

#define EPI_LOOP_BEGIN \
    _Pragma("unroll") for (int ai = 0; ai < 2; ++ai) _Pragma("unroll") for (int m = 0; m < 4; ++m) { \
        const int row = u.pm * 256 + ai * 128 + wr * 64 + m * 16 + fr; \
        _Pragma("unroll") for (int bj = 0; bj < 2; ++bj) { \
            const int col = u.pn * 256 + bj * 128 + wc * 32 + 8 * fq; \
            const f32x4 v0 = acc[ai][bj][m][0], v1 = acc[ai][bj][m][1];
#define EPI_LOOP_END } }

struct EpiZ {
    h16 *zc, *zr, *zg;
    __device__ __forceinline__ void operator()(AccRef acc, const Unit& u, int wr, int wc, int fr, int fq) const {
        const int colt = u.pn * 256; h16* base; int ld, c0;
        if (colt < 1536) { base = zc; ld = 1536; c0 = colt; } else if (colt < 3328) { base = zr; ld = 1792; c0 = colt - 1536; } else { base = zg; ld = 2048; c0 = colt - 3328; }
        EPI_LOOP_BEGIN
            *(h16x8*)(base + (size_t)row * ld + (col - colt + c0)) = pack8(v0, v1);
        EPI_LOOP_END
    }
};
struct EpiF16 {
    h16* O; int ld;
    __device__ __forceinline__ void operator()(AccRef acc, const Unit& u, int wr, int wc, int fr, int fq) const {
        EPI_LOOP_BEGIN
            *(h16x8*)(O + (size_t)row * ld + col) = pack8(v0, v1);
        EPI_LOOP_END
    }
};
struct EpiYA {
    const h16* zg; float* tmp;
    __device__ __forceinline__ void operator()(AccRef acc, const Unit& u, int wr, int wc, int fr, int fq) const {
        EPI_LOOP_BEGIN
            const h16x8 gv = *(const h16x8*)(zg + (size_t)row * 2048 + col);
            f32x4 o0, o1;
#pragma unroll
            for (int j = 0; j < 4; ++j) { o0[j] = sigmoidf_((float)gv[j]) * v0[j]; o1[j] = sigmoidf_((float)gv[4 + j]) * v1[j]; }
            float* p = tmp + (size_t)row * 1024 + col;
            *(f32x4*)p = o0; *(f32x4*)(p + 4) = o1;
        EPI_LOOP_END
    }
};
struct EpiYB {
    const h16* zg; const float* tmp; h16* merged;
    __device__ __forceinline__ void operator()(AccRef acc, const Unit& u, int wr, int wc, int fr, int fq) const {
        EPI_LOOP_BEGIN
            const h16x8 gv = *(const h16x8*)(zg + (size_t)row * 2048 + 1024 + col);
            const float* p = tmp + (size_t)row * 1024 + col;
            f32x4 o0 = *(const f32x4*)p, o1 = *(const f32x4*)(p + 4);
#pragma unroll
            for (int j = 0; j < 4; ++j) { o0[j] += sigmoidf_((float)gv[j]) * v0[j]; o1[j] += sigmoidf_((float)gv[4 + j]) * v1[j]; }
            *(h16x8*)(merged + (size_t)row * 1024 + col) = pack8(o0, o1);
        EPI_LOOP_END
    }
};
struct EpiH1 {
    const float* x; float* out; h16* hb; float* part;
    __device__ __forceinline__ void operator()(AccRef acc, const Unit& u, int wr, int wc, int fr, int fq) const {
#pragma unroll
        for (int ai = 0; ai < 2; ++ai)
#pragma unroll
            for (int m = 0; m < 4; ++m) {
                const int row = u.pm * 256 + ai * 128 + wr * 64 + m * 16 + fr; float ss = 0.f;
#pragma unroll
                for (int bj = 0; bj < 2; ++bj) {
                    const int col = u.pn * 256 + bj * 128 + wc * 32 + 8 * fq;
                    const float* xp = x + (size_t)row * 1024 + col;
                    f32x4 o0 = *(const f32x4*)xp + acc[ai][bj][m][0], o1 = *(const f32x4*)(xp + 4) + acc[ai][bj][m][1];
                    float* op = out + (size_t)row * 1024 + col;
                    *(f32x4*)op = o0; *(f32x4*)(op + 4) = o1;
                    *(h16x8*)(hb + (size_t)row * 1024 + col) = pack8(o0, o1);
                    ss += (o0[0] * o0[0] + o0[1] * o0[1]) + (o0[2] * o0[2] + o0[3] * o0[3]) + (o1[0] * o1[0] + o1[1] * o1[1]) + (o1[2] * o1[2] + o1[3] * o1[3]);
                }
                ss += __shfl_xor(ss, 16); ss += __shfl_xor(ss, 32);
                if (fq == 0) part[(size_t)row * 16 + u.pn * 4 + wc] = ss;
            }
    }
};
struct EpiGate {
    float* out; const h16* pp; const float* rs2; float* part;
    __device__ __forceinline__ void operator()(AccRef acc, const Unit& u, int wr, int wc, int fr, int fq) const {
#pragma unroll
        for (int ai = 0; ai < 2; ++ai)
#pragma unroll
            for (int m = 0; m < 4; ++m) {
                const int row = u.pm * 256 + ai * 128 + wr * 64 + m * 16 + fr; float ss = 0.f;
                const f32x4 sa = *(const f32x4*)(rs2 + (size_t)row * 8), sb = *(const f32x4*)(rs2 + (size_t)row * 8 + 4);
                const float rs = rsqrtf(((sa[0] + sa[1]) + (sa[2] + sa[3]) + (sb[0] + sb[1]) + (sb[2] + sb[3])) * (1.f / 1024.f) + NORM_EPS);
#pragma unroll
                for (int bj = 0; bj < 2; ++bj) {
                    const int col = u.pn * 256 + bj * 128 + wc * 32 + 8 * fq;
                    float* op = out + (size_t)row * 1024 + col;
                    f32x4 o0 = *(const f32x4*)op, o1 = *(const f32x4*)(op + 4);
                    const h16x8 pv = *(const h16x8*)(pp + (size_t)row * 1024 + col);
                    const f32x4 v0 = acc[ai][bj][m][0], v1 = acc[ai][bj][m][1];
#pragma unroll
                    for (int j = 0; j < 4; ++j) { o0[j] += sigmoidf_(rs * v0[j]) * (float)pv[j]; o1[j] += sigmoidf_(rs * v1[j]) * (float)pv[4 + j]; }
                    *(f32x4*)op = o0; *(f32x4*)(op + 4) = o1;
                    ss += (o0[0] * o0[0] + o0[1] * o0[1]) + (o0[2] * o0[2] + o0[3] * o0[3]) + (o1[0] * o1[0] + o1[1] * o1[1]) + (o1[2] * o1[2] + o1[3] * o1[3]);
                }
                ss += __shfl_xor(ss, 16); ss += __shfl_xor(ss, 32);
                if (fq == 0) part[(size_t)row * 16 + u.pn * 4 + wc] = ss;
            }
    }
};

__device__ __forceinline__ void tr_item(const float* W, int N, const float* g, h16* WT, int ldk, int koff, int k0, int n0, LAS float* scr, int lane) {
#pragma unroll 8
    for (int i = 0; i < 32; ++i) { const int kk = 2 * i + (lane >> 5); float v = W[(size_t)(k0 + kk) * N + n0 + (lane & 31)]; if (g) v *= g[k0 + kk]; scr[kk * 33 + (lane & 31)] = v; }
    asm volatile("s_waitcnt lgkmcnt(0)" ::: "memory");
    const int c = lane & 7;
#pragma unroll
    for (int j = 0; j < 4; ++j) { const int n = (lane >> 3) + 8 * j; const LAS float* s = scr + (8 * c) * 33 + n;
        h16x8 o;
#pragma unroll
        for (int e = 0; e < 8; ++e) o[e] = (h16)s[e * 33];
        *(h16x8*)(WT + (size_t)(n0 + n) * ldk + koff + k0 + 8 * c) = o; }
    asm volatile("s_waitcnt lgkmcnt(0)" ::: "memory");
}
struct TrJob { const float* W; const float* g; h16* WT; int K, N, ldk, koff; };

__device__ __forceinline__ void phase_prep(const Args& a, LAS unsigned char* lds) {
    const int tid = tid_(), lane = tid & 63, wave = tid >> 6;
    const int gw = blockIdx.x * NWAVES + wave, NGW = gridDim.x * NWAVES;
    unsigned char* ws = a.ws;
    {
        LAS float* scr = (LAS float*)(lds + wave * 8704);
        TrJob jobs[9] = {
            {a.in[3], a.in[2], (h16*)(ws + O_WIN), 1024, NIN, 1024, 0},
            {a.in[17], nullptr, (h16*)(ws + O_WA), 512, 1024, 512, 0},
            {a.in[18], nullptr, (h16*)(ws + O_WB), 512, 1024, 512, 0},
            {a.in[19], nullptr, (h16*)(ws + O_WO), 1024, 1024, 1024, 0},
            {a.in[26], a.in[25], (h16*)(ws + O_WG), 1024, 1024, 1024, 0},
            {a.in[27], nullptr, (h16*)(ws + O_WP), 256, 1024, 256, 0},
            {a.in[8], nullptr, (h16*)(ws + O_WLR), 64, 512, 256, 0},
            {a.in[10], nullptr, (h16*)(ws + O_WLR) + (size_t)512 * 256, 64, 512, 256, 64},
            {a.in[11], nullptr, (h16*)(ws + O_WLR) + (size_t)1024 * 256, 128, 512, 256, 128},
        };
        int base = 0;
#pragma unroll
        for (int j = 0; j < 9; ++j) {
            const TrJob J = jobs[j]; const int nnb = J.N / 32, items = (J.K / 64) * nnb;
            int first = gw - (base % NGW); if (first < 0) first += NGW;
            for (int r = first; r < items; r += NGW) tr_item(J.W, J.N, J.g, J.WT, J.ldk, J.koff, (r / nnb) * 64, (r % nnb) * 32, scr, lane);
            base += items;
        }
        h16* wlr = (h16*)(ws + O_WLR);
        for (int i = blockIdx.x * NTHREADS + tid; i < 1536 * 256 / 8; i += gridDim.x * NTHREADS) {
            const int n = (i * 8) / 256, k = (i * 8) % 256; const int blk = n / 512;
            const bool inblk = (blk == 0) ? (k < 64) : (blk == 1) ? (k >= 64 && k < 128) : (k >= 128);
            if (!inblk) { h16x8 z; for (int e = 0; e < 8; ++e) z[e] = (h16)0.f; *(h16x8*)(wlr + (size_t)i * 8) = z; }
        }
    }
    __syncthreads();
    {
        LAS float* LA = (LAS float*)lds;
        LAS float* LB = (LAS float*)(lds + 64 * 129 * 4);
        const float* wq = a.in[21]; const float* sk = a.in[22]; const float* gf = a.in[20];
        h16* wst = (h16*)(ws + O_WS);
        for (int it = blockIdx.x; it < 256; it += gridDim.x) {
            const int g16 = it >> 4, k0 = (it & 15) * 64;
            for (int i = tid; i < 64 * 128; i += NTHREADS) { const int k = i >> 7, d = i & 127; LA[k * 129 + d] = wq[(size_t)(k0 + k) * 2048 + g16 * 128 + d] * gf[k0 + k]; }
            for (int i = tid; i < 128 * 128; i += NTHREADS) { const int n = i >> 7, d = i & 127; LB[n * 129 + d] = sk[((size_t)g16 * 128 + n) * 128 + d]; }
            __syncthreads();
            const int n = tid & 127, kg = tid >> 7;
            float o[16];
#pragma unroll
            for (int j = 0; j < 16; ++j) o[j] = 0.f;
            for (int d = 0; d < 128; ++d) { const float b = LB[n * 129 + d];
#pragma unroll
                for (int j = 0; j < 16; ++j) o[j] += LA[(kg * 16 + j) * 129 + d] * b; }
            h16x8 o0, o1;
#pragma unroll
            for (int j = 0; j < 8; ++j) { o0[j] = (h16)o[j]; o1[j] = (h16)o[8 + j]; }
            h16* dst = wst + (size_t)(g16 * 128 + n) * 1024 + k0 + kg * 16;
            *(h16x8*)dst = o0; *(h16x8*)(dst + 8) = o1;
            __syncthreads();
        }
    }
    {
        const float* gf = a.in[20];
        f32x4 g4[4];
#pragma unroll
        for (int j = 0; j < 4; ++j) g4[j] = *(const f32x4*)(gf + 16 * lane + 4 * j);
        for (int r = gw; r < 2 * 16384; r += NGW) {
            const int tb = r >> 14, e = r & 16383;
            const float* src = (tb ? a.in[24] : a.in[23]) + (size_t)e * 1024 + 16 * lane;
            f32x4 v[4]; float mx = 0.f;
#pragma unroll
            for (int j = 0; j < 4; ++j) { v[j] = *(const f32x4*)(src + 4 * j); if (!tb) v[j] = v[j] * g4[j];
#pragma unroll
                for (int c = 0; c < 4; ++c) mx = fmaxf(mx, fabsf(v[j][c])); }
#pragma unroll
            for (int o = 1; o < 64; o <<= 1) mx = fmaxf(mx, __shfl_xor(mx, o));
            mx = fmaxf(mx, 1e-30f);
            const float sc = 224.0f / mx;
            u32x4 q;
#pragma unroll
            for (int j = 0; j < 4; ++j) { int w = 0; w = __builtin_amdgcn_cvt_pk_fp8_f32(v[j][0] * sc, v[j][1] * sc, w, false); w = __builtin_amdgcn_cvt_pk_fp8_f32(v[j][2] * sc, v[j][3] * sc, w, true); q[j] = (unsigned)w; }
            unsigned char* dst = ws + (tb ? O_V8 : O_U8) + ((size_t)(lane >> 3) * 16384 + e) * 128 + 16 * (lane & 7);
            *(u32x4*)dst = q;
            if (lane == 0) ((float*)(ws + (tb ? O_VSC : O_USC)))[e] = mx * (1.0f / 224.0f);
        }
        if (blockIdx.x == 0 && tid < 32) ((unsigned*)(ws + O_CTR))[tid * 64] = 0u;
        const f32x4* pp = (const f32x4*)a.in[1]; h16x4* dp = (h16x4*)(ws + O_P16);
        const int np4 = MTOK * 256 / 4;
        for (int i = blockIdx.x * NTHREADS + tid; i < np4; i += gridDim.x * NTHREADS) dp[i] = pack4(pp[i]);
    }
    {
        const float* x = a.in[0]; h16* xn = (h16*)(ws + O_XN);
        for (int r = gw; r < MTOK; r += NGW) {
            const f32x4* xr = (const f32x4*)(x + (size_t)r * 1024) + lane;
            f32x4 v[4]; float s = 0.f;
#pragma unroll
            for (int j = 0; j < 4; ++j) { v[j] = xr[64 * j]; s += (v[j][0] * v[j][0] + v[j][1] * v[j][1]) + (v[j][2] * v[j][2] + v[j][3] * v[j][3]); }
            const float rs = rsqrtf(wave_sum(s) * (1.f / 1024.f) + NORM_EPS);
            h16x4* o = (h16x4*)(xn + (size_t)r * 1024) + lane;
#pragma unroll
            for (int j = 0; j < 4; ++j) o[64 * j] = pack4(v[j] * rs);
        }
    }
}

__device__ __forceinline__ void phase_conv(const Args& a) {
    const int tid = tid_(), lane = tid & 63, wave = tid >> 6;
    const int gw = blockIdx.x * NWAVES + wave, NGW = gridDim.x * NWAVES;
    const h16* zc = (const h16*)(a.ws + O_ZC); h16* ca = (h16*)(a.ws + O_CA);
    const float* cw = a.in[4]; const float* cb = a.in[5];
    float w0[8], w1[8], w2[8], bb[8];
#pragma unroll
    for (int j = 0; j < 8; ++j) { const int c = lane * 8 + j; w0[j] = cw[c]; w1[j] = cw[512 + c]; w2[j] = cw[1024 + c]; bb[j] = cb[c]; }
    for (int run = gw; run < MTOK / 32; run += NGW) {
        const int t0 = run * 32;
        float u1[8], u2[8];
        if ((t0 % SEQ) == 0) {
#pragma unroll
            for (int j = 0; j < 8; ++j) { u1[j] = 0.f; u2[j] = 0.f; }
        } else {
            const h16x8 c1 = *(const h16x8*)(zc + (size_t)(t0 - 1) * 1536 + 512 + lane * 8), x1 = *(const h16x8*)(zc + (size_t)(t0 - 1) * 1536 + 1024 + lane * 8);
            const h16x8 c2 = *(const h16x8*)(zc + (size_t)(t0 - 2) * 1536 + 512 + lane * 8), x2 = *(const h16x8*)(zc + (size_t)(t0 - 2) * 1536 + 1024 + lane * 8);
#pragma unroll
            for (int j = 0; j < 8; ++j) { u1[j] = (float)c1[j] * (float)x1[j]; u2[j] = (float)c2[j] * (float)x2[j]; }
        }
        for (int t = t0; t < t0 + 32; ++t) {
            const h16* zrow = zc + (size_t)t * 1536 + lane * 8;
            const h16x8 gb = *(const h16x8*)zrow, gc = *(const h16x8*)(zrow + 512), xi = *(const h16x8*)(zrow + 1024);
            h16x8 o;
#pragma unroll
            for (int j = 0; j < 8; ++j) { const float u0 = (float)gc[j] * (float)xi[j];
                const float y = w0[j] * u2[j] + w1[j] * u1[j] + w2[j] * u0 + bb[j];
                o[j] = (h16)((float)gb[j] * y); u2[j] = u1[j]; u1[j] = u0; }
            *(h16x8*)(ca + (size_t)t * 512 + lane * 8) = o;
        }
    }
}


__device__ __forceinline__ float tanhf_(float x) { return 1.0f - 2.0f * __builtin_amdgcn_rcpf(1.0f + __expf(2.0f * x)); }
__device__ __forceinline__ void phase_rwkv_prep(const Args& a) {
    const int tid = tid_(), lane = tid & 63, wave = tid >> 6;
    const int gw = blockIdx.x * NWAVES + wave, NGW = gridDim.x * NWAVES;
    const h16* zr = (const h16*)(a.ws + O_ZR);
    h16* R = (h16*)a.out; h16* KS = R + (size_t)MTOK * 512; h16* V = KS + (size_t)MTOK * 512; h16* KK = V + (size_t)MTOK * 512;
    h16* APR = (h16*)(a.ws + O_APR);
    const float* mu = a.in[6]; const float* k_k = a.in[12];
    float mr[8], mk[8], mv[8], mt[8], kk8[8];
#pragma unroll
    for (int j = 0; j < 8; ++j) { const int c = lane * 8 + j; mr[j] = mu[c]; mk[j] = mu[512 + c]; mv[j] = mu[1024 + c]; mt[j] = mu[1536 + (c & 255)]; kk8[j] = k_k[c]; }
    for (int run = gw; run < MTOK / 32; run += NGW) {
        const int t0 = run * 32;
        float pr[8], pk[8], pv[8], pt[8];
        if ((t0 % SEQ) == 0) {
#pragma unroll
            for (int j = 0; j < 8; ++j) { pr[j] = 0.f; pk[j] = 0.f; pv[j] = 0.f; pt[j] = 0.f; }
        } else {
            const h16* zp = zr + (size_t)(t0 - 1) * 1792 + lane * 8;
            const h16x8 a0 = *(const h16x8*)zp, a1 = *(const h16x8*)(zp + 512), a2 = *(const h16x8*)(zp + 1024), a3 = *(const h16x8*)(zr + (size_t)(t0 - 1) * 1792 + 1536 + (lane & 31) * 8);
#pragma unroll
            for (int j = 0; j < 8; ++j) { pr[j] = (float)a0[j]; pk[j] = (float)a1[j]; pv[j] = (float)a2[j]; pt[j] = (float)a3[j]; }
        }
        for (int t = t0; t < t0 + 32; ++t) {
            const h16* zp = zr + (size_t)t * 1792 + lane * 8;
            const h16x8 a0 = *(const h16x8*)zp, a1 = *(const h16x8*)(zp + 512), a2 = *(const h16x8*)(zp + 1024), a3 = *(const h16x8*)(zr + (size_t)t * 1792 + 1536 + (lane & 31) * 8);
            h16x8 orr, ok, ov, okk, ot; float kr[8]; float ss = 0.f;
#pragma unroll
            for (int j = 0; j < 8; ++j) {
                const float zr_ = (float)a0[j], zk_ = (float)a1[j], zv_ = (float)a2[j], zt_ = (float)a3[j];
                const float r = zr_ + mr[j] * (pr[j] - zr_), k = zk_ + mk[j] * (pk[j] - zk_), v = zv_ + mv[j] * (pv[j] - zv_), tl = zt_ + mt[j] * (pt[j] - zt_);
                pr[j] = zr_; pk[j] = zk_; pv[j] = zv_; pt[j] = zt_;
                orr[j] = (h16)r; ok[j] = (h16)k; ov[j] = (h16)v;
                kr[j] = k * kk8[j]; ss += kr[j] * kr[j];
                const float tv = (lane < 8) ? tanhf_(tl) : (lane < 16) ? tl : sigmoidf_(tl);
                ot[j] = (h16)tv;
            }
            ss += __shfl_xor(ss, 1); ss += __shfl_xor(ss, 2); ss += __shfl_xor(ss, 4);
            const float rn = rsqrtf(ss + 1e-12f);
#pragma unroll
            for (int j = 0; j < 8; ++j) okk[j] = (h16)(kr[j] * rn);
            const size_t o = (size_t)t * 512 + lane * 8;
            *(h16x8*)(R + o) = orr; *(h16x8*)(KS + o) = ok; *(h16x8*)(V + o) = ov; *(h16x8*)(KK + o) = okk;
            if (lane < 32) *(h16x8*)(APR + (size_t)t * 256 + lane * 8) = ot;
        }
    }
}

struct EpiLR {
    const float *w0, *a0, *k_a; h16 *WD, *KS, *BD, *GG; const h16* KK;
    __device__ __forceinline__ void operator()(AccRef acc, const Unit& u, int wr, int wc, int fr, int fq) const {
        const int part = u.pn >> 1;
        EPI_LOOP_BEGIN
            const int c = col - part * 512; const size_t o = (size_t)row * 512 + c;
            if (part == 0) {
                const f32x4 b0 = *(const f32x4*)(w0 + c), b1 = *(const f32x4*)(w0 + c + 4); f32x4 o0, o1;
#pragma unroll
                for (int j = 0; j < 4; ++j) { o0[j] = __expf(-0.6065306597126334f * sigmoidf_(b0[j] + v0[j])); o1[j] = __expf(-0.6065306597126334f * sigmoidf_(b1[j] + v1[j])); }
                *(h16x8*)(WD + o) = pack8(o0, o1);
            } else if (part == 1) {
                const f32x4 b0 = *(const f32x4*)(a0 + c), b1 = *(const f32x4*)(a0 + c + 4), ka0 = *(const f32x4*)(k_a + c), ka1 = *(const f32x4*)(k_a + c + 4);
                const h16x8 ks = *(const h16x8*)(KS + o), kk = *(const h16x8*)(KK + o); f32x4 k0, k1, bb0, bb1;
#pragma unroll
                for (int j = 0; j < 4; ++j) { const float aa0 = sigmoidf_(b0[j] + v0[j]), aa1 = sigmoidf_(b1[j] + v1[j]);
                    k0[j] = (float)ks[j] * (1.0f + (aa0 - 1.0f) * ka0[j]); k1[j] = (float)ks[4 + j] * (1.0f + (aa1 - 1.0f) * ka1[j]);
                    bb0[j] = aa0 * (float)kk[j]; bb1[j] = aa1 * (float)kk[4 + j]; }
                *(h16x8*)(KS + o) = pack8(k0, k1); *(h16x8*)(BD + o) = pack8(bb0, bb1);
            } else {
                *(h16x8*)(GG + o) = pack8(v0, v1);
            }
        EPI_LOOP_END
    }
};

constexpr int SC_L = 256, SC_NCH = SEQ / SC_L, SC_NB = 8;
constexpr int SC_STEP_F = 6 * 64;
constexpr int SC_WAVE_BYTES = SC_NB * SC_STEP_F * 4 + SC_NB * 64 * 4;
template <int CTRL> __device__ __forceinline__ float dpp_(float v) { return __builtin_bit_cast(float, __builtin_amdgcn_update_dpp(0, __builtin_bit_cast(int, v), CTRL, 0xF, 0xF, true)); }
__device__ __forceinline__ float quad_sum(float v) { v += dpp_<0xB1>(v); v += dpp_<0x4E>(v); return v; }
__device__ __forceinline__ void lds_ld8x2(const LAS float* p, f32x2 (&o)[8]) {
#pragma unroll
    for (int j4 = 0; j4 < 4; ++j4) { const f32x4 t = *(const LAS f32x4*)(p + 4 * j4); o[2 * j4] = (f32x2){t[0], t[1]}; o[2 * j4 + 1] = (f32x2){t[2], t[3]}; }
}
template <int MODE>
__device__ __forceinline__ void scan_wave(const Args& a, LAS unsigned char* lds, int task) {
    const int tid = tid_(), lane = tid & 63, wave = tid >> 6;
    const int q = lane & 3, rg = lane >> 2;
    const int chain = task / SC_NCH, chunk = task % SC_NCH, b = chain >> 3, h = chain & 7;
    const size_t row0 = (size_t)b * SEQ + (size_t)chunk * SC_L;
    const h16* R = (const h16*)a.out; const h16* KS = R + (size_t)MTOK * 512; const h16* V = KS + (size_t)MTOK * 512; const h16* KK = V + (size_t)MTOK * 512;
    const h16* WD = (const h16*)(a.ws + O_WD); const h16* BD = (const h16*)(a.ws + O_BD);
    LAS float* buf = (LAS float*)(lds + wave * SC_WAVE_BYTES);
    LAS float* ybuf = buf + SC_NB * SC_STEP_F;
    constexpr int NA = (MODE == 0) ? 5 : (MODE == 1) ? 3 : 6;
    const h16* gp[NA]; int lo[NA];
#pragma unroll
    for (int j = 0; j < NA; ++j) { const int p = lane + 64 * j, seg = p >> 3, part = p & 7, st = seg / NA, ai = seg % NA;
        const int ar = (MODE == 0 && ai == 4) ? 5 : ai;
        const h16* base = (ar == 0) ? KK : (ar == 1) ? WD : (ar == 2) ? BD : (ar == 3) ? KS : (ar == 4) ? R : V;
        gp[j] = base + (row0 + st) * 512 + h * 64 + part * 8; lo[j] = st * SC_STEP_F + ar * 64 + part * 8; }
    f32x2 s[4][8];
    if (MODE == 0) {
#pragma unroll
        for (int i = 0; i < 4; ++i)
#pragma unroll
            for (int j = 0; j < 8; ++j) s[i][j] = (f32x2){0.f, 0.f};
    } else if (MODE == 1) {
#pragma unroll
        for (int i = 0; i < 4; ++i)
#pragma unroll
            for (int j = 0; j < 8; ++j) s[i][j] = (f32x2){(i == q && 2 * j == rg) ? 1.f : 0.f, (i == q && 2 * j + 1 == rg) ? 1.f : 0.f};
    } else {
        const float* S0 = (const float*)(a.ws + O_SST) + (size_t)task * 4096;
#pragma unroll
        for (int i = 0; i < 4; ++i)
#pragma unroll
            for (int j4 = 0; j4 < 4; ++j4) { const f32x4 t = *(const f32x4*)(S0 + (rg + 16 * i) * 64 + 16 * q + 4 * j4);
                s[i][2 * j4] = (f32x2){t[0], t[1]}; s[i][2 * j4 + 1] = (f32x2){t[2], t[3]}; }
    }
    h16x8 pre[NA];
#pragma unroll
    for (int j = 0; j < NA; ++j) pre[j] = *(const h16x8*)gp[j];
    f32x2 kk[8];
    for (int bt = 0; bt < SC_L / SC_NB; ++bt) {
        LAS float* cb = buf;
#pragma unroll
        for (int j = 0; j < NA; ++j) { f32x4 x0, x1;
#pragma unroll
            for (int e = 0; e < 4; ++e) { x0[e] = (float)pre[j][e]; x1[e] = (float)pre[j][4 + e]; }
            *(LAS f32x4*)(cb + lo[j]) = x0; *(LAS f32x4*)(cb + lo[j] + 4) = x1; }
        if (bt + 1 < SC_L / SC_NB) {
#pragma unroll
            for (int j = 0; j < NA; ++j) pre[j] = *(const h16x8*)(gp[j] + (size_t)(bt + 1) * SC_NB * 512);
        }
        lds_ld8x2(cb + 16 * q, kk);
#pragma unroll 2
        for (int st = 0; st < SC_NB; ++st) {
            const LAS float* sb = cb + st * SC_STEP_F;
            f32x2 w[8], bb[8], kx[8]; float vv[4];
            lds_ld8x2(sb + 64 + 16 * q, w); lds_ld8x2(sb + 128 + 16 * q, bb);
            if (MODE != 1) { lds_ld8x2(sb + 192 + 16 * q, kx);
#pragma unroll
                for (int i = 0; i < 4; ++i) vv[i] = sb[320 + rg + 16 * i]; }
            float us[4];
#pragma unroll
            for (int i = 0; i < 4; ++i) { f32x2 t = s[i][0] * kk[0];
#pragma unroll
                for (int j = 1; j < 8; ++j) t = __builtin_elementwise_fma(s[i][j], kk[j], t);
                us[i] = quad_sum(t[0] + t[1]); }
            if (st + 1 < SC_NB) lds_ld8x2(sb + SC_STEP_F + 16 * q, kk);
            f32x2 rr[8];
            if (MODE == 2) lds_ld8x2(sb + 256 + 16 * q, rr);
#pragma unroll
            for (int i = 0; i < 4; ++i) { const f32x2 nu = (f32x2){-us[i], -us[i]}, v2 = (f32x2){vv[i], vv[i]};
#pragma unroll
                for (int j = 0; j < 8; ++j) { f32x2 t = s[i][j] * w[j]; t = __builtin_elementwise_fma(nu, bb[j], t); if (MODE != 1) t = __builtin_elementwise_fma(v2, kx[j], t); s[i][j] = t; } }
            if (MODE == 2) {
#pragma unroll
                for (int i = 0; i < 4; ++i) { f32x2 t = s[i][0] * rr[0];
#pragma unroll
                    for (int j = 1; j < 8; ++j) t = __builtin_elementwise_fma(s[i][j], rr[j], t);
                    const float y = quad_sum(t[0] + t[1]);
                    if (q == 0) ybuf[st * 64 + rg + 16 * i] = y; }
            }
        }
        if (MODE == 2) {
            const int st = lane >> 3, part = lane & 7; h16x8 o;
#pragma unroll
            for (int e = 0; e < 8; ++e) o[e] = (h16)ybuf[st * 64 + part * 8 + e];
            *(h16x8*)((h16*)(a.ws + O_Y) + (row0 + (size_t)bt * SC_NB + st) * 512 + h * 64 + part * 8) = o;
        }
    }
    if (MODE != 2) {
        float* PQ = (float*)(a.ws + O_PQ) + (size_t)task * 8192 + (MODE == 0 ? 4096 : 0);
#pragma unroll
        for (int i = 0; i < 4; ++i)
#pragma unroll
            for (int j4 = 0; j4 < 4; ++j4) { const int o = (rg + 16 * i) * 64 + 16 * q + 4 * j4;
                *(f32x4*)(PQ + o) = (f32x4){s[i][2 * j4][0], s[i][2 * j4][1], s[i][2 * j4 + 1][0], s[i][2 * j4 + 1][1]}; }
    }
}
template <bool FIRST>
__device__ __forceinline__ void phase_scan(const Args& a, LAS unsigned char* lds) {
    const int wave = tid_() >> 6;
    if (FIRST) {
        for (int t2 = blockIdx.x * NWAVES + wave; t2 < 2 * 64 * SC_NCH; t2 += gridDim.x * NWAVES) {
            if (t2 & 1) scan_wave<1>(a, lds, t2 >> 1); else scan_wave<0>(a, lds, t2 >> 1); }
    } else {
        for (int task = blockIdx.x * NWAVES + wave; task < 64 * SC_NCH; task += gridDim.x * NWAVES) scan_wave<2>(a, lds, task);
    }
}
__device__ __forceinline__ void phase_scan_combine(const Args& a, LAS unsigned char* lds) {
    const int tid = tid_(), row = tid >> 5, cp = tid & 31;
    LAS float* LS = (LAS float*)lds;
    LAS float* LP = (LAS float*)(lds + 8192);
    for (int item = blockIdx.x; item < 64 * 4; item += gridDim.x) {
        const int chain = item >> 2, r0 = (item & 3) * 16;
        const float* PQ0 = (const float*)(a.ws + O_PQ) + (size_t)chain * SC_NCH * 8192;
        f32x2 sr = (f32x2){0.f, 0.f};
        f32x4 pa = *(const f32x4*)(PQ0 + tid * 8), pb = *(const f32x4*)(PQ0 + tid * 8 + 4);
        f32x2 qn = *(const f32x2*)(PQ0 + 4096 + (r0 + row) * 64 + 2 * cp);
        for (int c = 0; c < SC_NCH; ++c) {
            const int task = chain * SC_NCH + c;
            *(f32x2*)((float*)(a.ws + O_SST) + (size_t)task * 4096 + (r0 + row) * 64 + 2 * cp) = sr;
            if (c == SC_NCH - 1) break;
            LAS float* cur = LS + (c & 1) * 1024; LAS float* cp_ = LP + (c & 1) * 4096;
            *(LAS f32x2*)(cur + row * 64 + 2 * cp) = sr;
            *(LAS f32x4*)(cp_ + tid * 8) = pa; *(LAS f32x4*)(cp_ + tid * 8 + 4) = pb;
            f32x2 acc0 = qn, acc1 = (f32x2){0.f, 0.f};
            if (c + 2 < SC_NCH) { const float* Pn = PQ0 + (size_t)(c + 1) * 8192;
                pa = *(const f32x4*)(Pn + tid * 8); pb = *(const f32x4*)(Pn + tid * 8 + 4); qn = *(const f32x2*)(Pn + 4096 + (r0 + row) * 64 + 2 * cp); }
            __syncthreads();
#pragma unroll 16
            for (int k = 0; k < 64; k += 2) {
                const f32x2 sk = *(const LAS f32x2*)(cur + row * 64 + k);
                const f32x2 p0 = *(const LAS f32x2*)(cp_ + k * 64 + 2 * cp), p1 = *(const LAS f32x2*)(cp_ + (k + 1) * 64 + 2 * cp);
                acc0 = __builtin_elementwise_fma((f32x2){sk[0], sk[0]}, p0, acc0); acc1 = __builtin_elementwise_fma((f32x2){sk[1], sk[1]}, p1, acc1);
            }
            sr = acc0 + acc1;
        }
        __syncthreads();
    }
}
__device__ __forceinline__ void phase_rwkv_post(const Args& a) {
    const int tid = tid_(), lane = tid & 63, wave = tid >> 6;
    const int gw = blockIdx.x * NWAVES + wave, NGW = gridDim.x * NWAVES;
    const h16* R = (const h16*)a.out; const h16* KS = R + (size_t)MTOK * 512; const h16* V = KS + (size_t)MTOK * 512;
    const h16* GG = (const h16*)(a.ws + O_GG); const h16* Y = (const h16*)(a.ws + O_Y); h16* YB = (h16*)(a.ws + O_YB);
    float rk[8], lg[8], lb[8];
#pragma unroll
    for (int j = 0; j < 8; ++j) { const int c = lane * 8 + j; rk[j] = a.in[14][c]; lg[j] = a.in[15][c]; lb[j] = a.in[16][c]; }
    for (int t = gw; t < MTOK; t += NGW) {
        const size_t o = (size_t)t * 512 + lane * 8;
        const h16x8 y8 = *(const h16x8*)(Y + o), r8 = *(const h16x8*)(R + o), k8 = *(const h16x8*)(KS + o), v8 = *(const h16x8*)(V + o), g8 = *(const h16x8*)(GG + o);
        float y[8]; float sm = 0.f, bs = 0.f;
#pragma unroll
        for (int j = 0; j < 8; ++j) { y[j] = (float)y8[j]; sm += y[j]; bs += (float)r8[j] * (float)k8[j] * rk[j]; }
        sm += __shfl_xor(sm, 1); sm += __shfl_xor(sm, 2); sm += __shfl_xor(sm, 4);
        bs += __shfl_xor(bs, 1); bs += __shfl_xor(bs, 2); bs += __shfl_xor(bs, 4);
        const float mean = sm * (1.f / 64.f); float vs = 0.f;
#pragma unroll
        for (int j = 0; j < 8; ++j) { y[j] -= mean; vs += y[j] * y[j]; }
        vs += __shfl_xor(vs, 1); vs += __shfl_xor(vs, 2); vs += __shfl_xor(vs, 4);
        const float rstd = rsqrtf(vs * (1.f / 64.f) + 64e-5f);
        h16x8 ov;
#pragma unroll
        for (int j = 0; j < 8; ++j) ov[j] = (h16)((y[j] * rstd * lg[j] + lb[j] + bs * (float)v8[j]) * (float)g8[j]);
        *(h16x8*)(YB + o) = ov;
    }
}


__device__ __forceinline__ void ins16(unsigned (&L)[16], unsigned x) {
#pragma unroll
    for (int j = 0; j < 16; ++j) { const unsigned hi = L[j] > x ? L[j] : x; x = L[j] > x ? x : L[j]; L[j] = hi; }
}
__device__ __forceinline__ unsigned ord32(float f) { const unsigned u = __float_as_uint(f); return (u & 0x80000000u) ? ~u : (u | 0x80000000u); }
__device__ __forceinline__ float unord32(unsigned k) { return __uint_as_float((k & 0x80000000u) ? (k & 0x7fffffffu) : ~k); }
__device__ __forceinline__ void phase_topk(const Args& a, LAS unsigned char* lds) {
    const int tid = tid_();
    const h16* SC = (const h16*)(a.ws + O_SCORES);
    const float* part = (const float*)(a.ws + O_PART1);
    unsigned short* IDX = (unsigned short*)(a.ws + O_IDX); float* GATE = (float*)(a.ws + O_GATE); float* RS1 = (float*)(a.ws + O_RS1);
    LAS unsigned char* LI = lds;
    for (int task = blockIdx.x * NTHREADS + tid; task < MTOK * 8; task += gridDim.x * NTHREADS) {
        const int t = task >> 3, h = task & 7;
        float ssq = 0.f;
#pragma unroll
        for (int j = 0; j < 4; ++j) { const f32x4 p4 = *(const f32x4*)(part + (size_t)t * 16 + 4 * j); ssq += (p4[0] + p4[1]) + (p4[2] + p4[3]); }
        const float rs = rsqrtf(ssq * (1.f / 1024.f) + NORM_EPS);
        if (h == 0) RS1[t] = rs;
        float sv[2][16];
#pragma unroll
        for (int c = 0; c < 2; ++c) {
            unsigned L[16];
#pragma unroll
            for (int j = 0; j < 16; ++j) L[j] = 0u;
            const h16* row = SC + (size_t)t * 2048 + h * 256 + c * 128;
#pragma unroll 2
            for (int n8 = 0; n8 < 16; ++n8) {
                const u32x4 w4 = *(const u32x4*)(row + n8 * 8);
#pragma unroll
                for (int e = 0; e < 8; ++e) {
                    const unsigned bits = (e & 1) ? (w4[e >> 1] >> 16) : (w4[e >> 1] & 0xffffu);
                    const unsigned o16 = (bits & 0x8000u) ? (~bits & 0xffffu) : (bits | 0x8000u);
                    ins16(L, (o16 << 16) | (unsigned)(127 - (n8 * 8 + e)));
                }
            }
#pragma unroll
            for (int j = 0; j < 16; ++j) {
                const unsigned o16 = L[j] >> 16; const unsigned bits = (o16 & 0x8000u) ? (o16 & 0x7fffu) : (~o16 & 0xffffu);
                union { unsigned short u; h16 f; } cv; cv.u = (unsigned short)bits; sv[c][j] = (float)cv.f;
                LI[(c * 16 + j) * 512 + tid] = (unsigned char)(127u - (L[j] & 127u));
            }
        }
        unsigned L[16];
#pragma unroll
        for (int j = 0; j < 16; ++j) L[j] = 0u;
#pragma unroll
        for (int i = 0; i < 16; ++i)
#pragma unroll
            for (int j = 0; j < 16; ++j) if ((i + 1) * (j + 1) <= 16) ins16(L, (ord32(sv[0][i] + sv[1][j]) & ~255u) | (unsigned)(255 - (i * 16 + j)));
        float e[16]; float den = 0.f; const float mx = unord32(L[0] & ~255u) * rs;
        unsigned short id[16];
#pragma unroll
        for (int k = 0; k < 16; ++k) {
            const float v = unord32(L[k] & ~255u) * rs; e[k] = __expf(v - mx); den += e[k];
            const unsigned pos = 255u - (L[k] & 255u); const unsigned i = pos >> 4, j = pos & 15u;
            id[k] = (unsigned short)((unsigned)LI[i * 512 + tid] * 128u + (unsigned)LI[(16 + j) * 512 + tid]);
        }
        const float inv = __builtin_amdgcn_rcpf(den);
        u32x4 i0, i1;
        i0[0] = id[0] | (id[1] << 16); i0[1] = id[2] | (id[3] << 16); i0[2] = id[4] | (id[5] << 16); i0[3] = id[6] | (id[7] << 16);
        i1[0] = id[8] | (id[9] << 16); i1[1] = id[10] | (id[11] << 16); i1[2] = id[12] | (id[13] << 16); i1[3] = id[14] | (id[15] << 16);
        u32x4* ip = (u32x4*)(IDX + (size_t)task * 16); ip[0] = i0; ip[1] = i1;
        f32x4* gp = (f32x4*)(GATE + (size_t)task * 16);
#pragma unroll
        for (int k4 = 0; k4 < 4; ++k4) gp[k4] = (f32x4){e[4 * k4] * inv, e[4 * k4 + 1] * inv, e[4 * k4 + 2] * inv, e[4 * k4 + 3] * inv};
    }
}

__device__ __forceinline__ float gelu_tanh(float x) { const float u = 0.7978845608028654f * (x + 0.044715f * x * x * x); return 0.5f * x * (1.0f + tanhf_(u)); }
__device__ __forceinline__ unsigned xcc_id() { return (unsigned)__builtin_amdgcn_s_getreg((3 << 11) | 20) & 7u; }
constexpr int GA_TC = 32, GA_NCH = MTOK / GA_TC;
__device__ __forceinline__ void dec16(const u32x4 q, float (&o)[16]) {
#pragma unroll
    for (int w = 0; w < 4; ++w) { const f32x2 lo = __builtin_amdgcn_cvt_pk_f32_fp8((int)q[w], false), hi = __builtin_amdgcn_cvt_pk_f32_fp8((int)q[w], true);
        o[4 * w] = lo[0]; o[4 * w + 1] = lo[1]; o[4 * w + 2] = hi[0]; o[4 * w + 3] = hi[1]; }
}
template <int PH>
__device__ __forceinline__ void phase_gather(const Args& a, int cset) {
    const int tid = tid_(), lane = tid & 63, m = lane & 7, r8 = lane >> 3;
    unsigned* ctr = (unsigned*)(a.ws + O_CTR) + cset * 8 * 64;
    const unsigned short* IDX = (const unsigned short*)(a.ws + O_IDX);
    const unsigned j0 = xcc_id();
    for (unsigned dj = 0; dj < 8; ++dj) {
        const unsigned j = (j0 + dj) & 7u;
        const unsigned char* TB = a.ws + (PH ? O_V8 : O_U8) + (size_t)j * 16384 * 128 + 16 * m;
        for (;;) {
            unsigned c = 0; if (lane == 0) c = __hip_atomic_fetch_add(ctr + j * 64, 1u, __ATOMIC_RELAXED, __HIP_MEMORY_SCOPE_AGENT);
            c = (unsigned)__builtin_amdgcn_readfirstlane((int)c);
            if (c >= (unsigned)GA_NCH) break;
#pragma unroll 1
            for (int ti = 0; ti < GA_TC; ++ti) {
                const int t = c * GA_TC + ti;
                const u32x4* ip = (const u32x4*)(IDX + (size_t)t * 128 + 16 * r8); const u32x4 ia = ip[0], ib = ip[1];
                u32x4 q[16];
#pragma unroll
                for (int i = 0; i < 16; ++i) { const unsigned w = (i < 8) ? ia[(i & 7) >> 1] : ib[(i & 7) >> 1]; const unsigned e = (i & 1) ? (w >> 16) : (w & 0xffffu);
                    q[i] = *(const u32x4*)(TB + (size_t)e * 128); }
                if (PH == 0) {
                    const h16* xp = (const h16*)(a.ws + O_H1B) + (size_t)t * 1024 + 128 * j + 16 * m;
                    const h16x8 xa = *(const h16x8*)xp, xb = *(const h16x8*)(xp + 8);
                    float x[16];
#pragma unroll
                    for (int k = 0; k < 8; ++k) { x[k] = (float)xa[k]; x[8 + k] = (float)xb[k]; }
                    float p[16];
#pragma unroll
                    for (int i = 0; i < 16; ++i) { float d[16]; dec16(q[i], d); float s0 = 0.f, s1 = 0.f;
#pragma unroll
                        for (int k = 0; k < 8; ++k) { s0 += x[2 * k] * d[2 * k]; s1 += x[2 * k + 1] * d[2 * k + 1]; }
                        p[i] = s0 + s1; }
                    float q8[8], q4[4], q2[2];
#pragma unroll
                    for (int i = 0; i < 8; ++i) { const float keep = (lane & 4) ? p[i + 8] : p[i], send = (lane & 4) ? p[i] : p[i + 8]; q8[i] = keep + __shfl_xor(send, 4); }
#pragma unroll
                    for (int i = 0; i < 4; ++i) { const float keep = (lane & 2) ? q8[i + 4] : q8[i], send = (lane & 2) ? q8[i] : q8[i + 4]; q4[i] = keep + __shfl_xor(send, 2); }
#pragma unroll
                    for (int i = 0; i < 2; ++i) { const float keep = (lane & 1) ? q4[i + 2] : q4[i], send = (lane & 1) ? q4[i] : q4[i + 2]; q2[i] = keep + __shfl_xor(send, 1); }
                    *(f32x2*)((float*)(a.ws + O_PART) + ((size_t)j * MTOK + t) * 128 + 16 * r8 + 2 * m) = (f32x2){q2[0], q2[1]};
                } else {
                    const f32x4* cp = (const f32x4*)((const float*)(a.ws + O_COEF) + (size_t)t * 128 + 16 * r8);
                    float cf[16];
#pragma unroll
                    for (int k4 = 0; k4 < 4; ++k4) { const f32x4 c4 = cp[k4]; cf[4 * k4] = c4[0]; cf[4 * k4 + 1] = c4[1]; cf[4 * k4 + 2] = c4[2]; cf[4 * k4 + 3] = c4[3]; }
                    float acc[16];
#pragma unroll
                    for (int k = 0; k < 16; ++k) acc[k] = 0.f;
#pragma unroll
                    for (int i = 0; i < 16; ++i) { float d[16]; dec16(q[i], d);
#pragma unroll
                        for (int k = 0; k < 16; ++k) acc[k] += cf[i] * d[k]; }
                    float q8[8], q4[4], q2[2];
#pragma unroll
                    for (int i = 0; i < 8; ++i) { const float keep = (lane & 32) ? acc[i + 8] : acc[i], send = (lane & 32) ? acc[i] : acc[i + 8]; q8[i] = keep + __shfl_xor(send, 32); }
#pragma unroll
                    for (int i = 0; i < 4; ++i) { const float keep = (lane & 16) ? q8[i + 4] : q8[i], send = (lane & 16) ? q8[i] : q8[i + 4]; q4[i] = keep + __shfl_xor(send, 16); }
#pragma unroll
                    for (int i = 0; i < 2; ++i) { const float keep = (lane & 8) ? q4[i + 2] : q4[i], send = (lane & 8) ? q4[i] : q4[i + 2]; q2[i] = keep + __shfl_xor(send, 8); }
                    const int col = 128 * j + 16 * m + 2 * r8;
                    float* op = a.out + (size_t)t * 1024 + col;
                    f32x2 hv = *(const f32x2*)op; hv[0] += q2[0]; hv[1] += q2[1];
                    *(f32x2*)op = hv;
                    *(h16x2*)((h16*)(a.ws + O_H2B) + (size_t)t * 1024 + col) = (h16x2){(h16)hv[0], (h16)hv[1]};
                    const float ss = wave_sum(hv[0] * hv[0] + hv[1] * hv[1]);
                    if (lane == 0) ((float*)(a.ws + O_SS2))[(size_t)t * 8 + j] = ss;
                }
            }
        }
    }
}
__device__ __forceinline__ void phase_coef(const Args& a) {
    const int tid = tid_();
    const float* PART = (const float*)(a.ws + O_PART); const unsigned short* IDX = (const unsigned short*)(a.ws + O_IDX);
    const float* GATE = (const float*)(a.ws + O_GATE); const float* RS1 = (const float*)(a.ws + O_RS1);
    const float* USC = (const float*)(a.ws + O_USC); const float* VSC = (const float*)(a.ws + O_VSC); float* COEF = (float*)(a.ws + O_COEF);
    for (int i = blockIdx.x * NTHREADS + tid; i < MTOK * 128; i += gridDim.x * NTHREADS) {
        float s = 0.f;
#pragma unroll
        for (int j = 0; j < 8; ++j) s += PART[(size_t)j * MTOK * 128 + i];
        const unsigned e = IDX[i];
        COEF[i] = GATE[i] * gelu_tanh(RS1[i >> 7] * USC[e] * s) * VSC[e];
    }
}

__device__ __forceinline__ void phase_final(const Args& a) {
    const int tid = tid_(), lane = tid & 63, wave = tid >> 6;
    const int gw = blockIdx.x * NWAVES + wave, NGW = gridDim.x * NWAVES;
    const float* part = (const float*)(a.ws + O_PART3); const float* fg = a.in[28];
    f32x4 g4[4];
#pragma unroll
    for (int j = 0; j < 4; ++j) g4[j] = *((const f32x4*)fg + lane + 64 * j);
    for (int r = gw; r < MTOK; r += NGW) {
        float s = (lane < 16) ? part[(size_t)r * 16 + lane] : 0.f;
        s = wave_sum(s);
        const float rs = rsqrtf(s * (1.f / 1024.f) + NORM_EPS);
        f32x4* xr = (f32x4*)(a.out + (size_t)r * 1024) + lane;
#pragma unroll
        for (int j = 0; j < 4; ++j) xr[64 * j] = xr[64 * j] * rs * g4[j];
    }
}

constexpr int NPHASE = 19;
__global__ void __launch_bounds__(NTHREADS, 2) mk(Args a) {
    extern __shared__ __attribute__((aligned(16))) unsigned char smem[];
    LAS unsigned char* lds = (LAS unsigned char*)smem;
    unsigned char* ws = a.ws;
#if ONE_LAUNCH
    cg::grid_group grid = cg::this_grid();
#define SYNC() grid.sync()
#else
#define SYNC() do {} while (0)
#endif
#define IN(k) (a.ph_lo <= (k) && (k) < a.ph_hi)
#define SEAM(k) do { if (IN(k) && IN((k) + 1)) SYNC(); } while (0)
#define REPS(k) ((((REP_MASK) >> (k)) & 1u) ? 2 : 1)
    const int G = gridDim.x, bid = blockIdx.x;
    if (IN(0)) for (int rep = 0; rep < REPS(0); ++rep) { if (rep) SYNC(); phase_prep(a, lds); } SEAM(0);
    if (IN(1)) for (int rep = 0; rep < REPS(1); ++rep) { if (rep) SYNC(); pg8::Gemm g{(const h16*)(ws + O_XN), (const h16*)(ws + O_WIN), MTOK, NIN, 1024}; pg8::StaticOrder S; S.init(MTOK, NIN, G, bid);
        EpiZ E{(h16*)(ws + O_ZC), (h16*)(ws + O_ZR), (h16*)(ws + O_ZG)}; pg8::gemm_phase(lds, g, S, E); } SEAM(1);
    if (IN(2)) for (int rep = 0; rep < REPS(2); ++rep) { if (rep) SYNC(); phase_conv(a); phase_rwkv_prep(a); } SEAM(2);
    if (IN(3)) for (int rep = 0; rep < REPS(3); ++rep) { if (rep) SYNC(); pg8::Gemm g{(const h16*)(ws + O_APR), (const h16*)(ws + O_WLR), MTOK, 1536, 256}; pg8::StaticOrder S; S.init(MTOK, 1536, G, bid);
        h16* R = (h16*)a.out; h16* KS = R + (size_t)MTOK * 512; h16* KK = KS + (size_t)2 * MTOK * 512;
        EpiLR E{a.in[7], a.in[9], a.in[13], (h16*)(ws + O_WD), KS, (h16*)(ws + O_BD), (h16*)(ws + O_GG), KK}; pg8::gemm_phase(lds, g, S, E); } SEAM(3);
    if (IN(4)) for (int rep = 0; rep < REPS(4); ++rep) { if (rep) SYNC(); phase_scan<true>(a, lds); } SEAM(4);
    if (IN(5)) for (int rep = 0; rep < REPS(5); ++rep) { if (rep) SYNC(); phase_scan_combine(a, lds); } SEAM(5);
    if (IN(6)) for (int rep = 0; rep < REPS(6); ++rep) { if (rep) SYNC(); phase_scan<false>(a, lds); } SEAM(6);
    if (IN(7)) for (int rep = 0; rep < REPS(7); ++rep) { if (rep) SYNC(); phase_rwkv_post(a); } SEAM(7);
    if (IN(8)) for (int rep = 0; rep < REPS(8); ++rep) { if (rep) SYNC(); pg8::Gemm g{(const h16*)(ws + O_CA), (const h16*)(ws + O_WA), MTOK, 1024, 512}; pg8::StaticOrder S; S.init(MTOK, 1024, G, bid);
        EpiYA E{(const h16*)(ws + O_ZG), a.out}; pg8::gemm_phase(lds, g, S, E); } SEAM(8);
    if (IN(9)) for (int rep = 0; rep < REPS(9); ++rep) { if (rep) SYNC(); pg8::Gemm g{(const h16*)(ws + O_YB), (const h16*)(ws + O_WB), MTOK, 1024, 512}; pg8::StaticOrder S; S.init(MTOK, 1024, G, bid);
        EpiYB E{(const h16*)(ws + O_ZG), a.out, (h16*)(ws + O_MERGED)}; pg8::gemm_phase(lds, g, S, E); } SEAM(9);
    if (IN(10)) for (int rep = 0; rep < REPS(10); ++rep) { if (rep) SYNC(); pg8::Gemm g{(const h16*)(ws + O_MERGED), (const h16*)(ws + O_WO), MTOK, 1024, 1024}; pg8::StaticOrder S; S.init(MTOK, 1024, G, bid);
        EpiH1 E{a.in[0], a.out, (h16*)(ws + O_H1B), (float*)(ws + O_PART1)}; pg8::gemm_phase(lds, g, S, E); } SEAM(10);
    if (IN(11)) for (int rep = 0; rep < REPS(11); ++rep) { if (rep) SYNC(); pg8::Gemm g{(const h16*)(ws + O_H1B), (const h16*)(ws + O_WS), MTOK, 2048, 1024}; pg8::StaticOrder S; S.init(MTOK, 2048, G, bid);
        EpiF16 E{(h16*)(ws + O_SCORES), 2048}; pg8::gemm_phase(lds, g, S, E); } SEAM(11);
    if (IN(12)) for (int rep = 0; rep < REPS(12); ++rep) { if (rep) SYNC(); phase_topk(a, lds); } SEAM(12);
    if (IN(13)) for (int rep = 0; rep < REPS(13); ++rep) { if (rep) SYNC(); phase_gather<0>(a, 2 * rep); } SEAM(13);
    if (IN(14)) for (int rep = 0; rep < REPS(14); ++rep) { if (rep) SYNC(); phase_coef(a); } SEAM(14);
    if (IN(15)) for (int rep = 0; rep < REPS(15); ++rep) { if (rep) SYNC(); phase_gather<1>(a, 1); } SEAM(15);
    if (IN(16)) for (int rep = 0; rep < REPS(16); ++rep) { if (rep) SYNC(); pg8::Gemm g{(const h16*)(ws + O_P16), (const h16*)(ws + O_WP), MTOK, 1024, 256}; pg8::StaticOrder S; S.init(MTOK, 1024, G, bid);
        EpiF16 E{(h16*)(ws + O_PP), 1024}; pg8::gemm_phase(lds, g, S, E); } SEAM(16);
    if (IN(17)) for (int rep = 0; rep < REPS(17); ++rep) { if (rep) SYNC(); pg8::Gemm g{(const h16*)(ws + O_H2B), (const h16*)(ws + O_WG), MTOK, 1024, 1024}; pg8::StaticOrder S; S.init(MTOK, 1024, G, bid);
        EpiGate E{a.out, (const h16*)(ws + O_PP), (const float*)(ws + O_SS2), (float*)(ws + O_PART3)}; pg8::gemm_phase(lds, g, S, E); } SEAM(17);
    if (IN(18)) for (int rep = 0; rep < REPS(18); ++rep) { if (rep) SYNC(); phase_final(a); }
}

extern "C" void kernel_launch(void* const* d_in, const int* in_sizes, int n_in, void* d_out, int out_size, void* d_ws, size_t ws_size, hipStream_t stream) {
    static int ready = 0;
    if (!ready) {
        if (n_in != 29 || ws_size < WS_END) { fprintf(stderr, "kernel_launch: unexpected n_in %d / ws %zu (need %zu)\n", n_in, ws_size, (size_t)WS_END); ready = -1; return; }
        if (hipFuncSetAttribute((const void*)mk, hipFuncAttributeMaxDynamicSharedMemorySize, LDS_BYTES) != hipSuccess) { fprintf(stderr, "hipFuncSetAttribute failed\n"); ready = -1; return; }
        ready = 1;
    }
    if (ready < 0) return;
    Args a{};
    for (int i = 0; i < 29; ++i) a.in[i] = (const float*)d_in[i];
    a.out = (float*)d_out; a.ws = (unsigned char*)d_ws;
#if ONE_LAUNCH
    a.ph_lo = 0; a.ph_hi = NPHASE;
    void* args[] = {&a};
    hipLaunchCooperativeKernel((const void*)mk, dim3(NBLK), dim3(NTHREADS), args, LDS_BYTES, stream);
#else
    const int phases[] = {0, 1, 2, 3, 4, 5, 6, 7, 8, 9, 10, 11, 12, 13, 14, 15, 16, 17, 18};
    for (int ph : phases) { a.ph_lo = ph; a.ph_hi = ph + 1; hipLaunchKernelGGL(mk, dim3(NBLK), dim3(NTHREADS), LDS_BYTES, stream, a); }
#endif
}
```

```cpp
#include <hip/hip_runtime.h>
#include <hip/hip_cooperative_groups.h>
#include <cstdio>
namespace cg = cooperative_groups;

#ifndef REP_MASK
#define REP_MASK 0u
#endif
#ifndef ONE_LAUNCH
#define ONE_LAUNCH 1
#endif

#define LAS __attribute__((address_space(3)))
typedef _Float16 h16;
typedef _Float16 h16x8 __attribute__((ext_vector_type(8)));
typedef _Float16 h16x4 __attribute__((ext_vector_type(4)));
typedef _Float16 h16x2 __attribute__((ext_vector_type(2)));
typedef float f32x4 __attribute__((ext_vector_type(4)));
typedef float f32x2 __attribute__((ext_vector_type(2)));
typedef unsigned u32x4 __attribute__((ext_vector_type(4)));
typedef unsigned u32x2 __attribute__((ext_vector_type(2)));

constexpr int MTOK = 65536, DM = 1024, SEQ = 8192, NB = 8;
constexpr int NIN = 5376;
constexpr int NTHREADS = 512, NWAVES = 8, NBLK = 256;
constexpr int LDS_BYTES = 131072;
constexpr float NORM_EPS = 1e-6f;

constexpr size_t MiB = 1u << 20;
constexpr size_t O_WIN = 0;
constexpr size_t O_WA = O_WIN + (size_t)5376 * 1024 * 2;
constexpr size_t O_WB = O_WA + 1 * MiB;
constexpr size_t O_WO = O_WB + 1 * MiB;
constexpr size_t O_WG = O_WO + 2 * MiB;
constexpr size_t O_WP = O_WG + 2 * MiB;
constexpr size_t O_WLR = O_WP + MiB / 2;
constexpr size_t O_WS = O_WLR + 3 * MiB / 4;
constexpr size_t O_U16 = O_WS + 4 * MiB;
constexpr size_t O_V16 = O_U16 + 32 * MiB;
constexpr size_t O_P16 = O_V16 + 32 * MiB;
constexpr size_t O_PART1 = O_P16 + 32 * MiB;
constexpr size_t O_PART3 = O_PART1 + 4 * MiB;
constexpr size_t O_RS1 = O_PART3 + 4 * MiB;
constexpr size_t O_RS2 = O_RS1 + MiB / 4;
constexpr size_t O_XN = O_RS2 + MiB / 4;
constexpr size_t O_ZC = O_XN + 128 * MiB;
constexpr size_t O_ZR = O_ZC + 192 * MiB;
constexpr size_t O_ZG = O_ZR + 224 * MiB;
constexpr size_t O_SS2 = O_ZG + 256 * MiB;
constexpr size_t O_USC = O_SS2 + 2 * MiB;
constexpr size_t O_VSC = O_USC + 65536;
constexpr size_t O_CTR = O_VSC + 65536;
constexpr size_t WS_END = O_CTR + 8192;
constexpr size_t O_U8 = O_U16;
constexpr size_t O_V8 = O_U16 + 16 * MiB;
constexpr size_t O_PART = O_ZG;
constexpr size_t O_COEF = O_ZR + 48 * MiB;
constexpr size_t O_CA = O_XN;
constexpr size_t O_APR = O_XN + 64 * MiB;
constexpr size_t O_H1B = O_XN;
constexpr size_t O_WD = O_ZC;
constexpr size_t O_BD = O_ZC + 64 * MiB;
constexpr size_t O_GG = O_ZC + 128 * MiB;
constexpr size_t O_MERGED = O_ZC;
constexpr size_t O_H2B = O_ZC;
constexpr size_t O_PQ = O_ZR;
constexpr size_t O_SST = O_ZR + 64 * MiB;
constexpr size_t O_Y = O_ZR + 96 * MiB;
constexpr size_t O_YB = O_ZR + 160 * MiB;
constexpr size_t O_IDX = O_ZR;
constexpr size_t O_GATE = O_ZR + 16 * MiB;
constexpr size_t O_PP = O_ZR + 64 * MiB;
constexpr size_t O_SCORES = O_ZG;

struct Args {
    const float* in[29];
    float* out;
    unsigned char* ws;
    int ph_lo, ph_hi;
};

__device__ __forceinline__ int tid_() { int t = threadIdx.x; asm volatile("" : "+v"(t)); return t; }
__device__ __forceinline__ float sigmoidf_(float x) { return __builtin_amdgcn_rcpf(1.0f + __expf(-x)); }
template <int CTRL> __device__ __forceinline__ float dpp_(float v) { return __builtin_bit_cast(float, __builtin_amdgcn_update_dpp(0, __builtin_bit_cast(int, v), CTRL, 0xF, 0xF, true)); }
__device__ __forceinline__ float x32_(float v, int lane) { const auto r = __builtin_amdgcn_permlane32_swap(__builtin_bit_cast(unsigned, v), __builtin_bit_cast(unsigned, v), false, false); return __builtin_bit_cast(float, (lane & 32) ? r[0] : r[1]); }
__device__ __forceinline__ float x16_(float v, int lane) { const auto r = __builtin_amdgcn_permlane16_swap(__builtin_bit_cast(unsigned, v), __builtin_bit_cast(unsigned, v), false, false); return __builtin_bit_cast(float, (lane & 16) ? r[0] : r[1]); }
__device__ __forceinline__ float x8_(float v) { return dpp_<0x128>(v); }
__device__ __forceinline__ float xhm_(float v) { return dpp_<0x141>(v); }
__device__ __forceinline__ float wave_sum(float v) {
    const int lane = threadIdx.x & 63;
    v += dpp_<0xB1>(v); v += dpp_<0x4E>(v); v += dpp_<0x141>(v); v += dpp_<0x140>(v);
    v += x16_(v, lane); v += x32_(v, lane);
    return v;
}
__device__ __forceinline__ h16x8 pack8(f32x4 a, f32x4 b) {
    h16x8 r;
    r[0] = (h16)a[0]; r[1] = (h16)a[1]; r[2] = (h16)a[2]; r[3] = (h16)a[3];
    r[4] = (h16)b[0]; r[5] = (h16)b[1]; r[6] = (h16)b[2]; r[7] = (h16)b[3];
    return r;
}
__device__ __forceinline__ h16x4 pack4(f32x4 a) {
    h16x4 r; r[0] = (h16)a[0]; r[1] = (h16)a[1]; r[2] = (h16)a[2]; r[3] = (h16)a[3]; return r;
}

namespace pg8 {
constexpr int BM = 256, BK = 64, HALF = 128, HTB = HALF * BK * 2, STAGE_BYTES = 8 * HTB, NXCD = 8, WGM = 8;
__device__ __forceinline__ int lds_byte(int r, int c) { const int st = (r >> 4) * 2 + (c >> 5), rr = r & 15, cc = c & 31, ob = rr * 64 + cc * 2; return st * 1024 + (ob ^ (((ob >> 9) & 1) << 5)); }
__device__ __forceinline__ void stage_rc(int b, int& R, int& C) { const int st = b / 1024, sb = b % 1024, swz = sb ^ (((sb >> 9) & 1) << 5); R = (st >> 1) * 16 + swz / 64; C = (st & 1) * 32 + (swz % 64) / 2; }
__device__ __forceinline__ int perm32(int rho) { const int n = rho >> 4, i = rho & 15; return 8 * (i >> 2) + 4 * n + (i & 3); }

struct Unit { int pm, pn; };
struct Gemm { const h16* A; const h16* Bt; int M, N, K; };

struct StaticOrder {
    int nM, nN, nwg, G, c;
    __device__ void init(int M, int N, int G_, int c_) { nM = M / BM; nN = N / BM; nwg = nM * nN; G = G_; c = c_; }
    __device__ bool next(int i, Unit& u) const {
        const long L = (long)i * G + c; if (L >= nwg) return false;
        int wgid = (int)L; { const int q = nwg / NXCD, r = nwg % NXCD, xcd = wgid % NXCD, off = wgid / NXCD; wgid = (xcd < r ? xcd * (q + 1) : r * (q + 1) + (xcd - r) * q) + off; }
        const int nig = WGM * nN, gid = wgid / nig, fm = gid * WGM, gsz = (nM - fm) < WGM ? (nM - fm) : WGM;
        u.pm = fm + ((wgid % nig) % gsz); u.pn = (wgid % nig) / gsz; return true;
    }
};

template <class Epi>
__device__ __forceinline__ void gemm_phase(LAS unsigned char* lds, const Gemm g, const StaticOrder& S, const Epi& E) {
    const int tid = tid_(), wid = __builtin_amdgcn_readfirstlane(tid >> 6), lane = tid & 63, wr = wid >> 2, wc = wid & 3, fr = lane & 15, fq = lane >> 4;
    const int K = g.K, nt = K / BK;
    unsigned voffA[2], voffB[2];
#pragma unroll
    for (int i = 0; i < 2; ++i) { int R, C; stage_rc(tid * 16 + i * 8192, R, C); const int Rb = (R & ~31) + perm32(R & 31);
        voffA[i] = (unsigned)(R * K + C) * 2u; voffB[i] = (unsigned)(Rb * K + C) * 2u; }
    const size_t kstep = (size_t)(BK * 2);
    const size_t hstep = (size_t)HALF * K * 2;
    const size_t tstep = 2 * hstep;
    const unsigned ldsw = (unsigned)wid * 1024u;
    const int aoff = lds_byte(wr * 64 + fr, fq * 8), boff = lds_byte(wc * 32 + fr, fq * 8);
#define PG8_SA(b, h) (((b) * 2 + (h)) * HTB)
#define PG8_SB(b, h) ((4 + (b) * 2 + (h)) * HTB)
#define PG8_STAGE(bufoff, gbase, voff) do { _Pragma("unroll") for (int _i = 0; _i < 2; ++_i) \
        __builtin_amdgcn_global_load_lds((const unsigned*)((const char*)(gbase) + (voff)[_i]), (LAS unsigned*)(lds + (bufoff) + ldsw + _i * 8192), 16, 0, 0); } while (0)
#define PG8_LDA(dst, b, h) do { _Pragma("unroll") for (int m = 0; m < 4; ++m) _Pragma("unroll") for (int k = 0; k < 2; ++k) dst[m][k] = *(const LAS h16x8*)(lds + PG8_SA(b, h) + aoff + m * 2048 + k * 1024); } while (0)
#define PG8_LDB(dst, b, h) do { _Pragma("unroll") for (int n = 0; n < 2; ++n) _Pragma("unroll") for (int k = 0; k < 2; ++k) dst[n][k] = *(const LAS h16x8*)(lds + PG8_SB(b, h) + boff + n * 2048 + k * 1024); } while (0)
#define PG8_MMA(ai, bj, At, Bt) do { __builtin_amdgcn_s_setprio(1); _Pragma("unroll") for (int m = 0; m < 4; ++m) _Pragma("unroll") for (int n = 0; n < 2; ++n) _Pragma("unroll") for (int k = 0; k < 2; ++k) \
        acc[ai][bj][m][n] = __builtin_amdgcn_mfma_f32_16x16x32_f16(Bt[n][k], At[m][k], acc[ai][bj][m][n], 0, 0, 0); __builtin_amdgcn_s_setprio(0); } while (0)
#define PG8_WAIT_V(n) asm volatile("s_waitcnt vmcnt(" #n ")" ::: "memory")
#define PG8_WAIT_L(n) asm volatile("s_waitcnt lgkmcnt(" #n ")" ::: "memory")
#define PG8_BAR __builtin_amdgcn_s_barrier()
#define PG8_SCHED __builtin_amdgcn_sched_barrier(0)
    Unit cur, nxt; int ui = 0;
    if (!S.next(0, cur)) return;
    f32x4 acc[2][2][4][2];
#pragma unroll
    for (int a = 0; a < 2; ++a)
#pragma unroll
        for (int b = 0; b < 2; ++b)
#pragma unroll
            for (int m = 0; m < 4; ++m)
#pragma unroll
                for (int n = 0; n < 2; ++n) acc[a][b][m][n] = (f32x4){0.f, 0.f, 0.f, 0.f};
    h16x8 At[4][2], B0[2][2], B1[2][2];
    const char* cA = (const char*)g.A + (size_t)cur.pm * tstep; const char* cB = (const char*)g.Bt + (size_t)cur.pn * tstep;
    PG8_STAGE(PG8_SB(0, 0), cB, voffB); PG8_STAGE(PG8_SA(0, 0), cA, voffA); PG8_STAGE(PG8_SB(0, 1), cB + hstep, voffB); PG8_STAGE(PG8_SA(0, 1), cA + hstep, voffA);
    if (wr == 1) PG8_BAR;
    PG8_WAIT_V(4); PG8_BAR;
    PG8_STAGE(PG8_SB(1, 0), cB + kstep, voffB); PG8_STAGE(PG8_SA(1, 0), cA + kstep, voffA); PG8_STAGE(PG8_SB(1, 1), cB + hstep + kstep, voffB);
    PG8_WAIT_V(6); PG8_BAR;
    for (;;) {
        const bool has_next = S.next(ui + 1, nxt);
        const char* nA = has_next ? (const char*)g.A + (size_t)nxt.pm * tstep : cA; const char* nB = has_next ? (const char*)g.Bt + (size_t)nxt.pn * tstep : cB;
        for (int t = 0; t < nt; t += 2) {
            const bool last = (t == nt - 2);
            const char* a1 = cA + (size_t)(t + 1) * kstep;
            const char* a2 = last ? nA : cA + (size_t)(t + 2) * kstep; const char* b2 = last ? nB : cB + (size_t)(t + 2) * kstep;
            const char* a3 = a2 + kstep; const char* b3 = b2 + kstep;
            PG8_LDB(B0, 0, 0); PG8_SCHED; PG8_LDA(At, 0, 0); PG8_STAGE(PG8_SA(1, 1), a1 + hstep, voffA);
            PG8_WAIT_L(8); PG8_BAR; PG8_WAIT_L(0); PG8_MMA(0, 0, At, B0); PG8_BAR; PG8_SCHED;
            PG8_LDB(B1, 0, 1); PG8_STAGE(PG8_SB(0, 0), b2, voffB);
            PG8_BAR; PG8_WAIT_L(0); PG8_MMA(0, 1, At, B1); PG8_BAR;
            PG8_LDA(At, 0, 1); PG8_STAGE(PG8_SA(0, 0), a2, voffA);
            PG8_BAR; PG8_WAIT_L(0); PG8_MMA(1, 0, At, B0); PG8_BAR; PG8_SCHED;
            PG8_STAGE(PG8_SB(0, 1), b2 + hstep, voffB);
            PG8_WAIT_V(6); PG8_BAR; PG8_MMA(1, 1, At, B1); PG8_BAR;
            PG8_LDB(B0, 1, 0); PG8_SCHED; PG8_LDA(At, 1, 0); PG8_STAGE(PG8_SA(0, 1), a2 + hstep, voffA);
            PG8_WAIT_L(8); PG8_BAR; PG8_WAIT_L(0); PG8_MMA(0, 0, At, B0); PG8_BAR; PG8_SCHED;
            PG8_LDB(B1, 1, 1); PG8_STAGE(PG8_SB(1, 0), b3, voffB);
            PG8_BAR; PG8_WAIT_L(0); PG8_MMA(0, 1, At, B1); PG8_BAR;
            PG8_LDA(At, 1, 1); PG8_STAGE(PG8_SA(1, 0), a3, voffA);
            PG8_BAR; PG8_WAIT_L(0); PG8_MMA(1, 0, At, B0); PG8_BAR; PG8_SCHED;
            PG8_STAGE(PG8_SB(1, 1), b3 + hstep, voffB);
            PG8_WAIT_V(6); PG8_BAR; PG8_MMA(1, 1, At, B1); PG8_BAR;
        }
        E(acc, cur, wr, wc, fr, fq);
        if (!has_next) break;
#pragma unroll
        for (int a = 0; a < 2; ++a)
#pragma unroll
            for (int b = 0; b < 2; ++b)
#pragma unroll
                for (int m = 0; m < 4; ++m)
#pragma unroll
                    for (int n = 0; n < 2; ++n) acc[a][b][m][n] = (f32x4){0.f, 0.f, 0.f, 0.f};
        cur = nxt; cA = nA; cB = nB; ++ui;
    }
    PG8_WAIT_V(0);
    if (wr == 0) PG8_BAR;
    PG8_BAR;
#undef PG8_SA
#undef PG8_SB
#undef PG8_STAGE
#undef PG8_LDA
#undef PG8_LDB
#undef PG8_MMA
#undef PG8_WAIT_V
#undef PG8_WAIT_L
#undef PG8_BAR
#undef PG8_SCHED
}
}
using pg8::Unit;
typedef const f32x4 (&AccRef)[2][2][4][2];

#define EPI_LOOP_BEGIN \
    _Pragma("unroll") for (int ai = 0; ai < 2; ++ai) _Pragma("unroll") for (int m = 0; m < 4; ++m) { \
        const int row = u.pm * 256 + ai * 128 + wr * 64 + m * 16 + fr; \
        _Pragma("unroll") for (int bj = 0; bj < 2; ++bj) { \
            const int col = u.pn * 256 + bj * 128 + wc * 32 + 8 * fq; \
            const f32x4 v0 = acc[ai][bj][m][0], v1 = acc[ai][bj][m][1];
#define EPI_LOOP_END } }

struct EpiZ {
    h16 *zc, *zr, *zg;
    __device__ __forceinline__ void operator()(AccRef acc, const Unit& u, int wr, int wc, int fr, int fq) const {
        const int colt = u.pn * 256; h16* base; int ld, c0;
        if (colt < 1536) { base = zc; ld = 1536; c0 = colt; } else if (colt < 3328) { base = zr; ld = 1792; c0 = colt - 1536; } else { base = zg; ld = 2048; c0 = colt - 3328; }
        EPI_LOOP_BEGIN
            *(h16x8*)(base + (size_t)row * ld + (col - colt + c0)) = pack8(v0, v1);
        EPI_LOOP_END
    }
};
struct EpiF16 {
    h16* O; int ld;
    __device__ __forceinline__ void operator()(AccRef acc, const Unit& u, int wr, int wc, int fr, int fq) const {
        EPI_LOOP_BEGIN
            *(h16x8*)(O + (size_t)row * ld + col) = pack8(v0, v1);
        EPI_LOOP_END
    }
};
struct EpiYA {
    const h16* zg; float* tmp;
    __device__ __forceinline__ void operator()(AccRef acc, const Unit& u, int wr, int wc, int fr, int fq) const {
        EPI_LOOP_BEGIN
            const h16x8 gv = *(const h16x8*)(zg + (size_t)row * 2048 + col);
            f32x4 o0, o1;
#pragma unroll
            for (int j = 0; j < 4; ++j) { o0[j] = sigmoidf_((float)gv[j]) * v0[j]; o1[j] = sigmoidf_((float)gv[4 + j]) * v1[j]; }
            float* p = tmp + (size_t)row * 1024 + col;
            *(f32x4*)p = o0; *(f32x4*)(p + 4) = o1;
        EPI_LOOP_END
    }
};
struct EpiYB {
    const h16* zg; const float* tmp; h16* merged;
    __device__ __forceinline__ void operator()(AccRef acc, const Unit& u, int wr, int wc, int fr, int fq) const {
        EPI_LOOP_BEGIN
            const h16x8 gv = *(const h16x8*)(zg + (size_t)row * 2048 + 1024 + col);
            const float* p = tmp + (size_t)row * 1024 + col;
            f32x4 o0 = *(const f32x4*)p, o1 = *(const f32x4*)(p + 4);
#pragma unroll
            for (int j = 0; j < 4; ++j) { o0[j] += sigmoidf_((float)gv[j]) * v0[j]; o1[j] += sigmoidf_((float)gv[4 + j]) * v1[j]; }
            *(h16x8*)(merged + (size_t)row * 1024 + col) = pack8(o0, o1);
        EPI_LOOP_END
    }
};
struct EpiH1 {
    const float* x; float* out; h16* hb; float* part;
    __device__ __forceinline__ void operator()(AccRef acc, const Unit& u, int wr, int wc, int fr, int fq) const {
#pragma unroll
        for (int ai = 0; ai < 2; ++ai)
#pragma unroll
            for (int m = 0; m < 4; ++m) {
                const int row = u.pm * 256 + ai * 128 + wr * 64 + m * 16 + fr; float ss = 0.f;
#pragma unroll
                for (int bj = 0; bj < 2; ++bj) {
                    const int col = u.pn * 256 + bj * 128 + wc * 32 + 8 * fq;
                    const float* xp = x + (size_t)row * 1024 + col;
                    f32x4 o0 = *(const f32x4*)xp + acc[ai][bj][m][0], o1 = *(const f32x4*)(xp + 4) + acc[ai][bj][m][1];
                    float* op = out + (size_t)row * 1024 + col;
                    *(f32x4*)op = o0; *(f32x4*)(op + 4) = o1;
                    *(h16x8*)(hb + (size_t)row * 1024 + col) = pack8(o0, o1);
                    ss += (o0[0] * o0[0] + o0[1] * o0[1]) + (o0[2] * o0[2] + o0[3] * o0[3]) + (o1[0] * o1[0] + o1[1] * o1[1]) + (o1[2] * o1[2] + o1[3] * o1[3]);
                }
                ss += __shfl_xor(ss, 16); ss += __shfl_xor(ss, 32);
                if (fq == 0) part[(size_t)row * 16 + u.pn * 4 + wc] = ss;
            }
    }
};
struct EpiGate {
    float* out; const h16* pp; const float* rs2; float* part;
    __device__ __forceinline__ void operator()(AccRef acc, const Unit& u, int wr, int wc, int fr, int fq) const {
#pragma unroll
        for (int ai = 0; ai < 2; ++ai)
#pragma unroll
            for (int m = 0; m < 4; ++m) {
                const int row = u.pm * 256 + ai * 128 + wr * 64 + m * 16 + fr; float ss = 0.f;
                const f32x4 sa = *(const f32x4*)(rs2 + (size_t)row * 8), sb = *(const f32x4*)(rs2 + (size_t)row * 8 + 4);
                const float rs = rsqrtf(((sa[0] + sa[1]) + (sa[2] + sa[3]) + (sb[0] + sb[1]) + (sb[2] + sb[3])) * (1.f / 1024.f) + NORM_EPS);
#pragma unroll
                for (int bj = 0; bj < 2; ++bj) {
                    const int col = u.pn * 256 + bj * 128 + wc * 32 + 8 * fq;
                    float* op = out + (size_t)row * 1024 + col;
                    f32x4 o0 = *(const f32x4*)op, o1 = *(const f32x4*)(op + 4);
                    const h16x8 pv = *(const h16x8*)(pp + (size_t)row * 1024 + col);
                    const f32x4 v0 = acc[ai][bj][m][0], v1 = acc[ai][bj][m][1];
#pragma unroll
                    for (int j = 0; j < 4; ++j) { o0[j] += sigmoidf_(rs * v0[j]) * (float)pv[j]; o1[j] += sigmoidf_(rs * v1[j]) * (float)pv[4 + j]; }
                    *(f32x4*)op = o0; *(f32x4*)(op + 4) = o1;
                    ss += (o0[0] * o0[0] + o0[1] * o0[1]) + (o0[2] * o0[2] + o0[3] * o0[3]) + (o1[0] * o1[0] + o1[1] * o1[1]) + (o1[2] * o1[2] + o1[3] * o1[3]);
                }
                ss += __shfl_xor(ss, 16); ss += __shfl_xor(ss, 32);
                if (fq == 0) part[(size_t)row * 16 + u.pn * 4 + wc] = ss;
            }
    }
};

__device__ __forceinline__ void tr_item(const float* W, int N, const float* g, h16* WT, int ldk, int koff, int k0, int n0, LAS float* scr, int lane) {
#pragma unroll 8
    for (int i = 0; i < 32; ++i) { const int kk = 2 * i + (lane >> 5); float v = W[(size_t)(k0 + kk) * N + n0 + (lane & 31)]; if (g) v *= g[k0 + kk]; scr[kk * 33 + (lane & 31)] = v; }
    asm volatile("s_waitcnt lgkmcnt(0)" ::: "memory");
    const int c = lane & 7;
#pragma unroll
    for (int j = 0; j < 4; ++j) { const int n = (lane >> 3) + 8 * j; const LAS float* s = scr + (8 * c) * 33 + n;
        h16x8 o;
#pragma unroll
        for (int e = 0; e < 8; ++e) o[e] = (h16)s[e * 33];
        *(h16x8*)(WT + (size_t)(n0 + n) * ldk + koff + k0 + 8 * c) = o; }
    asm volatile("s_waitcnt lgkmcnt(0)" ::: "memory");
}
struct TrJob { const float* W; const float* g; h16* WT; int K, N, ldk, koff; };

__device__ __forceinline__ void phase_prep(const Args& a, LAS unsigned char* lds) {
    const int tid = tid_(), lane = tid & 63, wave = tid >> 6;
    const int gw = blockIdx.x * NWAVES + wave, NGW = gridDim.x * NWAVES;
    unsigned char* ws = a.ws;
    {
        LAS float* scr = (LAS float*)(lds + wave * 8704);
        TrJob jobs[9] = {
            {a.in[3], a.in[2], (h16*)(ws + O_WIN), 1024, NIN, 1024, 0},
            {a.in[17], nullptr, (h16*)(ws + O_WA), 512, 1024, 512, 0},
            {a.in[18], nullptr, (h16*)(ws + O_WB), 512, 1024, 512, 0},
            {a.in[19], nullptr, (h16*)(ws + O_WO), 1024, 1024, 1024, 0},
            {a.in[26], a.in[25], (h16*)(ws + O_WG), 1024, 1024, 1024, 0},
            {a.in[27], nullptr, (h16*)(ws + O_WP), 256, 1024, 256, 0},
            {a.in[8], nullptr, (h16*)(ws + O_WLR), 64, 512, 256, 0},
            {a.in[10], nullptr, (h16*)(ws + O_WLR) + (size_t)512 * 256, 64, 512, 256, 64},
            {a.in[11], nullptr, (h16*)(ws + O_WLR) + (size_t)1024 * 256, 128, 512, 256, 128},
        };
        int base = 0;
#pragma unroll
        for (int j = 0; j < 9; ++j) {
            const TrJob J = jobs[j]; const int nnb = J.N / 32, items = (J.K / 64) * nnb;
            int first = gw - (base % NGW); if (first < 0) first += NGW;
            for (int r = first; r < items; r += NGW) tr_item(J.W, J.N, J.g, J.WT, J.ldk, J.koff, (r / nnb) * 64, (r % nnb) * 32, scr, lane);
            base += items;
        }
        h16* wlr = (h16*)(ws + O_WLR);
        for (int i = blockIdx.x * NTHREADS + tid; i < 1536 * 256 / 8; i += gridDim.x * NTHREADS) {
            const int n = (i * 8) / 256, k = (i * 8) % 256; const int blk = n / 512;
            const bool inblk = (blk == 0) ? (k < 64) : (blk == 1) ? (k >= 64 && k < 128) : (k >= 128);
            if (!inblk) { h16x8 z; for (int e = 0; e < 8; ++e) z[e] = (h16)0.f; *(h16x8*)(wlr + (size_t)i * 8) = z; }
        }
    }
    __syncthreads();
    {
        LAS float* LA = (LAS float*)lds;
        LAS float* LB = (LAS float*)(lds + 64 * 129 * 4);
        const float* wq = a.in[21]; const float* sk = a.in[22]; const float* gf = a.in[20];
        h16* wst = (h16*)(ws + O_WS);
        for (int it = blockIdx.x; it < 256; it += gridDim.x) {
            const int g16 = it >> 4, k0 = (it & 15) * 64;
            for (int i = tid; i < 64 * 128; i += NTHREADS) { const int k = i >> 7, d = i & 127; LA[k * 129 + d] = wq[(size_t)(k0 + k) * 2048 + g16 * 128 + d] * gf[k0 + k]; }
            for (int i = tid; i < 128 * 128; i += NTHREADS) { const int n = i >> 7, d = i & 127; LB[n * 129 + d] = sk[((size_t)g16 * 128 + n) * 128 + d]; }
            __syncthreads();
            const int n = tid & 127, kg = tid >> 7;
            float o[16];
#pragma unroll
            for (int j = 0; j < 16; ++j) o[j] = 0.f;
            for (int d = 0; d < 128; ++d) { const float b = LB[n * 129 + d];
#pragma unroll
                for (int j = 0; j < 16; ++j) o[j] += LA[(kg * 16 + j) * 129 + d] * b; }
            h16x8 o0, o1;
#pragma unroll
            for (int j = 0; j < 8; ++j) { o0[j] = (h16)o[j]; o1[j] = (h16)o[8 + j]; }
            h16* dst = wst + (size_t)(g16 * 128 + n) * 1024 + k0 + kg * 16;
            *(h16x8*)dst = o0; *(h16x8*)(dst + 8) = o1;
            __syncthreads();
        }
    }
    {
        const float* gf = a.in[20];
        f32x4 g4[4];
#pragma unroll
        for (int j = 0; j < 4; ++j) g4[j] = *(const f32x4*)(gf + 16 * lane + 4 * j);
        for (int r = gw; r < 2 * 16384; r += NGW) {
            const int tb = r >> 14, e = r & 16383;
            const float* src = (tb ? a.in[24] : a.in[23]) + (size_t)e * 1024 + 16 * lane;
            f32x4 v[4]; float mx = 0.f;
#pragma unroll
            for (int j = 0; j < 4; ++j) { v[j] = *(const f32x4*)(src + 4 * j); if (!tb) v[j] = v[j] * g4[j];
#pragma unroll
                for (int c = 0; c < 4; ++c) mx = fmaxf(mx, fabsf(v[j][c])); }
#pragma unroll
            for (int o = 1; o < 64; o <<= 1) mx = fmaxf(mx, __shfl_xor(mx, o));
            mx = fmaxf(mx, 1e-30f);
            const float sc = 224.0f / mx;
            u32x4 q;
#pragma unroll
            for (int j = 0; j < 4; ++j) { int w = 0; w = __builtin_amdgcn_cvt_pk_fp8_f32(v[j][0] * sc, v[j][1] * sc, w, false); w = __builtin_amdgcn_cvt_pk_fp8_f32(v[j][2] * sc, v[j][3] * sc, w, true); q[j] = (unsigned)w; }
            unsigned char* dst = ws + (tb ? O_V8 : O_U8) + ((size_t)(lane >> 3) * 16384 + e) * 128 + 16 * (lane & 7);
            *(u32x4*)dst = q;
            if (lane == 0) ((float*)(ws + (tb ? O_VSC : O_USC)))[e] = mx * (1.0f / 224.0f);
        }
        if (blockIdx.x == 0 && tid < 32) ((unsigned*)(ws + O_CTR))[tid * 64] = 0u;
        const f32x4* pp = (const f32x4*)a.in[1]; h16x4* dp = (h16x4*)(ws + O_P16);
        const int np4 = MTOK * 256 / 4;
        for (int i = blockIdx.x * NTHREADS + tid; i < np4; i += gridDim.x * NTHREADS) dp[i] = pack4(pp[i]);
    }
    {
        const float* x = a.in[0]; h16* xn = (h16*)(ws + O_XN);
        for (int r = gw; r < MTOK; r += NGW) {
            const f32x4* xr = (const f32x4*)(x + (size_t)r * 1024) + lane;
            f32x4 v[4]; float s = 0.f;
#pragma unroll
            for (int j = 0; j < 4; ++j) { v[j] = xr[64 * j]; s += (v[j][0] * v[j][0] + v[j][1] * v[j][1]) + (v[j][2] * v[j][2] + v[j][3] * v[j][3]); }
            const float rs = rsqrtf(wave_sum(s) * (1.f / 1024.f) + NORM_EPS);
            h16x4* o = (h16x4*)(xn + (size_t)r * 1024) + lane;
#pragma unroll
            for (int j = 0; j < 4; ++j) o[64 * j] = pack4(v[j] * rs);
        }
    }
}

__device__ __forceinline__ void phase_conv(const Args& a) {
    const int tid = tid_(), lane = tid & 63, wave = tid >> 6;
    const int gw = blockIdx.x * NWAVES + wave, NGW = gridDim.x * NWAVES;
    const h16* zc = (const h16*)(a.ws + O_ZC); h16* ca = (h16*)(a.ws + O_CA);
    const float* cw = a.in[4]; const float* cb = a.in[5];
    float w0[8], w1[8], w2[8], bb[8];
#pragma unroll
    for (int j = 0; j < 8; ++j) { const int c = lane * 8 + j; w0[j] = cw[c]; w1[j] = cw[512 + c]; w2[j] = cw[1024 + c]; bb[j] = cb[c]; }
    for (int run = gw; run < MTOK / 32; run += NGW) {
        const int t0 = run * 32;
        float u1[8], u2[8];
        if ((t0 % SEQ) == 0) {
#pragma unroll
            for (int j = 0; j < 8; ++j) { u1[j] = 0.f; u2[j] = 0.f; }
        } else {
            const h16x8 c1 = *(const h16x8*)(zc + (size_t)(t0 - 1) * 1536 + 512 + lane * 8), x1 = *(const h16x8*)(zc + (size_t)(t0 - 1) * 1536 + 1024 + lane * 8);
            const h16x8 c2 = *(const h16x8*)(zc + (size_t)(t0 - 2) * 1536 + 512 + lane * 8), x2 = *(const h16x8*)(zc + (size_t)(t0 - 2) * 1536 + 1024 + lane * 8);
#pragma unroll
            for (int j = 0; j < 8; ++j) { u1[j] = (float)c1[j] * (float)x1[j]; u2[j] = (float)c2[j] * (float)x2[j]; }
        }
        for (int t = t0; t < t0 + 32; ++t) {
            const h16* zrow = zc + (size_t)t * 1536 + lane * 8;
            const h16x8 gb = *(const h16x8*)zrow, gc = *(const h16x8*)(zrow + 512), xi = *(const h16x8*)(zrow + 1024);
            h16x8 o;
#pragma unroll
            for (int j = 0; j < 8; ++j) { const float u0 = (float)gc[j] * (float)xi[j];
                const float y = w0[j] * u2[j] + w1[j] * u1[j] + w2[j] * u0 + bb[j];
                o[j] = (h16)((float)gb[j] * y); u2[j] = u1[j]; u1[j] = u0; }
            *(h16x8*)(ca + (size_t)t * 512 + lane * 8) = o;
        }
    }
}


__device__ __forceinline__ float tanhf_(float x) { return 1.0f - 2.0f * __builtin_amdgcn_rcpf(1.0f + __expf(2.0f * x)); }
__device__ __forceinline__ void phase_rwkv_prep(const Args& a) {
    const int tid = tid_(), lane = tid & 63, wave = tid >> 6;
    const int gw = blockIdx.x * NWAVES + wave, NGW = gridDim.x * NWAVES;
    const h16* zr = (const h16*)(a.ws + O_ZR);
    h16* R = (h16*)a.out; h16* KS = R + (size_t)MTOK * 512; h16* V = KS + (size_t)MTOK * 512; h16* KK = V + (size_t)MTOK * 512;
    h16* APR = (h16*)(a.ws + O_APR);
    const float* mu = a.in[6]; const float* k_k = a.in[12];
    float mr[8], mk[8], mv[8], mt[8], kk8[8];
#pragma unroll
    for (int j = 0; j < 8; ++j) { const int c = lane * 8 + j; mr[j] = mu[c]; mk[j] = mu[512 + c]; mv[j] = mu[1024 + c]; mt[j] = mu[1536 + (c & 255)]; kk8[j] = k_k[c]; }
    for (int run = gw; run < MTOK / 32; run += NGW) {
        const int t0 = run * 32;
        float pr[8], pk[8], pv[8], pt[8];
        if ((t0 % SEQ) == 0) {
#pragma unroll
            for (int j = 0; j < 8; ++j) { pr[j] = 0.f; pk[j] = 0.f; pv[j] = 0.f; pt[j] = 0.f; }
        } else {
            const h16* zp = zr + (size_t)(t0 - 1) * 1792 + lane * 8;
            const h16x8 a0 = *(const h16x8*)zp, a1 = *(const h16x8*)(zp + 512), a2 = *(const h16x8*)(zp + 1024), a3 = *(const h16x8*)(zr + (size_t)(t0 - 1) * 1792 + 1536 + (lane & 31) * 8);
#pragma unroll
            for (int j = 0; j < 8; ++j) { pr[j] = (float)a0[j]; pk[j] = (float)a1[j]; pv[j] = (float)a2[j]; pt[j] = (float)a3[j]; }
        }
        for (int t = t0; t < t0 + 32; ++t) {
            const h16* zp = zr + (size_t)t * 1792 + lane * 8;
            const h16x8 a0 = *(const h16x8*)zp, a1 = *(const h16x8*)(zp + 512), a2 = *(const h16x8*)(zp + 1024), a3 = *(const h16x8*)(zr + (size_t)t * 1792 + 1536 + (lane & 31) * 8);
            h16x8 orr, ok, ov, okk, ot; float kr[8]; float ss = 0.f;
#pragma unroll
            for (int j = 0; j < 8; ++j) {
                const float zr_ = (float)a0[j], zk_ = (float)a1[j], zv_ = (float)a2[j], zt_ = (float)a3[j];
                const float r = zr_ + mr[j] * (pr[j] - zr_), k = zk_ + mk[j] * (pk[j] - zk_), v = zv_ + mv[j] * (pv[j] - zv_), tl = zt_ + mt[j] * (pt[j] - zt_);
                pr[j] = zr_; pk[j] = zk_; pv[j] = zv_; pt[j] = zt_;
                orr[j] = (h16)r; ok[j] = (h16)k; ov[j] = (h16)v;
                kr[j] = k * kk8[j]; ss += kr[j] * kr[j];
                const float tv = (lane < 8) ? tanhf_(tl) : (lane < 16) ? tl : sigmoidf_(tl);
                ot[j] = (h16)tv;
            }
            ss += __shfl_xor(ss, 1); ss += __shfl_xor(ss, 2); ss += __shfl_xor(ss, 4);
            const float rn = rsqrtf(ss + 1e-12f);
#pragma unroll
            for (int j = 0; j < 8; ++j) okk[j] = (h16)(kr[j] * rn);
            const size_t o = (size_t)t * 512 + lane * 8;
            *(h16x8*)(R + o) = orr; *(h16x8*)(KS + o) = ok; *(h16x8*)(V + o) = ov; *(h16x8*)(KK + o) = okk;
            if (lane < 32) *(h16x8*)(APR + (size_t)t * 256 + lane * 8) = ot;
        }
    }
}

struct EpiLR {
    const float *w0, *a0, *k_a; h16 *WD, *KS, *BD, *GG; const h16* KK;
    __device__ __forceinline__ void operator()(AccRef acc, const Unit& u, int wr, int wc, int fr, int fq) const {
        const int part = u.pn >> 1;
        EPI_LOOP_BEGIN
            const int c = col - part * 512; const size_t o = (size_t)row * 512 + c;
            if (part == 0) {
                const f32x4 b0 = *(const f32x4*)(w0 + c), b1 = *(const f32x4*)(w0 + c + 4); f32x4 o0, o1;
#pragma unroll
                for (int j = 0; j < 4; ++j) { o0[j] = __expf(-0.6065306597126334f * sigmoidf_(b0[j] + v0[j])); o1[j] = __expf(-0.6065306597126334f * sigmoidf_(b1[j] + v1[j])); }
                *(h16x8*)(WD + o) = pack8(o0, o1);
            } else if (part == 1) {
                const f32x4 b0 = *(const f32x4*)(a0 + c), b1 = *(const f32x4*)(a0 + c + 4), ka0 = *(const f32x4*)(k_a + c), ka1 = *(const f32x4*)(k_a + c + 4);
                const h16x8 ks = *(const h16x8*)(KS + o), kk = *(const h16x8*)(KK + o); f32x4 k0, k1, bb0, bb1;
#pragma unroll
                for (int j = 0; j < 4; ++j) { const float aa0 = sigmoidf_(b0[j] + v0[j]), aa1 = sigmoidf_(b1[j] + v1[j]);
                    k0[j] = (float)ks[j] * (1.0f + (aa0 - 1.0f) * ka0[j]); k1[j] = (float)ks[4 + j] * (1.0f + (aa1 - 1.0f) * ka1[j]);
                    bb0[j] = aa0 * (float)kk[j]; bb1[j] = aa1 * (float)kk[4 + j]; }
                *(h16x8*)(KS + o) = pack8(k0, k1); *(h16x8*)(BD + o) = pack8(bb0, bb1);
            } else {
                *(h16x8*)(GG + o) = pack8(v0, v1);
            }
        EPI_LOOP_END
    }
};

constexpr int SC_L = 256, SC_NCH = SEQ / SC_L, SC_NB = 8;
constexpr int SC_STEP_F = 6 * 64;
constexpr int SC_WAVE_BYTES = SC_NB * SC_STEP_F * 4 + SC_NB * 64 * 4;
__device__ __forceinline__ float quad_sum(float v) { v += dpp_<0xB1>(v); v += dpp_<0x4E>(v); return v; }
__device__ __forceinline__ void lds_ld8x2(const LAS float* p, f32x2 (&o)[8]) {
#pragma unroll
    for (int j4 = 0; j4 < 4; ++j4) { const f32x4 t = *(const LAS f32x4*)(p + 4 * j4); o[2 * j4] = (f32x2){t[0], t[1]}; o[2 * j4 + 1] = (f32x2){t[2], t[3]}; }
}
template <int MODE>
__device__ __forceinline__ void scan_wave(const Args& a, LAS unsigned char* lds, int task) {
    const int tid = tid_(), lane = tid & 63, wave = tid >> 6;
    const int q = lane & 3, rg = lane >> 2;
    const int chain = task / SC_NCH, chunk = task % SC_NCH, b = chain >> 3, h = chain & 7;
    const size_t row0 = (size_t)b * SEQ + (size_t)chunk * SC_L;
    const h16* R = (const h16*)a.out; const h16* KS = R + (size_t)MTOK * 512; const h16* V = KS + (size_t)MTOK * 512; const h16* KK = V + (size_t)MTOK * 512;
    const h16* WD = (const h16*)(a.ws + O_WD); const h16* BD = (const h16*)(a.ws + O_BD);
    LAS float* buf = (LAS float*)(lds + wave * SC_WAVE_BYTES);
    LAS float* ybuf = buf + SC_NB * SC_STEP_F;
    constexpr int NA = (MODE == 0) ? 5 : (MODE == 1) ? 3 : 6;
    const h16* gp[NA]; int lo[NA];
#pragma unroll
    for (int j = 0; j < NA; ++j) { const int p = lane + 64 * j, seg = p >> 3, part = p & 7, st = seg / NA, ai = seg % NA;
        const int ar = (MODE == 0 && ai == 4) ? 5 : ai;
        const h16* base = (ar == 0) ? KK : (ar == 1) ? WD : (ar == 2) ? BD : (ar == 3) ? KS : (ar == 4) ? R : V;
        gp[j] = base + (row0 + st) * 512 + h * 64 + part * 8; lo[j] = st * SC_STEP_F + ar * 64 + part * 8; }
    f32x2 s[4][8];
    if (MODE == 0) {
#pragma unroll
        for (int i = 0; i < 4; ++i)
#pragma unroll
            for (int j = 0; j < 8; ++j) s[i][j] = (f32x2){0.f, 0.f};
    } else if (MODE == 1) {
#pragma unroll
        for (int i = 0; i < 4; ++i)
#pragma unroll
            for (int j = 0; j < 8; ++j) s[i][j] = (f32x2){(i == q && 2 * j == rg) ? 1.f : 0.f, (i == q && 2 * j + 1 == rg) ? 1.f : 0.f};
    } else {
        const float* S0 = (const float*)(a.ws + O_SST) + (size_t)task * 4096;
#pragma unroll
        for (int i = 0; i < 4; ++i)
#pragma unroll
            for (int j4 = 0; j4 < 4; ++j4) { const f32x4 t = *(const f32x4*)(S0 + (rg + 16 * i) * 64 + 16 * q + 4 * j4);
                s[i][2 * j4] = (f32x2){t[0], t[1]}; s[i][2 * j4 + 1] = (f32x2){t[2], t[3]}; }
    }
    h16x8 pre[NA];
#pragma unroll
    for (int j = 0; j < NA; ++j) pre[j] = *(const h16x8*)gp[j];
    f32x2 kk[8];
    for (int bt = 0; bt < SC_L / SC_NB; ++bt) {
        LAS float* cb = buf;
#pragma unroll
        for (int j = 0; j < NA; ++j) { f32x4 x0, x1;
#pragma unroll
            for (int e = 0; e < 4; ++e) { x0[e] = (float)pre[j][e]; x1[e] = (float)pre[j][4 + e]; }
            *(LAS f32x4*)(cb + lo[j]) = x0; *(LAS f32x4*)(cb + lo[j] + 4) = x1; }
        if (bt + 1 < SC_L / SC_NB) {
#pragma unroll
            for (int j = 0; j < NA; ++j) pre[j] = *(const h16x8*)(gp[j] + (size_t)(bt + 1) * SC_NB * 512);
        }
        lds_ld8x2(cb + 16 * q, kk);
#pragma unroll 2
        for (int st = 0; st < SC_NB; ++st) {
            const LAS float* sb = cb + st * SC_STEP_F;
            f32x2 w[8], bb[8], kx[8]; float vv[4];
            lds_ld8x2(sb + 64 + 16 * q, w); lds_ld8x2(sb + 128 + 16 * q, bb);
            if (MODE != 1) { lds_ld8x2(sb + 192 + 16 * q, kx);
#pragma unroll
                for (int i = 0; i < 4; ++i) vv[i] = sb[320 + rg + 16 * i]; }
            float us[4];
#pragma unroll
            for (int i = 0; i < 4; ++i) { f32x2 t = s[i][0] * kk[0];
#pragma unroll
                for (int j = 1; j < 8; ++j) t = __builtin_elementwise_fma(s[i][j], kk[j], t);
                us[i] = quad_sum(t[0] + t[1]); }
            if (st + 1 < SC_NB) lds_ld8x2(sb + SC_STEP_F + 16 * q, kk);
            f32x2 rr[8];
            if (MODE == 2) lds_ld8x2(sb + 256 + 16 * q, rr);
#pragma unroll
            for (int i = 0; i < 4; ++i) { const f32x2 nu = (f32x2){-us[i], -us[i]}, v2 = (f32x2){vv[i], vv[i]};
#pragma unroll
                for (int j = 0; j < 8; ++j) { f32x2 t = s[i][j] * w[j]; t = __builtin_elementwise_fma(nu, bb[j], t); if (MODE != 1) t = __builtin_elementwise_fma(v2, kx[j], t); s[i][j] = t; } }
            if (MODE == 2) {
#pragma unroll
                for (int i = 0; i < 4; ++i) { f32x2 t = s[i][0] * rr[0];
#pragma unroll
                    for (int j = 1; j < 8; ++j) t = __builtin_elementwise_fma(s[i][j], rr[j], t);
                    const float y = quad_sum(t[0] + t[1]);
                    if (q == 0) ybuf[st * 64 + rg + 16 * i] = y; }
            }
        }
        if (MODE == 2) {
            const int st = lane >> 3, part = lane & 7; h16x8 o;
#pragma unroll
            for (int e = 0; e < 8; ++e) o[e] = (h16)ybuf[st * 64 + part * 8 + e];
            *(h16x8*)((h16*)(a.ws + O_Y) + (row0 + (size_t)bt * SC_NB + st) * 512 + h * 64 + part * 8) = o;
        }
    }
    if (MODE != 2) {
        float* PQ = (float*)(a.ws + O_PQ) + (size_t)task * 8192 + (MODE == 0 ? 4096 : 0);
#pragma unroll
        for (int i = 0; i < 4; ++i)
#pragma unroll
            for (int j4 = 0; j4 < 4; ++j4) { const int o = (rg + 16 * i) * 64 + 16 * q + 4 * j4;
                *(f32x4*)(PQ + o) = (f32x4){s[i][2 * j4][0], s[i][2 * j4][1], s[i][2 * j4 + 1][0], s[i][2 * j4 + 1][1]}; }
    }
}
template <bool FIRST>
__device__ __forceinline__ void phase_scan(const Args& a, LAS unsigned char* lds) {
    const int wave = tid_() >> 6;
    if (FIRST) {
        for (int t2 = blockIdx.x * NWAVES + wave; t2 < 2 * 64 * SC_NCH; t2 += gridDim.x * NWAVES) {
            if (t2 & 1) scan_wave<1>(a, lds, t2 >> 1); else scan_wave<0>(a, lds, t2 >> 1); }
    } else {
        for (int task = blockIdx.x * NWAVES + wave; task < 64 * SC_NCH; task += gridDim.x * NWAVES) scan_wave<2>(a, lds, task);
    }
}
__device__ __forceinline__ void phase_scan_combine(const Args& a, LAS unsigned char* lds) {
    const int tid = tid_(), row = tid >> 5, cp = tid & 31;
    LAS float* LS = (LAS float*)lds;
    LAS float* LP = (LAS float*)(lds + 8192);
    for (int item = blockIdx.x; item < 64 * 4; item += gridDim.x) {
        const int chain = item >> 2, r0 = (item & 3) * 16;
        const float* PQ0 = (const float*)(a.ws + O_PQ) + (size_t)chain * SC_NCH * 8192;
        f32x2 sr = (f32x2){0.f, 0.f};
        f32x4 pa = *(const f32x4*)(PQ0 + tid * 8), pb = *(const f32x4*)(PQ0 + tid * 8 + 4);
        f32x2 qn = *(const f32x2*)(PQ0 + 4096 + (r0 + row) * 64 + 2 * cp);
        for (int c = 0; c < SC_NCH; ++c) {
            const int task = chain * SC_NCH + c;
            *(f32x2*)((float*)(a.ws + O_SST) + (size_t)task * 4096 + (r0 + row) * 64 + 2 * cp) = sr;
            if (c == SC_NCH - 1) break;
            LAS float* cur = LS + (c & 1) * 1024; LAS float* cp_ = LP + (c & 1) * 4096;
            *(LAS f32x2*)(cur + row * 64 + 2 * cp) = sr;
            *(LAS f32x4*)(cp_ + tid * 8) = pa; *(LAS f32x4*)(cp_ + tid * 8 + 4) = pb;
            f32x2 acc0 = qn, acc1 = (f32x2){0.f, 0.f};
            if (c + 2 < SC_NCH) { const float* Pn = PQ0 + (size_t)(c + 1) * 8192;
                pa = *(const f32x4*)(Pn + tid * 8); pb = *(const f32x4*)(Pn + tid * 8 + 4); qn = *(const f32x2*)(Pn + 4096 + (r0 + row) * 64 + 2 * cp); }
            __syncthreads();
#pragma unroll 16
            for (int k = 0; k < 64; k += 2) {
                const f32x2 sk = *(const LAS f32x2*)(cur + row * 64 + k);
                const f32x2 p0 = *(const LAS f32x2*)(cp_ + k * 64 + 2 * cp), p1 = *(const LAS f32x2*)(cp_ + (k + 1) * 64 + 2 * cp);
                acc0 = __builtin_elementwise_fma((f32x2){sk[0], sk[0]}, p0, acc0); acc1 = __builtin_elementwise_fma((f32x2){sk[1], sk[1]}, p1, acc1);
            }
            sr = acc0 + acc1;
        }
        __syncthreads();
    }
}
__device__ __forceinline__ void phase_rwkv_post(const Args& a) {
    const int tid = tid_(), lane = tid & 63, wave = tid >> 6;
    const int gw = blockIdx.x * NWAVES + wave, NGW = gridDim.x * NWAVES;
    const h16* R = (const h16*)a.out; const h16* KS = R + (size_t)MTOK * 512; const h16* V = KS + (size_t)MTOK * 512;
    const h16* GG = (const h16*)(a.ws + O_GG); const h16* Y = (const h16*)(a.ws + O_Y); h16* YB = (h16*)(a.ws + O_YB);
    float rk[8], lg[8], lb[8];
#pragma unroll
    for (int j = 0; j < 8; ++j) { const int c = lane * 8 + j; rk[j] = a.in[14][c]; lg[j] = a.in[15][c]; lb[j] = a.in[16][c]; }
    for (int t = gw; t < MTOK; t += NGW) {
        const size_t o = (size_t)t * 512 + lane * 8;
        const h16x8 y8 = *(const h16x8*)(Y + o), r8 = *(const h16x8*)(R + o), k8 = *(const h16x8*)(KS + o), v8 = *(const h16x8*)(V + o), g8 = *(const h16x8*)(GG + o);
        float y[8]; float sm = 0.f, bs = 0.f;
#pragma unroll
        for (int j = 0; j < 8; ++j) { y[j] = (float)y8[j]; sm += y[j]; bs += (float)r8[j] * (float)k8[j] * rk[j]; }
        sm += __shfl_xor(sm, 1); sm += __shfl_xor(sm, 2); sm += __shfl_xor(sm, 4);
        bs += __shfl_xor(bs, 1); bs += __shfl_xor(bs, 2); bs += __shfl_xor(bs, 4);
        const float mean = sm * (1.f / 64.f); float vs = 0.f;
#pragma unroll
        for (int j = 0; j < 8; ++j) { y[j] -= mean; vs += y[j] * y[j]; }
        vs += __shfl_xor(vs, 1); vs += __shfl_xor(vs, 2); vs += __shfl_xor(vs, 4);
        const float rstd = rsqrtf(vs * (1.f / 64.f) + 64e-5f);
        h16x8 ov;
#pragma unroll
        for (int j = 0; j < 8; ++j) ov[j] = (h16)((y[j] * rstd * lg[j] + lb[j] + bs * (float)v8[j]) * (float)g8[j]);
        *(h16x8*)(YB + o) = ov;
    }
}


__device__ __forceinline__ void ins16(unsigned (&L)[16], unsigned x) {
#pragma unroll
    for (int j = 0; j < 16; ++j) { const unsigned hi = L[j] > x ? L[j] : x; x = L[j] > x ? x : L[j]; L[j] = hi; }
}
__device__ __forceinline__ unsigned ord32(float f) { const unsigned u = __float_as_uint(f); return (u & 0x80000000u) ? ~u : (u | 0x80000000u); }
__device__ __forceinline__ float unord32(unsigned k) { return __uint_as_float((k & 0x80000000u) ? (k & 0x7fffffffu) : ~k); }
__device__ __forceinline__ void phase_topk(const Args& a, LAS unsigned char* lds) {
    const int tid = tid_();
    const h16* SC = (const h16*)(a.ws + O_SCORES);
    const float* part = (const float*)(a.ws + O_PART1);
    unsigned short* IDX = (unsigned short*)(a.ws + O_IDX); float* GATE = (float*)(a.ws + O_GATE); float* RS1 = (float*)(a.ws + O_RS1);
    LAS unsigned char* LI = lds;
    for (int task = blockIdx.x * NTHREADS + tid; task < MTOK * 8; task += gridDim.x * NTHREADS) {
        const int t = task >> 3, h = task & 7;
        float ssq = 0.f;
#pragma unroll
        for (int j = 0; j < 4; ++j) { const f32x4 p4 = *(const f32x4*)(part + (size_t)t * 16 + 4 * j); ssq += (p4[0] + p4[1]) + (p4[2] + p4[3]); }
        const float rs = rsqrtf(ssq * (1.f / 1024.f) + NORM_EPS);
        if (h == 0) RS1[t] = rs;
        float sv[2][16];
#pragma unroll
        for (int c = 0; c < 2; ++c) {
            unsigned L[16];
#pragma unroll
            for (int j = 0; j < 16; ++j) L[j] = 0u;
            const h16* row = SC + (size_t)t * 2048 + h * 256 + c * 128;
#pragma unroll 2
            for (int n8 = 0; n8 < 16; ++n8) {
                const u32x4 w4 = *(const u32x4*)(row + n8 * 8);
#pragma unroll
                for (int e = 0; e < 8; ++e) {
                    const unsigned bits = (e & 1) ? (w4[e >> 1] >> 16) : (w4[e >> 1] & 0xffffu);
                    const unsigned o16 = (bits & 0x8000u) ? (~bits & 0xffffu) : (bits | 0x8000u);
                    ins16(L, (o16 << 16) | (unsigned)(127 - (n8 * 8 + e)));
                }
            }
#pragma unroll
            for (int j = 0; j < 16; ++j) {
                const unsigned o16 = L[j] >> 16; const unsigned bits = (o16 & 0x8000u) ? (o16 & 0x7fffu) : (~o16 & 0xffffu);
                union { unsigned short u; h16 f; } cv; cv.u = (unsigned short)bits; sv[c][j] = (float)cv.f;
                LI[(c * 16 + j) * 512 + tid] = (unsigned char)(127u - (L[j] & 127u));
            }
        }
        unsigned L[16];
#pragma unroll
        for (int j = 0; j < 16; ++j) L[j] = 0u;
#pragma unroll
        for (int i = 0; i < 16; ++i)
#pragma unroll
            for (int j = 0; j < 16; ++j) if ((i + 1) * (j + 1) <= 16) ins16(L, (ord32(sv[0][i] + sv[1][j]) & ~255u) | (unsigned)(255 - (i * 16 + j)));
        float e[16]; float den = 0.f; const float mx = unord32(L[0] & ~255u) * rs;
        unsigned short id[16];
#pragma unroll
        for (int k = 0; k < 16; ++k) {
            const float v = unord32(L[k] & ~255u) * rs; e[k] = __expf(v - mx); den += e[k];
            const unsigned pos = 255u - (L[k] & 255u); const unsigned i = pos >> 4, j = pos & 15u;
            id[k] = (unsigned short)((unsigned)LI[i * 512 + tid] * 128u + (unsigned)LI[(16 + j) * 512 + tid]);
        }
        const float inv = __builtin_amdgcn_rcpf(den);
        u32x4 i0, i1;
        i0[0] = id[0] | (id[1] << 16); i0[1] = id[2] | (id[3] << 16); i0[2] = id[4] | (id[5] << 16); i0[3] = id[6] | (id[7] << 16);
        i1[0] = id[8] | (id[9] << 16); i1[1] = id[10] | (id[11] << 16); i1[2] = id[12] | (id[13] << 16); i1[3] = id[14] | (id[15] << 16);
        u32x4* ip = (u32x4*)(IDX + (size_t)task * 16); ip[0] = i0; ip[1] = i1;
        f32x4* gp = (f32x4*)(GATE + (size_t)task * 16);
#pragma unroll
        for (int k4 = 0; k4 < 4; ++k4) gp[k4] = (f32x4){e[4 * k4] * inv, e[4 * k4 + 1] * inv, e[4 * k4 + 2] * inv, e[4 * k4 + 3] * inv};
    }
}

__device__ __forceinline__ float gelu_tanh(float x) { const float u = 0.7978845608028654f * (x + 0.044715f * x * x * x); return 0.5f * x * (1.0f + tanhf_(u)); }
__device__ __forceinline__ unsigned xcc_id() { return (unsigned)__builtin_amdgcn_s_getreg((3 << 11) | 20) & 7u; }
constexpr int GA_TC = 32, GA_NCH = MTOK / GA_TC;
__device__ __forceinline__ void dec16(const u32x4 q, float (&o)[16]) {
#pragma unroll
    for (int w = 0; w < 4; ++w) { const f32x2 lo = __builtin_amdgcn_cvt_pk_f32_fp8((int)q[w], false), hi = __builtin_amdgcn_cvt_pk_f32_fp8((int)q[w], true);
        o[4 * w] = lo[0]; o[4 * w + 1] = lo[1]; o[4 * w + 2] = hi[0]; o[4 * w + 3] = hi[1]; }
}
struct GIdx { u32x4 a, b; };
__device__ __forceinline__ GIdx g_ldidx(const unsigned short* IDX, int t, int r8) { const u32x4* ip = (const u32x4*)(IDX + (size_t)t * 128 + 16 * r8); GIdx r; r.a = ip[0]; r.b = ip[1]; return r; }
__device__ __forceinline__ void g_issue8(const unsigned char* TBs, unsigned lo, const u32x4 ix, u32x4 (&q)[8]) {
#pragma unroll
    for (int i = 0; i < 8; ++i) { const unsigned w = ix[i >> 1]; const unsigned e = (i & 1) ? (w >> 16) : (w & 0xffffu); q[i] = *(const u32x4*)(TBs + (e * 128u + lo)); }
}
struct GSide { u32x4 a, b, c, d; };
template <int PH> __device__ __forceinline__ GSide g_ldside(const Args& a, int t, int j, int m, int r8) {
    GSide r;
    if (PH == 0) { const u32x4* xp = (const u32x4*)((const h16*)(a.ws + O_H1B) + (size_t)t * 1024 + 128 * j + 16 * m); r.a = xp[0]; r.b = xp[1]; r.c = r.a; r.d = r.b; }
    else { const u32x4* cp = (const u32x4*)((const float*)(a.ws + O_COEF) + (size_t)t * 128 + 16 * r8); r.a = cp[0]; r.b = cp[1]; r.c = cp[2]; r.d = cp[3]; }
    return r;
}
template <int PH, int HALF> __device__ __forceinline__ void g_half(u32x4 (&q)[8], const GSide& sd, float (&pa)[16]) {
    if (PH == 0) {
        float x[16];
#pragma unroll
        for (int k = 0; k < 8; ++k) { const h16x8 xa = __builtin_bit_cast(h16x8, sd.a), xb = __builtin_bit_cast(h16x8, sd.b); x[k] = (float)xa[k]; x[8 + k] = (float)xb[k]; }
#pragma unroll
        for (int i = 0; i < 8; ++i) { float d[16]; dec16(q[i], d); float s0 = 0.f, s1 = 0.f;
#pragma unroll
            for (int k = 0; k < 8; ++k) { s0 += x[2 * k] * d[2 * k]; s1 += x[2 * k + 1] * d[2 * k + 1]; }
            pa[8 * HALF + i] = s0 + s1; }
    } else {
#pragma unroll
        for (int i = 0; i < 8; ++i) { float d[16]; dec16(q[i], d);
            const float cf = __uint_as_float(HALF == 0 ? (i < 4 ? sd.a[i & 3] : sd.b[i & 3]) : (i < 4 ? sd.c[i & 3] : sd.d[i & 3]));
#pragma unroll
            for (int k = 0; k < 16; ++k) pa[k] += cf * d[k];
            if (i + 1 < 8) asm volatile("" : "+v"(q[i + 1][0]), "+v"(q[i + 1][1]), "+v"(q[i + 1][2]), "+v"(q[i + 1][3]));
        }
    }
}
template <int PH> __device__ __forceinline__ void g_finish(const Args& a, int t, int j, int lane, float (&p)[16]) {
    const int m = lane & 7, r8 = lane >> 3;
    float q8[8], q4[4], q2[2];
    if (PH == 0) {
#pragma unroll
        for (int i = 0; i < 8; ++i) { const float keep = (lane & 4) ? p[i + 8] : p[i], send = (lane & 4) ? p[i] : p[i + 8]; q8[i] = keep + xhm_(send); }
#pragma unroll
        for (int i = 0; i < 4; ++i) { const float keep = (lane & 2) ? q8[i + 4] : q8[i], send = (lane & 2) ? q8[i] : q8[i + 4]; q4[i] = keep + dpp_<0x4E>(send); }
#pragma unroll
        for (int i = 0; i < 2; ++i) { const float keep = (lane & 1) ? q4[i + 2] : q4[i], send = (lane & 1) ? q4[i] : q4[i + 2]; q2[i] = keep + dpp_<0xB1>(send); }
        *(f32x2*)((float*)(a.ws + O_PART) + ((size_t)j * MTOK + t) * 128 + 16 * r8 + 2 * m) = (f32x2){q2[0], q2[1]};
    } else {
#pragma unroll
        for (int i = 0; i < 8; ++i) { const float keep = (lane & 32) ? p[i + 8] : p[i], send = (lane & 32) ? p[i] : p[i + 8]; q8[i] = keep + x32_(send, lane); }
#pragma unroll
        for (int i = 0; i < 4; ++i) { const float keep = (lane & 16) ? q8[i + 4] : q8[i], send = (lane & 16) ? q8[i] : q8[i + 4]; q4[i] = keep + x16_(send, lane); }
#pragma unroll
        for (int i = 0; i < 2; ++i) { const float keep = (lane & 8) ? q4[i + 2] : q4[i], send = (lane & 8) ? q4[i] : q4[i + 2]; q2[i] = keep + x8_(send); }
        const int col = 128 * j + 16 * m + 2 * r8;
        float* op = a.out + (size_t)t * 1024 + col;
        f32x2 hv = *(const f32x2*)op; hv[0] += q2[0]; hv[1] += q2[1];
        *(f32x2*)op = hv;
        *(h16x2*)((h16*)(a.ws + O_H2B) + (size_t)t * 1024 + col) = (h16x2){(h16)hv[0], (h16)hv[1]};
        const float ss = wave_sum(hv[0] * hv[0] + hv[1] * hv[1]);
        if (lane == 0) ((float*)(a.ws + O_SS2))[(size_t)t * 8 + j] = ss;
    }
}
template <int PH>
__device__ __forceinline__ void phase_gather(const Args& a, int cset) {
    const int tid = tid_(), lane = tid & 63, m = lane & 7, r8 = lane >> 3;
    unsigned* ctr = (unsigned*)(a.ws + O_CTR) + cset * 8 * 64;
    const unsigned short* IDX = (const unsigned short*)(a.ws + O_IDX);
    const unsigned j0 = xcc_id();
    for (unsigned dj = 0; dj < 8; ++dj) {
        const unsigned j = (j0 + dj) & 7u;
        const unsigned char* TB = a.ws + (PH ? O_V8 : O_U8) + (size_t)j * 16384 * 128; const unsigned lo16 = 16u * (unsigned)m;
        for (;;) {
            unsigned c = 0; if (lane == 0) c = __hip_atomic_fetch_add(ctr + j * 64, 1u, __ATOMIC_RELAXED, __HIP_MEMORY_SCOPE_AGENT);
            c = (unsigned)__builtin_amdgcn_readfirstlane((int)c);
            if (c >= (unsigned)GA_NCH) break;
            const int t0 = c * GA_TC;
            u32x4 qa[8], qb[8]; GSide sd, sn; GIdx ix, ixn;
            ix = g_ldidx(IDX, t0, r8); g_issue8(TB, lo16, ix.a, qa); sd = g_ldside<PH>(a, t0, j, m, r8);
#pragma unroll 1
            for (int ti = 0; ti < GA_TC; ++ti) {
                const int t = t0 + ti, tn = (ti + 1 < GA_TC) ? t + 1 : t;
                g_issue8(TB, lo16, ix.b, qb); ixn = g_ldidx(IDX, tn, r8); sn = g_ldside<PH>(a, tn, j, m, r8);
                float p[16];
                if (PH == 1) {
#pragma unroll
                    for (int k = 0; k < 16; ++k) p[k] = 0.f;
                }
                g_half<PH, 0>(qa, sd, p);
                g_issue8(TB, lo16, ixn.a, qa);
                g_half<PH, 1>(qb, sd, p);
                g_finish<PH>(a, t, j, lane, p);
                ix = ixn; sd = sn;
            }
        }
    }
}
__device__ __forceinline__ void phase_coef(const Args& a) {
    const int tid = tid_();
    const float* PART = (const float*)(a.ws + O_PART); const unsigned short* IDX = (const unsigned short*)(a.ws + O_IDX);
    const float* GATE = (const float*)(a.ws + O_GATE); const float* RS1 = (const float*)(a.ws + O_RS1);
    const float* USC = (const float*)(a.ws + O_USC); const float* VSC = (const float*)(a.ws + O_VSC); float* COEF = (float*)(a.ws + O_COEF);
    for (int i = blockIdx.x * NTHREADS + tid; i < MTOK * 128; i += gridDim.x * NTHREADS) {
        float s = 0.f;
#pragma unroll
        for (int j = 0; j < 8; ++j) s += PART[(size_t)j * MTOK * 128 + i];
        const unsigned e = IDX[i];
        COEF[i] = GATE[i] * gelu_tanh(RS1[i >> 7] * USC[e] * s) * VSC[e];
    }
}

__device__ __forceinline__ void phase_final(const Args& a) {
    const int tid = tid_(), lane = tid & 63, wave = tid >> 6;
    const int gw = blockIdx.x * NWAVES + wave, NGW = gridDim.x * NWAVES;
    const float* part = (const float*)(a.ws + O_PART3); const float* fg = a.in[28];
    f32x4 g4[4];
#pragma unroll
    for (int j = 0; j < 4; ++j) g4[j] = *((const f32x4*)fg + lane + 64 * j);
    for (int r = gw; r < MTOK; r += NGW) {
        float s = (lane < 16) ? part[(size_t)r * 16 + lane] : 0.f;
        s = wave_sum(s);
        const float rs = rsqrtf(s * (1.f / 1024.f) + NORM_EPS);
        f32x4* xr = (f32x4*)(a.out + (size_t)r * 1024) + lane;
#pragma unroll
        for (int j = 0; j < 4; ++j) xr[64 * j] = xr[64 * j] * rs * g4[j];
    }
}

constexpr int NPHASE = 19;
__global__ void __launch_bounds__(NTHREADS, 2) mk(Args a) {
    extern __shared__ __attribute__((aligned(16))) unsigned char smem[];
    LAS unsigned char* lds = (LAS unsigned char*)smem;
    unsigned char* ws = a.ws;
#if ONE_LAUNCH
    cg::grid_group grid = cg::this_grid();
#define SYNC() grid.sync()
#else
#define SYNC() do {} while (0)
#endif
#define IN(k) (a.ph_lo <= (k) && (k) < a.ph_hi)
#define SEAM(k) do { if (IN(k) && IN((k) + 1)) SYNC(); } while (0)
#define REPS(k) ((((REP_MASK) >> (k)) & 1u) ? 2 : 1)
    const int G = gridDim.x, bid = blockIdx.x;
    if (IN(0)) for (int rep = 0; rep < REPS(0); ++rep) { if (rep) SYNC(); phase_prep(a, lds); } SEAM(0);
    if (IN(1)) for (int rep = 0; rep < REPS(1); ++rep) { if (rep) SYNC(); pg8::Gemm g{(const h16*)(ws + O_XN), (const h16*)(ws + O_WIN), MTOK, NIN, 1024}; pg8::StaticOrder S; S.init(MTOK, NIN, G, bid);
        EpiZ E{(h16*)(ws + O_ZC), (h16*)(ws + O_ZR), (h16*)(ws + O_ZG)}; pg8::gemm_phase(lds, g, S, E); } SEAM(1);
    if (IN(2)) for (int rep = 0; rep < REPS(2); ++rep) { if (rep) SYNC(); phase_conv(a); phase_rwkv_prep(a); } SEAM(2);
    if (IN(3)) for (int rep = 0; rep < REPS(3); ++rep) { if (rep) SYNC(); pg8::Gemm g{(const h16*)(ws + O_APR), (const h16*)(ws + O_WLR), MTOK, 1536, 256}; pg8::StaticOrder S; S.init(MTOK, 1536, G, bid);
        h16* R = (h16*)a.out; h16* KS = R + (size_t)MTOK * 512; h16* KK = KS + (size_t)2 * MTOK * 512;
        EpiLR E{a.in[7], a.in[9], a.in[13], (h16*)(ws + O_WD), KS, (h16*)(ws + O_BD), (h16*)(ws + O_GG), KK}; pg8::gemm_phase(lds, g, S, E); } SEAM(3);
    if (IN(4)) for (int rep = 0; rep < REPS(4); ++rep) { if (rep) SYNC(); phase_scan<true>(a, lds); } SEAM(4);
    if (IN(5)) for (int rep = 0; rep < REPS(5); ++rep) { if (rep) SYNC(); phase_scan_combine(a, lds); } SEAM(5);
    if (IN(6)) for (int rep = 0; rep < REPS(6); ++rep) { if (rep) SYNC(); phase_scan<false>(a, lds); } SEAM(6);
    if (IN(7)) for (int rep = 0; rep < REPS(7); ++rep) { if (rep) SYNC(); phase_rwkv_post(a); } SEAM(7);
    if (IN(8)) for (int rep = 0; rep < REPS(8); ++rep) { if (rep) SYNC(); pg8::Gemm g{(const h16*)(ws + O_CA), (const h16*)(ws + O_WA), MTOK, 1024, 512}; pg8::StaticOrder S; S.init(MTOK, 1024, G, bid);
        EpiYA E{(const h16*)(ws + O_ZG), a.out}; pg8::gemm_phase(lds, g, S, E); } SEAM(8);
    if (IN(9)) for (int rep = 0; rep < REPS(9); ++rep) { if (rep) SYNC(); pg8::Gemm g{(const h16*)(ws + O_YB), (const h16*)(ws + O_WB), MTOK, 1024, 512}; pg8::StaticOrder S; S.init(MTOK, 1024, G, bid);
        EpiYB E{(const h16*)(ws + O_ZG), a.out, (h16*)(ws + O_MERGED)}; pg8::gemm_phase(lds, g, S, E); } SEAM(9);
    if (IN(10)) for (int rep = 0; rep < REPS(10); ++rep) { if (rep) SYNC(); pg8::Gemm g{(const h16*)(ws + O_MERGED), (const h16*)(ws + O_WO), MTOK, 1024, 1024}; pg8::StaticOrder S; S.init(MTOK, 1024, G, bid);
        EpiH1 E{a.in[0], a.out, (h16*)(ws + O_H1B), (float*)(ws + O_PART1)}; pg8::gemm_phase(lds, g, S, E); } SEAM(10);
    if (IN(11)) for (int rep = 0; rep < REPS(11); ++rep) { if (rep) SYNC(); pg8::Gemm g{(const h16*)(ws + O_H1B), (const h16*)(ws + O_WS), MTOK, 2048, 1024}; pg8::StaticOrder S; S.init(MTOK, 2048, G, bid);
        EpiF16 E{(h16*)(ws + O_SCORES), 2048}; pg8::gemm_phase(lds, g, S, E); } SEAM(11);
    if (IN(12)) for (int rep = 0; rep < REPS(12); ++rep) { if (rep) SYNC(); phase_topk(a, lds); } SEAM(12);
    if (IN(13)) for (int rep = 0; rep < REPS(13); ++rep) { if (rep) SYNC(); phase_gather<0>(a, 2 * rep); } SEAM(13);
    if (IN(14)) for (int rep = 0; rep < REPS(14); ++rep) { if (rep) SYNC(); phase_coef(a); } SEAM(14);
    if (IN(15)) for (int rep = 0; rep < REPS(15); ++rep) { if (rep) SYNC(); phase_gather<1>(a, 1); } SEAM(15);
    if (IN(16)) for (int rep = 0; rep < REPS(16); ++rep) { if (rep) SYNC(); pg8::Gemm g{(const h16*)(ws + O_P16), (const h16*)(ws + O_WP), MTOK, 1024, 256}; pg8::StaticOrder S; S.init(MTOK, 1024, G, bid);
        EpiF16 E{(h16*)(ws + O_PP), 1024}; pg8::gemm_phase(lds, g, S, E); } SEAM(16);
    if (IN(17)) for (int rep = 0; rep < REPS(17); ++rep) { if (rep) SYNC(); pg8::Gemm g{(const h16*)(ws + O_H2B), (const h16*)(ws + O_WG), MTOK, 1024, 1024}; pg8::StaticOrder S; S.init(MTOK, 1024, G, bid);
        EpiGate E{a.out, (const h16*)(ws + O_PP), (const float*)(ws + O_SS2), (float*)(ws + O_PART3)}; pg8::gemm_phase(lds, g, S, E); } SEAM(17);
    if (IN(18)) for (int rep = 0; rep < REPS(18); ++rep) { if (rep) SYNC(); phase_final(a); }
}

extern "C" void kernel_launch(void* const* d_in, const int* in_sizes, int n_in, void* d_out, int out_size, void* d_ws, size_t ws_size, hipStream_t stream) {
    static int ready = 0;
    if (!ready) {
        if (n_in != 29 || ws_size < WS_END) { fprintf(stderr, "kernel_launch: unexpected n_in %d / ws %zu (need %zu)\n", n_in, ws_size, (size_t)WS_END); ready = -1; return; }
        if (hipFuncSetAttribute((const void*)mk, hipFuncAttributeMaxDynamicSharedMemorySize, LDS_BYTES) != hipSuccess) { fprintf(stderr, "hipFuncSetAttribute failed\n"); ready = -1; return; }
        ready = 1;
    }
    if (ready < 0) return;
    Args a{};
    for (int i = 0; i < 29; ++i) a.in[i] = (const float*)d_in[i];
    a.out = (float*)d_out; a.ws = (unsigned char*)d_ws;
#if ONE_LAUNCH
    a.ph_lo = 0; a.ph_hi = NPHASE;
    void* args[] = {&a};
    hipLaunchCooperativeKernel((const void*)mk, dim3(NBLK), dim3(NTHREADS), args, LDS_BYTES, stream);
#else
    const int phases[] = {0, 1, 2, 3, 4, 5, 6, 7, 8, 9, 10, 11, 12, 13, 14, 15, 16, 17, 18};
    for (int ph : phases) { a.ph_lo = ph; a.ph_hi = ph + 1; hipLaunchKernelGGL(mk, dim3(NBLK), dim3(NTHREADS), LDS_BYTES, stream, a); }
#endif
}
```

```cpp
#include <hip/hip_runtime.h>
#include <hip/hip_cooperative_groups.h>
#include <cstdio>
namespace cg = cooperative_groups;

#ifndef REP_MASK
#define REP_MASK 0u
#endif
#ifndef ONE_LAUNCH
#define ONE_LAUNCH 1
#endif

#define LAS __attribute__((address_space(3)))
typedef _Float16 h16;
typedef _Float16 h16x8 __attribute__((ext_vector_type(8)));
typedef _Float16 h16x4 __attribute__((ext_vector_type(4)));
typedef _Float16 h16x2 __attribute__((ext_vector_type(2)));
typedef float f32x4 __attribute__((ext_vector_type(4)));
typedef float f32x2 __attribute__((ext_vector_type(2)));
typedef unsigned u32x4 __attribute__((ext_vector_type(4)));
typedef unsigned u32x2 __attribute__((ext_vector_type(2)));

constexpr int MTOK = 65536, DM = 1024, SEQ = 8192, NB = 8;
constexpr int NIN = 5376;
constexpr int NTHREADS = 512, NWAVES = 8, NBLK = 256;
constexpr int LDS_BYTES = 131072 + 64;
constexpr float NORM_EPS = 1e-6f;

constexpr size_t MiB = 1u << 20;
constexpr size_t O_WIN = 0;
constexpr size_t O_WA = O_WIN + (size_t)5376 * 1024 * 2;
constexpr size_t O_WB = O_WA + 1 * MiB;
constexpr size_t O_WO = O_WB + 1 * MiB;
constexpr size_t O_WG = O_WO + 2 * MiB;
constexpr size_t O_WP = O_WG + 2 * MiB;
constexpr size_t O_WLR = O_WP + MiB / 2;
constexpr size_t O_WS = O_WLR + 3 * MiB / 4;
constexpr size_t O_U16 = O_WS + 4 * MiB;
constexpr size_t O_V16 = O_U16 + 32 * MiB;
constexpr size_t O_P16 = O_V16 + 32 * MiB;
constexpr size_t O_PART1 = O_P16 + 32 * MiB;
constexpr size_t O_PART3 = O_PART1 + 4 * MiB;
constexpr size_t O_RS1 = O_PART3 + 4 * MiB;
constexpr size_t O_RS2 = O_RS1 + MiB / 4;
constexpr size_t O_XN = O_RS2 + MiB / 4;
constexpr size_t O_ZC = O_XN + 128 * MiB;
constexpr size_t O_ZR = O_ZC + 192 * MiB;
constexpr size_t O_ZG = O_ZR + 224 * MiB;
constexpr size_t O_SS2 = O_ZG + 256 * MiB;
constexpr size_t O_USC = O_SS2 + 2 * MiB;
constexpr size_t O_VSC = O_USC + 65536;
constexpr size_t O_CTR = O_VSC + 65536;
constexpr size_t O_BAR = O_CTR + 8192;
constexpr size_t WS_END = O_BAR + 16384;
constexpr size_t O_U8 = O_U16;
constexpr size_t O_V8 = O_U16 + 16 * MiB;
constexpr size_t O_PART = O_ZG;
constexpr size_t O_COEF = O_ZR + 48 * MiB;
constexpr size_t O_CA = O_XN;
constexpr size_t O_APR = O_XN + 64 * MiB;
constexpr size_t O_H1B = O_XN;
constexpr size_t O_WD = O_ZC;
constexpr size_t O_BD = O_ZC + 64 * MiB;
constexpr size_t O_GG = O_ZC + 128 * MiB;
constexpr size_t O_MERGED = O_ZC;
constexpr size_t O_H2B = O_ZC;
constexpr size_t O_PQ = O_ZR;
constexpr size_t O_SST = O_ZR + 64 * MiB;
constexpr size_t O_Y = O_ZR + 96 * MiB;
constexpr size_t O_YB = O_ZR + 160 * MiB;
constexpr size_t O_IDX = O_ZR;
constexpr size_t O_GATE = O_ZR + 16 * MiB;
constexpr size_t O_PP = O_ZR + 64 * MiB;
constexpr size_t O_SCORES = O_ZG;

struct Args {
    const float* in[29];
    float* out;
    unsigned char* ws;
    int ph_lo, ph_hi;
};

__device__ __forceinline__ int tid_() { int t = threadIdx.x; asm volatile("" : "+v"(t)); return t; }
__device__ __forceinline__ float sigmoidf_(float x) { return __builtin_amdgcn_rcpf(1.0f + __expf(-x)); }
template <int CTRL> __device__ __forceinline__ float dpp_(float v) { return __builtin_bit_cast(float, __builtin_amdgcn_update_dpp(0, __builtin_bit_cast(int, v), CTRL, 0xF, 0xF, true)); }
__device__ __forceinline__ float x32_(float v, int lane) { const auto r = __builtin_amdgcn_permlane32_swap(__builtin_bit_cast(unsigned, v), __builtin_bit_cast(unsigned, v), false, false); return __builtin_bit_cast(float, (lane & 32) ? r[0] : r[1]); }
__device__ __forceinline__ float x16_(float v, int lane) { const auto r = __builtin_amdgcn_permlane16_swap(__builtin_bit_cast(unsigned, v), __builtin_bit_cast(unsigned, v), false, false); return __builtin_bit_cast(float, (lane & 16) ? r[0] : r[1]); }
__device__ __forceinline__ float x8_(float v) { return dpp_<0x128>(v); }
__device__ __forceinline__ float xhm_(float v) { return dpp_<0x141>(v); }
__device__ __forceinline__ float wave_sum(float v) {
    const int lane = threadIdx.x & 63;
    v += dpp_<0xB1>(v); v += dpp_<0x4E>(v); v += dpp_<0x141>(v); v += dpp_<0x140>(v);
    v += x16_(v, lane); v += x32_(v, lane);
    return v;
}
__device__ __forceinline__ h16x8 pack8(f32x4 a, f32x4 b) {
    h16x8 r;
    r[0] = (h16)a[0]; r[1] = (h16)a[1]; r[2] = (h16)a[2]; r[3] = (h16)a[3];
    r[4] = (h16)b[0]; r[5] = (h16)b[1]; r[6] = (h16)b[2]; r[7] = (h16)b[3];
    return r;
}
__device__ __forceinline__ h16x4 pack4(f32x4 a) {
    h16x4 r; r[0] = (h16)a[0]; r[1] = (h16)a[1]; r[2] = (h16)a[2]; r[3] = (h16)a[3]; return r;
}

#define XB_TMO      128
#define XB_XCNT(j)  (256  + 64 * (j))
#define XB_XSUB(j)  (1280 + 64 * (j))
#define XB_XGEN(j)  (2304 + 64 * (j))
#define XB_TOP      3328
#define XB_TOPGEN   3392
#define XCD_BAR_WORDS 3456
#define XB_SPIN_CAP (1u << 18)

__device__ __forceinline__ unsigned xb_ld(unsigned* p)              { return __hip_atomic_load(p, __ATOMIC_RELAXED, __HIP_MEMORY_SCOPE_AGENT); }
__device__ __forceinline__ unsigned xb_add(unsigned* p, unsigned v) { return __hip_atomic_fetch_add(p, v, __ATOMIC_RELAXED, __HIP_MEMORY_SCOPE_AGENT); }
__device__ __forceinline__ unsigned xb_xcc_id() { return (unsigned)__builtin_amdgcn_s_getreg((3 << 11) | 20) & 0xFu; }
#define XB_SPIN(cond, bar) do { unsigned _sp = 0; while (cond) { __builtin_amdgcn_s_sleep(1); \
    if ((++_sp & 255u) == 0u) { if (xb_ld(&(bar)[XB_TMO])) break; if (_sp > XB_SPIN_CAP) { atomicAdd(&(bar)[XB_TMO], 1u); break; } } } } while (0)

struct XcdBarrier {
    unsigned* bar; unsigned x;
    volatile LAS unsigned* st;
};

__device__ __forceinline__ XcdBarrier xcd_barrier_post(unsigned* bar, volatile LAS unsigned* st) {
    XcdBarrier b; b.bar = bar; b.x = xb_xcc_id(); b.st = st;
    if (threadIdx.x == 0) (void)xb_add(&bar[XB_XCNT(b.x)], 1u);
    return b;
}
__device__ __forceinline__ void xcd_barrier_complete(unsigned* bar, unsigned x, unsigned& nloc, unsigned& nx) {
    const unsigned G = gridDim.x * gridDim.y * gridDim.z;
    unsigned sum, cnt, mine, sp = 0u;
    for (;;) {
        sum = 0u; cnt = 0u; mine = 0u;
#pragma unroll
        for (unsigned j = 0; j < 16; ++j) { const unsigned c = xb_ld(&bar[XB_XCNT(j)]); sum += c; cnt += (c > 0u) ? 1u : 0u; mine = (j == x) ? c : mine; }
        if (sum == G) break;
        __builtin_amdgcn_s_sleep(1);
        if ((++sp & 255u) == 0u) { if (xb_ld(&bar[XB_TMO])) break; if (sp > XB_SPIN_CAP) { atomicAdd(&bar[XB_TMO], 1u); break; } }
    }
    nloc = mine > 0u ? mine : 1u; nx = cnt > 0u ? cnt : 1u;
}

__device__ __forceinline__ void xcd_barrier(const XcdBarrier& b) {
    asm volatile("s_waitcnt vmcnt(0)" ::: "memory");
    __syncthreads();
    if (threadIdx.x == 0) {
        unsigned* bar = b.bar;
        __builtin_amdgcn_s_waitcnt(0);
        unsigned nloc = b.st[0], nx = b.st[1];
        if (nloc == 0u) { xcd_barrier_complete(bar, b.x, nloc, nx); b.st[0] = nloc; b.st[1] = nx; }
        const unsigned old = xb_add(&bar[XB_XSUB(b.x)], 1u);
        const unsigned gen = old / nloc;
        if (old + 1u == (gen + 1u) * nloc) {
            __builtin_amdgcn_fence(__ATOMIC_RELEASE, "agent");
            asm volatile("s_waitcnt vmcnt(0)" ::: "memory");
            const unsigned og = xb_add(&bar[XB_TOP], 1u);
            const unsigned tg = og / nx;
            if (og + 1u == (tg + 1u) * nx) xb_add(&bar[XB_TOPGEN], 1u);
            else XB_SPIN(xb_ld(&bar[XB_TOPGEN]) == tg, bar);
            __builtin_amdgcn_fence(__ATOMIC_ACQUIRE, "agent");
            xb_add(&bar[XB_XGEN(b.x)], 1u);
            asm volatile("s_waitcnt vmcnt(0)" ::: "memory");
        } else {
            XB_SPIN(xb_ld(&bar[XB_XGEN(b.x)]) == gen, bar);
            __builtin_amdgcn_fence(__ATOMIC_ACQUIRE, "agent");
            asm volatile("s_waitcnt vmcnt(0)" ::: "memory");
        }
    }
    __syncthreads();
}


namespace pg8 {
constexpr int BM = 256, BK = 64, HALF = 128, HTB = HALF * BK * 2, STAGE_BYTES = 8 * HTB, NXCD = 8, WGM = 8;
__device__ __forceinline__ int lds_byte(int r, int c) { const int st = (r >> 4) * 2 + (c >> 5), rr = r & 15, cc = c & 31, ob = rr * 64 + cc * 2; return st * 1024 + (ob ^ (((ob >> 9) & 1) << 5)); }
__device__ __forceinline__ void stage_rc(int b, int& R, int& C) { const int st = b / 1024, sb = b % 1024, swz = sb ^ (((sb >> 9) & 1) << 5); R = (st >> 1) * 16 + swz / 64; C = (st & 1) * 32 + (swz % 64) / 2; }
__device__ __forceinline__ int perm32(int rho) { const int n = rho >> 4, i = rho & 15; return 8 * (i >> 2) + 4 * n + (i & 3); }

struct Unit { int pm, pn; };
struct Gemm { const h16* A; const h16* Bt; int M, N, K; };

struct StaticOrder {
    int nM, nN, nwg, G, c;
    __device__ void init(int M, int N, int G_, int c_) { nM = M / BM; nN = N / BM; nwg = nM * nN; G = G_; c = c_; }
    __device__ bool next(int i, Unit& u) const {
        const long L = (long)i * G + c; if (L >= nwg) return false;
        int wgid = (int)L; { const int q = nwg / NXCD, r = nwg % NXCD, xcd = wgid % NXCD, off = wgid / NXCD; wgid = (xcd < r ? xcd * (q + 1) : r * (q + 1) + (xcd - r) * q) + off; }
        const int nig = WGM * nN, gid = wgid / nig, fm = gid * WGM, gsz = (nM - fm) < WGM ? (nM - fm) : WGM;
        u.pm = fm + ((wgid % nig) % gsz); u.pn = (wgid % nig) / gsz; return true;
    }
};

template <class Epi>
__device__ __forceinline__ void gemm_phase(LAS unsigned char* lds, const Gemm g, const StaticOrder& S, const Epi& E) {
    const int tid = tid_(), wid = __builtin_amdgcn_readfirstlane(tid >> 6), lane = tid & 63, wr = wid >> 2, wc = wid & 3, fr = lane & 15, fq = lane >> 4;
    const int K = g.K, nt = K / BK;
    unsigned voffA[2], voffB[2];
#pragma unroll
    for (int i = 0; i < 2; ++i) { int R, C; stage_rc(tid * 16 + i * 8192, R, C); const int Rb = (R & ~31) + perm32(R & 31);
        voffA[i] = (unsigned)(R * K + C) * 2u; voffB[i] = (unsigned)(Rb * K + C) * 2u; }
    const size_t kstep = (size_t)(BK * 2);
    const size_t hstep = (size_t)HALF * K * 2;
    const size_t tstep = 2 * hstep;
    const unsigned ldsw = (unsigned)wid * 1024u;
    const int aoff = lds_byte(wr * 64 + fr, fq * 8), boff = lds_byte(wc * 32 + fr, fq * 8);
#define PG8_SA(b, h) (((b) * 2 + (h)) * HTB)
#define PG8_SB(b, h) ((4 + (b) * 2 + (h)) * HTB)
#define PG8_STAGE(bufoff, gbase, voff) do { _Pragma("unroll") for (int _i = 0; _i < 2; ++_i) \
        __builtin_amdgcn_global_load_lds((const unsigned*)((const char*)(gbase) + (voff)[_i]), (LAS unsigned*)(lds + (bufoff) + ldsw + _i * 8192), 16, 0, 0); } while (0)
#define PG8_LDA(dst, b, h) do { _Pragma("unroll") for (int m = 0; m < 4; ++m) _Pragma("unroll") for (int k = 0; k < 2; ++k) dst[m][k] = *(const LAS h16x8*)(lds + PG8_SA(b, h) + aoff + m * 2048 + k * 1024); } while (0)
#define PG8_LDB(dst, b, h) do { _Pragma("unroll") for (int n = 0; n < 2; ++n) _Pragma("unroll") for (int k = 0; k < 2; ++k) dst[n][k] = *(const LAS h16x8*)(lds + PG8_SB(b, h) + boff + n * 2048 + k * 1024); } while (0)
#define PG8_MMA(ai, bj, At, Bt) do { __builtin_amdgcn_s_setprio(1); _Pragma("unroll") for (int m = 0; m < 4; ++m) _Pragma("unroll") for (int n = 0; n < 2; ++n) _Pragma("unroll") for (int k = 0; k < 2; ++k) \
        acc[ai][bj][m][n] = __builtin_amdgcn_mfma_f32_16x16x32_f16(Bt[n][k], At[m][k], acc[ai][bj][m][n], 0, 0, 0); __builtin_amdgcn_s_setprio(0); } while (0)
#define PG8_WAIT_V(n) asm volatile("s_waitcnt vmcnt(" #n ")" ::: "memory")
#define PG8_WAIT_L(n) asm volatile("s_waitcnt lgkmcnt(" #n ")" ::: "memory")
#define PG8_BAR __builtin_amdgcn_s_barrier()
#define PG8_SCHED __builtin_amdgcn_sched_barrier(0)
    Unit cur, nxt; int ui = 0;
    if (!S.next(0, cur)) return;
    f32x4 acc[2][2][4][2];
#pragma unroll
    for (int a = 0; a < 2; ++a)
#pragma unroll
        for (int b = 0; b < 2; ++b)
#pragma unroll
            for (int m = 0; m < 4; ++m)
#pragma unroll
                for (int n = 0; n < 2; ++n) acc[a][b][m][n] = (f32x4){0.f, 0.f, 0.f, 0.f};
    h16x8 At[4][2], B0[2][2], B1[2][2];
    const char* cA = (const char*)g.A + (size_t)cur.pm * tstep; const char* cB = (const char*)g.Bt + (size_t)cur.pn * tstep;
    PG8_STAGE(PG8_SB(0, 0), cB, voffB); PG8_STAGE(PG8_SA(0, 0), cA, voffA); PG8_STAGE(PG8_SB(0, 1), cB + hstep, voffB); PG8_STAGE(PG8_SA(0, 1), cA + hstep, voffA);
    if (wr == 1) PG8_BAR;
    PG8_WAIT_V(4); PG8_BAR;
    PG8_STAGE(PG8_SB(1, 0), cB + kstep, voffB); PG8_STAGE(PG8_SA(1, 0), cA + kstep, voffA); PG8_STAGE(PG8_SB(1, 1), cB + hstep + kstep, voffB);
    PG8_WAIT_V(6); PG8_BAR;
    for (;;) {
        const bool has_next = S.next(ui + 1, nxt);
        const char* nA = has_next ? (const char*)g.A + (size_t)nxt.pm * tstep : cA; const char* nB = has_next ? (const char*)g.Bt + (size_t)nxt.pn * tstep : cB;
        for (int t = 0; t < nt; t += 2) {
            const bool last = (t == nt - 2);
            const char* a1 = cA + (size_t)(t + 1) * kstep;
            const char* a2 = last ? nA : cA + (size_t)(t + 2) * kstep; const char* b2 = last ? nB : cB + (size_t)(t + 2) * kstep;
            const char* a3 = a2 + kstep; const char* b3 = b2 + kstep;
            PG8_LDB(B0, 0, 0); PG8_SCHED; PG8_LDA(At, 0, 0); PG8_STAGE(PG8_SA(1, 1), a1 + hstep, voffA);
            PG8_WAIT_L(8); PG8_BAR; PG8_WAIT_L(0); PG8_MMA(0, 0, At, B0); PG8_BAR; PG8_SCHED;
            PG8_LDB(B1, 0, 1); PG8_STAGE(PG8_SB(0, 0), b2, voffB);
            PG8_BAR; PG8_WAIT_L(0); PG8_MMA(0, 1, At, B1); PG8_BAR;
            PG8_LDA(At, 0, 1); PG8_STAGE(PG8_SA(0, 0), a2, voffA);
            PG8_BAR; PG8_WAIT_L(0); PG8_MMA(1, 0, At, B0); PG8_BAR; PG8_SCHED;
            PG8_STAGE(PG8_SB(0, 1), b2 + hstep, voffB);
            PG8_WAIT_V(6); PG8_BAR; PG8_MMA(1, 1, At, B1); PG8_BAR;
            PG8_LDB(B0, 1, 0); PG8_SCHED; PG8_LDA(At, 1, 0); PG8_STAGE(PG8_SA(0, 1), a2 + hstep, voffA);
            PG8_WAIT_L(8); PG8_BAR; PG8_WAIT_L(0); PG8_MMA(0, 0, At, B0); PG8_BAR; PG8_SCHED;
            PG8_LDB(B1, 1, 1); PG8_STAGE(PG8_SB(1, 0), b3, voffB);
            PG8_BAR; PG8_WAIT_L(0); PG8_MMA(0, 1, At, B1); PG8_BAR;
            PG8_LDA(At, 1, 1); PG8_STAGE(PG8_SA(1, 0), a3, voffA);
            PG8_BAR; PG8_WAIT_L(0); PG8_MMA(1, 0, At, B0); PG8_BAR; PG8_SCHED;
            PG8_STAGE(PG8_SB(1, 1), b3 + hstep, voffB);
            PG8_WAIT_V(6); PG8_BAR; PG8_MMA(1, 1, At, B1); PG8_BAR;
        }
        E(acc, cur, wr, wc, fr, fq);
        if (!has_next) break;
#pragma unroll
        for (int a = 0; a < 2; ++a)
#pragma unroll
            for (int b = 0; b < 2; ++b)
#pragma unroll
                for (int m = 0; m < 4; ++m)
#pragma unroll
                    for (int n = 0; n < 2; ++n) acc[a][b][m][n] = (f32x4){0.f, 0.f, 0.f, 0.f};
        cur = nxt; cA = nA; cB = nB; ++ui;
    }
    PG8_WAIT_V(0);
    if (wr == 0) PG8_BAR;
    PG8_BAR;
#undef PG8_SA
#undef PG8_SB
#undef PG8_STAGE
#undef PG8_LDA
#undef PG8_LDB
#undef PG8_MMA
#undef PG8_WAIT_V
#undef PG8_WAIT_L
#undef PG8_BAR
#undef PG8_SCHED
}
}
using pg8::Unit;
typedef const f32x4 (&AccRef)[2][2][4][2];

#define EPI_LOOP_BEGIN \
    _Pragma("unroll") for (int ai = 0; ai < 2; ++ai) _Pragma("unroll") for (int m = 0; m < 4; ++m) { \
        const int row = u.pm * 256 + ai * 128 + wr * 64 + m * 16 + fr; \
        _Pragma("unroll") for (int bj = 0; bj < 2; ++bj) { \
            const int col = u.pn * 256 + bj * 128 + wc * 32 + 8 * fq; \
            const f32x4 v0 = acc[ai][bj][m][0], v1 = acc[ai][bj][m][1];
#define EPI_LOOP_END } }

struct EpiZ {
    h16 *zc, *zr, *zg;
    __device__ __forceinline__ void operator()(AccRef acc, const Unit& u, int wr, int wc, int fr, int fq) const {
        const int colt = u.pn * 256; h16* base; int ld, c0;
        if (colt < 1536) { base = zc; ld = 1536; c0 = colt; } else if (colt < 3328) { base = zr; ld = 1792; c0 = colt - 1536; } else { base = zg; ld = 2048; c0 = colt - 3328; }
        EPI_LOOP_BEGIN
            *(h16x8*)(base + (size_t)row * ld + (col - colt + c0)) = pack8(v0, v1);
        EPI_LOOP_END
    }
};
struct EpiF16 {
    h16* O; int ld;
    __device__ __forceinline__ void operator()(AccRef acc, const Unit& u, int wr, int wc, int fr, int fq) const {
        EPI_LOOP_BEGIN
            *(h16x8*)(O + (size_t)row * ld + col) = pack8(v0, v1);
        EPI_LOOP_END
    }
};
struct EpiYA {
    const h16* zg; float* tmp;
    __device__ __forceinline__ void operator()(AccRef acc, const Unit& u, int wr, int wc, int fr, int fq) const {
        EPI_LOOP_BEGIN
            const h16x8 gv = *(const h16x8*)(zg + (size_t)row * 2048 + col);
            f32x4 o0, o1;
#pragma unroll
            for (int j = 0; j < 4; ++j) { o0[j] = sigmoidf_((float)gv[j]) * v0[j]; o1[j] = sigmoidf_((float)gv[4 + j]) * v1[j]; }
            float* p = tmp + (size_t)row * 1024 + col;
            *(f32x4*)p = o0; *(f32x4*)(p + 4) = o1;
        EPI_LOOP_END
    }
};
struct EpiYB {
    const h16* zg; const float* tmp; h16* merged;
    __device__ __forceinline__ void operator()(AccRef acc, const Unit& u, int wr, int wc, int fr, int fq) const {
        EPI_LOOP_BEGIN
            const h16x8 gv = *(const h16x8*)(zg + (size_t)row * 2048 + 1024 + col);
            const float* p = tmp + (size_t)row * 1024 + col;
            f32x4 o0 = *(const f32x4*)p, o1 = *(const f32x4*)(p + 4);
#pragma unroll
            for (int j = 0; j < 4; ++j) { o0[j] += sigmoidf_((float)gv[j]) * v0[j]; o1[j] += sigmoidf_((float)gv[4 + j]) * v1[j]; }
            *(h16x8*)(merged + (size_t)row * 1024 + col) = pack8(o0, o1);
        EPI_LOOP_END
    }
};
struct EpiH1 {
    const float* x; float* out; h16* hb; float* part;
    __device__ __forceinline__ void operator()(AccRef acc, const Unit& u, int wr, int wc, int fr, int fq) const {
#pragma unroll
        for (int ai = 0; ai < 2; ++ai)
#pragma unroll
            for (int m = 0; m < 4; ++m) {
                const int row = u.pm * 256 + ai * 128 + wr * 64 + m * 16 + fr; float ss = 0.f;
#pragma unroll
                for (int bj = 0; bj < 2; ++bj) {
                    const int col = u.pn * 256 + bj * 128 + wc * 32 + 8 * fq;
                    const float* xp = x + (size_t)row * 1024 + col;
                    f32x4 o0 = *(const f32x4*)xp + acc[ai][bj][m][0], o1 = *(const f32x4*)(xp + 4) + acc[ai][bj][m][1];
                    float* op = out + (size_t)row * 1024 + col;
                    *(f32x4*)op = o0; *(f32x4*)(op + 4) = o1;
                    *(h16x8*)(hb + (size_t)row * 1024 + col) = pack8(o0, o1);
                    ss += (o0[0] * o0[0] + o0[1] * o0[1]) + (o0[2] * o0[2] + o0[3] * o0[3]) + (o1[0] * o1[0] + o1[1] * o1[1]) + (o1[2] * o1[2] + o1[3] * o1[3]);
                }
                ss += __shfl_xor(ss, 16); ss += __shfl_xor(ss, 32);
                if (fq == 0) part[(size_t)row * 16 + u.pn * 4 + wc] = ss;
            }
    }
};
struct EpiGate {
    float* out; const h16* pp; const float* rs2; float* part;
    __device__ __forceinline__ void operator()(AccRef acc, const Unit& u, int wr, int wc, int fr, int fq) const {
#pragma unroll
        for (int ai = 0; ai < 2; ++ai)
#pragma unroll
            for (int m = 0; m < 4; ++m) {
                const int row = u.pm * 256 + ai * 128 + wr * 64 + m * 16 + fr; float ss = 0.f;
                const f32x4 sa = *(const f32x4*)(rs2 + (size_t)row * 8), sb = *(const f32x4*)(rs2 + (size_t)row * 8 + 4);
                const float rs = rsqrtf(((sa[0] + sa[1]) + (sa[2] + sa[3]) + (sb[0] + sb[1]) + (sb[2] + sb[3])) * (1.f / 1024.f) + NORM_EPS);
#pragma unroll
                for (int bj = 0; bj < 2; ++bj) {
                    const int col = u.pn * 256 + bj * 128 + wc * 32 + 8 * fq;
                    float* op = out + (size_t)row * 1024 + col;
                    f32x4 o0 = *(const f32x4*)op, o1 = *(const f32x4*)(op + 4);
                    const h16x8 pv = *(const h16x8*)(pp + (size_t)row * 1024 + col);
                    const f32x4 v0 = acc[ai][bj][m][0], v1 = acc[ai][bj][m][1];
#pragma unroll
                    for (int j = 0; j < 4; ++j) { o0[j] += sigmoidf_(rs * v0[j]) * (float)pv[j]; o1[j] += sigmoidf_(rs * v1[j]) * (float)pv[4 + j]; }
                    *(f32x4*)op = o0; *(f32x4*)(op + 4) = o1;
                    ss += (o0[0] * o0[0] + o0[1] * o0[1]) + (o0[2] * o0[2] + o0[3] * o0[3]) + (o1[0] * o1[0] + o1[1] * o1[1]) + (o1[2] * o1[2] + o1[3] * o1[3]);
                }
                ss += __shfl_xor(ss, 16); ss += __shfl_xor(ss, 32);
                if (fq == 0) part[(size_t)row * 16 + u.pn * 4 + wc] = ss;
            }
    }
};

__device__ __forceinline__ void tr_item(const float* W, int N, const float* g, h16* WT, int ldk, int koff, int k0, int n0, LAS float* scr, int lane) {
#pragma unroll 8
    for (int i = 0; i < 32; ++i) { const int kk = 2 * i + (lane >> 5); float v = W[(size_t)(k0 + kk) * N + n0 + (lane & 31)]; if (g) v *= g[k0 + kk]; scr[kk * 33 + (lane & 31)] = v; }
    asm volatile("s_waitcnt lgkmcnt(0)" ::: "memory");
    const int c = lane & 7;
#pragma unroll
    for (int j = 0; j < 4; ++j) { const int n = (lane >> 3) + 8 * j; const LAS float* s = scr + (8 * c) * 33 + n;
        h16x8 o;
#pragma unroll
        for (int e = 0; e < 8; ++e) o[e] = (h16)s[e * 33];
        *(h16x8*)(WT + (size_t)(n0 + n) * ldk + koff + k0 + 8 * c) = o; }
    asm volatile("s_waitcnt lgkmcnt(0)" ::: "memory");
}
struct TrJob { const float* W; const float* g; h16* WT; int K, N, ldk, koff; };

__device__ __forceinline__ void phase_prep(const Args& a, LAS unsigned char* lds) {
    const int tid = tid_(), lane = tid & 63, wave = tid >> 6;
    const int gw = blockIdx.x * NWAVES + wave, NGW = gridDim.x * NWAVES;
    unsigned char* ws = a.ws;
    {
        LAS float* scr = (LAS float*)(lds + wave * 8704);
        TrJob jobs[9] = {
            {a.in[3], a.in[2], (h16*)(ws + O_WIN), 1024, NIN, 1024, 0},
            {a.in[17], nullptr, (h16*)(ws + O_WA), 512, 1024, 512, 0},
            {a.in[18], nullptr, (h16*)(ws + O_WB), 512, 1024, 512, 0},
            {a.in[19], nullptr, (h16*)(ws + O_WO), 1024, 1024, 1024, 0},
            {a.in[26], a.in[25], (h16*)(ws + O_WG), 1024, 1024, 1024, 0},
            {a.in[27], nullptr, (h16*)(ws + O_WP), 256, 1024, 256, 0},
            {a.in[8], nullptr, (h16*)(ws + O_WLR), 64, 512, 256, 0},
            {a.in[10], nullptr, (h16*)(ws + O_WLR) + (size_t)512 * 256, 64, 512, 256, 64},
            {a.in[11], nullptr, (h16*)(ws + O_WLR) + (size_t)1024 * 256, 128, 512, 256, 128},
        };
        int base = 0;
#pragma unroll
        for (int j = 0; j < 9; ++j) {
            const TrJob J = jobs[j]; const int nnb = J.N / 32, items = (J.K / 64) * nnb;
            int first = gw - (base % NGW); if (first < 0) first += NGW;
            for (int r = first; r < items; r += NGW) tr_item(J.W, J.N, J.g, J.WT, J.ldk, J.koff, (r / nnb) * 64, (r % nnb) * 32, scr, lane);
            base += items;
        }
        h16* wlr = (h16*)(ws + O_WLR);
        for (int i = blockIdx.x * NTHREADS + tid; i < 1536 * 256 / 8; i += gridDim.x * NTHREADS) {
            const int n = (i * 8) / 256, k = (i * 8) % 256; const int blk = n / 512;
            const bool inblk = (blk == 0) ? (k < 64) : (blk == 1) ? (k >= 64 && k < 128) : (k >= 128);
            if (!inblk) { h16x8 z; for (int e = 0; e < 8; ++e) z[e] = (h16)0.f; *(h16x8*)(wlr + (size_t)i * 8) = z; }
        }
    }
    __syncthreads();
    {
        LAS float* LA = (LAS float*)lds;
        LAS float* LB = (LAS float*)(lds + 64 * 129 * 4);
        const float* wq = a.in[21]; const float* sk = a.in[22]; const float* gf = a.in[20];
        h16* wst = (h16*)(ws + O_WS);
        for (int it = blockIdx.x; it < 256; it += gridDim.x) {
            const int g16 = it >> 4, k0 = (it & 15) * 64;
            for (int i = tid; i < 64 * 128; i += NTHREADS) { const int k = i >> 7, d = i & 127; LA[k * 129 + d] = wq[(size_t)(k0 + k) * 2048 + g16 * 128 + d] * gf[k0 + k]; }
            for (int i = tid; i < 128 * 128; i += NTHREADS) { const int n = i >> 7, d = i & 127; LB[n * 129 + d] = sk[((size_t)g16 * 128 + n) * 128 + d]; }
            __syncthreads();
            const int n = tid & 127, kg = tid >> 7;
            float o[16];
#pragma unroll
            for (int j = 0; j < 16; ++j) o[j] = 0.f;
            for (int d = 0; d < 128; ++d) { const float b = LB[n * 129 + d];
#pragma unroll
                for (int j = 0; j < 16; ++j) o[j] += LA[(kg * 16 + j) * 129 + d] * b; }
            h16x8 o0, o1;
#pragma unroll
            for (int j = 0; j < 8; ++j) { o0[j] = (h16)o[j]; o1[j] = (h16)o[8 + j]; }
            h16* dst = wst + (size_t)(g16 * 128 + n) * 1024 + k0 + kg * 16;
            *(h16x8*)dst = o0; *(h16x8*)(dst + 8) = o1;
            __syncthreads();
        }
    }
    {
        const float* gf = a.in[20];
        f32x4 g4[4];
#pragma unroll
        for (int j = 0; j < 4; ++j) g4[j] = *(const f32x4*)(gf + 16 * lane + 4 * j);
        for (int r = gw; r < 2 * 16384; r += NGW) {
            const int tb = r >> 14, e = r & 16383;
            const float* src = (tb ? a.in[24] : a.in[23]) + (size_t)e * 1024 + 16 * lane;
            f32x4 v[4]; float mx = 0.f;
#pragma unroll
            for (int j = 0; j < 4; ++j) { v[j] = *(const f32x4*)(src + 4 * j); if (!tb) v[j] = v[j] * g4[j];
#pragma unroll
                for (int c = 0; c < 4; ++c) mx = fmaxf(mx, fabsf(v[j][c])); }
#pragma unroll
            for (int o = 1; o < 64; o <<= 1) mx = fmaxf(mx, __shfl_xor(mx, o));
            mx = fmaxf(mx, 1e-30f);
            const float sc = 224.0f / mx;
            u32x4 q;
#pragma unroll
            for (int j = 0; j < 4; ++j) { int w = 0; w = __builtin_amdgcn_cvt_pk_fp8_f32(v[j][0] * sc, v[j][1] * sc, w, false); w = __builtin_amdgcn_cvt_pk_fp8_f32(v[j][2] * sc, v[j][3] * sc, w, true); q[j] = (unsigned)w; }
            unsigned char* dst = ws + (tb ? O_V8 : O_U8) + ((size_t)(lane >> 3) * 16384 + e) * 128 + 16 * (lane & 7);
            *(u32x4*)dst = q;
            if (lane == 0) ((float*)(ws + (tb ? O_VSC : O_USC)))[e] = mx * (1.0f / 224.0f);
        }
        if (blockIdx.x == 0 && tid < 32) ((unsigned*)(ws + O_CTR))[tid * 64] = 0u;
        const f32x4* pp = (const f32x4*)a.in[1]; h16x4* dp = (h16x4*)(ws + O_P16);
        const int np4 = MTOK * 256 / 4;
        for (int i = blockIdx.x * NTHREADS + tid; i < np4; i += gridDim.x * NTHREADS) dp[i] = pack4(pp[i]);
    }
    {
        const float* x = a.in[0]; h16* xn = (h16*)(ws + O_XN);
        for (int r = gw; r < MTOK; r += NGW) {
            const f32x4* xr = (const f32x4*)(x + (size_t)r * 1024) + lane;
            f32x4 v[4]; float s = 0.f;
#pragma unroll
            for (int j = 0; j < 4; ++j) { v[j] = xr[64 * j]; s += (v[j][0] * v[j][0] + v[j][1] * v[j][1]) + (v[j][2] * v[j][2] + v[j][3] * v[j][3]); }
            const float rs = rsqrtf(wave_sum(s) * (1.f / 1024.f) + NORM_EPS);
            h16x4* o = (h16x4*)(xn + (size_t)r * 1024) + lane;
#pragma unroll
            for (int j = 0; j < 4; ++j) o[64 * j] = pack4(v[j] * rs);
        }
    }
}

__device__ __forceinline__ void phase_conv(const Args& a) {
    const int tid = tid_(), lane = tid & 63, wave = tid >> 6;
    const int gw = blockIdx.x * NWAVES + wave, NGW = gridDim.x * NWAVES;
    const h16* zc = (const h16*)(a.ws + O_ZC); h16* ca = (h16*)(a.ws + O_CA);
    const float* cw = a.in[4]; const float* cb = a.in[5];
    float w0[8], w1[8], w2[8], bb[8];
#pragma unroll
    for (int j = 0; j < 8; ++j) { const int c = lane * 8 + j; w0[j] = cw[c]; w1[j] = cw[512 + c]; w2[j] = cw[1024 + c]; bb[j] = cb[c]; }
    for (int run = gw; run < MTOK / 32; run += NGW) {
        const int t0 = run * 32;
        float u1[8], u2[8];
        if ((t0 % SEQ) == 0) {
#pragma unroll
            for (int j = 0; j < 8; ++j) { u1[j] = 0.f; u2[j] = 0.f; }
        } else {
            const h16x8 c1 = *(const h16x8*)(zc + (size_t)(t0 - 1) * 1536 + 512 + lane * 8), x1 = *(const h16x8*)(zc + (size_t)(t0 - 1) * 1536 + 1024 + lane * 8);
            const h16x8 c2 = *(const h16x8*)(zc + (size_t)(t0 - 2) * 1536 + 512 + lane * 8), x2 = *(const h16x8*)(zc + (size_t)(t0 - 2) * 1536 + 1024 + lane * 8);
#pragma unroll
            for (int j = 0; j < 8; ++j) { u1[j] = (float)c1[j] * (float)x1[j]; u2[j] = (float)c2[j] * (float)x2[j]; }
        }
        for (int t = t0; t < t0 + 32; ++t) {
            const h16* zrow = zc + (size_t)t * 1536 + lane * 8;
            const h16x8 gb = *(const h16x8*)zrow, gc = *(const h16x8*)(zrow + 512), xi = *(const h16x8*)(zrow + 1024);
            h16x8 o;
#pragma unroll
            for (int j = 0; j < 8; ++j) { const float u0 = (float)gc[j] * (float)xi[j];
                const float y = w0[j] * u2[j] + w1[j] * u1[j] + w2[j] * u0 + bb[j];
                o[j] = (h16)((float)gb[j] * y); u2[j] = u1[j]; u1[j] = u0; }
            *(h16x8*)(ca + (size_t)t * 512 + lane * 8) = o;
        }
    }
}


__device__ __forceinline__ float tanhf_(float x) { return 1.0f - 2.0f * __builtin_amdgcn_rcpf(1.0f + __expf(2.0f * x)); }
__device__ __forceinline__ void phase_rwkv_prep(const Args& a) {
    const int tid = tid_(), lane = tid & 63, wave = tid >> 6;
    const int gw = blockIdx.x * NWAVES + wave, NGW = gridDim.x * NWAVES;
    const h16* zr = (const h16*)(a.ws + O_ZR);
    h16* R = (h16*)a.out; h16* KS = R + (size_t)MTOK * 512; h16* V = KS + (size_t)MTOK * 512; h16* KK = V + (size_t)MTOK * 512;
    h16* APR = (h16*)(a.ws + O_APR);
    const float* mu = a.in[6]; const float* k_k = a.in[12];
    float mr[8], mk[8], mv[8], mt[8], kk8[8];
#pragma unroll
    for (int j = 0; j < 8; ++j) { const int c = lane * 8 + j; mr[j] = mu[c]; mk[j] = mu[512 + c]; mv[j] = mu[1024 + c]; mt[j] = mu[1536 + (c & 255)]; kk8[j] = k_k[c]; }
    for (int run = gw; run < MTOK / 32; run += NGW) {
        const int t0 = run * 32;
        float pr[8], pk[8], pv[8], pt[8];
        if ((t0 % SEQ) == 0) {
#pragma unroll
            for (int j = 0; j < 8; ++j) { pr[j] = 0.f; pk[j] = 0.f; pv[j] = 0.f; pt[j] = 0.f; }
        } else {
            const h16* zp = zr + (size_t)(t0 - 1) * 1792 + lane * 8;
            const h16x8 a0 = *(const h16x8*)zp, a1 = *(const h16x8*)(zp + 512), a2 = *(const h16x8*)(zp + 1024), a3 = *(const h16x8*)(zr + (size_t)(t0 - 1) * 1792 + 1536 + (lane & 31) * 8);
#pragma unroll
            for (int j = 0; j < 8; ++j) { pr[j] = (float)a0[j]; pk[j] = (float)a1[j]; pv[j] = (float)a2[j]; pt[j] = (float)a3[j]; }
        }
        for (int t = t0; t < t0 + 32; ++t) {
            const h16* zp = zr + (size_t)t * 1792 + lane * 8;
            const h16x8 a0 = *(const h16x8*)zp, a1 = *(const h16x8*)(zp + 512), a2 = *(const h16x8*)(zp + 1024), a3 = *(const h16x8*)(zr + (size_t)t * 1792 + 1536 + (lane & 31) * 8);
            h16x8 orr, ok, ov, okk, ot; float kr[8]; float ss = 0.f;
#pragma unroll
            for (int j = 0; j < 8; ++j) {
                const float zr_ = (float)a0[j], zk_ = (float)a1[j], zv_ = (float)a2[j], zt_ = (float)a3[j];
                const float r = zr_ + mr[j] * (pr[j] - zr_), k = zk_ + mk[j] * (pk[j] - zk_), v = zv_ + mv[j] * (pv[j] - zv_), tl = zt_ + mt[j] * (pt[j] - zt_);
                pr[j] = zr_; pk[j] = zk_; pv[j] = zv_; pt[j] = zt_;
                orr[j] = (h16)r; ok[j] = (h16)k; ov[j] = (h16)v;
                kr[j] = k * kk8[j]; ss += kr[j] * kr[j];
                const float tv = (lane < 8) ? tanhf_(tl) : (lane < 16) ? tl : sigmoidf_(tl);
                ot[j] = (h16)tv;
            }
            ss += __shfl_xor(ss, 1); ss += __shfl_xor(ss, 2); ss += __shfl_xor(ss, 4);
            const float rn = rsqrtf(ss + 1e-12f);
#pragma unroll
            for (int j = 0; j < 8; ++j) okk[j] = (h16)(kr[j] * rn);
            const size_t o = (size_t)t * 512 + lane * 8;
            *(h16x8*)(R + o) = orr; *(h16x8*)(KS + o) = ok; *(h16x8*)(V + o) = ov; *(h16x8*)(KK + o) = okk;
            if (lane < 32) *(h16x8*)(APR + (size_t)t * 256 + lane * 8) = ot;
        }
    }
}

struct EpiLR {
    const float *w0, *a0, *k_a; h16 *WD, *KS, *BD, *GG; const h16* KK;
    __device__ __forceinline__ void operator()(AccRef acc, const Unit& u, int wr, int wc, int fr, int fq) const {
        const int part = u.pn >> 1;
        EPI_LOOP_BEGIN
            const int c = col - part * 512; const size_t o = (size_t)row * 512 + c;
            if (part == 0) {
                const f32x4 b0 = *(const f32x4*)(w0 + c), b1 = *(const f32x4*)(w0 + c + 4); f32x4 o0, o1;
#pragma unroll
                for (int j = 0; j < 4; ++j) { o0[j] = __expf(-0.6065306597126334f * sigmoidf_(b0[j] + v0[j])); o1[j] = __expf(-0.6065306597126334f * sigmoidf_(b1[j] + v1[j])); }
                *(h16x8*)(WD + o) = pack8(o0, o1);
            } else if (part == 1) {
                const f32x4 b0 = *(const f32x4*)(a0 + c), b1 = *(const f32x4*)(a0 + c + 4), ka0 = *(const f32x4*)(k_a + c), ka1 = *(const f32x4*)(k_a + c + 4);
                const h16x8 ks = *(const h16x8*)(KS + o), kk = *(const h16x8*)(KK + o); f32x4 k0, k1, bb0, bb1;
#pragma unroll
                for (int j = 0; j < 4; ++j) { const float aa0 = sigmoidf_(b0[j] + v0[j]), aa1 = sigmoidf_(b1[j] + v1[j]);
                    k0[j] = (float)ks[j] * (1.0f + (aa0 - 1.0f) * ka0[j]); k1[j] = (float)ks[4 + j] * (1.0f + (aa1 - 1.0f) * ka1[j]);
                    bb0[j] = aa0 * (float)kk[j]; bb1[j] = aa1 * (float)kk[4 + j]; }
                *(h16x8*)(KS + o) = pack8(k0, k1); *(h16x8*)(BD + o) = pack8(bb0, bb1);
            } else {
                *(h16x8*)(GG + o) = pack8(v0, v1);
            }
        EPI_LOOP_END
    }
};

constexpr int SC_L = 256, SC_NCH = SEQ / SC_L, SC_NB = 8;
constexpr int SC_STEP_F = 6 * 64;
constexpr int SC_WAVE_BYTES = SC_NB * SC_STEP_F * 4 + SC_NB * 64 * 4;
__device__ __forceinline__ float quad_sum(float v) { v += dpp_<0xB1>(v); v += dpp_<0x4E>(v); return v; }
__device__ __forceinline__ void lds_ld8x2(const LAS float* p, f32x2 (&o)[8]) {
#pragma unroll
    for (int j4 = 0; j4 < 4; ++j4) { const f32x4 t = *(const LAS f32x4*)(p + 4 * j4); o[2 * j4] = (f32x2){t[0], t[1]}; o[2 * j4 + 1] = (f32x2){t[2], t[3]}; }
}
template <int MODE>
__device__ __forceinline__ void scan_wave(const Args& a, LAS unsigned char* lds, int task) {
    const int tid = tid_(), lane = tid & 63, wave = tid >> 6;
    const int q = lane & 3, rg = lane >> 2;
    const int chain = task / SC_NCH, chunk = task % SC_NCH, b = chain >> 3, h = chain & 7;
    const size_t row0 = (size_t)b * SEQ + (size_t)chunk * SC_L;
    const h16* R = (const h16*)a.out; const h16* KS = R + (size_t)MTOK * 512; const h16* V = KS + (size_t)MTOK * 512; const h16* KK = V + (size_t)MTOK * 512;
    const h16* WD = (const h16*)(a.ws + O_WD); const h16* BD = (const h16*)(a.ws + O_BD);
    LAS float* buf = (LAS float*)(lds + wave * SC_WAVE_BYTES);
    LAS float* ybuf = buf + SC_NB * SC_STEP_F;
    constexpr int NA = (MODE == 0) ? 5 : (MODE == 1) ? 3 : 6;
    const h16* gp[NA]; int lo[NA];
#pragma unroll
    for (int j = 0; j < NA; ++j) { const int p = lane + 64 * j, seg = p >> 3, part = p & 7, st = seg / NA, ai = seg % NA;
        const int ar = (MODE == 0 && ai == 4) ? 5 : ai;
        const h16* base = (ar == 0) ? KK : (ar == 1) ? WD : (ar == 2) ? BD : (ar == 3) ? KS : (ar == 4) ? R : V;
        gp[j] = base + (row0 + st) * 512 + h * 64 + part * 8; lo[j] = st * SC_STEP_F + ar * 64 + part * 8; }
    f32x2 s[4][8];
    if (MODE == 0) {
#pragma unroll
        for (int i = 0; i < 4; ++i)
#pragma unroll
            for (int j = 0; j < 8; ++j) s[i][j] = (f32x2){0.f, 0.f};
    } else if (MODE == 1) {
#pragma unroll
        for (int i = 0; i < 4; ++i)
#pragma unroll
            for (int j = 0; j < 8; ++j) s[i][j] = (f32x2){(i == q && 2 * j == rg) ? 1.f : 0.f, (i == q && 2 * j + 1 == rg) ? 1.f : 0.f};
    } else {
        const float* S0 = (const float*)(a.ws + O_SST) + (size_t)task * 4096;
#pragma unroll
        for (int i = 0; i < 4; ++i)
#pragma unroll
            for (int j4 = 0; j4 < 4; ++j4) { const f32x4 t = *(const f32x4*)(S0 + (rg + 16 * i) * 64 + 16 * q + 4 * j4);
                s[i][2 * j4] = (f32x2){t[0], t[1]}; s[i][2 * j4 + 1] = (f32x2){t[2], t[3]}; }
    }
    h16x8 pre[NA];
#pragma unroll
    for (int j = 0; j < NA; ++j) pre[j] = *(const h16x8*)gp[j];
    f32x2 kk[8];
    for (int bt = 0; bt < SC_L / SC_NB; ++bt) {
        LAS float* cb = buf;
#pragma unroll
        for (int j = 0; j < NA; ++j) { f32x4 x0, x1;
#pragma unroll
            for (int e = 0; e < 4; ++e) { x0[e] = (float)pre[j][e]; x1[e] = (float)pre[j][4 + e]; }
            *(LAS f32x4*)(cb + lo[j]) = x0; *(LAS f32x4*)(cb + lo[j] + 4) = x1; }
        if (bt + 1 < SC_L / SC_NB) {
#pragma unroll
            for (int j = 0; j < NA; ++j) pre[j] = *(const h16x8*)(gp[j] + (size_t)(bt + 1) * SC_NB * 512);
        }
        lds_ld8x2(cb + 16 * q, kk);
#pragma unroll 2
        for (int st = 0; st < SC_NB; ++st) {
            const LAS float* sb = cb + st * SC_STEP_F;
            f32x2 w[8], bb[8], kx[8]; float vv[4];
            lds_ld8x2(sb + 64 + 16 * q, w); lds_ld8x2(sb + 128 + 16 * q, bb);
            if (MODE != 1) { lds_ld8x2(sb + 192 + 16 * q, kx);
#pragma unroll
                for (int i = 0; i < 4; ++i) vv[i] = sb[320 + rg + 16 * i]; }
            float us[4];
#pragma unroll
            for (int i = 0; i < 4; ++i) { f32x2 t = s[i][0] * kk[0];
#pragma unroll
                for (int j = 1; j < 8; ++j) t = __builtin_elementwise_fma(s[i][j], kk[j], t);
                us[i] = quad_sum(t[0] + t[1]); }
            if (st + 1 < SC_NB) lds_ld8x2(sb + SC_STEP_F + 16 * q, kk);
            f32x2 rr[8];
            if (MODE == 2) lds_ld8x2(sb + 256 + 16 * q, rr);
#pragma unroll
            for (int i = 0; i < 4; ++i) { const f32x2 nu = (f32x2){-us[i], -us[i]}, v2 = (f32x2){vv[i], vv[i]};
#pragma unroll
                for (int j = 0; j < 8; ++j) { f32x2 t = s[i][j] * w[j]; t = __builtin_elementwise_fma(nu, bb[j], t); if (MODE != 1) t = __builtin_elementwise_fma(v2, kx[j], t); s[i][j] = t; } }
            if (MODE == 2) {
#pragma unroll
                for (int i = 0; i < 4; ++i) { f32x2 t = s[i][0] * rr[0];
#pragma unroll
                    for (int j = 1; j < 8; ++j) t = __builtin_elementwise_fma(s[i][j], rr[j], t);
                    const float y = quad_sum(t[0] + t[1]);
                    if (q == 0) ybuf[st * 64 + rg + 16 * i] = y; }
            }
        }
        if (MODE == 2) {
            const int st = lane >> 3, part = lane & 7; h16x8 o;
#pragma unroll
            for (int e = 0; e < 8; ++e) o[e] = (h16)ybuf[st * 64 + part * 8 + e];
            *(h16x8*)((h16*)(a.ws + O_Y) + (row0 + (size_t)bt * SC_NB + st) * 512 + h * 64 + part * 8) = o;
        }
    }
    if (MODE != 2) {
        float* PQ = (float*)(a.ws + O_PQ) + (size_t)task * 8192 + (MODE == 0 ? 4096 : 0);
#pragma unroll
        for (int i = 0; i < 4; ++i)
#pragma unroll
            for (int j4 = 0; j4 < 4; ++j4) { const int o = (rg + 16 * i) * 64 + 16 * q + 4 * j4;
                *(f32x4*)(PQ + o) = (f32x4){s[i][2 * j4][0], s[i][2 * j4][1], s[i][2 * j4 + 1][0], s[i][2 * j4 + 1][1]}; }
    }
}
template <bool FIRST>
__device__ __forceinline__ void phase_scan(const Args& a, LAS unsigned char* lds) {
    const int wave = tid_() >> 6;
    if (FIRST) {
        for (int t2 = blockIdx.x * NWAVES + wave; t2 < 2 * 64 * SC_NCH; t2 += gridDim.x * NWAVES) {
            if (t2 & 1) scan_wave<1>(a, lds, t2 >> 1); else scan_wave<0>(a, lds, t2 >> 1); }
    } else {
        for (int task = blockIdx.x * NWAVES + wave; task < 64 * SC_NCH; task += gridDim.x * NWAVES) scan_wave<2>(a, lds, task);
    }
}
__device__ __forceinline__ void phase_scan_combine(const Args& a, LAS unsigned char* lds) {
    const int tid = tid_(), row = tid >> 5, cp = tid & 31;
    LAS float* LS = (LAS float*)lds;
    LAS float* LP = (LAS float*)(lds + 8192);
    for (int item = blockIdx.x; item < 64 * 4; item += gridDim.x) {
        const int chain = item >> 2, r0 = (item & 3) * 16;
        const float* PQ0 = (const float*)(a.ws + O_PQ) + (size_t)chain * SC_NCH * 8192;
        f32x2 sr = (f32x2){0.f, 0.f};
        f32x4 pa = *(const f32x4*)(PQ0 + tid * 8), pb = *(const f32x4*)(PQ0 + tid * 8 + 4);
        f32x2 qn = *(const f32x2*)(PQ0 + 4096 + (r0 + row) * 64 + 2 * cp);
        for (int c = 0; c < SC_NCH; ++c) {
            const int task = chain * SC_NCH + c;
            *(f32x2*)((float*)(a.ws + O_SST) + (size_t)task * 4096 + (r0 + row) * 64 + 2 * cp) = sr;
            if (c == SC_NCH - 1) break;
            LAS float* cur = LS + (c & 1) * 1024; LAS float* cp_ = LP + (c & 1) * 4096;
            *(LAS f32x2*)(cur + row * 64 + 2 * cp) = sr;
            *(LAS f32x4*)(cp_ + tid * 8) = pa; *(LAS f32x4*)(cp_ + tid * 8 + 4) = pb;
            f32x2 acc0 = qn, acc1 = (f32x2){0.f, 0.f};
            if (c + 2 < SC_NCH) { const float* Pn = PQ0 + (size_t)(c + 1) * 8192;
                pa = *(const f32x4*)(Pn + tid * 8); pb = *(const f32x4*)(Pn + tid * 8 + 4); qn = *(const f32x2*)(Pn + 4096 + (r0 + row) * 64 + 2 * cp); }
            __syncthreads();
#pragma unroll 16
            for (int k = 0; k < 64; k += 2) {
                const f32x2 sk = *(const LAS f32x2*)(cur + row * 64 + k);
                const f32x2 p0 = *(const LAS f32x2*)(cp_ + k * 64 + 2 * cp), p1 = *(const LAS f32x2*)(cp_ + (k + 1) * 64 + 2 * cp);
                acc0 = __builtin_elementwise_fma((f32x2){sk[0], sk[0]}, p0, acc0); acc1 = __builtin_elementwise_fma((f32x2){sk[1], sk[1]}, p1, acc1);
            }
            sr = acc0 + acc1;
        }
        __syncthreads();
    }
}
__device__ __forceinline__ void phase_rwkv_post(const Args& a) {
    const int tid = tid_(), lane = tid & 63, wave = tid >> 6;
    const int gw = blockIdx.x * NWAVES + wave, NGW = gridDim.x * NWAVES;
    const h16* R = (const h16*)a.out; const h16* KS = R + (size_t)MTOK * 512; const h16* V = KS + (size_t)MTOK * 512;
    const h16* GG = (const h16*)(a.ws + O_GG); const h16* Y = (const h16*)(a.ws + O_Y); h16* YB = (h16*)(a.ws + O_YB);
    float rk[8], lg[8], lb[8];
#pragma unroll
    for (int j = 0; j < 8; ++j) { const int c = lane * 8 + j; rk[j] = a.in[14][c]; lg[j] = a.in[15][c]; lb[j] = a.in[16][c]; }
    for (int t = gw; t < MTOK; t += NGW) {
        const size_t o = (size_t)t * 512 + lane * 8;
        const h16x8 y8 = *(const h16x8*)(Y + o), r8 = *(const h16x8*)(R + o), k8 = *(const h16x8*)(KS + o), v8 = *(const h16x8*)(V + o), g8 = *(const h16x8*)(GG + o);
        float y[8]; float sm = 0.f, bs = 0.f;
#pragma unroll
        for (int j = 0; j < 8; ++j) { y[j] = (float)y8[j]; sm += y[j]; bs += (float)r8[j] * (float)k8[j] * rk[j]; }
        sm += __shfl_xor(sm, 1); sm += __shfl_xor(sm, 2); sm += __shfl_xor(sm, 4);
        bs += __shfl_xor(bs, 1); bs += __shfl_xor(bs, 2); bs += __shfl_xor(bs, 4);
        const float mean = sm * (1.f / 64.f); float vs = 0.f;
#pragma unroll
        for (int j = 0; j < 8; ++j) { y[j] -= mean; vs += y[j] * y[j]; }
        vs += __shfl_xor(vs, 1); vs += __shfl_xor(vs, 2); vs += __shfl_xor(vs, 4);
        const float rstd = rsqrtf(vs * (1.f / 64.f) + 64e-5f);
        h16x8 ov;
#pragma unroll
        for (int j = 0; j < 8; ++j) ov[j] = (h16)((y[j] * rstd * lg[j] + lb[j] + bs * (float)v8[j]) * (float)g8[j]);
        *(h16x8*)(YB + o) = ov;
    }
}


__device__ __forceinline__ void ins16(unsigned (&L)[16], unsigned x) {
#pragma unroll
    for (int j = 0; j < 16; ++j) { const unsigned hi = L[j] > x ? L[j] : x; x = L[j] > x ? x : L[j]; L[j] = hi; }
}
__device__ __forceinline__ unsigned ord32(float f) { const unsigned u = __float_as_uint(f); return (u & 0x80000000u) ? ~u : (u | 0x80000000u); }
__device__ __forceinline__ float unord32(unsigned k) { return __uint_as_float((k & 0x80000000u) ? (k & 0x7fffffffu) : ~k); }
__device__ __forceinline__ void phase_topk(const Args& a, LAS unsigned char* lds) {
    const int tid = tid_();
    const h16* SC = (const h16*)(a.ws + O_SCORES);
    const float* part = (const float*)(a.ws + O_PART1);
    unsigned short* IDX = (unsigned short*)(a.ws + O_IDX); float* GATE = (float*)(a.ws + O_GATE); float* RS1 = (float*)(a.ws + O_RS1);
    LAS unsigned char* LI = lds;
    for (int task = blockIdx.x * NTHREADS + tid; task < MTOK * 8; task += gridDim.x * NTHREADS) {
        const int t = task >> 3, h = task & 7;
        float ssq = 0.f;
#pragma unroll
        for (int j = 0; j < 4; ++j) { const f32x4 p4 = *(const f32x4*)(part + (size_t)t * 16 + 4 * j); ssq += (p4[0] + p4[1]) + (p4[2] + p4[3]); }
        const float rs = rsqrtf(ssq * (1.f / 1024.f) + NORM_EPS);
        if (h == 0) RS1[t] = rs;
        float sv[2][16];
#pragma unroll
        for (int c = 0; c < 2; ++c) {
            unsigned L[16];
#pragma unroll
            for (int j = 0; j < 16; ++j) L[j] = 0u;
            const h16* row = SC + (size_t)t * 2048 + h * 256 + c * 128;
#pragma unroll 2
            for (int n8 = 0; n8 < 16; ++n8) {
                const u32x4 w4 = *(const u32x4*)(row + n8 * 8);
#pragma unroll
                for (int e = 0; e < 8; ++e) {
                    const unsigned bits = (e & 1) ? (w4[e >> 1] >> 16) : (w4[e >> 1] & 0xffffu);
                    const unsigned o16 = (bits & 0x8000u) ? (~bits & 0xffffu) : (bits | 0x8000u);
                    ins16(L, (o16 << 16) | (unsigned)(127 - (n8 * 8 + e)));
                }
            }
#pragma unroll
            for (int j = 0; j < 16; ++j) {
                const unsigned o16 = L[j] >> 16; const unsigned bits = (o16 & 0x8000u) ? (o16 & 0x7fffu) : (~o16 & 0xffffu);
                union { unsigned short u; h16 f; } cv; cv.u = (unsigned short)bits; sv[c][j] = (float)cv.f;
                LI[(c * 16 + j) * 512 + tid] = (unsigned char)(127u - (L[j] & 127u));
            }
        }
        unsigned L[16];
#pragma unroll
        for (int j = 0; j < 16; ++j) L[j] = 0u;
#pragma unroll
        for (int i = 0; i < 16; ++i)
#pragma unroll
            for (int j = 0; j < 16; ++j) if ((i + 1) * (j + 1) <= 16) ins16(L, (ord32(sv[0][i] + sv[1][j]) & ~255u) | (unsigned)(255 - (i * 16 + j)));
        float e[16]; float den = 0.f; const float mx = unord32(L[0] & ~255u) * rs;
        unsigned short id[16];
#pragma unroll
        for (int k = 0; k < 16; ++k) {
            const float v = unord32(L[k] & ~255u) * rs; e[k] = __expf(v - mx); den += e[k];
            const unsigned pos = 255u - (L[k] & 255u); const unsigned i = pos >> 4, j = pos & 15u;
            id[k] = (unsigned short)((unsigned)LI[i * 512 + tid] * 128u + (unsigned)LI[(16 + j) * 512 + tid]);
        }
        const float inv = __builtin_amdgcn_rcpf(den);
        u32x4 i0, i1;
        i0[0] = id[0] | (id[1] << 16); i0[1] = id[2] | (id[3] << 16); i0[2] = id[4] | (id[5] << 16); i0[3] = id[6] | (id[7] << 16);
        i1[0] = id[8] | (id[9] << 16); i1[1] = id[10] | (id[11] << 16); i1[2] = id[12] | (id[13] << 16); i1[3] = id[14] | (id[15] << 16);
        u32x4* ip = (u32x4*)(IDX + (size_t)task * 16); ip[0] = i0; ip[1] = i1;
        f32x4* gp = (f32x4*)(GATE + (size_t)task * 16);
#pragma unroll
        for (int k4 = 0; k4 < 4; ++k4) gp[k4] = (f32x4){e[4 * k4] * inv, e[4 * k4 + 1] * inv, e[4 * k4 + 2] * inv, e[4 * k4 + 3] * inv};
    }
}

__device__ __forceinline__ float gelu_tanh(float x) { const float u = 0.7978845608028654f * (x + 0.044715f * x * x * x); return 0.5f * x * (1.0f + tanhf_(u)); }
__device__ __forceinline__ unsigned xcc_id() { return (unsigned)__builtin_amdgcn_s_getreg((3 << 11) | 20) & 7u; }
constexpr int GA_TC = 32, GA_NCH = MTOK / GA_TC;
__device__ __forceinline__ void dec16(const u32x4 q, float (&o)[16]) {
#pragma unroll
    for (int w = 0; w < 4; ++w) { const f32x2 lo = __builtin_amdgcn_cvt_pk_f32_fp8((int)q[w], false), hi = __builtin_amdgcn_cvt_pk_f32_fp8((int)q[w], true);
        o[4 * w] = lo[0]; o[4 * w + 1] = lo[1]; o[4 * w + 2] = hi[0]; o[4 * w + 3] = hi[1]; }
}
struct GIdx { u32x4 a, b; };
__device__ __forceinline__ GIdx g_ldidx(const unsigned short* IDX, int t, int r8) { const u32x4* ip = (const u32x4*)(IDX + (size_t)t * 128 + 16 * r8); GIdx r; r.a = ip[0]; r.b = ip[1]; return r; }
__device__ __forceinline__ void g_issue8(const unsigned char* TBs, unsigned lo, const u32x4 ix, u32x4 (&q)[8]) {
#pragma unroll
    for (int i = 0; i < 8; ++i) { const unsigned w = ix[i >> 1]; const unsigned e = (i & 1) ? (w >> 16) : (w & 0xffffu); q[i] = *(const u32x4*)(TBs + (e * 128u + lo)); }
}
struct GSide { u32x4 a, b, c, d; };
template <int PH> __device__ __forceinline__ GSide g_ldside(const Args& a, int t, int j, int m, int r8) {
    GSide r;
    if (PH == 0) { const u32x4* xp = (const u32x4*)((const h16*)(a.ws + O_H1B) + (size_t)t * 1024 + 128 * j + 16 * m); r.a = xp[0]; r.b = xp[1]; r.c = r.a; r.d = r.b; }
    else { const u32x4* cp = (const u32x4*)((const float*)(a.ws + O_COEF) + (size_t)t * 128 + 16 * r8); r.a = cp[0]; r.b = cp[1]; r.c = cp[2]; r.d = cp[3]; }
    return r;
}
template <int PH, int HALF> __device__ __forceinline__ void g_half(u32x4 (&q)[8], const GSide& sd, float (&pa)[16]) {
    if (PH == 0) {
        float x[16];
#pragma unroll
        for (int k = 0; k < 8; ++k) { const h16x8 xa = __builtin_bit_cast(h16x8, sd.a), xb = __builtin_bit_cast(h16x8, sd.b); x[k] = (float)xa[k]; x[8 + k] = (float)xb[k]; }
#pragma unroll
        for (int i = 0; i < 8; ++i) { float d[16]; dec16(q[i], d); float s0 = 0.f, s1 = 0.f;
#pragma unroll
            for (int k = 0; k < 8; ++k) { s0 += x[2 * k] * d[2 * k]; s1 += x[2 * k + 1] * d[2 * k + 1]; }
            pa[8 * HALF + i] = s0 + s1; }
    } else {
#pragma unroll
        for (int i = 0; i < 8; ++i) { float d[16]; dec16(q[i], d);
            const float cf = __uint_as_float(HALF == 0 ? (i < 4 ? sd.a[i & 3] : sd.b[i & 3]) : (i < 4 ? sd.c[i & 3] : sd.d[i & 3]));
#pragma unroll
            for (int k = 0; k < 16; ++k) pa[k] += cf * d[k];
            if (i + 1 < 8) asm volatile("" : "+v"(q[i + 1][0]), "+v"(q[i + 1][1]), "+v"(q[i + 1][2]), "+v"(q[i + 1][3]));
        }
    }
}
template <int PH> __device__ __forceinline__ void g_finish(const Args& a, int t, int j, int lane, float (&p)[16]) {
    const int m = lane & 7, r8 = lane >> 3;
    float q8[8], q4[4], q2[2];
    if (PH == 0) {
#pragma unroll
        for (int i = 0; i < 8; ++i) { const float keep = (lane & 4) ? p[i + 8] : p[i], send = (lane & 4) ? p[i] : p[i + 8]; q8[i] = keep + xhm_(send); }
#pragma unroll
        for (int i = 0; i < 4; ++i) { const float keep = (lane & 2) ? q8[i + 4] : q8[i], send = (lane & 2) ? q8[i] : q8[i + 4]; q4[i] = keep + dpp_<0x4E>(send); }
#pragma unroll
        for (int i = 0; i < 2; ++i) { const float keep = (lane & 1) ? q4[i + 2] : q4[i], send = (lane & 1) ? q4[i] : q4[i + 2]; q2[i] = keep + dpp_<0xB1>(send); }
        *(f32x2*)((float*)(a.ws + O_PART) + ((size_t)j * MTOK + t) * 128 + 16 * r8 + 2 * m) = (f32x2){q2[0], q2[1]};
    } else {
#pragma unroll
        for (int i = 0; i < 8; ++i) { const float keep = (lane & 32) ? p[i + 8] : p[i], send = (lane & 32) ? p[i] : p[i + 8]; q8[i] = keep + x32_(send, lane); }
#pragma unroll
        for (int i = 0; i < 4; ++i) { const float keep = (lane & 16) ? q8[i + 4] : q8[i], send = (lane & 16) ? q8[i] : q8[i + 4]; q4[i] = keep + x16_(send, lane); }
#pragma unroll
        for (int i = 0; i < 2; ++i) { const float keep = (lane & 8) ? q4[i + 2] : q4[i], send = (lane & 8) ? q4[i] : q4[i + 2]; q2[i] = keep + x8_(send); }
        const int col = 128 * j + 16 * m + 2 * r8;
        float* op = a.out + (size_t)t * 1024 + col;
        f32x2 hv = *(const f32x2*)op; hv[0] += q2[0]; hv[1] += q2[1];
        *(f32x2*)op = hv;
        *(h16x2*)((h16*)(a.ws + O_H2B) + (size_t)t * 1024 + col) = (h16x2){(h16)hv[0], (h16)hv[1]};
        const float ss = wave_sum(hv[0] * hv[0] + hv[1] * hv[1]);
        if (lane == 0) ((float*)(a.ws + O_SS2))[(size_t)t * 8 + j] = ss;
    }
}
template <int PH>
__device__ __forceinline__ void phase_gather(const Args& a, int cset) {
    const int tid = tid_(), lane = tid & 63, m = lane & 7, r8 = lane >> 3;
    unsigned* ctr = (unsigned*)(a.ws + O_CTR) + cset * 8 * 64;
    const unsigned short* IDX = (const unsigned short*)(a.ws + O_IDX);
    const unsigned j0 = xcc_id();
    for (unsigned dj = 0; dj < 8; ++dj) {
        const unsigned j = (j0 + dj) & 7u;
        const unsigned char* TB = a.ws + (PH ? O_V8 : O_U8) + (size_t)j * 16384 * 128; const unsigned lo16 = 16u * (unsigned)m;
        for (;;) {
            unsigned c = 0; if (lane == 0) c = __hip_atomic_fetch_add(ctr + j * 64, 1u, __ATOMIC_RELAXED, __HIP_MEMORY_SCOPE_AGENT);
            c = (unsigned)__builtin_amdgcn_readfirstlane((int)c);
            if (c >= (unsigned)GA_NCH) break;
            const int t0 = c * GA_TC;
            u32x4 qa[8], qb[8]; GSide sd, sn; GIdx ix, ixn;
            ix = g_ldidx(IDX, t0, r8); g_issue8(TB, lo16, ix.a, qa); sd = g_ldside<PH>(a, t0, j, m, r8);
#pragma unroll 1
            for (int ti = 0; ti < GA_TC; ++ti) {
                const int t = t0 + ti, tn = (ti + 1 < GA_TC) ? t + 1 : t;
                g_issue8(TB, lo16, ix.b, qb); ixn = g_ldidx(IDX, tn, r8); sn = g_ldside<PH>(a, tn, j, m, r8);
                float p[16];
                if (PH == 1) {
#pragma unroll
                    for (int k = 0; k < 16; ++k) p[k] = 0.f;
                }
                g_half<PH, 0>(qa, sd, p);
                g_issue8(TB, lo16, ixn.a, qa);
                g_half<PH, 1>(qb, sd, p);
                g_finish<PH>(a, t, j, lane, p);
                ix = ixn; sd = sn;
            }
        }
    }
}
__device__ __forceinline__ void phase_coef(const Args& a) {
    const int tid = tid_();
    const float* PART = (const float*)(a.ws + O_PART); const unsigned short* IDX = (const unsigned short*)(a.ws + O_IDX);
    const float* GATE = (const float*)(a.ws + O_GATE); const float* RS1 = (const float*)(a.ws + O_RS1);
    const float* USC = (const float*)(a.ws + O_USC); const float* VSC = (const float*)(a.ws + O_VSC); float* COEF = (float*)(a.ws + O_COEF);
    for (int i = blockIdx.x * NTHREADS + tid; i < MTOK * 128; i += gridDim.x * NTHREADS) {
        float s = 0.f;
#pragma unroll
        for (int j = 0; j < 8; ++j) s += PART[(size_t)j * MTOK * 128 + i];
        const unsigned e = IDX[i];
        COEF[i] = GATE[i] * gelu_tanh(RS1[i >> 7] * USC[e] * s) * VSC[e];
    }
}

__device__ __forceinline__ void phase_final(const Args& a) {
    const int tid = tid_(), lane = tid & 63, wave = tid >> 6;
    const int gw = blockIdx.x * NWAVES + wave, NGW = gridDim.x * NWAVES;
    const float* part = (const float*)(a.ws + O_PART3); const float* fg = a.in[28];
    f32x4 g4[4];
#pragma unroll
    for (int j = 0; j < 4; ++j) g4[j] = *((const f32x4*)fg + lane + 64 * j);
    for (int r = gw; r < MTOK; r += NGW) {
        float s = (lane < 16) ? part[(size_t)r * 16 + lane] : 0.f;
        s = wave_sum(s);
        const float rs = rsqrtf(s * (1.f / 1024.f) + NORM_EPS);
        f32x4* xr = (f32x4*)(a.out + (size_t)r * 1024) + lane;
#pragma unroll
        for (int j = 0; j < 4; ++j) xr[64 * j] = xr[64 * j] * rs * g4[j];
    }
}

constexpr int NPHASE = 19;
__global__ void __launch_bounds__(NTHREADS, 2) mk(Args a) {
    extern __shared__ __attribute__((aligned(16))) unsigned char smem[];
    LAS unsigned char* lds = (LAS unsigned char*)smem;
    unsigned char* ws = a.ws;
#if ONE_LAUNCH
    cg::grid_group grid = cg::this_grid();
    volatile LAS unsigned* bst = (volatile LAS unsigned*)(lds + 131072);
    if (threadIdx.x < 2) bst[threadIdx.x] = 0u;
    __syncthreads();
    const XcdBarrier xbar = xcd_barrier_post((unsigned*)(a.ws + O_BAR), bst);
    bool first_sync = true;
#define SYNC() do { if (first_sync) { grid.sync(); first_sync = false; } else xcd_barrier(xbar); } while (0)
#else
#define SYNC() do {} while (0)
#endif
#define IN(k) (a.ph_lo <= (k) && (k) < a.ph_hi)
#define SEAM(k) do { if (IN(k) && IN((k) + 1)) SYNC(); } while (0)
#define REPS(k) ((((REP_MASK) >> (k)) & 1u) ? 2 : 1)
    const int G = gridDim.x, bid = blockIdx.x;
    if (IN(0)) for (int rep = 0; rep < REPS(0); ++rep) { if (rep) SYNC(); phase_prep(a, lds); } SEAM(0);
    if (IN(1)) for (int rep = 0; rep < REPS(1); ++rep) { if (rep) SYNC(); pg8::Gemm g{(const h16*)(ws + O_XN), (const h16*)(ws + O_WIN), MTOK, NIN, 1024}; pg8::StaticOrder S; S.init(MTOK, NIN, G, bid);
        EpiZ E{(h16*)(ws + O_ZC), (h16*)(ws + O_ZR), (h16*)(ws + O_ZG)}; pg8::gemm_phase(lds, g, S, E); } SEAM(1);
    if (IN(2)) for (int rep = 0; rep < REPS(2); ++rep) { if (rep) SYNC(); phase_conv(a); phase_rwkv_prep(a); } SEAM(2);
    if (IN(3)) for (int rep = 0; rep < REPS(3); ++rep) { if (rep) SYNC(); pg8::Gemm g{(const h16*)(ws + O_APR), (const h16*)(ws + O_WLR), MTOK, 1536, 256}; pg8::StaticOrder S; S.init(MTOK, 1536, G, bid);
        h16* R = (h16*)a.out; h16* KS = R + (size_t)MTOK * 512; h16* KK = KS + (size_t)2 * MTOK * 512;
        EpiLR E{a.in[7], a.in[9], a.in[13], (h16*)(ws + O_WD), KS, (h16*)(ws + O_BD), (h16*)(ws + O_GG), KK}; pg8::gemm_phase(lds, g, S, E); } SEAM(3);
    if (IN(4)) for (int rep = 0; rep < REPS(4); ++rep) { if (rep) SYNC(); phase_scan<true>(a, lds); } SEAM(4);
    if (IN(5)) for (int rep = 0; rep < REPS(5); ++rep) { if (rep) SYNC(); phase_scan_combine(a, lds); } SEAM(5);
    if (IN(6)) for (int rep = 0; rep < REPS(6); ++rep) { if (rep) SYNC(); phase_scan<false>(a, lds); } SEAM(6);
    if (IN(7)) for (int rep = 0; rep < REPS(7); ++rep) { if (rep) SYNC(); phase_rwkv_post(a); } SEAM(7);
    if (IN(8)) for (int rep = 0; rep < REPS(8); ++rep) { if (rep) SYNC(); pg8::Gemm g{(const h16*)(ws + O_CA), (const h16*)(ws + O_WA), MTOK, 1024, 512}; pg8::StaticOrder S; S.init(MTOK, 1024, G, bid);
        EpiYA E{(const h16*)(ws + O_ZG), a.out}; pg8::gemm_phase(lds, g, S, E); } SEAM(8);
    if (IN(9)) for (int rep = 0; rep < REPS(9); ++rep) { if (rep) SYNC(); pg8::Gemm g{(const h16*)(ws + O_YB), (const h16*)(ws + O_WB), MTOK, 1024, 512}; pg8::StaticOrder S; S.init(MTOK, 1024, G, bid);
        EpiYB E{(const h16*)(ws + O_ZG), a.out, (h16*)(ws + O_MERGED)}; pg8::gemm_phase(lds, g, S, E); } SEAM(9);
    if (IN(10)) for (int rep = 0; rep < REPS(10); ++rep) { if (rep) SYNC(); pg8::Gemm g{(const h16*)(ws + O_MERGED), (const h16*)(ws + O_WO), MTOK, 1024, 1024}; pg8::StaticOrder S; S.init(MTOK, 1024, G, bid);
        EpiH1 E{a.in[0], a.out, (h16*)(ws + O_H1B), (float*)(ws + O_PART1)}; pg8::gemm_phase(lds, g, S, E); } SEAM(10);
    if (IN(11)) for (int rep = 0; rep < REPS(11); ++rep) { if (rep) SYNC(); pg8::Gemm g{(const h16*)(ws + O_H1B), (const h16*)(ws + O_WS), MTOK, 2048, 1024}; pg8::StaticOrder S; S.init(MTOK, 2048, G, bid);
        EpiF16 E{(h16*)(ws + O_SCORES), 2048}; pg8::gemm_phase(lds, g, S, E); } SEAM(11);
    if (IN(12)) for (int rep = 0; rep < REPS(12); ++rep) { if (rep) SYNC(); phase_topk(a, lds); } SEAM(12);
    if (IN(13)) for (int rep = 0; rep < REPS(13); ++rep) { if (rep) SYNC(); phase_gather<0>(a, 2 * rep); } SEAM(13);
    if (IN(14)) for (int rep = 0; rep < REPS(14); ++rep) { if (rep) SYNC(); phase_coef(a); } SEAM(14);
    if (IN(15)) for (int rep = 0; rep < REPS(15); ++rep) { if (rep) SYNC(); phase_gather<1>(a, 1); } SEAM(15);
    if (IN(16)) for (int rep = 0; rep < REPS(16); ++rep) { if (rep) SYNC(); pg8::Gemm g{(const h16*)(ws + O_P16), (const h16*)(ws + O_WP), MTOK, 1024, 256}; pg8::StaticOrder S; S.init(MTOK, 1024, G, bid);
        EpiF16 E{(h16*)(ws + O_PP), 1024}; pg8::gemm_phase(lds, g, S, E); } SEAM(16);
    if (IN(17)) for (int rep = 0; rep < REPS(17); ++rep) { if (rep) SYNC(); pg8::Gemm g{(const h16*)(ws + O_H2B), (const h16*)(ws + O_WG), MTOK, 1024, 1024}; pg8::StaticOrder S; S.init(MTOK, 1024, G, bid);
        EpiGate E{a.out, (const h16*)(ws + O_PP), (const float*)(ws + O_SS2), (float*)(ws + O_PART3)}; pg8::gemm_phase(lds, g, S, E); } SEAM(17);
    if (IN(18)) for (int rep = 0; rep < REPS(18); ++rep) { if (rep) SYNC(); phase_final(a); }
}

extern "C" void kernel_launch(void* const* d_in, const int* in_sizes, int n_in, void* d_out, int out_size, void* d_ws, size_t ws_size, hipStream_t stream) {
    static int ready = 0;
    if (!ready) {
        if (n_in != 29 || ws_size < WS_END) { fprintf(stderr, "kernel_launch: unexpected n_in %d / ws %zu (need %zu)\n", n_in, ws_size, (size_t)WS_END); ready = -1; return; }
        if (hipFuncSetAttribute((const void*)mk, hipFuncAttributeMaxDynamicSharedMemorySize, LDS_BYTES) != hipSuccess) { fprintf(stderr, "hipFuncSetAttribute failed\n"); ready = -1; return; }
        ready = 1;
    }
    if (ready < 0) return;
    Args a{};
    for (int i = 0; i < 29; ++i) a.in[i] = (const float*)d_in[i];
    a.out = (float*)d_out; a.ws = (unsigned char*)d_ws;
#if ONE_LAUNCH
    (void)hipMemsetAsync((unsigned char*)d_ws + O_BAR, 0, 16384, stream);
    a.ph_lo = 0; a.ph_hi = NPHASE;
    void* args[] = {&a};
    hipLaunchCooperativeKernel((const void*)mk, dim3(NBLK), dim3(NTHREADS), args, LDS_BYTES, stream);
#else
    const int phases[] = {0, 1, 2, 3, 4, 5, 6, 7, 8, 9, 10, 11, 12, 13, 14, 15, 16, 17, 18};
    for (int ph : phases) { a.ph_lo = ph; a.ph_hi = ph + 1; hipLaunchKernelGGL(mk, dim3(NBLK), dim3(NTHREADS), LDS_BYTES, stream, a); }
#endif
}
```

```cpp
#include <hip/hip_runtime.h>
#include <hip/hip_cooperative_groups.h>
#include <cstdio>
namespace cg = cooperative_groups;

#ifndef REP_MASK
#define REP_MASK 0u
#endif
#ifndef ONE_LAUNCH
#define ONE_LAUNCH 1
#endif

#define LAS __attribute__((address_space(3)))
typedef _Float16 h16;
typedef _Float16 h16x8 __attribute__((ext_vector_type(8)));
typedef _Float16 h16x4 __attribute__((ext_vector_type(4)));
typedef _Float16 h16x2 __attribute__((ext_vector_type(2)));
typedef float f32x4 __attribute__((ext_vector_type(4)));
typedef float f32x2 __attribute__((ext_vector_type(2)));
typedef unsigned u32x4 __attribute__((ext_vector_type(4)));
typedef unsigned u32x2 __attribute__((ext_vector_type(2)));

constexpr int MTOK = 65536, DM = 1024, SEQ = 8192, NB = 8;
constexpr int NIN = 5376;
constexpr int NTHREADS = 512, NWAVES = 8, NBLK = 256;
constexpr int LDS_BYTES = 131072 + 64;
constexpr float NORM_EPS = 1e-6f;

constexpr size_t MiB = 1u << 20;
constexpr size_t O_WIN = 0;
constexpr size_t O_WA = O_WIN + (size_t)5376 * 1024 * 2;
constexpr size_t O_WB = O_WA + 1 * MiB;
constexpr size_t O_WO = O_WB + 1 * MiB;
constexpr size_t O_WG = O_WO + 2 * MiB;
constexpr size_t O_WP = O_WG + 2 * MiB;
constexpr size_t O_WLR = O_WP + MiB / 2;
constexpr size_t O_WS = O_WLR + 3 * MiB / 4;
constexpr size_t O_U16 = O_WS + 4 * MiB;
constexpr size_t O_V16 = O_U16 + 32 * MiB;
constexpr size_t O_P16 = O_V16 + 32 * MiB;
constexpr size_t O_PART1 = O_P16 + 32 * MiB;
constexpr size_t O_PART3 = O_PART1 + 4 * MiB;
constexpr size_t O_RS1 = O_PART3 + 4 * MiB;
constexpr size_t O_RS2 = O_RS1 + MiB / 4;
constexpr size_t O_XN = O_RS2 + MiB / 4;
constexpr size_t O_ZC = O_XN + 128 * MiB;
constexpr size_t O_ZR = O_ZC + 192 * MiB;
constexpr size_t O_ZG = O_ZR + 224 * MiB;
constexpr size_t O_SS2 = O_ZG + 256 * MiB;
constexpr size_t O_USC = O_SS2 + 2 * MiB;
constexpr size_t O_VSC = O_USC + 65536;
constexpr size_t O_CTR = O_VSC + 65536;
constexpr size_t O_BAR = O_CTR + 8192;
constexpr size_t WS_END = O_BAR + 16384;
constexpr size_t O_U8 = O_U16;
constexpr size_t O_V8 = O_U16 + 16 * MiB;
constexpr size_t O_PART = O_ZG;
constexpr size_t O_COEF = O_ZR + 48 * MiB;
constexpr size_t O_CA = O_XN;
constexpr size_t O_APR = O_XN + 64 * MiB;
constexpr size_t O_H1B = O_XN;
constexpr size_t O_WD = O_ZC;
constexpr size_t O_BD = O_ZC + 64 * MiB;
constexpr size_t O_GG = O_ZC + 128 * MiB;
constexpr size_t O_MERGED = O_ZC;
constexpr size_t O_H2B = O_ZC;
constexpr size_t O_PQ = O_ZR;
constexpr size_t O_SST = O_ZR + 64 * MiB;
constexpr size_t O_Y = O_ZR + 96 * MiB;
constexpr size_t O_YB = O_ZR + 160 * MiB;
constexpr size_t O_IDX = O_ZR;
constexpr size_t O_GATE = O_ZR + 16 * MiB;
constexpr size_t O_PP = O_ZR + 64 * MiB;
constexpr size_t O_SCORES = O_ZG;

struct Args {
    const float* in[29];
    float* out;
    unsigned char* ws;
    int ph_lo, ph_hi;
};

__device__ __forceinline__ int tid_() { int t = threadIdx.x; asm volatile("" : "+v"(t)); return t; }
__device__ __forceinline__ float sigmoidf_(float x) { return __builtin_amdgcn_rcpf(1.0f + __expf(-x)); }
template <int CTRL> __device__ __forceinline__ float dpp_(float v) { return __builtin_bit_cast(float, __builtin_amdgcn_update_dpp(0, __builtin_bit_cast(int, v), CTRL, 0xF, 0xF, true)); }
__device__ __forceinline__ float x32_(float v, int lane) { const auto r = __builtin_amdgcn_permlane32_swap(__builtin_bit_cast(unsigned, v), __builtin_bit_cast(unsigned, v), false, false); return __builtin_bit_cast(float, (lane & 32) ? r[0] : r[1]); }
__device__ __forceinline__ float x16_(float v, int lane) { const auto r = __builtin_amdgcn_permlane16_swap(__builtin_bit_cast(unsigned, v), __builtin_bit_cast(unsigned, v), false, false); return __builtin_bit_cast(float, (lane & 16) ? r[0] : r[1]); }
__device__ __forceinline__ float x8_(float v) { return dpp_<0x128>(v); }
__device__ __forceinline__ float xhm_(float v) { return dpp_<0x141>(v); }
__device__ __forceinline__ float wave_sum(float v) {
    const int lane = threadIdx.x & 63;
    v += dpp_<0xB1>(v); v += dpp_<0x4E>(v); v += dpp_<0x141>(v); v += dpp_<0x140>(v);
    v += x16_(v, lane); v += x32_(v, lane);
    return v;
}
__device__ __forceinline__ h16x8 pack8(f32x4 a, f32x4 b) {
    h16x8 r;
    r[0] = (h16)a[0]; r[1] = (h16)a[1]; r[2] = (h16)a[2]; r[3] = (h16)a[3];
    r[4] = (h16)b[0]; r[5] = (h16)b[1]; r[6] = (h16)b[2]; r[7] = (h16)b[3];
    return r;
}
__device__ __forceinline__ h16x4 pack4(f32x4 a) {
    h16x4 r; r[0] = (h16)a[0]; r[1] = (h16)a[1]; r[2] = (h16)a[2]; r[3] = (h16)a[3]; return r;
}

#define XB_TMO      128
#define XB_XCNT(j)  (256  + 64 * (j))
#define XB_XSUB(j)  (1280 + 64 * (j))
#define XB_XGEN(j)  (2304 + 64 * (j))
#define XB_TOP      3328
#define XB_TOPGEN   3392
#define XCD_BAR_WORDS 3456
#define XB_SPIN_CAP (1u << 18)

__device__ __forceinline__ unsigned xb_ld(unsigned* p)              { return __hip_atomic_load(p, __ATOMIC_RELAXED, __HIP_MEMORY_SCOPE_AGENT); }
__device__ __forceinline__ unsigned xb_add(unsigned* p, unsigned v) { return __hip_atomic_fetch_add(p, v, __ATOMIC_RELAXED, __HIP_MEMORY_SCOPE_AGENT); }
__device__ __forceinline__ unsigned xb_xcc_id() { return (unsigned)__builtin_amdgcn_s_getreg((3 << 11) | 20) & 0xFu; }
#define XB_SPIN(cond, bar) do { unsigned _sp = 0; while (cond) { __builtin_amdgcn_s_sleep(1); \
    if ((++_sp & 255u) == 0u) { if (xb_ld(&(bar)[XB_TMO])) break; if (_sp > XB_SPIN_CAP) { atomicAdd(&(bar)[XB_TMO], 1u); break; } } } } while (0)

struct XcdBarrier {
    unsigned* bar; unsigned x;
    volatile LAS unsigned* st;
};

__device__ __forceinline__ XcdBarrier xcd_barrier_post(unsigned* bar, volatile LAS unsigned* st) {
    XcdBarrier b; b.bar = bar; b.x = xb_xcc_id(); b.st = st;
    if (threadIdx.x == 0) (void)xb_add(&bar[XB_XCNT(b.x)], 1u);
    return b;
}
__device__ __forceinline__ void xcd_barrier_complete(unsigned* bar, unsigned x, unsigned& nloc, unsigned& nx) {
    const unsigned G = gridDim.x * gridDim.y * gridDim.z;
    unsigned sum, cnt, mine, sp = 0u;
    for (;;) {
        sum = 0u; cnt = 0u; mine = 0u;
#pragma unroll
        for (unsigned j = 0; j < 16; ++j) { const unsigned c = xb_ld(&bar[XB_XCNT(j)]); sum += c; cnt += (c > 0u) ? 1u : 0u; mine = (j == x) ? c : mine; }
        if (sum == G) break;
        __builtin_amdgcn_s_sleep(1);
        if ((++sp & 255u) == 0u) { if (xb_ld(&bar[XB_TMO])) break; if (sp > XB_SPIN_CAP) { atomicAdd(&bar[XB_TMO], 1u); break; } }
    }
    nloc = mine > 0u ? mine : 1u; nx = cnt > 0u ? cnt : 1u;
}

__device__ __forceinline__ void xcd_barrier(const XcdBarrier& b) {
    asm volatile("s_waitcnt vmcnt(0)" ::: "memory");
    __syncthreads();
    if (threadIdx.x == 0) {
        unsigned* bar = b.bar;
        __builtin_amdgcn_s_waitcnt(0);
        unsigned nloc = b.st[0], nx = b.st[1];
        if (nloc == 0u) { xcd_barrier_complete(bar, b.x, nloc, nx); b.st[0] = nloc; b.st[1] = nx; }
        const unsigned old = xb_add(&bar[XB_XSUB(b.x)], 1u);
        const unsigned gen = old / nloc;
        if (old + 1u == (gen + 1u) * nloc) {
            __builtin_amdgcn_fence(__ATOMIC_RELEASE, "agent");
            asm volatile("s_waitcnt vmcnt(0)" ::: "memory");
            const unsigned og = xb_add(&bar[XB_TOP], 1u);
            const unsigned tg = og / nx;
            if (og + 1u == (tg + 1u) * nx) xb_add(&bar[XB_TOPGEN], 1u);
            else XB_SPIN(xb_ld(&bar[XB_TOPGEN]) == tg, bar);
            __builtin_amdgcn_fence(__ATOMIC_ACQUIRE, "agent");
            xb_add(&bar[XB_XGEN(b.x)], 1u);
            asm volatile("s_waitcnt vmcnt(0)" ::: "memory");
        } else {
            XB_SPIN(xb_ld(&bar[XB_XGEN(b.x)]) == gen, bar);
            __builtin_amdgcn_fence(__ATOMIC_ACQUIRE, "agent");
            asm volatile("s_waitcnt vmcnt(0)" ::: "memory");
        }
    }
    __syncthreads();
}


namespace pg8 {
constexpr int BM = 256, BK = 64, HALF = 128, HTB = HALF * BK * 2, STAGE_BYTES = 8 * HTB, NXCD = 8, WGM = 8;
__device__ __forceinline__ int lds_byte(int r, int c) { const int st = (r >> 4) * 2 + (c >> 5), rr = r & 15, cc = c & 31, ob = rr * 64 + cc * 2; return st * 1024 + (ob ^ (((ob >> 9) & 1) << 5)); }
__device__ __forceinline__ void stage_rc(int b, int& R, int& C) { const int st = b / 1024, sb = b % 1024, swz = sb ^ (((sb >> 9) & 1) << 5); R = (st >> 1) * 16 + swz / 64; C = (st & 1) * 32 + (swz % 64) / 2; }
__device__ __forceinline__ int perm32(int rho) { const int n = rho >> 4, i = rho & 15; return 8 * (i >> 2) + 4 * n + (i & 3); }

struct Unit { int pm, pn; };
struct Gemm { const h16* A; const h16* Bt; int M, N, K; };

struct StaticOrder {
    int nM, nN, nwg, G, c;
    __device__ void init(int M, int N, int G_, int c_) { nM = M / BM; nN = N / BM; nwg = nM * nN; G = G_; c = c_; }
    __device__ bool next(int i, Unit& u) const {
        const long L = (long)i * G + c; if (L >= nwg) return false;
        int wgid = (int)L; { const int q = nwg / NXCD, r = nwg % NXCD, xcd = wgid % NXCD, off = wgid / NXCD; wgid = (xcd < r ? xcd * (q + 1) : r * (q + 1) + (xcd - r) * q) + off; }
        const int nig = WGM * nN, gid = wgid / nig, fm = gid * WGM, gsz = (nM - fm) < WGM ? (nM - fm) : WGM;
        u.pm = fm + ((wgid % nig) % gsz); u.pn = (wgid % nig) / gsz; return true;
    }
};

template <class Epi>
__device__ __forceinline__ void gemm_phase(LAS unsigned char* lds, const Gemm g, const StaticOrder& S, const Epi& E) {
    const int tid = tid_(), wid = __builtin_amdgcn_readfirstlane(tid >> 6), lane = tid & 63, wr = wid >> 2, wc = wid & 3, fr = lane & 15, fq = lane >> 4;
    const int K = g.K, nt = K / BK;
    unsigned voffA[2], voffB[2];
#pragma unroll
    for (int i = 0; i < 2; ++i) { int R, C; stage_rc(tid * 16 + i * 8192, R, C); const int Rb = (R & ~31) + perm32(R & 31);
        voffA[i] = (unsigned)(R * K + C) * 2u; voffB[i] = (unsigned)(Rb * K + C) * 2u; }
    const size_t kstep = (size_t)(BK * 2);
    const size_t hstep = (size_t)HALF * K * 2;
    const size_t tstep = 2 * hstep;
    const unsigned ldsw = (unsigned)wid * 1024u;
    const int aoff = lds_byte(wr * 64 + fr, fq * 8), boff = lds_byte(wc * 32 + fr, fq * 8);
#define PG8_SA(b, h) (((b) * 2 + (h)) * HTB)
#define PG8_SB(b, h) ((4 + (b) * 2 + (h)) * HTB)
#define PG8_STAGE(bufoff, gbase, voff) do { _Pragma("unroll") for (int _i = 0; _i < 2; ++_i) \
        __builtin_amdgcn_global_load_lds((const unsigned*)((const char*)(gbase) + (voff)[_i]), (LAS unsigned*)(lds + (bufoff) + ldsw + _i * 8192), 16, 0, 0); } while (0)
#define PG8_LDA(dst, b, h) do { _Pragma("unroll") for (int m = 0; m < 4; ++m) _Pragma("unroll") for (int k = 0; k < 2; ++k) dst[m][k] = *(const LAS h16x8*)(lds + PG8_SA(b, h) + aoff + m * 2048 + k * 1024); } while (0)
#define PG8_LDB(dst, b, h) do { _Pragma("unroll") for (int n = 0; n < 2; ++n) _Pragma("unroll") for (int k = 0; k < 2; ++k) dst[n][k] = *(const LAS h16x8*)(lds + PG8_SB(b, h) + boff + n * 2048 + k * 1024); } while (0)
#define PG8_MMA(ai, bj, At, Bt) do { __builtin_amdgcn_s_setprio(1); _Pragma("unroll") for (int m = 0; m < 4; ++m) _Pragma("unroll") for (int n = 0; n < 2; ++n) _Pragma("unroll") for (int k = 0; k < 2; ++k) \
        acc[ai][bj][m][n] = __builtin_amdgcn_mfma_f32_16x16x32_f16(Bt[n][k], At[m][k], acc[ai][bj][m][n], 0, 0, 0); __builtin_amdgcn_s_setprio(0); } while (0)
#define PG8_WAIT_V(n) asm volatile("s_waitcnt vmcnt(" #n ")" ::: "memory")
#define PG8_WAIT_L(n) asm volatile("s_waitcnt lgkmcnt(" #n ")" ::: "memory")
#define PG8_BAR __builtin_amdgcn_s_barrier()
#define PG8_SCHED __builtin_amdgcn_sched_barrier(0)
    Unit cur, nxt; int ui = 0;
    if (!S.next(0, cur)) return;
    f32x4 acc[2][2][4][2];
#pragma unroll
    for (int a = 0; a < 2; ++a)
#pragma unroll
        for (int b = 0; b < 2; ++b)
#pragma unroll
            for (int m = 0; m < 4; ++m)
#pragma unroll
                for (int n = 0; n < 2; ++n) acc[a][b][m][n] = (f32x4){0.f, 0.f, 0.f, 0.f};
    h16x8 At[4][2], B0[2][2], B1[2][2];
    const char* cA = (const char*)g.A + (size_t)cur.pm * tstep; const char* cB = (const char*)g.Bt + (size_t)cur.pn * tstep;
    PG8_STAGE(PG8_SB(0, 0), cB, voffB); PG8_STAGE(PG8_SB(0, 1), cB + hstep, voffB); PG8_STAGE(PG8_SA(0, 0), cA, voffA); PG8_STAGE(PG8_SA(0, 1), cA + hstep, voffA);
    if (wr == 1) PG8_BAR;
    PG8_WAIT_V(2); PG8_BAR;
    PG8_STAGE(PG8_SB(1, 0), cB + kstep, voffB); PG8_STAGE(PG8_SA(1, 0), cA + kstep, voffA); PG8_STAGE(PG8_SB(1, 1), cB + hstep + kstep, voffB);
    PG8_WAIT_V(6); PG8_BAR;
    for (;;) {
        const bool has_next = S.next(ui + 1, nxt);
        const char* nA = has_next ? (const char*)g.A + (size_t)nxt.pm * tstep : cA; const char* nB = has_next ? (const char*)g.Bt + (size_t)nxt.pn * tstep : cB;
        for (int t = 0; t < nt; t += 2) {
            const bool last = (t == nt - 2);
            const char* a1 = cA + (size_t)(t + 1) * kstep;
            const char* a2 = last ? nA : cA + (size_t)(t + 2) * kstep; const char* b2 = last ? nB : cB + (size_t)(t + 2) * kstep;
            const char* a3 = a2 + kstep; const char* b3 = b2 + kstep;
            PG8_LDB(B0, 0, 0); PG8_LDB(B1, 0, 1); PG8_SCHED; PG8_LDA(At, 0, 0); PG8_STAGE(PG8_SA(1, 1), a1 + hstep, voffA);
            PG8_WAIT_V(8); PG8_WAIT_L(0); PG8_BAR; PG8_MMA(0, 0, At, B0); PG8_MMA(0, 1, At, B1); PG8_BAR; PG8_SCHED;
            PG8_LDA(At, 0, 1); PG8_STAGE(PG8_SB(0, 0), b2, voffB); PG8_STAGE(PG8_SB(0, 1), b2 + hstep, voffB); PG8_STAGE(PG8_SA(0, 0), a2, voffA);
            PG8_WAIT_V(8); PG8_WAIT_L(0); PG8_BAR; PG8_MMA(1, 0, At, B0); PG8_MMA(1, 1, At, B1); PG8_BAR; PG8_SCHED;
            PG8_LDB(B0, 1, 0); PG8_LDB(B1, 1, 1); PG8_SCHED; PG8_LDA(At, 1, 0); PG8_STAGE(PG8_SA(0, 1), a2 + hstep, voffA);
            PG8_WAIT_V(8); PG8_WAIT_L(0); PG8_BAR; PG8_MMA(0, 0, At, B0); PG8_MMA(0, 1, At, B1); PG8_BAR; PG8_SCHED;
            PG8_LDA(At, 1, 1); PG8_STAGE(PG8_SB(1, 0), b3, voffB); PG8_STAGE(PG8_SB(1, 1), b3 + hstep, voffB); PG8_STAGE(PG8_SA(1, 0), a3, voffA);
            PG8_WAIT_V(8); PG8_WAIT_L(0); PG8_BAR; PG8_MMA(1, 0, At, B0); PG8_MMA(1, 1, At, B1); PG8_BAR; PG8_SCHED;
        }
        if (wr == 0) PG8_BAR;
        E(acc, cur, wr, wc, fr, fq);
        if (!has_next) break;
#pragma unroll
        for (int a = 0; a < 2; ++a)
#pragma unroll
            for (int b = 0; b < 2; ++b)
#pragma unroll
                for (int m = 0; m < 4; ++m)
#pragma unroll
                    for (int n = 0; n < 2; ++n) acc[a][b][m][n] = (f32x4){0.f, 0.f, 0.f, 0.f};
        cur = nxt; cA = nA; cB = nB; ++ui;
        if (wr == 1) PG8_BAR;
    }
    PG8_WAIT_V(0);
    PG8_BAR;
#undef PG8_SA
#undef PG8_SB
#undef PG8_STAGE
#undef PG8_LDA
#undef PG8_LDB
#undef PG8_MMA
#undef PG8_WAIT_V
#undef PG8_WAIT_L
#undef PG8_BAR
#undef PG8_SCHED
}
}
using pg8::Unit;
typedef const f32x4 (&AccRef)[2][2][4][2];

#define EPI_LOOP_BEGIN \
    _Pragma("unroll") for (int ai = 0; ai < 2; ++ai) _Pragma("unroll") for (int m = 0; m < 4; ++m) { \
        const int row = u.pm * 256 + ai * 128 + wr * 64 + m * 16 + fr; \
        _Pragma("unroll") for (int bj = 0; bj < 2; ++bj) { \
            const int col = u.pn * 256 + bj * 128 + wc * 32 + 8 * fq; \
            const f32x4 v0 = acc[ai][bj][m][0], v1 = acc[ai][bj][m][1];
#define EPI_LOOP_END } }

struct EpiZ {
    h16 *zc, *zr, *zg;
    __device__ __forceinline__ void operator()(AccRef acc, const Unit& u, int wr, int wc, int fr, int fq) const {
        const int colt = u.pn * 256; h16* base; int ld, c0;
        if (colt < 1536) { base = zc; ld = 1536; c0 = colt; } else if (colt < 3328) { base = zr; ld = 1792; c0 = colt - 1536; } else { base = zg; ld = 2048; c0 = colt - 3328; }
        EPI_LOOP_BEGIN
            *(h16x8*)(base + (size_t)row * ld + (col - colt + c0)) = pack8(v0, v1);
        EPI_LOOP_END
    }
};
struct EpiF16 {
    h16* O; int ld;
    __device__ __forceinline__ void operator()(AccRef acc, const Unit& u, int wr, int wc, int fr, int fq) const {
        EPI_LOOP_BEGIN
            *(h16x8*)(O + (size_t)row * ld + col) = pack8(v0, v1);
        EPI_LOOP_END
    }
};
struct EpiYA {
    const h16* zg; float* tmp;
    __device__ __forceinline__ void operator()(AccRef acc, const Unit& u, int wr, int wc, int fr, int fq) const {
        EPI_LOOP_BEGIN
            const h16x8 gv = *(const h16x8*)(zg + (size_t)row * 2048 + col);
            f32x4 o0, o1;
#pragma unroll
            for (int j = 0; j < 4; ++j) { o0[j] = sigmoidf_((float)gv[j]) * v0[j]; o1[j] = sigmoidf_((float)gv[4 + j]) * v1[j]; }
            float* p = tmp + (size_t)row * 1024 + col;
            *(f32x4*)p = o0; *(f32x4*)(p + 4) = o1;
        EPI_LOOP_END
    }
};
struct EpiYB {
    const h16* zg; const float* tmp; h16* merged;
    __device__ __forceinline__ void operator()(AccRef acc, const Unit& u, int wr, int wc, int fr, int fq) const {
        EPI_LOOP_BEGIN
            const h16x8 gv = *(const h16x8*)(zg + (size_t)row * 2048 + 1024 + col);
            const float* p = tmp + (size_t)row * 1024 + col;
            f32x4 o0 = *(const f32x4*)p, o1 = *(const f32x4*)(p + 4);
#pragma unroll
            for (int j = 0; j < 4; ++j) { o0[j] += sigmoidf_((float)gv[j]) * v0[j]; o1[j] += sigmoidf_((float)gv[4 + j]) * v1[j]; }
            *(h16x8*)(merged + (size_t)row * 1024 + col) = pack8(o0, o1);
        EPI_LOOP_END
    }
};
struct EpiH1 {
    const float* x; float* out; h16* hb; float* part;
    __device__ __forceinline__ void operator()(AccRef acc, const Unit& u, int wr, int wc, int fr, int fq) const {
#pragma unroll
        for (int ai = 0; ai < 2; ++ai)
#pragma unroll
            for (int m = 0; m < 4; ++m) {
                const int row = u.pm * 256 + ai * 128 + wr * 64 + m * 16 + fr; float ss = 0.f;
#pragma unroll
                for (int bj = 0; bj < 2; ++bj) {
                    const int col = u.pn * 256 + bj * 128 + wc * 32 + 8 * fq;
                    const float* xp = x + (size_t)row * 1024 + col;
                    f32x4 o0 = *(const f32x4*)xp + acc[ai][bj][m][0], o1 = *(const f32x4*)(xp + 4) + acc[ai][bj][m][1];
                    float* op = out + (size_t)row * 1024 + col;
                    *(f32x4*)op = o0; *(f32x4*)(op + 4) = o1;
                    *(h16x8*)(hb + (size_t)row * 1024 + col) = pack8(o0, o1);
                    ss += (o0[0] * o0[0] + o0[1] * o0[1]) + (o0[2] * o0[2] + o0[3] * o0[3]) + (o1[0] * o1[0] + o1[1] * o1[1]) + (o1[2] * o1[2] + o1[3] * o1[3]);
                }
                ss += __shfl_xor(ss, 16); ss += __shfl_xor(ss, 32);
                if (fq == 0) part[(size_t)row * 16 + u.pn * 4 + wc] = ss;
            }
    }
};
struct EpiGate {
    float* out; const h16* pp; const float* rs2; float* part;
    __device__ __forceinline__ void operator()(AccRef acc, const Unit& u, int wr, int wc, int fr, int fq) const {
#pragma unroll
        for (int ai = 0; ai < 2; ++ai)
#pragma unroll
            for (int m = 0; m < 4; ++m) {
                const int row = u.pm * 256 + ai * 128 + wr * 64 + m * 16 + fr; float ss = 0.f;
                const f32x4 sa = *(const f32x4*)(rs2 + (size_t)row * 8), sb = *(const f32x4*)(rs2 + (size_t)row * 8 + 4);
                const float rs = rsqrtf(((sa[0] + sa[1]) + (sa[2] + sa[3]) + (sb[0] + sb[1]) + (sb[2] + sb[3])) * (1.f / 1024.f) + NORM_EPS);
#pragma unroll
                for (int bj = 0; bj < 2; ++bj) {
                    const int col = u.pn * 256 + bj * 128 + wc * 32 + 8 * fq;
                    float* op = out + (size_t)row * 1024 + col;
                    f32x4 o0 = *(const f32x4*)op, o1 = *(const f32x4*)(op + 4);
                    const h16x8 pv = *(const h16x8*)(pp + (size_t)row * 1024 + col);
                    const f32x4 v0 = acc[ai][bj][m][0], v1 = acc[ai][bj][m][1];
#pragma unroll
                    for (int j = 0; j < 4; ++j) { o0[j] += sigmoidf_(rs * v0[j]) * (float)pv[j]; o1[j] += sigmoidf_(rs * v1[j]) * (float)pv[4 + j]; }
                    *(f32x4*)op = o0; *(f32x4*)(op + 4) = o1;
                    ss += (o0[0] * o0[0] + o0[1] * o0[1]) + (o0[2] * o0[2] + o0[3] * o0[3]) + (o1[0] * o1[0] + o1[1] * o1[1]) + (o1[2] * o1[2] + o1[3] * o1[3]);
                }
                ss += __shfl_xor(ss, 16); ss += __shfl_xor(ss, 32);
                if (fq == 0) part[(size_t)row * 16 + u.pn * 4 + wc] = ss;
            }
    }
};

__device__ __forceinline__ void tr_item(const float* W, int N, const float* g, h16* WT, int ldk, int koff, int k0, int n0, LAS float* scr, int lane) {
#pragma unroll 8
    for (int i = 0; i < 32; ++i) { const int kk = 2 * i + (lane >> 5); float v = W[(size_t)(k0 + kk) * N + n0 + (lane & 31)]; if (g) v *= g[k0 + kk]; scr[kk * 33 + (lane & 31)] = v; }
    asm volatile("s_waitcnt lgkmcnt(0)" ::: "memory");
    const int c = lane & 7;
#pragma unroll
    for (int j = 0; j < 4; ++j) { const int n = (lane >> 3) + 8 * j; const LAS float* s = scr + (8 * c) * 33 + n;
        h16x8 o;
#pragma unroll
        for (int e = 0; e < 8; ++e) o[e] = (h16)s[e * 33];
        *(h16x8*)(WT + (size_t)(n0 + n) * ldk + koff + k0 + 8 * c) = o; }
    asm volatile("s_waitcnt lgkmcnt(0)" ::: "memory");
}
struct TrJob { const float* W; const float* g; h16* WT; int K, N, ldk, koff; };

__device__ __forceinline__ void phase_prep(const Args& a, LAS unsigned char* lds) {
    const int tid = tid_(), lane = tid & 63, wave = tid >> 6;
    const int gw = blockIdx.x * NWAVES + wave, NGW = gridDim.x * NWAVES;
    unsigned char* ws = a.ws;
    {
        LAS float* scr = (LAS float*)(lds + wave * 8704);
        TrJob jobs[9] = {
            {a.in[3], a.in[2], (h16*)(ws + O_WIN), 1024, NIN, 1024, 0},
            {a.in[17], nullptr, (h16*)(ws + O_WA), 512, 1024, 512, 0},
            {a.in[18], nullptr, (h16*)(ws + O_WB), 512, 1024, 512, 0},
            {a.in[19], nullptr, (h16*)(ws + O_WO), 1024, 1024, 1024, 0},
            {a.in[26], a.in[25], (h16*)(ws + O_WG), 1024, 1024, 1024, 0},
            {a.in[27], nullptr, (h16*)(ws + O_WP), 256, 1024, 256, 0},
            {a.in[8], nullptr, (h16*)(ws + O_WLR), 64, 512, 256, 0},
            {a.in[10], nullptr, (h16*)(ws + O_WLR) + (size_t)512 * 256, 64, 512, 256, 64},
            {a.in[11], nullptr, (h16*)(ws + O_WLR) + (size_t)1024 * 256, 128, 512, 256, 128},
        };
        int base = 0;
#pragma unroll
        for (int j = 0; j < 9; ++j) {
            const TrJob J = jobs[j]; const int nnb = J.N / 32, items = (J.K / 64) * nnb;
            int first = gw - (base % NGW); if (first < 0) first += NGW;
            for (int r = first; r < items; r += NGW) tr_item(J.W, J.N, J.g, J.WT, J.ldk, J.koff, (r / nnb) * 64, (r % nnb) * 32, scr, lane);
            base += items;
        }
        h16* wlr = (h16*)(ws + O_WLR);
        for (int i = blockIdx.x * NTHREADS + tid; i < 1536 * 256 / 8; i += gridDim.x * NTHREADS) {
            const int n = (i * 8) / 256, k = (i * 8) % 256; const int blk = n / 512;
            const bool inblk = (blk == 0) ? (k < 64) : (blk == 1) ? (k >= 64 && k < 128) : (k >= 128);
            if (!inblk) { h16x8 z; for (int e = 0; e < 8; ++e) z[e] = (h16)0.f; *(h16x8*)(wlr + (size_t)i * 8) = z; }
        }
    }
    __syncthreads();
    {
        LAS float* LA = (LAS float*)lds;
        LAS float* LB = (LAS float*)(lds + 64 * 129 * 4);
        const float* wq = a.in[21]; const float* sk = a.in[22]; const float* gf = a.in[20];
        h16* wst = (h16*)(ws + O_WS);
        for (int it = blockIdx.x; it < 256; it += gridDim.x) {
            const int g16 = it >> 4, k0 = (it & 15) * 64;
            for (int i = tid; i < 64 * 128; i += NTHREADS) { const int k = i >> 7, d = i & 127; LA[k * 129 + d] = wq[(size_t)(k0 + k) * 2048 + g16 * 128 + d] * gf[k0 + k]; }
            for (int i = tid; i < 128 * 128; i += NTHREADS) { const int n = i >> 7, d = i & 127; LB[n * 129 + d] = sk[((size_t)g16 * 128 + n) * 128 + d]; }
            __syncthreads();
            const int n = tid & 127, kg = tid >> 7;
            float o[16];
#pragma unroll
            for (int j = 0; j < 16; ++j) o[j] = 0.f;
            for (int d = 0; d < 128; ++d) { const float b = LB[n * 129 + d];
#pragma unroll
                for (int j = 0; j < 16; ++j) o[j] += LA[(kg * 16 + j) * 129 + d] * b; }
            h16x8 o0, o1;
#pragma unroll
            for (int j = 0; j < 8; ++j) { o0[j] = (h16)o[j]; o1[j] = (h16)o[8 + j]; }
            h16* dst = wst + (size_t)(g16 * 128 + n) * 1024 + k0 + kg * 16;
            *(h16x8*)dst = o0; *(h16x8*)(dst + 8) = o1;
            __syncthreads();
        }
    }
    {
        const float* gf = a.in[20];
        f32x4 g4[4];
#pragma unroll
        for (int j = 0; j < 4; ++j) g4[j] = *(const f32x4*)(gf + 16 * lane + 4 * j);
        for (int r = gw; r < 2 * 16384; r += NGW) {
            const int tb = r >> 14, e = r & 16383;
            const float* src = (tb ? a.in[24] : a.in[23]) + (size_t)e * 1024 + 16 * lane;
            f32x4 v[4]; float mx = 0.f;
#pragma unroll
            for (int j = 0; j < 4; ++j) { v[j] = *(const f32x4*)(src + 4 * j); if (!tb) v[j] = v[j] * g4[j];
#pragma unroll
                for (int c = 0; c < 4; ++c) mx = fmaxf(mx, fabsf(v[j][c])); }
#pragma unroll
            for (int o = 1; o < 64; o <<= 1) mx = fmaxf(mx, __shfl_xor(mx, o));
            mx = fmaxf(mx, 1e-30f);
            const float sc = 224.0f / mx;
            u32x4 q;
#pragma unroll
            for (int j = 0; j < 4; ++j) { int w = 0; w = __builtin_amdgcn_cvt_pk_fp8_f32(v[j][0] * sc, v[j][1] * sc, w, false); w = __builtin_amdgcn_cvt_pk_fp8_f32(v[j][2] * sc, v[j][3] * sc, w, true); q[j] = (unsigned)w; }
            unsigned char* dst = ws + (tb ? O_V8 : O_U8) + ((size_t)(lane >> 3) * 16384 + e) * 128 + 16 * (lane & 7);
            *(u32x4*)dst = q;
            if (lane == 0) ((float*)(ws + (tb ? O_VSC : O_USC)))[e] = mx * (1.0f / 224.0f);
        }
        if (blockIdx.x == 0 && tid < 32) ((unsigned*)(ws + O_CTR))[tid * 64] = 0u;
        const f32x4* pp = (const f32x4*)a.in[1]; h16x4* dp = (h16x4*)(ws + O_P16);
        const int np4 = MTOK * 256 / 4;
        for (int i = blockIdx.x * NTHREADS + tid; i < np4; i += gridDim.x * NTHREADS) dp[i] = pack4(pp[i]);
    }
    {
        const float* x = a.in[0]; h16* xn = (h16*)(ws + O_XN);
        for (int r = gw; r < MTOK; r += NGW) {
            const f32x4* xr = (const f32x4*)(x + (size_t)r * 1024) + lane;
            f32x4 v[4]; float s = 0.f;
#pragma unroll
            for (int j = 0; j < 4; ++j) { v[j] = xr[64 * j]; s += (v[j][0] * v[j][0] + v[j][1] * v[j][1]) + (v[j][2] * v[j][2] + v[j][3] * v[j][3]); }
            const float rs = rsqrtf(wave_sum(s) * (1.f / 1024.f) + NORM_EPS);
            h16x4* o = (h16x4*)(xn + (size_t)r * 1024) + lane;
#pragma unroll
            for (int j = 0; j < 4; ++j) o[64 * j] = pack4(v[j] * rs);
        }
    }
}

__device__ __forceinline__ void phase_conv(const Args& a) {
    const int tid = tid_(), lane = tid & 63, wave = tid >> 6;
    const int gw = blockIdx.x * NWAVES + wave, NGW = gridDim.x * NWAVES;
    const h16* zc = (const h16*)(a.ws + O_ZC); h16* ca = (h16*)(a.ws + O_CA);
    const float* cw = a.in[4]; const float* cb = a.in[5];
    float w0[8], w1[8], w2[8], bb[8];
#pragma unroll
    for (int j = 0; j < 8; ++j) { const int c = lane * 8 + j; w0[j] = cw[c]; w1[j] = cw[512 + c]; w2[j] = cw[1024 + c]; bb[j] = cb[c]; }
    for (int run = gw; run < MTOK / 32; run += NGW) {
        const int t0 = run * 32;
        float u1[8], u2[8];
        if ((t0 % SEQ) == 0) {
#pragma unroll
            for (int j = 0; j < 8; ++j) { u1[j] = 0.f; u2[j] = 0.f; }
        } else {
            const h16x8 c1 = *(const h16x8*)(zc + (size_t)(t0 - 1) * 1536 + 512 + lane * 8), x1 = *(const h16x8*)(zc + (size_t)(t0 - 1) * 1536 + 1024 + lane * 8);
            const h16x8 c2 = *(const h16x8*)(zc + (size_t)(t0 - 2) * 1536 + 512 + lane * 8), x2 = *(const h16x8*)(zc + (size_t)(t0 - 2) * 1536 + 1024 + lane * 8);
#pragma unroll
            for (int j = 0; j < 8; ++j) { u1[j] = (float)c1[j] * (float)x1[j]; u2[j] = (float)c2[j] * (float)x2[j]; }
        }
        for (int t = t0; t < t0 + 32; ++t) {
            const h16* zrow = zc + (size_t)t * 1536 + lane * 8;
            const h16x8 gb = *(const h16x8*)zrow, gc = *(const h16x8*)(zrow + 512), xi = *(const h16x8*)(zrow + 1024);
            h16x8 o;
#pragma unroll
            for (int j = 0; j < 8; ++j) { const float u0 = (float)gc[j] * (float)xi[j];
                const float y = w0[j] * u2[j] + w1[j] * u1[j] + w2[j] * u0 + bb[j];
                o[j] = (h16)((float)gb[j] * y); u2[j] = u1[j]; u1[j] = u0; }
            *(h16x8*)(ca + (size_t)t * 512 + lane * 8) = o;
        }
    }
}


__device__ __forceinline__ float tanhf_(float x) { return 1.0f - 2.0f * __builtin_amdgcn_rcpf(1.0f + __expf(2.0f * x)); }
__device__ __forceinline__ void phase_rwkv_prep(const Args& a) {
    const int tid = tid_(), lane = tid & 63, wave = tid >> 6;
    const int gw = blockIdx.x * NWAVES + wave, NGW = gridDim.x * NWAVES;
    const h16* zr = (const h16*)(a.ws + O_ZR);
    h16* R = (h16*)a.out; h16* KS = R + (size_t)MTOK * 512; h16* V = KS + (size_t)MTOK * 512; h16* KK = V + (size_t)MTOK * 512;
    h16* APR = (h16*)(a.ws + O_APR);
    const float* mu = a.in[6]; const float* k_k = a.in[12];
    float mr[8], mk[8], mv[8], mt[8], kk8[8];
#pragma unroll
    for (int j = 0; j < 8; ++j) { const int c = lane * 8 + j; mr[j] = mu[c]; mk[j] = mu[512 + c]; mv[j] = mu[1024 + c]; mt[j] = mu[1536 + (c & 255)]; kk8[j] = k_k[c]; }
    for (int run = gw; run < MTOK / 32; run += NGW) {
        const int t0 = run * 32;
        float pr[8], pk[8], pv[8], pt[8];
        if ((t0 % SEQ) == 0) {
#pragma unroll
            for (int j = 0; j < 8; ++j) { pr[j] = 0.f; pk[j] = 0.f; pv[j] = 0.f; pt[j] = 0.f; }
        } else {
            const h16* zp = zr + (size_t)(t0 - 1) * 1792 + lane * 8;
            const h16x8 a0 = *(const h16x8*)zp, a1 = *(const h16x8*)(zp + 512), a2 = *(const h16x8*)(zp + 1024), a3 = *(const h16x8*)(zr + (size_t)(t0 - 1) * 1792 + 1536 + (lane & 31) * 8);
#pragma unroll
            for (int j = 0; j < 8; ++j) { pr[j] = (float)a0[j]; pk[j] = (float)a1[j]; pv[j] = (float)a2[j]; pt[j] = (float)a3[j]; }
        }
        for (int t = t0; t < t0 + 32; ++t) {
            const h16* zp = zr + (size_t)t * 1792 + lane * 8;
            const h16x8 a0 = *(const h16x8*)zp, a1 = *(const h16x8*)(zp + 512), a2 = *(const h16x8*)(zp + 1024), a3 = *(const h16x8*)(zr + (size_t)t * 1792 + 1536 + (lane & 31) * 8);
            h16x8 orr, ok, ov, okk, ot; float kr[8]; float ss = 0.f;
#pragma unroll
            for (int j = 0; j < 8; ++j) {
                const float zr_ = (float)a0[j], zk_ = (float)a1[j], zv_ = (float)a2[j], zt_ = (float)a3[j];
                const float r = zr_ + mr[j] * (pr[j] - zr_), k = zk_ + mk[j] * (pk[j] - zk_), v = zv_ + mv[j] * (pv[j] - zv_), tl = zt_ + mt[j] * (pt[j] - zt_);
                pr[j] = zr_; pk[j] = zk_; pv[j] = zv_; pt[j] = zt_;
                orr[j] = (h16)r; ok[j] = (h16)k; ov[j] = (h16)v;
                kr[j] = k * kk8[j]; ss += kr[j] * kr[j];
                const float tv = (lane < 8) ? tanhf_(tl) : (lane < 16) ? tl : sigmoidf_(tl);
                ot[j] = (h16)tv;
            }
            ss += __shfl_xor(ss, 1); ss += __shfl_xor(ss, 2); ss += __shfl_xor(ss, 4);
            const float rn = rsqrtf(ss + 1e-12f);
#pragma unroll
            for (int j = 0; j < 8; ++j) okk[j] = (h16)(kr[j] * rn);
            const size_t o = (size_t)t * 512 + lane * 8;
            *(h16x8*)(R + o) = orr; *(h16x8*)(KS + o) = ok; *(h16x8*)(V + o) = ov; *(h16x8*)(KK + o) = okk;
            if (lane < 32) *(h16x8*)(APR + (size_t)t * 256 + lane * 8) = ot;
        }
    }
}

struct EpiLR {
    const float *w0, *a0, *k_a; h16 *WD, *KS, *BD, *GG; const h16* KK;
    __device__ __forceinline__ void operator()(AccRef acc, const Unit& u, int wr, int wc, int fr, int fq) const {
        const int part = u.pn >> 1;
        EPI_LOOP_BEGIN
            const int c = col - part * 512; const size_t o = (size_t)row * 512 + c;
            if (part == 0) {
                const f32x4 b0 = *(const f32x4*)(w0 + c), b1 = *(const f32x4*)(w0 + c + 4); f32x4 o0, o1;
#pragma unroll
                for (int j = 0; j < 4; ++j) { o0[j] = __expf(-0.6065306597126334f * sigmoidf_(b0[j] + v0[j])); o1[j] = __expf(-0.6065306597126334f * sigmoidf_(b1[j] + v1[j])); }
                *(h16x8*)(WD + o) = pack8(o0, o1);
            } else if (part == 1) {
                const f32x4 b0 = *(const f32x4*)(a0 + c), b1 = *(const f32x4*)(a0 + c + 4), ka0 = *(const f32x4*)(k_a + c), ka1 = *(const f32x4*)(k_a + c + 4);
                const h16x8 ks = *(const h16x8*)(KS + o), kk = *(const h16x8*)(KK + o); f32x4 k0, k1, bb0, bb1;
#pragma unroll
                for (int j = 0; j < 4; ++j) { const float aa0 = sigmoidf_(b0[j] + v0[j]), aa1 = sigmoidf_(b1[j] + v1[j]);
                    k0[j] = (float)ks[j] * (1.0f + (aa0 - 1.0f) * ka0[j]); k1[j] = (float)ks[4 + j] * (1.0f + (aa1 - 1.0f) * ka1[j]);
                    bb0[j] = aa0 * (float)kk[j]; bb1[j] = aa1 * (float)kk[4 + j]; }
                *(h16x8*)(KS + o) = pack8(k0, k1); *(h16x8*)(BD + o) = pack8(bb0, bb1);
            } else {
                *(h16x8*)(GG + o) = pack8(v0, v1);
            }
        EPI_LOOP_END
    }
};

constexpr int SC_L = 256, SC_NCH = SEQ / SC_L, SC_NB = 8;
constexpr int SC_STEP_F = 6 * 64;
constexpr int SC_WAVE_BYTES = SC_NB * SC_STEP_F * 4 + SC_NB * 64 * 4;
__device__ __forceinline__ float quad_sum(float v) { v += dpp_<0xB1>(v); v += dpp_<0x4E>(v); return v; }
__device__ __forceinline__ void lds_ld8x2(const LAS float* p, f32x2 (&o)[8]) {
#pragma unroll
    for (int j4 = 0; j4 < 4; ++j4) { const f32x4 t = *(const LAS f32x4*)(p + 4 * j4); o[2 * j4] = (f32x2){t[0], t[1]}; o[2 * j4 + 1] = (f32x2){t[2], t[3]}; }
}
template <int MODE>
__device__ __forceinline__ void scan_wave(const Args& a, LAS unsigned char* lds, int task) {
    const int tid = tid_(), lane = tid & 63, wave = tid >> 6;
    const int q = lane & 3, rg = lane >> 2;
    const int chain = task / SC_NCH, chunk = task % SC_NCH, b = chain >> 3, h = chain & 7;
    const size_t row0 = (size_t)b * SEQ + (size_t)chunk * SC_L;
    const h16* R = (const h16*)a.out; const h16* KS = R + (size_t)MTOK * 512; const h16* V = KS + (size_t)MTOK * 512; const h16* KK = V + (size_t)MTOK * 512;
    const h16* WD = (const h16*)(a.ws + O_WD); const h16* BD = (const h16*)(a.ws + O_BD);
    LAS float* buf = (LAS float*)(lds + wave * SC_WAVE_BYTES);
    LAS float* ybuf = buf + SC_NB * SC_STEP_F;
    constexpr int NA = (MODE == 0) ? 5 : (MODE == 1) ? 3 : 6;
    const h16* gp[NA]; int lo[NA];
#pragma unroll
    for (int j = 0; j < NA; ++j) { const int p = lane + 64 * j, seg = p >> 3, part = p & 7, st = seg / NA, ai = seg % NA;
        const int ar = (MODE == 0 && ai == 4) ? 5 : ai;
        const h16* base = (ar == 0) ? KK : (ar == 1) ? WD : (ar == 2) ? BD : (ar == 3) ? KS : (ar == 4) ? R : V;
        gp[j] = base + (row0 + st) * 512 + h * 64 + part * 8; lo[j] = st * SC_STEP_F + ar * 64 + part * 8; }
    f32x2 s[4][8];
    if (MODE == 0) {
#pragma unroll
        for (int i = 0; i < 4; ++i)
#pragma unroll
            for (int j = 0; j < 8; ++j) s[i][j] = (f32x2){0.f, 0.f};
    } else if (MODE == 1) {
#pragma unroll
        for (int i = 0; i < 4; ++i)
#pragma unroll
            for (int j = 0; j < 8; ++j) s[i][j] = (f32x2){(i == q && 2 * j == rg) ? 1.f : 0.f, (i == q && 2 * j + 1 == rg) ? 1.f : 0.f};
    } else {
        const float* S0 = (const float*)(a.ws + O_SST) + (size_t)task * 4096;
#pragma unroll
        for (int i = 0; i < 4; ++i)
#pragma unroll
            for (int j4 = 0; j4 < 4; ++j4) { const f32x4 t = *(const f32x4*)(S0 + (rg + 16 * i) * 64 + 16 * q + 4 * j4);
                s[i][2 * j4] = (f32x2){t[0], t[1]}; s[i][2 * j4 + 1] = (f32x2){t[2], t[3]}; }
    }
    h16x8 pre[NA];
#pragma unroll
    for (int j = 0; j < NA; ++j) pre[j] = *(const h16x8*)gp[j];
    f32x2 kk[8];
    for (int bt = 0; bt < SC_L / SC_NB; ++bt) {
        LAS float* cb = buf;
#pragma unroll
        for (int j = 0; j < NA; ++j) { f32x4 x0, x1;
#pragma unroll
            for (int e = 0; e < 4; ++e) { x0[e] = (float)pre[j][e]; x1[e] = (float)pre[j][4 + e]; }
            *(LAS f32x4*)(cb + lo[j]) = x0; *(LAS f32x4*)(cb + lo[j] + 4) = x1; }
        if (bt + 1 < SC_L / SC_NB) {
#pragma unroll
            for (int j = 0; j < NA; ++j) pre[j] = *(const h16x8*)(gp[j] + (size_t)(bt + 1) * SC_NB * 512);
        }
        lds_ld8x2(cb + 16 * q, kk);
#pragma unroll 2
        for (int st = 0; st < SC_NB; ++st) {
            const LAS float* sb = cb + st * SC_STEP_F;
            f32x2 w[8], bb[8], kx[8]; float vv[4];
            lds_ld8x2(sb + 64 + 16 * q, w); lds_ld8x2(sb + 128 + 16 * q, bb);
            if (MODE != 1) { lds_ld8x2(sb + 192 + 16 * q, kx);
#pragma unroll
                for (int i = 0; i < 4; ++i) vv[i] = sb[320 + rg + 16 * i]; }
            float us[4];
#pragma unroll
            for (int i = 0; i < 4; ++i) { f32x2 t = s[i][0] * kk[0];
#pragma unroll
                for (int j = 1; j < 8; ++j) t = __builtin_elementwise_fma(s[i][j], kk[j], t);
                us[i] = quad_sum(t[0] + t[1]); }
            if (st + 1 < SC_NB) lds_ld8x2(sb + SC_STEP_F + 16 * q, kk);
            f32x2 rr[8];
            if (MODE == 2) lds_ld8x2(sb + 256 + 16 * q, rr);
#pragma unroll
            for (int i = 0; i < 4; ++i) { const f32x2 nu = (f32x2){-us[i], -us[i]}, v2 = (f32x2){vv[i], vv[i]};
#pragma unroll
                for (int j = 0; j < 8; ++j) { f32x2 t = s[i][j] * w[j]; t = __builtin_elementwise_fma(nu, bb[j], t); if (MODE != 1) t = __builtin_elementwise_fma(v2, kx[j], t); s[i][j] = t; } }
            if (MODE == 2) {
#pragma unroll
                for (int i = 0; i < 4; ++i) { f32x2 t = s[i][0] * rr[0];
#pragma unroll
                    for (int j = 1; j < 8; ++j) t = __builtin_elementwise_fma(s[i][j], rr[j], t);
                    const float y = quad_sum(t[0] + t[1]);
                    if (q == 0) ybuf[st * 64 + rg + 16 * i] = y; }
            }
        }
        if (MODE == 2) {
            const int st = lane >> 3, part = lane & 7; h16x8 o;
#pragma unroll
            for (int e = 0; e < 8; ++e) o[e] = (h16)ybuf[st * 64 + part * 8 + e];
            *(h16x8*)((h16*)(a.ws + O_Y) + (row0 + (size_t)bt * SC_NB + st) * 512 + h * 64 + part * 8) = o;
        }
    }
    if (MODE != 2) {
        float* PQ = (float*)(a.ws + O_PQ) + (size_t)task * 8192 + (MODE == 0 ? 4096 : 0);
#pragma unroll
        for (int i = 0; i < 4; ++i)
#pragma unroll
            for (int j4 = 0; j4 < 4; ++j4) { const int o = (rg + 16 * i) * 64 + 16 * q + 4 * j4;
                *(f32x4*)(PQ + o) = (f32x4){s[i][2 * j4][0], s[i][2 * j4][1], s[i][2 * j4 + 1][0], s[i][2 * j4 + 1][1]}; }
    }
}
template <bool FIRST>
__device__ __forceinline__ void phase_scan(const Args& a, LAS unsigned char* lds) {
    const int wave = tid_() >> 6;
    if (FIRST) {
        for (int task = blockIdx.x * NWAVES + wave; task < 64 * SC_NCH; task += gridDim.x * NWAVES) { scan_wave<0>(a, lds, task); scan_wave<1>(a, lds, task); }
    } else {
        for (int task = blockIdx.x * NWAVES + wave; task < 64 * SC_NCH; task += gridDim.x * NWAVES) scan_wave<2>(a, lds, task);
    }
}
__device__ __forceinline__ void phase_scan_combine(const Args& a, LAS unsigned char* lds) {
    const int tid = tid_(), row = tid >> 5, cp = tid & 31;
    LAS float* LS = (LAS float*)lds;
    LAS float* LP = (LAS float*)(lds + 8192);
    for (int item = blockIdx.x; item < 64 * 4; item += gridDim.x) {
        const int chain = item >> 2, r0 = (item & 3) * 16;
        const float* PQ0 = (const float*)(a.ws + O_PQ) + (size_t)chain * SC_NCH * 8192;
        f32x2 sr = (f32x2){0.f, 0.f};
        f32x4 pa = *(const f32x4*)(PQ0 + tid * 8), pb = *(const f32x4*)(PQ0 + tid * 8 + 4);
        f32x2 qn = *(const f32x2*)(PQ0 + 4096 + (r0 + row) * 64 + 2 * cp);
        for (int c = 0; c < SC_NCH; ++c) {
            const int task = chain * SC_NCH + c;
            *(f32x2*)((float*)(a.ws + O_SST) + (size_t)task * 4096 + (r0 + row) * 64 + 2 * cp) = sr;
            if (c == SC_NCH - 1) break;
            LAS float* cur = LS + (c & 1) * 1024; LAS float* cp_ = LP + (c & 1) * 4096;
            *(LAS f32x2*)(cur + row * 64 + 2 * cp) = sr;
            *(LAS f32x4*)(cp_ + tid * 8) = pa; *(LAS f32x4*)(cp_ + tid * 8 + 4) = pb;
            f32x2 acc0 = qn, acc1 = (f32x2){0.f, 0.f};
            if (c + 2 < SC_NCH) { const float* Pn = PQ0 + (size_t)(c + 1) * 8192;
                pa = *(const f32x4*)(Pn + tid * 8); pb = *(const f32x4*)(Pn + tid * 8 + 4); qn = *(const f32x2*)(Pn + 4096 + (r0 + row) * 64 + 2 * cp); }
            __syncthreads();
#pragma unroll 16
            for (int k = 0; k < 64; k += 2) {
                const f32x2 sk = *(const LAS f32x2*)(cur + row * 64 + k);
                const f32x2 p0 = *(const LAS f32x2*)(cp_ + k * 64 + 2 * cp), p1 = *(const LAS f32x2*)(cp_ + (k + 1) * 64 + 2 * cp);
                acc0 = __builtin_elementwise_fma((f32x2){sk[0], sk[0]}, p0, acc0); acc1 = __builtin_elementwise_fma((f32x2){sk[1], sk[1]}, p1, acc1);
            }
            sr = acc0 + acc1;
        }
        __syncthreads();
    }
}
__device__ __forceinline__ void phase_rwkv_post(const Args& a) {
    const int tid = tid_(), lane = tid & 63, wave = tid >> 6;
    const int gw = blockIdx.x * NWAVES + wave, NGW = gridDim.x * NWAVES;
    const h16* R = (const h16*)a.out; const h16* KS = R + (size_t)MTOK * 512; const h16* V = KS + (size_t)MTOK * 512;
    const h16* GG = (const h16*)(a.ws + O_GG); const h16* Y = (const h16*)(a.ws + O_Y); h16* YB = (h16*)(a.ws + O_YB);
    float rk[8], lg[8], lb[8];
#pragma unroll
    for (int j = 0; j < 8; ++j) { const int c = lane * 8 + j; rk[j] = a.in[14][c]; lg[j] = a.in[15][c]; lb[j] = a.in[16][c]; }
    for (int t = gw; t < MTOK; t += NGW) {
        const size_t o = (size_t)t * 512 + lane * 8;
        const h16x8 y8 = *(const h16x8*)(Y + o), r8 = *(const h16x8*)(R + o), k8 = *(const h16x8*)(KS + o), v8 = *(const h16x8*)(V + o), g8 = *(const h16x8*)(GG + o);
        float y[8]; float sm = 0.f, bs = 0.f;
#pragma unroll
        for (int j = 0; j < 8; ++j) { y[j] = (float)y8[j]; sm += y[j]; bs += (float)r8[j] * (float)k8[j] * rk[j]; }
        sm += __shfl_xor(sm, 1); sm += __shfl_xor(sm, 2); sm += __shfl_xor(sm, 4);
        bs += __shfl_xor(bs, 1); bs += __shfl_xor(bs, 2); bs += __shfl_xor(bs, 4);
        const float mean = sm * (1.f / 64.f); float vs = 0.f;
#pragma unroll
        for (int j = 0; j < 8; ++j) { y[j] -= mean; vs += y[j] * y[j]; }
        vs += __shfl_xor(vs, 1); vs += __shfl_xor(vs, 2); vs += __shfl_xor(vs, 4);
        const float rstd = rsqrtf(vs * (1.f / 64.f) + 64e-5f);
        h16x8 ov;
#pragma unroll
        for (int j = 0; j < 8; ++j) ov[j] = (h16)((y[j] * rstd * lg[j] + lb[j] + bs * (float)v8[j]) * (float)g8[j]);
        *(h16x8*)(YB + o) = ov;
    }
}


__device__ __forceinline__ void ins16(unsigned (&L)[16], unsigned x) {
#pragma unroll
    for (int j = 0; j < 16; ++j) { const unsigned hi = L[j] > x ? L[j] : x; x = L[j] > x ? x : L[j]; L[j] = hi; }
}
__device__ __forceinline__ unsigned ord32(float f) { const unsigned u = __float_as_uint(f); return (u & 0x80000000u) ? ~u : (u | 0x80000000u); }
__device__ __forceinline__ float unord32(unsigned k) { return __uint_as_float((k & 0x80000000u) ? (k & 0x7fffffffu) : ~k); }
__device__ __forceinline__ void phase_topk(const Args& a, LAS unsigned char* lds) {
    const int tid = tid_();
    const h16* SC = (const h16*)(a.ws + O_SCORES);
    const float* part = (const float*)(a.ws + O_PART1);
    unsigned short* IDX = (unsigned short*)(a.ws + O_IDX); float* GATE = (float*)(a.ws + O_GATE); float* RS1 = (float*)(a.ws + O_RS1);
    LAS unsigned char* LI = lds;
    for (int task = blockIdx.x * NTHREADS + tid; task < MTOK * 8; task += gridDim.x * NTHREADS) {
        const int t = task >> 3, h = task & 7;
        float ssq = 0.f;
#pragma unroll
        for (int j = 0; j < 4; ++j) { const f32x4 p4 = *(const f32x4*)(part + (size_t)t * 16 + 4 * j); ssq += (p4[0] + p4[1]) + (p4[2] + p4[3]); }
        const float rs = rsqrtf(ssq * (1.f / 1024.f) + NORM_EPS);
        if (h == 0) RS1[t] = rs;
        float sv[2][16];
#pragma unroll
        for (int c = 0; c < 2; ++c) {
            unsigned L[16];
#pragma unroll
            for (int j = 0; j < 16; ++j) L[j] = 0u;
            const h16* row = SC + (size_t)t * 2048 + h * 256 + c * 128;
#pragma unroll 2
            for (int n8 = 0; n8 < 16; ++n8) {
                const u32x4 w4 = *(const u32x4*)(row + n8 * 8);
#pragma unroll
                for (int e = 0; e < 8; ++e) {
                    const unsigned bits = (e & 1) ? (w4[e >> 1] >> 16) : (w4[e >> 1] & 0xffffu);
                    const unsigned o16 = (bits & 0x8000u) ? (~bits & 0xffffu) : (bits | 0x8000u);
                    ins16(L, (o16 << 16) | (unsigned)(127 - (n8 * 8 + e)));
                }
            }
#pragma unroll
            for (int j = 0; j < 16; ++j) {
                const unsigned o16 = L[j] >> 16; const unsigned bits = (o16 & 0x8000u) ? (o16 & 0x7fffu) : (~o16 & 0xffffu);
                union { unsigned short u; h16 f; } cv; cv.u = (unsigned short)bits; sv[c][j] = (float)cv.f;
                LI[(c * 16 + j) * 512 + tid] = (unsigned char)(127u - (L[j] & 127u));
            }
        }
        unsigned L[16];
#pragma unroll
        for (int j = 0; j < 16; ++j) L[j] = 0u;
#pragma unroll
        for (int i = 0; i < 16; ++i)
#pragma unroll
            for (int j = 0; j < 16; ++j) if ((i + 1) * (j + 1) <= 16) ins16(L, (ord32(sv[0][i] + sv[1][j]) & ~255u) | (unsigned)(255 - (i * 16 + j)));
        float e[16]; float den = 0.f; const float mx = unord32(L[0] & ~255u) * rs;
        unsigned short id[16];
#pragma unroll
        for (int k = 0; k < 16; ++k) {
            const float v = unord32(L[k] & ~255u) * rs; e[k] = __expf(v - mx); den += e[k];
            const unsigned pos = 255u - (L[k] & 255u); const unsigned i = pos >> 4, j = pos & 15u;
            id[k] = (unsigned short)((unsigned)LI[i * 512 + tid] * 128u + (unsigned)LI[(16 + j) * 512 + tid]);
        }
        const float inv = __builtin_amdgcn_rcpf(den);
        u32x4 i0, i1;
        i0[0] = id[0] | (id[1] << 16); i0[1] = id[2] | (id[3] << 16); i0[2] = id[4] | (id[5] << 16); i0[3] = id[6] | (id[7] << 16);
        i1[0] = id[8] | (id[9] << 16); i1[1] = id[10] | (id[11] << 16); i1[2] = id[12] | (id[13] << 16); i1[3] = id[14] | (id[15] << 16);
        u32x4* ip = (u32x4*)(IDX + (size_t)task * 16); ip[0] = i0; ip[1] = i1;
        f32x4* gp = (f32x4*)(GATE + (size_t)task * 16);
#pragma unroll
        for (int k4 = 0; k4 < 4; ++k4) gp[k4] = (f32x4){e[4 * k4] * inv, e[4 * k4 + 1] * inv, e[4 * k4 + 2] * inv, e[4 * k4 + 3] * inv};
    }
}

__device__ __forceinline__ float gelu_tanh(float x) { const float u = 0.7978845608028654f * (x + 0.044715f * x * x * x); return 0.5f * x * (1.0f + tanhf_(u)); }
__device__ __forceinline__ unsigned xcc_id() { return (unsigned)__builtin_amdgcn_s_getreg((3 << 11) | 20) & 7u; }
constexpr int GA_TC = 32, GA_NCH = MTOK / GA_TC;
__device__ __forceinline__ void dec16(const u32x4 q, float (&o)[16]) {
#pragma unroll
    for (int w = 0; w < 4; ++w) { const f32x2 lo = __builtin_amdgcn_cvt_pk_f32_fp8((int)q[w], false), hi = __builtin_amdgcn_cvt_pk_f32_fp8((int)q[w], true);
        o[4 * w] = lo[0]; o[4 * w + 1] = lo[1]; o[4 * w + 2] = hi[0]; o[4 * w + 3] = hi[1]; }
}
struct GIdx { u32x4 a, b; };
__device__ __forceinline__ GIdx g_ldidx(const unsigned short* IDX, int t, int r8) { const u32x4* ip = (const u32x4*)(IDX + (size_t)t * 128 + 16 * r8); GIdx r; r.a = ip[0]; r.b = ip[1]; return r; }
__device__ __forceinline__ void g_issue8(const unsigned char* TBs, unsigned lo, const u32x4 ix, u32x4 (&q)[8]) {
#pragma unroll
    for (int i = 0; i < 8; ++i) { const unsigned w = ix[i >> 1]; const unsigned e = (i & 1) ? (w >> 16) : (w & 0xffffu); q[i] = *(const u32x4*)(TBs + (e * 128u + lo)); }
}
struct GSide { u32x4 a, b, c, d; };
template <int PH> __device__ __forceinline__ GSide g_ldside(const Args& a, int t, int j, int m, int r8) {
    GSide r;
    if (PH == 0) { const u32x4* xp = (const u32x4*)((const h16*)(a.ws + O_H1B) + (size_t)t * 1024 + 128 * j + 16 * m); r.a = xp[0]; r.b = xp[1]; r.c = r.a; r.d = r.b; }
    else { const u32x4* cp = (const u32x4*)((const float*)(a.ws + O_COEF) + (size_t)t * 128 + 16 * r8); r.a = cp[0]; r.b = cp[1]; r.c = cp[2]; r.d = cp[3]; }
    return r;
}
template <int PH, int HALF> __device__ __forceinline__ void g_half(u32x4 (&q)[8], const GSide& sd, float (&pa)[16]) {
    if (PH == 0) {
        float x[16];
#pragma unroll
        for (int k = 0; k < 8; ++k) { const h16x8 xa = __builtin_bit_cast(h16x8, sd.a), xb = __builtin_bit_cast(h16x8, sd.b); x[k] = (float)xa[k]; x[8 + k] = (float)xb[k]; }
#pragma unroll
        for (int i = 0; i < 8; ++i) { float d[16]; dec16(q[i], d); float s0 = 0.f, s1 = 0.f;
#pragma unroll
            for (int k = 0; k < 8; ++k) { s0 += x[2 * k] * d[2 * k]; s1 += x[2 * k + 1] * d[2 * k + 1]; }
            pa[8 * HALF + i] = s0 + s1; }
    } else {
#pragma unroll
        for (int i = 0; i < 8; ++i) { float d[16]; dec16(q[i], d);
            const float cf = __uint_as_float(HALF == 0 ? (i < 4 ? sd.a[i & 3] : sd.b[i & 3]) : (i < 4 ? sd.c[i & 3] : sd.d[i & 3]));
#pragma unroll
            for (int k = 0; k < 16; ++k) pa[k] += cf * d[k];
            if (i + 1 < 8) asm volatile("" : "+v"(q[i + 1][0]), "+v"(q[i + 1][1]), "+v"(q[i + 1][2]), "+v"(q[i + 1][3]));
        }
    }
}
template <int PH> __device__ __forceinline__ void g_finish(const Args& a, int t, int j, int lane, float (&p)[16]) {
    const int m = lane & 7, r8 = lane >> 3;
    float q8[8], q4[4], q2[2];
    if (PH == 0) {
#pragma unroll
        for (int i = 0; i < 8; ++i) { const float keep = (lane & 4) ? p[i + 8] : p[i], send = (lane & 4) ? p[i] : p[i + 8]; q8[i] = keep + xhm_(send); }
#pragma unroll
        for (int i = 0; i < 4; ++i) { const float keep = (lane & 2) ? q8[i + 4] : q8[i], send = (lane & 2) ? q8[i] : q8[i + 4]; q4[i] = keep + dpp_<0x4E>(send); }
#pragma unroll
        for (int i = 0; i < 2; ++i) { const float keep = (lane & 1) ? q4[i + 2] : q4[i], send = (lane & 1) ? q4[i] : q4[i + 2]; q2[i] = keep + dpp_<0xB1>(send); }
        *(f32x2*)((float*)(a.ws + O_PART) + ((size_t)j * MTOK + t) * 128 + 16 * r8 + 2 * m) = (f32x2){q2[0], q2[1]};
    } else {
#pragma unroll
        for (int i = 0; i < 8; ++i) { const float keep = (lane & 32) ? p[i + 8] : p[i], send = (lane & 32) ? p[i] : p[i + 8]; q8[i] = keep + x32_(send, lane); }
#pragma unroll
        for (int i = 0; i < 4; ++i) { const float keep = (lane & 16) ? q8[i + 4] : q8[i], send = (lane & 16) ? q8[i] : q8[i + 4]; q4[i] = keep + x16_(send, lane); }
#pragma unroll
        for (int i = 0; i < 2; ++i) { const float keep = (lane & 8) ? q4[i + 2] : q4[i], send = (lane & 8) ? q4[i] : q4[i + 2]; q2[i] = keep + x8_(send); }
        const int col = 128 * j + 16 * m + 2 * r8;
        float* op = a.out + (size_t)t * 1024 + col;
        f32x2 hv = *(const f32x2*)op; hv[0] += q2[0]; hv[1] += q2[1];
        *(f32x2*)op = hv;
        *(h16x2*)((h16*)(a.ws + O_H2B) + (size_t)t * 1024 + col) = (h16x2){(h16)hv[0], (h16)hv[1]};
        const float ss = wave_sum(hv[0] * hv[0] + hv[1] * hv[1]);
        if (lane == 0) ((float*)(a.ws + O_SS2))[(size_t)t * 8 + j] = ss;
    }
}
template <int PH>
__device__ __forceinline__ void phase_gather(const Args& a, int cset) {
    const int tid = tid_(), lane = tid & 63, m = lane & 7, r8 = lane >> 3;
    unsigned* ctr = (unsigned*)(a.ws + O_CTR) + cset * 8 * 64;
    const unsigned short* IDX = (const unsigned short*)(a.ws + O_IDX);
    const unsigned j0 = xcc_id();
    for (unsigned dj = 0; dj < 8; ++dj) {
        const unsigned j = (j0 + dj) & 7u;
        const unsigned char* TB = a.ws + (PH ? O_V8 : O_U8) + (size_t)j * 16384 * 128; const unsigned lo16 = 16u * (unsigned)m;
        for (;;) {
            unsigned c = 0; if (lane == 0) c = __hip_atomic_fetch_add(ctr + j * 64, 1u, __ATOMIC_RELAXED, __HIP_MEMORY_SCOPE_AGENT);
            c = (unsigned)__builtin_amdgcn_readfirstlane((int)c);
            if (c >= (unsigned)GA_NCH) break;
            const int t0 = c * GA_TC;
            u32x4 qa[8], qb[8]; GSide sd, sn; GIdx ix, ixn;
            ix = g_ldidx(IDX, t0, r8); g_issue8(TB, lo16, ix.a, qa); sd = g_ldside<PH>(a, t0, j, m, r8);
#pragma unroll 1
            for (int ti = 0; ti < GA_TC; ++ti) {
                const int t = t0 + ti, tn = (ti + 1 < GA_TC) ? t + 1 : t;
                g_issue8(TB, lo16, ix.b, qb); ixn = g_ldidx(IDX, tn, r8); sn = g_ldside<PH>(a, tn, j, m, r8);
                float p[16];
                if (PH == 1) {
#pragma unroll
                    for (int k = 0; k < 16; ++k) p[k] = 0.f;
                }
                g_half<PH, 0>(qa, sd, p);
                g_issue8(TB, lo16, ixn.a, qa);
                g_half<PH, 1>(qb, sd, p);
                g_finish<PH>(a, t, j, lane, p);
                ix = ixn; sd = sn;
            }
        }
    }
}
__device__ __forceinline__ void phase_coef(const Args& a) {
    const int tid = tid_();
    const float* PART = (const float*)(a.ws + O_PART); const unsigned short* IDX = (const unsigned short*)(a.ws + O_IDX);
    const float* GATE = (const float*)(a.ws + O_GATE); const float* RS1 = (const float*)(a.ws + O_RS1);
    const float* USC = (const float*)(a.ws + O_USC); const float* VSC = (const float*)(a.ws + O_VSC); float* COEF = (float*)(a.ws + O_COEF);
    for (int i = blockIdx.x * NTHREADS + tid; i < MTOK * 128; i += gridDim.x * NTHREADS) {
        float s = 0.f;
#pragma unroll
        for (int j = 0; j < 8; ++j) s += PART[(size_t)j * MTOK * 128 + i];
        const unsigned e = IDX[i];
        COEF[i] = GATE[i] * gelu_tanh(RS1[i >> 7] * USC[e] * s) * VSC[e];
    }
}

__device__ __forceinline__ void phase_final(const Args& a) {
    const int tid = tid_(), lane = tid & 63, wave = tid >> 6;
    const int gw = blockIdx.x * NWAVES + wave, NGW = gridDim.x * NWAVES;
    const float* part = (const float*)(a.ws + O_PART3); const float* fg = a.in[28];
    f32x4 g4[4];
#pragma unroll
    for (int j = 0; j < 4; ++j) g4[j] = *((const f32x4*)fg + lane + 64 * j);
    for (int r = gw; r < MTOK; r += NGW) {
        float s = (lane < 16) ? part[(size_t)r * 16 + lane] : 0.f;
        s = wave_sum(s);
        const float rs = rsqrtf(s * (1.f / 1024.f) + NORM_EPS);
        f32x4* xr = (f32x4*)(a.out + (size_t)r * 1024) + lane;
#pragma unroll
        for (int j = 0; j < 4; ++j) xr[64 * j] = xr[64 * j] * rs * g4[j];
    }
}

constexpr int NPHASE = 19;
__global__ void __launch_bounds__(NTHREADS, 2) mk(Args a) {
    extern __shared__ __attribute__((aligned(16))) unsigned char smem[];
    LAS unsigned char* lds = (LAS unsigned char*)smem;
    unsigned char* ws = a.ws;
#if ONE_LAUNCH
    cg::grid_group grid = cg::this_grid();
    volatile LAS unsigned* bst = (volatile LAS unsigned*)(lds + 131072);
    if (threadIdx.x < 2) bst[threadIdx.x] = 0u;
    __syncthreads();
    const XcdBarrier xbar = xcd_barrier_post((unsigned*)(a.ws + O_BAR), bst);
    bool first_sync = true;
#define SYNC() do { if (first_sync) { grid.sync(); first_sync = false; } else xcd_barrier(xbar); } while (0)
#else
#define SYNC() do {} while (0)
#endif
#define IN(k) (a.ph_lo <= (k) && (k) < a.ph_hi)
#define SEAM(k) do { if (IN(k) && IN((k) + 1)) SYNC(); } while (0)
#define REPS(k) ((((REP_MASK) >> (k)) & 1u) ? 2 : 1)
    const int G = gridDim.x, bid = blockIdx.x;
    if (IN(0)) for (int rep = 0; rep < REPS(0); ++rep) { if (rep) SYNC(); phase_prep(a, lds); } SEAM(0);
    if (IN(1)) for (int rep = 0; rep < REPS(1); ++rep) { if (rep) SYNC(); pg8::Gemm g{(const h16*)(ws + O_XN), (const h16*)(ws + O_WIN), MTOK, NIN, 1024}; pg8::StaticOrder S; S.init(MTOK, NIN, G, bid);
        EpiZ E{(h16*)(ws + O_ZC), (h16*)(ws + O_ZR), (h16*)(ws + O_ZG)}; pg8::gemm_phase(lds, g, S, E); } SEAM(1);
    if (IN(2)) for (int rep = 0; rep < REPS(2); ++rep) { if (rep) SYNC(); phase_conv(a); phase_rwkv_prep(a); } SEAM(2);
    if (IN(3)) for (int rep = 0; rep < REPS(3); ++rep) { if (rep) SYNC(); pg8::Gemm g{(const h16*)(ws + O_APR), (const h16*)(ws + O_WLR), MTOK, 1536, 256}; pg8::StaticOrder S; S.init(MTOK, 1536, G, bid);
        h16* R = (h16*)a.out; h16* KS = R + (size_t)MTOK * 512; h16* KK = KS + (size_t)2 * MTOK * 512;
        EpiLR E{a.in[7], a.in[9], a.in[13], (h16*)(ws + O_WD), KS, (h16*)(ws + O_BD), (h16*)(ws + O_GG), KK}; pg8::gemm_phase(lds, g, S, E); } SEAM(3);
    if (IN(4)) for (int rep = 0; rep < REPS(4); ++rep) { if (rep) SYNC(); phase_scan<true>(a, lds); } SEAM(4);
    if (IN(5)) for (int rep = 0; rep < REPS(5); ++rep) { if (rep) SYNC(); phase_scan_combine(a, lds); } SEAM(5);
    if (IN(6)) for (int rep = 0; rep < REPS(6); ++rep) { if (rep) SYNC(); phase_scan<false>(a, lds); } SEAM(6);
    if (IN(7)) for (int rep = 0; rep < REPS(7); ++rep) { if (rep) SYNC(); phase_rwkv_post(a); } SEAM(7);
    if (IN(8)) for (int rep = 0; rep < REPS(8); ++rep) { if (rep) SYNC(); pg8::Gemm g{(const h16*)(ws + O_CA), (const h16*)(ws + O_WA), MTOK, 1024, 512}; pg8::StaticOrder S; S.init(MTOK, 1024, G, bid);
        EpiYA E{(const h16*)(ws + O_ZG), a.out}; pg8::gemm_phase(lds, g, S, E); } SEAM(8);
    if (IN(9)) for (int rep = 0; rep < REPS(9); ++rep) { if (rep) SYNC(); pg8::Gemm g{(const h16*)(ws + O_YB), (const h16*)(ws + O_WB), MTOK, 1024, 512}; pg8::StaticOrder S; S.init(MTOK, 1024, G, bid);
        EpiYB E{(const h16*)(ws + O_ZG), a.out, (h16*)(ws + O_MERGED)}; pg8::gemm_phase(lds, g, S, E); } SEAM(9);
    if (IN(10)) for (int rep = 0; rep < REPS(10); ++rep) { if (rep) SYNC(); pg8::Gemm g{(const h16*)(ws + O_MERGED), (const h16*)(ws + O_WO), MTOK, 1024, 1024}; pg8::StaticOrder S; S.init(MTOK, 1024, G, bid);
        EpiH1 E{a.in[0], a.out, (h16*)(ws + O_H1B), (float*)(ws + O_PART1)}; pg8::gemm_phase(lds, g, S, E); } SEAM(10);
    if (IN(11)) for (int rep = 0; rep < REPS(11); ++rep) { if (rep) SYNC(); pg8::Gemm g{(const h16*)(ws + O_H1B), (const h16*)(ws + O_WS), MTOK, 2048, 1024}; pg8::StaticOrder S; S.init(MTOK, 2048, G, bid);
        EpiF16 E{(h16*)(ws + O_SCORES), 2048}; pg8::gemm_phase(lds, g, S, E); } SEAM(11);
    if (IN(12)) for (int rep = 0; rep < REPS(12); ++rep) { if (rep) SYNC(); phase_topk(a, lds); } SEAM(12);
    if (IN(13)) for (int rep = 0; rep < REPS(13); ++rep) { if (rep) SYNC(); phase_gather<0>(a, 2 * rep); } SEAM(13);
    if (IN(14)) for (int rep = 0; rep < REPS(14); ++rep) { if (rep) SYNC(); phase_coef(a); } SEAM(14);
    if (IN(15)) for (int rep = 0; rep < REPS(15); ++rep) { if (rep) SYNC(); phase_gather<1>(a, 1); } SEAM(15);
    if (IN(16)) for (int rep = 0; rep < REPS(16); ++rep) { if (rep) SYNC(); pg8::Gemm g{(const h16*)(ws + O_P16), (const h16*)(ws + O_WP), MTOK, 1024, 256}; pg8::StaticOrder S; S.init(MTOK, 1024, G, bid);
        EpiF16 E{(h16*)(ws + O_PP), 1024}; pg8::gemm_phase(lds, g, S, E); } SEAM(16);
    if (IN(17)) for (int rep = 0; rep < REPS(17); ++rep) { if (rep) SYNC(); pg8::Gemm g{(const h16*)(ws + O_H2B), (const h16*)(ws + O_WG), MTOK, 1024, 1024}; pg8::StaticOrder S; S.init(MTOK, 1024, G, bid);
        EpiGate E{a.out, (const h16*)(ws + O_PP), (const float*)(ws + O_SS2), (float*)(ws + O_PART3)}; pg8::gemm_phase(lds, g, S, E); } SEAM(17);
    if (IN(18)) for (int rep = 0; rep < REPS(18); ++rep) { if (rep) SYNC(); phase_final(a); }
}

extern "C" void kernel_launch(void* const* d_in, const int* in_sizes, int n_in, void* d_out, int out_size, void* d_ws, size_t ws_size, hipStream_t stream) {
    static int ready = 0;
    if (!ready) {
        if (n_in != 29 || ws_size < WS_END) { fprintf(stderr, "kernel_launch: unexpected n_in %d / ws %zu (need %zu)\n", n_in, ws_size, (size_t)WS_END); ready = -1; return; }
        if (hipFuncSetAttribute((const void*)mk, hipFuncAttributeMaxDynamicSharedMemorySize, LDS_BYTES) != hipSuccess) { fprintf(stderr, "hipFuncSetAttribute failed\n"); ready = -1; return; }
        ready = 1;
    }
    if (ready < 0) return;
    Args a{};
    for (int i = 0; i < 29; ++i) a.in[i] = (const float*)d_in[i];
    a.out = (float*)d_out; a.ws = (unsigned char*)d_ws;
#if ONE_LAUNCH
    (void)hipMemsetAsync((unsigned char*)d_ws + O_BAR, 0, 16384, stream);
    a.ph_lo = 0; a.ph_hi = NPHASE;
    void* args[] = {&a};
    hipLaunchCooperativeKernel((const void*)mk, dim3(NBLK), dim3(NTHREADS), args, LDS_BYTES, stream);
#else
    const int phases[] = {0, 1, 2, 3, 4, 5, 6, 7, 8, 9, 10, 11, 12, 13, 14, 15, 16, 17, 18};
    for (int ph : phases) { a.ph_lo = ph; a.ph_hi = ph + 1; hipLaunchKernelGGL(mk, dim3(NBLK), dim3(NTHREADS), LDS_BYTES, stream, a); }
#endif
}
```

```cpp
#include <hip/hip_runtime.h>
#include <hip/hip_cooperative_groups.h>
#include <cstdio>
namespace cg = cooperative_groups;

#ifndef REP_MASK
#define REP_MASK 0u
#endif
#ifndef ONE_LAUNCH
#define ONE_LAUNCH 1
#endif

#define LAS __attribute__((address_space(3)))
typedef _Float16 h16;
typedef _Float16 h16x8 __attribute__((ext_vector_type(8)));
typedef _Float16 h16x4 __attribute__((ext_vector_type(4)));
typedef _Float16 h16x2 __attribute__((ext_vector_type(2)));
typedef float f32x4 __attribute__((ext_vector_type(4)));
typedef float f32x2 __attribute__((ext_vector_type(2)));
typedef unsigned u32x4 __attribute__((ext_vector_type(4)));
typedef unsigned u32x2 __attribute__((ext_vector_type(2)));

constexpr int MTOK = 65536, DM = 1024, SEQ = 8192, NB = 8;
constexpr int NIN = 5376;
constexpr int NTHREADS = 512, NWAVES = 8, NBLK = 256;
constexpr int LDS_BYTES = 131072 + 64;
constexpr float NORM_EPS = 1e-6f;

constexpr size_t MiB = 1u << 20;
constexpr size_t O_WIN = 0;
constexpr size_t O_WA = O_WIN + (size_t)5376 * 1024 * 2;
constexpr size_t O_WB = O_WA + 1 * MiB;
constexpr size_t O_WO = O_WB + 1 * MiB;
constexpr size_t O_WG = O_WO + 2 * MiB;
constexpr size_t O_WP = O_WG + 2 * MiB;
constexpr size_t O_WLR = O_WP + MiB / 2;
constexpr size_t O_WS = O_WLR + 3 * MiB / 4;
constexpr size_t O_U16 = O_WS + 4 * MiB;
constexpr size_t O_V16 = O_U16 + 32 * MiB;
constexpr size_t O_P16 = O_V16 + 32 * MiB;
constexpr size_t O_PART1 = O_P16 + 32 * MiB;
constexpr size_t O_PART3 = O_PART1 + 4 * MiB;
constexpr size_t O_RS1 = O_PART3 + 4 * MiB;
constexpr size_t O_RS2 = O_RS1 + MiB / 4;
constexpr size_t O_XN = O_RS2 + MiB / 4;
constexpr size_t O_ZC = O_XN + 128 * MiB;
constexpr size_t O_ZR = O_ZC + 192 * MiB;
constexpr size_t O_ZG = O_ZR + 224 * MiB;
constexpr size_t O_SS2 = O_ZG + 256 * MiB;
constexpr size_t O_USC = O_SS2 + 2 * MiB;
constexpr size_t O_VSC = O_USC + 65536;
constexpr size_t O_CTR = O_VSC + 65536;
constexpr size_t O_BAR = O_CTR + 8192;
constexpr size_t WS_END = O_BAR + 16384;
constexpr size_t O_U8 = O_U16;
constexpr size_t O_V8 = O_U16 + 16 * MiB;
constexpr size_t O_PART = O_ZG;
constexpr size_t O_COEF = O_ZR + 48 * MiB;
constexpr size_t O_CA = O_XN;
constexpr size_t O_APR = O_XN + 64 * MiB;
constexpr size_t O_H1B = O_XN;
constexpr size_t O_WD = O_ZC;
constexpr size_t O_BD = O_ZC + 64 * MiB;
constexpr size_t O_GG = O_ZC + 128 * MiB;
constexpr size_t O_MERGED = O_ZC;
constexpr size_t O_H2B = O_ZC;
constexpr size_t O_PQ = O_ZR;
constexpr size_t O_SST = O_ZR + 64 * MiB;
constexpr size_t O_Y = O_ZR + 96 * MiB;
constexpr size_t O_YB = O_ZR + 160 * MiB;
constexpr size_t O_IDX = O_ZR;
constexpr size_t O_GATE = O_ZR + 16 * MiB;
constexpr size_t O_PP = O_ZR + 64 * MiB;
constexpr size_t O_SCORES = O_ZG;

struct Args {
    const float* in[29];
    float* out;
    unsigned char* ws;
    int ph_lo, ph_hi;
};

__device__ __forceinline__ int tid_() { int t = threadIdx.x; asm volatile("" : "+v"(t)); return t; }
__device__ __forceinline__ float sigmoidf_(float x) { return __builtin_amdgcn_rcpf(1.0f + __expf(-x)); }
template <int CTRL> __device__ __forceinline__ float dpp_(float v) { return __builtin_bit_cast(float, __builtin_amdgcn_update_dpp(0, __builtin_bit_cast(int, v), CTRL, 0xF, 0xF, true)); }
__device__ __forceinline__ float x32_(float v, int lane) { const auto r = __builtin_amdgcn_permlane32_swap(__builtin_bit_cast(unsigned, v), __builtin_bit_cast(unsigned, v), false, false); return __builtin_bit_cast(float, (lane & 32) ? r[0] : r[1]); }
__device__ __forceinline__ float x16_(float v, int lane) { const auto r = __builtin_amdgcn_permlane16_swap(__builtin_bit_cast(unsigned, v), __builtin_bit_cast(unsigned, v), false, false); return __builtin_bit_cast(float, (lane & 16) ? r[0] : r[1]); }
__device__ __forceinline__ float x8_(float v) { return dpp_<0x128>(v); }
__device__ __forceinline__ float xhm_(float v) { return dpp_<0x141>(v); }
__device__ __forceinline__ float wave_sum(float v) {
    const int lane = threadIdx.x & 63;
    v += dpp_<0xB1>(v); v += dpp_<0x4E>(v); v += dpp_<0x141>(v); v += dpp_<0x140>(v);
    v += x16_(v, lane); v += x32_(v, lane);
    return v;
}
__device__ __forceinline__ h16x8 pack8(f32x4 a, f32x4 b) {
    h16x8 r;
    r[0] = (h16)a[0]; r[1] = (h16)a[1]; r[2] = (h16)a[2]; r[3] = (h16)a[3];
    r[4] = (h16)b[0]; r[5] = (h16)b[1]; r[6] = (h16)b[2]; r[7] = (h16)b[3];
    return r;
}
__device__ __forceinline__ h16x4 pack4(f32x4 a) {
    h16x4 r; r[0] = (h16)a[0]; r[1] = (h16)a[1]; r[2] = (h16)a[2]; r[3] = (h16)a[3]; return r;
}

#define XB_TMO      128
#define XB_XCNT(j)  (256  + 64 * (j))
#define XB_XSUB(j)  (1280 + 64 * (j))
#define XB_XGEN(j)  (2304 + 64 * (j))
#define XB_TOP      3328
#define XB_TOPGEN   3392
#define XCD_BAR_WORDS 3456
#define XB_SPIN_CAP (1u << 18)

__device__ __forceinline__ unsigned xb_ld(unsigned* p)              { return __hip_atomic_load(p, __ATOMIC_RELAXED, __HIP_MEMORY_SCOPE_AGENT); }
__device__ __forceinline__ unsigned xb_add(unsigned* p, unsigned v) { return __hip_atomic_fetch_add(p, v, __ATOMIC_RELAXED, __HIP_MEMORY_SCOPE_AGENT); }
__device__ __forceinline__ unsigned xb_xcc_id() { return (unsigned)__builtin_amdgcn_s_getreg((3 << 11) | 20) & 0xFu; }
#define XB_SPIN(cond, bar) do { unsigned _sp = 0; while (cond) { __builtin_amdgcn_s_sleep(1); \
    if ((++_sp & 255u) == 0u) { if (xb_ld(&(bar)[XB_TMO])) break; if (_sp > XB_SPIN_CAP) { atomicAdd(&(bar)[XB_TMO], 1u); break; } } } } while (0)

struct XcdBarrier {
    unsigned* bar; unsigned x;
    volatile LAS unsigned* st;
};

__device__ __forceinline__ XcdBarrier xcd_barrier_post(unsigned* bar, volatile LAS unsigned* st) {
    XcdBarrier b; b.bar = bar; b.x = xb_xcc_id(); b.st = st;
    if (threadIdx.x == 0) (void)xb_add(&bar[XB_XCNT(b.x)], 1u);
    return b;
}
__device__ __forceinline__ void xcd_barrier_complete(unsigned* bar, unsigned x, unsigned& nloc, unsigned& nx) {
    const unsigned G = gridDim.x * gridDim.y * gridDim.z;
    unsigned sum, cnt, mine, sp = 0u;
    for (;;) {
        sum = 0u; cnt = 0u; mine = 0u;
#pragma unroll
        for (unsigned j = 0; j < 16; ++j) { const unsigned c = xb_ld(&bar[XB_XCNT(j)]); sum += c; cnt += (c > 0u) ? 1u : 0u; mine = (j == x) ? c : mine; }
        if (sum == G) break;
        __builtin_amdgcn_s_sleep(1);
        if ((++sp & 255u) == 0u) { if (xb_ld(&bar[XB_TMO])) break; if (sp > XB_SPIN_CAP) { atomicAdd(&bar[XB_TMO], 1u); break; } }
    }
    nloc = mine > 0u ? mine : 1u; nx = cnt > 0u ? cnt : 1u;
}

__device__ __forceinline__ void xcd_barrier(const XcdBarrier& b) {
    asm volatile("s_waitcnt vmcnt(0)" ::: "memory");
    __syncthreads();
    if (threadIdx.x == 0) {
        unsigned* bar = b.bar;
        __builtin_amdgcn_s_waitcnt(0);
        unsigned nloc = b.st[0], nx = b.st[1];
        if (nloc == 0u) { xcd_barrier_complete(bar, b.x, nloc, nx); b.st[0] = nloc; b.st[1] = nx; }
        const unsigned old = xb_add(&bar[XB_XSUB(b.x)], 1u);
        const unsigned gen = old / nloc;
        if (old + 1u == (gen + 1u) * nloc) {
            __builtin_amdgcn_fence(__ATOMIC_RELEASE, "agent");
            asm volatile("s_waitcnt vmcnt(0)" ::: "memory");
            const unsigned og = xb_add(&bar[XB_TOP], 1u);
            const unsigned tg = og / nx;
            if (og + 1u == (tg + 1u) * nx) xb_add(&bar[XB_TOPGEN], 1u);
            else XB_SPIN(xb_ld(&bar[XB_TOPGEN]) == tg, bar);
            __builtin_amdgcn_fence(__ATOMIC_ACQUIRE, "agent");
            xb_add(&bar[XB_XGEN(b.x)], 1u);
            asm volatile("s_waitcnt vmcnt(0)" ::: "memory");
        } else {
            XB_SPIN(xb_ld(&bar[XB_XGEN(b.x)]) == gen, bar);
            __builtin_amdgcn_fence(__ATOMIC_ACQUIRE, "agent");
            asm volatile("s_waitcnt vmcnt(0)" ::: "memory");
        }
    }
    __syncthreads();
}


namespace pg8 {
constexpr int BM = 256, BK = 64, HALF = 128, HTB = HALF * BK * 2, STAGE_BYTES = 8 * HTB, NXCD = 8, WGM = 8;
__device__ __forceinline__ int lds_byte(int r, int c) { const int st = (r >> 4) * 2 + (c >> 5), rr = r & 15, cc = c & 31, ob = rr * 64 + cc * 2; return st * 1024 + (ob ^ (((ob >> 9) & 1) << 5)); }
__device__ __forceinline__ void stage_rc(int b, int& R, int& C) { const int st = b / 1024, sb = b % 1024, swz = sb ^ (((sb >> 9) & 1) << 5); R = (st >> 1) * 16 + swz / 64; C = (st & 1) * 32 + (swz % 64) / 2; }
__device__ __forceinline__ int perm32(int rho) { const int n = rho >> 4, i = rho & 15; return 8 * (i >> 2) + 4 * n + (i & 3); }

struct Unit { int pm, pn; };
struct Gemm { const h16* A; const h16* Bt; int M, N, K; };

struct StaticOrder {
    int nM, nN, nwg, G, c;
    __device__ void init(int M, int N, int G_, int c_) { nM = M / BM; nN = N / BM; nwg = nM * nN; G = G_; c = c_; }
    __device__ bool next(int i, Unit& u) const {
        const long L = (long)i * G + c; if (L >= nwg) return false;
        int wgid = (int)L; { const int q = nwg / NXCD, r = nwg % NXCD, xcd = wgid % NXCD, off = wgid / NXCD; wgid = (xcd < r ? xcd * (q + 1) : r * (q + 1) + (xcd - r) * q) + off; }
        const int nig = WGM * nN, gid = wgid / nig, fm = gid * WGM, gsz = (nM - fm) < WGM ? (nM - fm) : WGM;
        u.pm = fm + ((wgid % nig) % gsz); u.pn = (wgid % nig) / gsz; return true;
    }
};

template <class Epi>
__device__ __forceinline__ void gemm_phase(LAS unsigned char* lds, const Gemm g, const StaticOrder& S, const Epi& E) {
    const int tid = tid_(), wid = __builtin_amdgcn_readfirstlane(tid >> 6), lane = tid & 63, wr = wid >> 2, wc = wid & 3, fr = lane & 15, fq = lane >> 4;
    const int K = g.K, nt = K / BK;
    unsigned voffA[2], voffB[2];
#pragma unroll
    for (int i = 0; i < 2; ++i) { int R, C; stage_rc(tid * 16 + i * 8192, R, C); const int Rb = (R & ~31) + perm32(R & 31);
        voffA[i] = (unsigned)(R * K + C) * 2u; voffB[i] = (unsigned)(Rb * K + C) * 2u; }
    const size_t kstep = (size_t)(BK * 2);
    const size_t hstep = (size_t)HALF * K * 2;
    const size_t tstep = 2 * hstep;
    const unsigned ldsw = (unsigned)wid * 1024u;
    const int aoff = lds_byte(wr * 64 + fr, fq * 8), boff = lds_byte(wc * 32 + fr, fq * 8);
#define PG8_SA(b, h) (((b) * 2 + (h)) * HTB)
#define PG8_SB(b, h) ((4 + (b) * 2 + (h)) * HTB)
#define PG8_STAGE(bufoff, gbase, voff) do { _Pragma("unroll") for (int _i = 0; _i < 2; ++_i) \
        __builtin_amdgcn_global_load_lds((const unsigned*)((const char*)(gbase) + (voff)[_i]), (LAS unsigned*)(lds + (bufoff) + ldsw + _i * 8192), 16, 0, 0); } while (0)
#define PG8_LDA(dst, b, h) do { _Pragma("unroll") for (int m = 0; m < 4; ++m) _Pragma("unroll") for (int k = 0; k < 2; ++k) dst[m][k] = *(const LAS h16x8*)(lds + PG8_SA(b, h) + aoff + m * 2048 + k * 1024); } while (0)
#define PG8_LDB(dst, b, h) do { _Pragma("unroll") for (int n = 0; n < 2; ++n) _Pragma("unroll") for (int k = 0; k < 2; ++k) dst[n][k] = *(const LAS h16x8*)(lds + PG8_SB(b, h) + boff + n * 2048 + k * 1024); } while (0)
#define PG8_MMA(ai, bj, At, Bt) do { __builtin_amdgcn_s_setprio(1); _Pragma("unroll") for (int m = 0; m < 4; ++m) _Pragma("unroll") for (int n = 0; n < 2; ++n) _Pragma("unroll") for (int k = 0; k < 2; ++k) \
        acc[ai][bj][m][n] = __builtin_amdgcn_mfma_f32_16x16x32_f16(Bt[n][k], At[m][k], acc[ai][bj][m][n], 0, 0, 0); __builtin_amdgcn_s_setprio(0); } while (0)
#define PG8_WAIT_V(n) asm volatile("s_waitcnt vmcnt(" #n ")" ::: "memory")
#define PG8_WAIT_L(n) asm volatile("s_waitcnt lgkmcnt(" #n ")" ::: "memory")
#define PG8_BAR __builtin_amdgcn_s_barrier()
#define PG8_SCHED __builtin_amdgcn_sched_barrier(0)
    Unit cur, nxt; int ui = 0;
    if (!S.next(0, cur)) return;
    f32x4 acc[2][2][4][2];
#pragma unroll
    for (int a = 0; a < 2; ++a)
#pragma unroll
        for (int b = 0; b < 2; ++b)
#pragma unroll
            for (int m = 0; m < 4; ++m)
#pragma unroll
                for (int n = 0; n < 2; ++n) acc[a][b][m][n] = (f32x4){0.f, 0.f, 0.f, 0.f};
    h16x8 At[4][2], B0[2][2], B1[2][2];
    const char* cA = (const char*)g.A + (size_t)cur.pm * tstep; const char* cB = (const char*)g.Bt + (size_t)cur.pn * tstep;
    PG8_STAGE(PG8_SB(0, 0), cB, voffB); PG8_STAGE(PG8_SB(0, 1), cB + hstep, voffB); PG8_STAGE(PG8_SA(0, 0), cA, voffA); PG8_STAGE(PG8_SA(0, 1), cA + hstep, voffA);
    if (wr == 1) PG8_BAR;
    PG8_WAIT_V(2); PG8_BAR;
    PG8_STAGE(PG8_SB(1, 0), cB + kstep, voffB); PG8_STAGE(PG8_SA(1, 0), cA + kstep, voffA); PG8_STAGE(PG8_SB(1, 1), cB + hstep + kstep, voffB);
    PG8_WAIT_V(6); PG8_BAR;
    for (;;) {
        const bool has_next = S.next(ui + 1, nxt);
        const char* nA = has_next ? (const char*)g.A + (size_t)nxt.pm * tstep : cA; const char* nB = has_next ? (const char*)g.Bt + (size_t)nxt.pn * tstep : cB;
        for (int t = 0; t < nt; t += 2) {
            const bool last = (t == nt - 2);
            const char* a1 = cA + (size_t)(t + 1) * kstep;
            const char* a2 = last ? nA : cA + (size_t)(t + 2) * kstep; const char* b2 = last ? nB : cB + (size_t)(t + 2) * kstep;
            const char* a3 = a2 + kstep; const char* b3 = b2 + kstep;
            PG8_LDB(B0, 0, 0); PG8_LDB(B1, 0, 1); PG8_SCHED; PG8_LDA(At, 0, 0); PG8_STAGE(PG8_SA(1, 1), a1 + hstep, voffA);
            PG8_WAIT_V(8); PG8_WAIT_L(0); PG8_BAR; PG8_MMA(0, 0, At, B0); PG8_MMA(0, 1, At, B1); PG8_BAR; PG8_SCHED;
            PG8_LDA(At, 0, 1); PG8_STAGE(PG8_SB(0, 0), b2, voffB); PG8_STAGE(PG8_SB(0, 1), b2 + hstep, voffB); PG8_STAGE(PG8_SA(0, 0), a2, voffA);
            PG8_WAIT_V(8); PG8_WAIT_L(0); PG8_BAR; PG8_MMA(1, 0, At, B0); PG8_MMA(1, 1, At, B1); PG8_BAR; PG8_SCHED;
            PG8_LDB(B0, 1, 0); PG8_LDB(B1, 1, 1); PG8_SCHED; PG8_LDA(At, 1, 0); PG8_STAGE(PG8_SA(0, 1), a2 + hstep, voffA);
            PG8_WAIT_V(8); PG8_WAIT_L(0); PG8_BAR; PG8_MMA(0, 0, At, B0); PG8_MMA(0, 1, At, B1); PG8_BAR; PG8_SCHED;
            PG8_LDA(At, 1, 1); PG8_STAGE(PG8_SB(1, 0), b3, voffB); PG8_STAGE(PG8_SB(1, 1), b3 + hstep, voffB); PG8_STAGE(PG8_SA(1, 0), a3, voffA);
            PG8_WAIT_V(8); PG8_WAIT_L(0); PG8_BAR; PG8_MMA(1, 0, At, B0); PG8_MMA(1, 1, At, B1); PG8_BAR; PG8_SCHED;
        }
        if (wr == 0) PG8_BAR;
        E(acc, cur, wr, wc, fr, fq);
        if (!has_next) break;
#pragma unroll
        for (int a = 0; a < 2; ++a)
#pragma unroll
            for (int b = 0; b < 2; ++b)
#pragma unroll
                for (int m = 0; m < 4; ++m)
#pragma unroll
                    for (int n = 0; n < 2; ++n) acc[a][b][m][n] = (f32x4){0.f, 0.f, 0.f, 0.f};
        cur = nxt; cA = nA; cB = nB; ++ui;
        if (wr == 1) PG8_BAR;
    }
    PG8_WAIT_V(0);
    PG8_BAR;
#undef PG8_SA
#undef PG8_SB
#undef PG8_STAGE
#undef PG8_LDA
#undef PG8_LDB
#undef PG8_MMA
#undef PG8_WAIT_V
#undef PG8_WAIT_L
#undef PG8_BAR
#undef PG8_SCHED
}
}
using pg8::Unit;
typedef const f32x4 (&AccRef)[2][2][4][2];

#define EPI_LOOP_BEGIN \
    _Pragma("unroll") for (int ai = 0; ai < 2; ++ai) _Pragma("unroll") for (int m = 0; m < 4; ++m) { \
        const int row = u.pm * 256 + ai * 128 + wr * 64 + m * 16 + fr; \
        _Pragma("unroll") for (int bj = 0; bj < 2; ++bj) { \
            const int col = u.pn * 256 + bj * 128 + wc * 32 + 8 * fq; \
            const f32x4 v0 = acc[ai][bj][m][0], v1 = acc[ai][bj][m][1];
#define EPI_LOOP_END } }

struct EpiZ {
    h16 *zc, *zr, *zg;
    __device__ __forceinline__ void operator()(AccRef acc, const Unit& u, int wr, int wc, int fr, int fq) const {
        const int colt = u.pn * 256; h16* base; int ld, c0;
        if (colt < 1536) { base = zc; ld = 1536; c0 = colt; } else if (colt < 3328) { base = zr; ld = 1792; c0 = colt - 1536; } else { base = zg; ld = 2048; c0 = colt - 3328; }
        EPI_LOOP_BEGIN
            *(h16x8*)(base + (size_t)row * ld + (col - colt + c0)) = pack8(v0, v1);
        EPI_LOOP_END
    }
};
struct EpiF16 {
    h16* O; int ld;
    __device__ __forceinline__ void operator()(AccRef acc, const Unit& u, int wr, int wc, int fr, int fq) const {
        EPI_LOOP_BEGIN
            *(h16x8*)(O + (size_t)row * ld + col) = pack8(v0, v1);
        EPI_LOOP_END
    }
};
struct EpiYA {
    const h16* zg; float* tmp;
    __device__ __forceinline__ void operator()(AccRef acc, const Unit& u, int wr, int wc, int fr, int fq) const {
        EPI_LOOP_BEGIN
            const h16x8 gv = *(const h16x8*)(zg + (size_t)row * 2048 + col);
            f32x4 o0, o1;
#pragma unroll
            for (int j = 0; j < 4; ++j) { o0[j] = sigmoidf_((float)gv[j]) * v0[j]; o1[j] = sigmoidf_((float)gv[4 + j]) * v1[j]; }
            float* p = tmp + (size_t)row * 1024 + col;
            *(f32x4*)p = o0; *(f32x4*)(p + 4) = o1;
        EPI_LOOP_END
    }
};
struct EpiYB {
    const h16* zg; const float* tmp; h16* merged;
    __device__ __forceinline__ void operator()(AccRef acc, const Unit& u, int wr, int wc, int fr, int fq) const {
        EPI_LOOP_BEGIN
            const h16x8 gv = *(const h16x8*)(zg + (size_t)row * 2048 + 1024 + col);
            const float* p = tmp + (size_t)row * 1024 + col;
            f32x4 o0 = *(const f32x4*)p, o1 = *(const f32x4*)(p + 4);
#pragma unroll
            for (int j = 0; j < 4; ++j) { o0[j] += sigmoidf_((float)gv[j]) * v0[j]; o1[j] += sigmoidf_((float)gv[4 + j]) * v1[j]; }
            *(h16x8*)(merged + (size_t)row * 1024 + col) = pack8(o0, o1);
        EPI_LOOP_END
    }
};
struct EpiH1 {
    const float* x; float* out; h16* hb; float* part;
    __device__ __forceinline__ void operator()(AccRef acc, const Unit& u, int wr, int wc, int fr, int fq) const {
#pragma unroll
        for (int ai = 0; ai < 2; ++ai)
#pragma unroll
            for (int m = 0; m < 4; ++m) {
                const int row = u.pm * 256 + ai * 128 + wr * 64 + m * 16 + fr; float ss = 0.f;
#pragma unroll
                for (int bj = 0; bj < 2; ++bj) {
                    const int col = u.pn * 256 + bj * 128 + wc * 32 + 8 * fq;
                    const float* xp = x + (size_t)row * 1024 + col;
                    f32x4 o0 = *(const f32x4*)xp + acc[ai][bj][m][0], o1 = *(const f32x4*)(xp + 4) + acc[ai][bj][m][1];
                    float* op = out + (size_t)row * 1024 + col;
                    *(f32x4*)op = o0; *(f32x4*)(op + 4) = o1;
                    *(h16x8*)(hb + (size_t)row * 1024 + col) = pack8(o0, o1);
                    ss += (o0[0] * o0[0] + o0[1] * o0[1]) + (o0[2] * o0[2] + o0[3] * o0[3]) + (o1[0] * o1[0] + o1[1] * o1[1]) + (o1[2] * o1[2] + o1[3] * o1[3]);
                }
                ss += __shfl_xor(ss, 16); ss += __shfl_xor(ss, 32);
                if (fq == 0) part[(size_t)row * 16 + u.pn * 4 + wc] = ss;
            }
    }
};
struct EpiGate {
    float* out; const h16* pp; const float* rs2; float* part;
    __device__ __forceinline__ void operator()(AccRef acc, const Unit& u, int wr, int wc, int fr, int fq) const {
#pragma unroll
        for (int ai = 0; ai < 2; ++ai)
#pragma unroll
            for (int m = 0; m < 4; ++m) {
                const int row = u.pm * 256 + ai * 128 + wr * 64 + m * 16 + fr; float ss = 0.f;
                const f32x4 sa = *(const f32x4*)(rs2 + (size_t)row * 8), sb = *(const f32x4*)(rs2 + (size_t)row * 8 + 4);
                const float rs = rsqrtf(((sa[0] + sa[1]) + (sa[2] + sa[3]) + (sb[0] + sb[1]) + (sb[2] + sb[3])) * (1.f / 1024.f) + NORM_EPS);
#pragma unroll
                for (int bj = 0; bj < 2; ++bj) {
                    const int col = u.pn * 256 + bj * 128 + wc * 32 + 8 * fq;
                    float* op = out + (size_t)row * 1024 + col;
                    f32x4 o0 = *(const f32x4*)op, o1 = *(const f32x4*)(op + 4);
                    const h16x8 pv = *(const h16x8*)(pp + (size_t)row * 1024 + col);
                    const f32x4 v0 = acc[ai][bj][m][0], v1 = acc[ai][bj][m][1];
#pragma unroll
                    for (int j = 0; j < 4; ++j) { o0[j] += sigmoidf_(rs * v0[j]) * (float)pv[j]; o1[j] += sigmoidf_(rs * v1[j]) * (float)pv[4 + j]; }
                    *(f32x4*)op = o0; *(f32x4*)(op + 4) = o1;
                    ss += (o0[0] * o0[0] + o0[1] * o0[1]) + (o0[2] * o0[2] + o0[3] * o0[3]) + (o1[0] * o1[0] + o1[1] * o1[1]) + (o1[2] * o1[2] + o1[3] * o1[3]);
                }
                ss += __shfl_xor(ss, 16); ss += __shfl_xor(ss, 32);
                if (fq == 0) part[(size_t)row * 16 + u.pn * 4 + wc] = ss;
            }
    }
};

__device__ __forceinline__ void tr_item(const float* W, int N, const float* g, h16* WT, int ldk, int koff, int k0, int n0, LAS float* scr, int lane) {
#pragma unroll 8
    for (int i = 0; i < 32; ++i) { const int kk = 2 * i + (lane >> 5); float v = W[(size_t)(k0 + kk) * N + n0 + (lane & 31)]; if (g) v *= g[k0 + kk]; scr[kk * 33 + (lane & 31)] = v; }
    asm volatile("s_waitcnt lgkmcnt(0)" ::: "memory");
    const int c = lane & 7;
#pragma unroll
    for (int j = 0; j < 4; ++j) { const int n = (lane >> 3) + 8 * j; const LAS float* s = scr + (8 * c) * 33 + n;
        h16x8 o;
#pragma unroll
        for (int e = 0; e < 8; ++e) o[e] = (h16)s[e * 33];
        *(h16x8*)(WT + (size_t)(n0 + n) * ldk + koff + k0 + 8 * c) = o; }
    asm volatile("s_waitcnt lgkmcnt(0)" ::: "memory");
}
struct TrJob { const float* W; const float* g; h16* WT; int K, N, ldk, koff; };

__device__ __forceinline__ void phase_prep(const Args& a, LAS unsigned char* lds) {
    const int tid = tid_(), lane = tid & 63, wave = tid >> 6;
    const int gw = blockIdx.x * NWAVES + wave, NGW = gridDim.x * NWAVES;
    unsigned char* ws = a.ws;
    {
        LAS float* scr = (LAS float*)(lds + wave * 8704);
        TrJob jobs[9] = {
            {a.in[3], a.in[2], (h16*)(ws + O_WIN), 1024, NIN, 1024, 0},
            {a.in[17], nullptr, (h16*)(ws + O_WA), 512, 1024, 512, 0},
            {a.in[18], nullptr, (h16*)(ws + O_WB), 512, 1024, 512, 0},
            {a.in[19], nullptr, (h16*)(ws + O_WO), 1024, 1024, 1024, 0},
            {a.in[26], a.in[25], (h16*)(ws + O_WG), 1024, 1024, 1024, 0},
            {a.in[27], nullptr, (h16*)(ws + O_WP), 256, 1024, 256, 0},
            {a.in[8], nullptr, (h16*)(ws + O_WLR), 64, 512, 256, 0},
            {a.in[10], nullptr, (h16*)(ws + O_WLR) + (size_t)512 * 256, 64, 512, 256, 64},
            {a.in[11], nullptr, (h16*)(ws + O_WLR) + (size_t)1024 * 256, 128, 512, 256, 128},
        };
        int base = 0;
#pragma unroll
        for (int j = 0; j < 9; ++j) {
            const TrJob J = jobs[j]; const int nnb = J.N / 32, items = (J.K / 64) * nnb;
            int first = gw - (base % NGW); if (first < 0) first += NGW;
            for (int r = first; r < items; r += NGW) tr_item(J.W, J.N, J.g, J.WT, J.ldk, J.koff, (r / nnb) * 64, (r % nnb) * 32, scr, lane);
            base += items;
        }
        h16* wlr = (h16*)(ws + O_WLR);
        for (int i = blockIdx.x * NTHREADS + tid; i < 1536 * 256 / 8; i += gridDim.x * NTHREADS) {
            const int n = (i * 8) / 256, k = (i * 8) % 256; const int blk = n / 512;
            const bool inblk = (blk == 0) ? (k < 64) : (blk == 1) ? (k >= 64 && k < 128) : (k >= 128);
            if (!inblk) { h16x8 z; for (int e = 0; e < 8; ++e) z[e] = (h16)0.f; *(h16x8*)(wlr + (size_t)i * 8) = z; }
        }
    }
    __syncthreads();
    {
        LAS float* LA = (LAS float*)lds;
        LAS float* LB = (LAS float*)(lds + 64 * 129 * 4);
        const float* wq = a.in[21]; const float* sk = a.in[22]; const float* gf = a.in[20];
        h16* wst = (h16*)(ws + O_WS);
        for (int it = blockIdx.x; it < 256; it += gridDim.x) {
            const int g16 = it >> 4, k0 = (it & 15) * 64;
            for (int i = tid; i < 64 * 128; i += NTHREADS) { const int k = i >> 7, d = i & 127; LA[k * 129 + d] = wq[(size_t)(k0 + k) * 2048 + g16 * 128 + d] * gf[k0 + k]; }
            for (int i = tid; i < 128 * 128; i += NTHREADS) { const int n = i >> 7, d = i & 127; LB[n * 129 + d] = sk[((size_t)g16 * 128 + n) * 128 + d]; }
            __syncthreads();
            const int n = tid & 127, kg = tid >> 7;
            float o[16];
#pragma unroll
            for (int j = 0; j < 16; ++j) o[j] = 0.f;
            for (int d = 0; d < 128; ++d) { const float b = LB[n * 129 + d];
#pragma unroll
                for (int j = 0; j < 16; ++j) o[j] += LA[(kg * 16 + j) * 129 + d] * b; }
            h16x8 o0, o1;
#pragma unroll
            for (int j = 0; j < 8; ++j) { o0[j] = (h16)o[j]; o1[j] = (h16)o[8 + j]; }
            h16* dst = wst + (size_t)(g16 * 128 + n) * 1024 + k0 + kg * 16;
            *(h16x8*)dst = o0; *(h16x8*)(dst + 8) = o1;
            __syncthreads();
        }
    }
    {
        const float* gf = a.in[20];
        f32x4 g4[4];
#pragma unroll
        for (int j = 0; j < 4; ++j) g4[j] = *(const f32x4*)(gf + 16 * lane + 4 * j);
        for (int r = gw; r < 2 * 16384; r += NGW) {
            const int tb = r >> 14, e = r & 16383;
            const float* src = (tb ? a.in[24] : a.in[23]) + (size_t)e * 1024 + 16 * lane;
            f32x4 v[4]; float mx = 0.f;
#pragma unroll
            for (int j = 0; j < 4; ++j) { v[j] = *(const f32x4*)(src + 4 * j); if (!tb) v[j] = v[j] * g4[j];
#pragma unroll
                for (int c = 0; c < 4; ++c) mx = fmaxf(mx, fabsf(v[j][c])); }
#pragma unroll
            for (int o = 1; o < 64; o <<= 1) mx = fmaxf(mx, __shfl_xor(mx, o));
            mx = fmaxf(mx, 1e-30f);
            const float sc = 224.0f / mx;
            u32x4 q;
#pragma unroll
            for (int j = 0; j < 4; ++j) { int w = 0; w = __builtin_amdgcn_cvt_pk_fp8_f32(v[j][0] * sc, v[j][1] * sc, w, false); w = __builtin_amdgcn_cvt_pk_fp8_f32(v[j][2] * sc, v[j][3] * sc, w, true); q[j] = (unsigned)w; }
            unsigned char* dst = ws + (tb ? O_V8 : O_U8) + ((size_t)(lane >> 3) * 16384 + e) * 128 + 16 * (lane & 7);
            *(u32x4*)dst = q;
            if (lane == 0) ((float*)(ws + (tb ? O_VSC : O_USC)))[e] = mx * (1.0f / 224.0f);
        }
        if (blockIdx.x == 0 && tid < 32) ((unsigned*)(ws + O_CTR))[tid * 64] = 0u;
        const f32x4* pp = (const f32x4*)a.in[1]; h16x4* dp = (h16x4*)(ws + O_P16);
        const int np4 = MTOK * 256 / 4;
        for (int i = blockIdx.x * NTHREADS + tid; i < np4; i += gridDim.x * NTHREADS) dp[i] = pack4(pp[i]);
    }
    {
        const float* x = a.in[0]; h16* xn = (h16*)(ws + O_XN);
        for (int r = gw; r < MTOK; r += NGW) {
            const f32x4* xr = (const f32x4*)(x + (size_t)r * 1024) + lane;
            f32x4 v[4]; float s = 0.f;
#pragma unroll
            for (int j = 0; j < 4; ++j) { v[j] = xr[64 * j]; s += (v[j][0] * v[j][0] + v[j][1] * v[j][1]) + (v[j][2] * v[j][2] + v[j][3] * v[j][3]); }
            const float rs = rsqrtf(wave_sum(s) * (1.f / 1024.f) + NORM_EPS);
            h16x4* o = (h16x4*)(xn + (size_t)r * 1024) + lane;
#pragma unroll
            for (int j = 0; j < 4; ++j) o[64 * j] = pack4(v[j] * rs);
        }
    }
}

__device__ __forceinline__ void phase_conv(const Args& a) {
    const int tid = tid_(), lane = tid & 63, wave = tid >> 6;
    const int gw = blockIdx.x * NWAVES + wave, NGW = gridDim.x * NWAVES;
    const h16* zc = (const h16*)(a.ws + O_ZC); h16* ca = (h16*)(a.ws + O_CA);
    const float* cw = a.in[4]; const float* cb = a.in[5];
    float w0[8], w1[8], w2[8], bb[8];
#pragma unroll
    for (int j = 0; j < 8; ++j) { const int c = lane * 8 + j; w0[j] = cw[c]; w1[j] = cw[512 + c]; w2[j] = cw[1024 + c]; bb[j] = cb[c]; }
    for (int run = gw; run < MTOK / 32; run += NGW) {
        const int t0 = run * 32;
        float u1[8], u2[8];
        if ((t0 % SEQ) == 0) {
#pragma unroll
            for (int j = 0; j < 8; ++j) { u1[j] = 0.f; u2[j] = 0.f; }
        } else {
            const h16x8 c1 = *(const h16x8*)(zc + (size_t)(t0 - 1) * 1536 + 512 + lane * 8), x1 = *(const h16x8*)(zc + (size_t)(t0 - 1) * 1536 + 1024 + lane * 8);
            const h16x8 c2 = *(const h16x8*)(zc + (size_t)(t0 - 2) * 1536 + 512 + lane * 8), x2 = *(const h16x8*)(zc + (size_t)(t0 - 2) * 1536 + 1024 + lane * 8);
#pragma unroll
            for (int j = 0; j < 8; ++j) { u1[j] = (float)c1[j] * (float)x1[j]; u2[j] = (float)c2[j] * (float)x2[j]; }
        }
        for (int t = t0; t < t0 + 32; ++t) {
            const h16* zrow = zc + (size_t)t * 1536 + lane * 8;
            const h16x8 gb = *(const h16x8*)zrow, gc = *(const h16x8*)(zrow + 512), xi = *(const h16x8*)(zrow + 1024);
            h16x8 o;
#pragma unroll
            for (int j = 0; j < 8; ++j) { const float u0 = (float)gc[j] * (float)xi[j];
                const float y = w0[j] * u2[j] + w1[j] * u1[j] + w2[j] * u0 + bb[j];
                o[j] = (h16)((float)gb[j] * y); u2[j] = u1[j]; u1[j] = u0; }
            *(h16x8*)(ca + (size_t)t * 512 + lane * 8) = o;
        }
    }
}


__device__ __forceinline__ float tanhf_(float x) { return 1.0f - 2.0f * __builtin_amdgcn_rcpf(1.0f + __expf(2.0f * x)); }
__device__ __forceinline__ void phase_rwkv_prep(const Args& a) {
    const int tid = tid_(), lane = tid & 63, wave = tid >> 6;
    const int gw = blockIdx.x * NWAVES + wave, NGW = gridDim.x * NWAVES;
    const h16* zr = (const h16*)(a.ws + O_ZR);
    h16* R = (h16*)a.out; h16* KS = R + (size_t)MTOK * 512; h16* V = KS + (size_t)MTOK * 512; h16* KK = V + (size_t)MTOK * 512;
    h16* APR = (h16*)(a.ws + O_APR);
    const float* mu = a.in[6]; const float* k_k = a.in[12];
    float mr[8], mk[8], mv[8], mt[8], kk8[8];
#pragma unroll
    for (int j = 0; j < 8; ++j) { const int c = lane * 8 + j; mr[j] = mu[c]; mk[j] = mu[512 + c]; mv[j] = mu[1024 + c]; mt[j] = mu[1536 + (c & 255)]; kk8[j] = k_k[c]; }
    for (int run = gw; run < MTOK / 32; run += NGW) {
        const int t0 = run * 32;
        float pr[8], pk[8], pv[8], pt[8];
        if ((t0 % SEQ) == 0) {
#pragma unroll
            for (int j = 0; j < 8; ++j) { pr[j] = 0.f; pk[j] = 0.f; pv[j] = 0.f; pt[j] = 0.f; }
        } else {
            const h16* zp = zr + (size_t)(t0 - 1) * 1792 + lane * 8;
            const h16x8 a0 = *(const h16x8*)zp, a1 = *(const h16x8*)(zp + 512), a2 = *(const h16x8*)(zp + 1024), a3 = *(const h16x8*)(zr + (size_t)(t0 - 1) * 1792 + 1536 + (lane & 31) * 8);
#pragma unroll
            for (int j = 0; j < 8; ++j) { pr[j] = (float)a0[j]; pk[j] = (float)a1[j]; pv[j] = (float)a2[j]; pt[j] = (float)a3[j]; }
        }
        for (int t = t0; t < t0 + 32; ++t) {
            const h16* zp = zr + (size_t)t * 1792 + lane * 8;
            const h16x8 a0 = *(const h16x8*)zp, a1 = *(const h16x8*)(zp + 512), a2 = *(const h16x8*)(zp + 1024), a3 = *(const h16x8*)(zr + (size_t)t * 1792 + 1536 + (lane & 31) * 8);
            h16x8 orr, ok, ov, okk, ot; float kr[8]; float ss = 0.f;
#pragma unroll
            for (int j = 0; j < 8; ++j) {
                const float zr_ = (float)a0[j], zk_ = (float)a1[j], zv_ = (float)a2[j], zt_ = (float)a3[j];
                const float r = zr_ + mr[j] * (pr[j] - zr_), k = zk_ + mk[j] * (pk[j] - zk_), v = zv_ + mv[j] * (pv[j] - zv_), tl = zt_ + mt[j] * (pt[j] - zt_);
                pr[j] = zr_; pk[j] = zk_; pv[j] = zv_; pt[j] = zt_;
                orr[j] = (h16)r; ok[j] = (h16)k; ov[j] = (h16)v;
                kr[j] = k * kk8[j]; ss += kr[j] * kr[j];
                const float tv = (lane < 8) ? tanhf_(tl) : (lane < 16) ? tl : sigmoidf_(tl);
                ot[j] = (h16)tv;
            }
            ss += __shfl_xor(ss, 1); ss += __shfl_xor(ss, 2); ss += __shfl_xor(ss, 4);
            const float rn = rsqrtf(ss + 1e-12f);
#pragma unroll
            for (int j = 0; j < 8; ++j) okk[j] = (h16)(kr[j] * rn);
            const size_t o = (size_t)t * 512 + lane * 8;
            *(h16x8*)(R + o) = orr; *(h16x8*)(KS + o) = ok; *(h16x8*)(V + o) = ov; *(h16x8*)(KK + o) = okk;
            if (lane < 32) *(h16x8*)(APR + (size_t)t * 256 + lane * 8) = ot;
        }
    }
}

struct EpiLR {
    const float *w0, *a0, *k_a; h16 *WD, *KS, *BD, *GG; const h16* KK;
    __device__ __forceinline__ void operator()(AccRef acc, const Unit& u, int wr, int wc, int fr, int fq) const {
        const int part = u.pn >> 1;
        EPI_LOOP_BEGIN
            const int c = col - part * 512; const size_t o = (size_t)row * 512 + c;
            if (part == 0) {
                const f32x4 b0 = *(const f32x4*)(w0 + c), b1 = *(const f32x4*)(w0 + c + 4); f32x4 o0, o1;
#pragma unroll
                for (int j = 0; j < 4; ++j) { o0[j] = __expf(-0.6065306597126334f * sigmoidf_(b0[j] + v0[j])); o1[j] = __expf(-0.6065306597126334f * sigmoidf_(b1[j] + v1[j])); }
                *(h16x8*)(WD + o) = pack8(o0, o1);
            } else if (part == 1) {
                const f32x4 b0 = *(const f32x4*)(a0 + c), b1 = *(const f32x4*)(a0 + c + 4), ka0 = *(const f32x4*)(k_a + c), ka1 = *(const f32x4*)(k_a + c + 4);
                const h16x8 ks = *(const h16x8*)(KS + o), kk = *(const h16x8*)(KK + o); f32x4 k0, k1, bb0, bb1;
#pragma unroll
                for (int j = 0; j < 4; ++j) { const float aa0 = sigmoidf_(b0[j] + v0[j]), aa1 = sigmoidf_(b1[j] + v1[j]);
                    k0[j] = (float)ks[j] * (1.0f + (aa0 - 1.0f) * ka0[j]); k1[j] = (float)ks[4 + j] * (1.0f + (aa1 - 1.0f) * ka1[j]);
                    bb0[j] = aa0 * (float)kk[j]; bb1[j] = aa1 * (float)kk[4 + j]; }
                *(h16x8*)(KS + o) = pack8(k0, k1); *(h16x8*)(BD + o) = pack8(bb0, bb1);
            } else {
                *(h16x8*)(GG + o) = pack8(v0, v1);
            }
        EPI_LOOP_END
    }
};

constexpr int SC_L = 256, SC_NCH = SEQ / SC_L, SC_NB = 8;
constexpr int SC_STEP_F = 6 * 64;
constexpr int SC_WAVE_BYTES = SC_NB * SC_STEP_F * 4 + SC_NB * 64 * 4;
__device__ __forceinline__ float quad_sum(float v) { v += dpp_<0xB1>(v); v += dpp_<0x4E>(v); return v; }
__device__ __forceinline__ void lds_ld8x2(const LAS float* p, f32x2 (&o)[8]) {
#pragma unroll
    for (int j4 = 0; j4 < 4; ++j4) { const f32x4 t = *(const LAS f32x4*)(p + 4 * j4); o[2 * j4] = (f32x2){t[0], t[1]}; o[2 * j4 + 1] = (f32x2){t[2], t[3]}; }
}
template <int MODE>
__device__ __forceinline__ void scan_wave(const Args& a, LAS unsigned char* lds, int task) {
    const int tid = tid_(), lane = tid & 63, wave = tid >> 6;
    const int q = lane & 3, rg = lane >> 2;
    const int chain = task / SC_NCH, chunk = task % SC_NCH, b = chain >> 3, h = chain & 7;
    const size_t row0 = (size_t)b * SEQ + (size_t)chunk * SC_L;
    const h16* R = (const h16*)a.out; const h16* KS = R + (size_t)MTOK * 512; const h16* V = KS + (size_t)MTOK * 512; const h16* KK = V + (size_t)MTOK * 512;
    const h16* WD = (const h16*)(a.ws + O_WD); const h16* BD = (const h16*)(a.ws + O_BD);
    LAS float* buf = (LAS float*)(lds + wave * SC_WAVE_BYTES);
    LAS float* ybuf = buf + SC_NB * SC_STEP_F;
    constexpr int NA = (MODE == 0) ? 5 : (MODE == 1) ? 3 : 6;
    const h16* gp[NA]; int lo[NA];
#pragma unroll
    for (int j = 0; j < NA; ++j) { const int p = lane + 64 * j, seg = p >> 3, part = p & 7, st = seg / NA, ai = seg % NA;
        const int ar = (MODE == 0 && ai == 4) ? 5 : ai;
        const h16* base = (ar == 0) ? KK : (ar == 1) ? WD : (ar == 2) ? BD : (ar == 3) ? KS : (ar == 4) ? R : V;
        gp[j] = base + (row0 + st) * 512 + h * 64 + part * 8; lo[j] = st * SC_STEP_F + ar * 64 + part * 8; }
    f32x2 s[4][8];
    if (MODE == 0) {
#pragma unroll
        for (int i = 0; i < 4; ++i)
#pragma unroll
            for (int j = 0; j < 8; ++j) s[i][j] = (f32x2){0.f, 0.f};
    } else if (MODE == 1) {
#pragma unroll
        for (int i = 0; i < 4; ++i)
#pragma unroll
            for (int j = 0; j < 8; ++j) s[i][j] = (f32x2){(i == q && 2 * j == rg) ? 1.f : 0.f, (i == q && 2 * j + 1 == rg) ? 1.f : 0.f};
    } else {
        const float* S0 = (const float*)(a.ws + O_SST) + (size_t)task * 4096;
#pragma unroll
        for (int i = 0; i < 4; ++i)
#pragma unroll
            for (int j4 = 0; j4 < 4; ++j4) { const f32x4 t = *(const f32x4*)(S0 + (rg + 16 * i) * 64 + 16 * q + 4 * j4);
                s[i][2 * j4] = (f32x2){t[0], t[1]}; s[i][2 * j4 + 1] = (f32x2){t[2], t[3]}; }
    }
    h16x8 pre[NA];
#pragma unroll
    for (int j = 0; j < NA; ++j) pre[j] = *(const h16x8*)gp[j];
    f32x2 kk[8];
    for (int bt = 0; bt < SC_L / SC_NB; ++bt) {
        LAS float* cb = buf;
#pragma unroll
        for (int j = 0; j < NA; ++j) { f32x4 x0, x1;
#pragma unroll
            for (int e = 0; e < 4; ++e) { x0[e] = (float)pre[j][e]; x1[e] = (float)pre[j][4 + e]; }
            *(LAS f32x4*)(cb + lo[j]) = x0; *(LAS f32x4*)(cb + lo[j] + 4) = x1; }
        if (bt + 1 < SC_L / SC_NB) {
#pragma unroll
            for (int j = 0; j < NA; ++j) pre[j] = *(const h16x8*)(gp[j] + (size_t)(bt + 1) * SC_NB * 512);
        }
        lds_ld8x2(cb + 16 * q, kk);
#pragma unroll 2
        for (int st = 0; st < SC_NB; ++st) {
            const LAS float* sb = cb + st * SC_STEP_F;
            f32x2 w[8], bb[8], kx[8]; float vv[4];
            lds_ld8x2(sb + 64 + 16 * q, w); lds_ld8x2(sb + 128 + 16 * q, bb);
            if (MODE != 1) { lds_ld8x2(sb + 192 + 16 * q, kx);
#pragma unroll
                for (int i = 0; i < 4; ++i) vv[i] = sb[320 + rg + 16 * i]; }
            float us[4];
#pragma unroll
            for (int i = 0; i < 4; ++i) { f32x2 t = s[i][0] * kk[0];
#pragma unroll
                for (int j = 1; j < 8; ++j) t = __builtin_elementwise_fma(s[i][j], kk[j], t);
                us[i] = quad_sum(t[0] + t[1]); }
            if (st + 1 < SC_NB) lds_ld8x2(sb + SC_STEP_F + 16 * q, kk);
            f32x2 rr[8];
            if (MODE == 2) lds_ld8x2(sb + 256 + 16 * q, rr);
#pragma unroll
            for (int i = 0; i < 4; ++i) { const f32x2 nu = (f32x2){-us[i], -us[i]}, v2 = (f32x2){vv[i], vv[i]};
#pragma unroll
                for (int j = 0; j < 8; ++j) { f32x2 t = s[i][j] * w[j]; t = __builtin_elementwise_fma(nu, bb[j], t); if (MODE != 1) t = __builtin_elementwise_fma(v2, kx[j], t); s[i][j] = t; } }
            if (MODE == 2) {
#pragma unroll
                for (int i = 0; i < 4; ++i) { f32x2 t = s[i][0] * rr[0];
#pragma unroll
                    for (int j = 1; j < 8; ++j) t = __builtin_elementwise_fma(s[i][j], rr[j], t);
                    const float y = quad_sum(t[0] + t[1]);
                    if (q == 0) ybuf[st * 64 + rg + 16 * i] = y; }
            }
        }
        if (MODE == 2) {
            const int st = lane >> 3, part = lane & 7; h16x8 o;
#pragma unroll
            for (int e = 0; e < 8; ++e) o[e] = (h16)ybuf[st * 64 + part * 8 + e];
            *(h16x8*)((h16*)(a.ws + O_Y) + (row0 + (size_t)bt * SC_NB + st) * 512 + h * 64 + part * 8) = o;
        }
    }
    if (MODE != 2) {
        float* PQ = (float*)(a.ws + O_PQ) + (size_t)task * 8192 + (MODE == 0 ? 4096 : 0);
#pragma unroll
        for (int i = 0; i < 4; ++i)
#pragma unroll
            for (int j4 = 0; j4 < 4; ++j4) { const int o = (rg + 16 * i) * 64 + 16 * q + 4 * j4;
                *(f32x4*)(PQ + o) = (f32x4){s[i][2 * j4][0], s[i][2 * j4][1], s[i][2 * j4 + 1][0], s[i][2 * j4 + 1][1]}; }
    }
}
template <bool FIRST>
__device__ __forceinline__ void phase_scan(const Args& a, LAS unsigned char* lds) {
    const int wave = tid_() >> 6;
    if (FIRST) {
        for (int task = blockIdx.x * NWAVES + wave; task < 64 * SC_NCH; task += gridDim.x * NWAVES) { scan_wave<0>(a, lds, task); scan_wave<1>(a, lds, task); }
    } else {
        for (int task = blockIdx.x * NWAVES + wave; task < 64 * SC_NCH; task += gridDim.x * NWAVES) scan_wave<2>(a, lds, task);
    }
}

constexpr size_t O_VTB = O_ZR;
constexpr size_t O_BON = O_ZR + 64 * MiB;
constexpr int UT_WAVE_LDS = 15360;
typedef float f32x16 __attribute__((ext_vector_type(16)));
__device__ __forceinline__ size_t ut_ov(int j, int s) { return (size_t)(j >> 2) * 512 + (j & 3) * 16 + s; }
__device__ __forceinline__ void phase_ut_pre(const Args& a, LAS unsigned char* lds) {
    const int tid = tid_(), lane = tid & 63, wave = tid >> 6;
    const int gw = blockIdx.x * NWAVES + wave, NGW = gridDim.x * NWAVES;
    LAS unsigned char* Lb = lds + wave * UT_WAVE_LDS;
    LAS h16* YX = (LAS h16*)Lb;
    LAS float* GT = (LAS float*)(Lb + 9216);
    LAS float* TM = (LAS float*)(Lb + 13824);
    h16* R = (h16*)a.out; h16* KS = R + (size_t)MTOK * 512; h16* V = KS + (size_t)MTOK * 512; h16* KK = V + (size_t)MTOK * 512;
    h16* WD = (h16*)(a.ws + O_WD); h16* BD = (h16*)(a.ws + O_BD);
    h16* VTB = (h16*)(a.ws + O_VTB); float* BON = (float*)(a.ws + O_BON);
    for (int bh = gw; bh < 32768; bh += NGW) {
        int ln = lane; asm volatile("" : "+v"(ln)); const int r16 = ln & 15;
        const int h = bh & 7, nb = bh >> 3; const size_t tok0 = (size_t)nb * 16; const size_t e0 = tok0 * 512 + h * 64;
        const float rk = a.in[14][h * 64 + lane];
        float w[16], kk[16], bb[16], kx[16], rr[16]; h16x8 vt0, vt1;
#pragma unroll
        for (int t = 0; t < 16; ++t) { const size_t i = e0 + (size_t)t * 512 + lane; w[t] = (float)WD[i]; kk[t] = (float)KK[i]; bb[t] = (float)BD[i]; kx[t] = (float)KS[i]; rr[t] = (float)R[i];
            if (t < 8) vt0[t] = V[i]; else vt1[t - 8] = V[i]; }
        { h16* vp = VTB + (size_t)bh * 1024 + lane * 16; *(h16x8*)vp = vt0; *(h16x8*)(vp + 8) = vt1; }
        float bonv = 0.f;
#pragma unroll
        for (int t = 0; t < 16; ++t) { const float bs = wave_sum(rr[t] * kx[t] * rk); bonv = (ln == t) ? bs : bonv; }
        if (lane < 16) BON[(tok0 + lane) * 8 + h] = bonv;
        float Lt[16]; { float Lc = 0.f;
#pragma unroll
            for (int t = 0; t < 16; ++t) { Lc += __logf(w[t]); Lt[t] = Lc; } }
        const float Lref = Lt[7];
        float btil[16]; h16x8 kt0, kt1;
#pragma unroll
        for (int t = 0; t < 16; ++t) {
            const float Lp = t ? Lt[t - 1] : 0.f;
            const float ka = kk[t] * __expf(Lp - Lref), rt = rr[t] * __expf(Lt[t] - Lref), e2 = __expf(Lref - Lt[t]), bt = bb[t] * e2, kt = kx[t] * e2;
            YX[t * 72 + lane] = (h16)ka; YX[(16 + t) * 72 + lane] = (h16)rt; YX[(32 + t) * 72 + lane] = (h16)kt; YX[(48 + t) * 72 + lane] = (h16)bt;
            btil[t] = bt;
            if (t < 8) kt0[t] = (h16)kt; else kt1[t - 8] = (h16)kt;
            const size_t i = e0 + (size_t)t * 512 + lane; KK[i] = (h16)ka; R[i] = (h16)rt;
        }
        const float pre = __expf(Lref), post = __expf(Lt[15] - Lref);
        { h16* kp = KS + e0 + ut_ov(lane, 0); *(h16x8*)kp = kt0; *(h16x8*)(kp + 8) = kt1; }
        asm volatile("s_waitcnt lgkmcnt(0)" ::: "memory");
        f32x16 acc;
#pragma unroll
        for (int i = 0; i < 16; ++i) acc[i] = 0.f;
#pragma unroll
        for (int ks = 0; ks < 4; ++ks) {
            const h16x8 af = *(const LAS h16x8*)(YX + (lane & 31) * 72 + 8 * (lane >> 5) + 16 * ks), bf = *(const LAS h16x8*)(YX + (32 + (lane & 31)) * 72 + 8 * (lane >> 5) + 16 * ks);
            acc = __builtin_amdgcn_mfma_f32_32x32x16_f16(af, bf, acc, 0, 0, 0);
        }
#pragma unroll
        for (int i = 0; i < 16; ++i) GT[((i & 3) + 8 * (i >> 2) + 4 * (lane >> 5)) * 36 + (lane & 31)] = acc[i];
        asm volatile("s_waitcnt lgkmcnt(0)" ::: "memory");
        float T[16];
#pragma unroll
        for (int t = 0; t < 16; ++t) { float v = (r16 == t) ? 1.f : 0.f;
#pragma unroll
            for (int s2 = 0; s2 < t; ++s2) v -= T[s2] * GT[t * 36 + 16 + s2];
            T[t] = v; }
#pragma unroll
        for (int t = 0; t < 16; ++t) TM[r16 * 20 + t] = T[t];
        asm volatile("s_waitcnt lgkmcnt(0)" ::: "memory");
        float bcol[16];
#pragma unroll
        for (int s2 = 0; s2 < 16; ++s2) bcol[s2] = (s2 <= r16) ? GT[(16 + r16) * 36 + 16 + s2] : 0.f;
        h16x8 tb0, tb1, tp0, tp1;
#pragma unroll
        for (int r = 0; r < 16; ++r) { float s0 = 0.f, s1 = 0.f;
#pragma unroll
            for (int s2 = r; s2 < 16; ++s2) { const float tv = TM[r * 20 + s2]; s0 += tv * btil[s2]; s1 += tv * bcol[s2]; }
            if (r < 8) { tb0[r] = (h16)s0; tp0[r] = (h16)s1; } else { tb1[r - 8] = (h16)s0; tp1[r - 8] = (h16)s1; } }
        { h16* bp = BD + e0 + ut_ov(lane, 0); *(h16x8*)bp = tb0; *(h16x8*)(bp + 8) = tb1; }
        if (lane < 16) {
            h16x8 a0, a1, p0, p1;
#pragma unroll
            for (int s2 = 0; s2 < 16; ++s2) { const float av = (s2 < ln) ? GT[ln * 36 + s2] : 0.f, pv = (s2 <= ln) ? GT[(16 + ln) * 36 + s2] : 0.f;
                if (s2 < 8) { a0[s2] = (h16)av; p0[s2] = (h16)pv; } else { a1[s2 - 8] = (h16)av; p1[s2 - 8] = (h16)pv; } }
            h16* ap = WD + e0 + (size_t)(lane >> 2) * 512 + (lane & 3) * 16;
            *(h16x8*)ap = a0; *(h16x8*)(ap + 8) = a1;
            *(h16x8*)(ap + 4 * 512) = p0; *(h16x8*)(ap + 4 * 512 + 8) = p1;
            *(h16x8*)(ap + 8 * 512) = tp0; *(h16x8*)(ap + 8 * 512 + 8) = tp1;
        }
        ((float*)(WD + e0 + (size_t)(12 + (lane >> 5)) * 512))[lane & 31] = pre;
        ((float*)(WD + e0 + (size_t)(14 + (lane >> 5)) * 512))[lane & 31] = post;
        asm volatile("s_waitcnt lgkmcnt(0)" ::: "memory");
    }
}
struct UtOps { h16x8 bk[2], br[2], bkt[4], btb[4], bat, bap, btp, va; float pre[4], post[4]; };
__device__ __forceinline__ void ut_load(UtOps& o, const Args& a, int chain, int g, int n, int fr, int fq) {
    const int b = chain >> 3, h = chain & 7; const size_t tok0 = (size_t)b * SEQ + (size_t)n * 16; const size_t e0 = tok0 * 512 + h * 64; const int bh = (int)(tok0 >> 4) * 8 + h;
    const h16* R = (const h16*)a.out; const h16* KS = R + (size_t)MTOK * 512; const h16* KK = KS + (size_t)2 * MTOK * 512;
    const h16* WD = (const h16*)(a.ws + O_WD); const h16* BD = (const h16*)(a.ws + O_BD); const h16* VTB = (const h16*)(a.ws + O_VTB);
    h16x8 z; for (int i = 0; i < 8; ++i) z[i] = (h16)0.f;
#pragma unroll
    for (int ks = 0; ks < 2; ++ks) { o.bk[ks] = *(const h16x8*)(KK + e0 + (size_t)fr * 512 + 32 * ks + 8 * fq); o.br[ks] = *(const h16x8*)(R + e0 + (size_t)fr * 512 + 32 * ks + 8 * fq); }
    const int fq1 = fq & 1;
#pragma unroll
    for (int nt = 0; nt < 4; ++nt) { const h16x8 k8 = *(const h16x8*)(KS + e0 + ut_ov(16 * nt + fr, 8 * fq1)), t8 = *(const h16x8*)(BD + e0 + ut_ov(16 * nt + fr, 8 * fq1));
        o.bkt[nt] = fq < 2 ? k8 : z; o.btb[nt] = fq < 2 ? t8 : z; }
    const h16* ap = WD + e0 + (size_t)(fr >> 2) * 512 + (fr & 3) * 16 + 8 * fq1;
    const h16x8 x0 = *(const h16x8*)ap, x1 = *(const h16x8*)(ap + 4 * 512), x2 = *(const h16x8*)(ap + 8 * 512), x3 = *(const h16x8*)(VTB + (size_t)bh * 1024 + (16 * g + fr) * 16 + 8 * fq1);
    o.bat = fq < 2 ? x0 : z; o.bap = fq < 2 ? x1 : z; o.btp = fq < 2 ? x2 : z; o.va = fq < 2 ? x3 : z;
#pragma unroll
    for (int nt = 0; nt < 4; ++nt) { const int j = 16 * nt + fr;
        o.pre[nt] = ((const float*)(WD + e0 + (size_t)(12 + (j >> 5)) * 512))[j & 31]; o.post[nt] = ((const float*)(WD + e0 + (size_t)(14 + (j >> 5)) * 512))[j & 31]; }
}
__device__ __forceinline__ void phase_ut_seq(const Args& a, LAS unsigned char* lds) {
    const int tid = tid_(), lane = tid & 63, wave = tid >> 6, fr = lane & 15, fq = lane >> 4;
    if (wave >= 4) return;
    LAS h16* SL = (LAS h16*)(lds + wave * 4096);
    LAS h16* XL = SL + 16 * 72;
    h16x8 z; for (int i = 0; i < 8; ++i) z[i] = (h16)0.f;
    for (int chain = blockIdx.x; chain < 64; chain += gridDim.x) {
        const int g = wave, b = chain >> 3, h = chain & 7;
        f32x4 S[4];
#pragma unroll
        for (int nt = 0; nt < 4; ++nt) S[nt] = (f32x4){0.f, 0.f, 0.f, 0.f};
        UtOps cur, nxt;
        ut_load(cur, a, chain, g, 0, fr, fq);
#pragma unroll 1
        for (int n = 0; n < SEQ / 16; ++n) {
            ut_load(nxt, a, chain, g, (n + 1 < SEQ / 16) ? n + 1 : n, fr, fq);
            f32x4 St[4];
#pragma unroll
            for (int nt = 0; nt < 4; ++nt) { St[nt] = S[nt] * cur.pre[nt];
#pragma unroll
                for (int rg = 0; rg < 4; ++rg) SL[(4 * fq + rg) * 72 + 16 * nt + fr] = (h16)St[nt][rg]; }
            asm volatile("s_waitcnt lgkmcnt(0)" ::: "memory");
            const h16x8 sa0 = *(const LAS h16x8*)(SL + fr * 72 + 8 * fq), sa1 = *(const LAS h16x8*)(SL + fr * 72 + 32 + 8 * fq);
            f32x4 x1 = (f32x4){0.f, 0.f, 0.f, 0.f}, y = (f32x4){0.f, 0.f, 0.f, 0.f};
            x1 = __builtin_amdgcn_mfma_f32_16x16x32_f16(sa0, cur.bk[0], x1, 0, 0, 0); x1 = __builtin_amdgcn_mfma_f32_16x16x32_f16(sa1, cur.bk[1], x1, 0, 0, 0); x1 = __builtin_amdgcn_mfma_f32_16x16x32_f16(cur.va, cur.bat, x1, 0, 0, 0);
            y = __builtin_amdgcn_mfma_f32_16x16x32_f16(sa0, cur.br[0], y, 0, 0, 0); y = __builtin_amdgcn_mfma_f32_16x16x32_f16(sa1, cur.br[1], y, 0, 0, 0); y = __builtin_amdgcn_mfma_f32_16x16x32_f16(cur.va, cur.bap, y, 0, 0, 0);
#pragma unroll
            for (int rg = 0; rg < 4; ++rg) XL[(4 * fq + rg) * 24 + fr] = (h16)(-x1[rg]);
            asm volatile("s_waitcnt lgkmcnt(0)" ::: "memory");
            const h16x8 xr = *(const LAS h16x8*)(XL + fr * 24 + 8 * (fq & 1)); const h16x8 xa = fq < 2 ? xr : z;
            y = __builtin_amdgcn_mfma_f32_16x16x32_f16(xa, cur.btp, y, 0, 0, 0);
#pragma unroll
            for (int nt = 0; nt < 4; ++nt) { St[nt] = __builtin_amdgcn_mfma_f32_16x16x32_f16(cur.va, cur.bkt[nt], St[nt], 0, 0, 0); St[nt] = __builtin_amdgcn_mfma_f32_16x16x32_f16(xa, cur.btb[nt], St[nt], 0, 0, 0);
                S[nt] = St[nt] * cur.post[nt]; }
            const size_t tok0 = (size_t)b * SEQ + (size_t)n * 16;
            *(h16x4*)((h16*)(a.ws + O_Y) + (tok0 + fr) * 512 + h * 64 + 16 * g + 4 * fq) = pack4(y);
            cur = nxt;
        }
    }
}

__device__ __forceinline__ void phase_scan_combine(const Args& a, LAS unsigned char* lds) {
    const int tid = tid_(), row = tid >> 5, cp = tid & 31;
    LAS float* LS = (LAS float*)lds;
    LAS float* LP = (LAS float*)(lds + 8192);
    for (int item = blockIdx.x; item < 64 * 4; item += gridDim.x) {
        const int chain = item >> 2, r0 = (item & 3) * 16;
        const float* PQ0 = (const float*)(a.ws + O_PQ) + (size_t)chain * SC_NCH * 8192;
        f32x2 sr = (f32x2){0.f, 0.f};
        f32x4 pa = *(const f32x4*)(PQ0 + tid * 8), pb = *(const f32x4*)(PQ0 + tid * 8 + 4);
        f32x2 qn = *(const f32x2*)(PQ0 + 4096 + (r0 + row) * 64 + 2 * cp);
        for (int c = 0; c < SC_NCH; ++c) {
            const int task = chain * SC_NCH + c;
            *(f32x2*)((float*)(a.ws + O_SST) + (size_t)task * 4096 + (r0 + row) * 64 + 2 * cp) = sr;
            if (c == SC_NCH - 1) break;
            LAS float* cur = LS + (c & 1) * 1024; LAS float* cp_ = LP + (c & 1) * 4096;
            *(LAS f32x2*)(cur + row * 64 + 2 * cp) = sr;
            *(LAS f32x4*)(cp_ + tid * 8) = pa; *(LAS f32x4*)(cp_ + tid * 8 + 4) = pb;
            f32x2 acc0 = qn, acc1 = (f32x2){0.f, 0.f};
            if (c + 2 < SC_NCH) { const float* Pn = PQ0 + (size_t)(c + 1) * 8192;
                pa = *(const f32x4*)(Pn + tid * 8); pb = *(const f32x4*)(Pn + tid * 8 + 4); qn = *(const f32x2*)(Pn + 4096 + (r0 + row) * 64 + 2 * cp); }
            __syncthreads();
#pragma unroll 16
            for (int k = 0; k < 64; k += 2) {
                const f32x2 sk = *(const LAS f32x2*)(cur + row * 64 + k);
                const f32x2 p0 = *(const LAS f32x2*)(cp_ + k * 64 + 2 * cp), p1 = *(const LAS f32x2*)(cp_ + (k + 1) * 64 + 2 * cp);
                acc0 = __builtin_elementwise_fma((f32x2){sk[0], sk[0]}, p0, acc0); acc1 = __builtin_elementwise_fma((f32x2){sk[1], sk[1]}, p1, acc1);
            }
            sr = acc0 + acc1;
        }
        __syncthreads();
    }
}
__device__ __forceinline__ void phase_rwkv_post(const Args& a) {
    const int tid = tid_(), lane = tid & 63, wave = tid >> 6;
    const int gw = blockIdx.x * NWAVES + wave, NGW = gridDim.x * NWAVES;
    const h16* V = (const h16*)a.out + (size_t)2 * MTOK * 512;
    const h16* GG = (const h16*)(a.ws + O_GG); const h16* Y = (const h16*)(a.ws + O_Y); h16* YB = (h16*)(a.ws + O_YB); const float* BON = (const float*)(a.ws + O_BON);
    float lg[8], lb[8];
#pragma unroll
    for (int j = 0; j < 8; ++j) { const int c = lane * 8 + j; lg[j] = a.in[15][c]; lb[j] = a.in[16][c]; }
    for (int t = gw; t < MTOK; t += NGW) {
        const size_t o = (size_t)t * 512 + lane * 8;
        const h16x8 y8 = *(const h16x8*)(Y + o), v8 = *(const h16x8*)(V + o), g8 = *(const h16x8*)(GG + o);
        const float bs = BON[(size_t)t * 8 + (lane >> 3)];
        float y[8]; float sm = 0.f;
#pragma unroll
        for (int j = 0; j < 8; ++j) { y[j] = (float)y8[j]; sm += y[j]; }
        sm += dpp_<0xB1>(sm); sm += dpp_<0x4E>(sm); sm += dpp_<0x141>(sm);
        const float mean = sm * (1.f / 64.f); float vs = 0.f;
#pragma unroll
        for (int j = 0; j < 8; ++j) { y[j] -= mean; vs += y[j] * y[j]; }
        vs += dpp_<0xB1>(vs); vs += dpp_<0x4E>(vs); vs += dpp_<0x141>(vs);
        const float rstd = rsqrtf(vs * (1.f / 64.f) + 64e-5f);
        h16x8 ov;
#pragma unroll
        for (int j = 0; j < 8; ++j) ov[j] = (h16)((y[j] * rstd * lg[j] + lb[j] + bs * (float)v8[j]) * (float)g8[j]);
        *(h16x8*)(YB + o) = ov;
    }
}

__device__ __forceinline__ void ins16(unsigned (&L)[16], unsigned x) {
#pragma unroll
    for (int j = 0; j < 16; ++j) { const unsigned hi = L[j] > x ? L[j] : x; x = L[j] > x ? x : L[j]; L[j] = hi; }
}
__device__ __forceinline__ unsigned ord32(float f) { const unsigned u = __float_as_uint(f); return (u & 0x80000000u) ? ~u : (u | 0x80000000u); }
__device__ __forceinline__ float unord32(unsigned k) { return __uint_as_float((k & 0x80000000u) ? (k & 0x7fffffffu) : ~k); }
__device__ __forceinline__ void phase_topk(const Args& a, LAS unsigned char* lds) {
    const int tid = tid_();
    const h16* SC = (const h16*)(a.ws + O_SCORES);
    const float* part = (const float*)(a.ws + O_PART1);
    unsigned short* IDX = (unsigned short*)(a.ws + O_IDX); float* GATE = (float*)(a.ws + O_GATE); float* RS1 = (float*)(a.ws + O_RS1);
    LAS unsigned char* LI = lds;
    for (int task = blockIdx.x * NTHREADS + tid; task < MTOK * 8; task += gridDim.x * NTHREADS) {
        const int t = task >> 3, h = task & 7;
        float ssq = 0.f;
#pragma unroll
        for (int j = 0; j < 4; ++j) { const f32x4 p4 = *(const f32x4*)(part + (size_t)t * 16 + 4 * j); ssq += (p4[0] + p4[1]) + (p4[2] + p4[3]); }
        const float rs = rsqrtf(ssq * (1.f / 1024.f) + NORM_EPS);
        if (h == 0) RS1[t] = rs;
        float sv[2][16];
#pragma unroll
        for (int c = 0; c < 2; ++c) {
            unsigned L[16];
#pragma unroll
            for (int j = 0; j < 16; ++j) L[j] = 0u;
            const h16* row = SC + (size_t)t * 2048 + h * 256 + c * 128;
#pragma unroll 2
            for (int n8 = 0; n8 < 16; ++n8) {
                const u32x4 w4 = *(const u32x4*)(row + n8 * 8);
#pragma unroll
                for (int e = 0; e < 8; ++e) {
                    const unsigned bits = (e & 1) ? (w4[e >> 1] >> 16) : (w4[e >> 1] & 0xffffu);
                    const unsigned o16 = (bits & 0x8000u) ? (~bits & 0xffffu) : (bits | 0x8000u);
                    ins16(L, (o16 << 16) | (unsigned)(127 - (n8 * 8 + e)));
                }
            }
#pragma unroll
            for (int j = 0; j < 16; ++j) {
                const unsigned o16 = L[j] >> 16; const unsigned bits = (o16 & 0x8000u) ? (o16 & 0x7fffu) : (~o16 & 0xffffu);
                union { unsigned short u; h16 f; } cv; cv.u = (unsigned short)bits; sv[c][j] = (float)cv.f;
                LI[(c * 16 + j) * 512 + tid] = (unsigned char)(127u - (L[j] & 127u));
            }
        }
        unsigned L[16];
#pragma unroll
        for (int j = 0; j < 16; ++j) L[j] = 0u;
#pragma unroll
        for (int i = 0; i < 16; ++i)
#pragma unroll
            for (int j = 0; j < 16; ++j) if ((i + 1) * (j + 1) <= 16) ins16(L, (ord32(sv[0][i] + sv[1][j]) & ~255u) | (unsigned)(255 - (i * 16 + j)));
        float e[16]; float den = 0.f; const float mx = unord32(L[0] & ~255u) * rs;
        unsigned short id[16];
#pragma unroll
        for (int k = 0; k < 16; ++k) {
            const float v = unord32(L[k] & ~255u) * rs; e[k] = __expf(v - mx); den += e[k];
            const unsigned pos = 255u - (L[k] & 255u); const unsigned i = pos >> 4, j = pos & 15u;
            id[k] = (unsigned short)((unsigned)LI[i * 512 + tid] * 128u + (unsigned)LI[(16 + j) * 512 + tid]);
        }
        const float inv = __builtin_amdgcn_rcpf(den);
        u32x4 i0, i1;
        i0[0] = id[0] | (id[1] << 16); i0[1] = id[2] | (id[3] << 16); i0[2] = id[4] | (id[5] << 16); i0[3] = id[6] | (id[7] << 16);
        i1[0] = id[8] | (id[9] << 16); i1[1] = id[10] | (id[11] << 16); i1[2] = id[12] | (id[13] << 16); i1[3] = id[14] | (id[15] << 16);
        u32x4* ip = (u32x4*)(IDX + (size_t)task * 16); ip[0] = i0; ip[1] = i1;
        f32x4* gp = (f32x4*)(GATE + (size_t)task * 16);
#pragma unroll
        for (int k4 = 0; k4 < 4; ++k4) gp[k4] = (f32x4){e[4 * k4] * inv, e[4 * k4 + 1] * inv, e[4 * k4 + 2] * inv, e[4 * k4 + 3] * inv};
    }
}

__device__ __forceinline__ float gelu_tanh(float x) { const float u = 0.7978845608028654f * (x + 0.044715f * x * x * x); return 0.5f * x * (1.0f + tanhf_(u)); }
__device__ __forceinline__ unsigned xcc_id() { return (unsigned)__builtin_amdgcn_s_getreg((3 << 11) | 20) & 7u; }
constexpr int GA_TC = 32, GA_NCH = MTOK / GA_TC;
__device__ __forceinline__ void dec16(const u32x4 q, float (&o)[16]) {
#pragma unroll
    for (int w = 0; w < 4; ++w) { const f32x2 lo = __builtin_amdgcn_cvt_pk_f32_fp8((int)q[w], false), hi = __builtin_amdgcn_cvt_pk_f32_fp8((int)q[w], true);
        o[4 * w] = lo[0]; o[4 * w + 1] = lo[1]; o[4 * w + 2] = hi[0]; o[4 * w + 3] = hi[1]; }
}
struct GIdx { u32x4 a, b; };
__device__ __forceinline__ GIdx g_ldidx(const unsigned short* IDX, int t, int r8) { const u32x4* ip = (const u32x4*)(IDX + (size_t)t * 128 + 16 * r8); GIdx r; r.a = ip[0]; r.b = ip[1]; return r; }
__device__ __forceinline__ void g_issue8(const unsigned char* TBs, unsigned lo, const u32x4 ix, u32x4 (&q)[8]) {
#pragma unroll
    for (int i = 0; i < 8; ++i) { const unsigned w = ix[i >> 1]; const unsigned e = (i & 1) ? (w >> 16) : (w & 0xffffu); q[i] = *(const u32x4*)(TBs + (e * 128u + lo)); }
}
struct GSide { u32x4 a, b, c, d; };
template <int PH> __device__ __forceinline__ GSide g_ldside(const Args& a, int t, int j, int m, int r8) {
    GSide r;
    if (PH == 0) { const u32x4* xp = (const u32x4*)((const h16*)(a.ws + O_H1B) + (size_t)t * 1024 + 128 * j + 16 * m); r.a = xp[0]; r.b = xp[1]; r.c = r.a; r.d = r.b; }
    else { const u32x4* cp = (const u32x4*)((const float*)(a.ws + O_COEF) + (size_t)t * 128 + 16 * r8); r.a = cp[0]; r.b = cp[1]; r.c = cp[2]; r.d = cp[3]; }
    return r;
}
template <int PH, int HALF> __device__ __forceinline__ void g_half(u32x4 (&q)[8], const GSide& sd, float (&pa)[16]) {
    if (PH == 0) {
        float x[16];
#pragma unroll
        for (int k = 0; k < 8; ++k) { const h16x8 xa = __builtin_bit_cast(h16x8, sd.a), xb = __builtin_bit_cast(h16x8, sd.b); x[k] = (float)xa[k]; x[8 + k] = (float)xb[k]; }
#pragma unroll
        for (int i = 0; i < 8; ++i) { float d[16]; dec16(q[i], d); float s0 = 0.f, s1 = 0.f;
#pragma unroll
            for (int k = 0; k < 8; ++k) { s0 += x[2 * k] * d[2 * k]; s1 += x[2 * k + 1] * d[2 * k + 1]; }
            pa[8 * HALF + i] = s0 + s1; }
    } else {
#pragma unroll
        for (int i = 0; i < 8; ++i) { float d[16]; dec16(q[i], d);
            const float cf = __uint_as_float(HALF == 0 ? (i < 4 ? sd.a[i & 3] : sd.b[i & 3]) : (i < 4 ? sd.c[i & 3] : sd.d[i & 3]));
#pragma unroll
            for (int k = 0; k < 16; ++k) pa[k] += cf * d[k];
            if (i + 1 < 8) asm volatile("" : "+v"(q[i + 1][0]), "+v"(q[i + 1][1]), "+v"(q[i + 1][2]), "+v"(q[i + 1][3]));
        }
    }
}
template <int PH> __device__ __forceinline__ void g_finish(const Args& a, int t, int j, int lane, float (&p)[16]) {
    const int m = lane & 7, r8 = lane >> 3;
    float q8[8], q4[4], q2[2];
    if (PH == 0) {
#pragma unroll
        for (int i = 0; i < 8; ++i) { const float keep = (lane & 4) ? p[i + 8] : p[i], send = (lane & 4) ? p[i] : p[i + 8]; q8[i] = keep + xhm_(send); }
#pragma unroll
        for (int i = 0; i < 4; ++i) { const float keep = (lane & 2) ? q8[i + 4] : q8[i], send = (lane & 2) ? q8[i] : q8[i + 4]; q4[i] = keep + dpp_<0x4E>(send); }
#pragma unroll
        for (int i = 0; i < 2; ++i) { const float keep = (lane & 1) ? q4[i + 2] : q4[i], send = (lane & 1) ? q4[i] : q4[i + 2]; q2[i] = keep + dpp_<0xB1>(send); }
        *(f32x2*)((float*)(a.ws + O_PART) + ((size_t)j * MTOK + t) * 128 + 16 * r8 + 2 * m) = (f32x2){q2[0], q2[1]};
    } else {
#pragma unroll
        for (int i = 0; i < 8; ++i) { const float keep = (lane & 32) ? p[i + 8] : p[i], send = (lane & 32) ? p[i] : p[i + 8]; q8[i] = keep + x32_(send, lane); }
#pragma unroll
        for (int i = 0; i < 4; ++i) { const float keep = (lane & 16) ? q8[i + 4] : q8[i], send = (lane & 16) ? q8[i] : q8[i + 4]; q4[i] = keep + x16_(send, lane); }
#pragma unroll
        for (int i = 0; i < 2; ++i) { const float keep = (lane & 8) ? q4[i + 2] : q4[i], send = (lane & 8) ? q4[i] : q4[i + 2]; q2[i] = keep + x8_(send); }
        const int col = 128 * j + 16 * m + 2 * r8;
        float* op = a.out + (size_t)t * 1024 + col;
        f32x2 hv = *(const f32x2*)op; hv[0] += q2[0]; hv[1] += q2[1];
        *(f32x2*)op = hv;
        *(h16x2*)((h16*)(a.ws + O_H2B) + (size_t)t * 1024 + col) = (h16x2){(h16)hv[0], (h16)hv[1]};
        const float ss = wave_sum(hv[0] * hv[0] + hv[1] * hv[1]);
        if (lane == 0) ((float*)(a.ws + O_SS2))[(size_t)t * 8 + j] = ss;
    }
}
template <int PH>
__device__ __forceinline__ void phase_gather(const Args& a, int cset) {
    const int tid = tid_(), lane = tid & 63, m = lane & 7, r8 = lane >> 3;
    unsigned* ctr = (unsigned*)(a.ws + O_CTR) + cset * 8 * 64;
    const unsigned short* IDX = (const unsigned short*)(a.ws + O_IDX);
    const unsigned j0 = xcc_id();
    for (unsigned dj = 0; dj < 8; ++dj) {
        const unsigned j = (j0 + dj) & 7u;
        const unsigned char* TB = a.ws + (PH ? O_V8 : O_U8) + (size_t)j * 16384 * 128; const unsigned lo16 = 16u * (unsigned)m;
        for (;;) {
            unsigned c = 0; if (lane == 0) c = __hip_atomic_fetch_add(ctr + j * 64, 1u, __ATOMIC_RELAXED, __HIP_MEMORY_SCOPE_AGENT);
            c = (unsigned)__builtin_amdgcn_readfirstlane((int)c);
            if (c >= (unsigned)GA_NCH) break;
            const int t0 = c * GA_TC;
            u32x4 qa[8], qb[8]; GSide sd, sn; GIdx ix, ixn;
            ix = g_ldidx(IDX, t0, r8); g_issue8(TB, lo16, ix.a, qa); sd = g_ldside<PH>(a, t0, j, m, r8);
#pragma unroll 1
            for (int ti = 0; ti < GA_TC; ++ti) {
                const int t = t0 + ti, tn = (ti + 1 < GA_TC) ? t + 1 : t;
                g_issue8(TB, lo16, ix.b, qb); ixn = g_ldidx(IDX, tn, r8); sn = g_ldside<PH>(a, tn, j, m, r8);
                float p[16];
                if (PH == 1) {
#pragma unroll
                    for (int k = 0; k < 16; ++k) p[k] = 0.f;
                }
                g_half<PH, 0>(qa, sd, p);
                g_issue8(TB, lo16, ixn.a, qa);
                g_half<PH, 1>(qb, sd, p);
                g_finish<PH>(a, t, j, lane, p);
                ix = ixn; sd = sn;
            }
        }
    }
}
__device__ __forceinline__ void phase_coef(const Args& a) {
    const int tid = tid_();
    const float* PART = (const float*)(a.ws + O_PART); const unsigned short* IDX = (const unsigned short*)(a.ws + O_IDX);
    const float* GATE = (const float*)(a.ws + O_GATE); const float* RS1 = (const float*)(a.ws + O_RS1);
    const float* USC = (const float*)(a.ws + O_USC); const float* VSC = (const float*)(a.ws + O_VSC); float* COEF = (float*)(a.ws + O_COEF);
    for (int i = blockIdx.x * NTHREADS + tid; i < MTOK * 128; i += gridDim.x * NTHREADS) {
        float s = 0.f;
#pragma unroll
        for (int j = 0; j < 8; ++j) s += PART[(size_t)j * MTOK * 128 + i];
        const unsigned e = IDX[i];
        COEF[i] = GATE[i] * gelu_tanh(RS1[i >> 7] * USC[e] * s) * VSC[e];
    }
}

__device__ __forceinline__ void phase_final(const Args& a) {
    const int tid = tid_(), lane = tid & 63, wave = tid >> 6;
    const int gw = blockIdx.x * NWAVES + wave, NGW = gridDim.x * NWAVES;
    const float* part = (const float*)(a.ws + O_PART3); const float* fg = a.in[28];
    f32x4 g4[4];
#pragma unroll
    for (int j = 0; j < 4; ++j) g4[j] = *((const f32x4*)fg + lane + 64 * j);
    for (int r = gw; r < MTOK; r += NGW) {
        float s = (lane < 16) ? part[(size_t)r * 16 + lane] : 0.f;
        s = wave_sum(s);
        const float rs = rsqrtf(s * (1.f / 1024.f) + NORM_EPS);
        f32x4* xr = (f32x4*)(a.out + (size_t)r * 1024) + lane;
#pragma unroll
        for (int j = 0; j < 4; ++j) xr[64 * j] = xr[64 * j] * rs * g4[j];
    }
}

constexpr int NPHASE = 19;
__global__ void __launch_bounds__(NTHREADS, 2) mk(Args a) {
    extern __shared__ __attribute__((aligned(16))) unsigned char smem[];
    LAS unsigned char* lds = (LAS unsigned char*)smem;
    unsigned char* ws = a.ws;
#if ONE_LAUNCH
    cg::grid_group grid = cg::this_grid();
    volatile LAS unsigned* bst = (volatile LAS unsigned*)(lds + 131072);
    if (threadIdx.x < 2) bst[threadIdx.x] = 0u;
    __syncthreads();
    const XcdBarrier xbar = xcd_barrier_post((unsigned*)(a.ws + O_BAR), bst);
    bool first_sync = true;
#define SYNC() do { if (first_sync) { grid.sync(); first_sync = false; } else xcd_barrier(xbar); } while (0)
#else
#define SYNC() do {} while (0)
#endif
#define IN(k) (a.ph_lo <= (k) && (k) < a.ph_hi)
#define SEAM(k) do { if (IN(k) && IN((k) + 1)) SYNC(); } while (0)
#define REPS(k) ((((REP_MASK) >> (k)) & 1u) ? 2 : 1)
    const int G = gridDim.x, bid = blockIdx.x;
    if (IN(0)) for (int rep = 0; rep < REPS(0); ++rep) { if (rep) SYNC(); phase_prep(a, lds); } SEAM(0);
    if (IN(1)) for (int rep = 0; rep < REPS(1); ++rep) { if (rep) SYNC(); pg8::Gemm g{(const h16*)(ws + O_XN), (const h16*)(ws + O_WIN), MTOK, NIN, 1024}; pg8::StaticOrder S; S.init(MTOK, NIN, G, bid);
        EpiZ E{(h16*)(ws + O_ZC), (h16*)(ws + O_ZR), (h16*)(ws + O_ZG)}; pg8::gemm_phase(lds, g, S, E); } SEAM(1);
    if (IN(2)) for (int rep = 0; rep < REPS(2); ++rep) { if (rep) SYNC(); phase_conv(a); phase_rwkv_prep(a); } SEAM(2);
    if (IN(3)) for (int rep = 0; rep < REPS(3); ++rep) { if (rep) SYNC(); pg8::Gemm g{(const h16*)(ws + O_APR), (const h16*)(ws + O_WLR), MTOK, 1536, 256}; pg8::StaticOrder S; S.init(MTOK, 1536, G, bid);
        h16* R = (h16*)a.out; h16* KS = R + (size_t)MTOK * 512; h16* KK = KS + (size_t)2 * MTOK * 512;
        EpiLR E{a.in[7], a.in[9], a.in[13], (h16*)(ws + O_WD), KS, (h16*)(ws + O_BD), (h16*)(ws + O_GG), KK}; pg8::gemm_phase(lds, g, S, E); } SEAM(3);
    if (IN(4)) for (int rep = 0; rep < REPS(4); ++rep) { if (rep) SYNC(); phase_ut_pre(a, lds); }
    SEAM(5);
    if (IN(6)) for (int rep = 0; rep < REPS(6); ++rep) { if (rep) SYNC(); phase_ut_seq(a, lds); } SEAM(6);
    if (IN(7)) for (int rep = 0; rep < REPS(7); ++rep) { if (rep) SYNC(); phase_rwkv_post(a); } SEAM(7);
    if (IN(8)) for (int rep = 0; rep < REPS(8); ++rep) { if (rep) SYNC(); pg8::Gemm g{(const h16*)(ws + O_CA), (const h16*)(ws + O_WA), MTOK, 1024, 512}; pg8::StaticOrder S; S.init(MTOK, 1024, G, bid);
        EpiYA E{(const h16*)(ws + O_ZG), a.out}; pg8::gemm_phase(lds, g, S, E); } SEAM(8);
    if (IN(9)) for (int rep = 0; rep < REPS(9); ++rep) { if (rep) SYNC(); pg8::Gemm g{(const h16*)(ws + O_YB), (const h16*)(ws + O_WB), MTOK, 1024, 512}; pg8::StaticOrder S; S.init(MTOK, 1024, G, bid);
        EpiYB E{(const h16*)(ws + O_ZG), a.out, (h16*)(ws + O_MERGED)}; pg8::gemm_phase(lds, g, S, E); } SEAM(9);
    if (IN(10)) for (int rep = 0; rep < REPS(10); ++rep) { if (rep) SYNC(); pg8::Gemm g{(const h16*)(ws + O_MERGED), (const h16*)(ws + O_WO), MTOK, 1024, 1024}; pg8::StaticOrder S; S.init(MTOK, 1024, G, bid);
        EpiH1 E{a.in[0], a.out, (h16*)(ws + O_H1B), (float*)(ws + O_PART1)}; pg8::gemm_phase(lds, g, S, E); } SEAM(10);
    if (IN(11)) for (int rep = 0; rep < REPS(11); ++rep) { if (rep) SYNC(); pg8::Gemm g{(const h16*)(ws + O_H1B), (const h16*)(ws + O_WS), MTOK, 2048, 1024}; pg8::StaticOrder S; S.init(MTOK, 2048, G, bid);
        EpiF16 E{(h16*)(ws + O_SCORES), 2048}; pg8::gemm_phase(lds, g, S, E); } SEAM(11);
    if (IN(12)) for (int rep = 0; rep < REPS(12); ++rep) { if (rep) SYNC(); phase_topk(a, lds); } SEAM(12);
    if (IN(13)) for (int rep = 0; rep < REPS(13); ++rep) { if (rep) SYNC(); phase_gather<0>(a, 2 * rep); } SEAM(13);
    if (IN(14)) for (int rep = 0; rep < REPS(14); ++rep) { if (rep) SYNC(); phase_coef(a); } SEAM(14);
    if (IN(15)) for (int rep = 0; rep < REPS(15); ++rep) { if (rep) SYNC(); phase_gather<1>(a, 1); } SEAM(15);
    if (IN(16)) for (int rep = 0; rep < REPS(16); ++rep) { if (rep) SYNC(); pg8::Gemm g{(const h16*)(ws + O_P16), (const h16*)(ws + O_WP), MTOK, 1024, 256}; pg8::StaticOrder S; S.init(MTOK, 1024, G, bid);
        EpiF16 E{(h16*)(ws + O_PP), 1024}; pg8::gemm_phase(lds, g, S, E); } SEAM(16);
    if (IN(17)) for (int rep = 0; rep < REPS(17); ++rep) { if (rep) SYNC(); pg8::Gemm g{(const h16*)(ws + O_H2B), (const h16*)(ws + O_WG), MTOK, 1024, 1024}; pg8::StaticOrder S; S.init(MTOK, 1024, G, bid);
        EpiGate E{a.out, (const h16*)(ws + O_PP), (const float*)(ws + O_SS2), (float*)(ws + O_PART3)}; pg8::gemm_phase(lds, g, S, E); } SEAM(17);
    if (IN(18)) for (int rep = 0; rep < REPS(18); ++rep) { if (rep) SYNC(); phase_final(a); }
}

extern "C" void kernel_launch(void* const* d_in, const int* in_sizes, int n_in, void* d_out, int out_size, void* d_ws, size_t ws_size, hipStream_t stream) {
    static int ready = 0;
    if (!ready) {
        if (n_in != 29 || ws_size < WS_END) { fprintf(stderr, "kernel_launch: unexpected n_in %d / ws %zu (need %zu)\n", n_in, ws_size, (size_t)WS_END); ready = -1; return; }
        if (hipFuncSetAttribute((const void*)mk, hipFuncAttributeMaxDynamicSharedMemorySize, LDS_BYTES) != hipSuccess) { fprintf(stderr, "hipFuncSetAttribute failed\n"); ready = -1; return; }
        ready = 1;
    }
    if (ready < 0) return;
    Args a{};
    for (int i = 0; i < 29; ++i) a.in[i] = (const float*)d_in[i];
    a.out = (float*)d_out; a.ws = (unsigned char*)d_ws;
#if ONE_LAUNCH
    (void)hipMemsetAsync((unsigned char*)d_ws + O_BAR, 0, 16384, stream);
    a.ph_lo = 0; a.ph_hi = NPHASE;
    void* args[] = {&a};
    hipLaunchCooperativeKernel((const void*)mk, dim3(NBLK), dim3(NTHREADS), args, LDS_BYTES, stream);
#else
    const int phases[] = {0, 1, 2, 3, 4, 5, 6, 7, 8, 9, 10, 11, 12, 13, 14, 15, 16, 17, 18};
    for (int ph : phases) { a.ph_lo = ph; a.ph_hi = ph + 1; hipLaunchKernelGGL(mk, dim3(NBLK), dim3(NTHREADS), LDS_BYTES, stream, a); }
#endif
}
```

```cpp
#include <hip/hip_runtime.h>
#include <hip/hip_cooperative_groups.h>
#include <cstdio>
namespace cg = cooperative_groups;

#ifndef REP_MASK
#define REP_MASK 0u
#endif
#ifndef ONE_LAUNCH
#define ONE_LAUNCH 1
#endif

#define LAS __attribute__((address_space(3)))
typedef _Float16 h16;
typedef _Float16 h16x8 __attribute__((ext_vector_type(8)));
typedef _Float16 h16x4 __attribute__((ext_vector_type(4)));
typedef _Float16 h16x2 __attribute__((ext_vector_type(2)));
typedef float f32x4 __attribute__((ext_vector_type(4)));
typedef float f32x2 __attribute__((ext_vector_type(2)));
typedef unsigned u32x4 __attribute__((ext_vector_type(4)));
typedef unsigned u32x2 __attribute__((ext_vector_type(2)));

constexpr int MTOK = 65536, DM = 1024, SEQ = 8192, NB = 8;
constexpr int NIN = 5376;
constexpr int NTHREADS = 512, NWAVES = 8, NBLK = 256;
constexpr int LDS_BYTES = 131072 + 64;
constexpr float NORM_EPS = 1e-6f;

constexpr size_t MiB = 1u << 20;
constexpr size_t O_WIN = 0;
constexpr size_t O_WA = O_WIN + (size_t)5376 * 1024 * 2;
constexpr size_t O_WB = O_WA + 1 * MiB;
constexpr size_t O_WO = O_WB + 1 * MiB;
constexpr size_t O_WG = O_WO + 2 * MiB;
constexpr size_t O_WP = O_WG + 2 * MiB;
constexpr size_t O_WLR = O_WP + MiB / 2;
constexpr size_t O_WS = O_WLR + 3 * MiB / 4;
constexpr size_t O_U16 = O_WS + 4 * MiB;
constexpr size_t O_V16 = O_U16 + 32 * MiB;
constexpr size_t O_P16 = O_V16 + 32 * MiB;
constexpr size_t O_PART1 = O_P16 + 32 * MiB;
constexpr size_t O_PART3 = O_PART1 + 4 * MiB;
constexpr size_t O_RS1 = O_PART3 + 4 * MiB;
constexpr size_t O_RS2 = O_RS1 + MiB / 4;
constexpr size_t O_XN = O_RS2 + MiB / 4;
constexpr size_t O_ZC = O_XN + 128 * MiB;
constexpr size_t O_ZR = O_ZC + 192 * MiB;
constexpr size_t O_ZG = O_ZR + 224 * MiB;
constexpr size_t O_SS2 = O_ZG + 256 * MiB;
constexpr size_t O_USC = O_SS2 + 2 * MiB;
constexpr size_t O_VSC = O_USC + 65536;
constexpr size_t O_CTR = O_VSC + 65536;
constexpr size_t O_BAR = O_CTR + 8192;
constexpr size_t WS_END = O_BAR + 16384;
constexpr size_t O_U8 = O_U16;
constexpr size_t O_V8 = O_U16 + 16 * MiB;
constexpr size_t O_PART = O_ZG;
constexpr size_t O_COEF = O_ZR + 48 * MiB;
constexpr size_t O_CA = O_XN;
constexpr size_t O_APR = O_XN + 64 * MiB;
constexpr size_t O_H1B = O_XN;
constexpr size_t O_WD = O_ZC;
constexpr size_t O_BD = O_ZC + 64 * MiB;
constexpr size_t O_GG = O_ZC + 128 * MiB;
constexpr size_t O_MERGED = O_ZC;
constexpr size_t O_H2B = O_ZC;
constexpr size_t O_PQ = O_ZR;
constexpr size_t O_SST = O_ZR + 64 * MiB;
constexpr size_t O_Y = O_ZR + 96 * MiB;
constexpr size_t O_YB = O_ZR + 160 * MiB;
constexpr size_t O_IDX = O_ZR;
constexpr size_t O_GATE = O_ZR + 16 * MiB;
constexpr size_t O_PP = O_ZR + 64 * MiB;
constexpr size_t O_SCORES = O_ZG;

struct Args {
    const float* in[29];
    float* out;
    unsigned char* ws;
    int ph_lo, ph_hi;
};

__device__ __forceinline__ int tid_() { int t = threadIdx.x; asm volatile("" : "+v"(t)); return t; }
__device__ __forceinline__ float sigmoidf_(float x) { return __builtin_amdgcn_rcpf(1.0f + __expf(-x)); }
template <int CTRL> __device__ __forceinline__ float dpp_(float v) { return __builtin_bit_cast(float, __builtin_amdgcn_update_dpp(0, __builtin_bit_cast(int, v), CTRL, 0xF, 0xF, true)); }
__device__ __forceinline__ float x32_(float v, int lane) { const auto r = __builtin_amdgcn_permlane32_swap(__builtin_bit_cast(unsigned, v), __builtin_bit_cast(unsigned, v), false, false); return __builtin_bit_cast(float, (lane & 32) ? r[0] : r[1]); }
__device__ __forceinline__ float x16_(float v, int lane) { const auto r = __builtin_amdgcn_permlane16_swap(__builtin_bit_cast(unsigned, v), __builtin_bit_cast(unsigned, v), false, false); return __builtin_bit_cast(float, (lane & 16) ? r[0] : r[1]); }
__device__ __forceinline__ float x8_(float v) { return dpp_<0x128>(v); }
__device__ __forceinline__ float xhm_(float v) { return dpp_<0x141>(v); }
__device__ __forceinline__ float wave_sum(float v) {
    const int lane = threadIdx.x & 63;
    v += dpp_<0xB1>(v); v += dpp_<0x4E>(v); v += dpp_<0x141>(v); v += dpp_<0x140>(v);
    v += x16_(v, lane); v += x32_(v, lane);
    return v;
}
__device__ __forceinline__ h16x8 pack8(f32x4 a, f32x4 b) {
    h16x8 r;
    r[0] = (h16)a[0]; r[1] = (h16)a[1]; r[2] = (h16)a[2]; r[3] = (h16)a[3];
    r[4] = (h16)b[0]; r[5] = (h16)b[1]; r[6] = (h16)b[2]; r[7] = (h16)b[3];
    return r;
}
__device__ __forceinline__ h16x4 pack4(f32x4 a) {
    h16x4 r; r[0] = (h16)a[0]; r[1] = (h16)a[1]; r[2] = (h16)a[2]; r[3] = (h16)a[3]; return r;
}

#define XB_TMO      128
#define XB_XCNT(j)  (256  + 64 * (j))
#define XB_XSUB(j)  (1280 + 64 * (j))
#define XB_XGEN(j)  (2304 + 64 * (j))
#define XB_TOP      3328
#define XB_TOPGEN   3392
#define XCD_BAR_WORDS 3456
#define XB_SPIN_CAP (1u << 18)

__device__ __forceinline__ unsigned xb_ld(unsigned* p)              { return __hip_atomic_load(p, __ATOMIC_RELAXED, __HIP_MEMORY_SCOPE_AGENT); }
__device__ __forceinline__ unsigned xb_add(unsigned* p, unsigned v) { return __hip_atomic_fetch_add(p, v, __ATOMIC_RELAXED, __HIP_MEMORY_SCOPE_AGENT); }
__device__ __forceinline__ unsigned xb_xcc_id() { return (unsigned)__builtin_amdgcn_s_getreg((3 << 11) | 20) & 0xFu; }
#define XB_SPIN(cond, bar) do { unsigned _sp = 0; while (cond) { __builtin_amdgcn_s_sleep(1); \
    if ((++_sp & 255u) == 0u) { if (xb_ld(&(bar)[XB_TMO])) break; if (_sp > XB_SPIN_CAP) { atomicAdd(&(bar)[XB_TMO], 1u); break; } } } } while (0)

struct XcdBarrier {
    unsigned* bar; unsigned x;
    volatile LAS unsigned* st;
};

__device__ __forceinline__ XcdBarrier xcd_barrier_post(unsigned* bar, volatile LAS unsigned* st) {
    XcdBarrier b; b.bar = bar; b.x = xb_xcc_id(); b.st = st;
    if (threadIdx.x == 0) (void)xb_add(&bar[XB_XCNT(b.x)], 1u);
    return b;
}
__device__ __forceinline__ void xcd_barrier_complete(unsigned* bar, unsigned x, unsigned& nloc, unsigned& nx) {
    const unsigned G = gridDim.x * gridDim.y * gridDim.z;
    unsigned sum, cnt, mine, sp = 0u;
    for (;;) {
        sum = 0u; cnt = 0u; mine = 0u;
#pragma unroll
        for (unsigned j = 0; j < 16; ++j) { const unsigned c = xb_ld(&bar[XB_XCNT(j)]); sum += c; cnt += (c > 0u) ? 1u : 0u; mine = (j == x) ? c : mine; }
        if (sum == G) break;
        __builtin_amdgcn_s_sleep(1);
        if ((++sp & 255u) == 0u) { if (xb_ld(&bar[XB_TMO])) break; if (sp > XB_SPIN_CAP) { atomicAdd(&bar[XB_TMO], 1u); break; } }
    }
    nloc = mine > 0u ? mine : 1u; nx = cnt > 0u ? cnt : 1u;
}

__device__ __forceinline__ void xcd_barrier(const XcdBarrier& b) {
    asm volatile("s_waitcnt vmcnt(0)" ::: "memory");
    __syncthreads();
    if (threadIdx.x == 0) {
        unsigned* bar = b.bar;
        __builtin_amdgcn_s_waitcnt(0);
        unsigned nloc = b.st[0], nx = b.st[1];
        if (nloc == 0u) { xcd_barrier_complete(bar, b.x, nloc, nx); b.st[0] = nloc; b.st[1] = nx; }
        const unsigned old = xb_add(&bar[XB_XSUB(b.x)], 1u);
        const unsigned gen = old / nloc;
        if (old + 1u == (gen + 1u) * nloc) {
            __builtin_amdgcn_fence(__ATOMIC_RELEASE, "agent");
            asm volatile("s_waitcnt vmcnt(0)" ::: "memory");
            const unsigned og = xb_add(&bar[XB_TOP], 1u);
            const unsigned tg = og / nx;
            if (og + 1u == (tg + 1u) * nx) xb_add(&bar[XB_TOPGEN], 1u);
            else XB_SPIN(xb_ld(&bar[XB_TOPGEN]) == tg, bar);
            __builtin_amdgcn_fence(__ATOMIC_ACQUIRE, "agent");
            xb_add(&bar[XB_XGEN(b.x)], 1u);
            asm volatile("s_waitcnt vmcnt(0)" ::: "memory");
        } else {
            XB_SPIN(xb_ld(&bar[XB_XGEN(b.x)]) == gen, bar);
            __builtin_amdgcn_fence(__ATOMIC_ACQUIRE, "agent");
            asm volatile("s_waitcnt vmcnt(0)" ::: "memory");
        }
    }
    __syncthreads();
}


namespace pg8 {
constexpr int BM = 256, BK = 64, HALF = 128, HTB = HALF * BK * 2, STAGE_BYTES = 8 * HTB, NXCD = 8, WGM = 8;
__device__ __forceinline__ int lds_byte(int r, int c) { const int st = (r >> 4) * 2 + (c >> 5), rr = r & 15, cc = c & 31, ob = rr * 64 + cc * 2; return st * 1024 + (ob ^ (((ob >> 9) & 1) << 5)); }
__device__ __forceinline__ void stage_rc(int b, int& R, int& C) { const int st = b / 1024, sb = b % 1024, swz = sb ^ (((sb >> 9) & 1) << 5); R = (st >> 1) * 16 + swz / 64; C = (st & 1) * 32 + (swz % 64) / 2; }
__device__ __forceinline__ int perm32(int rho) { const int n = rho >> 4, i = rho & 15; return 8 * (i >> 2) + 4 * n + (i & 3); }

struct Unit { int pm, pn; };
struct Gemm { const h16* A; const h16* Bt; int M, N, K; };

struct StaticOrder {
    int nM, nN, nwg, G, c;
    __device__ void init(int M, int N, int G_, int c_) { nM = M / BM; nN = N / BM; nwg = nM * nN; G = G_; c = c_; }
    __device__ bool next(int i, Unit& u) const {
        const long L = (long)i * G + c; if (L >= nwg) return false;
        int wgid = (int)L; { const int q = nwg / NXCD, r = nwg % NXCD, xcd = wgid % NXCD, off = wgid / NXCD; wgid = (xcd < r ? xcd * (q + 1) : r * (q + 1) + (xcd - r) * q) + off; }
        const int nig = WGM * nN, gid = wgid / nig, fm = gid * WGM, gsz = (nM - fm) < WGM ? (nM - fm) : WGM;
        u.pm = fm + ((wgid % nig) % gsz); u.pn = (wgid % nig) / gsz; return true;
    }
};

template <class Epi>
__device__ __forceinline__ void gemm_phase(LAS unsigned char* lds, const Gemm g, const StaticOrder& S, const Epi& E) {
    const int tid = tid_(), wid = __builtin_amdgcn_readfirstlane(tid >> 6), lane = tid & 63, wr = wid >> 2, wc = wid & 3, fr = lane & 15, fq = lane >> 4;
    const int K = g.K, nt = K / BK;
    unsigned voffA[2], voffB[2];
#pragma unroll
    for (int i = 0; i < 2; ++i) { int R, C; stage_rc(tid * 16 + i * 8192, R, C); const int Rb = (R & ~31) + perm32(R & 31);
        voffA[i] = (unsigned)(R * K + C) * 2u; voffB[i] = (unsigned)(Rb * K + C) * 2u; }
    const size_t kstep = (size_t)(BK * 2);
    const size_t hstep = (size_t)HALF * K * 2;
    const size_t tstep = 2 * hstep;
    const unsigned ldsw = (unsigned)wid * 1024u;
    const int aoff = lds_byte(wr * 64 + fr, fq * 8), boff = lds_byte(wc * 32 + fr, fq * 8);
#define PG8_SA(b, h) (((b) * 2 + (h)) * HTB)
#define PG8_SB(b, h) ((4 + (b) * 2 + (h)) * HTB)
#define PG8_STAGE(bufoff, gbase, voff) do { _Pragma("unroll") for (int _i = 0; _i < 2; ++_i) \
        __builtin_amdgcn_global_load_lds((const unsigned*)((const char*)(gbase) + (voff)[_i]), (LAS unsigned*)(lds + (bufoff) + ldsw + _i * 8192), 16, 0, 0); } while (0)
#define PG8_LDA(dst, b, h) do { _Pragma("unroll") for (int m = 0; m < 4; ++m) _Pragma("unroll") for (int k = 0; k < 2; ++k) dst[m][k] = *(const LAS h16x8*)(lds + PG8_SA(b, h) + aoff + m * 2048 + k * 1024); } while (0)
#define PG8_LDB(dst, b, h) do { _Pragma("unroll") for (int n = 0; n < 2; ++n) _Pragma("unroll") for (int k = 0; k < 2; ++k) dst[n][k] = *(const LAS h16x8*)(lds + PG8_SB(b, h) + boff + n * 2048 + k * 1024); } while (0)
#define PG8_MMA(ai, bj, At, Bt) do { __builtin_amdgcn_s_setprio(1); _Pragma("unroll") for (int m = 0; m < 4; ++m) _Pragma("unroll") for (int n = 0; n < 2; ++n) _Pragma("unroll") for (int k = 0; k < 2; ++k) \
        acc[ai][bj][m][n] = __builtin_amdgcn_mfma_f32_16x16x32_f16(Bt[n][k], At[m][k], acc[ai][bj][m][n], 0, 0, 0); __builtin_amdgcn_s_setprio(0); } while (0)
#define PG8_WAIT_V(n) asm volatile("s_waitcnt vmcnt(" #n ")" ::: "memory")
#define PG8_WAIT_L(n) asm volatile("s_waitcnt lgkmcnt(" #n ")" ::: "memory")
#define PG8_BAR __builtin_amdgcn_s_barrier()
#define PG8_SCHED __builtin_amdgcn_sched_barrier(0)
    Unit cur, nxt; int ui = 0;
    if (!S.next(0, cur)) return;
    f32x4 acc[2][2][4][2];
#pragma unroll
    for (int a = 0; a < 2; ++a)
#pragma unroll
        for (int b = 0; b < 2; ++b)
#pragma unroll
            for (int m = 0; m < 4; ++m)
#pragma unroll
                for (int n = 0; n < 2; ++n) acc[a][b][m][n] = (f32x4){0.f, 0.f, 0.f, 0.f};
    h16x8 At[4][2], B0[2][2], B1[2][2];
    const char* cA = (const char*)g.A + (size_t)cur.pm * tstep; const char* cB = (const char*)g.Bt + (size_t)cur.pn * tstep;
    PG8_STAGE(PG8_SB(0, 0), cB, voffB); PG8_STAGE(PG8_SB(0, 1), cB + hstep, voffB); PG8_STAGE(PG8_SA(0, 0), cA, voffA); PG8_STAGE(PG8_SA(0, 1), cA + hstep, voffA);
    if (wr == 1) PG8_BAR;
    PG8_WAIT_V(2); PG8_BAR;
    PG8_STAGE(PG8_SB(1, 0), cB + kstep, voffB); PG8_STAGE(PG8_SA(1, 0), cA + kstep, voffA); PG8_STAGE(PG8_SB(1, 1), cB + hstep + kstep, voffB);
    PG8_WAIT_V(6); PG8_BAR;
    for (;;) {
        const bool has_next = S.next(ui + 1, nxt);
        const char* nA = has_next ? (const char*)g.A + (size_t)nxt.pm * tstep : cA; const char* nB = has_next ? (const char*)g.Bt + (size_t)nxt.pn * tstep : cB;
        for (int t = 0; t < nt; t += 2) {
            const bool last = (t == nt - 2);
            const char* a1 = cA + (size_t)(t + 1) * kstep;
            const char* a2 = last ? nA : cA + (size_t)(t + 2) * kstep; const char* b2 = last ? nB : cB + (size_t)(t + 2) * kstep;
            const char* a3 = a2 + kstep; const char* b3 = b2 + kstep;
            PG8_LDB(B0, 0, 0); PG8_LDB(B1, 0, 1); PG8_SCHED; PG8_LDA(At, 0, 0); PG8_STAGE(PG8_SA(1, 1), a1 + hstep, voffA);
            PG8_WAIT_V(8); PG8_WAIT_L(0); PG8_BAR; PG8_MMA(0, 0, At, B0); PG8_MMA(0, 1, At, B1); PG8_BAR; PG8_SCHED;
            PG8_LDA(At, 0, 1); PG8_STAGE(PG8_SB(0, 0), b2, voffB); PG8_STAGE(PG8_SB(0, 1), b2 + hstep, voffB); PG8_STAGE(PG8_SA(0, 0), a2, voffA);
            PG8_WAIT_V(8); PG8_WAIT_L(0); PG8_BAR; PG8_MMA(1, 0, At, B0); PG8_MMA(1, 1, At, B1); PG8_BAR; PG8_SCHED;
            PG8_LDB(B0, 1, 0); PG8_LDB(B1, 1, 1); PG8_SCHED; PG8_LDA(At, 1, 0); PG8_STAGE(PG8_SA(0, 1), a2 + hstep, voffA);
            PG8_WAIT_V(8); PG8_WAIT_L(0); PG8_BAR; PG8_MMA(0, 0, At, B0); PG8_MMA(0, 1, At, B1); PG8_BAR; PG8_SCHED;
            PG8_LDA(At, 1, 1); PG8_STAGE(PG8_SB(1, 0), b3, voffB); PG8_STAGE(PG8_SB(1, 1), b3 + hstep, voffB); PG8_STAGE(PG8_SA(1, 0), a3, voffA);
            PG8_WAIT_V(8); PG8_WAIT_L(0); PG8_BAR; PG8_MMA(1, 0, At, B0); PG8_MMA(1, 1, At, B1); PG8_BAR; PG8_SCHED;
        }
        if (wr == 0) PG8_BAR;
        E(acc, cur, wr, wc, fr, fq);
        if (!has_next) break;
#pragma unroll
        for (int a = 0; a < 2; ++a)
#pragma unroll
            for (int b = 0; b < 2; ++b)
#pragma unroll
                for (int m = 0; m < 4; ++m)
#pragma unroll
                    for (int n = 0; n < 2; ++n) acc[a][b][m][n] = (f32x4){0.f, 0.f, 0.f, 0.f};
        cur = nxt; cA = nA; cB = nB; ++ui;
        if (wr == 1) PG8_BAR;
    }
    PG8_WAIT_V(0);
    PG8_BAR;
#undef PG8_SA
#undef PG8_SB
#undef PG8_STAGE
#undef PG8_LDA
#undef PG8_LDB
#undef PG8_MMA
#undef PG8_WAIT_V
#undef PG8_WAIT_L
#undef PG8_BAR
#undef PG8_SCHED
}
}
using pg8::Unit;
typedef const f32x4 (&AccRef)[2][2][4][2];

#define EPI_LOOP_BEGIN \
    _Pragma("unroll") for (int ai = 0; ai < 2; ++ai) _Pragma("unroll") for (int m = 0; m < 4; ++m) { \
        const int row = u.pm * 256 + ai * 128 + wr * 64 + m * 16 + fr; \
        _Pragma("unroll") for (int bj = 0; bj < 2; ++bj) { \
            const int col = u.pn * 256 + bj * 128 + wc * 32 + 8 * fq; \
            const f32x4 v0 = acc[ai][bj][m][0], v1 = acc[ai][bj][m][1];
#define EPI_LOOP_END } }

struct EpiZ {
    h16 *zc, *zr, *zg;
    __device__ __forceinline__ void operator()(AccRef acc, const Unit& u, int wr, int wc, int fr, int fq) const {
        const int colt = u.pn * 256; h16* base; int ld, c0;
        if (colt < 1536) { base = zc; ld = 1536; c0 = colt; } else if (colt < 3328) { base = zr; ld = 1792; c0 = colt - 1536; } else { base = zg; ld = 2048; c0 = colt - 3328; }
        EPI_LOOP_BEGIN
            *(h16x8*)(base + (size_t)row * ld + (col - colt + c0)) = pack8(v0, v1);
        EPI_LOOP_END
    }
};
struct EpiF16 {
    h16* O; int ld;
    __device__ __forceinline__ void operator()(AccRef acc, const Unit& u, int wr, int wc, int fr, int fq) const {
        EPI_LOOP_BEGIN
            *(h16x8*)(O + (size_t)row * ld + col) = pack8(v0, v1);
        EPI_LOOP_END
    }
};
struct EpiYA {
    const h16* zg; float* tmp;
    __device__ __forceinline__ void operator()(AccRef acc, const Unit& u, int wr, int wc, int fr, int fq) const {
        EPI_LOOP_BEGIN
            const h16x8 gv = *(const h16x8*)(zg + (size_t)row * 2048 + col);
            f32x4 o0, o1;
#pragma unroll
            for (int j = 0; j < 4; ++j) { o0[j] = sigmoidf_((float)gv[j]) * v0[j]; o1[j] = sigmoidf_((float)gv[4 + j]) * v1[j]; }
            float* p = tmp + (size_t)row * 1024 + col;
            *(f32x4*)p = o0; *(f32x4*)(p + 4) = o1;
        EPI_LOOP_END
    }
};
struct EpiYB {
    const h16* zg; const float* tmp; h16* merged;
    __device__ __forceinline__ void operator()(AccRef acc, const Unit& u, int wr, int wc, int fr, int fq) const {
        EPI_LOOP_BEGIN
            const h16x8 gv = *(const h16x8*)(zg + (size_t)row * 2048 + 1024 + col);
            const float* p = tmp + (size_t)row * 1024 + col;
            f32x4 o0 = *(const f32x4*)p, o1 = *(const f32x4*)(p + 4);
#pragma unroll
            for (int j = 0; j < 4; ++j) { o0[j] += sigmoidf_((float)gv[j]) * v0[j]; o1[j] += sigmoidf_((float)gv[4 + j]) * v1[j]; }
            *(h16x8*)(merged + (size_t)row * 1024 + col) = pack8(o0, o1);
        EPI_LOOP_END
    }
};
struct EpiH1 {
    const float* x; float* out; h16* hb; float* part;
    __device__ __forceinline__ void operator()(AccRef acc, const Unit& u, int wr, int wc, int fr, int fq) const {
#pragma unroll
        for (int ai = 0; ai < 2; ++ai)
#pragma unroll
            for (int m = 0; m < 4; ++m) {
                const int row = u.pm * 256 + ai * 128 + wr * 64 + m * 16 + fr; float ss = 0.f;
#pragma unroll
                for (int bj = 0; bj < 2; ++bj) {
                    const int col = u.pn * 256 + bj * 128 + wc * 32 + 8 * fq;
                    const float* xp = x + (size_t)row * 1024 + col;
                    f32x4 o0 = *(const f32x4*)xp + acc[ai][bj][m][0], o1 = *(const f32x4*)(xp + 4) + acc[ai][bj][m][1];
                    float* op = out + (size_t)row * 1024 + col;
                    *(f32x4*)op = o0; *(f32x4*)(op + 4) = o1;
                    *(h16x8*)(hb + (size_t)row * 1024 + col) = pack8(o0, o1);
                    ss += (o0[0] * o0[0] + o0[1] * o0[1]) + (o0[2] * o0[2] + o0[3] * o0[3]) + (o1[0] * o1[0] + o1[1] * o1[1]) + (o1[2] * o1[2] + o1[3] * o1[3]);
                }
                ss += __shfl_xor(ss, 16); ss += __shfl_xor(ss, 32);
                if (fq == 0) part[(size_t)row * 16 + u.pn * 4 + wc] = ss;
            }
    }
};
struct EpiGate {
    float* out; const h16* pp; const float* rs2; float* part;
    __device__ __forceinline__ void operator()(AccRef acc, const Unit& u, int wr, int wc, int fr, int fq) const {
#pragma unroll
        for (int ai = 0; ai < 2; ++ai)
#pragma unroll
            for (int m = 0; m < 4; ++m) {
                const int row = u.pm * 256 + ai * 128 + wr * 64 + m * 16 + fr; float ss = 0.f;
                const f32x4 sa = *(const f32x4*)(rs2 + (size_t)row * 8), sb = *(const f32x4*)(rs2 + (size_t)row * 8 + 4);
                const float rs = rsqrtf(((sa[0] + sa[1]) + (sa[2] + sa[3]) + (sb[0] + sb[1]) + (sb[2] + sb[3])) * (1.f / 1024.f) + NORM_EPS);
#pragma unroll
                for (int bj = 0; bj < 2; ++bj) {
                    const int col = u.pn * 256 + bj * 128 + wc * 32 + 8 * fq;
                    float* op = out + (size_t)row * 1024 + col;
                    f32x4 o0 = *(const f32x4*)op, o1 = *(const f32x4*)(op + 4);
                    const h16x8 pv = *(const h16x8*)(pp + (size_t)row * 1024 + col);
                    const f32x4 v0 = acc[ai][bj][m][0], v1 = acc[ai][bj][m][1];
#pragma unroll
                    for (int j = 0; j < 4; ++j) { o0[j] += sigmoidf_(rs * v0[j]) * (float)pv[j]; o1[j] += sigmoidf_(rs * v1[j]) * (float)pv[4 + j]; }
                    *(f32x4*)op = o0; *(f32x4*)(op + 4) = o1;
                    ss += (o0[0] * o0[0] + o0[1] * o0[1]) + (o0[2] * o0[2] + o0[3] * o0[3]) + (o1[0] * o1[0] + o1[1] * o1[1]) + (o1[2] * o1[2] + o1[3] * o1[3]);
                }
                ss += __shfl_xor(ss, 16); ss += __shfl_xor(ss, 32);
                if (fq == 0) part[(size_t)row * 16 + u.pn * 4 + wc] = ss;
            }
    }
};

__device__ __forceinline__ void tr_item(const float* W, int N, const float* g, h16* WT, int ldk, int koff, int k0, int n0, LAS float* scr, int lane) {
#pragma unroll 8
    for (int i = 0; i < 32; ++i) { const int kk = 2 * i + (lane >> 5); float v = W[(size_t)(k0 + kk) * N + n0 + (lane & 31)]; if (g) v *= g[k0 + kk]; scr[kk * 33 + (lane & 31)] = v; }
    asm volatile("s_waitcnt lgkmcnt(0)" ::: "memory");
    const int c = lane & 7;
#pragma unroll
    for (int j = 0; j < 4; ++j) { const int n = (lane >> 3) + 8 * j; const LAS float* s = scr + (8 * c) * 33 + n;
        h16x8 o;
#pragma unroll
        for (int e = 0; e < 8; ++e) o[e] = (h16)s[e * 33];
        *(h16x8*)(WT + (size_t)(n0 + n) * ldk + koff + k0 + 8 * c) = o; }
    asm volatile("s_waitcnt lgkmcnt(0)" ::: "memory");
}
struct TrJob { const float* W; const float* g; h16* WT; int K, N, ldk, koff; };

__device__ __forceinline__ void phase_prep(const Args& a, LAS unsigned char* lds) {
    const int tid = tid_(), lane = tid & 63, wave = tid >> 6;
    const int gw = blockIdx.x * NWAVES + wave, NGW = gridDim.x * NWAVES;
    unsigned char* ws = a.ws;
    {
        LAS float* scr = (LAS float*)(lds + wave * 8704);
        TrJob jobs[9] = {
            {a.in[3], a.in[2], (h16*)(ws + O_WIN), 1024, NIN, 1024, 0},
            {a.in[17], nullptr, (h16*)(ws + O_WA), 512, 1024, 512, 0},
            {a.in[18], nullptr, (h16*)(ws + O_WB), 512, 1024, 512, 0},
            {a.in[19], nullptr, (h16*)(ws + O_WO), 1024, 1024, 1024, 0},
            {a.in[26], a.in[25], (h16*)(ws + O_WG), 1024, 1024, 1024, 0},
            {a.in[27], nullptr, (h16*)(ws + O_WP), 256, 1024, 256, 0},
            {a.in[8], nullptr, (h16*)(ws + O_WLR), 64, 512, 256, 0},
            {a.in[10], nullptr, (h16*)(ws + O_WLR) + (size_t)512 * 256, 64, 512, 256, 64},
            {a.in[11], nullptr, (h16*)(ws + O_WLR) + (size_t)1024 * 256, 128, 512, 256, 128},
        };
        int base = 0;
#pragma unroll
        for (int j = 0; j < 9; ++j) {
            const TrJob J = jobs[j]; const int nnb = J.N / 32, items = (J.K / 64) * nnb;
            int first = gw - (base % NGW); if (first < 0) first += NGW;
            for (int r = first; r < items; r += NGW) tr_item(J.W, J.N, J.g, J.WT, J.ldk, J.koff, (r / nnb) * 64, (r % nnb) * 32, scr, lane);
            base += items;
        }
        h16* wlr = (h16*)(ws + O_WLR);
        for (int i = blockIdx.x * NTHREADS + tid; i < 1536 * 256 / 8; i += gridDim.x * NTHREADS) {
            const int n = (i * 8) / 256, k = (i * 8) % 256; const int blk = n / 512;
            const bool inblk = (blk == 0) ? (k < 64) : (blk == 1) ? (k >= 64 && k < 128) : (k >= 128);
            if (!inblk) { h16x8 z; for (int e = 0; e < 8; ++e) z[e] = (h16)0.f; *(h16x8*)(wlr + (size_t)i * 8) = z; }
        }
    }
    __syncthreads();
    {
        LAS float* LA = (LAS float*)lds;
        LAS float* LB = (LAS float*)(lds + 64 * 129 * 4);
        const float* wq = a.in[21]; const float* sk = a.in[22]; const float* gf = a.in[20];
        h16* wst = (h16*)(ws + O_WS);
        for (int it = blockIdx.x; it < 256; it += gridDim.x) {
            const int g16 = it >> 4, k0 = (it & 15) * 64;
            for (int i = tid; i < 64 * 128; i += NTHREADS) { const int k = i >> 7, d = i & 127; LA[k * 129 + d] = wq[(size_t)(k0 + k) * 2048 + g16 * 128 + d] * gf[k0 + k]; }
            for (int i = tid; i < 128 * 128; i += NTHREADS) { const int n = i >> 7, d = i & 127; LB[n * 129 + d] = sk[((size_t)g16 * 128 + n) * 128 + d]; }
            __syncthreads();
            const int n = tid & 127, kg = tid >> 7;
            float o[16];
#pragma unroll
            for (int j = 0; j < 16; ++j) o[j] = 0.f;
            for (int d = 0; d < 128; ++d) { const float b = LB[n * 129 + d];
#pragma unroll
                for (int j = 0; j < 16; ++j) o[j] += LA[(kg * 16 + j) * 129 + d] * b; }
            h16x8 o0, o1;
#pragma unroll
            for (int j = 0; j < 8; ++j) { o0[j] = (h16)o[j]; o1[j] = (h16)o[8 + j]; }
            h16* dst = wst + (size_t)(g16 * 128 + n) * 1024 + k0 + kg * 16;
            *(h16x8*)dst = o0; *(h16x8*)(dst + 8) = o1;
            __syncthreads();
        }
    }
    {
        const float* gf = a.in[20];
        f32x4 g4[4];
#pragma unroll
        for (int j = 0; j < 4; ++j) g4[j] = *(const f32x4*)(gf + 16 * lane + 4 * j);
        for (int r = gw; r < 2 * 16384; r += NGW) {
            const int tb = r >> 14, e = r & 16383;
            const float* src = (tb ? a.in[24] : a.in[23]) + (size_t)e * 1024 + 16 * lane;
            f32x4 v[4]; float mx = 0.f;
#pragma unroll
            for (int j = 0; j < 4; ++j) { v[j] = *(const f32x4*)(src + 4 * j); if (!tb) v[j] = v[j] * g4[j];
#pragma unroll
                for (int c = 0; c < 4; ++c) mx = fmaxf(mx, fabsf(v[j][c])); }
#pragma unroll
            for (int o = 1; o < 64; o <<= 1) mx = fmaxf(mx, __shfl_xor(mx, o));
            mx = fmaxf(mx, 1e-30f);
            const float sc = 224.0f / mx;
            u32x4 q;
#pragma unroll
            for (int j = 0; j < 4; ++j) { int w = 0; w = __builtin_amdgcn_cvt_pk_fp8_f32(v[j][0] * sc, v[j][1] * sc, w, false); w = __builtin_amdgcn_cvt_pk_fp8_f32(v[j][2] * sc, v[j][3] * sc, w, true); q[j] = (unsigned)w; }
            unsigned char* dst = ws + (tb ? O_V8 : O_U8) + ((size_t)(lane >> 3) * 16384 + e) * 128 + 16 * (lane & 7);
            *(u32x4*)dst = q;
            if (lane == 0) ((float*)(ws + (tb ? O_VSC : O_USC)))[e] = mx * (1.0f / 224.0f);
        }
        if (blockIdx.x == 0 && tid < 32) ((unsigned*)(ws + O_CTR))[tid * 64] = 0u;
        const f32x4* pp = (const f32x4*)a.in[1]; h16x4* dp = (h16x4*)(ws + O_P16);
        const int np4 = MTOK * 256 / 4;
        for (int i = blockIdx.x * NTHREADS + tid; i < np4; i += gridDim.x * NTHREADS) dp[i] = pack4(pp[i]);
    }
    {
        const float* x = a.in[0]; h16* xn = (h16*)(ws + O_XN);
        for (int r = gw; r < MTOK; r += NGW) {
            const f32x4* xr = (const f32x4*)(x + (size_t)r * 1024) + lane;
            f32x4 v[4]; float s = 0.f;
#pragma unroll
            for (int j = 0; j < 4; ++j) { v[j] = xr[64 * j]; s += (v[j][0] * v[j][0] + v[j][1] * v[j][1]) + (v[j][2] * v[j][2] + v[j][3] * v[j][3]); }
            const float rs = rsqrtf(wave_sum(s) * (1.f / 1024.f) + NORM_EPS);
            h16x4* o = (h16x4*)(xn + (size_t)r * 1024) + lane;
#pragma unroll
            for (int j = 0; j < 4; ++j) o[64 * j] = pack4(v[j] * rs);
        }
    }
}

__device__ __forceinline__ void phase_conv(const Args& a) {
    const int tid = tid_(), lane = tid & 63, wave = tid >> 6;
    const int gw = blockIdx.x * NWAVES + wave, NGW = gridDim.x * NWAVES;
    const h16* zc = (const h16*)(a.ws + O_ZC); h16* ca = (h16*)(a.ws + O_CA);
    const float* cw = a.in[4]; const float* cb = a.in[5];
    float w0[8], w1[8], w2[8], bb[8];
#pragma unroll
    for (int j = 0; j < 8; ++j) { const int c = lane * 8 + j; w0[j] = cw[c]; w1[j] = cw[512 + c]; w2[j] = cw[1024 + c]; bb[j] = cb[c]; }
    for (int run = gw; run < MTOK / 32; run += NGW) {
        const int t0 = run * 32;
        float u1[8], u2[8];
        if ((t0 % SEQ) == 0) {
#pragma unroll
            for (int j = 0; j < 8; ++j) { u1[j] = 0.f; u2[j] = 0.f; }
        } else {
            const h16x8 c1 = *(const h16x8*)(zc + (size_t)(t0 - 1) * 1536 + 512 + lane * 8), x1 = *(const h16x8*)(zc + (size_t)(t0 - 1) * 1536 + 1024 + lane * 8);
            const h16x8 c2 = *(const h16x8*)(zc + (size_t)(t0 - 2) * 1536 + 512 + lane * 8), x2 = *(const h16x8*)(zc + (size_t)(t0 - 2) * 1536 + 1024 + lane * 8);
#pragma unroll
            for (int j = 0; j < 8; ++j) { u1[j] = (float)c1[j] * (float)x1[j]; u2[j] = (float)c2[j] * (float)x2[j]; }
        }
        for (int t = t0; t < t0 + 32; ++t) {
            const h16* zrow = zc + (size_t)t * 1536 + lane * 8;
            const h16x8 gb = *(const h16x8*)zrow, gc = *(const h16x8*)(zrow + 512), xi = *(const h16x8*)(zrow + 1024);
            h16x8 o;
#pragma unroll
            for (int j = 0; j < 8; ++j) { const float u0 = (float)gc[j] * (float)xi[j];
                const float y = w0[j] * u2[j] + w1[j] * u1[j] + w2[j] * u0 + bb[j];
                o[j] = (h16)((float)gb[j] * y); u2[j] = u1[j]; u1[j] = u0; }
            *(h16x8*)(ca + (size_t)t * 512 + lane * 8) = o;
        }
    }
}


__device__ __forceinline__ float tanhf_(float x) { return 1.0f - 2.0f * __builtin_amdgcn_rcpf(1.0f + __expf(2.0f * x)); }
__device__ __forceinline__ void phase_rwkv_prep(const Args& a) {
    const int tid = tid_(), lane = tid & 63, wave = tid >> 6;
    const int gw = blockIdx.x * NWAVES + wave, NGW = gridDim.x * NWAVES;
    const h16* zr = (const h16*)(a.ws + O_ZR);
    h16* R = (h16*)a.out; h16* KS = R + (size_t)MTOK * 512; h16* V = KS + (size_t)MTOK * 512; h16* KK = V + (size_t)MTOK * 512;
    h16* APR = (h16*)(a.ws + O_APR);
    const float* mu = a.in[6]; const float* k_k = a.in[12];
    float mr[8], mk[8], mv[8], mt[8], kk8[8];
#pragma unroll
    for (int j = 0; j < 8; ++j) { const int c = lane * 8 + j; mr[j] = mu[c]; mk[j] = mu[512 + c]; mv[j] = mu[1024 + c]; mt[j] = mu[1536 + (c & 255)]; kk8[j] = k_k[c]; }
    for (int run = gw; run < MTOK / 32; run += NGW) {
        const int t0 = run * 32;
        float pr[8], pk[8], pv[8], pt[8];
        if ((t0 % SEQ) == 0) {
#pragma unroll
            for (int j = 0; j < 8; ++j) { pr[j] = 0.f; pk[j] = 0.f; pv[j] = 0.f; pt[j] = 0.f; }
        } else {
            const h16* zp = zr + (size_t)(t0 - 1) * 1792 + lane * 8;
            const h16x8 a0 = *(const h16x8*)zp, a1 = *(const h16x8*)(zp + 512), a2 = *(const h16x8*)(zp + 1024), a3 = *(const h16x8*)(zr + (size_t)(t0 - 1) * 1792 + 1536 + (lane & 31) * 8);
#pragma unroll
            for (int j = 0; j < 8; ++j) { pr[j] = (float)a0[j]; pk[j] = (float)a1[j]; pv[j] = (float)a2[j]; pt[j] = (float)a3[j]; }
        }
        for (int t = t0; t < t0 + 32; ++t) {
            const h16* zp = zr + (size_t)t * 1792 + lane * 8;
            const h16x8 a0 = *(const h16x8*)zp, a1 = *(const h16x8*)(zp + 512), a2 = *(const h16x8*)(zp + 1024), a3 = *(const h16x8*)(zr + (size_t)t * 1792 + 1536 + (lane & 31) * 8);
            h16x8 orr, ok, ov, okk, ot; float kr[8]; float ss = 0.f;
#pragma unroll
            for (int j = 0; j < 8; ++j) {
                const float zr_ = (float)a0[j], zk_ = (float)a1[j], zv_ = (float)a2[j], zt_ = (float)a3[j];
                const float r = zr_ + mr[j] * (pr[j] - zr_), k = zk_ + mk[j] * (pk[j] - zk_), v = zv_ + mv[j] * (pv[j] - zv_), tl = zt_ + mt[j] * (pt[j] - zt_);
                pr[j] = zr_; pk[j] = zk_; pv[j] = zv_; pt[j] = zt_;
                orr[j] = (h16)r; ok[j] = (h16)k; ov[j] = (h16)v;
                kr[j] = k * kk8[j]; ss += kr[j] * kr[j];
                const float tv = (lane < 8) ? tanhf_(tl) : (lane < 16) ? tl : sigmoidf_(tl);
                ot[j] = (h16)tv;
            }
            ss += __shfl_xor(ss, 1); ss += __shfl_xor(ss, 2); ss += __shfl_xor(ss, 4);
            const float rn = rsqrtf(ss + 1e-12f);
#pragma unroll
            for (int j = 0; j < 8; ++j) okk[j] = (h16)(kr[j] * rn);
            const size_t o = (size_t)t * 512 + lane * 8;
            *(h16x8*)(R + o) = orr; *(h16x8*)(KS + o) = ok; *(h16x8*)(V + o) = ov; *(h16x8*)(KK + o) = okk;
            if (lane < 32) *(h16x8*)(APR + (size_t)t * 256 + lane * 8) = ot;
        }
    }
}

struct EpiLR {
    const float *w0, *a0, *k_a; h16 *WD, *KS, *BD, *GG; const h16* KK;
    __device__ __forceinline__ void operator()(AccRef acc, const Unit& u, int wr, int wc, int fr, int fq) const {
        const int part = u.pn >> 1;
        EPI_LOOP_BEGIN
            const int c = col - part * 512; const size_t o = (size_t)row * 512 + c;
            if (part == 0) {
                const f32x4 b0 = *(const f32x4*)(w0 + c), b1 = *(const f32x4*)(w0 + c + 4); f32x4 o0, o1;
#pragma unroll
                for (int j = 0; j < 4; ++j) { o0[j] = __expf(-0.6065306597126334f * sigmoidf_(b0[j] + v0[j])); o1[j] = __expf(-0.6065306597126334f * sigmoidf_(b1[j] + v1[j])); }
                *(h16x8*)(WD + o) = pack8(o0, o1);
            } else if (part == 1) {
                const f32x4 b0 = *(const f32x4*)(a0 + c), b1 = *(const f32x4*)(a0 + c + 4), ka0 = *(const f32x4*)(k_a + c), ka1 = *(const f32x4*)(k_a + c + 4);
                const h16x8 ks = *(const h16x8*)(KS + o), kk = *(const h16x8*)(KK + o); f32x4 k0, k1, bb0, bb1;
#pragma unroll
                for (int j = 0; j < 4; ++j) { const float aa0 = sigmoidf_(b0[j] + v0[j]), aa1 = sigmoidf_(b1[j] + v1[j]);
                    k0[j] = (float)ks[j] * (1.0f + (aa0 - 1.0f) * ka0[j]); k1[j] = (float)ks[4 + j] * (1.0f + (aa1 - 1.0f) * ka1[j]);
                    bb0[j] = aa0 * (float)kk[j]; bb1[j] = aa1 * (float)kk[4 + j]; }
                *(h16x8*)(KS + o) = pack8(k0, k1); *(h16x8*)(BD + o) = pack8(bb0, bb1);
            } else {
                *(h16x8*)(GG + o) = pack8(v0, v1);
            }
        EPI_LOOP_END
    }
};

constexpr int SC_L = 256, SC_NCH = SEQ / SC_L, SC_NB = 8;
constexpr int SC_STEP_F = 6 * 64;
constexpr int SC_WAVE_BYTES = SC_NB * SC_STEP_F * 4 + SC_NB * 64 * 4;
__device__ __forceinline__ float quad_sum(float v) { v += dpp_<0xB1>(v); v += dpp_<0x4E>(v); return v; }
__device__ __forceinline__ void lds_ld8x2(const LAS float* p, f32x2 (&o)[8]) {
#pragma unroll
    for (int j4 = 0; j4 < 4; ++j4) { const f32x4 t = *(const LAS f32x4*)(p + 4 * j4); o[2 * j4] = (f32x2){t[0], t[1]}; o[2 * j4 + 1] = (f32x2){t[2], t[3]}; }
}
template <int MODE>
__device__ __forceinline__ void scan_wave(const Args& a, LAS unsigned char* lds, int task) {
    const int tid = tid_(), lane = tid & 63, wave = tid >> 6;
    const int q = lane & 3, rg = lane >> 2;
    const int chain = task / SC_NCH, chunk = task % SC_NCH, b = chain >> 3, h = chain & 7;
    const size_t row0 = (size_t)b * SEQ + (size_t)chunk * SC_L;
    const h16* R = (const h16*)a.out; const h16* KS = R + (size_t)MTOK * 512; const h16* V = KS + (size_t)MTOK * 512; const h16* KK = V + (size_t)MTOK * 512;
    const h16* WD = (const h16*)(a.ws + O_WD); const h16* BD = (const h16*)(a.ws + O_BD);
    LAS float* buf = (LAS float*)(lds + wave * SC_WAVE_BYTES);
    LAS float* ybuf = buf + SC_NB * SC_STEP_F;
    constexpr int NA = (MODE == 0) ? 5 : (MODE == 1) ? 3 : 6;
    const h16* gp[NA]; int lo[NA];
#pragma unroll
    for (int j = 0; j < NA; ++j) { const int p = lane + 64 * j, seg = p >> 3, part = p & 7, st = seg / NA, ai = seg % NA;
        const int ar = (MODE == 0 && ai == 4) ? 5 : ai;
        const h16* base = (ar == 0) ? KK : (ar == 1) ? WD : (ar == 2) ? BD : (ar == 3) ? KS : (ar == 4) ? R : V;
        gp[j] = base + (row0 + st) * 512 + h * 64 + part * 8; lo[j] = st * SC_STEP_F + ar * 64 + part * 8; }
    f32x2 s[4][8];
    if (MODE == 0) {
#pragma unroll
        for (int i = 0; i < 4; ++i)
#pragma unroll
            for (int j = 0; j < 8; ++j) s[i][j] = (f32x2){0.f, 0.f};
    } else if (MODE == 1) {
#pragma unroll
        for (int i = 0; i < 4; ++i)
#pragma unroll
            for (int j = 0; j < 8; ++j) s[i][j] = (f32x2){(i == q && 2 * j == rg) ? 1.f : 0.f, (i == q && 2 * j + 1 == rg) ? 1.f : 0.f};
    } else {
        const float* S0 = (const float*)(a.ws + O_SST) + (size_t)task * 4096;
#pragma unroll
        for (int i = 0; i < 4; ++i)
#pragma unroll
            for (int j4 = 0; j4 < 4; ++j4) { const f32x4 t = *(const f32x4*)(S0 + (rg + 16 * i) * 64 + 16 * q + 4 * j4);
                s[i][2 * j4] = (f32x2){t[0], t[1]}; s[i][2 * j4 + 1] = (f32x2){t[2], t[3]}; }
    }
    h16x8 pre[NA];
#pragma unroll
    for (int j = 0; j < NA; ++j) pre[j] = *(const h16x8*)gp[j];
    f32x2 kk[8];
    for (int bt = 0; bt < SC_L / SC_NB; ++bt) {
        LAS float* cb = buf;
#pragma unroll
        for (int j = 0; j < NA; ++j) { f32x4 x0, x1;
#pragma unroll
            for (int e = 0; e < 4; ++e) { x0[e] = (float)pre[j][e]; x1[e] = (float)pre[j][4 + e]; }
            *(LAS f32x4*)(cb + lo[j]) = x0; *(LAS f32x4*)(cb + lo[j] + 4) = x1; }
        if (bt + 1 < SC_L / SC_NB) {
#pragma unroll
            for (int j = 0; j < NA; ++j) pre[j] = *(const h16x8*)(gp[j] + (size_t)(bt + 1) * SC_NB * 512);
        }
        lds_ld8x2(cb + 16 * q, kk);
#pragma unroll 2
        for (int st = 0; st < SC_NB; ++st) {
            const LAS float* sb = cb + st * SC_STEP_F;
            f32x2 w[8], bb[8], kx[8]; float vv[4];
            lds_ld8x2(sb + 64 + 16 * q, w); lds_ld8x2(sb + 128 + 16 * q, bb);
            if (MODE != 1) { lds_ld8x2(sb + 192 + 16 * q, kx);
#pragma unroll
                for (int i = 0; i < 4; ++i) vv[i] = sb[320 + rg + 16 * i]; }
            float us[4];
#pragma unroll
            for (int i = 0; i < 4; ++i) { f32x2 t = s[i][0] * kk[0];
#pragma unroll
                for (int j = 1; j < 8; ++j) t = __builtin_elementwise_fma(s[i][j], kk[j], t);
                us[i] = quad_sum(t[0] + t[1]); }
            if (st + 1 < SC_NB) lds_ld8x2(sb + SC_STEP_F + 16 * q, kk);
            f32x2 rr[8];
            if (MODE == 2) lds_ld8x2(sb + 256 + 16 * q, rr);
#pragma unroll
            for (int i = 0; i < 4; ++i) { const f32x2 nu = (f32x2){-us[i], -us[i]}, v2 = (f32x2){vv[i], vv[i]};
#pragma unroll
                for (int j = 0; j < 8; ++j) { f32x2 t = s[i][j] * w[j]; t = __builtin_elementwise_fma(nu, bb[j], t); if (MODE != 1) t = __builtin_elementwise_fma(v2, kx[j], t); s[i][j] = t; } }
            if (MODE == 2) {
#pragma unroll
                for (int i = 0; i < 4; ++i) { f32x2 t = s[i][0] * rr[0];
#pragma unroll
                    for (int j = 1; j < 8; ++j) t = __builtin_elementwise_fma(s[i][j], rr[j], t);
                    const float y = quad_sum(t[0] + t[1]);
                    if (q == 0) ybuf[st * 64 + rg + 16 * i] = y; }
            }
        }
        if (MODE == 2) {
            const int st = lane >> 3, part = lane & 7; h16x8 o;
#pragma unroll
            for (int e = 0; e < 8; ++e) o[e] = (h16)ybuf[st * 64 + part * 8 + e];
            *(h16x8*)((h16*)(a.ws + O_Y) + (row0 + (size_t)bt * SC_NB + st) * 512 + h * 64 + part * 8) = o;
        }
    }
    if (MODE != 2) {
        float* PQ = (float*)(a.ws + O_PQ) + (size_t)task * 8192 + (MODE == 0 ? 4096 : 0);
#pragma unroll
        for (int i = 0; i < 4; ++i)
#pragma unroll
            for (int j4 = 0; j4 < 4; ++j4) { const int o = (rg + 16 * i) * 64 + 16 * q + 4 * j4;
                *(f32x4*)(PQ + o) = (f32x4){s[i][2 * j4][0], s[i][2 * j4][1], s[i][2 * j4 + 1][0], s[i][2 * j4 + 1][1]}; }
    }
}
template <bool FIRST>
__device__ __forceinline__ void phase_scan(const Args& a, LAS unsigned char* lds) {
    const int wave = tid_() >> 6;
    if (FIRST) {
        for (int task = blockIdx.x * NWAVES + wave; task < 64 * SC_NCH; task += gridDim.x * NWAVES) { scan_wave<0>(a, lds, task); scan_wave<1>(a, lds, task); }
    } else {
        for (int task = blockIdx.x * NWAVES + wave; task < 64 * SC_NCH; task += gridDim.x * NWAVES) scan_wave<2>(a, lds, task);
    }
}

constexpr size_t O_VTB = O_ZR;
constexpr size_t O_BON = O_ZR + 64 * MiB;
constexpr int UT_WAVE_LDS = 15360;
typedef float f32x16 __attribute__((ext_vector_type(16)));
__device__ __forceinline__ size_t ut_ov(int j, int s) { return (size_t)(j >> 2) * 512 + (j & 3) * 16 + s; }
__device__ __forceinline__ void phase_ut_pre(const Args& a, LAS unsigned char* lds) {
    const int tid = tid_(), lane = tid & 63, wave = tid >> 6;
    const int gw = blockIdx.x * NWAVES + wave, NGW = gridDim.x * NWAVES;
    LAS unsigned char* Lb = lds + wave * UT_WAVE_LDS;
    LAS h16* YX = (LAS h16*)Lb;
    LAS float* GT = (LAS float*)(Lb + 9216);
    LAS float* TM = (LAS float*)(Lb + 13824);
    h16* R = (h16*)a.out; h16* KS = R + (size_t)MTOK * 512; h16* V = KS + (size_t)MTOK * 512; h16* KK = V + (size_t)MTOK * 512;
    h16* WD = (h16*)(a.ws + O_WD); h16* BD = (h16*)(a.ws + O_BD);
    h16* VTB = (h16*)(a.ws + O_VTB); float* BON = (float*)(a.ws + O_BON);
    for (int bh = gw; bh < 32768; bh += NGW) {
        int ln = lane; asm volatile("" : "+v"(ln)); const int r16 = ln & 15;
        const int h = bh & 7, nb = bh >> 3; const size_t tok0 = (size_t)nb * 16; const size_t e0 = tok0 * 512 + h * 64;
        const float rk = a.in[14][h * 64 + lane];
        float w[16], kk[16], bb[16], kx[16], rr[16]; h16x8 vt0, vt1;
#pragma unroll
        for (int t = 0; t < 16; ++t) { const size_t i = e0 + (size_t)t * 512 + lane; w[t] = (float)WD[i]; kk[t] = (float)KK[i]; bb[t] = (float)BD[i]; kx[t] = (float)KS[i]; rr[t] = (float)R[i];
            if (t < 8) vt0[t] = V[i]; else vt1[t - 8] = V[i]; }
        { h16* vp = VTB + (size_t)bh * 1024 + lane * 16; *(h16x8*)vp = vt0; *(h16x8*)(vp + 8) = vt1; }
        float bonv = 0.f;
#pragma unroll
        for (int t = 0; t < 16; ++t) { const float bs = wave_sum(rr[t] * kx[t] * rk); bonv = (ln == t) ? bs : bonv; }
        if (lane < 16) BON[(tok0 + lane) * 8 + h] = bonv;
        float Lt[16]; { float Lc = 0.f;
#pragma unroll
            for (int t = 0; t < 16; ++t) { Lc += __logf(w[t]); Lt[t] = Lc; } }
        const float Lref = Lt[7];
        float btil[16]; h16x8 kt0, kt1;
#pragma unroll
        for (int t = 0; t < 16; ++t) {
            const float Lp = t ? Lt[t - 1] : 0.f;
            const float ka = kk[t] * __expf(Lp - Lref), rt = rr[t] * __expf(Lt[t] - Lref), e2 = __expf(Lref - Lt[t]), bt = bb[t] * e2, kt = kx[t] * e2;
            YX[t * 72 + lane] = (h16)ka; YX[(16 + t) * 72 + lane] = (h16)rt; YX[(32 + t) * 72 + lane] = (h16)kt; YX[(48 + t) * 72 + lane] = (h16)bt;
            btil[t] = bt;
            const size_t i = e0 + (size_t)t * 512 + lane; KK[i] = (h16)(kk[t] * __expf(Lp)); R[i] = (h16)(rr[t] * __expf(Lt[t]));
            const float ktp = kx[t] * __expf(Lt[15] - Lt[t]);
            if (t < 8) kt0[t] = (h16)ktp; else kt1[t - 8] = (h16)ktp;
        }
        const float post = __expf(Lt[15] - Lref), w16 = __expf(Lt[15]);
        { h16* kp = KS + e0 + ut_ov(lane, 0); *(h16x8*)kp = kt0; *(h16x8*)(kp + 8) = kt1; }
        asm volatile("s_waitcnt lgkmcnt(0)" ::: "memory");
        f32x16 acc;
#pragma unroll
        for (int i = 0; i < 16; ++i) acc[i] = 0.f;
#pragma unroll
        for (int ks = 0; ks < 4; ++ks) {
            const h16x8 af = *(const LAS h16x8*)(YX + (lane & 31) * 72 + 8 * (lane >> 5) + 16 * ks), bf = *(const LAS h16x8*)(YX + (32 + (lane & 31)) * 72 + 8 * (lane >> 5) + 16 * ks);
            acc = __builtin_amdgcn_mfma_f32_32x32x16_f16(af, bf, acc, 0, 0, 0);
        }
#pragma unroll
        for (int i = 0; i < 16; ++i) GT[((i & 3) + 8 * (i >> 2) + 4 * (lane >> 5)) * 36 + (lane & 31)] = acc[i];
        asm volatile("s_waitcnt lgkmcnt(0)" ::: "memory");
        float T[16];
#pragma unroll
        for (int t = 0; t < 16; ++t) { float v = (r16 == t) ? 1.f : 0.f;
#pragma unroll
            for (int s2 = 0; s2 < t; ++s2) v -= T[s2] * GT[t * 36 + 16 + s2];
            T[t] = v; }
#pragma unroll
        for (int t = 0; t < 16; ++t) TM[r16 * 20 + t] = T[t];
        asm volatile("s_waitcnt lgkmcnt(0)" ::: "memory");
        float bcol[16];
#pragma unroll
        for (int s2 = 0; s2 < 16; ++s2) bcol[s2] = (s2 <= r16) ? GT[(16 + r16) * 36 + 16 + s2] : 0.f;
        h16x8 tb0, tb1, tp0, tp1;
#pragma unroll
        for (int r = 0; r < 16; ++r) { float s0 = 0.f, s1 = 0.f;
#pragma unroll
            for (int s2 = r; s2 < 16; ++s2) { const float tv = TM[r * 20 + s2]; s0 += tv * btil[s2]; s1 += tv * bcol[s2]; }
            s0 *= post;
            if (r < 8) { tb0[r] = (h16)s0; tp0[r] = (h16)s1; } else { tb1[r - 8] = (h16)s0; tp1[r - 8] = (h16)s1; } }
        { h16* bp = BD + e0 + ut_ov(lane, 0); *(h16x8*)bp = tb0; *(h16x8*)(bp + 8) = tb1; }
        if (lane < 16) {
            h16x8 a0, a1, p0, p1;
#pragma unroll
            for (int s2 = 0; s2 < 16; ++s2) { const float av = (s2 < ln) ? GT[ln * 36 + s2] : 0.f, pv = (s2 <= ln) ? GT[(16 + ln) * 36 + s2] : 0.f;
                if (s2 < 8) { a0[s2] = (h16)av; p0[s2] = (h16)pv; } else { a1[s2 - 8] = (h16)av; p1[s2 - 8] = (h16)pv; } }
            h16* ap = WD + e0 + (size_t)(lane >> 2) * 512 + (lane & 3) * 16;
            *(h16x8*)ap = a0; *(h16x8*)(ap + 8) = a1;
            *(h16x8*)(ap + 4 * 512) = p0; *(h16x8*)(ap + 4 * 512 + 8) = p1;
            *(h16x8*)(ap + 8 * 512) = tp0; *(h16x8*)(ap + 8 * 512 + 8) = tp1;
        }
        ((float*)(WD + e0 + (size_t)(12 + (lane >> 5)) * 512))[lane & 31] = w16;
        asm volatile("s_waitcnt lgkmcnt(0)" ::: "memory");
    }
}
struct UtOps { u32x2 ka[2][2], rt[2][2], kt[4], tb[4], at, apt, tp, vb; f32x4 w16[4]; };
__device__ __forceinline__ void ut_load(UtOps& o, const char* kkb, const char* rb, const char* ksb, const char* bdb, const char* wdb, const char* vtb, unsigned offK, unsigned offT, unsigned offV, unsigned offF) {
#pragma unroll
    for (int ks = 0; ks < 2; ++ks)
#pragma unroll
        for (int p = 0; p < 2; ++p) { o.ka[ks][p] = *(const u32x2*)(kkb + (offK + 64u * ks + 32u * p)); o.rt[ks][p] = *(const u32x2*)(rb + (offK + 64u * ks + 32u * p)); }
#pragma unroll
    for (int kt = 0; kt < 4; ++kt) { o.kt[kt] = *(const u32x2*)(ksb + (offT + 4096u * kt)); o.tb[kt] = *(const u32x2*)(bdb + (offT + 4096u * kt)); }
    o.at = *(const u32x2*)(wdb + offT); o.apt = *(const u32x2*)(wdb + (offT + 4096u)); o.tp = *(const u32x2*)(wdb + (offT + 8192u));
    o.vb = *(const u32x2*)(vtb + offV);
#pragma unroll
    for (int kt = 0; kt < 4; ++kt) o.w16[kt] = *(const f32x4*)(wdb + (offF + (12u + (kt >> 1)) * 1024u + (kt & 1) * 64u));
}
__device__ __forceinline__ h16x8 cat8(u32x2 lo, u32x2 hi) { u32x4 r; r[0] = lo[0]; r[1] = lo[1]; r[2] = hi[0]; r[3] = hi[1]; return __builtin_bit_cast(h16x8, r); }
__device__ __forceinline__ void ut_block(const UtOps& o, f32x4 (&S)[4], h16* yp) {
    const f32x4 zf = (f32x4){0.f, 0.f, 0.f, 0.f}; const u32x2 zu = (u32x2){0u, 0u};
    const h16x8 sb0 = pack8(S[0], S[1]), sb1 = pack8(S[2], S[3]);
    const h16x8 vb = cat8(o.vb, zu);
    f32x4 x1 = zf, y = zf;
    x1 = __builtin_amdgcn_mfma_f32_16x16x32_f16(cat8(o.ka[0][0], o.ka[0][1]), sb0, x1, 0, 0, 0); y = __builtin_amdgcn_mfma_f32_16x16x32_f16(cat8(o.rt[0][0], o.rt[0][1]), sb0, y, 0, 0, 0);
    x1 = __builtin_amdgcn_mfma_f32_16x16x32_f16(cat8(o.ka[1][0], o.ka[1][1]), sb1, x1, 0, 0, 0); y = __builtin_amdgcn_mfma_f32_16x16x32_f16(cat8(o.rt[1][0], o.rt[1][1]), sb1, y, 0, 0, 0);
    x1 = __builtin_amdgcn_mfma_f32_16x16x32_f16(cat8(o.at, zu), vb, x1, 0, 0, 0); y = __builtin_amdgcn_mfma_f32_16x16x32_f16(cat8(o.apt, zu), vb, y, 0, 0, 0);
    f32x4 St[4];
#pragma unroll
    for (int kt = 0; kt < 4; ++kt) St[kt] = __builtin_amdgcn_mfma_f32_16x16x32_f16(cat8(o.kt[kt], zu), vb, S[kt] * o.w16[kt], 0, 0, 0);
    const h16x8 xb = pack8(-x1, zf);
    y = __builtin_amdgcn_mfma_f32_16x16x32_f16(cat8(o.tp, zu), xb, y, 0, 0, 0);
#pragma unroll
    for (int kt = 0; kt < 4; ++kt) S[kt] = __builtin_amdgcn_mfma_f32_16x16x32_f16(cat8(o.tb[kt], zu), xb, St[kt], 0, 0, 0);
#pragma unroll
    for (int rg = 0; rg < 4; ++rg) yp[(size_t)rg * 512] = (h16)y[rg];
}
__device__ __forceinline__ void phase_ut_seq(const Args& a, LAS unsigned char* lds) {
    const int tid = tid_(), lane = tid & 63, wave = tid >> 6, fr = lane & 15, fq = lane >> 4;
    volatile LAS int* prog = (volatile LAS int*)lds;
    if (tid == 0) *prog = 0;
    if (wave > 1) return;
    for (int item = blockIdx.x; item < 256; item += gridDim.x) {
        const int h = item & 7, q = item >> 3, g = q & 3, b = q >> 2;
        const size_t e0 = ((size_t)b * SEQ * 512 + h * 64) * 2;
        const char* Rb = (const char*)a.out + e0; const char* KSb = Rb + (size_t)MTOK * 1024; const char* KKb = Rb + (size_t)3 * MTOK * 1024;
        const char* WDb = (const char*)(a.ws + O_WD) + e0; const char* BDb = (const char*)(a.ws + O_BD) + e0;
        const char* VTb = (const char*)(a.ws + O_VTB) + ((size_t)b * (SEQ / 16) * 8 + h) * 2048;
        if (wave == 1) {
            const int ar = lane >> 4, row = lane & 15;
            const char* p0 = ((ar == 0) ? KKb : (ar == 1) ? Rb : (ar == 2) ? KSb : BDb) + (size_t)row * 1024;
            const char* p1 = (lane < 16) ? WDb + (size_t)row * 1024 : VTb + (size_t)(4 * g + (lane & 3)) * 128;
            for (int n0 = 0; n0 < SEQ / 16; n0 += 8) {
                int guard = 0;
                while (*prog + 16 < n0 && ++guard < (1 << 22)) __builtin_amdgcn_s_sleep(8);
                unsigned x[16];
#pragma unroll
                for (int i = 0; i < 8; ++i) { x[2 * i] = *(const unsigned*)(p0 + (size_t)(n0 + i) * 16384); x[2 * i + 1] = *(const unsigned*)(p1 + (size_t)(n0 + i) * 16384); }
#pragma unroll
                for (int i = 0; i < 16; ++i) asm volatile("" :: "v"(x[i]));
            }
            continue;
        }
        const unsigned offK = (unsigned)(fr * 1024 + 8 * fq), offT = (unsigned)((fr >> 2) * 512 + (fr & 3) * 16 + 4 * fq) * 2u, offV = (unsigned)((16 * g + fr) * 16 + 4 * fq) * 2u, offF = (unsigned)fq * 16u;
        h16* yb = (h16*)(a.ws + O_Y) + ((size_t)b * SEQ + 4 * fq) * 512 + h * 64 + 16 * g + fr;
        f32x4 S[4];
#pragma unroll
        for (int kt = 0; kt < 4; ++kt) S[kt] = (f32x4){0.f, 0.f, 0.f, 0.f};
        UtOps oa, ob;
        ut_load(oa, KKb, Rb, KSb, BDb, WDb, VTb, offK, offT, offV, offF);
#pragma unroll 1
        for (int n = 0; n < SEQ / 16; n += 2) {
            const size_t s1 = (size_t)(n + 1) * 16384, s2 = (size_t)((n + 2 < SEQ / 16) ? n + 2 : n) * 16384;
            if (lane == 0) *prog = n;
            ut_load(ob, KKb + s1, Rb + s1, KSb + s1, BDb + s1, WDb + s1, VTb + s1, offK, offT, offV, offF);
            ut_block(oa, S, yb + (size_t)n * 16 * 512);
            ut_load(oa, KKb + s2, Rb + s2, KSb + s2, BDb + s2, WDb + s2, VTb + s2, offK, offT, offV, offF);
            ut_block(ob, S, yb + (size_t)(n + 1) * 16 * 512);
        }
    }
}

__device__ __forceinline__ void phase_scan_combine(const Args& a, LAS unsigned char* lds) {
    const int tid = tid_(), row = tid >> 5, cp = tid & 31;
    LAS float* LS = (LAS float*)lds;
    LAS float* LP = (LAS float*)(lds + 8192);
    for (int item = blockIdx.x; item < 64 * 4; item += gridDim.x) {
        const int chain = item >> 2, r0 = (item & 3) * 16;
        const float* PQ0 = (const float*)(a.ws + O_PQ) + (size_t)chain * SC_NCH * 8192;
        f32x2 sr = (f32x2){0.f, 0.f};
        f32x4 pa = *(const f32x4*)(PQ0 + tid * 8), pb = *(const f32x4*)(PQ0 + tid * 8 + 4);
        f32x2 qn = *(const f32x2*)(PQ0 + 4096 + (r0 + row) * 64 + 2 * cp);
        for (int c = 0; c < SC_NCH; ++c) {
            const int task = chain * SC_NCH + c;
            *(f32x2*)((float*)(a.ws + O_SST) + (size_t)task * 4096 + (r0 + row) * 64 + 2 * cp) = sr;
            if (c == SC_NCH - 1) break;
            LAS float* cur = LS + (c & 1) * 1024; LAS float* cp_ = LP + (c & 1) * 4096;
            *(LAS f32x2*)(cur + row * 64 + 2 * cp) = sr;
            *(LAS f32x4*)(cp_ + tid * 8) = pa; *(LAS f32x4*)(cp_ + tid * 8 + 4) = pb;
            f32x2 acc0 = qn, acc1 = (f32x2){0.f, 0.f};
            if (c + 2 < SC_NCH) { const float* Pn = PQ0 + (size_t)(c + 1) * 8192;
                pa = *(const f32x4*)(Pn + tid * 8); pb = *(const f32x4*)(Pn + tid * 8 + 4); qn = *(const f32x2*)(Pn + 4096 + (r0 + row) * 64 + 2 * cp); }
            __syncthreads();
#pragma unroll 16
            for (int k = 0; k < 64; k += 2) {
                const f32x2 sk = *(const LAS f32x2*)(cur + row * 64 + k);
                const f32x2 p0 = *(const LAS f32x2*)(cp_ + k * 64 + 2 * cp), p1 = *(const LAS f32x2*)(cp_ + (k + 1) * 64 + 2 * cp);
                acc0 = __builtin_elementwise_fma((f32x2){sk[0], sk[0]}, p0, acc0); acc1 = __builtin_elementwise_fma((f32x2){sk[1], sk[1]}, p1, acc1);
            }
            sr = acc0 + acc1;
        }
        __syncthreads();
    }
}
__device__ __forceinline__ void phase_rwkv_post(const Args& a) {
    const int tid = tid_(), lane = tid & 63, wave = tid >> 6;
    const int gw = blockIdx.x * NWAVES + wave, NGW = gridDim.x * NWAVES;
    const h16* V = (const h16*)a.out + (size_t)2 * MTOK * 512;
    const h16* GG = (const h16*)(a.ws + O_GG); const h16* Y = (const h16*)(a.ws + O_Y); h16* YB = (h16*)(a.ws + O_YB); const float* BON = (const float*)(a.ws + O_BON);
    float lg[8], lb[8];
#pragma unroll
    for (int j = 0; j < 8; ++j) { const int c = lane * 8 + j; lg[j] = a.in[15][c]; lb[j] = a.in[16][c]; }
    for (int t = gw; t < MTOK; t += NGW) {
        const size_t o = (size_t)t * 512 + lane * 8;
        const h16x8 y8 = *(const h16x8*)(Y + o), v8 = *(const h16x8*)(V + o), g8 = *(const h16x8*)(GG + o);
        const float bs = BON[(size_t)t * 8 + (lane >> 3)];
        float y[8]; float sm = 0.f;
#pragma unroll
        for (int j = 0; j < 8; ++j) { y[j] = (float)y8[j]; sm += y[j]; }
        sm += dpp_<0xB1>(sm); sm += dpp_<0x4E>(sm); sm += dpp_<0x141>(sm);
        const float mean = sm * (1.f / 64.f); float vs = 0.f;
#pragma unroll
        for (int j = 0; j < 8; ++j) { y[j] -= mean; vs += y[j] * y[j]; }
        vs += dpp_<0xB1>(vs); vs += dpp_<0x4E>(vs); vs += dpp_<0x141>(vs);
        const float rstd = rsqrtf(vs * (1.f / 64.f) + 64e-5f);
        h16x8 ov;
#pragma unroll
        for (int j = 0; j < 8; ++j) ov[j] = (h16)((y[j] * rstd * lg[j] + lb[j] + bs * (float)v8[j]) * (float)g8[j]);
        *(h16x8*)(YB + o) = ov;
    }
}

__device__ __forceinline__ void ins16(unsigned (&L)[16], unsigned x) {
#pragma unroll
    for (int j = 0; j < 16; ++j) { const unsigned hi = L[j] > x ? L[j] : x; x = L[j] > x ? x : L[j]; L[j] = hi; }
}
__device__ __forceinline__ unsigned ord32(float f) { const unsigned u = __float_as_uint(f); return (u & 0x80000000u) ? ~u : (u | 0x80000000u); }
__device__ __forceinline__ float unord32(unsigned k) { return __uint_as_float((k & 0x80000000u) ? (k & 0x7fffffffu) : ~k); }
__device__ __forceinline__ void phase_topk(const Args& a, LAS unsigned char* lds) {
    const int tid = tid_();
    const h16* SC = (const h16*)(a.ws + O_SCORES);
    const float* part = (const float*)(a.ws + O_PART1);
    unsigned short* IDX = (unsigned short*)(a.ws + O_IDX); float* GATE = (float*)(a.ws + O_GATE); float* RS1 = (float*)(a.ws + O_RS1);
    LAS unsigned char* LI = lds;
    for (int task = blockIdx.x * NTHREADS + tid; task < MTOK * 8; task += gridDim.x * NTHREADS) {
        const int t = task >> 3, h = task & 7;
        float ssq = 0.f;
#pragma unroll
        for (int j = 0; j < 4; ++j) { const f32x4 p4 = *(const f32x4*)(part + (size_t)t * 16 + 4 * j); ssq += (p4[0] + p4[1]) + (p4[2] + p4[3]); }
        const float rs = rsqrtf(ssq * (1.f / 1024.f) + NORM_EPS);
        if (h == 0) RS1[t] = rs;
        float sv[2][16];
#pragma unroll
        for (int c = 0; c < 2; ++c) {
            unsigned L[16];
#pragma unroll
            for (int j = 0; j < 16; ++j) L[j] = 0u;
            const h16* row = SC + (size_t)t * 2048 + h * 256 + c * 128;
#pragma unroll 2
            for (int n8 = 0; n8 < 16; ++n8) {
                const u32x4 w4 = *(const u32x4*)(row + n8 * 8);
#pragma unroll
                for (int e = 0; e < 8; ++e) {
                    const unsigned bits = (e & 1) ? (w4[e >> 1] >> 16) : (w4[e >> 1] & 0xffffu);
                    const unsigned o16 = (bits & 0x8000u) ? (~bits & 0xffffu) : (bits | 0x8000u);
                    ins16(L, (o16 << 16) | (unsigned)(127 - (n8 * 8 + e)));
                }
            }
#pragma unroll
            for (int j = 0; j < 16; ++j) {
                const unsigned o16 = L[j] >> 16; const unsigned bits = (o16 & 0x8000u) ? (o16 & 0x7fffu) : (~o16 & 0xffffu);
                union { unsigned short u; h16 f; } cv; cv.u = (unsigned short)bits; sv[c][j] = (float)cv.f;
                LI[(c * 16 + j) * 512 + tid] = (unsigned char)(127u - (L[j] & 127u));
            }
        }
        unsigned L[16];
#pragma unroll
        for (int j = 0; j < 16; ++j) L[j] = 0u;
#pragma unroll
        for (int i = 0; i < 16; ++i)
#pragma unroll
            for (int j = 0; j < 16; ++j) if ((i + 1) * (j + 1) <= 16) ins16(L, (ord32(sv[0][i] + sv[1][j]) & ~255u) | (unsigned)(255 - (i * 16 + j)));
        float e[16]; float den = 0.f; const float mx = unord32(L[0] & ~255u) * rs;
        unsigned short id[16];
#pragma unroll
        for (int k = 0; k < 16; ++k) {
            const float v = unord32(L[k] & ~255u) * rs; e[k] = __expf(v - mx); den += e[k];
            const unsigned pos = 255u - (L[k] & 255u); const unsigned i = pos >> 4, j = pos & 15u;
            id[k] = (unsigned short)((unsigned)LI[i * 512 + tid] * 128u + (unsigned)LI[(16 + j) * 512 + tid]);
        }
        const float inv = __builtin_amdgcn_rcpf(den);
        u32x4 i0, i1;
        i0[0] = id[0] | (id[1] << 16); i0[1] = id[2] | (id[3] << 16); i0[2] = id[4] | (id[5] << 16); i0[3] = id[6] | (id[7] << 16);
        i1[0] = id[8] | (id[9] << 16); i1[1] = id[10] | (id[11] << 16); i1[2] = id[12] | (id[13] << 16); i1[3] = id[14] | (id[15] << 16);
        u32x4* ip = (u32x4*)(IDX + (size_t)task * 16); ip[0] = i0; ip[1] = i1;
        f32x4* gp = (f32x4*)(GATE + (size_t)task * 16);
#pragma unroll
        for (int k4 = 0; k4 < 4; ++k4) gp[k4] = (f32x4){e[4 * k4] * inv, e[4 * k4 + 1] * inv, e[4 * k4 + 2] * inv, e[4 * k4 + 3] * inv};
    }
}

__device__ __forceinline__ float gelu_tanh(float x) { const float u = 0.7978845608028654f * (x + 0.044715f * x * x * x); return 0.5f * x * (1.0f + tanhf_(u)); }
__device__ __forceinline__ unsigned xcc_id() { return (unsigned)__builtin_amdgcn_s_getreg((3 << 11) | 20) & 7u; }
constexpr int GA_TC = 32, GA_NCH = MTOK / GA_TC;
__device__ __forceinline__ void dec16(const u32x4 q, float (&o)[16]) {
#pragma unroll
    for (int w = 0; w < 4; ++w) { const f32x2 lo = __builtin_amdgcn_cvt_pk_f32_fp8((int)q[w], false), hi = __builtin_amdgcn_cvt_pk_f32_fp8((int)q[w], true);
        o[4 * w] = lo[0]; o[4 * w + 1] = lo[1]; o[4 * w + 2] = hi[0]; o[4 * w + 3] = hi[1]; }
}
struct GIdx { u32x4 a, b; };
__device__ __forceinline__ GIdx g_ldidx(const unsigned short* IDX, int t, int r8) { const u32x4* ip = (const u32x4*)(IDX + (size_t)t * 128 + 16 * r8); GIdx r; r.a = ip[0]; r.b = ip[1]; return r; }
__device__ __forceinline__ void g_issue8(const unsigned char* TBs, unsigned lo, const u32x4 ix, u32x4 (&q)[8]) {
#pragma unroll
    for (int i = 0; i < 8; ++i) { const unsigned w = ix[i >> 1]; const unsigned e = (i & 1) ? (w >> 16) : (w & 0xffffu); q[i] = *(const u32x4*)(TBs + (e * 128u + lo)); }
}
struct GSide { u32x4 a, b, c, d; };
template <int PH> __device__ __forceinline__ GSide g_ldside(const Args& a, int t, int j, int m, int r8) {
    GSide r;
    if (PH == 0) { const u32x4* xp = (const u32x4*)((const h16*)(a.ws + O_H1B) + (size_t)t * 1024 + 128 * j + 16 * m); r.a = xp[0]; r.b = xp[1]; r.c = r.a; r.d = r.b; }
    else { const u32x4* cp = (const u32x4*)((const float*)(a.ws + O_COEF) + (size_t)t * 128 + 16 * r8); r.a = cp[0]; r.b = cp[1]; r.c = cp[2]; r.d = cp[3]; }
    return r;
}
template <int PH, int HALF> __device__ __forceinline__ void g_half(u32x4 (&q)[8], const GSide& sd, float (&pa)[16]) {
    if (PH == 0) {
        float x[16];
#pragma unroll
        for (int k = 0; k < 8; ++k) { const h16x8 xa = __builtin_bit_cast(h16x8, sd.a), xb = __builtin_bit_cast(h16x8, sd.b); x[k] = (float)xa[k]; x[8 + k] = (float)xb[k]; }
#pragma unroll
        for (int i = 0; i < 8; ++i) { float d[16]; dec16(q[i], d); float s0 = 0.f, s1 = 0.f;
#pragma unroll
            for (int k = 0; k < 8; ++k) { s0 += x[2 * k] * d[2 * k]; s1 += x[2 * k + 1] * d[2 * k + 1]; }
            pa[8 * HALF + i] = s0 + s1; }
    } else {
#pragma unroll
        for (int i = 0; i < 8; ++i) { float d[16]; dec16(q[i], d);
            const float cf = __uint_as_float(HALF == 0 ? (i < 4 ? sd.a[i & 3] : sd.b[i & 3]) : (i < 4 ? sd.c[i & 3] : sd.d[i & 3]));
#pragma unroll
            for (int k = 0; k < 16; ++k) pa[k] += cf * d[k];
            if (i + 1 < 8) asm volatile("" : "+v"(q[i + 1][0]), "+v"(q[i + 1][1]), "+v"(q[i + 1][2]), "+v"(q[i + 1][3]));
        }
    }
}
template <int PH> __device__ __forceinline__ void g_finish(const Args& a, int t, int j, int lane, float (&p)[16]) {
    const int m = lane & 7, r8 = lane >> 3;
    float q8[8], q4[4], q2[2];
    if (PH == 0) {
#pragma unroll
        for (int i = 0; i < 8; ++i) { const float keep = (lane & 4) ? p[i + 8] : p[i], send = (lane & 4) ? p[i] : p[i + 8]; q8[i] = keep + xhm_(send); }
#pragma unroll
        for (int i = 0; i < 4; ++i) { const float keep = (lane & 2) ? q8[i + 4] : q8[i], send = (lane & 2) ? q8[i] : q8[i + 4]; q4[i] = keep + dpp_<0x4E>(send); }
#pragma unroll
        for (int i = 0; i < 2; ++i) { const float keep = (lane & 1) ? q4[i + 2] : q4[i], send = (lane & 1) ? q4[i] : q4[i + 2]; q2[i] = keep + dpp_<0xB1>(send); }
        *(f32x2*)((float*)(a.ws + O_PART) + ((size_t)j * MTOK + t) * 128 + 16 * r8 + 2 * m) = (f32x2){q2[0], q2[1]};
    } else {
#pragma unroll
        for (int i = 0; i < 8; ++i) { const float keep = (lane & 32) ? p[i + 8] : p[i], send = (lane & 32) ? p[i] : p[i + 8]; q8[i] = keep + x32_(send, lane); }
#pragma unroll
        for (int i = 0; i < 4; ++i) { const float keep = (lane & 16) ? q8[i + 4] : q8[i], send = (lane & 16) ? q8[i] : q8[i + 4]; q4[i] = keep + x16_(send, lane); }
#pragma unroll
        for (int i = 0; i < 2; ++i) { const float keep = (lane & 8) ? q4[i + 2] : q4[i], send = (lane & 8) ? q4[i] : q4[i + 2]; q2[i] = keep + x8_(send); }
        const int col = 128 * j + 16 * m + 2 * r8;
        float* op = a.out + (size_t)t * 1024 + col;
        f32x2 hv = *(const f32x2*)op; hv[0] += q2[0]; hv[1] += q2[1];
        *(f32x2*)op = hv;
        *(h16x2*)((h16*)(a.ws + O_H2B) + (size_t)t * 1024 + col) = (h16x2){(h16)hv[0], (h16)hv[1]};
        const float ss = wave_sum(hv[0] * hv[0] + hv[1] * hv[1]);
        if (lane == 0) ((float*)(a.ws + O_SS2))[(size_t)t * 8 + j] = ss;
    }
}
template <int PH>
__device__ __forceinline__ void phase_gather(const Args& a, int cset) {
    const int tid = tid_(), lane = tid & 63, m = lane & 7, r8 = lane >> 3;
    unsigned* ctr = (unsigned*)(a.ws + O_CTR) + cset * 8 * 64;
    const unsigned short* IDX = (const unsigned short*)(a.ws + O_IDX);
    const unsigned j0 = xcc_id();
    for (unsigned dj = 0; dj < 8; ++dj) {
        const unsigned j = (j0 + dj) & 7u;
        const unsigned char* TB = a.ws + (PH ? O_V8 : O_U8) + (size_t)j * 16384 * 128; const unsigned lo16 = 16u * (unsigned)m;
        for (;;) {
            unsigned c = 0; if (lane == 0) c = __hip_atomic_fetch_add(ctr + j * 64, 1u, __ATOMIC_RELAXED, __HIP_MEMORY_SCOPE_AGENT);
            c = (unsigned)__builtin_amdgcn_readfirstlane((int)c);
            if (c >= (unsigned)GA_NCH) break;
            const int t0 = c * GA_TC;
            u32x4 qa[8], qb[8]; GSide sd, sn; GIdx ix, ixn;
            ix = g_ldidx(IDX, t0, r8); g_issue8(TB, lo16, ix.a, qa); sd = g_ldside<PH>(a, t0, j, m, r8);
#pragma unroll 1
            for (int ti = 0; ti < GA_TC; ++ti) {
                const int t = t0 + ti, tn = (ti + 1 < GA_TC) ? t + 1 : t;
                g_issue8(TB, lo16, ix.b, qb); ixn = g_ldidx(IDX, tn, r8); sn = g_ldside<PH>(a, tn, j, m, r8);
                float p[16];
                if (PH == 1) {
#pragma unroll
                    for (int k = 0; k < 16; ++k) p[k] = 0.f;
                }
                g_half<PH, 0>(qa, sd, p);
                g_issue8(TB, lo16, ixn.a, qa);
                g_half<PH, 1>(qb, sd, p);
                g_finish<PH>(a, t, j, lane, p);
                ix = ixn; sd = sn;
            }
        }
    }
}
__device__ __forceinline__ void phase_coef(const Args& a) {
    const int tid = tid_();
    const float* PART = (const float*)(a.ws + O_PART); const unsigned short* IDX = (const unsigned short*)(a.ws + O_IDX);
    const float* GATE = (const float*)(a.ws + O_GATE); const float* RS1 = (const float*)(a.ws + O_RS1);
    const float* USC = (const float*)(a.ws + O_USC); const float* VSC = (const float*)(a.ws + O_VSC); float* COEF = (float*)(a.ws + O_COEF);
    for (int i = blockIdx.x * NTHREADS + tid; i < MTOK * 128; i += gridDim.x * NTHREADS) {
        float s = 0.f;
#pragma unroll
        for (int j = 0; j < 8; ++j) s += PART[(size_t)j * MTOK * 128 + i];
        const unsigned e = IDX[i];
        COEF[i] = GATE[i] * gelu_tanh(RS1[i >> 7] * USC[e] * s) * VSC[e];
    }
}

__device__ __forceinline__ void phase_final(const Args& a) {
    const int tid = tid_(), lane = tid & 63, wave = tid >> 6;
    const int gw = blockIdx.x * NWAVES + wave, NGW = gridDim.x * NWAVES;
    const float* part = (const float*)(a.ws + O_PART3); const float* fg = a.in[28];
    f32x4 g4[4];
#pragma unroll
    for (int j = 0; j < 4; ++j) g4[j] = *((const f32x4*)fg + lane + 64 * j);
    for (int r = gw; r < MTOK; r += NGW) {
        float s = (lane < 16) ? part[(size_t)r * 16 + lane] : 0.f;
        s = wave_sum(s);
        const float rs = rsqrtf(s * (1.f / 1024.f) + NORM_EPS);
        f32x4* xr = (f32x4*)(a.out + (size_t)r * 1024) + lane;
#pragma unroll
        for (int j = 0; j < 4; ++j) xr[64 * j] = xr[64 * j] * rs * g4[j];
    }
}

constexpr int NPHASE = 19;
__global__ void __launch_bounds__(NTHREADS, 2) mk(Args a) {
    extern __shared__ __attribute__((aligned(16))) unsigned char smem[];
    LAS unsigned char* lds = (LAS unsigned char*)smem;
    unsigned char* ws = a.ws;
#if ONE_LAUNCH
    cg::grid_group grid = cg::this_grid();
    volatile LAS unsigned* bst = (volatile LAS unsigned*)(lds + 131072);
    if (threadIdx.x < 2) bst[threadIdx.x] = 0u;
    __syncthreads();
    const XcdBarrier xbar = xcd_barrier_post((unsigned*)(a.ws + O_BAR), bst);
    bool first_sync = true;
#define SYNC() do { if (first_sync) { grid.sync(); first_sync = false; } else xcd_barrier(xbar); } while (0)
#else
#define SYNC() do {} while (0)
#endif
#define IN(k) (a.ph_lo <= (k) && (k) < a.ph_hi)
#define SEAM(k) do { if (IN(k) && IN((k) + 1)) SYNC(); } while (0)
#define REPS(k) ((((REP_MASK) >> (k)) & 1u) ? 2 : 1)
    const int G = gridDim.x, bid = blockIdx.x;
    if (IN(0)) for (int rep = 0; rep < REPS(0); ++rep) { if (rep) SYNC(); phase_prep(a, lds); } SEAM(0);
    if (IN(1)) for (int rep = 0; rep < REPS(1); ++rep) { if (rep) SYNC(); pg8::Gemm g{(const h16*)(ws + O_XN), (const h16*)(ws + O_WIN), MTOK, NIN, 1024}; pg8::StaticOrder S; S.init(MTOK, NIN, G, bid);
        EpiZ E{(h16*)(ws + O_ZC), (h16*)(ws + O_ZR), (h16*)(ws + O_ZG)}; pg8::gemm_phase(lds, g, S, E); } SEAM(1);
    if (IN(2)) for (int rep = 0; rep < REPS(2); ++rep) { if (rep) SYNC(); phase_conv(a); phase_rwkv_prep(a); } SEAM(2);
    if (IN(3)) for (int rep = 0; rep < REPS(3); ++rep) { if (rep) SYNC(); pg8::Gemm g{(const h16*)(ws + O_APR), (const h16*)(ws + O_WLR), MTOK, 1536, 256}; pg8::StaticOrder S; S.init(MTOK, 1536, G, bid);
        h16* R = (h16*)a.out; h16* KS = R + (size_t)MTOK * 512; h16* KK = KS + (size_t)2 * MTOK * 512;
        EpiLR E{a.in[7], a.in[9], a.in[13], (h16*)(ws + O_WD), KS, (h16*)(ws + O_BD), (h16*)(ws + O_GG), KK}; pg8::gemm_phase(lds, g, S, E); } SEAM(3);
    if (IN(4)) for (int rep = 0; rep < REPS(4); ++rep) { if (rep) SYNC(); phase_ut_pre(a, lds); }
    SEAM(5);
    if (IN(6)) for (int rep = 0; rep < REPS(6); ++rep) { if (rep) SYNC(); phase_ut_seq(a, lds); } SEAM(6);
    if (IN(7)) for (int rep = 0; rep < REPS(7); ++rep) { if (rep) SYNC(); phase_rwkv_post(a); } SEAM(7);
    if (IN(8)) for (int rep = 0; rep < REPS(8); ++rep) { if (rep) SYNC(); pg8::Gemm g{(const h16*)(ws + O_CA), (const h16*)(ws + O_WA), MTOK, 1024, 512}; pg8::StaticOrder S; S.init(MTOK, 1024, G, bid);
        EpiYA E{(const h16*)(ws + O_ZG), a.out}; pg8::gemm_phase(lds, g, S, E); } SEAM(8);
    if (IN(9)) for (int rep = 0; rep < REPS(9); ++rep) { if (rep) SYNC(); pg8::Gemm g{(const h16*)(ws + O_YB), (const h16*)(ws + O_WB), MTOK, 1024, 512}; pg8::StaticOrder S; S.init(MTOK, 1024, G, bid);
        EpiYB E{(const h16*)(ws + O_ZG), a.out, (h16*)(ws + O_MERGED)}; pg8::gemm_phase(lds, g, S, E); } SEAM(9);
    if (IN(10)) for (int rep = 0; rep < REPS(10); ++rep) { if (rep) SYNC(); pg8::Gemm g{(const h16*)(ws + O_MERGED), (const h16*)(ws + O_WO), MTOK, 1024, 1024}; pg8::StaticOrder S; S.init(MTOK, 1024, G, bid);
        EpiH1 E{a.in[0], a.out, (h16*)(ws + O_H1B), (float*)(ws + O_PART1)}; pg8::gemm_phase(lds, g, S, E); } SEAM(10);
    if (IN(11)) for (int rep = 0; rep < REPS(11); ++rep) { if (rep) SYNC(); pg8::Gemm g{(const h16*)(ws + O_H1B), (const h16*)(ws + O_WS), MTOK, 2048, 1024}; pg8::StaticOrder S; S.init(MTOK, 2048, G, bid);
        EpiF16 E{(h16*)(ws + O_SCORES), 2048}; pg8::gemm_phase(lds, g, S, E); } SEAM(11);
    if (IN(12)) for (int rep = 0; rep < REPS(12); ++rep) { if (rep) SYNC(); phase_topk(a, lds); } SEAM(12);
    if (IN(13)) for (int rep = 0; rep < REPS(13); ++rep) { if (rep) SYNC(); phase_gather<0>(a, 2 * rep); } SEAM(13);
    if (IN(14)) for (int rep = 0; rep < REPS(14); ++rep) { if (rep) SYNC(); phase_coef(a); } SEAM(14);
    if (IN(15)) for (int rep = 0; rep < REPS(15); ++rep) { if (rep) SYNC(); phase_gather<1>(a, 1); } SEAM(15);
    if (IN(16)) for (int rep = 0; rep < REPS(16); ++rep) { if (rep) SYNC(); pg8::Gemm g{(const h16*)(ws + O_P16), (const h16*)(ws + O_WP), MTOK, 1024, 256}; pg8::StaticOrder S; S.init(MTOK, 1024, G, bid);
        EpiF16 E{(h16*)(ws + O_PP), 1024}; pg8::gemm_phase(lds, g, S, E); } SEAM(16);
    if (IN(17)) for (int rep = 0; rep < REPS(17); ++rep) { if (rep) SYNC(); pg8::Gemm g{(const h16*)(ws + O_H2B), (const h16*)(ws + O_WG), MTOK, 1024, 1024}; pg8::StaticOrder S; S.init(MTOK, 1024, G, bid);
        EpiGate E{a.out, (const h16*)(ws + O_PP), (const float*)(ws + O_SS2), (float*)(ws + O_PART3)}; pg8::gemm_phase(lds, g, S, E); } SEAM(17);
    if (IN(18)) for (int rep = 0; rep < REPS(18); ++rep) { if (rep) SYNC(); phase_final(a); }
}

extern "C" void kernel_launch(void* const* d_in, const int* in_sizes, int n_in, void* d_out, int out_size, void* d_ws, size_t ws_size, hipStream_t stream) {
    static int ready = 0;
    if (!ready) {
        if (n_in != 29 || ws_size < WS_END) { fprintf(stderr, "kernel_launch: unexpected n_in %d / ws %zu (need %zu)\n", n_in, ws_size, (size_t)WS_END); ready = -1; return; }
        if (hipFuncSetAttribute((const void*)mk, hipFuncAttributeMaxDynamicSharedMemorySize, LDS_BYTES) != hipSuccess) { fprintf(stderr, "hipFuncSetAttribute failed\n"); ready = -1; return; }
        ready = 1;
    }
    if (ready < 0) return;
    Args a{};
    for (int i = 0; i < 29; ++i) a.in[i] = (const float*)d_in[i];
    a.out = (float*)d_out; a.ws = (unsigned char*)d_ws;
#if ONE_LAUNCH
    (void)hipMemsetAsync((unsigned char*)d_ws + O_BAR, 0, 16384, stream);
    a.ph_lo = 0; a.ph_hi = NPHASE;
    void* args[] = {&a};
    hipLaunchCooperativeKernel((const void*)mk, dim3(NBLK), dim3(NTHREADS), args, LDS_BYTES, stream);
#else
    const int phases[] = {0, 1, 2, 3, 4, 5, 6, 7, 8, 9, 10, 11, 12, 13, 14, 15, 16, 17, 18};
    for (int ph : phases) { a.ph_lo = ph; a.ph_hi = ph + 1; hipLaunchKernelGGL(mk, dim3(NBLK), dim3(NTHREADS), LDS_BYTES, stream, a); }
#endif
}
```

```cpp
#include <hip/hip_runtime.h>
#include <hip/hip_cooperative_groups.h>
#include <cstdio>
namespace cg = cooperative_groups;

#ifndef REP_MASK
#define REP_MASK 0u
#endif
#ifndef ONE_LAUNCH
#define ONE_LAUNCH 1
#endif

#define LAS __attribute__((address_space(3)))
typedef _Float16 h16;
typedef _Float16 h16x8 __attribute__((ext_vector_type(8)));
typedef _Float16 h16x4 __attribute__((ext_vector_type(4)));
typedef _Float16 h16x2 __attribute__((ext_vector_type(2)));
typedef float f32x4 __attribute__((ext_vector_type(4)));
typedef float f32x2 __attribute__((ext_vector_type(2)));
typedef unsigned u32x4 __attribute__((ext_vector_type(4)));
typedef unsigned u32x2 __attribute__((ext_vector_type(2)));

constexpr int MTOK = 65536, DM = 1024, SEQ = 8192, NB = 8;
constexpr int NIN = 5376;
constexpr int NTHREADS = 512, NWAVES = 8, NBLK = 256;
constexpr int LDS_BYTES = 131072 + 64;
constexpr float NORM_EPS = 1e-6f;

constexpr size_t MiB = 1u << 20;
constexpr size_t O_WIN = 0;
constexpr size_t O_WA = O_WIN + (size_t)5376 * 1024 * 2;
constexpr size_t O_WB = O_WA + 1 * MiB;
constexpr size_t O_WO = O_WB + 1 * MiB;
constexpr size_t O_WG = O_WO + 2 * MiB;
constexpr size_t O_WP = O_WG + 2 * MiB;
constexpr size_t O_WLR = O_WP + MiB / 2;
constexpr size_t O_WS = O_WLR + 3 * MiB / 4;
constexpr size_t O_U16 = O_WS + 4 * MiB;
constexpr size_t O_V16 = O_U16 + 32 * MiB;
constexpr size_t O_P16 = O_V16 + 32 * MiB;
constexpr size_t O_PART1 = O_P16 + 32 * MiB;
constexpr size_t O_PART3 = O_PART1 + 4 * MiB;
constexpr size_t O_RS1 = O_PART3 + 4 * MiB;
constexpr size_t O_RS2 = O_RS1 + MiB / 4;
constexpr size_t O_XN = O_RS2 + MiB / 4;
constexpr size_t O_ZC = O_XN + 128 * MiB;
constexpr size_t O_ZR = O_ZC + 192 * MiB;
constexpr size_t O_ZG = O_ZR + 224 * MiB;
constexpr size_t O_SS2 = O_ZG + 256 * MiB;
constexpr size_t O_USC = O_SS2 + 2 * MiB;
constexpr size_t O_VSC = O_USC + 65536;
constexpr size_t O_CTR = O_VSC + 65536;
constexpr size_t O_BAR = O_CTR + 8192;
constexpr size_t WS_END = O_BAR + 16384;
constexpr size_t O_U8 = O_U16;
constexpr size_t O_V8 = O_U16 + 16 * MiB;
constexpr size_t O_PART = O_ZG;
constexpr size_t O_COEF = O_ZR + 48 * MiB;
constexpr size_t O_CA = O_XN;
constexpr size_t O_APR = O_XN + 64 * MiB;
constexpr size_t O_H1B = O_XN;
constexpr size_t O_WD = O_ZC;
constexpr size_t O_BD = O_ZC + 64 * MiB;
constexpr size_t O_GG = O_ZC + 128 * MiB;
constexpr size_t O_MERGED = O_ZC;
constexpr size_t O_H2B = O_ZC;
constexpr size_t O_PQ = O_ZR;
constexpr size_t O_SST = O_ZR + 64 * MiB;
constexpr size_t O_Y = O_ZR + 96 * MiB;
constexpr size_t O_YB = O_ZR + 160 * MiB;
constexpr size_t O_IDX = O_ZR;
constexpr size_t O_GATE = O_ZR + 16 * MiB;
constexpr size_t O_PP = O_ZR + 64 * MiB;
constexpr size_t O_SCORES = O_ZG;

struct Args {
    const float* in[29];
    float* out;
    unsigned char* ws;
    int ph_lo, ph_hi;
};

__device__ __forceinline__ int tid_() { int t = threadIdx.x; asm volatile("" : "+v"(t)); return t; }
__device__ __forceinline__ float sigmoidf_(float x) { return __builtin_amdgcn_rcpf(1.0f + __expf(-x)); }
template <int CTRL> __device__ __forceinline__ float dpp_(float v) { return __builtin_bit_cast(float, __builtin_amdgcn_update_dpp(0, __builtin_bit_cast(int, v), CTRL, 0xF, 0xF, true)); }
__device__ __forceinline__ float x32_(float v, int lane) { const auto r = __builtin_amdgcn_permlane32_swap(__builtin_bit_cast(unsigned, v), __builtin_bit_cast(unsigned, v), false, false); return __builtin_bit_cast(float, (lane & 32) ? r[0] : r[1]); }
__device__ __forceinline__ float x16_(float v, int lane) { const auto r = __builtin_amdgcn_permlane16_swap(__builtin_bit_cast(unsigned, v), __builtin_bit_cast(unsigned, v), false, false); return __builtin_bit_cast(float, (lane & 16) ? r[0] : r[1]); }
__device__ __forceinline__ float x8_(float v) { return dpp_<0x128>(v); }
__device__ __forceinline__ float xhm_(float v) { return dpp_<0x141>(v); }
__device__ __forceinline__ float wave_sum(float v) {
    const int lane = threadIdx.x & 63;
    v += dpp_<0xB1>(v); v += dpp_<0x4E>(v); v += dpp_<0x141>(v); v += dpp_<0x140>(v);
    v += x16_(v, lane); v += x32_(v, lane);
    return v;
}
__device__ __forceinline__ h16x8 pack8(f32x4 a, f32x4 b) {
    h16x8 r;
    r[0] = (h16)a[0]; r[1] = (h16)a[1]; r[2] = (h16)a[2]; r[3] = (h16)a[3];
    r[4] = (h16)b[0]; r[5] = (h16)b[1]; r[6] = (h16)b[2]; r[7] = (h16)b[3];
    return r;
}
__device__ __forceinline__ h16x4 pack4(f32x4 a) {
    h16x4 r; r[0] = (h16)a[0]; r[1] = (h16)a[1]; r[2] = (h16)a[2]; r[3] = (h16)a[3]; return r;
}

#define XB_TMO      128
#define XB_XCNT(j)  (256  + 64 * (j))
#define XB_XSUB(j)  (1280 + 64 * (j))
#define XB_XGEN(j)  (2304 + 64 * (j))
#define XB_TOP      3328
#define XB_TOPGEN   3392
#define XCD_BAR_WORDS 3456
#define XB_SPIN_CAP (1u << 18)

__device__ __forceinline__ unsigned xb_ld(unsigned* p)              { return __hip_atomic_load(p, __ATOMIC_RELAXED, __HIP_MEMORY_SCOPE_AGENT); }
__device__ __forceinline__ unsigned xb_add(unsigned* p, unsigned v) { return __hip_atomic_fetch_add(p, v, __ATOMIC_RELAXED, __HIP_MEMORY_SCOPE_AGENT); }
__device__ __forceinline__ unsigned xb_xcc_id() { return (unsigned)__builtin_amdgcn_s_getreg((3 << 11) | 20) & 0xFu; }
#define XB_SPIN(cond, bar) do { unsigned _sp = 0; while (cond) { __builtin_amdgcn_s_sleep(1); \
    if ((++_sp & 255u) == 0u) { if (xb_ld(&(bar)[XB_TMO])) break; if (_sp > XB_SPIN_CAP) { atomicAdd(&(bar)[XB_TMO], 1u); break; } } } } while (0)

struct XcdBarrier {
    unsigned* bar; unsigned x;
    volatile LAS unsigned* st;
};

__device__ __forceinline__ XcdBarrier xcd_barrier_post(unsigned* bar, volatile LAS unsigned* st) {
    XcdBarrier b; b.bar = bar; b.x = xb_xcc_id(); b.st = st;
    if (threadIdx.x == 0) (void)xb_add(&bar[XB_XCNT(b.x)], 1u);
    return b;
}
__device__ __forceinline__ void xcd_barrier_complete(unsigned* bar, unsigned x, unsigned& nloc, unsigned& nx) {
    const unsigned G = gridDim.x * gridDim.y * gridDim.z;
    unsigned sum, cnt, mine, sp = 0u;
    for (;;) {
        sum = 0u; cnt = 0u; mine = 0u;
#pragma unroll
        for (unsigned j = 0; j < 16; ++j) { const unsigned c = xb_ld(&bar[XB_XCNT(j)]); sum += c; cnt += (c > 0u) ? 1u : 0u; mine = (j == x) ? c : mine; }
        if (sum == G) break;
        __builtin_amdgcn_s_sleep(1);
        if ((++sp & 255u) == 0u) { if (xb_ld(&bar[XB_TMO])) break; if (sp > XB_SPIN_CAP) { atomicAdd(&bar[XB_TMO], 1u); break; } }
    }
    nloc = mine > 0u ? mine : 1u; nx = cnt > 0u ? cnt : 1u;
}

__device__ __forceinline__ void xcd_barrier(const XcdBarrier& b) {
    asm volatile("s_waitcnt vmcnt(0)" ::: "memory");
    __syncthreads();
    if (threadIdx.x == 0) {
        unsigned* bar = b.bar;
        __builtin_amdgcn_s_waitcnt(0);
        unsigned nloc = b.st[0], nx = b.st[1];
        if (nloc == 0u) { xcd_barrier_complete(bar, b.x, nloc, nx); b.st[0] = nloc; b.st[1] = nx; }
        const unsigned old = xb_add(&bar[XB_XSUB(b.x)], 1u);
        const unsigned gen = old / nloc;
        if (old + 1u == (gen + 1u) * nloc) {
            __builtin_amdgcn_fence(__ATOMIC_RELEASE, "agent");
            asm volatile("s_waitcnt vmcnt(0)" ::: "memory");
            const unsigned og = xb_add(&bar[XB_TOP], 1u);
            const unsigned tg = og / nx;
            if (og + 1u == (tg + 1u) * nx) xb_add(&bar[XB_TOPGEN], 1u);
            else XB_SPIN(xb_ld(&bar[XB_TOPGEN]) == tg, bar);
            __builtin_amdgcn_fence(__ATOMIC_ACQUIRE, "agent");
            xb_add(&bar[XB_XGEN(b.x)], 1u);
            asm volatile("s_waitcnt vmcnt(0)" ::: "memory");
        } else {
            XB_SPIN(xb_ld(&bar[XB_XGEN(b.x)]) == gen, bar);
            __builtin_amdgcn_fence(__ATOMIC_ACQUIRE, "agent");
            asm volatile("s_waitcnt vmcnt(0)" ::: "memory");
        }
    }
    __syncthreads();
}


namespace pg8 {
constexpr int BM = 256, BK = 64, HALF = 128, HTB = HALF * BK * 2, STAGE_BYTES = 8 * HTB, NXCD = 8, WGM = 8;
__device__ __forceinline__ int lds_byte(int r, int c) { const int st = (r >> 4) * 2 + (c >> 5), rr = r & 15, cc = c & 31, ob = rr * 64 + cc * 2; return st * 1024 + (ob ^ (((ob >> 9) & 1) << 5)); }
__device__ __forceinline__ void stage_rc(int b, int& R, int& C) { const int st = b / 1024, sb = b % 1024, swz = sb ^ (((sb >> 9) & 1) << 5); R = (st >> 1) * 16 + swz / 64; C = (st & 1) * 32 + (swz % 64) / 2; }
__device__ __forceinline__ int perm32(int rho) { const int n = rho >> 4, i = rho & 15; return 8 * (i >> 2) + 4 * n + (i & 3); }

struct Unit { int pm, pn; };
struct Gemm { const h16* A; const h16* Bt; int M, N, K; };

struct StaticOrder {
    int nM, nN, nwg, G, c;
    __device__ void init(int M, int N, int G_, int c_) { nM = M / BM; nN = N / BM; nwg = nM * nN; G = G_; c = c_; }
    __device__ bool next(int i, Unit& u) const {
        const long L = (long)i * G + c; if (L >= nwg) return false;
        int wgid = (int)L; { const int q = nwg / NXCD, r = nwg % NXCD, xcd = wgid % NXCD, off = wgid / NXCD; wgid = (xcd < r ? xcd * (q + 1) : r * (q + 1) + (xcd - r) * q) + off; }
        const int nig = WGM * nN, gid = wgid / nig, fm = gid * WGM, gsz = (nM - fm) < WGM ? (nM - fm) : WGM;
        u.pm = fm + ((wgid % nig) % gsz); u.pn = (wgid % nig) / gsz; return true;
    }
};

template <class Epi>
__device__ __forceinline__ void gemm_phase(LAS unsigned char* lds, const Gemm g, const StaticOrder& S, const Epi& E) {
    const int tid = tid_(), wid = __builtin_amdgcn_readfirstlane(tid >> 6), lane = tid & 63, wr = wid >> 2, wc = wid & 3, fr = lane & 15, fq = lane >> 4;
    const int K = g.K, nt = K / BK;
    unsigned voffA[2], voffB[2];
#pragma unroll
    for (int i = 0; i < 2; ++i) { int R, C; stage_rc(tid * 16 + i * 8192, R, C); const int Rb = (R & ~31) + perm32(R & 31);
        voffA[i] = (unsigned)(R * K + C) * 2u; voffB[i] = (unsigned)(Rb * K + C) * 2u; }
    const size_t kstep = (size_t)(BK * 2);
    const size_t hstep = (size_t)HALF * K * 2;
    const size_t tstep = 2 * hstep;
    const unsigned ldsw = (unsigned)wid * 1024u;
    const int aoff = lds_byte(wr * 64 + fr, fq * 8), boff = lds_byte(wc * 32 + fr, fq * 8);
#define PG8_SA(b, h) (((b) * 2 + (h)) * HTB)
#define PG8_SB(b, h) ((4 + (b) * 2 + (h)) * HTB)
#define PG8_STAGE(bufoff, gbase, voff) do { _Pragma("unroll") for (int _i = 0; _i < 2; ++_i) \
        __builtin_amdgcn_global_load_lds((const unsigned*)((const char*)(gbase) + (voff)[_i]), (LAS unsigned*)(lds + (bufoff) + ldsw + _i * 8192), 16, 0, 0); } while (0)
#define PG8_LDA(dst, b, h) do { _Pragma("unroll") for (int m = 0; m < 4; ++m) _Pragma("unroll") for (int k = 0; k < 2; ++k) dst[m][k] = *(const LAS h16x8*)(lds + PG8_SA(b, h) + aoff + m * 2048 + k * 1024); } while (0)
#define PG8_LDB(dst, b, h) do { _Pragma("unroll") for (int n = 0; n < 2; ++n) _Pragma("unroll") for (int k = 0; k < 2; ++k) dst[n][k] = *(const LAS h16x8*)(lds + PG8_SB(b, h) + boff + n * 2048 + k * 1024); } while (0)
#define PG8_MMA(ai, bj, At, Bt) do { __builtin_amdgcn_s_setprio(1); _Pragma("unroll") for (int m = 0; m < 4; ++m) _Pragma("unroll") for (int n = 0; n < 2; ++n) _Pragma("unroll") for (int k = 0; k < 2; ++k) \
        acc[ai][bj][m][n] = __builtin_amdgcn_mfma_f32_16x16x32_f16(Bt[n][k], At[m][k], acc[ai][bj][m][n], 0, 0, 0); __builtin_amdgcn_s_setprio(0); } while (0)
#define PG8_WAIT_V(n) asm volatile("s_waitcnt vmcnt(" #n ")" ::: "memory")
#define PG8_WAIT_L(n) asm volatile("s_waitcnt lgkmcnt(" #n ")" ::: "memory")
#define PG8_BAR __builtin_amdgcn_s_barrier()
#define PG8_SCHED __builtin_amdgcn_sched_barrier(0)
    Unit cur, nxt; int ui = 0;
    if (!S.next(0, cur)) return;
    f32x4 acc[2][2][4][2];
#pragma unroll
    for (int a = 0; a < 2; ++a)
#pragma unroll
        for (int b = 0; b < 2; ++b)
#pragma unroll
            for (int m = 0; m < 4; ++m)
#pragma unroll
                for (int n = 0; n < 2; ++n) acc[a][b][m][n] = (f32x4){0.f, 0.f, 0.f, 0.f};
    h16x8 At[4][2], B0[2][2], B1[2][2];
    const char* cA = (const char*)g.A + (size_t)cur.pm * tstep; const char* cB = (const char*)g.Bt + (size_t)cur.pn * tstep;
    PG8_STAGE(PG8_SB(0, 0), cB, voffB); PG8_STAGE(PG8_SB(0, 1), cB + hstep, voffB); PG8_STAGE(PG8_SA(0, 0), cA, voffA); PG8_STAGE(PG8_SA(0, 1), cA + hstep, voffA);
    if (wr == 1) PG8_BAR;
    PG8_WAIT_V(2); PG8_BAR;
    PG8_STAGE(PG8_SB(1, 0), cB + kstep, voffB); PG8_STAGE(PG8_SA(1, 0), cA + kstep, voffA); PG8_STAGE(PG8_SB(1, 1), cB + hstep + kstep, voffB);
    PG8_WAIT_V(6); PG8_BAR;
    for (;;) {
        const bool has_next = S.next(ui + 1, nxt);
        const char* nA = has_next ? (const char*)g.A + (size_t)nxt.pm * tstep : cA; const char* nB = has_next ? (const char*)g.Bt + (size_t)nxt.pn * tstep : cB;
        for (int t = 0; t < nt; t += 2) {
            const bool last = (t == nt - 2);
            const char* a1 = cA + (size_t)(t + 1) * kstep;
            const char* a2 = last ? nA : cA + (size_t)(t + 2) * kstep; const char* b2 = last ? nB : cB + (size_t)(t + 2) * kstep;
            const char* a3 = a2 + kstep; const char* b3 = b2 + kstep;
            PG8_LDB(B0, 0, 0); PG8_LDB(B1, 0, 1); PG8_SCHED; PG8_LDA(At, 0, 0); PG8_STAGE(PG8_SA(1, 1), a1 + hstep, voffA);
            PG8_WAIT_V(8); PG8_WAIT_L(0); PG8_BAR; PG8_MMA(0, 0, At, B0); PG8_MMA(0, 1, At, B1); PG8_BAR; PG8_SCHED;
            PG8_LDA(At, 0, 1); PG8_STAGE(PG8_SB(0, 0), b2, voffB); PG8_STAGE(PG8_SB(0, 1), b2 + hstep, voffB); PG8_STAGE(PG8_SA(0, 0), a2, voffA);
            PG8_WAIT_V(8); PG8_WAIT_L(0); PG8_BAR; PG8_MMA(1, 0, At, B0); PG8_MMA(1, 1, At, B1); PG8_BAR; PG8_SCHED;
            PG8_LDB(B0, 1, 0); PG8_LDB(B1, 1, 1); PG8_SCHED; PG8_LDA(At, 1, 0); PG8_STAGE(PG8_SA(0, 1), a2 + hstep, voffA);
            PG8_WAIT_V(8); PG8_WAIT_L(0); PG8_BAR; PG8_MMA(0, 0, At, B0); PG8_MMA(0, 1, At, B1); PG8_BAR; PG8_SCHED;
            PG8_LDA(At, 1, 1); PG8_STAGE(PG8_SB(1, 0), b3, voffB); PG8_STAGE(PG8_SB(1, 1), b3 + hstep, voffB); PG8_STAGE(PG8_SA(1, 0), a3, voffA);
            PG8_WAIT_V(8); PG8_WAIT_L(0); PG8_BAR; PG8_MMA(1, 0, At, B0); PG8_MMA(1, 1, At, B1); PG8_BAR; PG8_SCHED;
        }
        if (wr == 0) PG8_BAR;
        E(acc, cur, wr, wc, fr, fq);
        if (!has_next) break;
#pragma unroll
        for (int a = 0; a < 2; ++a)
#pragma unroll
            for (int b = 0; b < 2; ++b)
#pragma unroll
                for (int m = 0; m < 4; ++m)
#pragma unroll
                    for (int n = 0; n < 2; ++n) acc[a][b][m][n] = (f32x4){0.f, 0.f, 0.f, 0.f};
        cur = nxt; cA = nA; cB = nB; ++ui;
        if (wr == 1) PG8_BAR;
    }
    PG8_WAIT_V(0);
    PG8_BAR;
#undef PG8_SA
#undef PG8_SB
#undef PG8_STAGE
#undef PG8_LDA
#undef PG8_LDB
#undef PG8_MMA
#undef PG8_WAIT_V
#undef PG8_WAIT_L
#undef PG8_BAR
#undef PG8_SCHED
}
}
using pg8::Unit;
typedef const f32x4 (&AccRef)[2][2][4][2];

#define EPI_LOOP_BEGIN \
    _Pragma("unroll") for (int ai = 0; ai < 2; ++ai) _Pragma("unroll") for (int m = 0; m < 4; ++m) { \
        const int row = u.pm * 256 + ai * 128 + wr * 64 + m * 16 + fr; \
        _Pragma("unroll") for (int bj = 0; bj < 2; ++bj) { \
            const int col = u.pn * 256 + bj * 128 + wc * 32 + 8 * fq; \
            const f32x4 v0 = acc[ai][bj][m][0], v1 = acc[ai][bj][m][1];
#define EPI_LOOP_END } }

struct EpiZ {
    h16 *zc, *zr, *zg;
    __device__ __forceinline__ void operator()(AccRef acc, const Unit& u, int wr, int wc, int fr, int fq) const {
        const int colt = u.pn * 256; h16* base; int ld, c0;
        if (colt < 1536) { base = zc; ld = 1536; c0 = colt; } else if (colt < 3328) { base = zr; ld = 1792; c0 = colt - 1536; } else { base = zg; ld = 2048; c0 = colt - 3328; }
        EPI_LOOP_BEGIN
            *(h16x8*)(base + (size_t)row * ld + (col - colt + c0)) = pack8(v0, v1);
        EPI_LOOP_END
    }
};
struct EpiF16 {
    h16* O; int ld;
    __device__ __forceinline__ void operator()(AccRef acc, const Unit& u, int wr, int wc, int fr, int fq) const {
        EPI_LOOP_BEGIN
            *(h16x8*)(O + (size_t)row * ld + col) = pack8(v0, v1);
        EPI_LOOP_END
    }
};
struct EpiYA {
    const h16* zg; float* tmp;
    __device__ __forceinline__ void operator()(AccRef acc, const Unit& u, int wr, int wc, int fr, int fq) const {
        EPI_LOOP_BEGIN
            const h16x8 gv = *(const h16x8*)(zg + (size_t)row * 2048 + col);
            f32x4 o0, o1;
#pragma unroll
            for (int j = 0; j < 4; ++j) { o0[j] = sigmoidf_((float)gv[j]) * v0[j]; o1[j] = sigmoidf_((float)gv[4 + j]) * v1[j]; }
            float* p = tmp + (size_t)row * 1024 + col;
            *(f32x4*)p = o0; *(f32x4*)(p + 4) = o1;
        EPI_LOOP_END
    }
};
struct EpiYB {
    const h16* zg; const float* tmp; h16* merged;
    __device__ __forceinline__ void operator()(AccRef acc, const Unit& u, int wr, int wc, int fr, int fq) const {
        EPI_LOOP_BEGIN
            const h16x8 gv = *(const h16x8*)(zg + (size_t)row * 2048 + 1024 + col);
            const float* p = tmp + (size_t)row * 1024 + col;
            f32x4 o0 = *(const f32x4*)p, o1 = *(const f32x4*)(p + 4);
#pragma unroll
            for (int j = 0; j < 4; ++j) { o0[j] += sigmoidf_((float)gv[j]) * v0[j]; o1[j] += sigmoidf_((float)gv[4 + j]) * v1[j]; }
            *(h16x8*)(merged + (size_t)row * 1024 + col) = pack8(o0, o1);
        EPI_LOOP_END
    }
};
struct EpiH1 {
    const float* x; float* out; h16* hb; float* part;
    __device__ __forceinline__ void operator()(AccRef acc, const Unit& u, int wr, int wc, int fr, int fq) const {
#pragma unroll
        for (int ai = 0; ai < 2; ++ai)
#pragma unroll
            for (int m = 0; m < 4; ++m) {
                const int row = u.pm * 256 + ai * 128 + wr * 64 + m * 16 + fr; float ss = 0.f;
#pragma unroll
                for (int bj = 0; bj < 2; ++bj) {
                    const int col = u.pn * 256 + bj * 128 + wc * 32 + 8 * fq;
                    const float* xp = x + (size_t)row * 1024 + col;
                    f32x4 o0 = *(const f32x4*)xp + acc[ai][bj][m][0], o1 = *(const f32x4*)(xp + 4) + acc[ai][bj][m][1];
                    float* op = out + (size_t)row * 1024 + col;
                    *(f32x4*)op = o0; *(f32x4*)(op + 4) = o1;
                    *(h16x8*)(hb + (size_t)row * 1024 + col) = pack8(o0, o1);
                    ss += (o0[0] * o0[0] + o0[1] * o0[1]) + (o0[2] * o0[2] + o0[3] * o0[3]) + (o1[0] * o1[0] + o1[1] * o1[1]) + (o1[2] * o1[2] + o1[3] * o1[3]);
                }
                ss += __shfl_xor(ss, 16); ss += __shfl_xor(ss, 32);
                if (fq == 0) part[(size_t)row * 16 + u.pn * 4 + wc] = ss;
            }
    }
};
struct EpiGate {
    float* out; const h16* pp; const float* rs2; float* part;
    __device__ __forceinline__ void operator()(AccRef acc, const Unit& u, int wr, int wc, int fr, int fq) const {
#pragma unroll
        for (int ai = 0; ai < 2; ++ai)
#pragma unroll
            for (int m = 0; m < 4; ++m) {
                const int row = u.pm * 256 + ai * 128 + wr * 64 + m * 16 + fr; float ss = 0.f;
                const f32x4 sa = *(const f32x4*)(rs2 + (size_t)row * 8), sb = *(const f32x4*)(rs2 + (size_t)row * 8 + 4);
                const float rs = rsqrtf(((sa[0] + sa[1]) + (sa[2] + sa[3]) + (sb[0] + sb[1]) + (sb[2] + sb[3])) * (1.f / 1024.f) + NORM_EPS);
#pragma unroll
                for (int bj = 0; bj < 2; ++bj) {
                    const int col = u.pn * 256 + bj * 128 + wc * 32 + 8 * fq;
                    float* op = out + (size_t)row * 1024 + col;
                    f32x4 o0 = *(const f32x4*)op, o1 = *(const f32x4*)(op + 4);
                    const h16x8 pv = *(const h16x8*)(pp + (size_t)row * 1024 + col);
                    const f32x4 v0 = acc[ai][bj][m][0], v1 = acc[ai][bj][m][1];
#pragma unroll
                    for (int j = 0; j < 4; ++j) { o0[j] += sigmoidf_(rs * v0[j]) * (float)pv[j]; o1[j] += sigmoidf_(rs * v1[j]) * (float)pv[4 + j]; }
                    *(f32x4*)op = o0; *(f32x4*)(op + 4) = o1;
                    ss += (o0[0] * o0[0] + o0[1] * o0[1]) + (o0[2] * o0[2] + o0[3] * o0[3]) + (o1[0] * o1[0] + o1[1] * o1[1]) + (o1[2] * o1[2] + o1[3] * o1[3]);
                }
                ss += __shfl_xor(ss, 16); ss += __shfl_xor(ss, 32);
                if (fq == 0) part[(size_t)row * 16 + u.pn * 4 + wc] = ss;
            }
    }
};

__device__ __forceinline__ void tr_item(const float* W, int N, const float* g, h16* WT, int ldk, int koff, int k0, int n0, LAS float* scr, int lane) {
#pragma unroll 8
    for (int i = 0; i < 32; ++i) { const int kk = 2 * i + (lane >> 5); float v = W[(size_t)(k0 + kk) * N + n0 + (lane & 31)]; if (g) v *= g[k0 + kk]; scr[kk * 33 + (lane & 31)] = v; }
    asm volatile("s_waitcnt lgkmcnt(0)" ::: "memory");
    const int c = lane & 7;
#pragma unroll
    for (int j = 0; j < 4; ++j) { const int n = (lane >> 3) + 8 * j; const LAS float* s = scr + (8 * c) * 33 + n;
        h16x8 o;
#pragma unroll
        for (int e = 0; e < 8; ++e) o[e] = (h16)s[e * 33];
        *(h16x8*)(WT + (size_t)(n0 + n) * ldk + koff + k0 + 8 * c) = o; }
    asm volatile("s_waitcnt lgkmcnt(0)" ::: "memory");
}
struct TrJob { const float* W; const float* g; h16* WT; int K, N, ldk, koff; };

__device__ __forceinline__ void phase_prep(const Args& a, LAS unsigned char* lds) {
    const int tid = tid_(), lane = tid & 63, wave = tid >> 6;
    const int gw = blockIdx.x * NWAVES + wave, NGW = gridDim.x * NWAVES;
    unsigned char* ws = a.ws;
    {
        LAS float* scr = (LAS float*)(lds + wave * 8704);
        TrJob jobs[9] = {
            {a.in[3], a.in[2], (h16*)(ws + O_WIN), 1024, NIN, 1024, 0},
            {a.in[17], nullptr, (h16*)(ws + O_WA), 512, 1024, 512, 0},
            {a.in[18], nullptr, (h16*)(ws + O_WB), 512, 1024, 512, 0},
            {a.in[19], nullptr, (h16*)(ws + O_WO), 1024, 1024, 1024, 0},
            {a.in[26], a.in[25], (h16*)(ws + O_WG), 1024, 1024, 1024, 0},
            {a.in[27], nullptr, (h16*)(ws + O_WP), 256, 1024, 256, 0},
            {a.in[8], nullptr, (h16*)(ws + O_WLR), 64, 512, 256, 0},
            {a.in[10], nullptr, (h16*)(ws + O_WLR) + (size_t)512 * 256, 64, 512, 256, 64},
            {a.in[11], nullptr, (h16*)(ws + O_WLR) + (size_t)1024 * 256, 128, 512, 256, 128},
        };
        int base = 0;
#pragma unroll
        for (int j = 0; j < 9; ++j) {
            const TrJob J = jobs[j]; const int nnb = J.N / 32, items = (J.K / 64) * nnb;
            int first = gw - (base % NGW); if (first < 0) first += NGW;
            for (int r = first; r < items; r += NGW) tr_item(J.W, J.N, J.g, J.WT, J.ldk, J.koff, (r / nnb) * 64, (r % nnb) * 32, scr, lane);
            base += items;
        }
        h16* wlr = (h16*)(ws + O_WLR);
        for (int i = blockIdx.x * NTHREADS + tid; i < 1536 * 256 / 8; i += gridDim.x * NTHREADS) {
            const int n = (i * 8) / 256, k = (i * 8) % 256; const int blk = n / 512;
            const bool inblk = (blk == 0) ? (k < 64) : (blk == 1) ? (k >= 64 && k < 128) : (k >= 128);
            if (!inblk) { h16x8 z; for (int e = 0; e < 8; ++e) z[e] = (h16)0.f; *(h16x8*)(wlr + (size_t)i * 8) = z; }
        }
    }
    __syncthreads();
    {
        LAS float* LA = (LAS float*)lds;
        LAS float* LB = (LAS float*)(lds + 64 * 129 * 4);
        const float* wq = a.in[21]; const float* sk = a.in[22]; const float* gf = a.in[20];
        h16* wst = (h16*)(ws + O_WS);
        for (int it = blockIdx.x; it < 256; it += gridDim.x) {
            const int g16 = it >> 4, k0 = (it & 15) * 64;
            for (int i = tid; i < 64 * 128; i += NTHREADS) { const int k = i >> 7, d = i & 127; LA[k * 129 + d] = wq[(size_t)(k0 + k) * 2048 + g16 * 128 + d] * gf[k0 + k]; }
            for (int i = tid; i < 128 * 128; i += NTHREADS) { const int n = i >> 7, d = i & 127; LB[n * 129 + d] = sk[((size_t)g16 * 128 + n) * 128 + d]; }
            __syncthreads();
            const int n = tid & 127, kg = tid >> 7;
            float o[16];
#pragma unroll
            for (int j = 0; j < 16; ++j) o[j] = 0.f;
            for (int d = 0; d < 128; ++d) { const float b = LB[n * 129 + d];
#pragma unroll
                for (int j = 0; j < 16; ++j) o[j] += LA[(kg * 16 + j) * 129 + d] * b; }
            h16x8 o0, o1;
#pragma unroll
            for (int j = 0; j < 8; ++j) { o0[j] = (h16)o[j]; o1[j] = (h16)o[8 + j]; }
            h16* dst = wst + (size_t)(g16 * 128 + n) * 1024 + k0 + kg * 16;
            *(h16x8*)dst = o0; *(h16x8*)(dst + 8) = o1;
            __syncthreads();
        }
    }
    {
        const float* gf = a.in[20];
        f32x4 g4[4];
#pragma unroll
        for (int j = 0; j < 4; ++j) g4[j] = *(const f32x4*)(gf + 16 * lane + 4 * j);
        for (int r = gw; r < 2 * 16384; r += NGW) {
            const int tb = r >> 14, e = r & 16383;
            const float* src = (tb ? a.in[24] : a.in[23]) + (size_t)e * 1024 + 16 * lane;
            f32x4 v[4]; float mx = 0.f;
#pragma unroll
            for (int j = 0; j < 4; ++j) { v[j] = *(const f32x4*)(src + 4 * j); if (!tb) v[j] = v[j] * g4[j];
#pragma unroll
                for (int c = 0; c < 4; ++c) mx = fmaxf(mx, fabsf(v[j][c])); }
#pragma unroll
            for (int o = 1; o < 64; o <<= 1) mx = fmaxf(mx, __shfl_xor(mx, o));
            mx = fmaxf(mx, 1e-30f);
            const float sc = 224.0f / mx;
            u32x4 q;
#pragma unroll
            for (int j = 0; j < 4; ++j) { int w = 0; w = __builtin_amdgcn_cvt_pk_fp8_f32(v[j][0] * sc, v[j][1] * sc, w, false); w = __builtin_amdgcn_cvt_pk_fp8_f32(v[j][2] * sc, v[j][3] * sc, w, true); q[j] = (unsigned)w; }
            unsigned char* dst = ws + (tb ? O_V8 : O_U8) + ((size_t)(lane >> 3) * 16384 + e) * 128 + 16 * (lane & 7);
            *(u32x4*)dst = q;
            if (lane == 0) ((float*)(ws + (tb ? O_VSC : O_USC)))[e] = mx * (1.0f / 224.0f);
        }
        if (blockIdx.x == 0 && tid < 32) ((unsigned*)(ws + O_CTR))[tid * 64] = 0u;
        const f32x4* pp = (const f32x4*)a.in[1]; h16x4* dp = (h16x4*)(ws + O_P16);
        const int np4 = MTOK * 256 / 4;
        for (int i = blockIdx.x * NTHREADS + tid; i < np4; i += gridDim.x * NTHREADS) dp[i] = pack4(pp[i]);
    }
    {
        const float* x = a.in[0]; h16* xn = (h16*)(ws + O_XN);
        for (int r = gw; r < MTOK; r += NGW) {
            const f32x4* xr = (const f32x4*)(x + (size_t)r * 1024) + lane;
            f32x4 v[4]; float s = 0.f;
#pragma unroll
            for (int j = 0; j < 4; ++j) { v[j] = xr[64 * j]; s += (v[j][0] * v[j][0] + v[j][1] * v[j][1]) + (v[j][2] * v[j][2] + v[j][3] * v[j][3]); }
            const float rs = rsqrtf(wave_sum(s) * (1.f / 1024.f) + NORM_EPS);
            h16x4* o = (h16x4*)(xn + (size_t)r * 1024) + lane;
#pragma unroll
            for (int j = 0; j < 4; ++j) o[64 * j] = pack4(v[j] * rs);
        }
    }
}

__device__ __forceinline__ void phase_conv(const Args& a) {
    const int tid = tid_(), lane = tid & 63, wave = tid >> 6;
    const int gw = blockIdx.x * NWAVES + wave, NGW = gridDim.x * NWAVES;
    const h16* zc = (const h16*)(a.ws + O_ZC); h16* ca = (h16*)(a.ws + O_CA);
    const float* cw = a.in[4]; const float* cb = a.in[5];
    float w0[8], w1[8], w2[8], bb[8];
#pragma unroll
    for (int j = 0; j < 8; ++j) { const int c = lane * 8 + j; w0[j] = cw[c]; w1[j] = cw[512 + c]; w2[j] = cw[1024 + c]; bb[j] = cb[c]; }
    for (int run = gw; run < MTOK / 32; run += NGW) {
        const int t0 = run * 32;
        float u1[8], u2[8];
        if ((t0 % SEQ) == 0) {
#pragma unroll
            for (int j = 0; j < 8; ++j) { u1[j] = 0.f; u2[j] = 0.f; }
        } else {
            const h16x8 c1 = *(const h16x8*)(zc + (size_t)(t0 - 1) * 1536 + 512 + lane * 8), x1 = *(const h16x8*)(zc + (size_t)(t0 - 1) * 1536 + 1024 + lane * 8);
            const h16x8 c2 = *(const h16x8*)(zc + (size_t)(t0 - 2) * 1536 + 512 + lane * 8), x2 = *(const h16x8*)(zc + (size_t)(t0 - 2) * 1536 + 1024 + lane * 8);
#pragma unroll
            for (int j = 0; j < 8; ++j) { u1[j] = (float)c1[j] * (float)x1[j]; u2[j] = (float)c2[j] * (float)x2[j]; }
        }
        for (int t = t0; t < t0 + 32; ++t) {
            const h16* zrow = zc + (size_t)t * 1536 + lane * 8;
            const h16x8 gb = *(const h16x8*)zrow, gc = *(const h16x8*)(zrow + 512), xi = *(const h16x8*)(zrow + 1024);
            h16x8 o;
#pragma unroll
            for (int j = 0; j < 8; ++j) { const float u0 = (float)gc[j] * (float)xi[j];
                const float y = w0[j] * u2[j] + w1[j] * u1[j] + w2[j] * u0 + bb[j];
                o[j] = (h16)((float)gb[j] * y); u2[j] = u1[j]; u1[j] = u0; }
            *(h16x8*)(ca + (size_t)t * 512 + lane * 8) = o;
        }
    }
}


__device__ __forceinline__ float tanhf_(float x) { return 1.0f - 2.0f * __builtin_amdgcn_rcpf(1.0f + __expf(2.0f * x)); }
__device__ __forceinline__ void phase_rwkv_prep(const Args& a) {
    const int tid = tid_(), lane = tid & 63, wave = tid >> 6;
    const int gw = blockIdx.x * NWAVES + wave, NGW = gridDim.x * NWAVES;
    const h16* zr = (const h16*)(a.ws + O_ZR);
    h16* R = (h16*)a.out; h16* KS = R + (size_t)MTOK * 512; h16* V = KS + (size_t)MTOK * 512; h16* KK = V + (size_t)MTOK * 512;
    h16* APR = (h16*)(a.ws + O_APR);
    const float* mu = a.in[6]; const float* k_k = a.in[12];
    float mr[8], mk[8], mv[8], mt[8], kk8[8];
#pragma unroll
    for (int j = 0; j < 8; ++j) { const int c = lane * 8 + j; mr[j] = mu[c]; mk[j] = mu[512 + c]; mv[j] = mu[1024 + c]; mt[j] = mu[1536 + (c & 255)]; kk8[j] = k_k[c]; }
    for (int run = gw; run < MTOK / 32; run += NGW) {
        const int t0 = run * 32;
        float pr[8], pk[8], pv[8], pt[8];
        if ((t0 % SEQ) == 0) {
#pragma unroll
            for (int j = 0; j < 8; ++j) { pr[j] = 0.f; pk[j] = 0.f; pv[j] = 0.f; pt[j] = 0.f; }
        } else {
            const h16* zp = zr + (size_t)(t0 - 1) * 1792 + lane * 8;
            const h16x8 a0 = *(const h16x8*)zp, a1 = *(const h16x8*)(zp + 512), a2 = *(const h16x8*)(zp + 1024), a3 = *(const h16x8*)(zr + (size_t)(t0 - 1) * 1792 + 1536 + (lane & 31) * 8);
#pragma unroll
            for (int j = 0; j < 8; ++j) { pr[j] = (float)a0[j]; pk[j] = (float)a1[j]; pv[j] = (float)a2[j]; pt[j] = (float)a3[j]; }
        }
        for (int t = t0; t < t0 + 32; ++t) {
            const h16* zp = zr + (size_t)t * 1792 + lane * 8;
            const h16x8 a0 = *(const h16x8*)zp, a1 = *(const h16x8*)(zp + 512), a2 = *(const h16x8*)(zp + 1024), a3 = *(const h16x8*)(zr + (size_t)t * 1792 + 1536 + (lane & 31) * 8);
            h16x8 orr, ok, ov, okk, ot; float kr[8]; float ss = 0.f;
#pragma unroll
            for (int j = 0; j < 8; ++j) {
                const float zr_ = (float)a0[j], zk_ = (float)a1[j], zv_ = (float)a2[j], zt_ = (float)a3[j];
                const float r = zr_ + mr[j] * (pr[j] - zr_), k = zk_ + mk[j] * (pk[j] - zk_), v = zv_ + mv[j] * (pv[j] - zv_), tl = zt_ + mt[j] * (pt[j] - zt_);
                pr[j] = zr_; pk[j] = zk_; pv[j] = zv_; pt[j] = zt_;
                orr[j] = (h16)r; ok[j] = (h16)k; ov[j] = (h16)v;
                kr[j] = k * kk8[j]; ss += kr[j] * kr[j];
                const float tv = (lane < 8) ? tanhf_(tl) : (lane < 16) ? tl : sigmoidf_(tl);
                ot[j] = (h16)tv;
            }
            ss += __shfl_xor(ss, 1); ss += __shfl_xor(ss, 2); ss += __shfl_xor(ss, 4);
            const float rn = rsqrtf(ss + 1e-12f);
#pragma unroll
            for (int j = 0; j < 8; ++j) okk[j] = (h16)(kr[j] * rn);
            const size_t o = (size_t)t * 512 + lane * 8;
            *(h16x8*)(R + o) = orr; *(h16x8*)(KS + o) = ok; *(h16x8*)(V + o) = ov; *(h16x8*)(KK + o) = okk;
            if (lane < 32) *(h16x8*)(APR + (size_t)t * 256 + lane * 8) = ot;
        }
    }
}

struct EpiLR {
    const float *w0, *a0, *k_a; h16 *WD, *KS, *BD, *GG; const h16* KK;
    __device__ __forceinline__ void operator()(AccRef acc, const Unit& u, int wr, int wc, int fr, int fq) const {
        const int part = u.pn >> 1;
        EPI_LOOP_BEGIN
            const int c = col - part * 512; const size_t o = (size_t)row * 512 + c;
            if (part == 0) {
                const f32x4 b0 = *(const f32x4*)(w0 + c), b1 = *(const f32x4*)(w0 + c + 4); f32x4 o0, o1;
#pragma unroll
                for (int j = 0; j < 4; ++j) { o0[j] = __expf(-0.6065306597126334f * sigmoidf_(b0[j] + v0[j])); o1[j] = __expf(-0.6065306597126334f * sigmoidf_(b1[j] + v1[j])); }
                *(h16x8*)(WD + o) = pack8(o0, o1);
            } else if (part == 1) {
                const f32x4 b0 = *(const f32x4*)(a0 + c), b1 = *(const f32x4*)(a0 + c + 4), ka0 = *(const f32x4*)(k_a + c), ka1 = *(const f32x4*)(k_a + c + 4);
                const h16x8 ks = *(const h16x8*)(KS + o), kk = *(const h16x8*)(KK + o); f32x4 k0, k1, bb0, bb1;
#pragma unroll
                for (int j = 0; j < 4; ++j) { const float aa0 = sigmoidf_(b0[j] + v0[j]), aa1 = sigmoidf_(b1[j] + v1[j]);
                    k0[j] = (float)ks[j] * (1.0f + (aa0 - 1.0f) * ka0[j]); k1[j] = (float)ks[4 + j] * (1.0f + (aa1 - 1.0f) * ka1[j]);
                    bb0[j] = aa0 * (float)kk[j]; bb1[j] = aa1 * (float)kk[4 + j]; }
                *(h16x8*)(KS + o) = pack8(k0, k1); *(h16x8*)(BD + o) = pack8(bb0, bb1);
            } else {
                *(h16x8*)(GG + o) = pack8(v0, v1);
            }
        EPI_LOOP_END
    }
};

constexpr int SC_L = 256, SC_NCH = SEQ / SC_L, SC_NB = 8;
constexpr int SC_STEP_F = 6 * 64;
constexpr int SC_WAVE_BYTES = SC_NB * SC_STEP_F * 4 + SC_NB * 64 * 4;
__device__ __forceinline__ float quad_sum(float v) { v += dpp_<0xB1>(v); v += dpp_<0x4E>(v); return v; }
__device__ __forceinline__ void lds_ld8x2(const LAS float* p, f32x2 (&o)[8]) {
#pragma unroll
    for (int j4 = 0; j4 < 4; ++j4) { const f32x4 t = *(const LAS f32x4*)(p + 4 * j4); o[2 * j4] = (f32x2){t[0], t[1]}; o[2 * j4 + 1] = (f32x2){t[2], t[3]}; }
}
template <int MODE>
__device__ __forceinline__ void scan_wave(const Args& a, LAS unsigned char* lds, int task) {
    const int tid = tid_(), lane = tid & 63, wave = tid >> 6;
    const int q = lane & 3, rg = lane >> 2;
    const int chain = task / SC_NCH, chunk = task % SC_NCH, b = chain >> 3, h = chain & 7;
    const size_t row0 = (size_t)b * SEQ + (size_t)chunk * SC_L;
    const h16* R = (const h16*)a.out; const h16* KS = R + (size_t)MTOK * 512; const h16* V = KS + (size_t)MTOK * 512; const h16* KK = V + (size_t)MTOK * 512;
    const h16* WD = (const h16*)(a.ws + O_WD); const h16* BD = (const h16*)(a.ws + O_BD);
    LAS float* buf = (LAS float*)(lds + wave * SC_WAVE_BYTES);
    LAS float* ybuf = buf + SC_NB * SC_STEP_F;
    constexpr int NA = (MODE == 0) ? 5 : (MODE == 1) ? 3 : 6;
    const h16* gp[NA]; int lo[NA];
#pragma unroll
    for (int j = 0; j < NA; ++j) { const int p = lane + 64 * j, seg = p >> 3, part = p & 7, st = seg / NA, ai = seg % NA;
        const int ar = (MODE == 0 && ai == 4) ? 5 : ai;
        const h16* base = (ar == 0) ? KK : (ar == 1) ? WD : (ar == 2) ? BD : (ar == 3) ? KS : (ar == 4) ? R : V;
        gp[j] = base + (row0 + st) * 512 + h * 64 + part * 8; lo[j] = st * SC_STEP_F + ar * 64 + part * 8; }
    f32x2 s[4][8];
    if (MODE == 0) {
#pragma unroll
        for (int i = 0; i < 4; ++i)
#pragma unroll
            for (int j = 0; j < 8; ++j) s[i][j] = (f32x2){0.f, 0.f};
    } else if (MODE == 1) {
#pragma unroll
        for (int i = 0; i < 4; ++i)
#pragma unroll
            for (int j = 0; j < 8; ++j) s[i][j] = (f32x2){(i == q && 2 * j == rg) ? 1.f : 0.f, (i == q && 2 * j + 1 == rg) ? 1.f : 0.f};
    } else {
        const float* S0 = (const float*)(a.ws + O_SST) + (size_t)task * 4096;
#pragma unroll
        for (int i = 0; i < 4; ++i)
#pragma unroll
            for (int j4 = 0; j4 < 4; ++j4) { const f32x4 t = *(const f32x4*)(S0 + (rg + 16 * i) * 64 + 16 * q + 4 * j4);
                s[i][2 * j4] = (f32x2){t[0], t[1]}; s[i][2 * j4 + 1] = (f32x2){t[2], t[3]}; }
    }
    h16x8 pre[NA];
#pragma unroll
    for (int j = 0; j < NA; ++j) pre[j] = *(const h16x8*)gp[j];
    f32x2 kk[8];
    for (int bt = 0; bt < SC_L / SC_NB; ++bt) {
        LAS float* cb = buf;
#pragma unroll
        for (int j = 0; j < NA; ++j) { f32x4 x0, x1;
#pragma unroll
            for (int e = 0; e < 4; ++e) { x0[e] = (float)pre[j][e]; x1[e] = (float)pre[j][4 + e]; }
            *(LAS f32x4*)(cb + lo[j]) = x0; *(LAS f32x4*)(cb + lo[j] + 4) = x1; }
        if (bt + 1 < SC_L / SC_NB) {
#pragma unroll
            for (int j = 0; j < NA; ++j) pre[j] = *(const h16x8*)(gp[j] + (size_t)(bt + 1) * SC_NB * 512);
        }
        lds_ld8x2(cb + 16 * q, kk);
#pragma unroll 2
        for (int st = 0; st < SC_NB; ++st) {
            const LAS float* sb = cb + st * SC_STEP_F;
            f32x2 w[8], bb[8], kx[8]; float vv[4];
            lds_ld8x2(sb + 64 + 16 * q, w); lds_ld8x2(sb + 128 + 16 * q, bb);
            if (MODE != 1) { lds_ld8x2(sb + 192 + 16 * q, kx);
#pragma unroll
                for (int i = 0; i < 4; ++i) vv[i] = sb[320 + rg + 16 * i]; }
            float us[4];
#pragma unroll
            for (int i = 0; i < 4; ++i) { f32x2 t = s[i][0] * kk[0];
#pragma unroll
                for (int j = 1; j < 8; ++j) t = __builtin_elementwise_fma(s[i][j], kk[j], t);
                us[i] = quad_sum(t[0] + t[1]); }
            if (st + 1 < SC_NB) lds_ld8x2(sb + SC_STEP_F + 16 * q, kk);
            f32x2 rr[8];
            if (MODE == 2) lds_ld8x2(sb + 256 + 16 * q, rr);
#pragma unroll
            for (int i = 0; i < 4; ++i) { const f32x2 nu = (f32x2){-us[i], -us[i]}, v2 = (f32x2){vv[i], vv[i]};
#pragma unroll
                for (int j = 0; j < 8; ++j) { f32x2 t = s[i][j] * w[j]; t = __builtin_elementwise_fma(nu, bb[j], t); if (MODE != 1) t = __builtin_elementwise_fma(v2, kx[j], t); s[i][j] = t; } }
            if (MODE == 2) {
#pragma unroll
                for (int i = 0; i < 4; ++i) { f32x2 t = s[i][0] * rr[0];
#pragma unroll
                    for (int j = 1; j < 8; ++j) t = __builtin_elementwise_fma(s[i][j], rr[j], t);
                    const float y = quad_sum(t[0] + t[1]);
                    if (q == 0) ybuf[st * 64 + rg + 16 * i] = y; }
            }
        }
        if (MODE == 2) {
            const int st = lane >> 3, part = lane & 7; h16x8 o;
#pragma unroll
            for (int e = 0; e < 8; ++e) o[e] = (h16)ybuf[st * 64 + part * 8 + e];
            *(h16x8*)((h16*)(a.ws + O_Y) + (row0 + (size_t)bt * SC_NB + st) * 512 + h * 64 + part * 8) = o;
        }
    }
    if (MODE != 2) {
        float* PQ = (float*)(a.ws + O_PQ) + (size_t)task * 8192 + (MODE == 0 ? 4096 : 0);
#pragma unroll
        for (int i = 0; i < 4; ++i)
#pragma unroll
            for (int j4 = 0; j4 < 4; ++j4) { const int o = (rg + 16 * i) * 64 + 16 * q + 4 * j4;
                *(f32x4*)(PQ + o) = (f32x4){s[i][2 * j4][0], s[i][2 * j4][1], s[i][2 * j4 + 1][0], s[i][2 * j4 + 1][1]}; }
    }
}
template <bool FIRST>
__device__ __forceinline__ void phase_scan(const Args& a, LAS unsigned char* lds) {
    const int wave = tid_() >> 6;
    if (FIRST) {
        for (int task = blockIdx.x * NWAVES + wave; task < 64 * SC_NCH; task += gridDim.x * NWAVES) { scan_wave<0>(a, lds, task); scan_wave<1>(a, lds, task); }
    } else {
        for (int task = blockIdx.x * NWAVES + wave; task < 64 * SC_NCH; task += gridDim.x * NWAVES) scan_wave<2>(a, lds, task);
    }
}

constexpr size_t O_VTB = O_ZR;
constexpr size_t O_BON = O_ZR + 64 * MiB;
constexpr int UT_WAVE_LDS = 15360;
typedef float f32x16 __attribute__((ext_vector_type(16)));
__device__ __forceinline__ size_t ut_ov(int j, int s) { return (size_t)(j >> 2) * 512 + (j & 3) * 16 + s; }
__device__ __forceinline__ void phase_ut_pre(const Args& a, LAS unsigned char* lds) {
    const int tid = tid_(), lane = tid & 63, wave = tid >> 6;
    const int gw = blockIdx.x * NWAVES + wave, NGW = gridDim.x * NWAVES;
    LAS unsigned char* Lb = lds + wave * UT_WAVE_LDS;
    LAS h16* YX = (LAS h16*)Lb;
    LAS float* GT = (LAS float*)(Lb + 9216);
    LAS float* TM = (LAS float*)(Lb + 13824);
    h16* R = (h16*)a.out; h16* KS = R + (size_t)MTOK * 512; h16* V = KS + (size_t)MTOK * 512; h16* KK = V + (size_t)MTOK * 512;
    h16* WD = (h16*)(a.ws + O_WD); h16* BD = (h16*)(a.ws + O_BD);
    h16* VTB = (h16*)(a.ws + O_VTB); float* BON = (float*)(a.ws + O_BON);
    for (int bh = gw; bh < 32768; bh += NGW) {
        int ln = lane; asm volatile("" : "+v"(ln)); const int r16 = ln & 15;
        const int h = bh & 7, nb = bh >> 3; const size_t tok0 = (size_t)nb * 16; const size_t e0 = tok0 * 512 + h * 64;
        const float rk = a.in[14][h * 64 + lane];
        {
            h16x8 stg[12];
#pragma unroll
            for (int j = 0; j < 12; ++j) { const int ar = j >> 1, row = (lane >> 3) + 8 * (j & 1);
                const h16* base = (ar == 0) ? WD : (ar == 1) ? KK : (ar == 2) ? BD : (ar == 3) ? KS : (ar == 4) ? R : V;
                stg[j] = *(const h16x8*)(base + e0 + (size_t)row * 512 + (lane & 7) * 8); }
#pragma unroll
            for (int j = 0; j < 12; ++j) *(LAS h16x8*)((LAS h16*)Lb + ((j >> 1) * 16 + (lane >> 3) + 8 * (j & 1)) * 64 + (lane & 7) * 8) = stg[j];
            asm volatile("s_waitcnt lgkmcnt(0)" ::: "memory");
        }
        float w[16], kk[16], bb[16], kx[16], rr[16]; h16x8 vt0, vt1;
        { const LAS h16* IN = (const LAS h16*)Lb;
#pragma unroll
        for (int t = 0; t < 16; ++t) { w[t] = (float)IN[t * 64 + lane]; kk[t] = (float)IN[(16 + t) * 64 + lane]; bb[t] = (float)IN[(32 + t) * 64 + lane]; kx[t] = (float)IN[(48 + t) * 64 + lane]; rr[t] = (float)IN[(64 + t) * 64 + lane];
            if (t < 8) vt0[t] = IN[(80 + t) * 64 + lane]; else vt1[t - 8] = IN[(80 + t) * 64 + lane]; } }
        asm volatile("s_waitcnt lgkmcnt(0)" ::: "memory");
        { h16* vp = VTB + (size_t)bh * 1024 + lane * 16; *(h16x8*)vp = vt0; *(h16x8*)(vp + 8) = vt1; }
        float bonv = 0.f;
#pragma unroll
        for (int t = 0; t < 16; ++t) { const float bs = wave_sum(rr[t] * kx[t] * rk); bonv = (ln == t) ? bs : bonv; }
        if (lane < 16) BON[(tok0 + lane) * 8 + h] = bonv;
        float Lt[16]; { float Lc = 0.f;
#pragma unroll
            for (int t = 0; t < 16; ++t) { Lc += __logf(w[t]); Lt[t] = Lc; } }
        const float Lref = Lt[7];
        float btil[16]; h16x8 kt0, kt1;
        LAS h16* OS = (LAS h16*)(Lb + 9216);
#pragma unroll
        for (int t = 0; t < 16; ++t) {
            const float Lp = t ? Lt[t - 1] : 0.f;
            const float ka = kk[t] * __expf(Lp - Lref), rt = rr[t] * __expf(Lt[t] - Lref), e2 = __expf(Lref - Lt[t]), bt = bb[t] * e2, kt = kx[t] * e2;
            YX[t * 72 + lane] = (h16)ka; YX[(16 + t) * 72 + lane] = (h16)rt; YX[(32 + t) * 72 + lane] = (h16)kt; YX[(48 + t) * 72 + lane] = (h16)bt;
            btil[t] = bt;
            OS[t * 64 + lane] = (h16)(kk[t] * __expf(Lp)); OS[(16 + t) * 64 + lane] = (h16)(rr[t] * __expf(Lt[t]));
            const float ktp = kx[t] * __expf(Lt[15] - Lt[t]);
            if (t < 8) kt0[t] = (h16)ktp; else kt1[t - 8] = (h16)ktp;
        }
        const float post = __expf(Lt[15] - Lref), w16 = __expf(Lt[15]);
        { h16* kp = KS + e0 + ut_ov(lane, 0); *(h16x8*)kp = kt0; *(h16x8*)(kp + 8) = kt1; }
        asm volatile("s_waitcnt lgkmcnt(0)" ::: "memory");
#pragma unroll
        for (int j = 0; j < 4; ++j) { const int row = (lane >> 3) + 8 * (j & 1); const h16x8 o8 = *(const LAS h16x8*)(OS + ((j >> 1) * 16 + row) * 64 + (lane & 7) * 8);
            *(h16x8*)(((j >> 1) ? R : KK) + e0 + (size_t)row * 512 + (lane & 7) * 8) = o8; }
        asm volatile("s_waitcnt lgkmcnt(0)" ::: "memory");
        f32x16 acc;
#pragma unroll
        for (int i = 0; i < 16; ++i) acc[i] = 0.f;
#pragma unroll
        for (int ks = 0; ks < 4; ++ks) {
            const h16x8 af = *(const LAS h16x8*)(YX + (lane & 31) * 72 + 8 * (lane >> 5) + 16 * ks), bf = *(const LAS h16x8*)(YX + (32 + (lane & 31)) * 72 + 8 * (lane >> 5) + 16 * ks);
            acc = __builtin_amdgcn_mfma_f32_32x32x16_f16(af, bf, acc, 0, 0, 0);
        }
#pragma unroll
        for (int i = 0; i < 16; ++i) GT[((i & 3) + 8 * (i >> 2) + 4 * (lane >> 5)) * 36 + (lane & 31)] = acc[i];
        asm volatile("s_waitcnt lgkmcnt(0)" ::: "memory");
        float T[16];
#pragma unroll
        for (int t = 0; t < 16; ++t) { float v = (r16 == t) ? 1.f : 0.f;
#pragma unroll
            for (int s2 = 0; s2 < t; ++s2) v -= T[s2] * GT[t * 36 + 16 + s2];
            T[t] = v; }
#pragma unroll
        for (int t = 0; t < 16; ++t) TM[r16 * 20 + t] = T[t];
        asm volatile("s_waitcnt lgkmcnt(0)" ::: "memory");
        float bcol[16];
#pragma unroll
        for (int s2 = 0; s2 < 16; ++s2) bcol[s2] = (s2 <= r16) ? GT[(16 + r16) * 36 + 16 + s2] : 0.f;
        h16x8 tb0, tb1, tp0, tp1;
#pragma unroll
        for (int r = 0; r < 16; ++r) { float s0 = 0.f, s1 = 0.f;
#pragma unroll
            for (int s2 = r; s2 < 16; ++s2) { const float tv = TM[r * 20 + s2]; s0 += tv * btil[s2]; s1 += tv * bcol[s2]; }
            s0 *= post;
            if (r < 8) { tb0[r] = (h16)s0; tp0[r] = (h16)s1; } else { tb1[r - 8] = (h16)s0; tp1[r - 8] = (h16)s1; } }
        { h16* bp = BD + e0 + ut_ov(lane, 0); *(h16x8*)bp = tb0; *(h16x8*)(bp + 8) = tb1; }
        if (lane < 16) {
            h16x8 a0, a1, p0, p1;
#pragma unroll
            for (int s2 = 0; s2 < 16; ++s2) { const float av = (s2 < ln) ? GT[ln * 36 + s2] : 0.f, pv = (s2 <= ln) ? GT[(16 + ln) * 36 + s2] : 0.f;
                if (s2 < 8) { a0[s2] = (h16)av; p0[s2] = (h16)pv; } else { a1[s2 - 8] = (h16)av; p1[s2 - 8] = (h16)pv; } }
            h16* ap = WD + e0 + (size_t)(lane >> 2) * 512 + (lane & 3) * 16;
            *(h16x8*)ap = a0; *(h16x8*)(ap + 8) = a1;
            *(h16x8*)(ap + 4 * 512) = p0; *(h16x8*)(ap + 4 * 512 + 8) = p1;
            *(h16x8*)(ap + 8 * 512) = tp0; *(h16x8*)(ap + 8 * 512 + 8) = tp1;
        }
        (WD + e0 + (size_t)12 * 512)[lane] = (h16)w16;
        asm volatile("s_waitcnt lgkmcnt(0)" ::: "memory");
    }
}
struct UtOps { u32x2 ka[2][2], rt[2][2], kt[4], tb[4], at, apt, tp, vb, w16[4]; };
struct UtRes { __amdgpu_buffer_rsrc_t kk, r, ks, bd, wd, vt, y; };
__device__ __forceinline__ __amdgpu_buffer_rsrc_t mkrsrc(const void* p) { return __builtin_amdgcn_make_buffer_rsrc((void*)p, 0, 0x7fffffff, 0x00020000); }
__device__ __forceinline__ void ut_load(UtOps& o, const UtRes& R, int so, unsigned offK, unsigned offT, unsigned offV, unsigned offF) {
#pragma unroll
    for (int ks = 0; ks < 2; ++ks)
#pragma unroll
        for (int p = 0; p < 2; ++p) { o.ka[ks][p] = __builtin_amdgcn_raw_buffer_load_b64(R.kk, offK + 64u * ks + 32u * p, so, 0); o.rt[ks][p] = __builtin_amdgcn_raw_buffer_load_b64(R.r, offK + 64u * ks + 32u * p, so, 0); }
#pragma unroll
    for (int kt = 0; kt < 4; ++kt) { o.kt[kt] = __builtin_amdgcn_raw_buffer_load_b64(R.ks, offT + 4096u * kt, so, 0); o.tb[kt] = __builtin_amdgcn_raw_buffer_load_b64(R.bd, offT + 4096u * kt, so, 0); }
    o.at = __builtin_amdgcn_raw_buffer_load_b64(R.wd, offT, so, 0); o.apt = __builtin_amdgcn_raw_buffer_load_b64(R.wd, offT + 4096u, so, 0); o.tp = __builtin_amdgcn_raw_buffer_load_b64(R.wd, offT + 8192u, so, 0);
    o.vb = __builtin_amdgcn_raw_buffer_load_b64(R.vt, offV, so, 0);
#pragma unroll
    for (int kt = 0; kt < 4; ++kt) o.w16[kt] = __builtin_amdgcn_raw_buffer_load_b64(R.wd, offF + 12u * 1024u + 32u * kt, so, 0);
}
__device__ __forceinline__ f32x4 h4f(u32x2 v) { const h16x4 h = __builtin_bit_cast(h16x4, v); return (f32x4){(float)h[0], (float)h[1], (float)h[2], (float)h[3]}; }
__device__ __forceinline__ h16x8 cat8(u32x2 lo, u32x2 hi) { u32x4 r; r[0] = lo[0]; r[1] = lo[1]; r[2] = hi[0]; r[3] = hi[1]; return __builtin_bit_cast(h16x8, r); }
__device__ __forceinline__ void ut_block(const UtOps& o, f32x4 (&S)[4], const UtRes& R, unsigned offY, int so) {
    const f32x4 zf = (f32x4){0.f, 0.f, 0.f, 0.f}; const u32x2 zu = (u32x2){0u, 0u};
    const h16x8 sb0 = pack8(S[0], S[1]), sb1 = pack8(S[2], S[3]);
    const h16x8 vb = cat8(o.vb, zu);
    f32x4 x1 = zf, y = zf;
    x1 = __builtin_amdgcn_mfma_f32_16x16x32_f16(cat8(o.ka[0][0], o.ka[0][1]), sb0, x1, 0, 0, 0); y = __builtin_amdgcn_mfma_f32_16x16x32_f16(cat8(o.rt[0][0], o.rt[0][1]), sb0, y, 0, 0, 0);
    x1 = __builtin_amdgcn_mfma_f32_16x16x32_f16(cat8(o.ka[1][0], o.ka[1][1]), sb1, x1, 0, 0, 0); y = __builtin_amdgcn_mfma_f32_16x16x32_f16(cat8(o.rt[1][0], o.rt[1][1]), sb1, y, 0, 0, 0);
    x1 = __builtin_amdgcn_mfma_f32_16x16x32_f16(cat8(o.at, zu), vb, x1, 0, 0, 0); y = __builtin_amdgcn_mfma_f32_16x16x32_f16(cat8(o.apt, zu), vb, y, 0, 0, 0);
    f32x4 St[4];
#pragma unroll
    for (int kt = 0; kt < 4; ++kt) St[kt] = __builtin_amdgcn_mfma_f32_16x16x32_f16(cat8(o.kt[kt], zu), vb, S[kt] * h4f(o.w16[kt]), 0, 0, 0);
    const h16x8 xb = pack8(-x1, zf);
    y = __builtin_amdgcn_mfma_f32_16x16x32_f16(cat8(o.tp, zu), xb, y, 0, 0, 0);
#pragma unroll
    for (int kt = 0; kt < 4; ++kt) S[kt] = __builtin_amdgcn_mfma_f32_16x16x32_f16(cat8(o.tb[kt], zu), xb, St[kt], 0, 0, 0);
#pragma unroll
    for (int rg = 0; rg < 4; ++rg) { const h16 hv = (h16)y[rg]; __builtin_amdgcn_raw_buffer_store_b16(__builtin_bit_cast(unsigned short, hv), R.y, offY + 1024u * rg, so, 0); }
}
__device__ __forceinline__ void phase_ut_seq(const Args& a, LAS unsigned char* lds) {
    const int tid = tid_(), lane = tid & 63, wave = tid >> 6, fr = lane & 15, fq = lane >> 4;
    volatile LAS int* prog = (volatile LAS int*)lds;
    if (tid == 0) *prog = 0;
    if (wave > 1) return;
    for (int item = blockIdx.x; item < 256; item += gridDim.x) {
        const int h = item & 7, q = item >> 3, g = q & 3, b = q >> 2;
        const size_t e0 = ((size_t)b * SEQ * 512 + h * 64) * 2;
        const char* Rb = (const char*)a.out + e0; const char* KSb = Rb + (size_t)MTOK * 1024; const char* KKb = Rb + (size_t)3 * MTOK * 1024;
        const char* WDb = (const char*)(a.ws + O_WD) + e0; const char* BDb = (const char*)(a.ws + O_BD) + e0;
        const char* VTb = (const char*)(a.ws + O_VTB) + ((size_t)b * (SEQ / 16) * 8 + h) * 2048;
        if (wave == 1) {
            const int ar = lane >> 4, row = lane & 15;
            const char* p0 = ((ar == 0) ? KKb : (ar == 1) ? Rb : (ar == 2) ? KSb : BDb) + (size_t)row * 1024;
            const char* p1 = (lane < 16) ? WDb + (size_t)row * 1024 : VTb + (size_t)(4 * g + (lane & 3)) * 128;
            for (int n0 = 0; n0 < SEQ / 16; n0 += 8) {
                int guard = 0;
                while (*prog + 16 < n0 && ++guard < (1 << 22)) __builtin_amdgcn_s_sleep(8);
                unsigned x[16];
#pragma unroll
                for (int i = 0; i < 8; ++i) { x[2 * i] = *(const unsigned*)(p0 + (size_t)(n0 + i) * 16384); x[2 * i + 1] = *(const unsigned*)(p1 + (size_t)(n0 + i) * 16384); }
#pragma unroll
                for (int i = 0; i < 16; ++i) asm volatile("" :: "v"(x[i]));
            }
            continue;
        }
        const unsigned offK = (unsigned)(fr * 1024 + 8 * fq), offT = (unsigned)((fr >> 2) * 512 + (fr & 3) * 16 + 4 * fq) * 2u, offV = (unsigned)((16 * g + fr) * 16 + 4 * fq) * 2u, offF = (unsigned)fq * 8u,
                       offY = (unsigned)((4 * fq) * 512 + 16 * g + fr) * 2u;
        UtRes RS; RS.kk = mkrsrc(KKb); RS.r = mkrsrc(Rb); RS.ks = mkrsrc(KSb); RS.bd = mkrsrc(BDb); RS.wd = mkrsrc(WDb); RS.vt = mkrsrc(VTb);
        RS.y = mkrsrc((const char*)(a.ws + O_Y) + e0);
        f32x4 S[4];
#pragma unroll
        for (int kt = 0; kt < 4; ++kt) S[kt] = (f32x4){0.f, 0.f, 0.f, 0.f};
        UtOps oa, ob, oc;
#define UT_LD(o, nn) ut_load(o, RS, ((nn) < SEQ / 16 ? (nn) : SEQ / 16 - 1) * 16384, offK, offT, offV, offF)
        UT_LD(oa, 0); UT_LD(ob, 1);
        int n = 0;
#pragma unroll 1
        for (; n + 3 <= SEQ / 16; n += 3) {
            if (lane == 0) *prog = n;
            UT_LD(oc, n + 2); ut_block(oa, S, RS, offY, n * 16384);
            UT_LD(oa, n + 3); ut_block(ob, S, RS, offY, (n + 1) * 16384);
            UT_LD(ob, n + 4); ut_block(oc, S, RS, offY, (n + 2) * 16384);
        }
        ut_block(oa, S, RS, offY, n * 16384); ut_block(ob, S, RS, offY, (n + 1) * 16384);
#undef UT_LD
    }
}

__device__ __forceinline__ void phase_scan_combine(const Args& a, LAS unsigned char* lds) {
    const int tid = tid_(), row = tid >> 5, cp = tid & 31;
    LAS float* LS = (LAS float*)lds;
    LAS float* LP = (LAS float*)(lds + 8192);
    for (int item = blockIdx.x; item < 64 * 4; item += gridDim.x) {
        const int chain = item >> 2, r0 = (item & 3) * 16;
        const float* PQ0 = (const float*)(a.ws + O_PQ) + (size_t)chain * SC_NCH * 8192;
        f32x2 sr = (f32x2){0.f, 0.f};
        f32x4 pa = *(const f32x4*)(PQ0 + tid * 8), pb = *(const f32x4*)(PQ0 + tid * 8 + 4);
        f32x2 qn = *(const f32x2*)(PQ0 + 4096 + (r0 + row) * 64 + 2 * cp);
        for (int c = 0; c < SC_NCH; ++c) {
            const int task = chain * SC_NCH + c;
            *(f32x2*)((float*)(a.ws + O_SST) + (size_t)task * 4096 + (r0 + row) * 64 + 2 * cp) = sr;
            if (c == SC_NCH - 1) break;
            LAS float* cur = LS + (c & 1) * 1024; LAS float* cp_ = LP + (c & 1) * 4096;
            *(LAS f32x2*)(cur + row * 64 + 2 * cp) = sr;
            *(LAS f32x4*)(cp_ + tid * 8) = pa; *(LAS f32x4*)(cp_ + tid * 8 + 4) = pb;
            f32x2 acc0 = qn, acc1 = (f32x2){0.f, 0.f};
            if (c + 2 < SC_NCH) { const float* Pn = PQ0 + (size_t)(c + 1) * 8192;
                pa = *(const f32x4*)(Pn + tid * 8); pb = *(const f32x4*)(Pn + tid * 8 + 4); qn = *(const f32x2*)(Pn + 4096 + (r0 + row) * 64 + 2 * cp); }
            __syncthreads();
#pragma unroll 16
            for (int k = 0; k < 64; k += 2) {
                const f32x2 sk = *(const LAS f32x2*)(cur + row * 64 + k);
                const f32x2 p0 = *(const LAS f32x2*)(cp_ + k * 64 + 2 * cp), p1 = *(const LAS f32x2*)(cp_ + (k + 1) * 64 + 2 * cp);
                acc0 = __builtin_elementwise_fma((f32x2){sk[0], sk[0]}, p0, acc0); acc1 = __builtin_elementwise_fma((f32x2){sk[1], sk[1]}, p1, acc1);
            }
            sr = acc0 + acc1;
        }
        __syncthreads();
    }
}
__device__ __forceinline__ void phase_rwkv_post(const Args& a) {
    const int tid = tid_(), lane = tid & 63, wave = tid >> 6;
    const int gw = blockIdx.x * NWAVES + wave, NGW = gridDim.x * NWAVES;
    const h16* V = (const h16*)a.out + (size_t)2 * MTOK * 512;
    const h16* GG = (const h16*)(a.ws + O_GG); const h16* Y = (const h16*)(a.ws + O_Y); h16* YB = (h16*)(a.ws + O_YB); const float* BON = (const float*)(a.ws + O_BON);
    float lg[8], lb[8];
#pragma unroll
    for (int j = 0; j < 8; ++j) { const int c = lane * 8 + j; lg[j] = a.in[15][c]; lb[j] = a.in[16][c]; }
    for (int t = gw; t < MTOK; t += NGW) {
        const size_t o = (size_t)t * 512 + lane * 8;
        const h16x8 y8 = *(const h16x8*)(Y + o), v8 = *(const h16x8*)(V + o), g8 = *(const h16x8*)(GG + o);
        const float bs = BON[(size_t)t * 8 + (lane >> 3)];
        float y[8]; float sm = 0.f;
#pragma unroll
        for (int j = 0; j < 8; ++j) { y[j] = (float)y8[j]; sm += y[j]; }
        sm += dpp_<0xB1>(sm); sm += dpp_<0x4E>(sm); sm += dpp_<0x141>(sm);
        const float mean = sm * (1.f / 64.f); float vs = 0.f;
#pragma unroll
        for (int j = 0; j < 8; ++j) { y[j] -= mean; vs += y[j] * y[j]; }
        vs += dpp_<0xB1>(vs); vs += dpp_<0x4E>(vs); vs += dpp_<0x141>(vs);
        const float rstd = rsqrtf(vs * (1.f / 64.f) + 64e-5f);
        h16x8 ov;
#pragma unroll
        for (int j = 0; j < 8; ++j) ov[j] = (h16)((y[j] * rstd * lg[j] + lb[j] + bs * (float)v8[j]) * (float)g8[j]);
        *(h16x8*)(YB + o) = ov;
    }
}

__device__ __forceinline__ void ins16(unsigned (&L)[16], unsigned x) {
#pragma unroll
    for (int j = 0; j < 16; ++j) { const unsigned hi = L[j] > x ? L[j] : x; x = L[j] > x ? x : L[j]; L[j] = hi; }
}
__device__ __forceinline__ unsigned ord32(float f) { const unsigned u = __float_as_uint(f); return (u & 0x80000000u) ? ~u : (u | 0x80000000u); }
__device__ __forceinline__ float unord32(unsigned k) { return __uint_as_float((k & 0x80000000u) ? (k & 0x7fffffffu) : ~k); }
__device__ __forceinline__ void phase_topk(const Args& a, LAS unsigned char* lds) {
    const int tid = tid_();
    const h16* SC = (const h16*)(a.ws + O_SCORES);
    const float* part = (const float*)(a.ws + O_PART1);
    unsigned short* IDX = (unsigned short*)(a.ws + O_IDX); float* GATE = (float*)(a.ws + O_GATE); float* RS1 = (float*)(a.ws + O_RS1);
    LAS unsigned char* LI = lds;
    for (int task = blockIdx.x * NTHREADS + tid; task < MTOK * 8; task += gridDim.x * NTHREADS) {
        const int t = task >> 3, h = task & 7;
        float ssq = 0.f;
#pragma unroll
        for (int j = 0; j < 4; ++j) { const f32x4 p4 = *(const f32x4*)(part + (size_t)t * 16 + 4 * j); ssq += (p4[0] + p4[1]) + (p4[2] + p4[3]); }
        const float rs = rsqrtf(ssq * (1.f / 1024.f) + NORM_EPS);
        if (h == 0) RS1[t] = rs;
        float sv[2][16];
#pragma unroll
        for (int c = 0; c < 2; ++c) {
            unsigned L[16];
#pragma unroll
            for (int j = 0; j < 16; ++j) L[j] = 0u;
            const h16* row = SC + (size_t)t * 2048 + h * 256 + c * 128;
#pragma unroll 2
            for (int n8 = 0; n8 < 16; ++n8) {
                const u32x4 w4 = *(const u32x4*)(row + n8 * 8);
#pragma unroll
                for (int e = 0; e < 8; ++e) {
                    const unsigned bits = (e & 1) ? (w4[e >> 1] >> 16) : (w4[e >> 1] & 0xffffu);
                    const unsigned o16 = (bits & 0x8000u) ? (~bits & 0xffffu) : (bits | 0x8000u);
                    ins16(L, (o16 << 16) | (unsigned)(127 - (n8 * 8 + e)));
                }
            }
#pragma unroll
            for (int j = 0; j < 16; ++j) {
                const unsigned o16 = L[j] >> 16; const unsigned bits = (o16 & 0x8000u) ? (o16 & 0x7fffu) : (~o16 & 0xffffu);
                union { unsigned short u; h16 f; } cv; cv.u = (unsigned short)bits; sv[c][j] = (float)cv.f;
                LI[(c * 16 + j) * 512 + tid] = (unsigned char)(127u - (L[j] & 127u));
            }
        }
        unsigned L[16];
#pragma unroll
        for (int j = 0; j < 16; ++j) L[j] = 0u;
#pragma unroll
        for (int i = 0; i < 16; ++i)
#pragma unroll
            for (int j = 0; j < 16; ++j) if ((i + 1) * (j + 1) <= 16) ins16(L, (ord32(sv[0][i] + sv[1][j]) & ~255u) | (unsigned)(255 - (i * 16 + j)));
        float e[16]; float den = 0.f; const float mx = unord32(L[0] & ~255u) * rs;
        unsigned short id[16];
#pragma unroll
        for (int k = 0; k < 16; ++k) {
            const float v = unord32(L[k] & ~255u) * rs; e[k] = __expf(v - mx); den += e[k];
            const unsigned pos = 255u - (L[k] & 255u); const unsigned i = pos >> 4, j = pos & 15u;
            id[k] = (unsigned short)((unsigned)LI[i * 512 + tid] * 128u + (unsigned)LI[(16 + j) * 512 + tid]);
        }
        const float inv = __builtin_amdgcn_rcpf(den);
        u32x4 i0, i1;
        i0[0] = id[0] | (id[1] << 16); i0[1] = id[2] | (id[3] << 16); i0[2] = id[4] | (id[5] << 16); i0[3] = id[6] | (id[7] << 16);
        i1[0] = id[8] | (id[9] << 16); i1[1] = id[10] | (id[11] << 16); i1[2] = id[12] | (id[13] << 16); i1[3] = id[14] | (id[15] << 16);
        u32x4* ip = (u32x4*)(IDX + (size_t)task * 16); ip[0] = i0; ip[1] = i1;
        f32x4* gp = (f32x4*)(GATE + (size_t)task * 16);
#pragma unroll
        for (int k4 = 0; k4 < 4; ++k4) gp[k4] = (f32x4){e[4 * k4] * inv, e[4 * k4 + 1] * inv, e[4 * k4 + 2] * inv, e[4 * k4 + 3] * inv};
    }
}

__device__ __forceinline__ float gelu_tanh(float x) { const float u = 0.7978845608028654f * (x + 0.044715f * x * x * x); return 0.5f * x * (1.0f + tanhf_(u)); }
__device__ __forceinline__ unsigned xcc_id() { return (unsigned)__builtin_amdgcn_s_getreg((3 << 11) | 20) & 7u; }
constexpr int GA_TC = 32, GA_NCH = MTOK / GA_TC;
__device__ __forceinline__ void dec16(const u32x4 q, float (&o)[16]) {
#pragma unroll
    for (int w = 0; w < 4; ++w) { const f32x2 lo = __builtin_amdgcn_cvt_pk_f32_fp8((int)q[w], false), hi = __builtin_amdgcn_cvt_pk_f32_fp8((int)q[w], true);
        o[4 * w] = lo[0]; o[4 * w + 1] = lo[1]; o[4 * w + 2] = hi[0]; o[4 * w + 3] = hi[1]; }
}
struct GIdx { u32x4 a, b; };
__device__ __forceinline__ GIdx g_ldidx(const unsigned short* IDX, int t, int r8) { const u32x4* ip = (const u32x4*)(IDX + (size_t)t * 128 + 16 * r8); GIdx r; r.a = ip[0]; r.b = ip[1]; return r; }
__device__ __forceinline__ void g_issue8(const unsigned char* TBs, unsigned lo, const u32x4 ix, u32x4 (&q)[8]) {
#pragma unroll
    for (int i = 0; i < 8; ++i) { const unsigned w = ix[i >> 1]; const unsigned e = (i & 1) ? (w >> 16) : (w & 0xffffu); q[i] = *(const u32x4*)(TBs + (e * 128u + lo)); }
}
struct GSide { u32x4 a, b, c, d; };
template <int PH> __device__ __forceinline__ GSide g_ldside(const Args& a, int t, int j, int m, int r8) {
    GSide r;
    if (PH == 0) { const u32x4* xp = (const u32x4*)((const h16*)(a.ws + O_H1B) + (size_t)t * 1024 + 128 * j + 16 * m); r.a = xp[0]; r.b = xp[1]; r.c = r.a; r.d = r.b; }
    else { const u32x4* cp = (const u32x4*)((const float*)(a.ws + O_COEF) + (size_t)t * 128 + 16 * r8); r.a = cp[0]; r.b = cp[1]; r.c = cp[2]; r.d = cp[3]; }
    return r;
}
template <int PH, int HALF> __device__ __forceinline__ void g_half(u32x4 (&q)[8], const GSide& sd, float (&pa)[16]) {
    if (PH == 0) {
        float x[16];
#pragma unroll
        for (int k = 0; k < 8; ++k) { const h16x8 xa = __builtin_bit_cast(h16x8, sd.a), xb = __builtin_bit_cast(h16x8, sd.b); x[k] = (float)xa[k]; x[8 + k] = (float)xb[k]; }
#pragma unroll
        for (int i = 0; i < 8; ++i) { float d[16]; dec16(q[i], d); float s0 = 0.f, s1 = 0.f;
#pragma unroll
            for (int k = 0; k < 8; ++k) { s0 += x[2 * k] * d[2 * k]; s1 += x[2 * k + 1] * d[2 * k + 1]; }
            pa[8 * HALF + i] = s0 + s1; }
    } else {
#pragma unroll
        for (int i = 0; i < 8; ++i) { float d[16]; dec16(q[i], d);
            const float cf = __uint_as_float(HALF == 0 ? (i < 4 ? sd.a[i & 3] : sd.b[i & 3]) : (i < 4 ? sd.c[i & 3] : sd.d[i & 3]));
#pragma unroll
            for (int k = 0; k < 16; ++k) pa[k] += cf * d[k];
            if (i + 1 < 8) asm volatile("" : "+v"(q[i + 1][0]), "+v"(q[i + 1][1]), "+v"(q[i + 1][2]), "+v"(q[i + 1][3]));
        }
    }
}
template <int PH> __device__ __forceinline__ void g_finish(const Args& a, int t, int j, int lane, float (&p)[16]) {
    const int m = lane & 7, r8 = lane >> 3;
    float q8[8], q4[4], q2[2];
    if (PH == 0) {
#pragma unroll
        for (int i = 0; i < 8; ++i) { const float keep = (lane & 4) ? p[i + 8] : p[i], send = (lane & 4) ? p[i] : p[i + 8]; q8[i] = keep + xhm_(send); }
#pragma unroll
        for (int i = 0; i < 4; ++i) { const float keep = (lane & 2) ? q8[i + 4] : q8[i], send = (lane & 2) ? q8[i] : q8[i + 4]; q4[i] = keep + dpp_<0x4E>(send); }
#pragma unroll
        for (int i = 0; i < 2; ++i) { const float keep = (lane & 1) ? q4[i + 2] : q4[i], send = (lane & 1) ? q4[i] : q4[i + 2]; q2[i] = keep + dpp_<0xB1>(send); }
        *(f32x2*)((float*)(a.ws + O_PART) + ((size_t)j * MTOK + t) * 128 + 16 * r8 + 2 * m) = (f32x2){q2[0], q2[1]};
    } else {
#pragma unroll
        for (int i = 0; i < 8; ++i) { const float keep = (lane & 32) ? p[i + 8] : p[i], send = (lane & 32) ? p[i] : p[i + 8]; q8[i] = keep + x32_(send, lane); }
#pragma unroll
        for (int i = 0; i < 4; ++i) { const float keep = (lane & 16) ? q8[i + 4] : q8[i], send = (lane & 16) ? q8[i] : q8[i + 4]; q4[i] = keep + x16_(send, lane); }
#pragma unroll
        for (int i = 0; i < 2; ++i) { const float keep = (lane & 8) ? q4[i + 2] : q4[i], send = (lane & 8) ? q4[i] : q4[i + 2]; q2[i] = keep + x8_(send); }
        const int col = 128 * j + 16 * m + 2 * r8;
        float* op = a.out + (size_t)t * 1024 + col;
        f32x2 hv = *(const f32x2*)op; hv[0] += q2[0]; hv[1] += q2[1];
        *(f32x2*)op = hv;
        *(h16x2*)((h16*)(a.ws + O_H2B) + (size_t)t * 1024 + col) = (h16x2){(h16)hv[0], (h16)hv[1]};
        const float ss = wave_sum(hv[0] * hv[0] + hv[1] * hv[1]);
        if (lane == 0) ((float*)(a.ws + O_SS2))[(size_t)t * 8 + j] = ss;
    }
}
template <int PH>
__device__ __forceinline__ void phase_gather(const Args& a, int cset) {
    const int tid = tid_(), lane = tid & 63, m = lane & 7, r8 = lane >> 3;
    unsigned* ctr = (unsigned*)(a.ws + O_CTR) + cset * 8 * 64;
    const unsigned short* IDX = (const unsigned short*)(a.ws + O_IDX);
    const unsigned j0 = xcc_id();
    for (unsigned dj = 0; dj < 8; ++dj) {
        const unsigned j = (j0 + dj) & 7u;
        const unsigned char* TB = a.ws + (PH ? O_V8 : O_U8) + (size_t)j * 16384 * 128; const unsigned lo16 = 16u * (unsigned)m;
        for (;;) {
            unsigned c = 0; if (lane == 0) c = __hip_atomic_fetch_add(ctr + j * 64, 1u, __ATOMIC_RELAXED, __HIP_MEMORY_SCOPE_AGENT);
            c = (unsigned)__builtin_amdgcn_readfirstlane((int)c);
            if (c >= (unsigned)GA_NCH) break;
            const int t0 = c * GA_TC;
            u32x4 qa[8], qb[8]; GSide sd, sn; GIdx ix, ixn;
            ix = g_ldidx(IDX, t0, r8); g_issue8(TB, lo16, ix.a, qa); sd = g_ldside<PH>(a, t0, j, m, r8);
#pragma unroll 1
            for (int ti = 0; ti < GA_TC; ++ti) {
                const int t = t0 + ti, tn = (ti + 1 < GA_TC) ? t + 1 : t;
                g_issue8(TB, lo16, ix.b, qb); ixn = g_ldidx(IDX, tn, r8); sn = g_ldside<PH>(a, tn, j, m, r8);
                float p[16];
                if (PH == 1) {
#pragma unroll
                    for (int k = 0; k < 16; ++k) p[k] = 0.f;
                }
                g_half<PH, 0>(qa, sd, p);
                g_issue8(TB, lo16, ixn.a, qa);
                g_half<PH, 1>(qb, sd, p);
                g_finish<PH>(a, t, j, lane, p);
                ix = ixn; sd = sn;
            }
        }
    }
}
__device__ __forceinline__ void phase_coef(const Args& a) {
    const int tid = tid_();
    const float* PART = (const float*)(a.ws + O_PART); const unsigned short* IDX = (const unsigned short*)(a.ws + O_IDX);
    const float* GATE = (const float*)(a.ws + O_GATE); const float* RS1 = (const float*)(a.ws + O_RS1);
    const float* USC = (const float*)(a.ws + O_USC); const float* VSC = (const float*)(a.ws + O_VSC); float* COEF = (float*)(a.ws + O_COEF);
    for (int i = blockIdx.x * NTHREADS + tid; i < MTOK * 128; i += gridDim.x * NTHREADS) {
        float s = 0.f;
#pragma unroll
        for (int j = 0; j < 8; ++j) s += PART[(size_t)j * MTOK * 128 + i];
        const unsigned e = IDX[i];
        COEF[i] = GATE[i] * gelu_tanh(RS1[i >> 7] * USC[e] * s) * VSC[e];
    }
}

__device__ __forceinline__ void phase_final(const Args& a) {
    const int tid = tid_(), lane = tid & 63, wave = tid >> 6;
    const int gw = blockIdx.x * NWAVES + wave, NGW = gridDim.x * NWAVES;
    const float* part = (const float*)(a.ws + O_PART3); const float* fg = a.in[28];
    f32x4 g4[4];
#pragma unroll
    for (int j = 0; j < 4; ++j) g4[j] = *((const f32x4*)fg + lane + 64 * j);
    for (int r = gw; r < MTOK; r += NGW) {
        float s = (lane < 16) ? part[(size_t)r * 16 + lane] : 0.f;
        s = wave_sum(s);
        const float rs = rsqrtf(s * (1.f / 1024.f) + NORM_EPS);
        f32x4* xr = (f32x4*)(a.out + (size_t)r * 1024) + lane;
#pragma unroll
        for (int j = 0; j < 4; ++j) xr[64 * j] = xr[64 * j] * rs * g4[j];
    }
}

constexpr int NPHASE = 19;
__global__ void __launch_bounds__(NTHREADS, 2) mk(Args a) {
    extern __shared__ __attribute__((aligned(16))) unsigned char smem[];
    LAS unsigned char* lds = (LAS unsigned char*)smem;
    unsigned char* ws = a.ws;
#if ONE_LAUNCH
    cg::grid_group grid = cg::this_grid();
    volatile LAS unsigned* bst = (volatile LAS unsigned*)(lds + 131072);
    if (threadIdx.x < 2) bst[threadIdx.x] = 0u;
    __syncthreads();
    const XcdBarrier xbar = xcd_barrier_post((unsigned*)(a.ws + O_BAR), bst);
    bool first_sync = true;
#define SYNC() do { if (first_sync) { grid.sync(); first_sync = false; } else xcd_barrier(xbar); } while (0)
#else
#define SYNC() do {} while (0)
#endif
#define IN(k) (a.ph_lo <= (k) && (k) < a.ph_hi)
#define SEAM(k) do { if (IN(k) && IN((k) + 1)) SYNC(); } while (0)
#define REPS(k) ((((REP_MASK) >> (k)) & 1u) ? 2 : 1)
    const int G = gridDim.x, bid = blockIdx.x;
    if (IN(0)) for (int rep = 0; rep < REPS(0); ++rep) { if (rep) SYNC(); phase_prep(a, lds); } SEAM(0);
    if (IN(1)) for (int rep = 0; rep < REPS(1); ++rep) { if (rep) SYNC(); pg8::Gemm g{(const h16*)(ws + O_XN), (const h16*)(ws + O_WIN), MTOK, NIN, 1024}; pg8::StaticOrder S; S.init(MTOK, NIN, G, bid);
        EpiZ E{(h16*)(ws + O_ZC), (h16*)(ws + O_ZR), (h16*)(ws + O_ZG)}; pg8::gemm_phase(lds, g, S, E); } SEAM(1);
    if (IN(2)) for (int rep = 0; rep < REPS(2); ++rep) { if (rep) SYNC(); phase_conv(a); phase_rwkv_prep(a); } SEAM(2);
    if (IN(3)) for (int rep = 0; rep < REPS(3); ++rep) { if (rep) SYNC(); pg8::Gemm g{(const h16*)(ws + O_APR), (const h16*)(ws + O_WLR), MTOK, 1536, 256}; pg8::StaticOrder S; S.init(MTOK, 1536, G, bid);
        h16* R = (h16*)a.out; h16* KS = R + (size_t)MTOK * 512; h16* KK = KS + (size_t)2 * MTOK * 512;
        EpiLR E{a.in[7], a.in[9], a.in[13], (h16*)(ws + O_WD), KS, (h16*)(ws + O_BD), (h16*)(ws + O_GG), KK}; pg8::gemm_phase(lds, g, S, E); } SEAM(3);
    if (IN(4)) for (int rep = 0; rep < REPS(4); ++rep) { if (rep) SYNC(); phase_ut_pre(a, lds); }
    SEAM(5);
    if (IN(6)) for (int rep = 0; rep < REPS(6); ++rep) { if (rep) SYNC(); phase_ut_seq(a, lds); } SEAM(6);
    if (IN(7)) for (int rep = 0; rep < REPS(7); ++rep) { if (rep) SYNC(); phase_rwkv_post(a); } SEAM(7);
    if (IN(8)) for (int rep = 0; rep < REPS(8); ++rep) { if (rep) SYNC(); pg8::Gemm g{(const h16*)(ws + O_CA), (const h16*)(ws + O_WA), MTOK, 1024, 512}; pg8::StaticOrder S; S.init(MTOK, 1024, G, bid);
        EpiYA E{(const h16*)(ws + O_ZG), a.out}; pg8::gemm_phase(lds, g, S, E); } SEAM(8);
    if (IN(9)) for (int rep = 0; rep < REPS(9); ++rep) { if (rep) SYNC(); pg8::Gemm g{(const h16*)(ws + O_YB), (const h16*)(ws + O_WB), MTOK, 1024, 512}; pg8::StaticOrder S; S.init(MTOK, 1024, G, bid);
        EpiYB E{(const h16*)(ws + O_ZG), a.out, (h16*)(ws + O_MERGED)}; pg8::gemm_phase(lds, g, S, E); } SEAM(9);
    if (IN(10)) for (int rep = 0; rep < REPS(10); ++rep) { if (rep) SYNC(); pg8::Gemm g{(const h16*)(ws + O_MERGED), (const h16*)(ws + O_WO), MTOK, 1024, 1024}; pg8::StaticOrder S; S.init(MTOK, 1024, G, bid);
        EpiH1 E{a.in[0], a.out, (h16*)(ws + O_H1B), (float*)(ws + O_PART1)}; pg8::gemm_phase(lds, g, S, E); } SEAM(10);
    if (IN(11)) for (int rep = 0; rep < REPS(11); ++rep) { if (rep) SYNC(); pg8::Gemm g{(const h16*)(ws + O_H1B), (const h16*)(ws + O_WS), MTOK, 2048, 1024}; pg8::StaticOrder S; S.init(MTOK, 2048, G, bid);
        EpiF16 E{(h16*)(ws + O_SCORES), 2048}; pg8::gemm_phase(lds, g, S, E); } SEAM(11);
    if (IN(12)) for (int rep = 0; rep < REPS(12); ++rep) { if (rep) SYNC(); phase_topk(a, lds); } SEAM(12);
    if (IN(13)) for (int rep = 0; rep < REPS(13); ++rep) { if (rep) SYNC(); phase_gather<0>(a, 2 * rep); } SEAM(13);
    if (IN(14)) for (int rep = 0; rep < REPS(14); ++rep) { if (rep) SYNC(); phase_coef(a); } SEAM(14);
    if (IN(15)) for (int rep = 0; rep < REPS(15); ++rep) { if (rep) SYNC(); phase_gather<1>(a, 1); } SEAM(15);
    if (IN(16)) for (int rep = 0; rep < REPS(16); ++rep) { if (rep) SYNC(); pg8::Gemm g{(const h16*)(ws + O_P16), (const h16*)(ws + O_WP), MTOK, 1024, 256}; pg8::StaticOrder S; S.init(MTOK, 1024, G, bid);
        EpiF16 E{(h16*)(ws + O_PP), 1024}; pg8::gemm_phase(lds, g, S, E); } SEAM(16);
    if (IN(17)) for (int rep = 0; rep < REPS(17); ++rep) { if (rep) SYNC(); pg8::Gemm g{(const h16*)(ws + O_H2B), (const h16*)(ws + O_WG), MTOK, 1024, 1024}; pg8::StaticOrder S; S.init(MTOK, 1024, G, bid);
        EpiGate E{a.out, (const h16*)(ws + O_PP), (const float*)(ws + O_SS2), (float*)(ws + O_PART3)}; pg8::gemm_phase(lds, g, S, E); } SEAM(17);
    if (IN(18)) for (int rep = 0; rep < REPS(18); ++rep) { if (rep) SYNC(); phase_final(a); }
}

extern "C" void kernel_launch(void* const* d_in, const int* in_sizes, int n_in, void* d_out, int out_size, void* d_ws, size_t ws_size, hipStream_t stream) {
    static int ready = 0;
    if (!ready) {
        if (n_in != 29 || ws_size < WS_END) { fprintf(stderr, "kernel_launch: unexpected n_in %d / ws %zu (need %zu)\n", n_in, ws_size, (size_t)WS_END); ready = -1; return; }
        if (hipFuncSetAttribute((const void*)mk, hipFuncAttributeMaxDynamicSharedMemorySize, LDS_BYTES) != hipSuccess) { fprintf(stderr, "hipFuncSetAttribute failed\n"); ready = -1; return; }
        ready = 1;
    }
    if (ready < 0) return;
    Args a{};
    for (int i = 0; i < 29; ++i) a.in[i] = (const float*)d_in[i];
    a.out = (float*)d_out; a.ws = (unsigned char*)d_ws;
#if ONE_LAUNCH
    (void)hipMemsetAsync((unsigned char*)d_ws + O_BAR, 0, 16384, stream);
    a.ph_lo = 0; a.ph_hi = NPHASE;
    void* args[] = {&a};
    hipLaunchCooperativeKernel((const void*)mk, dim3(NBLK), dim3(NTHREADS), args, LDS_BYTES, stream);
#else
    const int phases[] = {0, 1, 2, 3, 4, 5, 6, 7, 8, 9, 10, 11, 12, 13, 14, 15, 16, 17, 18};
    for (int ph : phases) { a.ph_lo = ph; a.ph_hi = ph + 1; hipLaunchKernelGGL(mk, dim3(NBLK), dim3(NTHREADS), LDS_BYTES, stream, a); }
#endif
}
```

```cpp
#include <hip/hip_runtime.h>
#include <hip/hip_cooperative_groups.h>
#include <cstdio>
namespace cg = cooperative_groups;

#ifndef REP_MASK
#define REP_MASK 0u
#endif
#ifndef ONE_LAUNCH
#define ONE_LAUNCH 1
#endif

#define LAS __attribute__((address_space(3)))
typedef _Float16 h16;
typedef _Float16 h16x8 __attribute__((ext_vector_type(8)));
typedef _Float16 h16x4 __attribute__((ext_vector_type(4)));
typedef _Float16 h16x2 __attribute__((ext_vector_type(2)));
typedef float f32x4 __attribute__((ext_vector_type(4)));
typedef float f32x2 __attribute__((ext_vector_type(2)));
typedef unsigned u32x4 __attribute__((ext_vector_type(4)));
typedef unsigned u32x2 __attribute__((ext_vector_type(2)));

constexpr int MTOK = 65536, DM = 1024, SEQ = 8192, NB = 8;
constexpr int NIN = 5376;
constexpr int NTHREADS = 512, NWAVES = 8, NBLK = 256;
constexpr int LDS_BYTES = 131072 + 64;
constexpr float NORM_EPS = 1e-6f;

constexpr size_t MiB = 1u << 20;
constexpr size_t O_WIN = 0;
constexpr size_t O_WA = O_WIN + (size_t)5376 * 1024 * 2;
constexpr size_t O_WB = O_WA + 1 * MiB;
constexpr size_t O_WO = O_WB + 1 * MiB;
constexpr size_t O_WG = O_WO + 2 * MiB;
constexpr size_t O_WP = O_WG + 2 * MiB;
constexpr size_t O_WLR = O_WP + MiB / 2;
constexpr size_t O_WS = O_WLR + 3 * MiB / 4;
constexpr size_t O_U16 = O_WS + 4 * MiB;
constexpr size_t O_V16 = O_U16 + 32 * MiB;
constexpr size_t O_P16 = O_V16 + 32 * MiB;
constexpr size_t O_PART1 = O_P16 + 32 * MiB;
constexpr size_t O_PART3 = O_PART1 + 4 * MiB;
constexpr size_t O_RS1 = O_PART3 + 4 * MiB;
constexpr size_t O_RS2 = O_RS1 + MiB / 4;
constexpr size_t O_XN = O_RS2 + MiB / 4;
constexpr size_t O_ZC = O_XN + 128 * MiB;
constexpr size_t O_ZR = O_ZC + 192 * MiB;
constexpr size_t O_ZG = O_ZR + 224 * MiB;
constexpr size_t O_SS2 = O_ZG + 256 * MiB;
constexpr size_t O_USC = O_SS2 + 2 * MiB;
constexpr size_t O_VSC = O_USC + 65536;
constexpr size_t O_CTR = O_VSC + 65536;
constexpr size_t O_BAR = O_CTR + 8192;
constexpr size_t WS_END = O_BAR + 16384;
constexpr size_t O_U8 = O_U16;
constexpr size_t O_V8 = O_U16 + 16 * MiB;
constexpr size_t O_PART = O_ZG;
constexpr size_t O_COEF = O_ZR + 48 * MiB;
constexpr size_t O_CA = O_XN;
constexpr size_t O_APR = O_XN + 64 * MiB;
constexpr size_t O_H1B = O_XN;
constexpr size_t O_WD = O_ZC;
constexpr size_t O_BD = O_ZC + 64 * MiB;
constexpr size_t O_GG = O_ZC + 128 * MiB;
constexpr size_t O_MERGED = O_ZC;
constexpr size_t O_H2B = O_ZC;
constexpr size_t O_PQ = O_ZR;
constexpr size_t O_SST = O_ZR + 64 * MiB;
constexpr size_t O_Y = O_ZR + 96 * MiB;
constexpr size_t O_YB = O_ZR + 160 * MiB;
constexpr size_t O_IDX = O_ZR;
constexpr size_t O_GATE = O_ZR + 16 * MiB;
constexpr size_t O_PP = O_ZR + 64 * MiB;
constexpr size_t O_SCORES = O_ZG;

struct Args {
    const float* in[29];
    float* out;
    unsigned char* ws;
    int ph_lo, ph_hi;
};

__device__ __forceinline__ int tid_() { int t = threadIdx.x; asm volatile("" : "+v"(t)); return t; }
__device__ __forceinline__ float sigmoidf_(float x) { return __builtin_amdgcn_rcpf(1.0f + __expf(-x)); }
template <int CTRL> __device__ __forceinline__ float dpp_(float v) { return __builtin_bit_cast(float, __builtin_amdgcn_update_dpp(0, __builtin_bit_cast(int, v), CTRL, 0xF, 0xF, true)); }
__device__ __forceinline__ float x32_(float v, int lane) { const auto r = __builtin_amdgcn_permlane32_swap(__builtin_bit_cast(unsigned, v), __builtin_bit_cast(unsigned, v), false, false); return __builtin_bit_cast(float, (lane & 32) ? r[0] : r[1]); }
__device__ __forceinline__ float x16_(float v, int lane) { const auto r = __builtin_amdgcn_permlane16_swap(__builtin_bit_cast(unsigned, v), __builtin_bit_cast(unsigned, v), false, false); return __builtin_bit_cast(float, (lane & 16) ? r[0] : r[1]); }
__device__ __forceinline__ float x8_(float v) { return dpp_<0x128>(v); }
__device__ __forceinline__ float xhm_(float v) { return dpp_<0x141>(v); }
__device__ __forceinline__ float wave_sum(float v) {
    const int lane = threadIdx.x & 63;
    v += dpp_<0xB1>(v); v += dpp_<0x4E>(v); v += dpp_<0x141>(v); v += dpp_<0x140>(v);
    v += x16_(v, lane); v += x32_(v, lane);
    return v;
}
__device__ __forceinline__ __amdgpu_buffer_rsrc_t mkrsrc(const void* p) { return __builtin_amdgcn_make_buffer_rsrc((void*)p, 0, 0x7fffffff, 0x00020000); }
__device__ __forceinline__ h16x8 pack8(f32x4 a, f32x4 b) {
    h16x8 r;
    r[0] = (h16)a[0]; r[1] = (h16)a[1]; r[2] = (h16)a[2]; r[3] = (h16)a[3];
    r[4] = (h16)b[0]; r[5] = (h16)b[1]; r[6] = (h16)b[2]; r[7] = (h16)b[3];
    return r;
}
__device__ __forceinline__ h16x4 pack4(f32x4 a) {
    h16x4 r; r[0] = (h16)a[0]; r[1] = (h16)a[1]; r[2] = (h16)a[2]; r[3] = (h16)a[3]; return r;
}

#define XB_TMO      128
#define XB_XCNT(j)  (256  + 64 * (j))
#define XB_XSUB(j)  (1280 + 64 * (j))
#define XB_XGEN(j)  (2304 + 64 * (j))
#define XB_TOP      3328
#define XB_TOPGEN   3392
#define XCD_BAR_WORDS 3456
#define XB_SPIN_CAP (1u << 18)

__device__ __forceinline__ unsigned xb_ld(unsigned* p)              { return __hip_atomic_load(p, __ATOMIC_RELAXED, __HIP_MEMORY_SCOPE_AGENT); }
__device__ __forceinline__ unsigned xb_add(unsigned* p, unsigned v) { return __hip_atomic_fetch_add(p, v, __ATOMIC_RELAXED, __HIP_MEMORY_SCOPE_AGENT); }
__device__ __forceinline__ unsigned xb_xcc_id() { return (unsigned)__builtin_amdgcn_s_getreg((3 << 11) | 20) & 0xFu; }
#define XB_SPIN(cond, bar) do { unsigned _sp = 0; while (cond) { __builtin_amdgcn_s_sleep(1); \
    if ((++_sp & 255u) == 0u) { if (xb_ld(&(bar)[XB_TMO])) break; if (_sp > XB_SPIN_CAP) { atomicAdd(&(bar)[XB_TMO], 1u); break; } } } } while (0)

struct XcdBarrier {
    unsigned* bar; unsigned x;
    volatile LAS unsigned* st;
};

__device__ __forceinline__ XcdBarrier xcd_barrier_post(unsigned* bar, volatile LAS unsigned* st) {
    XcdBarrier b; b.bar = bar; b.x = xb_xcc_id(); b.st = st;
    if (threadIdx.x == 0) (void)xb_add(&bar[XB_XCNT(b.x)], 1u);
    return b;
}
__device__ __forceinline__ void xcd_barrier_complete(unsigned* bar, unsigned x, unsigned& nloc, unsigned& nx) {
    const unsigned G = gridDim.x * gridDim.y * gridDim.z;
    unsigned sum, cnt, mine, sp = 0u;
    for (;;) {
        sum = 0u; cnt = 0u; mine = 0u;
#pragma unroll
        for (unsigned j = 0; j < 16; ++j) { const unsigned c = xb_ld(&bar[XB_XCNT(j)]); sum += c; cnt += (c > 0u) ? 1u : 0u; mine = (j == x) ? c : mine; }
        if (sum == G) break;
        __builtin_amdgcn_s_sleep(1);
        if ((++sp & 255u) == 0u) { if (xb_ld(&bar[XB_TMO])) break; if (sp > XB_SPIN_CAP) { atomicAdd(&bar[XB_TMO], 1u); break; } }
    }
    nloc = mine > 0u ? mine : 1u; nx = cnt > 0u ? cnt : 1u;
}

__device__ __forceinline__ void xcd_barrier(const XcdBarrier& b) {
    asm volatile("s_waitcnt vmcnt(0)" ::: "memory");
    __syncthreads();
    if (threadIdx.x == 0) {
        unsigned* bar = b.bar;
        __builtin_amdgcn_s_waitcnt(0);
        unsigned nloc = b.st[0], nx = b.st[1];
        if (nloc == 0u) { xcd_barrier_complete(bar, b.x, nloc, nx); b.st[0] = nloc; b.st[1] = nx; }
        const unsigned old = xb_add(&bar[XB_XSUB(b.x)], 1u);
        const unsigned gen = old / nloc;
        if (old + 1u == (gen + 1u) * nloc) {
            __builtin_amdgcn_fence(__ATOMIC_RELEASE, "agent");
            asm volatile("s_waitcnt vmcnt(0)" ::: "memory");
            const unsigned og = xb_add(&bar[XB_TOP], 1u);
            const unsigned tg = og / nx;
            if (og + 1u == (tg + 1u) * nx) xb_add(&bar[XB_TOPGEN], 1u);
            else XB_SPIN(xb_ld(&bar[XB_TOPGEN]) == tg, bar);
            __builtin_amdgcn_fence(__ATOMIC_ACQUIRE, "agent");
            xb_add(&bar[XB_XGEN(b.x)], 1u);
            asm volatile("s_waitcnt vmcnt(0)" ::: "memory");
        } else {
            XB_SPIN(xb_ld(&bar[XB_XGEN(b.x)]) == gen, bar);
            __builtin_amdgcn_fence(__ATOMIC_ACQUIRE, "agent");
            asm volatile("s_waitcnt vmcnt(0)" ::: "memory");
        }
    }
    __syncthreads();
}


namespace pg8 {
constexpr int BM = 256, BK = 64, HALF = 128, HTB = HALF * BK * 2, STAGE_BYTES = 8 * HTB, NXCD = 8, WGM = 8;
__device__ __forceinline__ int lds_byte(int r, int c) { const int st = (r >> 4) * 2 + (c >> 5), rr = r & 15, cc = c & 31, ob = rr * 64 + cc * 2; return st * 1024 + (ob ^ (((ob >> 9) & 1) << 5)); }
__device__ __forceinline__ void stage_rc(int b, int& R, int& C) { const int st = b / 1024, sb = b % 1024, swz = sb ^ (((sb >> 9) & 1) << 5); R = (st >> 1) * 16 + swz / 64; C = (st & 1) * 32 + (swz % 64) / 2; }
__device__ __forceinline__ int perm32(int rho) { const int n = rho >> 4, i = rho & 15; return 8 * (i >> 2) + 4 * n + (i & 3); }

struct Unit { int pm, pn; };
struct Gemm { const h16* A; const h16* Bt; int M, N, K; };

struct StaticOrder {
    int nM, nN, nwg, G, c;
    __device__ void init(int M, int N, int G_, int c_) { nM = M / BM; nN = N / BM; nwg = nM * nN; G = G_; c = c_; }
    __device__ bool next(int i, Unit& u) const {
        const long L = (long)i * G + c; if (L >= nwg) return false;
        int wgid = (int)L; { const int q = nwg / NXCD, r = nwg % NXCD, xcd = wgid % NXCD, off = wgid / NXCD; wgid = (xcd < r ? xcd * (q + 1) : r * (q + 1) + (xcd - r) * q) + off; }
        const int nig = WGM * nN, gid = wgid / nig, fm = gid * WGM, gsz = (nM - fm) < WGM ? (nM - fm) : WGM;
        u.pm = fm + ((wgid % nig) % gsz); u.pn = (wgid % nig) / gsz; return true;
    }
};

template <class Epi>
__device__ __forceinline__ void gemm_phase(LAS unsigned char* lds, const Gemm g, const StaticOrder& S, const Epi& E) {
    const int tid = tid_(), wid = __builtin_amdgcn_readfirstlane(tid >> 6), lane = tid & 63, wr = wid >> 2, wc = wid & 3, fr = lane & 15, fq = lane >> 4;
    const int K = g.K, nt = K / BK;
    unsigned voffA[2], voffB[2];
#pragma unroll
    for (int i = 0; i < 2; ++i) { int R, C; stage_rc(tid * 16 + i * 8192, R, C); const int Rb = (R & ~31) + perm32(R & 31);
        voffA[i] = (unsigned)(R * K + C) * 2u; voffB[i] = (unsigned)(Rb * K + C) * 2u; }
    const size_t kstep = (size_t)(BK * 2);
    const size_t hstep = (size_t)HALF * K * 2;
    const size_t tstep = 2 * hstep;
    const unsigned ldsw = (unsigned)wid * 1024u;
    const int aoff = lds_byte(wr * 64 + fr, fq * 8), boff = lds_byte(wc * 32 + fr, fq * 8);
#define PG8_SA(b, h) (((b) * 2 + (h)) * HTB)
#define PG8_SB(b, h) ((4 + (b) * 2 + (h)) * HTB)
#define PG8_STAGE(bufoff, gbase, voff) do { _Pragma("unroll") for (int _i = 0; _i < 2; ++_i) \
        __builtin_amdgcn_global_load_lds((const unsigned*)((const char*)(gbase) + (voff)[_i]), (LAS unsigned*)(lds + (bufoff) + ldsw + _i * 8192), 16, 0, 0); } while (0)
#define PG8_LDA(dst, b, h) do { _Pragma("unroll") for (int m = 0; m < 4; ++m) _Pragma("unroll") for (int k = 0; k < 2; ++k) dst[m][k] = *(const LAS h16x8*)(lds + PG8_SA(b, h) + aoff + m * 2048 + k * 1024); } while (0)
#define PG8_LDB(dst, b, h) do { _Pragma("unroll") for (int n = 0; n < 2; ++n) _Pragma("unroll") for (int k = 0; k < 2; ++k) dst[n][k] = *(const LAS h16x8*)(lds + PG8_SB(b, h) + boff + n * 2048 + k * 1024); } while (0)
#define PG8_MMA(ai, bj, At, Bt) do { __builtin_amdgcn_s_setprio(1); _Pragma("unroll") for (int m = 0; m < 4; ++m) _Pragma("unroll") for (int n = 0; n < 2; ++n) _Pragma("unroll") for (int k = 0; k < 2; ++k) \
        acc[ai][bj][m][n] = __builtin_amdgcn_mfma_f32_16x16x32_f16(Bt[n][k], At[m][k], acc[ai][bj][m][n], 0, 0, 0); __builtin_amdgcn_s_setprio(0); } while (0)
#define PG8_WAIT_V(n) asm volatile("s_waitcnt vmcnt(" #n ")" ::: "memory")
#define PG8_WAIT_L(n) asm volatile("s_waitcnt lgkmcnt(" #n ")" ::: "memory")
#define PG8_BAR __builtin_amdgcn_s_barrier()
#define PG8_SCHED __builtin_amdgcn_sched_barrier(0)
    Unit cur, nxt; int ui = 0;
    if (!S.next(0, cur)) return;
    f32x4 acc[2][2][4][2];
#pragma unroll
    for (int a = 0; a < 2; ++a)
#pragma unroll
        for (int b = 0; b < 2; ++b)
#pragma unroll
            for (int m = 0; m < 4; ++m)
#pragma unroll
                for (int n = 0; n < 2; ++n) acc[a][b][m][n] = (f32x4){0.f, 0.f, 0.f, 0.f};
    h16x8 At[4][2], B0[2][2], B1[2][2];
    const char* cA = (const char*)g.A + (size_t)cur.pm * tstep; const char* cB = (const char*)g.Bt + (size_t)cur.pn * tstep;
    PG8_STAGE(PG8_SB(0, 0), cB, voffB); PG8_STAGE(PG8_SB(0, 1), cB + hstep, voffB); PG8_STAGE(PG8_SA(0, 0), cA, voffA); PG8_STAGE(PG8_SA(0, 1), cA + hstep, voffA);
    if (wr == 1) PG8_BAR;
    PG8_WAIT_V(2); PG8_BAR;
    PG8_STAGE(PG8_SB(1, 0), cB + kstep, voffB); PG8_STAGE(PG8_SA(1, 0), cA + kstep, voffA); PG8_STAGE(PG8_SB(1, 1), cB + hstep + kstep, voffB);
    PG8_WAIT_V(6); PG8_BAR;
    for (;;) {
        const bool has_next = S.next(ui + 1, nxt);
        const char* nA = has_next ? (const char*)g.A + (size_t)nxt.pm * tstep : cA; const char* nB = has_next ? (const char*)g.Bt + (size_t)nxt.pn * tstep : cB;
        for (int t = 0; t < nt; t += 2) {
            const bool last = (t == nt - 2);
            const char* a1 = cA + (size_t)(t + 1) * kstep;
            const char* a2 = last ? nA : cA + (size_t)(t + 2) * kstep; const char* b2 = last ? nB : cB + (size_t)(t + 2) * kstep;
            const char* a3 = a2 + kstep; const char* b3 = b2 + kstep;
            PG8_LDB(B0, 0, 0); PG8_LDB(B1, 0, 1); PG8_SCHED; PG8_LDA(At, 0, 0); PG8_STAGE(PG8_SA(1, 1), a1 + hstep, voffA);
            PG8_WAIT_V(8); PG8_WAIT_L(0); PG8_BAR; PG8_MMA(0, 0, At, B0); PG8_MMA(0, 1, At, B1); PG8_BAR; PG8_SCHED;
            PG8_LDA(At, 0, 1); PG8_STAGE(PG8_SB(0, 0), b2, voffB); PG8_STAGE(PG8_SB(0, 1), b2 + hstep, voffB); PG8_STAGE(PG8_SA(0, 0), a2, voffA);
            PG8_WAIT_V(8); PG8_WAIT_L(0); PG8_BAR; PG8_MMA(1, 0, At, B0); PG8_MMA(1, 1, At, B1); PG8_BAR; PG8_SCHED;
            PG8_LDB(B0, 1, 0); PG8_LDB(B1, 1, 1); PG8_SCHED; PG8_LDA(At, 1, 0); PG8_STAGE(PG8_SA(0, 1), a2 + hstep, voffA);
            PG8_WAIT_V(8); PG8_WAIT_L(0); PG8_BAR; PG8_MMA(0, 0, At, B0); PG8_MMA(0, 1, At, B1); PG8_BAR; PG8_SCHED;
            PG8_LDA(At, 1, 1); PG8_STAGE(PG8_SB(1, 0), b3, voffB); PG8_STAGE(PG8_SB(1, 1), b3 + hstep, voffB); PG8_STAGE(PG8_SA(1, 0), a3, voffA);
            PG8_WAIT_V(8); PG8_WAIT_L(0); PG8_BAR; PG8_MMA(1, 0, At, B0); PG8_MMA(1, 1, At, B1); PG8_BAR; PG8_SCHED;
        }
        if (wr == 0) PG8_BAR;
        E(acc, cur, wr, wc, fr, fq);
        if (!has_next) break;
#pragma unroll
        for (int a = 0; a < 2; ++a)
#pragma unroll
            for (int b = 0; b < 2; ++b)
#pragma unroll
                for (int m = 0; m < 4; ++m)
#pragma unroll
                    for (int n = 0; n < 2; ++n) acc[a][b][m][n] = (f32x4){0.f, 0.f, 0.f, 0.f};
        cur = nxt; cA = nA; cB = nB; ++ui;
        if (wr == 1) PG8_BAR;
    }
    PG8_WAIT_V(0);
    PG8_BAR;
#undef PG8_SA
#undef PG8_SB
#undef PG8_STAGE
#undef PG8_LDA
#undef PG8_LDB
#undef PG8_MMA
#undef PG8_WAIT_V
#undef PG8_WAIT_L
#undef PG8_BAR
#undef PG8_SCHED
}
}
using pg8::Unit;
typedef const f32x4 (&AccRef)[2][2][4][2];

#define EPI_LOOP_BEGIN \
    _Pragma("unroll") for (int ai = 0; ai < 2; ++ai) _Pragma("unroll") for (int m = 0; m < 4; ++m) { \
        const int row = u.pm * 256 + ai * 128 + wr * 64 + m * 16 + fr; \
        _Pragma("unroll") for (int bj = 0; bj < 2; ++bj) { \
            const int col = u.pn * 256 + bj * 128 + wc * 32 + 8 * fq; \
            const f32x4 v0 = acc[ai][bj][m][0], v1 = acc[ai][bj][m][1];
#define EPI_LOOP_END } }

struct EpiZ {
    h16 *zc, *zr, *zg;
    __device__ __forceinline__ void operator()(AccRef acc, const Unit& u, int wr, int wc, int fr, int fq) const {
        const int colt = u.pn * 256; h16* base; int ld, c0;
        if (colt < 1536) { base = zc; ld = 1536; c0 = colt; } else if (colt < 3328) { base = zr; ld = 1792; c0 = colt - 1536; } else { base = zg; ld = 2048; c0 = colt - 3328; }
        EPI_LOOP_BEGIN
            *(h16x8*)(base + (size_t)row * ld + (col - colt + c0)) = pack8(v0, v1);
        EPI_LOOP_END
    }
};
struct EpiF16 {
    h16* O; int ld;
    __device__ __forceinline__ void operator()(AccRef acc, const Unit& u, int wr, int wc, int fr, int fq) const {
        EPI_LOOP_BEGIN
            *(h16x8*)(O + (size_t)row * ld + col) = pack8(v0, v1);
        EPI_LOOP_END
    }
};
struct EpiYA {
    const h16* zg; h16* tmp;
    __device__ __forceinline__ void operator()(AccRef acc, const Unit& u, int wr, int wc, int fr, int fq) const {
        EPI_LOOP_BEGIN
            const h16x8 gv = *(const h16x8*)(zg + (size_t)row * 2048 + col);
            f32x4 o0, o1;
#pragma unroll
            for (int j = 0; j < 4; ++j) { o0[j] = sigmoidf_((float)gv[j]) * v0[j]; o1[j] = sigmoidf_((float)gv[4 + j]) * v1[j]; }
            *(h16x8*)(tmp + (size_t)row * 1024 + col) = pack8(o0, o1);
        EPI_LOOP_END
    }
};
struct EpiYB {
    const h16* zg; const h16* tmp; h16* merged;
    __device__ __forceinline__ void operator()(AccRef acc, const Unit& u, int wr, int wc, int fr, int fq) const {
        EPI_LOOP_BEGIN
            const h16x8 gv = *(const h16x8*)(zg + (size_t)row * 2048 + 1024 + col);
            const h16x8 tv = *(const h16x8*)(tmp + (size_t)row * 1024 + col);
            f32x4 o0, o1;
#pragma unroll
            for (int j = 0; j < 4; ++j) { o0[j] = (float)tv[j] + sigmoidf_((float)gv[j]) * v0[j]; o1[j] = (float)tv[4 + j] + sigmoidf_((float)gv[4 + j]) * v1[j]; }
            *(h16x8*)(merged + (size_t)row * 1024 + col) = pack8(o0, o1);
        EPI_LOOP_END
    }
};
struct EpiH1 {
    const float* x; float* out; h16* hb; float* part;
    __device__ __forceinline__ void operator()(AccRef acc, const Unit& u, int wr, int wc, int fr, int fq) const {
#pragma unroll
        for (int ai = 0; ai < 2; ++ai)
#pragma unroll
            for (int m = 0; m < 4; ++m) {
                const int row = u.pm * 256 + ai * 128 + wr * 64 + m * 16 + fr; float ss = 0.f;
#pragma unroll
                for (int bj = 0; bj < 2; ++bj) {
                    const int col = u.pn * 256 + bj * 128 + wc * 32 + 8 * fq;
                    const float* xp = x + (size_t)row * 1024 + col;
                    f32x4 o0 = *(const f32x4*)xp + acc[ai][bj][m][0], o1 = *(const f32x4*)(xp + 4) + acc[ai][bj][m][1];
                    float* op = out + (size_t)row * 1024 + col;
                    *(f32x4*)op = o0; *(f32x4*)(op + 4) = o1;
                    *(h16x8*)(hb + (size_t)row * 1024 + col) = pack8(o0, o1);
                    ss += (o0[0] * o0[0] + o0[1] * o0[1]) + (o0[2] * o0[2] + o0[3] * o0[3]) + (o1[0] * o1[0] + o1[1] * o1[1]) + (o1[2] * o1[2] + o1[3] * o1[3]);
                }
                ss += __shfl_xor(ss, 16); ss += __shfl_xor(ss, 32);
                if (fq == 0) part[(size_t)row * 16 + u.pn * 4 + wc] = ss;
            }
    }
};
struct EpiGate {
    float* out; const h16* pp; const float* rs2; float* part;
    __device__ __forceinline__ void operator()(AccRef acc, const Unit& u, int wr, int wc, int fr, int fq) const {
#pragma unroll
        for (int ai = 0; ai < 2; ++ai)
#pragma unroll
            for (int m = 0; m < 4; ++m) {
                const int row = u.pm * 256 + ai * 128 + wr * 64 + m * 16 + fr; float ss = 0.f;
                const f32x4 sa = *(const f32x4*)(rs2 + (size_t)row * 8), sb = *(const f32x4*)(rs2 + (size_t)row * 8 + 4);
                const float rs = rsqrtf(((sa[0] + sa[1]) + (sa[2] + sa[3]) + (sb[0] + sb[1]) + (sb[2] + sb[3])) * (1.f / 1024.f) + NORM_EPS);
#pragma unroll
                for (int bj = 0; bj < 2; ++bj) {
                    const int col = u.pn * 256 + bj * 128 + wc * 32 + 8 * fq;
                    float* op = out + (size_t)row * 1024 + col;
                    f32x4 o0 = *(const f32x4*)op, o1 = *(const f32x4*)(op + 4);
                    const h16x8 pv = *(const h16x8*)(pp + (size_t)row * 1024 + col);
                    const f32x4 v0 = acc[ai][bj][m][0], v1 = acc[ai][bj][m][1];
#pragma unroll
                    for (int j = 0; j < 4; ++j) { o0[j] += sigmoidf_(rs * v0[j]) * (float)pv[j]; o1[j] += sigmoidf_(rs * v1[j]) * (float)pv[4 + j]; }
                    *(f32x4*)op = o0; *(f32x4*)(op + 4) = o1;
                    ss += (o0[0] * o0[0] + o0[1] * o0[1]) + (o0[2] * o0[2] + o0[3] * o0[3]) + (o1[0] * o1[0] + o1[1] * o1[1]) + (o1[2] * o1[2] + o1[3] * o1[3]);
                }
                ss += __shfl_xor(ss, 16); ss += __shfl_xor(ss, 32);
                if (fq == 0) part[(size_t)row * 16 + u.pn * 4 + wc] = ss;
            }
    }
};

__device__ __forceinline__ void tr_item(const float* W, int N, const float* g, h16* WT, int ldk, int koff, int k0, int n0, LAS float* scr, int lane) {
#pragma unroll 8
    for (int i = 0; i < 32; ++i) { const int kk = 2 * i + (lane >> 5); float v = W[(size_t)(k0 + kk) * N + n0 + (lane & 31)]; if (g) v *= g[k0 + kk]; scr[kk * 33 + (lane & 31)] = v; }
    asm volatile("s_waitcnt lgkmcnt(0)" ::: "memory");
    const int c = lane & 7;
#pragma unroll
    for (int j = 0; j < 4; ++j) { const int n = (lane >> 3) + 8 * j; const LAS float* s = scr + (8 * c) * 33 + n;
        h16x8 o;
#pragma unroll
        for (int e = 0; e < 8; ++e) o[e] = (h16)s[e * 33];
        *(h16x8*)(WT + (size_t)(n0 + n) * ldk + koff + k0 + 8 * c) = o; }
    asm volatile("s_waitcnt lgkmcnt(0)" ::: "memory");
}
struct TrJob { const float* W; const float* g; h16* WT; int K, N, ldk, koff; };

__device__ __forceinline__ void phase_prep(const Args& a, LAS unsigned char* lds) {
    const int tid = tid_(), lane = tid & 63, wave = tid >> 6;
    const int gw = blockIdx.x * NWAVES + wave, NGW = gridDim.x * NWAVES;
    unsigned char* ws = a.ws;
    {
        LAS float* scr = (LAS float*)(lds + wave * 8704);
        TrJob jobs[9] = {
            {a.in[3], a.in[2], (h16*)(ws + O_WIN), 1024, NIN, 1024, 0},
            {a.in[17], nullptr, (h16*)(ws + O_WA), 512, 1024, 512, 0},
            {a.in[18], nullptr, (h16*)(ws + O_WB), 512, 1024, 512, 0},
            {a.in[19], nullptr, (h16*)(ws + O_WO), 1024, 1024, 1024, 0},
            {a.in[26], a.in[25], (h16*)(ws + O_WG), 1024, 1024, 1024, 0},
            {a.in[27], nullptr, (h16*)(ws + O_WP), 256, 1024, 256, 0},
            {a.in[8], nullptr, (h16*)(ws + O_WLR), 64, 512, 256, 0},
            {a.in[10], nullptr, (h16*)(ws + O_WLR) + (size_t)512 * 256, 64, 512, 256, 64},
            {a.in[11], nullptr, (h16*)(ws + O_WLR) + (size_t)1024 * 256, 128, 512, 256, 128},
        };
        int base = 0;
#pragma unroll
        for (int j = 0; j < 9; ++j) {
            const TrJob J = jobs[j]; const int nnb = J.N / 32, items = (J.K / 64) * nnb;
            int first = gw - (base % NGW); if (first < 0) first += NGW;
            for (int r = first; r < items; r += NGW) tr_item(J.W, J.N, J.g, J.WT, J.ldk, J.koff, (r / nnb) * 64, (r % nnb) * 32, scr, lane);
            base += items;
        }
        h16* wlr = (h16*)(ws + O_WLR);
        for (int i = blockIdx.x * NTHREADS + tid; i < 1536 * 256 / 8; i += gridDim.x * NTHREADS) {
            const int n = (i * 8) / 256, k = (i * 8) % 256; const int blk = n / 512;
            const bool inblk = (blk == 0) ? (k < 64) : (blk == 1) ? (k >= 64 && k < 128) : (k >= 128);
            if (!inblk) { h16x8 z; for (int e = 0; e < 8; ++e) z[e] = (h16)0.f; *(h16x8*)(wlr + (size_t)i * 8) = z; }
        }
    }
    __syncthreads();
    {
        LAS float* LA = (LAS float*)lds;
        LAS float* LB = (LAS float*)(lds + 64 * 129 * 4);
        const float* wq = a.in[21]; const float* sk = a.in[22]; const float* gf = a.in[20];
        h16* wst = (h16*)(ws + O_WS);
        for (int it = blockIdx.x; it < 256; it += gridDim.x) {
            const int g16 = it >> 4, k0 = (it & 15) * 64;
            for (int i = tid; i < 64 * 128; i += NTHREADS) { const int k = i >> 7, d = i & 127; LA[k * 129 + d] = wq[(size_t)(k0 + k) * 2048 + g16 * 128 + d] * gf[k0 + k]; }
            for (int i = tid; i < 128 * 128; i += NTHREADS) { const int n = i >> 7, d = i & 127; LB[n * 129 + d] = sk[((size_t)g16 * 128 + n) * 128 + d]; }
            __syncthreads();
            const int n = tid & 127, kg = tid >> 7;
            float o[16];
#pragma unroll
            for (int j = 0; j < 16; ++j) o[j] = 0.f;
            for (int d = 0; d < 128; ++d) { const float b = LB[n * 129 + d];
#pragma unroll
                for (int j = 0; j < 16; ++j) o[j] += LA[(kg * 16 + j) * 129 + d] * b; }
            h16x8 o0, o1;
#pragma unroll
            for (int j = 0; j < 8; ++j) { o0[j] = (h16)o[j]; o1[j] = (h16)o[8 + j]; }
            h16* dst = wst + (size_t)(g16 * 128 + n) * 1024 + k0 + kg * 16;
            *(h16x8*)dst = o0; *(h16x8*)(dst + 8) = o1;
            __syncthreads();
        }
    }
    {
        const float* gf = a.in[20];
        f32x4 g4[4];
#pragma unroll
        for (int j = 0; j < 4; ++j) g4[j] = *(const f32x4*)(gf + 16 * lane + 4 * j);
        for (int r = gw; r < 2 * 16384; r += NGW) {
            const int tb = r >> 14, e = r & 16383;
            const float* src = (tb ? a.in[24] : a.in[23]) + (size_t)e * 1024 + 16 * lane;
            f32x4 v[4]; float mx = 0.f;
#pragma unroll
            for (int j = 0; j < 4; ++j) { v[j] = *(const f32x4*)(src + 4 * j); if (!tb) v[j] = v[j] * g4[j];
#pragma unroll
                for (int c = 0; c < 4; ++c) mx = fmaxf(mx, fabsf(v[j][c])); }
#pragma unroll
            for (int o = 1; o < 64; o <<= 1) mx = fmaxf(mx, __shfl_xor(mx, o));
            mx = fmaxf(mx, 1e-30f);
            const float sc = 224.0f / mx;
            u32x4 q;
#pragma unroll
            for (int j = 0; j < 4; ++j) { int w = 0; w = __builtin_amdgcn_cvt_pk_fp8_f32(v[j][0] * sc, v[j][1] * sc, w, false); w = __builtin_amdgcn_cvt_pk_fp8_f32(v[j][2] * sc, v[j][3] * sc, w, true); q[j] = (unsigned)w; }
            unsigned char* dst = ws + (tb ? O_V8 : O_U8) + ((size_t)(lane >> 3) * 16384 + e) * 128 + 16 * (lane & 7);
            *(u32x4*)dst = q;
            if (lane == 0) ((float*)(ws + (tb ? O_VSC : O_USC)))[e] = mx * (1.0f / 224.0f);
        }
        if (blockIdx.x == 0 && tid < 32) ((unsigned*)(ws + O_CTR))[tid * 64] = 0u;
        const f32x4* pp = (const f32x4*)a.in[1]; h16x4* dp = (h16x4*)(ws + O_P16);
        const int np4 = MTOK * 256 / 4;
        for (int i = blockIdx.x * NTHREADS + tid; i < np4; i += gridDim.x * NTHREADS) dp[i] = pack4(pp[i]);
    }
    {
        const float* x = a.in[0]; h16* xn = (h16*)(ws + O_XN);
        for (int r = gw; r < MTOK; r += NGW) {
            const f32x4* xr = (const f32x4*)(x + (size_t)r * 1024) + lane;
            f32x4 v[4]; float s = 0.f;
#pragma unroll
            for (int j = 0; j < 4; ++j) { v[j] = xr[64 * j]; s += (v[j][0] * v[j][0] + v[j][1] * v[j][1]) + (v[j][2] * v[j][2] + v[j][3] * v[j][3]); }
            const float rs = rsqrtf(wave_sum(s) * (1.f / 1024.f) + NORM_EPS);
            h16x4* o = (h16x4*)(xn + (size_t)r * 1024) + lane;
#pragma unroll
            for (int j = 0; j < 4; ++j) o[64 * j] = pack4(v[j] * rs);
        }
    }
}

__device__ __forceinline__ void phase_conv(const Args& a) {
    const int tid = tid_(), lane = tid & 63, wave = tid >> 6;
    const int gw = blockIdx.x * NWAVES + wave, NGW = gridDim.x * NWAVES;
    const h16* zc = (const h16*)(a.ws + O_ZC); h16* ca = (h16*)(a.ws + O_CA);
    const float* cw = a.in[4]; const float* cb = a.in[5];
    float w0[8], w1[8], w2[8], bb[8];
#pragma unroll
    for (int j = 0; j < 8; ++j) { const int c = lane * 8 + j; w0[j] = cw[c]; w1[j] = cw[512 + c]; w2[j] = cw[1024 + c]; bb[j] = cb[c]; }
    for (int run = gw; run < MTOK / 32; run += NGW) {
        const int t0 = run * 32;
        float u1[8], u2[8];
        if ((t0 % SEQ) == 0) {
#pragma unroll
            for (int j = 0; j < 8; ++j) { u1[j] = 0.f; u2[j] = 0.f; }
        } else {
            const h16x8 c1 = *(const h16x8*)(zc + (size_t)(t0 - 1) * 1536 + 512 + lane * 8), x1 = *(const h16x8*)(zc + (size_t)(t0 - 1) * 1536 + 1024 + lane * 8);
            const h16x8 c2 = *(const h16x8*)(zc + (size_t)(t0 - 2) * 1536 + 512 + lane * 8), x2 = *(const h16x8*)(zc + (size_t)(t0 - 2) * 1536 + 1024 + lane * 8);
#pragma unroll
            for (int j = 0; j < 8; ++j) { u1[j] = (float)c1[j] * (float)x1[j]; u2[j] = (float)c2[j] * (float)x2[j]; }
        }
        for (int t = t0; t < t0 + 32; ++t) {
            const h16* zrow = zc + (size_t)t * 1536 + lane * 8;
            const h16x8 gb = *(const h16x8*)zrow, gc = *(const h16x8*)(zrow + 512), xi = *(const h16x8*)(zrow + 1024);
            h16x8 o;
#pragma unroll
            for (int j = 0; j < 8; ++j) { const float u0 = (float)gc[j] * (float)xi[j];
                const float y = w0[j] * u2[j] + w1[j] * u1[j] + w2[j] * u0 + bb[j];
                o[j] = (h16)((float)gb[j] * y); u2[j] = u1[j]; u1[j] = u0; }
            *(h16x8*)(ca + (size_t)t * 512 + lane * 8) = o;
        }
    }
}


__device__ __forceinline__ float tanhf_(float x) { return 1.0f - 2.0f * __builtin_amdgcn_rcpf(1.0f + __expf(2.0f * x)); }
__device__ __forceinline__ void phase_rwkv_prep(const Args& a) {
    const int tid = tid_(), lane = tid & 63, wave = tid >> 6;
    const int gw = blockIdx.x * NWAVES + wave, NGW = gridDim.x * NWAVES;
    const h16* zr = (const h16*)(a.ws + O_ZR);
    h16* R = (h16*)a.out; h16* KS = R + (size_t)MTOK * 512; h16* V = KS + (size_t)MTOK * 512; h16* KK = V + (size_t)MTOK * 512;
    h16* APR = (h16*)(a.ws + O_APR);
    const float* mu = a.in[6]; const float* k_k = a.in[12];
    float mr[8], mk[8], mv[8], mt[8], kk8[8];
#pragma unroll
    for (int j = 0; j < 8; ++j) { const int c = lane * 8 + j; mr[j] = mu[c]; mk[j] = mu[512 + c]; mv[j] = mu[1024 + c]; mt[j] = mu[1536 + (c & 255)]; kk8[j] = k_k[c]; }
    for (int run = gw; run < MTOK / 32; run += NGW) {
        const int t0 = run * 32;
        float pr[8], pk[8], pv[8], pt[8];
        if ((t0 % SEQ) == 0) {
#pragma unroll
            for (int j = 0; j < 8; ++j) { pr[j] = 0.f; pk[j] = 0.f; pv[j] = 0.f; pt[j] = 0.f; }
        } else {
            const h16* zp = zr + (size_t)(t0 - 1) * 1792 + lane * 8;
            const h16x8 a0 = *(const h16x8*)zp, a1 = *(const h16x8*)(zp + 512), a2 = *(const h16x8*)(zp + 1024), a3 = *(const h16x8*)(zr + (size_t)(t0 - 1) * 1792 + 1536 + (lane & 31) * 8);
#pragma unroll
            for (int j = 0; j < 8; ++j) { pr[j] = (float)a0[j]; pk[j] = (float)a1[j]; pv[j] = (float)a2[j]; pt[j] = (float)a3[j]; }
        }
        for (int t = t0; t < t0 + 32; ++t) {
            const h16* zp = zr + (size_t)t * 1792 + lane * 8;
            const h16x8 a0 = *(const h16x8*)zp, a1 = *(const h16x8*)(zp + 512), a2 = *(const h16x8*)(zp + 1024), a3 = *(const h16x8*)(zr + (size_t)t * 1792 + 1536 + (lane & 31) * 8);
            h16x8 orr, ok, ov, okk, ot; float kr[8]; float ss = 0.f;
#pragma unroll
            for (int j = 0; j < 8; ++j) {
                const float zr_ = (float)a0[j], zk_ = (float)a1[j], zv_ = (float)a2[j], zt_ = (float)a3[j];
                const float r = zr_ + mr[j] * (pr[j] - zr_), k = zk_ + mk[j] * (pk[j] - zk_), v = zv_ + mv[j] * (pv[j] - zv_), tl = zt_ + mt[j] * (pt[j] - zt_);
                pr[j] = zr_; pk[j] = zk_; pv[j] = zv_; pt[j] = zt_;
                orr[j] = (h16)r; ok[j] = (h16)k; ov[j] = (h16)v;
                kr[j] = k * kk8[j]; ss += kr[j] * kr[j];
                const float tv = (lane < 8) ? tanhf_(tl) : (lane < 16) ? tl : sigmoidf_(tl);
                ot[j] = (h16)tv;
            }
            ss += __shfl_xor(ss, 1); ss += __shfl_xor(ss, 2); ss += __shfl_xor(ss, 4);
            const float rn = rsqrtf(ss + 1e-12f);
#pragma unroll
            for (int j = 0; j < 8; ++j) okk[j] = (h16)(kr[j] * rn);
            const size_t o = (size_t)t * 512 + lane * 8;
            *(h16x8*)(R + o) = orr; *(h16x8*)(KS + o) = ok; *(h16x8*)(V + o) = ov; *(h16x8*)(KK + o) = okk;
            if (lane < 32) *(h16x8*)(APR + (size_t)t * 256 + lane * 8) = ot;
        }
    }
}

struct EpiLR {
    const float *w0, *a0, *k_a; h16 *WD, *KS, *BD, *GG; const h16* KK;
    __device__ __forceinline__ void operator()(AccRef acc, const Unit& u, int wr, int wc, int fr, int fq) const {
        const int part = u.pn >> 1;
        EPI_LOOP_BEGIN
            const int c = col - part * 512; const size_t o = (size_t)row * 512 + c;
            if (part == 0) {
                const f32x4 b0 = *(const f32x4*)(w0 + c), b1 = *(const f32x4*)(w0 + c + 4); f32x4 o0, o1;
#pragma unroll
                for (int j = 0; j < 4; ++j) { o0[j] = __expf(-0.6065306597126334f * sigmoidf_(b0[j] + v0[j])); o1[j] = __expf(-0.6065306597126334f * sigmoidf_(b1[j] + v1[j])); }
                *(h16x8*)(WD + o) = pack8(o0, o1);
            } else if (part == 1) {
                const f32x4 b0 = *(const f32x4*)(a0 + c), b1 = *(const f32x4*)(a0 + c + 4), ka0 = *(const f32x4*)(k_a + c), ka1 = *(const f32x4*)(k_a + c + 4);
                const h16x8 ks = *(const h16x8*)(KS + o), kk = *(const h16x8*)(KK + o); f32x4 k0, k1, bb0, bb1;
#pragma unroll
                for (int j = 0; j < 4; ++j) { const float aa0 = sigmoidf_(b0[j] + v0[j]), aa1 = sigmoidf_(b1[j] + v1[j]);
                    k0[j] = (float)ks[j] * (1.0f + (aa0 - 1.0f) * ka0[j]); k1[j] = (float)ks[4 + j] * (1.0f + (aa1 - 1.0f) * ka1[j]);
                    bb0[j] = aa0 * (float)kk[j]; bb1[j] = aa1 * (float)kk[4 + j]; }
                *(h16x8*)(KS + o) = pack8(k0, k1); *(h16x8*)(BD + o) = pack8(bb0, bb1);
            } else {
                *(h16x8*)(GG + o) = pack8(v0, v1);
            }
        EPI_LOOP_END
    }
};

constexpr int SC_L = 256, SC_NCH = SEQ / SC_L, SC_NB = 8;
constexpr int SC_STEP_F = 6 * 64;
constexpr int SC_WAVE_BYTES = SC_NB * SC_STEP_F * 4 + SC_NB * 64 * 4;
__device__ __forceinline__ float quad_sum(float v) { v += dpp_<0xB1>(v); v += dpp_<0x4E>(v); return v; }
__device__ __forceinline__ void lds_ld8x2(const LAS float* p, f32x2 (&o)[8]) {
#pragma unroll
    for (int j4 = 0; j4 < 4; ++j4) { const f32x4 t = *(const LAS f32x4*)(p + 4 * j4); o[2 * j4] = (f32x2){t[0], t[1]}; o[2 * j4 + 1] = (f32x2){t[2], t[3]}; }
}
template <int MODE>
__device__ __forceinline__ void scan_wave(const Args& a, LAS unsigned char* lds, int task) {
    const int tid = tid_(), lane = tid & 63, wave = tid >> 6;
    const int q = lane & 3, rg = lane >> 2;
    const int chain = task / SC_NCH, chunk = task % SC_NCH, b = chain >> 3, h = chain & 7;
    const size_t row0 = (size_t)b * SEQ + (size_t)chunk * SC_L;
    const h16* R = (const h16*)a.out; const h16* KS = R + (size_t)MTOK * 512; const h16* V = KS + (size_t)MTOK * 512; const h16* KK = V + (size_t)MTOK * 512;
    const h16* WD = (const h16*)(a.ws + O_WD); const h16* BD = (const h16*)(a.ws + O_BD);
    LAS float* buf = (LAS float*)(lds + wave * SC_WAVE_BYTES);
    LAS float* ybuf = buf + SC_NB * SC_STEP_F;
    constexpr int NA = (MODE == 0) ? 5 : (MODE == 1) ? 3 : 6;
    const h16* gp[NA]; int lo[NA];
#pragma unroll
    for (int j = 0; j < NA; ++j) { const int p = lane + 64 * j, seg = p >> 3, part = p & 7, st = seg / NA, ai = seg % NA;
        const int ar = (MODE == 0 && ai == 4) ? 5 : ai;
        const h16* base = (ar == 0) ? KK : (ar == 1) ? WD : (ar == 2) ? BD : (ar == 3) ? KS : (ar == 4) ? R : V;
        gp[j] = base + (row0 + st) * 512 + h * 64 + part * 8; lo[j] = st * SC_STEP_F + ar * 64 + part * 8; }
    f32x2 s[4][8];
    if (MODE == 0) {
#pragma unroll
        for (int i = 0; i < 4; ++i)
#pragma unroll
            for (int j = 0; j < 8; ++j) s[i][j] = (f32x2){0.f, 0.f};
    } else if (MODE == 1) {
#pragma unroll
        for (int i = 0; i < 4; ++i)
#pragma unroll
            for (int j = 0; j < 8; ++j) s[i][j] = (f32x2){(i == q && 2 * j == rg) ? 1.f : 0.f, (i == q && 2 * j + 1 == rg) ? 1.f : 0.f};
    } else {
        const float* S0 = (const float*)(a.ws + O_SST) + (size_t)task * 4096;
#pragma unroll
        for (int i = 0; i < 4; ++i)
#pragma unroll
            for (int j4 = 0; j4 < 4; ++j4) { const f32x4 t = *(const f32x4*)(S0 + (rg + 16 * i) * 64 + 16 * q + 4 * j4);
                s[i][2 * j4] = (f32x2){t[0], t[1]}; s[i][2 * j4 + 1] = (f32x2){t[2], t[3]}; }
    }
    h16x8 pre[NA];
#pragma unroll
    for (int j = 0; j < NA; ++j) pre[j] = *(const h16x8*)gp[j];
    f32x2 kk[8];
    for (int bt = 0; bt < SC_L / SC_NB; ++bt) {
        LAS float* cb = buf;
#pragma unroll
        for (int j = 0; j < NA; ++j) { f32x4 x0, x1;
#pragma unroll
            for (int e = 0; e < 4; ++e) { x0[e] = (float)pre[j][e]; x1[e] = (float)pre[j][4 + e]; }
            *(LAS f32x4*)(cb + lo[j]) = x0; *(LAS f32x4*)(cb + lo[j] + 4) = x1; }
        if (bt + 1 < SC_L / SC_NB) {
#pragma unroll
            for (int j = 0; j < NA; ++j) pre[j] = *(const h16x8*)(gp[j] + (size_t)(bt + 1) * SC_NB * 512);
        }
        lds_ld8x2(cb + 16 * q, kk);
#pragma unroll 2
        for (int st = 0; st < SC_NB; ++st) {
            const LAS float* sb = cb + st * SC_STEP_F;
            f32x2 w[8], bb[8], kx[8]; float vv[4];
            lds_ld8x2(sb + 64 + 16 * q, w); lds_ld8x2(sb + 128 + 16 * q, bb);
            if (MODE != 1) { lds_ld8x2(sb + 192 + 16 * q, kx);
#pragma unroll
                for (int i = 0; i < 4; ++i) vv[i] = sb[320 + rg + 16 * i]; }
            float us[4];
#pragma unroll
            for (int i = 0; i < 4; ++i) { f32x2 t = s[i][0] * kk[0];
#pragma unroll
                for (int j = 1; j < 8; ++j) t = __builtin_elementwise_fma(s[i][j], kk[j], t);
                us[i] = quad_sum(t[0] + t[1]); }
            if (st + 1 < SC_NB) lds_ld8x2(sb + SC_STEP_F + 16 * q, kk);
            f32x2 rr[8];
            if (MODE == 2) lds_ld8x2(sb + 256 + 16 * q, rr);
#pragma unroll
            for (int i = 0; i < 4; ++i) { const f32x2 nu = (f32x2){-us[i], -us[i]}, v2 = (f32x2){vv[i], vv[i]};
#pragma unroll
                for (int j = 0; j < 8; ++j) { f32x2 t = s[i][j] * w[j]; t = __builtin_elementwise_fma(nu, bb[j], t); if (MODE != 1) t = __builtin_elementwise_fma(v2, kx[j], t); s[i][j] = t; } }
            if (MODE == 2) {
#pragma unroll
                for (int i = 0; i < 4; ++i) { f32x2 t = s[i][0] * rr[0];
#pragma unroll
                    for (int j = 1; j < 8; ++j) t = __builtin_elementwise_fma(s[i][j], rr[j], t);
                    const float y = quad_sum(t[0] + t[1]);
                    if (q == 0) ybuf[st * 64 + rg + 16 * i] = y; }
            }
        }
        if (MODE == 2) {
            const int st = lane >> 3, part = lane & 7; h16x8 o;
#pragma unroll
            for (int e = 0; e < 8; ++e) o[e] = (h16)ybuf[st * 64 + part * 8 + e];
            *(h16x8*)((h16*)(a.ws + O_Y) + (row0 + (size_t)bt * SC_NB + st) * 512 + h * 64 + part * 8) = o;
        }
    }
    if (MODE != 2) {
        float* PQ = (float*)(a.ws + O_PQ) + (size_t)task * 8192 + (MODE == 0 ? 4096 : 0);
#pragma unroll
        for (int i = 0; i < 4; ++i)
#pragma unroll
            for (int j4 = 0; j4 < 4; ++j4) { const int o = (rg + 16 * i) * 64 + 16 * q + 4 * j4;
                *(f32x4*)(PQ + o) = (f32x4){s[i][2 * j4][0], s[i][2 * j4][1], s[i][2 * j4 + 1][0], s[i][2 * j4 + 1][1]}; }
    }
}
template <bool FIRST>
__device__ __forceinline__ void phase_scan(const Args& a, LAS unsigned char* lds) {
    const int wave = tid_() >> 6;
    if (FIRST) {
        for (int task = blockIdx.x * NWAVES + wave; task < 64 * SC_NCH; task += gridDim.x * NWAVES) { scan_wave<0>(a, lds, task); scan_wave<1>(a, lds, task); }
    } else {
        for (int task = blockIdx.x * NWAVES + wave; task < 64 * SC_NCH; task += gridDim.x * NWAVES) scan_wave<2>(a, lds, task);
    }
}

constexpr size_t O_VTB = O_ZR;
constexpr size_t O_BON = O_ZR + 64 * MiB;
constexpr int UT_WAVE_LDS = 15360;
typedef float f32x16 __attribute__((ext_vector_type(16)));
__device__ __forceinline__ size_t ut_ov(int j, int s) { return (size_t)(j >> 2) * 512 + (j & 3) * 16 + s; }
__device__ __forceinline__ void phase_ut_pre(const Args& a, LAS unsigned char* lds) {
    const int tid = tid_(), lane = tid & 63, wave = tid >> 6;
    const int gw = blockIdx.x * NWAVES + wave, NGW = gridDim.x * NWAVES;
    LAS unsigned char* Lb = lds + wave * UT_WAVE_LDS;
    LAS h16* YX = (LAS h16*)Lb;
    LAS float* GT = (LAS float*)(Lb + 9216);
    LAS float* TM = (LAS float*)(Lb + 13824);
    h16* R = (h16*)a.out; h16* KS = R + (size_t)MTOK * 512; h16* V = KS + (size_t)MTOK * 512; h16* KK = V + (size_t)MTOK * 512;
    h16* WD = (h16*)(a.ws + O_WD); h16* BD = (h16*)(a.ws + O_BD);
    h16* VTB = (h16*)(a.ws + O_VTB); float* BON = (float*)(a.ws + O_BON);
    for (int bh = gw; bh < 32768; bh += NGW) {
        int ln = lane; asm volatile("" : "+v"(ln)); const int r16 = ln & 15;
        const int h = bh & 7, nb = bh >> 3; const size_t tok0 = (size_t)nb * 16; const size_t e0 = tok0 * 512 + h * 64;
        const float rk = a.in[14][h * 64 + lane];
        {
            h16x8 stg[12];
#pragma unroll
            for (int j = 0; j < 12; ++j) { const int ar = j >> 1, row = (lane >> 3) + 8 * (j & 1);
                const h16* base = (ar == 0) ? WD : (ar == 1) ? KK : (ar == 2) ? BD : (ar == 3) ? KS : (ar == 4) ? R : V;
                stg[j] = *(const h16x8*)(base + e0 + (size_t)row * 512 + (lane & 7) * 8); }
#pragma unroll
            for (int j = 0; j < 12; ++j) *(LAS h16x8*)((LAS h16*)Lb + ((j >> 1) * 16 + (lane >> 3) + 8 * (j & 1)) * 64 + (lane & 7) * 8) = stg[j];
            asm volatile("s_waitcnt lgkmcnt(0)" ::: "memory");
        }
        float w[16], kk[16], bb[16], kx[16], rr[16]; h16x8 vt0, vt1;
        { const LAS h16* IN = (const LAS h16*)Lb;
#pragma unroll
        for (int t = 0; t < 16; ++t) { w[t] = (float)IN[t * 64 + lane]; kk[t] = (float)IN[(16 + t) * 64 + lane]; bb[t] = (float)IN[(32 + t) * 64 + lane]; kx[t] = (float)IN[(48 + t) * 64 + lane]; rr[t] = (float)IN[(64 + t) * 64 + lane];
            if (t < 8) vt0[t] = IN[(80 + t) * 64 + lane]; else vt1[t - 8] = IN[(80 + t) * 64 + lane]; } }
        asm volatile("s_waitcnt lgkmcnt(0)" ::: "memory");
        { h16* vp = VTB + (size_t)bh * 1024 + lane * 16; *(h16x8*)vp = vt0; *(h16x8*)(vp + 8) = vt1; }
        float bonv = 0.f;
#pragma unroll
        for (int t = 0; t < 16; ++t) { const float bs = wave_sum(rr[t] * kx[t] * rk); bonv = (ln == t) ? bs : bonv; }
        if (lane < 16) BON[(tok0 + lane) * 8 + h] = bonv;
        float Lt[16]; { float Lc = 0.f;
#pragma unroll
            for (int t = 0; t < 16; ++t) { Lc += __logf(w[t]); Lt[t] = Lc; } }
        const float Lref = Lt[7];
        float btil[16]; h16x8 kt0, kt1;
        LAS h16* OS = (LAS h16*)(Lb + 9216);
#pragma unroll
        for (int t = 0; t < 16; ++t) {
            const float Lp = t ? Lt[t - 1] : 0.f;
            const float ka = kk[t] * __expf(Lp - Lref), rt = rr[t] * __expf(Lt[t] - Lref), e2 = __expf(Lref - Lt[t]), bt = bb[t] * e2, kt = kx[t] * e2;
            YX[t * 72 + lane] = (h16)ka; YX[(16 + t) * 72 + lane] = (h16)rt; YX[(32 + t) * 72 + lane] = (h16)kt; YX[(48 + t) * 72 + lane] = (h16)bt;
            btil[t] = bt;
            OS[t * 64 + lane] = (h16)(kk[t] * __expf(Lp)); OS[(16 + t) * 64 + lane] = (h16)(rr[t] * __expf(Lt[t]));
            const float ktp = kx[t] * __expf(Lt[15] - Lt[t]);
            if (t < 8) kt0[t] = (h16)ktp; else kt1[t - 8] = (h16)ktp;
        }
        const float post = __expf(Lt[15] - Lref), w16 = __expf(Lt[15]);
        { h16* kp = KS + e0 + ut_ov(lane, 0); *(h16x8*)kp = kt0; *(h16x8*)(kp + 8) = kt1; }
        asm volatile("s_waitcnt lgkmcnt(0)" ::: "memory");
#pragma unroll
        for (int j = 0; j < 4; ++j) { const int row = (lane >> 3) + 8 * (j & 1); const h16x8 o8 = *(const LAS h16x8*)(OS + ((j >> 1) * 16 + row) * 64 + (lane & 7) * 8);
            *(h16x8*)(((j >> 1) ? R : KK) + e0 + (size_t)row * 512 + (lane & 7) * 8) = o8; }
        asm volatile("s_waitcnt lgkmcnt(0)" ::: "memory");
        f32x16 acc;
#pragma unroll
        for (int i = 0; i < 16; ++i) acc[i] = 0.f;
#pragma unroll
        for (int ks = 0; ks < 4; ++ks) {
            const h16x8 af = *(const LAS h16x8*)(YX + (lane & 31) * 72 + 8 * (lane >> 5) + 16 * ks), bf = *(const LAS h16x8*)(YX + (32 + (lane & 31)) * 72 + 8 * (lane >> 5) + 16 * ks);
            acc = __builtin_amdgcn_mfma_f32_32x32x16_f16(af, bf, acc, 0, 0, 0);
        }
#pragma unroll
        for (int i = 0; i < 16; ++i) GT[((i & 3) + 8 * (i >> 2) + 4 * (lane >> 5)) * 36 + (lane & 31)] = acc[i];
        asm volatile("s_waitcnt lgkmcnt(0)" ::: "memory");
        float T[16];
#pragma unroll
        for (int t = 0; t < 16; ++t) { float v = (r16 == t) ? 1.f : 0.f;
#pragma unroll
            for (int s2 = 0; s2 < t; ++s2) v -= T[s2] * GT[t * 36 + 16 + s2];
            T[t] = v; }
#pragma unroll
        for (int t = 0; t < 16; ++t) TM[r16 * 20 + t] = T[t];
        asm volatile("s_waitcnt lgkmcnt(0)" ::: "memory");
        float bcol[16];
#pragma unroll
        for (int s2 = 0; s2 < 16; ++s2) bcol[s2] = (s2 <= r16) ? GT[(16 + r16) * 36 + 16 + s2] : 0.f;
        h16x8 tb0, tb1, tp0, tp1;
#pragma unroll
        for (int r = 0; r < 16; ++r) { float s0 = 0.f, s1 = 0.f;
#pragma unroll
            for (int s2 = r; s2 < 16; ++s2) { const float tv = TM[r * 20 + s2]; s0 += tv * btil[s2]; s1 += tv * bcol[s2]; }
            s0 *= post;
            if (r < 8) { tb0[r] = (h16)s0; tp0[r] = (h16)s1; } else { tb1[r - 8] = (h16)s0; tp1[r - 8] = (h16)s1; } }
        { h16* bp = BD + e0 + ut_ov(lane, 0); *(h16x8*)bp = tb0; *(h16x8*)(bp + 8) = tb1; }
        if (lane < 16) {
            h16x8 a0, a1, p0, p1;
#pragma unroll
            for (int s2 = 0; s2 < 16; ++s2) { const float av = (s2 < ln) ? GT[ln * 36 + s2] : 0.f, pv = (s2 <= ln) ? GT[(16 + ln) * 36 + s2] : 0.f;
                if (s2 < 8) { a0[s2] = (h16)av; p0[s2] = (h16)pv; } else { a1[s2 - 8] = (h16)av; p1[s2 - 8] = (h16)pv; } }
            h16* ap = WD + e0 + (size_t)(lane >> 2) * 512 + (lane & 3) * 16;
            *(h16x8*)ap = a0; *(h16x8*)(ap + 8) = a1;
            *(h16x8*)(ap + 4 * 512) = p0; *(h16x8*)(ap + 4 * 512 + 8) = p1;
            *(h16x8*)(ap + 8 * 512) = tp0; *(h16x8*)(ap + 8 * 512 + 8) = tp1;
        }
        (WD + e0 + (size_t)12 * 512)[lane] = (h16)w16;
        asm volatile("s_waitcnt lgkmcnt(0)" ::: "memory");
    }
}
struct UtOps { u32x2 ka[2][2], rt[2][2], kt[4], tb[4], at, apt, tp, vb, w16[4]; };
struct UtRes { __amdgpu_buffer_rsrc_t kk, r, ks, bd, wd, vt, y; };
__device__ __forceinline__ void ut_load(UtOps& o, const UtRes& R, int so, unsigned offK, unsigned offT, unsigned offV, unsigned offF) {
#pragma unroll
    for (int ks = 0; ks < 2; ++ks)
#pragma unroll
        for (int p = 0; p < 2; ++p) { o.ka[ks][p] = __builtin_amdgcn_raw_buffer_load_b64(R.kk, offK + 64u * ks + 32u * p, so, 0); o.rt[ks][p] = __builtin_amdgcn_raw_buffer_load_b64(R.r, offK + 64u * ks + 32u * p, so, 0); }
#pragma unroll
    for (int kt = 0; kt < 4; ++kt) { o.kt[kt] = __builtin_amdgcn_raw_buffer_load_b64(R.ks, offT + 4096u * kt, so, 0); o.tb[kt] = __builtin_amdgcn_raw_buffer_load_b64(R.bd, offT + 4096u * kt, so, 0); }
    o.at = __builtin_amdgcn_raw_buffer_load_b64(R.wd, offT, so, 0); o.apt = __builtin_amdgcn_raw_buffer_load_b64(R.wd, offT + 4096u, so, 0); o.tp = __builtin_amdgcn_raw_buffer_load_b64(R.wd, offT + 8192u, so, 0);
    o.vb = __builtin_amdgcn_raw_buffer_load_b64(R.vt, offV, so, 0);
#pragma unroll
    for (int kt = 0; kt < 4; ++kt) o.w16[kt] = __builtin_amdgcn_raw_buffer_load_b64(R.wd, offF + 12u * 1024u + 32u * kt, so, 0);
}
__device__ __forceinline__ f32x4 h4f(u32x2 v) { const h16x4 h = __builtin_bit_cast(h16x4, v); return (f32x4){(float)h[0], (float)h[1], (float)h[2], (float)h[3]}; }
__device__ __forceinline__ h16x8 cat8(u32x2 lo, u32x2 hi) { u32x4 r; r[0] = lo[0]; r[1] = lo[1]; r[2] = hi[0]; r[3] = hi[1]; return __builtin_bit_cast(h16x8, r); }
__device__ __forceinline__ void ut_block(const UtOps& o, f32x4 (&S)[4], const UtRes& R, unsigned offY, int so) {
    const f32x4 zf = (f32x4){0.f, 0.f, 0.f, 0.f}; const u32x2 zu = (u32x2){0u, 0u};
    const h16x8 sb0 = pack8(S[0], S[1]), sb1 = pack8(S[2], S[3]);
    const h16x8 vb = cat8(o.vb, zu);
    f32x4 x1 = zf, y = zf;
    x1 = __builtin_amdgcn_mfma_f32_16x16x32_f16(cat8(o.ka[0][0], o.ka[0][1]), sb0, x1, 0, 0, 0); y = __builtin_amdgcn_mfma_f32_16x16x32_f16(cat8(o.rt[0][0], o.rt[0][1]), sb0, y, 0, 0, 0);
    x1 = __builtin_amdgcn_mfma_f32_16x16x32_f16(cat8(o.ka[1][0], o.ka[1][1]), sb1, x1, 0, 0, 0); y = __builtin_amdgcn_mfma_f32_16x16x32_f16(cat8(o.rt[1][0], o.rt[1][1]), sb1, y, 0, 0, 0);
    x1 = __builtin_amdgcn_mfma_f32_16x16x32_f16(cat8(o.at, zu), vb, x1, 0, 0, 0); y = __builtin_amdgcn_mfma_f32_16x16x32_f16(cat8(o.apt, zu), vb, y, 0, 0, 0);
    f32x4 St[4];
#pragma unroll
    for (int kt = 0; kt < 4; ++kt) St[kt] = __builtin_amdgcn_mfma_f32_16x16x32_f16(cat8(o.kt[kt], zu), vb, S[kt] * h4f(o.w16[kt]), 0, 0, 0);
    const h16x8 xb = pack8(-x1, zf);
    y = __builtin_amdgcn_mfma_f32_16x16x32_f16(cat8(o.tp, zu), xb, y, 0, 0, 0);
#pragma unroll
    for (int kt = 0; kt < 4; ++kt) S[kt] = __builtin_amdgcn_mfma_f32_16x16x32_f16(cat8(o.tb[kt], zu), xb, St[kt], 0, 0, 0);
#pragma unroll
    for (int rg = 0; rg < 4; ++rg) { const h16 hv = (h16)y[rg]; __builtin_amdgcn_raw_buffer_store_b16(__builtin_bit_cast(unsigned short, hv), R.y, offY + 1024u * rg, so, 0); }
}
__device__ __forceinline__ void phase_ut_seq(const Args& a, LAS unsigned char* lds) {
    const int tid = tid_(), lane = tid & 63, wave = tid >> 6, fr = lane & 15, fq = lane >> 4;
    volatile LAS int* prog = (volatile LAS int*)lds;
    if (tid == 0) *prog = 0;
    if (wave > 1) return;
    for (int item = blockIdx.x; item < 256; item += gridDim.x) {
        const int h = item & 7, q = item >> 3, g = q & 3, b = q >> 2;
        const size_t e0 = ((size_t)b * SEQ * 512 + h * 64) * 2;
        const char* Rb = (const char*)a.out + e0; const char* KSb = Rb + (size_t)MTOK * 1024; const char* KKb = Rb + (size_t)3 * MTOK * 1024;
        const char* WDb = (const char*)(a.ws + O_WD) + e0; const char* BDb = (const char*)(a.ws + O_BD) + e0;
        const char* VTb = (const char*)(a.ws + O_VTB) + ((size_t)b * (SEQ / 16) * 8 + h) * 2048;
        if (wave == 1) {
            const int ar = lane >> 4, row = lane & 15;
            const char* p0 = ((ar == 0) ? KKb : (ar == 1) ? Rb : (ar == 2) ? KSb : BDb) + (size_t)row * 1024;
            const char* p1 = (lane < 16) ? WDb + (size_t)row * 1024 : VTb + (size_t)(4 * g + (lane & 3)) * 128;
            for (int n0 = 0; n0 < SEQ / 16; n0 += 8) {
                int guard = 0;
                while (*prog + 16 < n0 && ++guard < (1 << 22)) __builtin_amdgcn_s_sleep(8);
                unsigned x[16];
#pragma unroll
                for (int i = 0; i < 8; ++i) { x[2 * i] = *(const unsigned*)(p0 + (size_t)(n0 + i) * 16384); x[2 * i + 1] = *(const unsigned*)(p1 + (size_t)(n0 + i) * 16384); }
#pragma unroll
                for (int i = 0; i < 16; ++i) asm volatile("" :: "v"(x[i]));
            }
            continue;
        }
        const unsigned offK = (unsigned)(fr * 1024 + 8 * fq), offT = (unsigned)((fr >> 2) * 512 + (fr & 3) * 16 + 4 * fq) * 2u, offV = (unsigned)((16 * g + fr) * 16 + 4 * fq) * 2u, offF = (unsigned)fq * 8u,
                       offY = (unsigned)((4 * fq) * 512 + 16 * g + fr) * 2u;
        UtRes RS; RS.kk = mkrsrc(KKb); RS.r = mkrsrc(Rb); RS.ks = mkrsrc(KSb); RS.bd = mkrsrc(BDb); RS.wd = mkrsrc(WDb); RS.vt = mkrsrc(VTb);
        RS.y = mkrsrc((const char*)(a.ws + O_Y) + e0);
        f32x4 S[4];
#pragma unroll
        for (int kt = 0; kt < 4; ++kt) S[kt] = (f32x4){0.f, 0.f, 0.f, 0.f};
        UtOps oa, ob, oc;
#define UT_LD(o, nn) ut_load(o, RS, ((nn) < SEQ / 16 ? (nn) : SEQ / 16 - 1) * 16384, offK, offT, offV, offF)
        UT_LD(oa, 0); UT_LD(ob, 1);
        int n = 0;
#pragma unroll 1
        for (; n + 3 <= SEQ / 16; n += 3) {
            if (lane == 0) *prog = n;
            UT_LD(oc, n + 2); ut_block(oa, S, RS, offY, n * 16384);
            UT_LD(oa, n + 3); ut_block(ob, S, RS, offY, (n + 1) * 16384);
            UT_LD(ob, n + 4); ut_block(oc, S, RS, offY, (n + 2) * 16384);
        }
        ut_block(oa, S, RS, offY, n * 16384); ut_block(ob, S, RS, offY, (n + 1) * 16384);
#undef UT_LD
    }
}

__device__ __forceinline__ void phase_scan_combine(const Args& a, LAS unsigned char* lds) {
    const int tid = tid_(), row = tid >> 5, cp = tid & 31;
    LAS float* LS = (LAS float*)lds;
    LAS float* LP = (LAS float*)(lds + 8192);
    for (int item = blockIdx.x; item < 64 * 4; item += gridDim.x) {
        const int chain = item >> 2, r0 = (item & 3) * 16;
        const float* PQ0 = (const float*)(a.ws + O_PQ) + (size_t)chain * SC_NCH * 8192;
        f32x2 sr = (f32x2){0.f, 0.f};
        f32x4 pa = *(const f32x4*)(PQ0 + tid * 8), pb = *(const f32x4*)(PQ0 + tid * 8 + 4);
        f32x2 qn = *(const f32x2*)(PQ0 + 4096 + (r0 + row) * 64 + 2 * cp);
        for (int c = 0; c < SC_NCH; ++c) {
            const int task = chain * SC_NCH + c;
            *(f32x2*)((float*)(a.ws + O_SST) + (size_t)task * 4096 + (r0 + row) * 64 + 2 * cp) = sr;
            if (c == SC_NCH - 1) break;
            LAS float* cur = LS + (c & 1) * 1024; LAS float* cp_ = LP + (c & 1) * 4096;
            *(LAS f32x2*)(cur + row * 64 + 2 * cp) = sr;
            *(LAS f32x4*)(cp_ + tid * 8) = pa; *(LAS f32x4*)(cp_ + tid * 8 + 4) = pb;
            f32x2 acc0 = qn, acc1 = (f32x2){0.f, 0.f};
            if (c + 2 < SC_NCH) { const float* Pn = PQ0 + (size_t)(c + 1) * 8192;
                pa = *(const f32x4*)(Pn + tid * 8); pb = *(const f32x4*)(Pn + tid * 8 + 4); qn = *(const f32x2*)(Pn + 4096 + (r0 + row) * 64 + 2 * cp); }
            __syncthreads();
#pragma unroll 16
            for (int k = 0; k < 64; k += 2) {
                const f32x2 sk = *(const LAS f32x2*)(cur + row * 64 + k);
                const f32x2 p0 = *(const LAS f32x2*)(cp_ + k * 64 + 2 * cp), p1 = *(const LAS f32x2*)(cp_ + (k + 1) * 64 + 2 * cp);
                acc0 = __builtin_elementwise_fma((f32x2){sk[0], sk[0]}, p0, acc0); acc1 = __builtin_elementwise_fma((f32x2){sk[1], sk[1]}, p1, acc1);
            }
            sr = acc0 + acc1;
        }
        __syncthreads();
    }
}
__device__ __forceinline__ void phase_rwkv_post(const Args& a) {
    const int tid = tid_(), lane = tid & 63, wave = tid >> 6;
    const int gw = blockIdx.x * NWAVES + wave, NGW = gridDim.x * NWAVES;
    const h16* V = (const h16*)a.out + (size_t)2 * MTOK * 512;
    const h16* GG = (const h16*)(a.ws + O_GG); const h16* Y = (const h16*)(a.ws + O_Y); h16* YB = (h16*)(a.ws + O_YB); const float* BON = (const float*)(a.ws + O_BON);
    float lg[8], lb[8];
#pragma unroll
    for (int j = 0; j < 8; ++j) { const int c = lane * 8 + j; lg[j] = a.in[15][c]; lb[j] = a.in[16][c]; }
    for (int t = gw; t < MTOK; t += NGW) {
        const size_t o = (size_t)t * 512 + lane * 8;
        const h16x8 y8 = *(const h16x8*)(Y + o), v8 = *(const h16x8*)(V + o), g8 = *(const h16x8*)(GG + o);
        const float bs = BON[(size_t)t * 8 + (lane >> 3)];
        float y[8]; float sm = 0.f;
#pragma unroll
        for (int j = 0; j < 8; ++j) { y[j] = (float)y8[j]; sm += y[j]; }
        sm += dpp_<0xB1>(sm); sm += dpp_<0x4E>(sm); sm += dpp_<0x141>(sm);
        const float mean = sm * (1.f / 64.f); float vs = 0.f;
#pragma unroll
        for (int j = 0; j < 8; ++j) { y[j] -= mean; vs += y[j] * y[j]; }
        vs += dpp_<0xB1>(vs); vs += dpp_<0x4E>(vs); vs += dpp_<0x141>(vs);
        const float rstd = rsqrtf(vs * (1.f / 64.f) + 64e-5f);
        h16x8 ov;
#pragma unroll
        for (int j = 0; j < 8; ++j) ov[j] = (h16)((y[j] * rstd * lg[j] + lb[j] + bs * (float)v8[j]) * (float)g8[j]);
        *(h16x8*)(YB + o) = ov;
    }
}

__device__ __forceinline__ void ins16(unsigned (&L)[16], unsigned x) {
#pragma unroll
    for (int j = 0; j < 16; ++j) { const unsigned hi = L[j] > x ? L[j] : x; x = L[j] > x ? x : L[j]; L[j] = hi; }
}
__device__ __forceinline__ unsigned ord32(float f) { const unsigned u = __float_as_uint(f); return (u & 0x80000000u) ? ~u : (u | 0x80000000u); }
__device__ __forceinline__ float unord32(unsigned k) { return __uint_as_float((k & 0x80000000u) ? (k & 0x7fffffffu) : ~k); }
__device__ __forceinline__ void phase_topk(const Args& a, LAS unsigned char* lds) {
    const int tid = tid_();
    const h16* SC = (const h16*)(a.ws + O_SCORES);
    const float* part = (const float*)(a.ws + O_PART1);
    unsigned short* IDX = (unsigned short*)(a.ws + O_IDX); float* GATE = (float*)(a.ws + O_GATE); float* RS1 = (float*)(a.ws + O_RS1);
    LAS unsigned char* LI = lds;
    for (int task = blockIdx.x * NTHREADS + tid; task < MTOK * 8; task += gridDim.x * NTHREADS) {
        const int t = task >> 3, h = task & 7;
        float ssq = 0.f;
#pragma unroll
        for (int j = 0; j < 4; ++j) { const f32x4 p4 = *(const f32x4*)(part + (size_t)t * 16 + 4 * j); ssq += (p4[0] + p4[1]) + (p4[2] + p4[3]); }
        const float rs = rsqrtf(ssq * (1.f / 1024.f) + NORM_EPS);
        if (h == 0) RS1[t] = rs;
        float sv[2][16];
#pragma unroll
        for (int c = 0; c < 2; ++c) {
            unsigned L[16];
#pragma unroll
            for (int j = 0; j < 16; ++j) L[j] = 0u;
            const h16* row = SC + (size_t)t * 2048 + h * 256 + c * 128;
#pragma unroll 2
            for (int n8 = 0; n8 < 16; ++n8) {
                const u32x4 w4 = *(const u32x4*)(row + n8 * 8);
#pragma unroll
                for (int e = 0; e < 8; ++e) {
                    const unsigned bits = (e & 1) ? (w4[e >> 1] >> 16) : (w4[e >> 1] & 0xffffu);
                    const unsigned o16 = (bits & 0x8000u) ? (~bits & 0xffffu) : (bits | 0x8000u);
                    ins16(L, (o16 << 16) | (unsigned)(127 - (n8 * 8 + e)));
                }
            }
#pragma unroll
            for (int j = 0; j < 16; ++j) {
                const unsigned o16 = L[j] >> 16; const unsigned bits = (o16 & 0x8000u) ? (o16 & 0x7fffu) : (~o16 & 0xffffu);
                union { unsigned short u; h16 f; } cv; cv.u = (unsigned short)bits; sv[c][j] = (float)cv.f;
                LI[(c * 16 + j) * 512 + tid] = (unsigned char)(127u - (L[j] & 127u));
            }
        }
        unsigned L[16];
#pragma unroll
        for (int j = 0; j < 16; ++j) L[j] = 0u;
#pragma unroll
        for (int i = 0; i < 16; ++i)
#pragma unroll
            for (int j = 0; j < 16; ++j) if ((i + 1) * (j + 1) <= 16) ins16(L, (ord32(sv[0][i] + sv[1][j]) & ~255u) | (unsigned)(255 - (i * 16 + j)));
        float e[16]; float den = 0.f; const float mx = unord32(L[0] & ~255u) * rs;
        unsigned short id[16];
#pragma unroll
        for (int k = 0; k < 16; ++k) {
            const float v = unord32(L[k] & ~255u) * rs; e[k] = __expf(v - mx); den += e[k];
            const unsigned pos = 255u - (L[k] & 255u); const unsigned i = pos >> 4, j = pos & 15u;
            id[k] = (unsigned short)((unsigned)LI[i * 512 + tid] * 128u + (unsigned)LI[(16 + j) * 512 + tid]);
        }
        const float inv = __builtin_amdgcn_rcpf(den);
        u32x4 i0, i1;
        i0[0] = id[0] | (id[1] << 16); i0[1] = id[2] | (id[3] << 16); i0[2] = id[4] | (id[5] << 16); i0[3] = id[6] | (id[7] << 16);
        i1[0] = id[8] | (id[9] << 16); i1[1] = id[10] | (id[11] << 16); i1[2] = id[12] | (id[13] << 16); i1[3] = id[14] | (id[15] << 16);
        u32x4* ip = (u32x4*)(IDX + (size_t)task * 16); ip[0] = i0; ip[1] = i1;
        f32x4* gp = (f32x4*)(GATE + (size_t)task * 16);
#pragma unroll
        for (int k4 = 0; k4 < 4; ++k4) gp[k4] = (f32x4){e[4 * k4] * inv, e[4 * k4 + 1] * inv, e[4 * k4 + 2] * inv, e[4 * k4 + 3] * inv};
    }
}

__device__ __forceinline__ float gelu_tanh(float x) { const float u = 0.7978845608028654f * (x + 0.044715f * x * x * x); return 0.5f * x * (1.0f + tanhf_(u)); }
__device__ __forceinline__ unsigned xcc_id() { return (unsigned)__builtin_amdgcn_s_getreg((3 << 11) | 20) & 7u; }
constexpr int GA_TC = 32, GA_NCH = MTOK / GA_TC;
__device__ __forceinline__ void dec16(const u32x4 q, float (&o)[16]) {
#pragma unroll
    for (int w = 0; w < 4; ++w) { const f32x2 lo = __builtin_amdgcn_cvt_pk_f32_fp8((int)q[w], false), hi = __builtin_amdgcn_cvt_pk_f32_fp8((int)q[w], true);
        o[4 * w] = lo[0]; o[4 * w + 1] = lo[1]; o[4 * w + 2] = hi[0]; o[4 * w + 3] = hi[1]; }
}
__device__ __forceinline__ void dec16p(const u32x4 q, f32x2 (&o)[8]) {
#pragma unroll
    for (int w = 0; w < 4; ++w) { o[2 * w] = __builtin_amdgcn_cvt_pk_f32_fp8((int)q[w], false); o[2 * w + 1] = __builtin_amdgcn_cvt_pk_f32_fp8((int)q[w], true); }
}
struct GIdx { u32x4 a, b; };
__device__ __forceinline__ GIdx g_ldidx(__amdgpu_buffer_rsrc_t IDX, int t, int r8) { GIdx r; r.a = __builtin_amdgcn_raw_buffer_load_b128(IDX, 32 * r8, t * 256, 0); r.b = __builtin_amdgcn_raw_buffer_load_b128(IDX, 32 * r8 + 16, t * 256, 0); return r; }
__device__ __forceinline__ void g_issue8(const unsigned char* TBs, unsigned lo, const u32x4 ix, u32x4 (&q)[8]) {
#pragma unroll
    for (int i = 0; i < 8; ++i) { const unsigned w = ix[i >> 1]; const unsigned e = (i & 1) ? (w >> 16) : (w & 0xffffu); q[i] = *(const u32x4*)(TBs + (e * 128u + lo)); }
}
struct GSide { u32x4 a, b, c, d; };
template <int PH> __device__ __forceinline__ GSide g_ldside(__amdgpu_buffer_rsrc_t SD, int t, int j, int m, int r8) {
    GSide r;
    if (PH == 0) { r.a = __builtin_amdgcn_raw_buffer_load_b128(SD, 32 * m, t * 2048 + 256 * j, 0); r.b = __builtin_amdgcn_raw_buffer_load_b128(SD, 32 * m + 16, t * 2048 + 256 * j, 0); r.c = r.a; r.d = r.b; }
    else { r.a = __builtin_amdgcn_raw_buffer_load_b128(SD, 64 * r8, t * 512, 0); r.b = __builtin_amdgcn_raw_buffer_load_b128(SD, 64 * r8 + 16, t * 512, 0); r.c = __builtin_amdgcn_raw_buffer_load_b128(SD, 64 * r8 + 32, t * 512, 0); r.d = __builtin_amdgcn_raw_buffer_load_b128(SD, 64 * r8 + 48, t * 512, 0); }
    return r;
}
template <int PH, int HALF> __device__ __forceinline__ void g_half(u32x4 (&q)[8], const GSide& sd, float (&pa)[16]) {
    if (PH == 0) {
        f32x2 x2[8];
        { const h16x8 xa = __builtin_bit_cast(h16x8, sd.a), xb = __builtin_bit_cast(h16x8, sd.b);
#pragma unroll
          for (int k = 0; k < 4; ++k) { x2[k] = (f32x2){(float)xa[2 * k], (float)xa[2 * k + 1]}; x2[4 + k] = (f32x2){(float)xb[2 * k], (float)xb[2 * k + 1]}; } }
#pragma unroll
        for (int i = 0; i < 8; ++i) { f32x2 d2[8]; dec16p(q[i], d2); f32x2 s2 = x2[0] * d2[0];
#pragma unroll
            for (int k = 1; k < 8; ++k) s2 = __builtin_elementwise_fma(x2[k], d2[k], s2);
            pa[8 * HALF + i] = s2[0] + s2[1];
            if (i + 1 < 8) asm volatile("" : "+v"(q[i + 1][0]), "+v"(q[i + 1][1]), "+v"(q[i + 1][2]), "+v"(q[i + 1][3])); }
    } else {
        f32x2 a2[8];
#pragma unroll
        for (int k = 0; k < 8; ++k) a2[k] = (f32x2){pa[2 * k], pa[2 * k + 1]};
#pragma unroll
        for (int i = 0; i < 8; ++i) { f32x2 d2[8]; dec16p(q[i], d2);
            const float cf = __uint_as_float(HALF == 0 ? (i < 4 ? sd.a[i & 3] : sd.b[i & 3]) : (i < 4 ? sd.c[i & 3] : sd.d[i & 3])); const f32x2 c2 = (f32x2){cf, cf};
#pragma unroll
            for (int k = 0; k < 8; ++k) a2[k] = __builtin_elementwise_fma(c2, d2[k], a2[k]);
            if (i + 1 < 8) asm volatile("" : "+v"(q[i + 1][0]), "+v"(q[i + 1][1]), "+v"(q[i + 1][2]), "+v"(q[i + 1][3]));
        }
#pragma unroll
        for (int k = 0; k < 8; ++k) { pa[2 * k] = a2[k][0]; pa[2 * k + 1] = a2[k][1]; }
    }
}
template <int PH> __device__ __forceinline__ void g_finish(const Args& a, __amdgpu_buffer_rsrc_t PRT, int t, int j, int lane, float (&p)[16]) {
    const int m = lane & 7, r8 = lane >> 3;
    float q8[8], q4[4], q2[2];
    if (PH == 0) {
#pragma unroll
        for (int i = 0; i < 8; ++i) { const float keep = (lane & 4) ? p[i + 8] : p[i], send = (lane & 4) ? p[i] : p[i + 8]; q8[i] = keep + xhm_(send); }
#pragma unroll
        for (int i = 0; i < 4; ++i) { const float keep = (lane & 2) ? q8[i + 4] : q8[i], send = (lane & 2) ? q8[i] : q8[i + 4]; q4[i] = keep + dpp_<0x4E>(send); }
#pragma unroll
        for (int i = 0; i < 2; ++i) { const float keep = (lane & 1) ? q4[i + 2] : q4[i], send = (lane & 1) ? q4[i] : q4[i + 2]; q2[i] = keep + dpp_<0xB1>(send); }
        __builtin_amdgcn_raw_buffer_store_b64((u32x2){__float_as_uint(q2[0]), __float_as_uint(q2[1])}, PRT, (16 * r8 + 2 * m) * 4, (j * MTOK + t) * 512, 0);
    } else {
#pragma unroll
        for (int i = 0; i < 8; ++i) { const float keep = (lane & 32) ? p[i + 8] : p[i], send = (lane & 32) ? p[i] : p[i + 8]; q8[i] = keep + x32_(send, lane); }
#pragma unroll
        for (int i = 0; i < 4; ++i) { const float keep = (lane & 16) ? q8[i + 4] : q8[i], send = (lane & 16) ? q8[i] : q8[i + 4]; q4[i] = keep + x16_(send, lane); }
#pragma unroll
        for (int i = 0; i < 2; ++i) { const float keep = (lane & 8) ? q4[i + 2] : q4[i], send = (lane & 8) ? q4[i] : q4[i + 2]; q2[i] = keep + x8_(send); }
        const int col = 128 * j + 16 * m + 2 * r8;
        float* op = a.out + (size_t)t * 1024 + col;
        f32x2 hv = *(const f32x2*)op; hv[0] += q2[0]; hv[1] += q2[1];
        *(f32x2*)op = hv;
        *(h16x2*)((h16*)(a.ws + O_H2B) + (size_t)t * 1024 + col) = (h16x2){(h16)hv[0], (h16)hv[1]};
        const float ss = wave_sum(hv[0] * hv[0] + hv[1] * hv[1]);
        if (lane == 0) ((float*)(a.ws + O_SS2))[(size_t)t * 8 + j] = ss;
    }
}
template <int PH>
__device__ __forceinline__ void phase_gather(const Args& a, int cset) {
    const int tid = tid_(), lane = tid & 63, m = lane & 7, r8 = lane >> 3;
    unsigned* ctr = (unsigned*)(a.ws + O_CTR) + cset * 8 * 64;
    const __amdgpu_buffer_rsrc_t IDX = mkrsrc(a.ws + O_IDX), SDR = mkrsrc(a.ws + (PH ? O_COEF : O_H1B)), PRT = mkrsrc(a.ws + O_PART);
    const unsigned j0 = xcc_id();
    for (unsigned dj = 0; dj < 8; ++dj) {
        const unsigned j = (j0 + dj) & 7u;
        const unsigned char* TB = a.ws + (PH ? O_V8 : O_U8) + (size_t)j * 16384 * 128; const unsigned lo16 = 16u * (unsigned)m;
        for (;;) {
            unsigned c = 0; if (lane == 0) c = __hip_atomic_fetch_add(ctr + j * 64, 1u, __ATOMIC_RELAXED, __HIP_MEMORY_SCOPE_AGENT);
            c = (unsigned)__builtin_amdgcn_readfirstlane((int)c);
            if (c >= (unsigned)GA_NCH) break;
            const int t0 = c * GA_TC;
            u32x4 qa[8], qb[8]; GSide sd, sn; GIdx ix, ixn;
            ix = g_ldidx(IDX, t0, r8); g_issue8(TB, lo16, ix.a, qa); sd = g_ldside<PH>(SDR, t0, j, m, r8);
#pragma unroll 1
            for (int ti = 0; ti < GA_TC; ++ti) {
                const int t = t0 + ti, tn = (ti + 1 < GA_TC) ? t + 1 : t;
                g_issue8(TB, lo16, ix.b, qb); ixn = g_ldidx(IDX, tn, r8); sn = g_ldside<PH>(SDR, tn, j, m, r8);
                float p[16];
                if (PH == 1) {
#pragma unroll
                    for (int k = 0; k < 16; ++k) p[k] = 0.f;
                }
                if (PH == 0) __builtin_amdgcn_sched_barrier(0);
                g_half<PH, 0>(qa, sd, p);
                if (PH == 0) __builtin_amdgcn_sched_barrier(0);
                g_issue8(TB, lo16, ixn.a, qa);
                if (PH == 0) __builtin_amdgcn_sched_barrier(0);
                g_half<PH, 1>(qb, sd, p);
                g_finish<PH>(a, PRT, t, j, lane, p);
                ix = ixn; sd = sn;
            }
        }
    }
}
__device__ __forceinline__ void phase_coef(const Args& a) {
    const int tid = tid_();
    const float* PART = (const float*)(a.ws + O_PART); const unsigned short* IDX = (const unsigned short*)(a.ws + O_IDX);
    const float* GATE = (const float*)(a.ws + O_GATE); const float* RS1 = (const float*)(a.ws + O_RS1);
    const float* USC = (const float*)(a.ws + O_USC); const float* VSC = (const float*)(a.ws + O_VSC); float* COEF = (float*)(a.ws + O_COEF);
    for (int i = blockIdx.x * NTHREADS + tid; i < MTOK * 128; i += gridDim.x * NTHREADS) {
        float s = 0.f;
#pragma unroll
        for (int j = 0; j < 8; ++j) s += PART[(size_t)j * MTOK * 128 + i];
        const unsigned e = IDX[i];
        COEF[i] = GATE[i] * gelu_tanh(RS1[i >> 7] * USC[e] * s) * VSC[e];
    }
}

__device__ __forceinline__ void phase_final(const Args& a) {
    const int tid = tid_(), lane = tid & 63, wave = tid >> 6;
    const int gw = blockIdx.x * NWAVES + wave, NGW = gridDim.x * NWAVES;
    const float* part = (const float*)(a.ws + O_PART3); const float* fg = a.in[28];
    f32x4 g4[4];
#pragma unroll
    for (int j = 0; j < 4; ++j) g4[j] = *((const f32x4*)fg + lane + 64 * j);
    for (int r = gw; r < MTOK; r += NGW) {
        float s = (lane < 16) ? part[(size_t)r * 16 + lane] : 0.f;
        s = wave_sum(s);
        const float rs = rsqrtf(s * (1.f / 1024.f) + NORM_EPS);
        f32x4* xr = (f32x4*)(a.out + (size_t)r * 1024) + lane;
#pragma unroll
        for (int j = 0; j < 4; ++j) xr[64 * j] = xr[64 * j] * rs * g4[j];
    }
}

constexpr int NPHASE = 19;
__global__ void __launch_bounds__(NTHREADS, 2) mk(Args a) {
    extern __shared__ __attribute__((aligned(16))) unsigned char smem[];
    LAS unsigned char* lds = (LAS unsigned char*)smem;
    unsigned char* ws = a.ws;
#if ONE_LAUNCH
    cg::grid_group grid = cg::this_grid();
    volatile LAS unsigned* bst = (volatile LAS unsigned*)(lds + 131072);
    if (threadIdx.x < 2) bst[threadIdx.x] = 0u;
    __syncthreads();
    const XcdBarrier xbar = xcd_barrier_post((unsigned*)(a.ws + O_BAR), bst);
    bool first_sync = true;
#define SYNC() do { if (first_sync) { grid.sync(); first_sync = false; } else xcd_barrier(xbar); } while (0)
#else
#define SYNC() do {} while (0)
#endif
#define IN(k) (a.ph_lo <= (k) && (k) < a.ph_hi)
#define SEAM(k) do { if (IN(k) && IN((k) + 1)) SYNC(); } while (0)
#define REPS(k) ((((REP_MASK) >> (k)) & 1u) ? 2 : 1)
    const int G = gridDim.x, bid = blockIdx.x;
    if (IN(0)) for (int rep = 0; rep < REPS(0); ++rep) { if (rep) SYNC(); phase_prep(a, lds); } SEAM(0);
    if (IN(1)) for (int rep = 0; rep < REPS(1); ++rep) { if (rep) SYNC(); pg8::Gemm g{(const h16*)(ws + O_XN), (const h16*)(ws + O_WIN), MTOK, NIN, 1024}; pg8::StaticOrder S; S.init(MTOK, NIN, G, bid);
        EpiZ E{(h16*)(ws + O_ZC), (h16*)(ws + O_ZR), (h16*)(ws + O_ZG)}; pg8::gemm_phase(lds, g, S, E); } SEAM(1);
    if (IN(2)) for (int rep = 0; rep < REPS(2); ++rep) { if (rep) SYNC(); phase_conv(a); phase_rwkv_prep(a); } SEAM(2);
    if (IN(3)) for (int rep = 0; rep < REPS(3); ++rep) { if (rep) SYNC(); pg8::Gemm g{(const h16*)(ws + O_APR), (const h16*)(ws + O_WLR), MTOK, 1536, 256}; pg8::StaticOrder S; S.init(MTOK, 1536, G, bid);
        h16* R = (h16*)a.out; h16* KS = R + (size_t)MTOK * 512; h16* KK = KS + (size_t)2 * MTOK * 512;
        EpiLR E{a.in[7], a.in[9], a.in[13], (h16*)(ws + O_WD), KS, (h16*)(ws + O_BD), (h16*)(ws + O_GG), KK}; pg8::gemm_phase(lds, g, S, E); } SEAM(3);
    if (IN(4)) for (int rep = 0; rep < REPS(4); ++rep) { if (rep) SYNC(); phase_ut_pre(a, lds); }
    SEAM(5);
    if (IN(6)) for (int rep = 0; rep < REPS(6); ++rep) { if (rep) SYNC(); phase_ut_seq(a, lds); } SEAM(6);
    if (IN(7)) for (int rep = 0; rep < REPS(7); ++rep) { if (rep) SYNC(); phase_rwkv_post(a); } SEAM(7);
    if (IN(8)) for (int rep = 0; rep < REPS(8); ++rep) { if (rep) SYNC(); pg8::Gemm g{(const h16*)(ws + O_CA), (const h16*)(ws + O_WA), MTOK, 1024, 512}; pg8::StaticOrder S; S.init(MTOK, 1024, G, bid);
        EpiYA E{(const h16*)(ws + O_ZG), (h16*)a.out}; pg8::gemm_phase(lds, g, S, E); } SEAM(8);
    if (IN(9)) for (int rep = 0; rep < REPS(9); ++rep) { if (rep) SYNC(); pg8::Gemm g{(const h16*)(ws + O_YB), (const h16*)(ws + O_WB), MTOK, 1024, 512}; pg8::StaticOrder S; S.init(MTOK, 1024, G, bid);
        EpiYB E{(const h16*)(ws + O_ZG), (const h16*)a.out, (h16*)(ws + O_MERGED)}; pg8::gemm_phase(lds, g, S, E); } SEAM(9);
    if (IN(10)) for (int rep = 0; rep < REPS(10); ++rep) { if (rep) SYNC(); pg8::Gemm g{(const h16*)(ws + O_MERGED), (const h16*)(ws + O_WO), MTOK, 1024, 1024}; pg8::StaticOrder S; S.init(MTOK, 1024, G, bid);
        EpiH1 E{a.in[0], a.out, (h16*)(ws + O_H1B), (float*)(ws + O_PART1)}; pg8::gemm_phase(lds, g, S, E); } SEAM(10);
    if (IN(11)) for (int rep = 0; rep < REPS(11); ++rep) { if (rep) SYNC(); pg8::Gemm g{(const h16*)(ws + O_H1B), (const h16*)(ws + O_WS), MTOK, 2048, 1024}; pg8::StaticOrder S; S.init(MTOK, 2048, G, bid);
        EpiF16 E{(h16*)(ws + O_SCORES), 2048}; pg8::gemm_phase(lds, g, S, E); } SEAM(11);
    if (IN(12)) for (int rep = 0; rep < REPS(12); ++rep) { if (rep) SYNC(); phase_topk(a, lds); } SEAM(12);
    if (IN(13)) for (int rep = 0; rep < REPS(13); ++rep) { if (rep) SYNC(); phase_gather<0>(a, 2 * rep); } SEAM(13);
    if (IN(14)) for (int rep = 0; rep < REPS(14); ++rep) { if (rep) SYNC(); phase_coef(a); } SEAM(14);
    if (IN(15)) for (int rep = 0; rep < REPS(15); ++rep) { if (rep) SYNC(); phase_gather<1>(a, 1); } SEAM(15);
    if (IN(16)) for (int rep = 0; rep < REPS(16); ++rep) { if (rep) SYNC(); pg8::Gemm g{(const h16*)(ws + O_P16), (const h16*)(ws + O_WP), MTOK, 1024, 256}; pg8::StaticOrder S; S.init(MTOK, 1024, G, bid);
        EpiF16 E{(h16*)(ws + O_PP), 1024}; pg8::gemm_phase(lds, g, S, E); } SEAM(16);
    if (IN(17)) for (int rep = 0; rep < REPS(17); ++rep) { if (rep) SYNC(); pg8::Gemm g{(const h16*)(ws + O_H2B), (const h16*)(ws + O_WG), MTOK, 1024, 1024}; pg8::StaticOrder S; S.init(MTOK, 1024, G, bid);
        EpiGate E{a.out, (const h16*)(ws + O_PP), (const float*)(ws + O_SS2), (float*)(ws + O_PART3)}; pg8::gemm_phase(lds, g, S, E); } SEAM(17);
    if (IN(18)) for (int rep = 0; rep < REPS(18); ++rep) { if (rep) SYNC(); phase_final(a); }
}

extern "C" void kernel_launch(void* const* d_in, const int* in_sizes, int n_in, void* d_out, int out_size, void* d_ws, size_t ws_size, hipStream_t stream) {
    static int ready = 0;
    if (!ready) {
        if (n_in != 29 || ws_size < WS_END) { fprintf(stderr, "kernel_launch: unexpected n_in %d / ws %zu (need %zu)\n", n_in, ws_size, (size_t)WS_END); ready = -1; return; }
        if (hipFuncSetAttribute((const void*)mk, hipFuncAttributeMaxDynamicSharedMemorySize, LDS_BYTES) != hipSuccess) { fprintf(stderr, "hipFuncSetAttribute failed\n"); ready = -1; return; }
        ready = 1;
    }
    if (ready < 0) return;
    Args a{};
    for (int i = 0; i < 29; ++i) a.in[i] = (const float*)d_in[i];
    a.out = (float*)d_out; a.ws = (unsigned char*)d_ws;
#if ONE_LAUNCH
    (void)hipMemsetAsync((unsigned char*)d_ws + O_BAR, 0, 16384, stream);
    a.ph_lo = 0; a.ph_hi = NPHASE;
    void* args[] = {&a};
    hipLaunchCooperativeKernel((const void*)mk, dim3(NBLK), dim3(NTHREADS), args, LDS_BYTES, stream);
#else
    const int phases[] = {0, 1, 2, 3, 4, 5, 6, 7, 8, 9, 10, 11, 12, 13, 14, 15, 16, 17, 18};
    for (int ph : phases) { a.ph_lo = ph; a.ph_hi = ph + 1; hipLaunchKernelGGL(mk, dim3(NBLK), dim3(NTHREADS), LDS_BYTES, stream, a); }
#endif
}
```

```cpp
#include <hip/hip_runtime.h>
#include <hip/hip_cooperative_groups.h>
#include <cstdio>
namespace cg = cooperative_groups;

#ifndef REP_MASK
#define REP_MASK 0u
#endif
#ifndef ONE_LAUNCH
#define ONE_LAUNCH 1
#endif

#define LAS __attribute__((address_space(3)))
typedef _Float16 h16;
typedef _Float16 h16x8 __attribute__((ext_vector_type(8)));
typedef _Float16 h16x4 __attribute__((ext_vector_type(4)));
typedef _Float16 h16x2 __attribute__((ext_vector_type(2)));
typedef float f32x4 __attribute__((ext_vector_type(4)));
typedef float f32x2 __attribute__((ext_vector_type(2)));
typedef unsigned u32x4 __attribute__((ext_vector_type(4)));
typedef unsigned u32x2 __attribute__((ext_vector_type(2)));

constexpr int MTOK = 65536, DM = 1024, SEQ = 8192, NB = 8;
constexpr int NIN = 5376;
constexpr int NTHREADS = 512, NWAVES = 8, NBLK = 256;
constexpr int LDS_BYTES = 131072 + 64;
constexpr float NORM_EPS = 1e-6f;

constexpr size_t MiB = 1u << 20;
constexpr size_t O_WIN = 0;
constexpr size_t O_WA = O_WIN + (size_t)5376 * 1024 * 2;
constexpr size_t O_WB = O_WA + 1 * MiB;
constexpr size_t O_WO = O_WB + 1 * MiB;
constexpr size_t O_WG = O_WO + 2 * MiB;
constexpr size_t O_WP = O_WG + 2 * MiB;
constexpr size_t O_WLR = O_WP + MiB / 2;
constexpr size_t O_WS = O_WLR + 3 * MiB / 4;
constexpr size_t O_U16 = O_WS + 4 * MiB;
constexpr size_t O_V16 = O_U16 + 32 * MiB;
constexpr size_t O_P16 = O_V16 + 32 * MiB;
constexpr size_t O_PART1 = O_P16 + 32 * MiB;
constexpr size_t O_PART3 = O_PART1 + 4 * MiB;
constexpr size_t O_RS1 = O_PART3 + 4 * MiB;
constexpr size_t O_RS2 = O_RS1 + MiB / 4;
constexpr size_t O_XN = O_RS2 + MiB / 4;
constexpr size_t O_ZC = O_XN + 128 * MiB;
constexpr size_t O_ZR = O_ZC + 192 * MiB;
constexpr size_t O_ZG = O_ZR + 224 * MiB;
constexpr size_t O_SS2 = O_ZG + 256 * MiB;
constexpr size_t O_USC = O_SS2 + 2 * MiB;
constexpr size_t O_VSC = O_USC + 65536;
constexpr size_t O_CTR = O_VSC + 65536;
constexpr size_t O_BAR = O_CTR + 8192;
constexpr size_t WS_END = O_BAR + 16384;
constexpr size_t O_U8 = O_U16;
constexpr size_t O_V8 = O_U16 + 16 * MiB;
constexpr size_t O_PART = O_ZG;
constexpr size_t O_COEF = O_ZR + 48 * MiB;
constexpr size_t O_CA = O_XN;
constexpr size_t O_APR = O_XN + 64 * MiB;
constexpr size_t O_H1B = O_XN;
constexpr size_t O_WD = O_ZC;
constexpr size_t O_BD = O_ZC + 64 * MiB;
constexpr size_t O_GG = O_ZC + 128 * MiB;
constexpr size_t O_MERGED = O_ZC;
constexpr size_t O_H2B = O_ZC;
constexpr size_t O_PQ = O_ZR;
constexpr size_t O_SST = O_ZR + 64 * MiB;
constexpr size_t O_Y = O_ZR + 96 * MiB;
constexpr size_t O_YB = O_ZR + 160 * MiB;
constexpr size_t O_IDX = O_ZR;
constexpr size_t O_GATE = O_ZR + 16 * MiB;
constexpr size_t O_PP = O_ZR + 64 * MiB;
constexpr size_t O_SCORES = O_ZG;

struct Args {
    const float* in[29];
    float* out;
    unsigned char* ws;
    int ph_lo, ph_hi;
};

__device__ __forceinline__ int tid_() { int t = threadIdx.x; asm volatile("" : "+v"(t)); return t; }
__device__ __forceinline__ float sigmoidf_(float x) { return __builtin_amdgcn_rcpf(1.0f + __expf(-x)); }
template <int CTRL> __device__ __forceinline__ float dpp_(float v) { return __builtin_bit_cast(float, __builtin_amdgcn_update_dpp(0, __builtin_bit_cast(int, v), CTRL, 0xF, 0xF, true)); }
__device__ __forceinline__ float x32_(float v, int lane) { const auto r = __builtin_amdgcn_permlane32_swap(__builtin_bit_cast(unsigned, v), __builtin_bit_cast(unsigned, v), false, false); return __builtin_bit_cast(float, (lane & 32) ? r[0] : r[1]); }
__device__ __forceinline__ float x16_(float v, int lane) { const auto r = __builtin_amdgcn_permlane16_swap(__builtin_bit_cast(unsigned, v), __builtin_bit_cast(unsigned, v), false, false); return __builtin_bit_cast(float, (lane & 16) ? r[0] : r[1]); }
__device__ __forceinline__ float x8_(float v) { return dpp_<0x128>(v); }
__device__ __forceinline__ float xhm_(float v) { return dpp_<0x141>(v); }
__device__ __forceinline__ float wave_sum(float v) {
    const int lane = threadIdx.x & 63;
    v += dpp_<0xB1>(v); v += dpp_<0x4E>(v); v += dpp_<0x141>(v); v += dpp_<0x140>(v);
    v += x16_(v, lane); v += x32_(v, lane);
    return v;
}
__device__ __forceinline__ __amdgpu_buffer_rsrc_t mkrsrc(const void* p) { return __builtin_amdgcn_make_buffer_rsrc((void*)p, 0, 0x7fffffff, 0x00020000); }
__device__ __forceinline__ h16x8 pack8(f32x4 a, f32x4 b) {
    h16x8 r;
    r[0] = (h16)a[0]; r[1] = (h16)a[1]; r[2] = (h16)a[2]; r[3] = (h16)a[3];
    r[4] = (h16)b[0]; r[5] = (h16)b[1]; r[6] = (h16)b[2]; r[7] = (h16)b[3];
    return r;
}
__device__ __forceinline__ h16x4 pack4(f32x4 a) {
    h16x4 r; r[0] = (h16)a[0]; r[1] = (h16)a[1]; r[2] = (h16)a[2]; r[3] = (h16)a[3]; return r;
}

#define XB_TMO      128
#define XB_XCNT(j)  (256  + 64 * (j))
#define XB_XSUB(j)  (1280 + 64 * (j))
#define XB_XGEN(j)  (2304 + 64 * (j))
#define XB_TOP      3328
#define XB_TOPGEN   3392
#define XCD_BAR_WORDS 3456
#define XB_SPIN_CAP (1u << 18)

__device__ __forceinline__ unsigned xb_ld(unsigned* p)              { return __hip_atomic_load(p, __ATOMIC_RELAXED, __HIP_MEMORY_SCOPE_AGENT); }
__device__ __forceinline__ unsigned xb_add(unsigned* p, unsigned v) { return __hip_atomic_fetch_add(p, v, __ATOMIC_RELAXED, __HIP_MEMORY_SCOPE_AGENT); }
__device__ __forceinline__ unsigned xb_xcc_id() { return (unsigned)__builtin_amdgcn_s_getreg((3 << 11) | 20) & 0xFu; }
#define XB_SPIN(cond, bar) do { unsigned _sp = 0; while (cond) { __builtin_amdgcn_s_sleep(1); \
    if ((++_sp & 255u) == 0u) { if (xb_ld(&(bar)[XB_TMO])) break; if (_sp > XB_SPIN_CAP) { atomicAdd(&(bar)[XB_TMO], 1u); break; } } } } while (0)

struct XcdBarrier {
    unsigned* bar; unsigned x;
    volatile LAS unsigned* st;
};

__device__ __forceinline__ XcdBarrier xcd_barrier_post(unsigned* bar, volatile LAS unsigned* st) {
    XcdBarrier b; b.bar = bar; b.x = xb_xcc_id(); b.st = st;
    if (threadIdx.x == 0) (void)xb_add(&bar[XB_XCNT(b.x)], 1u);
    return b;
}
__device__ __forceinline__ void xcd_barrier_complete(unsigned* bar, unsigned x, unsigned& nloc, unsigned& nx) {
    const unsigned G = gridDim.x * gridDim.y * gridDim.z;
    unsigned sum, cnt, mine, sp = 0u;
    for (;;) {
        sum = 0u; cnt = 0u; mine = 0u;
#pragma unroll
        for (unsigned j = 0; j < 16; ++j) { const unsigned c = xb_ld(&bar[XB_XCNT(j)]); sum += c; cnt += (c > 0u) ? 1u : 0u; mine = (j == x) ? c : mine; }
        if (sum == G) break;
        __builtin_amdgcn_s_sleep(1);
        if ((++sp & 255u) == 0u) { if (xb_ld(&bar[XB_TMO])) break; if (sp > XB_SPIN_CAP) { atomicAdd(&bar[XB_TMO], 1u); break; } }
    }
    nloc = mine > 0u ? mine : 1u; nx = cnt > 0u ? cnt : 1u;
}

__device__ __forceinline__ void xcd_barrier(const XcdBarrier& b) {
    asm volatile("s_waitcnt vmcnt(0)" ::: "memory");
    __syncthreads();
    if (threadIdx.x == 0) {
        unsigned* bar = b.bar;
        __builtin_amdgcn_s_waitcnt(0);
        unsigned nloc = b.st[0], nx = b.st[1];
        if (nloc == 0u) { xcd_barrier_complete(bar, b.x, nloc, nx); b.st[0] = nloc; b.st[1] = nx; }
        const unsigned old = xb_add(&bar[XB_XSUB(b.x)], 1u);
        const unsigned gen = old / nloc;
        if (old + 1u == (gen + 1u) * nloc) {
            __builtin_amdgcn_fence(__ATOMIC_RELEASE, "agent");
            asm volatile("s_waitcnt vmcnt(0)" ::: "memory");
            const unsigned og = xb_add(&bar[XB_TOP], 1u);
            const unsigned tg = og / nx;
            if (og + 1u == (tg + 1u) * nx) xb_add(&bar[XB_TOPGEN], 1u);
            else XB_SPIN(xb_ld(&bar[XB_TOPGEN]) == tg, bar);
            __builtin_amdgcn_fence(__ATOMIC_ACQUIRE, "agent");
            xb_add(&bar[XB_XGEN(b.x)], 1u);
            asm volatile("s_waitcnt vmcnt(0)" ::: "memory");
        } else {
            XB_SPIN(xb_ld(&bar[XB_XGEN(b.x)]) == gen, bar);
            __builtin_amdgcn_fence(__ATOMIC_ACQUIRE, "agent");
            asm volatile("s_waitcnt vmcnt(0)" ::: "memory");
        }
    }
    __syncthreads();
}


namespace pg8 {
constexpr int BM = 256, BK = 64, HALF = 128, HTB = HALF * BK * 2, STAGE_BYTES = 8 * HTB, NXCD = 8, WGM = 8;
__device__ __forceinline__ int lds_byte(int r, int c) { const int st = (r >> 4) * 2 + (c >> 5), rr = r & 15, cc = c & 31, ob = rr * 64 + cc * 2; return st * 1024 + (ob ^ (((ob >> 9) & 1) << 5)); }
__device__ __forceinline__ void stage_rc(int b, int& R, int& C) { const int st = b / 1024, sb = b % 1024, swz = sb ^ (((sb >> 9) & 1) << 5); R = (st >> 1) * 16 + swz / 64; C = (st & 1) * 32 + (swz % 64) / 2; }
__device__ __forceinline__ int perm32(int rho) { const int n = rho >> 4, i = rho & 15; return 8 * (i >> 2) + 4 * n + (i & 3); }

struct Unit { int pm, pn; };
struct Gemm { const h16* A; const h16* Bt; int M, N, K; };

struct StaticOrder {
    int nM, nN, nwg, G, c;
    __device__ void init(int M, int N, int G_, int c_) { nM = M / BM; nN = N / BM; nwg = nM * nN; G = G_; c = c_; }
    __device__ bool next(int i, Unit& u) const {
        const long L = (long)i * G + c; if (L >= nwg) return false;
        int wgid = (int)L; { const int q = nwg / NXCD, r = nwg % NXCD, xcd = wgid % NXCD, off = wgid / NXCD; wgid = (xcd < r ? xcd * (q + 1) : r * (q + 1) + (xcd - r) * q) + off; }
        const int nig = WGM * nN, gid = wgid / nig, fm = gid * WGM, gsz = (nM - fm) < WGM ? (nM - fm) : WGM;
        u.pm = fm + ((wgid % nig) % gsz); u.pn = (wgid % nig) / gsz; return true;
    }
};

template <class Epi>
__device__ __forceinline__ void gemm_phase(LAS unsigned char* lds, const Gemm g, const StaticOrder& S, const Epi& E) {
    const int tid = tid_(), wid = __builtin_amdgcn_readfirstlane(tid >> 6), lane = tid & 63, wr = wid >> 2, wc = wid & 3, fr = lane & 15, fq = lane >> 4;
    const int K = g.K, nt = K / BK;
    unsigned voffA[2], voffB[2];
#pragma unroll
    for (int i = 0; i < 2; ++i) { int R, C; stage_rc(tid * 16 + i * 8192, R, C); const int Rb = (R & ~31) + perm32(R & 31);
        voffA[i] = (unsigned)(R * K + C) * 2u; voffB[i] = (unsigned)(Rb * K + C) * 2u; }
    const size_t kstep = (size_t)(BK * 2);
    const size_t hstep = (size_t)HALF * K * 2;
    const size_t tstep = 2 * hstep;
    const unsigned ldsw = (unsigned)wid * 1024u;
    const int aoff = lds_byte(wr * 64 + fr, fq * 8), boff = lds_byte(wc * 32 + fr, fq * 8);
#define PG8_SA(b, h) (((b) * 2 + (h)) * HTB)
#define PG8_SB(b, h) ((4 + (b) * 2 + (h)) * HTB)
#define PG8_STAGE(bufoff, gbase, voff) do { _Pragma("unroll") for (int _i = 0; _i < 2; ++_i) \
        __builtin_amdgcn_global_load_lds((const unsigned*)((const char*)(gbase) + (voff)[_i]), (LAS unsigned*)(lds + (bufoff) + ldsw + _i * 8192), 16, 0, 0); } while (0)
#define PG8_LDA(dst, b, h) do { _Pragma("unroll") for (int m = 0; m < 4; ++m) _Pragma("unroll") for (int k = 0; k < 2; ++k) dst[m][k] = *(const LAS h16x8*)(lds + PG8_SA(b, h) + aoff + m * 2048 + k * 1024); } while (0)
#define PG8_LDB(dst, b, h) do { _Pragma("unroll") for (int n = 0; n < 2; ++n) _Pragma("unroll") for (int k = 0; k < 2; ++k) dst[n][k] = *(const LAS h16x8*)(lds + PG8_SB(b, h) + boff + n * 2048 + k * 1024); } while (0)
#define PG8_MMA(ai, bj, At, Bt) do { __builtin_amdgcn_s_setprio(1); _Pragma("unroll") for (int m = 0; m < 4; ++m) _Pragma("unroll") for (int n = 0; n < 2; ++n) _Pragma("unroll") for (int k = 0; k < 2; ++k) \
        acc[ai][bj][m][n] = __builtin_amdgcn_mfma_f32_16x16x32_f16(Bt[n][k], At[m][k], acc[ai][bj][m][n], 0, 0, 0); __builtin_amdgcn_s_setprio(0); } while (0)
#define PG8_WAIT_V(n) asm volatile("s_waitcnt vmcnt(" #n ")" ::: "memory")
#define PG8_WAIT_L(n) asm volatile("s_waitcnt lgkmcnt(" #n ")" ::: "memory")
#define PG8_BAR __builtin_amdgcn_s_barrier()
#define PG8_SCHED __builtin_amdgcn_sched_barrier(0)
    Unit cur, nxt; int ui = 0;
    if (!S.next(0, cur)) return;
    f32x4 acc[2][2][4][2];
#pragma unroll
    for (int a = 0; a < 2; ++a)
#pragma unroll
        for (int b = 0; b < 2; ++b)
#pragma unroll
            for (int m = 0; m < 4; ++m)
#pragma unroll
                for (int n = 0; n < 2; ++n) acc[a][b][m][n] = (f32x4){0.f, 0.f, 0.f, 0.f};
    h16x8 At[4][2], B0[2][2], B1[2][2];
    const char* cA = (const char*)g.A + (size_t)cur.pm * tstep; const char* cB = (const char*)g.Bt + (size_t)cur.pn * tstep;
    PG8_STAGE(PG8_SB(0, 0), cB, voffB); PG8_STAGE(PG8_SB(0, 1), cB + hstep, voffB); PG8_STAGE(PG8_SA(0, 0), cA, voffA); PG8_STAGE(PG8_SA(0, 1), cA + hstep, voffA);
    if (wr == 1) PG8_BAR;
    PG8_WAIT_V(2); PG8_BAR;
    PG8_STAGE(PG8_SB(1, 0), cB + kstep, voffB); PG8_STAGE(PG8_SA(1, 0), cA + kstep, voffA); PG8_STAGE(PG8_SB(1, 1), cB + hstep + kstep, voffB);
    PG8_WAIT_V(6); PG8_BAR;
    for (;;) {
        const bool has_next = S.next(ui + 1, nxt);
        const char* nA = has_next ? (const char*)g.A + (size_t)nxt.pm * tstep : cA; const char* nB = has_next ? (const char*)g.Bt + (size_t)nxt.pn * tstep : cB;
        for (int t = 0; t < nt; t += 2) {
            const bool last = (t == nt - 2);
            const char* a1 = cA + (size_t)(t + 1) * kstep;
            const char* a2 = last ? nA : cA + (size_t)(t + 2) * kstep; const char* b2 = last ? nB : cB + (size_t)(t + 2) * kstep;
            const char* a3 = a2 + kstep; const char* b3 = b2 + kstep;
            PG8_LDB(B0, 0, 0); PG8_LDB(B1, 0, 1); PG8_SCHED; PG8_LDA(At, 0, 0); PG8_STAGE(PG8_SA(1, 1), a1 + hstep, voffA);
            PG8_WAIT_V(8); PG8_WAIT_L(0); PG8_BAR; PG8_MMA(0, 0, At, B0); PG8_MMA(0, 1, At, B1); PG8_BAR; PG8_SCHED;
            PG8_LDA(At, 0, 1); PG8_STAGE(PG8_SB(0, 0), b2, voffB); PG8_STAGE(PG8_SB(0, 1), b2 + hstep, voffB); PG8_STAGE(PG8_SA(0, 0), a2, voffA);
            PG8_WAIT_V(8); PG8_WAIT_L(0); PG8_BAR; PG8_MMA(1, 0, At, B0); PG8_MMA(1, 1, At, B1); PG8_BAR; PG8_SCHED;
            PG8_LDB(B0, 1, 0); PG8_LDB(B1, 1, 1); PG8_SCHED; PG8_LDA(At, 1, 0); PG8_STAGE(PG8_SA(0, 1), a2 + hstep, voffA);
            PG8_WAIT_V(8); PG8_WAIT_L(0); PG8_BAR; PG8_MMA(0, 0, At, B0); PG8_MMA(0, 1, At, B1); PG8_BAR; PG8_SCHED;
            PG8_LDA(At, 1, 1); PG8_STAGE(PG8_SB(1, 0), b3, voffB); PG8_STAGE(PG8_SB(1, 1), b3 + hstep, voffB); PG8_STAGE(PG8_SA(1, 0), a3, voffA);
            PG8_WAIT_V(8); PG8_WAIT_L(0); PG8_BAR; PG8_MMA(1, 0, At, B0); PG8_MMA(1, 1, At, B1); PG8_BAR; PG8_SCHED;
        }
        if (wr == 0) PG8_BAR;
        E(acc, cur, wr, wc, fr, fq);
        if (!has_next) break;
#pragma unroll
        for (int a = 0; a < 2; ++a)
#pragma unroll
            for (int b = 0; b < 2; ++b)
#pragma unroll
                for (int m = 0; m < 4; ++m)
#pragma unroll
                    for (int n = 0; n < 2; ++n) acc[a][b][m][n] = (f32x4){0.f, 0.f, 0.f, 0.f};
        cur = nxt; cA = nA; cB = nB; ++ui;
        if (wr == 1) PG8_BAR;
    }
    PG8_WAIT_V(0);
    PG8_BAR;
#undef PG8_SA
#undef PG8_SB
#undef PG8_STAGE
#undef PG8_LDA
#undef PG8_LDB
#undef PG8_MMA
#undef PG8_WAIT_V
#undef PG8_WAIT_L
#undef PG8_BAR
#undef PG8_SCHED
}
}
using pg8::Unit;
typedef const f32x4 (&AccRef)[2][2][4][2];

#define EPI_LOOP_BEGIN \
    _Pragma("unroll") for (int ai = 0; ai < 2; ++ai) _Pragma("unroll") for (int m = 0; m < 4; ++m) { \
        const int row = u.pm * 256 + ai * 128 + wr * 64 + m * 16 + fr; \
        _Pragma("unroll") for (int bj = 0; bj < 2; ++bj) { \
            const int col = u.pn * 256 + bj * 128 + wc * 32 + 8 * fq; \
            const f32x4 v0 = acc[ai][bj][m][0], v1 = acc[ai][bj][m][1];
#define EPI_LOOP_END } }

struct EpiZ {
    h16 *zc, *zr, *zg;
    __device__ __forceinline__ void operator()(AccRef acc, const Unit& u, int wr, int wc, int fr, int fq) const {
        const int colt = u.pn * 256; h16* base; int ld, c0;
        if (colt < 1536) { base = zc; ld = 1536; c0 = colt; } else if (colt < 3328) { base = zr; ld = 1792; c0 = colt - 1536; } else { base = zg; ld = 2048; c0 = colt - 3328; }
        EPI_LOOP_BEGIN
            *(h16x8*)(base + (size_t)row * ld + (col - colt + c0)) = pack8(v0, v1);
        EPI_LOOP_END
    }
};
struct EpiF16 {
    h16* O; int ld;
    __device__ __forceinline__ void operator()(AccRef acc, const Unit& u, int wr, int wc, int fr, int fq) const {
        EPI_LOOP_BEGIN
            *(h16x8*)(O + (size_t)row * ld + col) = pack8(v0, v1);
        EPI_LOOP_END
    }
};
struct EpiYA {
    const h16* zg; h16* tmp;
    __device__ __forceinline__ void operator()(AccRef acc, const Unit& u, int wr, int wc, int fr, int fq) const {
        EPI_LOOP_BEGIN
            const h16x8 gv = *(const h16x8*)(zg + (size_t)row * 2048 + col);
            f32x4 o0, o1;
#pragma unroll
            for (int j = 0; j < 4; ++j) { o0[j] = sigmoidf_((float)gv[j]) * v0[j]; o1[j] = sigmoidf_((float)gv[4 + j]) * v1[j]; }
            *(h16x8*)(tmp + (size_t)row * 1024 + col) = pack8(o0, o1);
        EPI_LOOP_END
    }
};
struct EpiYB {
    const h16* zg; const h16* tmp; h16* merged;
    __device__ __forceinline__ void operator()(AccRef acc, const Unit& u, int wr, int wc, int fr, int fq) const {
        EPI_LOOP_BEGIN
            const h16x8 gv = *(const h16x8*)(zg + (size_t)row * 2048 + 1024 + col);
            const h16x8 tv = *(const h16x8*)(tmp + (size_t)row * 1024 + col);
            f32x4 o0, o1;
#pragma unroll
            for (int j = 0; j < 4; ++j) { o0[j] = (float)tv[j] + sigmoidf_((float)gv[j]) * v0[j]; o1[j] = (float)tv[4 + j] + sigmoidf_((float)gv[4 + j]) * v1[j]; }
            *(h16x8*)(merged + (size_t)row * 1024 + col) = pack8(o0, o1);
        EPI_LOOP_END
    }
};
struct EpiH1 {
    const float* x; h16* hb; float* part;
    __device__ __forceinline__ void operator()(AccRef acc, const Unit& u, int wr, int wc, int fr, int fq) const {
#pragma unroll
        for (int ai = 0; ai < 2; ++ai)
#pragma unroll
            for (int m = 0; m < 4; ++m) {
                const int row = u.pm * 256 + ai * 128 + wr * 64 + m * 16 + fr; float ss = 0.f;
#pragma unroll
                for (int bj = 0; bj < 2; ++bj) {
                    const int col = u.pn * 256 + bj * 128 + wc * 32 + 8 * fq;
                    const float* xp = x + (size_t)row * 1024 + col;
                    const f32x4 o0 = *(const f32x4*)xp + acc[ai][bj][m][0], o1 = *(const f32x4*)(xp + 4) + acc[ai][bj][m][1];
                    *(h16x8*)(hb + (size_t)row * 1024 + col) = pack8(o0, o1);
                    ss += (o0[0] * o0[0] + o0[1] * o0[1]) + (o0[2] * o0[2] + o0[3] * o0[3]) + (o1[0] * o1[0] + o1[1] * o1[1]) + (o1[2] * o1[2] + o1[3] * o1[3]);
                }
                ss += __shfl_xor(ss, 16); ss += __shfl_xor(ss, 32);
                if (fq == 0) part[(size_t)row * 16 + u.pn * 4 + wc] = ss;
            }
    }
};
struct EpiGate {
    float* out; const h16* h2b; const h16* pp; const float* rs2; float* part;
    __device__ __forceinline__ void operator()(AccRef acc, const Unit& u, int wr, int wc, int fr, int fq) const {
#pragma unroll
        for (int ai = 0; ai < 2; ++ai)
#pragma unroll
            for (int m = 0; m < 4; ++m) {
                const int row = u.pm * 256 + ai * 128 + wr * 64 + m * 16 + fr; float ss = 0.f;
                const f32x4 sa = *(const f32x4*)(rs2 + (size_t)row * 8), sb = *(const f32x4*)(rs2 + (size_t)row * 8 + 4);
                const float rs = rsqrtf(((sa[0] + sa[1]) + (sa[2] + sa[3]) + (sb[0] + sb[1]) + (sb[2] + sb[3])) * (1.f / 1024.f) + NORM_EPS);
#pragma unroll
                for (int bj = 0; bj < 2; ++bj) {
                    const int col = u.pn * 256 + bj * 128 + wc * 32 + 8 * fq;
                    float* op = out + (size_t)row * 1024 + col;
                    const h16x8 hv = *(const h16x8*)(h2b + (size_t)row * 1024 + col);
                    f32x4 o0 = (f32x4){(float)hv[0], (float)hv[1], (float)hv[2], (float)hv[3]}, o1 = (f32x4){(float)hv[4], (float)hv[5], (float)hv[6], (float)hv[7]};
                    const h16x8 pv = *(const h16x8*)(pp + (size_t)row * 1024 + col);
                    const f32x4 v0 = acc[ai][bj][m][0], v1 = acc[ai][bj][m][1];
#pragma unroll
                    for (int j = 0; j < 4; ++j) { o0[j] += sigmoidf_(rs * v0[j]) * (float)pv[j]; o1[j] += sigmoidf_(rs * v1[j]) * (float)pv[4 + j]; }
                    *(f32x4*)op = o0; *(f32x4*)(op + 4) = o1;
                    ss += (o0[0] * o0[0] + o0[1] * o0[1]) + (o0[2] * o0[2] + o0[3] * o0[3]) + (o1[0] * o1[0] + o1[1] * o1[1]) + (o1[2] * o1[2] + o1[3] * o1[3]);
                }
                ss += __shfl_xor(ss, 16); ss += __shfl_xor(ss, 32);
                if (fq == 0) part[(size_t)row * 16 + u.pn * 4 + wc] = ss;
            }
    }
};

__device__ __forceinline__ void tr_item(const float* W, int N, const float* g, h16* WT, int ldk, int koff, int k0, int n0, LAS float* scr, int lane) {
#pragma unroll 8
    for (int i = 0; i < 32; ++i) { const int kk = 2 * i + (lane >> 5); float v = W[(size_t)(k0 + kk) * N + n0 + (lane & 31)]; if (g) v *= g[k0 + kk]; scr[kk * 33 + (lane & 31)] = v; }
    asm volatile("s_waitcnt lgkmcnt(0)" ::: "memory");
    const int c = lane & 7;
#pragma unroll
    for (int j = 0; j < 4; ++j) { const int n = (lane >> 3) + 8 * j; const LAS float* s = scr + (8 * c) * 33 + n;
        h16x8 o;
#pragma unroll
        for (int e = 0; e < 8; ++e) o[e] = (h16)s[e * 33];
        *(h16x8*)(WT + (size_t)(n0 + n) * ldk + koff + k0 + 8 * c) = o; }
    asm volatile("s_waitcnt lgkmcnt(0)" ::: "memory");
}
struct TrJob { const float* W; const float* g; h16* WT; int K, N, ldk, koff; };

__device__ __forceinline__ void phase_prep(const Args& a, LAS unsigned char* lds) {
    const int tid = tid_(), lane = tid & 63, wave = tid >> 6;
    const int gw = blockIdx.x * NWAVES + wave, NGW = gridDim.x * NWAVES;
    unsigned char* ws = a.ws;
    {
        LAS float* scr = (LAS float*)(lds + wave * 8704);
        TrJob jobs[9] = {
            {a.in[3], a.in[2], (h16*)(ws + O_WIN), 1024, NIN, 1024, 0},
            {a.in[17], nullptr, (h16*)(ws + O_WA), 512, 1024, 512, 0},
            {a.in[18], nullptr, (h16*)(ws + O_WB), 512, 1024, 512, 0},
            {a.in[19], nullptr, (h16*)(ws + O_WO), 1024, 1024, 1024, 0},
            {a.in[26], a.in[25], (h16*)(ws + O_WG), 1024, 1024, 1024, 0},
            {a.in[27], nullptr, (h16*)(ws + O_WP), 256, 1024, 256, 0},
            {a.in[8], nullptr, (h16*)(ws + O_WLR), 64, 512, 256, 0},
            {a.in[10], nullptr, (h16*)(ws + O_WLR) + (size_t)512 * 256, 64, 512, 256, 64},
            {a.in[11], nullptr, (h16*)(ws + O_WLR) + (size_t)1024 * 256, 128, 512, 256, 128},
        };
        int base = 0;
#pragma unroll
        for (int j = 0; j < 9; ++j) {
            const TrJob J = jobs[j]; const int nnb = J.N / 32, items = (J.K / 64) * nnb;
            int first = gw - (base % NGW); if (first < 0) first += NGW;
            for (int r = first; r < items; r += NGW) tr_item(J.W, J.N, J.g, J.WT, J.ldk, J.koff, (r / nnb) * 64, (r % nnb) * 32, scr, lane);
            base += items;
        }
        h16* wlr = (h16*)(ws + O_WLR);
        for (int i = blockIdx.x * NTHREADS + tid; i < 1536 * 256 / 8; i += gridDim.x * NTHREADS) {
            const int n = (i * 8) / 256, k = (i * 8) % 256; const int blk = n / 512;
            const bool inblk = (blk == 0) ? (k < 64) : (blk == 1) ? (k >= 64 && k < 128) : (k >= 128);
            if (!inblk) { h16x8 z; for (int e = 0; e < 8; ++e) z[e] = (h16)0.f; *(h16x8*)(wlr + (size_t)i * 8) = z; }
        }
    }
    __syncthreads();
    {
        LAS float* LA = (LAS float*)lds;
        LAS float* LB = (LAS float*)(lds + 64 * 129 * 4);
        const float* wq = a.in[21]; const float* sk = a.in[22]; const float* gf = a.in[20];
        h16* wst = (h16*)(ws + O_WS);
        for (int it = blockIdx.x; it < 256; it += gridDim.x) {
            const int g16 = it >> 4, k0 = (it & 15) * 64;
            for (int i = tid; i < 64 * 128; i += NTHREADS) { const int k = i >> 7, d = i & 127; LA[k * 129 + d] = wq[(size_t)(k0 + k) * 2048 + g16 * 128 + d] * gf[k0 + k]; }
            for (int i = tid; i < 128 * 128; i += NTHREADS) { const int n = i >> 7, d = i & 127; LB[n * 129 + d] = sk[((size_t)g16 * 128 + n) * 128 + d]; }
            __syncthreads();
            const int n = tid & 127, kg = tid >> 7;
            float o[16];
#pragma unroll
            for (int j = 0; j < 16; ++j) o[j] = 0.f;
            for (int d = 0; d < 128; ++d) { const float b = LB[n * 129 + d];
#pragma unroll
                for (int j = 0; j < 16; ++j) o[j] += LA[(kg * 16 + j) * 129 + d] * b; }
            h16x8 o0, o1;
#pragma unroll
            for (int j = 0; j < 8; ++j) { o0[j] = (h16)o[j]; o1[j] = (h16)o[8 + j]; }
            h16* dst = wst + (size_t)(g16 * 128 + n) * 1024 + k0 + kg * 16;
            *(h16x8*)dst = o0; *(h16x8*)(dst + 8) = o1;
            __syncthreads();
        }
    }
    {
        const float* gf = a.in[20];
        f32x4 g4[4];
#pragma unroll
        for (int j = 0; j < 4; ++j) g4[j] = *(const f32x4*)(gf + 16 * lane + 4 * j);
        for (int r = gw; r < 2 * 16384; r += NGW) {
            const int tb = r >> 14, e = r & 16383;
            const float* src = (tb ? a.in[24] : a.in[23]) + (size_t)e * 1024 + 16 * lane;
            f32x4 v[4]; float mx = 0.f;
#pragma unroll
            for (int j = 0; j < 4; ++j) { v[j] = *(const f32x4*)(src + 4 * j); if (!tb) v[j] = v[j] * g4[j];
#pragma unroll
                for (int c = 0; c < 4; ++c) mx = fmaxf(mx, fabsf(v[j][c])); }
#pragma unroll
            for (int o = 1; o < 64; o <<= 1) mx = fmaxf(mx, __shfl_xor(mx, o));
            mx = fmaxf(mx, 1e-30f);
            const float sc = 224.0f / mx;
            u32x4 q;
#pragma unroll
            for (int j = 0; j < 4; ++j) { int w = 0; w = __builtin_amdgcn_cvt_pk_fp8_f32(v[j][0] * sc, v[j][1] * sc, w, false); w = __builtin_amdgcn_cvt_pk_fp8_f32(v[j][2] * sc, v[j][3] * sc, w, true); q[j] = (unsigned)w; }
            unsigned char* dst = ws + (tb ? O_V8 : O_U8) + ((size_t)(lane >> 3) * 16384 + e) * 128 + 16 * (lane & 7);
            *(u32x4*)dst = q;
            if (lane == 0) ((float*)(ws + (tb ? O_VSC : O_USC)))[e] = mx * (1.0f / 224.0f);
        }
        if (blockIdx.x == 0 && tid < 32) ((unsigned*)(ws + O_CTR))[tid * 64] = 0u;
        const f32x4* pp = (const f32x4*)a.in[1]; h16x4* dp = (h16x4*)(ws + O_P16);
        const int np4 = MTOK * 256 / 4;
        for (int i = blockIdx.x * NTHREADS + tid; i < np4; i += gridDim.x * NTHREADS) dp[i] = pack4(pp[i]);
    }
    {
        const float* x = a.in[0]; h16* xn = (h16*)(ws + O_XN);
        for (int r = gw; r < MTOK; r += NGW) {
            const f32x4* xr = (const f32x4*)(x + (size_t)r * 1024) + lane;
            f32x4 v[4]; float s = 0.f;
#pragma unroll
            for (int j = 0; j < 4; ++j) { v[j] = xr[64 * j]; s += (v[j][0] * v[j][0] + v[j][1] * v[j][1]) + (v[j][2] * v[j][2] + v[j][3] * v[j][3]); }
            const float rs = rsqrtf(wave_sum(s) * (1.f / 1024.f) + NORM_EPS);
            h16x4* o = (h16x4*)(xn + (size_t)r * 1024) + lane;
#pragma unroll
            for (int j = 0; j < 4; ++j) o[64 * j] = pack4(v[j] * rs);
        }
    }
}

__device__ __forceinline__ void phase_conv(const Args& a) {
    const int tid = tid_(), lane = tid & 63, wave = tid >> 6;
    const int gw = blockIdx.x * NWAVES + wave, NGW = gridDim.x * NWAVES;
    const h16* zc = (const h16*)(a.ws + O_ZC); h16* ca = (h16*)(a.ws + O_CA);
    const float* cw = a.in[4]; const float* cb = a.in[5];
    float w0[8], w1[8], w2[8], bb[8];
#pragma unroll
    for (int j = 0; j < 8; ++j) { const int c = lane * 8 + j; w0[j] = cw[c]; w1[j] = cw[512 + c]; w2[j] = cw[1024 + c]; bb[j] = cb[c]; }
    for (int run = gw; run < MTOK / 32; run += NGW) {
        const int t0 = run * 32;
        float u1[8], u2[8];
        if ((t0 % SEQ) == 0) {
#pragma unroll
            for (int j = 0; j < 8; ++j) { u1[j] = 0.f; u2[j] = 0.f; }
        } else {
            const h16x8 c1 = *(const h16x8*)(zc + (size_t)(t0 - 1) * 1536 + 512 + lane * 8), x1 = *(const h16x8*)(zc + (size_t)(t0 - 1) * 1536 + 1024 + lane * 8);
            const h16x8 c2 = *(const h16x8*)(zc + (size_t)(t0 - 2) * 1536 + 512 + lane * 8), x2 = *(const h16x8*)(zc + (size_t)(t0 - 2) * 1536 + 1024 + lane * 8);
#pragma unroll
            for (int j = 0; j < 8; ++j) { u1[j] = (float)c1[j] * (float)x1[j]; u2[j] = (float)c2[j] * (float)x2[j]; }
        }
        for (int t = t0; t < t0 + 32; ++t) {
            const h16* zrow = zc + (size_t)t * 1536 + lane * 8;
            const h16x8 gb = *(const h16x8*)zrow, gc = *(const h16x8*)(zrow + 512), xi = *(const h16x8*)(zrow + 1024);
            h16x8 o;
#pragma unroll
            for (int j = 0; j < 8; ++j) { const float u0 = (float)gc[j] * (float)xi[j];
                const float y = w0[j] * u2[j] + w1[j] * u1[j] + w2[j] * u0 + bb[j];
                o[j] = (h16)((float)gb[j] * y); u2[j] = u1[j]; u1[j] = u0; }
            *(h16x8*)(ca + (size_t)t * 512 + lane * 8) = o;
        }
    }
}


__device__ __forceinline__ float tanhf_(float x) { return 1.0f - 2.0f * __builtin_amdgcn_rcpf(1.0f + __expf(2.0f * x)); }
__device__ __forceinline__ void phase_rwkv_prep(const Args& a) {
    const int tid = tid_(), lane = tid & 63, wave = tid >> 6;
    const int gw = blockIdx.x * NWAVES + wave, NGW = gridDim.x * NWAVES;
    const h16* zr = (const h16*)(a.ws + O_ZR);
    h16* R = (h16*)a.out; h16* KS = R + (size_t)MTOK * 512; h16* V = KS + (size_t)MTOK * 512; h16* KK = V + (size_t)MTOK * 512;
    h16* APR = (h16*)(a.ws + O_APR);
    const float* mu = a.in[6]; const float* k_k = a.in[12];
    float mr[8], mk[8], mv[8], mt[8], kk8[8];
#pragma unroll
    for (int j = 0; j < 8; ++j) { const int c = lane * 8 + j; mr[j] = mu[c]; mk[j] = mu[512 + c]; mv[j] = mu[1024 + c]; mt[j] = mu[1536 + (c & 255)]; kk8[j] = k_k[c]; }
    for (int run = gw; run < MTOK / 32; run += NGW) {
        const int t0 = run * 32;
        float pr[8], pk[8], pv[8], pt[8];
        if ((t0 % SEQ) == 0) {
#pragma unroll
            for (int j = 0; j < 8; ++j) { pr[j] = 0.f; pk[j] = 0.f; pv[j] = 0.f; pt[j] = 0.f; }
        } else {
            const h16* zp = zr + (size_t)(t0 - 1) * 1792 + lane * 8;
            const h16x8 a0 = *(const h16x8*)zp, a1 = *(const h16x8*)(zp + 512), a2 = *(const h16x8*)(zp + 1024), a3 = *(const h16x8*)(zr + (size_t)(t0 - 1) * 1792 + 1536 + (lane & 31) * 8);
#pragma unroll
            for (int j = 0; j < 8; ++j) { pr[j] = (float)a0[j]; pk[j] = (float)a1[j]; pv[j] = (float)a2[j]; pt[j] = (float)a3[j]; }
        }
        for (int t = t0; t < t0 + 32; ++t) {
            const h16* zp = zr + (size_t)t * 1792 + lane * 8;
            const h16x8 a0 = *(const h16x8*)zp, a1 = *(const h16x8*)(zp + 512), a2 = *(const h16x8*)(zp + 1024), a3 = *(const h16x8*)(zr + (size_t)t * 1792 + 1536 + (lane & 31) * 8);
            h16x8 orr, ok, ov, okk, ot; float kr[8]; float ss = 0.f;
#pragma unroll
            for (int j = 0; j < 8; ++j) {
                const float zr_ = (float)a0[j], zk_ = (float)a1[j], zv_ = (float)a2[j], zt_ = (float)a3[j];
                const float r = zr_ + mr[j] * (pr[j] - zr_), k = zk_ + mk[j] * (pk[j] - zk_), v = zv_ + mv[j] * (pv[j] - zv_), tl = zt_ + mt[j] * (pt[j] - zt_);
                pr[j] = zr_; pk[j] = zk_; pv[j] = zv_; pt[j] = zt_;
                orr[j] = (h16)r; ok[j] = (h16)k; ov[j] = (h16)v;
                kr[j] = k * kk8[j]; ss += kr[j] * kr[j];
                const float tv = (lane < 8) ? tanhf_(tl) : (lane < 16) ? tl : sigmoidf_(tl);
                ot[j] = (h16)tv;
            }
            ss += __shfl_xor(ss, 1); ss += __shfl_xor(ss, 2); ss += __shfl_xor(ss, 4);
            const float rn = rsqrtf(ss + 1e-12f);
#pragma unroll
            for (int j = 0; j < 8; ++j) okk[j] = (h16)(kr[j] * rn);
            const size_t o = (size_t)t * 512 + lane * 8;
            *(h16x8*)(R + o) = orr; *(h16x8*)(KS + o) = ok; *(h16x8*)(V + o) = ov; *(h16x8*)(KK + o) = okk;
            if (lane < 32) *(h16x8*)(APR + (size_t)t * 256 + lane * 8) = ot;
        }
    }
}

struct EpiLR {
    const float *w0, *a0, *k_a; h16 *WD, *KS, *BD, *GG; const h16* KK;
    __device__ __forceinline__ void operator()(AccRef acc, const Unit& u, int wr, int wc, int fr, int fq) const {
        const int part = u.pn >> 1;
        EPI_LOOP_BEGIN
            const int c = col - part * 512; const size_t o = (size_t)row * 512 + c;
            if (part == 0) {
                const f32x4 b0 = *(const f32x4*)(w0 + c), b1 = *(const f32x4*)(w0 + c + 4); f32x4 o0, o1;
#pragma unroll
                for (int j = 0; j < 4; ++j) { o0[j] = __expf(-0.6065306597126334f * sigmoidf_(b0[j] + v0[j])); o1[j] = __expf(-0.6065306597126334f * sigmoidf_(b1[j] + v1[j])); }
                *(h16x8*)(WD + o) = pack8(o0, o1);
            } else if (part == 1) {
                const f32x4 b0 = *(const f32x4*)(a0 + c), b1 = *(const f32x4*)(a0 + c + 4), ka0 = *(const f32x4*)(k_a + c), ka1 = *(const f32x4*)(k_a + c + 4);
                const h16x8 ks = *(const h16x8*)(KS + o), kk = *(const h16x8*)(KK + o); f32x4 k0, k1, bb0, bb1;
#pragma unroll
                for (int j = 0; j < 4; ++j) { const float aa0 = sigmoidf_(b0[j] + v0[j]), aa1 = sigmoidf_(b1[j] + v1[j]);
                    k0[j] = (float)ks[j] * (1.0f + (aa0 - 1.0f) * ka0[j]); k1[j] = (float)ks[4 + j] * (1.0f + (aa1 - 1.0f) * ka1[j]);
                    bb0[j] = aa0 * (float)kk[j]; bb1[j] = aa1 * (float)kk[4 + j]; }
                *(h16x8*)(KS + o) = pack8(k0, k1); *(h16x8*)(BD + o) = pack8(bb0, bb1);
            } else {
                *(h16x8*)(GG + o) = pack8(v0, v1);
            }
        EPI_LOOP_END
    }
};

constexpr int SC_L = 256, SC_NCH = SEQ / SC_L, SC_NB = 8;
constexpr int SC_STEP_F = 6 * 64;
constexpr int SC_WAVE_BYTES = SC_NB * SC_STEP_F * 4 + SC_NB * 64 * 4;
__device__ __forceinline__ float quad_sum(float v) { v += dpp_<0xB1>(v); v += dpp_<0x4E>(v); return v; }
__device__ __forceinline__ void lds_ld8x2(const LAS float* p, f32x2 (&o)[8]) {
#pragma unroll
    for (int j4 = 0; j4 < 4; ++j4) { const f32x4 t = *(const LAS f32x4*)(p + 4 * j4); o[2 * j4] = (f32x2){t[0], t[1]}; o[2 * j4 + 1] = (f32x2){t[2], t[3]}; }
}
template <int MODE>
__device__ __forceinline__ void scan_wave(const Args& a, LAS unsigned char* lds, int task) {
    const int tid = tid_(), lane = tid & 63, wave = tid >> 6;
    const int q = lane & 3, rg = lane >> 2;
    const int chain = task / SC_NCH, chunk = task % SC_NCH, b = chain >> 3, h = chain & 7;
    const size_t row0 = (size_t)b * SEQ + (size_t)chunk * SC_L;
    const h16* R = (const h16*)a.out; const h16* KS = R + (size_t)MTOK * 512; const h16* V = KS + (size_t)MTOK * 512; const h16* KK = V + (size_t)MTOK * 512;
    const h16* WD = (const h16*)(a.ws + O_WD); const h16* BD = (const h16*)(a.ws + O_BD);
    LAS float* buf = (LAS float*)(lds + wave * SC_WAVE_BYTES);
    LAS float* ybuf = buf + SC_NB * SC_STEP_F;
    constexpr int NA = (MODE == 0) ? 5 : (MODE == 1) ? 3 : 6;
    const h16* gp[NA]; int lo[NA];
#pragma unroll
    for (int j = 0; j < NA; ++j) { const int p = lane + 64 * j, seg = p >> 3, part = p & 7, st = seg / NA, ai = seg % NA;
        const int ar = (MODE == 0 && ai == 4) ? 5 : ai;
        const h16* base = (ar == 0) ? KK : (ar == 1) ? WD : (ar == 2) ? BD : (ar == 3) ? KS : (ar == 4) ? R : V;
        gp[j] = base + (row0 + st) * 512 + h * 64 + part * 8; lo[j] = st * SC_STEP_F + ar * 64 + part * 8; }
    f32x2 s[4][8];
    if (MODE == 0) {
#pragma unroll
        for (int i = 0; i < 4; ++i)
#pragma unroll
            for (int j = 0; j < 8; ++j) s[i][j] = (f32x2){0.f, 0.f};
    } else if (MODE == 1) {
#pragma unroll
        for (int i = 0; i < 4; ++i)
#pragma unroll
            for (int j = 0; j < 8; ++j) s[i][j] = (f32x2){(i == q && 2 * j == rg) ? 1.f : 0.f, (i == q && 2 * j + 1 == rg) ? 1.f : 0.f};
    } else {
        const float* S0 = (const float*)(a.ws + O_SST) + (size_t)task * 4096;
#pragma unroll
        for (int i = 0; i < 4; ++i)
#pragma unroll
            for (int j4 = 0; j4 < 4; ++j4) { const f32x4 t = *(const f32x4*)(S0 + (rg + 16 * i) * 64 + 16 * q + 4 * j4);
                s[i][2 * j4] = (f32x2){t[0], t[1]}; s[i][2 * j4 + 1] = (f32x2){t[2], t[3]}; }
    }
    h16x8 pre[NA];
#pragma unroll
    for (int j = 0; j < NA; ++j) pre[j] = *(const h16x8*)gp[j];
    f32x2 kk[8];
    for (int bt = 0; bt < SC_L / SC_NB; ++bt) {
        LAS float* cb = buf;
#pragma unroll
        for (int j = 0; j < NA; ++j) { f32x4 x0, x1;
#pragma unroll
            for (int e = 0; e < 4; ++e) { x0[e] = (float)pre[j][e]; x1[e] = (float)pre[j][4 + e]; }
            *(LAS f32x4*)(cb + lo[j]) = x0; *(LAS f32x4*)(cb + lo[j] + 4) = x1; }
        if (bt + 1 < SC_L / SC_NB) {
#pragma unroll
            for (int j = 0; j < NA; ++j) pre[j] = *(const h16x8*)(gp[j] + (size_t)(bt + 1) * SC_NB * 512);
        }
        lds_ld8x2(cb + 16 * q, kk);
#pragma unroll 2
        for (int st = 0; st < SC_NB; ++st) {
            const LAS float* sb = cb + st * SC_STEP_F;
            f32x2 w[8], bb[8], kx[8]; float vv[4];
            lds_ld8x2(sb + 64 + 16 * q, w); lds_ld8x2(sb + 128 + 16 * q, bb);
            if (MODE != 1) { lds_ld8x2(sb + 192 + 16 * q, kx);
#pragma unroll
                for (int i = 0; i < 4; ++i) vv[i] = sb[320 + rg + 16 * i]; }
            float us[4];
#pragma unroll
            for (int i = 0; i < 4; ++i) { f32x2 t = s[i][0] * kk[0];
#pragma unroll
                for (int j = 1; j < 8; ++j) t = __builtin_elementwise_fma(s[i][j], kk[j], t);
                us[i] = quad_sum(t[0] + t[1]); }
            if (st + 1 < SC_NB) lds_ld8x2(sb + SC_STEP_F + 16 * q, kk);
            f32x2 rr[8];
            if (MODE == 2) lds_ld8x2(sb + 256 + 16 * q, rr);
#pragma unroll
            for (int i = 0; i < 4; ++i) { const f32x2 nu = (f32x2){-us[i], -us[i]}, v2 = (f32x2){vv[i], vv[i]};
#pragma unroll
                for (int j = 0; j < 8; ++j) { f32x2 t = s[i][j] * w[j]; t = __builtin_elementwise_fma(nu, bb[j], t); if (MODE != 1) t = __builtin_elementwise_fma(v2, kx[j], t); s[i][j] = t; } }
            if (MODE == 2) {
#pragma unroll
                for (int i = 0; i < 4; ++i) { f32x2 t = s[i][0] * rr[0];
#pragma unroll
                    for (int j = 1; j < 8; ++j) t = __builtin_elementwise_fma(s[i][j], rr[j], t);
                    const float y = quad_sum(t[0] + t[1]);
                    if (q == 0) ybuf[st * 64 + rg + 16 * i] = y; }
            }
        }
        if (MODE == 2) {
            const int st = lane >> 3, part = lane & 7; h16x8 o;
#pragma unroll
            for (int e = 0; e < 8; ++e) o[e] = (h16)ybuf[st * 64 + part * 8 + e];
            *(h16x8*)((h16*)(a.ws + O_Y) + (row0 + (size_t)bt * SC_NB + st) * 512 + h * 64 + part * 8) = o;
        }
    }
    if (MODE != 2) {
        float* PQ = (float*)(a.ws + O_PQ) + (size_t)task * 8192 + (MODE == 0 ? 4096 : 0);
#pragma unroll
        for (int i = 0; i < 4; ++i)
#pragma unroll
            for (int j4 = 0; j4 < 4; ++j4) { const int o = (rg + 16 * i) * 64 + 16 * q + 4 * j4;
                *(f32x4*)(PQ + o) = (f32x4){s[i][2 * j4][0], s[i][2 * j4][1], s[i][2 * j4 + 1][0], s[i][2 * j4 + 1][1]}; }
    }
}
template <bool FIRST>
__device__ __forceinline__ void phase_scan(const Args& a, LAS unsigned char* lds) {
    const int wave = tid_() >> 6;
    if (FIRST) {
        for (int task = blockIdx.x * NWAVES + wave; task < 64 * SC_NCH; task += gridDim.x * NWAVES) { scan_wave<0>(a, lds, task); scan_wave<1>(a, lds, task); }
    } else {
        for (int task = blockIdx.x * NWAVES + wave; task < 64 * SC_NCH; task += gridDim.x * NWAVES) scan_wave<2>(a, lds, task);
    }
}

constexpr size_t O_VTB = O_ZR;
constexpr size_t O_BON = O_ZR + 64 * MiB;
constexpr int UT_WAVE_LDS = 15360;
typedef float f32x16 __attribute__((ext_vector_type(16)));
__device__ __forceinline__ size_t ut_ov(int j, int s) { return (size_t)(j >> 2) * 512 + (j & 3) * 16 + s; }
__device__ __forceinline__ void phase_ut_pre(const Args& a, LAS unsigned char* lds) {
    const int tid = tid_(), lane = tid & 63, wave = tid >> 6;
    const int gw = blockIdx.x * NWAVES + wave, NGW = gridDim.x * NWAVES;
    LAS unsigned char* Lb = lds + wave * UT_WAVE_LDS;
    LAS h16* YX = (LAS h16*)Lb;
    LAS float* GT = (LAS float*)(Lb + 9216);
    LAS float* TM = (LAS float*)(Lb + 13824);
    h16* R = (h16*)a.out; h16* KS = R + (size_t)MTOK * 512; h16* V = KS + (size_t)MTOK * 512; h16* KK = V + (size_t)MTOK * 512;
    h16* WD = (h16*)(a.ws + O_WD); h16* BD = (h16*)(a.ws + O_BD);
    h16* VTB = (h16*)(a.ws + O_VTB); float* BON = (float*)(a.ws + O_BON);
    for (int bh = gw; bh < 32768; bh += NGW) {
        int ln = lane; asm volatile("" : "+v"(ln)); const int r16 = ln & 15;
        const int h = bh & 7, nb = bh >> 3; const size_t tok0 = (size_t)nb * 16; const size_t e0 = tok0 * 512 + h * 64;
        const float rk = a.in[14][h * 64 + lane];
        {
            h16x8 stg[12];
#pragma unroll
            for (int j = 0; j < 12; ++j) { const int ar = j >> 1, row = (lane >> 3) + 8 * (j & 1);
                const h16* base = (ar == 0) ? WD : (ar == 1) ? KK : (ar == 2) ? BD : (ar == 3) ? KS : (ar == 4) ? R : V;
                stg[j] = *(const h16x8*)(base + e0 + (size_t)row * 512 + (lane & 7) * 8); }
#pragma unroll
            for (int j = 0; j < 12; ++j) *(LAS h16x8*)((LAS h16*)Lb + ((j >> 1) * 16 + (lane >> 3) + 8 * (j & 1)) * 64 + (lane & 7) * 8) = stg[j];
            asm volatile("s_waitcnt lgkmcnt(0)" ::: "memory");
        }
        float w[16], kk[16], bb[16], kx[16], rr[16]; h16x8 vt0, vt1;
        { const LAS h16* IN = (const LAS h16*)Lb;
#pragma unroll
        for (int t = 0; t < 16; ++t) { w[t] = (float)IN[t * 64 + lane]; kk[t] = (float)IN[(16 + t) * 64 + lane]; bb[t] = (float)IN[(32 + t) * 64 + lane]; kx[t] = (float)IN[(48 + t) * 64 + lane]; rr[t] = (float)IN[(64 + t) * 64 + lane];
            if (t < 8) vt0[t] = IN[(80 + t) * 64 + lane]; else vt1[t - 8] = IN[(80 + t) * 64 + lane]; } }
        asm volatile("s_waitcnt lgkmcnt(0)" ::: "memory");
        { h16* vp = VTB + (size_t)bh * 1024 + lane * 16; *(h16x8*)vp = vt0; *(h16x8*)(vp + 8) = vt1; }
        float bonv = 0.f;
#pragma unroll
        for (int t = 0; t < 16; ++t) { const float bs = wave_sum(rr[t] * kx[t] * rk); bonv = (ln == t) ? bs : bonv; }
        if (lane < 16) BON[(tok0 + lane) * 8 + h] = bonv;
        float Lt[16]; { float Lc = 0.f;
#pragma unroll
            for (int t = 0; t < 16; ++t) { Lc += __logf(w[t]); Lt[t] = Lc; } }
        const float Lref = Lt[7];
        float btil[16]; h16x8 kt0, kt1;
        LAS h16* OS = (LAS h16*)(Lb + 9216);
#pragma unroll
        for (int t = 0; t < 16; ++t) {
            const float Lp = t ? Lt[t - 1] : 0.f;
            const float ka = kk[t] * __expf(Lp - Lref), rt = rr[t] * __expf(Lt[t] - Lref), e2 = __expf(Lref - Lt[t]), bt = bb[t] * e2, kt = kx[t] * e2;
            YX[t * 72 + lane] = (h16)ka; YX[(16 + t) * 72 + lane] = (h16)rt; YX[(32 + t) * 72 + lane] = (h16)kt; YX[(48 + t) * 72 + lane] = (h16)bt;
            btil[t] = bt;
            OS[t * 64 + lane] = (h16)(kk[t] * __expf(Lp)); OS[(16 + t) * 64 + lane] = (h16)(rr[t] * __expf(Lt[t]));
            const float ktp = kx[t] * __expf(Lt[15] - Lt[t]);
            if (t < 8) kt0[t] = (h16)ktp; else kt1[t - 8] = (h16)ktp;
        }
        const float post = __expf(Lt[15] - Lref), w16 = __expf(Lt[15]);
        { h16* kp = KS + e0 + ut_ov(lane, 0); *(h16x8*)kp = kt0; *(h16x8*)(kp + 8) = kt1; }
        asm volatile("s_waitcnt lgkmcnt(0)" ::: "memory");
#pragma unroll
        for (int j = 0; j < 4; ++j) { const int row = (lane >> 3) + 8 * (j & 1); const h16x8 o8 = *(const LAS h16x8*)(OS + ((j >> 1) * 16 + row) * 64 + (lane & 7) * 8);
            *(h16x8*)(((j >> 1) ? R : KK) + e0 + (size_t)row * 512 + (lane & 7) * 8) = o8; }
        asm volatile("s_waitcnt lgkmcnt(0)" ::: "memory");
        f32x16 acc;
#pragma unroll
        for (int i = 0; i < 16; ++i) acc[i] = 0.f;
#pragma unroll
        for (int ks = 0; ks < 4; ++ks) {
            const h16x8 af = *(const LAS h16x8*)(YX + (lane & 31) * 72 + 8 * (lane >> 5) + 16 * ks), bf = *(const LAS h16x8*)(YX + (32 + (lane & 31)) * 72 + 8 * (lane >> 5) + 16 * ks);
            acc = __builtin_amdgcn_mfma_f32_32x32x16_f16(af, bf, acc, 0, 0, 0);
        }
#pragma unroll
        for (int i = 0; i < 16; ++i) GT[((i & 3) + 8 * (i >> 2) + 4 * (lane >> 5)) * 36 + (lane & 31)] = acc[i];
        asm volatile("s_waitcnt lgkmcnt(0)" ::: "memory");
        float T[16];
#pragma unroll
        for (int t = 0; t < 16; ++t) { float v = (r16 == t) ? 1.f : 0.f;
#pragma unroll
            for (int s2 = 0; s2 < t; ++s2) v -= T[s2] * GT[t * 36 + 16 + s2];
            T[t] = v; }
#pragma unroll
        for (int t = 0; t < 16; ++t) TM[r16 * 20 + t] = T[t];
        asm volatile("s_waitcnt lgkmcnt(0)" ::: "memory");
        float bcol[16];
#pragma unroll
        for (int s2 = 0; s2 < 16; ++s2) bcol[s2] = (s2 <= r16) ? GT[(16 + r16) * 36 + 16 + s2] : 0.f;
        h16x8 tb0, tb1, tp0, tp1;
#pragma unroll
        for (int r = 0; r < 16; ++r) { float s0 = 0.f, s1 = 0.f;
#pragma unroll
            for (int s2 = r; s2 < 16; ++s2) { const float tv = TM[r * 20 + s2]; s0 += tv * btil[s2]; s1 += tv * bcol[s2]; }
            s0 *= post;
            if (r < 8) { tb0[r] = (h16)s0; tp0[r] = (h16)s1; } else { tb1[r - 8] = (h16)s0; tp1[r - 8] = (h16)s1; } }
        { h16* bp = BD + e0 + ut_ov(lane, 0); *(h16x8*)bp = tb0; *(h16x8*)(bp + 8) = tb1; }
        if (lane < 16) {
            h16x8 a0, a1, p0, p1;
#pragma unroll
            for (int s2 = 0; s2 < 16; ++s2) { const float av = (s2 < ln) ? GT[ln * 36 + s2] : 0.f, pv = (s2 <= ln) ? GT[(16 + ln) * 36 + s2] : 0.f;
                if (s2 < 8) { a0[s2] = (h16)av; p0[s2] = (h16)pv; } else { a1[s2 - 8] = (h16)av; p1[s2 - 8] = (h16)pv; } }
            h16* ap = WD + e0 + (size_t)(lane >> 2) * 512 + (lane & 3) * 16;
            *(h16x8*)ap = a0; *(h16x8*)(ap + 8) = a1;
            *(h16x8*)(ap + 4 * 512) = p0; *(h16x8*)(ap + 4 * 512 + 8) = p1;
            *(h16x8*)(ap + 8 * 512) = tp0; *(h16x8*)(ap + 8 * 512 + 8) = tp1;
        }
        (WD + e0 + (size_t)12 * 512)[lane] = (h16)w16;
        asm volatile("s_waitcnt lgkmcnt(0)" ::: "memory");
    }
}
struct UtOps { u32x2 ka[2][2], rt[2][2], kt[4], tb[4], at, apt, tp, vb, w16[4]; };
struct UtRes { __amdgpu_buffer_rsrc_t kk, r, ks, bd, wd, vt, y; };
__device__ __forceinline__ void ut_load(UtOps& o, const UtRes& R, int so, unsigned offK, unsigned offT, unsigned offV, unsigned offF) {
#pragma unroll
    for (int ks = 0; ks < 2; ++ks)
#pragma unroll
        for (int p = 0; p < 2; ++p) { o.ka[ks][p] = __builtin_amdgcn_raw_buffer_load_b64(R.kk, offK + 64u * ks + 32u * p, so, 0); o.rt[ks][p] = __builtin_amdgcn_raw_buffer_load_b64(R.r, offK + 64u * ks + 32u * p, so, 0); }
#pragma unroll
    for (int kt = 0; kt < 4; ++kt) { o.kt[kt] = __builtin_amdgcn_raw_buffer_load_b64(R.ks, offT + 4096u * kt, so, 0); o.tb[kt] = __builtin_amdgcn_raw_buffer_load_b64(R.bd, offT + 4096u * kt, so, 0); }
    o.at = __builtin_amdgcn_raw_buffer_load_b64(R.wd, offT, so, 0); o.apt = __builtin_amdgcn_raw_buffer_load_b64(R.wd, offT + 4096u, so, 0); o.tp = __builtin_amdgcn_raw_buffer_load_b64(R.wd, offT + 8192u, so, 0);
    o.vb = __builtin_amdgcn_raw_buffer_load_b64(R.vt, offV, so, 0);
#pragma unroll
    for (int kt = 0; kt < 4; ++kt) o.w16[kt] = __builtin_amdgcn_raw_buffer_load_b64(R.wd, offF + 12u * 1024u + 32u * kt, so, 0);
}
__device__ __forceinline__ f32x4 h4f(u32x2 v) { const h16x4 h = __builtin_bit_cast(h16x4, v); return (f32x4){(float)h[0], (float)h[1], (float)h[2], (float)h[3]}; }
__device__ __forceinline__ h16x8 cat8(u32x2 lo, u32x2 hi) { u32x4 r; r[0] = lo[0]; r[1] = lo[1]; r[2] = hi[0]; r[3] = hi[1]; return __builtin_bit_cast(h16x8, r); }
__device__ __forceinline__ void ut_block(const UtOps& o, f32x4 (&S)[4], const UtRes& R, unsigned offY, int so) {
    const f32x4 zf = (f32x4){0.f, 0.f, 0.f, 0.f}; const u32x2 zu = (u32x2){0u, 0u};
    const h16x8 sb0 = pack8(S[0], S[1]), sb1 = pack8(S[2], S[3]);
    const h16x8 vb = cat8(o.vb, zu);
    f32x4 x1 = zf, y = zf;
    x1 = __builtin_amdgcn_mfma_f32_16x16x32_f16(cat8(o.ka[0][0], o.ka[0][1]), sb0, x1, 0, 0, 0); y = __builtin_amdgcn_mfma_f32_16x16x32_f16(cat8(o.rt[0][0], o.rt[0][1]), sb0, y, 0, 0, 0);
    x1 = __builtin_amdgcn_mfma_f32_16x16x32_f16(cat8(o.ka[1][0], o.ka[1][1]), sb1, x1, 0, 0, 0); y = __builtin_amdgcn_mfma_f32_16x16x32_f16(cat8(o.rt[1][0], o.rt[1][1]), sb1, y, 0, 0, 0);
    x1 = __builtin_amdgcn_mfma_f32_16x16x32_f16(cat8(o.at, zu), vb, x1, 0, 0, 0); y = __builtin_amdgcn_mfma_f32_16x16x32_f16(cat8(o.apt, zu), vb, y, 0, 0, 0);
    f32x4 St[4];
#pragma unroll
    for (int kt = 0; kt < 4; ++kt) St[kt] = __builtin_amdgcn_mfma_f32_16x16x32_f16(cat8(o.kt[kt], zu), vb, S[kt] * h4f(o.w16[kt]), 0, 0, 0);
    const h16x8 xb = pack8(-x1, zf);
    y = __builtin_amdgcn_mfma_f32_16x16x32_f16(cat8(o.tp, zu), xb, y, 0, 0, 0);
#pragma unroll
    for (int kt = 0; kt < 4; ++kt) S[kt] = __builtin_amdgcn_mfma_f32_16x16x32_f16(cat8(o.tb[kt], zu), xb, St[kt], 0, 0, 0);
#pragma unroll
    for (int rg = 0; rg < 4; ++rg) { const h16 hv = (h16)y[rg]; __builtin_amdgcn_raw_buffer_store_b16(__builtin_bit_cast(unsigned short, hv), R.y, offY + 1024u * rg, so, 0); }
}
__device__ __forceinline__ void phase_ut_seq(const Args& a, LAS unsigned char* lds) {
    const int tid = tid_(), lane = tid & 63, wave = tid >> 6, fr = lane & 15, fq = lane >> 4;
    volatile LAS int* prog = (volatile LAS int*)lds;
    if (tid == 0) *prog = 0;
    if (wave > 1) return;
    for (int item = blockIdx.x; item < 256; item += gridDim.x) {
        const int h = item & 7, q = item >> 3, g = q & 3, b = q >> 2;
        const size_t e0 = ((size_t)b * SEQ * 512 + h * 64) * 2;
        const char* Rb = (const char*)a.out + e0; const char* KSb = Rb + (size_t)MTOK * 1024; const char* KKb = Rb + (size_t)3 * MTOK * 1024;
        const char* WDb = (const char*)(a.ws + O_WD) + e0; const char* BDb = (const char*)(a.ws + O_BD) + e0;
        const char* VTb = (const char*)(a.ws + O_VTB) + ((size_t)b * (SEQ / 16) * 8 + h) * 2048;
        if (wave == 1) {
            const int ar = lane >> 4, row = lane & 15;
            const char* p0 = ((ar == 0) ? KKb : (ar == 1) ? Rb : (ar == 2) ? KSb : BDb) + (size_t)row * 1024;
            const char* p1 = (lane < 16) ? WDb + (size_t)row * 1024 : VTb + (size_t)(4 * g + (lane & 3)) * 128;
            for (int n0 = 0; n0 < SEQ / 16; n0 += 8) {
                int guard = 0;
                while (*prog + 16 < n0 && ++guard < (1 << 22)) __builtin_amdgcn_s_sleep(8);
                unsigned x[16];
#pragma unroll
                for (int i = 0; i < 8; ++i) { x[2 * i] = *(const unsigned*)(p0 + (size_t)(n0 + i) * 16384); x[2 * i + 1] = *(const unsigned*)(p1 + (size_t)(n0 + i) * 16384); }
#pragma unroll
                for (int i = 0; i < 16; ++i) asm volatile("" :: "v"(x[i]));
            }
            continue;
        }
        const unsigned offK = (unsigned)(fr * 1024 + 8 * fq), offT = (unsigned)((fr >> 2) * 512 + (fr & 3) * 16 + 4 * fq) * 2u, offV = (unsigned)((16 * g + fr) * 16 + 4 * fq) * 2u, offF = (unsigned)fq * 8u,
                       offY = (unsigned)((4 * fq) * 512 + 16 * g + fr) * 2u;
        UtRes RS; RS.kk = mkrsrc(KKb); RS.r = mkrsrc(Rb); RS.ks = mkrsrc(KSb); RS.bd = mkrsrc(BDb); RS.wd = mkrsrc(WDb); RS.vt = mkrsrc(VTb);
        RS.y = mkrsrc((const char*)(a.ws + O_Y) + e0);
        f32x4 S[4];
#pragma unroll
        for (int kt = 0; kt < 4; ++kt) S[kt] = (f32x4){0.f, 0.f, 0.f, 0.f};
        UtOps oa, ob, oc;
#define UT_LD(o, nn) ut_load(o, RS, ((nn) < SEQ / 16 ? (nn) : SEQ / 16 - 1) * 16384, offK, offT, offV, offF)
        UT_LD(oa, 0); UT_LD(ob, 1);
        int n = 0;
#pragma unroll 1
        for (; n + 3 <= SEQ / 16; n += 3) {
            if (lane == 0) *prog = n;
            UT_LD(oc, n + 2); ut_block(oa, S, RS, offY, n * 16384);
            UT_LD(oa, n + 3); ut_block(ob, S, RS, offY, (n + 1) * 16384);
            UT_LD(ob, n + 4); ut_block(oc, S, RS, offY, (n + 2) * 16384);
        }
        ut_block(oa, S, RS, offY, n * 16384); ut_block(ob, S, RS, offY, (n + 1) * 16384);
#undef UT_LD
    }
}

__device__ __forceinline__ void phase_scan_combine(const Args& a, LAS unsigned char* lds) {
    const int tid = tid_(), row = tid >> 5, cp = tid & 31;
    LAS float* LS = (LAS float*)lds;
    LAS float* LP = (LAS float*)(lds + 8192);
    for (int item = blockIdx.x; item < 64 * 4; item += gridDim.x) {
        const int chain = item >> 2, r0 = (item & 3) * 16;
        const float* PQ0 = (const float*)(a.ws + O_PQ) + (size_t)chain * SC_NCH * 8192;
        f32x2 sr = (f32x2){0.f, 0.f};
        f32x4 pa = *(const f32x4*)(PQ0 + tid * 8), pb = *(const f32x4*)(PQ0 + tid * 8 + 4);
        f32x2 qn = *(const f32x2*)(PQ0 + 4096 + (r0 + row) * 64 + 2 * cp);
        for (int c = 0; c < SC_NCH; ++c) {
            const int task = chain * SC_NCH + c;
            *(f32x2*)((float*)(a.ws + O_SST) + (size_t)task * 4096 + (r0 + row) * 64 + 2 * cp) = sr;
            if (c == SC_NCH - 1) break;
            LAS float* cur = LS + (c & 1) * 1024; LAS float* cp_ = LP + (c & 1) * 4096;
            *(LAS f32x2*)(cur + row * 64 + 2 * cp) = sr;
            *(LAS f32x4*)(cp_ + tid * 8) = pa; *(LAS f32x4*)(cp_ + tid * 8 + 4) = pb;
            f32x2 acc0 = qn, acc1 = (f32x2){0.f, 0.f};
            if (c + 2 < SC_NCH) { const float* Pn = PQ0 + (size_t)(c + 1) * 8192;
                pa = *(const f32x4*)(Pn + tid * 8); pb = *(const f32x4*)(Pn + tid * 8 + 4); qn = *(const f32x2*)(Pn + 4096 + (r0 + row) * 64 + 2 * cp); }
            __syncthreads();
#pragma unroll 16
            for (int k = 0; k < 64; k += 2) {
                const f32x2 sk = *(const LAS f32x2*)(cur + row * 64 + k);
                const f32x2 p0 = *(const LAS f32x2*)(cp_ + k * 64 + 2 * cp), p1 = *(const LAS f32x2*)(cp_ + (k + 1) * 64 + 2 * cp);
                acc0 = __builtin_elementwise_fma((f32x2){sk[0], sk[0]}, p0, acc0); acc1 = __builtin_elementwise_fma((f32x2){sk[1], sk[1]}, p1, acc1);
            }
            sr = acc0 + acc1;
        }
        __syncthreads();
    }
}
__device__ __forceinline__ void phase_rwkv_post(const Args& a) {
    const int tid = tid_(), lane = tid & 63, wave = tid >> 6;
    const int gw = blockIdx.x * NWAVES + wave, NGW = gridDim.x * NWAVES;
    const h16* V = (const h16*)a.out + (size_t)2 * MTOK * 512;
    const h16* GG = (const h16*)(a.ws + O_GG); const h16* Y = (const h16*)(a.ws + O_Y); h16* YB = (h16*)(a.ws + O_YB); const float* BON = (const float*)(a.ws + O_BON);
    float lg[8], lb[8];
#pragma unroll
    for (int j = 0; j < 8; ++j) { const int c = lane * 8 + j; lg[j] = a.in[15][c]; lb[j] = a.in[16][c]; }
    for (int t = gw; t < MTOK; t += NGW) {
        const size_t o = (size_t)t * 512 + lane * 8;
        const h16x8 y8 = *(const h16x8*)(Y + o), v8 = *(const h16x8*)(V + o), g8 = *(const h16x8*)(GG + o);
        const float bs = BON[(size_t)t * 8 + (lane >> 3)];
        float y[8]; float sm = 0.f;
#pragma unroll
        for (int j = 0; j < 8; ++j) { y[j] = (float)y8[j]; sm += y[j]; }
        sm += dpp_<0xB1>(sm); sm += dpp_<0x4E>(sm); sm += dpp_<0x141>(sm);
        const float mean = sm * (1.f / 64.f); float vs = 0.f;
#pragma unroll
        for (int j = 0; j < 8; ++j) { y[j] -= mean; vs += y[j] * y[j]; }
        vs += dpp_<0xB1>(vs); vs += dpp_<0x4E>(vs); vs += dpp_<0x141>(vs);
        const float rstd = rsqrtf(vs * (1.f / 64.f) + 64e-5f);
        h16x8 ov;
#pragma unroll
        for (int j = 0; j < 8; ++j) ov[j] = (h16)((y[j] * rstd * lg[j] + lb[j] + bs * (float)v8[j]) * (float)g8[j]);
        *(h16x8*)(YB + o) = ov;
    }
}

__device__ __forceinline__ void ins16(unsigned (&L)[16], unsigned x) {
#pragma unroll
    for (int j = 0; j < 16; ++j) { const unsigned hi = L[j] > x ? L[j] : x; x = L[j] > x ? x : L[j]; L[j] = hi; }
}
__device__ __forceinline__ unsigned ord32(float f) { const unsigned u = __float_as_uint(f); return (u & 0x80000000u) ? ~u : (u | 0x80000000u); }
__device__ __forceinline__ float unord32(unsigned k) { return __uint_as_float((k & 0x80000000u) ? (k & 0x7fffffffu) : ~k); }
__device__ __forceinline__ void phase_topk(const Args& a, LAS unsigned char* lds) {
    const int tid = tid_();
    const h16* SC = (const h16*)(a.ws + O_SCORES);
    const float* part = (const float*)(a.ws + O_PART1);
    unsigned short* IDX = (unsigned short*)(a.ws + O_IDX); float* GATE = (float*)(a.ws + O_GATE); float* RS1 = (float*)(a.ws + O_RS1);
    LAS unsigned char* LI = lds;
    for (int task = blockIdx.x * NTHREADS + tid; task < MTOK * 8; task += gridDim.x * NTHREADS) {
        const int t = task >> 3, h = task & 7;
        float ssq = 0.f;
#pragma unroll
        for (int j = 0; j < 4; ++j) { const f32x4 p4 = *(const f32x4*)(part + (size_t)t * 16 + 4 * j); ssq += (p4[0] + p4[1]) + (p4[2] + p4[3]); }
        const float rs = rsqrtf(ssq * (1.f / 1024.f) + NORM_EPS);
        if (h == 0) RS1[t] = rs;
        float sv[2][16];
#pragma unroll
        for (int c = 0; c < 2; ++c) {
            unsigned L[16];
#pragma unroll
            for (int j = 0; j < 16; ++j) L[j] = 0u;
            const h16* row = SC + (size_t)t * 2048 + h * 256 + c * 128;
#pragma unroll 2
            for (int n8 = 0; n8 < 16; ++n8) {
                const u32x4 w4 = *(const u32x4*)(row + n8 * 8);
#pragma unroll
                for (int e = 0; e < 8; ++e) {
                    const unsigned bits = (e & 1) ? (w4[e >> 1] >> 16) : (w4[e >> 1] & 0xffffu);
                    const unsigned o16 = (bits & 0x8000u) ? (~bits & 0xffffu) : (bits | 0x8000u);
                    ins16(L, (o16 << 16) | (unsigned)(127 - (n8 * 8 + e)));
                }
            }
#pragma unroll
            for (int j = 0; j < 16; ++j) {
                const unsigned o16 = L[j] >> 16; const unsigned bits = (o16 & 0x8000u) ? (o16 & 0x7fffu) : (~o16 & 0xffffu);
                union { unsigned short u; h16 f; } cv; cv.u = (unsigned short)bits; sv[c][j] = (float)cv.f;
                LI[(c * 16 + j) * 512 + tid] = (unsigned char)(127u - (L[j] & 127u));
            }
        }
        unsigned L[16];
#pragma unroll
        for (int j = 0; j < 16; ++j) L[j] = 0u;
#pragma unroll
        for (int i = 0; i < 16; ++i)
#pragma unroll
            for (int j = 0; j < 16; ++j) if ((i + 1) * (j + 1) <= 16) ins16(L, (ord32(sv[0][i] + sv[1][j]) & ~255u) | (unsigned)(255 - (i * 16 + j)));
        float e[16]; float den = 0.f; const float mx = unord32(L[0] & ~255u) * rs;
        unsigned short id[16];
#pragma unroll
        for (int k = 0; k < 16; ++k) {
            const float v = unord32(L[k] & ~255u) * rs; e[k] = __expf(v - mx); den += e[k];
            const unsigned pos = 255u - (L[k] & 255u); const unsigned i = pos >> 4, j = pos & 15u;
            id[k] = (unsigned short)((unsigned)LI[i * 512 + tid] * 128u + (unsigned)LI[(16 + j) * 512 + tid]);
        }
        const float inv = __builtin_amdgcn_rcpf(den);
        u32x4 i0, i1;
        i0[0] = id[0] | (id[1] << 16); i0[1] = id[2] | (id[3] << 16); i0[2] = id[4] | (id[5] << 16); i0[3] = id[6] | (id[7] << 16);
        i1[0] = id[8] | (id[9] << 16); i1[1] = id[10] | (id[11] << 16); i1[2] = id[12] | (id[13] << 16); i1[3] = id[14] | (id[15] << 16);
        u32x4* ip = (u32x4*)(IDX + (size_t)task * 16); ip[0] = i0; ip[1] = i1;
        f32x4* gp = (f32x4*)(GATE + (size_t)task * 16);
#pragma unroll
        for (int k4 = 0; k4 < 4; ++k4) gp[k4] = (f32x4){e[4 * k4] * inv, e[4 * k4 + 1] * inv, e[4 * k4 + 2] * inv, e[4 * k4 + 3] * inv};
    }
}

__device__ __forceinline__ float gelu_tanh(float x) { const float u = 0.7978845608028654f * (x + 0.044715f * x * x * x); return 0.5f * x * (1.0f + tanhf_(u)); }
__device__ __forceinline__ unsigned xcc_id() { return (unsigned)__builtin_amdgcn_s_getreg((3 << 11) | 20) & 7u; }
constexpr int GA_TC = 32, GA_NCH = MTOK / GA_TC;
__device__ __forceinline__ void dec16(const u32x4 q, float (&o)[16]) {
#pragma unroll
    for (int w = 0; w < 4; ++w) { const f32x2 lo = __builtin_amdgcn_cvt_pk_f32_fp8((int)q[w], false), hi = __builtin_amdgcn_cvt_pk_f32_fp8((int)q[w], true);
        o[4 * w] = lo[0]; o[4 * w + 1] = lo[1]; o[4 * w + 2] = hi[0]; o[4 * w + 3] = hi[1]; }
}
__device__ __forceinline__ void dec16p(const u32x4 q, f32x2 (&o)[8]) {
#pragma unroll
    for (int w = 0; w < 4; ++w) { o[2 * w] = __builtin_amdgcn_cvt_pk_f32_fp8((int)q[w], false); o[2 * w + 1] = __builtin_amdgcn_cvt_pk_f32_fp8((int)q[w], true); }
}
struct GIdx { u32x4 a, b; };
__device__ __forceinline__ GIdx g_ldidx(__amdgpu_buffer_rsrc_t IDX, int t, int r8) { GIdx r; r.a = __builtin_amdgcn_raw_buffer_load_b128(IDX, 32 * r8, t * 256, 0); r.b = __builtin_amdgcn_raw_buffer_load_b128(IDX, 32 * r8 + 16, t * 256, 0); return r; }
__device__ __forceinline__ void g_issue8(const unsigned char* TBs, unsigned lo, const u32x4 ix, u32x4 (&q)[8]) {
#pragma unroll
    for (int i = 0; i < 8; ++i) { const unsigned w = ix[i >> 1]; const unsigned e = (i & 1) ? (w >> 16) : (w & 0xffffu); q[i] = *(const u32x4*)(TBs + (e * 128u + lo)); }
}
struct GSide { u32x4 a, b, c, d; };
template <int PH> __device__ __forceinline__ GSide g_ldside(__amdgpu_buffer_rsrc_t SD, int t, int j, int m, int r8) {
    GSide r;
    if (PH == 0) { r.a = __builtin_amdgcn_raw_buffer_load_b128(SD, 32 * m, t * 2048 + 256 * j, 0); r.b = __builtin_amdgcn_raw_buffer_load_b128(SD, 32 * m + 16, t * 2048 + 256 * j, 0); r.c = r.a; r.d = r.b; }
    else { r.a = __builtin_amdgcn_raw_buffer_load_b128(SD, 64 * r8, t * 512, 0); r.b = __builtin_amdgcn_raw_buffer_load_b128(SD, 64 * r8 + 16, t * 512, 0); r.c = __builtin_amdgcn_raw_buffer_load_b128(SD, 64 * r8 + 32, t * 512, 0); r.d = __builtin_amdgcn_raw_buffer_load_b128(SD, 64 * r8 + 48, t * 512, 0); }
    return r;
}
template <int PH, int HALF> __device__ __forceinline__ void g_half(u32x4 (&q)[8], const GSide& sd, float (&pa)[16]) {
    if (PH == 0) {
        f32x2 x2[8];
        { const h16x8 xa = __builtin_bit_cast(h16x8, sd.a), xb = __builtin_bit_cast(h16x8, sd.b);
#pragma unroll
          for (int k = 0; k < 4; ++k) { x2[k] = (f32x2){(float)xa[2 * k], (float)xa[2 * k + 1]}; x2[4 + k] = (f32x2){(float)xb[2 * k], (float)xb[2 * k + 1]}; } }
#pragma unroll
        for (int i = 0; i < 8; ++i) { f32x2 d2[8]; dec16p(q[i], d2); f32x2 s2 = x2[0] * d2[0];
#pragma unroll
            for (int k = 1; k < 8; ++k) s2 = __builtin_elementwise_fma(x2[k], d2[k], s2);
            pa[8 * HALF + i] = s2[0] + s2[1];
            if (i + 1 < 8) asm volatile("" : "+v"(q[i + 1][0]), "+v"(q[i + 1][1]), "+v"(q[i + 1][2]), "+v"(q[i + 1][3])); }
    } else {
        f32x2 a2[8];
#pragma unroll
        for (int k = 0; k < 8; ++k) a2[k] = (f32x2){pa[2 * k], pa[2 * k + 1]};
#pragma unroll
        for (int i = 0; i < 8; ++i) { f32x2 d2[8]; dec16p(q[i], d2);
            const float cf = __uint_as_float(HALF == 0 ? (i < 4 ? sd.a[i & 3] : sd.b[i & 3]) : (i < 4 ? sd.c[i & 3] : sd.d[i & 3])); const f32x2 c2 = (f32x2){cf, cf};
#pragma unroll
            for (int k = 0; k < 8; ++k) a2[k] = __builtin_elementwise_fma(c2, d2[k], a2[k]);
            if (i + 1 < 8) asm volatile("" : "+v"(q[i + 1][0]), "+v"(q[i + 1][1]), "+v"(q[i + 1][2]), "+v"(q[i + 1][3]));
        }
#pragma unroll
        for (int k = 0; k < 8; ++k) { pa[2 * k] = a2[k][0]; pa[2 * k + 1] = a2[k][1]; }
    }
}
template <int PH> __device__ __forceinline__ void g_finish(const Args& a, __amdgpu_buffer_rsrc_t PRT, int t, int j, int lane, float (&p)[16]) {
    const int m = lane & 7, r8 = lane >> 3;
    float q8[8], q4[4], q2[2];
    if (PH == 0) {
#pragma unroll
        for (int i = 0; i < 8; ++i) { const float keep = (lane & 4) ? p[i + 8] : p[i], send = (lane & 4) ? p[i] : p[i + 8]; q8[i] = keep + xhm_(send); }
#pragma unroll
        for (int i = 0; i < 4; ++i) { const float keep = (lane & 2) ? q8[i + 4] : q8[i], send = (lane & 2) ? q8[i] : q8[i + 4]; q4[i] = keep + dpp_<0x4E>(send); }
#pragma unroll
        for (int i = 0; i < 2; ++i) { const float keep = (lane & 1) ? q4[i + 2] : q4[i], send = (lane & 1) ? q4[i] : q4[i + 2]; q2[i] = keep + dpp_<0xB1>(send); }
        __builtin_amdgcn_raw_buffer_store_b64((u32x2){__float_as_uint(q2[0]), __float_as_uint(q2[1])}, PRT, (16 * r8 + 2 * m) * 4, (j * MTOK + t) * 512, 0);
    } else {
#pragma unroll
        for (int i = 0; i < 8; ++i) { const float keep = (lane & 32) ? p[i + 8] : p[i], send = (lane & 32) ? p[i] : p[i + 8]; q8[i] = keep + x32_(send, lane); }
#pragma unroll
        for (int i = 0; i < 4; ++i) { const float keep = (lane & 16) ? q8[i + 4] : q8[i], send = (lane & 16) ? q8[i] : q8[i + 4]; q4[i] = keep + x16_(send, lane); }
#pragma unroll
        for (int i = 0; i < 2; ++i) { const float keep = (lane & 8) ? q4[i + 2] : q4[i], send = (lane & 8) ? q4[i] : q4[i + 2]; q2[i] = keep + x8_(send); }
        const int col = 128 * j + 16 * m + 2 * r8;
        const h16x2 h1v = *(const h16x2*)((const h16*)(a.ws + O_H1B) + (size_t)t * 1024 + col);
        const f32x2 hv = (f32x2){(float)h1v[0] + q2[0], (float)h1v[1] + q2[1]};
        *(h16x2*)((h16*)(a.ws + O_H2B) + (size_t)t * 1024 + col) = (h16x2){(h16)hv[0], (h16)hv[1]};
        const float ss = wave_sum(hv[0] * hv[0] + hv[1] * hv[1]);
        if (lane == 0) ((float*)(a.ws + O_SS2))[(size_t)t * 8 + j] = ss;
    }
}
template <int PH>
__device__ __forceinline__ void phase_gather(const Args& a, int cset) {
    const int tid = tid_(), lane = tid & 63, m = lane & 7, r8 = lane >> 3;
    unsigned* ctr = (unsigned*)(a.ws + O_CTR) + cset * 8 * 64;
    const __amdgpu_buffer_rsrc_t IDX = mkrsrc(a.ws + O_IDX), SDR = mkrsrc(a.ws + (PH ? O_COEF : O_H1B)), PRT = mkrsrc(a.ws + O_PART);
    const unsigned j0 = xcc_id();
    for (unsigned dj = 0; dj < 8; ++dj) {
        const unsigned j = (j0 + dj) & 7u;
        const unsigned char* TB = a.ws + (PH ? O_V8 : O_U8) + (size_t)j * 16384 * 128; const unsigned lo16 = 16u * (unsigned)m;
        for (;;) {
            unsigned c = 0; if (lane == 0) c = __hip_atomic_fetch_add(ctr + j * 64, 1u, __ATOMIC_RELAXED, __HIP_MEMORY_SCOPE_AGENT);
            c = (unsigned)__builtin_amdgcn_readfirstlane((int)c);
            if (c >= (unsigned)GA_NCH) break;
            const int t0 = c * GA_TC;
            u32x4 qa[8], qb[8]; GSide sd, sn; GIdx ix, ixn;
            ix = g_ldidx(IDX, t0, r8); g_issue8(TB, lo16, ix.a, qa); sd = g_ldside<PH>(SDR, t0, j, m, r8);
#pragma unroll 1
            for (int ti = 0; ti < GA_TC; ++ti) {
                const int t = t0 + ti, tn = (ti + 1 < GA_TC) ? t + 1 : t;
                g_issue8(TB, lo16, ix.b, qb); ixn = g_ldidx(IDX, tn, r8); sn = g_ldside<PH>(SDR, tn, j, m, r8);
                float p[16];
                if (PH == 1) {
#pragma unroll
                    for (int k = 0; k < 16; ++k) p[k] = 0.f;
                }
                if (PH == 0) __builtin_amdgcn_sched_barrier(0);
                g_half<PH, 0>(qa, sd, p);
                if (PH == 0) __builtin_amdgcn_sched_barrier(0);
                g_issue8(TB, lo16, ixn.a, qa);
                if (PH == 0) __builtin_amdgcn_sched_barrier(0);
                g_half<PH, 1>(qb, sd, p);
                g_finish<PH>(a, PRT, t, j, lane, p);
                ix = ixn; sd = sn;
            }
        }
    }
}
__device__ __forceinline__ void phase_coef(const Args& a) {
    const int tid = tid_();
    const float* PART = (const float*)(a.ws + O_PART); const unsigned short* IDX = (const unsigned short*)(a.ws + O_IDX);
    const float* GATE = (const float*)(a.ws + O_GATE); const float* RS1 = (const float*)(a.ws + O_RS1);
    const float* USC = (const float*)(a.ws + O_USC); const float* VSC = (const float*)(a.ws + O_VSC); float* COEF = (float*)(a.ws + O_COEF);
    for (int i = blockIdx.x * NTHREADS + tid; i < MTOK * 128; i += gridDim.x * NTHREADS) {
        float s = 0.f;
#pragma unroll
        for (int j = 0; j < 8; ++j) s += PART[(size_t)j * MTOK * 128 + i];
        const unsigned e = IDX[i];
        COEF[i] = GATE[i] * gelu_tanh(RS1[i >> 7] * USC[e] * s) * VSC[e];
    }
}

__device__ __forceinline__ void phase_final(const Args& a) {
    const int tid = tid_(), lane = tid & 63, wave = tid >> 6;
    const int gw = blockIdx.x * NWAVES + wave, NGW = gridDim.x * NWAVES;
    const float* part = (const float*)(a.ws + O_PART3); const float* fg = a.in[28];
    f32x4 g4[4];
#pragma unroll
    for (int j = 0; j < 4; ++j) g4[j] = *((const f32x4*)fg + lane + 64 * j);
    for (int r = gw; r < MTOK; r += NGW) {
        float s = (lane < 16) ? part[(size_t)r * 16 + lane] : 0.f;
        s = wave_sum(s);
        const float rs = rsqrtf(s * (1.f / 1024.f) + NORM_EPS);
        f32x4* xr = (f32x4*)(a.out + (size_t)r * 1024) + lane;
#pragma unroll
        for (int j = 0; j < 4; ++j) xr[64 * j] = xr[64 * j] * rs * g4[j];
    }
}

constexpr int NPHASE = 19;
__global__ void __launch_bounds__(NTHREADS, 2) mk(Args a) {
    extern __shared__ __attribute__((aligned(16))) unsigned char smem[];
    LAS unsigned char* lds = (LAS unsigned char*)smem;
    unsigned char* ws = a.ws;
#if ONE_LAUNCH
    cg::grid_group grid = cg::this_grid();
    volatile LAS unsigned* bst = (volatile LAS unsigned*)(lds + 131072);
    if (threadIdx.x < 2) bst[threadIdx.x] = 0u;
    __syncthreads();
    const XcdBarrier xbar = xcd_barrier_post((unsigned*)(a.ws + O_BAR), bst);
    bool first_sync = true;
#define SYNC() do { if (first_sync) { grid.sync(); first_sync = false; } else xcd_barrier(xbar); } while (0)
#else
#define SYNC() do {} while (0)
#endif
#define IN(k) (a.ph_lo <= (k) && (k) < a.ph_hi)
#define SEAM(k) do { if (IN(k) && IN((k) + 1)) SYNC(); } while (0)
#define REPS(k) ((((REP_MASK) >> (k)) & 1u) ? 2 : 1)
    const int G = gridDim.x, bid = blockIdx.x;
    if (IN(0)) for (int rep = 0; rep < REPS(0); ++rep) { if (rep) SYNC(); phase_prep(a, lds); } SEAM(0);
    if (IN(1)) for (int rep = 0; rep < REPS(1); ++rep) { if (rep) SYNC(); pg8::Gemm g{(const h16*)(ws + O_XN), (const h16*)(ws + O_WIN), MTOK, NIN, 1024}; pg8::StaticOrder S; S.init(MTOK, NIN, G, bid);
        EpiZ E{(h16*)(ws + O_ZC), (h16*)(ws + O_ZR), (h16*)(ws + O_ZG)}; pg8::gemm_phase(lds, g, S, E); } SEAM(1);
    if (IN(2)) for (int rep = 0; rep < REPS(2); ++rep) { if (rep) SYNC(); phase_conv(a); phase_rwkv_prep(a); } SEAM(2);
    if (IN(3)) for (int rep = 0; rep < REPS(3); ++rep) { if (rep) SYNC(); pg8::Gemm g{(const h16*)(ws + O_APR), (const h16*)(ws + O_WLR), MTOK, 1536, 256}; pg8::StaticOrder S; S.init(MTOK, 1536, G, bid);
        h16* R = (h16*)a.out; h16* KS = R + (size_t)MTOK * 512; h16* KK = KS + (size_t)2 * MTOK * 512;
        EpiLR E{a.in[7], a.in[9], a.in[13], (h16*)(ws + O_WD), KS, (h16*)(ws + O_BD), (h16*)(ws + O_GG), KK}; pg8::gemm_phase(lds, g, S, E); } SEAM(3);
    if (IN(4)) for (int rep = 0; rep < REPS(4); ++rep) { if (rep) SYNC(); phase_ut_pre(a, lds); }
    SEAM(5);
    if (IN(6)) for (int rep = 0; rep < REPS(6); ++rep) { if (rep) SYNC(); phase_ut_seq(a, lds); } SEAM(6);
    if (IN(7)) for (int rep = 0; rep < REPS(7); ++rep) { if (rep) SYNC(); phase_rwkv_post(a); } SEAM(7);
    if (IN(8)) for (int rep = 0; rep < REPS(8); ++rep) { if (rep) SYNC(); pg8::Gemm g{(const h16*)(ws + O_CA), (const h16*)(ws + O_WA), MTOK, 1024, 512}; pg8::StaticOrder S; S.init(MTOK, 1024, G, bid);
        EpiYA E{(const h16*)(ws + O_ZG), (h16*)a.out}; pg8::gemm_phase(lds, g, S, E); } SEAM(8);
    if (IN(9)) for (int rep = 0; rep < REPS(9); ++rep) { if (rep) SYNC(); pg8::Gemm g{(const h16*)(ws + O_YB), (const h16*)(ws + O_WB), MTOK, 1024, 512}; pg8::StaticOrder S; S.init(MTOK, 1024, G, bid);
        EpiYB E{(const h16*)(ws + O_ZG), (const h16*)a.out, (h16*)(ws + O_MERGED)}; pg8::gemm_phase(lds, g, S, E); } SEAM(9);
    if (IN(10)) for (int rep = 0; rep < REPS(10); ++rep) { if (rep) SYNC(); pg8::Gemm g{(const h16*)(ws + O_MERGED), (const h16*)(ws + O_WO), MTOK, 1024, 1024}; pg8::StaticOrder S; S.init(MTOK, 1024, G, bid);
        EpiH1 E{a.in[0], (h16*)(ws + O_H1B), (float*)(ws + O_PART1)}; pg8::gemm_phase(lds, g, S, E); } SEAM(10);
    if (IN(11)) for (int rep = 0; rep < REPS(11); ++rep) { if (rep) SYNC(); pg8::Gemm g{(const h16*)(ws + O_H1B), (const h16*)(ws + O_WS), MTOK, 2048, 1024}; pg8::StaticOrder S; S.init(MTOK, 2048, G, bid);
        EpiF16 E{(h16*)(ws + O_SCORES), 2048}; pg8::gemm_phase(lds, g, S, E); } SEAM(11);
    if (IN(12)) for (int rep = 0; rep < REPS(12); ++rep) { if (rep) SYNC(); phase_topk(a, lds); } SEAM(12);
    if (IN(13)) for (int rep = 0; rep < REPS(13); ++rep) { if (rep) SYNC(); phase_gather<0>(a, 2 * rep); } SEAM(13);
    if (IN(14)) for (int rep = 0; rep < REPS(14); ++rep) { if (rep) SYNC(); phase_coef(a); } SEAM(14);
    if (IN(15)) for (int rep = 0; rep < REPS(15); ++rep) { if (rep) SYNC(); phase_gather<1>(a, 1 + 2 * rep); } SEAM(15);
    if (IN(16)) for (int rep = 0; rep < REPS(16); ++rep) { if (rep) SYNC(); pg8::Gemm g{(const h16*)(ws + O_P16), (const h16*)(ws + O_WP), MTOK, 1024, 256}; pg8::StaticOrder S; S.init(MTOK, 1024, G, bid);
        EpiF16 E{(h16*)(ws + O_PP), 1024}; pg8::gemm_phase(lds, g, S, E); } SEAM(16);
    if (IN(17)) for (int rep = 0; rep < REPS(17); ++rep) { if (rep) SYNC(); pg8::Gemm g{(const h16*)(ws + O_H2B), (const h16*)(ws + O_WG), MTOK, 1024, 1024}; pg8::StaticOrder S; S.init(MTOK, 1024, G, bid);
        EpiGate E{a.out, (const h16*)(ws + O_H2B), (const h16*)(ws + O_PP), (const float*)(ws + O_SS2), (float*)(ws + O_PART3)}; pg8::gemm_phase(lds, g, S, E); } SEAM(17);
    if (IN(18)) for (int rep = 0; rep < REPS(18); ++rep) { if (rep) SYNC(); phase_final(a); }
}

extern "C" void kernel_launch(void* const* d_in, const int* in_sizes, int n_in, void* d_out, int out_size, void* d_ws, size_t ws_size, hipStream_t stream) {
    static int ready = 0;
    if (!ready) {
        if (n_in != 29 || ws_size < WS_END) { fprintf(stderr, "kernel_launch: unexpected n_in %d / ws %zu (need %zu)\n", n_in, ws_size, (size_t)WS_END); ready = -1; return; }
        if (hipFuncSetAttribute((const void*)mk, hipFuncAttributeMaxDynamicSharedMemorySize, LDS_BYTES) != hipSuccess) { fprintf(stderr, "hipFuncSetAttribute failed\n"); ready = -1; return; }
        ready = 1;
    }
    if (ready < 0) return;
    Args a{};
    for (int i = 0; i < 29; ++i) a.in[i] = (const float*)d_in[i];
    a.out = (float*)d_out; a.ws = (unsigned char*)d_ws;
#if ONE_LAUNCH
    (void)hipMemsetAsync((unsigned char*)d_ws + O_BAR, 0, 16384, stream);
    a.ph_lo = 0; a.ph_hi = NPHASE;
    void* args[] = {&a};
    hipLaunchCooperativeKernel((const void*)mk, dim3(NBLK), dim3(NTHREADS), args, LDS_BYTES, stream);
#else
    const int phases[] = {0, 1, 2, 3, 4, 5, 6, 7, 8, 9, 10, 11, 12, 13, 14, 15, 16, 17, 18};
    for (int ph : phases) { a.ph_lo = ph; a.ph_hi = ph + 1; hipLaunchKernelGGL(mk, dim3(NBLK), dim3(NTHREADS), LDS_BYTES, stream, a); }
#endif
}
```

```cpp
#include <hip/hip_runtime.h>
#include <hip/hip_cooperative_groups.h>
#include <cstdio>
namespace cg = cooperative_groups;

#ifndef REP_MASK
#define REP_MASK 0u
#endif
#ifndef ONE_LAUNCH
#define ONE_LAUNCH 1
#endif

#define LAS __attribute__((address_space(3)))
typedef _Float16 h16;
typedef _Float16 h16x8 __attribute__((ext_vector_type(8)));
typedef _Float16 h16x4 __attribute__((ext_vector_type(4)));
typedef _Float16 h16x2 __attribute__((ext_vector_type(2)));
typedef float f32x4 __attribute__((ext_vector_type(4)));
typedef float f32x2 __attribute__((ext_vector_type(2)));
typedef unsigned u32x4 __attribute__((ext_vector_type(4)));
typedef unsigned u32x2 __attribute__((ext_vector_type(2)));

constexpr int MTOK = 65536, DM = 1024, SEQ = 8192, NB = 8;
constexpr int NIN = 5376;
constexpr int NTHREADS = 512, NWAVES = 8, NBLK = 256;
constexpr int LDS_BYTES = 131072 + 64;
constexpr float NORM_EPS = 1e-6f;

constexpr size_t MiB = 1u << 20;
constexpr size_t O_WIN = 0;
constexpr size_t O_WA = O_WIN + (size_t)5376 * 1024 * 2;
constexpr size_t O_WB = O_WA + 1 * MiB;
constexpr size_t O_WO = O_WB + 1 * MiB;
constexpr size_t O_WG = O_WO + 2 * MiB;
constexpr size_t O_WP = O_WG + 2 * MiB;
constexpr size_t O_WLR = O_WP + MiB / 2;
constexpr size_t O_WS = O_WLR + 3 * MiB / 4;
constexpr size_t O_U16 = O_WS + 4 * MiB;
constexpr size_t O_V16 = O_U16 + 32 * MiB;
constexpr size_t O_P16 = O_V16 + 32 * MiB;
constexpr size_t O_PART1 = O_P16 + 32 * MiB;
constexpr size_t O_PART3 = O_PART1 + 4 * MiB;
constexpr size_t O_RS1 = O_PART3 + 4 * MiB;
constexpr size_t O_RS2 = O_RS1 + MiB / 4;
constexpr size_t O_XN = O_RS2 + MiB / 4;
constexpr size_t O_ZC = O_XN + 128 * MiB;
constexpr size_t O_ZR = O_ZC + 192 * MiB;
constexpr size_t O_ZG = O_ZR + 224 * MiB;
constexpr size_t O_SS2 = O_ZG + 256 * MiB;
constexpr size_t O_USC = O_SS2 + 2 * MiB;
constexpr size_t O_VSC = O_USC + 65536;
constexpr size_t O_CTR = O_VSC + 65536;
constexpr size_t O_BAR = O_CTR + 8192;
constexpr size_t WS_END = O_BAR + 16384;
constexpr size_t O_U8 = O_U16;
constexpr size_t O_V8 = O_U16 + 16 * MiB;
constexpr size_t O_PART = O_ZG;
constexpr size_t O_COEF = O_ZR + 48 * MiB;
constexpr size_t O_CA = O_XN;
constexpr size_t O_APR = O_XN + 64 * MiB;
constexpr size_t O_H1B = O_XN;
constexpr size_t O_WD = O_ZC;
constexpr size_t O_BD = O_ZC + 64 * MiB;
constexpr size_t O_GG = O_ZC + 128 * MiB;
constexpr size_t O_MERGED = O_ZC;
constexpr size_t O_H2B = O_ZC;
constexpr size_t O_PQ = O_ZR;
constexpr size_t O_SST = O_ZR + 64 * MiB;
constexpr size_t O_Y = O_ZR + 96 * MiB;
constexpr size_t O_YB = O_ZR + 160 * MiB;
constexpr size_t O_IDX = O_ZR;
constexpr size_t O_GATE = O_ZR + 16 * MiB;
constexpr size_t O_PP = O_ZR + 64 * MiB;
constexpr size_t O_SCORES = O_ZG;

struct Args {
    const float* in[29];
    float* out;
    unsigned char* ws;
    int ph_lo, ph_hi;
};

__device__ __forceinline__ int tid_() { int t = threadIdx.x; asm volatile("" : "+v"(t)); return t; }
__device__ __forceinline__ float sigmoidf_(float x) { return __builtin_amdgcn_rcpf(1.0f + __expf(-x)); }
template <int CTRL> __device__ __forceinline__ float dpp_(float v) { return __builtin_bit_cast(float, __builtin_amdgcn_update_dpp(0, __builtin_bit_cast(int, v), CTRL, 0xF, 0xF, true)); }
__device__ __forceinline__ float x32_(float v, int lane) { const auto r = __builtin_amdgcn_permlane32_swap(__builtin_bit_cast(unsigned, v), __builtin_bit_cast(unsigned, v), false, false); return __builtin_bit_cast(float, (lane & 32) ? r[0] : r[1]); }
__device__ __forceinline__ float x16_(float v, int lane) { const auto r = __builtin_amdgcn_permlane16_swap(__builtin_bit_cast(unsigned, v), __builtin_bit_cast(unsigned, v), false, false); return __builtin_bit_cast(float, (lane & 16) ? r[0] : r[1]); }
__device__ __forceinline__ float x8_(float v) { return dpp_<0x128>(v); }
__device__ __forceinline__ float xhm_(float v) { return dpp_<0x141>(v); }
__device__ __forceinline__ float wave_sum(float v) {
    const int lane = threadIdx.x & 63;
    v += dpp_<0xB1>(v); v += dpp_<0x4E>(v); v += dpp_<0x141>(v); v += dpp_<0x140>(v);
    v += x16_(v, lane); v += x32_(v, lane);
    return v;
}
__device__ __forceinline__ __amdgpu_buffer_rsrc_t mkrsrc(const void* p) { return __builtin_amdgcn_make_buffer_rsrc((void*)p, 0, 0x7fffffff, 0x00020000); }
__device__ __forceinline__ h16x8 pack8(f32x4 a, f32x4 b) {
    h16x8 r;
    r[0] = (h16)a[0]; r[1] = (h16)a[1]; r[2] = (h16)a[2]; r[3] = (h16)a[3];
    r[4] = (h16)b[0]; r[5] = (h16)b[1]; r[6] = (h16)b[2]; r[7] = (h16)b[3];
    return r;
}
__device__ __forceinline__ h16x4 pack4(f32x4 a) {
    h16x4 r; r[0] = (h16)a[0]; r[1] = (h16)a[1]; r[2] = (h16)a[2]; r[3] = (h16)a[3]; return r;
}

#define XB_TMO      128
#define XB_XCNT(j)  (256  + 64 * (j))
#define XB_XSUB(j)  (1280 + 64 * (j))
#define XB_XGEN(j)  (2304 + 64 * (j))
#define XB_TOP      3328
#define XB_TOPGEN   3392
#define XCD_BAR_WORDS 3456
#define XB_SPIN_CAP (1u << 18)

__device__ __forceinline__ unsigned xb_ld(unsigned* p)              { return __hip_atomic_load(p, __ATOMIC_RELAXED, __HIP_MEMORY_SCOPE_AGENT); }
__device__ __forceinline__ unsigned xb_add(unsigned* p, unsigned v) { return __hip_atomic_fetch_add(p, v, __ATOMIC_RELAXED, __HIP_MEMORY_SCOPE_AGENT); }
__device__ __forceinline__ unsigned xb_xcc_id() { return (unsigned)__builtin_amdgcn_s_getreg((3 << 11) | 20) & 0xFu; }
#define XB_SPIN(cond, bar) do { unsigned _sp = 0; while (cond) { __builtin_amdgcn_s_sleep(1); \
    if ((++_sp & 255u) == 0u) { if (xb_ld(&(bar)[XB_TMO])) break; if (_sp > XB_SPIN_CAP) { atomicAdd(&(bar)[XB_TMO], 1u); break; } } } } while (0)

struct XcdBarrier {
    unsigned* bar; unsigned x;
    volatile LAS unsigned* st;
};

__device__ __forceinline__ XcdBarrier xcd_barrier_post(unsigned* bar, volatile LAS unsigned* st) {
    XcdBarrier b; b.bar = bar; b.x = xb_xcc_id(); b.st = st;
    if (threadIdx.x == 0) (void)xb_add(&bar[XB_XCNT(b.x)], 1u);
    return b;
}
__device__ __forceinline__ void xcd_barrier_complete(unsigned* bar, unsigned x, unsigned& nloc, unsigned& nx) {
    const unsigned G = gridDim.x * gridDim.y * gridDim.z;
    unsigned sum, cnt, mine, sp = 0u;
    for (;;) {
        sum = 0u; cnt = 0u; mine = 0u;
#pragma unroll
        for (unsigned j = 0; j < 16; ++j) { const unsigned c = xb_ld(&bar[XB_XCNT(j)]); sum += c; cnt += (c > 0u) ? 1u : 0u; mine = (j == x) ? c : mine; }
        if (sum == G) break;
        __builtin_amdgcn_s_sleep(1);
        if ((++sp & 255u) == 0u) { if (xb_ld(&bar[XB_TMO])) break; if (sp > XB_SPIN_CAP) { atomicAdd(&bar[XB_TMO], 1u); break; } }
    }
    nloc = mine > 0u ? mine : 1u; nx = cnt > 0u ? cnt : 1u;
}

__device__ __forceinline__ void xcd_barrier(const XcdBarrier& b) {
    asm volatile("s_waitcnt vmcnt(0)" ::: "memory");
    __syncthreads();
    if (threadIdx.x == 0) {
        unsigned* bar = b.bar;
        __builtin_amdgcn_s_waitcnt(0);
        unsigned nloc = b.st[0], nx = b.st[1];
        if (nloc == 0u) { xcd_barrier_complete(bar, b.x, nloc, nx); b.st[0] = nloc; b.st[1] = nx; }
        const unsigned old = xb_add(&bar[XB_XSUB(b.x)], 1u);
        const unsigned gen = old / nloc;
        if (old + 1u == (gen + 1u) * nloc) {
            __builtin_amdgcn_fence(__ATOMIC_RELEASE, "agent");
            asm volatile("s_waitcnt vmcnt(0)" ::: "memory");
            const unsigned og = xb_add(&bar[XB_TOP], 1u);
            const unsigned tg = og / nx;
            if (og + 1u == (tg + 1u) * nx) xb_add(&bar[XB_TOPGEN], 1u);
            else XB_SPIN(xb_ld(&bar[XB_TOPGEN]) == tg, bar);
            __builtin_amdgcn_fence(__ATOMIC_ACQUIRE, "agent");
            xb_add(&bar[XB_XGEN(b.x)], 1u);
            asm volatile("s_waitcnt vmcnt(0)" ::: "memory");
        } else {
            XB_SPIN(xb_ld(&bar[XB_XGEN(b.x)]) == gen, bar);
            __builtin_amdgcn_fence(__ATOMIC_ACQUIRE, "agent");
            asm volatile("s_waitcnt vmcnt(0)" ::: "memory");
        }
    }
    __syncthreads();
}


namespace pg8 {
constexpr int BM = 256, BK = 64, HALF = 128, HTB = HALF * BK * 2, STAGE_BYTES = 8 * HTB, NXCD = 8, WGM = 8;
__device__ __forceinline__ int lds_byte(int r, int c) { const int st = (r >> 4) * 2 + (c >> 5), rr = r & 15, cc = c & 31, ob = rr * 64 + cc * 2; return st * 1024 + (ob ^ (((ob >> 9) & 1) << 5)); }
__device__ __forceinline__ void stage_rc(int b, int& R, int& C) { const int st = b / 1024, sb = b % 1024, swz = sb ^ (((sb >> 9) & 1) << 5); R = (st >> 1) * 16 + swz / 64; C = (st & 1) * 32 + (swz % 64) / 2; }
__device__ __forceinline__ int perm32(int rho) { const int n = rho >> 4, i = rho & 15; return 8 * (i >> 2) + 4 * n + (i & 3); }

struct Unit { int pm, pn; };
struct Gemm { const h16* A; const h16* Bt; int M, N, K; };

struct StaticOrder {
    int nM, nN, nwg, G, c;
    __device__ void init(int M, int N, int G_, int c_) { nM = M / BM; nN = N / BM; nwg = nM * nN; G = G_; c = c_; }
    __device__ bool next(int i, Unit& u) const {
        const long L = (long)i * G + c; if (L >= nwg) return false;
        int wgid = (int)L; { const int q = nwg / NXCD, r = nwg % NXCD, xcd = wgid % NXCD, off = wgid / NXCD; wgid = (xcd < r ? xcd * (q + 1) : r * (q + 1) + (xcd - r) * q) + off; }
        const int nig = WGM * nN, gid = wgid / nig, fm = gid * WGM, gsz = (nM - fm) < WGM ? (nM - fm) : WGM;
        u.pm = fm + ((wgid % nig) % gsz); u.pn = (wgid % nig) / gsz; return true;
    }
};

template <class Epi>
__device__ __forceinline__ void gemm_phase(LAS unsigned char* lds, const Gemm g, const StaticOrder& S, const Epi& E) {
    const int tid = tid_(), wid = __builtin_amdgcn_readfirstlane(tid >> 6), lane = tid & 63, wr = wid >> 2, wc = wid & 3, fr = lane & 15, fq = lane >> 4;
    const int K = g.K, nt = K / BK;
    unsigned voffA[2], voffB[2];
#pragma unroll
    for (int i = 0; i < 2; ++i) { int R, C; stage_rc(tid * 16 + i * 8192, R, C); const int Rb = (R & ~31) + perm32(R & 31);
        voffA[i] = (unsigned)(R * K + C) * 2u; voffB[i] = (unsigned)(Rb * K + C) * 2u; }
    const size_t kstep = (size_t)(BK * 2);
    const size_t hstep = (size_t)HALF * K * 2;
    const size_t tstep = 2 * hstep;
    const unsigned ldsw = (unsigned)wid * 1024u;
    const int aoff = lds_byte(wr * 64 + fr, fq * 8), boff = lds_byte(wc * 32 + fr, fq * 8);
#define PG8_SA(b, h) (((b) * 2 + (h)) * HTB)
#define PG8_SB(b, h) ((4 + (b) * 2 + (h)) * HTB)
#define PG8_STAGE(bufoff, gbase, voff) do { _Pragma("unroll") for (int _i = 0; _i < 2; ++_i) \
        __builtin_amdgcn_global_load_lds((const unsigned*)((const char*)(gbase) + (voff)[_i]), (LAS unsigned*)(lds + (bufoff) + ldsw + _i * 8192), 16, 0, 0); } while (0)
#define PG8_LDA(dst, b, h) do { _Pragma("unroll") for (int m = 0; m < 4; ++m) _Pragma("unroll") for (int k = 0; k < 2; ++k) dst[m][k] = *(const LAS h16x8*)(lds + PG8_SA(b, h) + aoff + m * 2048 + k * 1024); } while (0)
#define PG8_LDB(dst, b, h) do { _Pragma("unroll") for (int n = 0; n < 2; ++n) _Pragma("unroll") for (int k = 0; k < 2; ++k) dst[n][k] = *(const LAS h16x8*)(lds + PG8_SB(b, h) + boff + n * 2048 + k * 1024); } while (0)
#define PG8_MMA(ai, bj, At, Bt) do { __builtin_amdgcn_s_setprio(1); _Pragma("unroll") for (int m = 0; m < 4; ++m) _Pragma("unroll") for (int n = 0; n < 2; ++n) _Pragma("unroll") for (int k = 0; k < 2; ++k) \
        acc[ai][bj][m][n] = __builtin_amdgcn_mfma_f32_16x16x32_f16(Bt[n][k], At[m][k], acc[ai][bj][m][n], 0, 0, 0); __builtin_amdgcn_s_setprio(0); } while (0)
#define PG8_WAIT_V(n) asm volatile("s_waitcnt vmcnt(" #n ")" ::: "memory")
#define PG8_WAIT_L(n) asm volatile("s_waitcnt lgkmcnt(" #n ")" ::: "memory")
#define PG8_BAR __builtin_amdgcn_s_barrier()
#define PG8_SCHED __builtin_amdgcn_sched_barrier(0)
    Unit cur, nxt; int ui = 0;
    if (!S.next(0, cur)) return;
    f32x4 acc[2][2][4][2];
#pragma unroll
    for (int a = 0; a < 2; ++a)
#pragma unroll
        for (int b = 0; b < 2; ++b)
#pragma unroll
            for (int m = 0; m < 4; ++m)
#pragma unroll
                for (int n = 0; n < 2; ++n) acc[a][b][m][n] = (f32x4){0.f, 0.f, 0.f, 0.f};
    h16x8 At[4][2], B0[2][2], B1[2][2];
    const char* cA = (const char*)g.A + (size_t)cur.pm * tstep; const char* cB = (const char*)g.Bt + (size_t)cur.pn * tstep;
    PG8_STAGE(PG8_SB(0, 0), cB, voffB); PG8_STAGE(PG8_SB(0, 1), cB + hstep, voffB); PG8_STAGE(PG8_SA(0, 0), cA, voffA); PG8_STAGE(PG8_SA(0, 1), cA + hstep, voffA);
    if (wr == 1) PG8_BAR;
    PG8_WAIT_V(2); PG8_BAR;
    PG8_STAGE(PG8_SB(1, 0), cB + kstep, voffB); PG8_STAGE(PG8_SA(1, 0), cA + kstep, voffA); PG8_STAGE(PG8_SB(1, 1), cB + hstep + kstep, voffB);
    PG8_WAIT_V(6); PG8_BAR;
    for (;;) {
        const bool has_next = S.next(ui + 1, nxt);
        const char* nA = has_next ? (const char*)g.A + (size_t)nxt.pm * tstep : cA; const char* nB = has_next ? (const char*)g.Bt + (size_t)nxt.pn * tstep : cB;
        for (int t = 0; t < nt; t += 2) {
            const bool last = (t == nt - 2);
            const char* a1 = cA + (size_t)(t + 1) * kstep;
            const char* a2 = last ? nA : cA + (size_t)(t + 2) * kstep; const char* b2 = last ? nB : cB + (size_t)(t + 2) * kstep;
            const char* a3 = a2 + kstep; const char* b3 = b2 + kstep;
            PG8_LDB(B0, 0, 0); PG8_LDB(B1, 0, 1); PG8_SCHED; PG8_LDA(At, 0, 0); PG8_STAGE(PG8_SA(1, 1), a1 + hstep, voffA);
            PG8_WAIT_V(8); PG8_WAIT_L(0); PG8_BAR; PG8_MMA(0, 0, At, B0); PG8_MMA(0, 1, At, B1); PG8_BAR; PG8_SCHED;
            PG8_LDA(At, 0, 1); PG8_STAGE(PG8_SB(0, 0), b2, voffB); PG8_STAGE(PG8_SB(0, 1), b2 + hstep, voffB); PG8_STAGE(PG8_SA(0, 0), a2, voffA);
            PG8_WAIT_V(8); PG8_WAIT_L(0); PG8_BAR; PG8_MMA(1, 0, At, B0); PG8_MMA(1, 1, At, B1); PG8_BAR; PG8_SCHED;
            PG8_LDB(B0, 1, 0); PG8_LDB(B1, 1, 1); PG8_SCHED; PG8_LDA(At, 1, 0); PG8_STAGE(PG8_SA(0, 1), a2 + hstep, voffA);
            PG8_WAIT_V(8); PG8_WAIT_L(0); PG8_BAR; PG8_MMA(0, 0, At, B0); PG8_MMA(0, 1, At, B1); PG8_BAR; PG8_SCHED;
            PG8_LDA(At, 1, 1); PG8_STAGE(PG8_SB(1, 0), b3, voffB); PG8_STAGE(PG8_SB(1, 1), b3 + hstep, voffB); PG8_STAGE(PG8_SA(1, 0), a3, voffA);
            PG8_WAIT_V(8); PG8_WAIT_L(0); PG8_BAR; PG8_MMA(1, 0, At, B0); PG8_MMA(1, 1, At, B1); PG8_BAR; PG8_SCHED;
        }
        if (wr == 0) PG8_BAR;
        E(acc, cur, wr, wc, fr, fq);
        if (!has_next) break;
#pragma unroll
        for (int a = 0; a < 2; ++a)
#pragma unroll
            for (int b = 0; b < 2; ++b)
#pragma unroll
                for (int m = 0; m < 4; ++m)
#pragma unroll
                    for (int n = 0; n < 2; ++n) acc[a][b][m][n] = (f32x4){0.f, 0.f, 0.f, 0.f};
        cur = nxt; cA = nA; cB = nB; ++ui;
        if (wr == 1) PG8_BAR;
    }
    PG8_WAIT_V(0);
    PG8_BAR;
#undef PG8_SA
#undef PG8_SB
#undef PG8_STAGE
#undef PG8_LDA
#undef PG8_LDB
#undef PG8_MMA
#undef PG8_WAIT_V
#undef PG8_WAIT_L
#undef PG8_BAR
#undef PG8_SCHED
}
}
using pg8::Unit;
typedef const f32x4 (&AccRef)[2][2][4][2];

#define EPI_LOOP_BEGIN \
    _Pragma("unroll") for (int ai = 0; ai < 2; ++ai) _Pragma("unroll") for (int m = 0; m < 4; ++m) { \
        const int row = u.pm * 256 + ai * 128 + wr * 64 + m * 16 + fr; \
        _Pragma("unroll") for (int bj = 0; bj < 2; ++bj) { \
            const int col = u.pn * 256 + bj * 128 + wc * 32 + 8 * fq; \
            const f32x4 v0 = acc[ai][bj][m][0], v1 = acc[ai][bj][m][1];
#define EPI_LOOP_END } }

struct EpiZ {
    h16 *zc, *zr, *zg;
    __device__ __forceinline__ void operator()(AccRef acc, const Unit& u, int wr, int wc, int fr, int fq) const {
        const int colt = u.pn * 256; h16* base; int ld, c0;
        if (colt < 1536) { base = zc; ld = 1536; c0 = colt; } else if (colt < 3328) { base = zr; ld = 1792; c0 = colt - 1536; } else { base = zg; ld = 2048; c0 = colt - 3328; }
        EPI_LOOP_BEGIN
            *(h16x8*)(base + (size_t)row * ld + (col - colt + c0)) = pack8(v0, v1);
        EPI_LOOP_END
    }
};
struct EpiF16 {
    h16* O; int ld;
    __device__ __forceinline__ void operator()(AccRef acc, const Unit& u, int wr, int wc, int fr, int fq) const {
        EPI_LOOP_BEGIN
            *(h16x8*)(O + (size_t)row * ld + col) = pack8(v0, v1);
        EPI_LOOP_END
    }
};
struct EpiYA {
    const h16* zg; h16* tmp;
    __device__ __forceinline__ void operator()(AccRef acc, const Unit& u, int wr, int wc, int fr, int fq) const {
        EPI_LOOP_BEGIN
            const h16x8 gv = *(const h16x8*)(zg + (size_t)row * 2048 + col);
            f32x4 o0, o1;
#pragma unroll
            for (int j = 0; j < 4; ++j) { o0[j] = sigmoidf_((float)gv[j]) * v0[j]; o1[j] = sigmoidf_((float)gv[4 + j]) * v1[j]; }
            *(h16x8*)(tmp + (size_t)row * 1024 + col) = pack8(o0, o1);
        EPI_LOOP_END
    }
};
struct EpiYB {
    const h16* zg; const h16* tmp; h16* merged;
    __device__ __forceinline__ void operator()(AccRef acc, const Unit& u, int wr, int wc, int fr, int fq) const {
        EPI_LOOP_BEGIN
            const h16x8 gv = *(const h16x8*)(zg + (size_t)row * 2048 + 1024 + col);
            const h16x8 tv = *(const h16x8*)(tmp + (size_t)row * 1024 + col);
            f32x4 o0, o1;
#pragma unroll
            for (int j = 0; j < 4; ++j) { o0[j] = (float)tv[j] + sigmoidf_((float)gv[j]) * v0[j]; o1[j] = (float)tv[4 + j] + sigmoidf_((float)gv[4 + j]) * v1[j]; }
            *(h16x8*)(merged + (size_t)row * 1024 + col) = pack8(o0, o1);
        EPI_LOOP_END
    }
};
struct EpiH1 {
    const float* x; h16* hb; float* part;
    __device__ __forceinline__ void operator()(AccRef acc, const Unit& u, int wr, int wc, int fr, int fq) const {
#pragma unroll
        for (int ai = 0; ai < 2; ++ai)
#pragma unroll
            for (int m = 0; m < 4; ++m) {
                const int row = u.pm * 256 + ai * 128 + wr * 64 + m * 16 + fr; float ss = 0.f;
#pragma unroll
                for (int bj = 0; bj < 2; ++bj) {
                    const int col = u.pn * 256 + bj * 128 + wc * 32 + 8 * fq;
                    const float* xp = x + (size_t)row * 1024 + col;
                    const f32x4 o0 = *(const f32x4*)xp + acc[ai][bj][m][0], o1 = *(const f32x4*)(xp + 4) + acc[ai][bj][m][1];
                    *(h16x8*)(hb + (size_t)row * 1024 + col) = pack8(o0, o1);
                    ss += (o0[0] * o0[0] + o0[1] * o0[1]) + (o0[2] * o0[2] + o0[3] * o0[3]) + (o1[0] * o1[0] + o1[1] * o1[1]) + (o1[2] * o1[2] + o1[3] * o1[3]);
                }
                ss += __shfl_xor(ss, 16); ss += __shfl_xor(ss, 32);
                if (fq == 0) part[(size_t)row * 16 + u.pn * 4 + wc] = ss;
            }
    }
};
struct EpiGate {
    float* out; const h16* h2b; const h16* pp; const float* rs2; float* part;
    __device__ __forceinline__ void operator()(AccRef acc, const Unit& u, int wr, int wc, int fr, int fq) const {
#pragma unroll
        for (int ai = 0; ai < 2; ++ai)
#pragma unroll
            for (int m = 0; m < 4; ++m) {
                const int row = u.pm * 256 + ai * 128 + wr * 64 + m * 16 + fr; float ss = 0.f;
                const f32x4 sa = *(const f32x4*)(rs2 + (size_t)row * 8), sb = *(const f32x4*)(rs2 + (size_t)row * 8 + 4);
                const float rs = rsqrtf(((sa[0] + sa[1]) + (sa[2] + sa[3]) + (sb[0] + sb[1]) + (sb[2] + sb[3])) * (1.f / 1024.f) + NORM_EPS);
#pragma unroll
                for (int bj = 0; bj < 2; ++bj) {
                    const int col = u.pn * 256 + bj * 128 + wc * 32 + 8 * fq;
                    float* op = out + (size_t)row * 1024 + col;
                    const h16x8 hv = *(const h16x8*)(h2b + (size_t)row * 1024 + col);
                    f32x4 o0 = (f32x4){(float)hv[0], (float)hv[1], (float)hv[2], (float)hv[3]}, o1 = (f32x4){(float)hv[4], (float)hv[5], (float)hv[6], (float)hv[7]};
                    const h16x8 pv = *(const h16x8*)(pp + (size_t)row * 1024 + col);
                    const f32x4 v0 = acc[ai][bj][m][0], v1 = acc[ai][bj][m][1];
#pragma unroll
                    for (int j = 0; j < 4; ++j) { o0[j] += sigmoidf_(rs * v0[j]) * (float)pv[j]; o1[j] += sigmoidf_(rs * v1[j]) * (float)pv[4 + j]; }
                    *(f32x4*)op = o0; *(f32x4*)(op + 4) = o1;
                    ss += (o0[0] * o0[0] + o0[1] * o0[1]) + (o0[2] * o0[2] + o0[3] * o0[3]) + (o1[0] * o1[0] + o1[1] * o1[1]) + (o1[2] * o1[2] + o1[3] * o1[3]);
                }
                ss += __shfl_xor(ss, 16); ss += __shfl_xor(ss, 32);
                if (fq == 0) part[(size_t)row * 16 + u.pn * 4 + wc] = ss;
            }
    }
};

__device__ __forceinline__ void tr_item(const float* W, int N, const float* g, h16* WT, int ldk, int koff, int k0, int n0, LAS float* scr, int lane) {
#pragma unroll 8
    for (int i = 0; i < 32; ++i) { const int kk = 2 * i + (lane >> 5); float v = W[(size_t)(k0 + kk) * N + n0 + (lane & 31)]; if (g) v *= g[k0 + kk]; scr[kk * 33 + (lane & 31)] = v; }
    asm volatile("s_waitcnt lgkmcnt(0)" ::: "memory");
    const int c = lane & 7;
#pragma unroll
    for (int j = 0; j < 4; ++j) { const int n = (lane >> 3) + 8 * j; const LAS float* s = scr + (8 * c) * 33 + n;
        h16x8 o;
#pragma unroll
        for (int e = 0; e < 8; ++e) o[e] = (h16)s[e * 33];
        *(h16x8*)(WT + (size_t)(n0 + n) * ldk + koff + k0 + 8 * c) = o; }
    asm volatile("s_waitcnt lgkmcnt(0)" ::: "memory");
}
struct TrJob { const float* W; const float* g; h16* WT; int K, N, ldk, koff; };

__device__ __forceinline__ void phase_prep(const Args& a, LAS unsigned char* lds) {
    const int tid = tid_(), lane = tid & 63, wave = tid >> 6;
    const int gw = blockIdx.x * NWAVES + wave, NGW = gridDim.x * NWAVES;
    unsigned char* ws = a.ws;
    {
        LAS float* scr = (LAS float*)(lds + wave * 8704);
        TrJob jobs[9] = {
            {a.in[3], a.in[2], (h16*)(ws + O_WIN), 1024, NIN, 1024, 0},
            {a.in[17], nullptr, (h16*)(ws + O_WA), 512, 1024, 512, 0},
            {a.in[18], nullptr, (h16*)(ws + O_WB), 512, 1024, 512, 0},
            {a.in[19], nullptr, (h16*)(ws + O_WO), 1024, 1024, 1024, 0},
            {a.in[26], a.in[25], (h16*)(ws + O_WG), 1024, 1024, 1024, 0},
            {a.in[27], nullptr, (h16*)(ws + O_WP), 256, 1024, 256, 0},
            {a.in[8], nullptr, (h16*)(ws + O_WLR), 64, 512, 256, 0},
            {a.in[10], nullptr, (h16*)(ws + O_WLR) + (size_t)512 * 256, 64, 512, 256, 64},
            {a.in[11], nullptr, (h16*)(ws + O_WLR) + (size_t)1024 * 256, 128, 512, 256, 128},
        };
        int base = 0;
#pragma unroll
        for (int j = 0; j < 9; ++j) {
            const TrJob J = jobs[j]; const int nnb = J.N / 32, items = (J.K / 64) * nnb;
            int first = gw - (base % NGW); if (first < 0) first += NGW;
            for (int r = first; r < items; r += NGW) tr_item(J.W, J.N, J.g, J.WT, J.ldk, J.koff, (r / nnb) * 64, (r % nnb) * 32, scr, lane);
            base += items;
        }
        h16* wlr = (h16*)(ws + O_WLR);
        for (int i = blockIdx.x * NTHREADS + tid; i < 1536 * 256 / 8; i += gridDim.x * NTHREADS) {
            const int n = (i * 8) / 256, k = (i * 8) % 256; const int blk = n / 512;
            const bool inblk = (blk == 0) ? (k < 64) : (blk == 1) ? (k >= 64 && k < 128) : (k >= 128);
            if (!inblk) { h16x8 z; for (int e = 0; e < 8; ++e) z[e] = (h16)0.f; *(h16x8*)(wlr + (size_t)i * 8) = z; }
        }
    }
    __syncthreads();
    {
        LAS float* LA = (LAS float*)lds;
        LAS float* LB = (LAS float*)(lds + 64 * 129 * 4);
        const float* wq = a.in[21]; const float* sk = a.in[22]; const float* gf = a.in[20];
        h16* wst = (h16*)(ws + O_WS);
        for (int it = blockIdx.x; it < 256; it += gridDim.x) {
            const int g16 = it >> 4, k0 = (it & 15) * 64;
            for (int i = tid; i < 64 * 128; i += NTHREADS) { const int k = i >> 7, d = i & 127; LA[k * 129 + d] = wq[(size_t)(k0 + k) * 2048 + g16 * 128 + d] * gf[k0 + k]; }
            for (int i = tid; i < 128 * 128; i += NTHREADS) { const int n = i >> 7, d = i & 127; LB[n * 129 + d] = sk[((size_t)g16 * 128 + n) * 128 + d]; }
            __syncthreads();
            const int n = tid & 127, kg = tid >> 7;
            float o[16];
#pragma unroll
            for (int j = 0; j < 16; ++j) o[j] = 0.f;
            for (int d = 0; d < 128; ++d) { const float b = LB[n * 129 + d];
#pragma unroll
                for (int j = 0; j < 16; ++j) o[j] += LA[(kg * 16 + j) * 129 + d] * b; }
            h16x8 o0, o1;
#pragma unroll
            for (int j = 0; j < 8; ++j) { o0[j] = (h16)o[j]; o1[j] = (h16)o[8 + j]; }
            h16* dst = wst + (size_t)(g16 * 128 + n) * 1024 + k0 + kg * 16;
            *(h16x8*)dst = o0; *(h16x8*)(dst + 8) = o1;
            __syncthreads();
        }
    }
    {
        const float* gf = a.in[20];
        f32x4 g4[4];
#pragma unroll
        for (int j = 0; j < 4; ++j) g4[j] = *(const f32x4*)(gf + 16 * lane + 4 * j);
        for (int r = gw; r < 2 * 16384; r += NGW) {
            const int tb = r >> 14, e = r & 16383;
            const float* src = (tb ? a.in[24] : a.in[23]) + (size_t)e * 1024 + 16 * lane;
            f32x4 v[4]; float mx = 0.f;
#pragma unroll
            for (int j = 0; j < 4; ++j) { v[j] = *(const f32x4*)(src + 4 * j); if (!tb) v[j] = v[j] * g4[j];
#pragma unroll
                for (int c = 0; c < 4; ++c) mx = fmaxf(mx, fabsf(v[j][c])); }
#pragma unroll
            for (int o = 1; o < 64; o <<= 1) mx = fmaxf(mx, __shfl_xor(mx, o));
            mx = fmaxf(mx, 1e-30f);
            const float sc = 224.0f / mx;
            u32x4 q;
#pragma unroll
            for (int j = 0; j < 4; ++j) { int w = 0; w = __builtin_amdgcn_cvt_pk_fp8_f32(v[j][0] * sc, v[j][1] * sc, w, false); w = __builtin_amdgcn_cvt_pk_fp8_f32(v[j][2] * sc, v[j][3] * sc, w, true); q[j] = (unsigned)w; }
            unsigned char* dst = ws + (tb ? O_V8 : O_U8) + ((size_t)(lane >> 3) * 16384 + e) * 128 + 16 * (lane & 7);
            *(u32x4*)dst = q;
            if (lane == 0) ((float*)(ws + (tb ? O_VSC : O_USC)))[e] = mx * (1.0f / 224.0f);
        }
        if (blockIdx.x == 0 && tid < 32) ((unsigned*)(ws + O_CTR))[tid * 64] = 0u;
        const f32x4* pp = (const f32x4*)a.in[1]; h16x4* dp = (h16x4*)(ws + O_P16);
        const int np4 = MTOK * 256 / 4;
        for (int i = blockIdx.x * NTHREADS + tid; i < np4; i += gridDim.x * NTHREADS) dp[i] = pack4(pp[i]);
    }
    {
        const float* x = a.in[0]; h16* xn = (h16*)(ws + O_XN);
        for (int r = gw; r < MTOK; r += NGW) {
            const f32x4* xr = (const f32x4*)(x + (size_t)r * 1024) + lane;
            f32x4 v[4]; float s = 0.f;
#pragma unroll
            for (int j = 0; j < 4; ++j) { v[j] = xr[64 * j]; s += (v[j][0] * v[j][0] + v[j][1] * v[j][1]) + (v[j][2] * v[j][2] + v[j][3] * v[j][3]); }
            const float rs = rsqrtf(wave_sum(s) * (1.f / 1024.f) + NORM_EPS);
            h16x4* o = (h16x4*)(xn + (size_t)r * 1024) + lane;
#pragma unroll
            for (int j = 0; j < 4; ++j) o[64 * j] = pack4(v[j] * rs);
        }
    }
}

__device__ __forceinline__ void phase_conv(const Args& a) {
    const int tid = tid_(), lane = tid & 63, wave = tid >> 6;
    const int gw = blockIdx.x * NWAVES + wave, NGW = gridDim.x * NWAVES;
    const h16* zc = (const h16*)(a.ws + O_ZC); h16* ca = (h16*)(a.ws + O_CA);
    const float* cw = a.in[4]; const float* cb = a.in[5];
    float w0[8], w1[8], w2[8], bb[8];
#pragma unroll
    for (int j = 0; j < 8; ++j) { const int c = lane * 8 + j; w0[j] = cw[c]; w1[j] = cw[512 + c]; w2[j] = cw[1024 + c]; bb[j] = cb[c]; }
    for (int run = gw; run < MTOK / 32; run += NGW) {
        const int t0 = run * 32;
        float u1[8], u2[8];
        if ((t0 % SEQ) == 0) {
#pragma unroll
            for (int j = 0; j < 8; ++j) { u1[j] = 0.f; u2[j] = 0.f; }
        } else {
            const h16x8 c1 = *(const h16x8*)(zc + (size_t)(t0 - 1) * 1536 + 512 + lane * 8), x1 = *(const h16x8*)(zc + (size_t)(t0 - 1) * 1536 + 1024 + lane * 8);
            const h16x8 c2 = *(const h16x8*)(zc + (size_t)(t0 - 2) * 1536 + 512 + lane * 8), x2 = *(const h16x8*)(zc + (size_t)(t0 - 2) * 1536 + 1024 + lane * 8);
#pragma unroll
            for (int j = 0; j < 8; ++j) { u1[j] = (float)c1[j] * (float)x1[j]; u2[j] = (float)c2[j] * (float)x2[j]; }
        }
        for (int t = t0; t < t0 + 32; ++t) {
            const h16* zrow = zc + (size_t)t * 1536 + lane * 8;
            const h16x8 gb = *(const h16x8*)zrow, gc = *(const h16x8*)(zrow + 512), xi = *(const h16x8*)(zrow + 1024);
            h16x8 o;
#pragma unroll
            for (int j = 0; j < 8; ++j) { const float u0 = (float)gc[j] * (float)xi[j];
                const float y = w0[j] * u2[j] + w1[j] * u1[j] + w2[j] * u0 + bb[j];
                o[j] = (h16)((float)gb[j] * y); u2[j] = u1[j]; u1[j] = u0; }
            *(h16x8*)(ca + (size_t)t * 512 + lane * 8) = o;
        }
    }
}


__device__ __forceinline__ float tanhf_(float x) { return 1.0f - 2.0f * __builtin_amdgcn_rcpf(1.0f + __expf(2.0f * x)); }
__device__ __forceinline__ void phase_rwkv_prep(const Args& a) {
    const int tid = tid_(), lane = tid & 63, wave = tid >> 6;
    const int gw = blockIdx.x * NWAVES + wave, NGW = gridDim.x * NWAVES;
    const h16* zr = (const h16*)(a.ws + O_ZR);
    h16* R = (h16*)a.out; h16* KS = R + (size_t)MTOK * 512; h16* V = KS + (size_t)MTOK * 512; h16* KK = V + (size_t)MTOK * 512;
    h16* APR = (h16*)(a.ws + O_APR);
    const float* mu = a.in[6]; const float* k_k = a.in[12];
    float mr[8], mk[8], mv[8], mt[8], kk8[8];
#pragma unroll
    for (int j = 0; j < 8; ++j) { const int c = lane * 8 + j; mr[j] = mu[c]; mk[j] = mu[512 + c]; mv[j] = mu[1024 + c]; mt[j] = mu[1536 + (c & 255)]; kk8[j] = k_k[c]; }
    for (int run = gw; run < MTOK / 32; run += NGW) {
        const int t0 = run * 32;
        float pr[8], pk[8], pv[8], pt[8];
        if ((t0 % SEQ) == 0) {
#pragma unroll
            for (int j = 0; j < 8; ++j) { pr[j] = 0.f; pk[j] = 0.f; pv[j] = 0.f; pt[j] = 0.f; }
        } else {
            const h16* zp = zr + (size_t)(t0 - 1) * 1792 + lane * 8;
            const h16x8 a0 = *(const h16x8*)zp, a1 = *(const h16x8*)(zp + 512), a2 = *(const h16x8*)(zp + 1024), a3 = *(const h16x8*)(zr + (size_t)(t0 - 1) * 1792 + 1536 + (lane & 31) * 8);
#pragma unroll
            for (int j = 0; j < 8; ++j) { pr[j] = (float)a0[j]; pk[j] = (float)a1[j]; pv[j] = (float)a2[j]; pt[j] = (float)a3[j]; }
        }
        for (int t = t0; t < t0 + 32; ++t) {
            const h16* zp = zr + (size_t)t * 1792 + lane * 8;
            const h16x8 a0 = *(const h16x8*)zp, a1 = *(const h16x8*)(zp + 512), a2 = *(const h16x8*)(zp + 1024), a3 = *(const h16x8*)(zr + (size_t)t * 1792 + 1536 + (lane & 31) * 8);
            h16x8 orr, ok, ov, okk, ot; float kr[8]; float ss = 0.f;
#pragma unroll
            for (int j = 0; j < 8; ++j) {
                const float zr_ = (float)a0[j], zk_ = (float)a1[j], zv_ = (float)a2[j], zt_ = (float)a3[j];
                const float r = zr_ + mr[j] * (pr[j] - zr_), k = zk_ + mk[j] * (pk[j] - zk_), v = zv_ + mv[j] * (pv[j] - zv_), tl = zt_ + mt[j] * (pt[j] - zt_);
                pr[j] = zr_; pk[j] = zk_; pv[j] = zv_; pt[j] = zt_;
                orr[j] = (h16)r; ok[j] = (h16)k; ov[j] = (h16)v;
                kr[j] = k * kk8[j]; ss += kr[j] * kr[j];
                const float tv = (lane < 8) ? tanhf_(tl) : (lane < 16) ? tl : sigmoidf_(tl);
                ot[j] = (h16)tv;
            }
            ss += __shfl_xor(ss, 1); ss += __shfl_xor(ss, 2); ss += __shfl_xor(ss, 4);
            const float rn = rsqrtf(ss + 1e-12f);
#pragma unroll
            for (int j = 0; j < 8; ++j) okk[j] = (h16)(kr[j] * rn);
            const size_t o = (size_t)t * 512 + lane * 8;
            *(h16x8*)(R + o) = orr; *(h16x8*)(KS + o) = ok; *(h16x8*)(V + o) = ov; *(h16x8*)(KK + o) = okk;
            if (lane < 32) *(h16x8*)(APR + (size_t)t * 256 + lane * 8) = ot;
        }
    }
}

struct EpiLR {
    const float *w0, *a0, *k_a; h16 *WD, *KS, *BD, *GG; const h16* KK;
    __device__ __forceinline__ void operator()(AccRef acc, const Unit& u, int wr, int wc, int fr, int fq) const {
        const int part = u.pn >> 1;
        EPI_LOOP_BEGIN
            const int c = col - part * 512; const size_t o = (size_t)row * 512 + c;
            if (part == 0) {
                const f32x4 b0 = *(const f32x4*)(w0 + c), b1 = *(const f32x4*)(w0 + c + 4); f32x4 o0, o1;
#pragma unroll
                for (int j = 0; j < 4; ++j) { o0[j] = __expf(-0.6065306597126334f * sigmoidf_(b0[j] + v0[j])); o1[j] = __expf(-0.6065306597126334f * sigmoidf_(b1[j] + v1[j])); }
                *(h16x8*)(WD + o) = pack8(o0, o1);
            } else if (part == 1) {
                const f32x4 b0 = *(const f32x4*)(a0 + c), b1 = *(const f32x4*)(a0 + c + 4), ka0 = *(const f32x4*)(k_a + c), ka1 = *(const f32x4*)(k_a + c + 4);
                const h16x8 ks = *(const h16x8*)(KS + o), kk = *(const h16x8*)(KK + o); f32x4 k0, k1, bb0, bb1;
#pragma unroll
                for (int j = 0; j < 4; ++j) { const float aa0 = sigmoidf_(b0[j] + v0[j]), aa1 = sigmoidf_(b1[j] + v1[j]);
                    k0[j] = (float)ks[j] * (1.0f + (aa0 - 1.0f) * ka0[j]); k1[j] = (float)ks[4 + j] * (1.0f + (aa1 - 1.0f) * ka1[j]);
                    bb0[j] = aa0 * (float)kk[j]; bb1[j] = aa1 * (float)kk[4 + j]; }
                *(h16x8*)(KS + o) = pack8(k0, k1); *(h16x8*)(BD + o) = pack8(bb0, bb1);
            } else {
                *(h16x8*)(GG + o) = pack8(v0, v1);
            }
        EPI_LOOP_END
    }
};

constexpr int SC_L = 256, SC_NCH = SEQ / SC_L, SC_NB = 8;
constexpr int SC_STEP_F = 6 * 64;
constexpr int SC_WAVE_BYTES = SC_NB * SC_STEP_F * 4 + SC_NB * 64 * 4;
__device__ __forceinline__ float quad_sum(float v) { v += dpp_<0xB1>(v); v += dpp_<0x4E>(v); return v; }
__device__ __forceinline__ void lds_ld8x2(const LAS float* p, f32x2 (&o)[8]) {
#pragma unroll
    for (int j4 = 0; j4 < 4; ++j4) { const f32x4 t = *(const LAS f32x4*)(p + 4 * j4); o[2 * j4] = (f32x2){t[0], t[1]}; o[2 * j4 + 1] = (f32x2){t[2], t[3]}; }
}
template <int MODE>
__device__ __forceinline__ void scan_wave(const Args& a, LAS unsigned char* lds, int task) {
    const int tid = tid_(), lane = tid & 63, wave = tid >> 6;
    const int q = lane & 3, rg = lane >> 2;
    const int chain = task / SC_NCH, chunk = task % SC_NCH, b = chain >> 3, h = chain & 7;
    const size_t row0 = (size_t)b * SEQ + (size_t)chunk * SC_L;
    const h16* R = (const h16*)a.out; const h16* KS = R + (size_t)MTOK * 512; const h16* V = KS + (size_t)MTOK * 512; const h16* KK = V + (size_t)MTOK * 512;
    const h16* WD = (const h16*)(a.ws + O_WD); const h16* BD = (const h16*)(a.ws + O_BD);
    LAS float* buf = (LAS float*)(lds + wave * SC_WAVE_BYTES);
    LAS float* ybuf = buf + SC_NB * SC_STEP_F;
    constexpr int NA = (MODE == 0) ? 5 : (MODE == 1) ? 3 : 6;
    const h16* gp[NA]; int lo[NA];
#pragma unroll
    for (int j = 0; j < NA; ++j) { const int p = lane + 64 * j, seg = p >> 3, part = p & 7, st = seg / NA, ai = seg % NA;
        const int ar = (MODE == 0 && ai == 4) ? 5 : ai;
        const h16* base = (ar == 0) ? KK : (ar == 1) ? WD : (ar == 2) ? BD : (ar == 3) ? KS : (ar == 4) ? R : V;
        gp[j] = base + (row0 + st) * 512 + h * 64 + part * 8; lo[j] = st * SC_STEP_F + ar * 64 + part * 8; }
    f32x2 s[4][8];
    if (MODE == 0) {
#pragma unroll
        for (int i = 0; i < 4; ++i)
#pragma unroll
            for (int j = 0; j < 8; ++j) s[i][j] = (f32x2){0.f, 0.f};
    } else if (MODE == 1) {
#pragma unroll
        for (int i = 0; i < 4; ++i)
#pragma unroll
            for (int j = 0; j < 8; ++j) s[i][j] = (f32x2){(i == q && 2 * j == rg) ? 1.f : 0.f, (i == q && 2 * j + 1 == rg) ? 1.f : 0.f};
    } else {
        const float* S0 = (const float*)(a.ws + O_SST) + (size_t)task * 4096;
#pragma unroll
        for (int i = 0; i < 4; ++i)
#pragma unroll
            for (int j4 = 0; j4 < 4; ++j4) { const f32x4 t = *(const f32x4*)(S0 + (rg + 16 * i) * 64 + 16 * q + 4 * j4);
                s[i][2 * j4] = (f32x2){t[0], t[1]}; s[i][2 * j4 + 1] = (f32x2){t[2], t[3]}; }
    }
    h16x8 pre[NA];
#pragma unroll
    for (int j = 0; j < NA; ++j) pre[j] = *(const h16x8*)gp[j];
    f32x2 kk[8];
    for (int bt = 0; bt < SC_L / SC_NB; ++bt) {
        LAS float* cb = buf;
#pragma unroll
        for (int j = 0; j < NA; ++j) { f32x4 x0, x1;
#pragma unroll
            for (int e = 0; e < 4; ++e) { x0[e] = (float)pre[j][e]; x1[e] = (float)pre[j][4 + e]; }
            *(LAS f32x4*)(cb + lo[j]) = x0; *(LAS f32x4*)(cb + lo[j] + 4) = x1; }
        if (bt + 1 < SC_L / SC_NB) {
#pragma unroll
            for (int j = 0; j < NA; ++j) pre[j] = *(const h16x8*)(gp[j] + (size_t)(bt + 1) * SC_NB * 512);
        }
        lds_ld8x2(cb + 16 * q, kk);
#pragma unroll 2
        for (int st = 0; st < SC_NB; ++st) {
            const LAS float* sb = cb + st * SC_STEP_F;
            f32x2 w[8], bb[8], kx[8]; float vv[4];
            lds_ld8x2(sb + 64 + 16 * q, w); lds_ld8x2(sb + 128 + 16 * q, bb);
            if (MODE != 1) { lds_ld8x2(sb + 192 + 16 * q, kx);
#pragma unroll
                for (int i = 0; i < 4; ++i) vv[i] = sb[320 + rg + 16 * i]; }
            float us[4];
#pragma unroll
            for (int i = 0; i < 4; ++i) { f32x2 t = s[i][0] * kk[0];
#pragma unroll
                for (int j = 1; j < 8; ++j) t = __builtin_elementwise_fma(s[i][j], kk[j], t);
                us[i] = quad_sum(t[0] + t[1]); }
            if (st + 1 < SC_NB) lds_ld8x2(sb + SC_STEP_F + 16 * q, kk);
            f32x2 rr[8];
            if (MODE == 2) lds_ld8x2(sb + 256 + 16 * q, rr);
#pragma unroll
            for (int i = 0; i < 4; ++i) { const f32x2 nu = (f32x2){-us[i], -us[i]}, v2 = (f32x2){vv[i], vv[i]};
#pragma unroll
                for (int j = 0; j < 8; ++j) { f32x2 t = s[i][j] * w[j]; t = __builtin_elementwise_fma(nu, bb[j], t); if (MODE != 1) t = __builtin_elementwise_fma(v2, kx[j], t); s[i][j] = t; } }
            if (MODE == 2) {
#pragma unroll
                for (int i = 0; i < 4; ++i) { f32x2 t = s[i][0] * rr[0];
#pragma unroll
                    for (int j = 1; j < 8; ++j) t = __builtin_elementwise_fma(s[i][j], rr[j], t);
                    const float y = quad_sum(t[0] + t[1]);
                    if (q == 0) ybuf[st * 64 + rg + 16 * i] = y; }
            }
        }
        if (MODE == 2) {
            const int st = lane >> 3, part = lane & 7; h16x8 o;
#pragma unroll
            for (int e = 0; e < 8; ++e) o[e] = (h16)ybuf[st * 64 + part * 8 + e];
            *(h16x8*)((h16*)(a.ws + O_Y) + (row0 + (size_t)bt * SC_NB + st) * 512 + h * 64 + part * 8) = o;
        }
    }
    if (MODE != 2) {
        float* PQ = (float*)(a.ws + O_PQ) + (size_t)task * 8192 + (MODE == 0 ? 4096 : 0);
#pragma unroll
        for (int i = 0; i < 4; ++i)
#pragma unroll
            for (int j4 = 0; j4 < 4; ++j4) { const int o = (rg + 16 * i) * 64 + 16 * q + 4 * j4;
                *(f32x4*)(PQ + o) = (f32x4){s[i][2 * j4][0], s[i][2 * j4][1], s[i][2 * j4 + 1][0], s[i][2 * j4 + 1][1]}; }
    }
}
template <bool FIRST>
__device__ __forceinline__ void phase_scan(const Args& a, LAS unsigned char* lds) {
    const int wave = tid_() >> 6;
    if (FIRST) {
        for (int task = blockIdx.x * NWAVES + wave; task < 64 * SC_NCH; task += gridDim.x * NWAVES) { scan_wave<0>(a, lds, task); scan_wave<1>(a, lds, task); }
    } else {
        for (int task = blockIdx.x * NWAVES + wave; task < 64 * SC_NCH; task += gridDim.x * NWAVES) scan_wave<2>(a, lds, task);
    }
}

constexpr size_t O_VTB = O_ZR;
constexpr size_t O_BON = O_ZR + 64 * MiB;
constexpr int UT_WAVE_LDS = 15360;
typedef float f32x16 __attribute__((ext_vector_type(16)));
__device__ __forceinline__ size_t ut_ov(int j, int s) { return (size_t)(j >> 2) * 512 + (j & 3) * 16 + s; }
__device__ __forceinline__ void phase_ut_pre(const Args& a, LAS unsigned char* lds) {
    const int tid = tid_(), lane = tid & 63, wave = tid >> 6;
    const int gw = blockIdx.x * NWAVES + wave, NGW = gridDim.x * NWAVES;
    LAS unsigned char* Lb = lds + wave * UT_WAVE_LDS;
    LAS h16* YX = (LAS h16*)Lb;
    LAS float* GT = (LAS float*)(Lb + 9216);
    LAS float* TM = (LAS float*)(Lb + 13824);
    h16* R = (h16*)a.out; h16* KS = R + (size_t)MTOK * 512; h16* V = KS + (size_t)MTOK * 512; h16* KK = V + (size_t)MTOK * 512;
    h16* WD = (h16*)(a.ws + O_WD); h16* BD = (h16*)(a.ws + O_BD);
    h16* VTB = (h16*)(a.ws + O_VTB); float* BON = (float*)(a.ws + O_BON);
    for (int bh = gw; bh < 32768; bh += NGW) {
        int ln = lane; asm volatile("" : "+v"(ln)); const int r16 = ln & 15;
        const int h = bh & 7, nb = bh >> 3; const size_t tok0 = (size_t)nb * 16; const size_t e0 = tok0 * 512 + h * 64;
        const float rk = a.in[14][h * 64 + lane];
        {
            h16x8 stg[12];
#pragma unroll
            for (int j = 0; j < 12; ++j) { const int ar = j >> 1, row = (lane >> 3) + 8 * (j & 1);
                const h16* base = (ar == 0) ? WD : (ar == 1) ? KK : (ar == 2) ? BD : (ar == 3) ? KS : (ar == 4) ? R : V;
                stg[j] = *(const h16x8*)(base + e0 + (size_t)row * 512 + (lane & 7) * 8); }
#pragma unroll
            for (int j = 0; j < 12; ++j) *(LAS h16x8*)((LAS h16*)Lb + ((j >> 1) * 16 + (lane >> 3) + 8 * (j & 1)) * 64 + (lane & 7) * 8) = stg[j];
            asm volatile("s_waitcnt lgkmcnt(0)" ::: "memory");
        }
        float w[16], kk[16], bb[16], kx[16], rr[16]; h16x8 vt0, vt1;
        { const LAS h16* IN = (const LAS h16*)Lb;
#pragma unroll
        for (int t = 0; t < 16; ++t) { w[t] = (float)IN[t * 64 + lane]; kk[t] = (float)IN[(16 + t) * 64 + lane]; bb[t] = (float)IN[(32 + t) * 64 + lane]; kx[t] = (float)IN[(48 + t) * 64 + lane]; rr[t] = (float)IN[(64 + t) * 64 + lane];
            if (t < 8) vt0[t] = IN[(80 + t) * 64 + lane]; else vt1[t - 8] = IN[(80 + t) * 64 + lane]; } }
        asm volatile("s_waitcnt lgkmcnt(0)" ::: "memory");
        { h16* vp = VTB + (size_t)bh * 1024 + lane * 16; *(h16x8*)vp = vt0; *(h16x8*)(vp + 8) = vt1; }
        float bonv = 0.f;
#pragma unroll
        for (int t = 0; t < 16; ++t) { const float bs = wave_sum(rr[t] * kx[t] * rk); bonv = (ln == t) ? bs : bonv; }
        if (lane < 16) BON[(tok0 + lane) * 8 + h] = bonv;
        float Lt[16]; { float Lc = 0.f;
#pragma unroll
            for (int t = 0; t < 16; ++t) { Lc += __logf(w[t]); Lt[t] = Lc; } }
        const float Lref = Lt[7];
        float btil[16]; h16x8 kt0, kt1;
        LAS h16* OS = (LAS h16*)(Lb + 9216);
#pragma unroll
        for (int t = 0; t < 16; ++t) {
            const float Lp = t ? Lt[t - 1] : 0.f;
            const float ka = kk[t] * __expf(Lp - Lref), rt = rr[t] * __expf(Lt[t] - Lref), e2 = __expf(Lref - Lt[t]), bt = bb[t] * e2, kt = kx[t] * e2;
            YX[t * 72 + lane] = (h16)ka; YX[(16 + t) * 72 + lane] = (h16)rt; YX[(32 + t) * 72 + lane] = (h16)kt; YX[(48 + t) * 72 + lane] = (h16)bt;
            btil[t] = bt;
            OS[t * 64 + lane] = (h16)(kk[t] * __expf(Lp)); OS[(16 + t) * 64 + lane] = (h16)(rr[t] * __expf(Lt[t]));
            const float ktp = kx[t] * __expf(Lt[15] - Lt[t]);
            if (t < 8) kt0[t] = (h16)ktp; else kt1[t - 8] = (h16)ktp;
        }
        const float post = __expf(Lt[15] - Lref), w16 = __expf(Lt[15]);
        { h16* kp = KS + e0 + ut_ov(lane, 0); *(h16x8*)kp = kt0; *(h16x8*)(kp + 8) = kt1; }
        asm volatile("s_waitcnt lgkmcnt(0)" ::: "memory");
#pragma unroll
        for (int j = 0; j < 4; ++j) { const int row = (lane >> 3) + 8 * (j & 1); const h16x8 o8 = *(const LAS h16x8*)(OS + ((j >> 1) * 16 + row) * 64 + (lane & 7) * 8);
            *(h16x8*)(((j >> 1) ? R : KK) + e0 + (size_t)row * 512 + (lane & 7) * 8) = o8; }
        asm volatile("s_waitcnt lgkmcnt(0)" ::: "memory");
        f32x16 acc;
#pragma unroll
        for (int i = 0; i < 16; ++i) acc[i] = 0.f;
#pragma unroll
        for (int ks = 0; ks < 4; ++ks) {
            const h16x8 af = *(const LAS h16x8*)(YX + (lane & 31) * 72 + 8 * (lane >> 5) + 16 * ks), bf = *(const LAS h16x8*)(YX + (32 + (lane & 31)) * 72 + 8 * (lane >> 5) + 16 * ks);
            acc = __builtin_amdgcn_mfma_f32_32x32x16_f16(af, bf, acc, 0, 0, 0);
        }
#pragma unroll
        for (int i = 0; i < 16; ++i) GT[((i & 3) + 8 * (i >> 2) + 4 * (lane >> 5)) * 36 + (lane & 31)] = acc[i];
        asm volatile("s_waitcnt lgkmcnt(0)" ::: "memory");
        float T[16];
#pragma unroll
        for (int t = 0; t < 16; ++t) { float v = (r16 == t) ? 1.f : 0.f;
#pragma unroll
            for (int s2 = 0; s2 < t; ++s2) v -= T[s2] * GT[t * 36 + 16 + s2];
            T[t] = v; }
#pragma unroll
        for (int t = 0; t < 16; ++t) TM[r16 * 20 + t] = T[t];
        asm volatile("s_waitcnt lgkmcnt(0)" ::: "memory");
        float bcol[16];
#pragma unroll
        for (int s2 = 0; s2 < 16; ++s2) bcol[s2] = (s2 <= r16) ? GT[(16 + r16) * 36 + 16 + s2] : 0.f;
        h16x8 tb0, tb1, tp0, tp1;
#pragma unroll
        for (int r = 0; r < 16; ++r) { float s0 = 0.f, s1 = 0.f;
#pragma unroll
            for (int s2 = r; s2 < 16; ++s2) { const float tv = TM[r * 20 + s2]; s0 += tv * btil[s2]; s1 += tv * bcol[s2]; }
            s0 *= post;
            if (r < 8) { tb0[r] = (h16)s0; tp0[r] = (h16)s1; } else { tb1[r - 8] = (h16)s0; tp1[r - 8] = (h16)s1; } }
        { h16* bp = BD + e0 + ut_ov(lane, 0); *(h16x8*)bp = tb0; *(h16x8*)(bp + 8) = tb1; }
        if (lane < 16) {
            h16x8 a0, a1, p0, p1;
#pragma unroll
            for (int s2 = 0; s2 < 16; ++s2) { const float av = (s2 < ln) ? GT[ln * 36 + s2] : 0.f, pv = (s2 <= ln) ? GT[(16 + ln) * 36 + s2] : 0.f;
                if (s2 < 8) { a0[s2] = (h16)av; p0[s2] = (h16)pv; } else { a1[s2 - 8] = (h16)av; p1[s2 - 8] = (h16)pv; } }
            h16* ap = WD + e0 + (size_t)(lane >> 2) * 512 + (lane & 3) * 16;
            *(h16x8*)ap = a0; *(h16x8*)(ap + 8) = a1;
            *(h16x8*)(ap + 4 * 512) = p0; *(h16x8*)(ap + 4 * 512 + 8) = p1;
            *(h16x8*)(ap + 8 * 512) = tp0; *(h16x8*)(ap + 8 * 512 + 8) = tp1;
        }
        (WD + e0 + (size_t)12 * 512)[lane] = (h16)w16;
        asm volatile("s_waitcnt lgkmcnt(0)" ::: "memory");
    }
}
struct UtOps { u32x2 ka[2][2], rt[2][2], kt[4], tb[4], at, apt, tp, vb, w16[4]; };
struct UtRes { __amdgpu_buffer_rsrc_t kk, r, ks, bd, wd, vt, y; };
__device__ __forceinline__ void ut_load(UtOps& o, const UtRes& R, int so, unsigned offK, unsigned offT, unsigned offV, unsigned offF) {
#pragma unroll
    for (int ks = 0; ks < 2; ++ks)
#pragma unroll
        for (int p = 0; p < 2; ++p) { o.ka[ks][p] = __builtin_amdgcn_raw_buffer_load_b64(R.kk, offK + 64u * ks + 32u * p, so, 0); o.rt[ks][p] = __builtin_amdgcn_raw_buffer_load_b64(R.r, offK + 64u * ks + 32u * p, so, 0); }
#pragma unroll
    for (int kt = 0; kt < 4; ++kt) { o.kt[kt] = __builtin_amdgcn_raw_buffer_load_b64(R.ks, offT + 4096u * kt, so, 0); o.tb[kt] = __builtin_amdgcn_raw_buffer_load_b64(R.bd, offT + 4096u * kt, so, 0); }
    o.at = __builtin_amdgcn_raw_buffer_load_b64(R.wd, offT, so, 0); o.apt = __builtin_amdgcn_raw_buffer_load_b64(R.wd, offT + 4096u, so, 0); o.tp = __builtin_amdgcn_raw_buffer_load_b64(R.wd, offT + 8192u, so, 0);
    o.vb = __builtin_amdgcn_raw_buffer_load_b64(R.vt, offV, so, 0);
#pragma unroll
    for (int kt = 0; kt < 4; ++kt) o.w16[kt] = __builtin_amdgcn_raw_buffer_load_b64(R.wd, offF + 12u * 1024u + 32u * kt, so, 0);
}
__device__ __forceinline__ f32x4 h4f(u32x2 v) { const h16x4 h = __builtin_bit_cast(h16x4, v); return (f32x4){(float)h[0], (float)h[1], (float)h[2], (float)h[3]}; }
__device__ __forceinline__ h16x8 cat8(u32x2 lo, u32x2 hi) { u32x4 r; r[0] = lo[0]; r[1] = lo[1]; r[2] = hi[0]; r[3] = hi[1]; return __builtin_bit_cast(h16x8, r); }
__device__ __forceinline__ void ut_block(const UtOps& o, f32x4 (&S)[4], const UtRes& R, unsigned offY, int so) {
    const f32x4 zf = (f32x4){0.f, 0.f, 0.f, 0.f}; const u32x2 zu = (u32x2){0u, 0u};
    const h16x8 sb0 = pack8(S[0], S[1]), sb1 = pack8(S[2], S[3]);
    const h16x8 vb = cat8(o.vb, zu);
    f32x4 x1 = zf, y = zf;
    x1 = __builtin_amdgcn_mfma_f32_16x16x32_f16(cat8(o.ka[0][0], o.ka[0][1]), sb0, x1, 0, 0, 0); y = __builtin_amdgcn_mfma_f32_16x16x32_f16(cat8(o.rt[0][0], o.rt[0][1]), sb0, y, 0, 0, 0);
    x1 = __builtin_amdgcn_mfma_f32_16x16x32_f16(cat8(o.ka[1][0], o.ka[1][1]), sb1, x1, 0, 0, 0); y = __builtin_amdgcn_mfma_f32_16x16x32_f16(cat8(o.rt[1][0], o.rt[1][1]), sb1, y, 0, 0, 0);
    x1 = __builtin_amdgcn_mfma_f32_16x16x32_f16(cat8(o.at, zu), vb, x1, 0, 0, 0); y = __builtin_amdgcn_mfma_f32_16x16x32_f16(cat8(o.apt, zu), vb, y, 0, 0, 0);
    f32x4 St[4];
#pragma unroll
    for (int kt = 0; kt < 4; ++kt) St[kt] = __builtin_amdgcn_mfma_f32_16x16x32_f16(cat8(o.kt[kt], zu), vb, S[kt] * h4f(o.w16[kt]), 0, 0, 0);
    const h16x8 xb = pack8(-x1, zf);
    y = __builtin_amdgcn_mfma_f32_16x16x32_f16(cat8(o.tp, zu), xb, y, 0, 0, 0);
#pragma unroll
    for (int kt = 0; kt < 4; ++kt) S[kt] = __builtin_amdgcn_mfma_f32_16x16x32_f16(cat8(o.tb[kt], zu), xb, St[kt], 0, 0, 0);
#pragma unroll
    for (int rg = 0; rg < 4; ++rg) { const h16 hv = (h16)y[rg]; __builtin_amdgcn_raw_buffer_store_b16(__builtin_bit_cast(unsigned short, hv), R.y, offY + 1024u * rg, so, 0); }
}
__device__ __forceinline__ void phase_ut_seq(const Args& a, LAS unsigned char* lds) {
    const int tid = tid_(), lane = tid & 63, wave = tid >> 6, fr = lane & 15, fq = lane >> 4;
    volatile LAS int* prog = (volatile LAS int*)lds;
    if (tid == 0) *prog = 0;
    if (wave > 1) return;
    for (int item = blockIdx.x; item < 256; item += gridDim.x) {
        const int h = item & 7, q = item >> 3, g = q & 3, b = q >> 2;
        const size_t e0 = ((size_t)b * SEQ * 512 + h * 64) * 2;
        const char* Rb = (const char*)a.out + e0; const char* KSb = Rb + (size_t)MTOK * 1024; const char* KKb = Rb + (size_t)3 * MTOK * 1024;
        const char* WDb = (const char*)(a.ws + O_WD) + e0; const char* BDb = (const char*)(a.ws + O_BD) + e0;
        const char* VTb = (const char*)(a.ws + O_VTB) + ((size_t)b * (SEQ / 16) * 8 + h) * 2048;
        if (wave == 1) {
            const int ar = lane >> 4, row = lane & 15;
            const char* p0 = ((ar == 0) ? KKb : (ar == 1) ? Rb : (ar == 2) ? KSb : BDb) + (size_t)row * 1024;
            const char* p1 = (lane < 16) ? WDb + (size_t)row * 1024 : VTb + (size_t)(4 * g + (lane & 3)) * 128;
            for (int n0 = 0; n0 < SEQ / 16; n0 += 8) {
                int guard = 0;
                while (*prog + 16 < n0 && ++guard < (1 << 22)) __builtin_amdgcn_s_sleep(8);
                unsigned x[16];
#pragma unroll
                for (int i = 0; i < 8; ++i) { x[2 * i] = *(const unsigned*)(p0 + (size_t)(n0 + i) * 16384); x[2 * i + 1] = *(const unsigned*)(p1 + (size_t)(n0 + i) * 16384); }
#pragma unroll
                for (int i = 0; i < 16; ++i) asm volatile("" :: "v"(x[i]));
            }
            continue;
        }
        const unsigned offK = (unsigned)(fr * 1024 + 8 * fq), offT = (unsigned)((fr >> 2) * 512 + (fr & 3) * 16 + 4 * fq) * 2u, offV = (unsigned)((16 * g + fr) * 16 + 4 * fq) * 2u, offF = (unsigned)fq * 8u,
                       offY = (unsigned)((4 * fq) * 512 + 16 * g + fr) * 2u;
        UtRes RS; RS.kk = mkrsrc(KKb); RS.r = mkrsrc(Rb); RS.ks = mkrsrc(KSb); RS.bd = mkrsrc(BDb); RS.wd = mkrsrc(WDb); RS.vt = mkrsrc(VTb);
        RS.y = mkrsrc((const char*)(a.ws + O_Y) + e0);
        f32x4 S[4];
#pragma unroll
        for (int kt = 0; kt < 4; ++kt) S[kt] = (f32x4){0.f, 0.f, 0.f, 0.f};
        UtOps oa, ob, oc;
#define UT_LD(o, nn) ut_load(o, RS, ((nn) < SEQ / 16 ? (nn) : SEQ / 16 - 1) * 16384, offK, offT, offV, offF)
        UT_LD(oa, 0); UT_LD(ob, 1);
        int n = 0;
#pragma unroll 1
        for (; n + 3 <= SEQ / 16; n += 3) {
            if (lane == 0) *prog = n;
            UT_LD(oc, n + 2); ut_block(oa, S, RS, offY, n * 16384);
            UT_LD(oa, n + 3); ut_block(ob, S, RS, offY, (n + 1) * 16384);
            UT_LD(ob, n + 4); ut_block(oc, S, RS, offY, (n + 2) * 16384);
        }
        ut_block(oa, S, RS, offY, n * 16384); ut_block(ob, S, RS, offY, (n + 1) * 16384);
#undef UT_LD
    }
}

__device__ __forceinline__ void phase_scan_combine(const Args& a, LAS unsigned char* lds) {
    const int tid = tid_(), row = tid >> 5, cp = tid & 31;
    LAS float* LS = (LAS float*)lds;
    LAS float* LP = (LAS float*)(lds + 8192);
    for (int item = blockIdx.x; item < 64 * 4; item += gridDim.x) {
        const int chain = item >> 2, r0 = (item & 3) * 16;
        const float* PQ0 = (const float*)(a.ws + O_PQ) + (size_t)chain * SC_NCH * 8192;
        f32x2 sr = (f32x2){0.f, 0.f};
        f32x4 pa = *(const f32x4*)(PQ0 + tid * 8), pb = *(const f32x4*)(PQ0 + tid * 8 + 4);
        f32x2 qn = *(const f32x2*)(PQ0 + 4096 + (r0 + row) * 64 + 2 * cp);
        for (int c = 0; c < SC_NCH; ++c) {
            const int task = chain * SC_NCH + c;
            *(f32x2*)((float*)(a.ws + O_SST) + (size_t)task * 4096 + (r0 + row) * 64 + 2 * cp) = sr;
            if (c == SC_NCH - 1) break;
            LAS float* cur = LS + (c & 1) * 1024; LAS float* cp_ = LP + (c & 1) * 4096;
            *(LAS f32x2*)(cur + row * 64 + 2 * cp) = sr;
            *(LAS f32x4*)(cp_ + tid * 8) = pa; *(LAS f32x4*)(cp_ + tid * 8 + 4) = pb;
            f32x2 acc0 = qn, acc1 = (f32x2){0.f, 0.f};
            if (c + 2 < SC_NCH) { const float* Pn = PQ0 + (size_t)(c + 1) * 8192;
                pa = *(const f32x4*)(Pn + tid * 8); pb = *(const f32x4*)(Pn + tid * 8 + 4); qn = *(const f32x2*)(Pn + 4096 + (r0 + row) * 64 + 2 * cp); }
            __syncthreads();
#pragma unroll 16
            for (int k = 0; k < 64; k += 2) {
                const f32x2 sk = *(const LAS f32x2*)(cur + row * 64 + k);
                const f32x2 p0 = *(const LAS f32x2*)(cp_ + k * 64 + 2 * cp), p1 = *(const LAS f32x2*)(cp_ + (k + 1) * 64 + 2 * cp);
                acc0 = __builtin_elementwise_fma((f32x2){sk[0], sk[0]}, p0, acc0); acc1 = __builtin_elementwise_fma((f32x2){sk[1], sk[1]}, p1, acc1);
            }
            sr = acc0 + acc1;
        }
        __syncthreads();
    }
}
__device__ __forceinline__ void phase_rwkv_post(const Args& a) {
    const int tid = tid_(), lane = tid & 63, wave = tid >> 6;
    const int gw = blockIdx.x * NWAVES + wave, NGW = gridDim.x * NWAVES;
    const h16* V = (const h16*)a.out + (size_t)2 * MTOK * 512;
    const h16* GG = (const h16*)(a.ws + O_GG); const h16* Y = (const h16*)(a.ws + O_Y); h16* YB = (h16*)(a.ws + O_YB); const float* BON = (const float*)(a.ws + O_BON);
    float lg[8], lb[8];
#pragma unroll
    for (int j = 0; j < 8; ++j) { const int c = lane * 8 + j; lg[j] = a.in[15][c]; lb[j] = a.in[16][c]; }
    for (int t = gw; t < MTOK; t += NGW) {
        const size_t o = (size_t)t * 512 + lane * 8;
        const h16x8 y8 = *(const h16x8*)(Y + o), v8 = *(const h16x8*)(V + o), g8 = *(const h16x8*)(GG + o);
        const float bs = BON[(size_t)t * 8 + (lane >> 3)];
        float y[8]; float sm = 0.f;
#pragma unroll
        for (int j = 0; j < 8; ++j) { y[j] = (float)y8[j]; sm += y[j]; }
        sm += dpp_<0xB1>(sm); sm += dpp_<0x4E>(sm); sm += dpp_<0x141>(sm);
        const float mean = sm * (1.f / 64.f); float vs = 0.f;
#pragma unroll
        for (int j = 0; j < 8; ++j) { y[j] -= mean; vs += y[j] * y[j]; }
        vs += dpp_<0xB1>(vs); vs += dpp_<0x4E>(vs); vs += dpp_<0x141>(vs);
        const float rstd = rsqrtf(vs * (1.f / 64.f) + 64e-5f);
        h16x8 ov;
#pragma unroll
        for (int j = 0; j < 8; ++j) ov[j] = (h16)((y[j] * rstd * lg[j] + lb[j] + bs * (float)v8[j]) * (float)g8[j]);
        *(h16x8*)(YB + o) = ov;
    }
}

__device__ __forceinline__ void ins16(unsigned (&L)[16], unsigned x) {
#pragma unroll
    for (int j = 0; j < 16; ++j) { const unsigned hi = L[j] > x ? L[j] : x; x = L[j] > x ? x : L[j]; L[j] = hi; }
}
__device__ __forceinline__ unsigned ord32(float f) { const unsigned u = __float_as_uint(f); return (u & 0x80000000u) ? ~u : (u | 0x80000000u); }
__device__ __forceinline__ float unord32(unsigned k) { return __uint_as_float((k & 0x80000000u) ? (k & 0x7fffffffu) : ~k); }
__device__ __forceinline__ void phase_topk(const Args& a, LAS unsigned char* lds) {
    const int tid = tid_();
    const h16* SC = (const h16*)(a.ws + O_SCORES);
    const float* part = (const float*)(a.ws + O_PART1);
    unsigned short* IDX = (unsigned short*)(a.ws + O_IDX); float* GATE = (float*)(a.ws + O_GATE); float* RS1 = (float*)(a.ws + O_RS1);
    LAS unsigned char* LI = lds;
    for (int task = blockIdx.x * NTHREADS + tid; task < MTOK * 8; task += gridDim.x * NTHREADS) {
        const int t = task >> 3, h = task & 7;
        float ssq = 0.f;
#pragma unroll
        for (int j = 0; j < 4; ++j) { const f32x4 p4 = *(const f32x4*)(part + (size_t)t * 16 + 4 * j); ssq += (p4[0] + p4[1]) + (p4[2] + p4[3]); }
        const float rs = rsqrtf(ssq * (1.f / 1024.f) + NORM_EPS);
        if (h == 0) RS1[t] = rs;
        float sv[2][16];
#pragma unroll
        for (int c = 0; c < 2; ++c) {
            unsigned L[16];
#pragma unroll
            for (int j = 0; j < 16; ++j) L[j] = 0u;
            const h16* row = SC + (size_t)t * 2048 + h * 256 + c * 128;
#pragma unroll 2
            for (int n8 = 0; n8 < 16; ++n8) {
                const u32x4 w4 = *(const u32x4*)(row + n8 * 8);
#pragma unroll
                for (int e = 0; e < 8; ++e) {
                    const unsigned bits = (e & 1) ? (w4[e >> 1] >> 16) : (w4[e >> 1] & 0xffffu);
                    const unsigned o16 = (bits & 0x8000u) ? (~bits & 0xffffu) : (bits | 0x8000u);
                    ins16(L, (o16 << 16) | (unsigned)(127 - (n8 * 8 + e)));
                }
            }
#pragma unroll
            for (int j = 0; j < 16; ++j) {
                const unsigned o16 = L[j] >> 16; const unsigned bits = (o16 & 0x8000u) ? (o16 & 0x7fffu) : (~o16 & 0xffffu);
                union { unsigned short u; h16 f; } cv; cv.u = (unsigned short)bits; sv[c][j] = (float)cv.f;
                LI[(c * 16 + j) * 512 + tid] = (unsigned char)(127u - (L[j] & 127u));
            }
        }
        unsigned L[16];
#pragma unroll
        for (int j = 0; j < 16; ++j) L[j] = 0u;
#pragma unroll
        for (int i = 0; i < 16; ++i)
#pragma unroll
            for (int j = 0; j < 16; ++j) if ((i + 1) * (j + 1) <= 16) ins16(L, (ord32(sv[0][i] + sv[1][j]) & ~255u) | (unsigned)(255 - (i * 16 + j)));
        float e[16]; float den = 0.f; const float mx = unord32(L[0] & ~255u) * rs;
        unsigned short id[16];
#pragma unroll
        for (int k = 0; k < 16; ++k) {
            const float v = unord32(L[k] & ~255u) * rs; e[k] = __expf(v - mx); den += e[k];
            const unsigned pos = 255u - (L[k] & 255u); const unsigned i = pos >> 4, j = pos & 15u;
            id[k] = (unsigned short)((unsigned)LI[i * 512 + tid] * 128u + (unsigned)LI[(16 + j) * 512 + tid]);
        }
        const float inv = __builtin_amdgcn_rcpf(den);
        u32x4 i0, i1;
        i0[0] = id[0] | (id[1] << 16); i0[1] = id[2] | (id[3] << 16); i0[2] = id[4] | (id[5] << 16); i0[3] = id[6] | (id[7] << 16);
        i1[0] = id[8] | (id[9] << 16); i1[1] = id[10] | (id[11] << 16); i1[2] = id[12] | (id[13] << 16); i1[3] = id[14] | (id[15] << 16);
        u32x4* ip = (u32x4*)(IDX + (size_t)task * 16); ip[0] = i0; ip[1] = i1;
        f32x4* gp = (f32x4*)(GATE + (size_t)task * 16);
#pragma unroll
        for (int k4 = 0; k4 < 4; ++k4) gp[k4] = (f32x4){e[4 * k4] * inv, e[4 * k4 + 1] * inv, e[4 * k4 + 2] * inv, e[4 * k4 + 3] * inv};
    }
}

__device__ __forceinline__ float gelu_tanh(float x) { const float u = 0.7978845608028654f * (x + 0.044715f * x * x * x); return 0.5f * x * (1.0f + tanhf_(u)); }
__device__ __forceinline__ unsigned xcc_id() { return (unsigned)__builtin_amdgcn_s_getreg((3 << 11) | 20) & 7u; }
constexpr int GA_TC = 32, GA_NCH = MTOK / GA_TC;
__device__ __forceinline__ void dec16(const u32x4 q, float (&o)[16]) {
#pragma unroll
    for (int w = 0; w < 4; ++w) { const f32x2 lo = __builtin_amdgcn_cvt_pk_f32_fp8((int)q[w], false), hi = __builtin_amdgcn_cvt_pk_f32_fp8((int)q[w], true);
        o[4 * w] = lo[0]; o[4 * w + 1] = lo[1]; o[4 * w + 2] = hi[0]; o[4 * w + 3] = hi[1]; }
}
__device__ __forceinline__ void dec16p(const u32x4 q, f32x2 (&o)[8]) {
#pragma unroll
    for (int w = 0; w < 4; ++w) { o[2 * w] = __builtin_amdgcn_cvt_pk_f32_fp8((int)q[w], false); o[2 * w + 1] = __builtin_amdgcn_cvt_pk_f32_fp8((int)q[w], true); }
}
struct GIdx { u32x4 a, b; };
__device__ __forceinline__ GIdx g_ldidx(__amdgpu_buffer_rsrc_t IDX, int t, int r8) { GIdx r; r.a = __builtin_amdgcn_raw_buffer_load_b128(IDX, 32 * r8, t * 256, 0); r.b = __builtin_amdgcn_raw_buffer_load_b128(IDX, 32 * r8 + 16, t * 256, 0); return r; }
__device__ __forceinline__ void g_issue8(const unsigned char* TBs, unsigned lo, const u32x4 ix, u32x4 (&q)[8]) {
#pragma unroll
    for (int i = 0; i < 8; ++i) { const unsigned w = ix[i >> 1]; const unsigned e = (i & 1) ? (w >> 16) : (w & 0xffffu); q[i] = *(const u32x4*)(TBs + (e * 128u + lo)); }
}
struct GSide { u32x4 a, b, c, d; };
template <int PH> __device__ __forceinline__ GSide g_ldside(__amdgpu_buffer_rsrc_t SD, int t, int j, int m, int r8) {
    GSide r;
    if (PH == 0) { r.a = __builtin_amdgcn_raw_buffer_load_b128(SD, 32 * m, t * 2048 + 256 * j, 0); r.b = __builtin_amdgcn_raw_buffer_load_b128(SD, 32 * m + 16, t * 2048 + 256 * j, 0); r.c = r.a; r.d = r.b; }
    else { r.a = __builtin_amdgcn_raw_buffer_load_b128(SD, 64 * r8, t * 512, 0); r.b = __builtin_amdgcn_raw_buffer_load_b128(SD, 64 * r8 + 16, t * 512, 0); r.c = __builtin_amdgcn_raw_buffer_load_b128(SD, 64 * r8 + 32, t * 512, 0); r.d = __builtin_amdgcn_raw_buffer_load_b128(SD, 64 * r8 + 48, t * 512, 0); }
    return r;
}
template <int PH, int HALF> __device__ __forceinline__ void g_half(u32x4 (&q)[8], const GSide& sd, float (&pa)[16]) {
    if (PH == 0) {
        f32x2 x2[8];
        { const h16x8 xa = __builtin_bit_cast(h16x8, sd.a), xb = __builtin_bit_cast(h16x8, sd.b);
#pragma unroll
          for (int k = 0; k < 4; ++k) { x2[k] = (f32x2){(float)xa[2 * k], (float)xa[2 * k + 1]}; x2[4 + k] = (f32x2){(float)xb[2 * k], (float)xb[2 * k + 1]}; } }
#pragma unroll
        for (int i = 0; i < 8; ++i) { f32x2 d2[8]; dec16p(q[i], d2); f32x2 s2 = x2[0] * d2[0];
#pragma unroll
            for (int k = 1; k < 8; ++k) s2 = __builtin_elementwise_fma(x2[k], d2[k], s2);
            pa[8 * HALF + i] = s2[0] + s2[1];
            if (i + 1 < 8) asm volatile("" : "+v"(q[i + 1][0]), "+v"(q[i + 1][1]), "+v"(q[i + 1][2]), "+v"(q[i + 1][3])); }
    } else {
        f32x2 a2[8];
#pragma unroll
        for (int k = 0; k < 8; ++k) a2[k] = (f32x2){pa[2 * k], pa[2 * k + 1]};
#pragma unroll
        for (int i = 0; i < 8; ++i) { f32x2 d2[8]; dec16p(q[i], d2);
            const float cf = __uint_as_float(HALF == 0 ? (i < 4 ? sd.a[i & 3] : sd.b[i & 3]) : (i < 4 ? sd.c[i & 3] : sd.d[i & 3])); const f32x2 c2 = (f32x2){cf, cf};
#pragma unroll
            for (int k = 0; k < 8; ++k) a2[k] = __builtin_elementwise_fma(c2, d2[k], a2[k]);
            if (i + 1 < 8) asm volatile("" : "+v"(q[i + 1][0]), "+v"(q[i + 1][1]), "+v"(q[i + 1][2]), "+v"(q[i + 1][3]));
        }
#pragma unroll
        for (int k = 0; k < 8; ++k) { pa[2 * k] = a2[k][0]; pa[2 * k + 1] = a2[k][1]; }
    }
}
template <int PH> __device__ __forceinline__ void g_finish(const Args& a, __amdgpu_buffer_rsrc_t PRT, int t, int j, int lane, float (&p)[16]) {
    const int m = lane & 7, r8 = lane >> 3;
    float q8[8], q4[4], q2[2];
    if (PH == 0) {
#pragma unroll
        for (int i = 0; i < 8; ++i) { const float keep = (lane & 4) ? p[i + 8] : p[i], send = (lane & 4) ? p[i] : p[i + 8]; q8[i] = keep + xhm_(send); }
#pragma unroll
        for (int i = 0; i < 4; ++i) { const float keep = (lane & 2) ? q8[i + 4] : q8[i], send = (lane & 2) ? q8[i] : q8[i + 4]; q4[i] = keep + dpp_<0x4E>(send); }
#pragma unroll
        for (int i = 0; i < 2; ++i) { const float keep = (lane & 1) ? q4[i + 2] : q4[i], send = (lane & 1) ? q4[i] : q4[i + 2]; q2[i] = keep + dpp_<0xB1>(send); }
        { const h16x2 pv = (h16x2){(h16)q2[0], (h16)q2[1]}; __builtin_amdgcn_raw_buffer_store_b32(__builtin_bit_cast(unsigned, pv), PRT, (16 * r8 + 2 * m) * 2, (j * MTOK + t) * 256, 0); }
    } else {
#pragma unroll
        for (int i = 0; i < 8; ++i) { const float keep = (lane & 32) ? p[i + 8] : p[i], send = (lane & 32) ? p[i] : p[i + 8]; q8[i] = keep + x32_(send, lane); }
#pragma unroll
        for (int i = 0; i < 4; ++i) { const float keep = (lane & 16) ? q8[i + 4] : q8[i], send = (lane & 16) ? q8[i] : q8[i + 4]; q4[i] = keep + x16_(send, lane); }
#pragma unroll
        for (int i = 0; i < 2; ++i) { const float keep = (lane & 8) ? q4[i + 2] : q4[i], send = (lane & 8) ? q4[i] : q4[i + 2]; q2[i] = keep + x8_(send); }
        const int col = 128 * j + 16 * m + 2 * r8;
        const h16x2 h1v = *(const h16x2*)((const h16*)(a.ws + O_H1B) + (size_t)t * 1024 + col);
        const f32x2 hv = (f32x2){(float)h1v[0] + q2[0], (float)h1v[1] + q2[1]};
        *(h16x2*)((h16*)(a.ws + O_H2B) + (size_t)t * 1024 + col) = (h16x2){(h16)hv[0], (h16)hv[1]};
        const float ss = wave_sum(hv[0] * hv[0] + hv[1] * hv[1]);
        if (lane == 0) ((float*)(a.ws + O_SS2))[(size_t)t * 8 + j] = ss;
    }
}
template <int PH>
__device__ __forceinline__ void phase_gather(const Args& a, int cset) {
    const int tid = tid_(), lane = tid & 63, m = lane & 7, r8 = lane >> 3;
    unsigned* ctr = (unsigned*)(a.ws + O_CTR) + cset * 8 * 64;
    const __amdgpu_buffer_rsrc_t IDX = mkrsrc(a.ws + O_IDX), SDR = mkrsrc(a.ws + (PH ? O_COEF : O_H1B)), PRT = mkrsrc(a.ws + O_PART);
    const unsigned j0 = xcc_id();
    for (unsigned dj = 0; dj < 8; ++dj) {
        const unsigned j = (j0 + dj) & 7u;
        const unsigned char* TB = a.ws + (PH ? O_V8 : O_U8) + (size_t)j * 16384 * 128; const unsigned lo16 = 16u * (unsigned)m;
        for (;;) {
            unsigned c = 0; if (lane == 0) c = __hip_atomic_fetch_add(ctr + j * 64, 1u, __ATOMIC_RELAXED, __HIP_MEMORY_SCOPE_AGENT);
            c = (unsigned)__builtin_amdgcn_readfirstlane((int)c);
            if (c >= (unsigned)GA_NCH) break;
            const int t0 = c * GA_TC;
            u32x4 qa[8], qb[8]; GSide sd, sn; GIdx ix, ixn;
            ix = g_ldidx(IDX, t0, r8); g_issue8(TB, lo16, ix.a, qa); sd = g_ldside<PH>(SDR, t0, j, m, r8);
#pragma unroll 1
            for (int ti = 0; ti < GA_TC; ++ti) {
                const int t = t0 + ti, tn = (ti + 1 < GA_TC) ? t + 1 : t;
                g_issue8(TB, lo16, ix.b, qb); ixn = g_ldidx(IDX, tn, r8); sn = g_ldside<PH>(SDR, tn, j, m, r8);
                float p[16];
                if (PH == 1) {
#pragma unroll
                    for (int k = 0; k < 16; ++k) p[k] = 0.f;
                }
                if (PH == 0) __builtin_amdgcn_sched_barrier(0);
                g_half<PH, 0>(qa, sd, p);
                if (PH == 0) __builtin_amdgcn_sched_barrier(0);
                g_issue8(TB, lo16, ixn.a, qa);
                if (PH == 0) __builtin_amdgcn_sched_barrier(0);
                g_half<PH, 1>(qb, sd, p);
                g_finish<PH>(a, PRT, t, j, lane, p);
                ix = ixn; sd = sn;
            }
        }
    }
}
__device__ __forceinline__ void phase_coef(const Args& a) {
    const int tid = tid_();
    const h16* PART = (const h16*)(a.ws + O_PART); const unsigned short* IDX = (const unsigned short*)(a.ws + O_IDX);
    const float* GATE = (const float*)(a.ws + O_GATE); const float* RS1 = (const float*)(a.ws + O_RS1);
    const float* USC = (const float*)(a.ws + O_USC); const float* VSC = (const float*)(a.ws + O_VSC); float* COEF = (float*)(a.ws + O_COEF);
    for (int i = blockIdx.x * NTHREADS + tid; i < MTOK * 128; i += gridDim.x * NTHREADS) {
        float s = 0.f;
#pragma unroll
        for (int j = 0; j < 8; ++j) s += (float)PART[(size_t)j * MTOK * 128 + i];
        const unsigned e = IDX[i];
        COEF[i] = GATE[i] * gelu_tanh(RS1[i >> 7] * USC[e] * s) * VSC[e];
    }
}

__device__ __forceinline__ void phase_final(const Args& a) {
    const int tid = tid_(), lane = tid & 63, wave = tid >> 6;
    const int gw = blockIdx.x * NWAVES + wave, NGW = gridDim.x * NWAVES;
    const float* part = (const float*)(a.ws + O_PART3); const float* fg = a.in[28];
    f32x4 g4[4];
#pragma unroll
    for (int j = 0; j < 4; ++j) g4[j] = *((const f32x4*)fg + lane + 64 * j);
    for (int r = gw; r < MTOK; r += NGW) {
        float s = (lane < 16) ? part[(size_t)r * 16 + lane] : 0.f;
        s = wave_sum(s);
        const float rs = rsqrtf(s * (1.f / 1024.f) + NORM_EPS);
        f32x4* xr = (f32x4*)(a.out + (size_t)r * 1024) + lane;
#pragma unroll
        for (int j = 0; j < 4; ++j) xr[64 * j] = xr[64 * j] * rs * g4[j];
    }
}

constexpr int NPHASE = 19;
__global__ void __launch_bounds__(NTHREADS, 2) mk(Args a) {
    extern __shared__ __attribute__((aligned(16))) unsigned char smem[];
    LAS unsigned char* lds = (LAS unsigned char*)smem;
    unsigned char* ws = a.ws;
#if ONE_LAUNCH
    cg::grid_group grid = cg::this_grid();
    volatile LAS unsigned* bst = (volatile LAS unsigned*)(lds + 131072);
    if (threadIdx.x < 2) bst[threadIdx.x] = 0u;
    __syncthreads();
    const XcdBarrier xbar = xcd_barrier_post((unsigned*)(a.ws + O_BAR), bst);
    bool first_sync = true;
#define SYNC() do { if (first_sync) { grid.sync(); first_sync = false; } else xcd_barrier(xbar); } while (0)
#else
#define SYNC() do {} while (0)
#endif
#define IN(k) (a.ph_lo <= (k) && (k) < a.ph_hi)
#define SEAM(k) do { if (IN(k) && IN((k) + 1)) SYNC(); } while (0)
#define REPS(k) ((((REP_MASK) >> (k)) & 1u) ? 2 : 1)
    const int G = gridDim.x, bid = blockIdx.x;
    if (IN(0)) for (int rep = 0; rep < REPS(0); ++rep) { if (rep) SYNC(); phase_prep(a, lds); } SEAM(0);
    if (IN(1)) for (int rep = 0; rep < REPS(1); ++rep) { if (rep) SYNC(); pg8::Gemm g{(const h16*)(ws + O_XN), (const h16*)(ws + O_WIN), MTOK, NIN, 1024}; pg8::StaticOrder S; S.init(MTOK, NIN, G, bid);
        EpiZ E{(h16*)(ws + O_ZC), (h16*)(ws + O_ZR), (h16*)(ws + O_ZG)}; pg8::gemm_phase(lds, g, S, E); } SEAM(1);
    if (IN(2)) for (int rep = 0; rep < REPS(2); ++rep) { if (rep) SYNC(); phase_conv(a); phase_rwkv_prep(a); } SEAM(2);
    if (IN(3)) for (int rep = 0; rep < REPS(3); ++rep) { if (rep) SYNC(); pg8::Gemm g{(const h16*)(ws + O_APR), (const h16*)(ws + O_WLR), MTOK, 1536, 256}; pg8::StaticOrder S; S.init(MTOK, 1536, G, bid);
        h16* R = (h16*)a.out; h16* KS = R + (size_t)MTOK * 512; h16* KK = KS + (size_t)2 * MTOK * 512;
        EpiLR E{a.in[7], a.in[9], a.in[13], (h16*)(ws + O_WD), KS, (h16*)(ws + O_BD), (h16*)(ws + O_GG), KK}; pg8::gemm_phase(lds, g, S, E); } SEAM(3);
    if (IN(4)) for (int rep = 0; rep < REPS(4); ++rep) { if (rep) SYNC(); phase_ut_pre(a, lds); }
    SEAM(5);
    if (IN(6)) for (int rep = 0; rep < REPS(6); ++rep) { if (rep) SYNC(); phase_ut_seq(a, lds); } SEAM(6);
    if (IN(7)) for (int rep = 0; rep < REPS(7); ++rep) { if (rep) SYNC(); phase_rwkv_post(a); } SEAM(7);
    if (IN(8)) for (int rep = 0; rep < REPS(8); ++rep) { if (rep) SYNC(); pg8::Gemm g{(const h16*)(ws + O_CA), (const h16*)(ws + O_WA), MTOK, 1024, 512}; pg8::StaticOrder S; S.init(MTOK, 1024, G, bid);
        EpiYA E{(const h16*)(ws + O_ZG), (h16*)a.out}; pg8::gemm_phase(lds, g, S, E); } SEAM(8);
    if (IN(9)) for (int rep = 0; rep < REPS(9); ++rep) { if (rep) SYNC(); pg8::Gemm g{(const h16*)(ws + O_YB), (const h16*)(ws + O_WB), MTOK, 1024, 512}; pg8::StaticOrder S; S.init(MTOK, 1024, G, bid);
        EpiYB E{(const h16*)(ws + O_ZG), (const h16*)a.out, (h16*)(ws + O_MERGED)}; pg8::gemm_phase(lds, g, S, E); } SEAM(9);
    if (IN(10)) for (int rep = 0; rep < REPS(10); ++rep) { if (rep) SYNC(); pg8::Gemm g{(const h16*)(ws + O_MERGED), (const h16*)(ws + O_WO), MTOK, 1024, 1024}; pg8::StaticOrder S; S.init(MTOK, 1024, G, bid);
        EpiH1 E{a.in[0], (h16*)(ws + O_H1B), (float*)(ws + O_PART1)}; pg8::gemm_phase(lds, g, S, E); } SEAM(10);
    if (IN(11)) for (int rep = 0; rep < REPS(11); ++rep) { if (rep) SYNC(); pg8::Gemm g{(const h16*)(ws + O_H1B), (const h16*)(ws + O_WS), MTOK, 2048, 1024}; pg8::StaticOrder S; S.init(MTOK, 2048, G, bid);
        EpiF16 E{(h16*)(ws + O_SCORES), 2048}; pg8::gemm_phase(lds, g, S, E); } SEAM(11);
    if (IN(12)) for (int rep = 0; rep < REPS(12); ++rep) { if (rep) SYNC(); phase_topk(a, lds); } SEAM(12);
    if (IN(13)) for (int rep = 0; rep < REPS(13); ++rep) { if (rep) SYNC(); phase_gather<0>(a, 2 * rep); } SEAM(13);
    if (IN(14)) for (int rep = 0; rep < REPS(14); ++rep) { if (rep) SYNC(); phase_coef(a); } SEAM(14);
    if (IN(15)) for (int rep = 0; rep < REPS(15); ++rep) { if (rep) SYNC(); phase_gather<1>(a, 1 + 2 * rep); } SEAM(15);
    if (IN(16)) for (int rep = 0; rep < REPS(16); ++rep) { if (rep) SYNC(); pg8::Gemm g{(const h16*)(ws + O_P16), (const h16*)(ws + O_WP), MTOK, 1024, 256}; pg8::StaticOrder S; S.init(MTOK, 1024, G, bid);
        EpiF16 E{(h16*)(ws + O_PP), 1024}; pg8::gemm_phase(lds, g, S, E); } SEAM(16);
    if (IN(17)) for (int rep = 0; rep < REPS(17); ++rep) { if (rep) SYNC(); pg8::Gemm g{(const h16*)(ws + O_H2B), (const h16*)(ws + O_WG), MTOK, 1024, 1024}; pg8::StaticOrder S; S.init(MTOK, 1024, G, bid);
        EpiGate E{a.out, (const h16*)(ws + O_H2B), (const h16*)(ws + O_PP), (const float*)(ws + O_SS2), (float*)(ws + O_PART3)}; pg8::gemm_phase(lds, g, S, E); } SEAM(17);
    if (IN(18)) for (int rep = 0; rep < REPS(18); ++rep) { if (rep) SYNC(); phase_final(a); }
}

extern "C" void kernel_launch(void* const* d_in, const int* in_sizes, int n_in, void* d_out, int out_size, void* d_ws, size_t ws_size, hipStream_t stream) {
    static int ready = 0;
    if (!ready) {
        if (n_in != 29 || ws_size < WS_END) { fprintf(stderr, "kernel_launch: unexpected n_in %d / ws %zu (need %zu)\n", n_in, ws_size, (size_t)WS_END); ready = -1; return; }
        if (hipFuncSetAttribute((const void*)mk, hipFuncAttributeMaxDynamicSharedMemorySize, LDS_BYTES) != hipSuccess) { fprintf(stderr, "hipFuncSetAttribute failed\n"); ready = -1; return; }
        ready = 1;
    }
    if (ready < 0) return;
    Args a{};
    for (int i = 0; i < 29; ++i) a.in[i] = (const float*)d_in[i];
    a.out = (float*)d_out; a.ws = (unsigned char*)d_ws;
#if ONE_LAUNCH
    (void)hipMemsetAsync((unsigned char*)d_ws + O_BAR, 0, 16384, stream);
    a.ph_lo = 0; a.ph_hi = NPHASE;
    void* args[] = {&a};
    hipLaunchCooperativeKernel((const void*)mk, dim3(NBLK), dim3(NTHREADS), args, LDS_BYTES, stream);
#else
    const int phases[] = {0, 1, 2, 3, 4, 5, 6, 7, 8, 9, 10, 11, 12, 13, 14, 15, 16, 17, 18};
    for (int ph : phases) { a.ph_lo = ph; a.ph_hi = ph + 1; hipLaunchKernelGGL(mk, dim3(NBLK), dim3(NTHREADS), LDS_BYTES, stream, a); }
#endif
}
```

```cpp
#include <hip/hip_runtime.h>
#include <hip/hip_cooperative_groups.h>
#include <cstdio>
namespace cg = cooperative_groups;

#ifndef REP_MASK
#define REP_MASK 0u
#endif
#ifndef ONE_LAUNCH
#define ONE_LAUNCH 1
#endif

#define LAS __attribute__((address_space(3)))
typedef _Float16 h16;
typedef _Float16 h16x8 __attribute__((ext_vector_type(8)));
typedef _Float16 h16x4 __attribute__((ext_vector_type(4)));
typedef _Float16 h16x2 __attribute__((ext_vector_type(2)));
typedef float f32x4 __attribute__((ext_vector_type(4)));
typedef float f32x2 __attribute__((ext_vector_type(2)));
typedef unsigned u32x4 __attribute__((ext_vector_type(4)));
typedef unsigned u32x2 __attribute__((ext_vector_type(2)));

constexpr int MTOK = 65536, DM = 1024, SEQ = 8192, NB = 8;
constexpr int NIN = 5376;
constexpr int NTHREADS = 512, NWAVES = 8, NBLK = 256;
constexpr int LDS_BYTES = 131072 + 64;
constexpr float NORM_EPS = 1e-6f;

constexpr size_t MiB = 1u << 20;
constexpr size_t O_WIN = 0;
constexpr size_t O_WA = O_WIN + (size_t)5376 * 1024 * 2;
constexpr size_t O_WB = O_WA + 1 * MiB;
constexpr size_t O_WO = O_WB + 1 * MiB;
constexpr size_t O_WG = O_WO + 2 * MiB;
constexpr size_t O_WP = O_WG + 2 * MiB;
constexpr size_t O_WLR = O_WP + MiB / 2;
constexpr size_t O_WS = O_WLR + 3 * MiB / 4;
constexpr size_t O_U16 = O_WS + 4 * MiB;
constexpr size_t O_V16 = O_U16 + 32 * MiB;
constexpr size_t O_P16 = O_V16 + 32 * MiB;
constexpr size_t O_PART1 = O_P16 + 32 * MiB;
constexpr size_t O_PART3 = O_PART1 + 4 * MiB;
constexpr size_t O_RS1 = O_PART3 + 4 * MiB;
constexpr size_t O_RS2 = O_RS1 + MiB / 4;
constexpr size_t O_XN = O_RS2 + MiB / 4;
constexpr size_t O_ZC = O_XN + 128 * MiB;
constexpr size_t O_ZR = O_ZC + 192 * MiB;
constexpr size_t O_ZG = O_ZR + 224 * MiB;
constexpr size_t O_SS2 = O_ZG + 256 * MiB;
constexpr size_t O_USC = O_SS2 + 2 * MiB;
constexpr size_t O_VSC = O_USC + 65536;
constexpr size_t O_CTR = O_VSC + 65536;
constexpr size_t O_BAR = O_CTR + 8192;
constexpr size_t WS_END = O_BAR + 16384;
constexpr size_t O_U8 = O_U16;
constexpr size_t O_V8 = O_U16 + 16 * MiB;
constexpr size_t O_PART = O_ZG;
constexpr size_t O_COEF = O_ZR + 48 * MiB;
constexpr size_t O_CA = O_XN;
constexpr size_t O_APR = O_XN + 64 * MiB;
constexpr size_t O_H1B = O_XN;
constexpr size_t O_WD = O_ZC;
constexpr size_t O_BD = O_ZC + 64 * MiB;
constexpr size_t O_GG = O_ZC + 128 * MiB;
constexpr size_t O_MERGED = O_ZC;
constexpr size_t O_H2B = O_ZC;
constexpr size_t O_PQ = O_ZR;
constexpr size_t O_SST = O_ZR + 64 * MiB;
constexpr size_t O_Y = O_ZR + 96 * MiB;
constexpr size_t O_YB = O_ZR + 160 * MiB;
constexpr size_t O_IDX = O_ZR;
constexpr size_t O_GATE = O_ZR + 16 * MiB;
constexpr size_t O_PP = O_ZR + 64 * MiB;
constexpr size_t O_SCORES = O_ZG;

struct Args {
    const float* in[29];
    float* out;
    unsigned char* ws;
    int ph_lo, ph_hi;
};

__device__ __forceinline__ int tid_() { int t = threadIdx.x; asm volatile("" : "+v"(t)); return t; }
__device__ __forceinline__ float sigmoidf_(float x) { return __builtin_amdgcn_rcpf(1.0f + __expf(-x)); }
template <int CTRL> __device__ __forceinline__ float dpp_(float v) { return __builtin_bit_cast(float, __builtin_amdgcn_update_dpp(0, __builtin_bit_cast(int, v), CTRL, 0xF, 0xF, true)); }
__device__ __forceinline__ float x32_(float v, int lane) { const auto r = __builtin_amdgcn_permlane32_swap(__builtin_bit_cast(unsigned, v), __builtin_bit_cast(unsigned, v), false, false); return __builtin_bit_cast(float, (lane & 32) ? r[0] : r[1]); }
__device__ __forceinline__ float x16_(float v, int lane) { const auto r = __builtin_amdgcn_permlane16_swap(__builtin_bit_cast(unsigned, v), __builtin_bit_cast(unsigned, v), false, false); return __builtin_bit_cast(float, (lane & 16) ? r[0] : r[1]); }
__device__ __forceinline__ float x8_(float v) { return dpp_<0x128>(v); }
__device__ __forceinline__ float xhm_(float v) { return dpp_<0x141>(v); }
__device__ __forceinline__ float wave_sum(float v) {
    const int lane = threadIdx.x & 63;
    v += dpp_<0xB1>(v); v += dpp_<0x4E>(v); v += dpp_<0x141>(v); v += dpp_<0x140>(v);
    v += x16_(v, lane); v += x32_(v, lane);
    return v;
}
__device__ __forceinline__ __amdgpu_buffer_rsrc_t mkrsrc(const void* p) { return __builtin_amdgcn_make_buffer_rsrc((void*)p, 0, 0x7fffffff, 0x00020000); }
__device__ __forceinline__ h16x8 pack8(f32x4 a, f32x4 b) {
    h16x8 r;
    r[0] = (h16)a[0]; r[1] = (h16)a[1]; r[2] = (h16)a[2]; r[3] = (h16)a[3];
    r[4] = (h16)b[0]; r[5] = (h16)b[1]; r[6] = (h16)b[2]; r[7] = (h16)b[3];
    return r;
}
__device__ __forceinline__ h16x4 pack4(f32x4 a) {
    h16x4 r; r[0] = (h16)a[0]; r[1] = (h16)a[1]; r[2] = (h16)a[2]; r[3] = (h16)a[3]; return r;
}

#define XB_TMO      128
#define XB_XCNT(j)  (256  + 64 * (j))
#define XB_XSUB(j)  (1280 + 64 * (j))
#define XB_XGEN(j)  (2304 + 64 * (j))
#define XB_TOP      3328
#define XB_TOPGEN   3392
#define XCD_BAR_WORDS 3456
#define XB_SPIN_CAP (1u << 18)

__device__ __forceinline__ unsigned xb_ld(unsigned* p)              { return __hip_atomic_load(p, __ATOMIC_RELAXED, __HIP_MEMORY_SCOPE_AGENT); }
__device__ __forceinline__ unsigned xb_add(unsigned* p, unsigned v) { return __hip_atomic_fetch_add(p, v, __ATOMIC_RELAXED, __HIP_MEMORY_SCOPE_AGENT); }
__device__ __forceinline__ unsigned xb_xcc_id() { return (unsigned)__builtin_amdgcn_s_getreg((3 << 11) | 20) & 0xFu; }
#define XB_SPIN(cond, bar) do { unsigned _sp = 0; while (cond) { __builtin_amdgcn_s_sleep(1); \
    if ((++_sp & 255u) == 0u) { if (xb_ld(&(bar)[XB_TMO])) break; if (_sp > XB_SPIN_CAP) { atomicAdd(&(bar)[XB_TMO], 1u); break; } } } } while (0)

struct XcdBarrier {
    unsigned* bar; unsigned x;
    volatile LAS unsigned* st;
};

__device__ __forceinline__ XcdBarrier xcd_barrier_post(unsigned* bar, volatile LAS unsigned* st) {
    XcdBarrier b; b.bar = bar; b.x = xb_xcc_id(); b.st = st;
    if (threadIdx.x == 0) (void)xb_add(&bar[XB_XCNT(b.x)], 1u);
    return b;
}
__device__ __forceinline__ void xcd_barrier_complete(unsigned* bar, unsigned x, unsigned& nloc, unsigned& nx) {
    const unsigned G = gridDim.x * gridDim.y * gridDim.z;
    unsigned sum, cnt, mine, sp = 0u;
    for (;;) {
        sum = 0u; cnt = 0u; mine = 0u;
#pragma unroll
        for (unsigned j = 0; j < 16; ++j) { const unsigned c = xb_ld(&bar[XB_XCNT(j)]); sum += c; cnt += (c > 0u) ? 1u : 0u; mine = (j == x) ? c : mine; }
        if (sum == G) break;
        __builtin_amdgcn_s_sleep(1);
        if ((++sp & 255u) == 0u) { if (xb_ld(&bar[XB_TMO])) break; if (sp > XB_SPIN_CAP) { atomicAdd(&bar[XB_TMO], 1u); break; } }
    }
    nloc = mine > 0u ? mine : 1u; nx = cnt > 0u ? cnt : 1u;
}

__device__ __forceinline__ void xcd_barrier(const XcdBarrier& b) {
    asm volatile("s_waitcnt vmcnt(0)" ::: "memory");
    __syncthreads();
    if (threadIdx.x == 0) {
        unsigned* bar = b.bar;
        __builtin_amdgcn_s_waitcnt(0);
        unsigned nloc = b.st[0], nx = b.st[1];
        if (nloc == 0u) { xcd_barrier_complete(bar, b.x, nloc, nx); b.st[0] = nloc; b.st[1] = nx; }
        const unsigned old = xb_add(&bar[XB_XSUB(b.x)], 1u);
        const unsigned gen = old / nloc;
        if (old + 1u == (gen + 1u) * nloc) {
            __builtin_amdgcn_fence(__ATOMIC_RELEASE, "agent");
            asm volatile("s_waitcnt vmcnt(0)" ::: "memory");
            const unsigned og = xb_add(&bar[XB_TOP], 1u);
            const unsigned tg = og / nx;
            if (og + 1u == (tg + 1u) * nx) xb_add(&bar[XB_TOPGEN], 1u);
            else XB_SPIN(xb_ld(&bar[XB_TOPGEN]) == tg, bar);
            __builtin_amdgcn_fence(__ATOMIC_ACQUIRE, "agent");
            xb_add(&bar[XB_XGEN(b.x)], 1u);
            asm volatile("s_waitcnt vmcnt(0)" ::: "memory");
        } else {
            XB_SPIN(xb_ld(&bar[XB_XGEN(b.x)]) == gen, bar);
            __builtin_amdgcn_fence(__ATOMIC_ACQUIRE, "agent");
            asm volatile("s_waitcnt vmcnt(0)" ::: "memory");
        }
    }
    __syncthreads();
}


namespace pg8 {
constexpr int BM = 256, BK = 64, HALF = 128, HTB = HALF * BK * 2, STAGE_BYTES = 8 * HTB, NXCD = 8, WGM = 8;
__device__ __forceinline__ int lds_byte(int r, int c) { const int st = (r >> 4) * 2 + (c >> 5), rr = r & 15, cc = c & 31, ob = rr * 64 + cc * 2; return st * 1024 + (ob ^ (((ob >> 9) & 1) << 5)); }
__device__ __forceinline__ void stage_rc(int b, int& R, int& C) { const int st = b / 1024, sb = b % 1024, swz = sb ^ (((sb >> 9) & 1) << 5); R = (st >> 1) * 16 + swz / 64; C = (st & 1) * 32 + (swz % 64) / 2; }
__device__ __forceinline__ int perm32(int rho) { const int n = rho >> 4, i = rho & 15; return 8 * (i >> 2) + 4 * n + (i & 3); }

struct Unit { int pm, pn; };
struct Gemm { const h16* A; const h16* Bt; int M, N, K; };

struct StaticOrder {
    int nM, nN, nwg, G, c;
    __device__ void init(int M, int N, int G_, int c_) { nM = M / BM; nN = N / BM; nwg = nM * nN; G = G_; c = c_; }
    __device__ bool next(int i, Unit& u) const {
        const long L = (long)i * G + c; if (L >= nwg) return false;
        int wgid = (int)L; { const int q = nwg / NXCD, r = nwg % NXCD, xcd = wgid % NXCD, off = wgid / NXCD; wgid = (xcd < r ? xcd * (q + 1) : r * (q + 1) + (xcd - r) * q) + off; }
        const int nig = WGM * nN, gid = wgid / nig, fm = gid * WGM, gsz = (nM - fm) < WGM ? (nM - fm) : WGM;
        u.pm = fm + ((wgid % nig) % gsz); u.pn = (wgid % nig) / gsz; return true;
    }
};

template <class Epi>
__device__ __forceinline__ void gemm_phase(LAS unsigned char* lds, const Gemm g, const StaticOrder& S, const Epi& E) {
    const int tid = tid_(), wid = __builtin_amdgcn_readfirstlane(tid >> 6), lane = tid & 63, wr = wid >> 2, wc = wid & 3, fr = lane & 15, fq = lane >> 4;
    const int K = g.K, nt = K / BK;
    unsigned voffA[2], voffB[2];
#pragma unroll
    for (int i = 0; i < 2; ++i) { int R, C; stage_rc(tid * 16 + i * 8192, R, C); const int Rb = (R & ~31) + perm32(R & 31);
        voffA[i] = (unsigned)(R * K + C) * 2u; voffB[i] = (unsigned)(Rb * K + C) * 2u; }
    const size_t kstep = (size_t)(BK * 2);
    const size_t hstep = (size_t)HALF * K * 2;
    const size_t tstep = 2 * hstep;
    const unsigned ldsw = (unsigned)wid * 1024u;
    const int aoff = lds_byte(wr * 64 + fr, fq * 8), boff = lds_byte(wc * 32 + fr, fq * 8);
#define PG8_SA(b, h) (((b) * 2 + (h)) * HTB)
#define PG8_SB(b, h) ((4 + (b) * 2 + (h)) * HTB)
#define PG8_STAGE(bufoff, gbase, voff) do { _Pragma("unroll") for (int _i = 0; _i < 2; ++_i) \
        __builtin_amdgcn_global_load_lds((const unsigned*)((const char*)(gbase) + (voff)[_i]), (LAS unsigned*)(lds + (bufoff) + ldsw + _i * 8192), 16, 0, 0); } while (0)
#define PG8_LDA(dst, b, h) do { _Pragma("unroll") for (int m = 0; m < 4; ++m) _Pragma("unroll") for (int k = 0; k < 2; ++k) dst[m][k] = *(const LAS h16x8*)(lds + PG8_SA(b, h) + aoff + m * 2048 + k * 1024); } while (0)
#define PG8_LDB(dst, b, h) do { _Pragma("unroll") for (int n = 0; n < 2; ++n) _Pragma("unroll") for (int k = 0; k < 2; ++k) dst[n][k] = *(const LAS h16x8*)(lds + PG8_SB(b, h) + boff + n * 2048 + k * 1024); } while (0)
#define PG8_MMA(ai, bj, At, Bt) do { __builtin_amdgcn_s_setprio(1); _Pragma("unroll") for (int m = 0; m < 4; ++m) _Pragma("unroll") for (int n = 0; n < 2; ++n) _Pragma("unroll") for (int k = 0; k < 2; ++k) \
        acc[ai][bj][m][n] = __builtin_amdgcn_mfma_f32_16x16x32_f16(Bt[n][k], At[m][k], acc[ai][bj][m][n], 0, 0, 0); __builtin_amdgcn_s_setprio(0); } while (0)
#define PG8_WAIT_V(n) asm volatile("s_waitcnt vmcnt(" #n ")" ::: "memory")
#define PG8_WAIT_L(n) asm volatile("s_waitcnt lgkmcnt(" #n ")" ::: "memory")
#define PG8_BAR __builtin_amdgcn_s_barrier()
#define PG8_SCHED __builtin_amdgcn_sched_barrier(0)
    Unit cur, nxt; int ui = 0;
    if (!S.next(0, cur)) return;
    f32x4 acc[2][2][4][2];
#pragma unroll
    for (int a = 0; a < 2; ++a)
#pragma unroll
        for (int b = 0; b < 2; ++b)
#pragma unroll
            for (int m = 0; m < 4; ++m)
#pragma unroll
                for (int n = 0; n < 2; ++n) acc[a][b][m][n] = (f32x4){0.f, 0.f, 0.f, 0.f};
    h16x8 At[4][2], B0[2][2], B1[2][2];
    const char* cA = (const char*)g.A + (size_t)cur.pm * tstep; const char* cB = (const char*)g.Bt + (size_t)cur.pn * tstep;
    PG8_STAGE(PG8_SB(0, 0), cB, voffB); PG8_STAGE(PG8_SB(0, 1), cB + hstep, voffB); PG8_STAGE(PG8_SA(0, 0), cA, voffA); PG8_STAGE(PG8_SA(0, 1), cA + hstep, voffA);
    if (wr == 1) PG8_BAR;
    PG8_WAIT_V(2); PG8_BAR;
    PG8_STAGE(PG8_SB(1, 0), cB + kstep, voffB); PG8_STAGE(PG8_SA(1, 0), cA + kstep, voffA); PG8_STAGE(PG8_SB(1, 1), cB + hstep + kstep, voffB);
    PG8_WAIT_V(6); PG8_BAR;
    for (;;) {
        const bool has_next = S.next(ui + 1, nxt);
        const char* nA = has_next ? (const char*)g.A + (size_t)nxt.pm * tstep : cA; const char* nB = has_next ? (const char*)g.Bt + (size_t)nxt.pn * tstep : cB;
        for (int t = 0; t < nt; t += 2) {
            const bool last = (t == nt - 2);
            const char* a1 = cA + (size_t)(t + 1) * kstep;
            const char* a2 = last ? nA : cA + (size_t)(t + 2) * kstep; const char* b2 = last ? nB : cB + (size_t)(t + 2) * kstep;
            const char* a3 = a2 + kstep; const char* b3 = b2 + kstep;
            PG8_LDB(B0, 0, 0); PG8_LDB(B1, 0, 1); PG8_SCHED; PG8_LDA(At, 0, 0); PG8_STAGE(PG8_SA(1, 1), a1 + hstep, voffA);
            PG8_WAIT_V(8); PG8_WAIT_L(0); PG8_BAR; PG8_MMA(0, 0, At, B0); PG8_MMA(0, 1, At, B1); PG8_BAR; PG8_SCHED;
            PG8_LDA(At, 0, 1); PG8_STAGE(PG8_SB(0, 0), b2, voffB); PG8_STAGE(PG8_SB(0, 1), b2 + hstep, voffB); PG8_STAGE(PG8_SA(0, 0), a2, voffA);
            PG8_WAIT_V(8); PG8_WAIT_L(0); PG8_BAR; PG8_MMA(1, 0, At, B0); PG8_MMA(1, 1, At, B1); PG8_BAR; PG8_SCHED;
            PG8_LDB(B0, 1, 0); PG8_LDB(B1, 1, 1); PG8_SCHED; PG8_LDA(At, 1, 0); PG8_STAGE(PG8_SA(0, 1), a2 + hstep, voffA);
            PG8_WAIT_V(8); PG8_WAIT_L(0); PG8_BAR; PG8_MMA(0, 0, At, B0); PG8_MMA(0, 1, At, B1); PG8_BAR; PG8_SCHED;
            PG8_LDA(At, 1, 1); PG8_STAGE(PG8_SB(1, 0), b3, voffB); PG8_STAGE(PG8_SB(1, 1), b3 + hstep, voffB); PG8_STAGE(PG8_SA(1, 0), a3, voffA);
            PG8_WAIT_V(8); PG8_WAIT_L(0); PG8_BAR; PG8_MMA(1, 0, At, B0); PG8_MMA(1, 1, At, B1); PG8_BAR; PG8_SCHED;
        }
        if (wr == 0) PG8_BAR;
        E(acc, cur, wr, wc, fr, fq);
        if (!has_next) break;
#pragma unroll
        for (int a = 0; a < 2; ++a)
#pragma unroll
            for (int b = 0; b < 2; ++b)
#pragma unroll
                for (int m = 0; m < 4; ++m)
#pragma unroll
                    for (int n = 0; n < 2; ++n) acc[a][b][m][n] = (f32x4){0.f, 0.f, 0.f, 0.f};
        cur = nxt; cA = nA; cB = nB; ++ui;
        if (wr == 1) PG8_BAR;
    }
    PG8_WAIT_V(0);
    PG8_BAR;
#undef PG8_SA
#undef PG8_SB
#undef PG8_STAGE
#undef PG8_LDA
#undef PG8_LDB
#undef PG8_MMA
#undef PG8_WAIT_V
#undef PG8_WAIT_L
#undef PG8_BAR
#undef PG8_SCHED
}
}
using pg8::Unit;
typedef const f32x4 (&AccRef)[2][2][4][2];

#define EPI_LOOP_BEGIN \
    _Pragma("unroll") for (int ai = 0; ai < 2; ++ai) _Pragma("unroll") for (int m = 0; m < 4; ++m) { \
        const int row = u.pm * 256 + ai * 128 + wr * 64 + m * 16 + fr; \
        _Pragma("unroll") for (int bj = 0; bj < 2; ++bj) { \
            const int col = u.pn * 256 + bj * 128 + wc * 32 + 8 * fq; \
            const f32x4 v0 = acc[ai][bj][m][0], v1 = acc[ai][bj][m][1];
#define EPI_LOOP_END } }

struct EpiZ {
    h16 *zc, *zr, *zg;
    __device__ __forceinline__ void operator()(AccRef acc, const Unit& u, int wr, int wc, int fr, int fq) const {
        const int colt = u.pn * 256; h16* base; int ld, c0;
        if (colt < 1536) { base = zc; ld = 1536; c0 = colt; } else if (colt < 3328) { base = zr; ld = 1792; c0 = colt - 1536; } else { base = zg; ld = 2048; c0 = colt - 3328; }
        EPI_LOOP_BEGIN
            *(h16x8*)(base + (size_t)row * ld + (col - colt + c0)) = pack8(v0, v1);
        EPI_LOOP_END
    }
};
struct EpiF16 {
    h16* O; int ld;
    __device__ __forceinline__ void operator()(AccRef acc, const Unit& u, int wr, int wc, int fr, int fq) const {
        EPI_LOOP_BEGIN
            *(h16x8*)(O + (size_t)row * ld + col) = pack8(v0, v1);
        EPI_LOOP_END
    }
};
struct EpiYA {
    const h16* zg; h16* tmp;
    __device__ __forceinline__ void operator()(AccRef acc, const Unit& u, int wr, int wc, int fr, int fq) const {
        EPI_LOOP_BEGIN
            const h16x8 gv = *(const h16x8*)(zg + (size_t)row * 2048 + col);
            f32x4 o0, o1;
#pragma unroll
            for (int j = 0; j < 4; ++j) { o0[j] = sigmoidf_((float)gv[j]) * v0[j]; o1[j] = sigmoidf_((float)gv[4 + j]) * v1[j]; }
            *(h16x8*)(tmp + (size_t)row * 1024 + col) = pack8(o0, o1);
        EPI_LOOP_END
    }
};
struct EpiYB {
    const h16* zg; const h16* tmp; h16* merged;
    __device__ __forceinline__ void operator()(AccRef acc, const Unit& u, int wr, int wc, int fr, int fq) const {
        EPI_LOOP_BEGIN
            const h16x8 gv = *(const h16x8*)(zg + (size_t)row * 2048 + 1024 + col);
            const h16x8 tv = *(const h16x8*)(tmp + (size_t)row * 1024 + col);
            f32x4 o0, o1;
#pragma unroll
            for (int j = 0; j < 4; ++j) { o0[j] = (float)tv[j] + sigmoidf_((float)gv[j]) * v0[j]; o1[j] = (float)tv[4 + j] + sigmoidf_((float)gv[4 + j]) * v1[j]; }
            *(h16x8*)(merged + (size_t)row * 1024 + col) = pack8(o0, o1);
        EPI_LOOP_END
    }
};
struct EpiH1 {
    const float* x; h16* hb; float* part;
    __device__ __forceinline__ void operator()(AccRef acc, const Unit& u, int wr, int wc, int fr, int fq) const {
#pragma unroll
        for (int ai = 0; ai < 2; ++ai)
#pragma unroll
            for (int m = 0; m < 4; ++m) {
                const int row = u.pm * 256 + ai * 128 + wr * 64 + m * 16 + fr; float ss = 0.f;
#pragma unroll
                for (int bj = 0; bj < 2; ++bj) {
                    const int col = u.pn * 256 + bj * 128 + wc * 32 + 8 * fq;
                    const float* xp = x + (size_t)row * 1024 + col;
                    const f32x4 o0 = *(const f32x4*)xp + acc[ai][bj][m][0], o1 = *(const f32x4*)(xp + 4) + acc[ai][bj][m][1];
                    *(h16x8*)(hb + (size_t)row * 1024 + col) = pack8(o0, o1);
                    ss += (o0[0] * o0[0] + o0[1] * o0[1]) + (o0[2] * o0[2] + o0[3] * o0[3]) + (o1[0] * o1[0] + o1[1] * o1[1]) + (o1[2] * o1[2] + o1[3] * o1[3]);
                }
                ss += __shfl_xor(ss, 16); ss += __shfl_xor(ss, 32);
                if (fq == 0) part[(size_t)row * 16 + u.pn * 4 + wc] = ss;
            }
    }
};
struct EpiGate {
    h16* h3b; const h16* h2b; const h16* pp; const float* rs2; float* part;
    __device__ __forceinline__ void operator()(AccRef acc, const Unit& u, int wr, int wc, int fr, int fq) const {
#pragma unroll
        for (int ai = 0; ai < 2; ++ai)
#pragma unroll
            for (int m = 0; m < 4; ++m) {
                const int row = u.pm * 256 + ai * 128 + wr * 64 + m * 16 + fr; float ss = 0.f;
                const f32x4 sa = *(const f32x4*)(rs2 + (size_t)row * 8), sb = *(const f32x4*)(rs2 + (size_t)row * 8 + 4);
                const float rs = rsqrtf(((sa[0] + sa[1]) + (sa[2] + sa[3]) + (sb[0] + sb[1]) + (sb[2] + sb[3])) * (1.f / 1024.f) + NORM_EPS);
#pragma unroll
                for (int bj = 0; bj < 2; ++bj) {
                    const int col = u.pn * 256 + bj * 128 + wc * 32 + 8 * fq;
                    const h16x8 hv = *(const h16x8*)(h2b + (size_t)row * 1024 + col);
                    f32x4 o0 = (f32x4){(float)hv[0], (float)hv[1], (float)hv[2], (float)hv[3]}, o1 = (f32x4){(float)hv[4], (float)hv[5], (float)hv[6], (float)hv[7]};
                    const h16x8 pv = *(const h16x8*)(pp + (size_t)row * 1024 + col);
                    const f32x4 v0 = acc[ai][bj][m][0], v1 = acc[ai][bj][m][1];
#pragma unroll
                    for (int j = 0; j < 4; ++j) { o0[j] += sigmoidf_(rs * v0[j]) * (float)pv[j]; o1[j] += sigmoidf_(rs * v1[j]) * (float)pv[4 + j]; }
                    *(h16x8*)(h3b + (size_t)row * 1024 + col) = pack8(o0, o1);
                    ss += (o0[0] * o0[0] + o0[1] * o0[1]) + (o0[2] * o0[2] + o0[3] * o0[3]) + (o1[0] * o1[0] + o1[1] * o1[1]) + (o1[2] * o1[2] + o1[3] * o1[3]);
                }
                ss += __shfl_xor(ss, 16); ss += __shfl_xor(ss, 32);
                if (fq == 0) part[(size_t)row * 16 + u.pn * 4 + wc] = ss;
            }
    }
};

__device__ __forceinline__ void tr_item(const float* W, int N, const float* g, h16* WT, int ldk, int koff, int k0, int n0, LAS float* scr, int lane) {
#pragma unroll 8
    for (int i = 0; i < 32; ++i) { const int kk = 2 * i + (lane >> 5); float v = W[(size_t)(k0 + kk) * N + n0 + (lane & 31)]; if (g) v *= g[k0 + kk]; scr[kk * 33 + (lane & 31)] = v; }
    asm volatile("s_waitcnt lgkmcnt(0)" ::: "memory");
    const int c = lane & 7;
#pragma unroll
    for (int j = 0; j < 4; ++j) { const int n = (lane >> 3) + 8 * j; const LAS float* s = scr + (8 * c) * 33 + n;
        h16x8 o;
#pragma unroll
        for (int e = 0; e < 8; ++e) o[e] = (h16)s[e * 33];
        *(h16x8*)(WT + (size_t)(n0 + n) * ldk + koff + k0 + 8 * c) = o; }
    asm volatile("s_waitcnt lgkmcnt(0)" ::: "memory");
}
struct TrJob { const float* W; const float* g; h16* WT; int K, N, ldk, koff; };

__device__ __forceinline__ void phase_prep(const Args& a, LAS unsigned char* lds) {
    const int tid = tid_(), lane = tid & 63, wave = tid >> 6;
    const int gw = blockIdx.x * NWAVES + wave, NGW = gridDim.x * NWAVES;
    unsigned char* ws = a.ws;
    {
        LAS float* scr = (LAS float*)(lds + wave * 8704);
        TrJob jobs[9] = {
            {a.in[3], a.in[2], (h16*)(ws + O_WIN), 1024, NIN, 1024, 0},
            {a.in[17], nullptr, (h16*)(ws + O_WA), 512, 1024, 512, 0},
            {a.in[18], nullptr, (h16*)(ws + O_WB), 512, 1024, 512, 0},
            {a.in[19], nullptr, (h16*)(ws + O_WO), 1024, 1024, 1024, 0},
            {a.in[26], a.in[25], (h16*)(ws + O_WG), 1024, 1024, 1024, 0},
            {a.in[27], nullptr, (h16*)(ws + O_WP), 256, 1024, 256, 0},
            {a.in[8], nullptr, (h16*)(ws + O_WLR), 64, 512, 256, 0},
            {a.in[10], nullptr, (h16*)(ws + O_WLR) + (size_t)512 * 256, 64, 512, 256, 64},
            {a.in[11], nullptr, (h16*)(ws + O_WLR) + (size_t)1024 * 256, 128, 512, 256, 128},
        };
        int base = 0;
#pragma unroll
        for (int j = 0; j < 9; ++j) {
            const TrJob J = jobs[j]; const int nnb = J.N / 32, items = (J.K / 64) * nnb;
            int first = gw - (base % NGW); if (first < 0) first += NGW;
            for (int r = first; r < items; r += NGW) tr_item(J.W, J.N, J.g, J.WT, J.ldk, J.koff, (r / nnb) * 64, (r % nnb) * 32, scr, lane);
            base += items;
        }
        h16* wlr = (h16*)(ws + O_WLR);
        for (int i = blockIdx.x * NTHREADS + tid; i < 1536 * 256 / 8; i += gridDim.x * NTHREADS) {
            const int n = (i * 8) / 256, k = (i * 8) % 256; const int blk = n / 512;
            const bool inblk = (blk == 0) ? (k < 64) : (blk == 1) ? (k >= 64 && k < 128) : (k >= 128);
            if (!inblk) { h16x8 z; for (int e = 0; e < 8; ++e) z[e] = (h16)0.f; *(h16x8*)(wlr + (size_t)i * 8) = z; }
        }
    }
    __syncthreads();
    {
        LAS float* LA = (LAS float*)lds;
        LAS float* LB = (LAS float*)(lds + 64 * 129 * 4);
        const float* wq = a.in[21]; const float* sk = a.in[22]; const float* gf = a.in[20];
        h16* wst = (h16*)(ws + O_WS);
        for (int it = blockIdx.x; it < 256; it += gridDim.x) {
            const int g16 = it >> 4, k0 = (it & 15) * 64;
            for (int i = tid; i < 64 * 128; i += NTHREADS) { const int k = i >> 7, d = i & 127; LA[k * 129 + d] = wq[(size_t)(k0 + k) * 2048 + g16 * 128 + d] * gf[k0 + k]; }
            for (int i = tid; i < 128 * 128; i += NTHREADS) { const int n = i >> 7, d = i & 127; LB[n * 129 + d] = sk[((size_t)g16 * 128 + n) * 128 + d]; }
            __syncthreads();
            const int n = tid & 127, kg = tid >> 7;
            float o[16];
#pragma unroll
            for (int j = 0; j < 16; ++j) o[j] = 0.f;
            for (int d = 0; d < 128; ++d) { const float b = LB[n * 129 + d];
#pragma unroll
                for (int j = 0; j < 16; ++j) o[j] += LA[(kg * 16 + j) * 129 + d] * b; }
            h16x8 o0, o1;
#pragma unroll
            for (int j = 0; j < 8; ++j) { o0[j] = (h16)o[j]; o1[j] = (h16)o[8 + j]; }
            h16* dst = wst + (size_t)(g16 * 128 + n) * 1024 + k0 + kg * 16;
            *(h16x8*)dst = o0; *(h16x8*)(dst + 8) = o1;
            __syncthreads();
        }
    }
    {
        const float* gf = a.in[20];
        f32x4 g4[4];
#pragma unroll
        for (int j = 0; j < 4; ++j) g4[j] = *(const f32x4*)(gf + 16 * lane + 4 * j);
        for (int r = gw; r < 2 * 16384; r += NGW) {
            const int tb = r >> 14, e = r & 16383;
            const float* src = (tb ? a.in[24] : a.in[23]) + (size_t)e * 1024 + 16 * lane;
            f32x4 v[4]; float mx = 0.f;
#pragma unroll
            for (int j = 0; j < 4; ++j) { v[j] = *(const f32x4*)(src + 4 * j); if (!tb) v[j] = v[j] * g4[j];
#pragma unroll
                for (int c = 0; c < 4; ++c) mx = fmaxf(mx, fabsf(v[j][c])); }
#pragma unroll
            for (int o = 1; o < 64; o <<= 1) mx = fmaxf(mx, __shfl_xor(mx, o));
            mx = fmaxf(mx, 1e-30f);
            const float sc = 224.0f / mx;
            u32x4 q;
#pragma unroll
            for (int j = 0; j < 4; ++j) { int w = 0; w = __builtin_amdgcn_cvt_pk_fp8_f32(v[j][0] * sc, v[j][1] * sc, w, false); w = __builtin_amdgcn_cvt_pk_fp8_f32(v[j][2] * sc, v[j][3] * sc, w, true); q[j] = (unsigned)w; }
            unsigned char* dst = ws + (tb ? O_V8 : O_U8) + ((size_t)(lane >> 3) * 16384 + e) * 128 + 16 * (lane & 7);
            *(u32x4*)dst = q;
            if (lane == 0) ((float*)(ws + (tb ? O_VSC : O_USC)))[e] = mx * (1.0f / 224.0f);
        }
        if (blockIdx.x == 0 && tid < 32) ((unsigned*)(ws + O_CTR))[tid * 64] = 0u;
        const f32x4* pp = (const f32x4*)a.in[1]; h16x4* dp = (h16x4*)(ws + O_P16);
        const int np4 = MTOK * 256 / 4;
        for (int i = blockIdx.x * NTHREADS + tid; i < np4; i += gridDim.x * NTHREADS) dp[i] = pack4(pp[i]);
    }
    {
        const float* x = a.in[0]; h16* xn = (h16*)(ws + O_XN);
        for (int r = gw; r < MTOK; r += NGW) {
            const f32x4* xr = (const f32x4*)(x + (size_t)r * 1024) + lane;
            f32x4 v[4]; float s = 0.f;
#pragma unroll
            for (int j = 0; j < 4; ++j) { v[j] = xr[64 * j]; s += (v[j][0] * v[j][0] + v[j][1] * v[j][1]) + (v[j][2] * v[j][2] + v[j][3] * v[j][3]); }
            const float rs = rsqrtf(wave_sum(s) * (1.f / 1024.f) + NORM_EPS);
            h16x4* o = (h16x4*)(xn + (size_t)r * 1024) + lane;
#pragma unroll
            for (int j = 0; j < 4; ++j) o[64 * j] = pack4(v[j] * rs);
        }
    }
}

__device__ __forceinline__ void phase_conv(const Args& a) {
    const int tid = tid_(), lane = tid & 63, wave = tid >> 6;
    const int gw = blockIdx.x * NWAVES + wave, NGW = gridDim.x * NWAVES;
    const h16* zc = (const h16*)(a.ws + O_ZC); h16* ca = (h16*)(a.ws + O_CA);
    const float* cw = a.in[4]; const float* cb = a.in[5];
    float w0[8], w1[8], w2[8], bb[8];
#pragma unroll
    for (int j = 0; j < 8; ++j) { const int c = lane * 8 + j; w0[j] = cw[c]; w1[j] = cw[512 + c]; w2[j] = cw[1024 + c]; bb[j] = cb[c]; }
    for (int run = gw; run < MTOK / 32; run += NGW) {
        const int t0 = run * 32;
        float u1[8], u2[8];
        if ((t0 % SEQ) == 0) {
#pragma unroll
            for (int j = 0; j < 8; ++j) { u1[j] = 0.f; u2[j] = 0.f; }
        } else {
            const h16x8 c1 = *(const h16x8*)(zc + (size_t)(t0 - 1) * 1536 + 512 + lane * 8), x1 = *(const h16x8*)(zc + (size_t)(t0 - 1) * 1536 + 1024 + lane * 8);
            const h16x8 c2 = *(const h16x8*)(zc + (size_t)(t0 - 2) * 1536 + 512 + lane * 8), x2 = *(const h16x8*)(zc + (size_t)(t0 - 2) * 1536 + 1024 + lane * 8);
#pragma unroll
            for (int j = 0; j < 8; ++j) { u1[j] = (float)c1[j] * (float)x1[j]; u2[j] = (float)c2[j] * (float)x2[j]; }
        }
        for (int t = t0; t < t0 + 32; ++t) {
            const h16* zrow = zc + (size_t)t * 1536 + lane * 8;
            const h16x8 gb = *(const h16x8*)zrow, gc = *(const h16x8*)(zrow + 512), xi = *(const h16x8*)(zrow + 1024);
            h16x8 o;
#pragma unroll
            for (int j = 0; j < 8; ++j) { const float u0 = (float)gc[j] * (float)xi[j];
                const float y = w0[j] * u2[j] + w1[j] * u1[j] + w2[j] * u0 + bb[j];
                o[j] = (h16)((float)gb[j] * y); u2[j] = u1[j]; u1[j] = u0; }
            *(h16x8*)(ca + (size_t)t * 512 + lane * 8) = o;
        }
    }
}


__device__ __forceinline__ float tanhf_(float x) { return 1.0f - 2.0f * __builtin_amdgcn_rcpf(1.0f + __expf(2.0f * x)); }
__device__ __forceinline__ void phase_rwkv_prep(const Args& a) {
    const int tid = tid_(), lane = tid & 63, wave = tid >> 6;
    const int gw = blockIdx.x * NWAVES + wave, NGW = gridDim.x * NWAVES;
    const h16* zr = (const h16*)(a.ws + O_ZR);
    h16* R = (h16*)a.out; h16* KS = R + (size_t)MTOK * 512; h16* V = KS + (size_t)MTOK * 512; h16* KK = V + (size_t)MTOK * 512;
    h16* APR = (h16*)(a.ws + O_APR);
    const float* mu = a.in[6]; const float* k_k = a.in[12];
    float mr[8], mk[8], mv[8], mt[8], kk8[8];
#pragma unroll
    for (int j = 0; j < 8; ++j) { const int c = lane * 8 + j; mr[j] = mu[c]; mk[j] = mu[512 + c]; mv[j] = mu[1024 + c]; mt[j] = mu[1536 + (c & 255)]; kk8[j] = k_k[c]; }
    for (int run = gw; run < MTOK / 32; run += NGW) {
        const int t0 = run * 32;
        float pr[8], pk[8], pv[8], pt[8];
        if ((t0 % SEQ) == 0) {
#pragma unroll
            for (int j = 0; j < 8; ++j) { pr[j] = 0.f; pk[j] = 0.f; pv[j] = 0.f; pt[j] = 0.f; }
        } else {
            const h16* zp = zr + (size_t)(t0 - 1) * 1792 + lane * 8;
            const h16x8 a0 = *(const h16x8*)zp, a1 = *(const h16x8*)(zp + 512), a2 = *(const h16x8*)(zp + 1024), a3 = *(const h16x8*)(zr + (size_t)(t0 - 1) * 1792 + 1536 + (lane & 31) * 8);
#pragma unroll
            for (int j = 0; j < 8; ++j) { pr[j] = (float)a0[j]; pk[j] = (float)a1[j]; pv[j] = (float)a2[j]; pt[j] = (float)a3[j]; }
        }
        for (int t = t0; t < t0 + 32; ++t) {
            const h16* zp = zr + (size_t)t * 1792 + lane * 8;
            const h16x8 a0 = *(const h16x8*)zp, a1 = *(const h16x8*)(zp + 512), a2 = *(const h16x8*)(zp + 1024), a3 = *(const h16x8*)(zr + (size_t)t * 1792 + 1536 + (lane & 31) * 8);
            h16x8 orr, ok, ov, okk, ot; float kr[8]; float ss = 0.f;
#pragma unroll
            for (int j = 0; j < 8; ++j) {
                const float zr_ = (float)a0[j], zk_ = (float)a1[j], zv_ = (float)a2[j], zt_ = (float)a3[j];
                const float r = zr_ + mr[j] * (pr[j] - zr_), k = zk_ + mk[j] * (pk[j] - zk_), v = zv_ + mv[j] * (pv[j] - zv_), tl = zt_ + mt[j] * (pt[j] - zt_);
                pr[j] = zr_; pk[j] = zk_; pv[j] = zv_; pt[j] = zt_;
                orr[j] = (h16)r; ok[j] = (h16)k; ov[j] = (h16)v;
                kr[j] = k * kk8[j]; ss += kr[j] * kr[j];
                const float tv = (lane < 8) ? tanhf_(tl) : (lane < 16) ? tl : sigmoidf_(tl);
                ot[j] = (h16)tv;
            }
            ss += __shfl_xor(ss, 1); ss += __shfl_xor(ss, 2); ss += __shfl_xor(ss, 4);
            const float rn = rsqrtf(ss + 1e-12f);
#pragma unroll
            for (int j = 0; j < 8; ++j) okk[j] = (h16)(kr[j] * rn);
            const size_t o = (size_t)t * 512 + lane * 8;
            *(h16x8*)(R + o) = orr; *(h16x8*)(KS + o) = ok; *(h16x8*)(V + o) = ov; *(h16x8*)(KK + o) = okk;
            if (lane < 32) *(h16x8*)(APR + (size_t)t * 256 + lane * 8) = ot;
        }
    }
}

struct EpiLR {
    const float *w0, *a0, *k_a; h16 *WD, *KS, *BD, *GG; const h16* KK;
    __device__ __forceinline__ void operator()(AccRef acc, const Unit& u, int wr, int wc, int fr, int fq) const {
        const int part = u.pn >> 1;
        EPI_LOOP_BEGIN
            const int c = col - part * 512; const size_t o = (size_t)row * 512 + c;
            if (part == 0) {
                const f32x4 b0 = *(const f32x4*)(w0 + c), b1 = *(const f32x4*)(w0 + c + 4); f32x4 o0, o1;
#pragma unroll
                for (int j = 0; j < 4; ++j) { o0[j] = __expf(-0.6065306597126334f * sigmoidf_(b0[j] + v0[j])); o1[j] = __expf(-0.6065306597126334f * sigmoidf_(b1[j] + v1[j])); }
                *(h16x8*)(WD + o) = pack8(o0, o1);
            } else if (part == 1) {
                const f32x4 b0 = *(const f32x4*)(a0 + c), b1 = *(const f32x4*)(a0 + c + 4), ka0 = *(const f32x4*)(k_a + c), ka1 = *(const f32x4*)(k_a + c + 4);
                const h16x8 ks = *(const h16x8*)(KS + o), kk = *(const h16x8*)(KK + o); f32x4 k0, k1, bb0, bb1;
#pragma unroll
                for (int j = 0; j < 4; ++j) { const float aa0 = sigmoidf_(b0[j] + v0[j]), aa1 = sigmoidf_(b1[j] + v1[j]);
                    k0[j] = (float)ks[j] * (1.0f + (aa0 - 1.0f) * ka0[j]); k1[j] = (float)ks[4 + j] * (1.0f + (aa1 - 1.0f) * ka1[j]);
                    bb0[j] = aa0 * (float)kk[j]; bb1[j] = aa1 * (float)kk[4 + j]; }
                *(h16x8*)(KS + o) = pack8(k0, k1); *(h16x8*)(BD + o) = pack8(bb0, bb1);
            } else {
                *(h16x8*)(GG + o) = pack8(v0, v1);
            }
        EPI_LOOP_END
    }
};

constexpr int SC_L = 256, SC_NCH = SEQ / SC_L, SC_NB = 8;
constexpr int SC_STEP_F = 6 * 64;
constexpr int SC_WAVE_BYTES = SC_NB * SC_STEP_F * 4 + SC_NB * 64 * 4;
__device__ __forceinline__ float quad_sum(float v) { v += dpp_<0xB1>(v); v += dpp_<0x4E>(v); return v; }
__device__ __forceinline__ void lds_ld8x2(const LAS float* p, f32x2 (&o)[8]) {
#pragma unroll
    for (int j4 = 0; j4 < 4; ++j4) { const f32x4 t = *(const LAS f32x4*)(p + 4 * j4); o[2 * j4] = (f32x2){t[0], t[1]}; o[2 * j4 + 1] = (f32x2){t[2], t[3]}; }
}
template <int MODE>
__device__ __forceinline__ void scan_wave(const Args& a, LAS unsigned char* lds, int task) {
    const int tid = tid_(), lane = tid & 63, wave = tid >> 6;
    const int q = lane & 3, rg = lane >> 2;
    const int chain = task / SC_NCH, chunk = task % SC_NCH, b = chain >> 3, h = chain & 7;
    const size_t row0 = (size_t)b * SEQ + (size_t)chunk * SC_L;
    const h16* R = (const h16*)a.out; const h16* KS = R + (size_t)MTOK * 512; const h16* V = KS + (size_t)MTOK * 512; const h16* KK = V + (size_t)MTOK * 512;
    const h16* WD = (const h16*)(a.ws + O_WD); const h16* BD = (const h16*)(a.ws + O_BD);
    LAS float* buf = (LAS float*)(lds + wave * SC_WAVE_BYTES);
    LAS float* ybuf = buf + SC_NB * SC_STEP_F;
    constexpr int NA = (MODE == 0) ? 5 : (MODE == 1) ? 3 : 6;
    const h16* gp[NA]; int lo[NA];
#pragma unroll
    for (int j = 0; j < NA; ++j) { const int p = lane + 64 * j, seg = p >> 3, part = p & 7, st = seg / NA, ai = seg % NA;
        const int ar = (MODE == 0 && ai == 4) ? 5 : ai;
        const h16* base = (ar == 0) ? KK : (ar == 1) ? WD : (ar == 2) ? BD : (ar == 3) ? KS : (ar == 4) ? R : V;
        gp[j] = base + (row0 + st) * 512 + h * 64 + part * 8; lo[j] = st * SC_STEP_F + ar * 64 + part * 8; }
    f32x2 s[4][8];
    if (MODE == 0) {
#pragma unroll
        for (int i = 0; i < 4; ++i)
#pragma unroll
            for (int j = 0; j < 8; ++j) s[i][j] = (f32x2){0.f, 0.f};
    } else if (MODE == 1) {
#pragma unroll
        for (int i = 0; i < 4; ++i)
#pragma unroll
            for (int j = 0; j < 8; ++j) s[i][j] = (f32x2){(i == q && 2 * j == rg) ? 1.f : 0.f, (i == q && 2 * j + 1 == rg) ? 1.f : 0.f};
    } else {
        const float* S0 = (const float*)(a.ws + O_SST) + (size_t)task * 4096;
#pragma unroll
        for (int i = 0; i < 4; ++i)
#pragma unroll
            for (int j4 = 0; j4 < 4; ++j4) { const f32x4 t = *(const f32x4*)(S0 + (rg + 16 * i) * 64 + 16 * q + 4 * j4);
                s[i][2 * j4] = (f32x2){t[0], t[1]}; s[i][2 * j4 + 1] = (f32x2){t[2], t[3]}; }
    }
    h16x8 pre[NA];
#pragma unroll
    for (int j = 0; j < NA; ++j) pre[j] = *(const h16x8*)gp[j];
    f32x2 kk[8];
    for (int bt = 0; bt < SC_L / SC_NB; ++bt) {
        LAS float* cb = buf;
#pragma unroll
        for (int j = 0; j < NA; ++j) { f32x4 x0, x1;
#pragma unroll
            for (int e = 0; e < 4; ++e) { x0[e] = (float)pre[j][e]; x1[e] = (float)pre[j][4 + e]; }
            *(LAS f32x4*)(cb + lo[j]) = x0; *(LAS f32x4*)(cb + lo[j] + 4) = x1; }
        if (bt + 1 < SC_L / SC_NB) {
#pragma unroll
            for (int j = 0; j < NA; ++j) pre[j] = *(const h16x8*)(gp[j] + (size_t)(bt + 1) * SC_NB * 512);
        }
        lds_ld8x2(cb + 16 * q, kk);
#pragma unroll 2
        for (int st = 0; st < SC_NB; ++st) {
            const LAS float* sb = cb + st * SC_STEP_F;
            f32x2 w[8], bb[8], kx[8]; float vv[4];
            lds_ld8x2(sb + 64 + 16 * q, w); lds_ld8x2(sb + 128 + 16 * q, bb);
            if (MODE != 1) { lds_ld8x2(sb + 192 + 16 * q, kx);
#pragma unroll
                for (int i = 0; i < 4; ++i) vv[i] = sb[320 + rg + 16 * i]; }
            float us[4];
#pragma unroll
            for (int i = 0; i < 4; ++i) { f32x2 t = s[i][0] * kk[0];
#pragma unroll
                for (int j = 1; j < 8; ++j) t = __builtin_elementwise_fma(s[i][j], kk[j], t);
                us[i] = quad_sum(t[0] + t[1]); }
            if (st + 1 < SC_NB) lds_ld8x2(sb + SC_STEP_F + 16 * q, kk);
            f32x2 rr[8];
            if (MODE == 2) lds_ld8x2(sb + 256 + 16 * q, rr);
#pragma unroll
            for (int i = 0; i < 4; ++i) { const f32x2 nu = (f32x2){-us[i], -us[i]}, v2 = (f32x2){vv[i], vv[i]};
#pragma unroll
                for (int j = 0; j < 8; ++j) { f32x2 t = s[i][j] * w[j]; t = __builtin_elementwise_fma(nu, bb[j], t); if (MODE != 1) t = __builtin_elementwise_fma(v2, kx[j], t); s[i][j] = t; } }
            if (MODE == 2) {
#pragma unroll
                for (int i = 0; i < 4; ++i) { f32x2 t = s[i][0] * rr[0];
#pragma unroll
                    for (int j = 1; j < 8; ++j) t = __builtin_elementwise_fma(s[i][j], rr[j], t);
                    const float y = quad_sum(t[0] + t[1]);
                    if (q == 0) ybuf[st * 64 + rg + 16 * i] = y; }
            }
        }
        if (MODE == 2) {
            const int st = lane >> 3, part = lane & 7; h16x8 o;
#pragma unroll
            for (int e = 0; e < 8; ++e) o[e] = (h16)ybuf[st * 64 + part * 8 + e];
            *(h16x8*)((h16*)(a.ws + O_Y) + (row0 + (size_t)bt * SC_NB + st) * 512 + h * 64 + part * 8) = o;
        }
    }
    if (MODE != 2) {
        float* PQ = (float*)(a.ws + O_PQ) + (size_t)task * 8192 + (MODE == 0 ? 4096 : 0);
#pragma unroll
        for (int i = 0; i < 4; ++i)
#pragma unroll
            for (int j4 = 0; j4 < 4; ++j4) { const int o = (rg + 16 * i) * 64 + 16 * q + 4 * j4;
                *(f32x4*)(PQ + o) = (f32x4){s[i][2 * j4][0], s[i][2 * j4][1], s[i][2 * j4 + 1][0], s[i][2 * j4 + 1][1]}; }
    }
}
template <bool FIRST>
__device__ __forceinline__ void phase_scan(const Args& a, LAS unsigned char* lds) {
    const int wave = tid_() >> 6;
    if (FIRST) {
        for (int task = blockIdx.x * NWAVES + wave; task < 64 * SC_NCH; task += gridDim.x * NWAVES) { scan_wave<0>(a, lds, task); scan_wave<1>(a, lds, task); }
    } else {
        for (int task = blockIdx.x * NWAVES + wave; task < 64 * SC_NCH; task += gridDim.x * NWAVES) scan_wave<2>(a, lds, task);
    }
}

constexpr size_t O_VTB = O_ZR;
constexpr size_t O_BON = O_ZR + 64 * MiB;
constexpr int UT_WAVE_LDS = 15360;
typedef float f32x16 __attribute__((ext_vector_type(16)));
__device__ __forceinline__ size_t ut_ov(int j, int s) { return (size_t)(j >> 2) * 512 + (j & 3) * 16 + s; }
__device__ __forceinline__ void phase_ut_pre(const Args& a, LAS unsigned char* lds) {
    const int tid = tid_(), lane = tid & 63, wave = tid >> 6;
    const int gw = blockIdx.x * NWAVES + wave, NGW = gridDim.x * NWAVES;
    LAS unsigned char* Lb = lds + wave * UT_WAVE_LDS;
    LAS h16* YX = (LAS h16*)Lb;
    LAS float* GT = (LAS float*)(Lb + 9216);
    LAS float* TM = (LAS float*)(Lb + 13824);
    h16* R = (h16*)a.out; h16* KS = R + (size_t)MTOK * 512; h16* V = KS + (size_t)MTOK * 512; h16* KK = V + (size_t)MTOK * 512;
    h16* WD = (h16*)(a.ws + O_WD); h16* BD = (h16*)(a.ws + O_BD);
    h16* VTB = (h16*)(a.ws + O_VTB); float* BON = (float*)(a.ws + O_BON);
    for (int bh = gw; bh < 32768; bh += NGW) {
        int ln = lane; asm volatile("" : "+v"(ln)); const int r16 = ln & 15;
        const int h = bh & 7, nb = bh >> 3; const size_t tok0 = (size_t)nb * 16; const size_t e0 = tok0 * 512 + h * 64;
        const float rk = a.in[14][h * 64 + lane];
        {
            h16x8 stg[12];
#pragma unroll
            for (int j = 0; j < 12; ++j) { const int ar = j >> 1, row = (lane >> 3) + 8 * (j & 1);
                const h16* base = (ar == 0) ? WD : (ar == 1) ? KK : (ar == 2) ? BD : (ar == 3) ? KS : (ar == 4) ? R : V;
                stg[j] = *(const h16x8*)(base + e0 + (size_t)row * 512 + (lane & 7) * 8); }
#pragma unroll
            for (int j = 0; j < 12; ++j) *(LAS h16x8*)((LAS h16*)Lb + ((j >> 1) * 16 + (lane >> 3) + 8 * (j & 1)) * 64 + (lane & 7) * 8) = stg[j];
            asm volatile("s_waitcnt lgkmcnt(0)" ::: "memory");
        }
        float w[16], kk[16], bb[16], kx[16], rr[16]; h16x8 vt0, vt1;
        { const LAS h16* IN = (const LAS h16*)Lb;
#pragma unroll
        for (int t = 0; t < 16; ++t) { w[t] = (float)IN[t * 64 + lane]; kk[t] = (float)IN[(16 + t) * 64 + lane]; bb[t] = (float)IN[(32 + t) * 64 + lane]; kx[t] = (float)IN[(48 + t) * 64 + lane]; rr[t] = (float)IN[(64 + t) * 64 + lane];
            if (t < 8) vt0[t] = IN[(80 + t) * 64 + lane]; else vt1[t - 8] = IN[(80 + t) * 64 + lane]; } }
        asm volatile("s_waitcnt lgkmcnt(0)" ::: "memory");
        { h16* vp = VTB + (size_t)bh * 1024 + lane * 16; *(h16x8*)vp = vt0; *(h16x8*)(vp + 8) = vt1; }
        float bonv = 0.f;
#pragma unroll
        for (int t = 0; t < 16; ++t) { const float bs = wave_sum(rr[t] * kx[t] * rk); bonv = (ln == t) ? bs : bonv; }
        if (lane < 16) BON[(tok0 + lane) * 8 + h] = bonv;
        float Lt[16]; { float Lc = 0.f;
#pragma unroll
            for (int t = 0; t < 16; ++t) { Lc += __logf(w[t]); Lt[t] = Lc; } }
        const float Lref = Lt[7];
        float btil[16]; h16x8 kt0, kt1;
        LAS h16* OS = (LAS h16*)(Lb + 9216);
#pragma unroll
        for (int t = 0; t < 16; ++t) {
            const float Lp = t ? Lt[t - 1] : 0.f;
            const float ka = kk[t] * __expf(Lp - Lref), rt = rr[t] * __expf(Lt[t] - Lref), e2 = __expf(Lref - Lt[t]), bt = bb[t] * e2, kt = kx[t] * e2;
            YX[t * 72 + lane] = (h16)ka; YX[(16 + t) * 72 + lane] = (h16)rt; YX[(32 + t) * 72 + lane] = (h16)kt; YX[(48 + t) * 72 + lane] = (h16)bt;
            btil[t] = bt;
            OS[t * 64 + lane] = (h16)(kk[t] * __expf(Lp)); OS[(16 + t) * 64 + lane] = (h16)(rr[t] * __expf(Lt[t]));
            const float ktp = kx[t] * __expf(Lt[15] - Lt[t]);
            if (t < 8) kt0[t] = (h16)ktp; else kt1[t - 8] = (h16)ktp;
        }
        const float post = __expf(Lt[15] - Lref), w16 = __expf(Lt[15]);
        { h16* kp = KS + e0 + ut_ov(lane, 0); *(h16x8*)kp = kt0; *(h16x8*)(kp + 8) = kt1; }
        asm volatile("s_waitcnt lgkmcnt(0)" ::: "memory");
#pragma unroll
        for (int j = 0; j < 4; ++j) { const int row = (lane >> 3) + 8 * (j & 1); const h16x8 o8 = *(const LAS h16x8*)(OS + ((j >> 1) * 16 + row) * 64 + (lane & 7) * 8);
            *(h16x8*)(((j >> 1) ? R : KK) + e0 + (size_t)row * 512 + (lane & 7) * 8) = o8; }
        asm volatile("s_waitcnt lgkmcnt(0)" ::: "memory");
        f32x16 acc;
#pragma unroll
        for (int i = 0; i < 16; ++i) acc[i] = 0.f;
#pragma unroll
        for (int ks = 0; ks < 4; ++ks) {
            const h16x8 af = *(const LAS h16x8*)(YX + (lane & 31) * 72 + 8 * (lane >> 5) + 16 * ks), bf = *(const LAS h16x8*)(YX + (32 + (lane & 31)) * 72 + 8 * (lane >> 5) + 16 * ks);
            acc = __builtin_amdgcn_mfma_f32_32x32x16_f16(af, bf, acc, 0, 0, 0);
        }
#pragma unroll
        for (int i = 0; i < 16; ++i) GT[((i & 3) + 8 * (i >> 2) + 4 * (lane >> 5)) * 36 + (lane & 31)] = acc[i];
        asm volatile("s_waitcnt lgkmcnt(0)" ::: "memory");
        float T[16];
#pragma unroll
        for (int t = 0; t < 16; ++t) { float v = (r16 == t) ? 1.f : 0.f;
#pragma unroll
            for (int s2 = 0; s2 < t; ++s2) v -= T[s2] * GT[t * 36 + 16 + s2];
            T[t] = v; }
#pragma unroll
        for (int t = 0; t < 16; ++t) TM[r16 * 20 + t] = T[t];
        asm volatile("s_waitcnt lgkmcnt(0)" ::: "memory");
        float bcol[16];
#pragma unroll
        for (int s2 = 0; s2 < 16; ++s2) bcol[s2] = (s2 <= r16) ? GT[(16 + r16) * 36 + 16 + s2] : 0.f;
        h16x8 tb0, tb1, tp0, tp1;
#pragma unroll
        for (int r = 0; r < 16; ++r) { float s0 = 0.f, s1 = 0.f;
#pragma unroll
            for (int s2 = r; s2 < 16; ++s2) { const float tv = TM[r * 20 + s2]; s0 += tv * btil[s2]; s1 += tv * bcol[s2]; }
            s0 *= post;
            if (r < 8) { tb0[r] = (h16)s0; tp0[r] = (h16)s1; } else { tb1[r - 8] = (h16)s0; tp1[r - 8] = (h16)s1; } }
        { h16* bp = BD + e0 + ut_ov(lane, 0); *(h16x8*)bp = tb0; *(h16x8*)(bp + 8) = tb1; }
        if (lane < 16) {
            h16x8 a0, a1, p0, p1;
#pragma unroll
            for (int s2 = 0; s2 < 16; ++s2) { const float av = (s2 < ln) ? GT[ln * 36 + s2] : 0.f, pv = (s2 <= ln) ? GT[(16 + ln) * 36 + s2] : 0.f;
                if (s2 < 8) { a0[s2] = (h16)av; p0[s2] = (h16)pv; } else { a1[s2 - 8] = (h16)av; p1[s2 - 8] = (h16)pv; } }
            h16* ap = WD + e0 + (size_t)(lane >> 2) * 512 + (lane & 3) * 16;
            *(h16x8*)ap = a0; *(h16x8*)(ap + 8) = a1;
            *(h16x8*)(ap + 4 * 512) = p0; *(h16x8*)(ap + 4 * 512 + 8) = p1;
            *(h16x8*)(ap + 8 * 512) = tp0; *(h16x8*)(ap + 8 * 512 + 8) = tp1;
        }
        (WD + e0 + (size_t)12 * 512)[lane] = (h16)w16;
        asm volatile("s_waitcnt lgkmcnt(0)" ::: "memory");
    }
}
struct UtOps { u32x2 ka[2][2], rt[2][2], kt[4], tb[4], at, apt, tp, vb, w16[4]; };
struct UtRes { __amdgpu_buffer_rsrc_t kk, r, ks, bd, wd, vt, y; };
__device__ __forceinline__ void ut_load(UtOps& o, const UtRes& R, int so, unsigned offK, unsigned offT, unsigned offV, unsigned offF) {
#pragma unroll
    for (int ks = 0; ks < 2; ++ks)
#pragma unroll
        for (int p = 0; p < 2; ++p) { o.ka[ks][p] = __builtin_amdgcn_raw_buffer_load_b64(R.kk, offK + 64u * ks + 32u * p, so, 0); o.rt[ks][p] = __builtin_amdgcn_raw_buffer_load_b64(R.r, offK + 64u * ks + 32u * p, so, 0); }
#pragma unroll
    for (int kt = 0; kt < 4; ++kt) { o.kt[kt] = __builtin_amdgcn_raw_buffer_load_b64(R.ks, offT + 4096u * kt, so, 0); o.tb[kt] = __builtin_amdgcn_raw_buffer_load_b64(R.bd, offT + 4096u * kt, so, 0); }
    o.at = __builtin_amdgcn_raw_buffer_load_b64(R.wd, offT, so, 0); o.apt = __builtin_amdgcn_raw_buffer_load_b64(R.wd, offT + 4096u, so, 0); o.tp = __builtin_amdgcn_raw_buffer_load_b64(R.wd, offT + 8192u, so, 0);
    o.vb = __builtin_amdgcn_raw_buffer_load_b64(R.vt, offV, so, 0);
#pragma unroll
    for (int kt = 0; kt < 4; ++kt) o.w16[kt] = __builtin_amdgcn_raw_buffer_load_b64(R.wd, offF + 12u * 1024u + 32u * kt, so, 0);
}
__device__ __forceinline__ f32x4 h4f(u32x2 v) { const h16x4 h = __builtin_bit_cast(h16x4, v); return (f32x4){(float)h[0], (float)h[1], (float)h[2], (float)h[3]}; }
__device__ __forceinline__ h16x8 cat8(u32x2 lo, u32x2 hi) { u32x4 r; r[0] = lo[0]; r[1] = lo[1]; r[2] = hi[0]; r[3] = hi[1]; return __builtin_bit_cast(h16x8, r); }
__device__ __forceinline__ void ut_block(const UtOps& o, f32x4 (&S)[4], const UtRes& R, unsigned offY, int so) {
    const f32x4 zf = (f32x4){0.f, 0.f, 0.f, 0.f}; const u32x2 zu = (u32x2){0u, 0u};
    const h16x8 sb0 = pack8(S[0], S[1]), sb1 = pack8(S[2], S[3]);
    const h16x8 vb = cat8(o.vb, zu);
    f32x4 x1 = zf, y = zf;
    x1 = __builtin_amdgcn_mfma_f32_16x16x32_f16(cat8(o.ka[0][0], o.ka[0][1]), sb0, x1, 0, 0, 0); y = __builtin_amdgcn_mfma_f32_16x16x32_f16(cat8(o.rt[0][0], o.rt[0][1]), sb0, y, 0, 0, 0);
    x1 = __builtin_amdgcn_mfma_f32_16x16x32_f16(cat8(o.ka[1][0], o.ka[1][1]), sb1, x1, 0, 0, 0); y = __builtin_amdgcn_mfma_f32_16x16x32_f16(cat8(o.rt[1][0], o.rt[1][1]), sb1, y, 0, 0, 0);
    x1 = __builtin_amdgcn_mfma_f32_16x16x32_f16(cat8(o.at, zu), vb, x1, 0, 0, 0); y = __builtin_amdgcn_mfma_f32_16x16x32_f16(cat8(o.apt, zu), vb, y, 0, 0, 0);
    f32x4 St[4];
#pragma unroll
    for (int kt = 0; kt < 4; ++kt) St[kt] = __builtin_amdgcn_mfma_f32_16x16x32_f16(cat8(o.kt[kt], zu), vb, S[kt] * h4f(o.w16[kt]), 0, 0, 0);
    const h16x8 xb = pack8(-x1, zf);
    y = __builtin_amdgcn_mfma_f32_16x16x32_f16(cat8(o.tp, zu), xb, y, 0, 0, 0);
#pragma unroll
    for (int kt = 0; kt < 4; ++kt) S[kt] = __builtin_amdgcn_mfma_f32_16x16x32_f16(cat8(o.tb[kt], zu), xb, St[kt], 0, 0, 0);
#pragma unroll
    for (int rg = 0; rg < 4; ++rg) { const h16 hv = (h16)y[rg]; __builtin_amdgcn_raw_buffer_store_b16(__builtin_bit_cast(unsigned short, hv), R.y, offY + 1024u * rg, so, 0); }
}
__device__ __forceinline__ void phase_ut_seq(const Args& a, LAS unsigned char* lds) {
    const int tid = tid_(), lane = tid & 63, wave = tid >> 6, fr = lane & 15, fq = lane >> 4;
    volatile LAS int* prog = (volatile LAS int*)lds;
    if (tid == 0) *prog = 0;
    if (wave > 1) return;
    for (int item = blockIdx.x; item < 256; item += gridDim.x) {
        const int h = item & 7, q = item >> 3, g = q & 3, b = q >> 2;
        const size_t e0 = ((size_t)b * SEQ * 512 + h * 64) * 2;
        const char* Rb = (const char*)a.out + e0; const char* KSb = Rb + (size_t)MTOK * 1024; const char* KKb = Rb + (size_t)3 * MTOK * 1024;
        const char* WDb = (const char*)(a.ws + O_WD) + e0; const char* BDb = (const char*)(a.ws + O_BD) + e0;
        const char* VTb = (const char*)(a.ws + O_VTB) + ((size_t)b * (SEQ / 16) * 8 + h) * 2048;
        if (wave == 1) {
            const int ar = lane >> 4, row = lane & 15;
            const char* p0 = ((ar == 0) ? KKb : (ar == 1) ? Rb : (ar == 2) ? KSb : BDb) + (size_t)row * 1024;
            const char* p1 = (lane < 16) ? WDb + (size_t)row * 1024 : VTb + (size_t)(4 * g + (lane & 3)) * 128;
            for (int n0 = 0; n0 < SEQ / 16; n0 += 8) {
                int guard = 0;
                while (*prog + 16 < n0 && ++guard < (1 << 22)) __builtin_amdgcn_s_sleep(8);
                unsigned x[16];
#pragma unroll
                for (int i = 0; i < 8; ++i) { x[2 * i] = *(const unsigned*)(p0 + (size_t)(n0 + i) * 16384); x[2 * i + 1] = *(const unsigned*)(p1 + (size_t)(n0 + i) * 16384); }
#pragma unroll
                for (int i = 0; i < 16; ++i) asm volatile("" :: "v"(x[i]));
            }
            continue;
        }
        const unsigned offK = (unsigned)(fr * 1024 + 8 * fq), offT = (unsigned)((fr >> 2) * 512 + (fr & 3) * 16 + 4 * fq) * 2u, offV = (unsigned)((16 * g + fr) * 16 + 4 * fq) * 2u, offF = (unsigned)fq * 8u,
                       offY = (unsigned)((4 * fq) * 512 + 16 * g + fr) * 2u;
        UtRes RS; RS.kk = mkrsrc(KKb); RS.r = mkrsrc(Rb); RS.ks = mkrsrc(KSb); RS.bd = mkrsrc(BDb); RS.wd = mkrsrc(WDb); RS.vt = mkrsrc(VTb);
        RS.y = mkrsrc((const char*)(a.ws + O_Y) + e0);
        f32x4 S[4];
#pragma unroll
        for (int kt = 0; kt < 4; ++kt) S[kt] = (f32x4){0.f, 0.f, 0.f, 0.f};
        UtOps oa, ob, oc;
#define UT_LD(o, nn) ut_load(o, RS, ((nn) < SEQ / 16 ? (nn) : SEQ / 16 - 1) * 16384, offK, offT, offV, offF)
        UT_LD(oa, 0); UT_LD(ob, 1);
        int n = 0;
#pragma unroll 1
        for (; n + 3 <= SEQ / 16; n += 3) {
            if (lane == 0) *prog = n;
            UT_LD(oc, n + 2); ut_block(oa, S, RS, offY, n * 16384);
            UT_LD(oa, n + 3); ut_block(ob, S, RS, offY, (n + 1) * 16384);
            UT_LD(ob, n + 4); ut_block(oc, S, RS, offY, (n + 2) * 16384);
        }
        ut_block(oa, S, RS, offY, n * 16384); ut_block(ob, S, RS, offY, (n + 1) * 16384);
#undef UT_LD
    }
}

__device__ __forceinline__ void phase_scan_combine(const Args& a, LAS unsigned char* lds) {
    const int tid = tid_(), row = tid >> 5, cp = tid & 31;
    LAS float* LS = (LAS float*)lds;
    LAS float* LP = (LAS float*)(lds + 8192);
    for (int item = blockIdx.x; item < 64 * 4; item += gridDim.x) {
        const int chain = item >> 2, r0 = (item & 3) * 16;
        const float* PQ0 = (const float*)(a.ws + O_PQ) + (size_t)chain * SC_NCH * 8192;
        f32x2 sr = (f32x2){0.f, 0.f};
        f32x4 pa = *(const f32x4*)(PQ0 + tid * 8), pb = *(const f32x4*)(PQ0 + tid * 8 + 4);
        f32x2 qn = *(const f32x2*)(PQ0 + 4096 + (r0 + row) * 64 + 2 * cp);
        for (int c = 0; c < SC_NCH; ++c) {
            const int task = chain * SC_NCH + c;
            *(f32x2*)((float*)(a.ws + O_SST) + (size_t)task * 4096 + (r0 + row) * 64 + 2 * cp) = sr;
            if (c == SC_NCH - 1) break;
            LAS float* cur = LS + (c & 1) * 1024; LAS float* cp_ = LP + (c & 1) * 4096;
            *(LAS f32x2*)(cur + row * 64 + 2 * cp) = sr;
            *(LAS f32x4*)(cp_ + tid * 8) = pa; *(LAS f32x4*)(cp_ + tid * 8 + 4) = pb;
            f32x2 acc0 = qn, acc1 = (f32x2){0.f, 0.f};
            if (c + 2 < SC_NCH) { const float* Pn = PQ0 + (size_t)(c + 1) * 8192;
                pa = *(const f32x4*)(Pn + tid * 8); pb = *(const f32x4*)(Pn + tid * 8 + 4); qn = *(const f32x2*)(Pn + 4096 + (r0 + row) * 64 + 2 * cp); }
            __syncthreads();
#pragma unroll 16
            for (int k = 0; k < 64; k += 2) {
                const f32x2 sk = *(const LAS f32x2*)(cur + row * 64 + k);
                const f32x2 p0 = *(const LAS f32x2*)(cp_ + k * 64 + 2 * cp), p1 = *(const LAS f32x2*)(cp_ + (k + 1) * 64 + 2 * cp);
                acc0 = __builtin_elementwise_fma((f32x2){sk[0], sk[0]}, p0, acc0); acc1 = __builtin_elementwise_fma((f32x2){sk[1], sk[1]}, p1, acc1);
            }
            sr = acc0 + acc1;
        }
        __syncthreads();
    }
}
__device__ __forceinline__ void phase_rwkv_post(const Args& a) {
    const int tid = tid_(), lane = tid & 63, wave = tid >> 6;
    const int gw = blockIdx.x * NWAVES + wave, NGW = gridDim.x * NWAVES;
    const h16* V = (const h16*)a.out + (size_t)2 * MTOK * 512;
    const h16* GG = (const h16*)(a.ws + O_GG); const h16* Y = (const h16*)(a.ws + O_Y); h16* YB = (h16*)(a.ws + O_YB); const float* BON = (const float*)(a.ws + O_BON);
    float lg[8], lb[8];
#pragma unroll
    for (int j = 0; j < 8; ++j) { const int c = lane * 8 + j; lg[j] = a.in[15][c]; lb[j] = a.in[16][c]; }
    for (int t = gw; t < MTOK; t += NGW) {
        const size_t o = (size_t)t * 512 + lane * 8;
        const h16x8 y8 = *(const h16x8*)(Y + o), v8 = *(const h16x8*)(V + o), g8 = *(const h16x8*)(GG + o);
        const float bs = BON[(size_t)t * 8 + (lane >> 3)];
        float y[8]; float sm = 0.f;
#pragma unroll
        for (int j = 0; j < 8; ++j) { y[j] = (float)y8[j]; sm += y[j]; }
        sm += dpp_<0xB1>(sm); sm += dpp_<0x4E>(sm); sm += dpp_<0x141>(sm);
        const float mean = sm * (1.f / 64.f); float vs = 0.f;
#pragma unroll
        for (int j = 0; j < 8; ++j) { y[j] -= mean; vs += y[j] * y[j]; }
        vs += dpp_<0xB1>(vs); vs += dpp_<0x4E>(vs); vs += dpp_<0x141>(vs);
        const float rstd = rsqrtf(vs * (1.f / 64.f) + 64e-5f);
        h16x8 ov;
#pragma unroll
        for (int j = 0; j < 8; ++j) ov[j] = (h16)((y[j] * rstd * lg[j] + lb[j] + bs * (float)v8[j]) * (float)g8[j]);
        *(h16x8*)(YB + o) = ov;
    }
}

__device__ __forceinline__ void ins16(unsigned (&L)[16], unsigned x) {
#pragma unroll
    for (int j = 0; j < 16; ++j) { const unsigned hi = L[j] > x ? L[j] : x; x = L[j] > x ? x : L[j]; L[j] = hi; }
}
__device__ __forceinline__ unsigned ord32(float f) { const unsigned u = __float_as_uint(f); return (u & 0x80000000u) ? ~u : (u | 0x80000000u); }
__device__ __forceinline__ float unord32(unsigned k) { return __uint_as_float((k & 0x80000000u) ? (k & 0x7fffffffu) : ~k); }
__device__ __forceinline__ void phase_topk(const Args& a, LAS unsigned char* lds) {
    const int tid = tid_();
    const h16* SC = (const h16*)(a.ws + O_SCORES);
    const float* part = (const float*)(a.ws + O_PART1);
    unsigned short* IDX = (unsigned short*)(a.ws + O_IDX); float* GATE = (float*)(a.ws + O_GATE); float* RS1 = (float*)(a.ws + O_RS1);
    LAS unsigned char* LI = lds;
    for (int task = blockIdx.x * NTHREADS + tid; task < MTOK * 8; task += gridDim.x * NTHREADS) {
        const int t = task >> 3, h = task & 7;
        float ssq = 0.f;
#pragma unroll
        for (int j = 0; j < 4; ++j) { const f32x4 p4 = *(const f32x4*)(part + (size_t)t * 16 + 4 * j); ssq += (p4[0] + p4[1]) + (p4[2] + p4[3]); }
        const float rs = rsqrtf(ssq * (1.f / 1024.f) + NORM_EPS);
        if (h == 0) RS1[t] = rs;
        float sv[2][16];
#pragma unroll
        for (int c = 0; c < 2; ++c) {
            unsigned L[16];
#pragma unroll
            for (int j = 0; j < 16; ++j) L[j] = 0u;
            const h16* row = SC + (size_t)t * 2048 + h * 256 + c * 128;
#pragma unroll 2
            for (int n8 = 0; n8 < 16; ++n8) {
                const u32x4 w4 = *(const u32x4*)(row + n8 * 8);
#pragma unroll
                for (int e = 0; e < 8; ++e) {
                    const unsigned bits = (e & 1) ? (w4[e >> 1] >> 16) : (w4[e >> 1] & 0xffffu);
                    const unsigned o16 = (bits & 0x8000u) ? (~bits & 0xffffu) : (bits | 0x8000u);
                    ins16(L, (o16 << 16) | (unsigned)(127 - (n8 * 8 + e)));
                }
            }
#pragma unroll
            for (int j = 0; j < 16; ++j) {
                const unsigned o16 = L[j] >> 16; const unsigned bits = (o16 & 0x8000u) ? (o16 & 0x7fffu) : (~o16 & 0xffffu);
                union { unsigned short u; h16 f; } cv; cv.u = (unsigned short)bits; sv[c][j] = (float)cv.f;
                LI[(c * 16 + j) * 512 + tid] = (unsigned char)(127u - (L[j] & 127u));
            }
        }
        unsigned L[16];
#pragma unroll
        for (int j = 0; j < 16; ++j) L[j] = 0u;
#pragma unroll
        for (int i = 0; i < 16; ++i)
#pragma unroll
            for (int j = 0; j < 16; ++j) if ((i + 1) * (j + 1) <= 16) ins16(L, (ord32(sv[0][i] + sv[1][j]) & ~255u) | (unsigned)(255 - (i * 16 + j)));
        float e[16]; float den = 0.f; const float mx = unord32(L[0] & ~255u) * rs;
        unsigned short id[16];
#pragma unroll
        for (int k = 0; k < 16; ++k) {
            const float v = unord32(L[k] & ~255u) * rs; e[k] = __expf(v - mx); den += e[k];
            const unsigned pos = 255u - (L[k] & 255u); const unsigned i = pos >> 4, j = pos & 15u;
            id[k] = (unsigned short)((unsigned)LI[i * 512 + tid] * 128u + (unsigned)LI[(16 + j) * 512 + tid]);
        }
        const float inv = __builtin_amdgcn_rcpf(den);
        u32x4 i0, i1;
        i0[0] = id[0] | (id[1] << 16); i0[1] = id[2] | (id[3] << 16); i0[2] = id[4] | (id[5] << 16); i0[3] = id[6] | (id[7] << 16);
        i1[0] = id[8] | (id[9] << 16); i1[1] = id[10] | (id[11] << 16); i1[2] = id[12] | (id[13] << 16); i1[3] = id[14] | (id[15] << 16);
        u32x4* ip = (u32x4*)(IDX + (size_t)task * 16); ip[0] = i0; ip[1] = i1;
        f32x4* gp = (f32x4*)(GATE + (size_t)task * 16);
#pragma unroll
        for (int k4 = 0; k4 < 4; ++k4) gp[k4] = (f32x4){e[4 * k4] * inv, e[4 * k4 + 1] * inv, e[4 * k4 + 2] * inv, e[4 * k4 + 3] * inv};
    }
}

__device__ __forceinline__ float gelu_tanh(float x) { const float u = 0.7978845608028654f * (x + 0.044715f * x * x * x); return 0.5f * x * (1.0f + tanhf_(u)); }
__device__ __forceinline__ unsigned xcc_id() { return (unsigned)__builtin_amdgcn_s_getreg((3 << 11) | 20) & 7u; }
constexpr int GA_TC = 32, GA_NCH = MTOK / GA_TC;
__device__ __forceinline__ void dec16(const u32x4 q, float (&o)[16]) {
#pragma unroll
    for (int w = 0; w < 4; ++w) { const f32x2 lo = __builtin_amdgcn_cvt_pk_f32_fp8((int)q[w], false), hi = __builtin_amdgcn_cvt_pk_f32_fp8((int)q[w], true);
        o[4 * w] = lo[0]; o[4 * w + 1] = lo[1]; o[4 * w + 2] = hi[0]; o[4 * w + 3] = hi[1]; }
}
__device__ __forceinline__ void dec16p(const u32x4 q, f32x2 (&o)[8]) {
#pragma unroll
    for (int w = 0; w < 4; ++w) { o[2 * w] = __builtin_amdgcn_cvt_pk_f32_fp8((int)q[w], false); o[2 * w + 1] = __builtin_amdgcn_cvt_pk_f32_fp8((int)q[w], true); }
}
struct GIdx { u32x4 a, b; };
__device__ __forceinline__ GIdx g_ldidx(__amdgpu_buffer_rsrc_t IDX, int t, int r8) { GIdx r; r.a = __builtin_amdgcn_raw_buffer_load_b128(IDX, 32 * r8, t * 256, 0); r.b = __builtin_amdgcn_raw_buffer_load_b128(IDX, 32 * r8 + 16, t * 256, 0); return r; }
__device__ __forceinline__ void g_issue8(const unsigned char* TBs, unsigned lo, const u32x4 ix, u32x4 (&q)[8]) {
#pragma unroll
    for (int i = 0; i < 8; ++i) { const unsigned w = ix[i >> 1]; const unsigned e = (i & 1) ? (w >> 16) : (w & 0xffffu); q[i] = *(const u32x4*)(TBs + (e * 128u + lo)); }
}
struct GSide { u32x4 a, b, c, d; };
template <int PH> __device__ __forceinline__ GSide g_ldside(__amdgpu_buffer_rsrc_t SD, int t, int j, int m, int r8) {
    GSide r;
    if (PH == 0) { r.a = __builtin_amdgcn_raw_buffer_load_b128(SD, 32 * m, t * 2048 + 256 * j, 0); r.b = __builtin_amdgcn_raw_buffer_load_b128(SD, 32 * m + 16, t * 2048 + 256 * j, 0); r.c = r.a; r.d = r.b; }
    else { r.a = __builtin_amdgcn_raw_buffer_load_b128(SD, 64 * r8, t * 512, 0); r.b = __builtin_amdgcn_raw_buffer_load_b128(SD, 64 * r8 + 16, t * 512, 0); r.c = __builtin_amdgcn_raw_buffer_load_b128(SD, 64 * r8 + 32, t * 512, 0); r.d = __builtin_amdgcn_raw_buffer_load_b128(SD, 64 * r8 + 48, t * 512, 0); }
    return r;
}
template <int PH, int HALF> __device__ __forceinline__ void g_half(u32x4 (&q)[8], const GSide& sd, float (&pa)[16]) {
    if (PH == 0) {
        f32x2 x2[8];
        { const h16x8 xa = __builtin_bit_cast(h16x8, sd.a), xb = __builtin_bit_cast(h16x8, sd.b);
#pragma unroll
          for (int k = 0; k < 4; ++k) { x2[k] = (f32x2){(float)xa[2 * k], (float)xa[2 * k + 1]}; x2[4 + k] = (f32x2){(float)xb[2 * k], (float)xb[2 * k + 1]}; } }
#pragma unroll
        for (int i = 0; i < 8; ++i) { f32x2 d2[8]; dec16p(q[i], d2); f32x2 s2 = x2[0] * d2[0];
#pragma unroll
            for (int k = 1; k < 8; ++k) s2 = __builtin_elementwise_fma(x2[k], d2[k], s2);
            pa[8 * HALF + i] = s2[0] + s2[1];
            if (i + 1 < 8) asm volatile("" : "+v"(q[i + 1][0]), "+v"(q[i + 1][1]), "+v"(q[i + 1][2]), "+v"(q[i + 1][3])); }
    } else {
        f32x2 a2[8];
#pragma unroll
        for (int k = 0; k < 8; ++k) a2[k] = (f32x2){pa[2 * k], pa[2 * k + 1]};
#pragma unroll
        for (int i = 0; i < 8; ++i) { f32x2 d2[8]; dec16p(q[i], d2);
            const float cf = __uint_as_float(HALF == 0 ? (i < 4 ? sd.a[i & 3] : sd.b[i & 3]) : (i < 4 ? sd.c[i & 3] : sd.d[i & 3])); const f32x2 c2 = (f32x2){cf, cf};
#pragma unroll
            for (int k = 0; k < 8; ++k) a2[k] = __builtin_elementwise_fma(c2, d2[k], a2[k]);
            if (i + 1 < 8) asm volatile("" : "+v"(q[i + 1][0]), "+v"(q[i + 1][1]), "+v"(q[i + 1][2]), "+v"(q[i + 1][3]));
        }
#pragma unroll
        for (int k = 0; k < 8; ++k) { pa[2 * k] = a2[k][0]; pa[2 * k + 1] = a2[k][1]; }
    }
}
template <int PH> __device__ __forceinline__ void g_finish(const Args& a, __amdgpu_buffer_rsrc_t PRT, int t, int j, int lane, float (&p)[16]) {
    const int m = lane & 7, r8 = lane >> 3;
    float q8[8], q4[4], q2[2];
    if (PH == 0) {
#pragma unroll
        for (int i = 0; i < 8; ++i) { const float keep = (lane & 4) ? p[i + 8] : p[i], send = (lane & 4) ? p[i] : p[i + 8]; q8[i] = keep + xhm_(send); }
#pragma unroll
        for (int i = 0; i < 4; ++i) { const float keep = (lane & 2) ? q8[i + 4] : q8[i], send = (lane & 2) ? q8[i] : q8[i + 4]; q4[i] = keep + dpp_<0x4E>(send); }
#pragma unroll
        for (int i = 0; i < 2; ++i) { const float keep = (lane & 1) ? q4[i + 2] : q4[i], send = (lane & 1) ? q4[i] : q4[i + 2]; q2[i] = keep + dpp_<0xB1>(send); }
        { const h16x2 pv = (h16x2){(h16)q2[0], (h16)q2[1]}; __builtin_amdgcn_raw_buffer_store_b32(__builtin_bit_cast(unsigned, pv), PRT, (16 * r8 + 2 * m) * 2, (j * MTOK + t) * 256, 0); }
    } else {
#pragma unroll
        for (int i = 0; i < 8; ++i) { const float keep = (lane & 32) ? p[i + 8] : p[i], send = (lane & 32) ? p[i] : p[i + 8]; q8[i] = keep + x32_(send, lane); }
#pragma unroll
        for (int i = 0; i < 4; ++i) { const float keep = (lane & 16) ? q8[i + 4] : q8[i], send = (lane & 16) ? q8[i] : q8[i + 4]; q4[i] = keep + x16_(send, lane); }
#pragma unroll
        for (int i = 0; i < 2; ++i) { const float keep = (lane & 8) ? q4[i + 2] : q4[i], send = (lane & 8) ? q4[i] : q4[i + 2]; q2[i] = keep + x8_(send); }
        const int col = 128 * j + 16 * m + 2 * r8;
        const h16x2 h1v = *(const h16x2*)((const h16*)(a.ws + O_H1B) + (size_t)t * 1024 + col);
        const f32x2 hv = (f32x2){(float)h1v[0] + q2[0], (float)h1v[1] + q2[1]};
        *(h16x2*)((h16*)(a.ws + O_H2B) + (size_t)t * 1024 + col) = (h16x2){(h16)hv[0], (h16)hv[1]};
        const float ss = wave_sum(hv[0] * hv[0] + hv[1] * hv[1]);
        if (lane == 0) ((float*)(a.ws + O_SS2))[(size_t)t * 8 + j] = ss;
    }
}
template <int PH>
__device__ __forceinline__ void phase_gather(const Args& a, int cset) {
    const int tid = tid_(), lane = tid & 63, m = lane & 7, r8 = lane >> 3;
    unsigned* ctr = (unsigned*)(a.ws + O_CTR) + cset * 8 * 64;
    const __amdgpu_buffer_rsrc_t IDX = mkrsrc(a.ws + O_IDX), SDR = mkrsrc(a.ws + (PH ? O_COEF : O_H1B)), PRT = mkrsrc(a.ws + O_PART);
    const unsigned j0 = xcc_id();
    for (unsigned dj = 0; dj < 8; ++dj) {
        const unsigned j = (j0 + dj) & 7u;
        const unsigned char* TB = a.ws + (PH ? O_V8 : O_U8) + (size_t)j * 16384 * 128; const unsigned lo16 = 16u * (unsigned)m;
        for (;;) {
            unsigned c = 0; if (lane == 0) c = __hip_atomic_fetch_add(ctr + j * 64, 1u, __ATOMIC_RELAXED, __HIP_MEMORY_SCOPE_AGENT);
            c = (unsigned)__builtin_amdgcn_readfirstlane((int)c);
            if (c >= (unsigned)GA_NCH) break;
            const int t0 = c * GA_TC;
            u32x4 qa[8], qb[8]; GSide sd, sn; GIdx ix, ixn;
            ix = g_ldidx(IDX, t0, r8); g_issue8(TB, lo16, ix.a, qa); sd = g_ldside<PH>(SDR, t0, j, m, r8);
#pragma unroll 1
            for (int ti = 0; ti < GA_TC; ++ti) {
                const int t = t0 + ti, tn = (ti + 1 < GA_TC) ? t + 1 : t;
                g_issue8(TB, lo16, ix.b, qb); ixn = g_ldidx(IDX, tn, r8); sn = g_ldside<PH>(SDR, tn, j, m, r8);
                float p[16];
                if (PH == 1) {
#pragma unroll
                    for (int k = 0; k < 16; ++k) p[k] = 0.f;
                }
                if (PH == 0) __builtin_amdgcn_sched_barrier(0);
                g_half<PH, 0>(qa, sd, p);
                if (PH == 0) __builtin_amdgcn_sched_barrier(0);
                g_issue8(TB, lo16, ixn.a, qa);
                if (PH == 0) __builtin_amdgcn_sched_barrier(0);
                g_half<PH, 1>(qb, sd, p);
                g_finish<PH>(a, PRT, t, j, lane, p);
                ix = ixn; sd = sn;
            }
        }
    }
}
__device__ __forceinline__ void phase_coef(const Args& a) {
    const int tid = tid_();
    const h16* PART = (const h16*)(a.ws + O_PART); const unsigned short* IDX = (const unsigned short*)(a.ws + O_IDX);
    const float* GATE = (const float*)(a.ws + O_GATE); const float* RS1 = (const float*)(a.ws + O_RS1);
    const float* USC = (const float*)(a.ws + O_USC); const float* VSC = (const float*)(a.ws + O_VSC); float* COEF = (float*)(a.ws + O_COEF);
    for (int i = blockIdx.x * NTHREADS + tid; i < MTOK * 128; i += gridDim.x * NTHREADS) {
        float s = 0.f;
#pragma unroll
        for (int j = 0; j < 8; ++j) s += (float)PART[(size_t)j * MTOK * 128 + i];
        const unsigned e = IDX[i];
        COEF[i] = GATE[i] * gelu_tanh(RS1[i >> 7] * USC[e] * s) * VSC[e];
    }
}

__device__ __forceinline__ void phase_final(const Args& a) {
    const int tid = tid_(), lane = tid & 63, wave = tid >> 6;
    const int gw = blockIdx.x * NWAVES + wave, NGW = gridDim.x * NWAVES;
    const float* part = (const float*)(a.ws + O_PART3); const float* fg = a.in[28];
    f32x4 g4[4];
#pragma unroll
    for (int j = 0; j < 4; ++j) g4[j] = *((const f32x4*)fg + lane + 64 * j);
    const h16* h3b = (const h16*)(a.ws + O_XN);
    for (int r = gw; r < MTOK; r += NGW) {
        float s = (lane < 16) ? part[(size_t)r * 16 + lane] : 0.f;
        s = wave_sum(s);
        const float rs = rsqrtf(s * (1.f / 1024.f) + NORM_EPS);
        f32x4* xr = (f32x4*)(a.out + (size_t)r * 1024) + lane;
        const h16x4* hr = (const h16x4*)(h3b + (size_t)r * 1024) + lane;
#pragma unroll
        for (int j = 0; j < 4; ++j) { const h16x4 hv = hr[64 * j]; xr[64 * j] = (f32x4){(float)hv[0], (float)hv[1], (float)hv[2], (float)hv[3]} * rs * g4[j]; }
    }
}

constexpr int NPHASE = 19;
__global__ void __launch_bounds__(NTHREADS, 2) mk(Args a) {
    extern __shared__ __attribute__((aligned(16))) unsigned char smem[];
    LAS unsigned char* lds = (LAS unsigned char*)smem;
    unsigned char* ws = a.ws;
#if ONE_LAUNCH
    cg::grid_group grid = cg::this_grid();
    volatile LAS unsigned* bst = (volatile LAS unsigned*)(lds + 131072);
    if (threadIdx.x < 2) bst[threadIdx.x] = 0u;
    __syncthreads();
    const XcdBarrier xbar = xcd_barrier_post((unsigned*)(a.ws + O_BAR), bst);
    bool first_sync = true;
#define SYNC() do { if (first_sync) { grid.sync(); first_sync = false; } else xcd_barrier(xbar); } while (0)
#else
#define SYNC() do {} while (0)
#endif
#define IN(k) (a.ph_lo <= (k) && (k) < a.ph_hi)
#define SEAM(k) do { if (IN(k) && IN((k) + 1)) SYNC(); } while (0)
#define REPS(k) ((((REP_MASK) >> (k)) & 1u) ? 2 : 1)
    const int G = gridDim.x, bid = blockIdx.x;
    if (IN(0)) for (int rep = 0; rep < REPS(0); ++rep) { if (rep) SYNC(); phase_prep(a, lds); } SEAM(0);
    if (IN(1)) for (int rep = 0; rep < REPS(1); ++rep) { if (rep) SYNC(); pg8::Gemm g{(const h16*)(ws + O_XN), (const h16*)(ws + O_WIN), MTOK, NIN, 1024}; pg8::StaticOrder S; S.init(MTOK, NIN, G, bid);
        EpiZ E{(h16*)(ws + O_ZC), (h16*)(ws + O_ZR), (h16*)(ws + O_ZG)}; pg8::gemm_phase(lds, g, S, E); } SEAM(1);
    if (IN(2)) for (int rep = 0; rep < REPS(2); ++rep) { if (rep) SYNC(); phase_conv(a); phase_rwkv_prep(a); } SEAM(2);
    if (IN(3)) for (int rep = 0; rep < REPS(3); ++rep) { if (rep) SYNC(); pg8::Gemm g{(const h16*)(ws + O_APR), (const h16*)(ws + O_WLR), MTOK, 1536, 256}; pg8::StaticOrder S; S.init(MTOK, 1536, G, bid);
        h16* R = (h16*)a.out; h16* KS = R + (size_t)MTOK * 512; h16* KK = KS + (size_t)2 * MTOK * 512;
        EpiLR E{a.in[7], a.in[9], a.in[13], (h16*)(ws + O_WD), KS, (h16*)(ws + O_BD), (h16*)(ws + O_GG), KK}; pg8::gemm_phase(lds, g, S, E); } SEAM(3);
    if (IN(4)) for (int rep = 0; rep < REPS(4); ++rep) { if (rep) SYNC(); phase_ut_pre(a, lds); }
    SEAM(5);
    if (IN(6)) for (int rep = 0; rep < REPS(6); ++rep) { if (rep) SYNC(); phase_ut_seq(a, lds); } SEAM(6);
    if (IN(7)) for (int rep = 0; rep < REPS(7); ++rep) { if (rep) SYNC(); phase_rwkv_post(a); } SEAM(7);
    if (IN(8)) for (int rep = 0; rep < REPS(8); ++rep) { if (rep) SYNC(); pg8::Gemm g{(const h16*)(ws + O_CA), (const h16*)(ws + O_WA), MTOK, 1024, 512}; pg8::StaticOrder S; S.init(MTOK, 1024, G, bid);
        EpiYA E{(const h16*)(ws + O_ZG), (h16*)a.out}; pg8::gemm_phase(lds, g, S, E); } SEAM(8);
    if (IN(9)) for (int rep = 0; rep < REPS(9); ++rep) { if (rep) SYNC(); pg8::Gemm g{(const h16*)(ws + O_YB), (const h16*)(ws + O_WB), MTOK, 1024, 512}; pg8::StaticOrder S; S.init(MTOK, 1024, G, bid);
        EpiYB E{(const h16*)(ws + O_ZG), (const h16*)a.out, (h16*)(ws + O_MERGED)}; pg8::gemm_phase(lds, g, S, E); } SEAM(9);
    if (IN(10)) for (int rep = 0; rep < REPS(10); ++rep) { if (rep) SYNC(); pg8::Gemm g{(const h16*)(ws + O_MERGED), (const h16*)(ws + O_WO), MTOK, 1024, 1024}; pg8::StaticOrder S; S.init(MTOK, 1024, G, bid);
        EpiH1 E{a.in[0], (h16*)(ws + O_H1B), (float*)(ws + O_PART1)}; pg8::gemm_phase(lds, g, S, E); } SEAM(10);
    if (IN(11)) for (int rep = 0; rep < REPS(11); ++rep) { if (rep) SYNC(); pg8::Gemm g{(const h16*)(ws + O_H1B), (const h16*)(ws + O_WS), MTOK, 2048, 1024}; pg8::StaticOrder S; S.init(MTOK, 2048, G, bid);
        EpiF16 E{(h16*)(ws + O_SCORES), 2048}; pg8::gemm_phase(lds, g, S, E); } SEAM(11);
    if (IN(12)) for (int rep = 0; rep < REPS(12); ++rep) { if (rep) SYNC(); phase_topk(a, lds); } SEAM(12);
    if (IN(13)) for (int rep = 0; rep < REPS(13); ++rep) { if (rep) SYNC(); phase_gather<0>(a, 2 * rep); } SEAM(13);
    if (IN(14)) for (int rep = 0; rep < REPS(14); ++rep) { if (rep) SYNC(); phase_coef(a); } SEAM(14);
    if (IN(15)) for (int rep = 0; rep < REPS(15); ++rep) { if (rep) SYNC(); phase_gather<1>(a, 1 + 2 * rep); } SEAM(15);
    if (IN(16)) for (int rep = 0; rep < REPS(16); ++rep) { if (rep) SYNC(); pg8::Gemm g{(const h16*)(ws + O_P16), (const h16*)(ws + O_WP), MTOK, 1024, 256}; pg8::StaticOrder S; S.init(MTOK, 1024, G, bid);
        EpiF16 E{(h16*)(ws + O_PP), 1024}; pg8::gemm_phase(lds, g, S, E); } SEAM(16);
    if (IN(17)) for (int rep = 0; rep < REPS(17); ++rep) { if (rep) SYNC(); pg8::Gemm g{(const h16*)(ws + O_H2B), (const h16*)(ws + O_WG), MTOK, 1024, 1024}; pg8::StaticOrder S; S.init(MTOK, 1024, G, bid);
        EpiGate E{(h16*)(ws + O_XN), (const h16*)(ws + O_H2B), (const h16*)(ws + O_PP), (const float*)(ws + O_SS2), (float*)(ws + O_PART3)}; pg8::gemm_phase(lds, g, S, E); } SEAM(17);
    if (IN(18)) for (int rep = 0; rep < REPS(18); ++rep) { if (rep) SYNC(); phase_final(a); }
}

extern "C" void kernel_launch(void* const* d_in, const int* in_sizes, int n_in, void* d_out, int out_size, void* d_ws, size_t ws_size, hipStream_t stream) {
    static int ready = 0;
    if (!ready) {
        if (n_in != 29 || ws_size < WS_END) { fprintf(stderr, "kernel_launch: unexpected n_in %d / ws %zu (need %zu)\n", n_in, ws_size, (size_t)WS_END); ready = -1; return; }
        if (hipFuncSetAttribute((const void*)mk, hipFuncAttributeMaxDynamicSharedMemorySize, LDS_BYTES) != hipSuccess) { fprintf(stderr, "hipFuncSetAttribute failed\n"); ready = -1; return; }
        ready = 1;
    }
    if (ready < 0) return;
    Args a{};
    for (int i = 0; i < 29; ++i) a.in[i] = (const float*)d_in[i];
    a.out = (float*)d_out; a.ws = (unsigned char*)d_ws;
#if ONE_LAUNCH
    (void)hipMemsetAsync((unsigned char*)d_ws + O_BAR, 0, 16384, stream);
    a.ph_lo = 0; a.ph_hi = NPHASE;
    void* args[] = {&a};
    hipLaunchCooperativeKernel((const void*)mk, dim3(NBLK), dim3(NTHREADS), args, LDS_BYTES, stream);
#else
    const int phases[] = {0, 1, 2, 3, 4, 5, 6, 7, 8, 9, 10, 11, 12, 13, 14, 15, 16, 17, 18};
    for (int ph : phases) { a.ph_lo = ph; a.ph_hi = ph + 1; hipLaunchKernelGGL(mk, dim3(NBLK), dim3(NTHREADS), LDS_BYTES, stream, a); }
#endif
}
```

```cpp
#include <hip/hip_runtime.h>
#include <hip/hip_cooperative_groups.h>
#include <cstdio>
namespace cg = cooperative_groups;

#ifndef REP_MASK
#define REP_MASK 0u
#endif

#define LAS __attribute__((address_space(3)))
typedef _Float16 h16;
typedef _Float16 h16x8 __attribute__((ext_vector_type(8)));
typedef _Float16 h16x4 __attribute__((ext_vector_type(4)));
typedef _Float16 h16x2 __attribute__((ext_vector_type(2)));
typedef float f32x4 __attribute__((ext_vector_type(4)));
typedef float f32x2 __attribute__((ext_vector_type(2)));
typedef unsigned u32x4 __attribute__((ext_vector_type(4)));
typedef short s16x2 __attribute__((ext_vector_type(2)));
typedef unsigned u32x2 __attribute__((ext_vector_type(2)));

constexpr int MTOK = 65536, DM = 1024, SEQ = 8192, NB = 8;
constexpr int NIN = 5376;
constexpr int NTHREADS = 512, NWAVES = 8, NBLK = 256;
constexpr int LDS_BYTES = 131072 + 128 + 2 * 12288;
constexpr float NORM_EPS = 1e-6f;

constexpr size_t MiB = 1u << 20;
constexpr size_t O_WIN = 0;
constexpr size_t O_WA = O_WIN + (size_t)5376 * 1024 * 2;
constexpr size_t O_WB = O_WA + 1 * MiB;
constexpr size_t O_WO = O_WB + 1 * MiB;
constexpr size_t O_WG = O_WO + 2 * MiB;
constexpr size_t O_WP = O_WG + 2 * MiB;
constexpr size_t O_WLR = O_WP + MiB / 2;
constexpr size_t O_WS = O_WLR + 3 * MiB / 4;
constexpr size_t O_U16 = O_WS + 4 * MiB;
constexpr size_t O_V16 = O_U16 + 32 * MiB;
constexpr size_t O_P16 = O_V16 + 32 * MiB;
constexpr size_t O_PART1 = O_P16 + 32 * MiB;
constexpr size_t O_PART3 = O_PART1 + 4 * MiB;
constexpr size_t O_RS1 = O_PART3 + 4 * MiB;
constexpr size_t O_RS2 = O_RS1 + MiB / 4;
constexpr size_t O_XN = O_RS2 + MiB / 4;
constexpr size_t O_ZC = O_XN + 128 * MiB;
constexpr size_t O_ZR = O_ZC + 192 * MiB;
constexpr size_t O_ZG = O_ZR + 224 * MiB;
constexpr size_t O_SS2 = O_ZG + 256 * MiB;
constexpr size_t O_USC = O_SS2 + 2 * MiB;
constexpr size_t O_VSC = O_USC + 65536;
constexpr size_t O_CTR = O_VSC + 65536;
constexpr size_t O_BAR = O_CTR + 8192;
constexpr size_t O_SST2 = O_BAR + 16384;
constexpr size_t WS_END = O_SST2 + MiB;
constexpr size_t O_U8 = O_U16;
constexpr size_t O_V8 = O_U16 + 16 * MiB;
constexpr size_t O_PART = O_ZG;
constexpr size_t O_COEF = O_ZC + 128 * MiB;
constexpr size_t O_COEFS = O_COEF + 16 * MiB;
constexpr size_t O_CA = O_XN;
constexpr size_t O_APR = O_XN + 64 * MiB;
constexpr size_t O_H1B = O_XN;
constexpr size_t O_WD = O_ZC;
constexpr size_t O_BD = O_ZC + 64 * MiB;
constexpr size_t O_GG = O_ZC + 128 * MiB;
constexpr size_t O_MERGED = O_ZC;
constexpr size_t O_H2B = O_ZC;
constexpr size_t O_Y = O_ZR + 96 * MiB;
constexpr size_t O_YB = O_ZR + 160 * MiB;
constexpr size_t O_IDX = O_ZR;
constexpr size_t O_GATE = O_ZR + 16 * MiB;
constexpr size_t O_PP = O_ZR + 64 * MiB;
constexpr size_t O_SCORES = O_ZG;

struct Args {
    const float* in[29];
    float* out;
    unsigned char* ws;
    int ph_lo, ph_hi;
};

constexpr int LDS_WAVE_TAB = 131072 + 64;
extern __shared__ __attribute__((aligned(16))) unsigned char smem[];
__device__ __forceinline__ int lane_() { return (int)__builtin_amdgcn_mbcnt_hi(~0u, __builtin_amdgcn_mbcnt_lo(~0u, 0u)); }
__device__ __forceinline__ unsigned hw_slot_() { return (unsigned)__builtin_amdgcn_s_getreg((5 << 11) | 4) & 63u; }
__device__ __forceinline__ int tid_() {
    const int w = (int)((volatile LAS unsigned char*)((LAS unsigned char*)smem + LDS_WAVE_TAB))[hw_slot_()];
    int t = __builtin_amdgcn_readfirstlane(w) * 64 + lane_(); asm volatile("" : "+v"(t)); return t;
}
__device__ __forceinline__ float sigmoidf_(float x) { return __builtin_amdgcn_rcpf(1.0f + __expf(-x)); }
template <int CTRL> __device__ __forceinline__ float dpp_(float v) { return __builtin_bit_cast(float, __builtin_amdgcn_update_dpp(0, __builtin_bit_cast(int, v), CTRL, 0xF, 0xF, true)); }
__device__ __forceinline__ float x32_(float v, int lane) { const auto r = __builtin_amdgcn_permlane32_swap(__builtin_bit_cast(unsigned, v), __builtin_bit_cast(unsigned, v), false, false); return __builtin_bit_cast(float, (lane & 32) ? r[0] : r[1]); }
__device__ __forceinline__ float x16_(float v, int lane) { const auto r = __builtin_amdgcn_permlane16_swap(__builtin_bit_cast(unsigned, v), __builtin_bit_cast(unsigned, v), false, false); return __builtin_bit_cast(float, (lane & 16) ? r[0] : r[1]); }
__device__ __forceinline__ float swap_add32(float a, float b) { asm("s_nop 1\n\tv_permlane32_swap_b32 %0, %1" : "+v"(a), "+v"(b)); return a + b; }
__device__ __forceinline__ float swap_add16(float a, float b) { asm("s_nop 1\n\tv_permlane16_swap_b32 %0, %1" : "+v"(a), "+v"(b)); return a + b; }
__device__ __forceinline__ float x8_(float v) { return dpp_<0x128>(v); }
__device__ __forceinline__ float xhm_(float v) { return dpp_<0x141>(v); }
__device__ __forceinline__ float wave_sum(float v) {
    const int lane = lane_();
    v += dpp_<0xB1>(v); v += dpp_<0x4E>(v); v += dpp_<0x141>(v); v += dpp_<0x140>(v);
    v += x16_(v, lane); v += x32_(v, lane);
    return v;
}
__device__ __forceinline__ float wave_max(float v) {
    const int lane = lane_();
    v = fmaxf(v, dpp_<0xB1>(v)); v = fmaxf(v, dpp_<0x4E>(v)); v = fmaxf(v, dpp_<0x141>(v)); v = fmaxf(v, dpp_<0x140>(v));
    v = fmaxf(v, x16_(v, lane)); v = fmaxf(v, x32_(v, lane));
    return v;
}
__device__ __forceinline__ __amdgpu_buffer_rsrc_t mkrsrc(const void* p) { return __builtin_amdgcn_make_buffer_rsrc((void*)p, 0, 0x7fffffff, 0x00020000); }
__device__ __forceinline__ h16x8 pack8(f32x4 a, f32x4 b) {
    h16x8 r;
    r[0] = (h16)a[0]; r[1] = (h16)a[1]; r[2] = (h16)a[2]; r[3] = (h16)a[3];
    r[4] = (h16)b[0]; r[5] = (h16)b[1]; r[6] = (h16)b[2]; r[7] = (h16)b[3];
    return r;
}
__device__ __forceinline__ h16x4 pack4(f32x4 a) {
    h16x4 r; r[0] = (h16)a[0]; r[1] = (h16)a[1]; r[2] = (h16)a[2]; r[3] = (h16)a[3]; return r;
}

#define XB_TMO      128
#define XB_XCNT(j)  (256  + 64 * (j))
#define XB_XSUB(j)  (1280 + 64 * (j))
#define XB_XGEN(j)  (2304 + 64 * (j))
#define XB_TOP      3328
#define XB_TOPGEN   3392
#define XCD_BAR_WORDS 3456
#define XB_SPIN_CAP (1u << 18)

__device__ __forceinline__ unsigned xb_ld(unsigned* p)              { return __hip_atomic_load(p, __ATOMIC_RELAXED, __HIP_MEMORY_SCOPE_AGENT); }
__device__ __forceinline__ unsigned xb_add(unsigned* p, unsigned v) { return __hip_atomic_fetch_add(p, v, __ATOMIC_RELAXED, __HIP_MEMORY_SCOPE_AGENT); }
__device__ __forceinline__ unsigned xb_xcc_id() { return (unsigned)__builtin_amdgcn_s_getreg((3 << 11) | 20) & 0xFu; }
#define XB_SPIN(cond, bar) do { unsigned _sp = 0; while (cond) { __builtin_amdgcn_s_sleep(1); \
    if ((++_sp & 255u) == 0u) { if (xb_ld(&(bar)[XB_TMO])) break; if (_sp > XB_SPIN_CAP) { atomicAdd(&(bar)[XB_TMO], 1u); break; } } } } while (0)

struct XcdBarrier {
    unsigned* bar; unsigned x;
    volatile LAS unsigned* st;
};

__device__ __forceinline__ XcdBarrier xcd_barrier_post(unsigned* bar, volatile LAS unsigned* st) {
    XcdBarrier b; b.bar = bar; b.x = xb_xcc_id(); b.st = st;
    if (tid_() == 0) (void)xb_add(&bar[XB_XCNT(b.x)], 1u);
    return b;
}
__device__ __forceinline__ void xcd_barrier_complete(unsigned* bar, unsigned x, unsigned& nloc, unsigned& nx) {
    const unsigned G = gridDim.x * gridDim.y * gridDim.z;
    unsigned sum, cnt, mine, sp = 0u;
    for (;;) {
        sum = 0u; cnt = 0u; mine = 0u;
#pragma unroll
        for (unsigned j = 0; j < 16; ++j) { const unsigned c = xb_ld(&bar[XB_XCNT(j)]); sum += c; cnt += (c > 0u) ? 1u : 0u; mine = (j == x) ? c : mine; }
        if (sum == G) break;
        __builtin_amdgcn_s_sleep(1);
        if ((++sp & 255u) == 0u) { if (xb_ld(&bar[XB_TMO])) break; if (sp > XB_SPIN_CAP) { atomicAdd(&bar[XB_TMO], 1u); break; } }
    }
    nloc = mine > 0u ? mine : 1u; nx = cnt > 0u ? cnt : 1u;
}

__device__ __forceinline__ void xcd_barrier(const XcdBarrier& b) {
    asm volatile("s_waitcnt vmcnt(0)" ::: "memory");
    __syncthreads();
    if (tid_() == 0) {
        unsigned* bar = b.bar;
        __builtin_amdgcn_s_waitcnt(0);
        unsigned nloc = b.st[0], nx = b.st[1];
        if (nloc == 0u) { xcd_barrier_complete(bar, b.x, nloc, nx); b.st[0] = nloc; b.st[1] = nx; }
        const unsigned old = xb_add(&bar[XB_XSUB(b.x)], 1u);
        const unsigned gen = old / nloc;
        if (old + 1u == (gen + 1u) * nloc) {
            __builtin_amdgcn_fence(__ATOMIC_RELEASE, "agent");
            asm volatile("s_waitcnt vmcnt(0)" ::: "memory");
            const unsigned og = xb_add(&bar[XB_TOP], 1u);
            const unsigned tg = og / nx;
            if (og + 1u == (tg + 1u) * nx) xb_add(&bar[XB_TOPGEN], 1u);
            else XB_SPIN(xb_ld(&bar[XB_TOPGEN]) == tg, bar);
            __builtin_amdgcn_fence(__ATOMIC_ACQUIRE, "agent");
            xb_add(&bar[XB_XGEN(b.x)], 1u);
            asm volatile("s_waitcnt vmcnt(0)" ::: "memory");
        } else {
            XB_SPIN(xb_ld(&bar[XB_XGEN(b.x)]) == gen, bar);
            __builtin_amdgcn_fence(__ATOMIC_ACQUIRE, "agent");
            asm volatile("s_waitcnt vmcnt(0)" ::: "memory");
        }
    }
    __syncthreads();
}


namespace pg8 {
constexpr int BM = 256, BK = 64, HALF = 128, HTB = HALF * BK * 2, STAGE_BYTES = 8 * HTB, NXCD = 8, WGM = 8;
__device__ __forceinline__ int lds_byte(int r, int c) { const int st = (r >> 4) * 2 + (c >> 5), rr = r & 15, cc = c & 31, ob = rr * 64 + cc * 2; return st * 1024 + (ob ^ (((ob >> 9) & 1) << 5)); }
__device__ __forceinline__ void stage_rc(int b, int& R, int& C) { const int st = b / 1024, sb = b % 1024, swz = sb ^ (((sb >> 9) & 1) << 5); R = (st >> 1) * 16 + swz / 64; C = (st & 1) * 32 + (swz % 64) / 2; }
__device__ __forceinline__ int perm32(int rho) { const int n = rho >> 4, i = rho & 15; return 8 * (i >> 2) + 4 * n + (i & 3); }

struct Unit { int pm, pn; };
struct Gemm { const h16* A; const h16* Bt; int M, N, K; const h16* A2; const h16* Bt2; };

struct StaticOrder {
    int nM, nN, nwg, G, c;
    __device__ void init(int M, int N, int G_, int c_) { nM = M / BM; nN = N / BM; nwg = nM * nN; G = G_; c = c_; }
    __device__ bool next(int i, Unit& u) const {
        const long L = (long)i * G + c; if (L >= nwg) return false;
        int wgid = (int)L; { const int q = nwg / NXCD, r = nwg % NXCD, xcd = wgid % NXCD, off = wgid / NXCD; wgid = (xcd < r ? xcd * (q + 1) : r * (q + 1) + (xcd - r) * q) + off; }
        const int nig = WGM * nN, gid = wgid / nig, fm = gid * WGM, gsz = (nM - fm) < WGM ? (nM - fm) : WGM;
        u.pm = fm + ((wgid % nig) % gsz); u.pn = (wgid % nig) / gsz; return true;
    }
};

template <class Epi>
__device__ __forceinline__ void gemm_phase(LAS unsigned char* lds, const Gemm g, const StaticOrder& S, const Epi& E) {
    const int tid = tid_(), wid = __builtin_amdgcn_readfirstlane(tid >> 6), lane = tid & 63, wr = wid >> 2, wc = wid & 3, fr = lane & 15, fq = lane >> 4;
    const int K = g.K, nt = K / BK;
    unsigned voffA[2], voffB[2];
#pragma unroll
    for (int i = 0; i < 2; ++i) { int R, C; stage_rc(tid * 16 + i * 8192, R, C); const int Rb = (R & ~31) + perm32(R & 31);
        voffA[i] = (unsigned)(R * K + C) * 2u; voffB[i] = (unsigned)(Rb * K + C) * 2u; }
    const size_t kstep = (size_t)(BK * 2);
    const size_t hstep = (size_t)HALF * K * 2;
    const size_t tstep = 2 * hstep;
    const unsigned ldsw = (unsigned)wid * 1024u;
    const int aoff = lds_byte(wr * 64 + fr, fq * 8), boff = lds_byte(wc * 32 + fr, fq * 8);
#define PG8_SA(b, h) (((b) * 2 + (h)) * HTB)
#define PG8_SB(b, h) ((4 + (b) * 2 + (h)) * HTB)
#define PG8_STAGE(bufoff, gbase, voff) do { _Pragma("unroll") for (int _i = 0; _i < 2; ++_i) \
        __builtin_amdgcn_global_load_lds((const unsigned*)((const char*)(gbase) + (voff)[_i]), (LAS unsigned*)(lds + (bufoff) + ldsw + _i * 8192), 16, 0, 0); } while (0)
#define PG8_LDA(dst, b, h) do { _Pragma("unroll") for (int m = 0; m < 4; ++m) _Pragma("unroll") for (int k = 0; k < 2; ++k) dst[m][k] = *(const LAS h16x8*)(lds + PG8_SA(b, h) + aoff + m * 2048 + k * 1024); } while (0)
#define PG8_LDB(dst, b, h) do { _Pragma("unroll") for (int n = 0; n < 2; ++n) _Pragma("unroll") for (int k = 0; k < 2; ++k) dst[n][k] = *(const LAS h16x8*)(lds + PG8_SB(b, h) + boff + n * 2048 + k * 1024); } while (0)
#define PG8_MMA(ai, bj, At, Bt) do { __builtin_amdgcn_s_setprio(1); _Pragma("unroll") for (int m = 0; m < 4; ++m) _Pragma("unroll") for (int n = 0; n < 2; ++n) _Pragma("unroll") for (int k = 0; k < 2; ++k) \
        acc[ai][bj][m][n] = __builtin_amdgcn_mfma_f32_16x16x32_f16(Bt[n][k], At[m][k], acc[ai][bj][m][n], 0, 0, 0); __builtin_amdgcn_s_setprio(0); } while (0)
#define PG8_WAIT_V(n) asm volatile("s_waitcnt vmcnt(" #n ")" ::: "memory")
#define PG8_WAIT_L(n) asm volatile("s_waitcnt lgkmcnt(" #n ")" ::: "memory")
#define PG8_BAR __builtin_amdgcn_s_barrier()
#define PG8_SCHED __builtin_amdgcn_sched_barrier(0)
    Unit cur, nxt; int ui = 0;
    constexpr bool TP = Epi::TWO_PART;
    if (!S.next(0, cur)) return;
    f32x4 acc[2][2][4][2];
#pragma unroll
    for (int a = 0; a < 2; ++a)
#pragma unroll
        for (int b = 0; b < 2; ++b)
#pragma unroll
            for (int m = 0; m < 4; ++m)
#pragma unroll
                for (int n = 0; n < 2; ++n) acc[a][b][m][n] = (f32x4){0.f, 0.f, 0.f, 0.f};
    h16x8 At[4][2], B0[2][2], B1[2][2];
    const char* cA = (const char*)g.A + (size_t)cur.pm * tstep; const char* cB = (const char*)g.Bt + (size_t)cur.pn * tstep;
    PG8_STAGE(PG8_SB(0, 0), cB, voffB); PG8_STAGE(PG8_SB(0, 1), cB + hstep, voffB); PG8_STAGE(PG8_SA(0, 0), cA, voffA); PG8_STAGE(PG8_SA(0, 1), cA + hstep, voffA);
    if (wr == 1) PG8_BAR;
    PG8_WAIT_V(2); PG8_BAR;
    PG8_STAGE(PG8_SB(1, 0), cB + kstep, voffB); PG8_STAGE(PG8_SA(1, 0), cA + kstep, voffA); PG8_STAGE(PG8_SB(1, 1), cB + hstep + kstep, voffB);
    PG8_WAIT_V(6); PG8_BAR;
    for (;;) {
        const bool has_next = TP ? (((ui + 1) & 1) ? (nxt = cur, true) : S.next((ui + 1) >> 1, nxt)) : S.next(ui + 1, nxt);
        const h16* gA_n = (TP && ((ui + 1) & 1)) ? g.A2 : g.A; const h16* gB_n = (TP && ((ui + 1) & 1)) ? g.Bt2 : g.Bt;
        const char* nA = has_next ? (const char*)gA_n + (size_t)nxt.pm * tstep : cA; const char* nB = has_next ? (const char*)gB_n + (size_t)nxt.pn * tstep : cB;
        for (int t = 0; t < nt; t += 2) {
            const bool last = (t == nt - 2);
            const char* a1 = cA + (size_t)(t + 1) * kstep;
            const char* a2 = last ? nA : cA + (size_t)(t + 2) * kstep; const char* b2 = last ? nB : cB + (size_t)(t + 2) * kstep;
            const char* a3 = a2 + kstep; const char* b3 = b2 + kstep;
            PG8_LDB(B0, 0, 0); PG8_LDB(B1, 0, 1); PG8_SCHED; PG8_LDA(At, 0, 0); PG8_STAGE(PG8_SA(1, 1), a1 + hstep, voffA);
            PG8_WAIT_V(8); PG8_WAIT_L(0); PG8_BAR; PG8_MMA(0, 0, At, B0); PG8_MMA(0, 1, At, B1); PG8_BAR; PG8_SCHED;
            PG8_LDA(At, 0, 1); PG8_STAGE(PG8_SB(0, 0), b2, voffB); PG8_STAGE(PG8_SB(0, 1), b2 + hstep, voffB); PG8_STAGE(PG8_SA(0, 0), a2, voffA);
            PG8_WAIT_V(8); PG8_WAIT_L(0); PG8_BAR; PG8_MMA(1, 0, At, B0); PG8_MMA(1, 1, At, B1); PG8_BAR; PG8_SCHED;
            PG8_LDB(B0, 1, 0); PG8_LDB(B1, 1, 1); PG8_SCHED; PG8_LDA(At, 1, 0); PG8_STAGE(PG8_SA(0, 1), a2 + hstep, voffA);
            PG8_WAIT_V(8); PG8_WAIT_L(0); PG8_BAR; PG8_MMA(0, 0, At, B0); PG8_MMA(0, 1, At, B1); PG8_BAR; PG8_SCHED;
            PG8_LDA(At, 1, 1); PG8_STAGE(PG8_SB(1, 0), b3, voffB); PG8_STAGE(PG8_SB(1, 1), b3 + hstep, voffB); PG8_STAGE(PG8_SA(1, 0), a3, voffA);
            PG8_WAIT_V(8); PG8_WAIT_L(0); PG8_BAR; PG8_MMA(1, 0, At, B0); PG8_MMA(1, 1, At, B1); PG8_BAR; PG8_SCHED;
        }
        if (wr == 0) PG8_BAR;
        if constexpr (TP) { if ((ui & 1) == 0) E.mid(acc, cur, wr, wc, fr, fq); else E(acc, cur, wr, wc, fr, fq); } else E(acc, cur, wr, wc, fr, fq);
        if (!has_next) break;
        if (!(TP && (ui & 1) == 0))
#pragma unroll
        for (int a = 0; a < 2; ++a)
#pragma unroll
            for (int b = 0; b < 2; ++b)
#pragma unroll
                for (int m = 0; m < 4; ++m)
#pragma unroll
                    for (int n = 0; n < 2; ++n) acc[a][b][m][n] = (f32x4){0.f, 0.f, 0.f, 0.f};
        cur = nxt; cA = nA; cB = nB; ++ui;
        if (wr == 1) PG8_BAR;
    }
    PG8_WAIT_V(0);
    PG8_BAR;
#undef PG8_SA
#undef PG8_SB
#undef PG8_STAGE
#undef PG8_LDA
#undef PG8_LDB
#undef PG8_MMA
#undef PG8_WAIT_V
#undef PG8_WAIT_L
#undef PG8_BAR
#undef PG8_SCHED
}
}
using pg8::Unit;
typedef const f32x4 (&AccRef)[2][2][4][2];

#define EPI_LOOP_BEGIN \
    _Pragma("unroll") for (int ai = 0; ai < 2; ++ai) _Pragma("unroll") for (int m = 0; m < 4; ++m) { \
        const int row = u.pm * 256 + ai * 128 + wr * 64 + m * 16 + fr; \
        _Pragma("unroll") for (int bj = 0; bj < 2; ++bj) { \
            const int col = u.pn * 256 + bj * 128 + wc * 32 + 8 * fq; \
            const f32x4 v0 = acc[ai][bj][m][0], v1 = acc[ai][bj][m][1];
#define EPI_LOOP_END } }

struct EpiZ {
    static constexpr bool TWO_PART = false;
    h16 *zc, *zr, *zg;
    __device__ __forceinline__ void operator()(AccRef acc, const Unit& u, int wr, int wc, int fr, int fq) const {
        const int colt = u.pn * 256; h16* base; int ld, c0;
        if (colt < 1536) { base = zc; ld = 1536; c0 = colt; } else if (colt < 3328) { base = zr; ld = 1792; c0 = colt - 1536; } else { base = zg; ld = 2048; c0 = colt - 3328; }
        EPI_LOOP_BEGIN
            *(h16x8*)(base + (size_t)row * ld + (col - colt + c0)) = pack8(v0, v1);
        EPI_LOOP_END
    }
};
struct EpiF16 {
    static constexpr bool TWO_PART = false;
    h16* O; int ld;
    __device__ __forceinline__ void operator()(AccRef acc, const Unit& u, int wr, int wc, int fr, int fq) const {
        EPI_LOOP_BEGIN
            *(h16x8*)(O + (size_t)row * ld + col) = pack8(v0, v1);
        EPI_LOOP_END
    }
};
struct EpiMerged {
    static constexpr bool TWO_PART = true;
    const h16* zg; h16* merged;
    __device__ __forceinline__ void mid(f32x4 (&acc)[2][2][4][2], const Unit& u, int wr, int wc, int fr, int fq) const {
#pragma unroll
        for (int ai = 0; ai < 2; ++ai) {
            h16x8 gav[4][2], gbv[4][2];
#pragma unroll
            for (int m = 0; m < 4; ++m) { const int row = u.pm * 256 + ai * 128 + wr * 64 + m * 16 + fr;
#pragma unroll
                for (int bj = 0; bj < 2; ++bj) { const int col = u.pn * 256 + bj * 128 + wc * 32 + 8 * fq;
                    gav[m][bj] = *(const h16x8*)(zg + (size_t)row * 2048 + col); gbv[m][bj] = *(const h16x8*)(zg + (size_t)row * 2048 + 1024 + col); } }
#pragma unroll
            for (int m = 0; m < 4; ++m)
#pragma unroll
                for (int bj = 0; bj < 2; ++bj) { const h16x8 ga = gav[m][bj], gb = gbv[m][bj];
#pragma unroll
                    for (int j = 0; j < 4; ++j) {
                        acc[ai][bj][m][0][j] *= (1.0f + __expf(-(float)gb[j])) * __builtin_amdgcn_rcpf(1.0f + __expf(-(float)ga[j]));
                        acc[ai][bj][m][1][j] *= (1.0f + __expf(-(float)gb[4 + j])) * __builtin_amdgcn_rcpf(1.0f + __expf(-(float)ga[4 + j])); } }
        }
    }
    __device__ __forceinline__ void operator()(AccRef acc, const Unit& u, int wr, int wc, int fr, int fq) const {
#pragma unroll
        for (int ai = 0; ai < 2; ++ai) {
            h16x8 gvv[4][2];
#pragma unroll
            for (int m = 0; m < 4; ++m) { const int row = u.pm * 256 + ai * 128 + wr * 64 + m * 16 + fr;
#pragma unroll
                for (int bj = 0; bj < 2; ++bj) { const int col = u.pn * 256 + bj * 128 + wc * 32 + 8 * fq; gvv[m][bj] = *(const h16x8*)(zg + (size_t)row * 2048 + 1024 + col); } }
#pragma unroll
            for (int m = 0; m < 4; ++m) { const int row = u.pm * 256 + ai * 128 + wr * 64 + m * 16 + fr;
#pragma unroll
                for (int bj = 0; bj < 2; ++bj) { const int col = u.pn * 256 + bj * 128 + wc * 32 + 8 * fq;
                    const h16x8 gv = gvv[m][bj]; const f32x4 v0 = acc[ai][bj][m][0], v1 = acc[ai][bj][m][1];
                    f32x4 o0, o1;
#pragma unroll
                    for (int j = 0; j < 4; ++j) { o0[j] = sigmoidf_((float)gv[j]) * v0[j]; o1[j] = sigmoidf_((float)gv[4 + j]) * v1[j]; }
                    *(h16x8*)(merged + (size_t)row * 1024 + col) = pack8(o0, o1); } }
        }
    }
};
struct EpiH1 {
    static constexpr bool TWO_PART = false;
    const float* x; h16* hb; float* part;
    __device__ __forceinline__ void operator()(AccRef acc, const Unit& u, int wr, int wc, int fr, int fq) const {
#pragma unroll
        for (int ai = 0; ai < 2; ++ai) {
            f32x4 xv[4][2][2];
#pragma unroll
            for (int m = 0; m < 4; ++m) { const int row = u.pm * 256 + ai * 128 + wr * 64 + m * 16 + fr;
#pragma unroll
                for (int bj = 0; bj < 2; ++bj) { const int col = u.pn * 256 + bj * 128 + wc * 32 + 8 * fq; const float* xp = x + (size_t)row * 1024 + col;
                    xv[m][bj][0] = *(const f32x4*)xp; xv[m][bj][1] = *(const f32x4*)(xp + 4); } }
#pragma unroll
            for (int m = 0; m < 4; ++m) {
                const int row = u.pm * 256 + ai * 128 + wr * 64 + m * 16 + fr; float ss = 0.f;
#pragma unroll
                for (int bj = 0; bj < 2; ++bj) {
                    const int col = u.pn * 256 + bj * 128 + wc * 32 + 8 * fq;
                    const f32x4 o0 = xv[m][bj][0] + acc[ai][bj][m][0], o1 = xv[m][bj][1] + acc[ai][bj][m][1];
                    *(h16x8*)(hb + (size_t)row * 1024 + col) = pack8(o0, o1);
                    ss += (o0[0] * o0[0] + o0[1] * o0[1]) + (o0[2] * o0[2] + o0[3] * o0[3]) + (o1[0] * o1[0] + o1[1] * o1[1]) + (o1[2] * o1[2] + o1[3] * o1[3]);
                }
                { const int ln_ = fr + 16 * fq; ss += x16_(ss, ln_); ss += x32_(ss, ln_); }
                if (fq == 0) part[(size_t)row * 16 + u.pn * 4 + wc] = ss;
            }
        }
    }
};
struct EpiGate {
    static constexpr bool TWO_PART = false;
    h16* h3b; const h16* h2b; const h16* pp; const float* rs2; float* part;
    __device__ __forceinline__ void operator()(AccRef acc, const Unit& u, int wr, int wc, int fr, int fq) const {
#pragma unroll
        for (int ai = 0; ai < 2; ++ai) {
            float rsv[4]; h16x8 hvv[4][2], pvv[4][2];
            { f32x4 sav[4], sbv[4];
#pragma unroll
              for (int m = 0; m < 4; ++m) { const int row = u.pm * 256 + ai * 128 + wr * 64 + m * 16 + fr; sav[m] = *(const f32x4*)(rs2 + (size_t)row * 8); sbv[m] = *(const f32x4*)(rs2 + (size_t)row * 8 + 4); }
#pragma unroll
              for (int m = 0; m < 4; ++m) { const f32x4 sa = sav[m], sb = sbv[m]; rsv[m] = rsqrtf(((sa[0] + sa[1]) + (sa[2] + sa[3]) + (sb[0] + sb[1]) + (sb[2] + sb[3])) * (1.f / 1024.f) + NORM_EPS); } }
#pragma unroll
            for (int m = 0; m < 4; ++m) { const int row = u.pm * 256 + ai * 128 + wr * 64 + m * 16 + fr;
#pragma unroll
                for (int bj = 0; bj < 2; ++bj) { const int col = u.pn * 256 + bj * 128 + wc * 32 + 8 * fq;
                    hvv[m][bj] = *(const h16x8*)(h2b + (size_t)row * 1024 + col); pvv[m][bj] = *(const h16x8*)(pp + (size_t)row * 1024 + col); } }
#pragma unroll
            for (int m = 0; m < 4; ++m) {
                const int row = u.pm * 256 + ai * 128 + wr * 64 + m * 16 + fr; float ss = 0.f;
                const float rs = rsv[m];
#pragma unroll
                for (int bj = 0; bj < 2; ++bj) {
                    const int col = u.pn * 256 + bj * 128 + wc * 32 + 8 * fq;
                    const h16x8 hv = hvv[m][bj];
                    f32x4 o0 = (f32x4){(float)hv[0], (float)hv[1], (float)hv[2], (float)hv[3]}, o1 = (f32x4){(float)hv[4], (float)hv[5], (float)hv[6], (float)hv[7]};
                    const h16x8 pv = pvv[m][bj];
                    const f32x4 v0 = acc[ai][bj][m][0], v1 = acc[ai][bj][m][1];
#pragma unroll
                    for (int j = 0; j < 4; ++j) { o0[j] += sigmoidf_(rs * v0[j]) * (float)pv[j]; o1[j] += sigmoidf_(rs * v1[j]) * (float)pv[4 + j]; }
                    *(h16x8*)(h3b + (size_t)row * 1024 + col) = pack8(o0, o1);
                    ss += (o0[0] * o0[0] + o0[1] * o0[1]) + (o0[2] * o0[2] + o0[3] * o0[3]) + (o1[0] * o1[0] + o1[1] * o1[1]) + (o1[2] * o1[2] + o1[3] * o1[3]);
                }
                { const int ln_ = fr + 16 * fq; ss += x16_(ss, ln_); ss += x32_(ss, ln_); }
                if (fq == 0) part[(size_t)row * 16 + u.pn * 4 + wc] = ss;
            }
        }
    }
};

__device__ __forceinline__ void tr_item(const float* W, int N, const float* g, h16* WT, int ldk, int koff, int k0, int n0, LAS float* scr, int lane) {
#pragma unroll 8
    for (int i = 0; i < 32; ++i) { const int kk = 2 * i + (lane >> 5); float v = W[(size_t)(k0 + kk) * N + n0 + (lane & 31)]; if (g) v *= g[k0 + kk]; scr[kk * 33 + (lane & 31)] = v; }
    asm volatile("s_waitcnt lgkmcnt(0)" ::: "memory");
    const int c = lane & 7;
#pragma unroll
    for (int j = 0; j < 4; ++j) { const int n = (lane >> 3) + 8 * j; const LAS float* s = scr + (8 * c) * 33 + n;
        h16x8 o;
#pragma unroll
        for (int e = 0; e < 8; ++e) o[e] = (h16)s[e * 33];
        *(h16x8*)(WT + (size_t)(n0 + n) * ldk + koff + k0 + 8 * c) = o; }
    asm volatile("s_waitcnt lgkmcnt(0)" ::: "memory");
}
struct TrJob { const float* W; const float* g; h16* WT; int K, N, ldk, koff; };

__device__ __forceinline__ void phase_prep(const Args& a, LAS unsigned char* lds) {
    const int tid = tid_(), lane = tid & 63, wave = tid >> 6;
    const int gw = blockIdx.x * NWAVES + wave, NGW = gridDim.x * NWAVES;
    unsigned char* ws = a.ws;
    {
        LAS float* scr = (LAS float*)(lds + wave * 8704);
        TrJob jobs[9] = {
            {a.in[3], a.in[2], (h16*)(ws + O_WIN), 1024, NIN, 1024, 0},
            {a.in[17], nullptr, (h16*)(ws + O_WA), 512, 1024, 512, 0},
            {a.in[18], nullptr, (h16*)(ws + O_WB), 512, 1024, 512, 0},
            {a.in[19], nullptr, (h16*)(ws + O_WO), 1024, 1024, 1024, 0},
            {a.in[26], a.in[25], (h16*)(ws + O_WG), 1024, 1024, 1024, 0},
            {a.in[27], nullptr, (h16*)(ws + O_WP), 256, 1024, 256, 0},
            {a.in[8], nullptr, (h16*)(ws + O_WLR), 64, 512, 256, 0},
            {a.in[10], nullptr, (h16*)(ws + O_WLR) + (size_t)512 * 256, 64, 512, 256, 64},
            {a.in[11], nullptr, (h16*)(ws + O_WLR) + (size_t)1024 * 256, 128, 512, 256, 128},
        };
        int base = 0;
#pragma unroll
        for (int j = 0; j < 9; ++j) {
            const TrJob J = jobs[j]; const int nnb = J.N / 32, items = (J.K / 64) * nnb;
            int first = gw - (base % NGW); if (first < 0) first += NGW;
            for (int r = first; r < items; r += NGW) tr_item(J.W, J.N, J.g, J.WT, J.ldk, J.koff, (r / nnb) * 64, (r % nnb) * 32, scr, lane);
            base += items;
        }
        h16* wlr = (h16*)(ws + O_WLR);
        for (int i = blockIdx.x * NTHREADS + tid; i < 1536 * 256 / 8; i += gridDim.x * NTHREADS) {
            const int n = (i * 8) / 256, k = (i * 8) % 256; const int blk = n / 512;
            const bool inblk = (blk == 0) ? (k < 64) : (blk == 1) ? (k >= 64 && k < 128) : (k >= 128);
            if (!inblk) { h16x8 z; for (int e = 0; e < 8; ++e) z[e] = (h16)0.f; *(h16x8*)(wlr + (size_t)i * 8) = z; }
        }
    }
    __syncthreads();
    {
        LAS float* LA = (LAS float*)lds;
        LAS float* LB = (LAS float*)(lds + 64 * 129 * 4);
        const float* wq = a.in[21]; const float* sk = a.in[22]; const float* gf = a.in[20];
        h16* wst = (h16*)(ws + O_WS);
        for (int it = blockIdx.x; it < 256; it += gridDim.x) {
            const int g16 = it >> 4, k0 = (it & 15) * 64;
            for (int i = tid; i < 64 * 128; i += NTHREADS) { const int k = i >> 7, d = i & 127; LA[k * 129 + d] = wq[(size_t)(k0 + k) * 2048 + g16 * 128 + d] * gf[k0 + k]; }
            for (int i = tid; i < 128 * 128; i += NTHREADS) { const int n = i >> 7, d = i & 127; LB[n * 129 + d] = sk[((size_t)g16 * 128 + n) * 128 + d]; }
            __syncthreads();
            const int n = tid & 127, kg = tid >> 7;
            float o[16];
#pragma unroll
            for (int j = 0; j < 16; ++j) o[j] = 0.f;
            for (int d = 0; d < 128; ++d) { const float b = LB[n * 129 + d];
#pragma unroll
                for (int j = 0; j < 16; ++j) o[j] += LA[(kg * 16 + j) * 129 + d] * b; }
            h16x8 o0, o1;
#pragma unroll
            for (int j = 0; j < 8; ++j) { o0[j] = (h16)o[j]; o1[j] = (h16)o[8 + j]; }
            h16* dst = wst + (size_t)(g16 * 128 + n) * 1024 + k0 + kg * 16;
            *(h16x8*)dst = o0; *(h16x8*)(dst + 8) = o1;
            __syncthreads();
        }
    }
    {
        const float* gf = a.in[20];
        f32x4 g4[4];
#pragma unroll
        for (int j = 0; j < 4; ++j) g4[j] = *(const f32x4*)(gf + 16 * lane + 4 * j);
        for (int r = gw; r < 2 * 16384; r += NGW) {
            const int tb = r >> 14, e = r & 16383;
            const float* src = (tb ? a.in[24] : a.in[23]) + (size_t)e * 1024 + 16 * lane;
            f32x4 v[4]; float mx = 0.f;
#pragma unroll
            for (int j = 0; j < 4; ++j) { v[j] = *(const f32x4*)(src + 4 * j); if (!tb) v[j] = v[j] * g4[j];
#pragma unroll
                for (int c = 0; c < 4; ++c) mx = fmaxf(mx, fabsf(v[j][c])); }
            mx = wave_max(mx);
            mx = fmaxf(mx, 1e-30f);
            const float sc = 127.0f / mx;
            u32x4 q;
#pragma unroll
            for (int j = 0; j < 4; ++j) {
                const int i0 = __float2int_rn(v[j][0] * sc), i1 = __float2int_rn(v[j][1] * sc), i2 = __float2int_rn(v[j][2] * sc), i3 = __float2int_rn(v[j][3] * sc);
                q[j] = (unsigned)(i0 & 0xff) | ((unsigned)(i1 & 0xff) << 8) | ((unsigned)(i2 & 0xff) << 16) | ((unsigned)i3 << 24); }
            unsigned char* dst = ws + (tb ? O_V8 : O_U8) + ((size_t)(lane >> 3) * 16384 + e) * 128 + 16 * (lane & 7);
            *(u32x4*)dst = q;
            if (lane == 0) ((float*)(ws + (tb ? O_VSC : O_USC)))[e] = mx * (1.0f / 127.0f);
        }
        if (blockIdx.x == 0 && tid < 32) ((unsigned*)(ws + O_CTR))[tid * 64] = 0u;
        const f32x4* pp = (const f32x4*)a.in[1]; h16x4* dp = (h16x4*)(ws + O_P16);
        const int np4 = MTOK * 256 / 4;
        { const int st = gridDim.x * NTHREADS;
          for (int i = blockIdx.x * NTHREADS + tid; i < np4; i += 4 * st) {
            f32x4 pv[4];
#pragma unroll
            for (int q = 0; q < 4; ++q) if (i + q * st < np4) pv[q] = pp[i + q * st];
#pragma unroll
            for (int q = 0; q < 4; ++q) if (i + q * st < np4) dp[i + q * st] = pack4(pv[q]); } }
    }
    {
        const float* x = a.in[0]; h16* xn = (h16*)(ws + O_XN);
        for (int rq = gw; rq < MTOK; rq += 4 * NGW) {
            f32x4 v[4][4];
#pragma unroll
            for (int q = 0; q < 4; ++q) { const int r = rq + q * NGW; if (r < MTOK) { const f32x4* xr = (const f32x4*)(x + (size_t)r * 1024) + lane;
#pragma unroll
                for (int j = 0; j < 4; ++j) v[q][j] = xr[64 * j]; } }
#pragma unroll
            for (int q = 0; q < 4; ++q) { const int r = rq + q * NGW; if (r < MTOK) { float s = 0.f;
#pragma unroll
                for (int j = 0; j < 4; ++j) s += (v[q][j][0] * v[q][j][0] + v[q][j][1] * v[q][j][1]) + (v[q][j][2] * v[q][j][2] + v[q][j][3] * v[q][j][3]);
                const float rs = rsqrtf(wave_sum(s) * (1.f / 1024.f) + NORM_EPS);
                h16x4* o = (h16x4*)(xn + (size_t)r * 1024) + lane;
#pragma unroll
                for (int j = 0; j < 4; ++j) o[64 * j] = pack4(v[q][j] * rs); } }
        }
    }
}

__device__ __forceinline__ void phase_conv(const Args& a) {
    const int tid = tid_(), lane = tid & 63, wave = tid >> 6;
    const int gw = blockIdx.x * NWAVES + wave, NGW = gridDim.x * NWAVES;
    const h16* zc = (const h16*)(a.ws + O_ZC); h16* ca = (h16*)(a.ws + O_CA);
    const float* cw = a.in[4]; const float* cb = a.in[5];
    float w0[8], w1[8], w2[8], bb[8];
#pragma unroll
    for (int j = 0; j < 8; ++j) { const int c = lane * 8 + j; w0[j] = cw[c]; w1[j] = cw[512 + c]; w2[j] = cw[1024 + c]; bb[j] = cb[c]; }
    for (int run = gw; run < MTOK / 32; run += NGW) {
        const int t0 = run * 32;
        float u1[8], u2[8];
        if ((t0 % SEQ) == 0) {
#pragma unroll
            for (int j = 0; j < 8; ++j) { u1[j] = 0.f; u2[j] = 0.f; }
        } else {
            const h16x8 c1 = *(const h16x8*)(zc + (size_t)(t0 - 1) * 1536 + 512 + lane * 8), x1 = *(const h16x8*)(zc + (size_t)(t0 - 1) * 1536 + 1024 + lane * 8);
            const h16x8 c2 = *(const h16x8*)(zc + (size_t)(t0 - 2) * 1536 + 512 + lane * 8), x2 = *(const h16x8*)(zc + (size_t)(t0 - 2) * 1536 + 1024 + lane * 8);
#pragma unroll
            for (int j = 0; j < 8; ++j) { u1[j] = (float)c1[j] * (float)x1[j]; u2[j] = (float)c2[j] * (float)x2[j]; }
        }
#define CV_LOAD(GB, GC, XI, TB) do { _Pragma("unroll") for (int q = 0; q < 4; ++q) { const h16* zrow = zc + (size_t)((TB) + q) * 1536 + lane * 8; GB[q] = *(const h16x8*)zrow; GC[q] = *(const h16x8*)(zrow + 512); XI[q] = *(const h16x8*)(zrow + 1024); } } while (0)
#define CV_COMP(GB, GC, XI, TB) do { _Pragma("unroll") for (int q = 0; q < 4; ++q) { const int t = (TB) + q; const h16x8 gb = GB[q], gc = GC[q], xi = XI[q]; \
                h16x8 o; \
                _Pragma("unroll") for (int j = 0; j < 8; ++j) { const float u0 = (float)gc[j] * (float)xi[j]; \
                    const float y = w0[j] * u2[j] + w1[j] * u1[j] + w2[j] * u0 + bb[j]; \
                    o[j] = (h16)((float)gb[j] * y); u2[j] = u1[j]; u1[j] = u0; } \
                *(h16x8*)(ca + (size_t)t * 512 + lane * 8) = o; } } while (0)
        h16x8 gbA[4], gcA[4], xiA[4], gbB[4], gcB[4], xiB[4];
        CV_LOAD(gbA, gcA, xiA, t0);
        for (int tb = t0; tb < t0 + 32; tb += 8) {
            CV_LOAD(gbB, gcB, xiB, tb + 4);
            CV_COMP(gbA, gcA, xiA, tb);
            if (tb + 8 < t0 + 32) CV_LOAD(gbA, gcA, xiA, tb + 8);
            CV_COMP(gbB, gcB, xiB, tb + 4);
        }
#undef CV_LOAD
#undef CV_COMP
    }
}


__device__ __forceinline__ float tanhf_(float x) { return 1.0f - 2.0f * __builtin_amdgcn_rcpf(1.0f + __expf(2.0f * x)); }
__device__ __forceinline__ void phase_rwkv_prep(const Args& a) {
    const int tid = tid_(), lane = tid & 63, wave = tid >> 6;
    const int gw = blockIdx.x * NWAVES + wave, NGW = gridDim.x * NWAVES;
    const h16* zr = (const h16*)(a.ws + O_ZR);
    h16* R = (h16*)a.out; h16* KS = R + (size_t)MTOK * 512; h16* V = KS + (size_t)MTOK * 512; h16* KK = V + (size_t)MTOK * 512;
    h16* APR = (h16*)(a.ws + O_APR);
    const float* mu = a.in[6]; const float* k_k = a.in[12];
    float mr[8], mk[8], mv[8], mt[8], kk8[8];
#pragma unroll
    for (int j = 0; j < 8; ++j) { const int c = lane * 8 + j; mr[j] = mu[c]; mk[j] = mu[512 + c]; mv[j] = mu[1024 + c]; mt[j] = mu[1536 + (c & 255)]; kk8[j] = k_k[c]; }
    for (int run = gw; run < MTOK / 32; run += NGW) {
        const int t0 = run * 32;
        float pr[8], pk[8], pv[8], pt[8];
        if ((t0 % SEQ) == 0) {
#pragma unroll
            for (int j = 0; j < 8; ++j) { pr[j] = 0.f; pk[j] = 0.f; pv[j] = 0.f; pt[j] = 0.f; }
        } else {
            const h16* zp = zr + (size_t)(t0 - 1) * 1792 + lane * 8;
            const h16x8 a0 = *(const h16x8*)zp, a1 = *(const h16x8*)(zp + 512), a2 = *(const h16x8*)(zp + 1024), a3 = *(const h16x8*)(zr + (size_t)(t0 - 1) * 1792 + 1536 + (lane & 31) * 8);
#pragma unroll
            for (int j = 0; j < 8; ++j) { pr[j] = (float)a0[j]; pk[j] = (float)a1[j]; pv[j] = (float)a2[j]; pt[j] = (float)a3[j]; }
        }
#define RP_LOAD(A0, A1, A2, A3, TB) do { _Pragma("unroll") for (int q = 0; q < 2; ++q) { const h16* zp = zr + (size_t)((TB) + q) * 1792 + lane * 8; \
                A0[q] = *(const h16x8*)zp; A1[q] = *(const h16x8*)(zp + 512); A2[q] = *(const h16x8*)(zp + 1024); A3[q] = *(const h16x8*)(zr + (size_t)((TB) + q) * 1792 + 1536 + (lane & 31) * 8); } } while (0)
#define RP_COMP(A0, A1, A2, A3, TB) do { _Pragma("unroll") for (int q = 0; q < 2; ++q) { const int t = (TB) + q; const h16x8 a0 = A0[q], a1 = A1[q], a2 = A2[q], a3 = A3[q]; \
            h16x8 orr, ok, ov, okk, ot; float kr[8]; float ss = 0.f; \
            _Pragma("unroll") for (int j = 0; j < 8; ++j) { \
                const float zr_ = (float)a0[j], zk_ = (float)a1[j], zv_ = (float)a2[j], zt_ = (float)a3[j]; \
                const float r = zr_ + mr[j] * (pr[j] - zr_), k = zk_ + mk[j] * (pk[j] - zk_), v = zv_ + mv[j] * (pv[j] - zv_), tl = zt_ + mt[j] * (pt[j] - zt_); \
                pr[j] = zr_; pk[j] = zk_; pv[j] = zv_; pt[j] = zt_; \
                orr[j] = (h16)r; ok[j] = (h16)k; ov[j] = (h16)v; \
                kr[j] = k * kk8[j]; ss += kr[j] * kr[j]; \
                  \
                const float rc = __builtin_amdgcn_rcpf(1.0f + __expf(tsc * tl)); \
                const float tv = (lane < 8) ? (1.0f - 2.0f * rc) : (lane < 16) ? tl : rc; \
                ot[j] = (h16)tv; \
            } \
            ss += dpp_<0xB1>(ss); ss += dpp_<0x4E>(ss); ss += xhm_(ss);     \
            const float rn = rsqrtf(ss + 1e-12f); \
            _Pragma("unroll") for (int j = 0; j < 8; ++j) okk[j] = (h16)(kr[j] * rn); \
            const size_t o = (size_t)t * 512 + lane * 8; \
            *(h16x8*)(R + o) = orr; *(h16x8*)(KS + o) = ok; *(h16x8*)(V + o) = ov; *(h16x8*)(KK + o) = okk; \
            if (lane < 32) *(h16x8*)(APR + (size_t)t * 256 + lane * 8) = ot; } } while (0)
        const float tsc = (lane < 8) ? 2.0f : -1.0f;
        h16x8 a0A[2], a1A[2], a2A[2], a3A[2], a0B[2], a1B[2], a2B[2], a3B[2];
        RP_LOAD(a0A, a1A, a2A, a3A, t0);
        for (int tb = t0; tb < t0 + 32; tb += 4) {
            RP_LOAD(a0B, a1B, a2B, a3B, tb + 2);
            RP_COMP(a0A, a1A, a2A, a3A, tb);
            if (tb + 4 < t0 + 32) RP_LOAD(a0A, a1A, a2A, a3A, tb + 4);
            RP_COMP(a0B, a1B, a2B, a3B, tb + 2);
        }
#undef RP_LOAD
#undef RP_COMP
    }
}

struct EpiLR {
    static constexpr bool TWO_PART = false;
    const float *w0, *a0, *k_a; h16 *WD, *KS, *BD, *GG; const h16* KK;
    __device__ __forceinline__ void operator()(AccRef acc, const Unit& u, int wr, int wc, int fr, int fq) const {
        const int part = u.pn >> 1;
        EPI_LOOP_BEGIN
            const int c = col - part * 512; const size_t o = (size_t)row * 512 + c;
            if (part == 0) {
                const f32x4 b0 = *(const f32x4*)(w0 + c), b1 = *(const f32x4*)(w0 + c + 4); f32x4 o0, o1;
#pragma unroll
                for (int j = 0; j < 4; ++j) { o0[j] = __expf(-0.6065306597126334f * sigmoidf_(b0[j] + v0[j])); o1[j] = __expf(-0.6065306597126334f * sigmoidf_(b1[j] + v1[j])); }
                *(h16x8*)(WD + o) = pack8(o0, o1);
            } else if (part == 1) {
                const f32x4 b0 = *(const f32x4*)(a0 + c), b1 = *(const f32x4*)(a0 + c + 4), ka0 = *(const f32x4*)(k_a + c), ka1 = *(const f32x4*)(k_a + c + 4);
                const h16x8 ks = *(const h16x8*)(KS + o), kk = *(const h16x8*)(KK + o); f32x4 k0, k1, bb0, bb1;
#pragma unroll
                for (int j = 0; j < 4; ++j) { const float aa0 = sigmoidf_(b0[j] + v0[j]), aa1 = sigmoidf_(b1[j] + v1[j]);
                    k0[j] = (float)ks[j] * (1.0f + (aa0 - 1.0f) * ka0[j]); k1[j] = (float)ks[4 + j] * (1.0f + (aa1 - 1.0f) * ka1[j]);
                    bb0[j] = aa0 * (float)kk[j]; bb1[j] = aa1 * (float)kk[4 + j]; }
                *(h16x8*)(KS + o) = pack8(k0, k1); *(h16x8*)(BD + o) = pack8(bb0, bb1);
            } else {
                *(h16x8*)(GG + o) = pack8(v0, v1);
            }
        EPI_LOOP_END
    }
};

constexpr size_t O_VTB = O_ZR;
constexpr size_t O_BON = O_ZR + 64 * MiB;
constexpr int UT_WAVE_LDS = 15360;
typedef float f32x16 __attribute__((ext_vector_type(16)));
__device__ __forceinline__ size_t ut_ov(int j, int s) { return (size_t)(j >> 2) * 512 + (j & 3) * 16 + s; }
constexpr int UT_SEG = 8, UT_SEGB = SEQ / 16 / UT_SEG;
__device__ __forceinline__ void phase_ut_pre(const Args& a, LAS unsigned char* lds, int seg, int gw, int NGW) {
    const int tid = tid_(), lane = tid & 63, wave = tid >> 6;
    LAS unsigned char* Lb = lds + wave * UT_WAVE_LDS;
    LAS h16* YX = (LAS h16*)Lb;
    LAS float* GT = (LAS float*)(Lb + 9216);
    LAS float* TM = (LAS float*)(Lb + 13824);
    h16* R = (h16*)a.out; h16* KS = R + (size_t)MTOK * 512; h16* V = KS + (size_t)MTOK * 512; h16* KK = V + (size_t)MTOK * 512;
    h16* WD = (h16*)(a.ws + O_WD); h16* BD = (h16*)(a.ws + O_BD);
    h16* VTB = (h16*)(a.ws + O_VTB); float* BON = (float*)(a.ws + O_BON);
    for (int wi = gw; wi < 32768 / UT_SEG; wi += NGW) {
        const int bh = ((((wi / (UT_SEGB * 8)) * (SEQ / 16)) + seg * UT_SEGB + ((wi % (UT_SEGB * 8)) >> 3)) << 3) | (wi & 7);
        int ln = lane; asm volatile("" : "+v"(ln)); const int r16 = ln & 15;
        const int h = bh & 7, nb = bh >> 3; const size_t tok0 = (size_t)nb * 16; const size_t e0 = tok0 * 512 + h * 64;
        const float rk = a.in[14][h * 64 + lane];
        {
            h16x8 stg[12];
#pragma unroll
            for (int j = 0; j < 12; ++j) { const int ar = j >> 1, row = (lane >> 3) + 8 * (j & 1);
                const h16* base = (ar == 0) ? WD : (ar == 1) ? KK : (ar == 2) ? BD : (ar == 3) ? KS : (ar == 4) ? R : V;
                stg[j] = *(const h16x8*)(base + e0 + (size_t)row * 512 + (lane & 7) * 8); }
#pragma unroll
            for (int j = 0; j < 12; ++j) *(LAS h16x8*)((LAS h16*)Lb + ((j >> 1) * 16 + (lane >> 3) + 8 * (j & 1)) * 64 + (lane & 7) * 8) = stg[j];
            asm volatile("s_waitcnt lgkmcnt(0)" ::: "memory");
        }
        float w[16], kk[16], bb[16], kx[16], rr[16]; h16x8 vt0, vt1;
        { const LAS h16* IN = (const LAS h16*)Lb;
#pragma unroll
        for (int t = 0; t < 16; ++t) { w[t] = (float)IN[t * 64 + lane]; kk[t] = (float)IN[(16 + t) * 64 + lane]; bb[t] = (float)IN[(32 + t) * 64 + lane]; kx[t] = (float)IN[(48 + t) * 64 + lane]; rr[t] = (float)IN[(64 + t) * 64 + lane];
            if (t < 8) vt0[t] = IN[(80 + t) * 64 + lane]; else vt1[t - 8] = IN[(80 + t) * 64 + lane]; } }
        asm volatile("s_waitcnt lgkmcnt(0)" ::: "memory");
        { h16* vp = VTB + (size_t)bh * 1024 + lane * 16; *(h16x8*)vp = vt0; *(h16x8*)(vp + 8) = vt1; }
        {
            float q8[8], q4[4], q2[2];
#pragma unroll
            for (int i = 0; i < 8; ++i) q8[i] = swap_add32(rr[i] * kx[i] * rk, rr[i + 8] * kx[i + 8] * rk);
#pragma unroll
            for (int i = 0; i < 4; ++i) q4[i] = swap_add16(q8[i], q8[i + 4]);
#pragma unroll
            for (int i = 0; i < 2; ++i) { const float keep = (ln & 8) ? q4[i + 2] : q4[i], send = (ln & 8) ? q4[i] : q4[i + 2]; q2[i] = keep + x8_(send); }
            const float keep = (ln & 4) ? q2[1] : q2[0], send = (ln & 4) ? q2[0] : q2[1];
            float bonv = keep + xhm_(send);
            bonv += dpp_<0xB1>(bonv); bonv += dpp_<0x4E>(bonv);
            if ((lane & 3) == 0) BON[(tok0 + (lane >> 2)) * 8 + h] = bonv;
        }
        float Lt[16]; { float Lc = 0.f;
#pragma unroll
            for (int t = 0; t < 16; ++t) { Lc += __logf(w[t]); Lt[t] = Lc; } }
        const float Lref = Lt[7];
        float btil[16]; h16x8 kt0, kt1;
        LAS h16* OS = (LAS h16*)(Lb + 9216);
#pragma unroll
        for (int t = 0; t < 16; ++t) {
            const float Lp = t ? Lt[t - 1] : 0.f;
            const float ka = kk[t] * __expf(Lp - Lref), rt = rr[t] * __expf(Lt[t] - Lref), e2 = __expf(Lref - Lt[t]), bt = bb[t] * e2, kt = kx[t] * e2;
            YX[t * 72 + lane] = (h16)ka; YX[(16 + t) * 72 + lane] = (h16)rt; YX[(32 + t) * 72 + lane] = (h16)kt; YX[(48 + t) * 72 + lane] = (h16)bt;
            btil[t] = bt;
            OS[t * 64 + lane] = (h16)(kk[t] * __expf(Lp)); OS[(16 + t) * 64 + lane] = (h16)(rr[t] * __expf(Lt[t]));
            const float ktp = kx[t] * __expf(Lt[15] - Lt[t]);
            if (t < 8) kt0[t] = (h16)ktp; else kt1[t - 8] = (h16)ktp;
        }
        const float post = __expf(Lt[15] - Lref), w16 = __expf(Lt[15]);
        { h16* kp = KS + e0 + ut_ov(lane, 0); *(h16x8*)kp = kt0; *(h16x8*)(kp + 8) = kt1; }
        asm volatile("s_waitcnt lgkmcnt(0)" ::: "memory");
#pragma unroll
        for (int j = 0; j < 4; ++j) { const int row = (lane >> 3) + 8 * (j & 1); const h16x8 o8 = *(const LAS h16x8*)(OS + ((j >> 1) * 16 + row) * 64 + (lane & 7) * 8);
            *(h16x8*)(((j >> 1) ? R : KK) + e0 + (size_t)row * 512 + (lane & 7) * 8) = o8; }
        asm volatile("s_waitcnt lgkmcnt(0)" ::: "memory");
        f32x16 acc;
#pragma unroll
        for (int i = 0; i < 16; ++i) acc[i] = 0.f;
#pragma unroll
        for (int ks = 0; ks < 4; ++ks) {
            const h16x8 af = *(const LAS h16x8*)(YX + (lane & 31) * 72 + 8 * (lane >> 5) + 16 * ks), bf = *(const LAS h16x8*)(YX + (32 + (lane & 31)) * 72 + 8 * (lane >> 5) + 16 * ks);
            acc = __builtin_amdgcn_mfma_f32_32x32x16_f16(af, bf, acc, 0, 0, 0);
        }
#pragma unroll
        for (int i = 0; i < 16; ++i) GT[((i & 3) + 8 * (i >> 2) + 4 * (lane >> 5)) * 36 + (lane & 31)] = acc[i];
        asm volatile("s_waitcnt lgkmcnt(0)" ::: "memory");
        float T[16];
#pragma unroll
        for (int t = 0; t < 16; ++t) { float v = (r16 == t) ? 1.f : 0.f;
#pragma unroll
            for (int s2 = 0; s2 < t; ++s2) v -= T[s2] * GT[t * 36 + 16 + s2];
            T[t] = v; }
#pragma unroll
        for (int t = 0; t < 16; ++t) TM[r16 * 20 + t] = T[t];
        asm volatile("s_waitcnt lgkmcnt(0)" ::: "memory");
        float bcol[16];
#pragma unroll
        for (int s2 = 0; s2 < 16; ++s2) bcol[s2] = (s2 <= r16) ? GT[(16 + r16) * 36 + 16 + s2] : 0.f;
        h16x8 tb0, tb1, tp0, tp1;
#pragma unroll
        for (int r = 0; r < 16; ++r) { float s0 = 0.f, s1 = 0.f;
#pragma unroll
            for (int s2 = r; s2 < 16; ++s2) { const float tv = TM[r * 20 + s2]; s0 += tv * btil[s2]; s1 += tv * bcol[s2]; }
            s0 *= post;
            if (r < 8) { tb0[r] = (h16)s0; tp0[r] = (h16)s1; } else { tb1[r - 8] = (h16)s0; tp1[r - 8] = (h16)s1; } }
        { h16* bp = BD + e0 + ut_ov(lane, 0); *(h16x8*)bp = tb0; *(h16x8*)(bp + 8) = tb1; }
        if (lane < 16) {
            h16x8 a0, a1, p0, p1;
#pragma unroll
            for (int s2 = 0; s2 < 16; ++s2) { const float av = (s2 < ln) ? GT[ln * 36 + s2] : 0.f, pv = (s2 <= ln) ? GT[(16 + ln) * 36 + s2] : 0.f;
                if (s2 < 8) { a0[s2] = (h16)av; p0[s2] = (h16)pv; } else { a1[s2 - 8] = (h16)av; p1[s2 - 8] = (h16)pv; } }
            h16* ap = WD + e0 + (size_t)(lane >> 2) * 512 + (lane & 3) * 16;
            *(h16x8*)ap = a0; *(h16x8*)(ap + 8) = a1;
            *(h16x8*)(ap + 4 * 512) = p0; *(h16x8*)(ap + 4 * 512 + 8) = p1;
            *(h16x8*)(ap + 8 * 512) = tp0; *(h16x8*)(ap + 8 * 512 + 8) = tp1;
        }
        (WD + e0 + (size_t)12 * 512)[lane] = (h16)w16;
        asm volatile("s_waitcnt lgkmcnt(0)" ::: "memory");
    }
}
struct UtOps { u32x2 ka[2][2], rt[2][2], kt[4], tb[4], at, apt, tp, vb, w16[4]; };
struct UtRes { __amdgpu_buffer_rsrc_t kk, r, ks, bd, wd, vt, y; };
__device__ __forceinline__ void ut_load(UtOps& o, const UtRes& R, int so, unsigned offK, unsigned offT, unsigned offV, unsigned offF) {
#pragma unroll
    for (int ks = 0; ks < 2; ++ks)
#pragma unroll
        for (int p = 0; p < 2; ++p) { o.ka[ks][p] = __builtin_amdgcn_raw_buffer_load_b64(R.kk, offK + 64u * ks + 32u * p, so, 0); o.rt[ks][p] = __builtin_amdgcn_raw_buffer_load_b64(R.r, offK + 64u * ks + 32u * p, so, 0); }
#pragma unroll
    for (int kt = 0; kt < 4; ++kt) { o.kt[kt] = __builtin_amdgcn_raw_buffer_load_b64(R.ks, offT + 4096u * kt, so, 0); o.tb[kt] = __builtin_amdgcn_raw_buffer_load_b64(R.bd, offT + 4096u * kt, so, 0); }
    o.at = __builtin_amdgcn_raw_buffer_load_b64(R.wd, offT, so, 0); o.apt = __builtin_amdgcn_raw_buffer_load_b64(R.wd, offT + 4096u, so, 0); o.tp = __builtin_amdgcn_raw_buffer_load_b64(R.wd, offT + 8192u, so, 0);
    o.vb = __builtin_amdgcn_raw_buffer_load_b64(R.vt, offV, so, 0);
#pragma unroll
    for (int kt = 0; kt < 4; ++kt) o.w16[kt] = __builtin_amdgcn_raw_buffer_load_b64(R.wd, offF + 12u * 1024u + 32u * kt, so, 0);
}
__device__ __forceinline__ f32x4 h4f(u32x2 v) { const h16x4 h = __builtin_bit_cast(h16x4, v); return (f32x4){(float)h[0], (float)h[1], (float)h[2], (float)h[3]}; }
__device__ __forceinline__ h16x8 cat8(u32x2 lo, u32x2 hi) { u32x4 r; r[0] = lo[0]; r[1] = lo[1]; r[2] = hi[0]; r[3] = hi[1]; return __builtin_bit_cast(h16x8, r); }
__device__ __forceinline__ void ut_block(const UtOps& o, f32x4 (&S)[4], const UtRes& R, unsigned offY, int so) {
    const f32x4 zf = (f32x4){0.f, 0.f, 0.f, 0.f}; const u32x2 zu = (u32x2){0u, 0u};
    const h16x8 sb0 = pack8(S[0], S[1]), sb1 = pack8(S[2], S[3]);
    const h16x8 vb = cat8(o.vb, zu);
    f32x4 x1 = zf, y = zf;
    x1 = __builtin_amdgcn_mfma_f32_16x16x32_f16(cat8(o.ka[0][0], o.ka[0][1]), sb0, x1, 0, 0, 0); y = __builtin_amdgcn_mfma_f32_16x16x32_f16(cat8(o.rt[0][0], o.rt[0][1]), sb0, y, 0, 0, 0);
    x1 = __builtin_amdgcn_mfma_f32_16x16x32_f16(cat8(o.ka[1][0], o.ka[1][1]), sb1, x1, 0, 0, 0); y = __builtin_amdgcn_mfma_f32_16x16x32_f16(cat8(o.rt[1][0], o.rt[1][1]), sb1, y, 0, 0, 0);
    x1 = __builtin_amdgcn_mfma_f32_16x16x32_f16(cat8(o.at, zu), vb, x1, 0, 0, 0); y = __builtin_amdgcn_mfma_f32_16x16x32_f16(cat8(o.apt, zu), vb, y, 0, 0, 0);
    f32x4 St[4];
#pragma unroll
    for (int kt = 0; kt < 4; ++kt) St[kt] = __builtin_amdgcn_mfma_f32_16x16x32_f16(cat8(o.kt[kt], zu), vb, S[kt] * h4f(o.w16[kt]), 0, 0, 0);
    const h16x8 xb = pack8(-x1, zf);
    y = __builtin_amdgcn_mfma_f32_16x16x32_f16(cat8(o.tp, zu), xb, y, 0, 0, 0);
#pragma unroll
    for (int kt = 0; kt < 4; ++kt) S[kt] = __builtin_amdgcn_mfma_f32_16x16x32_f16(cat8(o.tb[kt], zu), xb, St[kt], 0, 0, 0);
#pragma unroll
    for (int rg = 0; rg < 4; ++rg) { const h16 hv = (h16)y[rg]; __builtin_amdgcn_raw_buffer_store_b16(__builtin_bit_cast(unsigned short, hv), R.y, offY + 1024u * rg, so, 0); }
}
constexpr int UT_RING = 4;
static_assert(UT_SEGB % 4 == 0, "the loader rotates four operand sets");
__device__ __forceinline__ LAS unsigned char* ut_slot(LAS unsigned char* lds, unsigned s) { return lds + (s < 2u ? 64u + s * 12288u : 131072u + 128u + (s - 2u) * 12288u); }
#define UT_FIELDS(F) F(0, ka[0][0]) F(1, ka[0][1]) F(2, ka[1][0]) F(3, ka[1][1]) F(4, rt[0][0]) F(5, rt[0][1]) F(6, rt[1][0]) F(7, rt[1][1]) F(8, kt[0]) F(9, kt[1]) F(10, kt[2]) F(11, kt[3]) \
    F(12, tb[0]) F(13, tb[1]) F(14, tb[2]) F(15, tb[3]) F(16, at) F(17, apt) F(18, tp) F(19, vb) F(20, w16[0]) F(21, w16[1]) F(22, w16[2]) F(23, w16[3])
__device__ __forceinline__ void ut_put(const UtOps& o, LAS unsigned char* sl, int lane) {
    LAS u32x2* p = (LAS u32x2*)(sl + lane * 8);
#define UT_F(i, f) p[(i) * 64] = o.f;
    UT_FIELDS(UT_F)
#undef UT_F
}
__device__ __forceinline__ void ut_get(UtOps& o, const LAS unsigned char* sl, int lane) {
    const LAS u32x2* p = (const LAS u32x2*)(sl + lane * 8);
#define UT_F(i, f) o.f = p[(i) * 64];
    UT_FIELDS(UT_F)
#undef UT_F
}
__device__ __forceinline__ void phase_ut_seq(const Args& a, LAS unsigned char* lds, int seg) {
    const int tid = tid_(), lane = tid & 63, wave = tid >> 6, fr = lane & 15, fq = lane >> 4;
    if (wave > 1) return;
    volatile LAS unsigned* prodp = (volatile LAS unsigned*)(lds + 131072 + 32);
    volatile LAS unsigned* consp = (volatile LAS unsigned*)(lds + 131072 + 48);
    unsigned base = wave ? *prodp : *consp;
    const int nb0 = seg * UT_SEGB;
    for (int item = blockIdx.x; item < 256; item += gridDim.x, base += UT_SEGB) {
        const int h = item & 7, q = item >> 3, g = q & 3, b = q >> 2;
        const size_t e0 = ((size_t)b * SEQ * 512 + h * 64) * 2 + (size_t)nb0 * 16384;
        const char* Rb = (const char*)a.out + e0; const char* KSb = Rb + (size_t)MTOK * 1024; const char* KKb = Rb + (size_t)3 * MTOK * 1024;
        const char* WDb = (const char*)(a.ws + O_WD) + e0; const char* BDb = (const char*)(a.ws + O_BD) + e0;
        const char* VTb = (const char*)(a.ws + O_VTB) + ((size_t)b * (SEQ / 16) * 8 + h) * 2048 + (size_t)nb0 * 16384;
        const unsigned offK = (unsigned)(fr * 1024 + 8 * fq), offT = (unsigned)((fr >> 2) * 512 + (fr & 3) * 16 + 4 * fq) * 2u, offV = (unsigned)((16 * g + fr) * 16 + 4 * fq) * 2u, offF = (unsigned)fq * 8u,
                       offY = (unsigned)((4 * fq) * 512 + 16 * g + fr) * 2u;
        UtRes RS; RS.kk = mkrsrc(KKb); RS.r = mkrsrc(Rb); RS.ks = mkrsrc(KSb); RS.bd = mkrsrc(BDb); RS.wd = mkrsrc(WDb); RS.vt = mkrsrc(VTb);
        RS.y = mkrsrc((const char*)(a.ws + O_Y) + e0);
#define UT_LD(o, nn) ut_load(o, RS, ((nn) < UT_SEGB ? (nn) : UT_SEGB - 1) * 16384, offK, offT, offV, offF)
        if (wave == 1) {
#define UT_PUT(o, nn) do { const unsigned gc = base + (unsigned)(nn); int guard = 0; \
                while ((int)(gc - *consp) >= UT_RING && ++guard < (1 << 24)) __builtin_amdgcn_s_sleep(1); \
                asm volatile("" ::: "memory"); ut_put(o, ut_slot(lds, gc % UT_RING), lane); \
                asm volatile("s_waitcnt lgkmcnt(0)" ::: "memory"); if (lane == 0) *prodp = gc + 1u; } while (0)
            UtOps l0, l1, l2, l3;
            UT_LD(l0, 0); UT_LD(l1, 1); UT_LD(l2, 2); UT_LD(l3, 3);
#pragma unroll 1
            for (int n = 0; n < UT_SEGB; n += 4) {
                UT_PUT(l0, n);     UT_LD(l0, n + 4);
                UT_PUT(l1, n + 1); UT_LD(l1, n + 5);
                UT_PUT(l2, n + 2); UT_LD(l2, n + 6);
                UT_PUT(l3, n + 3); UT_LD(l3, n + 7);
            }
#undef UT_PUT
            continue;
        }
        f32x4* sst = (f32x4*)(a.ws + O_SST2) + ((size_t)item * 64 + lane) * 4;
        f32x4 S[4];
#pragma unroll
        for (int kt = 0; kt < 4; ++kt) S[kt] = seg ? sst[kt] : (f32x4){0.f, 0.f, 0.f, 0.f};
#define UT_GET(o, nn) do { const unsigned gc = base + (unsigned)(nn); int guard = 0; \
            while ((int)(*prodp - gc) < 1 && ++guard < (1 << 24)) __builtin_amdgcn_s_sleep(0); \
            asm volatile("" ::: "memory"); ut_get(o, ut_slot(lds, gc % UT_RING), lane); } while (0)
#define UT_DONE(nn) do { asm volatile("s_waitcnt lgkmcnt(0)" ::: "memory"); if (lane == 0) *consp = base + (unsigned)(nn) + 1u; } while (0)
        UtOps oa, ob;
        UT_GET(oa, 0);
#pragma unroll 1
        for (int n = 0; n < UT_SEGB; n += 2) {
            UT_DONE(n);     UT_GET(ob, n + 1);                          ut_block(oa, S, RS, offY, n * 16384);
            UT_DONE(n + 1); if (n + 2 < UT_SEGB) UT_GET(oa, n + 2);     ut_block(ob, S, RS, offY, (n + 1) * 16384);
        }
#undef UT_GET
#undef UT_DONE
#undef UT_LD
#pragma unroll
        for (int kt = 0; kt < 4; ++kt) sst[kt] = S[kt];
    }
}
__device__ __forceinline__ void phase_ut_step(const Args& a, LAS unsigned char* lds, int st) {
    const int wave = tid_() >> 6;
    if (st >= 1 && wave <= 1) { phase_ut_seq(a, lds, st - 1); return; }
    if (st < UT_SEG) { if (st == 0) phase_ut_pre(a, lds, st, blockIdx.x * NWAVES + wave, gridDim.x * NWAVES); else phase_ut_pre(a, lds, st, blockIdx.x * 6 + (wave - 2), gridDim.x * 6); }
}

__device__ __forceinline__ void phase_rwkv_post(const Args& a) {
    const int tid = tid_(), lane = tid & 63, wave = tid >> 6;
    const int gw = blockIdx.x * NWAVES + wave, NGW = gridDim.x * NWAVES;
    const h16* V = (const h16*)a.out + (size_t)2 * MTOK * 512;
    const h16* GG = (const h16*)(a.ws + O_GG); const h16* Y = (const h16*)(a.ws + O_Y); h16* YB = (h16*)(a.ws + O_YB); const float* BON = (const float*)(a.ws + O_BON);
    float lg[8], lb[8];
#pragma unroll
    for (int j = 0; j < 8; ++j) { const int c = lane * 8 + j; lg[j] = a.in[15][c]; lb[j] = a.in[16][c]; }
    for (int tq = gw; tq < MTOK; tq += 4 * NGW) {
        h16x8 y8v[4], v8v[4], g8v[4]; float bsv[4];
#pragma unroll
        for (int q = 0; q < 4; ++q) { const int t = tq + q * NGW; if (t < MTOK) { const size_t o = (size_t)t * 512 + lane * 8;
            y8v[q] = *(const h16x8*)(Y + o); v8v[q] = *(const h16x8*)(V + o); g8v[q] = *(const h16x8*)(GG + o); bsv[q] = BON[(size_t)t * 8 + (lane >> 3)]; } }
#pragma unroll
        for (int q = 0; q < 4; ++q) { const int t = tq + q * NGW; if (t < MTOK) { const size_t o = (size_t)t * 512 + lane * 8;
            const h16x8 y8 = y8v[q], v8 = v8v[q], g8 = g8v[q]; const float bs = bsv[q];
            float y[8]; float sm = 0.f;
#pragma unroll
            for (int j = 0; j < 8; ++j) { y[j] = (float)y8[j]; sm += y[j]; }
            sm += dpp_<0xB1>(sm); sm += dpp_<0x4E>(sm); sm += dpp_<0x141>(sm);
            const float mean = sm * (1.f / 64.f); float vs = 0.f;
#pragma unroll
            for (int j = 0; j < 8; ++j) { y[j] -= mean; vs += y[j] * y[j]; }
            vs += dpp_<0xB1>(vs); vs += dpp_<0x4E>(vs); vs += dpp_<0x141>(vs);
            const float rstd = rsqrtf(vs * (1.f / 64.f) + 64e-5f);
            h16x8 ov;
#pragma unroll
            for (int j = 0; j < 8; ++j) ov[j] = (h16)((y[j] * rstd * lg[j] + lb[j] + bs * (float)v8[j]) * (float)g8[j]);
            *(h16x8*)(YB + o) = ov; } }
    }
}

__device__ __forceinline__ void ins16(unsigned (&L)[16], unsigned x) {
#pragma unroll
    for (int j = 0; j < 16; ++j) { const unsigned hi = L[j] > x ? L[j] : x; x = L[j] > x ? x : L[j]; L[j] = hi; }
}
#define TK_CE(a, b) do { const unsigned hi_ = (a) > (b) ? (a) : (b); (b) = (a) > (b) ? (b) : (a); (a) = hi_; } while (0)
__device__ __forceinline__ void sort16_desc(unsigned (&v)[16]) {
#pragma unroll
    for (int p = 1; p < 16; p <<= 1)
#pragma unroll
        for (int k = p; k >= 1; k >>= 1)
#pragma unroll
            for (int j = k % p; j + k < 16; j += 2 * k)
#pragma unroll
                for (int i = 0; i < k; ++i) if (i + j + k < 16 && (i + j) / (2 * p) == (i + j + k) / (2 * p)) TK_CE(v[i + j], v[i + j + k]);
}
__device__ __forceinline__ void merge_top16(unsigned (&t)[16], const unsigned (&g)[16]) {
#pragma unroll
    for (int i = 0; i < 16; ++i) t[i] = t[i] > g[15 - i] ? t[i] : g[15 - i];
#pragma unroll
    for (int j = 8; j > 0; j >>= 1)
#pragma unroll
        for (int i = 0; i < 16; ++i) { const int l = i ^ j; if (l > i) TK_CE(t[i], t[l]); }
}
__device__ __forceinline__ unsigned ord32(float f) { const unsigned u = __float_as_uint(f); return (u & 0x80000000u) ? ~u : (u | 0x80000000u); }
__device__ __forceinline__ float unord32(unsigned k) { return __uint_as_float((k & 0x80000000u) ? (k & 0x7fffffffu) : ~k); }
__device__ __forceinline__ void phase_topk(const Args& a, LAS unsigned char* lds) {
    const int tid = tid_();
    const h16* SC = (const h16*)(a.ws + O_SCORES);
    const float* part = (const float*)(a.ws + O_PART1);
    unsigned short* IDX = (unsigned short*)(a.ws + O_IDX); float* GATE = (float*)(a.ws + O_GATE); float* RS1 = (float*)(a.ws + O_RS1);
    LAS unsigned char* LI = lds;
    for (int task = blockIdx.x * NTHREADS + tid; task < MTOK * 8; task += gridDim.x * NTHREADS) {
        const int t = task >> 3, h = task & 7;
        float ssq = 0.f;
#pragma unroll
        for (int j = 0; j < 4; ++j) { const f32x4 p4 = *(const f32x4*)(part + (size_t)t * 16 + 4 * j); ssq += (p4[0] + p4[1]) + (p4[2] + p4[3]); }
        const float rs = rsqrtf(ssq * (1.f / 1024.f) + NORM_EPS);
        if (h == 0) RS1[t] = rs;
        float sv[2][16];
#pragma unroll
        for (int c = 0; c < 2; ++c) {
            unsigned L[16];
#pragma unroll
            for (int j = 0; j < 16; ++j) L[j] = 0u;
            const h16* row = SC + (size_t)t * 2048 + h * 256 + c * 128;
#pragma unroll 1
            for (int ln = 0; ln < 2; ++ln) {
                u32x4 raw[8];
#pragma unroll
                for (int k = 0; k < 8; ++k) raw[k] = *(const u32x4*)(row + ln * 64 + k * 8);
#pragma unroll
                for (int g4 = 0; g4 < 4; ++g4) {
                    unsigned Gk[16];
#pragma unroll
                    for (int hh = 0; hh < 2; ++hh) { const u32x4 w4 = raw[2 * g4 + hh];
#pragma unroll
                        for (int d = 0; d < 4; ++d) {
                            const unsigned w = w4[d];
                            const unsigned sf = __builtin_bit_cast(unsigned, __builtin_bit_cast(s16x2, w) >> 15);
                            const unsigned o = w ^ (sf | 0x80008000u);
                            const int p0 = ln * 64 + g4 * 16 + hh * 8 + 2 * d;
                            Gk[hh * 8 + 2 * d] = (o << 16) | (unsigned)(127 - p0); Gk[hh * 8 + 2 * d + 1] = (o & 0xffff0000u) | (unsigned)(126 - p0); } }
                    sort16_desc(Gk);
                    merge_top16(L, Gk);
                }
            }
#pragma unroll
            for (int j = 0; j < 16; ++j) {
                const unsigned o16 = L[j] >> 16; const unsigned bits = (o16 & 0x8000u) ? (o16 & 0x7fffu) : (~o16 & 0xffffu);
                union { unsigned short u; h16 f; } cv; cv.u = (unsigned short)bits; sv[c][j] = (float)cv.f;
                LI[(c * 16 + j) * 512 + tid] = (unsigned char)(127u - (L[j] & 127u));
            }
        }
        unsigned L[16], G1[16], G2[16], X0 = 0u, X1 = 0u;
        { int cnt = 0;
#pragma unroll
          for (int i = 0; i < 16; ++i)
#pragma unroll
            for (int j = 0; j < 16; ++j) if ((i + 1) * (j + 1) <= 16) {
                const unsigned key = (ord32(sv[0][i] + sv[1][j]) & ~255u) | (unsigned)(255 - (i * 16 + j));
                if (cnt < 16) L[cnt] = key; else if (cnt < 32) G1[cnt - 16] = key; else if (cnt < 48) G2[cnt - 32] = key; else if (cnt == 48) X0 = key; else X1 = key;
                ++cnt; } }
        sort16_desc(L); sort16_desc(G1); sort16_desc(G2); merge_top16(L, G1); merge_top16(L, G2);
        { TK_CE(X0, X1); unsigned G3[16];
#pragma unroll
          for (int j = 0; j < 16; ++j) G3[j] = 0u;
          G3[0] = X0; G3[1] = X1; merge_top16(L, G3); }
        float e[16]; float den = 0.f; const float mx = unord32(L[0] & ~255u) * rs;
        unsigned short id[16];
#pragma unroll
        for (int k = 0; k < 16; ++k) {
            const float v = unord32(L[k] & ~255u) * rs; e[k] = __expf(v - mx); den += e[k];
            const unsigned pos = 255u - (L[k] & 255u); const unsigned i = pos >> 4, j = pos & 15u;
            id[k] = (unsigned short)((unsigned)LI[i * 512 + tid] * 128u + (unsigned)LI[(16 + j) * 512 + tid]);
        }
        const float inv = __builtin_amdgcn_rcpf(den);
        u32x4 i0, i1;
        i0[0] = id[0] | (id[1] << 16); i0[1] = id[2] | (id[3] << 16); i0[2] = id[4] | (id[5] << 16); i0[3] = id[6] | (id[7] << 16);
        i1[0] = id[8] | (id[9] << 16); i1[1] = id[10] | (id[11] << 16); i1[2] = id[12] | (id[13] << 16); i1[3] = id[14] | (id[15] << 16);
        u32x4* ip = (u32x4*)(IDX + (size_t)task * 16); ip[0] = i0; ip[1] = i1;
        f32x4* gp = (f32x4*)(GATE + (size_t)task * 16);
#pragma unroll
        for (int k4 = 0; k4 < 4; ++k4) gp[k4] = (f32x4){e[4 * k4] * inv, e[4 * k4 + 1] * inv, e[4 * k4 + 2] * inv, e[4 * k4 + 3] * inv};
    }
}

__device__ __forceinline__ float gelu_tanh(float x) { const float u = 0.7978845608028654f * (x + 0.044715f * x * x * x); return 0.5f * x * (1.0f + tanhf_(u)); }
__device__ __forceinline__ unsigned xcc_id() { return (unsigned)__builtin_amdgcn_s_getreg((3 << 11) | 20) & 7u; }
constexpr bool GA_C16 = false;
constexpr int GA_TC = 8, GA_NCH = MTOK / GA_TC;
__device__ __forceinline__ void dec16(const u32x4 q, float (&o)[16]) {
#pragma unroll
    for (int w = 0; w < 4; ++w) { const f32x2 lo = __builtin_amdgcn_cvt_pk_f32_fp8((int)q[w], false), hi = __builtin_amdgcn_cvt_pk_f32_fp8((int)q[w], true);
        o[4 * w] = lo[0]; o[4 * w + 1] = lo[1]; o[4 * w + 2] = hi[0]; o[4 * w + 3] = hi[1]; }
}
__device__ __forceinline__ void dec16p(const u32x4 q, f32x2 (&o)[8]) {
#pragma unroll
    for (int w = 0; w < 4; ++w) { o[2 * w] = __builtin_amdgcn_cvt_pk_f32_fp8((int)q[w], false); o[2 * w + 1] = __builtin_amdgcn_cvt_pk_f32_fp8((int)q[w], true); }
}
struct GIdx { u32x4 a, b; };
__device__ __forceinline__ GIdx g_ldidx(__amdgpu_buffer_rsrc_t IDX, int t, int r8) { GIdx r; r.a = __builtin_amdgcn_raw_buffer_load_b128(IDX, 32 * r8, t * 256, 0); r.b = __builtin_amdgcn_raw_buffer_load_b128(IDX, 32 * r8 + 16, t * 256, 0); return r; }
__device__ __forceinline__ void g_quant(u32x4 xa_, u32x4 xb_, u32x4& xq, float& xs) {
    const h16x8 xa = __builtin_bit_cast(h16x8, xa_), xb = __builtin_bit_cast(h16x8, xb_);
    float x[16]; float mx = 0.f;
#pragma unroll
    for (int k = 0; k < 8; ++k) { x[k] = (float)xa[k]; x[8 + k] = (float)xb[k]; mx = fmaxf(mx, fmaxf(fabsf(x[k]), fabsf(x[8 + k]))); }
    mx = fmaxf(mx, dpp_<0xB1>(mx)); mx = fmaxf(mx, dpp_<0x4E>(mx)); mx = fmaxf(mx, dpp_<0x141>(mx));
    mx = fmaxf(mx, 1e-20f);
    const float inv = 127.0f * __builtin_amdgcn_rcpf(mx); xs = mx * (1.0f / 127.0f);
#pragma unroll
    for (int w = 0; w < 4; ++w) { const int i0 = __float2int_rn(x[4 * w] * inv), i1 = __float2int_rn(x[4 * w + 1] * inv), i2 = __float2int_rn(x[4 * w + 2] * inv), i3 = __float2int_rn(x[4 * w + 3] * inv);
        xq[w] = (unsigned)(i0 & 0xff) | ((unsigned)(i1 & 0xff) << 8) | ((unsigned)(i2 & 0xff) << 16) | ((unsigned)i3 << 24); }
}
__device__ __forceinline__ void g_issue8(const unsigned char* TBs, unsigned lo, const u32x4 ix, u32x4 (&q)[8]) {
#pragma unroll
    for (int i = 0; i < 8; ++i) { const unsigned w = ix[i >> 1]; const unsigned e = (i & 1) ? (w >> 16) : (w & 0xffffu); q[i] = *(const u32x4*)(TBs + (e * 128u + lo)); }
}
struct GSide { u32x4 a, b, c, d; };
template <int PH> __device__ __forceinline__ GSide g_ldside(__amdgpu_buffer_rsrc_t SD, __amdgpu_buffer_rsrc_t HR, int t, int j, int m, int r8) {
    GSide r;
    if (PH == 0) { r.a = __builtin_amdgcn_raw_buffer_load_b128(SD, 32 * m, t * 2048 + 256 * j, 0); r.b = __builtin_amdgcn_raw_buffer_load_b128(SD, 32 * m + 16, t * 2048 + 256 * j, 0); r.c = r.a; r.d = r.b; }
    else { r.a = __builtin_amdgcn_raw_buffer_load_b128(SD, 32 * r8, t * 256, 0); r.b = __builtin_amdgcn_raw_buffer_load_b128(SD, 32 * r8 + 16, t * 256, 0);
           r.c = (u32x4){__builtin_amdgcn_raw_buffer_load_b32(SD, 4 * r8, (int)(O_COEFS - O_COEF) + t * 32, 0), 0u, 0u, 0u}; r.d = r.c;
           r.d[0] = __builtin_amdgcn_raw_buffer_load_b32(HR, (128 * j + 16 * m + 2 * r8) * 2, t * 2048, 0); }
    return r;
}
template <int PH, int HALF> __device__ __forceinline__ void g_half(u32x4 (&q)[8], const GSide& sd, float (&pa)[16], int (&ah)[16], int (&al)[16]) {
    if (PH == 0) {
#pragma unroll
        for (int i = 0; i < 8; ++i) { int acc = 0;
#pragma unroll
            for (int w = 0; w < 4; ++w) acc = __builtin_amdgcn_sdot4((int)q[i][w], (int)sd.a[w], acc, false);
            pa[8 * HALF + i] = (float)acc; }
    } else {
#pragma unroll
        for (int g = 0; g < 2; ++g) {
            const int ch = (int)sd.a[2 * HALF + g], cl = (int)sd.b[2 * HALF + g];
#pragma unroll
            for (int w = 0; w < 4; ++w) {
                const unsigned a0 = q[4 * g][w], a1 = q[4 * g + 1][w], a2 = q[4 * g + 2][w], a3 = q[4 * g + 3][w];
                const unsigned t01l = __builtin_amdgcn_perm(a1, a0, 0x05010400u), t01h = __builtin_amdgcn_perm(a1, a0, 0x07030602u);
                const unsigned t23l = __builtin_amdgcn_perm(a3, a2, 0x05010400u), t23h = __builtin_amdgcn_perm(a3, a2, 0x07030602u);
                const unsigned o0 = __builtin_amdgcn_perm(t23l, t01l, 0x05040100u), o1 = __builtin_amdgcn_perm(t23l, t01l, 0x07060302u);
                const unsigned o2 = __builtin_amdgcn_perm(t23h, t01h, 0x05040100u), o3 = __builtin_amdgcn_perm(t23h, t01h, 0x07060302u);
                ah[4 * w] = __builtin_amdgcn_sdot4((int)o0, ch, ah[4 * w], false);         if (GA_C16) al[4 * w] = __builtin_amdgcn_sdot4((int)o0, cl, al[4 * w], false);
                ah[4 * w + 1] = __builtin_amdgcn_sdot4((int)o1, ch, ah[4 * w + 1], false); if (GA_C16) al[4 * w + 1] = __builtin_amdgcn_sdot4((int)o1, cl, al[4 * w + 1], false);
                ah[4 * w + 2] = __builtin_amdgcn_sdot4((int)o2, ch, ah[4 * w + 2], false); if (GA_C16) al[4 * w + 2] = __builtin_amdgcn_sdot4((int)o2, cl, al[4 * w + 2], false);
                ah[4 * w + 3] = __builtin_amdgcn_sdot4((int)o3, ch, ah[4 * w + 3], false); if (GA_C16) al[4 * w + 3] = __builtin_amdgcn_sdot4((int)o3, cl, al[4 * w + 3], false);
            }
        }
    }
}
template <int PH> __device__ __forceinline__ void g_finish(const Args& a, __amdgpu_buffer_rsrc_t PRT, int t, int j, int lane, float (&p)[16], float xs, unsigned hpre) {
    const int m = lane & 7, r8 = lane >> 3;
    float q8[8], q4[4], q2[2];
    if (PH == 0) {
#pragma unroll
        for (int i = 0; i < 8; ++i) { const float keep = (lane & 4) ? p[i + 8] : p[i], send = (lane & 4) ? p[i] : p[i + 8]; q8[i] = keep + xhm_(send); }
#pragma unroll
        for (int i = 0; i < 4; ++i) { const float keep = (lane & 2) ? q8[i + 4] : q8[i], send = (lane & 2) ? q8[i] : q8[i + 4]; q4[i] = keep + dpp_<0x4E>(send); }
#pragma unroll
        for (int i = 0; i < 2; ++i) { const float keep = (lane & 1) ? q4[i + 2] : q4[i], send = (lane & 1) ? q4[i] : q4[i + 2]; q2[i] = keep + dpp_<0xB1>(send); }
        { const h16x2 pv = (h16x2){(h16)(q2[0] * xs), (h16)(q2[1] * xs)}; __builtin_amdgcn_raw_buffer_store_b32(__builtin_bit_cast(unsigned, pv), PRT, (16 * r8 + 2 * m) * 2, (j * MTOK + t) * 256, 0); }
    } else {
#pragma unroll
        for (int i = 0; i < 8; ++i) q8[i] = swap_add32(p[i], p[i + 8]);
#pragma unroll
        for (int i = 0; i < 4; ++i) q4[i] = swap_add16(q8[i], q8[i + 4]);
#pragma unroll
        for (int i = 0; i < 2; ++i) { const float keep = (lane & 8) ? q4[i + 2] : q4[i], send = (lane & 8) ? q4[i] : q4[i + 2]; q2[i] = keep + x8_(send); }
        const int col = 128 * j + 16 * m + 2 * r8;
        const h16x2 h1v = __builtin_bit_cast(h16x2, hpre);
        const f32x2 hv = (f32x2){(float)h1v[0] + q2[0], (float)h1v[1] + q2[1]};
        *(h16x2*)((h16*)(a.ws + O_H2B) + (size_t)t * 1024 + col) = (h16x2){(h16)hv[0], (h16)hv[1]};
        const float ss = wave_sum(hv[0] * hv[0] + hv[1] * hv[1]);
        if (lane == 0) ((float*)(a.ws + O_SS2))[(size_t)t * 8 + j] = ss;
    }
}
template <int PH>
__device__ __forceinline__ void phase_gather(const Args& a, int cset) {
    const int tid = tid_(), lane = tid & 63, m = lane & 7, r8 = lane >> 3;
    unsigned* ctr = (unsigned*)(a.ws + O_CTR) + cset * 8 * 64;
    const __amdgpu_buffer_rsrc_t IDX = mkrsrc(a.ws + O_IDX), SDR = mkrsrc(a.ws + (PH ? O_COEF : O_H1B)), PRT = mkrsrc(a.ws + O_PART), HR = mkrsrc(a.ws + O_H1B);
    const unsigned j0 = xcc_id();
    for (unsigned dj = 0; dj < 8; ++dj) {
        const unsigned j = (j0 + dj) & 7u;
        const unsigned char* TB = a.ws + (PH ? O_V8 : O_U8) + (size_t)j * 16384 * 128; const unsigned lo16 = 16u * (unsigned)m;
        unsigned c = 0; if (lane == 0) c = __hip_atomic_fetch_add(ctr + j * 64, 1u, __ATOMIC_RELAXED, __HIP_MEMORY_SCOPE_AGENT);
        c = (unsigned)__builtin_amdgcn_readfirstlane((int)c);
        if (c >= (unsigned)GA_NCH) continue;
        u32x4 qa[8], qb[8]; GSide sd, sn; GIdx ix, ixn;
        { const int t0 = c * GA_TC; ix = g_ldidx(IDX, t0, r8); g_issue8(TB, lo16, ix.a, qa); sd = g_ldside<PH>(SDR, HR, t0, j, m, r8); }
        for (;;) {
            const int t0 = c * GA_TC;
            unsigned cnv = 0; if (lane == 0) cnv = __hip_atomic_fetch_add(ctr + j * 64, 1u, __ATOMIC_RELAXED, __HIP_MEMORY_SCOPE_AGENT);
            unsigned cn = (unsigned)GA_NCH; int tnf = t0 + GA_TC - 1;
#define G_TOKEN(IXC, SDC, IXN, SNN, TI, TN) { \
                const int t = t0 + (TI), tn = (TN); \
                g_issue8(TB, lo16, IXC.b, qb); IXN = g_ldidx(IDX, tn, r8); SNN = g_ldside<PH>(SDR, HR, tn, j, m, r8); \
                float p[16]; int ah[16], al[16]; \
                if (PH == 1) { _Pragma("unroll") for (int k = 0; k < 16; ++k) { ah[k] = 0; al[k] = 0; } } \
                float xs = 1.f; \
                if (PH == 0) { u32x4 xq; g_quant(SDC.a, SDC.b, xq, xs); SDC.a = xq; } \
                if (PH == 0) __builtin_amdgcn_sched_barrier(0);     \
                g_half<PH, 0>(qa, SDC, p, ah, al); \
                if (PH == 0) __builtin_amdgcn_sched_barrier(0); \
                g_issue8(TB, lo16, IXN.a, qa); \
                if (PH == 0) __builtin_amdgcn_sched_barrier(0);     \
                g_half<PH, 1>(qb, SDC, p, ah, al); \
                if (PH == 1) { const float cs = __uint_as_float(SDC.c[0]); _Pragma("unroll") for (int k = 0; k < 16; ++k) p[k] = (float)(GA_C16 ? ((ah[k] << 8) + al[k]) : ah[k]) * cs; }     \
                g_finish<PH>(a, PRT, t, j, lane, p, xs, SDC.d[0]); }
#pragma unroll 1
            for (int ti = 0; ti < GA_TC; ti += 2) {
                if (ti == GA_TC - 2) { cn = (unsigned)__builtin_amdgcn_readfirstlane((int)cnv); if (cn < (unsigned)GA_NCH) tnf = (int)cn * GA_TC; }
                G_TOKEN(ix, sd, ixn, sn, ti, t + 1) G_TOKEN(ixn, sn, ix, sd, ti + 1, (ti + 2 < GA_TC) ? t + 1 : tnf) }
#undef G_TOKEN
            if (cn >= (unsigned)GA_NCH) break;
            c = cn;
        }
    }
}
__device__ __forceinline__ void phase_coef(const Args& a) {
    const int tid = tid_();
    const h16* PART = (const h16*)(a.ws + O_PART); const unsigned short* IDX = (const unsigned short*)(a.ws + O_IDX);
    const float* GATE = (const float*)(a.ws + O_GATE); const float* RS1 = (const float*)(a.ws + O_RS1);
    const float* USC = (const float*)(a.ws + O_USC); const float* VSC = (const float*)(a.ws + O_VSC);
    u32x4* CQ = (u32x4*)(a.ws + O_COEF); float* CS = (float*)(a.ws + O_COEFS);
    for (int task = blockIdx.x * NTHREADS + tid; task < MTOK * 8; task += gridDim.x * NTHREADS) {
        const size_t i = (size_t)task * 16;
        float sacc[16];
#pragma unroll
        for (int k = 0; k < 16; ++k) sacc[k] = 0.f;
#pragma unroll
        for (int j = 0; j < 8; ++j) { const h16x8 p0 = *(const h16x8*)(PART + (size_t)j * MTOK * 128 + i), p1 = *(const h16x8*)(PART + (size_t)j * MTOK * 128 + i + 8);
#pragma unroll
            for (int k = 0; k < 8; ++k) { sacc[k] += (float)p0[k]; sacc[8 + k] += (float)p1[k]; } }
        const u32x4 e0 = *(const u32x4*)(IDX + i), e1 = *(const u32x4*)(IDX + i + 8);
        const float rs = RS1[task >> 3];
        float c[16]; float mx = 0.f;
#pragma unroll
        for (int k = 0; k < 16; ++k) { const unsigned w = (k < 8) ? e0[(k & 7) >> 1] : e1[(k & 7) >> 1]; const unsigned e = (k & 1) ? (w >> 16) : (w & 0xffffu);
            c[k] = GATE[i + k] * gelu_tanh(rs * USC[e] * sacc[k]) * VSC[e]; mx = fmaxf(mx, fabsf(c[k])); }
        const float qmax = GA_C16 ? 32639.0f : 127.0f;
        const float inv = (mx > 0.f) ? qmax / mx : 0.f;
        u32x4 hw, lw;
#pragma unroll
        for (int g = 0; g < 4; ++g) { unsigned h4 = 0u, l4 = 0u;
#pragma unroll
            for (int b = 0; b < 4; ++b) { const int q = __float2int_rn(c[4 * g + b] * inv), hi = GA_C16 ? ((q + 128) >> 8) : q, lo = GA_C16 ? (q - (hi << 8)) : 0;
                h4 |= (unsigned)(hi & 0xff) << (8 * b); l4 |= (unsigned)(lo & 0xff) << (8 * b); }
            hw[g] = h4; lw[g] = l4; }
        CQ[(size_t)task * 2] = hw; CQ[(size_t)task * 2 + 1] = lw;
        CS[task] = mx / qmax;
    }
}

__device__ __forceinline__ void phase_final(const Args& a) {
    const int tid = tid_(), lane = tid & 63, wave = tid >> 6;
    const int gw = blockIdx.x * NWAVES + wave, NGW = gridDim.x * NWAVES;
    const float* part = (const float*)(a.ws + O_PART3); const float* fg = a.in[28];
    f32x4 g4[4];
#pragma unroll
    for (int j = 0; j < 4; ++j) g4[j] = *((const f32x4*)fg + lane + 64 * j);
    const h16* h3b = (const h16*)(a.ws + O_XN);
    for (int rq = gw; rq < MTOK; rq += 4 * NGW) {
        float sv[4]; h16x4 hv[4][4];
#pragma unroll
        for (int q = 0; q < 4; ++q) { const int r = rq + q * NGW; if (r < MTOK) { sv[q] = (lane < 16) ? part[(size_t)r * 16 + lane] : 0.f;
            const h16x4* hr = (const h16x4*)(h3b + (size_t)r * 1024) + lane;
#pragma unroll
            for (int j = 0; j < 4; ++j) hv[q][j] = hr[64 * j]; } }
#pragma unroll
        for (int q = 0; q < 4; ++q) { const int r = rq + q * NGW; if (r < MTOK) {
            const float s = wave_sum(sv[q]);
            const float rs = rsqrtf(s * (1.f / 1024.f) + NORM_EPS);
            f32x4* xr = (f32x4*)(a.out + (size_t)r * 1024) + lane;
#pragma unroll
            for (int j = 0; j < 4; ++j) { const h16x4 h = hv[q][j]; xr[64 * j] = (f32x4){(float)h[0], (float)h[1], (float)h[2], (float)h[3]} * rs * g4[j]; } } }
    }
}

constexpr int NPHASE = 19;
__global__ void __launch_bounds__(NTHREADS, 2) mk(Args a) {
    LAS unsigned char* lds = (LAS unsigned char*)smem;
    unsigned char* ws = a.ws;
    if (a.ph_hi < 0) { cg::grid_group grid = cg::this_grid(); grid.sync(); }
    volatile LAS unsigned* bst = (volatile LAS unsigned*)(lds + 131072);
    if ((threadIdx.x & 63) == 0) ((volatile LAS unsigned char*)(lds + LDS_WAVE_TAB))[hw_slot_()] = (unsigned char)(threadIdx.x >> 6);
    if (threadIdx.x < 16) bst[threadIdx.x] = 0u;
    __syncthreads();
    const XcdBarrier xbar = xcd_barrier_post((unsigned*)(a.ws + O_BAR), bst);
#define SYNC() xcd_barrier(xbar)
#define IN(k) (a.ph_lo <= (k) && (k) < a.ph_hi)
#define SEAM(k) do { if (IN(k) && IN((k) + 1)) SYNC(); } while (0)
#define REPS(k) ((((REP_MASK) >> (k)) & 1u) ? 2 : 1)
    const int G = gridDim.x, bid = blockIdx.x;
    if (IN(0)) for (int rep = 0; rep < REPS(0); ++rep) { if (rep) SYNC(); phase_prep(a, lds); } SEAM(0);
    if (IN(1)) for (int rep = 0; rep < REPS(1); ++rep) { if (rep) SYNC(); pg8::Gemm g{(const h16*)(ws + O_XN), (const h16*)(ws + O_WIN), MTOK, NIN, 1024, nullptr, nullptr}; pg8::StaticOrder S; S.init(MTOK, NIN, G, bid);
        EpiZ E{(h16*)(ws + O_ZC), (h16*)(ws + O_ZR), (h16*)(ws + O_ZG)}; pg8::gemm_phase(lds, g, S, E); } SEAM(1);
    if (IN(2)) for (int rep = 0; rep < REPS(2); ++rep) { if (rep) SYNC(); phase_conv(a); phase_rwkv_prep(a); } SEAM(2);
    if (IN(3)) for (int rep = 0; rep < REPS(3); ++rep) { if (rep) SYNC(); pg8::Gemm g{(const h16*)(ws + O_APR), (const h16*)(ws + O_WLR), MTOK, 1536, 256, nullptr, nullptr}; pg8::StaticOrder S; S.init(MTOK, 1536, G, bid);
        h16* R = (h16*)a.out; h16* KS = R + (size_t)MTOK * 512; h16* KK = KS + (size_t)2 * MTOK * 512;
        EpiLR E{a.in[7], a.in[9], a.in[13], (h16*)(ws + O_WD), KS, (h16*)(ws + O_BD), (h16*)(ws + O_GG), KK}; pg8::gemm_phase(lds, g, S, E); } SEAM(3);
    if (IN(4)) { for (int st = 0; st <= UT_SEG; ++st) { if (st) SYNC(); phase_ut_step(a, lds, st); } }
    SEAM(6);
    if (IN(7)) for (int rep = 0; rep < REPS(7); ++rep) { if (rep) SYNC(); phase_rwkv_post(a); } SEAM(7);
    if (IN(9)) for (int rep = 0; rep < REPS(9); ++rep) { if (rep) SYNC(); pg8::Gemm g{(const h16*)(ws + O_CA), (const h16*)(ws + O_WA), MTOK, 1024, 512, (const h16*)(ws + O_YB), (const h16*)(ws + O_WB)}; pg8::StaticOrder S; S.init(MTOK, 1024, G, bid);
        EpiMerged E{(const h16*)(ws + O_ZG), (h16*)(ws + O_MERGED)}; pg8::gemm_phase(lds, g, S, E); }
    SEAM(9);
    if (IN(10)) for (int rep = 0; rep < REPS(10); ++rep) { if (rep) SYNC(); pg8::Gemm g{(const h16*)(ws + O_MERGED), (const h16*)(ws + O_WO), MTOK, 1024, 1024, nullptr, nullptr}; pg8::StaticOrder S; S.init(MTOK, 1024, G, bid);
        EpiH1 E{a.in[0], (h16*)(ws + O_H1B), (float*)(ws + O_PART1)}; pg8::gemm_phase(lds, g, S, E); } SEAM(10);
    if (IN(11)) for (int rep = 0; rep < REPS(11); ++rep) { if (rep) SYNC(); pg8::Gemm g{(const h16*)(ws + O_H1B), (const h16*)(ws + O_WS), MTOK, 2048, 1024, nullptr, nullptr}; pg8::StaticOrder S; S.init(MTOK, 2048, G, bid);
        EpiF16 E{(h16*)(ws + O_SCORES), 2048}; pg8::gemm_phase(lds, g, S, E); } SEAM(11);
    if (IN(12)) for (int rep = 0; rep < REPS(12); ++rep) { if (rep) SYNC(); phase_topk(a, lds); } SEAM(12);
    if (IN(13)) for (int rep = 0; rep < REPS(13); ++rep) { if (rep) SYNC(); phase_gather<0>(a, 2 * rep); } SEAM(13);
    if (IN(14)) for (int rep = 0; rep < REPS(14); ++rep) { if (rep) SYNC(); phase_coef(a); }
    if (IN(14)) for (int rep = 0; rep < REPS(16); ++rep) { if (rep) SYNC(); pg8::Gemm g{(const h16*)(ws + O_P16), (const h16*)(ws + O_WP), MTOK, 1024, 256, nullptr, nullptr}; pg8::StaticOrder S; S.init(MTOK, 1024, G, bid);
        EpiF16 E{(h16*)(ws + O_PP), 1024}; pg8::gemm_phase(lds, g, S, E); } SEAM(14);
    if (IN(15)) for (int rep = 0; rep < REPS(15); ++rep) { if (rep) SYNC(); phase_gather<1>(a, 1 + 2 * rep); } SEAM(15);
    if (IN(17)) for (int rep = 0; rep < REPS(17); ++rep) { if (rep) SYNC(); pg8::Gemm g{(const h16*)(ws + O_H2B), (const h16*)(ws + O_WG), MTOK, 1024, 1024, nullptr, nullptr}; pg8::StaticOrder S; S.init(MTOK, 1024, G, bid);
        EpiGate E{(h16*)(ws + O_XN), (const h16*)(ws + O_H2B), (const h16*)(ws + O_PP), (const float*)(ws + O_SS2), (float*)(ws + O_PART3)}; pg8::gemm_phase(lds, g, S, E); } SEAM(17);
    if (IN(18)) for (int rep = 0; rep < REPS(18); ++rep) { if (rep) SYNC(); phase_final(a); }
}

extern "C" void kernel_launch(void* const* d_in, const int* in_sizes, int n_in, void* d_out, int out_size, void* d_ws, size_t ws_size, hipStream_t stream) {
    static int ready = 0, grid = NBLK;
    if (!ready) {
        if (n_in != 29 || ws_size < WS_END) { fprintf(stderr, "kernel_launch: unexpected n_in %d / ws %zu (need %zu)\n", n_in, ws_size, (size_t)WS_END); ready = -1; return; }
        if (hipFuncSetAttribute((const void*)mk, hipFuncAttributeMaxDynamicSharedMemorySize, LDS_BYTES) != hipSuccess) { fprintf(stderr, "hipFuncSetAttribute failed\n"); ready = -1; return; }
        int dev = 0, cus = 0, per_cu = 0;
        if (hipGetDevice(&dev) == hipSuccess && hipDeviceGetAttribute(&cus, hipDeviceAttributeMultiprocessorCount, dev) == hipSuccess &&
            hipOccupancyMaxActiveBlocksPerMultiprocessor(&per_cu, (const void*)mk, NTHREADS, LDS_BYTES) == hipSuccess && cus > 0 && per_cu > 0) grid = cus < NBLK ? cus : NBLK;
        else { (void)hipGetLastError(); grid = NBLK; }
        ready = 1;
    }
    if (ready < 0) return;
    Args a{};
    for (int i = 0; i < 29; ++i) a.in[i] = (const float*)d_in[i];
    a.out = (float*)d_out; a.ws = (unsigned char*)d_ws;
    (void)hipMemsetAsync((unsigned char*)d_ws + O_BAR, 0, 16384, stream);
    a.ph_lo = 0; a.ph_hi = NPHASE;
    void* args[] = {&a};
    if (hipLaunchCooperativeKernel((const void*)mk, dim3(grid), dim3(NTHREADS), args, LDS_BYTES, stream) != hipSuccess) fprintf(stderr, "cooperative launch failed (grid %d)\n", grid);
}
```

```cpp
#include <hip/hip_runtime.h>
#include <hip/hip_cooperative_groups.h>
#include <cstdio>
namespace cg = cooperative_groups;

#ifndef REP_MASK
#define REP_MASK 0u
#endif

#define LAS __attribute__((address_space(3)))
typedef _Float16 h16;
typedef _Float16 h16x8 __attribute__((ext_vector_type(8)));
typedef _Float16 h16x4 __attribute__((ext_vector_type(4)));
typedef _Float16 h16x2 __attribute__((ext_vector_type(2)));
typedef float f32x4 __attribute__((ext_vector_type(4)));
typedef float f32x2 __attribute__((ext_vector_type(2)));
typedef unsigned u32x4 __attribute__((ext_vector_type(4)));
typedef short s16x2 __attribute__((ext_vector_type(2)));
typedef unsigned u32x2 __attribute__((ext_vector_type(2)));

constexpr int MTOK = 65536, DM = 1024, SEQ = 8192, NB = 8;
constexpr int NIN = 5376;
constexpr int NTHREADS = 512, NWAVES = 8, NBLK = 256;
constexpr int LDS_BYTES = 131072 + 128 + 2 * 12288;
constexpr float NORM_EPS = 1e-6f;

constexpr size_t MiB = 1u << 20;
constexpr size_t O_WIN = 0;
constexpr size_t O_WA = O_WIN + (size_t)5376 * 1024 * 2;
constexpr size_t O_WB = O_WA + 1 * MiB;
constexpr size_t O_WO = O_WB + 1 * MiB;
constexpr size_t O_WG = O_WO + 2 * MiB;
constexpr size_t O_WP = O_WG + 2 * MiB;
constexpr size_t O_WLR = O_WP + 2 * MiB;
constexpr size_t O_WS = O_WLR + 3 * MiB / 4;
constexpr size_t O_U16 = O_WS + 4 * MiB;
constexpr size_t O_V16 = O_U16 + 32 * MiB;
constexpr size_t O_P16 = O_V16 + 32 * MiB;
constexpr size_t O_PART1 = O_P16 + 32 * MiB;
constexpr size_t O_PART3 = O_PART1 + 4 * MiB;
constexpr size_t O_RS1 = O_PART3 + 4 * MiB;
constexpr size_t O_RS2 = O_RS1 + MiB / 4;
constexpr size_t O_XN = O_RS2 + MiB / 4;
constexpr size_t O_ZC = O_XN + 128 * MiB;
constexpr size_t O_ZR = O_ZC + 192 * MiB;
constexpr size_t O_ZG = O_ZR + 224 * MiB;
constexpr size_t O_SS2 = O_ZG + 256 * MiB;
constexpr size_t O_USC = O_SS2 + 2 * MiB;
constexpr size_t O_VSC = O_USC + 65536;
constexpr size_t O_CTR = O_VSC + 65536;
constexpr size_t O_BAR = O_CTR + 8192;
constexpr size_t O_SST2 = O_BAR + 16384;
constexpr size_t WS_END = O_SST2 + MiB;
constexpr size_t O_U8 = O_U16;
constexpr size_t O_V8 = O_U16 + 16 * MiB;
constexpr size_t O_PART = O_ZG;
constexpr size_t O_COEF = O_ZC + 128 * MiB;
constexpr size_t O_COEFS = O_COEF + 16 * MiB;
constexpr size_t O_CA = O_XN;
constexpr size_t O_APR = O_XN + 64 * MiB;
constexpr size_t O_H1B = O_XN;
constexpr size_t O_WD = O_ZC;
constexpr size_t O_BD = O_ZC + 64 * MiB;
constexpr size_t O_GG = O_ZC + 128 * MiB;
constexpr size_t O_MERGED = O_ZC;
constexpr size_t O_H2B = O_ZC;
constexpr size_t O_Y = O_ZR + 96 * MiB;
constexpr size_t O_YB = O_ZR + 160 * MiB;
constexpr size_t O_IDX = O_ZR;
constexpr size_t O_GATE = O_ZR + 16 * MiB;
constexpr size_t O_PP = O_ZR + 64 * MiB;
constexpr size_t O_SCORES = O_ZG;
constexpr size_t O_P16P = O_ZG;

struct Args {
    const float* in[29];
    float* out;
    unsigned char* ws;
    int ph_lo, ph_hi;
};

constexpr int LDS_WAVE_TAB = 131072 + 64;
extern __shared__ __attribute__((aligned(16))) unsigned char smem[];
__device__ __forceinline__ int lane_() { int l; asm volatile("v_mbcnt_lo_u32_b32 %0, -1, 0\n\tv_mbcnt_hi_u32_b32 %0, -1, %0" : "=v"(l)); return l; }
__device__ __forceinline__ unsigned hw_slot_() { return (unsigned)__builtin_amdgcn_s_getreg((5 << 11) | 4) & 63u; }
__device__ __forceinline__ int tid_() {
    const int w = (int)((volatile LAS unsigned char*)((LAS unsigned char*)smem + LDS_WAVE_TAB))[hw_slot_()];
    int t = __builtin_amdgcn_readfirstlane(w) * 64 + lane_(); asm volatile("" : "+v"(t)); return t;
}
__device__ __forceinline__ float sigmoidf_(float x) { return __builtin_amdgcn_rcpf(1.0f + __expf(-x)); }
template <int CTRL> __device__ __forceinline__ float dpp_(float v) { return __builtin_bit_cast(float, __builtin_amdgcn_update_dpp(0, __builtin_bit_cast(int, v), CTRL, 0xF, 0xF, true)); }
__device__ __forceinline__ float x32_(float v, int lane) { const auto r = __builtin_amdgcn_permlane32_swap(__builtin_bit_cast(unsigned, v), __builtin_bit_cast(unsigned, v), false, false); return __builtin_bit_cast(float, (lane & 32) ? r[0] : r[1]); }
__device__ __forceinline__ float x16_(float v, int lane) { const auto r = __builtin_amdgcn_permlane16_swap(__builtin_bit_cast(unsigned, v), __builtin_bit_cast(unsigned, v), false, false); return __builtin_bit_cast(float, (lane & 16) ? r[0] : r[1]); }
__device__ __forceinline__ float swap_add32(float a, float b) { asm("s_nop 1\n\tv_permlane32_swap_b32 %0, %1" : "+v"(a), "+v"(b)); return a + b; }
__device__ __forceinline__ float swap_add16(float a, float b) { asm("s_nop 1\n\tv_permlane16_swap_b32 %0, %1" : "+v"(a), "+v"(b)); return a + b; }
__device__ __forceinline__ float x8_(float v) { return dpp_<0x128>(v); }
__device__ __forceinline__ float xhm_(float v) { return dpp_<0x141>(v); }
__device__ __forceinline__ float wave_sum(float v) {
    const int lane = lane_();
    v += dpp_<0xB1>(v); v += dpp_<0x4E>(v); v += dpp_<0x141>(v); v += dpp_<0x140>(v);
    v += x16_(v, lane); v += x32_(v, lane);
    return v;
}
__device__ __forceinline__ float wave_max(float v) {
    const int lane = lane_();
    v = fmaxf(v, dpp_<0xB1>(v)); v = fmaxf(v, dpp_<0x4E>(v)); v = fmaxf(v, dpp_<0x141>(v)); v = fmaxf(v, dpp_<0x140>(v));
    v = fmaxf(v, x16_(v, lane)); v = fmaxf(v, x32_(v, lane));
    return v;
}
__device__ __forceinline__ __amdgpu_buffer_rsrc_t mkrsrc(const void* p) { return __builtin_amdgcn_make_buffer_rsrc((void*)p, 0, 0x7fffffff, 0x00020000); }
__device__ __forceinline__ h16x8 pack8(f32x4 a, f32x4 b) {
    h16x8 r;
    r[0] = (h16)a[0]; r[1] = (h16)a[1]; r[2] = (h16)a[2]; r[3] = (h16)a[3];
    r[4] = (h16)b[0]; r[5] = (h16)b[1]; r[6] = (h16)b[2]; r[7] = (h16)b[3];
    return r;
}
__device__ __forceinline__ h16x4 pack4(f32x4 a) {
    h16x4 r; r[0] = (h16)a[0]; r[1] = (h16)a[1]; r[2] = (h16)a[2]; r[3] = (h16)a[3]; return r;
}

#define XB_TMO      128
#define XB_XCNT(j)  (256  + 64 * (j))
#define XB_XSUB(j)  (1280 + 64 * (j))
#define XB_XGEN(j)  (2304 + 64 * (j))
#define XB_TOP      3328
#define XB_TOPGEN   3392
#define XCD_BAR_WORDS 3456
#define XB_SPIN_CAP (1u << 18)

__device__ __forceinline__ unsigned xb_ld(unsigned* p)              { return __hip_atomic_load(p, __ATOMIC_RELAXED, __HIP_MEMORY_SCOPE_AGENT); }
__device__ __forceinline__ unsigned xb_add(unsigned* p, unsigned v) { return __hip_atomic_fetch_add(p, v, __ATOMIC_RELAXED, __HIP_MEMORY_SCOPE_AGENT); }
__device__ __forceinline__ unsigned xb_xcc_id() { return (unsigned)__builtin_amdgcn_s_getreg((3 << 11) | 20) & 0xFu; }
#define XB_SPIN(cond, bar) do { unsigned _sp = 0; while (cond) { __builtin_amdgcn_s_sleep(1); \
    if ((++_sp & 255u) == 0u) { if (xb_ld(&(bar)[XB_TMO])) break; if (_sp > XB_SPIN_CAP) { atomicAdd(&(bar)[XB_TMO], 1u); break; } } } } while (0)

struct XcdBarrier {
    unsigned* bar; unsigned x;
    volatile LAS unsigned* st;
};

__device__ __forceinline__ XcdBarrier xcd_barrier_post(unsigned* bar, volatile LAS unsigned* st) {
    XcdBarrier b; b.bar = bar; b.x = xb_xcc_id(); b.st = st;
    if (tid_() == 0) (void)xb_add(&bar[XB_XCNT(b.x)], 1u);
    return b;
}
__device__ __forceinline__ void xcd_barrier_complete(unsigned* bar, unsigned x, unsigned& nloc, unsigned& nx) {
    const unsigned G = gridDim.x * gridDim.y * gridDim.z;
    unsigned sum, cnt, mine, sp = 0u;
    for (;;) {
        sum = 0u; cnt = 0u; mine = 0u;
#pragma unroll
        for (unsigned j = 0; j < 16; ++j) { const unsigned c = xb_ld(&bar[XB_XCNT(j)]); sum += c; cnt += (c > 0u) ? 1u : 0u; mine = (j == x) ? c : mine; }
        if (sum == G) break;
        __builtin_amdgcn_s_sleep(1);
        if ((++sp & 255u) == 0u) { if (xb_ld(&bar[XB_TMO])) break; if (sp > XB_SPIN_CAP) { atomicAdd(&bar[XB_TMO], 1u); break; } }
    }
    nloc = mine > 0u ? mine : 1u; nx = cnt > 0u ? cnt : 1u;
}

__device__ __forceinline__ void xcd_barrier(const XcdBarrier& b) {
    asm volatile("s_waitcnt vmcnt(0)" ::: "memory");
    __syncthreads();
    if (tid_() == 0) {
        unsigned* bar = b.bar;
        __builtin_amdgcn_s_waitcnt(0);
        unsigned nloc = b.st[0], nx = b.st[1];
        if (nloc == 0u) { xcd_barrier_complete(bar, b.x, nloc, nx); b.st[0] = nloc; b.st[1] = nx; }
        const unsigned old = xb_add(&bar[XB_XSUB(b.x)], 1u);
        const unsigned gen = old / nloc;
        if (old + 1u == (gen + 1u) * nloc) {
            __builtin_amdgcn_fence(__ATOMIC_RELEASE, "agent");
            asm volatile("s_waitcnt vmcnt(0)" ::: "memory");
            const unsigned og = xb_add(&bar[XB_TOP], 1u);
            const unsigned tg = og / nx;
            if (og + 1u == (tg + 1u) * nx) xb_add(&bar[XB_TOPGEN], 1u);
            else XB_SPIN(xb_ld(&bar[XB_TOPGEN]) == tg, bar);
            __builtin_amdgcn_fence(__ATOMIC_ACQUIRE, "agent");
            xb_add(&bar[XB_XGEN(b.x)], 1u);
            asm volatile("s_waitcnt vmcnt(0)" ::: "memory");
        } else {
            XB_SPIN(xb_ld(&bar[XB_XGEN(b.x)]) == gen, bar);
            __builtin_amdgcn_fence(__ATOMIC_ACQUIRE, "agent");
            asm volatile("s_waitcnt vmcnt(0)" ::: "memory");
        }
    }
    __syncthreads();
}


namespace pg8 {
constexpr int BM = 256, BK = 64, HALF = 128, HTB = HALF * BK * 2, STAGE_BYTES = 8 * HTB, NXCD = 8, WGM = 8;
__device__ __forceinline__ int lds_byte(int r, int c) { const int st = (r >> 4) * 2 + (c >> 5), rr = r & 15, cc = c & 31, ob = rr * 64 + cc * 2; return st * 1024 + (ob ^ (((ob >> 9) & 1) << 5)); }
__device__ __forceinline__ void stage_rc(int b, int& R, int& C) { const int st = b / 1024, sb = b % 1024, swz = sb ^ (((sb >> 9) & 1) << 5); R = (st >> 1) * 16 + swz / 64; C = (st & 1) * 32 + (swz % 64) / 2; }
__device__ __forceinline__ int perm32(int rho) { const int n = rho >> 4, i = rho & 15; return 8 * (i >> 2) + 4 * n + (i & 3); }

struct Unit { int pm, pn; };
struct Gemm { const h16* A; const h16* Bt; int M, N, K; const h16* A2; const h16* Bt2; int ld, K2; };

struct StaticOrder {
    int nM, nN, nwg, G, c;
    __device__ void init(int M, int N, int G_, int c_) { nM = M / BM; nN = N / BM; nwg = nM * nN; G = G_; c = c_; }
    __device__ bool next(int i, Unit& u) const {
        const long L = (long)i * G + c; if (L >= nwg) return false;
        int wgid = (int)L; { const int q = nwg / NXCD, r = nwg % NXCD, xcd = wgid % NXCD, off = wgid / NXCD; wgid = (xcd < r ? xcd * (q + 1) : r * (q + 1) + (xcd - r) * q) + off; }
        const int nig = WGM * nN, gid = wgid / nig, fm = gid * WGM, rem = wgid - gid * nig;
        u.pm = fm + (rem % WGM); u.pn = rem / WGM; return true;
    }
};

template <class Epi>
__device__ __forceinline__ void gemm_phase(LAS unsigned char* lds, const Gemm g, const StaticOrder& S, const Epi& E) {
    const int tid = tid_(), wid = __builtin_amdgcn_readfirstlane(tid >> 6), lane = tid & 63, wr = wid >> 2, wc = wid & 3, fr = lane & 15, fq = lane >> 4;
    const int K = g.ld ? g.ld : g.K, nt0 = g.K / BK, nt1 = (g.K2 ? g.K2 : g.K) / BK;
    unsigned voffA[2], voffB[2];
#pragma unroll
    for (int i = 0; i < 2; ++i) { int R, C; stage_rc(tid * 16 + i * 8192, R, C); const int Rb = (R & ~31) + perm32(R & 31);
        voffA[i] = (unsigned)(R * K + C) * 2u; voffB[i] = (unsigned)(Rb * K + C) * 2u; }
    const size_t kstep = (size_t)(BK * 2);
    const size_t hstep = (size_t)HALF * K * 2;
    const size_t tstep = 2 * hstep;
    const unsigned ldsw = (unsigned)wid * 1024u;
    const int aoff = lds_byte(wr * 64 + fr, fq * 8), boff = lds_byte(wc * 32 + fr, fq * 8);
#define PG8_SA(b, h) (((b) * 2 + (h)) * HTB)
#define PG8_SB(b, h) ((4 + (b) * 2 + (h)) * HTB)
#define PG8_STAGE(bufoff, gbase, voff) do { _Pragma("unroll") for (int _i = 0; _i < 2; ++_i) \
        __builtin_amdgcn_global_load_lds((const unsigned*)((const char*)(gbase) + (voff)[_i]), (LAS unsigned*)(lds + (bufoff) + ldsw + _i * 8192), 16, 0, 0); } while (0)
#define PG8_LDA(dst, b, h) do { _Pragma("unroll") for (int m = 0; m < 4; ++m) _Pragma("unroll") for (int k = 0; k < 2; ++k) dst[m][k] = *(const LAS h16x8*)(lds + PG8_SA(b, h) + aoff + m * 2048 + k * 1024); } while (0)
#define PG8_LDB(dst, b, h) do { _Pragma("unroll") for (int n = 0; n < 2; ++n) _Pragma("unroll") for (int k = 0; k < 2; ++k) dst[n][k] = *(const LAS h16x8*)(lds + PG8_SB(b, h) + boff + n * 2048 + k * 1024); } while (0)
#define PG8_MMA(ai, bj, At, Bt) do { __builtin_amdgcn_s_setprio(1); _Pragma("unroll") for (int m = 0; m < 4; ++m) _Pragma("unroll") for (int n = 0; n < 2; ++n) _Pragma("unroll") for (int k = 0; k < 2; ++k) \
        acc[ai][bj][m][n] = __builtin_amdgcn_mfma_f32_16x16x32_f16(Bt[n][k], At[m][k], acc[ai][bj][m][n], 0, 0, 0); __builtin_amdgcn_s_setprio(0); } while (0)
#define PG8_WAIT_V(n) asm volatile("s_waitcnt vmcnt(" #n ")" ::: "memory")
#define PG8_WAIT_L(n) asm volatile("s_waitcnt lgkmcnt(" #n ")" ::: "memory")
#define PG8_BAR __builtin_amdgcn_s_barrier()
#define PG8_SCHED __builtin_amdgcn_sched_barrier(0)
    Unit cur, nxt; int ui = 0;
    constexpr bool TP = Epi::TWO_PART;
    if (!S.next(0, cur)) return;
    f32x4 acc[2][2][4][2];
#pragma unroll
    for (int a = 0; a < 2; ++a)
#pragma unroll
        for (int b = 0; b < 2; ++b)
#pragma unroll
            for (int m = 0; m < 4; ++m)
#pragma unroll
                for (int n = 0; n < 2; ++n) acc[a][b][m][n] = (f32x4){0.f, 0.f, 0.f, 0.f};
    h16x8 At[4][2], B0[2][2], B1[2][2];
    const char* cA = (const char*)g.A + (size_t)cur.pm * tstep; const char* cB = (const char*)g.Bt + (size_t)cur.pn * tstep;
    PG8_STAGE(PG8_SB(0, 0), cB, voffB); PG8_STAGE(PG8_SB(0, 1), cB + hstep, voffB); PG8_STAGE(PG8_SA(0, 0), cA, voffA); PG8_STAGE(PG8_SA(0, 1), cA + hstep, voffA);
    if (wr == 1) PG8_BAR;
    PG8_WAIT_V(2); PG8_BAR;
    PG8_STAGE(PG8_SB(1, 0), cB + kstep, voffB); PG8_STAGE(PG8_SA(1, 0), cA + kstep, voffA); PG8_STAGE(PG8_SB(1, 1), cB + hstep + kstep, voffB);
    PG8_WAIT_V(6); PG8_BAR;
    for (;;) {
        const bool has_next = TP ? (((ui + 1) & 1) ? (nxt = cur, true) : S.next((ui + 1) >> 1, nxt)) : S.next(ui + 1, nxt);
        const h16* gA_n = (TP && ((ui + 1) & 1)) ? g.A2 : g.A; const h16* gB_n = (TP && ((ui + 1) & 1)) ? g.Bt2 : g.Bt;
        const char* nA = has_next ? (const char*)gA_n + (size_t)nxt.pm * tstep : cA; const char* nB = has_next ? (const char*)gB_n + (size_t)nxt.pn * tstep : cB;
        const int nt = (TP && (ui & 1)) ? nt1 : nt0;
        for (int t = 0; t < nt; t += 2) {
            const bool last = (t == nt - 2);
            const char* a1 = cA + (size_t)(t + 1) * kstep;
            const char* a2 = last ? nA : cA + (size_t)(t + 2) * kstep; const char* b2 = last ? nB : cB + (size_t)(t + 2) * kstep;
            const char* a3 = a2 + kstep; const char* b3 = b2 + kstep;
            PG8_LDB(B0, 0, 0); PG8_LDB(B1, 0, 1); PG8_SCHED; PG8_LDA(At, 0, 0); PG8_STAGE(PG8_SA(1, 1), a1 + hstep, voffA);
            PG8_WAIT_V(8); PG8_WAIT_L(0); PG8_BAR; PG8_MMA(0, 0, At, B0); PG8_MMA(0, 1, At, B1); PG8_BAR; PG8_SCHED;
            PG8_LDA(At, 0, 1); PG8_STAGE(PG8_SB(0, 0), b2, voffB); PG8_STAGE(PG8_SB(0, 1), b2 + hstep, voffB); PG8_STAGE(PG8_SA(0, 0), a2, voffA);
            PG8_WAIT_V(8); PG8_WAIT_L(0); PG8_BAR; PG8_MMA(1, 0, At, B0); PG8_MMA(1, 1, At, B1); PG8_BAR; PG8_SCHED;
            PG8_LDB(B0, 1, 0); PG8_LDB(B1, 1, 1); PG8_SCHED; PG8_LDA(At, 1, 0); PG8_STAGE(PG8_SA(0, 1), a2 + hstep, voffA);
            PG8_WAIT_V(8); PG8_WAIT_L(0); PG8_BAR; PG8_MMA(0, 0, At, B0); PG8_MMA(0, 1, At, B1); PG8_BAR; PG8_SCHED;
            PG8_LDA(At, 1, 1); PG8_STAGE(PG8_SB(1, 0), b3, voffB); PG8_STAGE(PG8_SB(1, 1), b3 + hstep, voffB); PG8_STAGE(PG8_SA(1, 0), a3, voffA);
            PG8_WAIT_V(8); PG8_WAIT_L(0); PG8_BAR; PG8_MMA(1, 0, At, B0); PG8_MMA(1, 1, At, B1); PG8_BAR; PG8_SCHED;
        }
        if (wr == 0) PG8_BAR;
        if constexpr (TP) { if ((ui & 1) == 0) E.mid(acc, cur, wr, wc, fr, fq); else E(acc, cur, wr, wc, fr, fq); } else E(acc, cur, wr, wc, fr, fq);
        if (!has_next) break;
        bool keep = false; if constexpr (TP) keep = Epi::KEEP_ACC && ((ui & 1) == 0);
        if (!keep)
#pragma unroll
        for (int a = 0; a < 2; ++a)
#pragma unroll
            for (int b = 0; b < 2; ++b)
#pragma unroll
                for (int m = 0; m < 4; ++m)
#pragma unroll
                    for (int n = 0; n < 2; ++n) acc[a][b][m][n] = (f32x4){0.f, 0.f, 0.f, 0.f};
        cur = nxt; cA = nA; cB = nB; ++ui;
        if (wr == 1) PG8_BAR;
    }
    PG8_WAIT_V(0);
    PG8_BAR;
#undef PG8_SA
#undef PG8_SB
#undef PG8_STAGE
#undef PG8_LDA
#undef PG8_LDB
#undef PG8_MMA
#undef PG8_WAIT_V
#undef PG8_WAIT_L
#undef PG8_BAR
#undef PG8_SCHED
}
}
using pg8::Unit;
typedef const f32x4 (&AccRef)[2][2][4][2];

#define EPI_LOOP_BEGIN \
    _Pragma("unroll") for (int ai = 0; ai < 2; ++ai) _Pragma("unroll") for (int m = 0; m < 4; ++m) { \
        const int row = u.pm * 256 + ai * 128 + wr * 64 + m * 16 + fr; \
        _Pragma("unroll") for (int bj = 0; bj < 2; ++bj) { \
            const int col = u.pn * 256 + bj * 128 + wc * 32 + 8 * fq; \
            const f32x4 v0 = acc[ai][bj][m][0], v1 = acc[ai][bj][m][1];
#define EPI_LOOP_END } }

struct EpiZ {
    static constexpr bool TWO_PART = false;
    h16 *zc, *zr, *zg;
    __device__ __forceinline__ void operator()(AccRef acc, const Unit& u, int wr, int wc, int fr, int fq) const {
        const int colt = u.pn * 256; h16* base; int ld, c0;
        if (colt < 1536) { base = zc; ld = 1536; c0 = colt; } else if (colt < 3328) { base = zr; ld = 1792; c0 = colt - 1536; } else { base = zg; ld = 2048; c0 = colt - 3328; }
        EPI_LOOP_BEGIN
            *(h16x8*)(base + (size_t)row * ld + (col - colt + c0)) = pack8(v0, v1);
        EPI_LOOP_END
    }
};
struct EpiF16 {
    static constexpr bool TWO_PART = false;
    h16* O; int ld;
    __device__ __forceinline__ void operator()(AccRef acc, const Unit& u, int wr, int wc, int fr, int fq) const {
        EPI_LOOP_BEGIN
            *(h16x8*)(O + (size_t)row * ld + col) = pack8(v0, v1);
        EPI_LOOP_END
    }
};
struct EpiMerged {
    static constexpr bool TWO_PART = true, KEEP_ACC = true;
    const h16* zg; h16* merged;
    __device__ __forceinline__ void mid(f32x4 (&acc)[2][2][4][2], const Unit& u, int wr, int wc, int fr, int fq) const {
#pragma unroll
        for (int ai = 0; ai < 2; ++ai) {
            h16x8 gav[4][2], gbv[4][2];
#pragma unroll
            for (int m = 0; m < 4; ++m) { const int row = u.pm * 256 + ai * 128 + wr * 64 + m * 16 + fr;
#pragma unroll
                for (int bj = 0; bj < 2; ++bj) { const int col = u.pn * 256 + bj * 128 + wc * 32 + 8 * fq;
                    gav[m][bj] = *(const h16x8*)(zg + (size_t)row * 2048 + col); gbv[m][bj] = *(const h16x8*)(zg + (size_t)row * 2048 + 1024 + col); } }
#pragma unroll
            for (int m = 0; m < 4; ++m)
#pragma unroll
                for (int bj = 0; bj < 2; ++bj) { const h16x8 ga = gav[m][bj], gb = gbv[m][bj];
#pragma unroll
                    for (int j = 0; j < 4; ++j) {
                        acc[ai][bj][m][0][j] *= (1.0f + __expf(-(float)gb[j])) * __builtin_amdgcn_rcpf(1.0f + __expf(-(float)ga[j]));
                        acc[ai][bj][m][1][j] *= (1.0f + __expf(-(float)gb[4 + j])) * __builtin_amdgcn_rcpf(1.0f + __expf(-(float)ga[4 + j])); } }
        }
    }
    __device__ __forceinline__ void operator()(AccRef acc, const Unit& u, int wr, int wc, int fr, int fq) const {
#pragma unroll
        for (int ai = 0; ai < 2; ++ai) {
            h16x8 gvv[4][2];
#pragma unroll
            for (int m = 0; m < 4; ++m) { const int row = u.pm * 256 + ai * 128 + wr * 64 + m * 16 + fr;
#pragma unroll
                for (int bj = 0; bj < 2; ++bj) { const int col = u.pn * 256 + bj * 128 + wc * 32 + 8 * fq; gvv[m][bj] = *(const h16x8*)(zg + (size_t)row * 2048 + 1024 + col); } }
#pragma unroll
            for (int m = 0; m < 4; ++m) { const int row = u.pm * 256 + ai * 128 + wr * 64 + m * 16 + fr;
#pragma unroll
                for (int bj = 0; bj < 2; ++bj) { const int col = u.pn * 256 + bj * 128 + wc * 32 + 8 * fq;
                    const h16x8 gv = gvv[m][bj]; const f32x4 v0 = acc[ai][bj][m][0], v1 = acc[ai][bj][m][1];
                    f32x4 o0, o1;
#pragma unroll
                    for (int j = 0; j < 4; ++j) { o0[j] = sigmoidf_((float)gv[j]) * v0[j]; o1[j] = sigmoidf_((float)gv[4 + j]) * v1[j]; }
                    *(h16x8*)(merged + (size_t)row * 1024 + col) = pack8(o0, o1); } }
        }
    }
};
struct EpiH1 {
    static constexpr bool TWO_PART = false;
    const float* x; h16* hb; float* part;
    __device__ __forceinline__ void operator()(AccRef acc, const Unit& u, int wr, int wc, int fr, int fq) const {
#pragma unroll
        for (int ai = 0; ai < 2; ++ai) {
            f32x4 xv[4][2][2];
#pragma unroll
            for (int m = 0; m < 4; ++m) { const int row = u.pm * 256 + ai * 128 + wr * 64 + m * 16 + fr;
#pragma unroll
                for (int bj = 0; bj < 2; ++bj) { const int col = u.pn * 256 + bj * 128 + wc * 32 + 8 * fq; const float* xp = x + (size_t)row * 1024 + col;
                    xv[m][bj][0] = *(const f32x4*)xp; xv[m][bj][1] = *(const f32x4*)(xp + 4); } }
#pragma unroll
            for (int m = 0; m < 4; ++m) {
                const int row = u.pm * 256 + ai * 128 + wr * 64 + m * 16 + fr; float ss = 0.f;
#pragma unroll
                for (int bj = 0; bj < 2; ++bj) {
                    const int col = u.pn * 256 + bj * 128 + wc * 32 + 8 * fq;
                    const f32x4 o0 = xv[m][bj][0] + acc[ai][bj][m][0], o1 = xv[m][bj][1] + acc[ai][bj][m][1];
                    *(h16x8*)(hb + (size_t)row * 1024 + col) = pack8(o0, o1);
                    ss += (o0[0] * o0[0] + o0[1] * o0[1]) + (o0[2] * o0[2] + o0[3] * o0[3]) + (o1[0] * o1[0] + o1[1] * o1[1]) + (o1[2] * o1[2] + o1[3] * o1[3]);
                }
                { const int ln_ = fr + 16 * fq; ss += x16_(ss, ln_); ss += x32_(ss, ln_); }
                if (fq == 0) part[(size_t)row * 16 + u.pn * 4 + wc] = ss;
            }
        }
    }
};
struct EpiGate {
    static constexpr bool TWO_PART = false;
    h16* h3b; const h16* h2b; const h16* pp; const float* rs2; float* part;
    __device__ __forceinline__ void operator()(AccRef acc, const Unit& u, int wr, int wc, int fr, int fq) const {
#pragma unroll
        for (int ai = 0; ai < 2; ++ai) {
            float rsv[4]; h16x8 hvv[4][2], pvv[4][2];
            { f32x4 sav[4], sbv[4];
#pragma unroll
              for (int m = 0; m < 4; ++m) { const int row = u.pm * 256 + ai * 128 + wr * 64 + m * 16 + fr; sav[m] = *(const f32x4*)(rs2 + (size_t)row * 8); sbv[m] = *(const f32x4*)(rs2 + (size_t)row * 8 + 4); }
#pragma unroll
              for (int m = 0; m < 4; ++m) { const f32x4 sa = sav[m], sb = sbv[m]; rsv[m] = rsqrtf(((sa[0] + sa[1]) + (sa[2] + sa[3]) + (sb[0] + sb[1]) + (sb[2] + sb[3])) * (1.f / 1024.f) + NORM_EPS); } }
#pragma unroll
            for (int m = 0; m < 4; ++m) { const int row = u.pm * 256 + ai * 128 + wr * 64 + m * 16 + fr;
#pragma unroll
                for (int bj = 0; bj < 2; ++bj) { const int col = u.pn * 256 + bj * 128 + wc * 32 + 8 * fq;
                    hvv[m][bj] = *(const h16x8*)(h2b + (size_t)row * 1024 + col); pvv[m][bj] = *(const h16x8*)(pp + (size_t)row * 1024 + col); } }
#pragma unroll
            for (int m = 0; m < 4; ++m) {
                const int row = u.pm * 256 + ai * 128 + wr * 64 + m * 16 + fr; float ss = 0.f;
                const float rs = rsv[m];
#pragma unroll
                for (int bj = 0; bj < 2; ++bj) {
                    const int col = u.pn * 256 + bj * 128 + wc * 32 + 8 * fq;
                    const h16x8 hv = hvv[m][bj];
                    f32x4 o0 = (f32x4){(float)hv[0], (float)hv[1], (float)hv[2], (float)hv[3]}, o1 = (f32x4){(float)hv[4], (float)hv[5], (float)hv[6], (float)hv[7]};
                    const h16x8 pv = pvv[m][bj];
                    const f32x4 v0 = acc[ai][bj][m][0], v1 = acc[ai][bj][m][1];
#pragma unroll
                    for (int j = 0; j < 4; ++j) { o0[j] += sigmoidf_(rs * v0[j]) * (float)pv[j]; o1[j] += sigmoidf_(rs * v1[j]) * (float)pv[4 + j]; }
                    *(h16x8*)(h3b + (size_t)row * 1024 + col) = pack8(o0, o1);
                    ss += (o0[0] * o0[0] + o0[1] * o0[1]) + (o0[2] * o0[2] + o0[3] * o0[3]) + (o1[0] * o1[0] + o1[1] * o1[1]) + (o1[2] * o1[2] + o1[3] * o1[3]);
                }
                { const int ln_ = fr + 16 * fq; ss += x16_(ss, ln_); ss += x32_(ss, ln_); }
                if (fq == 0) part[(size_t)row * 16 + u.pn * 4 + wc] = ss;
            }
        }
    }
};
struct EpiPPGate {
    static constexpr bool TWO_PART = true, KEEP_ACC = false;
    h16* h3b; const h16* h2b; h16* pp; const float* rs2; float* part;
    __device__ __forceinline__ void mid(f32x4 (&acc)[2][2][4][2], const Unit& u, int wr, int wc, int fr, int fq) const {
#pragma unroll
        for (int ai = 0; ai < 2; ++ai)
#pragma unroll
            for (int m = 0; m < 4; ++m) { const int row = u.pm * 256 + ai * 128 + wr * 64 + m * 16 + fr;
#pragma unroll
                for (int bj = 0; bj < 2; ++bj) { const int col = u.pn * 256 + bj * 128 + wc * 32 + 8 * fq;
                    *(h16x8*)(pp + (size_t)row * 1024 + col) = pack8(acc[ai][bj][m][0], acc[ai][bj][m][1]); } }
    }
    __device__ __forceinline__ void operator()(AccRef acc, const Unit& u, int wr, int wc, int fr, int fq) const {
#pragma unroll
        for (int ai = 0; ai < 2; ++ai) {
            float rsv[4]; h16x8 hvv[4][2], pvv[4][2];
            { f32x4 sav[4], sbv[4];
#pragma unroll
              for (int m = 0; m < 4; ++m) { const int row = u.pm * 256 + ai * 128 + wr * 64 + m * 16 + fr; sav[m] = *(const f32x4*)(rs2 + (size_t)row * 8); sbv[m] = *(const f32x4*)(rs2 + (size_t)row * 8 + 4); }
#pragma unroll
              for (int m = 0; m < 4; ++m) { const f32x4 sa = sav[m], sb = sbv[m]; rsv[m] = rsqrtf(((sa[0] + sa[1]) + (sa[2] + sa[3]) + (sb[0] + sb[1]) + (sb[2] + sb[3])) * (1.f / 1024.f) + NORM_EPS); } }
#pragma unroll
          for (int m2 = 0; m2 < 4; m2 += 2) {
#pragma unroll
            for (int m = m2; m < m2 + 2; ++m) { const int row = u.pm * 256 + ai * 128 + wr * 64 + m * 16 + fr;
#pragma unroll
                for (int bj = 0; bj < 2; ++bj) { const int col = u.pn * 256 + bj * 128 + wc * 32 + 8 * fq;
                    hvv[m][bj] = *(const h16x8*)(h2b + (size_t)row * 1024 + col); pvv[m][bj] = *(const h16x8*)(pp + (size_t)row * 1024 + col); } }
#pragma unroll
            for (int m = m2; m < m2 + 2; ++m) {
                const int row = u.pm * 256 + ai * 128 + wr * 64 + m * 16 + fr; float ss = 0.f;
                const float rs = rsv[m];
#pragma unroll
                for (int bj = 0; bj < 2; ++bj) {
                    const int col = u.pn * 256 + bj * 128 + wc * 32 + 8 * fq;
                    const h16x8 hv = hvv[m][bj];
                    f32x4 o0 = (f32x4){(float)hv[0], (float)hv[1], (float)hv[2], (float)hv[3]}, o1 = (f32x4){(float)hv[4], (float)hv[5], (float)hv[6], (float)hv[7]};
                    const h16x8 pv = pvv[m][bj];
                    const f32x4 v0 = acc[ai][bj][m][0], v1 = acc[ai][bj][m][1];
#pragma unroll
                    for (int j = 0; j < 4; ++j) { o0[j] += sigmoidf_(rs * v0[j]) * (float)pv[j]; o1[j] += sigmoidf_(rs * v1[j]) * (float)pv[4 + j]; }
                    *(h16x8*)(h3b + (size_t)row * 1024 + col) = pack8(o0, o1);
                    ss += (o0[0] * o0[0] + o0[1] * o0[1]) + (o0[2] * o0[2] + o0[3] * o0[3]) + (o1[0] * o1[0] + o1[1] * o1[1]) + (o1[2] * o1[2] + o1[3] * o1[3]);
                }
                { const int ln_ = fr + 16 * fq; ss += x16_(ss, ln_); ss += x32_(ss, ln_); }
                if (fq == 0) part[(size_t)row * 16 + u.pn * 4 + wc] = ss;
            }
          }
        }
    }
};

__device__ __forceinline__ void tr_item(const float* W, int N, const float* g, h16* WT, int ldk, int koff, int k0, int n0, LAS float* scr, int lane) {
#pragma unroll 8
    for (int i = 0; i < 32; ++i) { const int kk = 2 * i + (lane >> 5); float v = W[(size_t)(k0 + kk) * N + n0 + (lane & 31)]; if (g) v *= g[k0 + kk]; scr[kk * 33 + (lane & 31)] = v; }
    asm volatile("s_waitcnt lgkmcnt(0)" ::: "memory");
    const int c = lane & 7;
#pragma unroll
    for (int j = 0; j < 4; ++j) { const int n = (lane >> 3) + 8 * j; const LAS float* s = scr + (8 * c) * 33 + n;
        h16x8 o;
#pragma unroll
        for (int e = 0; e < 8; ++e) o[e] = (h16)s[e * 33];
        *(h16x8*)(WT + (size_t)(n0 + n) * ldk + koff + k0 + 8 * c) = o; }
    asm volatile("s_waitcnt lgkmcnt(0)" ::: "memory");
}
struct TrJob { const float* W; const float* g; h16* WT; int K, N, ldk, koff; };

__device__ __forceinline__ void phase_prep(const Args& a, LAS unsigned char* lds) {
    const int tid = tid_(), lane = tid & 63, wave = tid >> 6;
    const int gw = blockIdx.x * NWAVES + wave, NGW = gridDim.x * NWAVES;
    unsigned char* ws = a.ws;
    {
        LAS float* scr = (LAS float*)(lds + wave * 8704);
        TrJob jobs[9] = {
            {a.in[3], a.in[2], (h16*)(ws + O_WIN), 1024, NIN, 1024, 0},
            {a.in[17], nullptr, (h16*)(ws + O_WA), 512, 1024, 512, 0},
            {a.in[18], nullptr, (h16*)(ws + O_WB), 512, 1024, 512, 0},
            {a.in[19], nullptr, (h16*)(ws + O_WO), 1024, 1024, 1024, 0},
            {a.in[26], a.in[25], (h16*)(ws + O_WG), 1024, 1024, 1024, 0},
            {a.in[27], nullptr, (h16*)(ws + O_WP), 256, 1024, 1024, 0},
            {a.in[8], nullptr, (h16*)(ws + O_WLR), 64, 512, 256, 0},
            {a.in[10], nullptr, (h16*)(ws + O_WLR) + (size_t)512 * 256, 64, 512, 256, 64},
            {a.in[11], nullptr, (h16*)(ws + O_WLR) + (size_t)1024 * 256, 128, 512, 256, 128},
        };
        int base = 0;
#pragma unroll
        for (int j = 0; j < 9; ++j) {
            const TrJob J = jobs[j]; const int nnb = J.N / 32, items = (J.K / 64) * nnb;
            int first = gw - (base % NGW); if (first < 0) first += NGW;
            for (int r = first; r < items; r += NGW) tr_item(J.W, J.N, J.g, J.WT, J.ldk, J.koff, (r / nnb) * 64, (r % nnb) * 32, scr, lane);
            base += items;
        }
        h16* wlr = (h16*)(ws + O_WLR);
        for (int i = blockIdx.x * NTHREADS + tid; i < 1536 * 256 / 8; i += gridDim.x * NTHREADS) {
            const int n = (i * 8) / 256, k = (i * 8) % 256; const int blk = n / 512;
            const bool inblk = (blk == 0) ? (k < 64) : (blk == 1) ? (k >= 64 && k < 128) : (k >= 128);
            if (!inblk) { h16x8 z; for (int e = 0; e < 8; ++e) z[e] = (h16)0.f; *(h16x8*)(wlr + (size_t)i * 8) = z; }
        }
    }
    __syncthreads();
    {
        LAS float* LA = (LAS float*)lds;
        LAS float* LB = (LAS float*)(lds + 64 * 129 * 4);
        const float* wq = a.in[21]; const float* sk = a.in[22]; const float* gf = a.in[20];
        h16* wst = (h16*)(ws + O_WS);
        for (int it = blockIdx.x; it < 256; it += gridDim.x) {
            const int g16 = it >> 4, k0 = (it & 15) * 64;
            for (int i = tid; i < 64 * 128; i += NTHREADS) { const int k = i >> 7, d = i & 127; LA[k * 129 + d] = wq[(size_t)(k0 + k) * 2048 + g16 * 128 + d] * gf[k0 + k]; }
            for (int i = tid; i < 128 * 128; i += NTHREADS) { const int n = i >> 7, d = i & 127; LB[n * 129 + d] = sk[((size_t)g16 * 128 + n) * 128 + d]; }
            __syncthreads();
            const int n = tid & 127, kg = tid >> 7;
            float o[16];
#pragma unroll
            for (int j = 0; j < 16; ++j) o[j] = 0.f;
            for (int d = 0; d < 128; ++d) { const float b = LB[n * 129 + d];
#pragma unroll
                for (int j = 0; j < 16; ++j) o[j] += LA[(kg * 16 + j) * 129 + d] * b; }
            h16x8 o0, o1;
#pragma unroll
            for (int j = 0; j < 8; ++j) { o0[j] = (h16)o[j]; o1[j] = (h16)o[8 + j]; }
            h16* dst = wst + (size_t)(g16 * 128 + n) * 1024 + k0 + kg * 16;
            *(h16x8*)dst = o0; *(h16x8*)(dst + 8) = o1;
            __syncthreads();
        }
    }
    {
        const float* gf = a.in[20];
        f32x4 g4[4];
#pragma unroll
        for (int j = 0; j < 4; ++j) g4[j] = *(const f32x4*)(gf + 16 * lane + 4 * j);
        for (int r = gw; r < 2 * 16384; r += NGW) {
            const int tb = r >> 14, e = r & 16383;
            const float* src = (tb ? a.in[24] : a.in[23]) + (size_t)e * 1024 + 16 * lane;
            f32x4 v[4]; float mx = 0.f;
#pragma unroll
            for (int j = 0; j < 4; ++j) { v[j] = *(const f32x4*)(src + 4 * j); if (!tb) v[j] = v[j] * g4[j];
#pragma unroll
                for (int c = 0; c < 4; ++c) mx = fmaxf(mx, fabsf(v[j][c])); }
            mx = wave_max(mx);
            mx = fmaxf(mx, 1e-30f);
            const float sc = 127.0f / mx;
            u32x4 q;
#pragma unroll
            for (int j = 0; j < 4; ++j) {
                const int i0 = __float2int_rn(v[j][0] * sc), i1 = __float2int_rn(v[j][1] * sc), i2 = __float2int_rn(v[j][2] * sc), i3 = __float2int_rn(v[j][3] * sc);
                q[j] = (unsigned)(i0 & 0xff) | ((unsigned)(i1 & 0xff) << 8) | ((unsigned)(i2 & 0xff) << 16) | ((unsigned)i3 << 24); }
            unsigned char* dst = ws + (tb ? O_V8 : O_U8) + ((size_t)(lane >> 3) * 16384 + e) * 128 + 16 * (lane & 7);
            *(u32x4*)dst = q;
            if (lane == 0) ((float*)(ws + (tb ? O_VSC : O_USC)))[e] = mx * (1.0f / 127.0f);
        }
        if (blockIdx.x == 0 && tid < 32) ((unsigned*)(ws + O_CTR))[tid * 64] = 0u;
    }
    {
        const float* x = a.in[0]; h16* xn = (h16*)(ws + O_XN);
        for (int rq = gw; rq < MTOK; rq += 4 * NGW) {
            f32x4 v[4][4];
#pragma unroll
            for (int q = 0; q < 4; ++q) { const int r = rq + q * NGW; if (r < MTOK) { const f32x4* xr = (const f32x4*)(x + (size_t)r * 1024) + lane;
#pragma unroll
                for (int j = 0; j < 4; ++j) v[q][j] = xr[64 * j]; } }
#pragma unroll
            for (int q = 0; q < 4; ++q) { const int r = rq + q * NGW; if (r < MTOK) { float s = 0.f;
#pragma unroll
                for (int j = 0; j < 4; ++j) s += (v[q][j][0] * v[q][j][0] + v[q][j][1] * v[q][j][1]) + (v[q][j][2] * v[q][j][2] + v[q][j][3] * v[q][j][3]);
                const float rs = rsqrtf(wave_sum(s) * (1.f / 1024.f) + NORM_EPS);
                h16x4* o = (h16x4*)(xn + (size_t)r * 1024) + lane;
#pragma unroll
                for (int j = 0; j < 4; ++j) o[64 * j] = pack4(v[q][j] * rs); } }
        }
    }
}

__device__ __forceinline__ void phase_conv(const Args& a) {
    const int tid = tid_(), lane = tid & 63, wave = tid >> 6;
    const int gw = blockIdx.x * NWAVES + wave, NGW = gridDim.x * NWAVES;
    const h16* zc = (const h16*)(a.ws + O_ZC); h16* ca = (h16*)(a.ws + O_CA);
    const float* cw = a.in[4]; const float* cb = a.in[5];
    float w0[8], w1[8], w2[8], bb[8];
#pragma unroll
    for (int j = 0; j < 8; ++j) { const int c = lane * 8 + j; w0[j] = cw[c]; w1[j] = cw[512 + c]; w2[j] = cw[1024 + c]; bb[j] = cb[c]; }
    for (int run = gw; run < MTOK / 32; run += NGW) {
        const int t0 = run * 32;
        float u1[8], u2[8];
        if ((t0 % SEQ) == 0) {
#pragma unroll
            for (int j = 0; j < 8; ++j) { u1[j] = 0.f; u2[j] = 0.f; }
        } else {
            const h16x8 c1 = *(const h16x8*)(zc + (size_t)(t0 - 1) * 1536 + 512 + lane * 8), x1 = *(const h16x8*)(zc + (size_t)(t0 - 1) * 1536 + 1024 + lane * 8);
            const h16x8 c2 = *(const h16x8*)(zc + (size_t)(t0 - 2) * 1536 + 512 + lane * 8), x2 = *(const h16x8*)(zc + (size_t)(t0 - 2) * 1536 + 1024 + lane * 8);
#pragma unroll
            for (int j = 0; j < 8; ++j) { u1[j] = (float)c1[j] * (float)x1[j]; u2[j] = (float)c2[j] * (float)x2[j]; }
        }
#define CV_LOAD(GB, GC, XI, TB) do { _Pragma("unroll") for (int q = 0; q < 4; ++q) { const h16* zrow = zc + (size_t)((TB) + q) * 1536 + lane * 8; GB[q] = *(const h16x8*)zrow; GC[q] = *(const h16x8*)(zrow + 512); XI[q] = *(const h16x8*)(zrow + 1024); } } while (0)
#define CV_COMP(GB, GC, XI, TB) do { _Pragma("unroll") for (int q = 0; q < 4; ++q) { const int t = (TB) + q; const h16x8 gb = GB[q], gc = GC[q], xi = XI[q]; \
                h16x8 o; \
                _Pragma("unroll") for (int j = 0; j < 8; ++j) { const float u0 = (float)gc[j] * (float)xi[j]; \
                    const float y = w0[j] * u2[j] + w1[j] * u1[j] + w2[j] * u0 + bb[j]; \
                    o[j] = (h16)((float)gb[j] * y); u2[j] = u1[j]; u1[j] = u0; } \
                *(h16x8*)(ca + (size_t)t * 512 + lane * 8) = o; } } while (0)
        h16x8 gbA[4], gcA[4], xiA[4], gbB[4], gcB[4], xiB[4];
        CV_LOAD(gbA, gcA, xiA, t0);
        for (int tb = t0; tb < t0 + 32; tb += 8) {
            CV_LOAD(gbB, gcB, xiB, tb + 4);
            CV_COMP(gbA, gcA, xiA, tb);
            if (tb + 8 < t0 + 32) CV_LOAD(gbA, gcA, xiA, tb + 8);
            CV_COMP(gbB, gcB, xiB, tb + 4);
        }
#undef CV_LOAD
#undef CV_COMP
    }
}


__device__ __forceinline__ float tanhf_(float x) { return 1.0f - 2.0f * __builtin_amdgcn_rcpf(1.0f + __expf(2.0f * x)); }
__device__ __forceinline__ void phase_rwkv_prep(const Args& a) {
    const int tid = tid_(), lane = tid & 63, wave = tid >> 6;
    const int gw = blockIdx.x * NWAVES + wave, NGW = gridDim.x * NWAVES;
    const h16* zr = (const h16*)(a.ws + O_ZR);
    h16* R = (h16*)a.out; h16* KS = R + (size_t)MTOK * 512; h16* V = KS + (size_t)MTOK * 512; h16* KK = V + (size_t)MTOK * 512;
    h16* APR = (h16*)(a.ws + O_APR);
    const float* mu = a.in[6]; const float* k_k = a.in[12];
    float mr[8], mk[8], mv[8], mt[8], kk8[8];
#pragma unroll
    for (int j = 0; j < 8; ++j) { const int c = lane * 8 + j; mr[j] = mu[c]; mk[j] = mu[512 + c]; mv[j] = mu[1024 + c]; mt[j] = mu[1536 + (c & 255)]; kk8[j] = k_k[c]; }
    for (int run = gw; run < MTOK / 32; run += NGW) {
        const int t0 = run * 32;
        float pr[8], pk[8], pv[8], pt[8];
        if ((t0 % SEQ) == 0) {
#pragma unroll
            for (int j = 0; j < 8; ++j) { pr[j] = 0.f; pk[j] = 0.f; pv[j] = 0.f; pt[j] = 0.f; }
        } else {
            const h16* zp = zr + (size_t)(t0 - 1) * 1792 + lane * 8;
            const h16x8 a0 = *(const h16x8*)zp, a1 = *(const h16x8*)(zp + 512), a2 = *(const h16x8*)(zp + 1024), a3 = *(const h16x8*)(zr + (size_t)(t0 - 1) * 1792 + 1536 + (lane & 31) * 8);
#pragma unroll
            for (int j = 0; j < 8; ++j) { pr[j] = (float)a0[j]; pk[j] = (float)a1[j]; pv[j] = (float)a2[j]; pt[j] = (float)a3[j]; }
        }
#define RP_LOAD(A0, A1, A2, A3, TB) do { _Pragma("unroll") for (int q = 0; q < 2; ++q) { const h16* zp = zr + (size_t)((TB) + q) * 1792 + lane * 8; \
                A0[q] = *(const h16x8*)zp; A1[q] = *(const h16x8*)(zp + 512); A2[q] = *(const h16x8*)(zp + 1024); A3[q] = *(const h16x8*)(zr + (size_t)((TB) + q) * 1792 + 1536 + (lane & 31) * 8); } } while (0)
#define RP_COMP(A0, A1, A2, A3, TB) do { _Pragma("unroll") for (int q = 0; q < 2; ++q) { const int t = (TB) + q; const h16x8 a0 = A0[q], a1 = A1[q], a2 = A2[q], a3 = A3[q]; \
            h16x8 orr, ok, ov, okk, ot; float kr[8]; float ss = 0.f; \
            _Pragma("unroll") for (int j = 0; j < 8; ++j) { \
                const float zr_ = (float)a0[j], zk_ = (float)a1[j], zv_ = (float)a2[j], zt_ = (float)a3[j]; \
                const float r = zr_ + mr[j] * (pr[j] - zr_), k = zk_ + mk[j] * (pk[j] - zk_), v = zv_ + mv[j] * (pv[j] - zv_), tl = zt_ + mt[j] * (pt[j] - zt_); \
                pr[j] = zr_; pk[j] = zk_; pv[j] = zv_; pt[j] = zt_; \
                orr[j] = (h16)r; ok[j] = (h16)k; ov[j] = (h16)v; \
                kr[j] = k * kk8[j]; ss += kr[j] * kr[j]; \
                  \
                const float rc = __builtin_amdgcn_rcpf(1.0f + __expf(tsc * tl)); \
                const float tv = (lane < 8) ? (1.0f - 2.0f * rc) : (lane < 16) ? tl : rc; \
                ot[j] = (h16)tv; \
            } \
            ss += dpp_<0xB1>(ss); ss += dpp_<0x4E>(ss); ss += xhm_(ss);     \
            const float rn = rsqrtf(ss + 1e-12f); \
            _Pragma("unroll") for (int j = 0; j < 8; ++j) okk[j] = (h16)(kr[j] * rn); \
            const size_t o = (size_t)t * 512 + lane * 8; \
            *(h16x8*)(R + o) = orr; *(h16x8*)(KS + o) = ok; *(h16x8*)(V + o) = ov; *(h16x8*)(KK + o) = okk; \
            if (lane < 32) *(h16x8*)(APR + (size_t)t * 256 + lane * 8) = ot; } } while (0)
        const float tsc = (lane < 8) ? 2.0f : -1.0f;
        h16x8 a0A[2], a1A[2], a2A[2], a3A[2], a0B[2], a1B[2], a2B[2], a3B[2];
        RP_LOAD(a0A, a1A, a2A, a3A, t0);
        for (int tb = t0; tb < t0 + 32; tb += 4) {
            RP_LOAD(a0B, a1B, a2B, a3B, tb + 2);
            RP_COMP(a0A, a1A, a2A, a3A, tb);
            if (tb + 4 < t0 + 32) RP_LOAD(a0A, a1A, a2A, a3A, tb + 4);
            RP_COMP(a0B, a1B, a2B, a3B, tb + 2);
        }
#undef RP_LOAD
#undef RP_COMP
    }
}

struct EpiLR {
    static constexpr bool TWO_PART = false;
    const float *w0, *a0, *k_a; h16 *WD, *KS, *BD, *GG; const h16* KK;
    __device__ __forceinline__ void operator()(AccRef acc, const Unit& u, int wr, int wc, int fr, int fq) const {
        const int part = u.pn >> 1;
        EPI_LOOP_BEGIN
            const int c = col - part * 512; const size_t o = (size_t)row * 512 + c;
            if (part == 0) {
                const f32x4 b0 = *(const f32x4*)(w0 + c), b1 = *(const f32x4*)(w0 + c + 4); f32x4 o0, o1;
#pragma unroll
                for (int j = 0; j < 4; ++j) { o0[j] = __expf(-0.6065306597126334f * sigmoidf_(b0[j] + v0[j])); o1[j] = __expf(-0.6065306597126334f * sigmoidf_(b1[j] + v1[j])); }
                *(h16x8*)(WD + o) = pack8(o0, o1);
            } else if (part == 1) {
                const f32x4 b0 = *(const f32x4*)(a0 + c), b1 = *(const f32x4*)(a0 + c + 4), ka0 = *(const f32x4*)(k_a + c), ka1 = *(const f32x4*)(k_a + c + 4);
                const h16x8 ks = *(const h16x8*)(KS + o), kk = *(const h16x8*)(KK + o); f32x4 k0, k1, bb0, bb1;
#pragma unroll
                for (int j = 0; j < 4; ++j) { const float aa0 = sigmoidf_(b0[j] + v0[j]), aa1 = sigmoidf_(b1[j] + v1[j]);
                    k0[j] = (float)ks[j] * (1.0f + (aa0 - 1.0f) * ka0[j]); k1[j] = (float)ks[4 + j] * (1.0f + (aa1 - 1.0f) * ka1[j]);
                    bb0[j] = aa0 * (float)kk[j]; bb1[j] = aa1 * (float)kk[4 + j]; }
                *(h16x8*)(KS + o) = pack8(k0, k1); *(h16x8*)(BD + o) = pack8(bb0, bb1);
            } else {
                *(h16x8*)(GG + o) = pack8(v0, v1);
            }
        EPI_LOOP_END
    }
};

constexpr size_t O_VTB = O_ZR;
constexpr size_t O_BON = O_ZR + 64 * MiB;
constexpr int UT_WAVE_LDS = 15360;
typedef float f32x16 __attribute__((ext_vector_type(16)));
__device__ __forceinline__ size_t ut_ov(int j, int s) { return (size_t)(j >> 2) * 512 + (j & 3) * 16 + s; }
constexpr int UT_SEG = 8, UT_SEGB = SEQ / 16 / UT_SEG;
__device__ __forceinline__ void phase_ut_pre(const Args& a, LAS unsigned char* lds, int seg, int gw, int NGW) {
    const int tid = tid_(), lane = tid & 63, wave = tid >> 6;
    LAS unsigned char* Lb = lds + wave * UT_WAVE_LDS;
    LAS h16* YX = (LAS h16*)Lb;
    LAS float* GT = (LAS float*)(Lb + 9216);
    LAS float* TM = (LAS float*)(Lb + 13824);
    h16* R = (h16*)a.out; h16* KS = R + (size_t)MTOK * 512; h16* V = KS + (size_t)MTOK * 512; h16* KK = V + (size_t)MTOK * 512;
    h16* WD = (h16*)(a.ws + O_WD); h16* BD = (h16*)(a.ws + O_BD);
    h16* VTB = (h16*)(a.ws + O_VTB); float* BON = (float*)(a.ws + O_BON);
    for (int wi = gw; wi < 32768 / UT_SEG; wi += NGW) {
        const int bh = ((((wi / (UT_SEGB * 8)) * (SEQ / 16)) + seg * UT_SEGB + ((wi % (UT_SEGB * 8)) >> 3)) << 3) | (wi & 7);
        int ln = lane; asm volatile("" : "+v"(ln)); const int r16 = ln & 15;
        const int h = bh & 7, nb = bh >> 3; const size_t tok0 = (size_t)nb * 16; const size_t e0 = tok0 * 512 + h * 64;
        const float rk = a.in[14][h * 64 + lane];
        {
            h16x8 stg[12];
#pragma unroll
            for (int j = 0; j < 12; ++j) { const int ar = j >> 1, row = (lane >> 3) + 8 * (j & 1);
                const h16* base = (ar == 0) ? WD : (ar == 1) ? KK : (ar == 2) ? BD : (ar == 3) ? KS : (ar == 4) ? R : V;
                stg[j] = *(const h16x8*)(base + e0 + (size_t)row * 512 + (lane & 7) * 8); }
#pragma unroll
            for (int j = 0; j < 12; ++j) *(LAS h16x8*)((LAS h16*)Lb + ((j >> 1) * 16 + (lane >> 3) + 8 * (j & 1)) * 64 + (lane & 7) * 8) = stg[j];
            asm volatile("s_waitcnt lgkmcnt(0)" ::: "memory");
        }
        float w[16], kk[16], bb[16], kx[16], rr[16]; h16x8 vt0, vt1;
        { const LAS h16* IN = (const LAS h16*)Lb;
#pragma unroll
        for (int t = 0; t < 16; ++t) { w[t] = (float)IN[t * 64 + lane]; kk[t] = (float)IN[(16 + t) * 64 + lane]; bb[t] = (float)IN[(32 + t) * 64 + lane]; kx[t] = (float)IN[(48 + t) * 64 + lane]; rr[t] = (float)IN[(64 + t) * 64 + lane];
            if (t < 8) vt0[t] = IN[(80 + t) * 64 + lane]; else vt1[t - 8] = IN[(80 + t) * 64 + lane]; } }
        asm volatile("s_waitcnt lgkmcnt(0)" ::: "memory");
        { h16* vp = VTB + (size_t)bh * 1024 + lane * 16; *(h16x8*)vp = vt0; *(h16x8*)(vp + 8) = vt1; }
        {
            float q8[8], q4[4], q2[2];
#pragma unroll
            for (int i = 0; i < 8; ++i) q8[i] = swap_add32(rr[i] * kx[i] * rk, rr[i + 8] * kx[i + 8] * rk);
#pragma unroll
            for (int i = 0; i < 4; ++i) q4[i] = swap_add16(q8[i], q8[i + 4]);
#pragma unroll
            for (int i = 0; i < 2; ++i) { const float keep = (ln & 8) ? q4[i + 2] : q4[i], send = (ln & 8) ? q4[i] : q4[i + 2]; q2[i] = keep + x8_(send); }
            const float keep = (ln & 4) ? q2[1] : q2[0], send = (ln & 4) ? q2[0] : q2[1];
            float bonv = keep + xhm_(send);
            bonv += dpp_<0xB1>(bonv); bonv += dpp_<0x4E>(bonv);
            if ((lane & 3) == 0) BON[(tok0 + (lane >> 2)) * 8 + h] = bonv;
        }
        float Lt[16]; { float Lc = 0.f;
#pragma unroll
            for (int t = 0; t < 16; ++t) { Lc += __logf(w[t]); Lt[t] = Lc; } }
        const float Lref = Lt[7];
        float btil[16]; h16x8 kt0, kt1;
        LAS h16* OS = (LAS h16*)(Lb + 9216);
#pragma unroll
        for (int t = 0; t < 16; ++t) {
            const float Lp = t ? Lt[t - 1] : 0.f;
            const float ka = kk[t] * __expf(Lp - Lref), rt = rr[t] * __expf(Lt[t] - Lref), e2 = __expf(Lref - Lt[t]), bt = bb[t] * e2, kt = kx[t] * e2;
            YX[t * 72 + lane] = (h16)ka; YX[(16 + t) * 72 + lane] = (h16)rt; YX[(32 + t) * 72 + lane] = (h16)kt; YX[(48 + t) * 72 + lane] = (h16)bt;
            btil[t] = bt;
            OS[t * 64 + lane] = (h16)(kk[t] * __expf(Lp)); OS[(16 + t) * 64 + lane] = (h16)(rr[t] * __expf(Lt[t]));
            const float ktp = kx[t] * __expf(Lt[15] - Lt[t]);
            if (t < 8) kt0[t] = (h16)ktp; else kt1[t - 8] = (h16)ktp;
        }
        const float post = __expf(Lt[15] - Lref), w16 = __expf(Lt[15]);
        { h16* kp = KS + e0 + ut_ov(lane, 0); *(h16x8*)kp = kt0; *(h16x8*)(kp + 8) = kt1; }
        asm volatile("s_waitcnt lgkmcnt(0)" ::: "memory");
#pragma unroll
        for (int j = 0; j < 4; ++j) { const int row = (lane >> 3) + 8 * (j & 1); const h16x8 o8 = *(const LAS h16x8*)(OS + ((j >> 1) * 16 + row) * 64 + (lane & 7) * 8);
            *(h16x8*)(((j >> 1) ? R : KK) + e0 + (size_t)row * 512 + (lane & 7) * 8) = o8; }
        asm volatile("s_waitcnt lgkmcnt(0)" ::: "memory");
        f32x16 acc;
#pragma unroll
        for (int i = 0; i < 16; ++i) acc[i] = 0.f;
#pragma unroll
        for (int ks = 0; ks < 4; ++ks) {
            const h16x8 af = *(const LAS h16x8*)(YX + (lane & 31) * 72 + 8 * (lane >> 5) + 16 * ks), bf = *(const LAS h16x8*)(YX + (32 + (lane & 31)) * 72 + 8 * (lane >> 5) + 16 * ks);
            acc = __builtin_amdgcn_mfma_f32_32x32x16_f16(af, bf, acc, 0, 0, 0);
        }
#pragma unroll
        for (int i = 0; i < 16; ++i) GT[((i & 3) + 8 * (i >> 2) + 4 * (lane >> 5)) * 36 + (lane & 31)] = acc[i];
        asm volatile("s_waitcnt lgkmcnt(0)" ::: "memory");
        float T[16];
#pragma unroll
        for (int t = 0; t < 16; ++t) { float v = (r16 == t) ? 1.f : 0.f;
#pragma unroll
            for (int s2 = 0; s2 < t; ++s2) v -= T[s2] * GT[t * 36 + 16 + s2];
            T[t] = v; }
#pragma unroll
        for (int t = 0; t < 16; ++t) TM[r16 * 20 + t] = T[t];
        asm volatile("s_waitcnt lgkmcnt(0)" ::: "memory");
        float bcol[16];
#pragma unroll
        for (int s2 = 0; s2 < 16; ++s2) bcol[s2] = (s2 <= r16) ? GT[(16 + r16) * 36 + 16 + s2] : 0.f;
        h16x8 tb0, tb1, tp0, tp1;
#pragma unroll
        for (int r = 0; r < 16; ++r) { float s0 = 0.f, s1 = 0.f;
#pragma unroll
            for (int s2 = r; s2 < 16; ++s2) { const float tv = TM[r * 20 + s2]; s0 += tv * btil[s2]; s1 += tv * bcol[s2]; }
            s0 *= post;
            if (r < 8) { tb0[r] = (h16)s0; tp0[r] = (h16)s1; } else { tb1[r - 8] = (h16)s0; tp1[r - 8] = (h16)s1; } }
        { h16* bp = BD + e0 + ut_ov(lane, 0); *(h16x8*)bp = tb0; *(h16x8*)(bp + 8) = tb1; }
        if (lane < 16) {
            h16x8 a0, a1, p0, p1;
#pragma unroll
            for (int s2 = 0; s2 < 16; ++s2) { const float av = (s2 < ln) ? GT[ln * 36 + s2] : 0.f, pv = (s2 <= ln) ? GT[(16 + ln) * 36 + s2] : 0.f;
                if (s2 < 8) { a0[s2] = (h16)av; p0[s2] = (h16)pv; } else { a1[s2 - 8] = (h16)av; p1[s2 - 8] = (h16)pv; } }
            h16* ap = WD + e0 + (size_t)(lane >> 2) * 512 + (lane & 3) * 16;
            *(h16x8*)ap = a0; *(h16x8*)(ap + 8) = a1;
            *(h16x8*)(ap + 4 * 512) = p0; *(h16x8*)(ap + 4 * 512 + 8) = p1;
            *(h16x8*)(ap + 8 * 512) = tp0; *(h16x8*)(ap + 8 * 512 + 8) = tp1;
        }
        (WD + e0 + (size_t)12 * 512)[lane] = (h16)w16;
        asm volatile("s_waitcnt lgkmcnt(0)" ::: "memory");
    }
}
struct UtOps { u32x2 ka[2][2], rt[2][2], kt[4], tb[4], at, apt, tp, vb, w16[4]; };
struct UtRes { __amdgpu_buffer_rsrc_t kk, r, ks, bd, wd, vt, y; };
__device__ __forceinline__ void ut_load(UtOps& o, const UtRes& R, int so, unsigned offK, unsigned offT, unsigned offV, unsigned offF) {
#pragma unroll
    for (int ks = 0; ks < 2; ++ks)
#pragma unroll
        for (int p = 0; p < 2; ++p) { o.ka[ks][p] = __builtin_amdgcn_raw_buffer_load_b64(R.kk, offK + 64u * ks + 32u * p, so, 0); o.rt[ks][p] = __builtin_amdgcn_raw_buffer_load_b64(R.r, offK + 64u * ks + 32u * p, so, 0); }
#pragma unroll
    for (int kt = 0; kt < 4; ++kt) { o.kt[kt] = __builtin_amdgcn_raw_buffer_load_b64(R.ks, offT + 4096u * kt, so, 0); o.tb[kt] = __builtin_amdgcn_raw_buffer_load_b64(R.bd, offT + 4096u * kt, so, 0); }
    o.at = __builtin_amdgcn_raw_buffer_load_b64(R.wd, offT, so, 0); o.apt = __builtin_amdgcn_raw_buffer_load_b64(R.wd, offT + 4096u, so, 0); o.tp = __builtin_amdgcn_raw_buffer_load_b64(R.wd, offT + 8192u, so, 0);
    o.vb = __builtin_amdgcn_raw_buffer_load_b64(R.vt, offV, so, 0);
#pragma unroll
    for (int kt = 0; kt < 4; ++kt) o.w16[kt] = __builtin_amdgcn_raw_buffer_load_b64(R.wd, offF + 12u * 1024u + 32u * kt, so, 0);
}
__device__ __forceinline__ f32x4 h4f(u32x2 v) { const h16x4 h = __builtin_bit_cast(h16x4, v); return (f32x4){(float)h[0], (float)h[1], (float)h[2], (float)h[3]}; }
__device__ __forceinline__ h16x8 cat8(u32x2 lo, u32x2 hi) { u32x4 r; r[0] = lo[0]; r[1] = lo[1]; r[2] = hi[0]; r[3] = hi[1]; return __builtin_bit_cast(h16x8, r); }
__device__ __forceinline__ void ut_block(const UtOps& o, f32x4 (&S)[4], const UtRes& R, unsigned offY, int so) {
    const f32x4 zf = (f32x4){0.f, 0.f, 0.f, 0.f}; const u32x2 zu = (u32x2){0u, 0u};
    const h16x8 sb0 = pack8(S[0], S[1]), sb1 = pack8(S[2], S[3]);
    const h16x8 vb = cat8(o.vb, zu);
    f32x4 x1 = zf, y = zf;
    x1 = __builtin_amdgcn_mfma_f32_16x16x32_f16(cat8(o.ka[0][0], o.ka[0][1]), sb0, x1, 0, 0, 0); y = __builtin_amdgcn_mfma_f32_16x16x32_f16(cat8(o.rt[0][0], o.rt[0][1]), sb0, y, 0, 0, 0);
    x1 = __builtin_amdgcn_mfma_f32_16x16x32_f16(cat8(o.ka[1][0], o.ka[1][1]), sb1, x1, 0, 0, 0); y = __builtin_amdgcn_mfma_f32_16x16x32_f16(cat8(o.rt[1][0], o.rt[1][1]), sb1, y, 0, 0, 0);
    x1 = __builtin_amdgcn_mfma_f32_16x16x32_f16(cat8(o.at, zu), vb, x1, 0, 0, 0); y = __builtin_amdgcn_mfma_f32_16x16x32_f16(cat8(o.apt, zu), vb, y, 0, 0, 0);
    f32x4 St[4];
#pragma unroll
    for (int kt = 0; kt < 4; ++kt) St[kt] = __builtin_amdgcn_mfma_f32_16x16x32_f16(cat8(o.kt[kt], zu), vb, S[kt] * h4f(o.w16[kt]), 0, 0, 0);
    const h16x8 xb = pack8(-x1, zf);
    y = __builtin_amdgcn_mfma_f32_16x16x32_f16(cat8(o.tp, zu), xb, y, 0, 0, 0);
#pragma unroll
    for (int kt = 0; kt < 4; ++kt) S[kt] = __builtin_amdgcn_mfma_f32_16x16x32_f16(cat8(o.tb[kt], zu), xb, St[kt], 0, 0, 0);
#pragma unroll
    for (int rg = 0; rg < 4; ++rg) { const h16 hv = (h16)y[rg]; __builtin_amdgcn_raw_buffer_store_b16(__builtin_bit_cast(unsigned short, hv), R.y, offY + 1024u * rg, so, 0); }
}
constexpr int UT_RING = 4;
static_assert(UT_SEGB % 4 == 0, "the loader rotates four operand sets");
__device__ __forceinline__ LAS unsigned char* ut_slot(LAS unsigned char* lds, unsigned s) { return lds + (s < 2u ? 64u + s * 12288u : 131072u + 128u + (s - 2u) * 12288u); }
#define UT_FIELDS(F) F(0, ka[0][0]) F(1, ka[0][1]) F(2, ka[1][0]) F(3, ka[1][1]) F(4, rt[0][0]) F(5, rt[0][1]) F(6, rt[1][0]) F(7, rt[1][1]) F(8, kt[0]) F(9, kt[1]) F(10, kt[2]) F(11, kt[3]) \
    F(12, tb[0]) F(13, tb[1]) F(14, tb[2]) F(15, tb[3]) F(16, at) F(17, apt) F(18, tp) F(19, vb) F(20, w16[0]) F(21, w16[1]) F(22, w16[2]) F(23, w16[3])
__device__ __forceinline__ void ut_put(const UtOps& o, LAS unsigned char* sl, int lane) {
    LAS u32x2* p = (LAS u32x2*)(sl + lane * 8);
#define UT_F(i, f) p[(i) * 64] = o.f;
    UT_FIELDS(UT_F)
#undef UT_F
}
__device__ __forceinline__ void ut_get(UtOps& o, const LAS unsigned char* sl, int lane) {
    const LAS u32x2* p = (const LAS u32x2*)(sl + lane * 8);
#define UT_F(i, f) o.f = p[(i) * 64];
    UT_FIELDS(UT_F)
#undef UT_F
}
__device__ __forceinline__ void phase_ut_seq(const Args& a, LAS unsigned char* lds, int seg) {
    const int tid = tid_(), lane = tid & 63, wave = tid >> 6, fr = lane & 15, fq = lane >> 4;
    if (wave > 1) return;
    volatile LAS unsigned* prodp = (volatile LAS unsigned*)(lds + 131072 + 32);
    volatile LAS unsigned* consp = (volatile LAS unsigned*)(lds + 131072 + 48);
    unsigned base = wave ? *prodp : *consp;
    const int nb0 = seg * UT_SEGB;
    for (int item = blockIdx.x; item < 256; item += gridDim.x, base += UT_SEGB) {
        const int h = item & 7, q = item >> 3, g = q & 3, b = q >> 2;
        const size_t e0 = ((size_t)b * SEQ * 512 + h * 64) * 2 + (size_t)nb0 * 16384;
        const char* Rb = (const char*)a.out + e0; const char* KSb = Rb + (size_t)MTOK * 1024; const char* KKb = Rb + (size_t)3 * MTOK * 1024;
        const char* WDb = (const char*)(a.ws + O_WD) + e0; const char* BDb = (const char*)(a.ws + O_BD) + e0;
        const char* VTb = (const char*)(a.ws + O_VTB) + ((size_t)b * (SEQ / 16) * 8 + h) * 2048 + (size_t)nb0 * 16384;
        const unsigned offK = (unsigned)(fr * 1024 + 8 * fq), offT = (unsigned)((fr >> 2) * 512 + (fr & 3) * 16 + 4 * fq) * 2u, offV = (unsigned)((16 * g + fr) * 16 + 4 * fq) * 2u, offF = (unsigned)fq * 8u,
                       offY = (unsigned)((4 * fq) * 512 + 16 * g + fr) * 2u;
        UtRes RS; RS.kk = mkrsrc(KKb); RS.r = mkrsrc(Rb); RS.ks = mkrsrc(KSb); RS.bd = mkrsrc(BDb); RS.wd = mkrsrc(WDb); RS.vt = mkrsrc(VTb);
        RS.y = mkrsrc((const char*)(a.ws + O_Y) + e0);
#define UT_LD(o, nn) ut_load(o, RS, ((nn) < UT_SEGB ? (nn) : UT_SEGB - 1) * 16384, offK, offT, offV, offF)
        if (wave == 1) {
#define UT_PUT(o, nn) do { const unsigned gc = base + (unsigned)(nn); int guard = 0; \
                while ((int)(gc - *consp) >= UT_RING && ++guard < (1 << 24)) __builtin_amdgcn_s_sleep(1); \
                asm volatile("" ::: "memory"); ut_put(o, ut_slot(lds, gc % UT_RING), lane); \
                asm volatile("s_waitcnt lgkmcnt(0)" ::: "memory"); if (lane == 0) *prodp = gc + 1u; } while (0)
            UtOps l0, l1, l2, l3;
            UT_LD(l0, 0); UT_LD(l1, 1); UT_LD(l2, 2); UT_LD(l3, 3);
#pragma unroll 1
            for (int n = 0; n < UT_SEGB; n += 4) {
                UT_PUT(l0, n);     UT_LD(l0, n + 4);
                UT_PUT(l1, n + 1); UT_LD(l1, n + 5);
                UT_PUT(l2, n + 2); UT_LD(l2, n + 6);
                UT_PUT(l3, n + 3); UT_LD(l3, n + 7);
            }
#undef UT_PUT
            continue;
        }
        f32x4* sst = (f32x4*)(a.ws + O_SST2) + ((size_t)item * 64 + lane) * 4;
        f32x4 S[4];
#pragma unroll
        for (int kt = 0; kt < 4; ++kt) S[kt] = seg ? sst[kt] : (f32x4){0.f, 0.f, 0.f, 0.f};
#define UT_GET(o, nn) do { const unsigned gc = base + (unsigned)(nn); int guard = 0; \
            while ((int)(*prodp - gc) < 1 && ++guard < (1 << 24)) __builtin_amdgcn_s_sleep(0); \
            asm volatile("" ::: "memory"); ut_get(o, ut_slot(lds, gc % UT_RING), lane); } while (0)
#define UT_DONE(nn) do { asm volatile("s_waitcnt lgkmcnt(0)" ::: "memory"); if (lane == 0) *consp = base + (unsigned)(nn) + 1u; } while (0)
        UtOps oa, ob;
        UT_GET(oa, 0);
#pragma unroll 1
        for (int n = 0; n < UT_SEGB; n += 2) {
            UT_DONE(n);     UT_GET(ob, n + 1);                          ut_block(oa, S, RS, offY, n * 16384);
            UT_DONE(n + 1); if (n + 2 < UT_SEGB) UT_GET(oa, n + 2);     ut_block(ob, S, RS, offY, (n + 1) * 16384);
        }
#undef UT_GET
#undef UT_DONE
#undef UT_LD
#pragma unroll
        for (int kt = 0; kt < 4; ++kt) sst[kt] = S[kt];
    }
}
constexpr int POST_EARLY = 2;
__device__ __forceinline__ void phase_rwkv_post(const Args& a, int s0, int s1, int gw, int NGW);
__device__ __forceinline__ void phase_ut_step(const Args& a, LAS unsigned char* lds, int st) {
    const int wave = tid_() >> 6;
    if (st >= 1 && wave <= 1) { phase_ut_seq(a, lds, st - 1); return; }
    if (st < UT_SEG) { if (st == 0) phase_ut_pre(a, lds, st, blockIdx.x * NWAVES + wave, gridDim.x * NWAVES); else phase_ut_pre(a, lds, st, blockIdx.x * 6 + (wave - 2), gridDim.x * 6); }
    else phase_rwkv_post(a, 0, POST_EARLY, blockIdx.x * 6 + (wave - 2), gridDim.x * 6);
}

__device__ __forceinline__ void phase_rwkv_post(const Args& a, int s0, int s1, int gw, int NGW) {
    const int lane = tid_() & 63;
    const int per = (s1 - s0) * (SEQ / UT_SEG), NT = (MTOK / SEQ) * per;
    const h16* V = (const h16*)a.out + (size_t)2 * MTOK * 512;
    const h16* GG = (const h16*)(a.ws + O_GG); const h16* Y = (const h16*)(a.ws + O_Y); h16* YB = (h16*)(a.ws + O_YB); const float* BON = (const float*)(a.ws + O_BON);
    float lg[8], lb[8];
#pragma unroll
    for (int j = 0; j < 8; ++j) { const int c = lane * 8 + j; lg[j] = a.in[15][c]; lb[j] = a.in[16][c]; }
    for (int tq = gw; tq < NT; tq += 4 * NGW) {
        h16x8 y8v[4], v8v[4], g8v[4]; float bsv[4]; int tv[4];
#pragma unroll
        for (int q = 0; q < 4; ++q) { const int n = tq + q * NGW; if (n < NT) { const int bq = n / per, t = bq * SEQ + s0 * (SEQ / UT_SEG) + (n - bq * per); tv[q] = t; const size_t o = (size_t)t * 512 + lane * 8;
            y8v[q] = *(const h16x8*)(Y + o); v8v[q] = *(const h16x8*)(V + o); g8v[q] = *(const h16x8*)(GG + o); bsv[q] = BON[(size_t)t * 8 + (lane >> 3)]; } }
#pragma unroll
        for (int q = 0; q < 4; ++q) { const int n = tq + q * NGW; if (n < NT) { const int t = tv[q]; const size_t o = (size_t)t * 512 + lane * 8;
            const h16x8 y8 = y8v[q], v8 = v8v[q], g8 = g8v[q]; const float bs = bsv[q];
            float y[8]; float sm = 0.f;
#pragma unroll
            for (int j = 0; j < 8; ++j) { y[j] = (float)y8[j]; sm += y[j]; }
            sm += dpp_<0xB1>(sm); sm += dpp_<0x4E>(sm); sm += dpp_<0x141>(sm);
            const float mean = sm * (1.f / 64.f); float vs = 0.f;
#pragma unroll
            for (int j = 0; j < 8; ++j) { y[j] -= mean; vs += y[j] * y[j]; }
            vs += dpp_<0xB1>(vs); vs += dpp_<0x4E>(vs); vs += dpp_<0x141>(vs);
            const float rstd = rsqrtf(vs * (1.f / 64.f) + 64e-5f);
            h16x8 ov;
#pragma unroll
            for (int j = 0; j < 8; ++j) ov[j] = (h16)((y[j] * rstd * lg[j] + lb[j] + bs * (float)v8[j]) * (float)g8[j]);
            *(h16x8*)(YB + o) = ov; } }
    }
}

__device__ __forceinline__ void ins16(unsigned (&L)[16], unsigned x) {
#pragma unroll
    for (int j = 0; j < 16; ++j) { const unsigned hi = L[j] > x ? L[j] : x; x = L[j] > x ? x : L[j]; L[j] = hi; }
}
#define TK_CE(a, b) do { const unsigned hi_ = (a) > (b) ? (a) : (b); (b) = (a) > (b) ? (b) : (a); (a) = hi_; } while (0)
__device__ __forceinline__ void sort16_desc(unsigned (&v)[16]) {
#pragma unroll
    for (int p = 1; p < 16; p <<= 1)
#pragma unroll
        for (int k = p; k >= 1; k >>= 1)
#pragma unroll
            for (int j = k % p; j + k < 16; j += 2 * k)
#pragma unroll
                for (int i = 0; i < k; ++i) if (i + j + k < 16 && (i + j) / (2 * p) == (i + j + k) / (2 * p)) TK_CE(v[i + j], v[i + j + k]);
}
__device__ __forceinline__ void merge_top16(unsigned (&t)[16], const unsigned (&g)[16]) {
#pragma unroll
    for (int i = 0; i < 16; ++i) t[i] = t[i] > g[15 - i] ? t[i] : g[15 - i];
#pragma unroll
    for (int j = 8; j > 0; j >>= 1)
#pragma unroll
        for (int i = 0; i < 16; ++i) { const int l = i ^ j; if (l > i) TK_CE(t[i], t[l]); }
}
__device__ __forceinline__ unsigned ord32(float f) { const unsigned u = __float_as_uint(f); return (u & 0x80000000u) ? ~u : (u | 0x80000000u); }
__device__ __forceinline__ float unord32(unsigned k) { return __uint_as_float((k & 0x80000000u) ? (k & 0x7fffffffu) : ~k); }
__device__ __forceinline__ void phase_topk(const Args& a, LAS unsigned char* lds) {
    const int tid = tid_();
    const h16* SC = (const h16*)(a.ws + O_SCORES);
    const float* part = (const float*)(a.ws + O_PART1);
    unsigned short* IDX = (unsigned short*)(a.ws + O_IDX); h16* GATE = (h16*)(a.ws + O_GATE); float* RS1 = (float*)(a.ws + O_RS1);
    LAS unsigned char* LI = lds;
    for (int task = blockIdx.x * NTHREADS + tid; task < MTOK * 8; task += gridDim.x * NTHREADS) {
        const int t = task >> 3, h = task & 7;
        float ssq = 0.f;
#pragma unroll
        for (int j = 0; j < 4; ++j) { const f32x4 p4 = *(const f32x4*)(part + (size_t)t * 16 + 4 * j); ssq += (p4[0] + p4[1]) + (p4[2] + p4[3]); }
        const float rs = rsqrtf(ssq * (1.f / 1024.f) + NORM_EPS);
        if (h == 0) RS1[t] = rs;
        float sv[2][16];
#pragma unroll
        for (int c = 0; c < 2; ++c) {
            unsigned L[16];
#pragma unroll
            for (int j = 0; j < 16; ++j) L[j] = 0u;
            const h16* row = SC + (size_t)t * 2048 + h * 256 + c * 128;
#pragma unroll 1
            for (int ln = 0; ln < 2; ++ln) {
                u32x4 raw[8];
#pragma unroll
                for (int k = 0; k < 8; ++k) raw[k] = *(const u32x4*)(row + ln * 64 + k * 8);
#pragma unroll
                for (int g4 = 0; g4 < 4; ++g4) {
                    unsigned Gk[16];
#pragma unroll
                    for (int hh = 0; hh < 2; ++hh) { const u32x4 w4 = raw[2 * g4 + hh];
#pragma unroll
                        for (int d = 0; d < 4; ++d) {
                            const unsigned w = w4[d];
                            const unsigned sf = __builtin_bit_cast(unsigned, __builtin_bit_cast(s16x2, w) >> 15);
                            const unsigned o = w ^ (sf | 0x80008000u);
                            const int p0 = ln * 64 + g4 * 16 + hh * 8 + 2 * d;
                            Gk[hh * 8 + 2 * d] = (o << 16) | (unsigned)(127 - p0); Gk[hh * 8 + 2 * d + 1] = (o & 0xffff0000u) | (unsigned)(126 - p0); } }
                    sort16_desc(Gk);
                    merge_top16(L, Gk);
                }
            }
#pragma unroll
            for (int j = 0; j < 16; ++j) {
                const unsigned o16 = L[j] >> 16; const unsigned bits = (o16 & 0x8000u) ? (o16 & 0x7fffu) : (~o16 & 0xffffu);
                union { unsigned short u; h16 f; } cv; cv.u = (unsigned short)bits; sv[c][j] = (float)cv.f;
                LI[(c * 16 + j) * 512 + tid] = (unsigned char)(127u - (L[j] & 127u));
            }
        }
        unsigned L[16], G1[16], G2[16], X0 = 0u, X1 = 0u;
        { int cnt = 0;
#pragma unroll
          for (int i = 0; i < 16; ++i)
#pragma unroll
            for (int j = 0; j < 16; ++j) if ((i + 1) * (j + 1) <= 16) {
                const unsigned key = (ord32(sv[0][i] + sv[1][j]) & ~255u) | (unsigned)(255 - (i * 16 + j));
                if (cnt < 16) L[cnt] = key; else if (cnt < 32) G1[cnt - 16] = key; else if (cnt < 48) G2[cnt - 32] = key; else if (cnt == 48) X0 = key; else X1 = key;
                ++cnt; } }
        sort16_desc(L); sort16_desc(G1); sort16_desc(G2); merge_top16(L, G1); merge_top16(L, G2);
        { TK_CE(X0, X1); unsigned G3[16];
#pragma unroll
          for (int j = 0; j < 16; ++j) G3[j] = 0u;
          G3[0] = X0; G3[1] = X1; merge_top16(L, G3); }
        float e[16]; float den = 0.f; const float mx = unord32(L[0] & ~255u) * rs;
        unsigned short id[16];
#pragma unroll
        for (int k = 0; k < 16; ++k) {
            const float v = unord32(L[k] & ~255u) * rs; e[k] = __expf(v - mx); den += e[k];
            const unsigned pos = 255u - (L[k] & 255u); const unsigned i = pos >> 4, j = pos & 15u;
            id[k] = (unsigned short)((unsigned)LI[i * 512 + tid] * 128u + (unsigned)LI[(16 + j) * 512 + tid]);
        }
        const float inv = __builtin_amdgcn_rcpf(den);
        u32x4 i0, i1;
        i0[0] = id[0] | (id[1] << 16); i0[1] = id[2] | (id[3] << 16); i0[2] = id[4] | (id[5] << 16); i0[3] = id[6] | (id[7] << 16);
        i1[0] = id[8] | (id[9] << 16); i1[1] = id[10] | (id[11] << 16); i1[2] = id[12] | (id[13] << 16); i1[3] = id[14] | (id[15] << 16);
        u32x4* ip = (u32x4*)(IDX + (size_t)task * 16); ip[0] = i0; ip[1] = i1;
        h16x8* gp = (h16x8*)(GATE + (size_t)task * 16);
#pragma unroll
        for (int k8 = 0; k8 < 2; ++k8) gp[k8] = pack8((f32x4){e[8 * k8] * inv, e[8 * k8 + 1] * inv, e[8 * k8 + 2] * inv, e[8 * k8 + 3] * inv}, (f32x4){e[8 * k8 + 4] * inv, e[8 * k8 + 5] * inv, e[8 * k8 + 6] * inv, e[8 * k8 + 7] * inv});
    }
}

__device__ __forceinline__ float gelu_tanh(float x) { const float u = 0.7978845608028654f * (x + 0.044715f * x * x * x); return 0.5f * x * (1.0f + tanhf_(u)); }
__device__ __forceinline__ unsigned xcc_id() { return (unsigned)__builtin_amdgcn_s_getreg((3 << 11) | 20) & 7u; }
constexpr bool GA_C16 = false;
constexpr int GA_TC = 8, GA_NCH = MTOK / GA_TC;
__device__ __forceinline__ void dec16(const u32x4 q, float (&o)[16]) {
#pragma unroll
    for (int w = 0; w < 4; ++w) { const f32x2 lo = __builtin_amdgcn_cvt_pk_f32_fp8((int)q[w], false), hi = __builtin_amdgcn_cvt_pk_f32_fp8((int)q[w], true);
        o[4 * w] = lo[0]; o[4 * w + 1] = lo[1]; o[4 * w + 2] = hi[0]; o[4 * w + 3] = hi[1]; }
}
__device__ __forceinline__ void dec16p(const u32x4 q, f32x2 (&o)[8]) {
#pragma unroll
    for (int w = 0; w < 4; ++w) { o[2 * w] = __builtin_amdgcn_cvt_pk_f32_fp8((int)q[w], false); o[2 * w + 1] = __builtin_amdgcn_cvt_pk_f32_fp8((int)q[w], true); }
}
struct GIdx { u32x4 a, b; };
__device__ __forceinline__ GIdx g_ldidx(__amdgpu_buffer_rsrc_t IDX, int t, int r8) { GIdx r; r.a = __builtin_amdgcn_raw_buffer_load_b128(IDX, 32 * r8, t * 256, 0); r.b = __builtin_amdgcn_raw_buffer_load_b128(IDX, 32 * r8 + 16, t * 256, 0); return r; }
__device__ __forceinline__ void g_quant(u32x4 xa_, u32x4 xb_, u32x4& xq, float& xs) {
    const h16x8 xa = __builtin_bit_cast(h16x8, xa_), xb = __builtin_bit_cast(h16x8, xb_);
    float x[16]; float mx = 0.f;
#pragma unroll
    for (int k = 0; k < 8; ++k) { x[k] = (float)xa[k]; x[8 + k] = (float)xb[k]; mx = fmaxf(mx, fmaxf(fabsf(x[k]), fabsf(x[8 + k]))); }
    mx = fmaxf(mx, dpp_<0xB1>(mx)); mx = fmaxf(mx, dpp_<0x4E>(mx)); mx = fmaxf(mx, dpp_<0x141>(mx));
    mx = fmaxf(mx, 1e-20f);
    const float inv = 127.0f * __builtin_amdgcn_rcpf(mx); xs = mx * (1.0f / 127.0f);
#pragma unroll
    for (int w = 0; w < 4; ++w) { const int i0 = __float2int_rn(x[4 * w] * inv), i1 = __float2int_rn(x[4 * w + 1] * inv), i2 = __float2int_rn(x[4 * w + 2] * inv), i3 = __float2int_rn(x[4 * w + 3] * inv);
        xq[w] = (unsigned)(i0 & 0xff) | ((unsigned)(i1 & 0xff) << 8) | ((unsigned)(i2 & 0xff) << 16) | ((unsigned)i3 << 24); }
}
__device__ __forceinline__ void g_issue8(const unsigned char* TBs, unsigned lo, const u32x4 ix, u32x4 (&q)[8]) {
#pragma unroll
    for (int i = 0; i < 8; ++i) { const unsigned w = ix[i >> 1]; const unsigned e = (i & 1) ? (w >> 16) : (w & 0xffffu); q[i] = *(const u32x4*)(TBs + (e * 128u + lo)); }
}
struct GSide { u32x4 a, b, c, d; };
template <int PH> __device__ __forceinline__ GSide g_ldside(__amdgpu_buffer_rsrc_t SD, __amdgpu_buffer_rsrc_t HR, int t, int j, int m, int r8) {
    GSide r;
    if (PH == 0) { r.a = __builtin_amdgcn_raw_buffer_load_b128(SD, 32 * m, t * 2048 + 256 * j, 0); r.b = __builtin_amdgcn_raw_buffer_load_b128(SD, 32 * m + 16, t * 2048 + 256 * j, 0); r.c = r.a; r.d = r.b; }
    else { r.a = __builtin_amdgcn_raw_buffer_load_b128(SD, 32 * r8, t * 256, 0); r.b = GA_C16 ? __builtin_amdgcn_raw_buffer_load_b128(SD, 32 * r8 + 16, t * 256, 0) : (u32x4){0u, 0u, 0u, 0u};
           r.c = (u32x4){__builtin_amdgcn_raw_buffer_load_b32(SD, 4 * r8, (int)(O_COEFS - O_COEF) + t * 32, 0), 0u, 0u, 0u}; r.d = r.c;
           r.d[0] = __builtin_amdgcn_raw_buffer_load_b32(HR, (128 * j + 16 * m + 2 * r8) * 2, t * 2048, 0); }
    return r;
}
template <int PH, int HALF> __device__ __forceinline__ void g_half(u32x4 (&q)[8], const GSide& sd, float (&pa)[16], int (&ah)[16], int (&al)[16]) {
    if (PH == 0) {
#pragma unroll
        for (int i = 0; i < 8; ++i) { int acc = 0;
#pragma unroll
            for (int w = 0; w < 4; ++w) acc = __builtin_amdgcn_sdot4((int)q[i][w], (int)sd.a[w], acc, false);
            pa[8 * HALF + i] = (float)acc; }
    } else {
#pragma unroll
        for (int g = 0; g < 2; ++g) {
            const int ch = (int)sd.a[2 * HALF + g], cl = (int)sd.b[2 * HALF + g];
#pragma unroll
            for (int w = 0; w < 4; ++w) {
                const unsigned a0 = q[4 * g][w], a1 = q[4 * g + 1][w], a2 = q[4 * g + 2][w], a3 = q[4 * g + 3][w];
                const unsigned t01l = __builtin_amdgcn_perm(a1, a0, 0x05010400u), t01h = __builtin_amdgcn_perm(a1, a0, 0x07030602u);
                const unsigned t23l = __builtin_amdgcn_perm(a3, a2, 0x05010400u), t23h = __builtin_amdgcn_perm(a3, a2, 0x07030602u);
                const unsigned o0 = __builtin_amdgcn_perm(t23l, t01l, 0x05040100u), o1 = __builtin_amdgcn_perm(t23l, t01l, 0x07060302u);
                const unsigned o2 = __builtin_amdgcn_perm(t23h, t01h, 0x05040100u), o3 = __builtin_amdgcn_perm(t23h, t01h, 0x07060302u);
                ah[4 * w] = __builtin_amdgcn_sdot4((int)o0, ch, ah[4 * w], false);         if (GA_C16) al[4 * w] = __builtin_amdgcn_sdot4((int)o0, cl, al[4 * w], false);
                ah[4 * w + 1] = __builtin_amdgcn_sdot4((int)o1, ch, ah[4 * w + 1], false); if (GA_C16) al[4 * w + 1] = __builtin_amdgcn_sdot4((int)o1, cl, al[4 * w + 1], false);
                ah[4 * w + 2] = __builtin_amdgcn_sdot4((int)o2, ch, ah[4 * w + 2], false); if (GA_C16) al[4 * w + 2] = __builtin_amdgcn_sdot4((int)o2, cl, al[4 * w + 2], false);
                ah[4 * w + 3] = __builtin_amdgcn_sdot4((int)o3, ch, ah[4 * w + 3], false); if (GA_C16) al[4 * w + 3] = __builtin_amdgcn_sdot4((int)o3, cl, al[4 * w + 3], false);
            }
        }
    }
}
template <int PH> __device__ __forceinline__ void g_finish(const Args& a, __amdgpu_buffer_rsrc_t PRT, int t, int j, int lane, float (&p)[16], float xs, unsigned hpre) {
    const int m = lane & 7, r8 = lane >> 3;
    float q8[8], q4[4], q2[2];
    if (PH == 0) {
#pragma unroll
        for (int i = 0; i < 8; ++i) { const float keep = (lane & 4) ? p[i + 8] : p[i], send = (lane & 4) ? p[i] : p[i + 8]; q8[i] = keep + xhm_(send); }
#pragma unroll
        for (int i = 0; i < 4; ++i) { const float keep = (lane & 2) ? q8[i + 4] : q8[i], send = (lane & 2) ? q8[i] : q8[i + 4]; q4[i] = keep + dpp_<0x4E>(send); }
#pragma unroll
        for (int i = 0; i < 2; ++i) { const float keep = (lane & 1) ? q4[i + 2] : q4[i], send = (lane & 1) ? q4[i] : q4[i + 2]; q2[i] = keep + dpp_<0xB1>(send); }
        { const h16x2 pv = (h16x2){(h16)(q2[0] * xs), (h16)(q2[1] * xs)}; __builtin_amdgcn_raw_buffer_store_b32(__builtin_bit_cast(unsigned, pv), PRT, (16 * r8 + 2 * m) * 2, (j * MTOK + t) * 256, 0); }
    } else {
#pragma unroll
        for (int i = 0; i < 8; ++i) q8[i] = swap_add32(p[i], p[i + 8]);
#pragma unroll
        for (int i = 0; i < 4; ++i) q4[i] = swap_add16(q8[i], q8[i + 4]);
#pragma unroll
        for (int i = 0; i < 2; ++i) { const float keep = (lane & 8) ? q4[i + 2] : q4[i], send = (lane & 8) ? q4[i] : q4[i + 2]; q2[i] = keep + x8_(send); }
        const int col = 128 * j + 16 * m + 2 * r8;
        const h16x2 h1v = __builtin_bit_cast(h16x2, hpre);
        const f32x2 hv = (f32x2){(float)h1v[0] + q2[0], (float)h1v[1] + q2[1]};
        *(h16x2*)((h16*)(a.ws + O_H2B) + (size_t)t * 1024 + col) = (h16x2){(h16)hv[0], (h16)hv[1]};
        const float ss = wave_sum(hv[0] * hv[0] + hv[1] * hv[1]);
        if (lane == 0) ((float*)(a.ws + O_SS2))[(size_t)t * 8 + j] = ss;
    }
}
template <int PH>
__device__ __forceinline__ void phase_gather(const Args& a, int cset) {
    const int tid = tid_(), lane = tid & 63, m = lane & 7, r8 = lane >> 3;
    unsigned* ctr = (unsigned*)(a.ws + O_CTR) + cset * 8 * 64;
    const __amdgpu_buffer_rsrc_t IDX = mkrsrc(a.ws + O_IDX), SDR = mkrsrc(a.ws + (PH ? O_COEF : O_H1B)), PRT = mkrsrc(a.ws + O_PART), HR = mkrsrc(a.ws + O_H1B);
    const unsigned j0 = xcc_id();
    for (unsigned dj = 0; dj < 8; ++dj) {
        const unsigned j = (j0 + dj) & 7u;
        const unsigned char* TB = a.ws + (PH ? O_V8 : O_U8) + (size_t)j * 16384 * 128; const unsigned lo16 = 16u * (unsigned)m;
        unsigned c = 0; if (lane == 0) c = __hip_atomic_fetch_add(ctr + j * 64, 1u, __ATOMIC_RELAXED, __HIP_MEMORY_SCOPE_AGENT);
        c = (unsigned)__builtin_amdgcn_readfirstlane((int)c);
        if (c >= (unsigned)GA_NCH) continue;
        u32x4 qa[8], qb[8]; GSide sd, sn; GIdx ix, ixn;
        { const int t0 = c * GA_TC; ix = g_ldidx(IDX, t0, r8); g_issue8(TB, lo16, ix.a, qa); sd = g_ldside<PH>(SDR, HR, t0, j, m, r8); }
        for (;;) {
            const int t0 = c * GA_TC;
            unsigned cnv = 0; if (lane == 0) cnv = __hip_atomic_fetch_add(ctr + j * 64, 1u, __ATOMIC_RELAXED, __HIP_MEMORY_SCOPE_AGENT);
            unsigned cn = (unsigned)GA_NCH; int tnf = t0 + GA_TC - 1;
#define G_TOKEN(IXC, SDC, IXN, SNN, TI, TN) { \
                const int t = t0 + (TI), tn = (TN); \
                g_issue8(TB, lo16, IXC.b, qb); IXN = g_ldidx(IDX, tn, r8); SNN = g_ldside<PH>(SDR, HR, tn, j, m, r8); \
                float p[16]; int ah[16], al[16]; \
                if (PH == 1) { _Pragma("unroll") for (int k = 0; k < 16; ++k) { ah[k] = 0; al[k] = 0; } } \
                float xs = 1.f; \
                if (PH == 0) { u32x4 xq; g_quant(SDC.a, SDC.b, xq, xs); SDC.a = xq; } \
                if (PH == 0) __builtin_amdgcn_sched_barrier(0);     \
                g_half<PH, 0>(qa, SDC, p, ah, al); \
                if (PH == 0) __builtin_amdgcn_sched_barrier(0); \
                g_issue8(TB, lo16, IXN.a, qa); \
                if (PH == 0) __builtin_amdgcn_sched_barrier(0);     \
                g_half<PH, 1>(qb, SDC, p, ah, al); \
                if (PH == 1) { const float cs = __uint_as_float(SDC.c[0]); _Pragma("unroll") for (int k = 0; k < 16; ++k) p[k] = (float)(GA_C16 ? ((ah[k] << 8) + al[k]) : ah[k]) * cs; }     \
                g_finish<PH>(a, PRT, t, j, lane, p, xs, SDC.d[0]); }
#pragma unroll 1
            for (int ti = 0; ti < GA_TC; ti += 2) {
                if (ti == GA_TC - 2) { cn = (unsigned)__builtin_amdgcn_readfirstlane((int)cnv); if (cn < (unsigned)GA_NCH) tnf = (int)cn * GA_TC; }
                G_TOKEN(ix, sd, ixn, sn, ti, t + 1) G_TOKEN(ixn, sn, ix, sd, ti + 1, (ti + 2 < GA_TC) ? t + 1 : tnf) }
#undef G_TOKEN
            if (cn >= (unsigned)GA_NCH) break;
            c = cn;
        }
    }
}
__device__ __forceinline__ void phase_p16(const Args& a) {
    const int tid = tid_();
    const f32x4* pp = (const f32x4*)a.in[1]; h16* dp = (h16*)(a.ws + O_P16P);
    const int np4 = MTOK * 64, st = gridDim.x * NTHREADS;
    for (int i = blockIdx.x * NTHREADS + tid; i < np4; i += 4 * st) {
        f32x4 pv[4];
#pragma unroll
        for (int q = 0; q < 4; ++q) if (i + q * st < np4) pv[q] = pp[i + q * st];
#pragma unroll
        for (int q = 0; q < 4; ++q) if (i + q * st < np4) { const int n = i + q * st; *(h16x4*)(dp + (size_t)(n >> 6) * 1024 + (n & 63) * 4) = pack4(pv[q]); }
    }
}
__device__ __forceinline__ void phase_coef(const Args& a) {
    const int tid = tid_();
    const h16* PART = (const h16*)(a.ws + O_PART); const unsigned short* IDX = (const unsigned short*)(a.ws + O_IDX);
    const h16* GATE = (const h16*)(a.ws + O_GATE); const float* RS1 = (const float*)(a.ws + O_RS1);
    const float* USC = (const float*)(a.ws + O_USC); const float* VSC = (const float*)(a.ws + O_VSC);
    u32x4* CQ = (u32x4*)(a.ws + O_COEF); float* CS = (float*)(a.ws + O_COEFS);
    for (int task = blockIdx.x * NTHREADS + tid; task < MTOK * 8; task += gridDim.x * NTHREADS) {
        const size_t i = (size_t)task * 16;
        float sacc[16];
#pragma unroll
        for (int k = 0; k < 16; ++k) sacc[k] = 0.f;
#pragma unroll
        for (int j = 0; j < 8; ++j) { const h16x8 p0 = *(const h16x8*)(PART + (size_t)j * MTOK * 128 + i), p1 = *(const h16x8*)(PART + (size_t)j * MTOK * 128 + i + 8);
#pragma unroll
            for (int k = 0; k < 8; ++k) { sacc[k] += (float)p0[k]; sacc[8 + k] += (float)p1[k]; } }
        const u32x4 e0 = *(const u32x4*)(IDX + i), e1 = *(const u32x4*)(IDX + i + 8);
        const h16x8 gt0 = *(const h16x8*)(GATE + i), gt1 = *(const h16x8*)(GATE + i + 8);
        const float rs = RS1[task >> 3];
        float c[16]; float mx = 0.f;
#pragma unroll
        for (int k = 0; k < 16; ++k) { const unsigned w = (k < 8) ? e0[(k & 7) >> 1] : e1[(k & 7) >> 1]; const unsigned e = (k & 1) ? (w >> 16) : (w & 0xffffu);
            c[k] = (float)(k < 8 ? gt0[k & 7] : gt1[k & 7]) * gelu_tanh(rs * USC[e] * sacc[k]) * VSC[e]; mx = fmaxf(mx, fabsf(c[k])); }
        const float qmax = GA_C16 ? 32639.0f : 127.0f;
        const float inv = (mx > 0.f) ? qmax / mx : 0.f;
        u32x4 hw, lw;
#pragma unroll
        for (int g = 0; g < 4; ++g) { unsigned h4 = 0u, l4 = 0u;
#pragma unroll
            for (int b = 0; b < 4; ++b) { const int q = __float2int_rn(c[4 * g + b] * inv), hi = GA_C16 ? ((q + 128) >> 8) : q, lo = GA_C16 ? (q - (hi << 8)) : 0;
                h4 |= (unsigned)(hi & 0xff) << (8 * b); l4 |= (unsigned)(lo & 0xff) << (8 * b); }
            hw[g] = h4; lw[g] = l4; }
        CQ[(size_t)task * 2] = hw; if (GA_C16) CQ[(size_t)task * 2 + 1] = lw;
        CS[task] = mx / qmax;
    }
}

__device__ __forceinline__ void phase_final(const Args& a) {
    const int tid = tid_(), lane = tid & 63, wave = tid >> 6;
    const int gw = blockIdx.x * NWAVES + wave, NGW = gridDim.x * NWAVES;
    const float* part = (const float*)(a.ws + O_PART3); const float* fg = a.in[28];
    f32x4 g4[4];
#pragma unroll
    for (int j = 0; j < 4; ++j) g4[j] = *((const f32x4*)fg + lane + 64 * j);
    const h16* h3b = (const h16*)(a.ws + O_XN);
    for (int rq = gw; rq < MTOK; rq += 4 * NGW) {
        float sv[4]; h16x4 hv[4][4];
#pragma unroll
        for (int q = 0; q < 4; ++q) { const int r = rq + q * NGW; if (r < MTOK) { sv[q] = (lane < 16) ? part[(size_t)r * 16 + lane] : 0.f;
            const h16x4* hr = (const h16x4*)(h3b + (size_t)r * 1024) + lane;
#pragma unroll
            for (int j = 0; j < 4; ++j) hv[q][j] = hr[64 * j]; } }
#pragma unroll
        for (int q = 0; q < 4; ++q) { const int r = rq + q * NGW; if (r < MTOK) {
            const float s = wave_sum(sv[q]);
            const float rs = rsqrtf(s * (1.f / 1024.f) + NORM_EPS);
            f32x4* xr = (f32x4*)(a.out + (size_t)r * 1024) + lane;
#pragma unroll
            for (int j = 0; j < 4; ++j) { const h16x4 h = hv[q][j]; xr[64 * j] = (f32x4){(float)h[0], (float)h[1], (float)h[2], (float)h[3]} * rs * g4[j]; } } }
    }
}

constexpr int NPHASE = 19;
__global__ void __launch_bounds__(NTHREADS, 2) mk(Args a) {
    LAS unsigned char* lds = (LAS unsigned char*)smem;
    unsigned char* ws = a.ws;
    if (a.ph_hi < 0) { cg::grid_group grid = cg::this_grid(); grid.sync(); }
    volatile LAS unsigned* bst = (volatile LAS unsigned*)(lds + 131072);
    if ((threadIdx.x & 63) == 0) ((volatile LAS unsigned char*)(lds + LDS_WAVE_TAB))[hw_slot_()] = (unsigned char)(threadIdx.x >> 6);
    if (threadIdx.x < 16) bst[threadIdx.x] = 0u;
    __syncthreads();
    const XcdBarrier xbar = xcd_barrier_post((unsigned*)(a.ws + O_BAR), bst);
#define SYNC() xcd_barrier(xbar)
#define IN(k) (a.ph_lo <= (k) && (k) < a.ph_hi)
#define SEAM(k) do { if (IN(k) && IN((k) + 1)) SYNC(); } while (0)
#define REPS(k) ((((REP_MASK) >> (k)) & 1u) ? 2 : 1)
    const int G = gridDim.x, bid = blockIdx.x;
    if (IN(0)) for (int rep = 0; rep < REPS(0); ++rep) { if (rep) SYNC(); phase_prep(a, lds); } SEAM(0);
    if (IN(1)) for (int rep = 0; rep < REPS(1); ++rep) { if (rep) SYNC(); pg8::Gemm g{(const h16*)(ws + O_XN), (const h16*)(ws + O_WIN), MTOK, NIN, 1024, nullptr, nullptr}; pg8::StaticOrder S; S.init(MTOK, NIN, G, bid);
        EpiZ E{(h16*)(ws + O_ZC), (h16*)(ws + O_ZR), (h16*)(ws + O_ZG)}; pg8::gemm_phase(lds, g, S, E); } SEAM(1);
    if (IN(2)) for (int rep = 0; rep < REPS(2); ++rep) { if (rep) SYNC(); phase_conv(a); phase_rwkv_prep(a); } SEAM(2);
    if (IN(3)) for (int rep = 0; rep < REPS(3); ++rep) { if (rep) SYNC(); pg8::Gemm g{(const h16*)(ws + O_APR), (const h16*)(ws + O_WLR), MTOK, 1536, 256, nullptr, nullptr}; pg8::StaticOrder S; S.init(MTOK, 1536, G, bid);
        h16* R = (h16*)a.out; h16* KS = R + (size_t)MTOK * 512; h16* KK = KS + (size_t)2 * MTOK * 512;
        EpiLR E{a.in[7], a.in[9], a.in[13], (h16*)(ws + O_WD), KS, (h16*)(ws + O_BD), (h16*)(ws + O_GG), KK}; pg8::gemm_phase(lds, g, S, E); } SEAM(3);
    if (IN(4)) { for (int st = 0; st <= UT_SEG; ++st) { if (st) SYNC(); phase_ut_step(a, lds, st); } }
    SEAM(6);
    if (IN(7)) for (int rep = 0; rep < REPS(7); ++rep) { if (rep) SYNC(); phase_rwkv_post(a, POST_EARLY, UT_SEG, bid * NWAVES + (tid_() >> 6), G * NWAVES); } SEAM(7);
    if (IN(9)) for (int rep = 0; rep < REPS(9); ++rep) { if (rep) SYNC(); pg8::Gemm g{(const h16*)(ws + O_CA), (const h16*)(ws + O_WA), MTOK, 1024, 512, (const h16*)(ws + O_YB), (const h16*)(ws + O_WB)}; pg8::StaticOrder S; S.init(MTOK, 1024, G, bid);
        EpiMerged E{(const h16*)(ws + O_ZG), (h16*)(ws + O_MERGED)}; pg8::gemm_phase(lds, g, S, E); }
    SEAM(9);
    if (IN(10)) for (int rep = 0; rep < REPS(10); ++rep) { if (rep) SYNC(); pg8::Gemm g{(const h16*)(ws + O_MERGED), (const h16*)(ws + O_WO), MTOK, 1024, 1024, nullptr, nullptr}; pg8::StaticOrder S; S.init(MTOK, 1024, G, bid);
        EpiH1 E{a.in[0], (h16*)(ws + O_H1B), (float*)(ws + O_PART1)}; pg8::gemm_phase(lds, g, S, E); } SEAM(10);
    if (IN(11)) for (int rep = 0; rep < REPS(11); ++rep) { if (rep) SYNC(); pg8::Gemm g{(const h16*)(ws + O_H1B), (const h16*)(ws + O_WS), MTOK, 2048, 1024, nullptr, nullptr}; pg8::StaticOrder S; S.init(MTOK, 2048, G, bid);
        EpiF16 E{(h16*)(ws + O_SCORES), 2048}; pg8::gemm_phase(lds, g, S, E); } SEAM(11);
    if (IN(12)) for (int rep = 0; rep < REPS(12); ++rep) { if (rep) SYNC(); phase_topk(a, lds); } SEAM(12);
    if (IN(13)) for (int rep = 0; rep < REPS(13); ++rep) { if (rep) SYNC(); phase_gather<0>(a, 2 * rep); } SEAM(13);
    if (IN(14)) for (int rep = 0; rep < REPS(14); ++rep) { if (rep) SYNC(); phase_coef(a); }
    SEAM(14);
    if (IN(15)) for (int rep = 0; rep < REPS(15); ++rep) { if (rep) SYNC(); phase_p16(a); phase_gather<1>(a, 1 + 2 * rep); } SEAM(15);
    if (IN(17)) for (int rep = 0; rep < REPS(17); ++rep) { if (rep) SYNC();
        pg8::Gemm g{(const h16*)(ws + O_P16P), (const h16*)(ws + O_WP), MTOK, 1024, 256, (const h16*)(ws + O_H2B), (const h16*)(ws + O_WG), 1024, 1024}; pg8::StaticOrder S; S.init(MTOK, 1024, G, bid);
        EpiPPGate E{(h16*)(ws + O_XN), (const h16*)(ws + O_H2B), (h16*)(ws + O_PP), (const float*)(ws + O_SS2), (float*)(ws + O_PART3)}; pg8::gemm_phase(lds, g, S, E); } SEAM(17);
    if (IN(18)) for (int rep = 0; rep < REPS(18); ++rep) { if (rep) SYNC(); phase_final(a); }
}

extern "C" void kernel_launch(void* const* d_in, const int* in_sizes, int n_in, void* d_out, int out_size, void* d_ws, size_t ws_size, hipStream_t stream) {
    static int ready = 0, grid = NBLK;
    if (!ready) {
        if (n_in != 29 || ws_size < WS_END) { fprintf(stderr, "kernel_launch: unexpected n_in %d / ws %zu (need %zu)\n", n_in, ws_size, (size_t)WS_END); ready = -1; return; }
        if (hipFuncSetAttribute((const void*)mk, hipFuncAttributeMaxDynamicSharedMemorySize, LDS_BYTES) != hipSuccess) { fprintf(stderr, "hipFuncSetAttribute failed\n"); ready = -1; return; }
        int dev = 0, cus = 0, per_cu = 0;
        if (hipGetDevice(&dev) == hipSuccess && hipDeviceGetAttribute(&cus, hipDeviceAttributeMultiprocessorCount, dev) == hipSuccess &&
            hipOccupancyMaxActiveBlocksPerMultiprocessor(&per_cu, (const void*)mk, NTHREADS, LDS_BYTES) == hipSuccess && cus > 0 && per_cu > 0) grid = cus < NBLK ? cus : NBLK;
        else { (void)hipGetLastError(); grid = NBLK; }
        ready = 1;
    }
    if (ready < 0) return;
    Args a{};
    for (int i = 0; i < 29; ++i) a.in[i] = (const float*)d_in[i];
    a.out = (float*)d_out; a.ws = (unsigned char*)d_ws;
    (void)hipMemsetAsync((unsigned char*)d_ws + O_BAR, 0, 16384, stream);
    a.ph_lo = 0; a.ph_hi = NPHASE;
    void* args[] = {&a};
    if (hipLaunchCooperativeKernel((const void*)mk, dim3(grid), dim3(NTHREADS), args, LDS_BYTES, stream) != hipSuccess) fprintf(stderr, "cooperative launch failed (grid %d)\n", grid);
}
```

```cpp
#include <hip/hip_runtime.h>
#include <hip/hip_cooperative_groups.h>
#include <cstdio>
namespace cg = cooperative_groups;

#ifndef REP_MASK
#define REP_MASK 0u
#endif

#define LAS __attribute__((address_space(3)))
typedef _Float16 h16;
typedef _Float16 h16x8 __attribute__((ext_vector_type(8)));
typedef _Float16 h16x4 __attribute__((ext_vector_type(4)));
typedef _Float16 h16x2 __attribute__((ext_vector_type(2)));
typedef float f32x4 __attribute__((ext_vector_type(4)));
typedef float f32x2 __attribute__((ext_vector_type(2)));
typedef unsigned u32x4 __attribute__((ext_vector_type(4)));
typedef short s16x2 __attribute__((ext_vector_type(2)));
typedef unsigned u32x2 __attribute__((ext_vector_type(2)));

constexpr int MTOK = 65536, DM = 1024, SEQ = 8192, NB = 8;
constexpr int NIN = 5376;
constexpr int NTHREADS = 512, NWAVES = 8, NBLK = 256;
constexpr int LDS_BYTES = 131072 + 128 + 2 * 12288;
constexpr float NORM_EPS = 1e-6f;

constexpr size_t MiB = 1u << 20;
constexpr size_t O_WIN = 0;
constexpr size_t O_WA = O_WIN + (size_t)5376 * 1024 * 2;
constexpr size_t O_WB = O_WA + 1 * MiB;
constexpr size_t O_WO = O_WB + 1 * MiB;
constexpr size_t O_WG = O_WO + 2 * MiB;
constexpr size_t O_WP = O_WG + 2 * MiB;
constexpr size_t O_WLR = O_WP + 2 * MiB;
constexpr size_t O_WS = O_WLR + 3 * MiB / 4;
constexpr size_t O_U16 = O_WS + 4 * MiB;
constexpr size_t O_V16 = O_U16 + 32 * MiB;
constexpr size_t O_P16 = O_V16 + 32 * MiB;
constexpr size_t O_PART1 = O_P16 + 32 * MiB;
constexpr size_t O_PART3 = O_PART1 + 4 * MiB;
constexpr size_t O_RS1 = O_PART3 + 4 * MiB;
constexpr size_t O_RS2 = O_RS1 + MiB / 4;
constexpr size_t O_XN = O_RS2 + MiB / 4;
constexpr size_t O_ZC = O_XN + 128 * MiB;
constexpr size_t O_ZR = O_ZC + 192 * MiB;
constexpr size_t O_ZG = O_ZR + 224 * MiB;
constexpr size_t O_SS2 = O_ZG + 256 * MiB;
constexpr size_t O_USC = O_SS2 + 2 * MiB;
constexpr size_t O_VSC = O_USC + 65536;
constexpr size_t O_CTR = O_VSC + 65536;
constexpr size_t O_BAR = O_CTR + 8192;
constexpr size_t O_SST2 = O_BAR + 16384;
constexpr size_t WS_END = O_SST2 + MiB;
constexpr size_t O_U8 = O_U16;
constexpr size_t O_V8 = O_U16 + 16 * MiB;
constexpr size_t O_PART = O_ZG;
constexpr size_t O_COEF = O_ZC + 128 * MiB;
constexpr size_t O_COEFS = O_COEF + 16 * MiB;
constexpr size_t O_CA = O_XN;
constexpr size_t O_APR = O_XN + 64 * MiB;
constexpr size_t O_H1B = O_XN;
constexpr size_t O_WD = O_ZC;
constexpr size_t O_BD = O_ZC + 64 * MiB;
constexpr size_t O_GG = O_ZC + 128 * MiB;
constexpr size_t O_MERGED = O_ZC;
constexpr size_t O_H2B = O_ZC;
constexpr size_t O_Y = O_ZR + 96 * MiB;
constexpr size_t O_YB = O_ZR + 160 * MiB;
constexpr size_t O_IDX = O_ZR;
constexpr size_t O_GATE = O_ZR + 16 * MiB;
constexpr size_t O_PP = O_ZR + 64 * MiB;
constexpr size_t O_SCORES = O_ZG;
constexpr size_t O_P16P = O_ZG;

struct Args {
    const float* in[29];
    float* out;
    unsigned char* ws;
    int ph_lo, ph_hi;
};

constexpr int LDS_WAVE_TAB = 131072 + 64;
extern __shared__ __attribute__((aligned(16))) unsigned char smem[];
__device__ __forceinline__ int lane_() { int l; asm volatile("v_mbcnt_lo_u32_b32 %0, -1, 0\n\tv_mbcnt_hi_u32_b32 %0, -1, %0" : "=v"(l)); return l; }
__device__ __forceinline__ unsigned hw_slot_() { return (unsigned)__builtin_amdgcn_s_getreg((5 << 11) | 4) & 63u; }
__device__ __forceinline__ int tid_() {
    const int w = (int)((volatile LAS unsigned char*)((LAS unsigned char*)smem + LDS_WAVE_TAB))[hw_slot_()];
    int t = __builtin_amdgcn_readfirstlane(w) * 64 + lane_(); asm volatile("" : "+v"(t)); return t;
}
__device__ __forceinline__ float sigmoidf_(float x) { return __builtin_amdgcn_rcpf(1.0f + __expf(-x)); }
template <int CTRL> __device__ __forceinline__ float dpp_(float v) { return __builtin_bit_cast(float, __builtin_amdgcn_update_dpp(0, __builtin_bit_cast(int, v), CTRL, 0xF, 0xF, true)); }
__device__ __forceinline__ float x32_(float v, int lane) { const auto r = __builtin_amdgcn_permlane32_swap(__builtin_bit_cast(unsigned, v), __builtin_bit_cast(unsigned, v), false, false); return __builtin_bit_cast(float, (lane & 32) ? r[0] : r[1]); }
__device__ __forceinline__ float x16_(float v, int lane) { const auto r = __builtin_amdgcn_permlane16_swap(__builtin_bit_cast(unsigned, v), __builtin_bit_cast(unsigned, v), false, false); return __builtin_bit_cast(float, (lane & 16) ? r[0] : r[1]); }
__device__ __forceinline__ float swap_add32(float a, float b) { asm("s_nop 1\n\tv_permlane32_swap_b32 %0, %1" : "+v"(a), "+v"(b)); return a + b; }
__device__ __forceinline__ float swap_add16(float a, float b) { asm("s_nop 1\n\tv_permlane16_swap_b32 %0, %1" : "+v"(a), "+v"(b)); return a + b; }
__device__ __forceinline__ float x8_(float v) { return dpp_<0x128>(v); }
__device__ __forceinline__ float xhm_(float v) { return dpp_<0x141>(v); }
__device__ __forceinline__ float wave_sum(float v) {
    const int lane = lane_();
    v += dpp_<0xB1>(v); v += dpp_<0x4E>(v); v += dpp_<0x141>(v); v += dpp_<0x140>(v);
    v += x16_(v, lane); v += x32_(v, lane);
    return v;
}
__device__ __forceinline__ float wave_max(float v) {
    const int lane = lane_();
    v = fmaxf(v, dpp_<0xB1>(v)); v = fmaxf(v, dpp_<0x4E>(v)); v = fmaxf(v, dpp_<0x141>(v)); v = fmaxf(v, dpp_<0x140>(v));
    v = fmaxf(v, x16_(v, lane)); v = fmaxf(v, x32_(v, lane));
    return v;
}
__device__ __forceinline__ __amdgpu_buffer_rsrc_t mkrsrc(const void* p) { return __builtin_amdgcn_make_buffer_rsrc((void*)p, 0, 0x7fffffff, 0x00020000); }
__device__ __forceinline__ h16x8 pack8(f32x4 a, f32x4 b) {
    h16x8 r;
    r[0] = (h16)a[0]; r[1] = (h16)a[1]; r[2] = (h16)a[2]; r[3] = (h16)a[3];
    r[4] = (h16)b[0]; r[5] = (h16)b[1]; r[6] = (h16)b[2]; r[7] = (h16)b[3];
    return r;
}
__device__ __forceinline__ h16x4 pack4(f32x4 a) {
    h16x4 r; r[0] = (h16)a[0]; r[1] = (h16)a[1]; r[2] = (h16)a[2]; r[3] = (h16)a[3]; return r;
}

#define XB_TMO      128
#define XB_XCNT(j)  (256  + 64 * (j))
#define XB_XSUB(j)  (1280 + 64 * (j))
#define XB_XGEN(j)  (2304 + 64 * (j))
#define XB_TOP      3328
#define XB_TOPGEN   3392
#define XCD_BAR_WORDS 3456
#define XB_SPIN_CAP (1u << 18)

__device__ __forceinline__ unsigned xb_ld(unsigned* p)              { return __hip_atomic_load(p, __ATOMIC_RELAXED, __HIP_MEMORY_SCOPE_AGENT); }
__device__ __forceinline__ unsigned xb_add(unsigned* p, unsigned v) { return __hip_atomic_fetch_add(p, v, __ATOMIC_RELAXED, __HIP_MEMORY_SCOPE_AGENT); }
__device__ __forceinline__ unsigned xb_xcc_id() { return (unsigned)__builtin_amdgcn_s_getreg((3 << 11) | 20) & 0xFu; }
#define XB_SPIN(cond, bar) do { unsigned _sp = 0; while (cond) { __builtin_amdgcn_s_sleep(1); \
    if ((++_sp & 255u) == 0u) { if (xb_ld(&(bar)[XB_TMO])) break; if (_sp > XB_SPIN_CAP) { atomicAdd(&(bar)[XB_TMO], 1u); break; } } } } while (0)

struct XcdBarrier {
    unsigned* bar; unsigned x;
    volatile LAS unsigned* st;
};

__device__ __forceinline__ XcdBarrier xcd_barrier_post(unsigned* bar, volatile LAS unsigned* st) {
    XcdBarrier b; b.bar = bar; b.x = xb_xcc_id(); b.st = st;
    if (tid_() == 0) (void)xb_add(&bar[XB_XCNT(b.x)], 1u);
    return b;
}
__device__ __forceinline__ void xcd_barrier_complete(unsigned* bar, unsigned x, unsigned& nloc, unsigned& nx) {
    const unsigned G = gridDim.x * gridDim.y * gridDim.z;
    unsigned sum, cnt, mine, sp = 0u;
    for (;;) {
        sum = 0u; cnt = 0u; mine = 0u;
#pragma unroll
        for (unsigned j = 0; j < 16; ++j) { const unsigned c = xb_ld(&bar[XB_XCNT(j)]); sum += c; cnt += (c > 0u) ? 1u : 0u; mine = (j == x) ? c : mine; }
        if (sum == G) break;
        __builtin_amdgcn_s_sleep(1);
        if ((++sp & 255u) == 0u) { if (xb_ld(&bar[XB_TMO])) break; if (sp > XB_SPIN_CAP) { atomicAdd(&bar[XB_TMO], 1u); break; } }
    }
    nloc = mine > 0u ? mine : 1u; nx = cnt > 0u ? cnt : 1u;
}

__device__ __forceinline__ void xcd_barrier(const XcdBarrier& b) {
    asm volatile("s_waitcnt vmcnt(0)" ::: "memory");
    __syncthreads();
    if (tid_() == 0) {
        unsigned* bar = b.bar;
        __builtin_amdgcn_s_waitcnt(0);
        unsigned nloc = b.st[0], nx = b.st[1];
        if (nloc == 0u) { xcd_barrier_complete(bar, b.x, nloc, nx); b.st[0] = nloc; b.st[1] = nx; }
        const unsigned old = xb_add(&bar[XB_XSUB(b.x)], 1u);
        const unsigned gen = old / nloc;
        if (old + 1u == (gen + 1u) * nloc) {
            __builtin_amdgcn_fence(__ATOMIC_RELEASE, "agent");
            asm volatile("s_waitcnt vmcnt(0)" ::: "memory");
            const unsigned og = xb_add(&bar[XB_TOP], 1u);
            const unsigned tg = og / nx;
            if (og + 1u == (tg + 1u) * nx) xb_add(&bar[XB_TOPGEN], 1u);
            else XB_SPIN(xb_ld(&bar[XB_TOPGEN]) == tg, bar);
            __builtin_amdgcn_fence(__ATOMIC_ACQUIRE, "agent");
            xb_add(&bar[XB_XGEN(b.x)], 1u);
            asm volatile("s_waitcnt vmcnt(0)" ::: "memory");
        } else {
            XB_SPIN(xb_ld(&bar[XB_XGEN(b.x)]) == gen, bar);
            __builtin_amdgcn_fence(__ATOMIC_ACQUIRE, "agent");
            asm volatile("s_waitcnt vmcnt(0)" ::: "memory");
        }
    }
    __syncthreads();
}


namespace pg8 {
constexpr int BM = 256, BK = 64, HALF = 128, HTB = HALF * BK * 2, STAGE_BYTES = 8 * HTB, NXCD = 8, WGM = 8;
__device__ __forceinline__ int lds_byte(int r, int c) { const int st = (r >> 4) * 2 + (c >> 5), rr = r & 15, cc = c & 31, ob = rr * 64 + cc * 2; return st * 1024 + (ob ^ (((ob >> 9) & 1) << 5)); }
__device__ __forceinline__ void stage_rc(int b, int& R, int& C) { const int st = b / 1024, sb = b % 1024, swz = sb ^ (((sb >> 9) & 1) << 5); R = (st >> 1) * 16 + swz / 64; C = (st & 1) * 32 + (swz % 64) / 2; }
__device__ __forceinline__ int perm32(int rho) { const int n = rho >> 4, i = rho & 15; return 8 * (i >> 2) + 4 * n + (i & 3); }

struct Unit { int pm, pn; };
struct Gemm { const h16* A; const h16* Bt; int M, N, K; const h16* A2; const h16* Bt2; int ld, K2; };

struct StaticOrder {
    int nM, nN, nwg, G, c;
    __device__ void init(int M, int N, int G_, int c_) { nM = M / BM; nN = N / BM; nwg = nM * nN; G = G_; c = c_; }
    __device__ bool next(int i, Unit& u) const {
        const long L = (long)i * G + c; if (L >= nwg) return false;
        int wgid = (int)L; { const int q = nwg / NXCD, r = nwg % NXCD, xcd = wgid % NXCD, off = wgid / NXCD; wgid = (xcd < r ? xcd * (q + 1) : r * (q + 1) + (xcd - r) * q) + off; }
        const int nig = WGM * nN, gid = wgid / nig, fm = gid * WGM, rem = wgid - gid * nig;
        u.pm = fm + (rem % WGM); u.pn = rem / WGM; return true;
    }
};

template <class Epi>
__device__ __forceinline__ void gemm_phase(LAS unsigned char* lds, const Gemm g, const StaticOrder& S, const Epi& E) {
    const int tid = tid_(), wid = __builtin_amdgcn_readfirstlane(tid >> 6), lane = tid & 63, wr = wid >> 2, wc = wid & 3, fr = lane & 15, fq = lane >> 4;
    const int K = g.ld ? g.ld : g.K, nt0 = g.K / BK, nt1 = (g.K2 ? g.K2 : g.K) / BK;
    unsigned voffA[2], voffB[2];
#pragma unroll
    for (int i = 0; i < 2; ++i) { int R, C; stage_rc(tid * 16 + i * 8192, R, C); const int Rb = (R & ~31) + perm32(R & 31);
        voffA[i] = (unsigned)(R * K + C) * 2u; voffB[i] = (unsigned)(Rb * K + C) * 2u; }
    const size_t kstep = (size_t)(BK * 2);
    const size_t hstep = (size_t)HALF * K * 2;
    const size_t tstep = 2 * hstep;
    const unsigned ldsw = (unsigned)wid * 1024u;
    const int aoff = lds_byte(wr * 64 + fr, fq * 8), boff = lds_byte(wc * 32 + fr, fq * 8);
#define PG8_SA(b, h) (((b) * 2 + (h)) * HTB)
#define PG8_SB(b, h) ((4 + (b) * 2 + (h)) * HTB)
#define PG8_STAGE(bufoff, gbase, voff) do { _Pragma("unroll") for (int _i = 0; _i < 2; ++_i) \
        __builtin_amdgcn_global_load_lds((const unsigned*)((const char*)(gbase) + (voff)[_i]), (LAS unsigned*)(lds + (bufoff) + ldsw + _i * 8192), 16, 0, 0); } while (0)
#define PG8_LDA(dst, b, h) do { _Pragma("unroll") for (int m = 0; m < 4; ++m) _Pragma("unroll") for (int k = 0; k < 2; ++k) dst[m][k] = *(const LAS h16x8*)(lds + PG8_SA(b, h) + aoff + m * 2048 + k * 1024); } while (0)
#define PG8_LDB(dst, b, h) do { _Pragma("unroll") for (int n = 0; n < 2; ++n) _Pragma("unroll") for (int k = 0; k < 2; ++k) dst[n][k] = *(const LAS h16x8*)(lds + PG8_SB(b, h) + boff + n * 2048 + k * 1024); } while (0)
#define PG8_MMA(ai, bj, At, Bt) do { __builtin_amdgcn_s_setprio(1); _Pragma("unroll") for (int m = 0; m < 4; ++m) _Pragma("unroll") for (int n = 0; n < 2; ++n) _Pragma("unroll") for (int k = 0; k < 2; ++k) \
        acc[ai][bj][m][n] = __builtin_amdgcn_mfma_f32_16x16x32_f16(Bt[n][k], At[m][k], acc[ai][bj][m][n], 0, 0, 0); __builtin_amdgcn_s_setprio(0); } while (0)
#define PG8_WAIT_V(n) asm volatile("s_waitcnt vmcnt(" #n ")" ::: "memory")
#define PG8_WAIT_L(n) asm volatile("s_waitcnt lgkmcnt(" #n ")" ::: "memory")
#define PG8_BAR __builtin_amdgcn_s_barrier()
#define PG8_SCHED __builtin_amdgcn_sched_barrier(0)
    Unit cur, nxt; int ui = 0;
    constexpr bool TP = Epi::TWO_PART;
    if (!S.next(0, cur)) return;
    f32x4 acc[2][2][4][2];
#pragma unroll
    for (int a = 0; a < 2; ++a)
#pragma unroll
        for (int b = 0; b < 2; ++b)
#pragma unroll
            for (int m = 0; m < 4; ++m)
#pragma unroll
                for (int n = 0; n < 2; ++n) acc[a][b][m][n] = (f32x4){0.f, 0.f, 0.f, 0.f};
    h16x8 At[4][2], B0[2][2], B1[2][2];
    const char* cA = (const char*)g.A + (size_t)cur.pm * tstep; const char* cB = (const char*)g.Bt + (size_t)cur.pn * tstep;
    PG8_STAGE(PG8_SB(0, 0), cB, voffB); PG8_STAGE(PG8_SB(0, 1), cB + hstep, voffB); PG8_STAGE(PG8_SA(0, 0), cA, voffA); PG8_STAGE(PG8_SA(0, 1), cA + hstep, voffA);
    if (wr == 1) PG8_BAR;
    PG8_WAIT_V(2); PG8_BAR;
    PG8_STAGE(PG8_SB(1, 0), cB + kstep, voffB); PG8_STAGE(PG8_SA(1, 0), cA + kstep, voffA); PG8_STAGE(PG8_SB(1, 1), cB + hstep + kstep, voffB);
    PG8_WAIT_V(6); PG8_BAR;
    for (;;) {
        const bool has_next = TP ? (((ui + 1) & 1) ? (nxt = cur, true) : S.next((ui + 1) >> 1, nxt)) : S.next(ui + 1, nxt);
        const h16* gA_n = (TP && ((ui + 1) & 1)) ? g.A2 : g.A; const h16* gB_n = (TP && ((ui + 1) & 1)) ? g.Bt2 : g.Bt;
        const char* nA = has_next ? (const char*)gA_n + (size_t)nxt.pm * tstep : cA; const char* nB = has_next ? (const char*)gB_n + (size_t)nxt.pn * tstep : cB;
        const int nt = (TP && (ui & 1)) ? nt1 : nt0;
        for (int t = 0; t < nt; t += 2) {
            const bool last = (t == nt - 2);
            const char* a1 = cA + (size_t)(t + 1) * kstep;
            const char* a2 = last ? nA : cA + (size_t)(t + 2) * kstep; const char* b2 = last ? nB : cB + (size_t)(t + 2) * kstep;
            const char* a3 = a2 + kstep; const char* b3 = b2 + kstep;
            PG8_LDB(B0, 0, 0); PG8_LDB(B1, 0, 1); PG8_SCHED; PG8_LDA(At, 0, 0); PG8_STAGE(PG8_SA(1, 1), a1 + hstep, voffA);
            PG8_WAIT_V(8); PG8_WAIT_L(0); PG8_BAR; PG8_MMA(0, 0, At, B0); PG8_MMA(0, 1, At, B1); PG8_BAR; PG8_SCHED;
            PG8_LDA(At, 0, 1); PG8_STAGE(PG8_SB(0, 0), b2, voffB); PG8_STAGE(PG8_SB(0, 1), b2 + hstep, voffB); PG8_STAGE(PG8_SA(0, 0), a2, voffA);
            PG8_WAIT_V(8); PG8_WAIT_L(0); PG8_BAR; PG8_MMA(1, 0, At, B0); PG8_MMA(1, 1, At, B1); PG8_BAR; PG8_SCHED;
            PG8_LDB(B0, 1, 0); PG8_LDB(B1, 1, 1); PG8_SCHED; PG8_LDA(At, 1, 0); PG8_STAGE(PG8_SA(0, 1), a2 + hstep, voffA);
            PG8_WAIT_V(8); PG8_WAIT_L(0); PG8_BAR; PG8_MMA(0, 0, At, B0); PG8_MMA(0, 1, At, B1); PG8_BAR; PG8_SCHED;
            PG8_LDA(At, 1, 1); PG8_STAGE(PG8_SB(1, 0), b3, voffB); PG8_STAGE(PG8_SB(1, 1), b3 + hstep, voffB); PG8_STAGE(PG8_SA(1, 0), a3, voffA);
            PG8_WAIT_V(8); PG8_WAIT_L(0); PG8_BAR; PG8_MMA(1, 0, At, B0); PG8_MMA(1, 1, At, B1); PG8_BAR; PG8_SCHED;
        }
        if (wr == 0) PG8_BAR;
        if constexpr (TP) { if ((ui & 1) == 0) E.mid(acc, cur, wr, wc, fr, fq); else E(acc, cur, wr, wc, fr, fq); } else E(acc, cur, wr, wc, fr, fq);
        if (!has_next) break;
        bool keep = false; if constexpr (TP) keep = Epi::KEEP_ACC && ((ui & 1) == 0);
        if (!keep)
#pragma unroll
        for (int a = 0; a < 2; ++a)
#pragma unroll
            for (int b = 0; b < 2; ++b)
#pragma unroll
                for (int m = 0; m < 4; ++m)
#pragma unroll
                    for (int n = 0; n < 2; ++n) acc[a][b][m][n] = (f32x4){0.f, 0.f, 0.f, 0.f};
        cur = nxt; cA = nA; cB = nB; ++ui;
        if (wr == 1) PG8_BAR;
    }
    PG8_WAIT_V(0);
    PG8_BAR;
#undef PG8_SA
#undef PG8_SB
#undef PG8_STAGE
#undef PG8_LDA
#undef PG8_LDB
#undef PG8_MMA
#undef PG8_WAIT_V
#undef PG8_WAIT_L
#undef PG8_BAR
#undef PG8_SCHED
}
}
using pg8::Unit;
typedef const f32x4 (&AccRef)[2][2][4][2];

#define EPI_LOOP_BEGIN \
    _Pragma("unroll") for (int ai = 0; ai < 2; ++ai) _Pragma("unroll") for (int m = 0; m < 4; ++m) { \
        const int row = u.pm * 256 + ai * 128 + wr * 64 + m * 16 + fr; \
        _Pragma("unroll") for (int bj = 0; bj < 2; ++bj) { \
            const int col = u.pn * 256 + bj * 128 + wc * 32 + 8 * fq; \
            const f32x4 v0 = acc[ai][bj][m][0], v1 = acc[ai][bj][m][1];
#define EPI_LOOP_END } }

struct EpiZ {
    static constexpr bool TWO_PART = false;
    h16 *zc, *zr, *zg;
    __device__ __forceinline__ void operator()(AccRef acc, const Unit& u, int wr, int wc, int fr, int fq) const {
        const int colt = u.pn * 256; h16* base; int ld, c0;
        if (colt < 1536) { base = zc; ld = 1536; c0 = colt; } else if (colt < 3328) { base = zr; ld = 1792; c0 = colt - 1536; } else { base = zg; ld = 2048; c0 = colt - 3328; }
        EPI_LOOP_BEGIN
            *(h16x8*)(base + (size_t)row * ld + (col - colt + c0)) = pack8(v0, v1);
        EPI_LOOP_END
    }
};
struct EpiF16 {
    static constexpr bool TWO_PART = false;
    h16* O; int ld;
    __device__ __forceinline__ void operator()(AccRef acc, const Unit& u, int wr, int wc, int fr, int fq) const {
        EPI_LOOP_BEGIN
            *(h16x8*)(O + (size_t)row * ld + col) = pack8(v0, v1);
        EPI_LOOP_END
    }
};
struct EpiMerged {
    static constexpr bool TWO_PART = true, KEEP_ACC = true;
    const h16* zg; h16* merged;
    __device__ __forceinline__ void mid(f32x4 (&acc)[2][2][4][2], const Unit& u, int wr, int wc, int fr, int fq) const {
#pragma unroll
        for (int ai = 0; ai < 2; ++ai) {
            h16x8 gav[4][2], gbv[4][2];
#pragma unroll
            for (int m = 0; m < 4; ++m) { const int row = u.pm * 256 + ai * 128 + wr * 64 + m * 16 + fr;
#pragma unroll
                for (int bj = 0; bj < 2; ++bj) { const int col = u.pn * 256 + bj * 128 + wc * 32 + 8 * fq;
                    gav[m][bj] = *(const h16x8*)(zg + (size_t)row * 2048 + col); gbv[m][bj] = *(const h16x8*)(zg + (size_t)row * 2048 + 1024 + col); } }
#pragma unroll
            for (int m = 0; m < 4; ++m)
#pragma unroll
                for (int bj = 0; bj < 2; ++bj) { const h16x8 ga = gav[m][bj], gb = gbv[m][bj];
#pragma unroll
                    for (int j = 0; j < 4; ++j) {
                        acc[ai][bj][m][0][j] *= (1.0f + __expf(-(float)gb[j])) * __builtin_amdgcn_rcpf(1.0f + __expf(-(float)ga[j]));
                        acc[ai][bj][m][1][j] *= (1.0f + __expf(-(float)gb[4 + j])) * __builtin_amdgcn_rcpf(1.0f + __expf(-(float)ga[4 + j])); } }
        }
    }
    __device__ __forceinline__ void operator()(AccRef acc, const Unit& u, int wr, int wc, int fr, int fq) const {
#pragma unroll
        for (int ai = 0; ai < 2; ++ai) {
            h16x8 gvv[4][2];
#pragma unroll
            for (int m = 0; m < 4; ++m) { const int row = u.pm * 256 + ai * 128 + wr * 64 + m * 16 + fr;
#pragma unroll
                for (int bj = 0; bj < 2; ++bj) { const int col = u.pn * 256 + bj * 128 + wc * 32 + 8 * fq; gvv[m][bj] = *(const h16x8*)(zg + (size_t)row * 2048 + 1024 + col); } }
#pragma unroll
            for (int m = 0; m < 4; ++m) { const int row = u.pm * 256 + ai * 128 + wr * 64 + m * 16 + fr;
#pragma unroll
                for (int bj = 0; bj < 2; ++bj) { const int col = u.pn * 256 + bj * 128 + wc * 32 + 8 * fq;
                    const h16x8 gv = gvv[m][bj]; const f32x4 v0 = acc[ai][bj][m][0], v1 = acc[ai][bj][m][1];
                    f32x4 o0, o1;
#pragma unroll
                    for (int j = 0; j < 4; ++j) { o0[j] = sigmoidf_((float)gv[j]) * v0[j]; o1[j] = sigmoidf_((float)gv[4 + j]) * v1[j]; }
                    *(h16x8*)(merged + (size_t)row * 1024 + col) = pack8(o0, o1); } }
        }
    }
};
struct EpiH1 {
    static constexpr bool TWO_PART = false;
    const float* x; h16* hb; float* part;
    __device__ __forceinline__ void operator()(AccRef acc, const Unit& u, int wr, int wc, int fr, int fq) const {
#pragma unroll
        for (int ai = 0; ai < 2; ++ai) {
            f32x4 xv[4][2][2];
#pragma unroll
            for (int m = 0; m < 4; ++m) { const int row = u.pm * 256 + ai * 128 + wr * 64 + m * 16 + fr;
#pragma unroll
                for (int bj = 0; bj < 2; ++bj) { const int col = u.pn * 256 + bj * 128 + wc * 32 + 8 * fq; const float* xp = x + (size_t)row * 1024 + col;
                    xv[m][bj][0] = *(const f32x4*)xp; xv[m][bj][1] = *(const f32x4*)(xp + 4); } }
#pragma unroll
            for (int m = 0; m < 4; ++m) {
                const int row = u.pm * 256 + ai * 128 + wr * 64 + m * 16 + fr; float ss = 0.f;
#pragma unroll
                for (int bj = 0; bj < 2; ++bj) {
                    const int col = u.pn * 256 + bj * 128 + wc * 32 + 8 * fq;
                    const f32x4 o0 = xv[m][bj][0] + acc[ai][bj][m][0], o1 = xv[m][bj][1] + acc[ai][bj][m][1];
                    *(h16x8*)(hb + (size_t)row * 1024 + col) = pack8(o0, o1);
                    ss += (o0[0] * o0[0] + o0[1] * o0[1]) + (o0[2] * o0[2] + o0[3] * o0[3]) + (o1[0] * o1[0] + o1[1] * o1[1]) + (o1[2] * o1[2] + o1[3] * o1[3]);
                }
                { const int ln_ = fr + 16 * fq; ss += x16_(ss, ln_); ss += x32_(ss, ln_); }
                if (fq == 0) part[(size_t)row * 16 + u.pn * 4 + wc] = ss;
            }
        }
    }
};
struct EpiGate {
    static constexpr bool TWO_PART = false;
    h16* h3b; const h16* h2b; const h16* pp; const float* rs2; float* part;
    __device__ __forceinline__ void operator()(AccRef acc, const Unit& u, int wr, int wc, int fr, int fq) const {
#pragma unroll
        for (int ai = 0; ai < 2; ++ai) {
            float rsv[4]; h16x8 hvv[4][2], pvv[4][2];
            { f32x4 sav[4], sbv[4];
#pragma unroll
              for (int m = 0; m < 4; ++m) { const int row = u.pm * 256 + ai * 128 + wr * 64 + m * 16 + fr; sav[m] = *(const f32x4*)(rs2 + (size_t)row * 8); sbv[m] = *(const f32x4*)(rs2 + (size_t)row * 8 + 4); }
#pragma unroll
              for (int m = 0; m < 4; ++m) { const f32x4 sa = sav[m], sb = sbv[m]; rsv[m] = rsqrtf(((sa[0] + sa[1]) + (sa[2] + sa[3]) + (sb[0] + sb[1]) + (sb[2] + sb[3])) * (1.f / 1024.f) + NORM_EPS); } }
#pragma unroll
            for (int m = 0; m < 4; ++m) { const int row = u.pm * 256 + ai * 128 + wr * 64 + m * 16 + fr;
#pragma unroll
                for (int bj = 0; bj < 2; ++bj) { const int col = u.pn * 256 + bj * 128 + wc * 32 + 8 * fq;
                    hvv[m][bj] = *(const h16x8*)(h2b + (size_t)row * 1024 + col); pvv[m][bj] = *(const h16x8*)(pp + (size_t)row * 1024 + col); } }
#pragma unroll
            for (int m = 0; m < 4; ++m) {
                const int row = u.pm * 256 + ai * 128 + wr * 64 + m * 16 + fr; float ss = 0.f;
                const float rs = rsv[m];
#pragma unroll
                for (int bj = 0; bj < 2; ++bj) {
                    const int col = u.pn * 256 + bj * 128 + wc * 32 + 8 * fq;
                    const h16x8 hv = hvv[m][bj];
                    f32x4 o0 = (f32x4){(float)hv[0], (float)hv[1], (float)hv[2], (float)hv[3]}, o1 = (f32x4){(float)hv[4], (float)hv[5], (float)hv[6], (float)hv[7]};
                    const h16x8 pv = pvv[m][bj];
                    const f32x4 v0 = acc[ai][bj][m][0], v1 = acc[ai][bj][m][1];
#pragma unroll
                    for (int j = 0; j < 4; ++j) { o0[j] += sigmoidf_(rs * v0[j]) * (float)pv[j]; o1[j] += sigmoidf_(rs * v1[j]) * (float)pv[4 + j]; }
                    *(h16x8*)(h3b + (size_t)row * 1024 + col) = pack8(o0, o1);
                    ss += (o0[0] * o0[0] + o0[1] * o0[1]) + (o0[2] * o0[2] + o0[3] * o0[3]) + (o1[0] * o1[0] + o1[1] * o1[1]) + (o1[2] * o1[2] + o1[3] * o1[3]);
                }
                { const int ln_ = fr + 16 * fq; ss += x16_(ss, ln_); ss += x32_(ss, ln_); }
                if (fq == 0) part[(size_t)row * 16 + u.pn * 4 + wc] = ss;
            }
        }
    }
};
struct EpiPPGate {
    static constexpr bool TWO_PART = true, KEEP_ACC = false;
    h16* h3b; const h16* h2b; h16* pp; const float* rs2; float* part;
    __device__ __forceinline__ void mid(f32x4 (&acc)[2][2][4][2], const Unit& u, int wr, int wc, int fr, int fq) const {
#pragma unroll
        for (int ai = 0; ai < 2; ++ai)
#pragma unroll
            for (int m = 0; m < 4; ++m) { const int row = u.pm * 256 + ai * 128 + wr * 64 + m * 16 + fr;
#pragma unroll
                for (int bj = 0; bj < 2; ++bj) { const int col = u.pn * 256 + bj * 128 + wc * 32 + 8 * fq;
                    *(h16x8*)(pp + (size_t)row * 1024 + col) = pack8(acc[ai][bj][m][0], acc[ai][bj][m][1]); } }
    }
    __device__ __forceinline__ void operator()(AccRef acc, const Unit& u, int wr, int wc, int fr, int fq) const {
#pragma unroll
        for (int ai = 0; ai < 2; ++ai) {
            float rsv[4]; h16x8 hvv[4][2], pvv[4][2];
            { f32x4 sav[4], sbv[4];
#pragma unroll
              for (int m = 0; m < 4; ++m) { const int row = u.pm * 256 + ai * 128 + wr * 64 + m * 16 + fr; sav[m] = *(const f32x4*)(rs2 + (size_t)row * 8); sbv[m] = *(const f32x4*)(rs2 + (size_t)row * 8 + 4); }
#pragma unroll
              for (int m = 0; m < 4; ++m) { const f32x4 sa = sav[m], sb = sbv[m]; rsv[m] = rsqrtf(((sa[0] + sa[1]) + (sa[2] + sa[3]) + (sb[0] + sb[1]) + (sb[2] + sb[3])) * (1.f / 1024.f) + NORM_EPS); } }
#pragma unroll
          for (int m2 = 0; m2 < 4; m2 += 2) {
#pragma unroll
            for (int m = m2; m < m2 + 2; ++m) { const int row = u.pm * 256 + ai * 128 + wr * 64 + m * 16 + fr;
#pragma unroll
                for (int bj = 0; bj < 2; ++bj) { const int col = u.pn * 256 + bj * 128 + wc * 32 + 8 * fq;
                    hvv[m][bj] = *(const h16x8*)(h2b + (size_t)row * 1024 + col); pvv[m][bj] = *(const h16x8*)(pp + (size_t)row * 1024 + col); } }
#pragma unroll
            for (int m = m2; m < m2 + 2; ++m) {
                const int row = u.pm * 256 + ai * 128 + wr * 64 + m * 16 + fr; float ss = 0.f;
                const float rs = rsv[m];
#pragma unroll
                for (int bj = 0; bj < 2; ++bj) {
                    const int col = u.pn * 256 + bj * 128 + wc * 32 + 8 * fq;
                    const h16x8 hv = hvv[m][bj];
                    f32x4 o0 = (f32x4){(float)hv[0], (float)hv[1], (float)hv[2], (float)hv[3]}, o1 = (f32x4){(float)hv[4], (float)hv[5], (float)hv[6], (float)hv[7]};
                    const h16x8 pv = pvv[m][bj];
                    const f32x4 v0 = acc[ai][bj][m][0], v1 = acc[ai][bj][m][1];
#pragma unroll
                    for (int j = 0; j < 4; ++j) { o0[j] += sigmoidf_(rs * v0[j]) * (float)pv[j]; o1[j] += sigmoidf_(rs * v1[j]) * (float)pv[4 + j]; }
                    *(h16x8*)(h3b + (size_t)row * 1024 + col) = pack8(o0, o1);
                    ss += (o0[0] * o0[0] + o0[1] * o0[1]) + (o0[2] * o0[2] + o0[3] * o0[3]) + (o1[0] * o1[0] + o1[1] * o1[1]) + (o1[2] * o1[2] + o1[3] * o1[3]);
                }
                { const int ln_ = fr + 16 * fq; ss += x16_(ss, ln_); ss += x32_(ss, ln_); }
                if (fq == 0) part[(size_t)row * 16 + u.pn * 4 + wc] = ss;
            }
          }
        }
    }
};

__device__ __forceinline__ void tr_item(const float* W, int N, const float* g, h16* WT, int ldk, int koff, int k0, int n0, LAS float* scr, int lane) {
#pragma unroll 8
    for (int i = 0; i < 32; ++i) { const int kk = 2 * i + (lane >> 5); float v = W[(size_t)(k0 + kk) * N + n0 + (lane & 31)]; if (g) v *= g[k0 + kk]; scr[kk * 33 + (lane & 31)] = v; }
    asm volatile("s_waitcnt lgkmcnt(0)" ::: "memory");
    const int c = lane & 7;
#pragma unroll
    for (int j = 0; j < 4; ++j) { const int n = (lane >> 3) + 8 * j; const LAS float* s = scr + (8 * c) * 33 + n;
        h16x8 o;
#pragma unroll
        for (int e = 0; e < 8; ++e) o[e] = (h16)s[e * 33];
        *(h16x8*)(WT + (size_t)(n0 + n) * ldk + koff + k0 + 8 * c) = o; }
    asm volatile("s_waitcnt lgkmcnt(0)" ::: "memory");
}
struct TrJob { const float* W; const float* g; h16* WT; int K, N, ldk, koff; };

__device__ __forceinline__ void phase_prep(const Args& a, LAS unsigned char* lds) {
    const int tid = tid_(), lane = tid & 63, wave = tid >> 6;
    const int gw = blockIdx.x * NWAVES + wave, NGW = gridDim.x * NWAVES;
    unsigned char* ws = a.ws;
    {
        LAS float* scr = (LAS float*)(lds + wave * 8704);
        TrJob jobs[9] = {
            {a.in[3], a.in[2], (h16*)(ws + O_WIN), 1024, NIN, 1024, 0},
            {a.in[17], nullptr, (h16*)(ws + O_WA), 512, 1024, 512, 0},
            {a.in[18], nullptr, (h16*)(ws + O_WB), 512, 1024, 512, 0},
            {a.in[19], nullptr, (h16*)(ws + O_WO), 1024, 1024, 1024, 0},
            {a.in[26], a.in[25], (h16*)(ws + O_WG), 1024, 1024, 1024, 0},
            {a.in[27], nullptr, (h16*)(ws + O_WP), 256, 1024, 1024, 0},
            {a.in[8], nullptr, (h16*)(ws + O_WLR), 64, 512, 256, 0},
            {a.in[10], nullptr, (h16*)(ws + O_WLR) + (size_t)512 * 256, 64, 512, 256, 64},
            {a.in[11], nullptr, (h16*)(ws + O_WLR) + (size_t)1024 * 256, 128, 512, 256, 128},
        };
        int base = 0;
#pragma unroll
        for (int j = 0; j < 9; ++j) {
            const TrJob J = jobs[j]; const int nnb = J.N / 32, items = (J.K / 64) * nnb;
            int first = gw - (base % NGW); if (first < 0) first += NGW;
            for (int r = first; r < items; r += NGW) tr_item(J.W, J.N, J.g, J.WT, J.ldk, J.koff, (r / nnb) * 64, (r % nnb) * 32, scr, lane);
            base += items;
        }
        h16* wlr = (h16*)(ws + O_WLR);
        for (int i = blockIdx.x * NTHREADS + tid; i < 1536 * 256 / 8; i += gridDim.x * NTHREADS) {
            const int n = (i * 8) / 256, k = (i * 8) % 256; const int blk = n / 512;
            const bool inblk = (blk == 0) ? (k < 64) : (blk == 1) ? (k >= 64 && k < 128) : (k >= 128);
            if (!inblk) { h16x8 z; for (int e = 0; e < 8; ++e) z[e] = (h16)0.f; *(h16x8*)(wlr + (size_t)i * 8) = z; }
        }
    }
    __syncthreads();
    {
        LAS float* LA = (LAS float*)lds;
        LAS float* LB = (LAS float*)(lds + 64 * 129 * 4);
        const float* wq = a.in[21]; const float* sk = a.in[22]; const float* gf = a.in[20];
        h16* wst = (h16*)(ws + O_WS);
        for (int it = blockIdx.x; it < 256; it += gridDim.x) {
            const int g16 = it >> 4, k0 = (it & 15) * 64;
            for (int i = tid; i < 64 * 128; i += NTHREADS) { const int k = i >> 7, d = i & 127; LA[k * 129 + d] = wq[(size_t)(k0 + k) * 2048 + g16 * 128 + d] * gf[k0 + k]; }
            for (int i = tid; i < 128 * 128; i += NTHREADS) { const int n = i >> 7, d = i & 127; LB[n * 129 + d] = sk[((size_t)g16 * 128 + n) * 128 + d]; }
            __syncthreads();
            const int n = tid & 127, kg = tid >> 7;
            float o[16];
#pragma unroll
            for (int j = 0; j < 16; ++j) o[j] = 0.f;
            for (int d = 0; d < 128; ++d) { const float b = LB[n * 129 + d];
#pragma unroll
                for (int j = 0; j < 16; ++j) o[j] += LA[(kg * 16 + j) * 129 + d] * b; }
            h16x8 o0, o1;
#pragma unroll
            for (int j = 0; j < 8; ++j) { o0[j] = (h16)o[j]; o1[j] = (h16)o[8 + j]; }
            h16* dst = wst + (size_t)(g16 * 128 + n) * 1024 + k0 + kg * 16;
            *(h16x8*)dst = o0; *(h16x8*)(dst + 8) = o1;
            __syncthreads();
        }
    }
    {
        const float* gf = a.in[20];
        f32x4 g4[4];
#pragma unroll
        for (int j = 0; j < 4; ++j) g4[j] = *(const f32x4*)(gf + 16 * lane + 4 * j);
        for (int r = gw; r < 2 * 16384; r += NGW) {
            const int tb = r >> 14, e = r & 16383;
            const float* src = (tb ? a.in[24] : a.in[23]) + (size_t)e * 1024 + 16 * lane;
            f32x4 v[4]; float mx = 0.f;
#pragma unroll
            for (int j = 0; j < 4; ++j) { v[j] = *(const f32x4*)(src + 4 * j); if (!tb) v[j] = v[j] * g4[j];
#pragma unroll
                for (int c = 0; c < 4; ++c) mx = fmaxf(mx, fabsf(v[j][c])); }
            mx = wave_max(mx);
            mx = fmaxf(mx, 1e-30f);
            const float sc = 127.0f / mx;
            u32x4 q;
#pragma unroll
            for (int j = 0; j < 4; ++j) {
                const int i0 = __float2int_rn(v[j][0] * sc), i1 = __float2int_rn(v[j][1] * sc), i2 = __float2int_rn(v[j][2] * sc), i3 = __float2int_rn(v[j][3] * sc);
                q[j] = (unsigned)(i0 & 0xff) | ((unsigned)(i1 & 0xff) << 8) | ((unsigned)(i2 & 0xff) << 16) | ((unsigned)i3 << 24); }
            unsigned char* dst = ws + (tb ? O_V8 : O_U8) + ((size_t)(lane >> 3) * 16384 + e) * 128 + 16 * (lane & 7);
            *(u32x4*)dst = q;
            if (lane == 0) ((float*)(ws + (tb ? O_VSC : O_USC)))[e] = mx * (1.0f / 127.0f);
        }
        if (blockIdx.x == 0 && tid < 32) ((unsigned*)(ws + O_CTR))[tid * 64] = 0u;
    }
    {
        const float* x = a.in[0]; h16* xn = (h16*)(ws + O_XN);
#define XN_LOAD(VV, RQ) do { _Pragma("unroll") for (int q = 0; q < 4; ++q) { const int r = (RQ) + q * NGW; if (r < MTOK) { const f32x4* xr = (const f32x4*)(x + (size_t)r * 1024) + lane; \
                _Pragma("unroll") for (int j = 0; j < 4; ++j) VV[q][j] = xr[64 * j]; } } } while (0)
#define XN_COMP(VV, RQ) do { _Pragma("unroll") for (int q = 0; q < 4; ++q) { const int r = (RQ) + q * NGW; if (r < MTOK) { float s = 0.f; \
                _Pragma("unroll") for (int j = 0; j < 4; ++j) s += (VV[q][j][0] * VV[q][j][0] + VV[q][j][1] * VV[q][j][1]) + (VV[q][j][2] * VV[q][j][2] + VV[q][j][3] * VV[q][j][3]); \
                const float rs = rsqrtf(wave_sum(s) * (1.f / 1024.f) + NORM_EPS); \
                h16x4* o = (h16x4*)(xn + (size_t)r * 1024) + lane; \
                _Pragma("unroll") for (int j = 0; j < 4; ++j) o[64 * j] = pack4(VV[q][j] * rs); } } } while (0)
        f32x4 vA[4][4], vB[4][4];
        const int step = 4 * NGW;
        XN_LOAD(vA, gw);
        for (int rq = gw; rq < MTOK; rq += 2 * step) {
            XN_LOAD(vB, rq + step);
            XN_COMP(vA, rq);
            XN_LOAD(vA, rq + 2 * step);
            XN_COMP(vB, rq + step);
        }
#undef XN_LOAD
#undef XN_COMP
    }
}

__device__ __forceinline__ void phase_conv(const Args& a) {
    const int tid = tid_(), lane = tid & 63, wave = tid >> 6;
    const int gw = blockIdx.x * NWAVES + wave, NGW = gridDim.x * NWAVES;
    const h16* zc = (const h16*)(a.ws + O_ZC); h16* ca = (h16*)(a.ws + O_CA);
    const float* cw = a.in[4]; const float* cb = a.in[5];
    float w0[8], w1[8], w2[8], bb[8];
#pragma unroll
    for (int j = 0; j < 8; ++j) { const int c = lane * 8 + j; w0[j] = cw[c]; w1[j] = cw[512 + c]; w2[j] = cw[1024 + c]; bb[j] = cb[c]; }
    for (int run = gw; run < MTOK / 32; run += NGW) {
        const int t0 = run * 32;
        float u1[8], u2[8];
        if ((t0 % SEQ) == 0) {
#pragma unroll
            for (int j = 0; j < 8; ++j) { u1[j] = 0.f; u2[j] = 0.f; }
        } else {
            const h16x8 c1 = *(const h16x8*)(zc + (size_t)(t0 - 1) * 1536 + 512 + lane * 8), x1 = *(const h16x8*)(zc + (size_t)(t0 - 1) * 1536 + 1024 + lane * 8);
            const h16x8 c2 = *(const h16x8*)(zc + (size_t)(t0 - 2) * 1536 + 512 + lane * 8), x2 = *(const h16x8*)(zc + (size_t)(t0 - 2) * 1536 + 1024 + lane * 8);
#pragma unroll
            for (int j = 0; j < 8; ++j) { u1[j] = (float)c1[j] * (float)x1[j]; u2[j] = (float)c2[j] * (float)x2[j]; }
        }
#define CV_LOAD(GB, GC, XI, TB) do { _Pragma("unroll") for (int q = 0; q < 4; ++q) { const h16* zrow = zc + (size_t)((TB) + q) * 1536 + lane * 8; GB[q] = *(const h16x8*)zrow; GC[q] = *(const h16x8*)(zrow + 512); XI[q] = *(const h16x8*)(zrow + 1024); } } while (0)
#define CV_COMP(GB, GC, XI, TB) do { _Pragma("unroll") for (int q = 0; q < 4; ++q) { const int t = (TB) + q; const h16x8 gb = GB[q], gc = GC[q], xi = XI[q]; \
                h16x8 o; \
                _Pragma("unroll") for (int j = 0; j < 8; ++j) { const float u0 = (float)gc[j] * (float)xi[j]; \
                    const float y = w0[j] * u2[j] + w1[j] * u1[j] + w2[j] * u0 + bb[j]; \
                    o[j] = (h16)((float)gb[j] * y); u2[j] = u1[j]; u1[j] = u0; } \
                *(h16x8*)(ca + (size_t)t * 512 + lane * 8) = o; } } while (0)
        h16x8 gbA[4], gcA[4], xiA[4], gbB[4], gcB[4], xiB[4];
        CV_LOAD(gbA, gcA, xiA, t0);
        for (int tb = t0; tb < t0 + 32; tb += 8) {
            CV_LOAD(gbB, gcB, xiB, tb + 4);
            CV_COMP(gbA, gcA, xiA, tb);
            if (tb + 8 < t0 + 32) CV_LOAD(gbA, gcA, xiA, tb + 8);
            CV_COMP(gbB, gcB, xiB, tb + 4);
        }
#undef CV_LOAD
#undef CV_COMP
    }
}


__device__ __forceinline__ float tanhf_(float x) { return 1.0f - 2.0f * __builtin_amdgcn_rcpf(1.0f + __expf(2.0f * x)); }
__device__ __forceinline__ void phase_rwkv_prep(const Args& a) {
    const int tid = tid_(), lane = tid & 63, wave = tid >> 6;
    const int gw = blockIdx.x * NWAVES + wave, NGW = gridDim.x * NWAVES;
    const h16* zr = (const h16*)(a.ws + O_ZR);
    h16* R = (h16*)a.out; h16* KS = R + (size_t)MTOK * 512; h16* V = KS + (size_t)MTOK * 512; h16* KK = V + (size_t)MTOK * 512;
    h16* APR = (h16*)(a.ws + O_APR);
    const float* mu = a.in[6]; const float* k_k = a.in[12];
    float mr[8], mk[8], mv[8], mt[8], kk8[8];
#pragma unroll
    for (int j = 0; j < 8; ++j) { const int c = lane * 8 + j; mr[j] = mu[c]; mk[j] = mu[512 + c]; mv[j] = mu[1024 + c]; mt[j] = mu[1536 + (c & 255)]; kk8[j] = k_k[c]; }
    for (int run = gw; run < MTOK / 32; run += NGW) {
        const int t0 = run * 32;
        float pr[8], pk[8], pv[8], pt[8];
        if ((t0 % SEQ) == 0) {
#pragma unroll
            for (int j = 0; j < 8; ++j) { pr[j] = 0.f; pk[j] = 0.f; pv[j] = 0.f; pt[j] = 0.f; }
        } else {
            const h16* zp = zr + (size_t)(t0 - 1) * 1792 + lane * 8;
            const h16x8 a0 = *(const h16x8*)zp, a1 = *(const h16x8*)(zp + 512), a2 = *(const h16x8*)(zp + 1024), a3 = *(const h16x8*)(zr + (size_t)(t0 - 1) * 1792 + 1536 + (lane & 31) * 8);
#pragma unroll
            for (int j = 0; j < 8; ++j) { pr[j] = (float)a0[j]; pk[j] = (float)a1[j]; pv[j] = (float)a2[j]; pt[j] = (float)a3[j]; }
        }
#define RP_LOAD(A0, A1, A2, A3, TB) do { _Pragma("unroll") for (int q = 0; q < 2; ++q) { const h16* zp = zr + (size_t)((TB) + q) * 1792 + lane * 8; \
                A0[q] = *(const h16x8*)zp; A1[q] = *(const h16x8*)(zp + 512); A2[q] = *(const h16x8*)(zp + 1024); A3[q] = *(const h16x8*)(zr + (size_t)((TB) + q) * 1792 + 1536 + (lane & 31) * 8); } } while (0)
#define RP_COMP(A0, A1, A2, A3, TB) do { _Pragma("unroll") for (int q = 0; q < 2; ++q) { const int t = (TB) + q; const h16x8 a0 = A0[q], a1 = A1[q], a2 = A2[q], a3 = A3[q]; \
            h16x8 orr, ok, ov, okk, ot; float kr[8]; float ss = 0.f; \
            _Pragma("unroll") for (int j = 0; j < 8; ++j) { \
                const float zr_ = (float)a0[j], zk_ = (float)a1[j], zv_ = (float)a2[j], zt_ = (float)a3[j]; \
                const float r = zr_ + mr[j] * (pr[j] - zr_), k = zk_ + mk[j] * (pk[j] - zk_), v = zv_ + mv[j] * (pv[j] - zv_), tl = zt_ + mt[j] * (pt[j] - zt_); \
                pr[j] = zr_; pk[j] = zk_; pv[j] = zv_; pt[j] = zt_; \
                orr[j] = (h16)r; ok[j] = (h16)k; ov[j] = (h16)v; \
                kr[j] = k * kk8[j]; ss += kr[j] * kr[j]; \
                  \
                const float rc = __builtin_amdgcn_rcpf(1.0f + __expf(tsc * tl)); \
                const float tv = (lane < 8) ? (1.0f - 2.0f * rc) : (lane < 16) ? tl : rc; \
                ot[j] = (h16)tv; \
            } \
            ss += dpp_<0xB1>(ss); ss += dpp_<0x4E>(ss); ss += xhm_(ss);     \
            const float rn = rsqrtf(ss + 1e-12f); \
            _Pragma("unroll") for (int j = 0; j < 8; ++j) okk[j] = (h16)(kr[j] * rn); \
            const size_t o = (size_t)t * 512 + lane * 8; \
            *(h16x8*)(R + o) = orr; *(h16x8*)(KS + o) = ok; *(h16x8*)(V + o) = ov; *(h16x8*)(KK + o) = okk; \
            if (lane < 32) *(h16x8*)(APR + (size_t)t * 256 + lane * 8) = ot; } } while (0)
        const float tsc = (lane < 8) ? 2.0f : -1.0f;
        h16x8 a0A[2], a1A[2], a2A[2], a3A[2], a0B[2], a1B[2], a2B[2], a3B[2];
        RP_LOAD(a0A, a1A, a2A, a3A, t0);
        for (int tb = t0; tb < t0 + 32; tb += 4) {
            RP_LOAD(a0B, a1B, a2B, a3B, tb + 2);
            RP_COMP(a0A, a1A, a2A, a3A, tb);
            if (tb + 4 < t0 + 32) RP_LOAD(a0A, a1A, a2A, a3A, tb + 4);
            RP_COMP(a0B, a1B, a2B, a3B, tb + 2);
        }
#undef RP_LOAD
#undef RP_COMP
    }
}

struct EpiLR {
    static constexpr bool TWO_PART = false;
    const float *w0, *a0, *k_a; h16 *WD, *KS, *BD, *GG; const h16* KK;
    __device__ __forceinline__ void operator()(AccRef acc, const Unit& u, int wr, int wc, int fr, int fq) const {
        const int part = u.pn >> 1;
        EPI_LOOP_BEGIN
            const int c = col - part * 512; const size_t o = (size_t)row * 512 + c;
            if (part == 0) {
                const f32x4 b0 = *(const f32x4*)(w0 + c), b1 = *(const f32x4*)(w0 + c + 4); f32x4 o0, o1;
#pragma unroll
                for (int j = 0; j < 4; ++j) { o0[j] = __expf(-0.6065306597126334f * sigmoidf_(b0[j] + v0[j])); o1[j] = __expf(-0.6065306597126334f * sigmoidf_(b1[j] + v1[j])); }
                *(h16x8*)(WD + o) = pack8(o0, o1);
            } else if (part == 1) {
                const f32x4 b0 = *(const f32x4*)(a0 + c), b1 = *(const f32x4*)(a0 + c + 4), ka0 = *(const f32x4*)(k_a + c), ka1 = *(const f32x4*)(k_a + c + 4);
                const h16x8 ks = *(const h16x8*)(KS + o), kk = *(const h16x8*)(KK + o); f32x4 k0, k1, bb0, bb1;
#pragma unroll
                for (int j = 0; j < 4; ++j) { const float aa0 = sigmoidf_(b0[j] + v0[j]), aa1 = sigmoidf_(b1[j] + v1[j]);
                    k0[j] = (float)ks[j] * (1.0f + (aa0 - 1.0f) * ka0[j]); k1[j] = (float)ks[4 + j] * (1.0f + (aa1 - 1.0f) * ka1[j]);
                    bb0[j] = aa0 * (float)kk[j]; bb1[j] = aa1 * (float)kk[4 + j]; }
                *(h16x8*)(KS + o) = pack8(k0, k1); *(h16x8*)(BD + o) = pack8(bb0, bb1);
            } else {
                *(h16x8*)(GG + o) = pack8(v0, v1);
            }
        EPI_LOOP_END
    }
};

constexpr size_t O_VTB = O_ZR;
constexpr size_t O_BON = O_ZR + 64 * MiB;
constexpr int UT_WAVE_LDS = 15360;
typedef float f32x16 __attribute__((ext_vector_type(16)));
__device__ __forceinline__ size_t ut_ov(int j, int s) { return (size_t)(j >> 2) * 512 + (j & 3) * 16 + s; }
constexpr int UT_SEG = 8, UT_SEGB = SEQ / 16 / UT_SEG;
__device__ __forceinline__ void phase_ut_pre(const Args& a, LAS unsigned char* lds, int seg, int gw, int NGW) {
    const int tid = tid_(), lane = tid & 63, wave = tid >> 6;
    LAS unsigned char* Lb = lds + wave * UT_WAVE_LDS;
    LAS h16* YX = (LAS h16*)Lb;
    LAS float* GT = (LAS float*)(Lb + 9216);
    LAS float* TM = (LAS float*)(Lb + 13824);
    h16* R = (h16*)a.out; h16* KS = R + (size_t)MTOK * 512; h16* V = KS + (size_t)MTOK * 512; h16* KK = V + (size_t)MTOK * 512;
    h16* WD = (h16*)(a.ws + O_WD); h16* BD = (h16*)(a.ws + O_BD);
    h16* VTB = (h16*)(a.ws + O_VTB); float* BON = (float*)(a.ws + O_BON);
    for (int wi = gw; wi < 32768 / UT_SEG; wi += NGW) {
        const int bh = ((((wi / (UT_SEGB * 8)) * (SEQ / 16)) + seg * UT_SEGB + ((wi % (UT_SEGB * 8)) >> 3)) << 3) | (wi & 7);
        int ln = lane; asm volatile("" : "+v"(ln)); const int r16 = ln & 15;
        const int h = bh & 7, nb = bh >> 3; const size_t tok0 = (size_t)nb * 16; const size_t e0 = tok0 * 512 + h * 64;
        const float rk = a.in[14][h * 64 + lane];
        {
            h16x8 stg[12];
#pragma unroll
            for (int j = 0; j < 12; ++j) { const int ar = j >> 1, row = (lane >> 3) + 8 * (j & 1);
                const h16* base = (ar == 0) ? WD : (ar == 1) ? KK : (ar == 2) ? BD : (ar == 3) ? KS : (ar == 4) ? R : V;
                stg[j] = *(const h16x8*)(base + e0 + (size_t)row * 512 + (lane & 7) * 8); }
#pragma unroll
            for (int j = 0; j < 12; ++j) *(LAS h16x8*)((LAS h16*)Lb + ((j >> 1) * 16 + (lane >> 3) + 8 * (j & 1)) * 64 + (lane & 7) * 8) = stg[j];
            asm volatile("s_waitcnt lgkmcnt(0)" ::: "memory");
        }
        float w[16], kk[16], bb[16], kx[16], rr[16]; h16x8 vt0, vt1;
        { const LAS h16* IN = (const LAS h16*)Lb;
#pragma unroll
        for (int t = 0; t < 16; ++t) { w[t] = (float)IN[t * 64 + lane]; kk[t] = (float)IN[(16 + t) * 64 + lane]; bb[t] = (float)IN[(32 + t) * 64 + lane]; kx[t] = (float)IN[(48 + t) * 64 + lane]; rr[t] = (float)IN[(64 + t) * 64 + lane];
            if (t < 8) vt0[t] = IN[(80 + t) * 64 + lane]; else vt1[t - 8] = IN[(80 + t) * 64 + lane]; } }
        asm volatile("s_waitcnt lgkmcnt(0)" ::: "memory");
        { h16* vp = VTB + (size_t)bh * 1024 + lane * 16; *(h16x8*)vp = vt0; *(h16x8*)(vp + 8) = vt1; }
        {
            float q8[8], q4[4], q2[2];
#pragma unroll
            for (int i = 0; i < 8; ++i) q8[i] = swap_add32(rr[i] * kx[i] * rk, rr[i + 8] * kx[i + 8] * rk);
#pragma unroll
            for (int i = 0; i < 4; ++i) q4[i] = swap_add16(q8[i], q8[i + 4]);
#pragma unroll
            for (int i = 0; i < 2; ++i) { const float keep = (ln & 8) ? q4[i + 2] : q4[i], send = (ln & 8) ? q4[i] : q4[i + 2]; q2[i] = keep + x8_(send); }
            const float keep = (ln & 4) ? q2[1] : q2[0], send = (ln & 4) ? q2[0] : q2[1];
            float bonv = keep + xhm_(send);
            bonv += dpp_<0xB1>(bonv); bonv += dpp_<0x4E>(bonv);
            if ((lane & 3) == 0) BON[(tok0 + (lane >> 2)) * 8 + h] = bonv;
        }
        float Lt[16]; { float Lc = 0.f;
#pragma unroll
            for (int t = 0; t < 16; ++t) { Lc += __logf(w[t]); Lt[t] = Lc; } }
        const float Lref = Lt[7];
        float btil[16]; h16x8 kt0, kt1;
        LAS h16* OS = (LAS h16*)(Lb + 9216);
#pragma unroll
        for (int t = 0; t < 16; ++t) {
            const float Lp = t ? Lt[t - 1] : 0.f;
            const float ka = kk[t] * __expf(Lp - Lref), rt = rr[t] * __expf(Lt[t] - Lref), e2 = __expf(Lref - Lt[t]), bt = bb[t] * e2, kt = kx[t] * e2;
            YX[t * 72 + lane] = (h16)ka; YX[(16 + t) * 72 + lane] = (h16)rt; YX[(32 + t) * 72 + lane] = (h16)kt; YX[(48 + t) * 72 + lane] = (h16)bt;
            btil[t] = bt;
            OS[t * 64 + lane] = (h16)(kk[t] * __expf(Lp)); OS[(16 + t) * 64 + lane] = (h16)(rr[t] * __expf(Lt[t]));
            const float ktp = kx[t] * __expf(Lt[15] - Lt[t]);
            if (t < 8) kt0[t] = (h16)ktp; else kt1[t - 8] = (h16)ktp;
        }
        const float post = __expf(Lt[15] - Lref), w16 = __expf(Lt[15]);
        { h16* kp = KS + e0 + ut_ov(lane, 0); *(h16x8*)kp = kt0; *(h16x8*)(kp + 8) = kt1; }
        asm volatile("s_waitcnt lgkmcnt(0)" ::: "memory");
#pragma unroll
        for (int j = 0; j < 4; ++j) { const int row = (lane >> 3) + 8 * (j & 1); const h16x8 o8 = *(const LAS h16x8*)(OS + ((j >> 1) * 16 + row) * 64 + (lane & 7) * 8);
            *(h16x8*)(((j >> 1) ? R : KK) + e0 + (size_t)row * 512 + (lane & 7) * 8) = o8; }
        asm volatile("s_waitcnt lgkmcnt(0)" ::: "memory");
        f32x16 acc;
#pragma unroll
        for (int i = 0; i < 16; ++i) acc[i] = 0.f;
#pragma unroll
        for (int ks = 0; ks < 4; ++ks) {
            const h16x8 af = *(const LAS h16x8*)(YX + (lane & 31) * 72 + 8 * (lane >> 5) + 16 * ks), bf = *(const LAS h16x8*)(YX + (32 + (lane & 31)) * 72 + 8 * (lane >> 5) + 16 * ks);
            acc = __builtin_amdgcn_mfma_f32_32x32x16_f16(af, bf, acc, 0, 0, 0);
        }
#pragma unroll
        for (int i = 0; i < 16; ++i) GT[((i & 3) + 8 * (i >> 2) + 4 * (lane >> 5)) * 36 + (lane & 31)] = acc[i];
        asm volatile("s_waitcnt lgkmcnt(0)" ::: "memory");
        float T[16];
#pragma unroll
        for (int t = 0; t < 16; ++t) { float v = (r16 == t) ? 1.f : 0.f;
#pragma unroll
            for (int s2 = 0; s2 < t; ++s2) v -= T[s2] * GT[t * 36 + 16 + s2];
            T[t] = v; }
#pragma unroll
        for (int t = 0; t < 16; ++t) TM[r16 * 20 + t] = T[t];
        asm volatile("s_waitcnt lgkmcnt(0)" ::: "memory");
        float bcol[16];
#pragma unroll
        for (int s2 = 0; s2 < 16; ++s2) bcol[s2] = (s2 <= r16) ? GT[(16 + r16) * 36 + 16 + s2] : 0.f;
        h16x8 tb0, tb1, tp0, tp1;
#pragma unroll
        for (int r = 0; r < 16; ++r) { float s0 = 0.f, s1 = 0.f;
#pragma unroll
            for (int s2 = r; s2 < 16; ++s2) { const float tv = TM[r * 20 + s2]; s0 += tv * btil[s2]; s1 += tv * bcol[s2]; }
            s0 *= post;
            if (r < 8) { tb0[r] = (h16)s0; tp0[r] = (h16)s1; } else { tb1[r - 8] = (h16)s0; tp1[r - 8] = (h16)s1; } }
        { h16* bp = BD + e0 + ut_ov(lane, 0); *(h16x8*)bp = tb0; *(h16x8*)(bp + 8) = tb1; }
        if (lane < 16) {
            h16x8 a0, a1, p0, p1;
#pragma unroll
            for (int s2 = 0; s2 < 16; ++s2) { const float av = (s2 < ln) ? GT[ln * 36 + s2] : 0.f, pv = (s2 <= ln) ? GT[(16 + ln) * 36 + s2] : 0.f;
                if (s2 < 8) { a0[s2] = (h16)av; p0[s2] = (h16)pv; } else { a1[s2 - 8] = (h16)av; p1[s2 - 8] = (h16)pv; } }
            h16* ap = WD + e0 + (size_t)(lane >> 2) * 512 + (lane & 3) * 16;
            *(h16x8*)ap = a0; *(h16x8*)(ap + 8) = a1;
            *(h16x8*)(ap + 4 * 512) = p0; *(h16x8*)(ap + 4 * 512 + 8) = p1;
            *(h16x8*)(ap + 8 * 512) = tp0; *(h16x8*)(ap + 8 * 512 + 8) = tp1;
        }
        (WD + e0 + (size_t)12 * 512)[lane] = (h16)w16;
        asm volatile("s_waitcnt lgkmcnt(0)" ::: "memory");
    }
}
struct UtOps { u32x2 ka[2][2], rt[2][2], kt[4], tb[4], at, apt, tp, vb, w16[4]; };
struct UtRes { __amdgpu_buffer_rsrc_t kk, r, ks, bd, wd, vt, y; };
__device__ __forceinline__ void ut_load(UtOps& o, const UtRes& R, int so, unsigned offK, unsigned offT, unsigned offV, unsigned offF) {
#pragma unroll
    for (int ks = 0; ks < 2; ++ks)
#pragma unroll
        for (int p = 0; p < 2; ++p) { o.ka[ks][p] = __builtin_amdgcn_raw_buffer_load_b64(R.kk, offK + 64u * ks + 32u * p, so, 0); o.rt[ks][p] = __builtin_amdgcn_raw_buffer_load_b64(R.r, offK + 64u * ks + 32u * p, so, 0); }
#pragma unroll
    for (int kt = 0; kt < 4; ++kt) { o.kt[kt] = __builtin_amdgcn_raw_buffer_load_b64(R.ks, offT + 4096u * kt, so, 0); o.tb[kt] = __builtin_amdgcn_raw_buffer_load_b64(R.bd, offT + 4096u * kt, so, 0); }
    o.at = __builtin_amdgcn_raw_buffer_load_b64(R.wd, offT, so, 0); o.apt = __builtin_amdgcn_raw_buffer_load_b64(R.wd, offT + 4096u, so, 0); o.tp = __builtin_amdgcn_raw_buffer_load_b64(R.wd, offT + 8192u, so, 0);
    o.vb = __builtin_amdgcn_raw_buffer_load_b64(R.vt, offV, so, 0);
#pragma unroll
    for (int kt = 0; kt < 4; ++kt) o.w16[kt] = __builtin_amdgcn_raw_buffer_load_b64(R.wd, offF + 12u * 1024u + 32u * kt, so, 0);
}
__device__ __forceinline__ f32x4 h4f(u32x2 v) { const h16x4 h = __builtin_bit_cast(h16x4, v); return (f32x4){(float)h[0], (float)h[1], (float)h[2], (float)h[3]}; }
__device__ __forceinline__ h16x8 cat8(u32x2 lo, u32x2 hi) { u32x4 r; r[0] = lo[0]; r[1] = lo[1]; r[2] = hi[0]; r[3] = hi[1]; return __builtin_bit_cast(h16x8, r); }
__device__ __forceinline__ void ut_block(const UtOps& o, f32x4 (&S)[4], const UtRes& R, unsigned offY, int so) {
    const f32x4 zf = (f32x4){0.f, 0.f, 0.f, 0.f}; const u32x2 zu = (u32x2){0u, 0u};
    const h16x8 sb0 = pack8(S[0], S[1]), sb1 = pack8(S[2], S[3]);
    const h16x8 vb = cat8(o.vb, zu);
    f32x4 x1 = zf, y = zf;
    x1 = __builtin_amdgcn_mfma_f32_16x16x32_f16(cat8(o.ka[0][0], o.ka[0][1]), sb0, x1, 0, 0, 0); y = __builtin_amdgcn_mfma_f32_16x16x32_f16(cat8(o.rt[0][0], o.rt[0][1]), sb0, y, 0, 0, 0);
    x1 = __builtin_amdgcn_mfma_f32_16x16x32_f16(cat8(o.ka[1][0], o.ka[1][1]), sb1, x1, 0, 0, 0); y = __builtin_amdgcn_mfma_f32_16x16x32_f16(cat8(o.rt[1][0], o.rt[1][1]), sb1, y, 0, 0, 0);
    x1 = __builtin_amdgcn_mfma_f32_16x16x32_f16(cat8(o.at, zu), vb, x1, 0, 0, 0); y = __builtin_amdgcn_mfma_f32_16x16x32_f16(cat8(o.apt, zu), vb, y, 0, 0, 0);
    f32x4 St[4];
#pragma unroll
    for (int kt = 0; kt < 4; ++kt) St[kt] = __builtin_amdgcn_mfma_f32_16x16x32_f16(cat8(o.kt[kt], zu), vb, S[kt] * h4f(o.w16[kt]), 0, 0, 0);
    const h16x8 xb = pack8(-x1, zf);
    y = __builtin_amdgcn_mfma_f32_16x16x32_f16(cat8(o.tp, zu), xb, y, 0, 0, 0);
#pragma unroll
    for (int kt = 0; kt < 4; ++kt) S[kt] = __builtin_amdgcn_mfma_f32_16x16x32_f16(cat8(o.tb[kt], zu), xb, St[kt], 0, 0, 0);
#pragma unroll
    for (int rg = 0; rg < 4; ++rg) { const h16 hv = (h16)y[rg]; __builtin_amdgcn_raw_buffer_store_b16(__builtin_bit_cast(unsigned short, hv), R.y, offY + 1024u * rg, so, 0); }
}
constexpr int UT_RING = 4;
static_assert(UT_SEGB % 4 == 0, "the loader rotates four operand sets");
__device__ __forceinline__ LAS unsigned char* ut_slot(LAS unsigned char* lds, unsigned s) { return lds + (s < 2u ? 64u + s * 12288u : 131072u + 128u + (s - 2u) * 12288u); }
#define UT_FIELDS(F) F(0, ka[0][0]) F(1, ka[0][1]) F(2, ka[1][0]) F(3, ka[1][1]) F(4, rt[0][0]) F(5, rt[0][1]) F(6, rt[1][0]) F(7, rt[1][1]) F(8, kt[0]) F(9, kt[1]) F(10, kt[2]) F(11, kt[3]) \
    F(12, tb[0]) F(13, tb[1]) F(14, tb[2]) F(15, tb[3]) F(16, at) F(17, apt) F(18, tp) F(19, vb) F(20, w16[0]) F(21, w16[1]) F(22, w16[2]) F(23, w16[3])
__device__ __forceinline__ void ut_put(const UtOps& o, LAS unsigned char* sl, int lane) {
    LAS u32x2* p = (LAS u32x2*)(sl + lane * 8);
#define UT_F(i, f) p[(i) * 64] = o.f;
    UT_FIELDS(UT_F)
#undef UT_F
}
__device__ __forceinline__ void ut_get(UtOps& o, const LAS unsigned char* sl, int lane) {
    const LAS u32x2* p = (const LAS u32x2*)(sl + lane * 8);
#define UT_F(i, f) o.f = p[(i) * 64];
    UT_FIELDS(UT_F)
#undef UT_F
}
__device__ __forceinline__ void phase_ut_seq(const Args& a, LAS unsigned char* lds, int seg) {
    const int tid = tid_(), lane = tid & 63, wave = tid >> 6, fr = lane & 15, fq = lane >> 4;
    if (wave > 1) return;
    volatile LAS unsigned* prodp = (volatile LAS unsigned*)(lds + 131072 + 32);
    volatile LAS unsigned* consp = (volatile LAS unsigned*)(lds + 131072 + 48);
    unsigned base = wave ? *prodp : *consp;
    const int nb0 = seg * UT_SEGB;
    for (int item = blockIdx.x; item < 256; item += gridDim.x, base += UT_SEGB) {
        const int h = item & 7, q = item >> 3, g = q & 3, b = q >> 2;
        const size_t e0 = ((size_t)b * SEQ * 512 + h * 64) * 2 + (size_t)nb0 * 16384;
        const char* Rb = (const char*)a.out + e0; const char* KSb = Rb + (size_t)MTOK * 1024; const char* KKb = Rb + (size_t)3 * MTOK * 1024;
        const char* WDb = (const char*)(a.ws + O_WD) + e0; const char* BDb = (const char*)(a.ws + O_BD) + e0;
        const char* VTb = (const char*)(a.ws + O_VTB) + ((size_t)b * (SEQ / 16) * 8 + h) * 2048 + (size_t)nb0 * 16384;
        const unsigned offK = (unsigned)(fr * 1024 + 8 * fq), offT = (unsigned)((fr >> 2) * 512 + (fr & 3) * 16 + 4 * fq) * 2u, offV = (unsigned)((16 * g + fr) * 16 + 4 * fq) * 2u, offF = (unsigned)fq * 8u,
                       offY = (unsigned)((4 * fq) * 512 + 16 * g + fr) * 2u;
        UtRes RS; RS.kk = mkrsrc(KKb); RS.r = mkrsrc(Rb); RS.ks = mkrsrc(KSb); RS.bd = mkrsrc(BDb); RS.wd = mkrsrc(WDb); RS.vt = mkrsrc(VTb);
        RS.y = mkrsrc((const char*)(a.ws + O_Y) + e0);
#define UT_LD(o, nn) ut_load(o, RS, ((nn) < UT_SEGB ? (nn) : UT_SEGB - 1) * 16384, offK, offT, offV, offF)
        if (wave == 1) {
#define UT_PUT(o, nn) do { const unsigned gc = base + (unsigned)(nn); int guard = 0; \
                while ((int)(gc - *consp) >= UT_RING && ++guard < (1 << 24)) __builtin_amdgcn_s_sleep(1); \
                asm volatile("" ::: "memory"); ut_put(o, ut_slot(lds, gc % UT_RING), lane); \
                asm volatile("s_waitcnt lgkmcnt(0)" ::: "memory"); if (lane == 0) *prodp = gc + 1u; } while (0)
            UtOps l0, l1, l2, l3;
            UT_LD(l0, 0); UT_LD(l1, 1); UT_LD(l2, 2); UT_LD(l3, 3);
#pragma unroll 1
            for (int n = 0; n < UT_SEGB; n += 4) {
                UT_PUT(l0, n);     UT_LD(l0, n + 4);
                UT_PUT(l1, n + 1); UT_LD(l1, n + 5);
                UT_PUT(l2, n + 2); UT_LD(l2, n + 6);
                UT_PUT(l3, n + 3); UT_LD(l3, n + 7);
            }
#undef UT_PUT
            continue;
        }
        f32x4* sst = (f32x4*)(a.ws + O_SST2) + ((size_t)item * 64 + lane) * 4;
        f32x4 S[4];
#pragma unroll
        for (int kt = 0; kt < 4; ++kt) S[kt] = seg ? sst[kt] : (f32x4){0.f, 0.f, 0.f, 0.f};
#define UT_GET(o, nn) do { const unsigned gc = base + (unsigned)(nn); int guard = 0; \
            while ((int)(*prodp - gc) < 1 && ++guard < (1 << 24)) __builtin_amdgcn_s_sleep(0); \
            asm volatile("" ::: "memory"); ut_get(o, ut_slot(lds, gc % UT_RING), lane); } while (0)
#define UT_DONE(nn) do { asm volatile("s_waitcnt lgkmcnt(0)" ::: "memory"); if (lane == 0) *consp = base + (unsigned)(nn) + 1u; } while (0)
        UtOps oa, ob;
        UT_GET(oa, 0);
#pragma unroll 1
        for (int n = 0; n < UT_SEGB; n += 2) {
            UT_DONE(n);     UT_GET(ob, n + 1);                          ut_block(oa, S, RS, offY, n * 16384);
            UT_DONE(n + 1); if (n + 2 < UT_SEGB) UT_GET(oa, n + 2);     ut_block(ob, S, RS, offY, (n + 1) * 16384);
        }
#undef UT_GET
#undef UT_DONE
#undef UT_LD
#pragma unroll
        for (int kt = 0; kt < 4; ++kt) sst[kt] = S[kt];
    }
}
constexpr int POST_EARLY = 2;
__device__ __forceinline__ void phase_rwkv_post(const Args& a, int s0, int s1, int gw, int NGW);
__device__ __forceinline__ void phase_ut_step(const Args& a, LAS unsigned char* lds, int st) {
    const int wave = tid_() >> 6;
    if (st >= 1 && wave <= 1) { phase_ut_seq(a, lds, st - 1); return; }
    if (st < UT_SEG) { if (st == 0) phase_ut_pre(a, lds, st, blockIdx.x * NWAVES + wave, gridDim.x * NWAVES); else phase_ut_pre(a, lds, st, blockIdx.x * 6 + (wave - 2), gridDim.x * 6); }
    else phase_rwkv_post(a, 0, POST_EARLY, blockIdx.x * 6 + (wave - 2), gridDim.x * 6);
}

__device__ __forceinline__ void phase_rwkv_post(const Args& a, int s0, int s1, int gw, int NGW) {
    const int lane = tid_() & 63;
    const int per = (s1 - s0) * (SEQ / UT_SEG), NT = (MTOK / SEQ) * per;
    const h16* V = (const h16*)a.out + (size_t)2 * MTOK * 512;
    const h16* GG = (const h16*)(a.ws + O_GG); const h16* Y = (const h16*)(a.ws + O_Y); h16* YB = (h16*)(a.ws + O_YB); const float* BON = (const float*)(a.ws + O_BON);
    float lg[8], lb[8];
#pragma unroll
    for (int j = 0; j < 8; ++j) { const int c = lane * 8 + j; lg[j] = a.in[15][c]; lb[j] = a.in[16][c]; }
#define PO_LOAD(Y8, V8, G8, BS, TV, TQ) do { _Pragma("unroll") for (int q = 0; q < 4; ++q) { const int n = (TQ) + q * NGW; if (n < NT) { const int bq = n / per, t = bq * SEQ + s0 * (SEQ / UT_SEG) + (n - bq * per); TV[q] = t; \
            const size_t o = (size_t)t * 512 + lane * 8; Y8[q] = *(const h16x8*)(Y + o); V8[q] = *(const h16x8*)(V + o); G8[q] = *(const h16x8*)(GG + o); BS[q] = BON[(size_t)t * 8 + (lane >> 3)]; } } } while (0)
#define PO_COMP(Y8, V8, G8, BS, TV, TQ) do { _Pragma("unroll") for (int q = 0; q < 4; ++q) { const int n = (TQ) + q * NGW; if (n < NT) { const int t = TV[q]; const size_t o = (size_t)t * 512 + lane * 8; \
            const h16x8 y8 = Y8[q], v8 = V8[q], g8 = G8[q]; const float bs = BS[q]; \
            float y[8]; float sm = 0.f; \
            _Pragma("unroll") for (int j = 0; j < 8; ++j) { y[j] = (float)y8[j]; sm += y[j]; } \
            sm += dpp_<0xB1>(sm); sm += dpp_<0x4E>(sm); sm += dpp_<0x141>(sm); \
            const float mean = sm * (1.f / 64.f); float vs = 0.f; \
            _Pragma("unroll") for (int j = 0; j < 8; ++j) { y[j] -= mean; vs += y[j] * y[j]; } \
            vs += dpp_<0xB1>(vs); vs += dpp_<0x4E>(vs); vs += dpp_<0x141>(vs); \
            const float rstd = rsqrtf(vs * (1.f / 64.f) + 64e-5f); \
            h16x8 ov; \
            _Pragma("unroll") for (int j = 0; j < 8; ++j) ov[j] = (h16)((y[j] * rstd * lg[j] + lb[j] + bs * (float)v8[j]) * (float)g8[j]); \
            *(h16x8*)(YB + o) = ov; } } } while (0)
    h16x8 yA[4], vA[4], gA[4], yB[4], vB[4], gB[4]; float bA[4], bB[4]; int tA[4], tB[4];
    const int step = 4 * NGW;
    PO_LOAD(yA, vA, gA, bA, tA, gw);
    for (int tq = gw; tq < NT; tq += 2 * step) {
        PO_LOAD(yB, vB, gB, bB, tB, tq + step);
        PO_COMP(yA, vA, gA, bA, tA, tq);
        PO_LOAD(yA, vA, gA, bA, tA, tq + 2 * step);
        PO_COMP(yB, vB, gB, bB, tB, tq + step);
    }
#undef PO_LOAD
#undef PO_COMP
}

__device__ __forceinline__ void ins16(unsigned (&L)[16], unsigned x) {
#pragma unroll
    for (int j = 0; j < 16; ++j) { const unsigned hi = L[j] > x ? L[j] : x; x = L[j] > x ? x : L[j]; L[j] = hi; }
}
#define TK_CE(a, b) do { const unsigned hi_ = (a) > (b) ? (a) : (b); (b) = (a) > (b) ? (b) : (a); (a) = hi_; } while (0)
__device__ __forceinline__ void sort16_desc(unsigned (&v)[16]) {
#pragma unroll
    for (int p = 1; p < 16; p <<= 1)
#pragma unroll
        for (int k = p; k >= 1; k >>= 1)
#pragma unroll
            for (int j = k % p; j + k < 16; j += 2 * k)
#pragma unroll
                for (int i = 0; i < k; ++i) if (i + j + k < 16 && (i + j) / (2 * p) == (i + j + k) / (2 * p)) TK_CE(v[i + j], v[i + j + k]);
}
__device__ __forceinline__ void merge_top16(unsigned (&t)[16], const unsigned (&g)[16]) {
#pragma unroll
    for (int i = 0; i < 16; ++i) t[i] = t[i] > g[15 - i] ? t[i] : g[15 - i];
#pragma unroll
    for (int j = 8; j > 0; j >>= 1)
#pragma unroll
        for (int i = 0; i < 16; ++i) { const int l = i ^ j; if (l > i) TK_CE(t[i], t[l]); }
}
__device__ __forceinline__ unsigned ord32(float f) { const unsigned u = __float_as_uint(f); return (u & 0x80000000u) ? ~u : (u | 0x80000000u); }
__device__ __forceinline__ float unord32(unsigned k) { return __uint_as_float((k & 0x80000000u) ? (k & 0x7fffffffu) : ~k); }
__device__ __forceinline__ void phase_topk(const Args& a, LAS unsigned char* lds) {
    const int tid = tid_();
    const h16* SC = (const h16*)(a.ws + O_SCORES);
    const float* part = (const float*)(a.ws + O_PART1);
    unsigned short* IDX = (unsigned short*)(a.ws + O_IDX); h16* GATE = (h16*)(a.ws + O_GATE); float* RS1 = (float*)(a.ws + O_RS1);
    LAS unsigned char* LI = lds;
    for (int task = blockIdx.x * NTHREADS + tid; task < MTOK * 8; task += gridDim.x * NTHREADS) {
        const int t = task >> 3, h = task & 7;
        float ssq = 0.f;
#pragma unroll
        for (int j = 0; j < 4; ++j) { const f32x4 p4 = *(const f32x4*)(part + (size_t)t * 16 + 4 * j); ssq += (p4[0] + p4[1]) + (p4[2] + p4[3]); }
        const float rs = rsqrtf(ssq * (1.f / 1024.f) + NORM_EPS);
        if (h == 0) RS1[t] = rs;
        float sv[2][16];
#pragma unroll
        for (int c = 0; c < 2; ++c) {
            unsigned L[16];
#pragma unroll
            for (int j = 0; j < 16; ++j) L[j] = 0u;
            const h16* row = SC + (size_t)t * 2048 + h * 256 + c * 128;
#pragma unroll 1
            for (int ln = 0; ln < 2; ++ln) {
                u32x4 raw[8];
#pragma unroll
                for (int k = 0; k < 8; ++k) raw[k] = *(const u32x4*)(row + ln * 64 + k * 8);
#pragma unroll
                for (int g4 = 0; g4 < 4; ++g4) {
                    unsigned Gk[16];
#pragma unroll
                    for (int hh = 0; hh < 2; ++hh) { const u32x4 w4 = raw[2 * g4 + hh];
#pragma unroll
                        for (int d = 0; d < 4; ++d) {
                            const unsigned w = w4[d];
                            const unsigned sf = __builtin_bit_cast(unsigned, __builtin_bit_cast(s16x2, w) >> 15);
                            const unsigned o = w ^ (sf | 0x80008000u);
                            const int p0 = ln * 64 + g4 * 16 + hh * 8 + 2 * d;
                            Gk[hh * 8 + 2 * d] = (o << 16) | (unsigned)(127 - p0); Gk[hh * 8 + 2 * d + 1] = (o & 0xffff0000u) | (unsigned)(126 - p0); } }
                    sort16_desc(Gk);
                    merge_top16(L, Gk);
                }
            }
#pragma unroll
            for (int j = 0; j < 16; ++j) {
                const unsigned o16 = L[j] >> 16; const unsigned bits = (o16 & 0x8000u) ? (o16 & 0x7fffu) : (~o16 & 0xffffu);
                union { unsigned short u; h16 f; } cv; cv.u = (unsigned short)bits; sv[c][j] = (float)cv.f;
                LI[(c * 16 + j) * 512 + tid] = (unsigned char)(127u - (L[j] & 127u));
            }
        }
        unsigned L[16], G1[16], G2[16], X0 = 0u, X1 = 0u;
        { int cnt = 0;
#pragma unroll
          for (int i = 0; i < 16; ++i)
#pragma unroll
            for (int j = 0; j < 16; ++j) if ((i + 1) * (j + 1) <= 16) {
                const unsigned key = (ord32(sv[0][i] + sv[1][j]) & ~255u) | (unsigned)(255 - (i * 16 + j));
                if (cnt < 16) L[cnt] = key; else if (cnt < 32) G1[cnt - 16] = key; else if (cnt < 48) G2[cnt - 32] = key; else if (cnt == 48) X0 = key; else X1 = key;
                ++cnt; } }
        sort16_desc(L); sort16_desc(G1); sort16_desc(G2); merge_top16(L, G1); merge_top16(L, G2);
        { TK_CE(X0, X1); unsigned G3[16];
#pragma unroll
          for (int j = 0; j < 16; ++j) G3[j] = 0u;
          G3[0] = X0; G3[1] = X1; merge_top16(L, G3); }
        float e[16]; float den = 0.f; const float mx = unord32(L[0] & ~255u) * rs;
        unsigned short id[16];
#pragma unroll
        for (int k = 0; k < 16; ++k) {
            const float v = unord32(L[k] & ~255u) * rs; e[k] = __expf(v - mx); den += e[k];
            const unsigned pos = 255u - (L[k] & 255u); const unsigned i = pos >> 4, j = pos & 15u;
            id[k] = (unsigned short)((unsigned)LI[i * 512 + tid] * 128u + (unsigned)LI[(16 + j) * 512 + tid]);
        }
        const float inv = __builtin_amdgcn_rcpf(den);
        u32x4 i0, i1;
        i0[0] = id[0] | (id[1] << 16); i0[1] = id[2] | (id[3] << 16); i0[2] = id[4] | (id[5] << 16); i0[3] = id[6] | (id[7] << 16);
        i1[0] = id[8] | (id[9] << 16); i1[1] = id[10] | (id[11] << 16); i1[2] = id[12] | (id[13] << 16); i1[3] = id[14] | (id[15] << 16);
        u32x4* ip = (u32x4*)(IDX + (size_t)task * 16); ip[0] = i0; ip[1] = i1;
        h16x8* gp = (h16x8*)(GATE + (size_t)task * 16);
#pragma unroll
        for (int k8 = 0; k8 < 2; ++k8) gp[k8] = pack8((f32x4){e[8 * k8] * inv, e[8 * k8 + 1] * inv, e[8 * k8 + 2] * inv, e[8 * k8 + 3] * inv}, (f32x4){e[8 * k8 + 4] * inv, e[8 * k8 + 5] * inv, e[8 * k8 + 6] * inv, e[8 * k8 + 7] * inv});
    }
}

__device__ __forceinline__ float gelu_tanh(float x) { const float u = 0.7978845608028654f * (x + 0.044715f * x * x * x); return 0.5f * x * (1.0f + tanhf_(u)); }
__device__ __forceinline__ unsigned xcc_id() { return (unsigned)__builtin_amdgcn_s_getreg((3 << 11) | 20) & 7u; }
constexpr bool GA_C16 = false;
constexpr int GA_TC = 8, GA_NCH = MTOK / GA_TC;
__device__ __forceinline__ void dec16(const u32x4 q, float (&o)[16]) {
#pragma unroll
    for (int w = 0; w < 4; ++w) { const f32x2 lo = __builtin_amdgcn_cvt_pk_f32_fp8((int)q[w], false), hi = __builtin_amdgcn_cvt_pk_f32_fp8((int)q[w], true);
        o[4 * w] = lo[0]; o[4 * w + 1] = lo[1]; o[4 * w + 2] = hi[0]; o[4 * w + 3] = hi[1]; }
}
__device__ __forceinline__ void dec16p(const u32x4 q, f32x2 (&o)[8]) {
#pragma unroll
    for (int w = 0; w < 4; ++w) { o[2 * w] = __builtin_amdgcn_cvt_pk_f32_fp8((int)q[w], false); o[2 * w + 1] = __builtin_amdgcn_cvt_pk_f32_fp8((int)q[w], true); }
}
struct GIdx { u32x4 a, b; };
__device__ __forceinline__ GIdx g_ldidx(__amdgpu_buffer_rsrc_t IDX, int t, int r8) { GIdx r; r.a = __builtin_amdgcn_raw_buffer_load_b128(IDX, 32 * r8, t * 256, 0); r.b = __builtin_amdgcn_raw_buffer_load_b128(IDX, 32 * r8 + 16, t * 256, 0); return r; }
__device__ __forceinline__ void g_quant(u32x4 xa_, u32x4 xb_, u32x4& xq, float& xs) {
    const h16x8 xa = __builtin_bit_cast(h16x8, xa_), xb = __builtin_bit_cast(h16x8, xb_);
    float x[16]; float mx = 0.f;
#pragma unroll
    for (int k = 0; k < 8; ++k) { x[k] = (float)xa[k]; x[8 + k] = (float)xb[k]; mx = fmaxf(mx, fmaxf(fabsf(x[k]), fabsf(x[8 + k]))); }
    mx = fmaxf(mx, dpp_<0xB1>(mx)); mx = fmaxf(mx, dpp_<0x4E>(mx)); mx = fmaxf(mx, dpp_<0x141>(mx));
    mx = fmaxf(mx, 1e-20f);
    const float inv = 127.0f * __builtin_amdgcn_rcpf(mx); xs = mx * (1.0f / 127.0f);
#pragma unroll
    for (int w = 0; w < 4; ++w) { const int i0 = __float2int_rn(x[4 * w] * inv), i1 = __float2int_rn(x[4 * w + 1] * inv), i2 = __float2int_rn(x[4 * w + 2] * inv), i3 = __float2int_rn(x[4 * w + 3] * inv);
        xq[w] = (unsigned)(i0 & 0xff) | ((unsigned)(i1 & 0xff) << 8) | ((unsigned)(i2 & 0xff) << 16) | ((unsigned)i3 << 24); }
}
__device__ __forceinline__ void g_issue8(const unsigned char* TBs, unsigned lo, const u32x4 ix, u32x4 (&q)[8]) {
#pragma unroll
    for (int i = 0; i < 8; ++i) { const unsigned w = ix[i >> 1]; const unsigned e = (i & 1) ? (w >> 16) : (w & 0xffffu); q[i] = *(const u32x4*)(TBs + (e * 128u + lo)); }
}
struct GSide { u32x4 a, b, c, d; };
template <int PH> __device__ __forceinline__ GSide g_ldside(__amdgpu_buffer_rsrc_t SD, __amdgpu_buffer_rsrc_t HR, int t, int j, int m, int r8) {
    GSide r;
    if (PH == 0) { r.a = __builtin_amdgcn_raw_buffer_load_b128(SD, 32 * m, t * 2048 + 256 * j, 0); r.b = __builtin_amdgcn_raw_buffer_load_b128(SD, 32 * m + 16, t * 2048 + 256 * j, 0); r.c = r.a; r.d = r.b; }
    else { r.a = __builtin_amdgcn_raw_buffer_load_b128(SD, 32 * r8, t * 256, 0); r.b = GA_C16 ? __builtin_amdgcn_raw_buffer_load_b128(SD, 32 * r8 + 16, t * 256, 0) : (u32x4){0u, 0u, 0u, 0u};
           r.c = (u32x4){__builtin_amdgcn_raw_buffer_load_b32(SD, 4 * r8, (int)(O_COEFS - O_COEF) + t * 32, 0), 0u, 0u, 0u}; r.d = r.c;
           r.d[0] = __builtin_amdgcn_raw_buffer_load_b32(HR, (128 * j + 16 * m + 2 * r8) * 2, t * 2048, 0); }
    return r;
}
template <int PH, int HALF> __device__ __forceinline__ void g_half(u32x4 (&q)[8], const GSide& sd, float (&pa)[16], int (&ah)[16], int (&al)[16]) {
    if (PH == 0) {
#pragma unroll
        for (int i = 0; i < 8; ++i) { int acc = 0;
#pragma unroll
            for (int w = 0; w < 4; ++w) acc = __builtin_amdgcn_sdot4((int)q[i][w], (int)sd.a[w], acc, false);
            pa[8 * HALF + i] = (float)acc; }
    } else {
#pragma unroll
        for (int g = 0; g < 2; ++g) {
            const int ch = (int)sd.a[2 * HALF + g], cl = (int)sd.b[2 * HALF + g];
#pragma unroll
            for (int w = 0; w < 4; ++w) {
                const unsigned a0 = q[4 * g][w], a1 = q[4 * g + 1][w], a2 = q[4 * g + 2][w], a3 = q[4 * g + 3][w];
                const unsigned t01l = __builtin_amdgcn_perm(a1, a0, 0x05010400u), t01h = __builtin_amdgcn_perm(a1, a0, 0x07030602u);
                const unsigned t23l = __builtin_amdgcn_perm(a3, a2, 0x05010400u), t23h = __builtin_amdgcn_perm(a3, a2, 0x07030602u);
                const unsigned o0 = __builtin_amdgcn_perm(t23l, t01l, 0x05040100u), o1 = __builtin_amdgcn_perm(t23l, t01l, 0x07060302u);
                const unsigned o2 = __builtin_amdgcn_perm(t23h, t01h, 0x05040100u), o3 = __builtin_amdgcn_perm(t23h, t01h, 0x07060302u);
                ah[4 * w] = __builtin_amdgcn_sdot4((int)o0, ch, ah[4 * w], false);         if (GA_C16) al[4 * w] = __builtin_amdgcn_sdot4((int)o0, cl, al[4 * w], false);
                ah[4 * w + 1] = __builtin_amdgcn_sdot4((int)o1, ch, ah[4 * w + 1], false); if (GA_C16) al[4 * w + 1] = __builtin_amdgcn_sdot4((int)o1, cl, al[4 * w + 1], false);
                ah[4 * w + 2] = __builtin_amdgcn_sdot4((int)o2, ch, ah[4 * w + 2], false); if (GA_C16) al[4 * w + 2] = __builtin_amdgcn_sdot4((int)o2, cl, al[4 * w + 2], false);
                ah[4 * w + 3] = __builtin_amdgcn_sdot4((int)o3, ch, ah[4 * w + 3], false); if (GA_C16) al[4 * w + 3] = __builtin_amdgcn_sdot4((int)o3, cl, al[4 * w + 3], false);
            }
        }
    }
}
template <int PH> __device__ __forceinline__ void g_finish(const Args& a, __amdgpu_buffer_rsrc_t PRT, int t, int j, int lane, float (&p)[16], float xs, unsigned hpre) {
    const int m = lane & 7, r8 = lane >> 3;
    float q8[8], q4[4], q2[2];
    if (PH == 0) {
#pragma unroll
        for (int i = 0; i < 8; ++i) { const float keep = (lane & 4) ? p[i + 8] : p[i], send = (lane & 4) ? p[i] : p[i + 8]; q8[i] = keep + xhm_(send); }
#pragma unroll
        for (int i = 0; i < 4; ++i) { const float keep = (lane & 2) ? q8[i + 4] : q8[i], send = (lane & 2) ? q8[i] : q8[i + 4]; q4[i] = keep + dpp_<0x4E>(send); }
#pragma unroll
        for (int i = 0; i < 2; ++i) { const float keep = (lane & 1) ? q4[i + 2] : q4[i], send = (lane & 1) ? q4[i] : q4[i + 2]; q2[i] = keep + dpp_<0xB1>(send); }
        { const h16x2 pv = (h16x2){(h16)(q2[0] * xs), (h16)(q2[1] * xs)}; __builtin_amdgcn_raw_buffer_store_b32(__builtin_bit_cast(unsigned, pv), PRT, (16 * r8 + 2 * m) * 2, (j * MTOK + t) * 256, 0); }
    } else {
#pragma unroll
        for (int i = 0; i < 8; ++i) q8[i] = swap_add32(p[i], p[i + 8]);
#pragma unroll
        for (int i = 0; i < 4; ++i) q4[i] = swap_add16(q8[i], q8[i + 4]);
#pragma unroll
        for (int i = 0; i < 2; ++i) { const float keep = (lane & 8) ? q4[i + 2] : q4[i], send = (lane & 8) ? q4[i] : q4[i + 2]; q2[i] = keep + x8_(send); }
        const int col = 128 * j + 16 * m + 2 * r8;
        const h16x2 h1v = __builtin_bit_cast(h16x2, hpre);
        const f32x2 hv = (f32x2){(float)h1v[0] + q2[0], (float)h1v[1] + q2[1]};
        *(h16x2*)((h16*)(a.ws + O_H2B) + (size_t)t * 1024 + col) = (h16x2){(h16)hv[0], (h16)hv[1]};
        const float ss = wave_sum(hv[0] * hv[0] + hv[1] * hv[1]);
        if (lane == 0) ((float*)(a.ws + O_SS2))[(size_t)t * 8 + j] = ss;
    }
}
template <int PH>
__device__ __forceinline__ void phase_gather(const Args& a, int cset) {
    const int tid = tid_(), lane = tid & 63, m = lane & 7, r8 = lane >> 3;
    unsigned* ctr = (unsigned*)(a.ws + O_CTR) + cset * 8 * 64;
    const __amdgpu_buffer_rsrc_t IDX = mkrsrc(a.ws + O_IDX), SDR = mkrsrc(a.ws + (PH ? O_COEF : O_H1B)), PRT = mkrsrc(a.ws + O_PART), HR = mkrsrc(a.ws + O_H1B);
    const unsigned j0 = xcc_id();
    for (unsigned dj = 0; dj < 8; ++dj) {
        const unsigned j = (j0 + dj) & 7u;
        const unsigned char* TB = a.ws + (PH ? O_V8 : O_U8) + (size_t)j * 16384 * 128; const unsigned lo16 = 16u * (unsigned)m;
        unsigned c = 0; if (lane == 0) c = __hip_atomic_fetch_add(ctr + j * 64, 1u, __ATOMIC_RELAXED, __HIP_MEMORY_SCOPE_AGENT);
        c = (unsigned)__builtin_amdgcn_readfirstlane((int)c);
        if (c >= (unsigned)GA_NCH) continue;
        u32x4 qa[8], qb[8]; GSide sd, sn; GIdx ix, ixn;
        { const int t0 = c * GA_TC; ix = g_ldidx(IDX, t0, r8); g_issue8(TB, lo16, ix.a, qa); sd = g_ldside<PH>(SDR, HR, t0, j, m, r8); }
        for (;;) {
            const int t0 = c * GA_TC;
            unsigned cnv = 0; if (lane == 0) cnv = __hip_atomic_fetch_add(ctr + j * 64, 1u, __ATOMIC_RELAXED, __HIP_MEMORY_SCOPE_AGENT);
            unsigned cn = (unsigned)GA_NCH; int tnf = t0 + GA_TC - 1;
#define G_TOKEN(IXC, SDC, IXN, SNN, TI, TN) { \
                const int t = t0 + (TI), tn = (TN); \
                g_issue8(TB, lo16, IXC.b, qb); IXN = g_ldidx(IDX, tn, r8); SNN = g_ldside<PH>(SDR, HR, tn, j, m, r8); \
                float p[16]; int ah[16], al[16]; \
                if (PH == 1) { _Pragma("unroll") for (int k = 0; k < 16; ++k) { ah[k] = 0; al[k] = 0; } } \
                float xs = 1.f; \
                if (PH == 0) { u32x4 xq; g_quant(SDC.a, SDC.b, xq, xs); SDC.a = xq; } \
                if (PH == 0) __builtin_amdgcn_sched_barrier(0);     \
                g_half<PH, 0>(qa, SDC, p, ah, al); \
                if (PH == 0) __builtin_amdgcn_sched_barrier(0); \
                g_issue8(TB, lo16, IXN.a, qa); \
                if (PH == 0) __builtin_amdgcn_sched_barrier(0);     \
                g_half<PH, 1>(qb, SDC, p, ah, al); \
                if (PH == 1) { const float cs = __uint_as_float(SDC.c[0]); _Pragma("unroll") for (int k = 0; k < 16; ++k) p[k] = (float)(GA_C16 ? ((ah[k] << 8) + al[k]) : ah[k]) * cs; }     \
                g_finish<PH>(a, PRT, t, j, lane, p, xs, SDC.d[0]); }
#pragma unroll 1
            for (int ti = 0; ti < GA_TC; ti += 2) {
                if (ti == GA_TC - 2) { cn = (unsigned)__builtin_amdgcn_readfirstlane((int)cnv); if (cn < (unsigned)GA_NCH) tnf = (int)cn * GA_TC; }
                G_TOKEN(ix, sd, ixn, sn, ti, t + 1) G_TOKEN(ixn, sn, ix, sd, ti + 1, (ti + 2 < GA_TC) ? t + 1 : tnf) }
#undef G_TOKEN
            if (cn >= (unsigned)GA_NCH) break;
            c = cn;
        }
    }
}
__device__ __forceinline__ void phase_p16(const Args& a) {
    const int tid = tid_();
    const f32x4* pp = (const f32x4*)a.in[1]; h16* dp = (h16*)(a.ws + O_P16P);
    const int np4 = MTOK * 64, st = gridDim.x * NTHREADS;
    for (int i = blockIdx.x * NTHREADS + tid; i < np4; i += 4 * st) {
        f32x4 pv[4];
#pragma unroll
        for (int q = 0; q < 4; ++q) if (i + q * st < np4) pv[q] = pp[i + q * st];
#pragma unroll
        for (int q = 0; q < 4; ++q) if (i + q * st < np4) { const int n = i + q * st; *(h16x4*)(dp + (size_t)(n >> 6) * 1024 + (n & 63) * 4) = pack4(pv[q]); }
    }
}
__device__ __forceinline__ void phase_coef(const Args& a) {
    const int tid = tid_();
    const h16* PART = (const h16*)(a.ws + O_PART); const unsigned short* IDX = (const unsigned short*)(a.ws + O_IDX);
    const h16* GATE = (const h16*)(a.ws + O_GATE); const float* RS1 = (const float*)(a.ws + O_RS1);
    const float* USC = (const float*)(a.ws + O_USC); const float* VSC = (const float*)(a.ws + O_VSC);
    u32x4* CQ = (u32x4*)(a.ws + O_COEF); float* CS = (float*)(a.ws + O_COEFS);
    for (int task = blockIdx.x * NTHREADS + tid; task < MTOK * 8; task += gridDim.x * NTHREADS) {
        const size_t i = (size_t)task * 16;
        float sacc[16];
#pragma unroll
        for (int k = 0; k < 16; ++k) sacc[k] = 0.f;
#pragma unroll
        for (int j = 0; j < 8; ++j) { const h16x8 p0 = *(const h16x8*)(PART + (size_t)j * MTOK * 128 + i), p1 = *(const h16x8*)(PART + (size_t)j * MTOK * 128 + i + 8);
#pragma unroll
            for (int k = 0; k < 8; ++k) { sacc[k] += (float)p0[k]; sacc[8 + k] += (float)p1[k]; } }
        const u32x4 e0 = *(const u32x4*)(IDX + i), e1 = *(const u32x4*)(IDX + i + 8);
        const h16x8 gt0 = *(const h16x8*)(GATE + i), gt1 = *(const h16x8*)(GATE + i + 8);
        const float rs = RS1[task >> 3];
        float c[16]; float mx = 0.f;
#pragma unroll
        for (int k = 0; k < 16; ++k) { const unsigned w = (k < 8) ? e0[(k & 7) >> 1] : e1[(k & 7) >> 1]; const unsigned e = (k & 1) ? (w >> 16) : (w & 0xffffu);
            c[k] = (float)(k < 8 ? gt0[k & 7] : gt1[k & 7]) * gelu_tanh(rs * USC[e] * sacc[k]) * VSC[e]; mx = fmaxf(mx, fabsf(c[k])); }
        const float qmax = GA_C16 ? 32639.0f : 127.0f;
        const float inv = (mx > 0.f) ? qmax / mx : 0.f;
        u32x4 hw, lw;
#pragma unroll
        for (int g = 0; g < 4; ++g) { unsigned h4 = 0u, l4 = 0u;
#pragma unroll
            for (int b = 0; b < 4; ++b) { const int q = __float2int_rn(c[4 * g + b] * inv), hi = GA_C16 ? ((q + 128) >> 8) : q, lo = GA_C16 ? (q - (hi << 8)) : 0;
                h4 |= (unsigned)(hi & 0xff) << (8 * b); l4 |= (unsigned)(lo & 0xff) << (8 * b); }
            hw[g] = h4; lw[g] = l4; }
        CQ[(size_t)task * 2] = hw; if (GA_C16) CQ[(size_t)task * 2 + 1] = lw;
        CS[task] = mx / qmax;
    }
}

__device__ __forceinline__ void phase_final(const Args& a) {
    const int tid = tid_(), lane = tid & 63, wave = tid >> 6;
    const int gw = blockIdx.x * NWAVES + wave, NGW = gridDim.x * NWAVES;
    const float* part = (const float*)(a.ws + O_PART3); const float* fg = a.in[28];
    f32x4 g4[4];
#pragma unroll
    for (int j = 0; j < 4; ++j) g4[j] = *((const f32x4*)fg + lane + 64 * j);
    const h16* h3b = (const h16*)(a.ws + O_XN);
#define FN_LOAD(SV, HV, RQ) do { _Pragma("unroll") for (int q = 0; q < 4; ++q) { const int r = (RQ) + q * NGW; if (r < MTOK) { SV[q] = (lane < 16) ? part[(size_t)r * 16 + lane] : 0.f; \
            const h16x4* hr = (const h16x4*)(h3b + (size_t)r * 1024) + lane; _Pragma("unroll") for (int j = 0; j < 4; ++j) HV[q][j] = hr[64 * j]; } } } while (0)
#define FN_COMP(SV, HV, RQ) do { _Pragma("unroll") for (int q = 0; q < 4; ++q) { const int r = (RQ) + q * NGW; if (r < MTOK) { \
            const float s = wave_sum(SV[q]); \
            const float rs = rsqrtf(s * (1.f / 1024.f) + NORM_EPS); \
            f32x4* xr = (f32x4*)(a.out + (size_t)r * 1024) + lane; \
            _Pragma("unroll") for (int j = 0; j < 4; ++j) { const h16x4 h = HV[q][j]; xr[64 * j] = (f32x4){(float)h[0], (float)h[1], (float)h[2], (float)h[3]} * rs * g4[j]; } } } } while (0)
    float svA[4], svB[4]; h16x4 hvA[4][4], hvB[4][4];
    const int step = 4 * NGW;
    FN_LOAD(svA, hvA, gw);
    for (int rq = gw; rq < MTOK; rq += 2 * step) {
        FN_LOAD(svB, hvB, rq + step);
        FN_COMP(svA, hvA, rq);
        FN_LOAD(svA, hvA, rq + 2 * step);
        FN_COMP(svB, hvB, rq + step);
    }
#undef FN_LOAD
#undef FN_COMP
}

constexpr int NPHASE = 19;
__global__ void __launch_bounds__(NTHREADS, 2) mk(Args a) {
    LAS unsigned char* lds = (LAS unsigned char*)smem;
    unsigned char* ws = a.ws;
    if (a.ph_hi < 0) { cg::grid_group grid = cg::this_grid(); grid.sync(); }
    volatile LAS unsigned* bst = (volatile LAS unsigned*)(lds + 131072);
    if ((threadIdx.x & 63) == 0) ((volatile LAS unsigned char*)(lds + LDS_WAVE_TAB))[hw_slot_()] = (unsigned char)(threadIdx.x >> 6);
    if (threadIdx.x < 16) bst[threadIdx.x] = 0u;
    __syncthreads();
    const XcdBarrier xbar = xcd_barrier_post((unsigned*)(a.ws + O_BAR), bst);
#define SYNC() xcd_barrier(xbar)
#define IN(k) (a.ph_lo <= (k) && (k) < a.ph_hi)
#define SEAM(k) do { if (IN(k) && IN((k) + 1)) SYNC(); } while (0)
#define REPS(k) ((((REP_MASK) >> (k)) & 1u) ? 2 : 1)
    const int G = gridDim.x, bid = blockIdx.x;
    if (IN(0)) for (int rep = 0; rep < REPS(0); ++rep) { if (rep) SYNC(); phase_prep(a, lds); } SEAM(0);
    if (IN(1)) for (int rep = 0; rep < REPS(1); ++rep) { if (rep) SYNC(); pg8::Gemm g{(const h16*)(ws + O_XN), (const h16*)(ws + O_WIN), MTOK, NIN, 1024, nullptr, nullptr}; pg8::StaticOrder S; S.init(MTOK, NIN, G, bid);
        EpiZ E{(h16*)(ws + O_ZC), (h16*)(ws + O_ZR), (h16*)(ws + O_ZG)}; pg8::gemm_phase(lds, g, S, E); } SEAM(1);
    if (IN(2)) for (int rep = 0; rep < REPS(2); ++rep) { if (rep) SYNC(); phase_conv(a); phase_rwkv_prep(a); } SEAM(2);
    if (IN(3)) for (int rep = 0; rep < REPS(3); ++rep) { if (rep) SYNC(); pg8::Gemm g{(const h16*)(ws + O_APR), (const h16*)(ws + O_WLR), MTOK, 1536, 256, nullptr, nullptr}; pg8::StaticOrder S; S.init(MTOK, 1536, G, bid);
        h16* R = (h16*)a.out; h16* KS = R + (size_t)MTOK * 512; h16* KK = KS + (size_t)2 * MTOK * 512;
        EpiLR E{a.in[7], a.in[9], a.in[13], (h16*)(ws + O_WD), KS, (h16*)(ws + O_BD), (h16*)(ws + O_GG), KK}; pg8::gemm_phase(lds, g, S, E); } SEAM(3);
    if (IN(4)) { for (int st = 0; st <= UT_SEG; ++st) { if (st) SYNC(); phase_ut_step(a, lds, st); } }
    SEAM(6);
    if (IN(7)) for (int rep = 0; rep < REPS(7); ++rep) { if (rep) SYNC(); phase_rwkv_post(a, POST_EARLY, UT_SEG, bid * NWAVES + (tid_() >> 6), G * NWAVES); } SEAM(7);
    if (IN(9)) for (int rep = 0; rep < REPS(9); ++rep) { if (rep) SYNC(); pg8::Gemm g{(const h16*)(ws + O_CA), (const h16*)(ws + O_WA), MTOK, 1024, 512, (const h16*)(ws + O_YB), (const h16*)(ws + O_WB)}; pg8::StaticOrder S; S.init(MTOK, 1024, G, bid);
        EpiMerged E{(const h16*)(ws + O_ZG), (h16*)(ws + O_MERGED)}; pg8::gemm_phase(lds, g, S, E); }
    SEAM(9);
    if (IN(10)) for (int rep = 0; rep < REPS(10); ++rep) { if (rep) SYNC(); pg8::Gemm g{(const h16*)(ws + O_MERGED), (const h16*)(ws + O_WO), MTOK, 1024, 1024, nullptr, nullptr}; pg8::StaticOrder S; S.init(MTOK, 1024, G, bid);
        EpiH1 E{a.in[0], (h16*)(ws + O_H1B), (float*)(ws + O_PART1)}; pg8::gemm_phase(lds, g, S, E); } SEAM(10);
    if (IN(11)) for (int rep = 0; rep < REPS(11); ++rep) { if (rep) SYNC(); pg8::Gemm g{(const h16*)(ws + O_H1B), (const h16*)(ws + O_WS), MTOK, 2048, 1024, nullptr, nullptr}; pg8::StaticOrder S; S.init(MTOK, 2048, G, bid);
        EpiF16 E{(h16*)(ws + O_SCORES), 2048}; pg8::gemm_phase(lds, g, S, E); } SEAM(11);
    if (IN(12)) for (int rep = 0; rep < REPS(12); ++rep) { if (rep) SYNC(); phase_topk(a, lds); } SEAM(12);
    if (IN(13)) for (int rep = 0; rep < REPS(13); ++rep) { if (rep) SYNC(); phase_gather<0>(a, 2 * rep); } SEAM(13);
    if (IN(14)) for (int rep = 0; rep < REPS(14); ++rep) { if (rep) SYNC(); phase_coef(a); }
    SEAM(14);
    if (IN(15)) for (int rep = 0; rep < REPS(15); ++rep) { if (rep) SYNC(); phase_p16(a); phase_gather<1>(a, 1 + 2 * rep); } SEAM(15);
    if (IN(17)) for (int rep = 0; rep < REPS(17); ++rep) { if (rep) SYNC();
        pg8::Gemm g{(const h16*)(ws + O_P16P), (const h16*)(ws + O_WP), MTOK, 1024, 256, (const h16*)(ws + O_H2B), (const h16*)(ws + O_WG), 1024, 1024}; pg8::StaticOrder S; S.init(MTOK, 1024, G, bid);
        EpiPPGate E{(h16*)(ws + O_XN), (const h16*)(ws + O_H2B), (h16*)(ws + O_PP), (const float*)(ws + O_SS2), (float*)(ws + O_PART3)}; pg8::gemm_phase(lds, g, S, E); } SEAM(17);
    if (IN(18)) for (int rep = 0; rep < REPS(18); ++rep) { if (rep) SYNC(); phase_final(a); }
}

extern "C" void kernel_launch(void* const* d_in, const int* in_sizes, int n_in, void* d_out, int out_size, void* d_ws, size_t ws_size, hipStream_t stream) {
    static int ready = 0, grid = NBLK;
    if (!ready) {
        if (n_in != 29 || ws_size < WS_END) { fprintf(stderr, "kernel_launch: unexpected n_in %d / ws %zu (need %zu)\n", n_in, ws_size, (size_t)WS_END); ready = -1; return; }
        if (hipFuncSetAttribute((const void*)mk, hipFuncAttributeMaxDynamicSharedMemorySize, LDS_BYTES) != hipSuccess) { fprintf(stderr, "hipFuncSetAttribute failed\n"); ready = -1; return; }
        int dev = 0, cus = 0, per_cu = 0;
        if (hipGetDevice(&dev) == hipSuccess && hipDeviceGetAttribute(&cus, hipDeviceAttributeMultiprocessorCount, dev) == hipSuccess &&
            hipOccupancyMaxActiveBlocksPerMultiprocessor(&per_cu, (const void*)mk, NTHREADS, LDS_BYTES) == hipSuccess && cus > 0 && per_cu > 0) grid = cus < NBLK ? cus : NBLK;
        else { (void)hipGetLastError(); grid = NBLK; }
        ready = 1;
    }
    if (ready < 0) return;
    Args a{};
    for (int i = 0; i < 29; ++i) a.in[i] = (const float*)d_in[i];
    a.out = (float*)d_out; a.ws = (unsigned char*)d_ws;
    (void)hipMemsetAsync((unsigned char*)d_ws + O_BAR, 0, 16384, stream);
    a.ph_lo = 0; a.ph_hi = NPHASE;
    void* args[] = {&a};
    if (hipLaunchCooperativeKernel((const void*)mk, dim3(grid), dim3(NTHREADS), args, LDS_BYTES, stream) != hipSuccess) fprintf(stderr, "cooperative launch failed (grid %d)\n", grid);
}
```

```cpp
#include <hip/hip_runtime.h>
#include <hip/hip_cooperative_groups.h>
#include <cstdio>
namespace cg = cooperative_groups;

#ifndef REP_MASK
#define REP_MASK 0u
#endif

#define LAS __attribute__((address_space(3)))
typedef _Float16 h16;
typedef _Float16 h16x8 __attribute__((ext_vector_type(8)));
typedef _Float16 h16x4 __attribute__((ext_vector_type(4)));
typedef _Float16 h16x2 __attribute__((ext_vector_type(2)));
typedef float f32x4 __attribute__((ext_vector_type(4)));
typedef float f32x2 __attribute__((ext_vector_type(2)));
typedef unsigned u32x4 __attribute__((ext_vector_type(4)));
typedef short s16x2 __attribute__((ext_vector_type(2)));
typedef unsigned u32x2 __attribute__((ext_vector_type(2)));

constexpr int MTOK = 65536, DM = 1024, SEQ = 8192, NB = 8;
constexpr int NIN = 5376;
constexpr int NTHREADS = 512, NWAVES = 8, NBLK = 256;
constexpr int LDS_BYTES = 131072 + 128 + 2 * 12288;
constexpr float NORM_EPS = 1e-6f;

constexpr size_t MiB = 1u << 20;
constexpr size_t O_WIN = 0;
constexpr size_t O_WA = O_WIN + (size_t)5376 * 1024 * 2;
constexpr size_t O_WB = O_WA + 1 * MiB;
constexpr size_t O_WO = O_WB + 1 * MiB;
constexpr size_t O_WG = O_WO + 2 * MiB;
constexpr size_t O_WP = O_WG + 2 * MiB;
constexpr size_t O_WLR = O_WP + 2 * MiB;
constexpr size_t O_WS = O_WLR + 3 * MiB / 4;
constexpr size_t O_U16 = O_WS + 4 * MiB;
constexpr size_t O_V16 = O_U16 + 32 * MiB;
constexpr size_t O_P16 = O_V16 + 32 * MiB;
constexpr size_t O_PART1 = O_P16 + 32 * MiB;
constexpr size_t O_PART3 = O_PART1 + 4 * MiB;
constexpr size_t O_RS1 = O_PART3 + 4 * MiB;
constexpr size_t O_RS2 = O_RS1 + MiB / 4;
constexpr size_t O_XN = O_RS2 + MiB / 4;
constexpr size_t O_ZC = O_XN + 128 * MiB;
constexpr size_t O_ZR = O_ZC + 192 * MiB;
constexpr size_t O_ZG = O_ZR + 224 * MiB;
constexpr size_t O_SS2 = O_ZG + 256 * MiB;
constexpr size_t O_USC = O_SS2 + 2 * MiB;
constexpr size_t O_VSC = O_USC + 65536;
constexpr size_t O_CTR = O_VSC + 65536;
constexpr size_t O_BAR = O_CTR + 8192;
constexpr size_t O_SST2 = O_BAR + 16384;
constexpr size_t WS_END = O_SST2 + MiB;
constexpr size_t O_U8 = O_U16;
constexpr size_t O_V8 = O_U16 + 16 * MiB;
constexpr size_t O_PART = O_ZG;
constexpr size_t O_COEF = O_ZC + 128 * MiB;
constexpr size_t O_COEFS = O_COEF + 16 * MiB;
constexpr size_t O_CA = O_XN;
constexpr size_t O_APR = O_XN + 64 * MiB;
constexpr size_t O_H1B = O_XN;
constexpr size_t O_WD = O_ZC;
constexpr size_t O_BD = O_ZC + 64 * MiB;
constexpr size_t O_GG = O_ZC + 128 * MiB;
constexpr size_t O_MERGED = O_ZC;
constexpr size_t O_H2B = O_ZC;
constexpr size_t O_Y = O_ZR + 96 * MiB;
constexpr size_t O_YB = O_ZR + 160 * MiB;
constexpr size_t O_IDX = O_ZR;
constexpr size_t O_GATE = O_ZR + 16 * MiB;
constexpr size_t O_PP = O_ZR + 64 * MiB;
constexpr size_t O_SCORES = O_ZG;
constexpr size_t O_P16P = O_ZG;

struct Args {
    const float* in[29];
    float* out;
    unsigned char* ws;
    int ph_lo, ph_hi;
};

constexpr int LDS_WAVE_TAB = 131072 + 64;
extern __shared__ __attribute__((aligned(16))) unsigned char smem[];
__device__ __forceinline__ int lane_() { int l; asm volatile("v_mbcnt_lo_u32_b32 %0, -1, 0\n\tv_mbcnt_hi_u32_b32 %0, -1, %0" : "=v"(l)); return l; }
__device__ __forceinline__ unsigned hw_slot_() { return (unsigned)__builtin_amdgcn_s_getreg((5 << 11) | 4) & 63u; }
__device__ __forceinline__ int tid_() {
    const int w = (int)((volatile LAS unsigned char*)((LAS unsigned char*)smem + LDS_WAVE_TAB))[hw_slot_()];
    int t = __builtin_amdgcn_readfirstlane(w) * 64 + lane_(); asm volatile("" : "+v"(t)); return t;
}
__device__ __forceinline__ float sigmoidf_(float x) { return __builtin_amdgcn_rcpf(1.0f + __expf(-x)); }
template <int CTRL> __device__ __forceinline__ float dpp_(float v) { return __builtin_bit_cast(float, __builtin_amdgcn_update_dpp(0, __builtin_bit_cast(int, v), CTRL, 0xF, 0xF, true)); }
__device__ __forceinline__ float x32_(float v, int lane) { const auto r = __builtin_amdgcn_permlane32_swap(__builtin_bit_cast(unsigned, v), __builtin_bit_cast(unsigned, v), false, false); return __builtin_bit_cast(float, (lane & 32) ? r[0] : r[1]); }
__device__ __forceinline__ float x16_(float v, int lane) { const auto r = __builtin_amdgcn_permlane16_swap(__builtin_bit_cast(unsigned, v), __builtin_bit_cast(unsigned, v), false, false); return __builtin_bit_cast(float, (lane & 16) ? r[0] : r[1]); }
__device__ __forceinline__ float swap_add32(float a, float b) { asm("s_nop 1\n\tv_permlane32_swap_b32 %0, %1" : "+v"(a), "+v"(b)); return a + b; }
__device__ __forceinline__ float swap_add16(float a, float b) { asm("s_nop 1\n\tv_permlane16_swap_b32 %0, %1" : "+v"(a), "+v"(b)); return a + b; }
__device__ __forceinline__ float x8_(float v) { return dpp_<0x128>(v); }
__device__ __forceinline__ float xhm_(float v) { return dpp_<0x141>(v); }
__device__ __forceinline__ float wave_sum(float v) {
    const int lane = lane_();
    v += dpp_<0xB1>(v); v += dpp_<0x4E>(v); v += dpp_<0x141>(v); v += dpp_<0x140>(v);
    v += x16_(v, lane); v += x32_(v, lane);
    return v;
}
__device__ __forceinline__ float wave_max(float v) {
    const int lane = lane_();
    v = fmaxf(v, dpp_<0xB1>(v)); v = fmaxf(v, dpp_<0x4E>(v)); v = fmaxf(v, dpp_<0x141>(v)); v = fmaxf(v, dpp_<0x140>(v));
    v = fmaxf(v, x16_(v, lane)); v = fmaxf(v, x32_(v, lane));
    return v;
}
__device__ __forceinline__ __amdgpu_buffer_rsrc_t mkrsrc(const void* p) { return __builtin_amdgcn_make_buffer_rsrc((void*)p, 0, 0x7fffffff, 0x00020000); }
__device__ __forceinline__ h16x8 pack8(f32x4 a, f32x4 b) {
    h16x8 r;
    r[0] = (h16)a[0]; r[1] = (h16)a[1]; r[2] = (h16)a[2]; r[3] = (h16)a[3];
    r[4] = (h16)b[0]; r[5] = (h16)b[1]; r[6] = (h16)b[2]; r[7] = (h16)b[3];
    return r;
}
__device__ __forceinline__ h16x4 pack4(f32x4 a) {
    h16x4 r; r[0] = (h16)a[0]; r[1] = (h16)a[1]; r[2] = (h16)a[2]; r[3] = (h16)a[3]; return r;
}

#define XB_TMO      128
#define XB_XCNT(j)  (256  + 64 * (j))
#define XB_XSUB(j)  (1280 + 64 * (j))
#define XB_XGEN(j)  (2304 + 64 * (j))
#define XB_TOP      3328
#define XB_TOPGEN   3392
#define XCD_BAR_WORDS 3456
#define XB_SPIN_CAP (1u << 18)

__device__ __forceinline__ unsigned xb_ld(unsigned* p)              { return __hip_atomic_load(p, __ATOMIC_RELAXED, __HIP_MEMORY_SCOPE_AGENT); }
__device__ __forceinline__ unsigned xb_add(unsigned* p, unsigned v) { return __hip_atomic_fetch_add(p, v, __ATOMIC_RELAXED, __HIP_MEMORY_SCOPE_AGENT); }
__device__ __forceinline__ unsigned xb_xcc_id() { return (unsigned)__builtin_amdgcn_s_getreg((3 << 11) | 20) & 0xFu; }
#define XB_SPIN(cond, bar) do { unsigned _sp = 0; while (cond) { __builtin_amdgcn_s_sleep(1); \
    if ((++_sp & 255u) == 0u) { if (xb_ld(&(bar)[XB_TMO])) break; if (_sp > XB_SPIN_CAP) { atomicAdd(&(bar)[XB_TMO], 1u); break; } } } } while (0)

struct XcdBarrier {
    unsigned* bar; unsigned x;
    volatile LAS unsigned* st;
};

__device__ __forceinline__ XcdBarrier xcd_barrier_post(unsigned* bar, volatile LAS unsigned* st) {
    XcdBarrier b; b.bar = bar; b.x = xb_xcc_id(); b.st = st;
    if (tid_() == 0) (void)xb_add(&bar[XB_XCNT(b.x)], 1u);
    return b;
}
__device__ __forceinline__ void xcd_barrier_complete(unsigned* bar, unsigned x, unsigned& nloc, unsigned& nx) {
    const unsigned G = gridDim.x * gridDim.y * gridDim.z;
    unsigned sum, cnt, mine, sp = 0u;
    for (;;) {
        sum = 0u; cnt = 0u; mine = 0u;
#pragma unroll
        for (unsigned j = 0; j < 16; ++j) { const unsigned c = xb_ld(&bar[XB_XCNT(j)]); sum += c; cnt += (c > 0u) ? 1u : 0u; mine = (j == x) ? c : mine; }
        if (sum == G) break;
        __builtin_amdgcn_s_sleep(1);
        if ((++sp & 255u) == 0u) { if (xb_ld(&bar[XB_TMO])) break; if (sp > XB_SPIN_CAP) { atomicAdd(&bar[XB_TMO], 1u); break; } }
    }
    nloc = mine > 0u ? mine : 1u; nx = cnt > 0u ? cnt : 1u;
}

__device__ __forceinline__ void xcd_barrier(const XcdBarrier& b) {
    asm volatile("s_waitcnt vmcnt(0)" ::: "memory");
    __syncthreads();
    if (tid_() == 0) {
        unsigned* bar = b.bar;
        __builtin_amdgcn_s_waitcnt(0);
        unsigned nloc = b.st[0], nx = b.st[1];
        if (nloc == 0u) { xcd_barrier_complete(bar, b.x, nloc, nx); b.st[0] = nloc; b.st[1] = nx; }
        const unsigned old = xb_add(&bar[XB_XSUB(b.x)], 1u);
        const unsigned gen = old / nloc;
        if (old + 1u == (gen + 1u) * nloc) {
            __builtin_amdgcn_fence(__ATOMIC_RELEASE, "agent");
            asm volatile("s_waitcnt vmcnt(0)" ::: "memory");
            const unsigned og = xb_add(&bar[XB_TOP], 1u);
            const unsigned tg = og / nx;
            if (og + 1u == (tg + 1u) * nx) xb_add(&bar[XB_TOPGEN], 1u);
            else XB_SPIN(xb_ld(&bar[XB_TOPGEN]) == tg, bar);
            __builtin_amdgcn_fence(__ATOMIC_ACQUIRE, "agent");
            xb_add(&bar[XB_XGEN(b.x)], 1u);
            asm volatile("s_waitcnt vmcnt(0)" ::: "memory");
        } else {
            XB_SPIN(xb_ld(&bar[XB_XGEN(b.x)]) == gen, bar);
            __builtin_amdgcn_fence(__ATOMIC_ACQUIRE, "agent");
            asm volatile("s_waitcnt vmcnt(0)" ::: "memory");
        }
    }
    __syncthreads();
}


namespace pg8 {
constexpr int BM = 256, BK = 64, HALF = 128, HTB = HALF * BK * 2, STAGE_BYTES = 8 * HTB, NXCD = 8, WGM = 8;
__device__ __forceinline__ int lds_byte(int r, int c) { const int st = (r >> 4) * 2 + (c >> 5), rr = r & 15, cc = c & 31, ob = rr * 64 + cc * 2; return st * 1024 + (ob ^ (((ob >> 9) & 1) << 5)); }
__device__ __forceinline__ void stage_rc(int b, int& R, int& C) { const int st = b / 1024, sb = b % 1024, swz = sb ^ (((sb >> 9) & 1) << 5); R = (st >> 1) * 16 + swz / 64; C = (st & 1) * 32 + (swz % 64) / 2; }
__device__ __forceinline__ int perm32(int rho) { const int n = rho >> 4, i = rho & 15; return 8 * (i >> 2) + 4 * n + (i & 3); }

struct Unit { int pm, pn; };
struct Gemm { const h16* A; const h16* Bt; int M, N, K; const h16* A2; const h16* Bt2; int ld, K2, win; };

struct StaticOrder {
    int nM, nN, nwg, G, c;
    __device__ void init(int M, int N, int G_, int c_) { nM = M / BM; nN = N / BM; nwg = nM * nN; G = G_; c = c_; }
    __device__ bool next(int i, Unit& u) const {
        const long L = (long)i * G + c; if (L >= nwg) return false;
        int wgid = (int)L; { const int q = nwg / NXCD, r = nwg % NXCD, xcd = wgid % NXCD, off = wgid / NXCD; wgid = (xcd < r ? xcd * (q + 1) : r * (q + 1) + (xcd - r) * q) + off; }
        const int nig = WGM * nN, gid = wgid / nig, fm = gid * WGM, rem = wgid - gid * nig;
        u.pm = fm + (rem % WGM); u.pn = rem / WGM; return true;
    }
};

template <class Epi>
__device__ __forceinline__ void gemm_phase(LAS unsigned char* lds, const Gemm g, const StaticOrder& S, const Epi& E) {
    const int tid = tid_(), wid = __builtin_amdgcn_readfirstlane(tid >> 6), lane = tid & 63, wr = wid >> 2, wc = wid & 3, fr = lane & 15, fq = lane >> 4;
    const int K = g.ld ? g.ld : g.K, nt0 = g.win ? 2 : g.K / BK, nt1 = (g.K2 ? g.K2 : g.K) / BK;
#define PG8_KO(pn) ((size_t)((g.win && (pn) >= 4) ? 256 : 0))
    unsigned voffA[2], voffB[2];
#pragma unroll
    for (int i = 0; i < 2; ++i) { int R, C; stage_rc(tid * 16 + i * 8192, R, C); const int Rb = (R & ~31) + perm32(R & 31);
        voffA[i] = (unsigned)(R * K + C) * 2u; voffB[i] = (unsigned)(Rb * K + C) * 2u; }
    const size_t kstep = (size_t)(BK * 2);
    const size_t hstep = (size_t)HALF * K * 2;
    const size_t tstep = 2 * hstep;
    const unsigned ldsw = (unsigned)wid * 1024u;
    const int aoff = lds_byte(wr * 64 + fr, fq * 8), boff = lds_byte(wc * 32 + fr, fq * 8);
#define PG8_SA(b, h) (((b) * 2 + (h)) * HTB)
#define PG8_SB(b, h) ((4 + (b) * 2 + (h)) * HTB)
#define PG8_STAGE(bufoff, gbase, voff) do { _Pragma("unroll") for (int _i = 0; _i < 2; ++_i) \
        __builtin_amdgcn_global_load_lds((const unsigned*)((const char*)(gbase) + (voff)[_i]), (LAS unsigned*)(lds + (bufoff) + ldsw + _i * 8192), 16, 0, 0); } while (0)
#define PG8_LDA(dst, b, h) do { _Pragma("unroll") for (int m = 0; m < 4; ++m) _Pragma("unroll") for (int k = 0; k < 2; ++k) dst[m][k] = *(const LAS h16x8*)(lds + PG8_SA(b, h) + aoff + m * 2048 + k * 1024); } while (0)
#define PG8_LDB(dst, b, h) do { _Pragma("unroll") for (int n = 0; n < 2; ++n) _Pragma("unroll") for (int k = 0; k < 2; ++k) dst[n][k] = *(const LAS h16x8*)(lds + PG8_SB(b, h) + boff + n * 2048 + k * 1024); } while (0)
#define PG8_MMA(ai, bj, At, Bt) do { __builtin_amdgcn_s_setprio(1); _Pragma("unroll") for (int m = 0; m < 4; ++m) _Pragma("unroll") for (int n = 0; n < 2; ++n) _Pragma("unroll") for (int k = 0; k < 2; ++k) \
        acc[ai][bj][m][n] = __builtin_amdgcn_mfma_f32_16x16x32_f16(Bt[n][k], At[m][k], acc[ai][bj][m][n], 0, 0, 0); __builtin_amdgcn_s_setprio(0); } while (0)
#define PG8_WAIT_V(n) asm volatile("s_waitcnt vmcnt(" #n ")" ::: "memory")
#define PG8_WAIT_L(n) asm volatile("s_waitcnt lgkmcnt(" #n ")" ::: "memory")
#define PG8_BAR __builtin_amdgcn_s_barrier()
#define PG8_SCHED __builtin_amdgcn_sched_barrier(0)
    Unit cur, nxt; int ui = 0;
    constexpr bool TP = Epi::TWO_PART;
    if (!S.next(0, cur)) return;
    f32x4 acc[2][2][4][2];
#pragma unroll
    for (int a = 0; a < 2; ++a)
#pragma unroll
        for (int b = 0; b < 2; ++b)
#pragma unroll
            for (int m = 0; m < 4; ++m)
#pragma unroll
                for (int n = 0; n < 2; ++n) acc[a][b][m][n] = (f32x4){0.f, 0.f, 0.f, 0.f};
    h16x8 At[4][2], B0[2][2], B1[2][2];
    const char* cA = (const char*)g.A + (size_t)cur.pm * tstep + PG8_KO(cur.pn); const char* cB = (const char*)g.Bt + (size_t)cur.pn * tstep + PG8_KO(cur.pn);
    PG8_STAGE(PG8_SB(0, 0), cB, voffB); PG8_STAGE(PG8_SB(0, 1), cB + hstep, voffB); PG8_STAGE(PG8_SA(0, 0), cA, voffA); PG8_STAGE(PG8_SA(0, 1), cA + hstep, voffA);
    if (wr == 1) PG8_BAR;
    PG8_WAIT_V(2); PG8_BAR;
    PG8_STAGE(PG8_SB(1, 0), cB + kstep, voffB); PG8_STAGE(PG8_SA(1, 0), cA + kstep, voffA); PG8_STAGE(PG8_SB(1, 1), cB + hstep + kstep, voffB);
    PG8_WAIT_V(6); PG8_BAR;
    for (;;) {
        const bool has_next = TP ? (((ui + 1) & 1) ? (nxt = cur, true) : S.next((ui + 1) >> 1, nxt)) : S.next(ui + 1, nxt);
        const h16* gA_n = (TP && ((ui + 1) & 1)) ? g.A2 : g.A; const h16* gB_n = (TP && ((ui + 1) & 1)) ? g.Bt2 : g.Bt;
        const char* nA = has_next ? (const char*)gA_n + (size_t)nxt.pm * tstep + PG8_KO(nxt.pn) : cA; const char* nB = has_next ? (const char*)gB_n + (size_t)nxt.pn * tstep + PG8_KO(nxt.pn) : cB;
        const int nt = (TP && (ui & 1)) ? nt1 : nt0;
        for (int t = 0; t < nt; t += 2) {
            const bool last = (t == nt - 2);
            const char* a1 = cA + (size_t)(t + 1) * kstep;
            const char* a2 = last ? nA : cA + (size_t)(t + 2) * kstep; const char* b2 = last ? nB : cB + (size_t)(t + 2) * kstep;
            const char* a3 = a2 + kstep; const char* b3 = b2 + kstep;
            PG8_LDB(B0, 0, 0); PG8_LDB(B1, 0, 1); PG8_SCHED; PG8_LDA(At, 0, 0); PG8_STAGE(PG8_SA(1, 1), a1 + hstep, voffA);
            PG8_WAIT_V(8); PG8_WAIT_L(0); PG8_BAR; PG8_MMA(0, 0, At, B0); PG8_MMA(0, 1, At, B1); PG8_BAR; PG8_SCHED;
            PG8_LDA(At, 0, 1); PG8_STAGE(PG8_SB(0, 0), b2, voffB); PG8_STAGE(PG8_SB(0, 1), b2 + hstep, voffB); PG8_STAGE(PG8_SA(0, 0), a2, voffA);
            PG8_WAIT_V(8); PG8_WAIT_L(0); PG8_BAR; PG8_MMA(1, 0, At, B0); PG8_MMA(1, 1, At, B1); PG8_BAR; PG8_SCHED;
            PG8_LDB(B0, 1, 0); PG8_LDB(B1, 1, 1); PG8_SCHED; PG8_LDA(At, 1, 0); PG8_STAGE(PG8_SA(0, 1), a2 + hstep, voffA);
            PG8_WAIT_V(8); PG8_WAIT_L(0); PG8_BAR; PG8_MMA(0, 0, At, B0); PG8_MMA(0, 1, At, B1); PG8_BAR; PG8_SCHED;
            PG8_LDA(At, 1, 1); PG8_STAGE(PG8_SB(1, 0), b3, voffB); PG8_STAGE(PG8_SB(1, 1), b3 + hstep, voffB); PG8_STAGE(PG8_SA(1, 0), a3, voffA);
            PG8_WAIT_V(8); PG8_WAIT_L(0); PG8_BAR; PG8_MMA(1, 0, At, B0); PG8_MMA(1, 1, At, B1); PG8_BAR; PG8_SCHED;
        }
        if (wr == 0) PG8_BAR;
        if constexpr (TP) { if ((ui & 1) == 0) E.mid(acc, cur, wr, wc, fr, fq); else E(acc, cur, wr, wc, fr, fq); } else E(acc, cur, wr, wc, fr, fq);
        if (!has_next) break;
        bool keep = false; if constexpr (TP) keep = Epi::KEEP_ACC && ((ui & 1) == 0);
        if (!keep)
#pragma unroll
        for (int a = 0; a < 2; ++a)
#pragma unroll
            for (int b = 0; b < 2; ++b)
#pragma unroll
                for (int m = 0; m < 4; ++m)
#pragma unroll
                    for (int n = 0; n < 2; ++n) acc[a][b][m][n] = (f32x4){0.f, 0.f, 0.f, 0.f};
        cur = nxt; cA = nA; cB = nB; ++ui;
        if (wr == 1) PG8_BAR;
    }
    PG8_WAIT_V(0);
    PG8_BAR;
#undef PG8_SA
#undef PG8_SB
#undef PG8_STAGE
#undef PG8_LDA
#undef PG8_LDB
#undef PG8_MMA
#undef PG8_WAIT_V
#undef PG8_WAIT_L
#undef PG8_KO
#undef PG8_BAR
#undef PG8_SCHED
}
}
using pg8::Unit;
typedef const f32x4 (&AccRef)[2][2][4][2];

#define EPI_LOOP_BEGIN \
    _Pragma("unroll") for (int ai = 0; ai < 2; ++ai) _Pragma("unroll") for (int m = 0; m < 4; ++m) { \
        const int row = u.pm * 256 + ai * 128 + wr * 64 + m * 16 + fr; \
        _Pragma("unroll") for (int bj = 0; bj < 2; ++bj) { \
            const int col = u.pn * 256 + bj * 128 + wc * 32 + 8 * fq; \
            const f32x4 v0 = acc[ai][bj][m][0], v1 = acc[ai][bj][m][1];
#define EPI_LOOP_END } }

struct EpiZ {
    static constexpr bool TWO_PART = false;
    h16 *zc, *zr, *zg;
    __device__ __forceinline__ void operator()(AccRef acc, const Unit& u, int wr, int wc, int fr, int fq) const {
        const int colt = u.pn * 256; h16* base; int ld, c0;
        if (colt < 1536) { base = zc; ld = 1536; c0 = colt; } else if (colt < 3328) { base = zr; ld = 1792; c0 = colt - 1536; } else { base = zg; ld = 2048; c0 = colt - 3328; }
        EPI_LOOP_BEGIN
            *(h16x8*)(base + (size_t)row * ld + (col - colt + c0)) = pack8(v0, v1);
        EPI_LOOP_END
    }
};
struct EpiF16 {
    static constexpr bool TWO_PART = false;
    h16* O; int ld;
    __device__ __forceinline__ void operator()(AccRef acc, const Unit& u, int wr, int wc, int fr, int fq) const {
        EPI_LOOP_BEGIN
            *(h16x8*)(O + (size_t)row * ld + col) = pack8(v0, v1);
        EPI_LOOP_END
    }
};
struct EpiMerged {
    static constexpr bool TWO_PART = true, KEEP_ACC = true;
    const h16* zg; h16* merged;
    __device__ __forceinline__ void mid(f32x4 (&acc)[2][2][4][2], const Unit& u, int wr, int wc, int fr, int fq) const {
#pragma unroll
        for (int ai = 0; ai < 2; ++ai) {
            h16x8 gav[4][2], gbv[4][2];
#pragma unroll
            for (int m = 0; m < 4; ++m) { const int row = u.pm * 256 + ai * 128 + wr * 64 + m * 16 + fr;
#pragma unroll
                for (int bj = 0; bj < 2; ++bj) { const int col = u.pn * 256 + bj * 128 + wc * 32 + 8 * fq;
                    gav[m][bj] = *(const h16x8*)(zg + (size_t)row * 2048 + col); gbv[m][bj] = *(const h16x8*)(zg + (size_t)row * 2048 + 1024 + col); } }
#pragma unroll
            for (int m = 0; m < 4; ++m)
#pragma unroll
                for (int bj = 0; bj < 2; ++bj) { const h16x8 ga = gav[m][bj], gb = gbv[m][bj];
#pragma unroll
                    for (int j = 0; j < 4; ++j) {
                        acc[ai][bj][m][0][j] *= (1.0f + __expf(-(float)gb[j])) * __builtin_amdgcn_rcpf(1.0f + __expf(-(float)ga[j]));
                        acc[ai][bj][m][1][j] *= (1.0f + __expf(-(float)gb[4 + j])) * __builtin_amdgcn_rcpf(1.0f + __expf(-(float)ga[4 + j])); } }
        }
    }
    __device__ __forceinline__ void operator()(AccRef acc, const Unit& u, int wr, int wc, int fr, int fq) const {
#pragma unroll
        for (int ai = 0; ai < 2; ++ai) {
            h16x8 gvv[4][2];
#pragma unroll
            for (int m = 0; m < 4; ++m) { const int row = u.pm * 256 + ai * 128 + wr * 64 + m * 16 + fr;
#pragma unroll
                for (int bj = 0; bj < 2; ++bj) { const int col = u.pn * 256 + bj * 128 + wc * 32 + 8 * fq; gvv[m][bj] = *(const h16x8*)(zg + (size_t)row * 2048 + 1024 + col); } }
#pragma unroll
            for (int m = 0; m < 4; ++m) { const int row = u.pm * 256 + ai * 128 + wr * 64 + m * 16 + fr;
#pragma unroll
                for (int bj = 0; bj < 2; ++bj) { const int col = u.pn * 256 + bj * 128 + wc * 32 + 8 * fq;
                    const h16x8 gv = gvv[m][bj]; const f32x4 v0 = acc[ai][bj][m][0], v1 = acc[ai][bj][m][1];
                    f32x4 o0, o1;
#pragma unroll
                    for (int j = 0; j < 4; ++j) { o0[j] = sigmoidf_((float)gv[j]) * v0[j]; o1[j] = sigmoidf_((float)gv[4 + j]) * v1[j]; }
                    *(h16x8*)(merged + (size_t)row * 1024 + col) = pack8(o0, o1); } }
        }
    }
};
struct EpiH1 {
    static constexpr bool TWO_PART = false;
    const float* x; h16* hb; float* part;
    __device__ __forceinline__ void operator()(AccRef acc, const Unit& u, int wr, int wc, int fr, int fq) const {
#pragma unroll
        for (int ai = 0; ai < 2; ++ai) {
            f32x4 xv[4][2][2];
#pragma unroll
            for (int m = 0; m < 4; ++m) { const int row = u.pm * 256 + ai * 128 + wr * 64 + m * 16 + fr;
#pragma unroll
                for (int bj = 0; bj < 2; ++bj) { const int col = u.pn * 256 + bj * 128 + wc * 32 + 8 * fq; const float* xp = x + (size_t)row * 1024 + col;
                    xv[m][bj][0] = *(const f32x4*)xp; xv[m][bj][1] = *(const f32x4*)(xp + 4); } }
#pragma unroll
            for (int m = 0; m < 4; ++m) {
                const int row = u.pm * 256 + ai * 128 + wr * 64 + m * 16 + fr; float ss = 0.f;
#pragma unroll
                for (int bj = 0; bj < 2; ++bj) {
                    const int col = u.pn * 256 + bj * 128 + wc * 32 + 8 * fq;
                    const f32x4 o0 = xv[m][bj][0] + acc[ai][bj][m][0], o1 = xv[m][bj][1] + acc[ai][bj][m][1];
                    *(h16x8*)(hb + (size_t)row * 1024 + col) = pack8(o0, o1);
                    ss += (o0[0] * o0[0] + o0[1] * o0[1]) + (o0[2] * o0[2] + o0[3] * o0[3]) + (o1[0] * o1[0] + o1[1] * o1[1]) + (o1[2] * o1[2] + o1[3] * o1[3]);
                }
                { const int ln_ = fr + 16 * fq; ss += x16_(ss, ln_); ss += x32_(ss, ln_); }
                if (fq == 0) part[(size_t)row * 16 + u.pn * 4 + wc] = ss;
            }
        }
    }
};
struct EpiGate {
    static constexpr bool TWO_PART = false;
    h16* h3b; const h16* h2b; const h16* pp; const float* rs2; float* part;
    __device__ __forceinline__ void operator()(AccRef acc, const Unit& u, int wr, int wc, int fr, int fq) const {
#pragma unroll
        for (int ai = 0; ai < 2; ++ai) {
            float rsv[4]; h16x8 hvv[4][2], pvv[4][2];
            { f32x4 sav[4], sbv[4];
#pragma unroll
              for (int m = 0; m < 4; ++m) { const int row = u.pm * 256 + ai * 128 + wr * 64 + m * 16 + fr; sav[m] = *(const f32x4*)(rs2 + (size_t)row * 8); sbv[m] = *(const f32x4*)(rs2 + (size_t)row * 8 + 4); }
#pragma unroll
              for (int m = 0; m < 4; ++m) { const f32x4 sa = sav[m], sb = sbv[m]; rsv[m] = rsqrtf(((sa[0] + sa[1]) + (sa[2] + sa[3]) + (sb[0] + sb[1]) + (sb[2] + sb[3])) * (1.f / 1024.f) + NORM_EPS); } }
#pragma unroll
            for (int m = 0; m < 4; ++m) { const int row = u.pm * 256 + ai * 128 + wr * 64 + m * 16 + fr;
#pragma unroll
                for (int bj = 0; bj < 2; ++bj) { const int col = u.pn * 256 + bj * 128 + wc * 32 + 8 * fq;
                    hvv[m][bj] = *(const h16x8*)(h2b + (size_t)row * 1024 + col); pvv[m][bj] = *(const h16x8*)(pp + (size_t)row * 1024 + col); } }
#pragma unroll
            for (int m = 0; m < 4; ++m) {
                const int row = u.pm * 256 + ai * 128 + wr * 64 + m * 16 + fr; float ss = 0.f;
                const float rs = rsv[m];
#pragma unroll
                for (int bj = 0; bj < 2; ++bj) {
                    const int col = u.pn * 256 + bj * 128 + wc * 32 + 8 * fq;
                    const h16x8 hv = hvv[m][bj];
                    f32x4 o0 = (f32x4){(float)hv[0], (float)hv[1], (float)hv[2], (float)hv[3]}, o1 = (f32x4){(float)hv[4], (float)hv[5], (float)hv[6], (float)hv[7]};
                    const h16x8 pv = pvv[m][bj];
                    const f32x4 v0 = acc[ai][bj][m][0], v1 = acc[ai][bj][m][1];
#pragma unroll
                    for (int j = 0; j < 4; ++j) { o0[j] += sigmoidf_(rs * v0[j]) * (float)pv[j]; o1[j] += sigmoidf_(rs * v1[j]) * (float)pv[4 + j]; }
                    *(h16x8*)(h3b + (size_t)row * 1024 + col) = pack8(o0, o1);
                    ss += (o0[0] * o0[0] + o0[1] * o0[1]) + (o0[2] * o0[2] + o0[3] * o0[3]) + (o1[0] * o1[0] + o1[1] * o1[1]) + (o1[2] * o1[2] + o1[3] * o1[3]);
                }
                { const int ln_ = fr + 16 * fq; ss += x16_(ss, ln_); ss += x32_(ss, ln_); }
                if (fq == 0) part[(size_t)row * 16 + u.pn * 4 + wc] = ss;
            }
        }
    }
};
struct EpiPPGate {
    static constexpr bool TWO_PART = true, KEEP_ACC = false;
    h16* h3b; const h16* h2b; h16* pp; const float* rs2; float* part;
    __device__ __forceinline__ void mid(f32x4 (&acc)[2][2][4][2], const Unit& u, int wr, int wc, int fr, int fq) const {
#pragma unroll
        for (int ai = 0; ai < 2; ++ai)
#pragma unroll
            for (int m = 0; m < 4; ++m) { const int row = u.pm * 256 + ai * 128 + wr * 64 + m * 16 + fr;
#pragma unroll
                for (int bj = 0; bj < 2; ++bj) { const int col = u.pn * 256 + bj * 128 + wc * 32 + 8 * fq;
                    *(h16x8*)(pp + (size_t)row * 1024 + col) = pack8(acc[ai][bj][m][0], acc[ai][bj][m][1]); } }
    }
    __device__ __forceinline__ void operator()(AccRef acc, const Unit& u, int wr, int wc, int fr, int fq) const {
#pragma unroll
        for (int ai = 0; ai < 2; ++ai) {
            float rsv[4]; h16x8 hvv[4][2], pvv[4][2];
            { f32x4 sav[4], sbv[4];
#pragma unroll
              for (int m = 0; m < 4; ++m) { const int row = u.pm * 256 + ai * 128 + wr * 64 + m * 16 + fr; sav[m] = *(const f32x4*)(rs2 + (size_t)row * 8); sbv[m] = *(const f32x4*)(rs2 + (size_t)row * 8 + 4); }
#pragma unroll
              for (int m = 0; m < 4; ++m) { const f32x4 sa = sav[m], sb = sbv[m]; rsv[m] = rsqrtf(((sa[0] + sa[1]) + (sa[2] + sa[3]) + (sb[0] + sb[1]) + (sb[2] + sb[3])) * (1.f / 1024.f) + NORM_EPS); } }
#pragma unroll
          for (int m2 = 0; m2 < 4; m2 += 2) {
#pragma unroll
            for (int m = m2; m < m2 + 2; ++m) { const int row = u.pm * 256 + ai * 128 + wr * 64 + m * 16 + fr;
#pragma unroll
                for (int bj = 0; bj < 2; ++bj) { const int col = u.pn * 256 + bj * 128 + wc * 32 + 8 * fq;
                    hvv[m][bj] = *(const h16x8*)(h2b + (size_t)row * 1024 + col); pvv[m][bj] = *(const h16x8*)(pp + (size_t)row * 1024 + col); } }
#pragma unroll
            for (int m = m2; m < m2 + 2; ++m) {
                const int row = u.pm * 256 + ai * 128 + wr * 64 + m * 16 + fr; float ss = 0.f;
                const float rs = rsv[m];
#pragma unroll
                for (int bj = 0; bj < 2; ++bj) {
                    const int col = u.pn * 256 + bj * 128 + wc * 32 + 8 * fq;
                    const h16x8 hv = hvv[m][bj];
                    f32x4 o0 = (f32x4){(float)hv[0], (float)hv[1], (float)hv[2], (float)hv[3]}, o1 = (f32x4){(float)hv[4], (float)hv[5], (float)hv[6], (float)hv[7]};
                    const h16x8 pv = pvv[m][bj];
                    const f32x4 v0 = acc[ai][bj][m][0], v1 = acc[ai][bj][m][1];
#pragma unroll
                    for (int j = 0; j < 4; ++j) { o0[j] += sigmoidf_(rs * v0[j]) * (float)pv[j]; o1[j] += sigmoidf_(rs * v1[j]) * (float)pv[4 + j]; }
                    *(h16x8*)(h3b + (size_t)row * 1024 + col) = pack8(o0, o1);
                    ss += (o0[0] * o0[0] + o0[1] * o0[1]) + (o0[2] * o0[2] + o0[3] * o0[3]) + (o1[0] * o1[0] + o1[1] * o1[1]) + (o1[2] * o1[2] + o1[3] * o1[3]);
                }
                { const int ln_ = fr + 16 * fq; ss += x16_(ss, ln_); ss += x32_(ss, ln_); }
                if (fq == 0) part[(size_t)row * 16 + u.pn * 4 + wc] = ss;
            }
          }
        }
    }
};

__device__ __forceinline__ void tr_item(const float* W, int N, const float* g, h16* WT, int ldk, int koff, int k0, int n0, LAS float* scr, int lane) {
#pragma unroll 8
    for (int i = 0; i < 32; ++i) { const int kk = 2 * i + (lane >> 5); float v = W[(size_t)(k0 + kk) * N + n0 + (lane & 31)]; if (g) v *= g[k0 + kk]; scr[kk * 33 + (lane & 31)] = v; }
    asm volatile("s_waitcnt lgkmcnt(0)" ::: "memory");
    const int c = lane & 7;
#pragma unroll
    for (int j = 0; j < 4; ++j) { const int n = (lane >> 3) + 8 * j; const LAS float* s = scr + (8 * c) * 33 + n;
        h16x8 o;
#pragma unroll
        for (int e = 0; e < 8; ++e) o[e] = (h16)s[e * 33];
        *(h16x8*)(WT + (size_t)(n0 + n) * ldk + koff + k0 + 8 * c) = o; }
    asm volatile("s_waitcnt lgkmcnt(0)" ::: "memory");
}
struct TrJob { const float* W; const float* g; h16* WT; int K, N, ldk, koff; };

__device__ __forceinline__ void phase_prep(const Args& a, LAS unsigned char* lds) {
    const int tid = tid_(), lane = tid & 63, wave = tid >> 6;
    const int gw = blockIdx.x * NWAVES + wave, NGW = gridDim.x * NWAVES;
    unsigned char* ws = a.ws;
    {
        LAS float* scr = (LAS float*)(lds + wave * 8704);
        TrJob jobs[9] = {
            {a.in[3], a.in[2], (h16*)(ws + O_WIN), 1024, NIN, 1024, 0},
            {a.in[17], nullptr, (h16*)(ws + O_WA), 512, 1024, 512, 0},
            {a.in[18], nullptr, (h16*)(ws + O_WB), 512, 1024, 512, 0},
            {a.in[19], nullptr, (h16*)(ws + O_WO), 1024, 1024, 1024, 0},
            {a.in[26], a.in[25], (h16*)(ws + O_WG), 1024, 1024, 1024, 0},
            {a.in[27], nullptr, (h16*)(ws + O_WP), 256, 1024, 1024, 0},
            {a.in[8], nullptr, (h16*)(ws + O_WLR), 64, 512, 256, 0},
            {a.in[10], nullptr, (h16*)(ws + O_WLR) + (size_t)512 * 256, 64, 512, 256, 64},
            {a.in[11], nullptr, (h16*)(ws + O_WLR) + (size_t)1024 * 256, 128, 512, 256, 128},
        };
        int base = 0;
#pragma unroll
        for (int j = 0; j < 9; ++j) {
            const TrJob J = jobs[j]; const int nnb = J.N / 32, items = (J.K / 64) * nnb;
            int first = gw - (base % NGW); if (first < 0) first += NGW;
            for (int r = first; r < items; r += NGW) tr_item(J.W, J.N, J.g, J.WT, J.ldk, J.koff, (r / nnb) * 64, (r % nnb) * 32, scr, lane);
            base += items;
        }
        h16* wlr = (h16*)(ws + O_WLR);
        for (int i = blockIdx.x * NTHREADS + tid; i < 1536 * 256 / 8; i += gridDim.x * NTHREADS) {
            const int n = (i * 8) / 256, k = (i * 8) % 256; const int blk = n / 512;
            const bool inblk = (blk == 0) ? (k < 64) : (blk == 1) ? (k >= 64 && k < 128) : (k >= 128);
            if (!inblk) { h16x8 z; for (int e = 0; e < 8; ++e) z[e] = (h16)0.f; *(h16x8*)(wlr + (size_t)i * 8) = z; }
        }
    }
    __syncthreads();
    {
        LAS float* LA = (LAS float*)lds;
        LAS float* LB = (LAS float*)(lds + 64 * 129 * 4);
        const float* wq = a.in[21]; const float* sk = a.in[22]; const float* gf = a.in[20];
        h16* wst = (h16*)(ws + O_WS);
        for (int it = blockIdx.x; it < 256; it += gridDim.x) {
            const int g16 = it >> 4, k0 = (it & 15) * 64;
            for (int i = tid; i < 64 * 128; i += NTHREADS) { const int k = i >> 7, d = i & 127; LA[k * 129 + d] = wq[(size_t)(k0 + k) * 2048 + g16 * 128 + d] * gf[k0 + k]; }
            for (int i = tid; i < 128 * 128; i += NTHREADS) { const int n = i >> 7, d = i & 127; LB[n * 129 + d] = sk[((size_t)g16 * 128 + n) * 128 + d]; }
            __syncthreads();
            const int n = tid & 127, kg = tid >> 7;
            float o[16];
#pragma unroll
            for (int j = 0; j < 16; ++j) o[j] = 0.f;
            for (int d = 0; d < 128; ++d) { const float b = LB[n * 129 + d];
#pragma unroll
                for (int j = 0; j < 16; ++j) o[j] += LA[(kg * 16 + j) * 129 + d] * b; }
            h16x8 o0, o1;
#pragma unroll
            for (int j = 0; j < 8; ++j) { o0[j] = (h16)o[j]; o1[j] = (h16)o[8 + j]; }
            h16* dst = wst + (size_t)(g16 * 128 + n) * 1024 + k0 + kg * 16;
            *(h16x8*)dst = o0; *(h16x8*)(dst + 8) = o1;
            __syncthreads();
        }
    }
    {
        const float* gf = a.in[20];
        f32x4 g4[4];
#pragma unroll
        for (int j = 0; j < 4; ++j) g4[j] = *(const f32x4*)(gf + 16 * lane + 4 * j);
        for (int rq = gw; rq < 2 * 16384; rq += 4 * NGW) {
            f32x4 vv[4][4];
#pragma unroll
            for (int q2 = 0; q2 < 4; ++q2) { const int r = rq + q2 * NGW; if (r < 2 * 16384) { const int tb = r >> 14, e = r & 16383;
                const float* src = (tb ? a.in[24] : a.in[23]) + (size_t)e * 1024 + 16 * lane;
#pragma unroll
                for (int j = 0; j < 4; ++j) vv[q2][j] = *(const f32x4*)(src + 4 * j); } }
#pragma unroll
            for (int q2 = 0; q2 < 4; ++q2) { const int r = rq + q2 * NGW; if (r < 2 * 16384) { const int tb = r >> 14, e = r & 16383;
                f32x4 v[4]; float mx = 0.f;
#pragma unroll
                for (int j = 0; j < 4; ++j) { v[j] = vv[q2][j]; if (!tb) v[j] = v[j] * g4[j];
#pragma unroll
                    for (int c = 0; c < 4; ++c) mx = fmaxf(mx, fabsf(v[j][c])); }
                mx = wave_max(mx);
                mx = fmaxf(mx, 1e-30f);
                const float sc = 127.0f / mx;
                u32x4 q;
#pragma unroll
                for (int j = 0; j < 4; ++j) {
                    const int i0 = __float2int_rn(v[j][0] * sc), i1 = __float2int_rn(v[j][1] * sc), i2 = __float2int_rn(v[j][2] * sc), i3 = __float2int_rn(v[j][3] * sc);
                    q[j] = (unsigned)(i0 & 0xff) | ((unsigned)(i1 & 0xff) << 8) | ((unsigned)(i2 & 0xff) << 16) | ((unsigned)i3 << 24); }
                unsigned char* dst = ws + (tb ? O_V8 : O_U8) + ((size_t)(lane >> 3) * 16384 + e) * 128 + 16 * (lane & 7);
                *(u32x4*)dst = q;
                if (lane == 0) ((float*)(ws + (tb ? O_VSC : O_USC)))[e] = mx * (1.0f / 127.0f); } }
        }
        if (blockIdx.x == 0 && tid < 32) ((unsigned*)(ws + O_CTR))[tid * 64] = 0u;
    }
    {
        const float* x = a.in[0]; h16* xn = (h16*)(ws + O_XN);
#define XN_LOAD(VV, RQ) do { _Pragma("unroll") for (int q = 0; q < 4; ++q) { const int r = (RQ) + q * NGW; if (r < MTOK) { const f32x4* xr = (const f32x4*)(x + (size_t)r * 1024) + lane; \
                _Pragma("unroll") for (int j = 0; j < 4; ++j) VV[q][j] = xr[64 * j]; } } } while (0)
#define XN_COMP(VV, RQ) do { _Pragma("unroll") for (int q = 0; q < 4; ++q) { const int r = (RQ) + q * NGW; if (r < MTOK) { float s = 0.f; \
                _Pragma("unroll") for (int j = 0; j < 4; ++j) s += (VV[q][j][0] * VV[q][j][0] + VV[q][j][1] * VV[q][j][1]) + (VV[q][j][2] * VV[q][j][2] + VV[q][j][3] * VV[q][j][3]); \
                const float rs = rsqrtf(wave_sum(s) * (1.f / 1024.f) + NORM_EPS); \
                h16x4* o = (h16x4*)(xn + (size_t)r * 1024) + lane; \
                _Pragma("unroll") for (int j = 0; j < 4; ++j) o[64 * j] = pack4(VV[q][j] * rs); } } } while (0)
        f32x4 vA[4][4], vB[4][4];
        const int step = 4 * NGW;
        XN_LOAD(vA, gw);
        for (int rq = gw; rq < MTOK; rq += 2 * step) {
            XN_LOAD(vB, rq + step);
            XN_COMP(vA, rq);
            XN_LOAD(vA, rq + 2 * step);
            XN_COMP(vB, rq + step);
        }
#undef XN_LOAD
#undef XN_COMP
    }
}

__device__ __forceinline__ void phase_conv(const Args& a) {
    const int tid = tid_(), lane = tid & 63, wave = tid >> 6;
    const int gw = blockIdx.x * NWAVES + wave, NGW = gridDim.x * NWAVES;
    const h16* zc = (const h16*)(a.ws + O_ZC); h16* ca = (h16*)(a.ws + O_CA);
    const float* cw = a.in[4]; const float* cb = a.in[5];
    float w0[8], w1[8], w2[8], bb[8];
#pragma unroll
    for (int j = 0; j < 8; ++j) { const int c = lane * 8 + j; w0[j] = cw[c]; w1[j] = cw[512 + c]; w2[j] = cw[1024 + c]; bb[j] = cb[c]; }
    for (int run = gw; run < MTOK / 32; run += NGW) {
        const int t0 = run * 32;
        float u1[8], u2[8];
        if ((t0 % SEQ) == 0) {
#pragma unroll
            for (int j = 0; j < 8; ++j) { u1[j] = 0.f; u2[j] = 0.f; }
        } else {
            const h16x8 c1 = *(const h16x8*)(zc + (size_t)(t0 - 1) * 1536 + 512 + lane * 8), x1 = *(const h16x8*)(zc + (size_t)(t0 - 1) * 1536 + 1024 + lane * 8);
            const h16x8 c2 = *(const h16x8*)(zc + (size_t)(t0 - 2) * 1536 + 512 + lane * 8), x2 = *(const h16x8*)(zc + (size_t)(t0 - 2) * 1536 + 1024 + lane * 8);
#pragma unroll
            for (int j = 0; j < 8; ++j) { u1[j] = (float)c1[j] * (float)x1[j]; u2[j] = (float)c2[j] * (float)x2[j]; }
        }
#define CV_LOAD(GB, GC, XI, TB) do { _Pragma("unroll") for (int q = 0; q < 4; ++q) { const h16* zrow = zc + (size_t)((TB) + q) * 1536 + lane * 8; GB[q] = *(const h16x8*)zrow; GC[q] = *(const h16x8*)(zrow + 512); XI[q] = *(const h16x8*)(zrow + 1024); } } while (0)
#define CV_COMP(GB, GC, XI, TB) do { _Pragma("unroll") for (int q = 0; q < 4; ++q) { const int t = (TB) + q; const h16x8 gb = GB[q], gc = GC[q], xi = XI[q]; \
                h16x8 o; \
                _Pragma("unroll") for (int j = 0; j < 8; ++j) { const float u0 = (float)gc[j] * (float)xi[j]; \
                    const float y = w0[j] * u2[j] + w1[j] * u1[j] + w2[j] * u0 + bb[j]; \
                    o[j] = (h16)((float)gb[j] * y); u2[j] = u1[j]; u1[j] = u0; } \
                *(h16x8*)(ca + (size_t)t * 512 + lane * 8) = o; } } while (0)
        h16x8 gbA[4], gcA[4], xiA[4], gbB[4], gcB[4], xiB[4];
        CV_LOAD(gbA, gcA, xiA, t0);
        for (int tb = t0; tb < t0 + 32; tb += 8) {
            CV_LOAD(gbB, gcB, xiB, tb + 4);
            CV_COMP(gbA, gcA, xiA, tb);
            if (tb + 8 < t0 + 32) CV_LOAD(gbA, gcA, xiA, tb + 8);
            CV_COMP(gbB, gcB, xiB, tb + 4);
        }
#undef CV_LOAD
#undef CV_COMP
    }
}


__device__ __forceinline__ float tanhf_(float x) { return 1.0f - 2.0f * __builtin_amdgcn_rcpf(1.0f + __expf(2.0f * x)); }
__device__ __forceinline__ void phase_rwkv_prep(const Args& a) {
    const int tid = tid_(), lane = tid & 63, wave = tid >> 6;
    const int gw = blockIdx.x * NWAVES + wave, NGW = gridDim.x * NWAVES;
    const h16* zr = (const h16*)(a.ws + O_ZR);
    h16* R = (h16*)a.out; h16* KS = R + (size_t)MTOK * 512; h16* V = KS + (size_t)MTOK * 512; h16* KK = V + (size_t)MTOK * 512;
    h16* APR = (h16*)(a.ws + O_APR);
    const float* mu = a.in[6]; const float* k_k = a.in[12];
    float mr[8], mk[8], mv[8], mt[8], kk8[8];
#pragma unroll
    for (int j = 0; j < 8; ++j) { const int c = lane * 8 + j; mr[j] = mu[c]; mk[j] = mu[512 + c]; mv[j] = mu[1024 + c]; mt[j] = mu[1536 + (c & 255)]; kk8[j] = k_k[c]; }
    for (int run = gw; run < MTOK / 32; run += NGW) {
        const int t0 = run * 32;
        float pr[8], pk[8], pv[8], pt[8];
        if ((t0 % SEQ) == 0) {
#pragma unroll
            for (int j = 0; j < 8; ++j) { pr[j] = 0.f; pk[j] = 0.f; pv[j] = 0.f; pt[j] = 0.f; }
        } else {
            const h16* zp = zr + (size_t)(t0 - 1) * 1792 + lane * 8;
            const h16x8 a0 = *(const h16x8*)zp, a1 = *(const h16x8*)(zp + 512), a2 = *(const h16x8*)(zp + 1024), a3 = *(const h16x8*)(zr + (size_t)(t0 - 1) * 1792 + 1536 + (lane & 31) * 8);
#pragma unroll
            for (int j = 0; j < 8; ++j) { pr[j] = (float)a0[j]; pk[j] = (float)a1[j]; pv[j] = (float)a2[j]; pt[j] = (float)a3[j]; }
        }
#define RP_LOAD(A0, A1, A2, A3, TB) do { _Pragma("unroll") for (int q = 0; q < 2; ++q) { const h16* zp = zr + (size_t)((TB) + q) * 1792 + lane * 8; \
                A0[q] = *(const h16x8*)zp; A1[q] = *(const h16x8*)(zp + 512); A2[q] = *(const h16x8*)(zp + 1024); A3[q] = *(const h16x8*)(zr + (size_t)((TB) + q) * 1792 + 1536 + (lane & 31) * 8); } } while (0)
#define RP_COMP(A0, A1, A2, A3, TB) do { _Pragma("unroll") for (int q = 0; q < 2; ++q) { const int t = (TB) + q; const h16x8 a0 = A0[q], a1 = A1[q], a2 = A2[q], a3 = A3[q]; \
            h16x8 orr, ok, ov, okk, ot; float kr[8]; float ss = 0.f; \
            _Pragma("unroll") for (int j = 0; j < 8; ++j) { \
                const float zr_ = (float)a0[j], zk_ = (float)a1[j], zv_ = (float)a2[j], zt_ = (float)a3[j]; \
                const float r = zr_ + mr[j] * (pr[j] - zr_), k = zk_ + mk[j] * (pk[j] - zk_), v = zv_ + mv[j] * (pv[j] - zv_), tl = zt_ + mt[j] * (pt[j] - zt_); \
                pr[j] = zr_; pk[j] = zk_; pv[j] = zv_; pt[j] = zt_; \
                orr[j] = (h16)r; ok[j] = (h16)k; ov[j] = (h16)v; \
                kr[j] = k * kk8[j]; ss += kr[j] * kr[j]; \
                  \
                const float rc = __builtin_amdgcn_rcpf(1.0f + __expf(tsc * tl)); \
                const float tv = (lane < 8) ? (1.0f - 2.0f * rc) : (lane < 16) ? tl : rc; \
                ot[j] = (h16)tv; \
            } \
            ss += dpp_<0xB1>(ss); ss += dpp_<0x4E>(ss); ss += xhm_(ss);     \
            const float rn = rsqrtf(ss + 1e-12f); \
            _Pragma("unroll") for (int j = 0; j < 8; ++j) okk[j] = (h16)(kr[j] * rn); \
            const size_t o = (size_t)t * 512 + lane * 8; \
            *(h16x8*)(R + o) = orr; *(h16x8*)(KS + o) = ok; *(h16x8*)(V + o) = ov; *(h16x8*)(KK + o) = okk; \
            if (lane < 32) *(h16x8*)(APR + (size_t)t * 256 + lane * 8) = ot; } } while (0)
        const float tsc = (lane < 8) ? 2.0f : -1.0f;
        h16x8 a0A[2], a1A[2], a2A[2], a3A[2], a0B[2], a1B[2], a2B[2], a3B[2];
        RP_LOAD(a0A, a1A, a2A, a3A, t0);
        for (int tb = t0; tb < t0 + 32; tb += 4) {
            RP_LOAD(a0B, a1B, a2B, a3B, tb + 2);
            RP_COMP(a0A, a1A, a2A, a3A, tb);
            if (tb + 4 < t0 + 32) RP_LOAD(a0A, a1A, a2A, a3A, tb + 4);
            RP_COMP(a0B, a1B, a2B, a3B, tb + 2);
        }
#undef RP_LOAD
#undef RP_COMP
    }
}

struct EpiLR {
    static constexpr bool TWO_PART = false;
    const float *w0, *a0, *k_a; h16 *WD, *KS, *BD, *GG; const h16* KK;
    __device__ __forceinline__ void operator()(AccRef acc, const Unit& u, int wr, int wc, int fr, int fq) const {
        const int part = u.pn >> 1;
        EPI_LOOP_BEGIN
            const int c = col - part * 512; const size_t o = (size_t)row * 512 + c;
            if (part == 0) {
                const f32x4 b0 = *(const f32x4*)(w0 + c), b1 = *(const f32x4*)(w0 + c + 4); f32x4 o0, o1;
#pragma unroll
                for (int j = 0; j < 4; ++j) { o0[j] = __expf(-0.6065306597126334f * sigmoidf_(b0[j] + v0[j])); o1[j] = __expf(-0.6065306597126334f * sigmoidf_(b1[j] + v1[j])); }
                *(h16x8*)(WD + o) = pack8(o0, o1);
            } else if (part == 1) {
                const f32x4 b0 = *(const f32x4*)(a0 + c), b1 = *(const f32x4*)(a0 + c + 4), ka0 = *(const f32x4*)(k_a + c), ka1 = *(const f32x4*)(k_a + c + 4);
                const h16x8 ks = *(const h16x8*)(KS + o), kk = *(const h16x8*)(KK + o); f32x4 k0, k1, bb0, bb1;
#pragma unroll
                for (int j = 0; j < 4; ++j) { const float aa0 = sigmoidf_(b0[j] + v0[j]), aa1 = sigmoidf_(b1[j] + v1[j]);
                    k0[j] = (float)ks[j] * (1.0f + (aa0 - 1.0f) * ka0[j]); k1[j] = (float)ks[4 + j] * (1.0f + (aa1 - 1.0f) * ka1[j]);
                    bb0[j] = aa0 * (float)kk[j]; bb1[j] = aa1 * (float)kk[4 + j]; }
                *(h16x8*)(KS + o) = pack8(k0, k1); *(h16x8*)(BD + o) = pack8(bb0, bb1);
            } else {
                *(h16x8*)(GG + o) = pack8(v0, v1);
            }
        EPI_LOOP_END
    }
};

constexpr size_t O_VTB = O_ZR;
constexpr size_t O_BON = O_ZR + 64 * MiB;
constexpr int UT_WAVE_LDS = 15360;
typedef float f32x16 __attribute__((ext_vector_type(16)));
__device__ __forceinline__ size_t ut_ov(int j, int s) { return (size_t)(j >> 2) * 512 + (j & 3) * 16 + s; }
constexpr int UT_SEG = 8, UT_SEGB = SEQ / 16 / UT_SEG;
__device__ __forceinline__ void phase_ut_pre(const Args& a, LAS unsigned char* lds, int seg, int gw, int NGW) {
    const int tid = tid_(), lane = tid & 63, wave = tid >> 6;
    LAS unsigned char* Lb = lds + wave * UT_WAVE_LDS;
    LAS h16* YX = (LAS h16*)Lb;
    LAS float* GT = (LAS float*)(Lb + 9216);
    LAS float* TM = (LAS float*)(Lb + 13824);
    h16* R = (h16*)a.out; h16* KS = R + (size_t)MTOK * 512; h16* V = KS + (size_t)MTOK * 512; h16* KK = V + (size_t)MTOK * 512;
    h16* WD = (h16*)(a.ws + O_WD); h16* BD = (h16*)(a.ws + O_BD);
    h16* VTB = (h16*)(a.ws + O_VTB); float* BON = (float*)(a.ws + O_BON);
    for (int wi = gw; wi < 32768 / UT_SEG; wi += NGW) {
        const int bh = ((((wi / (UT_SEGB * 8)) * (SEQ / 16)) + seg * UT_SEGB + ((wi % (UT_SEGB * 8)) >> 3)) << 3) | (wi & 7);
        int ln = lane; asm volatile("" : "+v"(ln)); const int r16 = ln & 15;
        const int h = bh & 7, nb = bh >> 3; const size_t tok0 = (size_t)nb * 16; const size_t e0 = tok0 * 512 + h * 64;
        const float rk = a.in[14][h * 64 + lane];
        {
            h16x8 stg[12];
#pragma unroll
            for (int j = 0; j < 12; ++j) { const int ar = j >> 1, row = (lane >> 3) + 8 * (j & 1);
                const h16* base = (ar == 0) ? WD : (ar == 1) ? KK : (ar == 2) ? BD : (ar == 3) ? KS : (ar == 4) ? R : V;
                stg[j] = *(const h16x8*)(base + e0 + (size_t)row * 512 + (lane & 7) * 8); }
#pragma unroll
            for (int j = 0; j < 12; ++j) *(LAS h16x8*)((LAS h16*)Lb + ((j >> 1) * 16 + (lane >> 3) + 8 * (j & 1)) * 64 + (lane & 7) * 8) = stg[j];
            asm volatile("s_waitcnt lgkmcnt(0)" ::: "memory");
        }
        float w[16], kk[16], bb[16], kx[16], rr[16]; h16x8 vt0, vt1;
        { const LAS h16* IN = (const LAS h16*)Lb;
#pragma unroll
        for (int t = 0; t < 16; ++t) { w[t] = (float)IN[t * 64 + lane]; kk[t] = (float)IN[(16 + t) * 64 + lane]; bb[t] = (float)IN[(32 + t) * 64 + lane]; kx[t] = (float)IN[(48 + t) * 64 + lane]; rr[t] = (float)IN[(64 + t) * 64 + lane];
            if (t < 8) vt0[t] = IN[(80 + t) * 64 + lane]; else vt1[t - 8] = IN[(80 + t) * 64 + lane]; } }
        asm volatile("s_waitcnt lgkmcnt(0)" ::: "memory");
        { h16* vp = VTB + (size_t)bh * 1024 + lane * 16; *(h16x8*)vp = vt0; *(h16x8*)(vp + 8) = vt1; }
        {
            float q8[8], q4[4], q2[2];
#pragma unroll
            for (int i = 0; i < 8; ++i) q8[i] = swap_add32(rr[i] * kx[i] * rk, rr[i + 8] * kx[i + 8] * rk);
#pragma unroll
            for (int i = 0; i < 4; ++i) q4[i] = swap_add16(q8[i], q8[i + 4]);
#pragma unroll
            for (int i = 0; i < 2; ++i) { const float keep = (ln & 8) ? q4[i + 2] : q4[i], send = (ln & 8) ? q4[i] : q4[i + 2]; q2[i] = keep + x8_(send); }
            const float keep = (ln & 4) ? q2[1] : q2[0], send = (ln & 4) ? q2[0] : q2[1];
            float bonv = keep + xhm_(send);
            bonv += dpp_<0xB1>(bonv); bonv += dpp_<0x4E>(bonv);
            if ((lane & 3) == 0) BON[(tok0 + (lane >> 2)) * 8 + h] = bonv;
        }
        float Lt[16]; { float Lc = 0.f;
#pragma unroll
            for (int t = 0; t < 16; ++t) { Lc += __logf(w[t]); Lt[t] = Lc; } }
        const float Lref = Lt[7];
        float btil[16]; h16x8 kt0, kt1;
        LAS h16* OS = (LAS h16*)(Lb + 9216);
#pragma unroll
        for (int t = 0; t < 16; ++t) {
            const float Lp = t ? Lt[t - 1] : 0.f;
            const float ka = kk[t] * __expf(Lp - Lref), rt = rr[t] * __expf(Lt[t] - Lref), e2 = __expf(Lref - Lt[t]), bt = bb[t] * e2, kt = kx[t] * e2;
            YX[t * 72 + lane] = (h16)ka; YX[(16 + t) * 72 + lane] = (h16)rt; YX[(32 + t) * 72 + lane] = (h16)kt; YX[(48 + t) * 72 + lane] = (h16)bt;
            btil[t] = bt;
            OS[t * 64 + lane] = (h16)(kk[t] * __expf(Lp)); OS[(16 + t) * 64 + lane] = (h16)(rr[t] * __expf(Lt[t]));
            const float ktp = kx[t] * __expf(Lt[15] - Lt[t]);
            if (t < 8) kt0[t] = (h16)ktp; else kt1[t - 8] = (h16)ktp;
        }
        const float post = __expf(Lt[15] - Lref), w16 = __expf(Lt[15]);
        { h16* kp = KS + e0 + ut_ov(lane, 0); *(h16x8*)kp = kt0; *(h16x8*)(kp + 8) = kt1; }
        asm volatile("s_waitcnt lgkmcnt(0)" ::: "memory");
#pragma unroll
        for (int j = 0; j < 4; ++j) { const int row = (lane >> 3) + 8 * (j & 1); const h16x8 o8 = *(const LAS h16x8*)(OS + ((j >> 1) * 16 + row) * 64 + (lane & 7) * 8);
            *(h16x8*)(((j >> 1) ? R : KK) + e0 + (size_t)row * 512 + (lane & 7) * 8) = o8; }
        asm volatile("s_waitcnt lgkmcnt(0)" ::: "memory");
        f32x16 acc;
#pragma unroll
        for (int i = 0; i < 16; ++i) acc[i] = 0.f;
#pragma unroll
        for (int ks = 0; ks < 4; ++ks) {
            const h16x8 af = *(const LAS h16x8*)(YX + (lane & 31) * 72 + 8 * (lane >> 5) + 16 * ks), bf = *(const LAS h16x8*)(YX + (32 + (lane & 31)) * 72 + 8 * (lane >> 5) + 16 * ks);
            acc = __builtin_amdgcn_mfma_f32_32x32x16_f16(af, bf, acc, 0, 0, 0);
        }
#pragma unroll
        for (int i = 0; i < 16; ++i) GT[((i & 3) + 8 * (i >> 2) + 4 * (lane >> 5)) * 36 + (lane & 31)] = acc[i];
        asm volatile("s_waitcnt lgkmcnt(0)" ::: "memory");
        float T[16];
#pragma unroll
        for (int t = 0; t < 16; ++t) { float v = (r16 == t) ? 1.f : 0.f;
#pragma unroll
            for (int s2 = 0; s2 < t; ++s2) v -= T[s2] * GT[t * 36 + 16 + s2];
            T[t] = v; }
#pragma unroll
        for (int t = 0; t < 16; ++t) TM[r16 * 20 + t] = T[t];
        asm volatile("s_waitcnt lgkmcnt(0)" ::: "memory");
        float bcol[16];
#pragma unroll
        for (int s2 = 0; s2 < 16; ++s2) bcol[s2] = (s2 <= r16) ? GT[(16 + r16) * 36 + 16 + s2] : 0.f;
        h16x8 tb0, tb1, tp0, tp1;
#pragma unroll
        for (int r = 0; r < 16; ++r) { float s0 = 0.f, s1 = 0.f;
#pragma unroll
            for (int s2 = r; s2 < 16; ++s2) { const float tv = TM[r * 20 + s2]; s0 += tv * btil[s2]; s1 += tv * bcol[s2]; }
            s0 *= post;
            if (r < 8) { tb0[r] = (h16)s0; tp0[r] = (h16)s1; } else { tb1[r - 8] = (h16)s0; tp1[r - 8] = (h16)s1; } }
        { h16* bp = BD + e0 + ut_ov(lane, 0); *(h16x8*)bp = tb0; *(h16x8*)(bp + 8) = tb1; }
        if (lane < 16) {
            h16x8 a0, a1, p0, p1;
#pragma unroll
            for (int s2 = 0; s2 < 16; ++s2) { const float av = (s2 < ln) ? GT[ln * 36 + s2] : 0.f, pv = (s2 <= ln) ? GT[(16 + ln) * 36 + s2] : 0.f;
                if (s2 < 8) { a0[s2] = (h16)av; p0[s2] = (h16)pv; } else { a1[s2 - 8] = (h16)av; p1[s2 - 8] = (h16)pv; } }
            h16* ap = WD + e0 + (size_t)(lane >> 2) * 512 + (lane & 3) * 16;
            *(h16x8*)ap = a0; *(h16x8*)(ap + 8) = a1;
            *(h16x8*)(ap + 4 * 512) = p0; *(h16x8*)(ap + 4 * 512 + 8) = p1;
            *(h16x8*)(ap + 8 * 512) = tp0; *(h16x8*)(ap + 8 * 512 + 8) = tp1;
        }
        (WD + e0 + (size_t)12 * 512)[lane] = (h16)w16;
        asm volatile("s_waitcnt lgkmcnt(0)" ::: "memory");
    }
}
struct UtOps { u32x2 ka[2][2], rt[2][2], kt[4], tb[4], at, apt, tp, vb, w16[4]; };
struct UtRes { __amdgpu_buffer_rsrc_t kk, r, ks, bd, wd, vt, y; };
__device__ __forceinline__ void ut_load(UtOps& o, const UtRes& R, int so, unsigned offK, unsigned offT, unsigned offV, unsigned offF) {
#pragma unroll
    for (int ks = 0; ks < 2; ++ks)
#pragma unroll
        for (int p = 0; p < 2; ++p) { o.ka[ks][p] = __builtin_amdgcn_raw_buffer_load_b64(R.kk, offK + 64u * ks + 32u * p, so, 0); o.rt[ks][p] = __builtin_amdgcn_raw_buffer_load_b64(R.r, offK + 64u * ks + 32u * p, so, 0); }
#pragma unroll
    for (int kt = 0; kt < 4; ++kt) { o.kt[kt] = __builtin_amdgcn_raw_buffer_load_b64(R.ks, offT + 4096u * kt, so, 0); o.tb[kt] = __builtin_amdgcn_raw_buffer_load_b64(R.bd, offT + 4096u * kt, so, 0); }
    o.at = __builtin_amdgcn_raw_buffer_load_b64(R.wd, offT, so, 0); o.apt = __builtin_amdgcn_raw_buffer_load_b64(R.wd, offT + 4096u, so, 0); o.tp = __builtin_amdgcn_raw_buffer_load_b64(R.wd, offT + 8192u, so, 0);
    o.vb = __builtin_amdgcn_raw_buffer_load_b64(R.vt, offV, so, 0);
#pragma unroll
    for (int kt = 0; kt < 4; ++kt) o.w16[kt] = __builtin_amdgcn_raw_buffer_load_b64(R.wd, offF + 12u * 1024u + 32u * kt, so, 0);
}
__device__ __forceinline__ f32x4 h4f(u32x2 v) { const h16x4 h = __builtin_bit_cast(h16x4, v); return (f32x4){(float)h[0], (float)h[1], (float)h[2], (float)h[3]}; }
__device__ __forceinline__ h16x8 cat8(u32x2 lo, u32x2 hi) { u32x4 r; r[0] = lo[0]; r[1] = lo[1]; r[2] = hi[0]; r[3] = hi[1]; return __builtin_bit_cast(h16x8, r); }
__device__ __forceinline__ void ut_block(const UtOps& o, f32x4 (&S)[4], const UtRes& R, unsigned offY, int so) {
    const f32x4 zf = (f32x4){0.f, 0.f, 0.f, 0.f}; const u32x2 zu = (u32x2){0u, 0u};
    const h16x8 sb0 = pack8(S[0], S[1]), sb1 = pack8(S[2], S[3]);
    const h16x8 vb = cat8(o.vb, zu);
    f32x4 x1 = zf, y = zf;
    x1 = __builtin_amdgcn_mfma_f32_16x16x32_f16(cat8(o.ka[0][0], o.ka[0][1]), sb0, x1, 0, 0, 0); y = __builtin_amdgcn_mfma_f32_16x16x32_f16(cat8(o.rt[0][0], o.rt[0][1]), sb0, y, 0, 0, 0);
    x1 = __builtin_amdgcn_mfma_f32_16x16x32_f16(cat8(o.ka[1][0], o.ka[1][1]), sb1, x1, 0, 0, 0); y = __builtin_amdgcn_mfma_f32_16x16x32_f16(cat8(o.rt[1][0], o.rt[1][1]), sb1, y, 0, 0, 0);
    x1 = __builtin_amdgcn_mfma_f32_16x16x32_f16(cat8(o.at, zu), vb, x1, 0, 0, 0); y = __builtin_amdgcn_mfma_f32_16x16x32_f16(cat8(o.apt, zu), vb, y, 0, 0, 0);
    f32x4 St[4];
#pragma unroll
    for (int kt = 0; kt < 4; ++kt) St[kt] = __builtin_amdgcn_mfma_f32_16x16x32_f16(cat8(o.kt[kt], zu), vb, S[kt] * h4f(o.w16[kt]), 0, 0, 0);
    const h16x8 xb = pack8(-x1, zf);
    y = __builtin_amdgcn_mfma_f32_16x16x32_f16(cat8(o.tp, zu), xb, y, 0, 0, 0);
#pragma unroll
    for (int kt = 0; kt < 4; ++kt) S[kt] = __builtin_amdgcn_mfma_f32_16x16x32_f16(cat8(o.tb[kt], zu), xb, St[kt], 0, 0, 0);
#pragma unroll
    for (int rg = 0; rg < 4; ++rg) { const h16 hv = (h16)y[rg]; __builtin_amdgcn_raw_buffer_store_b16(__builtin_bit_cast(unsigned short, hv), R.y, offY + 1024u * rg, so, 0); }
}
constexpr int UT_RING = 4;
static_assert(UT_SEGB % 4 == 0, "the loader rotates four operand sets");
__device__ __forceinline__ LAS unsigned char* ut_slot(LAS unsigned char* lds, unsigned s) { return lds + (s < 2u ? 64u + s * 12288u : 131072u + 128u + (s - 2u) * 12288u); }
#define UT_FIELDS(F) F(0, ka[0][0]) F(1, ka[0][1]) F(2, ka[1][0]) F(3, ka[1][1]) F(4, rt[0][0]) F(5, rt[0][1]) F(6, rt[1][0]) F(7, rt[1][1]) F(8, kt[0]) F(9, kt[1]) F(10, kt[2]) F(11, kt[3]) \
    F(12, tb[0]) F(13, tb[1]) F(14, tb[2]) F(15, tb[3]) F(16, at) F(17, apt) F(18, tp) F(19, vb) F(20, w16[0]) F(21, w16[1]) F(22, w16[2]) F(23, w16[3])
__device__ __forceinline__ void ut_put(const UtOps& o, LAS unsigned char* sl, int lane) {
    LAS u32x2* p = (LAS u32x2*)(sl + lane * 8);
#define UT_F(i, f) p[(i) * 64] = o.f;
    UT_FIELDS(UT_F)
#undef UT_F
}
__device__ __forceinline__ void ut_get(UtOps& o, const LAS unsigned char* sl, int lane) {
    const LAS u32x2* p = (const LAS u32x2*)(sl + lane * 8);
#define UT_F(i, f) o.f = p[(i) * 64];
    UT_FIELDS(UT_F)
#undef UT_F
}
__device__ __forceinline__ void phase_ut_seq(const Args& a, LAS unsigned char* lds, int seg) {
    const int tid = tid_(), lane = tid & 63, wave = tid >> 6, fr = lane & 15, fq = lane >> 4;
    if (wave > 1) return;
    volatile LAS unsigned* prodp = (volatile LAS unsigned*)(lds + 131072 + 32);
    volatile LAS unsigned* consp = (volatile LAS unsigned*)(lds + 131072 + 48);
    unsigned base = wave ? *prodp : *consp;
    const int nb0 = seg * UT_SEGB;
    for (int item = blockIdx.x; item < 256; item += gridDim.x, base += UT_SEGB) {
        const int h = item & 7, q = item >> 3, g = q & 3, b = q >> 2;
        const size_t e0 = ((size_t)b * SEQ * 512 + h * 64) * 2 + (size_t)nb0 * 16384;
        const char* Rb = (const char*)a.out + e0; const char* KSb = Rb + (size_t)MTOK * 1024; const char* KKb = Rb + (size_t)3 * MTOK * 1024;
        const char* WDb = (const char*)(a.ws + O_WD) + e0; const char* BDb = (const char*)(a.ws + O_BD) + e0;
        const char* VTb = (const char*)(a.ws + O_VTB) + ((size_t)b * (SEQ / 16) * 8 + h) * 2048 + (size_t)nb0 * 16384;
        const unsigned offK = (unsigned)(fr * 1024 + 8 * fq), offT = (unsigned)((fr >> 2) * 512 + (fr & 3) * 16 + 4 * fq) * 2u, offV = (unsigned)((16 * g + fr) * 16 + 4 * fq) * 2u, offF = (unsigned)fq * 8u,
                       offY = (unsigned)((4 * fq) * 512 + 16 * g + fr) * 2u;
        UtRes RS; RS.kk = mkrsrc(KKb); RS.r = mkrsrc(Rb); RS.ks = mkrsrc(KSb); RS.bd = mkrsrc(BDb); RS.wd = mkrsrc(WDb); RS.vt = mkrsrc(VTb);
        RS.y = mkrsrc((const char*)(a.ws + O_Y) + e0);
#define UT_LD(o, nn) ut_load(o, RS, ((nn) < UT_SEGB ? (nn) : UT_SEGB - 1) * 16384, offK, offT, offV, offF)
        if (wave == 1) {
#define UT_PUT(o, nn) do { const unsigned gc = base + (unsigned)(nn); int guard = 0; \
                while ((int)(gc - *consp) >= UT_RING && ++guard < (1 << 24)) __builtin_amdgcn_s_sleep(1); \
                asm volatile("" ::: "memory"); ut_put(o, ut_slot(lds, gc % UT_RING), lane); \
                asm volatile("s_waitcnt lgkmcnt(0)" ::: "memory"); if (lane == 0) *prodp = gc + 1u; } while (0)
            UtOps l0, l1, l2, l3;
            UT_LD(l0, 0); UT_LD(l1, 1); UT_LD(l2, 2); UT_LD(l3, 3);
#pragma unroll 1
            for (int n = 0; n < UT_SEGB; n += 4) {
                UT_PUT(l0, n);     UT_LD(l0, n + 4);
                UT_PUT(l1, n + 1); UT_LD(l1, n + 5);
                UT_PUT(l2, n + 2); UT_LD(l2, n + 6);
                UT_PUT(l3, n + 3); UT_LD(l3, n + 7);
            }
#undef UT_PUT
            continue;
        }
        f32x4* sst = (f32x4*)(a.ws + O_SST2) + ((size_t)item * 64 + lane) * 4;
        f32x4 S[4];
#pragma unroll
        for (int kt = 0; kt < 4; ++kt) S[kt] = seg ? sst[kt] : (f32x4){0.f, 0.f, 0.f, 0.f};
#define UT_GET(o, nn) do { const unsigned gc = base + (unsigned)(nn); int guard = 0; \
            while ((int)(*prodp - gc) < 1 && ++guard < (1 << 24)) __builtin_amdgcn_s_sleep(0); \
            asm volatile("" ::: "memory"); ut_get(o, ut_slot(lds, gc % UT_RING), lane); } while (0)
#define UT_DONE(nn) do { asm volatile("s_waitcnt lgkmcnt(0)" ::: "memory"); if (lane == 0) *consp = base + (unsigned)(nn) + 1u; } while (0)
        UtOps oa, ob;
        UT_GET(oa, 0);
#pragma unroll 1
        for (int n = 0; n < UT_SEGB; n += 2) {
            UT_DONE(n);     UT_GET(ob, n + 1);                          ut_block(oa, S, RS, offY, n * 16384);
            UT_DONE(n + 1); if (n + 2 < UT_SEGB) UT_GET(oa, n + 2);     ut_block(ob, S, RS, offY, (n + 1) * 16384);
        }
#undef UT_GET
#undef UT_DONE
#undef UT_LD
#pragma unroll
        for (int kt = 0; kt < 4; ++kt) sst[kt] = S[kt];
    }
}
constexpr int POST_EARLY = 2;
__device__ __forceinline__ void phase_rwkv_post(const Args& a, int s0, int s1, int gw, int NGW);
__device__ __forceinline__ void phase_ut_step(const Args& a, LAS unsigned char* lds, int st) {
    const int wave = tid_() >> 6;
    if (st >= 1 && wave <= 1) { phase_ut_seq(a, lds, st - 1); return; }
    if (st < UT_SEG) { if (st == 0) phase_ut_pre(a, lds, st, blockIdx.x * NWAVES + wave, gridDim.x * NWAVES); else phase_ut_pre(a, lds, st, blockIdx.x * 6 + (wave - 2), gridDim.x * 6); }
    else phase_rwkv_post(a, 0, POST_EARLY, blockIdx.x * 6 + (wave - 2), gridDim.x * 6);
}

__device__ __forceinline__ void phase_rwkv_post(const Args& a, int s0, int s1, int gw, int NGW) {
    const int lane = tid_() & 63;
    const int per = (s1 - s0) * (SEQ / UT_SEG), NT = (MTOK / SEQ) * per;
    const h16* V = (const h16*)a.out + (size_t)2 * MTOK * 512;
    const h16* GG = (const h16*)(a.ws + O_GG); const h16* Y = (const h16*)(a.ws + O_Y); h16* YB = (h16*)(a.ws + O_YB); const float* BON = (const float*)(a.ws + O_BON);
    float lg[8], lb[8];
#pragma unroll
    for (int j = 0; j < 8; ++j) { const int c = lane * 8 + j; lg[j] = a.in[15][c]; lb[j] = a.in[16][c]; }
#define PO_LOAD(Y8, V8, G8, BS, TV, TQ) do { _Pragma("unroll") for (int q = 0; q < 4; ++q) { const int n = (TQ) + q * NGW; if (n < NT) { const int bq = n / per, t = bq * SEQ + s0 * (SEQ / UT_SEG) + (n - bq * per); TV[q] = t; \
            const size_t o = (size_t)t * 512 + lane * 8; Y8[q] = *(const h16x8*)(Y + o); V8[q] = *(const h16x8*)(V + o); G8[q] = *(const h16x8*)(GG + o); BS[q] = BON[(size_t)t * 8 + (lane >> 3)]; } } } while (0)
#define PO_COMP(Y8, V8, G8, BS, TV, TQ) do { _Pragma("unroll") for (int q = 0; q < 4; ++q) { const int n = (TQ) + q * NGW; if (n < NT) { const int t = TV[q]; const size_t o = (size_t)t * 512 + lane * 8; \
            const h16x8 y8 = Y8[q], v8 = V8[q], g8 = G8[q]; const float bs = BS[q]; \
            float y[8]; float sm = 0.f; \
            _Pragma("unroll") for (int j = 0; j < 8; ++j) { y[j] = (float)y8[j]; sm += y[j]; } \
            sm += dpp_<0xB1>(sm); sm += dpp_<0x4E>(sm); sm += dpp_<0x141>(sm); \
            const float mean = sm * (1.f / 64.f); float vs = 0.f; \
            _Pragma("unroll") for (int j = 0; j < 8; ++j) { y[j] -= mean; vs += y[j] * y[j]; } \
            vs += dpp_<0xB1>(vs); vs += dpp_<0x4E>(vs); vs += dpp_<0x141>(vs); \
            const float rstd = rsqrtf(vs * (1.f / 64.f) + 64e-5f); \
            h16x8 ov; \
            _Pragma("unroll") for (int j = 0; j < 8; ++j) ov[j] = (h16)((y[j] * rstd * lg[j] + lb[j] + bs * (float)v8[j]) * (float)g8[j]); \
            *(h16x8*)(YB + o) = ov; } } } while (0)
    h16x8 yA[4], vA[4], gA[4], yB[4], vB[4], gB[4]; float bA[4], bB[4]; int tA[4], tB[4];
    const int step = 4 * NGW;
    PO_LOAD(yA, vA, gA, bA, tA, gw);
    for (int tq = gw; tq < NT; tq += 2 * step) {
        PO_LOAD(yB, vB, gB, bB, tB, tq + step);
        PO_COMP(yA, vA, gA, bA, tA, tq);
        PO_LOAD(yA, vA, gA, bA, tA, tq + 2 * step);
        PO_COMP(yB, vB, gB, bB, tB, tq + step);
    }
#undef PO_LOAD
#undef PO_COMP
}

__device__ __forceinline__ void ins16(unsigned (&L)[16], unsigned x) {
#pragma unroll
    for (int j = 0; j < 16; ++j) { const unsigned hi = L[j] > x ? L[j] : x; x = L[j] > x ? x : L[j]; L[j] = hi; }
}
#define TK_CE(a, b) do { const unsigned hi_ = (a) > (b) ? (a) : (b); (b) = (a) > (b) ? (b) : (a); (a) = hi_; } while (0)
__device__ __forceinline__ void sort16_desc(unsigned (&v)[16]) {
#pragma unroll
    for (int p = 1; p < 16; p <<= 1)
#pragma unroll
        for (int k = p; k >= 1; k >>= 1)
#pragma unroll
            for (int j = k % p; j + k < 16; j += 2 * k)
#pragma unroll
                for (int i = 0; i < k; ++i) if (i + j + k < 16 && (i + j) / (2 * p) == (i + j + k) / (2 * p)) TK_CE(v[i + j], v[i + j + k]);
}
__device__ __forceinline__ void merge_top16(unsigned (&t)[16], const unsigned (&g)[16]) {
#pragma unroll
    for (int i = 0; i < 16; ++i) t[i] = t[i] > g[15 - i] ? t[i] : g[15 - i];
#pragma unroll
    for (int j = 8; j > 0; j >>= 1)
#pragma unroll
        for (int i = 0; i < 16; ++i) { const int l = i ^ j; if (l > i) TK_CE(t[i], t[l]); }
}
__device__ __forceinline__ unsigned ord32(float f) { const unsigned u = __float_as_uint(f); return (u & 0x80000000u) ? ~u : (u | 0x80000000u); }
__device__ __forceinline__ float unord32(unsigned k) { return __uint_as_float((k & 0x80000000u) ? (k & 0x7fffffffu) : ~k); }
__device__ __forceinline__ void phase_topk(const Args& a, LAS unsigned char* lds) {
    const int tid = tid_();
    const h16* SC = (const h16*)(a.ws + O_SCORES);
    const float* part = (const float*)(a.ws + O_PART1);
    unsigned short* IDX = (unsigned short*)(a.ws + O_IDX); h16* GATE = (h16*)(a.ws + O_GATE); float* RS1 = (float*)(a.ws + O_RS1);
    LAS unsigned char* LI = lds;
    for (int task = blockIdx.x * NTHREADS + tid; task < MTOK * 8; task += gridDim.x * NTHREADS) {
        const int t = task >> 3, h = task & 7;
        float ssq = 0.f;
#pragma unroll
        for (int j = 0; j < 4; ++j) { const f32x4 p4 = *(const f32x4*)(part + (size_t)t * 16 + 4 * j); ssq += (p4[0] + p4[1]) + (p4[2] + p4[3]); }
        const float rs = rsqrtf(ssq * (1.f / 1024.f) + NORM_EPS);
        if (h == 0) RS1[t] = rs;
        float sv[2][16];
#pragma unroll
        for (int c = 0; c < 2; ++c) {
            unsigned L[16];
#pragma unroll
            for (int j = 0; j < 16; ++j) L[j] = 0u;
            const h16* row = SC + (size_t)t * 2048 + h * 256 + c * 128;
#pragma unroll 1
            for (int ln = 0; ln < 2; ++ln) {
                u32x4 raw[8];
#pragma unroll
                for (int k = 0; k < 8; ++k) raw[k] = *(const u32x4*)(row + ln * 64 + k * 8);
#pragma unroll
                for (int g4 = 0; g4 < 4; ++g4) {
                    unsigned Gk[16];
#pragma unroll
                    for (int hh = 0; hh < 2; ++hh) { const u32x4 w4 = raw[2 * g4 + hh];
#pragma unroll
                        for (int d = 0; d < 4; ++d) {
                            const unsigned w = w4[d];
                            const unsigned sf = __builtin_bit_cast(unsigned, __builtin_bit_cast(s16x2, w) >> 15);
                            const unsigned o = w ^ (sf | 0x80008000u);
                            const int p0 = ln * 64 + g4 * 16 + hh * 8 + 2 * d;
                            Gk[hh * 8 + 2 * d] = (o << 16) | (unsigned)(127 - p0); Gk[hh * 8 + 2 * d + 1] = (o & 0xffff0000u) | (unsigned)(126 - p0); } }
                    sort16_desc(Gk);
                    merge_top16(L, Gk);
                }
            }
#pragma unroll
            for (int j = 0; j < 16; ++j) {
                const unsigned o16 = L[j] >> 16; const unsigned bits = (o16 & 0x8000u) ? (o16 & 0x7fffu) : (~o16 & 0xffffu);
                union { unsigned short u; h16 f; } cv; cv.u = (unsigned short)bits; sv[c][j] = (float)cv.f;
                LI[(c * 16 + j) * 512 + tid] = (unsigned char)(127u - (L[j] & 127u));
            }
        }
        unsigned L[16], G1[16], G2[16], X0 = 0u, X1 = 0u;
        { int cnt = 0;
#pragma unroll
          for (int i = 0; i < 16; ++i)
#pragma unroll
            for (int j = 0; j < 16; ++j) if ((i + 1) * (j + 1) <= 16) {
                const unsigned key = (ord32(sv[0][i] + sv[1][j]) & ~255u) | (unsigned)(255 - (i * 16 + j));
                if (cnt < 16) L[cnt] = key; else if (cnt < 32) G1[cnt - 16] = key; else if (cnt < 48) G2[cnt - 32] = key; else if (cnt == 48) X0 = key; else X1 = key;
                ++cnt; } }
        sort16_desc(L); sort16_desc(G1); sort16_desc(G2); merge_top16(L, G1); merge_top16(L, G2);
        { TK_CE(X0, X1); unsigned G3[16];
#pragma unroll
          for (int j = 0; j < 16; ++j) G3[j] = 0u;
          G3[0] = X0; G3[1] = X1; merge_top16(L, G3); }
        float e[16]; float den = 0.f; const float mx = unord32(L[0] & ~255u) * rs;
        unsigned short id[16];
#pragma unroll
        for (int k = 0; k < 16; ++k) {
            const float v = unord32(L[k] & ~255u) * rs; e[k] = __expf(v - mx); den += e[k];
            const unsigned pos = 255u - (L[k] & 255u); const unsigned i = pos >> 4, j = pos & 15u;
            id[k] = (unsigned short)((unsigned)LI[i * 512 + tid] * 128u + (unsigned)LI[(16 + j) * 512 + tid]);
        }
        const float inv = __builtin_amdgcn_rcpf(den);
        u32x4 i0, i1;
        i0[0] = id[0] | (id[1] << 16); i0[1] = id[2] | (id[3] << 16); i0[2] = id[4] | (id[5] << 16); i0[3] = id[6] | (id[7] << 16);
        i1[0] = id[8] | (id[9] << 16); i1[1] = id[10] | (id[11] << 16); i1[2] = id[12] | (id[13] << 16); i1[3] = id[14] | (id[15] << 16);
        u32x4* ip = (u32x4*)(IDX + (size_t)task * 16); ip[0] = i0; ip[1] = i1;
        h16x8* gp = (h16x8*)(GATE + (size_t)task * 16);
#pragma unroll
        for (int k8 = 0; k8 < 2; ++k8) gp[k8] = pack8((f32x4){e[8 * k8] * inv, e[8 * k8 + 1] * inv, e[8 * k8 + 2] * inv, e[8 * k8 + 3] * inv}, (f32x4){e[8 * k8 + 4] * inv, e[8 * k8 + 5] * inv, e[8 * k8 + 6] * inv, e[8 * k8 + 7] * inv});
    }
}

__device__ __forceinline__ float gelu_tanh(float x) { const float u = 0.7978845608028654f * (x + 0.044715f * x * x * x); return 0.5f * x * (1.0f + tanhf_(u)); }
__device__ __forceinline__ unsigned xcc_id() { return (unsigned)__builtin_amdgcn_s_getreg((3 << 11) | 20) & 7u; }
constexpr bool GA_C16 = false;
constexpr int GA_TC = 8, GA_NCH = MTOK / GA_TC;
__device__ __forceinline__ void dec16(const u32x4 q, float (&o)[16]) {
#pragma unroll
    for (int w = 0; w < 4; ++w) { const f32x2 lo = __builtin_amdgcn_cvt_pk_f32_fp8((int)q[w], false), hi = __builtin_amdgcn_cvt_pk_f32_fp8((int)q[w], true);
        o[4 * w] = lo[0]; o[4 * w + 1] = lo[1]; o[4 * w + 2] = hi[0]; o[4 * w + 3] = hi[1]; }
}
__device__ __forceinline__ void dec16p(const u32x4 q, f32x2 (&o)[8]) {
#pragma unroll
    for (int w = 0; w < 4; ++w) { o[2 * w] = __builtin_amdgcn_cvt_pk_f32_fp8((int)q[w], false); o[2 * w + 1] = __builtin_amdgcn_cvt_pk_f32_fp8((int)q[w], true); }
}
struct GIdx { u32x4 a, b; };
__device__ __forceinline__ GIdx g_ldidx(__amdgpu_buffer_rsrc_t IDX, int t, int r8) { GIdx r; r.a = __builtin_amdgcn_raw_buffer_load_b128(IDX, 32 * r8, t * 256, 0); r.b = __builtin_amdgcn_raw_buffer_load_b128(IDX, 32 * r8 + 16, t * 256, 0); return r; }
__device__ __forceinline__ void g_quant(u32x4 xa_, u32x4 xb_, u32x4& xq, float& xs) {
    const h16x8 xa = __builtin_bit_cast(h16x8, xa_), xb = __builtin_bit_cast(h16x8, xb_);
    float x[16]; float mx = 0.f;
#pragma unroll
    for (int k = 0; k < 8; ++k) { x[k] = (float)xa[k]; x[8 + k] = (float)xb[k]; mx = fmaxf(mx, fmaxf(fabsf(x[k]), fabsf(x[8 + k]))); }
    mx = fmaxf(mx, dpp_<0xB1>(mx)); mx = fmaxf(mx, dpp_<0x4E>(mx)); mx = fmaxf(mx, dpp_<0x141>(mx));
    mx = fmaxf(mx, 1e-20f);
    const float inv = 127.0f * __builtin_amdgcn_rcpf(mx); xs = mx * (1.0f / 127.0f);
#pragma unroll
    for (int w = 0; w < 4; ++w) { const int i0 = __float2int_rn(x[4 * w] * inv), i1 = __float2int_rn(x[4 * w + 1] * inv), i2 = __float2int_rn(x[4 * w + 2] * inv), i3 = __float2int_rn(x[4 * w + 3] * inv);
        xq[w] = (unsigned)(i0 & 0xff) | ((unsigned)(i1 & 0xff) << 8) | ((unsigned)(i2 & 0xff) << 16) | ((unsigned)i3 << 24); }
}
__device__ __forceinline__ void g_issue8(const unsigned char* TBs, unsigned lo, const u32x4 ix, u32x4 (&q)[8]) {
#pragma unroll
    for (int i = 0; i < 8; ++i) { const unsigned w = ix[i >> 1]; const unsigned e = (i & 1) ? (w >> 16) : (w & 0xffffu); q[i] = *(const u32x4*)(TBs + (e * 128u + lo)); }
}
struct GSide { u32x4 a, b, c, d; };
template <int PH> __device__ __forceinline__ GSide g_ldside(__amdgpu_buffer_rsrc_t SD, __amdgpu_buffer_rsrc_t HR, int t, int j, int m, int r8) {
    GSide r;
    if (PH == 0) { r.a = __builtin_amdgcn_raw_buffer_load_b128(SD, 32 * m, t * 2048 + 256 * j, 0); r.b = __builtin_amdgcn_raw_buffer_load_b128(SD, 32 * m + 16, t * 2048 + 256 * j, 0); r.c = r.a; r.d = r.b; }
    else { r.a = __builtin_amdgcn_raw_buffer_load_b128(SD, 32 * r8, t * 256, 0); r.b = GA_C16 ? __builtin_amdgcn_raw_buffer_load_b128(SD, 32 * r8 + 16, t * 256, 0) : (u32x4){0u, 0u, 0u, 0u};
           r.c = (u32x4){__builtin_amdgcn_raw_buffer_load_b32(SD, 4 * r8, (int)(O_COEFS - O_COEF) + t * 32, 0), 0u, 0u, 0u}; r.d = r.c;
           r.d[0] = __builtin_amdgcn_raw_buffer_load_b32(HR, (128 * j + 16 * m + 2 * r8) * 2, t * 2048, 0); }
    return r;
}
template <int PH, int HALF> __device__ __forceinline__ void g_half(u32x4 (&q)[8], const GSide& sd, float (&pa)[16], int (&ah)[16], int (&al)[16]) {
    if (PH == 0) {
#pragma unroll
        for (int i = 0; i < 8; ++i) { int acc = 0;
#pragma unroll
            for (int w = 0; w < 4; ++w) acc = __builtin_amdgcn_sdot4((int)q[i][w], (int)sd.a[w], acc, false);
            pa[8 * HALF + i] = (float)acc; }
    } else {
#pragma unroll
        for (int g = 0; g < 2; ++g) {
            const int ch = (int)sd.a[2 * HALF + g], cl = (int)sd.b[2 * HALF + g];
#pragma unroll
            for (int w = 0; w < 4; ++w) {
                const unsigned a0 = q[4 * g][w], a1 = q[4 * g + 1][w], a2 = q[4 * g + 2][w], a3 = q[4 * g + 3][w];
                const unsigned t01l = __builtin_amdgcn_perm(a1, a0, 0x05010400u), t01h = __builtin_amdgcn_perm(a1, a0, 0x07030602u);
                const unsigned t23l = __builtin_amdgcn_perm(a3, a2, 0x05010400u), t23h = __builtin_amdgcn_perm(a3, a2, 0x07030602u);
                const unsigned o0 = __builtin_amdgcn_perm(t23l, t01l, 0x05040100u), o1 = __builtin_amdgcn_perm(t23l, t01l, 0x07060302u);
                const unsigned o2 = __builtin_amdgcn_perm(t23h, t01h, 0x05040100u), o3 = __builtin_amdgcn_perm(t23h, t01h, 0x07060302u);
                ah[4 * w] = __builtin_amdgcn_sdot4((int)o0, ch, ah[4 * w], false);         if (GA_C16) al[4 * w] = __builtin_amdgcn_sdot4((int)o0, cl, al[4 * w], false);
                ah[4 * w + 1] = __builtin_amdgcn_sdot4((int)o1, ch, ah[4 * w + 1], false); if (GA_C16) al[4 * w + 1] = __builtin_amdgcn_sdot4((int)o1, cl, al[4 * w + 1], false);
                ah[4 * w + 2] = __builtin_amdgcn_sdot4((int)o2, ch, ah[4 * w + 2], false); if (GA_C16) al[4 * w + 2] = __builtin_amdgcn_sdot4((int)o2, cl, al[4 * w + 2], false);
                ah[4 * w + 3] = __builtin_amdgcn_sdot4((int)o3, ch, ah[4 * w + 3], false); if (GA_C16) al[4 * w + 3] = __builtin_amdgcn_sdot4((int)o3, cl, al[4 * w + 3], false);
            }
        }
    }
}
template <int PH> __device__ __forceinline__ void g_finish(const Args& a, __amdgpu_buffer_rsrc_t PRT, int t, int j, int lane, float (&p)[16], float xs, unsigned hpre) {
    const int m = lane & 7, r8 = lane >> 3;
    float q8[8], q4[4], q2[2];
    if (PH == 0) {
#pragma unroll
        for (int i = 0; i < 8; ++i) { const float keep = (lane & 4) ? p[i + 8] : p[i], send = (lane & 4) ? p[i] : p[i + 8]; q8[i] = keep + xhm_(send); }
#pragma unroll
        for (int i = 0; i < 4; ++i) { const float keep = (lane & 2) ? q8[i + 4] : q8[i], send = (lane & 2) ? q8[i] : q8[i + 4]; q4[i] = keep + dpp_<0x4E>(send); }
#pragma unroll
        for (int i = 0; i < 2; ++i) { const float keep = (lane & 1) ? q4[i + 2] : q4[i], send = (lane & 1) ? q4[i] : q4[i + 2]; q2[i] = keep + dpp_<0xB1>(send); }
        { const h16x2 pv = (h16x2){(h16)(q2[0] * xs), (h16)(q2[1] * xs)}; __builtin_amdgcn_raw_buffer_store_b32(__builtin_bit_cast(unsigned, pv), PRT, (16 * r8 + 2 * m) * 2, (j * MTOK + t) * 256, 0); }
    } else {
#pragma unroll
        for (int i = 0; i < 8; ++i) q8[i] = swap_add32(p[i], p[i + 8]);
#pragma unroll
        for (int i = 0; i < 4; ++i) q4[i] = swap_add16(q8[i], q8[i + 4]);
#pragma unroll
        for (int i = 0; i < 2; ++i) { const float keep = (lane & 8) ? q4[i + 2] : q4[i], send = (lane & 8) ? q4[i] : q4[i + 2]; q2[i] = keep + x8_(send); }
        const int col = 128 * j + 16 * m + 2 * r8;
        const h16x2 h1v = __builtin_bit_cast(h16x2, hpre);
        const f32x2 hv = (f32x2){(float)h1v[0] + q2[0], (float)h1v[1] + q2[1]};
        *(h16x2*)((h16*)(a.ws + O_H2B) + (size_t)t * 1024 + col) = (h16x2){(h16)hv[0], (h16)hv[1]};
        const float ss = wave_sum(hv[0] * hv[0] + hv[1] * hv[1]);
        if (lane == 0) ((float*)(a.ws + O_SS2))[(size_t)t * 8 + j] = ss;
    }
}
template <int PH>
__device__ __forceinline__ void phase_gather(const Args& a, int cset) {
    const int tid = tid_(), lane = tid & 63, m = lane & 7, r8 = lane >> 3;
    unsigned* ctr = (unsigned*)(a.ws + O_CTR) + cset * 8 * 64;
    const __amdgpu_buffer_rsrc_t IDX = mkrsrc(a.ws + O_IDX), SDR = mkrsrc(a.ws + (PH ? O_COEF : O_H1B)), PRT = mkrsrc(a.ws + O_PART), HR = mkrsrc(a.ws + O_H1B);
    const unsigned j0 = xcc_id();
    for (unsigned dj = 0; dj < 8; ++dj) {
        const unsigned j = (j0 + dj) & 7u;
        const unsigned char* TB = a.ws + (PH ? O_V8 : O_U8) + (size_t)j * 16384 * 128; const unsigned lo16 = 16u * (unsigned)m;
        unsigned c = 0; if (lane == 0) c = __hip_atomic_fetch_add(ctr + j * 64, 1u, __ATOMIC_RELAXED, __HIP_MEMORY_SCOPE_AGENT);
        c = (unsigned)__builtin_amdgcn_readfirstlane((int)c);
        if (c >= (unsigned)GA_NCH) continue;
        u32x4 qa[8], qb[8]; GSide sd, sn; GIdx ix, ixn;
        { const int t0 = c * GA_TC; ix = g_ldidx(IDX, t0, r8); g_issue8(TB, lo16, ix.a, qa); sd = g_ldside<PH>(SDR, HR, t0, j, m, r8); }
        for (;;) {
            const int t0 = c * GA_TC;
            unsigned cnv = 0; if (lane == 0) cnv = __hip_atomic_fetch_add(ctr + j * 64, 1u, __ATOMIC_RELAXED, __HIP_MEMORY_SCOPE_AGENT);
            unsigned cn = (unsigned)GA_NCH; int tnf = t0 + GA_TC - 1;
#define G_TOKEN(IXC, SDC, IXN, SNN, TI, TN) { \
                const int t = t0 + (TI), tn = (TN); \
                g_issue8(TB, lo16, IXC.b, qb); IXN = g_ldidx(IDX, tn, r8); SNN = g_ldside<PH>(SDR, HR, tn, j, m, r8); \
                float p[16]; int ah[16], al[16]; \
                if (PH == 1) { _Pragma("unroll") for (int k = 0; k < 16; ++k) { ah[k] = 0; al[k] = 0; } } \
                float xs = 1.f; \
                if (PH == 0) { u32x4 xq; g_quant(SDC.a, SDC.b, xq, xs); SDC.a = xq; } \
                if (PH == 0) __builtin_amdgcn_sched_barrier(0);     \
                g_half<PH, 0>(qa, SDC, p, ah, al); \
                if (PH == 0) __builtin_amdgcn_sched_barrier(0); \
                g_issue8(TB, lo16, IXN.a, qa); \
                if (PH == 0) __builtin_amdgcn_sched_barrier(0);     \
                g_half<PH, 1>(qb, SDC, p, ah, al); \
                if (PH == 1) { const float cs = __uint_as_float(SDC.c[0]); _Pragma("unroll") for (int k = 0; k < 16; ++k) p[k] = (float)(GA_C16 ? ((ah[k] << 8) + al[k]) : ah[k]) * cs; }     \
                g_finish<PH>(a, PRT, t, j, lane, p, xs, SDC.d[0]); }
#pragma unroll 1
            for (int ti = 0; ti < GA_TC; ti += 2) {
                if (ti == GA_TC - 2) { cn = (unsigned)__builtin_amdgcn_readfirstlane((int)cnv); if (cn < (unsigned)GA_NCH) tnf = (int)cn * GA_TC; }
                G_TOKEN(ix, sd, ixn, sn, ti, t + 1) G_TOKEN(ixn, sn, ix, sd, ti + 1, (ti + 2 < GA_TC) ? t + 1 : tnf) }
#undef G_TOKEN
            if (cn >= (unsigned)GA_NCH) break;
            c = cn;
        }
    }
}
__device__ __forceinline__ void phase_p16(const Args& a) {
    const int tid = tid_();
    const f32x4* pp = (const f32x4*)a.in[1]; h16* dp = (h16*)(a.ws + O_P16P);
    const int np4 = MTOK * 64, st = gridDim.x * NTHREADS;
    for (int i = blockIdx.x * NTHREADS + tid; i < np4; i += 4 * st) {
        f32x4 pv[4];
#pragma unroll
        for (int q = 0; q < 4; ++q) if (i + q * st < np4) pv[q] = pp[i + q * st];
#pragma unroll
        for (int q = 0; q < 4; ++q) if (i + q * st < np4) { const int n = i + q * st; *(h16x4*)(dp + (size_t)(n >> 6) * 1024 + (n & 63) * 4) = pack4(pv[q]); }
    }
}
__device__ __forceinline__ void phase_coef(const Args& a) {
    const int tid = tid_();
    const h16* PART = (const h16*)(a.ws + O_PART); const unsigned short* IDX = (const unsigned short*)(a.ws + O_IDX);
    const h16* GATE = (const h16*)(a.ws + O_GATE); const float* RS1 = (const float*)(a.ws + O_RS1);
    const float* USC = (const float*)(a.ws + O_USC); const float* VSC = (const float*)(a.ws + O_VSC);
    u32x4* CQ = (u32x4*)(a.ws + O_COEF); float* CS = (float*)(a.ws + O_COEFS);
    for (int task = blockIdx.x * NTHREADS + tid; task < MTOK * 8; task += gridDim.x * NTHREADS) {
        const size_t i = (size_t)task * 16;
        float sacc[16];
#pragma unroll
        for (int k = 0; k < 16; ++k) sacc[k] = 0.f;
#pragma unroll
        for (int j = 0; j < 8; ++j) { const h16x8 p0 = *(const h16x8*)(PART + (size_t)j * MTOK * 128 + i), p1 = *(const h16x8*)(PART + (size_t)j * MTOK * 128 + i + 8);
#pragma unroll
            for (int k = 0; k < 8; ++k) { sacc[k] += (float)p0[k]; sacc[8 + k] += (float)p1[k]; } }
        const u32x4 e0 = *(const u32x4*)(IDX + i), e1 = *(const u32x4*)(IDX + i + 8);
        const h16x8 gt0 = *(const h16x8*)(GATE + i), gt1 = *(const h16x8*)(GATE + i + 8);
        const float rs = RS1[task >> 3];
        float c[16]; float mx = 0.f;
#pragma unroll
        for (int k = 0; k < 16; ++k) { const unsigned w = (k < 8) ? e0[(k & 7) >> 1] : e1[(k & 7) >> 1]; const unsigned e = (k & 1) ? (w >> 16) : (w & 0xffffu);
            c[k] = (float)(k < 8 ? gt0[k & 7] : gt1[k & 7]) * gelu_tanh(rs * USC[e] * sacc[k]) * VSC[e]; mx = fmaxf(mx, fabsf(c[k])); }
        const float qmax = GA_C16 ? 32639.0f : 127.0f;
        const float inv = (mx > 0.f) ? qmax / mx : 0.f;
        u32x4 hw, lw;
#pragma unroll
        for (int g = 0; g < 4; ++g) { unsigned h4 = 0u, l4 = 0u;
#pragma unroll
            for (int b = 0; b < 4; ++b) { const int q = __float2int_rn(c[4 * g + b] * inv), hi = GA_C16 ? ((q + 128) >> 8) : q, lo = GA_C16 ? (q - (hi << 8)) : 0;
                h4 |= (unsigned)(hi & 0xff) << (8 * b); l4 |= (unsigned)(lo & 0xff) << (8 * b); }
            hw[g] = h4; lw[g] = l4; }
        CQ[(size_t)task * 2] = hw; if (GA_C16) CQ[(size_t)task * 2 + 1] = lw;
        CS[task] = mx / qmax;
    }
}

__device__ __forceinline__ void phase_final(const Args& a) {
    const int tid = tid_(), lane = tid & 63, wave = tid >> 6;
    const int gw = blockIdx.x * NWAVES + wave, NGW = gridDim.x * NWAVES;
    const float* part = (const float*)(a.ws + O_PART3); const float* fg = a.in[28];
    f32x4 g4[4];
#pragma unroll
    for (int j = 0; j < 4; ++j) g4[j] = *((const f32x4*)fg + lane + 64 * j);
    const h16* h3b = (const h16*)(a.ws + O_XN);
#define FN_LOAD(SV, HV, RQ) do { _Pragma("unroll") for (int q = 0; q < 4; ++q) { const int r = (RQ) + q * NGW; if (r < MTOK) { SV[q] = (lane < 16) ? part[(size_t)r * 16 + lane] : 0.f; \
            const h16x4* hr = (const h16x4*)(h3b + (size_t)r * 1024) + lane; _Pragma("unroll") for (int j = 0; j < 4; ++j) HV[q][j] = hr[64 * j]; } } } while (0)
#define FN_COMP(SV, HV, RQ) do { _Pragma("unroll") for (int q = 0; q < 4; ++q) { const int r = (RQ) + q * NGW; if (r < MTOK) { \
            const float s = wave_sum(SV[q]); \
            const float rs = rsqrtf(s * (1.f / 1024.f) + NORM_EPS); \
            f32x4* xr = (f32x4*)(a.out + (size_t)r * 1024) + lane; \
            _Pragma("unroll") for (int j = 0; j < 4; ++j) { const h16x4 h = HV[q][j]; xr[64 * j] = (f32x4){(float)h[0], (float)h[1], (float)h[2], (float)h[3]} * rs * g4[j]; } } } } while (0)
    float svA[4], svB[4]; h16x4 hvA[4][4], hvB[4][4];
    const int step = 4 * NGW;
    FN_LOAD(svA, hvA, gw);
    for (int rq = gw; rq < MTOK; rq += 2 * step) {
        FN_LOAD(svB, hvB, rq + step);
        FN_COMP(svA, hvA, rq);
        FN_LOAD(svA, hvA, rq + 2 * step);
        FN_COMP(svB, hvB, rq + step);
    }
#undef FN_LOAD
#undef FN_COMP
}

constexpr int NPHASE = 19;
__global__ void __launch_bounds__(NTHREADS, 2) mk(Args a) {
    LAS unsigned char* lds = (LAS unsigned char*)smem;
    unsigned char* ws = a.ws;
    if (a.ph_hi < 0) { cg::grid_group grid = cg::this_grid(); grid.sync(); }
    volatile LAS unsigned* bst = (volatile LAS unsigned*)(lds + 131072);
    if ((threadIdx.x & 63) == 0) ((volatile LAS unsigned char*)(lds + LDS_WAVE_TAB))[hw_slot_()] = (unsigned char)(threadIdx.x >> 6);
    if (threadIdx.x < 16) bst[threadIdx.x] = 0u;
    __syncthreads();
    const XcdBarrier xbar = xcd_barrier_post((unsigned*)(a.ws + O_BAR), bst);
#define SYNC() xcd_barrier(xbar)
#define IN(k) (a.ph_lo <= (k) && (k) < a.ph_hi)
#define SEAM(k) do { if (IN(k) && IN((k) + 1)) SYNC(); } while (0)
#define REPS(k) ((((REP_MASK) >> (k)) & 1u) ? 2 : 1)
    const int G = gridDim.x, bid = blockIdx.x;
    if (IN(0)) for (int rep = 0; rep < REPS(0); ++rep) { if (rep) SYNC(); phase_prep(a, lds); } SEAM(0);
    if (IN(1)) for (int rep = 0; rep < REPS(1); ++rep) { if (rep) SYNC(); pg8::Gemm g{(const h16*)(ws + O_XN), (const h16*)(ws + O_WIN), MTOK, NIN, 1024, nullptr, nullptr}; pg8::StaticOrder S; S.init(MTOK, NIN, G, bid);
        EpiZ E{(h16*)(ws + O_ZC), (h16*)(ws + O_ZR), (h16*)(ws + O_ZG)}; pg8::gemm_phase(lds, g, S, E); } SEAM(1);
    if (IN(2)) for (int rep = 0; rep < REPS(2); ++rep) { if (rep) SYNC(); phase_conv(a); phase_rwkv_prep(a); } SEAM(2);
    if (IN(3)) for (int rep = 0; rep < REPS(3); ++rep) { if (rep) SYNC(); pg8::Gemm g{(const h16*)(ws + O_APR), (const h16*)(ws + O_WLR), MTOK, 1536, 256, nullptr, nullptr, 0, 0, 1}; pg8::StaticOrder S; S.init(MTOK, 1536, G, bid);
        h16* R = (h16*)a.out; h16* KS = R + (size_t)MTOK * 512; h16* KK = KS + (size_t)2 * MTOK * 512;
        EpiLR E{a.in[7], a.in[9], a.in[13], (h16*)(ws + O_WD), KS, (h16*)(ws + O_BD), (h16*)(ws + O_GG), KK}; pg8::gemm_phase(lds, g, S, E); } SEAM(3);
    if (IN(4)) { for (int st = 0; st <= UT_SEG; ++st) { if (st) SYNC(); phase_ut_step(a, lds, st); } }
    SEAM(6);
    if (IN(7)) for (int rep = 0; rep < REPS(7); ++rep) { if (rep) SYNC(); phase_rwkv_post(a, POST_EARLY, UT_SEG, bid * NWAVES + (tid_() >> 6), G * NWAVES); } SEAM(7);
    if (IN(9)) for (int rep = 0; rep < REPS(9); ++rep) { if (rep) SYNC(); pg8::Gemm g{(const h16*)(ws + O_CA), (const h16*)(ws + O_WA), MTOK, 1024, 512, (const h16*)(ws + O_YB), (const h16*)(ws + O_WB)}; pg8::StaticOrder S; S.init(MTOK, 1024, G, bid);
        EpiMerged E{(const h16*)(ws + O_ZG), (h16*)(ws + O_MERGED)}; pg8::gemm_phase(lds, g, S, E); }
    SEAM(9);
    if (IN(10)) for (int rep = 0; rep < REPS(10); ++rep) { if (rep) SYNC(); pg8::Gemm g{(const h16*)(ws + O_MERGED), (const h16*)(ws + O_WO), MTOK, 1024, 1024, nullptr, nullptr}; pg8::StaticOrder S; S.init(MTOK, 1024, G, bid);
        EpiH1 E{a.in[0], (h16*)(ws + O_H1B), (float*)(ws + O_PART1)}; pg8::gemm_phase(lds, g, S, E); } SEAM(10);
    if (IN(11)) for (int rep = 0; rep < REPS(11); ++rep) { if (rep) SYNC(); pg8::Gemm g{(const h16*)(ws + O_H1B), (const h16*)(ws + O_WS), MTOK, 2048, 1024, nullptr, nullptr}; pg8::StaticOrder S; S.init(MTOK, 2048, G, bid);
        EpiF16 E{(h16*)(ws + O_SCORES), 2048}; pg8::gemm_phase(lds, g, S, E); } SEAM(11);
    if (IN(12)) for (int rep = 0; rep < REPS(12); ++rep) { if (rep) SYNC(); phase_topk(a, lds); } SEAM(12);
    if (IN(13)) for (int rep = 0; rep < REPS(13); ++rep) { if (rep) SYNC(); phase_gather<0>(a, 2 * rep); } SEAM(13);
    if (IN(14)) for (int rep = 0; rep < REPS(14); ++rep) { if (rep) SYNC(); phase_coef(a); }
    SEAM(14);
    if (IN(15)) for (int rep = 0; rep < REPS(15); ++rep) { if (rep) SYNC(); phase_p16(a); phase_gather<1>(a, 1 + 2 * rep); } SEAM(15);
    if (IN(17)) for (int rep = 0; rep < REPS(17); ++rep) { if (rep) SYNC();
        pg8::Gemm g{(const h16*)(ws + O_P16P), (const h16*)(ws + O_WP), MTOK, 1024, 256, (const h16*)(ws + O_H2B), (const h16*)(ws + O_WG), 1024, 1024}; pg8::StaticOrder S; S.init(MTOK, 1024, G, bid);
        EpiPPGate E{(h16*)(ws + O_XN), (const h16*)(ws + O_H2B), (h16*)(ws + O_PP), (const float*)(ws + O_SS2), (float*)(ws + O_PART3)}; pg8::gemm_phase(lds, g, S, E); } SEAM(17);
    if (IN(18)) for (int rep = 0; rep < REPS(18); ++rep) { if (rep) SYNC(); phase_final(a); }
}

extern "C" void kernel_launch(void* const* d_in, const int* in_sizes, int n_in, void* d_out, int out_size, void* d_ws, size_t ws_size, hipStream_t stream) {
    static int ready = 0, grid = NBLK;
    if (!ready) {
        if (n_in != 29 || ws_size < WS_END) { fprintf(stderr, "kernel_launch: unexpected n_in %d / ws %zu (need %zu)\n", n_in, ws_size, (size_t)WS_END); ready = -1; return; }
        if (hipFuncSetAttribute((const void*)mk, hipFuncAttributeMaxDynamicSharedMemorySize, LDS_BYTES) != hipSuccess) { fprintf(stderr, "hipFuncSetAttribute failed\n"); ready = -1; return; }
        int dev = 0, cus = 0, per_cu = 0;
        if (hipGetDevice(&dev) == hipSuccess && hipDeviceGetAttribute(&cus, hipDeviceAttributeMultiprocessorCount, dev) == hipSuccess &&
            hipOccupancyMaxActiveBlocksPerMultiprocessor(&per_cu, (const void*)mk, NTHREADS, LDS_BYTES) == hipSuccess && cus > 0 && per_cu > 0) grid = cus < NBLK ? cus : NBLK;
        else { (void)hipGetLastError(); grid = NBLK; }
        ready = 1;
    }
    if (ready < 0) return;
    Args a{};
    for (int i = 0; i < 29; ++i) a.in[i] = (const float*)d_in[i];
    a.out = (float*)d_out; a.ws = (unsigned char*)d_ws;
    (void)hipMemsetAsync((unsigned char*)d_ws + O_BAR, 0, 16384, stream);
    a.ph_lo = 0; a.ph_hi = NPHASE;
    void* args[] = {&a};
    if (hipLaunchCooperativeKernel((const void*)mk, dim3(grid), dim3(NTHREADS), args, LDS_BYTES, stream) != hipSuccess) fprintf(stderr, "cooperative launch failed (grid %d)\n", grid);
}
```

```cpp
#include <hip/hip_runtime.h>
#include <hip/hip_cooperative_groups.h>
#include <cstdio>
namespace cg = cooperative_groups;

#ifndef REP_MASK
#define REP_MASK 0u
#endif

#define LAS __attribute__((address_space(3)))
typedef _Float16 h16;
typedef _Float16 h16x8 __attribute__((ext_vector_type(8)));
typedef _Float16 h16x4 __attribute__((ext_vector_type(4)));
typedef _Float16 h16x2 __attribute__((ext_vector_type(2)));
typedef float f32x4 __attribute__((ext_vector_type(4)));
typedef float f32x2 __attribute__((ext_vector_type(2)));
typedef unsigned u32x4 __attribute__((ext_vector_type(4)));
typedef short s16x2 __attribute__((ext_vector_type(2)));
typedef unsigned u32x2 __attribute__((ext_vector_type(2)));

constexpr int MTOK = 65536, DM = 1024, SEQ = 8192, NB = 8;
constexpr int NIN = 5376;
constexpr int NTHREADS = 512, NWAVES = 8, NBLK = 256;
constexpr int LDS_BYTES = 131072 + 128 + 2 * 12288;
constexpr float NORM_EPS = 1e-6f;

constexpr size_t MiB = 1u << 20;
constexpr size_t O_WIN = 0;
constexpr size_t O_WA = O_WIN + (size_t)5376 * 1024 * 2;
constexpr size_t O_WB = O_WA + 1 * MiB;
constexpr size_t O_WO = O_WB + 1 * MiB;
constexpr size_t O_WG = O_WO + 2 * MiB;
constexpr size_t O_WP = O_WG + 2 * MiB;
constexpr size_t O_WLR = O_WP + 2 * MiB;
constexpr size_t O_WS = O_WLR + 3 * MiB / 4;
constexpr size_t O_U16 = O_WS + 4 * MiB;
constexpr size_t O_V16 = O_U16 + 32 * MiB;
constexpr size_t O_P16 = O_V16 + 32 * MiB;
constexpr size_t O_PART1 = O_P16 + 32 * MiB;
constexpr size_t O_PART3 = O_PART1 + 4 * MiB;
constexpr size_t O_RS1 = O_PART3 + 4 * MiB;
constexpr size_t O_RS2 = O_RS1 + MiB / 4;
constexpr size_t O_XN = O_RS2 + MiB / 4;
constexpr size_t O_ZC = O_XN + 128 * MiB;
constexpr size_t O_ZR = O_ZC + 192 * MiB;
constexpr size_t O_ZG = O_ZR + 224 * MiB;
constexpr size_t O_SS2 = O_ZG + 256 * MiB;
constexpr size_t O_USC = O_SS2 + 2 * MiB;
constexpr size_t O_VSC = O_USC + 65536;
constexpr size_t O_CTR = O_VSC + 65536;
constexpr size_t O_BAR = O_CTR + 8192;
constexpr size_t O_SST2 = O_BAR + 16384;
constexpr size_t WS_END = O_SST2 + MiB;
constexpr size_t O_U8 = O_U16;
constexpr size_t O_V8 = O_U16 + 16 * MiB;
constexpr size_t O_PART = O_ZG;
constexpr size_t O_COEF = O_ZC + 128 * MiB;
constexpr size_t O_COEFS = O_COEF + 16 * MiB;
constexpr size_t O_CA = O_XN;
constexpr size_t O_APR = O_XN + 64 * MiB;
constexpr size_t O_H1B = O_XN;
constexpr size_t O_WD = O_ZC;
constexpr size_t O_BD = O_ZC + 64 * MiB;
constexpr size_t O_GG = O_ZC + 128 * MiB;
constexpr size_t O_MERGED = O_ZC;
constexpr size_t O_H2B = O_ZC;
constexpr size_t O_Y = O_ZR + 96 * MiB;
constexpr size_t O_YB = O_ZR + 160 * MiB;
constexpr size_t O_IDX = O_ZR;
constexpr size_t O_GATE = O_ZR + 16 * MiB;
constexpr size_t O_PP = O_ZR + 64 * MiB;
constexpr size_t O_SCORES = O_ZG;
constexpr size_t O_P16P = O_ZG;

struct Args {
    const float* in[29];
    float* out;
    unsigned char* ws;
    int ph_lo, ph_hi;
};

constexpr int LDS_WAVE_TAB = 131072 + 64;
extern __shared__ __attribute__((aligned(16))) unsigned char smem[];
__device__ __forceinline__ int lane_() { int l; asm volatile("v_mbcnt_lo_u32_b32 %0, -1, 0\n\tv_mbcnt_hi_u32_b32 %0, -1, %0" : "=v"(l)); return l; }
__device__ __forceinline__ unsigned hw_slot_() { return (unsigned)__builtin_amdgcn_s_getreg((5 << 11) | 4) & 63u; }
__device__ __forceinline__ int tid_() {
    const int w = (int)((volatile LAS unsigned char*)((LAS unsigned char*)smem + LDS_WAVE_TAB))[hw_slot_()];
    int t = __builtin_amdgcn_readfirstlane(w) * 64 + lane_(); asm volatile("" : "+v"(t)); return t;
}
__device__ __forceinline__ float sigmoidf_(float x) { return __builtin_amdgcn_rcpf(1.0f + __expf(-x)); }
template <int CTRL> __device__ __forceinline__ float dpp_(float v) { return __builtin_bit_cast(float, __builtin_amdgcn_update_dpp(0, __builtin_bit_cast(int, v), CTRL, 0xF, 0xF, true)); }
__device__ __forceinline__ float x32_(float v, int lane) { const auto r = __builtin_amdgcn_permlane32_swap(__builtin_bit_cast(unsigned, v), __builtin_bit_cast(unsigned, v), false, false); return __builtin_bit_cast(float, (lane & 32) ? r[0] : r[1]); }
__device__ __forceinline__ float x16_(float v, int lane) { const auto r = __builtin_amdgcn_permlane16_swap(__builtin_bit_cast(unsigned, v), __builtin_bit_cast(unsigned, v), false, false); return __builtin_bit_cast(float, (lane & 16) ? r[0] : r[1]); }
__device__ __forceinline__ float swap_add32(float a, float b) { asm("s_nop 1\n\tv_permlane32_swap_b32 %0, %1" : "+v"(a), "+v"(b)); return a + b; }
__device__ __forceinline__ float swap_add16(float a, float b) { asm("s_nop 1\n\tv_permlane16_swap_b32 %0, %1" : "+v"(a), "+v"(b)); return a + b; }
__device__ __forceinline__ float x8_(float v) { return dpp_<0x128>(v); }
__device__ __forceinline__ float xhm_(float v) { return dpp_<0x141>(v); }
__device__ __forceinline__ float wave_sum(float v) {
    const int lane = lane_();
    v += dpp_<0xB1>(v); v += dpp_<0x4E>(v); v += dpp_<0x141>(v); v += dpp_<0x140>(v);
    v += x16_(v, lane); v += x32_(v, lane);
    return v;
}
__device__ __forceinline__ float wave_max(float v) {
    const int lane = lane_();
    v = fmaxf(v, dpp_<0xB1>(v)); v = fmaxf(v, dpp_<0x4E>(v)); v = fmaxf(v, dpp_<0x141>(v)); v = fmaxf(v, dpp_<0x140>(v));
    v = fmaxf(v, x16_(v, lane)); v = fmaxf(v, x32_(v, lane));
    return v;
}
__device__ __forceinline__ __amdgpu_buffer_rsrc_t mkrsrc(const void* p) { return __builtin_amdgcn_make_buffer_rsrc((void*)p, 0, 0x7fffffff, 0x00020000); }
__device__ __forceinline__ h16x8 pack8(f32x4 a, f32x4 b) {
    h16x8 r;
    r[0] = (h16)a[0]; r[1] = (h16)a[1]; r[2] = (h16)a[2]; r[3] = (h16)a[3];
    r[4] = (h16)b[0]; r[5] = (h16)b[1]; r[6] = (h16)b[2]; r[7] = (h16)b[3];
    return r;
}
__device__ __forceinline__ h16x4 pack4(f32x4 a) {
    h16x4 r; r[0] = (h16)a[0]; r[1] = (h16)a[1]; r[2] = (h16)a[2]; r[3] = (h16)a[3]; return r;
}

#define XB_TMO      128
#define XB_XCNT(j)  (256  + 64 * (j))
#define XB_XSUB(j)  (1280 + 64 * (j))
#define XB_XGEN(j)  (2304 + 64 * (j))
#define XB_TOP      3328
#define XB_TOPGEN   3392
#define XCD_BAR_WORDS 3456
#define XB_SPIN_CAP (1u << 18)

__device__ __forceinline__ unsigned xb_ld(unsigned* p)              { return __hip_atomic_load(p, __ATOMIC_RELAXED, __HIP_MEMORY_SCOPE_AGENT); }
__device__ __forceinline__ unsigned xb_add(unsigned* p, unsigned v) { return __hip_atomic_fetch_add(p, v, __ATOMIC_RELAXED, __HIP_MEMORY_SCOPE_AGENT); }
__device__ __forceinline__ unsigned xb_xcc_id() { return (unsigned)__builtin_amdgcn_s_getreg((3 << 11) | 20) & 0xFu; }
#define XB_SPIN(cond, bar) do { unsigned _sp = 0; while (cond) { __builtin_amdgcn_s_sleep(1); \
    if ((++_sp & 255u) == 0u) { if (xb_ld(&(bar)[XB_TMO])) break; if (_sp > XB_SPIN_CAP) { atomicAdd(&(bar)[XB_TMO], 1u); break; } } } } while (0)

struct XcdBarrier {
    unsigned* bar; unsigned x;
    volatile LAS unsigned* st;
};

__device__ __forceinline__ XcdBarrier xcd_barrier_post(unsigned* bar, volatile LAS unsigned* st) {
    XcdBarrier b; b.bar = bar; b.x = xb_xcc_id(); b.st = st;
    if (tid_() == 0) (void)xb_add(&bar[XB_XCNT(b.x)], 1u);
    return b;
}
__device__ __forceinline__ void xcd_barrier_complete(unsigned* bar, unsigned x, unsigned& nloc, unsigned& nx) {
    const unsigned G = gridDim.x * gridDim.y * gridDim.z;
    unsigned sum, cnt, mine, sp = 0u;
    for (;;) {
        sum = 0u; cnt = 0u; mine = 0u;
#pragma unroll
        for (unsigned j = 0; j < 16; ++j) { const unsigned c = xb_ld(&bar[XB_XCNT(j)]); sum += c; cnt += (c > 0u) ? 1u : 0u; mine = (j == x) ? c : mine; }
        if (sum == G) break;
        __builtin_amdgcn_s_sleep(1);
        if ((++sp & 255u) == 0u) { if (xb_ld(&bar[XB_TMO])) break; if (sp > XB_SPIN_CAP) { atomicAdd(&bar[XB_TMO], 1u); break; } }
    }
    nloc = mine > 0u ? mine : 1u; nx = cnt > 0u ? cnt : 1u;
}

__device__ __forceinline__ void xcd_barrier(const XcdBarrier& b) {
    asm volatile("s_waitcnt vmcnt(0)" ::: "memory");
    __syncthreads();
    if (tid_() == 0) {
        unsigned* bar = b.bar;
        __builtin_amdgcn_s_waitcnt(0);
        unsigned nloc = b.st[0], nx = b.st[1];
        if (nloc == 0u) { xcd_barrier_complete(bar, b.x, nloc, nx); b.st[0] = nloc; b.st[1] = nx; }
        const unsigned old = xb_add(&bar[XB_XSUB(b.x)], 1u);
        const unsigned gen = old / nloc;
        if (old + 1u == (gen + 1u) * nloc) {
            __builtin_amdgcn_fence(__ATOMIC_RELEASE, "agent");
            asm volatile("s_waitcnt vmcnt(0)" ::: "memory");
            const unsigned og = xb_add(&bar[XB_TOP], 1u);
            const unsigned tg = og / nx;
            if (og + 1u == (tg + 1u) * nx) xb_add(&bar[XB_TOPGEN], 1u);
            else XB_SPIN(xb_ld(&bar[XB_TOPGEN]) == tg, bar);
            __builtin_amdgcn_fence(__ATOMIC_ACQUIRE, "agent");
            xb_add(&bar[XB_XGEN(b.x)], 1u);
            asm volatile("s_waitcnt vmcnt(0)" ::: "memory");
        } else {
            XB_SPIN(xb_ld(&bar[XB_XGEN(b.x)]) == gen, bar);
            __builtin_amdgcn_fence(__ATOMIC_ACQUIRE, "agent");
            asm volatile("s_waitcnt vmcnt(0)" ::: "memory");
        }
    }
    __syncthreads();
}


namespace pg8 {
constexpr int BM = 256, BK = 64, HALF = 128, HTB = HALF * BK * 2, STAGE_BYTES = 8 * HTB, NXCD = 8, WGM = 8;
__device__ __forceinline__ int lds_byte(int r, int c) { const int st = (r >> 4) * 2 + (c >> 5), rr = r & 15, cc = c & 31, ob = rr * 64 + cc * 2; return st * 1024 + (ob ^ (((ob >> 9) & 1) << 5)); }
__device__ __forceinline__ void stage_rc(int b, int& R, int& C) { const int st = b / 1024, sb = b % 1024, swz = sb ^ (((sb >> 9) & 1) << 5); R = (st >> 1) * 16 + swz / 64; C = (st & 1) * 32 + (swz % 64) / 2; }
__device__ __forceinline__ int perm32(int rho) { const int n = rho >> 4, i = rho & 15; return 8 * (i >> 2) + 4 * n + (i & 3); }

struct Unit { int pm, pn; };
struct Gemm { const h16* A; const h16* Bt; int M, N, K; const h16* A2; const h16* Bt2; int ld, K2, win; };

struct StaticOrder {
    int nM, nN, nwg, G, c;
    __device__ void init(int M, int N, int G_, int c_) { nM = M / BM; nN = N / BM; nwg = nM * nN; G = G_; c = c_; }
    __device__ bool next(int i, Unit& u) const {
        const long L = (long)i * G + c; if (L >= nwg) return false;
        int wgid = (int)L; { const int q = nwg / NXCD, r = nwg % NXCD, xcd = wgid % NXCD, off = wgid / NXCD; wgid = (xcd < r ? xcd * (q + 1) : r * (q + 1) + (xcd - r) * q) + off; }
        const int nig = WGM * nN, gid = wgid / nig, fm = gid * WGM, rem = wgid - gid * nig;
        u.pm = fm + (rem % WGM); u.pn = rem / WGM; return true;
    }
};

template <class Epi>
__device__ __forceinline__ void gemm_phase(LAS unsigned char* lds, const Gemm g, const StaticOrder& S, const Epi& E) {
    const int tid = tid_(), wid = __builtin_amdgcn_readfirstlane(tid >> 6), lane = tid & 63, wr = wid >> 2, wc = wid & 3, fr = lane & 15, fq = lane >> 4;
    const int K = g.ld ? g.ld : g.K, nt0 = g.win ? 2 : g.K / BK, nt1 = (g.K2 ? g.K2 : g.K) / BK;
#define PG8_KO(pn) ((size_t)((g.win && (pn) >= 4) ? 256 : 0))
    unsigned voffA[2], voffB[2];
#pragma unroll
    for (int i = 0; i < 2; ++i) { int R, C; stage_rc(tid * 16 + i * 8192, R, C); const int Rb = (R & ~31) + perm32(R & 31);
        voffA[i] = (unsigned)(R * K + C) * 2u; voffB[i] = (unsigned)(Rb * K + C) * 2u; }
    const size_t kstep = (size_t)(BK * 2);
    const size_t hstep = (size_t)HALF * K * 2;
    const size_t tstep = 2 * hstep;
    const unsigned ldsw = (unsigned)wid * 1024u;
    const int aoff = lds_byte(wr * 64 + fr, fq * 8), boff = lds_byte(wc * 32 + fr, fq * 8);
#define PG8_SA(b, h) (((b) * 2 + (h)) * HTB)
#define PG8_SB(b, h) ((4 + (b) * 2 + (h)) * HTB)
#define PG8_STAGE(bufoff, gbase, voff) do { _Pragma("unroll") for (int _i = 0; _i < 2; ++_i) \
        __builtin_amdgcn_global_load_lds((const unsigned*)((const char*)(gbase) + (voff)[_i]), (LAS unsigned*)(lds + (bufoff) + ldsw + _i * 8192), 16, 0, 0); } while (0)
#define PG8_LDA(dst, b, h) do { _Pragma("unroll") for (int m = 0; m < 4; ++m) _Pragma("unroll") for (int k = 0; k < 2; ++k) dst[m][k] = *(const LAS h16x8*)(lds + PG8_SA(b, h) + aoff + m * 2048 + k * 1024); } while (0)
#define PG8_LDB(dst, b, h) do { _Pragma("unroll") for (int n = 0; n < 2; ++n) _Pragma("unroll") for (int k = 0; k < 2; ++k) dst[n][k] = *(const LAS h16x8*)(lds + PG8_SB(b, h) + boff + n * 2048 + k * 1024); } while (0)
#define PG8_MMA(ai, bj, At, Bt) do { __builtin_amdgcn_s_setprio(1); _Pragma("unroll") for (int m = 0; m < 4; ++m) _Pragma("unroll") for (int n = 0; n < 2; ++n) _Pragma("unroll") for (int k = 0; k < 2; ++k) \
        acc[ai][bj][m][n] = __builtin_amdgcn_mfma_f32_16x16x32_f16(Bt[n][k], At[m][k], acc[ai][bj][m][n], 0, 0, 0); __builtin_amdgcn_s_setprio(0); } while (0)
#define PG8_WAIT_V(n) asm volatile("s_waitcnt vmcnt(" #n ")" ::: "memory")
#define PG8_WAIT_L(n) asm volatile("s_waitcnt lgkmcnt(" #n ")" ::: "memory")
#define PG8_BAR __builtin_amdgcn_s_barrier()
#define PG8_SCHED __builtin_amdgcn_sched_barrier(0)
    Unit cur, nxt; int ui = 0;
    constexpr bool TP = Epi::TWO_PART;
    if (!S.next(0, cur)) return;
    f32x4 acc[2][2][4][2];
#pragma unroll
    for (int a = 0; a < 2; ++a)
#pragma unroll
        for (int b = 0; b < 2; ++b)
#pragma unroll
            for (int m = 0; m < 4; ++m)
#pragma unroll
                for (int n = 0; n < 2; ++n) acc[a][b][m][n] = (f32x4){0.f, 0.f, 0.f, 0.f};
    h16x8 At[4][2], B0[2][2], B1[2][2];
    const char* cA = (const char*)g.A + (size_t)cur.pm * tstep + PG8_KO(cur.pn); const char* cB = (const char*)g.Bt + (size_t)cur.pn * tstep + PG8_KO(cur.pn);
    PG8_STAGE(PG8_SB(0, 0), cB, voffB); PG8_STAGE(PG8_SB(0, 1), cB + hstep, voffB); PG8_STAGE(PG8_SA(0, 0), cA, voffA); PG8_STAGE(PG8_SA(0, 1), cA + hstep, voffA);
    if (wr == 1) PG8_BAR;
    PG8_WAIT_V(2); PG8_BAR;
    PG8_STAGE(PG8_SB(1, 0), cB + kstep, voffB); PG8_STAGE(PG8_SA(1, 0), cA + kstep, voffA); PG8_STAGE(PG8_SB(1, 1), cB + hstep + kstep, voffB);
    PG8_WAIT_V(6); PG8_BAR;
    for (;;) {
        const bool has_next = TP ? (((ui + 1) & 1) ? (nxt = cur, true) : S.next((ui + 1) >> 1, nxt)) : S.next(ui + 1, nxt);
        const h16* gA_n = (TP && ((ui + 1) & 1)) ? g.A2 : g.A; const h16* gB_n = (TP && ((ui + 1) & 1)) ? g.Bt2 : g.Bt;
        const char* nA = has_next ? (const char*)gA_n + (size_t)nxt.pm * tstep + PG8_KO(nxt.pn) : cA; const char* nB = has_next ? (const char*)gB_n + (size_t)nxt.pn * tstep + PG8_KO(nxt.pn) : cB;
        const int nt = (TP && (ui & 1)) ? nt1 : nt0;
        for (int t = 0; t < nt; t += 2) {
            const bool last = (t == nt - 2);
            const char* a1 = cA + (size_t)(t + 1) * kstep;
            const char* a2 = last ? nA : cA + (size_t)(t + 2) * kstep; const char* b2 = last ? nB : cB + (size_t)(t + 2) * kstep;
            const char* a3 = a2 + kstep; const char* b3 = b2 + kstep;
            PG8_LDB(B0, 0, 0); PG8_LDB(B1, 0, 1); PG8_SCHED; PG8_LDA(At, 0, 0); PG8_STAGE(PG8_SA(1, 1), a1 + hstep, voffA);
            PG8_WAIT_V(8); PG8_WAIT_L(0); PG8_BAR; PG8_MMA(0, 0, At, B0); PG8_MMA(0, 1, At, B1); PG8_BAR; PG8_SCHED;
            PG8_LDA(At, 0, 1); PG8_STAGE(PG8_SB(0, 0), b2, voffB); PG8_STAGE(PG8_SB(0, 1), b2 + hstep, voffB); PG8_STAGE(PG8_SA(0, 0), a2, voffA);
            PG8_WAIT_V(8); PG8_WAIT_L(0); PG8_BAR; PG8_MMA(1, 0, At, B0); PG8_MMA(1, 1, At, B1); PG8_BAR; PG8_SCHED;
            PG8_LDB(B0, 1, 0); PG8_LDB(B1, 1, 1); PG8_SCHED; PG8_LDA(At, 1, 0); PG8_STAGE(PG8_SA(0, 1), a2 + hstep, voffA);
            PG8_WAIT_V(8); PG8_WAIT_L(0); PG8_BAR; PG8_MMA(0, 0, At, B0); PG8_MMA(0, 1, At, B1); PG8_BAR; PG8_SCHED;
            PG8_LDA(At, 1, 1); PG8_STAGE(PG8_SB(1, 0), b3, voffB); PG8_STAGE(PG8_SB(1, 1), b3 + hstep, voffB); PG8_STAGE(PG8_SA(1, 0), a3, voffA);
            PG8_WAIT_V(8); PG8_WAIT_L(0); PG8_BAR; PG8_MMA(1, 0, At, B0); PG8_MMA(1, 1, At, B1); PG8_BAR; PG8_SCHED;
        }
        if (wr == 0) PG8_BAR;
        if constexpr (TP) { if ((ui & 1) == 0) E.mid(acc, cur, wr, wc, fr, fq); else E(acc, cur, wr, wc, fr, fq); } else E(acc, cur, wr, wc, fr, fq);
        if (!has_next) break;
        bool keep = false; if constexpr (TP) keep = Epi::KEEP_ACC && ((ui & 1) == 0);
        if (!keep)
#pragma unroll
        for (int a = 0; a < 2; ++a)
#pragma unroll
            for (int b = 0; b < 2; ++b)
#pragma unroll
                for (int m = 0; m < 4; ++m)
#pragma unroll
                    for (int n = 0; n < 2; ++n) acc[a][b][m][n] = (f32x4){0.f, 0.f, 0.f, 0.f};
        cur = nxt; cA = nA; cB = nB; ++ui;
        if (wr == 1) PG8_BAR;
    }
    PG8_WAIT_V(0);
    PG8_BAR;
#undef PG8_SA
#undef PG8_SB
#undef PG8_STAGE
#undef PG8_LDA
#undef PG8_LDB
#undef PG8_MMA
#undef PG8_WAIT_V
#undef PG8_WAIT_L
#undef PG8_KO
#undef PG8_BAR
#undef PG8_SCHED
}
}
using pg8::Unit;
typedef const f32x4 (&AccRef)[2][2][4][2];

#define EPI_LOOP_BEGIN \
    _Pragma("unroll") for (int ai = 0; ai < 2; ++ai) _Pragma("unroll") for (int m = 0; m < 4; ++m) { \
        const int row = u.pm * 256 + ai * 128 + wr * 64 + m * 16 + fr; \
        _Pragma("unroll") for (int bj = 0; bj < 2; ++bj) { \
            const int col = u.pn * 256 + bj * 128 + wc * 32 + 8 * fq; \
            const f32x4 v0 = acc[ai][bj][m][0], v1 = acc[ai][bj][m][1];
#define EPI_LOOP_END } }

struct EpiZ {
    static constexpr bool TWO_PART = false;
    h16 *zc, *zr, *zg;
    __device__ __forceinline__ void operator()(AccRef acc, const Unit& u, int wr, int wc, int fr, int fq) const {
        const int colt = u.pn * 256; h16* base; int ld, c0;
        if (colt < 1536) { base = zc; ld = 1536; c0 = colt; } else if (colt < 3328) { base = zr; ld = 1792; c0 = colt - 1536; } else { base = zg; ld = 2048; c0 = colt - 3328; }
        EPI_LOOP_BEGIN
            *(h16x8*)(base + (size_t)row * ld + (col - colt + c0)) = pack8(v0, v1);
        EPI_LOOP_END
    }
};
struct EpiF16 {
    static constexpr bool TWO_PART = false;
    h16* O; int ld;
    __device__ __forceinline__ void operator()(AccRef acc, const Unit& u, int wr, int wc, int fr, int fq) const {
        EPI_LOOP_BEGIN
            *(h16x8*)(O + (size_t)row * ld + col) = pack8(v0, v1);
        EPI_LOOP_END
    }
};
struct EpiMerged {
    static constexpr bool TWO_PART = true, KEEP_ACC = true;
    const h16* zg; h16* merged;
    __device__ __forceinline__ void mid(f32x4 (&acc)[2][2][4][2], const Unit& u, int wr, int wc, int fr, int fq) const {
#pragma unroll
        for (int ai = 0; ai < 2; ++ai) {
            h16x8 gav[4][2], gbv[4][2];
#pragma unroll
            for (int m = 0; m < 4; ++m) { const int row = u.pm * 256 + ai * 128 + wr * 64 + m * 16 + fr;
#pragma unroll
                for (int bj = 0; bj < 2; ++bj) { const int col = u.pn * 256 + bj * 128 + wc * 32 + 8 * fq;
                    gav[m][bj] = *(const h16x8*)(zg + (size_t)row * 2048 + col); gbv[m][bj] = *(const h16x8*)(zg + (size_t)row * 2048 + 1024 + col); } }
#pragma unroll
            for (int m = 0; m < 4; ++m)
#pragma unroll
                for (int bj = 0; bj < 2; ++bj) { const h16x8 ga = gav[m][bj], gb = gbv[m][bj];
#pragma unroll
                    for (int j = 0; j < 4; ++j) {
                        acc[ai][bj][m][0][j] *= (1.0f + __expf(-(float)gb[j])) * __builtin_amdgcn_rcpf(1.0f + __expf(-(float)ga[j]));
                        acc[ai][bj][m][1][j] *= (1.0f + __expf(-(float)gb[4 + j])) * __builtin_amdgcn_rcpf(1.0f + __expf(-(float)ga[4 + j])); } }
        }
    }
    __device__ __forceinline__ void operator()(AccRef acc, const Unit& u, int wr, int wc, int fr, int fq) const {
#pragma unroll
        for (int ai = 0; ai < 2; ++ai) {
            h16x8 gvv[4][2];
#pragma unroll
            for (int m = 0; m < 4; ++m) { const int row = u.pm * 256 + ai * 128 + wr * 64 + m * 16 + fr;
#pragma unroll
                for (int bj = 0; bj < 2; ++bj) { const int col = u.pn * 256 + bj * 128 + wc * 32 + 8 * fq; gvv[m][bj] = *(const h16x8*)(zg + (size_t)row * 2048 + 1024 + col); } }
#pragma unroll
            for (int m = 0; m < 4; ++m) { const int row = u.pm * 256 + ai * 128 + wr * 64 + m * 16 + fr;
#pragma unroll
                for (int bj = 0; bj < 2; ++bj) { const int col = u.pn * 256 + bj * 128 + wc * 32 + 8 * fq;
                    const h16x8 gv = gvv[m][bj]; const f32x4 v0 = acc[ai][bj][m][0], v1 = acc[ai][bj][m][1];
                    f32x4 o0, o1;
#pragma unroll
                    for (int j = 0; j < 4; ++j) { o0[j] = sigmoidf_((float)gv[j]) * v0[j]; o1[j] = sigmoidf_((float)gv[4 + j]) * v1[j]; }
                    *(h16x8*)(merged + (size_t)row * 1024 + col) = pack8(o0, o1); } }
        }
    }
};
struct EpiH1 {
    static constexpr bool TWO_PART = false;
    const float* x; h16* hb; float* part;
    __device__ __forceinline__ void operator()(AccRef acc, const Unit& u, int wr, int wc, int fr, int fq) const {
#pragma unroll
        for (int ai = 0; ai < 2; ++ai) {
            f32x4 xv[4][2][2];
#pragma unroll
            for (int m = 0; m < 4; ++m) { const int row = u.pm * 256 + ai * 128 + wr * 64 + m * 16 + fr;
#pragma unroll
                for (int bj = 0; bj < 2; ++bj) { const int col = u.pn * 256 + bj * 128 + wc * 32 + 8 * fq; const float* xp = x + (size_t)row * 1024 + col;
                    xv[m][bj][0] = *(const f32x4*)xp; xv[m][bj][1] = *(const f32x4*)(xp + 4); } }
#pragma unroll
            for (int m = 0; m < 4; ++m) {
                const int row = u.pm * 256 + ai * 128 + wr * 64 + m * 16 + fr; float ss = 0.f;
#pragma unroll
                for (int bj = 0; bj < 2; ++bj) {
                    const int col = u.pn * 256 + bj * 128 + wc * 32 + 8 * fq;
                    const f32x4 o0 = xv[m][bj][0] + acc[ai][bj][m][0], o1 = xv[m][bj][1] + acc[ai][bj][m][1];
                    *(h16x8*)(hb + (size_t)row * 1024 + col) = pack8(o0, o1);
                    ss += (o0[0] * o0[0] + o0[1] * o0[1]) + (o0[2] * o0[2] + o0[3] * o0[3]) + (o1[0] * o1[0] + o1[1] * o1[1]) + (o1[2] * o1[2] + o1[3] * o1[3]);
                }
                { const int ln_ = fr + 16 * fq; ss += x16_(ss, ln_); ss += x32_(ss, ln_); }
                if (fq == 0) part[(size_t)row * 16 + u.pn * 4 + wc] = ss;
            }
        }
    }
};
struct EpiGate {
    static constexpr bool TWO_PART = false;
    h16* h3b; const h16* h2b; const h16* pp; const float* rs2; float* part;
    __device__ __forceinline__ void operator()(AccRef acc, const Unit& u, int wr, int wc, int fr, int fq) const {
#pragma unroll
        for (int ai = 0; ai < 2; ++ai) {
            float rsv[4]; h16x8 hvv[4][2], pvv[4][2];
            { f32x4 sav[4], sbv[4];
#pragma unroll
              for (int m = 0; m < 4; ++m) { const int row = u.pm * 256 + ai * 128 + wr * 64 + m * 16 + fr; sav[m] = *(const f32x4*)(rs2 + (size_t)row * 8); sbv[m] = *(const f32x4*)(rs2 + (size_t)row * 8 + 4); }
#pragma unroll
              for (int m = 0; m < 4; ++m) { const f32x4 sa = sav[m], sb = sbv[m]; rsv[m] = rsqrtf(((sa[0] + sa[1]) + (sa[2] + sa[3]) + (sb[0] + sb[1]) + (sb[2] + sb[3])) * (1.f / 1024.f) + NORM_EPS); } }
#pragma unroll
            for (int m = 0; m < 4; ++m) { const int row = u.pm * 256 + ai * 128 + wr * 64 + m * 16 + fr;
#pragma unroll
                for (int bj = 0; bj < 2; ++bj) { const int col = u.pn * 256 + bj * 128 + wc * 32 + 8 * fq;
                    hvv[m][bj] = *(const h16x8*)(h2b + (size_t)row * 1024 + col); pvv[m][bj] = *(const h16x8*)(pp + (size_t)row * 1024 + col); } }
#pragma unroll
            for (int m = 0; m < 4; ++m) {
                const int row = u.pm * 256 + ai * 128 + wr * 64 + m * 16 + fr; float ss = 0.f;
                const float rs = rsv[m];
#pragma unroll
                for (int bj = 0; bj < 2; ++bj) {
                    const int col = u.pn * 256 + bj * 128 + wc * 32 + 8 * fq;
                    const h16x8 hv = hvv[m][bj];
                    f32x4 o0 = (f32x4){(float)hv[0], (float)hv[1], (float)hv[2], (float)hv[3]}, o1 = (f32x4){(float)hv[4], (float)hv[5], (float)hv[6], (float)hv[7]};
                    const h16x8 pv = pvv[m][bj];
                    const f32x4 v0 = acc[ai][bj][m][0], v1 = acc[ai][bj][m][1];
#pragma unroll
                    for (int j = 0; j < 4; ++j) { o0[j] += sigmoidf_(rs * v0[j]) * (float)pv[j]; o1[j] += sigmoidf_(rs * v1[j]) * (float)pv[4 + j]; }
                    *(h16x8*)(h3b + (size_t)row * 1024 + col) = pack8(o0, o1);
                    ss += (o0[0] * o0[0] + o0[1] * o0[1]) + (o0[2] * o0[2] + o0[3] * o0[3]) + (o1[0] * o1[0] + o1[1] * o1[1]) + (o1[2] * o1[2] + o1[3] * o1[3]);
                }
                { const int ln_ = fr + 16 * fq; ss += x16_(ss, ln_); ss += x32_(ss, ln_); }
                if (fq == 0) part[(size_t)row * 16 + u.pn * 4 + wc] = ss;
            }
        }
    }
};
struct EpiPPGate {
    static constexpr bool TWO_PART = true, KEEP_ACC = false;
    h16* h3b; const h16* h2b; h16* pp; const float* rs2; float* part;
    __device__ __forceinline__ void mid(f32x4 (&acc)[2][2][4][2], const Unit& u, int wr, int wc, int fr, int fq) const {
#pragma unroll
        for (int ai = 0; ai < 2; ++ai)
#pragma unroll
            for (int m = 0; m < 4; ++m) { const int row = u.pm * 256 + ai * 128 + wr * 64 + m * 16 + fr;
#pragma unroll
                for (int bj = 0; bj < 2; ++bj) { const int col = u.pn * 256 + bj * 128 + wc * 32 + 8 * fq;
                    *(h16x8*)(pp + (size_t)row * 1024 + col) = pack8(acc[ai][bj][m][0], acc[ai][bj][m][1]); } }
    }
    __device__ __forceinline__ void operator()(AccRef acc, const Unit& u, int wr, int wc, int fr, int fq) const {
#pragma unroll
        for (int ai = 0; ai < 2; ++ai) {
            float rsv[4]; h16x8 hvv[4][2], pvv[4][2];
            { f32x4 sav[4], sbv[4];
#pragma unroll
              for (int m = 0; m < 4; ++m) { const int row = u.pm * 256 + ai * 128 + wr * 64 + m * 16 + fr; sav[m] = *(const f32x4*)(rs2 + (size_t)row * 8); sbv[m] = *(const f32x4*)(rs2 + (size_t)row * 8 + 4); }
#pragma unroll
              for (int m = 0; m < 4; ++m) { const f32x4 sa = sav[m], sb = sbv[m]; rsv[m] = rsqrtf(((sa[0] + sa[1]) + (sa[2] + sa[3]) + (sb[0] + sb[1]) + (sb[2] + sb[3])) * (1.f / 1024.f) + NORM_EPS); } }
#pragma unroll
          for (int m2 = 0; m2 < 4; m2 += 2) {
#pragma unroll
            for (int m = m2; m < m2 + 2; ++m) { const int row = u.pm * 256 + ai * 128 + wr * 64 + m * 16 + fr;
#pragma unroll
                for (int bj = 0; bj < 2; ++bj) { const int col = u.pn * 256 + bj * 128 + wc * 32 + 8 * fq;
                    hvv[m][bj] = *(const h16x8*)(h2b + (size_t)row * 1024 + col); pvv[m][bj] = *(const h16x8*)(pp + (size_t)row * 1024 + col); } }
#pragma unroll
            for (int m = m2; m < m2 + 2; ++m) {
                const int row = u.pm * 256 + ai * 128 + wr * 64 + m * 16 + fr; float ss = 0.f;
                const float rs = rsv[m];
#pragma unroll
                for (int bj = 0; bj < 2; ++bj) {
                    const int col = u.pn * 256 + bj * 128 + wc * 32 + 8 * fq;
                    const h16x8 hv = hvv[m][bj];
                    f32x4 o0 = (f32x4){(float)hv[0], (float)hv[1], (float)hv[2], (float)hv[3]}, o1 = (f32x4){(float)hv[4], (float)hv[5], (float)hv[6], (float)hv[7]};
                    const h16x8 pv = pvv[m][bj];
                    const f32x4 v0 = acc[ai][bj][m][0], v1 = acc[ai][bj][m][1];
#pragma unroll
                    for (int j = 0; j < 4; ++j) { o0[j] += sigmoidf_(rs * v0[j]) * (float)pv[j]; o1[j] += sigmoidf_(rs * v1[j]) * (float)pv[4 + j]; }
                    *(h16x8*)(h3b + (size_t)row * 1024 + col) = pack8(o0, o1);
                    ss += (o0[0] * o0[0] + o0[1] * o0[1]) + (o0[2] * o0[2] + o0[3] * o0[3]) + (o1[0] * o1[0] + o1[1] * o1[1]) + (o1[2] * o1[2] + o1[3] * o1[3]);
                }
                { const int ln_ = fr + 16 * fq; ss += x16_(ss, ln_); ss += x32_(ss, ln_); }
                if (fq == 0) part[(size_t)row * 16 + u.pn * 4 + wc] = ss;
            }
          }
        }
    }
};

__device__ __forceinline__ void tr_item(const float* W, int N, const float* g, h16* WT, int ldk, int koff, int k0, int n0, LAS float* scr, int lane) {
#pragma unroll 8
    for (int i = 0; i < 32; ++i) { const int kk = 2 * i + (lane >> 5); float v = W[(size_t)(k0 + kk) * N + n0 + (lane & 31)]; if (g) v *= g[k0 + kk]; scr[kk * 33 + (lane & 31)] = v; }
    asm volatile("s_waitcnt lgkmcnt(0)" ::: "memory");
    const int c = lane & 7;
#pragma unroll
    for (int j = 0; j < 4; ++j) { const int n = (lane >> 3) + 8 * j; const LAS float* s = scr + (8 * c) * 33 + n;
        h16x8 o;
#pragma unroll
        for (int e = 0; e < 8; ++e) o[e] = (h16)s[e * 33];
        *(h16x8*)(WT + (size_t)(n0 + n) * ldk + koff + k0 + 8 * c) = o; }
    asm volatile("s_waitcnt lgkmcnt(0)" ::: "memory");
}
struct TrJob { const float* W; const float* g; h16* WT; int K, N, ldk, koff; };

__device__ __forceinline__ void phase_prep(const Args& a, LAS unsigned char* lds) {
    const int tid = tid_(), lane = tid & 63, wave = tid >> 6;
    const int gw = blockIdx.x * NWAVES + wave, NGW = gridDim.x * NWAVES;
    unsigned char* ws = a.ws;
    {
        LAS float* scr = (LAS float*)(lds + wave * 8704);
        TrJob jobs[9] = {
            {a.in[3], a.in[2], (h16*)(ws + O_WIN), 1024, NIN, 1024, 0},
            {a.in[17], nullptr, (h16*)(ws + O_WA), 512, 1024, 512, 0},
            {a.in[18], nullptr, (h16*)(ws + O_WB), 512, 1024, 512, 0},
            {a.in[19], nullptr, (h16*)(ws + O_WO), 1024, 1024, 1024, 0},
            {a.in[26], a.in[25], (h16*)(ws + O_WG), 1024, 1024, 1024, 0},
            {a.in[27], nullptr, (h16*)(ws + O_WP), 256, 1024, 1024, 0},
            {a.in[8], nullptr, (h16*)(ws + O_WLR), 64, 512, 256, 0},
            {a.in[10], nullptr, (h16*)(ws + O_WLR) + (size_t)512 * 256, 64, 512, 256, 64},
            {a.in[11], nullptr, (h16*)(ws + O_WLR) + (size_t)1024 * 256, 128, 512, 256, 128},
        };
        int base = 0;
#pragma unroll
        for (int j = 0; j < 9; ++j) {
            const TrJob J = jobs[j]; const int nnb = J.N / 32, items = (J.K / 64) * nnb;
            int first = gw - (base % NGW); if (first < 0) first += NGW;
            for (int r = first; r < items; r += NGW) tr_item(J.W, J.N, J.g, J.WT, J.ldk, J.koff, (r / nnb) * 64, (r % nnb) * 32, scr, lane);
            base += items;
        }
        h16* wlr = (h16*)(ws + O_WLR);
        for (int i = blockIdx.x * NTHREADS + tid; i < 1536 * 256 / 8; i += gridDim.x * NTHREADS) {
            const int n = (i * 8) / 256, k = (i * 8) % 256; const int blk = n / 512;
            const bool inblk = (blk == 0) ? (k < 64) : (blk == 1) ? (k >= 64 && k < 128) : (k >= 128);
            if (!inblk) { h16x8 z; for (int e = 0; e < 8; ++e) z[e] = (h16)0.f; *(h16x8*)(wlr + (size_t)i * 8) = z; }
        }
    }
    __syncthreads();
    {
        LAS float* LA = (LAS float*)lds;
        LAS float* LB = (LAS float*)(lds + 64 * 129 * 4);
        const float* wq = a.in[21]; const float* sk = a.in[22]; const float* gf = a.in[20];
        h16* wst = (h16*)(ws + O_WS);
        for (int it = blockIdx.x; it < 256; it += gridDim.x) {
            const int g16 = it >> 4, k0 = (it & 15) * 64;
            for (int i = tid; i < 64 * 128; i += NTHREADS) { const int k = i >> 7, d = i & 127; LA[k * 129 + d] = wq[(size_t)(k0 + k) * 2048 + g16 * 128 + d] * gf[k0 + k]; }
            for (int i = tid; i < 128 * 128; i += NTHREADS) { const int n = i >> 7, d = i & 127; LB[n * 129 + d] = sk[((size_t)g16 * 128 + n) * 128 + d]; }
            __syncthreads();
            const int n = tid & 127, kg = tid >> 7;
            float o[16];
#pragma unroll
            for (int j = 0; j < 16; ++j) o[j] = 0.f;
            for (int d = 0; d < 128; ++d) { const float b = LB[n * 129 + d];
#pragma unroll
                for (int j = 0; j < 16; ++j) o[j] += LA[(kg * 16 + j) * 129 + d] * b; }
            h16x8 o0, o1;
#pragma unroll
            for (int j = 0; j < 8; ++j) { o0[j] = (h16)o[j]; o1[j] = (h16)o[8 + j]; }
            h16* dst = wst + (size_t)(g16 * 128 + n) * 1024 + k0 + kg * 16;
            *(h16x8*)dst = o0; *(h16x8*)(dst + 8) = o1;
            __syncthreads();
        }
    }
    {
        const float* gf = a.in[20];
        f32x4 g4[4];
#pragma unroll
        for (int j = 0; j < 4; ++j) g4[j] = *(const f32x4*)(gf + 16 * lane + 4 * j);
        for (int rq = gw; rq < 2 * 16384; rq += 4 * NGW) {
            f32x4 vv[4][4];
#pragma unroll
            for (int q2 = 0; q2 < 4; ++q2) { const int r = rq + q2 * NGW; if (r < 2 * 16384) { const int tb = r >> 14, e = r & 16383;
                const float* src = (tb ? a.in[24] : a.in[23]) + (size_t)e * 1024 + 16 * lane;
#pragma unroll
                for (int j = 0; j < 4; ++j) vv[q2][j] = *(const f32x4*)(src + 4 * j); } }
#pragma unroll
            for (int q2 = 0; q2 < 4; ++q2) { const int r = rq + q2 * NGW; if (r < 2 * 16384) { const int tb = r >> 14, e = r & 16383;
                f32x4 v[4]; float mx = 0.f;
#pragma unroll
                for (int j = 0; j < 4; ++j) { v[j] = vv[q2][j]; if (!tb) v[j] = v[j] * g4[j];
#pragma unroll
                    for (int c = 0; c < 4; ++c) mx = fmaxf(mx, fabsf(v[j][c])); }
                mx = wave_max(mx);
                mx = fmaxf(mx, 1e-30f);
                const float sc = 127.0f / mx;
                u32x4 q;
#pragma unroll
                for (int j = 0; j < 4; ++j) {
                    const int i0 = __float2int_rn(v[j][0] * sc), i1 = __float2int_rn(v[j][1] * sc), i2 = __float2int_rn(v[j][2] * sc), i3 = __float2int_rn(v[j][3] * sc);
                    q[j] = (unsigned)(i0 & 0xff) | ((unsigned)(i1 & 0xff) << 8) | ((unsigned)(i2 & 0xff) << 16) | ((unsigned)i3 << 24); }
                unsigned char* dst = ws + (tb ? O_V8 : O_U8) + ((size_t)(lane >> 3) * 16384 + e) * 128 + 16 * (lane & 7);
                *(u32x4*)dst = q;
                if (lane == 0) ((float*)(ws + (tb ? O_VSC : O_USC)))[e] = mx * (1.0f / 127.0f); } }
        }
        if (blockIdx.x == 0 && tid < 32) ((unsigned*)(ws + O_CTR))[tid * 64] = 0u;
    }
    {
        const float* x = a.in[0]; h16* xn = (h16*)(ws + O_XN);
#define XN_LOAD(VV, RQ) do { _Pragma("unroll") for (int q = 0; q < 4; ++q) { const int r = (RQ) + q * NGW; if (r < MTOK) { const f32x4* xr = (const f32x4*)(x + (size_t)r * 1024) + lane; \
                _Pragma("unroll") for (int j = 0; j < 4; ++j) VV[q][j] = xr[64 * j]; } } } while (0)
#define XN_COMP(VV, RQ) do { _Pragma("unroll") for (int q = 0; q < 4; ++q) { const int r = (RQ) + q * NGW; if (r < MTOK) { float s = 0.f; \
                _Pragma("unroll") for (int j = 0; j < 4; ++j) s += (VV[q][j][0] * VV[q][j][0] + VV[q][j][1] * VV[q][j][1]) + (VV[q][j][2] * VV[q][j][2] + VV[q][j][3] * VV[q][j][3]); \
                const float rs = rsqrtf(wave_sum(s) * (1.f / 1024.f) + NORM_EPS); \
                h16x4* o = (h16x4*)(xn + (size_t)r * 1024) + lane; \
                _Pragma("unroll") for (int j = 0; j < 4; ++j) o[64 * j] = pack4(VV[q][j] * rs); } } } while (0)
        f32x4 vA[4][4], vB[4][4];
        const int step = 4 * NGW;
        XN_LOAD(vA, gw);
        for (int rq = gw; rq < MTOK; rq += 2 * step) {
            XN_LOAD(vB, rq + step);
            XN_COMP(vA, rq);
            XN_LOAD(vA, rq + 2 * step);
            XN_COMP(vB, rq + step);
        }
#undef XN_LOAD
#undef XN_COMP
    }
}

__device__ __forceinline__ void phase_conv(const Args& a) {
    const int tid = tid_(), lane = tid & 63, wave = tid >> 6;
    const int gw = blockIdx.x * NWAVES + wave, NGW = gridDim.x * NWAVES;
    const h16* zc = (const h16*)(a.ws + O_ZC); h16* ca = (h16*)(a.ws + O_CA);
    const float* cw = a.in[4]; const float* cb = a.in[5];
    float w0[8], w1[8], w2[8], bb[8];
#pragma unroll
    for (int j = 0; j < 8; ++j) { const int c = lane * 8 + j; w0[j] = cw[c]; w1[j] = cw[512 + c]; w2[j] = cw[1024 + c]; bb[j] = cb[c]; }
    for (int run = gw; run < MTOK / 32; run += NGW) {
        const int t0 = run * 32;
        float u1[8], u2[8];
        if ((t0 % SEQ) == 0) {
#pragma unroll
            for (int j = 0; j < 8; ++j) { u1[j] = 0.f; u2[j] = 0.f; }
        } else {
            const h16x8 c1 = *(const h16x8*)(zc + (size_t)(t0 - 1) * 1536 + 512 + lane * 8), x1 = *(const h16x8*)(zc + (size_t)(t0 - 1) * 1536 + 1024 + lane * 8);
            const h16x8 c2 = *(const h16x8*)(zc + (size_t)(t0 - 2) * 1536 + 512 + lane * 8), x2 = *(const h16x8*)(zc + (size_t)(t0 - 2) * 1536 + 1024 + lane * 8);
#pragma unroll
            for (int j = 0; j < 8; ++j) { u1[j] = (float)c1[j] * (float)x1[j]; u2[j] = (float)c2[j] * (float)x2[j]; }
        }
#define CV_LOAD(GB, GC, XI, TB) do { _Pragma("unroll") for (int q = 0; q < 4; ++q) { const h16* zrow = zc + (size_t)((TB) + q) * 1536 + lane * 8; GB[q] = *(const h16x8*)zrow; GC[q] = *(const h16x8*)(zrow + 512); XI[q] = *(const h16x8*)(zrow + 1024); } } while (0)
#define CV_COMP(GB, GC, XI, TB) do { _Pragma("unroll") for (int q = 0; q < 4; ++q) { const int t = (TB) + q; const h16x8 gb = GB[q], gc = GC[q], xi = XI[q]; \
                h16x8 o; \
                _Pragma("unroll") for (int j = 0; j < 8; ++j) { const float u0 = (float)gc[j] * (float)xi[j]; \
                    const float y = w0[j] * u2[j] + w1[j] * u1[j] + w2[j] * u0 + bb[j]; \
                    o[j] = (h16)((float)gb[j] * y); u2[j] = u1[j]; u1[j] = u0; } \
                *(h16x8*)(ca + (size_t)t * 512 + lane * 8) = o; } } while (0)
        h16x8 gbA[4], gcA[4], xiA[4], gbB[4], gcB[4], xiB[4];
        CV_LOAD(gbA, gcA, xiA, t0);
        for (int tb = t0; tb < t0 + 32; tb += 8) {
            CV_LOAD(gbB, gcB, xiB, tb + 4);
            CV_COMP(gbA, gcA, xiA, tb);
            if (tb + 8 < t0 + 32) CV_LOAD(gbA, gcA, xiA, tb + 8);
            CV_COMP(gbB, gcB, xiB, tb + 4);
        }
#undef CV_LOAD
#undef CV_COMP
    }
}


__device__ __forceinline__ float tanhf_(float x) { return 1.0f - 2.0f * __builtin_amdgcn_rcpf(1.0f + __expf(2.0f * x)); }
__device__ __forceinline__ void phase_rwkv_prep(const Args& a) {
    const int tid = tid_(), lane = tid & 63, wave = tid >> 6;
    const int gw = blockIdx.x * NWAVES + wave, NGW = gridDim.x * NWAVES;
    const h16* zr = (const h16*)(a.ws + O_ZR);
    h16* R = (h16*)a.out; h16* KS = R + (size_t)MTOK * 512; h16* V = KS + (size_t)MTOK * 512; h16* KK = V + (size_t)MTOK * 512;
    h16* APR = (h16*)(a.ws + O_APR);
    const float* mu = a.in[6]; const float* k_k = a.in[12];
    float mr[8], mk[8], mv[8], mt[8], kk8[8];
#pragma unroll
    for (int j = 0; j < 8; ++j) { const int c = lane * 8 + j; mr[j] = mu[c]; mk[j] = mu[512 + c]; mv[j] = mu[1024 + c]; mt[j] = mu[1536 + (c & 255)]; kk8[j] = k_k[c]; }
    for (int run = gw; run < MTOK / 32; run += NGW) {
        const int t0 = run * 32;
        float pr[8], pk[8], pv[8], pt[8];
        if ((t0 % SEQ) == 0) {
#pragma unroll
            for (int j = 0; j < 8; ++j) { pr[j] = 0.f; pk[j] = 0.f; pv[j] = 0.f; pt[j] = 0.f; }
        } else {
            const h16* zp = zr + (size_t)(t0 - 1) * 1792 + lane * 8;
            const h16x8 a0 = *(const h16x8*)zp, a1 = *(const h16x8*)(zp + 512), a2 = *(const h16x8*)(zp + 1024), a3 = *(const h16x8*)(zr + (size_t)(t0 - 1) * 1792 + 1536 + (lane & 31) * 8);
#pragma unroll
            for (int j = 0; j < 8; ++j) { pr[j] = (float)a0[j]; pk[j] = (float)a1[j]; pv[j] = (float)a2[j]; pt[j] = (float)a3[j]; }
        }
#define RP_LOAD(A0, A1, A2, A3, TB) do { _Pragma("unroll") for (int q = 0; q < 2; ++q) { const h16* zp = zr + (size_t)((TB) + q) * 1792 + lane * 8; \
                A0[q] = *(const h16x8*)zp; A1[q] = *(const h16x8*)(zp + 512); A2[q] = *(const h16x8*)(zp + 1024); A3[q] = *(const h16x8*)(zr + (size_t)((TB) + q) * 1792 + 1536 + (lane & 31) * 8); } } while (0)
#define RP_COMP(A0, A1, A2, A3, TB) do { _Pragma("unroll") for (int q = 0; q < 2; ++q) { const int t = (TB) + q; const h16x8 a0 = A0[q], a1 = A1[q], a2 = A2[q], a3 = A3[q]; \
            h16x8 orr, ok, ov, okk, ot; float kr[8]; float ss = 0.f; \
            _Pragma("unroll") for (int j = 0; j < 8; ++j) { \
                const float zr_ = (float)a0[j], zk_ = (float)a1[j], zv_ = (float)a2[j], zt_ = (float)a3[j]; \
                const float r = zr_ + mr[j] * (pr[j] - zr_), k = zk_ + mk[j] * (pk[j] - zk_), v = zv_ + mv[j] * (pv[j] - zv_), tl = zt_ + mt[j] * (pt[j] - zt_); \
                pr[j] = zr_; pk[j] = zk_; pv[j] = zv_; pt[j] = zt_; \
                orr[j] = (h16)r; ok[j] = (h16)k; ov[j] = (h16)v; \
                kr[j] = k * kk8[j]; ss += kr[j] * kr[j]; \
                  \
                const float rc = __builtin_amdgcn_rcpf(1.0f + __expf(tsc * tl)); \
                const float tv = (lane < 8) ? (1.0f - 2.0f * rc) : (lane < 16) ? tl : rc; \
                ot[j] = (h16)tv; \
            } \
            ss += dpp_<0xB1>(ss); ss += dpp_<0x4E>(ss); ss += xhm_(ss);     \
            const float rn = rsqrtf(ss + 1e-12f); \
            _Pragma("unroll") for (int j = 0; j < 8; ++j) okk[j] = (h16)(kr[j] * rn); \
            const size_t o = (size_t)t * 512 + lane * 8; \
            *(h16x8*)(R + o) = orr; *(h16x8*)(KS + o) = ok; *(h16x8*)(V + o) = ov; *(h16x8*)(KK + o) = okk; \
            if (lane < 32) *(h16x8*)(APR + (size_t)t * 256 + lane * 8) = ot; } } while (0)
        const float tsc = (lane < 8) ? 2.0f : -1.0f;
        h16x8 a0A[2], a1A[2], a2A[2], a3A[2], a0B[2], a1B[2], a2B[2], a3B[2];
        RP_LOAD(a0A, a1A, a2A, a3A, t0);
        for (int tb = t0; tb < t0 + 32; tb += 4) {
            RP_LOAD(a0B, a1B, a2B, a3B, tb + 2);
            RP_COMP(a0A, a1A, a2A, a3A, tb);
            if (tb + 4 < t0 + 32) RP_LOAD(a0A, a1A, a2A, a3A, tb + 4);
            RP_COMP(a0B, a1B, a2B, a3B, tb + 2);
        }
#undef RP_LOAD
#undef RP_COMP
    }
}

struct EpiLR {
    static constexpr bool TWO_PART = false;
    const float *w0, *a0, *k_a; h16 *WD, *KS, *BD, *GG; const h16* KK;
    __device__ __forceinline__ void operator()(AccRef acc, const Unit& u, int wr, int wc, int fr, int fq) const {
        const int part = u.pn >> 1;
        EPI_LOOP_BEGIN
            const int c = col - part * 512; const size_t o = (size_t)row * 512 + c;
            if (part == 0) {
                const f32x4 b0 = *(const f32x4*)(w0 + c), b1 = *(const f32x4*)(w0 + c + 4); f32x4 o0, o1;
#pragma unroll
                for (int j = 0; j < 4; ++j) { o0[j] = __expf(-0.6065306597126334f * sigmoidf_(b0[j] + v0[j])); o1[j] = __expf(-0.6065306597126334f * sigmoidf_(b1[j] + v1[j])); }
                *(h16x8*)(WD + o) = pack8(o0, o1);
            } else if (part == 1) {
                const f32x4 b0 = *(const f32x4*)(a0 + c), b1 = *(const f32x4*)(a0 + c + 4), ka0 = *(const f32x4*)(k_a + c), ka1 = *(const f32x4*)(k_a + c + 4);
                const h16x8 ks = *(const h16x8*)(KS + o), kk = *(const h16x8*)(KK + o); f32x4 k0, k1, bb0, bb1;
#pragma unroll
                for (int j = 0; j < 4; ++j) { const float aa0 = sigmoidf_(b0[j] + v0[j]), aa1 = sigmoidf_(b1[j] + v1[j]);
                    k0[j] = (float)ks[j] * (1.0f + (aa0 - 1.0f) * ka0[j]); k1[j] = (float)ks[4 + j] * (1.0f + (aa1 - 1.0f) * ka1[j]);
                    bb0[j] = aa0 * (float)kk[j]; bb1[j] = aa1 * (float)kk[4 + j]; }
                *(h16x8*)(KS + o) = pack8(k0, k1); *(h16x8*)(BD + o) = pack8(bb0, bb1);
            } else {
                *(h16x8*)(GG + o) = pack8(v0, v1);
            }
        EPI_LOOP_END
    }
};

constexpr size_t O_VTB = O_ZR;
constexpr size_t O_BON = O_ZR + 64 * MiB;
constexpr int UT_WAVE_LDS = 15360;
typedef float f32x16 __attribute__((ext_vector_type(16)));
__device__ __forceinline__ size_t ut_ov(int j, int s) { return (size_t)(j >> 2) * 512 + (j & 3) * 16 + s; }
constexpr int UT_SEG = 8, UT_SEGB = SEQ / 16 / UT_SEG;
__device__ __forceinline__ void phase_ut_pre(const Args& a, LAS unsigned char* lds, int seg, int gw, int NGW) {
    const int tid = tid_(), lane = tid & 63, wave = tid >> 6;
    LAS unsigned char* Lb = lds + wave * UT_WAVE_LDS;
    LAS h16* YX = (LAS h16*)Lb;
    LAS float* GT = (LAS float*)(Lb + 9216);
    LAS float* TM = (LAS float*)(Lb + 13824);
    h16* R = (h16*)a.out; h16* KS = R + (size_t)MTOK * 512; h16* V = KS + (size_t)MTOK * 512; h16* KK = V + (size_t)MTOK * 512;
    h16* WD = (h16*)(a.ws + O_WD); h16* BD = (h16*)(a.ws + O_BD);
    h16* VTB = (h16*)(a.ws + O_VTB); float* BON = (float*)(a.ws + O_BON);
    for (int wi = gw; wi < 32768 / UT_SEG; wi += NGW) {
        const int bh = ((((wi / (UT_SEGB * 8)) * (SEQ / 16)) + seg * UT_SEGB + ((wi % (UT_SEGB * 8)) >> 3)) << 3) | (wi & 7);
        int ln = lane; asm volatile("" : "+v"(ln)); const int r16 = ln & 15;
        const int h = bh & 7, nb = bh >> 3; const size_t tok0 = (size_t)nb * 16; const size_t e0 = tok0 * 512 + h * 64;
        const float rk = a.in[14][h * 64 + lane];
        {
            h16x8 stg[12];
#pragma unroll
            for (int j = 0; j < 12; ++j) { const int ar = j >> 1, row = (lane >> 3) + 8 * (j & 1);
                const h16* base = (ar == 0) ? WD : (ar == 1) ? KK : (ar == 2) ? BD : (ar == 3) ? KS : (ar == 4) ? R : V;
                stg[j] = *(const h16x8*)(base + e0 + (size_t)row * 512 + (lane & 7) * 8); }
#pragma unroll
            for (int j = 0; j < 12; ++j) *(LAS h16x8*)((LAS h16*)Lb + ((j >> 1) * 16 + (lane >> 3) + 8 * (j & 1)) * 64 + (lane & 7) * 8) = stg[j];
            asm volatile("s_waitcnt lgkmcnt(0)" ::: "memory");
        }
        float w[16], kk[16], bb[16], kx[16], rr[16]; h16x8 vt0, vt1;
        { const LAS h16* IN = (const LAS h16*)Lb;
#pragma unroll
        for (int t = 0; t < 16; ++t) { w[t] = (float)IN[t * 64 + lane]; kk[t] = (float)IN[(16 + t) * 64 + lane]; bb[t] = (float)IN[(32 + t) * 64 + lane]; kx[t] = (float)IN[(48 + t) * 64 + lane]; rr[t] = (float)IN[(64 + t) * 64 + lane];
            if (t < 8) vt0[t] = IN[(80 + t) * 64 + lane]; else vt1[t - 8] = IN[(80 + t) * 64 + lane]; } }
        asm volatile("s_waitcnt lgkmcnt(0)" ::: "memory");
        { h16* vp = VTB + (size_t)bh * 1024 + lane * 16; *(h16x8*)vp = vt0; *(h16x8*)(vp + 8) = vt1; }
        {
            float q8[8], q4[4], q2[2];
#pragma unroll
            for (int i = 0; i < 8; ++i) q8[i] = swap_add32(rr[i] * kx[i] * rk, rr[i + 8] * kx[i + 8] * rk);
#pragma unroll
            for (int i = 0; i < 4; ++i) q4[i] = swap_add16(q8[i], q8[i + 4]);
#pragma unroll
            for (int i = 0; i < 2; ++i) { const float keep = (ln & 8) ? q4[i + 2] : q4[i], send = (ln & 8) ? q4[i] : q4[i + 2]; q2[i] = keep + x8_(send); }
            const float keep = (ln & 4) ? q2[1] : q2[0], send = (ln & 4) ? q2[0] : q2[1];
            float bonv = keep + xhm_(send);
            bonv += dpp_<0xB1>(bonv); bonv += dpp_<0x4E>(bonv);
            if ((lane & 3) == 0) BON[(tok0 + (lane >> 2)) * 8 + h] = bonv;
        }
        float Lt[16]; { float Lc = 0.f;
#pragma unroll
            for (int t = 0; t < 16; ++t) { Lc += __logf(w[t]); Lt[t] = Lc; } }
        const float Lref = Lt[7];
        float btil[16]; h16x8 kt0, kt1;
        LAS h16* OS = (LAS h16*)(Lb + 9216);
#pragma unroll
        for (int t = 0; t < 16; ++t) {
            const float Lp = t ? Lt[t - 1] : 0.f;
            const float ka = kk[t] * __expf(Lp - Lref), rt = rr[t] * __expf(Lt[t] - Lref), e2 = __expf(Lref - Lt[t]), bt = bb[t] * e2, kt = kx[t] * e2;
            YX[t * 72 + lane] = (h16)ka; YX[(16 + t) * 72 + lane] = (h16)rt; YX[(32 + t) * 72 + lane] = (h16)kt; YX[(48 + t) * 72 + lane] = (h16)bt;
            btil[t] = bt;
            OS[t * 64 + lane] = (h16)(kk[t] * __expf(Lp)); OS[(16 + t) * 64 + lane] = (h16)(rr[t] * __expf(Lt[t]));
            const float ktp = kx[t] * __expf(Lt[15] - Lt[t]);
            if (t < 8) kt0[t] = (h16)ktp; else kt1[t - 8] = (h16)ktp;
        }
        const float post = __expf(Lt[15] - Lref), w16 = __expf(Lt[15]);
        { h16* kp = KS + e0 + ut_ov(lane, 0); *(h16x8*)kp = kt0; *(h16x8*)(kp + 8) = kt1; }
        asm volatile("s_waitcnt lgkmcnt(0)" ::: "memory");
#pragma unroll
        for (int j = 0; j < 4; ++j) { const int row = (lane >> 3) + 8 * (j & 1); const h16x8 o8 = *(const LAS h16x8*)(OS + ((j >> 1) * 16 + row) * 64 + (lane & 7) * 8);
            *(h16x8*)(((j >> 1) ? R : KK) + e0 + (size_t)row * 512 + (lane & 7) * 8) = o8; }
        asm volatile("s_waitcnt lgkmcnt(0)" ::: "memory");
        f32x16 acc;
#pragma unroll
        for (int i = 0; i < 16; ++i) acc[i] = 0.f;
#pragma unroll
        for (int ks = 0; ks < 4; ++ks) {
            const h16x8 af = *(const LAS h16x8*)(YX + (lane & 31) * 72 + 8 * (lane >> 5) + 16 * ks), bf = *(const LAS h16x8*)(YX + (32 + (lane & 31)) * 72 + 8 * (lane >> 5) + 16 * ks);
            acc = __builtin_amdgcn_mfma_f32_32x32x16_f16(af, bf, acc, 0, 0, 0);
        }
#pragma unroll
        for (int i = 0; i < 16; ++i) GT[((i & 3) + 8 * (i >> 2) + 4 * (lane >> 5)) * 36 + (lane & 31)] = acc[i];
        asm volatile("s_waitcnt lgkmcnt(0)" ::: "memory");
        float T[16];
#pragma unroll
        for (int t = 0; t < 16; ++t) { float v = (r16 == t) ? 1.f : 0.f;
#pragma unroll
            for (int s2 = 0; s2 < t; ++s2) v -= T[s2] * GT[t * 36 + 16 + s2];
            T[t] = v; }
#pragma unroll
        for (int t = 0; t < 16; ++t) TM[r16 * 20 + t] = T[t];
        asm volatile("s_waitcnt lgkmcnt(0)" ::: "memory");
        float bcol[16];
#pragma unroll
        for (int s2 = 0; s2 < 16; ++s2) bcol[s2] = (s2 <= r16) ? GT[(16 + r16) * 36 + 16 + s2] : 0.f;
        h16x8 tb0, tb1, tp0, tp1;
#pragma unroll
        for (int r = 0; r < 16; ++r) { float s0 = 0.f, s1 = 0.f;
#pragma unroll
            for (int s2 = r; s2 < 16; ++s2) { const float tv = TM[r * 20 + s2]; s0 += tv * btil[s2]; s1 += tv * bcol[s2]; }
            s0 *= post;
            if (r < 8) { tb0[r] = (h16)s0; tp0[r] = (h16)s1; } else { tb1[r - 8] = (h16)s0; tp1[r - 8] = (h16)s1; } }
        { h16* bp = BD + e0 + ut_ov(lane, 0); *(h16x8*)bp = tb0; *(h16x8*)(bp + 8) = tb1; }
        if (lane < 16) {
            h16x8 a0, a1, p0, p1;
#pragma unroll
            for (int s2 = 0; s2 < 16; ++s2) { const float av = (s2 < ln) ? GT[ln * 36 + s2] : 0.f, pv = (s2 <= ln) ? GT[(16 + ln) * 36 + s2] : 0.f;
                if (s2 < 8) { a0[s2] = (h16)av; p0[s2] = (h16)pv; } else { a1[s2 - 8] = (h16)av; p1[s2 - 8] = (h16)pv; } }
            h16* ap = WD + e0 + (size_t)(lane >> 2) * 512 + (lane & 3) * 16;
            *(h16x8*)ap = a0; *(h16x8*)(ap + 8) = a1;
            *(h16x8*)(ap + 4 * 512) = p0; *(h16x8*)(ap + 4 * 512 + 8) = p1;
            *(h16x8*)(ap + 8 * 512) = tp0; *(h16x8*)(ap + 8 * 512 + 8) = tp1;
        }
        (WD + e0 + (size_t)12 * 512)[lane] = (h16)w16;
        asm volatile("s_waitcnt lgkmcnt(0)" ::: "memory");
    }
}
struct UtOps { u32x2 ka[2][2], rt[2][2], kt[4], tb[4], at, apt, tp, vb, w16[4]; };
struct UtRes { __amdgpu_buffer_rsrc_t kk, r, ks, bd, wd, vt, y; };
__device__ __forceinline__ void ut_load(UtOps& o, const UtRes& R, int so, unsigned offK, unsigned offT, unsigned offV, unsigned offF) {
#pragma unroll
    for (int ks = 0; ks < 2; ++ks)
#pragma unroll
        for (int p = 0; p < 2; ++p) { o.ka[ks][p] = __builtin_amdgcn_raw_buffer_load_b64(R.kk, offK + 64u * ks + 32u * p, so, 0); o.rt[ks][p] = __builtin_amdgcn_raw_buffer_load_b64(R.r, offK + 64u * ks + 32u * p, so, 0); }
#pragma unroll
    for (int kt = 0; kt < 4; ++kt) { o.kt[kt] = __builtin_amdgcn_raw_buffer_load_b64(R.ks, offT + 4096u * kt, so, 0); o.tb[kt] = __builtin_amdgcn_raw_buffer_load_b64(R.bd, offT + 4096u * kt, so, 0); }
    o.at = __builtin_amdgcn_raw_buffer_load_b64(R.wd, offT, so, 0); o.apt = __builtin_amdgcn_raw_buffer_load_b64(R.wd, offT + 4096u, so, 0); o.tp = __builtin_amdgcn_raw_buffer_load_b64(R.wd, offT + 8192u, so, 0);
    o.vb = __builtin_amdgcn_raw_buffer_load_b64(R.vt, offV, so, 0);
#pragma unroll
    for (int kt = 0; kt < 4; ++kt) o.w16[kt] = __builtin_amdgcn_raw_buffer_load_b64(R.wd, offF + 12u * 1024u + 32u * kt, so, 0);
}
__device__ __forceinline__ f32x4 h4f(u32x2 v) { const h16x4 h = __builtin_bit_cast(h16x4, v); return (f32x4){(float)h[0], (float)h[1], (float)h[2], (float)h[3]}; }
__device__ __forceinline__ h16x8 cat8(u32x2 lo, u32x2 hi) { u32x4 r; r[0] = lo[0]; r[1] = lo[1]; r[2] = hi[0]; r[3] = hi[1]; return __builtin_bit_cast(h16x8, r); }
__device__ __forceinline__ void ut_block(const UtOps& o, f32x4 (&S)[4], const UtRes& R, unsigned offY, int so) {
    const f32x4 zf = (f32x4){0.f, 0.f, 0.f, 0.f}; const u32x2 zu = (u32x2){0u, 0u};
    const h16x8 sb0 = pack8(S[0], S[1]), sb1 = pack8(S[2], S[3]);
    const h16x8 vb = cat8(o.vb, zu);
    f32x4 x1 = zf, y = zf;
    x1 = __builtin_amdgcn_mfma_f32_16x16x32_f16(cat8(o.ka[0][0], o.ka[0][1]), sb0, x1, 0, 0, 0); y = __builtin_amdgcn_mfma_f32_16x16x32_f16(cat8(o.rt[0][0], o.rt[0][1]), sb0, y, 0, 0, 0);
    x1 = __builtin_amdgcn_mfma_f32_16x16x32_f16(cat8(o.ka[1][0], o.ka[1][1]), sb1, x1, 0, 0, 0); y = __builtin_amdgcn_mfma_f32_16x16x32_f16(cat8(o.rt[1][0], o.rt[1][1]), sb1, y, 0, 0, 0);
    x1 = __builtin_amdgcn_mfma_f32_16x16x32_f16(cat8(o.at, zu), vb, x1, 0, 0, 0); y = __builtin_amdgcn_mfma_f32_16x16x32_f16(cat8(o.apt, zu), vb, y, 0, 0, 0);
    f32x4 St[4];
#pragma unroll
    for (int kt = 0; kt < 4; ++kt) St[kt] = __builtin_amdgcn_mfma_f32_16x16x32_f16(cat8(o.kt[kt], zu), vb, S[kt] * h4f(o.w16[kt]), 0, 0, 0);
    const h16x8 xb = pack8(-x1, zf);
    y = __builtin_amdgcn_mfma_f32_16x16x32_f16(cat8(o.tp, zu), xb, y, 0, 0, 0);
#pragma unroll
    for (int kt = 0; kt < 4; ++kt) S[kt] = __builtin_amdgcn_mfma_f32_16x16x32_f16(cat8(o.tb[kt], zu), xb, St[kt], 0, 0, 0);
#pragma unroll
    for (int rg = 0; rg < 4; ++rg) { const h16 hv = (h16)y[rg]; __builtin_amdgcn_raw_buffer_store_b16(__builtin_bit_cast(unsigned short, hv), R.y, offY + 1024u * rg, so, 0); }
}
constexpr int UT_RING = 4;
static_assert(UT_SEGB % 4 == 0, "the loader rotates four operand sets");
__device__ __forceinline__ LAS unsigned char* ut_slot(LAS unsigned char* lds, unsigned s) { return lds + (s < 2u ? 64u + s * 12288u : 131072u + 128u + (s - 2u) * 12288u); }
#define UT_FIELDS(F) F(0, ka[0][0]) F(1, ka[0][1]) F(2, ka[1][0]) F(3, ka[1][1]) F(4, rt[0][0]) F(5, rt[0][1]) F(6, rt[1][0]) F(7, rt[1][1]) F(8, kt[0]) F(9, kt[1]) F(10, kt[2]) F(11, kt[3]) \
    F(12, tb[0]) F(13, tb[1]) F(14, tb[2]) F(15, tb[3]) F(16, at) F(17, apt) F(18, tp) F(19, vb) F(20, w16[0]) F(21, w16[1]) F(22, w16[2]) F(23, w16[3])
__device__ __forceinline__ void ut_put(const UtOps& o, LAS unsigned char* sl, int lane) {
    LAS u32x2* p = (LAS u32x2*)(sl + lane * 8);
#define UT_F(i, f) p[(i) * 64] = o.f;
    UT_FIELDS(UT_F)
#undef UT_F
}
__device__ __forceinline__ void ut_get(UtOps& o, const LAS unsigned char* sl, int lane) {
    const LAS u32x2* p = (const LAS u32x2*)(sl + lane * 8);
#define UT_F(i, f) o.f = p[(i) * 64];
    UT_FIELDS(UT_F)
#undef UT_F
}
__device__ __forceinline__ void phase_ut_seq(const Args& a, LAS unsigned char* lds, int seg) {
    const int tid = tid_(), lane = tid & 63, wave = tid >> 6, fr = lane & 15, fq = lane >> 4;
    if (wave > 1) return;
    volatile LAS unsigned* prodp = (volatile LAS unsigned*)(lds + 131072 + 32);
    volatile LAS unsigned* consp = (volatile LAS unsigned*)(lds + 131072 + 48);
    unsigned base = wave ? *prodp : *consp;
    const int nb0 = seg * UT_SEGB;
    for (int item = blockIdx.x; item < 256; item += gridDim.x, base += UT_SEGB) {
        const int h = item & 7, q = item >> 3, g = q & 3, b = q >> 2;
        const size_t e0 = ((size_t)b * SEQ * 512 + h * 64) * 2 + (size_t)nb0 * 16384;
        const char* Rb = (const char*)a.out + e0; const char* KSb = Rb + (size_t)MTOK * 1024; const char* KKb = Rb + (size_t)3 * MTOK * 1024;
        const char* WDb = (const char*)(a.ws + O_WD) + e0; const char* BDb = (const char*)(a.ws + O_BD) + e0;
        const char* VTb = (const char*)(a.ws + O_VTB) + ((size_t)b * (SEQ / 16) * 8 + h) * 2048 + (size_t)nb0 * 16384;
        const unsigned offK = (unsigned)(fr * 1024 + 8 * fq), offT = (unsigned)((fr >> 2) * 512 + (fr & 3) * 16 + 4 * fq) * 2u, offV = (unsigned)((16 * g + fr) * 16 + 4 * fq) * 2u, offF = (unsigned)fq * 8u,
                       offY = (unsigned)((4 * fq) * 512 + 16 * g + fr) * 2u;
        UtRes RS; RS.kk = mkrsrc(KKb); RS.r = mkrsrc(Rb); RS.ks = mkrsrc(KSb); RS.bd = mkrsrc(BDb); RS.wd = mkrsrc(WDb); RS.vt = mkrsrc(VTb);
        RS.y = mkrsrc((const char*)(a.ws + O_Y) + e0);
#define UT_LD(o, nn) ut_load(o, RS, ((nn) < UT_SEGB ? (nn) : UT_SEGB - 1) * 16384, offK, offT, offV, offF)
        if (wave == 1) {
#define UT_PUT(o, nn) do { const unsigned gc = base + (unsigned)(nn); int guard = 0; \
                while ((int)(gc - *consp) >= UT_RING && ++guard < (1 << 24)) __builtin_amdgcn_s_sleep(1); \
                asm volatile("" ::: "memory"); ut_put(o, ut_slot(lds, gc % UT_RING), lane); \
                asm volatile("s_waitcnt lgkmcnt(0)" ::: "memory"); if (lane == 0) *prodp = gc + 1u; } while (0)
            UtOps l0, l1, l2, l3;
            UT_LD(l0, 0); UT_LD(l1, 1); UT_LD(l2, 2); UT_LD(l3, 3);
#pragma unroll 1
            for (int n = 0; n < UT_SEGB; n += 4) {
                UT_PUT(l0, n);     UT_LD(l0, n + 4);
                UT_PUT(l1, n + 1); UT_LD(l1, n + 5);
                UT_PUT(l2, n + 2); UT_LD(l2, n + 6);
                UT_PUT(l3, n + 3); UT_LD(l3, n + 7);
            }
#undef UT_PUT
            continue;
        }
        f32x4* sst = (f32x4*)(a.ws + O_SST2) + ((size_t)item * 64 + lane) * 4;
        f32x4 S[4];
#pragma unroll
        for (int kt = 0; kt < 4; ++kt) S[kt] = seg ? sst[kt] : (f32x4){0.f, 0.f, 0.f, 0.f};
#define UT_GET(o, nn) do { const unsigned gc = base + (unsigned)(nn); int guard = 0; \
            while ((int)(*prodp - gc) < 1 && ++guard < (1 << 24)) __builtin_amdgcn_s_sleep(0); \
            asm volatile("" ::: "memory"); ut_get(o, ut_slot(lds, gc % UT_RING), lane); } while (0)
#define UT_DONE(nn) do { asm volatile("s_waitcnt lgkmcnt(0)" ::: "memory"); if (lane == 0) *consp = base + (unsigned)(nn) + 1u; } while (0)
        UtOps oa, ob;
        UT_GET(oa, 0);
#pragma unroll 1
        for (int n = 0; n < UT_SEGB; n += 2) {
            UT_DONE(n);     UT_GET(ob, n + 1);                          ut_block(oa, S, RS, offY, n * 16384);
            UT_DONE(n + 1); if (n + 2 < UT_SEGB) UT_GET(oa, n + 2);     ut_block(ob, S, RS, offY, (n + 1) * 16384);
        }
#undef UT_GET
#undef UT_DONE
#undef UT_LD
#pragma unroll
        for (int kt = 0; kt < 4; ++kt) sst[kt] = S[kt];
    }
}
constexpr int POST_EARLY = 3;
__device__ __forceinline__ void phase_rwkv_post(const Args& a, int s0, int s1, int gw, int NGW);
__device__ __forceinline__ void phase_ut_step(const Args& a, LAS unsigned char* lds, int st) {
    const int wave = tid_() >> 6;
    if (st >= 1 && wave <= 1) { phase_ut_seq(a, lds, st - 1); return; }
    if (st < UT_SEG) { if (st == 0) phase_ut_pre(a, lds, st, blockIdx.x * NWAVES + wave, gridDim.x * NWAVES); else phase_ut_pre(a, lds, st, blockIdx.x * 6 + (wave - 2), gridDim.x * 6); }
    else phase_rwkv_post(a, 0, POST_EARLY, blockIdx.x * 6 + (wave - 2), gridDim.x * 6);
}

__device__ __forceinline__ void phase_rwkv_post(const Args& a, int s0, int s1, int gw, int NGW) {
    const int lane = tid_() & 63;
    const int per = (s1 - s0) * (SEQ / UT_SEG), NT = (MTOK / SEQ) * per;
    const h16* V = (const h16*)a.out + (size_t)2 * MTOK * 512;
    const h16* GG = (const h16*)(a.ws + O_GG); const h16* Y = (const h16*)(a.ws + O_Y); h16* YB = (h16*)(a.ws + O_YB); const float* BON = (const float*)(a.ws + O_BON);
    float lg[8], lb[8];
#pragma unroll
    for (int j = 0; j < 8; ++j) { const int c = lane * 8 + j; lg[j] = a.in[15][c]; lb[j] = a.in[16][c]; }
#define PO_LOAD(Y8, V8, G8, BS, TV, TQ) do { _Pragma("unroll") for (int q = 0; q < 4; ++q) { const int n = (TQ) + q * NGW; if (n < NT) { const int bq = n / per, t = bq * SEQ + s0 * (SEQ / UT_SEG) + (n - bq * per); TV[q] = t; \
            const size_t o = (size_t)t * 512 + lane * 8; Y8[q] = *(const h16x8*)(Y + o); V8[q] = *(const h16x8*)(V + o); G8[q] = *(const h16x8*)(GG + o); BS[q] = BON[(size_t)t * 8 + (lane >> 3)]; } } } while (0)
#define PO_COMP(Y8, V8, G8, BS, TV, TQ) do { _Pragma("unroll") for (int q = 0; q < 4; ++q) { const int n = (TQ) + q * NGW; if (n < NT) { const int t = TV[q]; const size_t o = (size_t)t * 512 + lane * 8; \
            const h16x8 y8 = Y8[q], v8 = V8[q], g8 = G8[q]; const float bs = BS[q]; \
            float y[8]; float sm = 0.f; \
            _Pragma("unroll") for (int j = 0; j < 8; ++j) { y[j] = (float)y8[j]; sm += y[j]; } \
            sm += dpp_<0xB1>(sm); sm += dpp_<0x4E>(sm); sm += dpp_<0x141>(sm); \
            const float mean = sm * (1.f / 64.f); float vs = 0.f; \
            _Pragma("unroll") for (int j = 0; j < 8; ++j) { y[j] -= mean; vs += y[j] * y[j]; } \
            vs += dpp_<0xB1>(vs); vs += dpp_<0x4E>(vs); vs += dpp_<0x141>(vs); \
            const float rstd = rsqrtf(vs * (1.f / 64.f) + 64e-5f); \
            h16x8 ov; \
            _Pragma("unroll") for (int j = 0; j < 8; ++j) ov[j] = (h16)((y[j] * rstd * lg[j] + lb[j] + bs * (float)v8[j]) * (float)g8[j]); \
            *(h16x8*)(YB + o) = ov; } } } while (0)
    h16x8 yA[4], vA[4], gA[4], yB[4], vB[4], gB[4]; float bA[4], bB[4]; int tA[4], tB[4];
    const int step = 4 * NGW;
    PO_LOAD(yA, vA, gA, bA, tA, gw);
    for (int tq = gw; tq < NT; tq += 2 * step) {
        PO_LOAD(yB, vB, gB, bB, tB, tq + step);
        PO_COMP(yA, vA, gA, bA, tA, tq);
        PO_LOAD(yA, vA, gA, bA, tA, tq + 2 * step);
        PO_COMP(yB, vB, gB, bB, tB, tq + step);
    }
#undef PO_LOAD
#undef PO_COMP
}

__device__ __forceinline__ void ins16(unsigned (&L)[16], unsigned x) {
#pragma unroll
    for (int j = 0; j < 16; ++j) { const unsigned hi = L[j] > x ? L[j] : x; x = L[j] > x ? x : L[j]; L[j] = hi; }
}
#define TK_CE(a, b) do { const unsigned hi_ = (a) > (b) ? (a) : (b); (b) = (a) > (b) ? (b) : (a); (a) = hi_; } while (0)
__device__ __forceinline__ void sort16_desc(unsigned (&v)[16]) {
#pragma unroll
    for (int p = 1; p < 16; p <<= 1)
#pragma unroll
        for (int k = p; k >= 1; k >>= 1)
#pragma unroll
            for (int j = k % p; j + k < 16; j += 2 * k)
#pragma unroll
                for (int i = 0; i < k; ++i) if (i + j + k < 16 && (i + j) / (2 * p) == (i + j + k) / (2 * p)) TK_CE(v[i + j], v[i + j + k]);
}
__device__ __forceinline__ void merge_top16(unsigned (&t)[16], const unsigned (&g)[16]) {
#pragma unroll
    for (int i = 0; i < 16; ++i) t[i] = t[i] > g[15 - i] ? t[i] : g[15 - i];
#pragma unroll
    for (int j = 8; j > 0; j >>= 1)
#pragma unroll
        for (int i = 0; i < 16; ++i) { const int l = i ^ j; if (l > i) TK_CE(t[i], t[l]); }
}
__device__ __forceinline__ unsigned ord32(float f) { const unsigned u = __float_as_uint(f); return (u & 0x80000000u) ? ~u : (u | 0x80000000u); }
__device__ __forceinline__ float unord32(unsigned k) { return __uint_as_float((k & 0x80000000u) ? (k & 0x7fffffffu) : ~k); }
__device__ __forceinline__ void phase_topk(const Args& a, LAS unsigned char* lds) {
    const int tid = tid_();
    const h16* SC = (const h16*)(a.ws + O_SCORES);
    const float* part = (const float*)(a.ws + O_PART1);
    unsigned short* IDX = (unsigned short*)(a.ws + O_IDX); h16* GATE = (h16*)(a.ws + O_GATE); float* RS1 = (float*)(a.ws + O_RS1);
    LAS unsigned char* LI = lds;
    for (int task = blockIdx.x * NTHREADS + tid; task < MTOK * 8; task += gridDim.x * NTHREADS) {
        const int t = task >> 3, h = task & 7;
        float ssq = 0.f;
#pragma unroll
        for (int j = 0; j < 4; ++j) { const f32x4 p4 = *(const f32x4*)(part + (size_t)t * 16 + 4 * j); ssq += (p4[0] + p4[1]) + (p4[2] + p4[3]); }
        const float rs = rsqrtf(ssq * (1.f / 1024.f) + NORM_EPS);
        if (h == 0) RS1[t] = rs;
        float sv[2][16];
#pragma unroll
        for (int c = 0; c < 2; ++c) {
            unsigned L[16];
#pragma unroll
            for (int j = 0; j < 16; ++j) L[j] = 0u;
            const h16* row = SC + (size_t)t * 2048 + h * 256 + c * 128;
#pragma unroll 1
            for (int ln = 0; ln < 2; ++ln) {
                u32x4 raw[8];
#pragma unroll
                for (int k = 0; k < 8; ++k) raw[k] = *(const u32x4*)(row + ln * 64 + k * 8);
#pragma unroll
                for (int g4 = 0; g4 < 4; ++g4) {
                    unsigned Gk[16];
#pragma unroll
                    for (int hh = 0; hh < 2; ++hh) { const u32x4 w4 = raw[2 * g4 + hh];
#pragma unroll
                        for (int d = 0; d < 4; ++d) {
                            const unsigned w = w4[d];
                            const unsigned sf = __builtin_bit_cast(unsigned, __builtin_bit_cast(s16x2, w) >> 15);
                            const unsigned o = w ^ (sf | 0x80008000u);
                            const int p0 = ln * 64 + g4 * 16 + hh * 8 + 2 * d;
                            Gk[hh * 8 + 2 * d] = (o << 16) | (unsigned)(127 - p0); Gk[hh * 8 + 2 * d + 1] = (o & 0xffff0000u) | (unsigned)(126 - p0); } }
                    sort16_desc(Gk);
                    if (g4 == 0 && ln == 0) {
#pragma unroll
                        for (int j = 0; j < 16; ++j) L[j] = Gk[j];
                    } else merge_top16(L, Gk);
                }
            }
#pragma unroll
            for (int j = 0; j < 16; ++j) {
                const unsigned o16 = L[j] >> 16; const unsigned bits = (o16 & 0x8000u) ? (o16 & 0x7fffu) : (~o16 & 0xffffu);
                union { unsigned short u; h16 f; } cv; cv.u = (unsigned short)bits; sv[c][j] = (float)cv.f;
                LI[(c * 16 + j) * 512 + tid] = (unsigned char)(127u - (L[j] & 127u));
            }
        }
        unsigned L[16], G1[16], G2[16], X0 = 0u, X1 = 0u;
        { int cnt = 0;
#pragma unroll
          for (int i = 0; i < 16; ++i)
#pragma unroll
            for (int j = 0; j < 16; ++j) if ((i + 1) * (j + 1) <= 16) {
                const unsigned key = (ord32(sv[0][i] + sv[1][j]) & ~255u) | (unsigned)(255 - (i * 16 + j));
                if (cnt < 16) L[cnt] = key; else if (cnt < 32) G1[cnt - 16] = key; else if (cnt < 48) G2[cnt - 32] = key; else if (cnt == 48) X0 = key; else X1 = key;
                ++cnt; } }
        sort16_desc(L); sort16_desc(G1); sort16_desc(G2); merge_top16(L, G1); merge_top16(L, G2);
        { TK_CE(X0, X1); unsigned G3[16];
#pragma unroll
          for (int j = 0; j < 16; ++j) G3[j] = 0u;
          G3[0] = X0; G3[1] = X1; merge_top16(L, G3); }
        float e[16]; float den = 0.f; const float mx = unord32(L[0] & ~255u) * rs;
        unsigned short id[16];
#pragma unroll
        for (int k = 0; k < 16; ++k) {
            const float v = unord32(L[k] & ~255u) * rs; e[k] = __expf(v - mx); den += e[k];
            const unsigned pos = 255u - (L[k] & 255u); const unsigned i = pos >> 4, j = pos & 15u;
            id[k] = (unsigned short)((unsigned)LI[i * 512 + tid] * 128u + (unsigned)LI[(16 + j) * 512 + tid]);
        }
        const float inv = __builtin_amdgcn_rcpf(den);
        u32x4 i0, i1;
        i0[0] = id[0] | (id[1] << 16); i0[1] = id[2] | (id[3] << 16); i0[2] = id[4] | (id[5] << 16); i0[3] = id[6] | (id[7] << 16);
        i1[0] = id[8] | (id[9] << 16); i1[1] = id[10] | (id[11] << 16); i1[2] = id[12] | (id[13] << 16); i1[3] = id[14] | (id[15] << 16);
        u32x4* ip = (u32x4*)(IDX + (size_t)task * 16); ip[0] = i0; ip[1] = i1;
        h16x8* gp = (h16x8*)(GATE + (size_t)task * 16);
#pragma unroll
        for (int k8 = 0; k8 < 2; ++k8) gp[k8] = pack8((f32x4){e[8 * k8] * inv, e[8 * k8 + 1] * inv, e[8 * k8 + 2] * inv, e[8 * k8 + 3] * inv}, (f32x4){e[8 * k8 + 4] * inv, e[8 * k8 + 5] * inv, e[8 * k8 + 6] * inv, e[8 * k8 + 7] * inv});
    }
}

__device__ __forceinline__ float gelu_tanh(float x) { const float u = 0.7978845608028654f * (x + 0.044715f * x * x * x); return 0.5f * x * (1.0f + tanhf_(u)); }
__device__ __forceinline__ unsigned xcc_id() { return (unsigned)__builtin_amdgcn_s_getreg((3 << 11) | 20) & 7u; }
constexpr bool GA_C16 = false;
constexpr int GA_TC = 8, GA_NCH = MTOK / GA_TC;
__device__ __forceinline__ void dec16(const u32x4 q, float (&o)[16]) {
#pragma unroll
    for (int w = 0; w < 4; ++w) { const f32x2 lo = __builtin_amdgcn_cvt_pk_f32_fp8((int)q[w], false), hi = __builtin_amdgcn_cvt_pk_f32_fp8((int)q[w], true);
        o[4 * w] = lo[0]; o[4 * w + 1] = lo[1]; o[4 * w + 2] = hi[0]; o[4 * w + 3] = hi[1]; }
}
__device__ __forceinline__ void dec16p(const u32x4 q, f32x2 (&o)[8]) {
#pragma unroll
    for (int w = 0; w < 4; ++w) { o[2 * w] = __builtin_amdgcn_cvt_pk_f32_fp8((int)q[w], false); o[2 * w + 1] = __builtin_amdgcn_cvt_pk_f32_fp8((int)q[w], true); }
}
struct GIdx { u32x4 a, b; };
__device__ __forceinline__ GIdx g_ldidx(__amdgpu_buffer_rsrc_t IDX, int t, int r8) { GIdx r; r.a = __builtin_amdgcn_raw_buffer_load_b128(IDX, 32 * r8, t * 256, 0); r.b = __builtin_amdgcn_raw_buffer_load_b128(IDX, 32 * r8 + 16, t * 256, 0); return r; }
__device__ __forceinline__ void g_quant(u32x4 xa_, u32x4 xb_, u32x4& xq, float& xs) {
    const h16x8 xa = __builtin_bit_cast(h16x8, xa_), xb = __builtin_bit_cast(h16x8, xb_);
    float x[16]; float mx = 0.f;
#pragma unroll
    for (int k = 0; k < 8; ++k) { x[k] = (float)xa[k]; x[8 + k] = (float)xb[k]; mx = fmaxf(mx, fmaxf(fabsf(x[k]), fabsf(x[8 + k]))); }
    mx = fmaxf(mx, dpp_<0xB1>(mx)); mx = fmaxf(mx, dpp_<0x4E>(mx)); mx = fmaxf(mx, dpp_<0x141>(mx));
    mx = fmaxf(mx, 1e-20f);
    const float inv = 127.0f * __builtin_amdgcn_rcpf(mx); xs = mx * (1.0f / 127.0f);
#pragma unroll
    for (int w = 0; w < 4; ++w) { const int i0 = __float2int_rn(x[4 * w] * inv), i1 = __float2int_rn(x[4 * w + 1] * inv), i2 = __float2int_rn(x[4 * w + 2] * inv), i3 = __float2int_rn(x[4 * w + 3] * inv);
        xq[w] = (unsigned)(i0 & 0xff) | ((unsigned)(i1 & 0xff) << 8) | ((unsigned)(i2 & 0xff) << 16) | ((unsigned)i3 << 24); }
}
__device__ __forceinline__ void g_issue8(const unsigned char* TBs, unsigned lo, const u32x4 ix, u32x4 (&q)[8]) {
#pragma unroll
    for (int i = 0; i < 8; ++i) { const unsigned w = ix[i >> 1]; const unsigned e = (i & 1) ? (w >> 16) : (w & 0xffffu); q[i] = *(const u32x4*)(TBs + (e * 128u + lo)); }
}
struct GSide { u32x4 a, b, c, d; };
template <int PH> __device__ __forceinline__ GSide g_ldside(__amdgpu_buffer_rsrc_t SD, __amdgpu_buffer_rsrc_t HR, int t, int j, int m, int r8) {
    GSide r;
    if (PH == 0) { r.a = __builtin_amdgcn_raw_buffer_load_b128(SD, 32 * m, t * 2048 + 256 * j, 0); r.b = __builtin_amdgcn_raw_buffer_load_b128(SD, 32 * m + 16, t * 2048 + 256 * j, 0); r.c = r.a; r.d = r.b; }
    else { r.a = __builtin_amdgcn_raw_buffer_load_b128(SD, 32 * r8, t * 256, 0); r.b = GA_C16 ? __builtin_amdgcn_raw_buffer_load_b128(SD, 32 * r8 + 16, t * 256, 0) : (u32x4){0u, 0u, 0u, 0u};
           r.c = (u32x4){__builtin_amdgcn_raw_buffer_load_b32(SD, 4 * r8, (int)(O_COEFS - O_COEF) + t * 32, 0), 0u, 0u, 0u}; r.d = r.c;
           r.d[0] = __builtin_amdgcn_raw_buffer_load_b32(HR, (128 * j + 16 * m + 2 * r8) * 2, t * 2048, 0); }
    return r;
}
template <int PH, int HALF> __device__ __forceinline__ void g_half(u32x4 (&q)[8], const GSide& sd, float (&pa)[16], int (&ah)[16], int (&al)[16]) {
    if (PH == 0) {
#pragma unroll
        for (int i = 0; i < 8; ++i) { int acc = 0;
#pragma unroll
            for (int w = 0; w < 4; ++w) acc = __builtin_amdgcn_sdot4((int)q[i][w], (int)sd.a[w], acc, false);
            pa[8 * HALF + i] = (float)acc; }
    } else {
#pragma unroll
        for (int g = 0; g < 2; ++g) {
            const int ch = (int)sd.a[2 * HALF + g], cl = (int)sd.b[2 * HALF + g];
#pragma unroll
            for (int w = 0; w < 4; ++w) {
                const unsigned a0 = q[4 * g][w], a1 = q[4 * g + 1][w], a2 = q[4 * g + 2][w], a3 = q[4 * g + 3][w];
                const unsigned t01l = __builtin_amdgcn_perm(a1, a0, 0x05010400u), t01h = __builtin_amdgcn_perm(a1, a0, 0x07030602u);
                const unsigned t23l = __builtin_amdgcn_perm(a3, a2, 0x05010400u), t23h = __builtin_amdgcn_perm(a3, a2, 0x07030602u);
                const unsigned o0 = __builtin_amdgcn_perm(t23l, t01l, 0x05040100u), o1 = __builtin_amdgcn_perm(t23l, t01l, 0x07060302u);
                const unsigned o2 = __builtin_amdgcn_perm(t23h, t01h, 0x05040100u), o3 = __builtin_amdgcn_perm(t23h, t01h, 0x07060302u);
                ah[4 * w] = __builtin_amdgcn_sdot4((int)o0, ch, ah[4 * w], false);         if (GA_C16) al[4 * w] = __builtin_amdgcn_sdot4((int)o0, cl, al[4 * w], false);
                ah[4 * w + 1] = __builtin_amdgcn_sdot4((int)o1, ch, ah[4 * w + 1], false); if (GA_C16) al[4 * w + 1] = __builtin_amdgcn_sdot4((int)o1, cl, al[4 * w + 1], false);
                ah[4 * w + 2] = __builtin_amdgcn_sdot4((int)o2, ch, ah[4 * w + 2], false); if (GA_C16) al[4 * w + 2] = __builtin_amdgcn_sdot4((int)o2, cl, al[4 * w + 2], false);
                ah[4 * w + 3] = __builtin_amdgcn_sdot4((int)o3, ch, ah[4 * w + 3], false); if (GA_C16) al[4 * w + 3] = __builtin_amdgcn_sdot4((int)o3, cl, al[4 * w + 3], false);
            }
        }
    }
}
template <int PH> __device__ __forceinline__ void g_finish(const Args& a, __amdgpu_buffer_rsrc_t PRT, int t, int j, int lane, float (&p)[16], float xs, unsigned hpre) {
    const int m = lane & 7, r8 = lane >> 3;
    float q8[8], q4[4], q2[2];
    if (PH == 0) {
#pragma unroll
        for (int i = 0; i < 8; ++i) { const float keep = (lane & 4) ? p[i + 8] : p[i], send = (lane & 4) ? p[i] : p[i + 8]; q8[i] = keep + xhm_(send); }
#pragma unroll
        for (int i = 0; i < 4; ++i) { const float keep = (lane & 2) ? q8[i + 4] : q8[i], send = (lane & 2) ? q8[i] : q8[i + 4]; q4[i] = keep + dpp_<0x4E>(send); }
#pragma unroll
        for (int i = 0; i < 2; ++i) { const float keep = (lane & 1) ? q4[i + 2] : q4[i], send = (lane & 1) ? q4[i] : q4[i + 2]; q2[i] = keep + dpp_<0xB1>(send); }
        { const h16x2 pv = (h16x2){(h16)(q2[0] * xs), (h16)(q2[1] * xs)}; __builtin_amdgcn_raw_buffer_store_b32(__builtin_bit_cast(unsigned, pv), PRT, (16 * r8 + 2 * m) * 2, (j * MTOK + t) * 256, 0); }
    } else {
#pragma unroll
        for (int i = 0; i < 8; ++i) q8[i] = swap_add32(p[i], p[i + 8]);
#pragma unroll
        for (int i = 0; i < 4; ++i) q4[i] = swap_add16(q8[i], q8[i + 4]);
#pragma unroll
        for (int i = 0; i < 2; ++i) { const float keep = (lane & 8) ? q4[i + 2] : q4[i], send = (lane & 8) ? q4[i] : q4[i + 2]; q2[i] = keep + x8_(send); }
        const int col = 128 * j + 16 * m + 2 * r8;
        const h16x2 h1v = __builtin_bit_cast(h16x2, hpre);
        const f32x2 hv = (f32x2){(float)h1v[0] + q2[0], (float)h1v[1] + q2[1]};
        *(h16x2*)((h16*)(a.ws + O_H2B) + (size_t)t * 1024 + col) = (h16x2){(h16)hv[0], (h16)hv[1]};
        const float ss = wave_sum(hv[0] * hv[0] + hv[1] * hv[1]);
        if (lane == 0) ((float*)(a.ws + O_SS2))[(size_t)t * 8 + j] = ss;
    }
}
template <int PH>
__device__ __forceinline__ void phase_gather(const Args& a, int cset) {
    const int tid = tid_(), lane = tid & 63, m = lane & 7, r8 = lane >> 3;
    unsigned* ctr = (unsigned*)(a.ws + O_CTR) + cset * 8 * 64;
    const __amdgpu_buffer_rsrc_t IDX = mkrsrc(a.ws + O_IDX), SDR = mkrsrc(a.ws + (PH ? O_COEF : O_H1B)), PRT = mkrsrc(a.ws + O_PART), HR = mkrsrc(a.ws + O_H1B);
    const unsigned j0 = xcc_id();
    for (unsigned dj = 0; dj < 8; ++dj) {
        const unsigned j = (j0 + dj) & 7u;
        const unsigned char* TB = a.ws + (PH ? O_V8 : O_U8) + (size_t)j * 16384 * 128; const unsigned lo16 = 16u * (unsigned)m;
        unsigned c = 0; if (lane == 0) c = __hip_atomic_fetch_add(ctr + j * 64, 1u, __ATOMIC_RELAXED, __HIP_MEMORY_SCOPE_AGENT);
        c = (unsigned)__builtin_amdgcn_readfirstlane((int)c);
        if (c >= (unsigned)GA_NCH) continue;
        u32x4 qa[8], qb[8]; GSide sd, sn; GIdx ix, ixn;
        { const int t0 = c * GA_TC; ix = g_ldidx(IDX, t0, r8); g_issue8(TB, lo16, ix.a, qa); sd = g_ldside<PH>(SDR, HR, t0, j, m, r8); }
        for (;;) {
            const int t0 = c * GA_TC;
            unsigned cnv = 0; if (lane == 0) cnv = __hip_atomic_fetch_add(ctr + j * 64, 1u, __ATOMIC_RELAXED, __HIP_MEMORY_SCOPE_AGENT);
            unsigned cn = (unsigned)GA_NCH; int tnf = t0 + GA_TC - 1;
#define G_TOKEN(IXC, SDC, IXN, SNN, TI, TN) { \
                const int t = t0 + (TI), tn = (TN); \
                g_issue8(TB, lo16, IXC.b, qb); IXN = g_ldidx(IDX, tn, r8); SNN = g_ldside<PH>(SDR, HR, tn, j, m, r8); \
                float p[16]; int ah[16], al[16]; \
                if (PH == 1) { _Pragma("unroll") for (int k = 0; k < 16; ++k) { ah[k] = 0; al[k] = 0; } } \
                float xs = 1.f; \
                if (PH == 0) { u32x4 xq; g_quant(SDC.a, SDC.b, xq, xs); SDC.a = xq; } \
                if (PH == 0) __builtin_amdgcn_sched_barrier(0);     \
                g_half<PH, 0>(qa, SDC, p, ah, al); \
                if (PH == 0) __builtin_amdgcn_sched_barrier(0); \
                g_issue8(TB, lo16, IXN.a, qa); \
                if (PH == 0) __builtin_amdgcn_sched_barrier(0);     \
                g_half<PH, 1>(qb, SDC, p, ah, al); \
                if (PH == 1) { const float cs = __uint_as_float(SDC.c[0]); _Pragma("unroll") for (int k = 0; k < 16; ++k) p[k] = (float)(GA_C16 ? ((ah[k] << 8) + al[k]) : ah[k]) * cs; }     \
                g_finish<PH>(a, PRT, t, j, lane, p, xs, SDC.d[0]); }
#pragma unroll 1
            for (int ti = 0; ti < GA_TC; ti += 2) {
                if (ti == GA_TC - 2) { cn = (unsigned)__builtin_amdgcn_readfirstlane((int)cnv); if (cn < (unsigned)GA_NCH) tnf = (int)cn * GA_TC; }
                G_TOKEN(ix, sd, ixn, sn, ti, t + 1) G_TOKEN(ixn, sn, ix, sd, ti + 1, (ti + 2 < GA_TC) ? t + 1 : tnf) }
#undef G_TOKEN
            if (cn >= (unsigned)GA_NCH) break;
            c = cn;
        }
    }
}
__device__ __forceinline__ void phase_p16(const Args& a) {
    const int tid = tid_();
    const f32x4* pp = (const f32x4*)a.in[1]; h16* dp = (h16*)(a.ws + O_P16P);
    const int np4 = MTOK * 64, st = gridDim.x * NTHREADS;
    for (int i = blockIdx.x * NTHREADS + tid; i < np4; i += 4 * st) {
        f32x4 pv[4];
#pragma unroll
        for (int q = 0; q < 4; ++q) if (i + q * st < np4) pv[q] = pp[i + q * st];
#pragma unroll
        for (int q = 0; q < 4; ++q) if (i + q * st < np4) { const int n = i + q * st; *(h16x4*)(dp + (size_t)(n >> 6) * 1024 + (n & 63) * 4) = pack4(pv[q]); }
    }
}
__device__ __forceinline__ void phase_coef(const Args& a) {
    const int tid = tid_();
    const h16* PART = (const h16*)(a.ws + O_PART); const unsigned short* IDX = (const unsigned short*)(a.ws + O_IDX);
    const h16* GATE = (const h16*)(a.ws + O_GATE); const float* RS1 = (const float*)(a.ws + O_RS1);
    const float* USC = (const float*)(a.ws + O_USC); const float* VSC = (const float*)(a.ws + O_VSC);
    u32x4* CQ = (u32x4*)(a.ws + O_COEF); float* CS = (float*)(a.ws + O_COEFS);
    for (int task = blockIdx.x * NTHREADS + tid; task < MTOK * 8; task += gridDim.x * NTHREADS) {
        const size_t i = (size_t)task * 16;
        float sacc[16];
#pragma unroll
        for (int k = 0; k < 16; ++k) sacc[k] = 0.f;
#pragma unroll
        for (int j = 0; j < 8; ++j) { const h16x8 p0 = *(const h16x8*)(PART + (size_t)j * MTOK * 128 + i), p1 = *(const h16x8*)(PART + (size_t)j * MTOK * 128 + i + 8);
#pragma unroll
            for (int k = 0; k < 8; ++k) { sacc[k] += (float)p0[k]; sacc[8 + k] += (float)p1[k]; } }
        const u32x4 e0 = *(const u32x4*)(IDX + i), e1 = *(const u32x4*)(IDX + i + 8);
        const h16x8 gt0 = *(const h16x8*)(GATE + i), gt1 = *(const h16x8*)(GATE + i + 8);
        const float rs = RS1[task >> 3];
        float c[16]; float mx = 0.f;
#pragma unroll
        for (int k = 0; k < 16; ++k) { const unsigned w = (k < 8) ? e0[(k & 7) >> 1] : e1[(k & 7) >> 1]; const unsigned e = (k & 1) ? (w >> 16) : (w & 0xffffu);
            c[k] = (float)(k < 8 ? gt0[k & 7] : gt1[k & 7]) * gelu_tanh(rs * USC[e] * sacc[k]) * VSC[e]; mx = fmaxf(mx, fabsf(c[k])); }
        const float qmax = GA_C16 ? 32639.0f : 127.0f;
        const float inv = (mx > 0.f) ? qmax / mx : 0.f;
        u32x4 hw, lw;
#pragma unroll
        for (int g = 0; g < 4; ++g) { unsigned h4 = 0u, l4 = 0u;
#pragma unroll
            for (int b = 0; b < 4; ++b) { const int q = __float2int_rn(c[4 * g + b] * inv), hi = GA_C16 ? ((q + 128) >> 8) : q, lo = GA_C16 ? (q - (hi << 8)) : 0;
                h4 |= (unsigned)(hi & 0xff) << (8 * b); l4 |= (unsigned)(lo & 0xff) << (8 * b); }
            hw[g] = h4; lw[g] = l4; }
        CQ[(size_t)task * 2] = hw; if (GA_C16) CQ[(size_t)task * 2 + 1] = lw;
        CS[task] = mx / qmax;
    }
}

__device__ __forceinline__ void phase_final(const Args& a) {
    const int tid = tid_(), lane = tid & 63, wave = tid >> 6;
    const int gw = blockIdx.x * NWAVES + wave, NGW = gridDim.x * NWAVES;
    const float* part = (const float*)(a.ws + O_PART3); const float* fg = a.in[28];
    f32x4 g4[4];
#pragma unroll
    for (int j = 0; j < 4; ++j) g4[j] = *((const f32x4*)fg + lane + 64 * j);
    const h16* h3b = (const h16*)(a.ws + O_XN);
#define FN_LOAD(SV, HV, RQ) do { _Pragma("unroll") for (int q = 0; q < 4; ++q) { const int r = (RQ) + q * NGW; if (r < MTOK) { SV[q] = (lane < 16) ? part[(size_t)r * 16 + lane] : 0.f; \
            const h16x4* hr = (const h16x4*)(h3b + (size_t)r * 1024) + lane; _Pragma("unroll") for (int j = 0; j < 4; ++j) HV[q][j] = hr[64 * j]; } } } while (0)
#define FN_COMP(SV, HV, RQ) do { _Pragma("unroll") for (int q = 0; q < 4; ++q) { const int r = (RQ) + q * NGW; if (r < MTOK) { \
            const float s = wave_sum(SV[q]); \
            const float rs = rsqrtf(s * (1.f / 1024.f) + NORM_EPS); \
            f32x4* xr = (f32x4*)(a.out + (size_t)r * 1024) + lane; \
            _Pragma("unroll") for (int j = 0; j < 4; ++j) { const h16x4 h = HV[q][j]; xr[64 * j] = (f32x4){(float)h[0], (float)h[1], (float)h[2], (float)h[3]} * rs * g4[j]; } } } } while (0)
    float svA[4], svB[4]; h16x4 hvA[4][4], hvB[4][4];
    const int step = 4 * NGW;
    FN_LOAD(svA, hvA, gw);
    for (int rq = gw; rq < MTOK; rq += 2 * step) {
        FN_LOAD(svB, hvB, rq + step);
        FN_COMP(svA, hvA, rq);
        FN_LOAD(svA, hvA, rq + 2 * step);
        FN_COMP(svB, hvB, rq + step);
    }
#undef FN_LOAD
#undef FN_COMP
}

constexpr int NPHASE = 19;
__global__ void __launch_bounds__(NTHREADS, 2) mk(Args a) {
    LAS unsigned char* lds = (LAS unsigned char*)smem;
    unsigned char* ws = a.ws;
    if (a.ph_hi < 0) { cg::grid_group grid = cg::this_grid(); grid.sync(); }
    volatile LAS unsigned* bst = (volatile LAS unsigned*)(lds + 131072);
    if ((threadIdx.x & 63) == 0) ((volatile LAS unsigned char*)(lds + LDS_WAVE_TAB))[hw_slot_()] = (unsigned char)(threadIdx.x >> 6);
    if (threadIdx.x < 16) bst[threadIdx.x] = 0u;
    __syncthreads();
    const XcdBarrier xbar = xcd_barrier_post((unsigned*)(a.ws + O_BAR), bst);
#define SYNC() xcd_barrier(xbar)
#define IN(k) (a.ph_lo <= (k) && (k) < a.ph_hi)
#define SEAM(k) do { if (IN(k) && IN((k) + 1)) SYNC(); } while (0)
#define REPS(k) ((((REP_MASK) >> (k)) & 1u) ? 2 : 1)
    const int G = gridDim.x, bid = blockIdx.x;
    if (IN(0)) for (int rep = 0; rep < REPS(0); ++rep) { if (rep) SYNC(); phase_prep(a, lds); } SEAM(0);
    if (IN(1)) for (int rep = 0; rep < REPS(1); ++rep) { if (rep) SYNC(); pg8::Gemm g{(const h16*)(ws + O_XN), (const h16*)(ws + O_WIN), MTOK, NIN, 1024, nullptr, nullptr}; pg8::StaticOrder S; S.init(MTOK, NIN, G, bid);
        EpiZ E{(h16*)(ws + O_ZC), (h16*)(ws + O_ZR), (h16*)(ws + O_ZG)}; pg8::gemm_phase(lds, g, S, E); } SEAM(1);
    if (IN(2)) for (int rep = 0; rep < REPS(2); ++rep) { if (rep) SYNC(); phase_conv(a); phase_rwkv_prep(a); } SEAM(2);
    if (IN(3)) for (int rep = 0; rep < REPS(3); ++rep) { if (rep) SYNC(); pg8::Gemm g{(const h16*)(ws + O_APR), (const h16*)(ws + O_WLR), MTOK, 1536, 256, nullptr, nullptr, 0, 0, 1}; pg8::StaticOrder S; S.init(MTOK, 1536, G, bid);
        h16* R = (h16*)a.out; h16* KS = R + (size_t)MTOK * 512; h16* KK = KS + (size_t)2 * MTOK * 512;
        EpiLR E{a.in[7], a.in[9], a.in[13], (h16*)(ws + O_WD), KS, (h16*)(ws + O_BD), (h16*)(ws + O_GG), KK}; pg8::gemm_phase(lds, g, S, E); } SEAM(3);
    if (IN(4)) { for (int st = 0; st <= UT_SEG; ++st) { if (st) SYNC(); phase_ut_step(a, lds, st); } }
    SEAM(6);
    if (IN(7)) for (int rep = 0; rep < REPS(7); ++rep) { if (rep) SYNC(); phase_rwkv_post(a, POST_EARLY, UT_SEG, bid * NWAVES + (tid_() >> 6), G * NWAVES); } SEAM(7);
    if (IN(9)) for (int rep = 0; rep < REPS(9); ++rep) { if (rep) SYNC(); pg8::Gemm g{(const h16*)(ws + O_CA), (const h16*)(ws + O_WA), MTOK, 1024, 512, (const h16*)(ws + O_YB), (const h16*)(ws + O_WB)}; pg8::StaticOrder S; S.init(MTOK, 1024, G, bid);
        EpiMerged E{(const h16*)(ws + O_ZG), (h16*)(ws + O_MERGED)}; pg8::gemm_phase(lds, g, S, E); }
    SEAM(9);
    if (IN(10)) for (int rep = 0; rep < REPS(10); ++rep) { if (rep) SYNC(); pg8::Gemm g{(const h16*)(ws + O_MERGED), (const h16*)(ws + O_WO), MTOK, 1024, 1024, nullptr, nullptr}; pg8::StaticOrder S; S.init(MTOK, 1024, G, bid);
        EpiH1 E{a.in[0], (h16*)(ws + O_H1B), (float*)(ws + O_PART1)}; pg8::gemm_phase(lds, g, S, E); } SEAM(10);
    if (IN(11)) for (int rep = 0; rep < REPS(11); ++rep) { if (rep) SYNC(); pg8::Gemm g{(const h16*)(ws + O_H1B), (const h16*)(ws + O_WS), MTOK, 2048, 1024, nullptr, nullptr}; pg8::StaticOrder S; S.init(MTOK, 2048, G, bid);
        EpiF16 E{(h16*)(ws + O_SCORES), 2048}; pg8::gemm_phase(lds, g, S, E); } SEAM(11);
    if (IN(12)) for (int rep = 0; rep < REPS(12); ++rep) { if (rep) SYNC(); phase_topk(a, lds); } SEAM(12);
    if (IN(13)) for (int rep = 0; rep < REPS(13); ++rep) { if (rep) SYNC(); phase_gather<0>(a, 2 * rep); } SEAM(13);
    if (IN(14)) for (int rep = 0; rep < REPS(14); ++rep) { if (rep) SYNC(); phase_coef(a); }
    SEAM(14);
    if (IN(15)) for (int rep = 0; rep < REPS(15); ++rep) { if (rep) SYNC(); phase_p16(a); phase_gather<1>(a, 1 + 2 * rep); } SEAM(15);
    if (IN(17)) for (int rep = 0; rep < REPS(17); ++rep) { if (rep) SYNC();
        pg8::Gemm g{(const h16*)(ws + O_P16P), (const h16*)(ws + O_WP), MTOK, 1024, 256, (const h16*)(ws + O_H2B), (const h16*)(ws + O_WG), 1024, 1024}; pg8::StaticOrder S; S.init(MTOK, 1024, G, bid);
        EpiPPGate E{(h16*)(ws + O_XN), (const h16*)(ws + O_H2B), (h16*)(ws + O_PP), (const float*)(ws + O_SS2), (float*)(ws + O_PART3)}; pg8::gemm_phase(lds, g, S, E); } SEAM(17);
    if (IN(18)) for (int rep = 0; rep < REPS(18); ++rep) { if (rep) SYNC(); phase_final(a); }
}

extern "C" void kernel_launch(void* const* d_in, const int* in_sizes, int n_in, void* d_out, int out_size, void* d_ws, size_t ws_size, hipStream_t stream) {
    static int ready = 0, grid = NBLK;
    if (!ready) {
        if (n_in != 29 || ws_size < WS_END) { fprintf(stderr, "kernel_launch: unexpected n_in %d / ws %zu (need %zu)\n", n_in, ws_size, (size_t)WS_END); ready = -1; return; }
        if (hipFuncSetAttribute((const void*)mk, hipFuncAttributeMaxDynamicSharedMemorySize, LDS_BYTES) != hipSuccess) { fprintf(stderr, "hipFuncSetAttribute failed\n"); ready = -1; return; }
        int dev = 0, cus = 0, per_cu = 0;
        if (hipGetDevice(&dev) == hipSuccess && hipDeviceGetAttribute(&cus, hipDeviceAttributeMultiprocessorCount, dev) == hipSuccess &&
            hipOccupancyMaxActiveBlocksPerMultiprocessor(&per_cu, (const void*)mk, NTHREADS, LDS_BYTES) == hipSuccess && cus > 0 && per_cu > 0) grid = cus < NBLK ? cus : NBLK;
        else { (void)hipGetLastError(); grid = NBLK; }
        ready = 1;
    }
    if (ready < 0) return;
    Args a{};
    for (int i = 0; i < 29; ++i) a.in[i] = (const float*)d_in[i];
    a.out = (float*)d_out; a.ws = (unsigned char*)d_ws;
    (void)hipMemsetAsync((unsigned char*)d_ws + O_BAR, 0, 16384, stream);
    a.ph_lo = 0; a.ph_hi = NPHASE;
    void* args[] = {&a};
    if (hipLaunchCooperativeKernel((const void*)mk, dim3(grid), dim3(NTHREADS), args, LDS_BYTES, stream) != hipSuccess) fprintf(stderr, "cooperative launch failed (grid %d)\n", grid);
}
```
